# Optimizing an MI355X kernel written in HIP

```python
import jax
import jax.numpy as jnp
from jax import lax
import numpy as np

D_MODEL = 1024
BATCH = 8
SEQ = 8192
DEPTH = 4

GRID_W = 64
CTX_LEN = 256
N_MIXERS = 2
EPS = 1e-6
N_MOD = 6

M_HEADS = 8
M_DK = 64
M_DV = 128
M_CHUNK = 64
M_CONV = 3
M_F_BIAS = 3.5

H_HEADS = 8
H_DK = 128
H_DV = 128
H_CHUNK = 32

FFN_HIDDEN = 2816
N_EXPERTS = 8
TOP_K = 2
EXPERT_HIDDEN = 2816

F32 = jnp.float32

kernel_name = 'hybrid_mlstm_hgrn2_moe_dit'


def rmsnorm(x, g):
    xf = x.astype(F32)
    y = xf * lax.rsqrt(jnp.mean(xf * xf, axis=-1, keepdims=True) + EPS)
    return (y * g.astype(F32)).astype(x.dtype)


def short_conv(x, w):
    K, C = w.shape
    left = (K - 1) // 2
    return lax.conv_general_dilated(x, w[:, None, :].astype(x.dtype), window_strides=(1,),
                                    padding=[(left, K - 1 - left)],
                                    dimension_numbers=('NWC', 'WIO', 'NWC'),
                                    feature_group_count=C)


def to_heads(a, n_heads):
    B, T, C = a.shape
    return a.reshape(B, T, n_heads, C // n_heads).transpose(0, 2, 1, 3).astype(F32)


def to_chunks(a, L):
    B, H, T = a.shape[:3]
    return jnp.moveaxis(a.reshape(B, H, T // L, L, *a.shape[3:]), 2, 0)


def from_chunks(a):
    N, B, H, L = a.shape[:4]
    return jnp.moveaxis(a, 0, 2).reshape(B, H, N * L, *a.shape[4:])


def to_column_major(a, rows):
    B, T, C = a.shape
    return a.reshape(B, rows, GRID_W, C).transpose(0, 2, 1, 3).reshape(B, T, C)


def from_column_major(a, rows):
    B, T, C = a.shape
    return a.reshape(B, GRID_W, rows, C).transpose(0, 2, 1, 3).reshape(B, T, C)


def mlstm_scan(q, k, v, ig, lf, state):
    L = M_CHUNK
    causal = jnp.tril(jnp.ones((L, L), dtype=bool))

    def step(carry, xs):
        C, n, m = carry
        qc, kc, vc, ic, fc = xs
        b = jnp.cumsum(fc, axis=-1)
        d = jnp.where(causal, b[..., :, None] - b[..., None, :] + ic[..., None, :], -jnp.inf)
        inter = b + m[..., None]
        m_t = jnp.maximum(inter, jnp.max(d, axis=-1))
        s = jnp.einsum('bhtd,bhsd->bhts', qc, kc) * jnp.exp(d - m_t[..., None])
        w_inter = jnp.exp(inter - m_t)
        num = jnp.einsum('bhts,bhsv->bhtv', s, vc) + w_inter[..., None] * jnp.einsum('bhtd,bhdv->bhtv', qc, C)
        den = jnp.sum(s, axis=-1) + w_inter * jnp.einsum('bhtd,bhd->bht', qc, n)
        h = num / jnp.maximum(jnp.abs(den), jnp.exp(-m_t))[..., None]
        b_last = b[..., -1]
        g = b_last[..., None] - b + ic
        m_new = jnp.maximum(b_last + m, jnp.max(g, axis=-1))
        w_k = jnp.exp(g - m_new[..., None])
        decay = jnp.exp(b_last + m - m_new)
        C = decay[..., None, None] * C + jnp.einsum('bhs,bhsd,bhsv->bhdv', w_k, kc, vc)
        n = decay[..., None] * n + jnp.einsum('bhs,bhsd->bhd', w_k, kc)
        return (C, n, m_new), h

    state, h = lax.scan(step, state, tuple(to_chunks(a, L) for a in (q, k, v, ig, lf)))
    return from_chunks(h), state


def hgrn2_scan(q, k, v, lf, S):
    L = H_CHUNK
    causal = jnp.tril(jnp.ones((L, L), dtype=bool))[:, :, None]

    def step(S, xs):
        qc, kc, vc, fc = xs
        a = jnp.cumsum(fc, axis=-2)
        decay = jnp.exp(jnp.where(causal, a[..., :, None, :] - a[..., None, :, :], -jnp.inf))
        s = jnp.einsum('bhtd,bhsd,bhtsd->bhts', qc, kc, decay)
        o = jnp.einsum('bhts,bhsv->bhtv', s, vc) + jnp.einsum('bhtd,bhdv->bhtv', qc * jnp.exp(a), S)
        a_last = a[..., -1:, :]
        S = jnp.exp(a_last[..., 0, :])[..., None] * S + jnp.einsum('bhsd,bhsv->bhdv', kc * jnp.exp(a_last - a), vc)
        return S, o

    S, o = lax.scan(step, S, tuple(to_chunks(a, L) for a in (q, k, v, lf)))
    return from_chunks(o), S


def _flip_t(a):
    return jnp.flip(a, axis=2)


def bidirectional_scan(scan_fn, ctx_fwd, ctx_bwd, lat_fwd, lat_bwd, state0):
    hc_f, st_f = scan_fn(*ctx_fwd, state0)
    hc_b, st_b = scan_fn(*[_flip_t(a) for a in ctx_bwd], state0)
    hl_f, _ = scan_fn(*lat_fwd, st_f)
    hl_b, _ = scan_fn(*[_flip_t(a) for a in lat_bwd], st_b)
    return hc_f + _flip_t(hc_b), hl_f + _flip_t(hl_b)


def head_out(h, gate, g_head, w_out, dtype):
    B, H, T, dv = h.shape
    h = h.transpose(0, 2, 1, 3)
    h = h * lax.rsqrt(jnp.mean(h * h, axis=-1, keepdims=True) + EPS)
    h = h.reshape(B, T, H * dv) * g_head.astype(F32) * gate
    return h.astype(dtype) @ w_out


def mlstm_mixer(u_ctx, u_lat, w_in, b_gate, w_conv, g_head, w_out, with_ctx_out):
    qk_w = 2 * M_HEADS * M_DK
    v_w = M_HEADS * M_DV

    def streams(u):
        B, T, _ = u.shape
        qk, v, o, gates = jnp.split(u @ w_in, [qk_w, qk_w + v_w, qk_w + 2 * v_w], axis=-1)
        qk = jax.nn.silu(short_conv(qk, w_conv))
        q, k = jnp.split(qk, 2, axis=-1)
        q = to_heads(q, M_HEADS)
        k = to_heads(k, M_HEADS) * (M_DK ** -0.5)
        v = to_heads(v, M_HEADS)
        g = (gates + b_gate.reshape(-1)).astype(F32).reshape(B, T, 4, M_HEADS).transpose(2, 0, 3, 1)
        fwd = (q, k, v, g[0], jax.nn.log_sigmoid(g[1]))
        bwd = (q, k, v, g[2], jax.nn.log_sigmoid(g[3]))
        return fwd, bwd, jax.nn.sigmoid(o.astype(F32))

    c_fwd, c_bwd, c_gate = streams(u_ctx)
    l_fwd, l_bwd, l_gate = streams(u_lat)
    B = u_lat.shape[0]
    state0 = (jnp.zeros((B, M_HEADS, M_DK, M_DV), F32),
              jnp.zeros((B, M_HEADS, M_DK), F32),
              jnp.zeros((B, M_HEADS), F32))
    h_ctx, h_lat = bidirectional_scan(mlstm_scan, c_fwd, c_bwd, l_fwd, l_bwd, state0)
    y_lat = head_out(h_lat, l_gate, g_head, w_out, u_lat.dtype)
    y_ctx = head_out(h_ctx, c_gate, g_head, w_out, u_ctx.dtype) if with_ctx_out else None
    return y_ctx, y_lat


def hgrn2_mixer(u_ctx, u_lat, w_in, b_f, lb, g_head, w_out, rows, with_ctx_out):
    kw = H_HEADS * H_DK
    vw = H_HEADS * H_DV

    def streams(u):
        q, v, f_f, f_b, g = jnp.split(u @ w_in, [kw, kw + vw, 2 * kw + vw, 3 * kw + vw], axis=-1)

        def direction(f_pre, bias, lbd):
            f = lbd + (1.0 - lbd) * jax.nn.sigmoid(f_pre.astype(F32) + bias.astype(F32))
            return to_heads(1.0 - f, H_HEADS), to_heads(jnp.log(f), H_HEADS)

        k_f, lf_f = direction(f_f, b_f[0], lb[0])
        k_b, lf_b = direction(f_b, b_f[1], lb[1])
        q = to_heads(q, H_HEADS)
        v = to_heads(v, H_HEADS)
        return (q, k_f, v, lf_f), (q, k_b, v, lf_b), jax.nn.sigmoid(g.astype(F32))

    c_fwd, c_bwd, c_gate = streams(u_ctx)
    l_fwd, l_bwd, l_gate = streams(to_column_major(u_lat, rows))
    B = u_lat.shape[0]
    state0 = jnp.zeros((B, H_HEADS, H_DK, H_DV), F32)
    h_ctx, h_lat = bidirectional_scan(hgrn2_scan, c_fwd, c_bwd, l_fwd, l_bwd, state0)
    y_lat = from_column_major(head_out(h_lat, l_gate, g_head, w_out, u_lat.dtype), rows)
    y_ctx = head_out(h_ctx, c_gate, g_head, w_out, u_ctx.dtype) if with_ctx_out else None
    return y_ctx, y_lat


def swiglu(u, w_gu, w_down):
    g, up = jnp.split(u @ w_gu, 2, axis=-1)
    return (jax.nn.silu(g) * up) @ w_down


def moe_swiglu(u, w_router, b_router, w_gu, w_down):
    logits = (u @ w_router).astype(F32) + b_router.astype(F32)
    top_val, top_idx = lax.top_k(logits, TOP_K)
    weights = jax.nn.softmax(top_val, axis=-1)
    combine = jnp.einsum('...k,...ke->...e', weights, jax.nn.one_hot(top_idx, N_EXPERTS, dtype=F32))
    out = jnp.zeros(u.shape[:-1] + (w_down.shape[-1],), F32)
    for e in range(N_EXPERTS):
        out = out + combine[..., e:e + 1] * swiglu(u, w_gu[e], w_down[e]).astype(F32)
    return out.astype(u.dtype)


def setup_inputs(seed: int = 0) -> dict:
    key = jax.random.key(seed)
    keys = jax.random.split(key, 24)
    D = D_MODEL
    n_even = (DEPTH + 1) // 2
    n_odd = DEPTH // 2
    m_in = 2 * M_HEADS * M_DK + 2 * M_HEADS * M_DV + 4 * M_HEADS
    h_in = 3 * H_HEADS * H_DK + 2 * H_HEADS * H_DV

    def nrm(k, shape, scale):
        return jax.random.normal(k, shape, jnp.float32) * scale

    gate_offset = jnp.tile(jnp.array([0.0, M_F_BIAS, 0.0, M_F_BIAS], jnp.float32)[:, None], (1, M_HEADS))
    return {
        'x': nrm(keys[0], (BATCH, SEQ, D), 1.0),
        'c': nrm(keys[1], (BATCH, D), 1.0),
        'ctx': nrm(keys[2], (BATCH, CTX_LEN, D), 1.0),
        'c_ctx': nrm(keys[3], (D,), 1.0),
        'mod_w': nrm(keys[4], (DEPTH, D, N_MOD * D), 0.5 * D ** -0.5),
        'mod_b': nrm(keys[5], (DEPTH, N_MOD * D), 0.02),
        'norm_g': 1.0 + nrm(keys[6], (DEPTH, 4, D), 0.1),
        'm_w_in': nrm(keys[7], (n_even, D, m_in), D ** -0.5),
        'm_b_gate': gate_offset + nrm(keys[8], (n_even, 4, M_HEADS), 0.5),
        'm_w_conv': nrm(keys[9], (n_even, M_CONV, 2 * M_HEADS * M_DK), M_CONV ** -0.5),
        'm_g_head': 1.0 + nrm(keys[10], (n_even, M_HEADS * M_DV), 0.1),
        'm_w_out': nrm(keys[11], (n_even, M_HEADS * M_DV, D), (M_HEADS * M_DV) ** -0.5),
        'h_w_in': nrm(keys[12], (n_odd, D, h_in), D ** -0.5),
        'h_b_f': nrm(keys[13], (n_odd, 2, H_HEADS * H_DK), 0.1),
        'h_lb_raw': nrm(keys[14], (n_odd, 2, H_HEADS * H_DK), 1.0),
        'h_g_head': 1.0 + nrm(keys[15], (n_odd, H_HEADS * H_DV), 0.1),
        'h_w_out': nrm(keys[16], (n_odd, H_HEADS * H_DV, D), (H_HEADS * H_DV) ** -0.5),
        'f_w_gu': nrm(keys[17], (n_even, D, 2 * FFN_HIDDEN), D ** -0.5),
        'f_w_down': nrm(keys[18], (n_even, FFN_HIDDEN, D), FFN_HIDDEN ** -0.5),
        'e_w_router': nrm(keys[19], (n_odd, D, N_EXPERTS), D ** -0.5),
        'e_b_router': nrm(keys[20], (n_odd, N_EXPERTS), 0.01),
        'e_w_gu': nrm(keys[21], (n_odd, N_EXPERTS, D, 2 * EXPERT_HIDDEN), D ** -0.5),
        'e_w_down': nrm(keys[22], (n_odd, N_EXPERTS, EXPERT_HIDDEN, D), EXPERT_HIDDEN ** -0.5),
    }


def reference(x, c, ctx, c_ctx, mod_w, mod_b, norm_g, m_w_in, m_b_gate, m_w_conv, m_g_head, m_w_out,
              h_w_in, h_b_f, h_lb_raw, h_g_head, h_w_out, f_w_gu, f_w_down,
              e_w_router, e_b_router, e_w_gu, e_w_down):
    B = x.shape[0]
    rows = x.shape[1] // GRID_W
    silu_c = jax.nn.silu(c)
    silu_cc = jax.nn.silu(c_ctx)
    lb_all = jax.nn.softmax(h_lb_raw.astype(F32), axis=0)
    lb_all = jnp.cumsum(lb_all, axis=0) - lb_all[0]
    lat, cx = x, ctx
    for i in range(DEPTH):
        j = i // 2
        with_ctx = i < DEPTH - 1
        mod_l = (silu_c @ mod_w[i] + mod_b[i]).reshape(B, 1, N_MOD, D_MODEL)
        mod_c = (silu_cc @ mod_w[i] + mod_b[i]).reshape(1, N_MOD, D_MODEL)
        sh1, sc1, gt1, sh2, sc2, gt2 = [mod_l[:, :, s] for s in range(N_MOD)]
        csh1, csc1, cgt1, csh2, csc2, cgt2 = [mod_c[:, s] for s in range(N_MOD)]

        u_l = rmsnorm(lat, norm_g[i, 0]) * (1 + sc1) + sh1
        u_c = rmsnorm(cx, norm_g[i, 0]) * (1 + csc1) + csh1
        if i % N_MIXERS == 0:
            y_c, y_l = mlstm_mixer(u_c, u_l, m_w_in[j], m_b_gate[j], m_w_conv[j], m_g_head[j], m_w_out[j], with_ctx)
        else:
            y_c, y_l = hgrn2_mixer(u_c, u_l, h_w_in[j], h_b_f[j], lb_all[j], h_g_head[j], h_w_out[j], rows, with_ctx)
        lat = lat + gt1 * rmsnorm(y_l, norm_g[i, 1])

        if i % 2 == 0:
            ffn = lambda u: swiglu(u, f_w_gu[j], f_w_down[j])
        else:
            ffn = lambda u: moe_swiglu(u, e_w_router[j], e_b_router[j], e_w_gu[j], e_w_down[j])
        u_l = rmsnorm(lat, norm_g[i, 2]) * (1 + sc2) + sh2
        lat = lat + gt2 * rmsnorm(ffn(u_l), norm_g[i, 3])

        if with_ctx:
            cx = cx + cgt1 * rmsnorm(y_c, norm_g[i, 1])
            u_c = rmsnorm(cx, norm_g[i, 2]) * (1 + csc2) + csh2
            cx = cx + cgt2 * rmsnorm(ffn(u_c), norm_g[i, 3])
    return lat
```

```cpp
#include <hip/hip_runtime.h>
#include <cstdio>
#include <cstdint>

namespace pg8 {
#define PG8_LAS __attribute__((address_space(3)))
typedef unsigned short bf16_t;
typedef short bf16x8 __attribute__((ext_vector_type(8)));
typedef float f32x4 __attribute__((ext_vector_type(4)));
typedef unsigned u32x4 __attribute__((ext_vector_type(4)));
constexpr int BM = 256, BK = 64, HALF = 128, HTB = HALF * BK * 2  , STAGE_BYTES = 8 * HTB, NXCD = 8, WGM = 8;

__host__ __device__ __forceinline__ int lds_byte(int r, int c) { const int st = (r >> 4) * 2 + (c >> 5), rr = r & 15, cc = c & 31, ob = rr * 64 + cc * 2; return st * 1024 + (ob ^ (((ob >> 9) & 1) << 5)); }
__host__ __device__ __forceinline__ void stage_rc(int b, int& R, int& C) { const int st = b / 1024, sb = b % 1024, swz = sb ^ (((sb >> 9) & 1) << 5); R = (st >> 1) * 16 + swz / 64; C = (st & 1) * 32 + (swz % 64) / 2; }
__host__ __device__ __forceinline__ int perm32(int rho) { const int n = rho >> 4, i = rho & 15; return 8 * (i >> 2) + 4 * n + (i & 3); }

struct Unit { int pm, pn; };
struct Gemm { const bf16_t* A; const bf16_t* Bt; int M, N, K; };

struct Order {
    int nM, nN, nwg, G, c; const int* pexp; size_t bstride;
    __device__ void init(int nM_, int N, int G_, int c_, const int* pexp_, size_t bstride_) { nM = nM_; nN = N / BM; nwg = nM * nN; G = G_; c = c_; pexp = pexp_; bstride = bstride_; }
    __device__ bool next(int i, Unit& u) const {
        const long L = (long)i * G + c; if (L >= nwg) return false;
        int wgid = (int)L; { const int q = nwg / NXCD, r = nwg % NXCD, xcd = wgid % NXCD, off = wgid / NXCD; wgid = (xcd < r ? xcd * (q + 1) : r * (q + 1) + (xcd - r) * q) + off; }
        const int nig = WGM * nN, gid = wgid / nig, fm = gid * WGM, gsz = (nM - fm) < WGM ? (nM - fm) : WGM;
        u.pm = fm + ((wgid % nig) % gsz); u.pn = (wgid % nig) / gsz; return true;
    }
    __device__ __forceinline__ size_t boff(const Unit& u) const { return pexp ? (size_t)__builtin_amdgcn_readfirstlane(pexp[u.pm]) * bstride : (size_t)0; }
    __device__ __forceinline__ void a_ready(const Unit&) const {}
    __device__ __forceinline__ void done(const Unit&) const {}
};

__device__ __forceinline__ unsigned cvt_pk_bf16(float lo, float hi) { unsigned r; asm volatile("v_cvt_pk_bf16_f32 %0, %1, %2" : "=v"(r) : "v"(lo), "v"(hi)); return r; }

struct EpiStore {
    static constexpr bool PERM = true, AFTER_DRAIN = false;
    bf16_t* O; int ldc; int ncol_tiles; int gate_pn; float* gates;
    __device__ __forceinline__ void operator()(const f32x4 (&acc)[2][2][4][2], const Unit& u, int wr, int wc, int fr, int fq) const {
        const int row0 = u.pm * BM + wr * 64 + fr;
        if (u.pn < ncol_tiles) {
            const int col0 = u.pn * BM + wc * 32 + 8 * fq;
#pragma unroll
            for (int ai = 0; ai < 2; ++ai)
#pragma unroll
                for (int m = 0; m < 4; ++m) { bf16_t* rowp = O + (size_t)(row0 + ai * HALF + m * 16) * ldc + col0;
#pragma unroll
                    for (int bj = 0; bj < 2; ++bj) { const f32x4 v0 = acc[ai][bj][m][0], v1 = acc[ai][bj][m][1];
                        u32x4 w; w.x = cvt_pk_bf16(v0[0], v0[1]); w.y = cvt_pk_bf16(v0[2], v0[3]); w.z = cvt_pk_bf16(v1[0], v1[1]); w.w = cvt_pk_bf16(v1[2], v1[3]);
                        *(u32x4*)(rowp + bj * HALF) = w; } }
        } else if (u.pn == gate_pn && wc == 0) {
#pragma unroll
            for (int ai = 0; ai < 2; ++ai)
#pragma unroll
                for (int m = 0; m < 4; ++m) { float* rowp = gates + (size_t)(row0 + ai * HALF + m * 16) * 32 + 8 * fq;
                    *(f32x4*)(rowp) = acc[ai][0][m][0]; *(f32x4*)(rowp + 4) = acc[ai][0][m][1]; }
        }
    }
};
struct EpiSwiGLU {
    static constexpr bool PERM = true, AFTER_DRAIN = false;
    bf16_t* O; int ldc;
    __device__ __forceinline__ void operator()(const f32x4 (&acc)[2][2][4][2], const Unit& u, int wr, int wc, int fr, int fq) const {
        const int row0 = u.pm * BM + wr * 64 + fr, col0 = u.pn * HALF + wc * 32 + 8 * fq;
#pragma unroll
        for (int ai = 0; ai < 2; ++ai)
#pragma unroll
            for (int m = 0; m < 4; ++m) { bf16_t* rowp = O + (size_t)(row0 + ai * HALF + m * 16) * ldc + col0; float r[8];
#pragma unroll
                for (int n = 0; n < 2; ++n)
#pragma unroll
                    for (int j = 0; j < 4; ++j) { const float g = acc[ai][0][m][n][j], up = acc[ai][1][m][n][j]; r[n * 4 + j] = g * __builtin_amdgcn_rcpf(1.0f + __expf(-g)) * up; }
                u32x4 w; w.x = cvt_pk_bf16(r[0], r[1]); w.y = cvt_pk_bf16(r[2], r[3]); w.z = cvt_pk_bf16(r[4], r[5]); w.w = cvt_pk_bf16(r[6], r[7]);
                *(u32x4*)(rowp) = w; }
    }
};

template <class Epi, class Sched, bool ALIGN_EPI = false, bool SP2 = false>
__device__ __forceinline__ void gemm_phase(PG8_LAS unsigned char* lds, const Gemm g, const Sched& S, const Epi& E) {
    int tid = threadIdx.x; asm volatile("" : "+v"(tid)); const int wid = __builtin_amdgcn_readfirstlane(tid >> 6), lane = tid & 63, wr = wid >> 2, wc = wid & 3, fr = lane & 15, fq = lane >> 4;
    const int K = g.K, nt = K / BK;
    unsigned voffA[2], voffB[2];
#pragma unroll
    for (int i = 0; i < 2; ++i) { int R, C; stage_rc(tid * 16 + i * 8192, R, C); const int Rb = Epi::PERM ? ((R & ~31) + perm32(R & 31)) : R;
        voffA[i] = (unsigned)(R * K + C) * 2u; voffB[i] = (unsigned)(Rb * K + C) * 2u; }
    const size_t kstep = (size_t)(BK * 2);
    const size_t hstep = (size_t)HALF * K * 2;
    const size_t tstep = 2 * hstep;
    const unsigned ldsw = (unsigned)wid * 1024u;
    const int aoff = lds_byte(wr * 64 + fr, fq * 8), boff = lds_byte(wc * 32 + fr, fq * 8);
#define PG8_SA(b, h) (((b) * 2 + (h)) * HTB)
#define PG8_SB(b, h) ((4 + (b) * 2 + (h)) * HTB)
#define PG8_STAGE(bufoff, gbase, voff) do { _Pragma("unroll") for (int _i = 0; _i < 2; ++_i) \
        __builtin_amdgcn_global_load_lds((const unsigned*)((const char*)(gbase) + (voff)[_i]), (PG8_LAS unsigned*)(lds + (bufoff) + ldsw + _i * 8192), 16, 0, 0); } while (0)
#define PG8_LDA(dst, b, h) do { _Pragma("unroll") for (int m = 0; m < 4; ++m) _Pragma("unroll") for (int k = 0; k < 2; ++k) dst[m][k] = *(const PG8_LAS bf16x8*)(lds + PG8_SA(b, h) + aoff + m * 2048 + k * 1024); } while (0)
#define PG8_LDB(dst, b, h) do { _Pragma("unroll") for (int n = 0; n < 2; ++n) _Pragma("unroll") for (int k = 0; k < 2; ++k) dst[n][k] = *(const PG8_LAS bf16x8*)(lds + PG8_SB(b, h) + boff + n * 2048 + k * 1024); } while (0)
#define PG8_MMA(ai, bj, At, Bt) do { __builtin_amdgcn_s_setprio(1); _Pragma("unroll") for (int m = 0; m < 4; ++m) _Pragma("unroll") for (int n = 0; n < 2; ++n) _Pragma("unroll") for (int k = 0; k < 2; ++k) \
        acc[ai][bj][m][n] = __builtin_amdgcn_mfma_f32_16x16x32_bf16(Bt[n][k], At[m][k], acc[ai][bj][m][n], 0, 0, 0); __builtin_amdgcn_s_setprio(0); } while (0)
#define PG8_WAIT_V(n) asm volatile("s_waitcnt vmcnt(" #n ")" ::: "memory")
#define PG8_WAIT_L(n) asm volatile("s_waitcnt lgkmcnt(" #n ")" ::: "memory")
#define PG8_BAR __builtin_amdgcn_s_barrier()
#define PG8_SCHED __builtin_amdgcn_sched_barrier(0)
    Unit cur, nxt; int ui = 0;
    if (!S.next(0, cur)) return;
    f32x4 acc[2][2][4][2];
#pragma unroll
    for (int a = 0; a < 2; ++a)
#pragma unroll
        for (int b = 0; b < 2; ++b)
#pragma unroll
            for (int m = 0; m < 4; ++m)
#pragma unroll
                for (int n = 0; n < 2; ++n) acc[a][b][m][n] = (f32x4){0.f, 0.f, 0.f, 0.f};
    bf16x8 At[4][2], B0[2][2], B1[2][2];
    const char* cA = (const char*)g.A + (size_t)cur.pm * tstep; const char* cB = (const char*)g.Bt + S.boff(cur) + (size_t)cur.pn * tstep;
    S.a_ready(cur);
    if constexpr (SP2) {
        PG8_STAGE(PG8_SB(0, 0), cB, voffB); PG8_STAGE(PG8_SB(0, 1), cB + hstep, voffB); PG8_STAGE(PG8_SA(0, 0), cA, voffA); PG8_STAGE(PG8_SA(0, 1), cA + hstep, voffA);
        if (wr == 1) PG8_BAR;
        PG8_WAIT_V(2); PG8_BAR;
        PG8_STAGE(PG8_SB(1, 0), cB + kstep, voffB); PG8_STAGE(PG8_SA(1, 0), cA + kstep, voffA); PG8_STAGE(PG8_SB(1, 1), cB + hstep + kstep, voffB);
        PG8_WAIT_V(6); PG8_BAR;
    } else {
        PG8_STAGE(PG8_SB(0, 0), cB, voffB); PG8_STAGE(PG8_SA(0, 0), cA, voffA); PG8_STAGE(PG8_SB(0, 1), cB + hstep, voffB); PG8_STAGE(PG8_SA(0, 1), cA + hstep, voffA);
        if (wr == 1) PG8_BAR;
        PG8_WAIT_V(4); PG8_BAR;
        PG8_STAGE(PG8_SB(1, 0), cB + kstep, voffB); PG8_STAGE(PG8_SA(1, 0), cA + kstep, voffA); PG8_STAGE(PG8_SB(1, 1), cB + hstep + kstep, voffB);
        PG8_WAIT_V(6); PG8_BAR;
    }
    for (;;) {
        const bool has_next = S.next(ui + 1, nxt);
        const char* nA = has_next ? (const char*)g.A + (size_t)nxt.pm * tstep : cA; const char* nB = has_next ? (const char*)g.Bt + S.boff(nxt) + (size_t)nxt.pn * tstep : cB;
        for (int t = 0; t < nt; t += 2) {
            const bool last = (t == nt - 2);
            const char* a1 = cA + (size_t)(t + 1) * kstep;
            const char* a2 = last ? nA : cA + (size_t)(t + 2) * kstep; const char* b2 = last ? nB : cB + (size_t)(t + 2) * kstep;
            const char* a3 = a2 + kstep; const char* b3 = b2 + kstep;
            if (last && has_next) S.a_ready(nxt);
            if constexpr (SP2) {
            PG8_LDB(B0, 0, 0); PG8_LDB(B1, 0, 1); PG8_SCHED; PG8_LDA(At, 0, 0); PG8_STAGE(PG8_SA(1, 1), a1 + hstep, voffA);
            PG8_WAIT_V(8); PG8_WAIT_L(0); PG8_BAR; PG8_MMA(0, 0, At, B0); PG8_MMA(0, 1, At, B1); PG8_BAR; PG8_SCHED;
            PG8_LDA(At, 0, 1); PG8_STAGE(PG8_SB(0, 0), b2, voffB); PG8_STAGE(PG8_SB(0, 1), b2 + hstep, voffB); PG8_STAGE(PG8_SA(0, 0), a2, voffA);
            PG8_WAIT_V(8); PG8_WAIT_L(0); PG8_BAR; PG8_MMA(1, 0, At, B0); PG8_MMA(1, 1, At, B1); PG8_BAR; PG8_SCHED;
            PG8_LDB(B0, 1, 0); PG8_LDB(B1, 1, 1); PG8_SCHED; PG8_LDA(At, 1, 0); PG8_STAGE(PG8_SA(0, 1), a2 + hstep, voffA);
            PG8_WAIT_V(8); PG8_WAIT_L(0); PG8_BAR; PG8_MMA(0, 0, At, B0); PG8_MMA(0, 1, At, B1); PG8_BAR; PG8_SCHED;
            PG8_LDA(At, 1, 1); PG8_STAGE(PG8_SB(1, 0), b3, voffB); PG8_STAGE(PG8_SB(1, 1), b3 + hstep, voffB); PG8_STAGE(PG8_SA(1, 0), a3, voffA);
            PG8_WAIT_V(8); PG8_WAIT_L(0); PG8_BAR; PG8_MMA(1, 0, At, B0); PG8_MMA(1, 1, At, B1); PG8_BAR; PG8_SCHED;
            } else {
            PG8_LDB(B0, 0, 0); PG8_SCHED; PG8_LDA(At, 0, 0); PG8_STAGE(PG8_SA(1, 1), a1 + hstep, voffA);
            PG8_WAIT_L(8); PG8_BAR; PG8_WAIT_L(0); PG8_MMA(0, 0, At, B0); PG8_BAR; PG8_SCHED;
            PG8_LDB(B1, 0, 1); PG8_STAGE(PG8_SB(0, 0), b2, voffB);
            PG8_BAR; PG8_WAIT_L(0); PG8_MMA(0, 1, At, B1); PG8_BAR;
            PG8_LDA(At, 0, 1); PG8_STAGE(PG8_SA(0, 0), a2, voffA);
            PG8_BAR; PG8_WAIT_L(0); PG8_MMA(1, 0, At, B0); PG8_BAR; PG8_SCHED;
            PG8_STAGE(PG8_SB(0, 1), b2 + hstep, voffB);
            PG8_WAIT_V(6); PG8_BAR; PG8_MMA(1, 1, At, B1); PG8_BAR;
            PG8_LDB(B0, 1, 0); PG8_SCHED; PG8_LDA(At, 1, 0); PG8_STAGE(PG8_SA(0, 1), a2 + hstep, voffA);
            PG8_WAIT_L(8); PG8_BAR; PG8_WAIT_L(0); PG8_MMA(0, 0, At, B0); PG8_BAR; PG8_SCHED;
            PG8_LDB(B1, 1, 1); PG8_STAGE(PG8_SB(1, 0), b3, voffB);
            PG8_BAR; PG8_WAIT_L(0); PG8_MMA(0, 1, At, B1); PG8_BAR;
            PG8_LDA(At, 1, 1); PG8_STAGE(PG8_SA(1, 0), a3, voffA);
            PG8_BAR; PG8_WAIT_L(0); PG8_MMA(1, 0, At, B0); PG8_BAR; PG8_SCHED;
            PG8_STAGE(PG8_SB(1, 1), b3 + hstep, voffB);
            PG8_WAIT_V(6); PG8_BAR; PG8_MMA(1, 1, At, B1); PG8_BAR;
            }
        }
        if constexpr (ALIGN_EPI) { if (wr == 0) PG8_BAR; }
        if constexpr (!Epi::AFTER_DRAIN) { E(acc, cur, wr, wc, fr, fq); S.done(cur); }
        if (!has_next) break;
#pragma unroll
        for (int a = 0; a < 2; ++a)
#pragma unroll
            for (int b = 0; b < 2; ++b)
#pragma unroll
                for (int m = 0; m < 4; ++m)
#pragma unroll
                    for (int n = 0; n < 2; ++n) acc[a][b][m][n] = (f32x4){0.f, 0.f, 0.f, 0.f};
        cur = nxt; cA = nA; cB = nB; ++ui;
        if constexpr (ALIGN_EPI) { if (wr == 1) PG8_BAR; }
    }
    PG8_WAIT_V(0);
    if constexpr (!ALIGN_EPI) { if (wr == 0) PG8_BAR; }
    PG8_BAR;
    if constexpr (Epi::AFTER_DRAIN) { E.fused(acc, cur, wr, wc, fr, fq, lds, wid, lane); S.done(cur); }
#undef PG8_SA
#undef PG8_SB
#undef PG8_STAGE
#undef PG8_LDA
#undef PG8_LDB
#undef PG8_MMA
#undef PG8_WAIT_V
#undef PG8_WAIT_L
#undef PG8_BAR
#undef PG8_SCHED
}
}

constexpr int D = 1024, NB = 8, SEQ = 8192, CTXL = 256, DEPTH = 4, GRIDW = 64, ROWS_G = SEQ / GRIDW  ;
constexpr int M_LAT = NB * SEQ  , M_CTX = NB * CTXL  , M_ALL = M_LAT + M_CTX  ;
constexpr int NHEAD = 8, M_DK = 64, M_DV = 128, H_DK = 128, H_DV = 128;
constexpr int NP_M = 3072, NIN_M = 3328, NW_M = 3104, NP_H = 5120;
constexpr int FF = 2816, NGU = 2 * FF, NEXP = 8;
constexpr int MOE_ROWS = 137216, MOE_PANELS = MOE_ROWS / 256;
constexpr float EPS = 1e-6f;
constexpr int NWAVES = 8, NTHR = 512;

constexpr size_t MiB = 1u << 20;
constexpr size_t WS_CTL = 0, CTL_ZERO_BYTES = 1 * MiB;
constexpr size_t WS_MODV = 1 * MiB;
constexpr size_t WS_SMALL = 2 * MiB;
constexpr size_t WS_LATC = 3 * MiB;
constexpr size_t WS_WE = 11 * MiB;
constexpr size_t WS_WO = 37 * MiB;
constexpr size_t WS_U = 181 * MiB;
constexpr size_t WS_GATES = 313 * MiB;
constexpr size_t WS_STATE = 322 * MiB;
constexpr size_t WS_ROUTE = 362 * MiB;
constexpr size_t WS_ACT = 364 * MiB;
constexpr size_t WS_Y = WS_ACT + 700 * MiB;
constexpr size_t WS_END = WS_ACT + 1005 * MiB;
constexpr size_t WE_IN = 0, WE_OUT = 7 * MiB, WE_GU = 9 * MiB, WE_DOWN = 20 * MiB;
constexpr size_t WOD_IN = 0, WOD_OUT = 10 * MiB, WOD_GU = 12 * MiB, WOD_DOWN = 100 * MiB;
constexpr size_t EGU_BYTES = (size_t)NGU * D * 2, EDOWN_BYTES = (size_t)D * FF * 2;
static_assert(WOD_GU + 8 * EGU_BYTES <= WOD_DOWN && WOD_DOWN + 8 * EDOWN_BYTES <= 144 * MiB, "odd weights map");
static_assert((size_t)NIN_M * D * 2 <= 7 * MiB && WE_GU + EGU_BYTES <= WE_DOWN && WE_DOWN + EDOWN_BYTES <= 26 * MiB, "even weights map");
static_assert((size_t)M_ALL * NP_H * 2 <= 700 * MiB && (size_t)MOE_ROWS * D * 2 + (size_t)MOE_ROWS * FF * 2 <= 1005 * MiB && 700 * MiB + (size_t)M_ALL * D * 2 <= 1005 * MiB, "act map");
constexpr int CW_BAR = 4096;
constexpr int CW_ECNT = 8192;
constexpr int CW_DBG = 16384;
constexpr size_t RT_E = 0;
constexpr size_t RT_R = 512 * 1024;
constexpr size_t RT_W = 512 * 1024 + 1024 * 1024;
constexpr size_t SM_LB = 0;
constexpr size_t SM_PEXP = 64 * 1024;
constexpr size_t SM_EBASE = 96 * 1024;

constexpr int LDS_MAIN = 147456;
constexpr int LDSCTL_OFF = LDS_MAIN;
constexpr int LDS_BYTES = LDS_MAIN + 512;

#define GAS __attribute__((address_space(1)))
#define LAS __attribute__((address_space(3)))
typedef unsigned short bf16;
typedef unsigned v4u __attribute__((ext_vector_type(4)));
typedef unsigned v2u __attribute__((ext_vector_type(2)));
typedef float f32x4 __attribute__((ext_vector_type(4)));
typedef float f32x16 __attribute__((ext_vector_type(16)));
typedef short bf16x8 __attribute__((ext_vector_type(8)));
typedef short s16x4 __attribute__((ext_vector_type(4)));
typedef GAS unsigned gu32;
#define RLX_AGENT __ATOMIC_RELAXED, __HIP_MEMORY_SCOPE_AGENT
#define LDS_WAIT() asm volatile("s_waitcnt lgkmcnt(0)" ::: "memory")
#define VM_WAIT() asm volatile("s_waitcnt vmcnt(0)" ::: "memory")
#define CFENCE() asm volatile("" ::: "memory")
__device__ __forceinline__ unsigned f2bf(float f) { unsigned u = __builtin_bit_cast(unsigned, f); return (u + 0x7fffu + ((u >> 16) & 1u)) >> 16; }
__device__ __forceinline__ unsigned pk2(float lo, float hi) { return f2bf(lo) | (f2bf(hi) << 16); }
__device__ __forceinline__ float bf2f(unsigned short b) { return __builtin_bit_cast(float, (unsigned)b << 16); }
__device__ __forceinline__ float bflo(unsigned w) { return __builtin_bit_cast(float, w << 16); }
__device__ __forceinline__ float bfhi(unsigned w) { return __builtin_bit_cast(float, w & 0xffff0000u); }
__device__ __forceinline__ float sigmoidf_(float x) { return __builtin_amdgcn_rcpf(1.0f + __expf(-x)); }
__device__ __forceinline__ float siluf_(float x) { return x * sigmoidf_(x); }
__device__ __forceinline__ float wave_sum(float v) {
#pragma unroll
    for (int o = 1; o < 64; o <<= 1) v += __shfl_xor(v, o);
    return v;
}

#define XB_TMO      128
#define XB_XCNT(j)  (256  + 64 * (j))
#define XB_XSUB(j)  (1280 + 64 * (j))
#define XB_XGEN(j)  (2304 + 64 * (j))
#define XB_TOP      3328
#define XB_TOPGEN   3392
#define XCD_BAR_WORDS 3456
#define XB_SPIN_CAP (1u << 18)
__device__ __forceinline__ unsigned xb_ld(unsigned* p)              { return __hip_atomic_load(p, __ATOMIC_RELAXED, __HIP_MEMORY_SCOPE_AGENT); }
__device__ __forceinline__ unsigned xb_add(unsigned* p, unsigned v) { return __hip_atomic_fetch_add(p, v, __ATOMIC_RELAXED, __HIP_MEMORY_SCOPE_AGENT); }
__device__ __forceinline__ unsigned xb_xcc_id() { return (unsigned)__builtin_amdgcn_s_getreg((3 << 11) | 20) & 0xFu; }
#define XB_SPIN(cond, bar) do { unsigned _sp = 0; while (cond) { __builtin_amdgcn_s_sleep(1); \
    if ((++_sp & 255u) == 0u) { if (xb_ld(&(bar)[XB_TMO])) break; if (_sp > XB_SPIN_CAP) { atomicAdd(&(bar)[XB_TMO], 1u); break; } } } } while (0)
struct XcdBarrier { unsigned* bar; unsigned x; volatile LAS unsigned* st; };
__device__ __forceinline__ XcdBarrier xcd_barrier_post(unsigned* bar, volatile LAS unsigned* st) {
    XcdBarrier b; b.bar = bar; b.x = xb_xcc_id(); b.st = st;
    if (threadIdx.x == 0) (void)xb_add(&bar[XB_XCNT(b.x)], 1u);
    return b;
}
__device__ __forceinline__ void xcd_barrier_complete(unsigned* bar, unsigned x, unsigned& nloc, unsigned& nx) {
    const unsigned G = gridDim.x * gridDim.y * gridDim.z;
    unsigned sum, cnt, mine, sp = 0u;
    for (;;) {
        sum = 0u; cnt = 0u; mine = 0u;
#pragma unroll
        for (unsigned j = 0; j < 16; ++j) { const unsigned c = xb_ld(&bar[XB_XCNT(j)]); sum += c; cnt += (c > 0u) ? 1u : 0u; mine = (j == x) ? c : mine; }
        if (sum == G) break;
        __builtin_amdgcn_s_sleep(1);
        if ((++sp & 255u) == 0u) { if (xb_ld(&bar[XB_TMO])) break; if (sp > XB_SPIN_CAP) { atomicAdd(&bar[XB_TMO], 1u); break; } }
    }
    nloc = mine > 0u ? mine : 1u; nx = cnt > 0u ? cnt : 1u;
}
__device__ __forceinline__ void xcd_barrier(const XcdBarrier& b) {
    asm volatile("s_waitcnt vmcnt(0)" ::: "memory");
    __syncthreads();
    if (threadIdx.x == 0) {
        unsigned* bar = b.bar;
        __builtin_amdgcn_s_waitcnt(0);
        unsigned nloc = b.st[0], nx = b.st[1];
        if (nloc == 0u) { xcd_barrier_complete(bar, b.x, nloc, nx); b.st[0] = nloc; b.st[1] = nx; }
        const unsigned old = xb_add(&bar[XB_XSUB(b.x)], 1u);
        const unsigned gen = old / nloc;
        if (old + 1u == (gen + 1u) * nloc) {
            __builtin_amdgcn_fence(__ATOMIC_RELEASE, "agent");
            asm volatile("s_waitcnt vmcnt(0)" ::: "memory");
            const unsigned og = xb_add(&bar[XB_TOP], 1u);
            const unsigned tg = og / nx;
            if (og + 1u == (tg + 1u) * nx) xb_add(&bar[XB_TOPGEN], 1u);
            else XB_SPIN(xb_ld(&bar[XB_TOPGEN]) == tg, bar);
            __builtin_amdgcn_fence(__ATOMIC_ACQUIRE, "agent");
            xb_add(&bar[XB_XGEN(b.x)], 1u);
            asm volatile("s_waitcnt vmcnt(0)" ::: "memory");
        } else {
            XB_SPIN(xb_ld(&bar[XB_XGEN(b.x)]) == gen, bar);
            __builtin_amdgcn_fence(__ATOMIC_ACQUIRE, "agent");
            asm volatile("s_waitcnt vmcnt(0)" ::: "memory");
        }
    }
    __syncthreads();
}

struct Args {
    const float* in[23];
    float* out; unsigned char* ws;
    int ph_lo, ph_hi;
    int use_bar, pad;
};
struct Frame {
    LAS unsigned char* lds;
    int tid, lane, wave, G, bid;
    unsigned char* ws;
    const float* const* in;
    float* out;
};
enum { I_X = 0, I_C, I_CTX, I_CCTX, I_MODW, I_MODB, I_NORMG, I_MWIN, I_MBGATE, I_MWCONV, I_MGHEAD, I_MWOUT, I_HWIN, I_HBF, I_HLB, I_HGHEAD, I_HWOUT, I_FWGU, I_FWDOWN, I_EWR, I_EBR, I_EWGU, I_EWDOWN };

__device__ __forceinline__ void phase_mods(Frame& F) {
    LAS float* SV = (LAS float*)(F.lds);
    LAS float* RED = (LAS float*)(F.lds + 9 * 1024 * 4);
    const float* cvec = F.in[I_C]; const float* cctx = F.in[I_CCTX];
    for (int i = F.tid; i < 9 * 1024; i += NTHR) { const int b = i >> 10, k = i & 1023; const float v = b < 8 ? cvec[b * 1024 + k] : cctx[k]; SV[i] = siluf_(v); }
    __syncthreads();
    const float* modw = F.in[I_MODW]; const float* modb = F.in[I_MODB]; const float* normg = F.in[I_NORMG];
    float* modv = (float*)(F.ws + WS_MODV);
    for (int item = F.bid; item < 4 * 96; item += F.G) {
        const int L = item / 96, n0 = (item % 96) * 64;
        const float* wp = modw + (size_t)L * 1024 * 6144 + n0 + F.lane;
        float acc[9];
#pragma unroll
        for (int b = 0; b < 9; ++b) acc[b] = 0.f;
        const int k0 = F.wave * 128;
#pragma unroll 4
        for (int k = 0; k < 128; ++k) { const float wv = wp[(size_t)(k0 + k) * 6144];
#pragma unroll
            for (int b = 0; b < 9; ++b) acc[b] += SV[b * 1024 + k0 + k] * wv; }
#pragma unroll
        for (int b = 0; b < 9; ++b) RED[(F.wave * 9 + b) * 64 + F.lane] = acc[b];
        __syncthreads();
        for (int o = F.tid; o < 9 * 64; o += NTHR) { const int b = o >> 6, l = o & 63; float v = 0.f;
#pragma unroll
            for (int w = 0; w < 8; ++w) v += RED[(w * 9 + b) * 64 + l];
            const int n = n0 + l, s = n >> 10, c = n & 1023; v += modb[L * 6144 + n];
            const float* g = normg + (size_t)L * 4 * 1024;
            int slot; float r;
            if (s == 0) { slot = 1; r = v; } else if (s == 1) { slot = 0; r = g[c] * (1.f + v); } else if (s == 2) { slot = 2; r = v * g[1024 + c]; }
            else if (s == 3) { slot = 4; r = v; } else if (s == 4) { slot = 3; r = g[2048 + c] * (1.f + v); } else { slot = 5; r = v * g[3072 + c]; }
            modv[((size_t)(L * 9 + b) * 6 + slot) * 1024 + c] = r; }
        __syncthreads();
    }
}

__device__ __forceinline__ void wconv_item(const float* W, int K, int N, bf16* WT, int gu_mode, LAS float* scr, int item, int lane) {
    const int nblk = N / 32, kb = item / nblk, nb = item % nblk, k0 = 64 * kb, n0 = 32 * nb;
    int row0 = n0;
    if (gu_mode) { const int half = n0 / FF, nn = n0 - half * FF; row0 = 256 * (nn >> 7) + 128 * half + (nn & 127); }
#pragma unroll 8
    for (int i = 0; i < 32; ++i) { const int kk = 2 * i + (lane >> 5); scr[kk * 33 + (lane & 31)] = W[(size_t)(k0 + kk) * N + n0 + (lane & 31)]; }
    LDS_WAIT(); CFENCE();
    const int c = lane & 7;
#pragma unroll
    for (int j = 0; j < 4; ++j) { const int n = (lane >> 3) + 8 * j; const LAS float* s = scr + (8 * c) * 33 + n;
        v4u o; o.x = pk2(s[0 * 33], s[1 * 33]); o.y = pk2(s[2 * 33], s[3 * 33]); o.z = pk2(s[4 * 33], s[5 * 33]); o.w = pk2(s[6 * 33], s[7 * 33]);
        *(GAS v4u*)(WT + (size_t)(row0 + n) * K + k0 + 8 * c) = o; }
    LDS_WAIT(); CFENCE();
}
__device__ __forceinline__ void phase_wconv(Frame& F, int L) {
    LAS float* scr = (LAS float*)(F.lds + F.wave * 16384);
    const int gw = F.bid * NWAVES + F.wave, NGW = F.G * NWAVES; const int j = L >> 1;
    if ((L & 1) == 0) {
        unsigned char* wb = F.ws + WS_WE;
        const float* w_in = F.in[I_MWIN] + (size_t)j * D * NW_M; const float* w_out = F.in[I_MWOUT] + (size_t)j * D * D;
        const float* w_gu = F.in[I_FWGU] + (size_t)j * D * NGU; const float* w_dn = F.in[I_FWDOWN] + (size_t)j * FF * D;
        constexpr int I0 = 16 * (NW_M / 32), I1 = 16 * 32, I2 = 16 * (NGU / 32), I3 = (FF / 64) * 32;
        for (int it = gw; it < I0 + I1 + I2 + I3; it += NGW) { int r = it;
            if (r < I0) { wconv_item(w_in, D, NW_M, (bf16*)(wb + WE_IN), 0, scr, r, F.lane); continue; } r -= I0;
            if (r < I1) { wconv_item(w_out, D, D, (bf16*)(wb + WE_OUT), 0, scr, r, F.lane); continue; } r -= I1;
            if (r < I2) { wconv_item(w_gu, D, NGU, (bf16*)(wb + WE_GU), 1, scr, r, F.lane); continue; } r -= I2;
            wconv_item(w_dn, FF, D, (bf16*)(wb + WE_DOWN), 0, scr, r, F.lane); }
        GAS v4u* z = (GAS v4u*)(wb + WE_IN + (size_t)NW_M * D * 2); const int nz = (NIN_M - NW_M) * D * 2 / 16;
        for (int i = F.bid * NTHR + F.tid; i < nz; i += F.G * NTHR) z[i] = (v4u){0u, 0u, 0u, 0u};
    } else {
        unsigned char* wb = F.ws + WS_WO;
        const float* w_in = F.in[I_HWIN] + (size_t)j * D * NP_H; const float* w_out = F.in[I_HWOUT] + (size_t)j * D * D;
        const float* w_gu = F.in[I_EWGU] + (size_t)j * NEXP * D * NGU; const float* w_dn = F.in[I_EWDOWN] + (size_t)j * NEXP * FF * D;
        constexpr int I0 = 16 * (NP_H / 32), I1 = 16 * 32, I2 = 16 * (NGU / 32), I3 = (FF / 64) * 32;
        for (int it = gw; it < I0 + I1 + NEXP * (I2 + I3); it += NGW) { int r = it;
            if (r < I0) { wconv_item(w_in, D, NP_H, (bf16*)(wb + WOD_IN), 0, scr, r, F.lane); continue; } r -= I0;
            if (r < I1) { wconv_item(w_out, D, D, (bf16*)(wb + WOD_OUT), 0, scr, r, F.lane); continue; } r -= I1;
            const int e = r / (I2 + I3); r -= e * (I2 + I3);
            if (r < I2) { wconv_item(w_gu + (size_t)e * D * NGU, D, NGU, (bf16*)(wb + WOD_GU + e * EGU_BYTES), 1, scr, r, F.lane); continue; } r -= I2;
            wconv_item(w_dn + (size_t)e * FF * D, FF, D, (bf16*)(wb + WOD_DOWN + e * EDOWN_BYTES), 0, scr, r, F.lane); }
    }
}

struct TokCfg {
    const float* lat_src_l; const float* lat_src_c;
    float* lat_dst_l; float* lat_dst_c;
    const bf16* y; int y_perm; int moe_combine;
    const float* vupd;
    const float* vna; const float* vnb;
    bf16* u; int u_perm;
    int route; int jr;
    int nrows;
};
__device__ __forceinline__ int perm_cm(int t) { return (t & 63) * ROWS_G + (t >> 6); }

__device__ __forceinline__ void phase_tok(Frame& F, const TokCfg& T) {
    const int gw = F.bid * NWAVES + F.wave, NGW = F.G * NWAVES;
    const int R = (T.nrows + NGW - 1) / NGW; const int r0 = gw * R; int r1 = r0 + R; if (r1 > T.nrows) r1 = T.nrows;
    LAS float* WR = (LAS float*)F.lds;
    if (T.route) { const float* wr = F.in[I_EWR] + (size_t)T.jr * 1024 * 8; for (int i = F.tid; i < 8192; i += NTHR) WR[i] = wr[i]; }
    __syncthreads();
    f32x4 VU[4], VA[4], VB[4]; int curb = -1;
    int my_e0 = 0, my_e1 = 0; float my_w = 0.f;
    for (int row = r0; row < r1; ++row) {
        const int b = row < M_LAT ? (row >> 13) : 8;
        if (b != curb) { curb = b;
#pragma unroll
            for (int j = 0; j < 4; ++j) {
                if (T.y) VU[j] = ((const f32x4*)(T.vupd + (size_t)b * 6144))[F.lane + 64 * j];
                if (T.vna) { VA[j] = ((const f32x4*)(T.vna + (size_t)b * 6144))[F.lane + 64 * j]; VB[j] = ((const f32x4*)(T.vnb + (size_t)b * 6144))[F.lane + 64 * j]; } } }
        const float* lp = row < M_LAT ? T.lat_src_l + (size_t)row * D : T.lat_src_c + (size_t)(row - M_LAT) * D;
        f32x4 v[4];
#pragma unroll
        for (int j = 0; j < 4; ++j) v[j] = ((const f32x4*)lp)[F.lane + 64 * j];
        if (T.y) {
            f32x4 yv[4];
            if (T.moe_combine) {
                const int* rr = (const int*)(F.ws + WS_ROUTE + RT_R); const float w0 = ((const float*)(F.ws + WS_ROUTE + RT_W))[row], w1 = 1.f - w0;
                const int p0 = rr[2 * row], p1 = rr[2 * row + 1];
                const v2u* ya = (const v2u*)(T.y + (size_t)p0 * D); const v2u* yb = (const v2u*)(T.y + (size_t)p1 * D);
#pragma unroll
                for (int j = 0; j < 4; ++j) { const v2u a = ya[F.lane + 64 * j], c = yb[F.lane + 64 * j];
                    yv[j] = (f32x4){w0 * bflo(a.x) + w1 * bflo(c.x), w0 * bfhi(a.x) + w1 * bfhi(c.x), w0 * bflo(a.y) + w1 * bflo(c.y), w0 * bfhi(a.y) + w1 * bfhi(c.y)}; }
            } else {
                int yr = row; if (T.y_perm && row < M_LAT) yr = (row & ~8191) + perm_cm(row & 8191);
                const v2u* yp = (const v2u*)(T.y + (size_t)yr * D);
#pragma unroll
                for (int j = 0; j < 4; ++j) { const v2u a = yp[F.lane + 64 * j]; yv[j] = (f32x4){bflo(a.x), bfhi(a.x), bflo(a.y), bfhi(a.y)}; }
            }
            float ss = 0.f;
#pragma unroll
            for (int j = 0; j < 4; ++j) ss += (yv[j].x * yv[j].x + yv[j].y * yv[j].y) + (yv[j].z * yv[j].z + yv[j].w * yv[j].w);
            const float rs = rsqrtf(wave_sum(ss) * (1.f / D) + EPS);
#pragma unroll
            for (int j = 0; j < 4; ++j) v[j] = v[j] + VU[j] * (yv[j] * rs);
        }
        float* dp = row < M_LAT ? (T.lat_dst_l ? T.lat_dst_l + (size_t)row * D : nullptr) : (T.lat_dst_c ? T.lat_dst_c + (size_t)(row - M_LAT) * D : nullptr);
        if (dp) {
#pragma unroll
            for (int j = 0; j < 4; ++j) ((f32x4*)dp)[F.lane + 64 * j] = v[j];
        }
        if (T.vna) {
            float ss = 0.f;
#pragma unroll
            for (int j = 0; j < 4; ++j) ss += (v[j].x * v[j].x + v[j].y * v[j].y) + (v[j].z * v[j].z + v[j].w * v[j].w);
            const float rs = rsqrtf(wave_sum(ss) * (1.f / D) + EPS);
            f32x4 uu[4];
#pragma unroll
            for (int j = 0; j < 4; ++j) uu[j] = (v[j] * rs) * VA[j] + VB[j];
            int ur = row; if (T.u_perm && row < M_LAT) ur = (row & ~8191) + perm_cm(row & 8191);
            v2u* up = (v2u*)(T.u + (size_t)ur * D);
#pragma unroll
            for (int j = 0; j < 4; ++j) { v2u o; o.x = pk2(uu[j].x, uu[j].y); o.y = pk2(uu[j].z, uu[j].w); up[F.lane + 64 * j] = o; }
            if (T.route) {
                float lg[8];
#pragma unroll
                for (int e = 0; e < 8; ++e) lg[e] = 0.f;
#pragma unroll
                for (int j = 0; j < 4; ++j)
#pragma unroll
                    for (int i = 0; i < 4; ++i) { const int c = 4 * (F.lane + 64 * j) + i; const f32x4 wa = *(const LAS f32x4*)(WR + c * 8), wb = *(const LAS f32x4*)(WR + c * 8 + 4); const float x = uu[j][i];
                        lg[0] += x * wa.x; lg[1] += x * wa.y; lg[2] += x * wa.z; lg[3] += x * wa.w; lg[4] += x * wb.x; lg[5] += x * wb.y; lg[6] += x * wb.z; lg[7] += x * wb.w; }
                const float* br = F.in[I_EBR] + T.jr * 8;
#pragma unroll
                for (int e = 0; e < 8; ++e) lg[e] = wave_sum(lg[e]) + br[e];
                int e0 = 0; float v0 = lg[0];
#pragma unroll
                for (int e = 1; e < 8; ++e) if (lg[e] > v0) { v0 = lg[e]; e0 = e; }
                int e1 = -1; float v1 = -3.0e38f;
#pragma unroll
                for (int e = 0; e < 8; ++e) if (e != e0 && lg[e] > v1) { v1 = lg[e]; e1 = e; }
                const float w0 = 1.f / (1.f + __expf(v1 - v0));
                if (F.lane == row - r0) { my_e0 = e0; my_e1 = e1; my_w = w0; }
            }
        }
    }
    if (T.route) {
        const int n = r1 - r0; const bool act = F.lane < n; const int row = r0 + F.lane;
        unsigned* ecnt = (unsigned*)(F.ws + WS_CTL) + CW_ECNT + T.jr * 8 * 64;
        int rk0 = 0, rk1 = 0;
        const unsigned long long ltmask = (F.lane == 0) ? 0ull : (~0ull >> (64 - F.lane));
#pragma unroll
        for (int e = 0; e < 8; ++e) {
            const unsigned long long m0 = __ballot(act && my_e0 == e), m1 = __ballot(act && my_e1 == e);
            const int c0 = __popcll(m0), c1 = __popcll(m1);
            unsigned base = 0;
            if (c0 + c1 > 0) { if (F.lane == 0) base = __hip_atomic_fetch_add(ecnt + e * 64, (unsigned)(c0 + c1), RLX_AGENT); base = __builtin_amdgcn_readfirstlane(base); }
            if (my_e0 == e) rk0 = (int)base + __popcll(m0 & ltmask);
            if (my_e1 == e) rk1 = (int)base + c0 + __popcll(m1 & ltmask);
        }
        if (act) { ((int*)(F.ws + WS_ROUTE + RT_E))[row] = my_e0 | (my_e1 << 8); ((int*)(F.ws + WS_ROUTE + RT_R))[2 * row] = rk0; ((int*)(F.ws + WS_ROUTE + RT_R))[2 * row + 1] = rk1;
            ((float*)(F.ws + WS_ROUTE + RT_W))[row] = my_w; }
    }
}

__device__ __forceinline__ void phase_moe_scatter(Frame& F, int jr, int nrows, const bf16* U, bf16* AM) {
    const unsigned* ecnt = (const unsigned*)(F.ws + WS_CTL) + CW_ECNT + jr * 8 * 64;
    int base[8]; int acc = 0;
#pragma unroll
    for (int e = 0; e < 8; ++e) { const int c = (int)__hip_atomic_load(ecnt + e * 64, RLX_AGENT); base[e] = acc; acc += (c + 255) & ~255; }
    int* pexp = (int*)(F.ws + WS_SMALL + SM_PEXP);
    if (F.bid == 0) { const int np = acc >> 8;
        for (int p = F.tid; p < np; p += NTHR) { int e = 0;
#pragma unroll
            for (int q = 1; q < 8; ++q) if (p * 256 >= base[q]) e = q;
            pexp[p] = e; }
        if (F.tid == 0) pexp[MOE_PANELS] = np; }
    const int gw = F.bid * NWAVES + F.wave, NGW = F.G * NWAVES;
    const int R = (nrows + NGW - 1) / NGW; const int r0 = gw * R; int r1 = r0 + R; if (r1 > nrows) r1 = nrows;
    int* rr = (int*)(F.ws + WS_ROUTE + RT_R); const int* re = (const int*)(F.ws + WS_ROUTE + RT_E);
    for (int row = r0; row < r1; ++row) {
        const int ee = re[row], e0 = ee & 255, e1 = ee >> 8; int b0 = 0, b1 = 0;
#pragma unroll
        for (int e = 0; e < 8; ++e) { if (e0 == e) b0 = base[e]; if (e1 == e) b1 = base[e]; }
        const int p0 = b0 + rr[2 * row], p1 = b1 + rr[2 * row + 1];
        const v4u* src = (const v4u*)(U + (size_t)row * D); v4u a = src[F.lane], c = src[F.lane + 64];
        v4u* d0 = (v4u*)(AM + (size_t)p0 * D); v4u* d1 = (v4u*)(AM + (size_t)p1 * D);
        d0[F.lane] = a; d0[F.lane + 64] = c; d1[F.lane] = a; d1[F.lane + 64] = c;
        CFENCE();
        if (F.lane == 0) { rr[2 * row] = p0; rr[2 * row + 1] = p1; }
    }
}

#define MFMA32(a, b, c) __builtin_amdgcn_mfma_f32_32x32x16_bf16((a), (b), (c), 0, 0, 0)
typedef __bf16 bf16x2_t __attribute__((ext_vector_type(2)));
typedef float f32x2_t __attribute__((ext_vector_type(2)));
typedef short v4i16_t __attribute__((ext_vector_type(4)));
typedef LAS unsigned char* ldsp;
__device__ __forceinline__ unsigned cvtpk(float lo, float hi) { f32x2_t v = {lo, hi}; bf16x2_t b = __builtin_convertvector(v, bf16x2_t); return __builtin_bit_cast(unsigned, b); }
__device__ __forceinline__ int crow(int reg, int h) { return (reg & 3) + 8 * (reg >> 2) + 4 * h; }
__device__ __forceinline__ bf16x8 pack8(const f32x16& x, int s) {
    v4u p; p.x = cvtpk(x[8 * s], x[8 * s + 1]); p.y = cvtpk(x[8 * s + 2], x[8 * s + 3]); p.z = cvtpk(x[8 * s + 4], x[8 * s + 5]); p.w = cvtpk(x[8 * s + 6], x[8 * s + 7]);
    return __builtin_bit_cast(bf16x8, p);
}
__device__ __forceinline__ bf16x8 lds16(ldsp p) { return *(const LAS bf16x8*)p; }
__device__ __forceinline__ bf16x8 lds8x2(ldsp p) { const s16x4 lo = *(const LAS s16x4*)p, hi = *(const LAS s16x4*)(p + 16); return __builtin_shufflevector(lo, hi, 0, 1, 2, 3, 4, 5, 6, 7); }
__device__ __forceinline__ s16x4 tr16(ldsp p) { return __builtin_bit_cast(s16x4, __builtin_amdgcn_ds_read_tr16_b64_v4i16((LAS v4i16_t*)p)); }
__device__ __forceinline__ bf16x8 ldstr2(ldsp p, int second) { const s16x4 lo = tr16(p), hi = tr16(p + second); return __builtin_shufflevector(lo, hi, 0, 1, 2, 3, 4, 5, 6, 7); }
__device__ __forceinline__ f32x16 zero16() { f32x16 z;
#pragma unroll
    for (int i = 0; i < 16; ++i) z[i] = 0.f; return z; }
__device__ __forceinline__ void unpack8(const v4u& w, float (&x)[8]) { x[0] = bflo(w.x); x[1] = bfhi(w.x); x[2] = bflo(w.y); x[3] = bfhi(w.y); x[4] = bflo(w.z); x[5] = bfhi(w.z); x[6] = bflo(w.w); x[7] = bfhi(w.w); }
__device__ __forceinline__ int launder_v(int x) { asm volatile("" : "+v"(x)); return x; }
struct FragOff { int o_row, o_perm, o_trn, o_trp; };
__device__ __forceinline__ FragOff frag_off(int lane, int LD) {
    const int r = lane & 31, hh = lane >> 5, i16 = lane & 15, q = i16 >> 2, p = i16 & 3, blk = (lane >> 4) & 1; FragOff f;
    f.o_row = (r * LD + 8 * hh) * 2; f.o_perm = (r * LD + 4 * hh) * 2;
    f.o_trn = ((8 * hh + q) * LD + 16 * blk + 4 * p) * 2; f.o_trp = ((4 * hh + q) * LD + 16 * blk + 4 * p) * 2; return f;
}

constexpr int ML_LDQ = 72, ML_LDV = 136;
constexpr int ML_QC = 0, ML_KC = 9216, ML_KH = 18432, ML_V = 27648, ML_GS = 45056, ML_OB = 50176, ML_NV = 68608, ML_SSQ = 70656, ML_INV = 71680, ML_GROUP = 73728;
static_assert(2 * ML_GROUP <= LDS_MAIN, "mLSTM LDS map");
constexpr int ML_STATE_F = 8448;

struct MlPref { v4u q[2], k[2], v[4]; float gi, gf; };
struct MlSeg { int rowbase; int len; int t0; int nchunk; };

__device__ __forceinline__ void ml_issue(MlPref& P, const bf16* proj, const bf16* qkc, const float* gates, int rowbase, int t0c, int g, int h, int tg, int lane, bool need_q) {
    const int c8q = tg & 7;
#pragma unroll
    for (int i = 0; i < 2; ++i) { const int tau = (tg + 256 * i) >> 3; const int t = t0c + (g ? 63 - tau : tau);
        const bf16* rp = qkc + (size_t)(rowbase + t) * D + h * 64 + c8q * 8;
        P.q[i] = need_q ? *(const v4u*)rp : (v4u){0u, 0u, 0u, 0u}; P.k[i] = *(const v4u*)(rp + 512); }
#pragma unroll
    for (int i = 0; i < 4; ++i) { const int p = tg + 256 * i, tau = p >> 4, c8 = p & 15; const int t = t0c + (g ? 63 - tau : tau);
        P.v[i] = *(const v4u*)(proj + (size_t)(rowbase + t) * NP_M + 1024 + h * 128 + c8 * 8); }
    { const int t = t0c + (g ? 63 - lane : lane); const float* gp = gates + (size_t)(rowbase + t) * 32 + g * 16 + h; P.gi = gp[0]; P.gf = gp[8]; }
}

template <bool OUTPUT>
__device__ __forceinline__ void mlstm_item(Frame& F, const bf16* proj, const bf16* qkc, const float* gates, bf16* aout, const float* ghead,
                                           int h, MlSeg S0, MlSeg S1, const float* st_in0, const float* st_in1, int npre0, int npre1, float* st_out0, float* st_out1) {
    const int tid_l = launder_v(F.tid); const int wave_l = __builtin_amdgcn_readfirstlane(tid_l >> 6);
    const int g = wave_l >> 2, j = wave_l & 3, tg = tid_l & 255, lane = tid_l & 63, r = lane & 31, hh = lane >> 5;
    const ldsp gb = F.lds + g * ML_GROUP;
    const ldsp GSb = gb + ML_GS + j * 1280;
    LAS float* GS = (LAS float*)GSb;
    const ldsp OBb = gb + ML_OB + j * 4608;
    LAS float* NV = (LAS float*)(gb + ML_NV);
    LAS float* SSQ = (LAS float*)(gb + ML_SSQ);
    const ldsp INVb = gb + ML_INV + j * 256;
    const int rowbase = g ? S1.rowbase : S0.rowbase, seg_t0 = g ? S1.t0 : S0.t0, nch = g ? S1.nchunk : S0.nchunk;
    const int vcol = 64 * j;
    __syncthreads();
    f32x16 C[2]; C[0] = zero16(); C[1] = zero16();
    float m_prev = -1.0e30f, btot = 0.f;
    float nreg = 0.f;
    if (OUTPUT) {
        const float* sp = g ? st_in1 : st_in0; const int np = g ? npre1 : npre0;
#pragma unroll 1
        for (int k = 0; k < np; ++k) { const float* e = sp + (size_t)k * ML_STATE_F;
            const float mloc = e[8192 + 64], B = e[8192 + 65];
            const float mnew = fmaxf(B + m_prev, mloc), al = __expf(B + m_prev - mnew), be = __expf(mloc - mnew);
            const float* ep = e + (4 * hh) * 128 + 32 * j + r;
#pragma unroll
            for (int dt = 0; dt < 2; ++dt)
#pragma unroll
                for (int i = 0; i < 16; ++i) C[dt][i] = al * C[dt][i] + be * ep[(32 * dt + (i & 3) + 8 * (i >> 2)) * 128];
            nreg = al * nreg + be * e[8192 + lane];
            m_prev = mnew; }
    }
    if (j == 0) NV[lane] = nreg;
    MlPref P; ml_issue(P, proj, qkc, gates, rowbase, seg_t0 + 64 * (g ? nch - 1 : 0), g, h, tg, lane, OUTPUT);
    __syncthreads();
#pragma unroll 1
    for (int step = 0; step < nch; ++step) {
        const int tgs = launder_v(tg), lns = launder_v(lane);
        const int r = lns & 31, hh = lns >> 5;
        const FragOff fq = frag_off(lns, ML_LDQ), fv = frag_off(lns, ML_LDV);
        const int o_h4 = 16 * hh;
        const int o_obw = (4 * hh * 36 + r) * 4, o_obr = ((lns >> 1) * 36 + 16 * (lns & 1)) * 4;
        const int ci = g ? nch - 1 - step : step;
        const int par = step & 1;
        float decay;
        {
            const float xi = P.gi, lf = P.gf;
            float bc = lf;
#pragma unroll
            for (int o = 1; o < 64; o <<= 1) { const float t = __shfl_up(bc, o); if (lns >= o) bc += t; }
            const float a = xi - bc; float pm = a;
#pragma unroll
            for (int o = 1; o < 64; o <<= 1) { const float t = __shfl_up(pm, o); if (lns >= o) pm = fmaxf(pm, t); }
            const float Mt = fmaxf(m_prev, pm);
            const float Ml = __shfl(Mt, 63), bl = __shfl(bc, 63);
            GS[lns] = a; GS[64 + lns] = Mt; GS[128 + lns] = __expf(m_prev - Mt); GS[192 + lns] = __expf(-(bc + Mt)); GS[256 + lns] = __expf(a - Ml);
            decay = __expf(m_prev - Ml); m_prev = bl + Ml; btot += bl;
        }
        LDS_WAIT(); CFENCE();
        {
            const int c8 = tgs & 7;
#pragma unroll
            for (int i = 0; i < 2; ++i) { const int tau = (tgs + 256 * i) >> 3; const ldsp tp = gb + (tau * ML_LDQ + c8 * 8) * 2;
                if (OUTPUT) { *(LAS v4u*)(tp + ML_QC) = P.q[i]; *(LAS v4u*)(tp + ML_KC) = P.k[i]; }
                float o[8]; unpack8(P.k[i], o); const float wkk = GS[256 + tau]; v4u w;
                w.x = pk2(o[0] * wkk, o[1] * wkk); w.y = pk2(o[2] * wkk, o[3] * wkk); w.z = pk2(o[4] * wkk, o[5] * wkk); w.w = pk2(o[6] * wkk, o[7] * wkk);
                *(LAS v4u*)(tp + ML_KH) = w; }
#pragma unroll
            for (int i = 0; i < 4; ++i) { const int p = tgs + 256 * i, tau = p >> 4, cc = p & 15; *(LAS v4u*)(gb + ML_V + (tau * ML_LDV + cc * 8) * 2) = P.v[i]; }
        }
        if (!OUTPUT) { if (step + 1 < nch) ml_issue(P, proj, qkc, gates, rowbase, seg_t0 + 64 * (g ? nch - 2 - step : step + 1), g, h, tgs, lns, OUTPUT); }
        __syncthreads();
        float hrow[2][16];
        if (OUTPUT) {
#pragma unroll
            for (int tt = 0; tt < 2; ++tt) {
                __builtin_amdgcn_sched_barrier(0);
                const float Mt = GS[64 + 32 * tt + r];
                bf16x8 pa[2][2]; float den = 0.f;
#pragma unroll
                for (int st = 0; st <= tt; ++st) {
                    __builtin_amdgcn_sched_barrier(0);
                    f32x16 s = zero16();
#pragma unroll
                    for (int ks = 0; ks < 4; ++ks) s = MFMA32(lds16(gb + ML_KC + fq.o_row + (32 * st * ML_LDQ + 16 * ks) * 2), lds16(gb + ML_QC + fq.o_row + (32 * tt * ML_LDQ + 16 * ks) * 2), s);
#pragma unroll
                    for (int q4 = 0; q4 < 4; ++q4) { const f32x4 av = *(const LAS f32x4*)(GSb + o_h4 + (32 * st + 8 * q4) * 4);
#pragma unroll
                        for (int e = 0; e < 4; ++e) { const int i = 4 * q4 + e; const int srow = 32 * st + crow(i, hh); const float pv = (srow <= 32 * tt + r) ? s[i] * __expf(av[e] - Mt) : 0.f; s[i] = pv; den += pv; } }
                    pa[st][0] = pack8(s, 0); pa[st][1] = pack8(s, 1);
                }
                __builtin_amdgcn_sched_barrier(0);
                f32x16 oi = zero16();
#pragma unroll
                for (int st = 0; st <= tt; ++st)
#pragma unroll
                    for (int sp = 0; sp < 2; ++sp) oi = MFMA32(pa[st][sp], ldstr2(gb + ML_V + fv.o_trp + vcol + ((32 * st + 16 * sp) * ML_LDV) * 2, 8 * ML_LDV * 2), oi);
                __builtin_amdgcn_sched_barrier(0);
                f32x16 oe = zero16();
#pragma unroll
                for (int dt = 0; dt < 2; ++dt)
#pragma unroll
                    for (int sp = 0; sp < 2; ++sp) oe = MFMA32(lds8x2(gb + ML_QC + fq.o_perm + (32 * tt * ML_LDQ + 32 * dt + 16 * sp) * 2), pack8(C[dt], sp), oe);
                __builtin_amdgcn_sched_barrier(0);
                float qn = 0.f;
#pragma unroll
                for (int c4 = 0; c4 < 4; ++c4) { const v4u qw = *(const LAS v4u*)(gb + ML_QC + (r * ML_LDQ + 32 * hh) * 2 + (32 * tt * ML_LDQ + 8 * c4) * 2); float qx[8]; unpack8(qw, qx);
                    const f32x4 n0 = *(const LAS f32x4*)(gb + ML_NV + 8 * o_h4 + (par * 64 + 8 * c4) * 4), n1 = *(const LAS f32x4*)(gb + ML_NV + 8 * o_h4 + (par * 64 + 8 * c4 + 4) * 4);
                    qn += qx[0] * n0[0] + qx[1] * n0[1] + qx[2] * n0[2] + qx[3] * n0[3] + qx[4] * n1[0] + qx[5] * n1[1] + qx[6] * n1[2] + qx[7] * n1[3]; }
                __builtin_amdgcn_sched_barrier(0);
                den += __shfl_xor(den, 32); qn += __shfl_xor(qn, 32);
                const float dtot = den + GS[128 + 32 * tt + r] * qn;
                const float inv = 1.0f / fmaxf(fabsf(dtot), GS[192 + 32 * tt + r]);
                if (hh == 0) *(LAS float*)(INVb + (32 * tt + r) * 4) = inv;
                LDS_WAIT(); CFENCE();
                f32x16 hv;
#pragma unroll
                for (int q4 = 0; q4 < 4; ++q4) { const f32x4 iv = *(const LAS f32x4*)(INVb + o_h4 + (32 * tt + 8 * q4) * 4), wv = *(const LAS f32x4*)(GSb + o_h4 + (128 + 32 * tt + 8 * q4) * 4);
#pragma unroll
                    for (int e = 0; e < 4; ++e) { const int i = 4 * q4 + e; hv[i] = (oi[i] + wv[e] * oe[i]) * iv[e]; } }
#pragma unroll
                for (int i = 0; i < 16; ++i) *(LAS float*)(OBb + o_obw + ((i & 3) + 8 * (i >> 2)) * 144) = hv[i];
                LDS_WAIT(); CFENCE();
#pragma unroll
                for (int k4 = 0; k4 < 4; ++k4) { const f32x4 x = *(const LAS f32x4*)(OBb + o_obr + 16 * k4); hrow[tt][4 * k4] = x[0]; hrow[tt][4 * k4 + 1] = x[1]; hrow[tt][4 * k4 + 2] = x[2]; hrow[tt][4 * k4 + 3] = x[3]; }
                LDS_WAIT(); CFENCE();
            }
        }
        __builtin_amdgcn_sched_barrier(0);
        if (OUTPUT) { if (step + 1 < nch) ml_issue(P, proj, qkc, gates, rowbase, seg_t0 + 64 * (g ? nch - 2 - step : step + 1), g, h, tgs, lns, OUTPUT); }
#pragma unroll
        for (int dt = 0; dt < 2; ++dt) {
#pragma unroll
            for (int i = 0; i < 16; ++i) C[dt][i] *= decay;
#pragma unroll
            for (int ks = 0; ks < 4; ++ks) C[dt] = MFMA32(ldstr2(gb + ML_KH + fq.o_trn + (16 * ks * ML_LDQ + 32 * dt) * 2, 4 * ML_LDQ * 2), ldstr2(gb + ML_V + fv.o_trn + vcol + (16 * ks * ML_LDV) * 2, 4 * ML_LDV * 2), C[dt]);
        }
        if (j == 0) { float sacc = 0.f;
#pragma unroll 8
            for (int tau = 0; tau < 64; ++tau) sacc += bf2f(*(const LAS bf16*)(gb + ML_KH + (tau * ML_LDQ + lns) * 2));
            nreg = decay * nreg + sacc; NV[(par ^ 1) * 64 + lns] = nreg; }
        __builtin_amdgcn_sched_barrier(0);
        if (OUTPUT) {
            const bool second = step >= (nch >> 1);
            const int colh = 32 * j + 16 * (lns & 1);
#pragma unroll
            for (int tt = 0; tt < 2; ++tt) { const int tau = 32 * tt + (lns >> 1); const int t = seg_t0 + 64 * ci + (g ? 63 - tau : tau);
                bf16* op = aout + (size_t)(rowbase + t) * D + h * 128 + colh;
                if (!second) { v4u w0, w1; w0.x = pk2(hrow[tt][0], hrow[tt][1]); w0.y = pk2(hrow[tt][2], hrow[tt][3]); w0.z = pk2(hrow[tt][4], hrow[tt][5]); w0.w = pk2(hrow[tt][6], hrow[tt][7]);
                    w1.x = pk2(hrow[tt][8], hrow[tt][9]); w1.y = pk2(hrow[tt][10], hrow[tt][11]); w1.z = pk2(hrow[tt][12], hrow[tt][13]); w1.w = pk2(hrow[tt][14], hrow[tt][15]);
                    *(v4u*)op = w0; *(v4u*)(op + 8) = w1; }
                else { const v4u p0 = *(const v4u*)op, p1 = *(const v4u*)(op + 8); float x0[8], x1[8]; unpack8(p0, x0); unpack8(p1, x1); float ss = 0.f;
#pragma unroll
                    for (int e = 0; e < 8; ++e) { hrow[tt][e] += x0[e]; hrow[tt][8 + e] += x1[e]; ss += hrow[tt][e] * hrow[tt][e] + hrow[tt][8 + e] * hrow[tt][8 + e]; }
                    ss += __shfl_xor(ss, 1);
                    if ((lns & 1) == 0) SSQ[(tt * 4 + j) * 32 + (lns >> 1)] = ss; }
            }
            VM_WAIT();
            __syncthreads();
            if (second) {
#pragma unroll
                for (int tt = 0; tt < 2; ++tt) { const int rr = lns >> 1, tau = 32 * tt + rr; const int t = seg_t0 + 64 * ci + (g ? 63 - tau : tau);
                    const float tot = SSQ[(tt * 4 + 0) * 32 + rr] + SSQ[(tt * 4 + 1) * 32 + rr] + SSQ[(tt * 4 + 2) * 32 + rr] + SSQ[(tt * 4 + 3) * 32 + rr];
                    const float rs = rsqrtf(tot * (1.f / 128.f) + EPS);
                    const bf16* gp = proj + (size_t)(rowbase + t) * NP_M + 2048 + h * 128 + colh; const v4u g0 = *(const v4u*)gp, g1 = *(const v4u*)(gp + 8); float o0[8], o1[8]; unpack8(g0, o0); unpack8(g1, o1);
                    const float* gh = ghead + h * 128 + colh; float y[16];
#pragma unroll
                    for (int e = 0; e < 8; ++e) { y[e] = hrow[tt][e] * rs * gh[e] * sigmoidf_(o0[e]); y[8 + e] = hrow[tt][8 + e] * rs * gh[8 + e] * sigmoidf_(o1[e]); }
                    bf16* op = aout + (size_t)(rowbase + t) * D + h * 128 + colh;
                    v4u w0, w1; w0.x = pk2(y[0], y[1]); w0.y = pk2(y[2], y[3]); w0.z = pk2(y[4], y[5]); w0.w = pk2(y[6], y[7]); w1.x = pk2(y[8], y[9]); w1.y = pk2(y[10], y[11]); w1.z = pk2(y[12], y[13]); w1.w = pk2(y[14], y[15]);
                    *(v4u*)op = w0; *(v4u*)(op + 8) = w1; }
            }
            VM_WAIT();
        } else {
            __syncthreads();
        }
    }
    if (!OUTPUT) {
        float* e = g ? st_out1 : st_out0; float* ep = e + (4 * hh) * 128 + 32 * j + r;
#pragma unroll
        for (int dt = 0; dt < 2; ++dt)
#pragma unroll
            for (int i = 0; i < 16; ++i) ep[(32 * dt + (i & 3) + 8 * (i >> 2)) * 128] = C[dt][i];
        if (j == 0) { e[8192 + lane] = nreg; if (lane == 0) { e[8192 + 64] = m_prev; e[8192 + 65] = btot; } }
    }
}

constexpr int HG_LD = 136;
constexpr int HG_LF = 0, HG_QT = 16384, HG_KT = 25088, HG_KH = 33792, HG_V = 42496, HG_OB = 51200, HG_AUX = 69632, HG_SSQ = 71168, HG_EAM = 71680, HG_BIAS = 72192, HG_LBV = 72704, HG_GROUP = 73728;
static_assert(2 * HG_GROUP <= LDS_MAIN, "HGRN2 LDS map");
constexpr int HG_STATE_F = 16512;

struct HgPref { v4u q[2], f[2], v[2]; };
__device__ __forceinline__ void hg_issue(HgPref& P, const bf16* proj, int rowbase, int t0c, int g, int h, int tg, bool need_q) {
#pragma unroll
    for (int i = 0; i < 2; ++i) { const int p = tg + 256 * i, tau = p >> 4, c8 = p & 15; const int t = t0c + (g ? 31 - tau : tau);
        const bf16* rp = proj + (size_t)(rowbase + t) * NP_H + h * 128 + c8 * 8;
        P.q[i] = need_q ? *(const v4u*)rp : (v4u){0u, 0u, 0u, 0u}; P.v[i] = *(const v4u*)(rp + 1024); P.f[i] = *(const v4u*)(rp + 2048 + 1024 * g); }
}
__device__ __forceinline__ float clamp80(float x) { return fminf(fmaxf(x, -80.f), 80.f); }

template <bool OUTPUT>
__device__ __forceinline__ void hgrn_item(Frame& F, const bf16* proj, bf16* aout, const float* bf_, const float* lbraw, int jl, const float* ghead,
                                          int h, MlSeg S0, MlSeg S1, const float* st_in0, const float* st_in1, int npre0, int npre1, float* st_out0, float* st_out1) {
    const int tid_l = launder_v(F.tid); const int wave_l = __builtin_amdgcn_readfirstlane(tid_l >> 6);
    const int g = wave_l >> 2, j = wave_l & 3, tg = tid_l & 255, lane = tid_l & 63, r = lane & 31, hh = lane >> 5;
    const ldsp gb = F.lds + g * HG_GROUP;
    LAS float* LF = (LAS float*)(gb + HG_LF);
    const ldsp OBb = gb + HG_OB + j * 4608;
    LAS float* AMID = (LAS float*)(gb + HG_AUX); LAS float* ALAST = AMID + 128; LAS float* DEC = AMID + 256;
    LAS float* SSQ = (LAS float*)(gb + HG_SSQ); LAS float* EAM = (LAS float*)(gb + HG_EAM); LAS float* BIASV = (LAS float*)(gb + HG_BIAS); LAS float* LBV = (LAS float*)(gb + HG_LBV);
    const int rowbase = g ? S1.rowbase : S0.rowbase, seg_t0 = g ? S1.t0 : S0.t0, nch = g ? S1.nchunk : S0.nchunk;
    const int vcol = 64 * j;
    __syncthreads();
    if (tg < 128) { const int c = h * 128 + tg; BIASV[tg] = bf_[g * 1024 + c]; LBV[tg] = jl == 0 ? 0.f : sigmoidf_(lbraw[(1 * 2 + g) * 1024 + c] - lbraw[(0 * 2 + g) * 1024 + c]); }
    f32x16 St[4];
#pragma unroll
    for (int dt = 0; dt < 4; ++dt) St[dt] = zero16();
    float atot = 0.f;
    if (OUTPUT) {   const float* sp = g ? st_in1 : st_in0; const int np = g ? npre1 : npre0;
#pragma unroll 1
        for (int k = 0; k < np; ++k) { const float* e = sp + (size_t)k * HG_STATE_F; const float* ep = e + (4 * hh) * 128 + 32 * j + r; const float* ap = e + 16384 + 4 * hh;
#pragma unroll
            for (int dt = 0; dt < 4; ++dt)
#pragma unroll
                for (int i = 0; i < 16; ++i) { const int dk0 = 32 * dt + (i & 3) + 8 * (i >> 2); St[dt][i] = __expf(ap[dk0]) * St[dt][i] + ep[dk0 * 128]; } }
    }
    HgPref P; hg_issue(P, proj, rowbase, seg_t0 + 32 * (g ? nch - 1 : 0), g, h, tg, OUTPUT);
    __syncthreads();
#pragma unroll 1
    for (int step = 0; step < nch; ++step) {
        const int tgs = launder_v(tg), lns = launder_v(lane);
        const int r = lns & 31, hh = lns >> 5;
        const FragOff fo = frag_off(lns, HG_LD);
        const int o_h4 = 16 * hh;
        const int o_obw = (4 * hh * 36 + r) * 4, o_obr = ((lns >> 1) * 36 + 16 * (lns & 1)) * 4;
        const int c8 = tgs & 15;
        const int o_piece = (((tgs >> 4) * HG_LD) + c8 * 8) * 2;
        const int ci = g ? nch - 1 - step : step;
#pragma unroll
        for (int i = 0; i < 2; ++i) { const int tau = (tgs + 256 * i) >> 4; float x[8], lf[8], kk[8]; unpack8(P.f[i], x);
            const f32x4 b0 = *(const LAS f32x4*)(BIASV + c8 * 8), b1 = *(const LAS f32x4*)(BIASV + c8 * 8 + 4), l0 = *(const LAS f32x4*)(LBV + c8 * 8), l1 = *(const LAS f32x4*)(LBV + c8 * 8 + 4);
            const float bb[8] = {b0[0], b0[1], b0[2], b0[3], b1[0], b1[1], b1[2], b1[3]}, ll[8] = {l0[0], l0[1], l0[2], l0[3], l1[0], l1[1], l1[2], l1[3]};
#pragma unroll
            for (int e = 0; e < 8; ++e) { const float sg = sigmoidf_(x[e] + bb[e]); const float f = ll[e] + (1.f - ll[e]) * sg; lf[e] = __logf(fmaxf(f, 1e-37f)); kk[e] = 1.f - f; }
            *(LAS f32x4*)(LF + tau * 128 + c8 * 8) = (f32x4){lf[0], lf[1], lf[2], lf[3]}; *(LAS f32x4*)(LF + tau * 128 + c8 * 8 + 4) = (f32x4){lf[4], lf[5], lf[6], lf[7]};
            v4u w; w.x = pk2(kk[0], kk[1]); w.y = pk2(kk[2], kk[3]); w.z = pk2(kk[4], kk[5]); w.w = pk2(kk[6], kk[7]);
            const ldsp tp = gb + o_piece + i * (16 * HG_LD * 2);
            *(LAS v4u*)(tp + HG_KT) = w;
            if (OUTPUT) *(LAS v4u*)(tp + HG_QT) = P.q[i];
            *(LAS v4u*)(tp + HG_V) = P.v[i]; }
        if (step + 1 < nch) hg_issue(P, proj, rowbase, seg_t0 + 32 * (g ? nch - 2 - step : step + 1), g, h, tgs, OUTPUT);
        __syncthreads();
        if (tgs < 128) { float run = 0.f, am = 0.f;
#pragma unroll 8
            for (int tau = 0; tau < 32; ++tau) { run += LF[tau * 128 + tgs]; LF[tau * 128 + tgs] = run; if (tau == 15) am = run; }
            AMID[tgs] = am; ALAST[tgs] = run; DEC[tgs] = __expf(run); EAM[tgs] = __expf(am); atot += run; }
        __syncthreads();
#pragma unroll
        for (int i = 0; i < 2; ++i) { const int tau = (tgs + 256 * i) >> 4; const ldsp tp = gb + o_piece + i * (16 * HG_LD * 2);
            const f32x4 a0 = *(const LAS f32x4*)(LF + tau * 128 + c8 * 8), a1 = *(const LAS f32x4*)(LF + tau * 128 + c8 * 8 + 4);
            const f32x4 m0 = *(const LAS f32x4*)(AMID + c8 * 8), m1 = *(const LAS f32x4*)(AMID + c8 * 8 + 4), l0 = *(const LAS f32x4*)(ALAST + c8 * 8), l1 = *(const LAS f32x4*)(ALAST + c8 * 8 + 4);
            float a[8] = {a0[0], a0[1], a0[2], a0[3], a1[0], a1[1], a1[2], a1[3]}, am[8] = {m0[0], m0[1], m0[2], m0[3], m1[0], m1[1], m1[2], m1[3]}, al[8] = {l0[0], l0[1], l0[2], l0[3], l1[0], l1[1], l1[2], l1[3]};
            float qx[8], kx[8], qo[8], ko[8], ho[8]; { const v4u kw = *(const LAS v4u*)(tp + HG_KT); unpack8(kw, kx); if (OUTPUT) { const v4u qw = *(const LAS v4u*)(tp + HG_QT); unpack8(qw, qx); } }
#pragma unroll
            for (int e = 0; e < 8; ++e) { if (OUTPUT) { qo[e] = qx[e] * __expf(clamp80(a[e] - am[e])); ko[e] = kx[e] * __expf(clamp80(am[e] - a[e])); } ho[e] = kx[e] * __expf(al[e] - a[e]); }
            v4u w;
            if (OUTPUT) { w.x = pk2(qo[0], qo[1]); w.y = pk2(qo[2], qo[3]); w.z = pk2(qo[4], qo[5]); w.w = pk2(qo[6], qo[7]); *(LAS v4u*)(tp + HG_QT) = w;
                w.x = pk2(ko[0], ko[1]); w.y = pk2(ko[2], ko[3]); w.z = pk2(ko[4], ko[5]); w.w = pk2(ko[6], ko[7]); *(LAS v4u*)(tp + HG_KT) = w; }
            w.x = pk2(ho[0], ho[1]); w.y = pk2(ho[2], ho[3]); w.z = pk2(ho[4], ho[5]); w.w = pk2(ho[6], ho[7]); *(LAS v4u*)(tp + HG_KH) = w; }
        __syncthreads();
        float hrow[16];
        if (OUTPUT) {
            f32x16 s = zero16();
#pragma unroll
            for (int ks = 0; ks < 8; ++ks) s = MFMA32(lds16(gb + HG_KT + fo.o_row + 32 * ks), lds16(gb + HG_QT + fo.o_row + 32 * ks), s);
#pragma unroll
            for (int i = 0; i < 16; ++i) s[i] = (crow(i, hh) <= r) ? s[i] : 0.f;
            f32x16 o = zero16();
#pragma unroll
            for (int sp = 0; sp < 2; ++sp) o = MFMA32(pack8(s, sp), ldstr2(gb + HG_V + fo.o_trp + vcol + (16 * sp * HG_LD) * 2, 8 * HG_LD * 2), o);
#pragma unroll
            for (int dt = 0; dt < 4; ++dt)
#pragma unroll
                for (int sp = 0; sp < 2; ++sp) { const f32x4 e0 = *(const LAS f32x4*)(gb + HG_EAM + o_h4 + (32 * dt + 16 * sp) * 4), e1 = *(const LAS f32x4*)(gb + HG_EAM + o_h4 + (32 * dt + 16 * sp + 8) * 4);
                    v4u pw; pw.x = cvtpk(St[dt][8 * sp] * e0[0], St[dt][8 * sp + 1] * e0[1]); pw.y = cvtpk(St[dt][8 * sp + 2] * e0[2], St[dt][8 * sp + 3] * e0[3]);
                    pw.z = cvtpk(St[dt][8 * sp + 4] * e1[0], St[dt][8 * sp + 5] * e1[1]); pw.w = cvtpk(St[dt][8 * sp + 6] * e1[2], St[dt][8 * sp + 7] * e1[3]);
                    o = MFMA32(lds8x2(gb + HG_QT + fo.o_perm + (32 * dt + 16 * sp) * 2), __builtin_bit_cast(bf16x8, pw), o); }
#pragma unroll
            for (int i = 0; i < 16; ++i) *(LAS float*)(OBb + o_obw + ((i & 3) + 8 * (i >> 2)) * 144) = o[i];
            LDS_WAIT(); CFENCE();
#pragma unroll
            for (int k4 = 0; k4 < 4; ++k4) { const f32x4 x = *(const LAS f32x4*)(OBb + o_obr + 16 * k4); hrow[4 * k4] = x[0]; hrow[4 * k4 + 1] = x[1]; hrow[4 * k4 + 2] = x[2]; hrow[4 * k4 + 3] = x[3]; }
            LDS_WAIT(); CFENCE();
        }
#pragma unroll
        for (int dt = 0; dt < 4; ++dt) {
#pragma unroll
            for (int q4 = 0; q4 < 4; ++q4) { const f32x4 dv = *(const LAS f32x4*)(gb + HG_AUX + 1024 + o_h4 + (32 * dt + 8 * q4) * 4);
#pragma unroll
                for (int e = 0; e < 4; ++e) St[dt][4 * q4 + e] *= dv[e]; }
#pragma unroll
            for (int sp = 0; sp < 2; ++sp) St[dt] = MFMA32(ldstr2(gb + HG_KH + fo.o_trn + (16 * sp * HG_LD + 32 * dt) * 2, 4 * HG_LD * 2), ldstr2(gb + HG_V + fo.o_trn + vcol + (16 * sp * HG_LD) * 2, 4 * HG_LD * 2), St[dt]);
        }
        if (OUTPUT) {
            const bool second = step >= (nch >> 1);
            const int colh = 32 * j + 16 * (lns & 1); const int tau = lns >> 1; const int t = seg_t0 + 32 * ci + (g ? 31 - tau : tau);
            bf16* op = aout + (size_t)(rowbase + t) * D + h * 128 + colh;
            if (!second) { v4u w0, w1; w0.x = pk2(hrow[0], hrow[1]); w0.y = pk2(hrow[2], hrow[3]); w0.z = pk2(hrow[4], hrow[5]); w0.w = pk2(hrow[6], hrow[7]);
                w1.x = pk2(hrow[8], hrow[9]); w1.y = pk2(hrow[10], hrow[11]); w1.z = pk2(hrow[12], hrow[13]); w1.w = pk2(hrow[14], hrow[15]);
                *(v4u*)op = w0; *(v4u*)(op + 8) = w1; }
            else { const v4u p0 = *(const v4u*)op, p1 = *(const v4u*)(op + 8); float x0[8], x1[8]; unpack8(p0, x0); unpack8(p1, x1); float ss = 0.f;
#pragma unroll
                for (int e = 0; e < 8; ++e) { hrow[e] += x0[e]; hrow[8 + e] += x1[e]; ss += hrow[e] * hrow[e] + hrow[8 + e] * hrow[8 + e]; }
                ss += __shfl_xor(ss, 1);
                if ((lns & 1) == 0) SSQ[j * 32 + (lns >> 1)] = ss; }
            VM_WAIT();
            __syncthreads();
            if (second) {
                const int rr = lns >> 1;
                const float tot = SSQ[rr] + SSQ[32 + rr] + SSQ[64 + rr] + SSQ[96 + rr];
                const float rs = rsqrtf(tot * (1.f / 128.f) + EPS);
                const bf16* gp = proj + (size_t)(rowbase + t) * NP_H + 4096 + h * 128 + colh; const v4u g0 = *(const v4u*)gp, g1 = *(const v4u*)(gp + 8); float o0[8], o1[8]; unpack8(g0, o0); unpack8(g1, o1);
                const float* gh = ghead + h * 128 + colh; float y[16];
#pragma unroll
                for (int e = 0; e < 8; ++e) { y[e] = hrow[e] * rs * gh[e] * sigmoidf_(o0[e]); y[8 + e] = hrow[8 + e] * rs * gh[8 + e] * sigmoidf_(o1[e]); }
                v4u w0, w1; w0.x = pk2(y[0], y[1]); w0.y = pk2(y[2], y[3]); w0.z = pk2(y[4], y[5]); w0.w = pk2(y[6], y[7]); w1.x = pk2(y[8], y[9]); w1.y = pk2(y[10], y[11]); w1.z = pk2(y[12], y[13]); w1.w = pk2(y[14], y[15]);
                *(v4u*)op = w0; *(v4u*)(op + 8) = w1; }
            VM_WAIT();
        } else {
            __syncthreads();
        }
    }
    if (!OUTPUT) {
        float* e = g ? st_out1 : st_out0; float* ep = e + (4 * hh) * 128 + 32 * j + r;
#pragma unroll
        for (int dt = 0; dt < 4; ++dt)
#pragma unroll
            for (int i = 0; i < 16; ++i) ep[(32 * dt + (i & 3) + 8 * (i >> 2)) * 128] = St[dt][i];
        if (tg < 128) e[16384 + tg] = atot;
    }
}

constexpr int PH_PER_LAYER = 10, PH_BASE = 2, N_PHASES = PH_BASE + DEPTH * PH_PER_LAYER;
#ifndef EN_GEMM
#define EN_GEMM 0xff
#endif
#ifndef EN_ML
#define EN_ML 3
#endif
#ifndef EN_HG
#define EN_HG 3
#endif
#ifndef EN_TOK
#define EN_TOK 1
#endif
#ifndef EN_MISC
#define EN_MISC 1
#endif
#ifndef PG_SP2
#define PG_SP2 true
#endif
#ifndef PG_ALIGN
#define PG_ALIGN true
#endif
#ifndef MK_SPLIT
#define MK_SPLIT 0
#endif


__device__ __forceinline__ void phase_conv(Frame& F, const bf16* proj, bf16* qkc, float* gates, const float* wconv, const float* bgate) {
    const int gt = F.bid * NTHR + F.tid, cp = gt & 127, rstep = (F.G * NTHR) >> 7;
    float w[3][8];
#pragma unroll
    for (int d = 0; d < 3; ++d)
#pragma unroll
        for (int e = 0; e < 8; ++e) w[d][e] = wconv[d * 1024 + cp * 8 + e];
    const float sc = cp >= 64 ? 0.125f : 1.0f;
    for (int row = gt >> 7; row < M_ALL; row += rstep) {
        int t, len; if (row < M_LAT) { t = row & (SEQ - 1); len = SEQ; } else { t = (row - M_LAT) & (CTXL - 1); len = CTXL; }
        const bf16* rp = proj + (size_t)row * NP_M + cp * 8;
        const v4u z = (v4u){0u, 0u, 0u, 0u};
        const v4u r0 = t > 0 ? *(const v4u*)(rp - NP_M) : z, r1 = *(const v4u*)rp, r2 = t + 1 < len ? *(const v4u*)(rp + NP_M) : z;
        float x0[8], x1[8], x2[8], o[8]; unpack8(r0, x0); unpack8(r1, x1); unpack8(r2, x2);
#pragma unroll
        for (int e = 0; e < 8; ++e) o[e] = sc * siluf_(w[0][e] * x0[e] + w[1][e] * x1[e] + w[2][e] * x2[e]);
        v4u q; q.x = pk2(o[0], o[1]); q.y = pk2(o[2], o[3]); q.z = pk2(o[4], o[5]); q.w = pk2(o[6], o[7]);
        *(v4u*)(qkc + (size_t)row * D + cp * 8) = q;
    }
    for (int i = gt; i < M_ALL * 32; i += F.G * NTHR) { const int c = i & 31; const float x = gates[i] + bgate[c];
        gates[i] = ((c >> 3) & 1) ? (fminf(x, 0.f) - __logf(1.f + __expf(-fabsf(x)))) : x; }
}

__device__ __forceinline__ Frame mkframe(const Args& args, unsigned char* lds_raw) {
    Frame F; int t = threadIdx.x; asm volatile("" : "+v"(t));
    F.lds = (LAS unsigned char*)lds_raw; F.tid = t; F.lane = t & 63; F.wave = __builtin_amdgcn_readfirstlane(t >> 6);
    int g = gridDim.x, b = blockIdx.x; asm volatile("" : "+s"(g), "+s"(b)); F.G = g; F.bid = b;
    unsigned char* w = args.ws; asm volatile("" : "+s"(w)); F.ws = w; F.in = args.in; F.out = args.out;
    return F;
}
#define PHASE_LOCALS \
    Frame F = mkframe(args, lds_raw); unsigned char* ws = F.ws; \
    float* modv = (float*)(ws + WS_MODV); bf16* U = (bf16*)(ws + WS_U); bf16* Y = (bf16*)(ws + WS_Y); bf16* PROJ = (bf16*)(ws + WS_ACT); bf16* HB = (bf16*)(ws + WS_ACT); \
    bf16* AMOE = (bf16*)(ws + WS_ACT); bf16* HMOE = (bf16*)(ws + WS_ACT + (size_t)MOE_ROWS * D * 2); \
    float* GATES = (float*)(ws + WS_GATES); float* LATC = (float*)(ws + WS_LATC); float* STATE = (float*)(ws + WS_STATE); \
    const int* pexp = (const int*)(ws + WS_SMALL + SM_PEXP); \
    unsigned char* wb = ws + (odd ? WS_WO : WS_WE); const float* mv = modv + (size_t)L * 9 * 6 * 1024; \
    (void)modv; (void)U; (void)Y; (void)PROJ; (void)HB; (void)AMOE; (void)HMOE; (void)GATES; (void)LATC; (void)STATE; (void)pexp; (void)wb; (void)mv;

__global__ void __launch_bounds__(NTHR, 2) fwd(Args args) {
    extern __shared__ __attribute__((aligned(16))) unsigned char lds_raw[];
    Frame F = mkframe(args, lds_raw);
    volatile LAS unsigned* LCTL = (volatile LAS unsigned*)(F.lds + LDSCTL_OFF);
    for (int u = F.tid; u < 128; u += NTHR) LCTL[u] = 0u;
    __syncthreads();
    XcdBarrier bar; bar.bar = (unsigned*)(F.ws + WS_CTL) + CW_BAR; bar.x = 0; bar.st = nullptr;
    if (args.use_bar) bar = xcd_barrier_post((unsigned*)(F.ws + WS_CTL) + CW_BAR, LCTL + 8);
    const int lo = args.ph_lo, hi = args.ph_hi;
#define IN(k) (lo <= (k) && (k) < hi)
#define SEAM(k) do { if ((k) + 1 < hi) xcd_barrier(bar); } while (0)
    if (IN(0)) { const int L = 0; const bool odd = false; PHASE_LOCALS if (EN_MISC) phase_mods(F); __syncthreads(); if (EN_MISC) phase_wconv(F, 0); SEAM(0); }
    if (IN(1)) { const int L = 0; const bool odd = false; PHASE_LOCALS
        TokCfg T{}; T.lat_src_l = F.in[I_X]; T.lat_src_c = F.in[I_CTX]; T.vna = modv + 0 * 1024; T.vnb = modv + 1 * 1024; T.u = U; T.nrows = M_ALL;
        if (EN_TOK) phase_tok(F, T); __syncthreads(); if (EN_MISC) phase_wconv(F, 1); SEAM(1);
    }
    for (int L = 0; L < DEPTH; ++L) {
        const int pb = PH_BASE + L * PH_PER_LAYER; const bool odd = (L & 1) != 0; const int jl = L >> 1;
        const bool ctx_out = L < DEPTH - 1;
        if (IN(pb + 0)) { PHASE_LOCALS
            pg8::Order S; pg8::Gemm g;
            if (!odd) { g = pg8::Gemm{U, (const bf16*)(wb + WE_IN), M_ALL, NIN_M, D}; S.init(M_ALL / 256, NIN_M, F.G, F.bid, nullptr, 0);
                pg8::EpiStore E{PROJ, NP_M, NP_M / 256, NP_M / 256, GATES}; if (EN_GEMM & (1 << 0)) pg8::gemm_phase<pg8::EpiStore, pg8::Order, PG_ALIGN, PG_SP2>(F.lds, g, S, E); }
            else { g = pg8::Gemm{U, (const bf16*)(wb + WOD_IN), M_ALL, NP_H, D}; S.init(M_ALL / 256, NP_H, F.G, F.bid, nullptr, 0);
                pg8::EpiStore E{PROJ, NP_H, NP_H / 256, -1, nullptr}; if (EN_GEMM & (1 << 1)) pg8::gemm_phase<pg8::EpiStore, pg8::Order, PG_ALIGN, PG_SP2>(F.lds, g, S, E); }
            SEAM(pb + 0);
        }
        if (IN(pb + 1)) {
            if (!odd) { PHASE_LOCALS
                phase_conv(F, PROJ, (bf16*)(ws + WS_ACT + 400 * MiB), GATES, F.in[I_MWCONV] + (size_t)jl * 3 * 1024, F.in[I_MBGATE] + jl * 32); SEAM(pb + 1); }
        }
        if (IN(pb + 2)) { PHASE_LOCALS
            for (int id = F.bid; id < 256; id += F.G) {
                const int bh = id >> 2, p = id & 3, b = bh >> 3, h = bh & 7;
                MlSeg SG0, SG1;
                const int csz = odd ? 32 : 64;
                if (p == 0) { SG0 = MlSeg{M_LAT + b * CTXL, CTXL, 0, CTXL / csz}; SG1 = SG0; }
                else { SG0 = MlSeg{b * SEQ, SEQ, (p - 1) * 2048, 2048 / csz}; SG1 = MlSeg{b * SEQ, SEQ, (4 - p) * 2048, 2048 / csz}; }
                if (!odd) { float* e0 = STATE + (size_t)((bh * 2 + 0) * 4 + p) * ML_STATE_F; float* e1 = STATE + (size_t)((bh * 2 + 1) * 4 + p) * ML_STATE_F;
                    if (EN_ML & 1) mlstm_item<false>(F, PROJ, (const bf16*)(ws + WS_ACT + 400 * MiB), GATES, U, F.in[I_MGHEAD] + jl * 1024, h, SG0, SG1, nullptr, nullptr, 0, 0, e0, e1); }
                else { float* e0 = STATE + (size_t)((bh * 2 + 0) * 4 + p) * HG_STATE_F; float* e1 = STATE + (size_t)((bh * 2 + 1) * 4 + p) * HG_STATE_F;
                    if (EN_HG & 1) hgrn_item<false>(F, PROJ, U, F.in[I_HBF] + (size_t)jl * 2048, F.in[I_HLB], jl, F.in[I_HGHEAD] + jl * 1024, h, SG0, SG1, nullptr, nullptr, 0, 0, e0, e1); }
            }
            SEAM(pb + 2);
        }
        if (IN(pb + 3)) { PHASE_LOCALS
            const int nitems = ctx_out ? 320 : 256;
            for (int id = F.bid; id < nitems; id += F.G) {
                MlSeg SG0, SG1; int bh, npre0 = 0, npre1 = 0; const int csz = odd ? 32 : 64;
                if (id < 256) { bh = id >> 2; const int q = id & 3; SG0 = MlSeg{(bh >> 3) * SEQ, SEQ, q * 2048, 2048 / csz}; npre0 = q + 1; npre1 = 4 - q; }
                else { bh = id - 256; SG0 = MlSeg{M_LAT + (bh >> 3) * CTXL, CTXL, 0, CTXL / csz}; }
                SG1 = SG0;
                const int h = bh & 7;
                if (!odd) { const float* s0 = STATE + (size_t)((bh * 2 + 0) * 4) * ML_STATE_F; const float* s1 = STATE + (size_t)((bh * 2 + 1) * 4) * ML_STATE_F;
                    if (EN_ML & 2) mlstm_item<true>(F, PROJ, (const bf16*)(ws + WS_ACT + 400 * MiB), GATES, U, F.in[I_MGHEAD] + jl * 1024, h, SG0, SG1, s0, s1, npre0, npre1, nullptr, nullptr); }
                else { const float* s0 = STATE + (size_t)((bh * 2 + 0) * 4) * HG_STATE_F; const float* s1 = STATE + (size_t)((bh * 2 + 1) * 4) * HG_STATE_F;
                    if (EN_HG & 2) hgrn_item<true>(F, PROJ, U, F.in[I_HBF] + (size_t)jl * 2048, F.in[I_HLB], jl, F.in[I_HGHEAD] + jl * 1024, h, SG0, SG1, s0, s1, npre0, npre1, nullptr, nullptr); }
            }
            SEAM(pb + 3);
        }
        if (IN(pb + 4)) { PHASE_LOCALS
            const int nM = (ctx_out ? M_ALL : M_LAT) / 256;
            pg8::Gemm g{U, (const bf16*)(wb + (odd ? WOD_OUT : WE_OUT)), nM * 256, D, D}; pg8::Order S; S.init(nM, D, F.G, F.bid, nullptr, 0);
            pg8::EpiStore E{Y, D, D / 256, -1, nullptr}; if (EN_GEMM & (1 << 2)) pg8::gemm_phase<pg8::EpiStore, pg8::Order, PG_ALIGN, PG_SP2>(F.lds, g, S, E);
            SEAM(pb + 4);
        }
        if (IN(pb + 5)) { PHASE_LOCALS
            TokCfg T{}; T.lat_src_l = (L == 0) ? F.in[I_X] : F.out; T.lat_src_c = (L == 0) ? F.in[I_CTX] : LATC; T.lat_dst_l = F.out; T.lat_dst_c = LATC;
            T.y = Y; T.y_perm = odd ? 1 : 0; T.vupd = mv + 2 * 1024; T.vna = mv + 3 * 1024; T.vnb = mv + 4 * 1024; T.u = U; T.route = odd ? 1 : 0; T.jr = jl; T.nrows = ctx_out ? M_ALL : M_LAT;
            if (EN_TOK) phase_tok(F, T);
            if (L >= 1 && L + 1 < DEPTH) { __syncthreads(); if (EN_MISC) phase_wconv(F, L + 1); }
            SEAM(pb + 5);
        }
        if (IN(pb + 6)) { PHASE_LOCALS
            if (odd) { if (EN_MISC) phase_moe_scatter(F, jl, ctx_out ? M_ALL : M_LAT, U, AMOE); SEAM(pb + 6); }
        }
        if (IN(pb + 7)) { PHASE_LOCALS
            if (!odd) { pg8::Gemm g{U, (const bf16*)(wb + WE_GU), M_ALL, NGU, D}; pg8::Order S; S.init(M_ALL / 256, NGU, F.G, F.bid, nullptr, 0);
                pg8::EpiSwiGLU E{HB, FF}; if (EN_GEMM & (1 << 3)) pg8::gemm_phase<pg8::EpiSwiGLU, pg8::Order, PG_ALIGN, PG_SP2>(F.lds, g, S, E); }
            else { const int np = __builtin_amdgcn_readfirstlane(pexp[MOE_PANELS]);
                pg8::Gemm g{AMOE, (const bf16*)(wb + WOD_GU), np * 256, NGU, D}; pg8::Order S; S.init(np, NGU, F.G, F.bid, pexp, EGU_BYTES);
                pg8::EpiSwiGLU E{HMOE, FF}; if (EN_GEMM & (1 << 4)) pg8::gemm_phase<pg8::EpiSwiGLU, pg8::Order, PG_ALIGN, PG_SP2>(F.lds, g, S, E); }
            SEAM(pb + 7);
        }
        if (IN(pb + 8)) { PHASE_LOCALS
            if (!odd) { pg8::Gemm g{HB, (const bf16*)(wb + WE_DOWN), M_ALL, D, FF}; pg8::Order S; S.init(M_ALL / 256, D, F.G, F.bid, nullptr, 0);
                pg8::EpiStore E{Y, D, D / 256, -1, nullptr}; if (EN_GEMM & (1 << 5)) pg8::gemm_phase<pg8::EpiStore, pg8::Order, PG_ALIGN, PG_SP2>(F.lds, g, S, E); }
            else { const int np = __builtin_amdgcn_readfirstlane(pexp[MOE_PANELS]);
                pg8::Gemm g{HMOE, (const bf16*)(wb + WOD_DOWN), np * 256, D, FF}; pg8::Order S; S.init(np, D, F.G, F.bid, pexp, EDOWN_BYTES);
                pg8::EpiStore E{AMOE, D, D / 256, -1, nullptr}; if (EN_GEMM & (1 << 6)) pg8::gemm_phase<pg8::EpiStore, pg8::Order, PG_ALIGN, PG_SP2>(F.lds, g, S, E); }
            SEAM(pb + 8);
        }
        if (IN(pb + 9)) { PHASE_LOCALS
            TokCfg T{}; T.lat_src_l = F.out; T.lat_src_c = LATC; T.lat_dst_l = F.out; T.lat_dst_c = LATC;
            T.y = odd ? AMOE : Y; T.moe_combine = odd ? 1 : 0; T.vupd = mv + 5 * 1024; T.nrows = ctx_out ? M_ALL : M_LAT;
            if (L + 1 < DEPTH) { const float* mn = modv + (size_t)(L + 1) * 9 * 6 * 1024; T.vna = mn; T.vnb = mn + 1024; T.u = U; T.u_perm = ((L + 1) & 1) ? 1 : 0; }
            if (EN_TOK) phase_tok(F, T);
            SEAM(pb + 9);
        }
    }
#undef IN
#undef SEAM
}

extern "C" void kernel_launch(void* const* d_in, const int* in_sizes, int n_in, void* d_out, int out_size, void* d_ws, size_t ws_size, hipStream_t stream) {
    static int grid = 0;
    if (grid == 0) {
        if (n_in != 23 || out_size != M_LAT * D || ws_size < WS_END) { fprintf(stderr, "kernel_launch: unexpected shapes / workspace (n_in %d out %d ws %zu need %zu)\n", n_in, out_size, ws_size, (size_t)WS_END); grid = -1; return; }
        int dev = 0, cus = 0, per_cu = 0;
        if (hipGetDevice(&dev) != hipSuccess || hipDeviceGetAttribute(&cus, hipDeviceAttributeMultiprocessorCount, dev) != hipSuccess) { grid = -1; return; }
        if (hipFuncSetAttribute((const void*)fwd, hipFuncAttributeMaxDynamicSharedMemorySize, LDS_BYTES) != hipSuccess) { fprintf(stderr, "kernel_launch: hipFuncSetAttribute failed\n"); grid = -1; return; }
        if (hipOccupancyMaxActiveBlocksPerMultiprocessor(&per_cu, (const void*)fwd, NTHR, LDS_BYTES) != hipSuccess || per_cu < 1) fprintf(stderr, "kernel_launch: occupancy query reports %d\n", per_cu);
        (void)hipGetLastError();
        grid = cus;
    }
    if (grid < 0) return;
    (void)hipMemsetAsync((char*)d_ws + WS_CTL, 0, CTL_ZERO_BYTES, stream);
    Args a{};
    for (int i = 0; i < 23; ++i) a.in[i] = (const float*)d_in[i];
    a.out = (float*)d_out; a.ws = (unsigned char*)d_ws;
#if MK_SPLIT
    for (int p = 0; p < N_PHASES; ++p) { a.ph_lo = p; a.ph_hi = p + 1; a.use_bar = 0; a.pad = 0; hipLaunchKernelGGL(fwd, dim3(grid), dim3(NTHR), LDS_BYTES, stream, a); }
#else
    a.ph_lo = 0; a.ph_hi = N_PHASES; a.use_bar = 1; a.pad = 0;
    hipLaunchKernelGGL(fwd, dim3(grid), dim3(NTHR), LDS_BYTES, stream, a);
#endif
}
```

```cpp
#include <hip/hip_runtime.h>
#include <cstdio>
#include <cstdint>

namespace pg8 {
#define PG8_LAS __attribute__((address_space(3)))
typedef unsigned short bf16_t;
typedef short bf16x8 __attribute__((ext_vector_type(8)));
typedef float f32x4 __attribute__((ext_vector_type(4)));
typedef unsigned u32x4 __attribute__((ext_vector_type(4)));
constexpr int BM = 256, BK = 64, HALF = 128, HTB = HALF * BK * 2  , STAGE_BYTES = 8 * HTB, NXCD = 8, WGM = 8;

__host__ __device__ __forceinline__ int lds_byte(int r, int c) { const int st = (r >> 4) * 2 + (c >> 5), rr = r & 15, cc = c & 31, ob = rr * 64 + cc * 2; return st * 1024 + (ob ^ (((ob >> 9) & 1) << 5)); }
__host__ __device__ __forceinline__ void stage_rc(int b, int& R, int& C) { const int st = b / 1024, sb = b % 1024, swz = sb ^ (((sb >> 9) & 1) << 5); R = (st >> 1) * 16 + swz / 64; C = (st & 1) * 32 + (swz % 64) / 2; }
__host__ __device__ __forceinline__ int perm32(int rho) { const int n = rho >> 4, i = rho & 15; return 8 * (i >> 2) + 4 * n + (i & 3); }

struct Unit { int pm, pn; };
struct Gemm { const bf16_t* A; const bf16_t* Bt; int M, N, K; };

struct Order {
    int nM, nN, nwg, G, c; const int* pexp; size_t bstride;
    __device__ void init(int nM_, int N, int G_, int c_, const int* pexp_, size_t bstride_) { nM = nM_; nN = N / BM; nwg = nM * nN; G = G_; c = c_; pexp = pexp_; bstride = bstride_; }
    __device__ bool next(int i, Unit& u) const {
        const long L = (long)i * G + c; if (L >= nwg) return false;
        int wgid = (int)L; { const int q = nwg / NXCD, r = nwg % NXCD, xcd = wgid % NXCD, off = wgid / NXCD; wgid = (xcd < r ? xcd * (q + 1) : r * (q + 1) + (xcd - r) * q) + off; }
        const int nig = WGM * nN, gid = wgid / nig, fm = gid * WGM, gsz = (nM - fm) < WGM ? (nM - fm) : WGM;
        u.pm = fm + ((wgid % nig) % gsz); u.pn = (wgid % nig) / gsz; return true;
    }
    __device__ __forceinline__ size_t boff(const Unit& u) const { return pexp ? (size_t)__builtin_amdgcn_readfirstlane(pexp[u.pm]) * bstride : (size_t)0; }
    __device__ __forceinline__ void a_ready(const Unit&) const {}
    __device__ __forceinline__ void done(const Unit&) const {}
};

__device__ __forceinline__ unsigned cvt_pk_bf16(float lo, float hi) { unsigned r; asm volatile("v_cvt_pk_bf16_f32 %0, %1, %2" : "=v"(r) : "v"(lo), "v"(hi)); return r; }

struct EpiStore {
    static constexpr bool PERM = true, AFTER_DRAIN = false;
    bf16_t* O; int ldc; int ncol_tiles; int gate_pn; float* gates;
    __device__ __forceinline__ void operator()(const f32x4 (&acc)[2][2][4][2], const Unit& u, int wr, int wc, int fr, int fq) const {
        const int row0 = u.pm * BM + wr * 64 + fr;
        if (u.pn < ncol_tiles) {
            const int col0 = u.pn * BM + wc * 32 + 8 * fq;
#pragma unroll
            for (int ai = 0; ai < 2; ++ai)
#pragma unroll
                for (int m = 0; m < 4; ++m) { bf16_t* rowp = O + (size_t)(row0 + ai * HALF + m * 16) * ldc + col0;
#pragma unroll
                    for (int bj = 0; bj < 2; ++bj) { const f32x4 v0 = acc[ai][bj][m][0], v1 = acc[ai][bj][m][1];
                        u32x4 w; w.x = cvt_pk_bf16(v0[0], v0[1]); w.y = cvt_pk_bf16(v0[2], v0[3]); w.z = cvt_pk_bf16(v1[0], v1[1]); w.w = cvt_pk_bf16(v1[2], v1[3]);
                        *(u32x4*)(rowp + bj * HALF) = w; } }
        } else if (u.pn == gate_pn && wc == 0) {
#pragma unroll
            for (int ai = 0; ai < 2; ++ai)
#pragma unroll
                for (int m = 0; m < 4; ++m) { float* rowp = gates + (size_t)(row0 + ai * HALF + m * 16) * 32 + 8 * fq;
                    *(f32x4*)(rowp) = acc[ai][0][m][0]; *(f32x4*)(rowp + 4) = acc[ai][0][m][1]; }
        }
    }
};
struct EpiSwiGLU {
    static constexpr bool PERM = true, AFTER_DRAIN = false;
    bf16_t* O; int ldc;
    __device__ __forceinline__ void operator()(const f32x4 (&acc)[2][2][4][2], const Unit& u, int wr, int wc, int fr, int fq) const {
        const int row0 = u.pm * BM + wr * 64 + fr, col0 = u.pn * HALF + wc * 32 + 8 * fq;
#pragma unroll
        for (int ai = 0; ai < 2; ++ai)
#pragma unroll
            for (int m = 0; m < 4; ++m) { bf16_t* rowp = O + (size_t)(row0 + ai * HALF + m * 16) * ldc + col0; float r[8];
#pragma unroll
                for (int n = 0; n < 2; ++n)
#pragma unroll
                    for (int j = 0; j < 4; ++j) { const float g = acc[ai][0][m][n][j], up = acc[ai][1][m][n][j]; r[n * 4 + j] = g * __builtin_amdgcn_rcpf(1.0f + __expf(-g)) * up; }
                u32x4 w; w.x = cvt_pk_bf16(r[0], r[1]); w.y = cvt_pk_bf16(r[2], r[3]); w.z = cvt_pk_bf16(r[4], r[5]); w.w = cvt_pk_bf16(r[6], r[7]);
                *(u32x4*)(rowp) = w; }
    }
};

template <class Epi, class Sched, bool ALIGN_EPI = false, bool SP2 = false>
__device__ __forceinline__ void gemm_phase(PG8_LAS unsigned char* lds, const Gemm g, const Sched& S, const Epi& E) {
    int tid = threadIdx.x; asm volatile("" : "+v"(tid)); const int wid = __builtin_amdgcn_readfirstlane(tid >> 6), lane = tid & 63, wr = wid >> 2, wc = wid & 3, fr = lane & 15, fq = lane >> 4;
    const int K = g.K, nt = K / BK;
    unsigned voffA[2], voffB[2];
#pragma unroll
    for (int i = 0; i < 2; ++i) { int R, C; stage_rc(tid * 16 + i * 8192, R, C); const int Rb = Epi::PERM ? ((R & ~31) + perm32(R & 31)) : R;
        voffA[i] = (unsigned)(R * K + C) * 2u; voffB[i] = (unsigned)(Rb * K + C) * 2u; }
    const size_t kstep = (size_t)(BK * 2);
    const size_t hstep = (size_t)HALF * K * 2;
    const size_t tstep = 2 * hstep;
    const unsigned ldsw = (unsigned)wid * 1024u;
    const int aoff = lds_byte(wr * 64 + fr, fq * 8), boff = lds_byte(wc * 32 + fr, fq * 8);
#define PG8_SA(b, h) (((b) * 2 + (h)) * HTB)
#define PG8_SB(b, h) ((4 + (b) * 2 + (h)) * HTB)
#define PG8_STAGE(bufoff, gbase, voff) do { _Pragma("unroll") for (int _i = 0; _i < 2; ++_i) \
        __builtin_amdgcn_global_load_lds((const unsigned*)((const char*)(gbase) + (voff)[_i]), (PG8_LAS unsigned*)(lds + (bufoff) + ldsw + _i * 8192), 16, 0, 0); } while (0)
#define PG8_LDA(dst, b, h) do { _Pragma("unroll") for (int m = 0; m < 4; ++m) _Pragma("unroll") for (int k = 0; k < 2; ++k) dst[m][k] = *(const PG8_LAS bf16x8*)(lds + PG8_SA(b, h) + aoff + m * 2048 + k * 1024); } while (0)
#define PG8_LDB(dst, b, h) do { _Pragma("unroll") for (int n = 0; n < 2; ++n) _Pragma("unroll") for (int k = 0; k < 2; ++k) dst[n][k] = *(const PG8_LAS bf16x8*)(lds + PG8_SB(b, h) + boff + n * 2048 + k * 1024); } while (0)
#define PG8_MMA(ai, bj, At, Bt) do { __builtin_amdgcn_s_setprio(1); _Pragma("unroll") for (int m = 0; m < 4; ++m) _Pragma("unroll") for (int n = 0; n < 2; ++n) _Pragma("unroll") for (int k = 0; k < 2; ++k) \
        acc[ai][bj][m][n] = __builtin_amdgcn_mfma_f32_16x16x32_bf16(Bt[n][k], At[m][k], acc[ai][bj][m][n], 0, 0, 0); __builtin_amdgcn_s_setprio(0); } while (0)
#define PG8_WAIT_V(n) asm volatile("s_waitcnt vmcnt(" #n ")" ::: "memory")
#define PG8_WAIT_L(n) asm volatile("s_waitcnt lgkmcnt(" #n ")" ::: "memory")
#define PG8_BAR __builtin_amdgcn_s_barrier()
#define PG8_SCHED __builtin_amdgcn_sched_barrier(0)
    Unit cur, nxt; int ui = 0;
    if (!S.next(0, cur)) return;
    f32x4 acc[2][2][4][2];
#pragma unroll
    for (int a = 0; a < 2; ++a)
#pragma unroll
        for (int b = 0; b < 2; ++b)
#pragma unroll
            for (int m = 0; m < 4; ++m)
#pragma unroll
                for (int n = 0; n < 2; ++n) acc[a][b][m][n] = (f32x4){0.f, 0.f, 0.f, 0.f};
    bf16x8 At[4][2], B0[2][2], B1[2][2];
    const char* cA = (const char*)g.A + (size_t)cur.pm * tstep; const char* cB = (const char*)g.Bt + S.boff(cur) + (size_t)cur.pn * tstep;
    S.a_ready(cur);
    if constexpr (SP2) {
        PG8_STAGE(PG8_SB(0, 0), cB, voffB); PG8_STAGE(PG8_SB(0, 1), cB + hstep, voffB); PG8_STAGE(PG8_SA(0, 0), cA, voffA); PG8_STAGE(PG8_SA(0, 1), cA + hstep, voffA);
        if (wr == 1) PG8_BAR;
        PG8_WAIT_V(2); PG8_BAR;
        PG8_STAGE(PG8_SB(1, 0), cB + kstep, voffB); PG8_STAGE(PG8_SA(1, 0), cA + kstep, voffA); PG8_STAGE(PG8_SB(1, 1), cB + hstep + kstep, voffB);
        PG8_WAIT_V(6); PG8_BAR;
    } else {
        PG8_STAGE(PG8_SB(0, 0), cB, voffB); PG8_STAGE(PG8_SA(0, 0), cA, voffA); PG8_STAGE(PG8_SB(0, 1), cB + hstep, voffB); PG8_STAGE(PG8_SA(0, 1), cA + hstep, voffA);
        if (wr == 1) PG8_BAR;
        PG8_WAIT_V(4); PG8_BAR;
        PG8_STAGE(PG8_SB(1, 0), cB + kstep, voffB); PG8_STAGE(PG8_SA(1, 0), cA + kstep, voffA); PG8_STAGE(PG8_SB(1, 1), cB + hstep + kstep, voffB);
        PG8_WAIT_V(6); PG8_BAR;
    }
    for (;;) {
        const bool has_next = S.next(ui + 1, nxt);
        const char* nA = has_next ? (const char*)g.A + (size_t)nxt.pm * tstep : cA; const char* nB = has_next ? (const char*)g.Bt + S.boff(nxt) + (size_t)nxt.pn * tstep : cB;
        for (int t = 0; t < nt; t += 2) {
            const bool last = (t == nt - 2);
            const char* a1 = cA + (size_t)(t + 1) * kstep;
            const char* a2 = last ? nA : cA + (size_t)(t + 2) * kstep; const char* b2 = last ? nB : cB + (size_t)(t + 2) * kstep;
            const char* a3 = a2 + kstep; const char* b3 = b2 + kstep;
            if (last && has_next) S.a_ready(nxt);
            if constexpr (SP2) {
            PG8_LDB(B0, 0, 0); PG8_LDB(B1, 0, 1); PG8_SCHED; PG8_LDA(At, 0, 0); PG8_STAGE(PG8_SA(1, 1), a1 + hstep, voffA);
            PG8_WAIT_V(8); PG8_WAIT_L(0); PG8_BAR; PG8_MMA(0, 0, At, B0); PG8_MMA(0, 1, At, B1); PG8_BAR; PG8_SCHED;
            PG8_LDA(At, 0, 1); PG8_STAGE(PG8_SB(0, 0), b2, voffB); PG8_STAGE(PG8_SB(0, 1), b2 + hstep, voffB); PG8_STAGE(PG8_SA(0, 0), a2, voffA);
            PG8_WAIT_V(8); PG8_WAIT_L(0); PG8_BAR; PG8_MMA(1, 0, At, B0); PG8_MMA(1, 1, At, B1); PG8_BAR; PG8_SCHED;
            PG8_LDB(B0, 1, 0); PG8_LDB(B1, 1, 1); PG8_SCHED; PG8_LDA(At, 1, 0); PG8_STAGE(PG8_SA(0, 1), a2 + hstep, voffA);
            PG8_WAIT_V(8); PG8_WAIT_L(0); PG8_BAR; PG8_MMA(0, 0, At, B0); PG8_MMA(0, 1, At, B1); PG8_BAR; PG8_SCHED;
            PG8_LDA(At, 1, 1); PG8_STAGE(PG8_SB(1, 0), b3, voffB); PG8_STAGE(PG8_SB(1, 1), b3 + hstep, voffB); PG8_STAGE(PG8_SA(1, 0), a3, voffA);
            PG8_WAIT_V(8); PG8_WAIT_L(0); PG8_BAR; PG8_MMA(1, 0, At, B0); PG8_MMA(1, 1, At, B1); PG8_BAR; PG8_SCHED;
            } else {
            PG8_LDB(B0, 0, 0); PG8_SCHED; PG8_LDA(At, 0, 0); PG8_STAGE(PG8_SA(1, 1), a1 + hstep, voffA);
            PG8_WAIT_L(8); PG8_BAR; PG8_WAIT_L(0); PG8_MMA(0, 0, At, B0); PG8_BAR; PG8_SCHED;
            PG8_LDB(B1, 0, 1); PG8_STAGE(PG8_SB(0, 0), b2, voffB);
            PG8_BAR; PG8_WAIT_L(0); PG8_MMA(0, 1, At, B1); PG8_BAR;
            PG8_LDA(At, 0, 1); PG8_STAGE(PG8_SA(0, 0), a2, voffA);
            PG8_BAR; PG8_WAIT_L(0); PG8_MMA(1, 0, At, B0); PG8_BAR; PG8_SCHED;
            PG8_STAGE(PG8_SB(0, 1), b2 + hstep, voffB);
            PG8_WAIT_V(6); PG8_BAR; PG8_MMA(1, 1, At, B1); PG8_BAR;
            PG8_LDB(B0, 1, 0); PG8_SCHED; PG8_LDA(At, 1, 0); PG8_STAGE(PG8_SA(0, 1), a2 + hstep, voffA);
            PG8_WAIT_L(8); PG8_BAR; PG8_WAIT_L(0); PG8_MMA(0, 0, At, B0); PG8_BAR; PG8_SCHED;
            PG8_LDB(B1, 1, 1); PG8_STAGE(PG8_SB(1, 0), b3, voffB);
            PG8_BAR; PG8_WAIT_L(0); PG8_MMA(0, 1, At, B1); PG8_BAR;
            PG8_LDA(At, 1, 1); PG8_STAGE(PG8_SA(1, 0), a3, voffA);
            PG8_BAR; PG8_WAIT_L(0); PG8_MMA(1, 0, At, B0); PG8_BAR; PG8_SCHED;
            PG8_STAGE(PG8_SB(1, 1), b3 + hstep, voffB);
            PG8_WAIT_V(6); PG8_BAR; PG8_MMA(1, 1, At, B1); PG8_BAR;
            }
        }
        if constexpr (ALIGN_EPI) { if (wr == 0) PG8_BAR; }
        if constexpr (!Epi::AFTER_DRAIN) { E(acc, cur, wr, wc, fr, fq); S.done(cur); }
        if (!has_next) break;
#pragma unroll
        for (int a = 0; a < 2; ++a)
#pragma unroll
            for (int b = 0; b < 2; ++b)
#pragma unroll
                for (int m = 0; m < 4; ++m)
#pragma unroll
                    for (int n = 0; n < 2; ++n) acc[a][b][m][n] = (f32x4){0.f, 0.f, 0.f, 0.f};
        cur = nxt; cA = nA; cB = nB; ++ui;
        if constexpr (ALIGN_EPI) { if (wr == 1) PG8_BAR; }
    }
    PG8_WAIT_V(0);
    if constexpr (!ALIGN_EPI) { if (wr == 0) PG8_BAR; }
    PG8_BAR;
    if constexpr (Epi::AFTER_DRAIN) { E.fused(acc, cur, wr, wc, fr, fq, lds, wid, lane); S.done(cur); }
#undef PG8_SA
#undef PG8_SB
#undef PG8_STAGE
#undef PG8_LDA
#undef PG8_LDB
#undef PG8_MMA
#undef PG8_WAIT_V
#undef PG8_WAIT_L
#undef PG8_BAR
#undef PG8_SCHED
}
}

constexpr int D = 1024, NB = 8, SEQ = 8192, CTXL = 256, DEPTH = 4, GRIDW = 64, ROWS_G = SEQ / GRIDW  ;
constexpr int M_LAT = NB * SEQ  , M_CTX = NB * CTXL  , M_ALL = M_LAT + M_CTX  ;
constexpr int NHEAD = 8, M_DK = 64, M_DV = 128, H_DK = 128, H_DV = 128;
constexpr int NP_M = 3072, NIN_M = 3328, NW_M = 3104, NP_H = 5120;
constexpr int FF = 2816, NGU = 2 * FF, NEXP = 8;
constexpr int MOE_ROWS = 137216, MOE_PANELS = MOE_ROWS / 256;
constexpr float EPS = 1e-6f;
constexpr int NWAVES = 8, NTHR = 512;

constexpr size_t MiB = 1u << 20;
constexpr size_t WS_CTL = 0, CTL_ZERO_BYTES = 1 * MiB;
constexpr size_t WS_MODV = 1 * MiB;
constexpr size_t WS_SMALL = 2 * MiB;
constexpr size_t WS_LATC = 3 * MiB;
constexpr size_t WS_WE = 11 * MiB;
constexpr size_t WS_WO = 37 * MiB;
constexpr size_t WS_U = 181 * MiB;
constexpr size_t WS_GATES = 313 * MiB;
constexpr size_t WS_STATE = 322 * MiB;
constexpr size_t WS_ROUTE = 362 * MiB;
constexpr size_t WS_ACT = 364 * MiB;
constexpr size_t WS_Y = WS_ACT + 700 * MiB;
constexpr size_t WS_END = WS_ACT + 1005 * MiB;
constexpr size_t WE_IN = 0, WE_OUT = 7 * MiB, WE_GU = 9 * MiB, WE_DOWN = 20 * MiB;
constexpr size_t WOD_IN = 0, WOD_OUT = 10 * MiB, WOD_GU = 12 * MiB, WOD_DOWN = 100 * MiB;
constexpr size_t EGU_BYTES = (size_t)NGU * D * 2, EDOWN_BYTES = (size_t)D * FF * 2;
static_assert(WOD_GU + 8 * EGU_BYTES <= WOD_DOWN && WOD_DOWN + 8 * EDOWN_BYTES <= 144 * MiB, "odd weights map");
static_assert((size_t)NIN_M * D * 2 <= 7 * MiB && WE_GU + EGU_BYTES <= WE_DOWN && WE_DOWN + EDOWN_BYTES <= 26 * MiB, "even weights map");
static_assert((size_t)M_ALL * NP_H * 2 <= 700 * MiB && (size_t)MOE_ROWS * D * 2 + (size_t)MOE_ROWS * FF * 2 <= 1005 * MiB && 700 * MiB + (size_t)M_ALL * D * 2 <= 1005 * MiB, "act map");
constexpr int CW_BAR = 4096;
constexpr int CW_ECNT = 8192;
constexpr int CW_DBG = 16384;
constexpr size_t RT_E = 0;
constexpr size_t RT_R = 512 * 1024;
constexpr size_t RT_W = 512 * 1024 + 1024 * 1024;
constexpr size_t SM_LB = 0;
constexpr size_t SM_PEXP = 64 * 1024;
constexpr size_t SM_EBASE = 96 * 1024;

constexpr int LDS_MAIN = 147456;
constexpr int LDSCTL_OFF = LDS_MAIN;
constexpr int LDS_BYTES = LDS_MAIN + 512;

#define GAS __attribute__((address_space(1)))
#define LAS __attribute__((address_space(3)))
typedef unsigned short bf16;
typedef unsigned v4u __attribute__((ext_vector_type(4)));
typedef unsigned v2u __attribute__((ext_vector_type(2)));
typedef float f32x4 __attribute__((ext_vector_type(4)));
typedef float f32x16 __attribute__((ext_vector_type(16)));
typedef short bf16x8 __attribute__((ext_vector_type(8)));
typedef short s16x4 __attribute__((ext_vector_type(4)));
typedef GAS unsigned gu32;
#define RLX_AGENT __ATOMIC_RELAXED, __HIP_MEMORY_SCOPE_AGENT
#define LDS_WAIT() asm volatile("s_waitcnt lgkmcnt(0)" ::: "memory")
#define VM_WAIT() asm volatile("s_waitcnt vmcnt(0)" ::: "memory")
#define CFENCE() asm volatile("" ::: "memory")
__device__ __forceinline__ unsigned f2bf(float f) { unsigned u = __builtin_bit_cast(unsigned, f); return (u + 0x7fffu + ((u >> 16) & 1u)) >> 16; }
typedef __bf16 bf16x2_t __attribute__((ext_vector_type(2)));
typedef float f32x2_t __attribute__((ext_vector_type(2)));
__device__ __forceinline__ unsigned pk2(float lo, float hi) { f32x2_t v = {lo, hi}; bf16x2_t b = __builtin_convertvector(v, bf16x2_t); return __builtin_bit_cast(unsigned, b); }
__device__ __forceinline__ float bf2f(unsigned short b) { return __builtin_bit_cast(float, (unsigned)b << 16); }
__device__ __forceinline__ float bflo(unsigned w) { return __builtin_bit_cast(float, w << 16); }
__device__ __forceinline__ float bfhi(unsigned w) { return __builtin_bit_cast(float, w & 0xffff0000u); }
__device__ __forceinline__ float sigmoidf_(float x) { return __builtin_amdgcn_rcpf(1.0f + __expf(-x)); }
__device__ __forceinline__ float siluf_(float x) { return x * sigmoidf_(x); }
__device__ __forceinline__ float wave_sum(float v) {
#pragma unroll
    for (int o = 1; o < 64; o <<= 1) v += __shfl_xor(v, o);
    return v;
}

#define XB_TMO      128
#define XB_XCNT(j)  (256  + 64 * (j))
#define XB_XSUB(j)  (1280 + 64 * (j))
#define XB_XGEN(j)  (2304 + 64 * (j))
#define XB_TOP      3328
#define XB_TOPGEN   3392
#define XCD_BAR_WORDS 3456
#define XB_SPIN_CAP (1u << 18)
__device__ __forceinline__ unsigned xb_ld(unsigned* p)              { return __hip_atomic_load(p, __ATOMIC_RELAXED, __HIP_MEMORY_SCOPE_AGENT); }
__device__ __forceinline__ unsigned xb_add(unsigned* p, unsigned v) { return __hip_atomic_fetch_add(p, v, __ATOMIC_RELAXED, __HIP_MEMORY_SCOPE_AGENT); }
__device__ __forceinline__ unsigned xb_xcc_id() { return (unsigned)__builtin_amdgcn_s_getreg((3 << 11) | 20) & 0xFu; }
#define XB_SPIN(cond, bar) do { unsigned _sp = 0; while (cond) { __builtin_amdgcn_s_sleep(1); \
    if ((++_sp & 255u) == 0u) { if (xb_ld(&(bar)[XB_TMO])) break; if (_sp > XB_SPIN_CAP) { atomicAdd(&(bar)[XB_TMO], 1u); break; } } } } while (0)
struct XcdBarrier { unsigned* bar; unsigned x; volatile LAS unsigned* st; };
__device__ __forceinline__ XcdBarrier xcd_barrier_post(unsigned* bar, volatile LAS unsigned* st) {
    XcdBarrier b; b.bar = bar; b.x = xb_xcc_id(); b.st = st;
    if (threadIdx.x == 0) (void)xb_add(&bar[XB_XCNT(b.x)], 1u);
    return b;
}
__device__ __forceinline__ void xcd_barrier_complete(unsigned* bar, unsigned x, unsigned& nloc, unsigned& nx) {
    const unsigned G = gridDim.x * gridDim.y * gridDim.z;
    unsigned sum, cnt, mine, sp = 0u;
    for (;;) {
        sum = 0u; cnt = 0u; mine = 0u;
#pragma unroll
        for (unsigned j = 0; j < 16; ++j) { const unsigned c = xb_ld(&bar[XB_XCNT(j)]); sum += c; cnt += (c > 0u) ? 1u : 0u; mine = (j == x) ? c : mine; }
        if (sum == G) break;
        __builtin_amdgcn_s_sleep(1);
        if ((++sp & 255u) == 0u) { if (xb_ld(&bar[XB_TMO])) break; if (sp > XB_SPIN_CAP) { atomicAdd(&bar[XB_TMO], 1u); break; } }
    }
    nloc = mine > 0u ? mine : 1u; nx = cnt > 0u ? cnt : 1u;
}
__device__ __forceinline__ void xcd_barrier(const XcdBarrier& b) {
    asm volatile("s_waitcnt vmcnt(0)" ::: "memory");
    __syncthreads();
    if (threadIdx.x == 0) {
        unsigned* bar = b.bar;
        __builtin_amdgcn_s_waitcnt(0);
        unsigned nloc = b.st[0], nx = b.st[1];
        if (nloc == 0u) { xcd_barrier_complete(bar, b.x, nloc, nx); b.st[0] = nloc; b.st[1] = nx; }
        const unsigned old = xb_add(&bar[XB_XSUB(b.x)], 1u);
        const unsigned gen = old / nloc;
        if (old + 1u == (gen + 1u) * nloc) {
            __builtin_amdgcn_fence(__ATOMIC_RELEASE, "agent");
            asm volatile("s_waitcnt vmcnt(0)" ::: "memory");
            const unsigned og = xb_add(&bar[XB_TOP], 1u);
            const unsigned tg = og / nx;
            if (og + 1u == (tg + 1u) * nx) xb_add(&bar[XB_TOPGEN], 1u);
            else XB_SPIN(xb_ld(&bar[XB_TOPGEN]) == tg, bar);
            __builtin_amdgcn_fence(__ATOMIC_ACQUIRE, "agent");
            xb_add(&bar[XB_XGEN(b.x)], 1u);
            asm volatile("s_waitcnt vmcnt(0)" ::: "memory");
        } else {
            XB_SPIN(xb_ld(&bar[XB_XGEN(b.x)]) == gen, bar);
            __builtin_amdgcn_fence(__ATOMIC_ACQUIRE, "agent");
            asm volatile("s_waitcnt vmcnt(0)" ::: "memory");
        }
    }
    __syncthreads();
}

struct Args {
    const float* in[23];
    float* out; unsigned char* ws;
    int ph_lo, ph_hi;
    int use_bar, pad;
};
struct Frame {
    LAS unsigned char* lds;
    int tid, lane, wave, G, bid;
    unsigned char* ws;
    const float* const* in;
    float* out;
};
enum { I_X = 0, I_C, I_CTX, I_CCTX, I_MODW, I_MODB, I_NORMG, I_MWIN, I_MBGATE, I_MWCONV, I_MGHEAD, I_MWOUT, I_HWIN, I_HBF, I_HLB, I_HGHEAD, I_HWOUT, I_FWGU, I_FWDOWN, I_EWR, I_EBR, I_EWGU, I_EWDOWN };

__device__ __forceinline__ void phase_mods(Frame& F) {
    LAS float* SV = (LAS float*)(F.lds);
    LAS float* RED = (LAS float*)(F.lds + 9 * 1024 * 4);
    const float* cvec = F.in[I_C]; const float* cctx = F.in[I_CCTX];
    for (int i = F.tid; i < 9 * 1024; i += NTHR) { const int b = i >> 10, k = i & 1023; const float v = b < 8 ? cvec[b * 1024 + k] : cctx[k]; SV[i] = siluf_(v); }
    __syncthreads();
    const float* modw = F.in[I_MODW]; const float* modb = F.in[I_MODB]; const float* normg = F.in[I_NORMG];
    float* modv = (float*)(F.ws + WS_MODV);
    for (int item = F.bid; item < 4 * 96; item += F.G) {
        const int L = item / 96, n0 = (item % 96) * 64;
        const float* wp = modw + (size_t)L * 1024 * 6144 + n0 + F.lane;
        float acc[9];
#pragma unroll
        for (int b = 0; b < 9; ++b) acc[b] = 0.f;
        const int k0 = F.wave * 128;
#pragma unroll 4
        for (int k = 0; k < 128; ++k) { const float wv = wp[(size_t)(k0 + k) * 6144];
#pragma unroll
            for (int b = 0; b < 9; ++b) acc[b] += SV[b * 1024 + k0 + k] * wv; }
#pragma unroll
        for (int b = 0; b < 9; ++b) RED[(F.wave * 9 + b) * 64 + F.lane] = acc[b];
        __syncthreads();
        for (int o = F.tid; o < 9 * 64; o += NTHR) { const int b = o >> 6, l = o & 63; float v = 0.f;
#pragma unroll
            for (int w = 0; w < 8; ++w) v += RED[(w * 9 + b) * 64 + l];
            const int n = n0 + l, s = n >> 10, c = n & 1023; v += modb[L * 6144 + n];
            const float* g = normg + (size_t)L * 4 * 1024;
            int slot; float r;
            if (s == 0) { slot = 1; r = v; } else if (s == 1) { slot = 0; r = g[c] * (1.f + v); } else if (s == 2) { slot = 2; r = v * g[1024 + c]; }
            else if (s == 3) { slot = 4; r = v; } else if (s == 4) { slot = 3; r = g[2048 + c] * (1.f + v); } else { slot = 5; r = v * g[3072 + c]; }
            modv[((size_t)(L * 9 + b) * 6 + slot) * 1024 + c] = r; }
        __syncthreads();
    }
}

__device__ __forceinline__ void wconv_item(const float* W, int K, int N, bf16* WT, int gu_mode, LAS float* scr, int item, int lane) {
    const int nblk = N / 32, kb = item / nblk, nb = item % nblk, k0 = 64 * kb, n0 = 32 * nb;
    int row0 = n0;
    if (gu_mode) { const int half = n0 / FF, nn = n0 - half * FF; row0 = 256 * (nn >> 7) + 128 * half + (nn & 127); }
#pragma unroll 8
    for (int i = 0; i < 32; ++i) { const int kk = 2 * i + (lane >> 5); scr[kk * 33 + (lane & 31)] = W[(size_t)(k0 + kk) * N + n0 + (lane & 31)]; }
    LDS_WAIT(); CFENCE();
    const int c = lane & 7;
#pragma unroll
    for (int j = 0; j < 4; ++j) { const int n = (lane >> 3) + 8 * j; const LAS float* s = scr + (8 * c) * 33 + n;
        v4u o; o.x = pk2(s[0 * 33], s[1 * 33]); o.y = pk2(s[2 * 33], s[3 * 33]); o.z = pk2(s[4 * 33], s[5 * 33]); o.w = pk2(s[6 * 33], s[7 * 33]);
        *(GAS v4u*)(WT + (size_t)(row0 + n) * K + k0 + 8 * c) = o; }
    LDS_WAIT(); CFENCE();
}
__device__ __forceinline__ void phase_wconv(Frame& F, int L) {
    LAS float* scr = (LAS float*)(F.lds + F.wave * 16384);
    const int gw = F.bid * NWAVES + F.wave, NGW = F.G * NWAVES; const int j = L >> 1;
    if ((L & 1) == 0) {
        unsigned char* wb = F.ws + WS_WE;
        const float* w_in = F.in[I_MWIN] + (size_t)j * D * NW_M; const float* w_out = F.in[I_MWOUT] + (size_t)j * D * D;
        const float* w_gu = F.in[I_FWGU] + (size_t)j * D * NGU; const float* w_dn = F.in[I_FWDOWN] + (size_t)j * FF * D;
        constexpr int I0 = 16 * (NW_M / 32), I1 = 16 * 32, I2 = 16 * (NGU / 32), I3 = (FF / 64) * 32;
        for (int it = gw; it < I0 + I1 + I2 + I3; it += NGW) { int r = it;
            if (r < I0) { wconv_item(w_in, D, NW_M, (bf16*)(wb + WE_IN), 0, scr, r, F.lane); continue; } r -= I0;
            if (r < I1) { wconv_item(w_out, D, D, (bf16*)(wb + WE_OUT), 0, scr, r, F.lane); continue; } r -= I1;
            if (r < I2) { wconv_item(w_gu, D, NGU, (bf16*)(wb + WE_GU), 1, scr, r, F.lane); continue; } r -= I2;
            wconv_item(w_dn, FF, D, (bf16*)(wb + WE_DOWN), 0, scr, r, F.lane); }
        GAS v4u* z = (GAS v4u*)(wb + WE_IN + (size_t)NW_M * D * 2); const int nz = (NIN_M - NW_M) * D * 2 / 16;
        for (int i = F.bid * NTHR + F.tid; i < nz; i += F.G * NTHR) z[i] = (v4u){0u, 0u, 0u, 0u};
    } else {
        unsigned char* wb = F.ws + WS_WO;
        const float* w_in = F.in[I_HWIN] + (size_t)j * D * NP_H; const float* w_out = F.in[I_HWOUT] + (size_t)j * D * D;
        const float* w_gu = F.in[I_EWGU] + (size_t)j * NEXP * D * NGU; const float* w_dn = F.in[I_EWDOWN] + (size_t)j * NEXP * FF * D;
        constexpr int I0 = 16 * (NP_H / 32), I1 = 16 * 32, I2 = 16 * (NGU / 32), I3 = (FF / 64) * 32;
        for (int it = gw; it < I0 + I1 + NEXP * (I2 + I3); it += NGW) { int r = it;
            if (r < I0) { wconv_item(w_in, D, NP_H, (bf16*)(wb + WOD_IN), 0, scr, r, F.lane); continue; } r -= I0;
            if (r < I1) { wconv_item(w_out, D, D, (bf16*)(wb + WOD_OUT), 0, scr, r, F.lane); continue; } r -= I1;
            const int e = r / (I2 + I3); r -= e * (I2 + I3);
            if (r < I2) { wconv_item(w_gu + (size_t)e * D * NGU, D, NGU, (bf16*)(wb + WOD_GU + e * EGU_BYTES), 1, scr, r, F.lane); continue; } r -= I2;
            wconv_item(w_dn + (size_t)e * FF * D, FF, D, (bf16*)(wb + WOD_DOWN + e * EDOWN_BYTES), 0, scr, r, F.lane); }
    }
}

struct TokCfg {
    const float* lat_src_l; const float* lat_src_c;
    float* lat_dst_l; float* lat_dst_c;
    const bf16* y; int y_perm; int moe_combine;
    const float* vupd;
    const float* vna; const float* vnb;
    bf16* u; int u_perm;
    int route; int jr;
    int nrows;
};
__device__ __forceinline__ int perm_cm(int t) { return (t & 63) * ROWS_G + (t >> 6); }

__device__ __forceinline__ void phase_tok(Frame& F, const TokCfg& T) {
    const int gw = F.bid * NWAVES + F.wave, NGW = F.G * NWAVES;
    const int R = (T.nrows + NGW - 1) / NGW; const int r0 = gw * R; int r1 = r0 + R; if (r1 > T.nrows) r1 = T.nrows;
    LAS float* WR = (LAS float*)F.lds;
    if (T.route) { const float* wr = F.in[I_EWR] + (size_t)T.jr * 1024 * 8; for (int i = F.tid; i < 8192; i += NTHR) WR[i] = wr[i]; }
    __syncthreads();
    f32x4 VU[4], VA[4], VB[4]; int curb = -1;
    int my_e0 = 0, my_e1 = 0; float my_w = 0.f;
    for (int row = r0; row < r1; ++row) {
        const int b = row < M_LAT ? (row >> 13) : 8;
        if (b != curb) { curb = b;
#pragma unroll
            for (int j = 0; j < 4; ++j) {
                if (T.y) VU[j] = ((const f32x4*)(T.vupd + (size_t)b * 6144))[F.lane + 64 * j];
                if (T.vna) { VA[j] = ((const f32x4*)(T.vna + (size_t)b * 6144))[F.lane + 64 * j]; VB[j] = ((const f32x4*)(T.vnb + (size_t)b * 6144))[F.lane + 64 * j]; } } }
        const float* lp = row < M_LAT ? T.lat_src_l + (size_t)row * D : T.lat_src_c + (size_t)(row - M_LAT) * D;
        f32x4 v[4];
#pragma unroll
        for (int j = 0; j < 4; ++j) v[j] = ((const f32x4*)lp)[F.lane + 64 * j];
        if (T.y) {
            f32x4 yv[4];
            if (T.moe_combine) {
                const int* rr = (const int*)(F.ws + WS_ROUTE + RT_R); const float w0 = ((const float*)(F.ws + WS_ROUTE + RT_W))[row], w1 = 1.f - w0;
                const int p0 = rr[2 * row], p1 = rr[2 * row + 1];
                const v2u* ya = (const v2u*)(T.y + (size_t)p0 * D); const v2u* yb = (const v2u*)(T.y + (size_t)p1 * D);
#pragma unroll
                for (int j = 0; j < 4; ++j) { const v2u a = ya[F.lane + 64 * j], c = yb[F.lane + 64 * j];
                    yv[j] = (f32x4){w0 * bflo(a.x) + w1 * bflo(c.x), w0 * bfhi(a.x) + w1 * bfhi(c.x), w0 * bflo(a.y) + w1 * bflo(c.y), w0 * bfhi(a.y) + w1 * bfhi(c.y)}; }
            } else {
                int yr = row; if (T.y_perm && row < M_LAT) yr = (row & ~8191) + perm_cm(row & 8191);
                const v2u* yp = (const v2u*)(T.y + (size_t)yr * D);
#pragma unroll
                for (int j = 0; j < 4; ++j) { const v2u a = yp[F.lane + 64 * j]; yv[j] = (f32x4){bflo(a.x), bfhi(a.x), bflo(a.y), bfhi(a.y)}; }
            }
            float ss = 0.f;
#pragma unroll
            for (int j = 0; j < 4; ++j) ss += (yv[j].x * yv[j].x + yv[j].y * yv[j].y) + (yv[j].z * yv[j].z + yv[j].w * yv[j].w);
            const float rs = rsqrtf(wave_sum(ss) * (1.f / D) + EPS);
#pragma unroll
            for (int j = 0; j < 4; ++j) v[j] = v[j] + VU[j] * (yv[j] * rs);
        }
        float* dp = row < M_LAT ? (T.lat_dst_l ? T.lat_dst_l + (size_t)row * D : nullptr) : (T.lat_dst_c ? T.lat_dst_c + (size_t)(row - M_LAT) * D : nullptr);
        if (dp) {
#pragma unroll
            for (int j = 0; j < 4; ++j) ((f32x4*)dp)[F.lane + 64 * j] = v[j];
        }
        if (T.vna) {
            float ss = 0.f;
#pragma unroll
            for (int j = 0; j < 4; ++j) ss += (v[j].x * v[j].x + v[j].y * v[j].y) + (v[j].z * v[j].z + v[j].w * v[j].w);
            const float rs = rsqrtf(wave_sum(ss) * (1.f / D) + EPS);
            f32x4 uu[4];
#pragma unroll
            for (int j = 0; j < 4; ++j) uu[j] = (v[j] * rs) * VA[j] + VB[j];
            int ur = row; if (T.u_perm && row < M_LAT) ur = (row & ~8191) + perm_cm(row & 8191);
            v2u* up = (v2u*)(T.u + (size_t)ur * D);
#pragma unroll
            for (int j = 0; j < 4; ++j) { v2u o; o.x = pk2(uu[j].x, uu[j].y); o.y = pk2(uu[j].z, uu[j].w); up[F.lane + 64 * j] = o; }
            if (T.route) {
                float lg[8];
#pragma unroll
                for (int e = 0; e < 8; ++e) lg[e] = 0.f;
#pragma unroll
                for (int j = 0; j < 4; ++j)
#pragma unroll
                    for (int i = 0; i < 4; ++i) { const int c = 4 * (F.lane + 64 * j) + i; const f32x4 wa = *(const LAS f32x4*)(WR + c * 8), wb = *(const LAS f32x4*)(WR + c * 8 + 4); const float x = uu[j][i];
                        lg[0] += x * wa.x; lg[1] += x * wa.y; lg[2] += x * wa.z; lg[3] += x * wa.w; lg[4] += x * wb.x; lg[5] += x * wb.y; lg[6] += x * wb.z; lg[7] += x * wb.w; }
                const float* br = F.in[I_EBR] + T.jr * 8;
#pragma unroll
                for (int e = 0; e < 8; ++e) lg[e] = wave_sum(lg[e]) + br[e];
                int e0 = 0; float v0 = lg[0];
#pragma unroll
                for (int e = 1; e < 8; ++e) if (lg[e] > v0) { v0 = lg[e]; e0 = e; }
                int e1 = -1; float v1 = -3.0e38f;
#pragma unroll
                for (int e = 0; e < 8; ++e) if (e != e0 && lg[e] > v1) { v1 = lg[e]; e1 = e; }
                const float w0 = 1.f / (1.f + __expf(v1 - v0));
                if (F.lane == row - r0) { my_e0 = e0; my_e1 = e1; my_w = w0; }
            }
        }
    }
    if (T.route) {
        const int n = r1 - r0; const bool act = F.lane < n; const int row = r0 + F.lane;
        unsigned* ecnt = (unsigned*)(F.ws + WS_CTL) + CW_ECNT + T.jr * 8 * 64;
        int rk0 = 0, rk1 = 0;
        const unsigned long long ltmask = (F.lane == 0) ? 0ull : (~0ull >> (64 - F.lane));
#pragma unroll
        for (int e = 0; e < 8; ++e) {
            const unsigned long long m0 = __ballot(act && my_e0 == e), m1 = __ballot(act && my_e1 == e);
            const int c0 = __popcll(m0), c1 = __popcll(m1);
            unsigned base = 0;
            if (c0 + c1 > 0) { if (F.lane == 0) base = __hip_atomic_fetch_add(ecnt + e * 64, (unsigned)(c0 + c1), RLX_AGENT); base = __builtin_amdgcn_readfirstlane(base); }
            if (my_e0 == e) rk0 = (int)base + __popcll(m0 & ltmask);
            if (my_e1 == e) rk1 = (int)base + c0 + __popcll(m1 & ltmask);
        }
        if (act) { ((int*)(F.ws + WS_ROUTE + RT_E))[row] = my_e0 | (my_e1 << 8); ((int*)(F.ws + WS_ROUTE + RT_R))[2 * row] = rk0; ((int*)(F.ws + WS_ROUTE + RT_R))[2 * row + 1] = rk1;
            ((float*)(F.ws + WS_ROUTE + RT_W))[row] = my_w; }
    }
}

__device__ __forceinline__ void phase_moe_scatter(Frame& F, int jr, int nrows, const bf16* U, bf16* AM) {
    const unsigned* ecnt = (const unsigned*)(F.ws + WS_CTL) + CW_ECNT + jr * 8 * 64;
    int base[8]; int acc = 0;
#pragma unroll
    for (int e = 0; e < 8; ++e) { const int c = (int)__hip_atomic_load(ecnt + e * 64, RLX_AGENT); base[e] = acc; acc += (c + 255) & ~255; }
    int* pexp = (int*)(F.ws + WS_SMALL + SM_PEXP);
    if (F.bid == 0) { const int np = acc >> 8;
        for (int p = F.tid; p < np; p += NTHR) { int e = 0;
#pragma unroll
            for (int q = 1; q < 8; ++q) if (p * 256 >= base[q]) e = q;
            pexp[p] = e; }
        if (F.tid == 0) pexp[MOE_PANELS] = np; }
    const int gw = F.bid * NWAVES + F.wave, NGW = F.G * NWAVES;
    const int R = (nrows + NGW - 1) / NGW; const int r0 = gw * R; int r1 = r0 + R; if (r1 > nrows) r1 = nrows;
    int* rr = (int*)(F.ws + WS_ROUTE + RT_R); const int* re = (const int*)(F.ws + WS_ROUTE + RT_E);
    for (int row = r0; row < r1; ++row) {
        const int ee = re[row], e0 = ee & 255, e1 = ee >> 8; int b0 = 0, b1 = 0;
#pragma unroll
        for (int e = 0; e < 8; ++e) { if (e0 == e) b0 = base[e]; if (e1 == e) b1 = base[e]; }
        const int p0 = b0 + rr[2 * row], p1 = b1 + rr[2 * row + 1];
        const v4u* src = (const v4u*)(U + (size_t)row * D); v4u a = src[F.lane], c = src[F.lane + 64];
        v4u* d0 = (v4u*)(AM + (size_t)p0 * D); v4u* d1 = (v4u*)(AM + (size_t)p1 * D);
        d0[F.lane] = a; d0[F.lane + 64] = c; d1[F.lane] = a; d1[F.lane + 64] = c;
        CFENCE();
        if (F.lane == 0) { rr[2 * row] = p0; rr[2 * row + 1] = p1; }
    }
}

#define MFMA32(a, b, c) __builtin_amdgcn_mfma_f32_32x32x16_bf16((a), (b), (c), 0, 0, 0)
typedef short v4i16_t __attribute__((ext_vector_type(4)));
typedef LAS unsigned char* ldsp;
__device__ __forceinline__ unsigned cvtpk(float lo, float hi) { f32x2_t v = {lo, hi}; bf16x2_t b = __builtin_convertvector(v, bf16x2_t); return __builtin_bit_cast(unsigned, b); }
__device__ __forceinline__ int crow(int reg, int h) { return (reg & 3) + 8 * (reg >> 2) + 4 * h; }
__device__ __forceinline__ bf16x8 pack8(const f32x16& x, int s) {
    v4u p; p.x = cvtpk(x[8 * s], x[8 * s + 1]); p.y = cvtpk(x[8 * s + 2], x[8 * s + 3]); p.z = cvtpk(x[8 * s + 4], x[8 * s + 5]); p.w = cvtpk(x[8 * s + 6], x[8 * s + 7]);
    return __builtin_bit_cast(bf16x8, p);
}
__device__ __forceinline__ bf16x8 lds16(ldsp p) { return *(const LAS bf16x8*)p; }
__device__ __forceinline__ bf16x8 lds8x2(ldsp p) { const s16x4 lo = *(const LAS s16x4*)p, hi = *(const LAS s16x4*)(p + 16); return __builtin_shufflevector(lo, hi, 0, 1, 2, 3, 4, 5, 6, 7); }
__device__ __forceinline__ s16x4 tr16(ldsp p) { return __builtin_bit_cast(s16x4, __builtin_amdgcn_ds_read_tr16_b64_v4i16((LAS v4i16_t*)p)); }
__device__ __forceinline__ bf16x8 ldstr2(ldsp p, int second) { const s16x4 lo = tr16(p), hi = tr16(p + second); return __builtin_shufflevector(lo, hi, 0, 1, 2, 3, 4, 5, 6, 7); }
__device__ __forceinline__ f32x16 zero16() { f32x16 z;
#pragma unroll
    for (int i = 0; i < 16; ++i) z[i] = 0.f; return z; }
__device__ __forceinline__ void unpack8(const v4u& w, float (&x)[8]) { x[0] = bflo(w.x); x[1] = bfhi(w.x); x[2] = bflo(w.y); x[3] = bfhi(w.y); x[4] = bflo(w.z); x[5] = bfhi(w.z); x[6] = bflo(w.w); x[7] = bfhi(w.w); }
__device__ __forceinline__ int launder_v(int x) { asm volatile("" : "+v"(x)); return x; }
struct FragOff { int o_row, o_perm, o_trn, o_trp; };
__device__ __forceinline__ FragOff frag_off(int lane, int LD) {
    const int r = lane & 31, hh = lane >> 5, i16 = lane & 15, q = i16 >> 2, p = i16 & 3, blk = (lane >> 4) & 1; FragOff f;
    f.o_row = (r * LD + 8 * hh) * 2; f.o_perm = (r * LD + 4 * hh) * 2;
    f.o_trn = ((8 * hh + q) * LD + 16 * blk + 4 * p) * 2; f.o_trp = ((4 * hh + q) * LD + 16 * blk + 4 * p) * 2; return f;
}


template <int CTRL, int RM, int BM> __device__ __forceinline__ float dpp_f(float old, float x) {
    return __builtin_bit_cast(float, __builtin_amdgcn_update_dpp(__builtin_bit_cast(int, old), __builtin_bit_cast(int, x), CTRL, RM, BM, false)); }
__device__ __forceinline__ float wave_scan_add(float x) {
    float r = x;
    r += dpp_f<0x111, 0xf, 0xf>(0.f, x); r += dpp_f<0x112, 0xf, 0xf>(0.f, x); r += dpp_f<0x113, 0xf, 0xf>(0.f, x);
    r += dpp_f<0x114, 0xf, 0xe>(0.f, r); r += dpp_f<0x118, 0xf, 0xc>(0.f, r);
    r += dpp_f<0x142, 0xa, 0xf>(0.f, r); r += dpp_f<0x143, 0xc, 0xf>(0.f, r);
    return r;
}
__device__ __forceinline__ float wave_scan_max(float x) {
    const float NEG = -3.0e38f; float r = x;
    r = fmaxf(r, dpp_f<0x111, 0xf, 0xf>(NEG, x)); r = fmaxf(r, dpp_f<0x112, 0xf, 0xf>(NEG, x)); r = fmaxf(r, dpp_f<0x113, 0xf, 0xf>(NEG, x));
    r = fmaxf(r, dpp_f<0x114, 0xf, 0xe>(NEG, r)); r = fmaxf(r, dpp_f<0x118, 0xf, 0xc>(NEG, r));
    r = fmaxf(r, dpp_f<0x142, 0xa, 0xf>(NEG, r)); r = fmaxf(r, dpp_f<0x143, 0xc, 0xf>(NEG, r));
    return r;
}
__device__ __forceinline__ float lane63(float x) { return __builtin_bit_cast(float, __builtin_amdgcn_readlane(__builtin_bit_cast(int, x), 63)); }
__device__ __forceinline__ float sum_halves(float x) {
    const unsigned u = __builtin_bit_cast(unsigned, x); auto rr = __builtin_amdgcn_permlane32_swap(u, u, false, false);
    return __builtin_bit_cast(float, (unsigned)rr[0]) + __builtin_bit_cast(float, (unsigned)rr[1]); }

constexpr int ML_LDQ = 72, ML_LDV = 136;
constexpr int ML_QC = 0, ML_KC = 9216, ML_KH = 18432, ML_V = 27648, ML_GS = 45056, ML_OB = 50176, ML_NV = 68608, ML_SSQ = 70656, ML_INV = 71680, ML_GROUP = 73728;
static_assert(2 * ML_GROUP <= LDS_MAIN, "mLSTM LDS map");
constexpr int ML_STATE_F = 8448;

struct MlPref { v4u q[2], k[2], v[4]; float gi, gf; };
struct MlSeg { int rowbase; int len; int t0; int nchunk; };

__device__ __forceinline__ void ml_issue(MlPref& P, const bf16* proj, const bf16* qkc, const float* gates, int rowbase, int t0c, int g, int h, int tg, int lane, bool need_q) {
    const int c8q = tg & 7;
#pragma unroll
    for (int i = 0; i < 2; ++i) { const int tau = (tg + 256 * i) >> 3; const int t = t0c + (g ? 63 - tau : tau);
        const bf16* rp = qkc + (size_t)(rowbase + t) * D + h * 64 + c8q * 8;
        P.q[i] = need_q ? *(const GAS v4u*)rp : (v4u){0u, 0u, 0u, 0u}; P.k[i] = *(const GAS v4u*)(rp + 512); }
#pragma unroll
    for (int i = 0; i < 4; ++i) { const int p = tg + 256 * i, tau = p >> 4, c8 = p & 15; const int t = t0c + (g ? 63 - tau : tau);
        P.v[i] = *(const GAS v4u*)(proj + (size_t)(rowbase + t) * NP_M + 1024 + h * 128 + c8 * 8); }
    { const int t = t0c + (g ? 63 - lane : lane); const GAS float* gp = (const GAS float*)(gates + (size_t)(rowbase + t) * 32 + g * 16 + h); P.gi = gp[0]; P.gf = gp[8]; }
}

template <bool OUTPUT>
__device__ __forceinline__ void mlstm_item(Frame& F, const bf16* proj, const bf16* qkc, const float* gates, bf16* hx0, bf16* hx1,
                                           int h, MlSeg S0, MlSeg S1, const float* st_in0, const float* st_in1, int npre0, int npre1, float* st_out0, float* st_out1) {
    const int tid_l = launder_v(F.tid); const int wave_l = __builtin_amdgcn_readfirstlane(tid_l >> 6);
    const int g = wave_l >> 2, j = wave_l & 3, tg = tid_l & 255, lane = tid_l & 63, r = lane & 31, hh = lane >> 5;
    const ldsp gb = F.lds + g * ML_GROUP;
    const ldsp GSb = gb + ML_GS + j * 1280;
    LAS float* GS = (LAS float*)GSb;
    const ldsp OBb = gb + ML_OB + j * 4608;
    LAS float* NV = (LAS float*)(gb + ML_NV);
    LAS float* SSQ = (LAS float*)(gb + ML_SSQ);
    const ldsp INVb = gb + ML_INV + j * 256;
    const int rowbase = g ? S1.rowbase : S0.rowbase, seg_t0 = g ? S1.t0 : S0.t0, nch = g ? S1.nchunk : S0.nchunk;
    const int vcol = 64 * j;
    __syncthreads();
    f32x16 C[2]; C[0] = zero16(); C[1] = zero16();
    float m_prev = -1.0e30f, btot = 0.f;
    float nreg = 0.f;
    if (OUTPUT) {
        const float* sp = g ? st_in1 : st_in0; const int np = g ? npre1 : npre0;
#pragma unroll 1
        for (int k = 0; k < np; ++k) { const float* e = sp + (size_t)k * ML_STATE_F;
            const float mloc = e[8192 + 64], B = e[8192 + 65];
            const float mnew = fmaxf(B + m_prev, mloc), al = __expf(B + m_prev - mnew), be = __expf(mloc - mnew);
            const float* ep = e + (4 * hh) * 128 + 32 * j + r;
#pragma unroll
            for (int dt = 0; dt < 2; ++dt)
#pragma unroll
                for (int i = 0; i < 16; ++i) C[dt][i] = al * C[dt][i] + be * ep[(32 * dt + (i & 3) + 8 * (i >> 2)) * 128];
            nreg = al * nreg + be * e[8192 + 16 * j + (lane & 15)];
            m_prev = mnew; }
    }
    if (lane < 16) NV[16 * j + lane] = nreg;
    MlPref PP[2]; ml_issue(PP[0], proj, qkc, gates, rowbase, seg_t0 + 64 * (g ? nch - 1 : 0), g, h, tg, lane, OUTPUT);
    ml_issue(PP[1], proj, qkc, gates, rowbase, seg_t0 + 64 * (g ? nch - 2 : 1), g, h, tg, lane, OUTPUT);
    __syncthreads();
#pragma unroll 1
    for (int step2 = 0; step2 < nch; step2 += 2) {
#pragma unroll
    for (int hf = 0; hf < 2; ++hf) { const int step = step2 + hf; MlPref& P = PP[hf];
        const int tgs = launder_v(tg), lns = launder_v(lane);
        const int r = lns & 31, hh = lns >> 5;
        const FragOff fq = frag_off(lns, ML_LDQ), fv = frag_off(lns, ML_LDV);
        const int o_h4 = 16 * hh;
        const int o_obw = (4 * hh * 36 + r) * 4, o_obr = ((lns >> 1) * 36 + 16 * (lns & 1)) * 4;
        const int ci = g ? nch - 1 - step : step;
        const int par = step & 1;
        float decay;
        {
            const float xi = P.gi, lf = P.gf;
            const float bc = wave_scan_add(lf);
            const float a = xi - bc; const float pm = wave_scan_max(a);
            const float Mt = fmaxf(m_prev, pm);
            const float Ml = lane63(Mt), bl = lane63(bc);
            GS[lns] = a; GS[64 + lns] = Mt; GS[128 + lns] = __expf(m_prev - Mt); GS[192 + lns] = __expf(-(bc + Mt)); GS[256 + lns] = __expf(a - Ml);
            decay = __expf(m_prev - Ml); m_prev = bl + Ml; btot += bl;
        }
        LDS_WAIT(); CFENCE();
        {
            const int c8 = tgs & 7;
#pragma unroll
            for (int i = 0; i < 2; ++i) { const int tau = (tgs + 256 * i) >> 3; const ldsp tp = gb + (tau * ML_LDQ + c8 * 8) * 2;
                if (OUTPUT) { *(LAS v4u*)(tp + ML_QC) = P.q[i]; *(LAS v4u*)(tp + ML_KC) = P.k[i]; }
                float o[8]; unpack8(P.k[i], o); const float wkk = GS[256 + tau]; v4u w;
                w.x = pk2(o[0] * wkk, o[1] * wkk); w.y = pk2(o[2] * wkk, o[3] * wkk); w.z = pk2(o[4] * wkk, o[5] * wkk); w.w = pk2(o[6] * wkk, o[7] * wkk);
                *(LAS v4u*)(tp + ML_KH) = w; }
#pragma unroll
            for (int i = 0; i < 4; ++i) { const int p = tgs + 256 * i, tau = p >> 4, cc = p & 15; *(LAS v4u*)(gb + ML_V + (tau * ML_LDV + cc * 8) * 2) = P.v[i]; }
        }
        if (step + 2 < nch) ml_issue(P, proj, qkc, gates, rowbase, seg_t0 + 64 * (g ? nch - 3 - step : step + 2), g, h, tgs, lns, OUTPUT);
        __syncthreads();
        if (OUTPUT) {
            bf16* hx = g ? hx1 : hx0;
#pragma unroll
            for (int tt = 0; tt < 2; ++tt) {
                f32x16 acc = zero16();
#pragma unroll
                for (int dt = 0; dt < 2; ++dt)
#pragma unroll
                    for (int sp = 0; sp < 2; ++sp) acc = MFMA32(lds8x2(gb + ML_QC + fq.o_perm + (32 * tt * ML_LDQ + 32 * dt + 16 * sp) * 2), pack8(C[dt], sp), acc);
#pragma unroll
                for (int q4 = 0; q4 < 4; ++q4) { const f32x4 wv = *(const LAS f32x4*)(GSb + o_h4 + (128 + 32 * tt + 8 * q4) * 4);
#pragma unroll
                    for (int e = 0; e < 4; ++e) acc[4 * q4 + e] *= wv[e]; }
                const float Mt = GS[64 + 32 * tt + r];
                float den = 0.f;
#pragma unroll
                for (int st = 0; st <= tt; ++st) {
                    f32x16 s = zero16();
#pragma unroll
                    for (int ks = 0; ks < 4; ++ks) s = MFMA32(lds16(gb + ML_KC + fq.o_row + (32 * st * ML_LDQ + 16 * ks) * 2), lds16(gb + ML_QC + fq.o_row + (32 * tt * ML_LDQ + 16 * ks) * 2), s);
#pragma unroll
                    for (int q4 = 0; q4 < 4; ++q4) { const f32x4 av = *(const LAS f32x4*)(GSb + o_h4 + (32 * st + 8 * q4) * 4);
#pragma unroll
                        for (int e = 0; e < 4; ++e) { const int i = 4 * q4 + e; const int srow = 32 * st + crow(i, hh); const float pv = (srow <= 32 * tt + r) ? s[i] * __expf(av[e] - Mt) : 0.f; s[i] = pv; den += pv; } }
                    const bf16x8 pa0 = pack8(s, 0), pa1 = pack8(s, 1);
                    acc = MFMA32(pa0, ldstr2(gb + ML_V + fv.o_trp + vcol + ((32 * st) * ML_LDV) * 2, 8 * ML_LDV * 2), acc);
                    acc = MFMA32(pa1, ldstr2(gb + ML_V + fv.o_trp + vcol + ((32 * st + 16) * ML_LDV) * 2, 8 * ML_LDV * 2), acc);
                    }
                float qn;
                { float q0 = 0.f, q1 = 0.f, q2 = 0.f, q3 = 0.f;
#pragma unroll
                for (int c4 = 0; c4 < 4; ++c4) { const v4u qw = *(const LAS v4u*)(gb + ML_QC + (r * ML_LDQ + 32 * hh) * 2 + (32 * tt * ML_LDQ + 8 * c4) * 2); float qx[8]; unpack8(qw, qx);
                    const f32x4 n0 = *(const LAS f32x4*)(gb + ML_NV + 8 * o_h4 + (par * 64 + 8 * c4) * 4), n1 = *(const LAS f32x4*)(gb + ML_NV + 8 * o_h4 + (par * 64 + 8 * c4 + 4) * 4);
                    q0 += qx[0] * n0[0] + qx[4] * n1[0]; q1 += qx[1] * n0[1] + qx[5] * n1[1]; q2 += qx[2] * n0[2] + qx[6] * n1[2]; q3 += qx[3] * n0[3] + qx[7] * n1[3]; }
                qn = (q0 + q1) + (q2 + q3); }
                den = sum_halves(den); qn = sum_halves(qn);
                const float dtot = den + GS[128 + 32 * tt + r] * qn;
                const float inv = __builtin_amdgcn_rcpf(fmaxf(fabsf(dtot), GS[192 + 32 * tt + r]));
                if (hh == 0) *(LAS float*)(INVb + (32 * tt + r) * 4) = inv;
                LDS_WAIT(); CFENCE();
                f32x16 hv;
#pragma unroll
                for (int q4 = 0; q4 < 4; ++q4) { const f32x4 iv = *(const LAS f32x4*)(INVb + o_h4 + (32 * tt + 8 * q4) * 4);
#pragma unroll
                    for (int e = 0; e < 4; ++e) { const int i = 4 * q4 + e; hv[i] = acc[i] * iv[e]; } }
#pragma unroll
                for (int i = 0; i < 16; ++i) *(LAS float*)(OBb + o_obw + ((i & 3) + 8 * (i >> 2)) * 144) = hv[i];
                LDS_WAIT(); CFENCE();
                { const f32x4 x0 = *(const LAS f32x4*)(OBb + o_obr), x1 = *(const LAS f32x4*)(OBb + o_obr + 16), x2 = *(const LAS f32x4*)(OBb + o_obr + 32), x3 = *(const LAS f32x4*)(OBb + o_obr + 48);
                    const int tau = 32 * tt + (lns >> 1); const int t = seg_t0 + 64 * ci + (g ? 63 - tau : tau);
                    bf16* op = hx + (size_t)(rowbase + t) * D + h * 128 + 32 * j + 16 * (lns & 1);
                    v4u w0, w1; w0.x = pk2(x0[0], x0[1]); w0.y = pk2(x0[2], x0[3]); w0.z = pk2(x1[0], x1[1]); w0.w = pk2(x1[2], x1[3]); w1.x = pk2(x2[0], x2[1]); w1.y = pk2(x2[2], x2[3]); w1.z = pk2(x3[0], x3[1]); w1.w = pk2(x3[2], x3[3]);
                    *(GAS v4u*)op = w0; *(GAS v4u*)(op + 8) = w1; }
                LDS_WAIT(); CFENCE();
            }
        }
        __builtin_amdgcn_sched_barrier(0);
#pragma unroll
        for (int dt = 0; dt < 2; ++dt) {
#pragma unroll
            for (int i = 0; i < 16; ++i) C[dt][i] *= decay;
#pragma unroll
            for (int ks = 0; ks < 4; ++ks) C[dt] = MFMA32(ldstr2(gb + ML_KH + fq.o_trn + (16 * ks * ML_LDQ + 32 * dt) * 2, 4 * ML_LDQ * 2), ldstr2(gb + ML_V + fv.o_trn + vcol + (16 * ks * ML_LDV) * 2, 4 * ML_LDV * 2), C[dt]);
        }
        {   const int dkl = 16 * j + (lns & 15), tq = lns >> 4; float s0 = 0.f, s1 = 0.f;
#pragma unroll
            for (int i = 0; i < 16; i += 2) { s0 += bf2f(*(const LAS bf16*)(gb + ML_KH + ((16 * tq + i) * ML_LDQ + dkl) * 2)); s1 += bf2f(*(const LAS bf16*)(gb + ML_KH + ((16 * tq + i + 1) * ML_LDQ + dkl) * 2)); }
            float sacc = s0 + s1; sacc += __shfl_xor(sacc, 16); sacc = sum_halves(sacc);
            nreg = decay * nreg + sacc; if (lns < 16) NV[(par ^ 1) * 64 + dkl] = nreg; }
        __syncthreads();
    } }
    if (!OUTPUT) {
        float* e = g ? st_out1 : st_out0; float* ep = e + (4 * hh) * 128 + 32 * j + r;
#pragma unroll
        for (int dt = 0; dt < 2; ++dt)
#pragma unroll
            for (int i = 0; i < 16; ++i) ep[(32 * dt + (i & 3) + 8 * (i >> 2)) * 128] = C[dt][i];
        if (lane < 16) e[8192 + 16 * j + lane] = nreg;
        if (j == 0 && lane == 0) { e[8192 + 64] = m_prev; e[8192 + 65] = btot; }
    }
}

constexpr int HG_LD = 136;
constexpr int HG_LF = 0, HG_QT = 16384, HG_KT = 25088, HG_KH = 33792, HG_V = 42496, HG_OB = 51200, HG_AUX = 69632, HG_SSQ = 71168, HG_EAM = 71680, HG_BIAS = 72192, HG_LBV = 72704, HG_GROUP = 73728;
static_assert(2 * HG_GROUP <= LDS_MAIN, "HGRN2 LDS map");
constexpr int HG_STATE_F = 16512;

struct HgPref { v4u q[2], f[2], v[2]; };
__device__ __forceinline__ void hg_issue(HgPref& P, const bf16* proj, int rowbase, int t0c, int g, int h, int tg, bool need_q) {
#pragma unroll
    for (int i = 0; i < 2; ++i) { const int p = tg + 256 * i, tau = p >> 4, c8 = p & 15; const int t = t0c + (g ? 31 - tau : tau);
        const bf16* rp = proj + (size_t)(rowbase + t) * NP_H + h * 128 + c8 * 8;
        P.q[i] = need_q ? *(const GAS v4u*)rp : (v4u){0u, 0u, 0u, 0u}; P.v[i] = *(const GAS v4u*)(rp + 1024); P.f[i] = *(const GAS v4u*)(rp + 2048 + 1024 * g); }
}
__device__ __forceinline__ float clamp80(float x) { return fminf(fmaxf(x, -80.f), 80.f); }

template <bool OUTPUT>
__device__ __forceinline__ void hgrn_item(Frame& F, const bf16* proj, bf16* hx0, bf16* hx1, const float* bf_, const float* lbraw, int jl,
                                          int h, MlSeg S0, MlSeg S1, const float* st_in0, const float* st_in1, int npre0, int npre1, float* st_out0, float* st_out1) {
    const int tid_l = launder_v(F.tid); const int wave_l = __builtin_amdgcn_readfirstlane(tid_l >> 6);
    const int g = wave_l >> 2, j = wave_l & 3, tg = tid_l & 255, lane = tid_l & 63, r = lane & 31, hh = lane >> 5;
    const ldsp gb = F.lds + g * HG_GROUP;
    LAS float* LF = (LAS float*)(gb + HG_LF);
    const ldsp OBb = gb + HG_OB + j * 4608;
    LAS float* AMID = (LAS float*)(gb + HG_AUX); LAS float* ALAST = AMID + 128; LAS float* DEC = AMID + 256;
    LAS float* SSQ = (LAS float*)(gb + HG_SSQ); LAS float* EAM = (LAS float*)(gb + HG_EAM); LAS float* BIASV = (LAS float*)(gb + HG_BIAS); LAS float* LBV = (LAS float*)(gb + HG_LBV);
    const int rowbase = g ? S1.rowbase : S0.rowbase, seg_t0 = g ? S1.t0 : S0.t0, nch = g ? S1.nchunk : S0.nchunk;
    const int vcol = 64 * j;
    __syncthreads();
    if (tg < 128) { const int c = h * 128 + tg; BIASV[tg] = bf_[g * 1024 + c]; LBV[tg] = jl == 0 ? 0.f : sigmoidf_(lbraw[(1 * 2 + g) * 1024 + c] - lbraw[(0 * 2 + g) * 1024 + c]); }
    f32x16 St[4];
#pragma unroll
    for (int dt = 0; dt < 4; ++dt) St[dt] = zero16();
    float atot = 0.f;
    if (OUTPUT) {   const float* sp = g ? st_in1 : st_in0; const int np = g ? npre1 : npre0;
#pragma unroll 1
        for (int k = 0; k < np; ++k) { const float* e = sp + (size_t)k * HG_STATE_F; const float* ep = e + (4 * hh) * 128 + 32 * j + r; const float* ap = e + 16384 + 4 * hh;
#pragma unroll
            for (int dt = 0; dt < 4; ++dt)
#pragma unroll
                for (int i = 0; i < 16; ++i) { const int dk0 = 32 * dt + (i & 3) + 8 * (i >> 2); St[dt][i] = __expf(ap[dk0]) * St[dt][i] + ep[dk0 * 128]; } }
    }
    HgPref PP[2]; hg_issue(PP[0], proj, rowbase, seg_t0 + 32 * (g ? nch - 1 : 0), g, h, tg, OUTPUT);
    hg_issue(PP[1], proj, rowbase, seg_t0 + 32 * (g ? nch - 2 : 1), g, h, tg, OUTPUT);
    __syncthreads();
#pragma unroll 1
    for (int step2 = 0; step2 < nch; step2 += 2) {
#pragma unroll
    for (int hf = 0; hf < 2; ++hf) { const int step = step2 + hf; HgPref& P = PP[hf];
        const int tgs = launder_v(tg), lns = launder_v(lane);
        const int r = lns & 31, hh = lns >> 5;
        const FragOff fo = frag_off(lns, HG_LD);
        const int o_h4 = 16 * hh;
        const int o_obw = (4 * hh * 36 + r) * 4, o_obr = ((lns >> 1) * 36 + 16 * (lns & 1)) * 4;
        const int c8 = tgs & 15;
        const int o_piece = (((tgs >> 4) * HG_LD) + c8 * 8) * 2;
        const int ci = g ? nch - 1 - step : step;
#pragma unroll
        for (int i = 0; i < 2; ++i) { const int tau = (tgs + 256 * i) >> 4; float x[8], lf[8], kk[8]; unpack8(P.f[i], x);
            const f32x4 b0 = *(const LAS f32x4*)(BIASV + c8 * 8), b1 = *(const LAS f32x4*)(BIASV + c8 * 8 + 4), l0 = *(const LAS f32x4*)(LBV + c8 * 8), l1 = *(const LAS f32x4*)(LBV + c8 * 8 + 4);
            const float bb[8] = {b0[0], b0[1], b0[2], b0[3], b1[0], b1[1], b1[2], b1[3]}, ll[8] = {l0[0], l0[1], l0[2], l0[3], l1[0], l1[1], l1[2], l1[3]};
#pragma unroll
            for (int e = 0; e < 8; ++e) { const float sg = sigmoidf_(x[e] + bb[e]); const float f = ll[e] + (1.f - ll[e]) * sg; lf[e] = __logf(fmaxf(f, 1e-37f)); kk[e] = 1.f - f; }
            *(LAS f32x4*)(LF + tau * 128 + c8 * 8) = (f32x4){lf[0], lf[1], lf[2], lf[3]}; *(LAS f32x4*)(LF + tau * 128 + c8 * 8 + 4) = (f32x4){lf[4], lf[5], lf[6], lf[7]};
            v4u w; w.x = pk2(kk[0], kk[1]); w.y = pk2(kk[2], kk[3]); w.z = pk2(kk[4], kk[5]); w.w = pk2(kk[6], kk[7]);
            const ldsp tp = gb + o_piece + i * (16 * HG_LD * 2);
            *(LAS v4u*)(tp + HG_KT) = w;
            if (OUTPUT) *(LAS v4u*)(tp + HG_QT) = P.q[i];
            *(LAS v4u*)(tp + HG_V) = P.v[i]; }
        if (step + 2 < nch) hg_issue(P, proj, rowbase, seg_t0 + 32 * (g ? nch - 3 - step : step + 2), g, h, tgs, OUTPUT);
        __syncthreads();
        {   const int dkc = tgs & 127, half = tgs >> 7; float pre = 0.f;
            if (half) { float p0 = 0.f, p1 = 0.f, p2 = 0.f, p3 = 0.f;
#pragma unroll
                for (int tau = 0; tau < 16; tau += 4) { p0 += LF[tau * 128 + dkc]; p1 += LF[(tau + 1) * 128 + dkc]; p2 += LF[(tau + 2) * 128 + dkc]; p3 += LF[(tau + 3) * 128 + dkc]; }
                pre = (p0 + p1) + (p2 + p3); }
            float v[16];
#pragma unroll
            for (int i = 0; i < 16; ++i) v[i] = LF[(16 * half + i) * 128 + dkc];
            LDS_WAIT(); __builtin_amdgcn_s_barrier(); CFENCE();
            float run = pre;
#pragma unroll
            for (int i = 0; i < 16; ++i) { run += v[i]; LF[(16 * half + i) * 128 + dkc] = run; }
            if (!half) { AMID[dkc] = run; EAM[dkc] = __expf(run); } else { ALAST[dkc] = run; DEC[dkc] = __expf(run); atot += run; } }
        __syncthreads();
#pragma unroll
        for (int i = 0; i < 2; ++i) { const int tau = (tgs + 256 * i) >> 4; const ldsp tp = gb + o_piece + i * (16 * HG_LD * 2);
            const f32x4 a0 = *(const LAS f32x4*)(LF + tau * 128 + c8 * 8), a1 = *(const LAS f32x4*)(LF + tau * 128 + c8 * 8 + 4);
            const f32x4 m0 = *(const LAS f32x4*)(AMID + c8 * 8), m1 = *(const LAS f32x4*)(AMID + c8 * 8 + 4), l0 = *(const LAS f32x4*)(ALAST + c8 * 8), l1 = *(const LAS f32x4*)(ALAST + c8 * 8 + 4);
            float a[8] = {a0[0], a0[1], a0[2], a0[3], a1[0], a1[1], a1[2], a1[3]}, am[8] = {m0[0], m0[1], m0[2], m0[3], m1[0], m1[1], m1[2], m1[3]}, al[8] = {l0[0], l0[1], l0[2], l0[3], l1[0], l1[1], l1[2], l1[3]};
            float qx[8], kx[8], qo[8], ko[8], ho[8]; { const v4u kw = *(const LAS v4u*)(tp + HG_KT); unpack8(kw, kx); if (OUTPUT) { const v4u qw = *(const LAS v4u*)(tp + HG_QT); unpack8(qw, qx); } }
#pragma unroll
            for (int e = 0; e < 8; ++e) { if (OUTPUT) { qo[e] = qx[e] * __expf(clamp80(a[e] - am[e])); ko[e] = kx[e] * __expf(clamp80(am[e] - a[e])); } ho[e] = kx[e] * __expf(al[e] - a[e]); }
            v4u w;
            if (OUTPUT) { w.x = pk2(qo[0], qo[1]); w.y = pk2(qo[2], qo[3]); w.z = pk2(qo[4], qo[5]); w.w = pk2(qo[6], qo[7]); *(LAS v4u*)(tp + HG_QT) = w;
                w.x = pk2(ko[0], ko[1]); w.y = pk2(ko[2], ko[3]); w.z = pk2(ko[4], ko[5]); w.w = pk2(ko[6], ko[7]); *(LAS v4u*)(tp + HG_KT) = w; }
            w.x = pk2(ho[0], ho[1]); w.y = pk2(ho[2], ho[3]); w.z = pk2(ho[4], ho[5]); w.w = pk2(ho[6], ho[7]); *(LAS v4u*)(tp + HG_KH) = w; }
        __syncthreads();
        if (OUTPUT) {
            bf16* hx = g ? hx1 : hx0;
            f32x16 s = zero16();
#pragma unroll
            for (int ks = 0; ks < 8; ++ks) s = MFMA32(lds16(gb + HG_KT + fo.o_row + 32 * ks), lds16(gb + HG_QT + fo.o_row + 32 * ks), s);
#pragma unroll
            for (int i = 0; i < 16; ++i) s[i] = (crow(i, hh) <= r) ? s[i] : 0.f;
            f32x16 o = zero16();
#pragma unroll
            for (int sp = 0; sp < 2; ++sp) o = MFMA32(pack8(s, sp), ldstr2(gb + HG_V + fo.o_trp + vcol + (16 * sp * HG_LD) * 2, 8 * HG_LD * 2), o);
#pragma unroll
            for (int dt = 0; dt < 4; ++dt)
#pragma unroll
                for (int sp = 0; sp < 2; ++sp) { const f32x4 e0 = *(const LAS f32x4*)(gb + HG_EAM + o_h4 + (32 * dt + 16 * sp) * 4), e1 = *(const LAS f32x4*)(gb + HG_EAM + o_h4 + (32 * dt + 16 * sp + 8) * 4);
                    v4u pw; pw.x = cvtpk(St[dt][8 * sp] * e0[0], St[dt][8 * sp + 1] * e0[1]); pw.y = cvtpk(St[dt][8 * sp + 2] * e0[2], St[dt][8 * sp + 3] * e0[3]);
                    pw.z = cvtpk(St[dt][8 * sp + 4] * e1[0], St[dt][8 * sp + 5] * e1[1]); pw.w = cvtpk(St[dt][8 * sp + 6] * e1[2], St[dt][8 * sp + 7] * e1[3]);
                    o = MFMA32(lds8x2(gb + HG_QT + fo.o_perm + (32 * dt + 16 * sp) * 2), __builtin_bit_cast(bf16x8, pw), o); }
#pragma unroll
            for (int i = 0; i < 16; ++i) *(LAS float*)(OBb + o_obw + ((i & 3) + 8 * (i >> 2)) * 144) = o[i];
            LDS_WAIT(); CFENCE();
            { const f32x4 x0 = *(const LAS f32x4*)(OBb + o_obr), x1 = *(const LAS f32x4*)(OBb + o_obr + 16), x2 = *(const LAS f32x4*)(OBb + o_obr + 32), x3 = *(const LAS f32x4*)(OBb + o_obr + 48);
                const int tau = lns >> 1; const int t = seg_t0 + 32 * ci + (g ? 31 - tau : tau);
                bf16* op = hx + (size_t)(rowbase + t) * D + h * 128 + 32 * j + 16 * (lns & 1);
                v4u w0, w1; w0.x = pk2(x0[0], x0[1]); w0.y = pk2(x0[2], x0[3]); w0.z = pk2(x1[0], x1[1]); w0.w = pk2(x1[2], x1[3]); w1.x = pk2(x2[0], x2[1]); w1.y = pk2(x2[2], x2[3]); w1.z = pk2(x3[0], x3[1]); w1.w = pk2(x3[2], x3[3]);
                *(GAS v4u*)op = w0; *(GAS v4u*)(op + 8) = w1; }
            LDS_WAIT(); CFENCE();
        }
#pragma unroll
        for (int dt = 0; dt < 4; ++dt) {
#pragma unroll
            for (int q4 = 0; q4 < 4; ++q4) { const f32x4 dv = *(const LAS f32x4*)(gb + HG_AUX + 1024 + o_h4 + (32 * dt + 8 * q4) * 4);
#pragma unroll
                for (int e = 0; e < 4; ++e) St[dt][4 * q4 + e] *= dv[e]; }
#pragma unroll
            for (int sp = 0; sp < 2; ++sp) St[dt] = MFMA32(ldstr2(gb + HG_KH + fo.o_trn + (16 * sp * HG_LD + 32 * dt) * 2, 4 * HG_LD * 2), ldstr2(gb + HG_V + fo.o_trn + vcol + (16 * sp * HG_LD) * 2, 4 * HG_LD * 2), St[dt]);
        }
        __syncthreads();
    } }
    if (!OUTPUT) {
        float* e = g ? st_out1 : st_out0; float* ep = e + (4 * hh) * 128 + 32 * j + r;
#pragma unroll
        for (int dt = 0; dt < 4; ++dt)
#pragma unroll
            for (int i = 0; i < 16; ++i) ep[(32 * dt + (i & 3) + 8 * (i >> 2)) * 128] = St[dt][i];
        if (tg >= 128) e[16384 + (tg & 127)] = atot;
    }
}

constexpr int PH_PER_LAYER = 11, PH_BASE = 2, N_PHASES = PH_BASE + DEPTH * PH_PER_LAYER;
#ifndef EN_GEMM
#define EN_GEMM 0xff
#endif
#ifndef EN_ML
#define EN_ML 3
#endif
#ifndef EN_HG
#define EN_HG 3
#endif
#ifndef EN_TOK
#define EN_TOK 1
#endif
#ifndef EN_MISC
#define EN_MISC 1
#endif
#ifndef PG_SP2
#define PG_SP2 true
#endif
#ifndef PG_ALIGN
#define PG_ALIGN true
#endif
#ifndef TIMER_MASK
#define TIMER_MASK 0ull
#endif
#ifndef TIMER_DIV
#define TIMER_DIV 20.0f
#endif
#ifndef MK_SPLIT
#define MK_SPLIT 0
#endif


__device__ __forceinline__ void phase_headnorm(Frame& F, const bf16* hf, const bf16* hb, const bf16* gate, int gpitch, int gcol0, const float* ghead, bf16* aout, int nrows) {
    const int tid = launder_v(F.tid); const int lane = tid & 63, wave = __builtin_amdgcn_readfirstlane(tid >> 6);
    const int gw = F.bid * NWAVES + wave, NGW = F.G * NWAVES;
    float gh[16];
#pragma unroll
    for (int e = 0; e < 16; ++e) gh[e] = ghead[lane * 16 + e];
    for (int row = gw; row < nrows; row += NGW) {
        const v4u a0 = *(const v4u*)(hf + (size_t)row * D + lane * 16), a1 = *(const v4u*)(hf + (size_t)row * D + lane * 16 + 8);
        const v4u b0 = *(const v4u*)(hb + (size_t)row * D + lane * 16), b1 = *(const v4u*)(hb + (size_t)row * D + lane * 16 + 8);
        const v4u g0 = *(const v4u*)(gate + (size_t)row * gpitch + gcol0 + lane * 16), g1 = *(const v4u*)(gate + (size_t)row * gpitch + gcol0 + lane * 16 + 8);
        float x[16], y[8], o[16]; unpack8(a0, y);
#pragma unroll
        for (int e = 0; e < 8; ++e) x[e] = y[e];
        unpack8(a1, y);
#pragma unroll
        for (int e = 0; e < 8; ++e) x[8 + e] = y[e];
        unpack8(b0, y);
#pragma unroll
        for (int e = 0; e < 8; ++e) x[e] += y[e];
        unpack8(b1, y);
#pragma unroll
        for (int e = 0; e < 8; ++e) x[8 + e] += y[e];
        float ss = 0.f;
#pragma unroll
        for (int e = 0; e < 16; ++e) ss += x[e] * x[e];
        ss += __shfl_xor(ss, 1); ss += __shfl_xor(ss, 2); ss += __shfl_xor(ss, 4);
        const float rs = rsqrtf(ss * (1.f / 128.f) + EPS);
        unpack8(g0, y);
#pragma unroll
        for (int e = 0; e < 8; ++e) o[e] = x[e] * rs * gh[e] * sigmoidf_(y[e]);
        unpack8(g1, y);
#pragma unroll
        for (int e = 0; e < 8; ++e) o[8 + e] = x[8 + e] * rs * gh[8 + e] * sigmoidf_(y[e]);
        v4u w0, w1; w0.x = pk2(o[0], o[1]); w0.y = pk2(o[2], o[3]); w0.z = pk2(o[4], o[5]); w0.w = pk2(o[6], o[7]); w1.x = pk2(o[8], o[9]); w1.y = pk2(o[10], o[11]); w1.z = pk2(o[12], o[13]); w1.w = pk2(o[14], o[15]);
        *(v4u*)(aout + (size_t)row * D + lane * 16) = w0; *(v4u*)(aout + (size_t)row * D + lane * 16 + 8) = w1;
    }
}

__device__ __forceinline__ void phase_conv(Frame& F, const bf16* proj, bf16* qkc, float* gates, const float* wconv, const float* bgate) {
    const int gt = F.bid * NTHR + F.tid, cp = gt & 127, rstep = (F.G * NTHR) >> 7;
    float w[3][8];
#pragma unroll
    for (int d = 0; d < 3; ++d)
#pragma unroll
        for (int e = 0; e < 8; ++e) w[d][e] = wconv[d * 1024 + cp * 8 + e];
    const float sc = cp >= 64 ? 0.125f : 1.0f;
    for (int row = gt >> 7; row < M_ALL; row += rstep) {
        int t, len; if (row < M_LAT) { t = row & (SEQ - 1); len = SEQ; } else { t = (row - M_LAT) & (CTXL - 1); len = CTXL; }
        const bf16* rp = proj + (size_t)row * NP_M + cp * 8;
        const v4u z = (v4u){0u, 0u, 0u, 0u};
        const v4u r0 = t > 0 ? *(const v4u*)(rp - NP_M) : z, r1 = *(const v4u*)rp, r2 = t + 1 < len ? *(const v4u*)(rp + NP_M) : z;
        float x0[8], x1[8], x2[8], o[8]; unpack8(r0, x0); unpack8(r1, x1); unpack8(r2, x2);
#pragma unroll
        for (int e = 0; e < 8; ++e) o[e] = sc * siluf_(w[0][e] * x0[e] + w[1][e] * x1[e] + w[2][e] * x2[e]);
        v4u q; q.x = pk2(o[0], o[1]); q.y = pk2(o[2], o[3]); q.z = pk2(o[4], o[5]); q.w = pk2(o[6], o[7]);
        *(v4u*)(qkc + (size_t)row * D + cp * 8) = q;
    }
    for (int i = gt; i < M_ALL * 32; i += F.G * NTHR) { const int c = i & 31; const float x = gates[i] + bgate[c];
        gates[i] = ((c >> 3) & 1) ? (fminf(x, 0.f) - __logf(1.f + __expf(-fabsf(x)))) : x; }
}

__device__ __forceinline__ void timer_stamp(unsigned char* lds_raw, bool add) {
    if (threadIdx.x == 0) { volatile LAS unsigned* tw = (volatile LAS unsigned*)((LAS unsigned char*)lds_raw + LDSCTL_OFF) + 32;
        const unsigned long long t = wall_clock64(); const unsigned long long last = ((unsigned long long)tw[1] << 32) | tw[0];
        if (add) { unsigned long long acc = ((unsigned long long)tw[3] << 32) | tw[2]; acc += t - last; tw[2] = (unsigned)acc; tw[3] = (unsigned)(acc >> 32); }
        tw[0] = (unsigned)t; tw[1] = (unsigned)(t >> 32); }
}

__device__ __forceinline__ Frame mkframe(const Args& args, unsigned char* lds_raw) {
    Frame F; int t = threadIdx.x; asm volatile("" : "+v"(t));
    F.lds = (LAS unsigned char*)lds_raw; F.tid = t; F.lane = t & 63; F.wave = __builtin_amdgcn_readfirstlane(t >> 6);
    int g = gridDim.x, b = blockIdx.x; asm volatile("" : "+s"(g), "+s"(b)); F.G = g; F.bid = b;
    unsigned char* w = args.ws; asm volatile("" : "+s"(w)); F.ws = w; F.in = args.in; F.out = args.out;
    return F;
}
#define PHASE_LOCALS \
    Frame F = mkframe(args, lds_raw); unsigned char* ws = F.ws; \
    float* modv = (float*)(ws + WS_MODV); bf16* U = (bf16*)(ws + WS_U); bf16* Y = (bf16*)(ws + WS_Y); bf16* PROJ = (bf16*)(ws + WS_ACT); bf16* HB = (bf16*)(ws + WS_ACT); \
    bf16* AMOE = (bf16*)(ws + WS_ACT); bf16* HMOE = (bf16*)(ws + WS_ACT + (size_t)MOE_ROWS * D * 2); \
    float* GATES = (float*)(ws + WS_GATES); float* LATC = (float*)(ws + WS_LATC); float* STATE = (float*)(ws + WS_STATE); \
    const int* pexp = (const int*)(ws + WS_SMALL + SM_PEXP); \
    unsigned char* wb = ws + (odd ? WS_WO : WS_WE); const float* mv = modv + (size_t)L * 9 * 6 * 1024; \
    (void)modv; (void)U; (void)Y; (void)PROJ; (void)HB; (void)AMOE; (void)HMOE; (void)GATES; (void)LATC; (void)STATE; (void)pexp; (void)wb; (void)mv;

__global__ void __launch_bounds__(NTHR, 2) fwd(Args args) {
    extern __shared__ __attribute__((aligned(16))) unsigned char lds_raw[];
    Frame F = mkframe(args, lds_raw);
    volatile LAS unsigned* LCTL = (volatile LAS unsigned*)(F.lds + LDSCTL_OFF);
    for (int u = F.tid; u < 128; u += NTHR) LCTL[u] = 0u;
    __syncthreads();
    XcdBarrier bar; bar.bar = (unsigned*)(F.ws + WS_CTL) + CW_BAR; bar.x = 0; bar.st = nullptr;
    if (args.use_bar) bar = xcd_barrier_post((unsigned*)(F.ws + WS_CTL) + CW_BAR, LCTL + 8);
    const int lo = args.ph_lo, hi = args.ph_hi;
#define IN(k) (lo <= (k) && (k) < hi)
#define SEAM(k) do { if ((k) + 1 < hi) xcd_barrier(bar); if (TIMER_MASK != 0ull) timer_stamp(lds_raw, ((TIMER_MASK >> (k)) & 1ull) != 0ull); } while (0)
    if (TIMER_MASK != 0ull) timer_stamp(lds_raw, false);
    if (IN(0)) { const int L = 0; const bool odd = false; PHASE_LOCALS if (EN_MISC) phase_mods(F); __syncthreads(); if (EN_MISC) phase_wconv(F, 0); SEAM(0); }
    if (IN(1)) { const int L = 0; const bool odd = false; PHASE_LOCALS
        TokCfg T{}; T.lat_src_l = F.in[I_X]; T.lat_src_c = F.in[I_CTX]; T.vna = modv + 0 * 1024; T.vnb = modv + 1 * 1024; T.u = U; T.nrows = M_ALL;
        if (EN_TOK) phase_tok(F, T); __syncthreads(); if (EN_MISC) phase_wconv(F, 1); SEAM(1);
    }
    for (int L = 0; L < DEPTH; ++L) {
        const int pb = PH_BASE + L * PH_PER_LAYER; const bool odd = (L & 1) != 0; const int jl = L >> 1;
        const bool ctx_out = L < DEPTH - 1;
        if (IN(pb + 0)) { PHASE_LOCALS
            pg8::Order S; pg8::Gemm g;
            if (!odd) { g = pg8::Gemm{U, (const bf16*)(wb + WE_IN), M_ALL, NIN_M, D}; S.init(M_ALL / 256, NIN_M, F.G, F.bid, nullptr, 0);
                pg8::EpiStore E{PROJ, NP_M, NP_M / 256, NP_M / 256, GATES}; if (EN_GEMM & (1 << 0)) pg8::gemm_phase<pg8::EpiStore, pg8::Order, PG_ALIGN, PG_SP2>(F.lds, g, S, E); }
            else { g = pg8::Gemm{U, (const bf16*)(wb + WOD_IN), M_ALL, NP_H, D}; S.init(M_ALL / 256, NP_H, F.G, F.bid, nullptr, 0);
                pg8::EpiStore E{PROJ, NP_H, NP_H / 256, -1, nullptr}; if (EN_GEMM & (1 << 1)) pg8::gemm_phase<pg8::EpiStore, pg8::Order, PG_ALIGN, PG_SP2>(F.lds, g, S, E); }
            SEAM(pb + 0);
        }
        if (IN(pb + 1)) {
            if (!odd) { PHASE_LOCALS
                phase_conv(F, PROJ, (bf16*)(ws + WS_ACT + 400 * MiB), GATES, F.in[I_MWCONV] + (size_t)jl * 3 * 1024, F.in[I_MBGATE] + jl * 32); SEAM(pb + 1); }
        }
        if (IN(pb + 2)) { PHASE_LOCALS
            for (int id = F.bid; id < 256; id += F.G) {
                const int bh = id >> 2, p = id & 3, b = bh >> 3, h = bh & 7;
                MlSeg SG0, SG1;
                const int csz = odd ? 32 : 64;
                if (p == 0) { SG0 = MlSeg{M_LAT + b * CTXL, CTXL, 0, CTXL / csz}; SG1 = SG0; }
                else { SG0 = MlSeg{b * SEQ, SEQ, (p - 1) * 2048, 2048 / csz}; SG1 = MlSeg{b * SEQ, SEQ, (4 - p) * 2048, 2048 / csz}; }
                if (!odd) { float* e0 = STATE + (size_t)((bh * 2 + 0) * 4 + p) * ML_STATE_F; float* e1 = STATE + (size_t)((bh * 2 + 1) * 4 + p) * ML_STATE_F;
                    if (EN_ML & 1) mlstm_item<false>(F, PROJ, (const bf16*)(ws + WS_ACT + 400 * MiB), GATES, (bf16*)(ws + WS_ACT + 536 * MiB), (bf16*)(ws + WS_Y), h, SG0, SG1, nullptr, nullptr, 0, 0, e0, e1); }
                else { float* e0 = STATE + (size_t)((bh * 2 + 0) * 4 + p) * HG_STATE_F; float* e1 = STATE + (size_t)((bh * 2 + 1) * 4 + p) * HG_STATE_F;
                    if (EN_HG & 1) hgrn_item<false>(F, PROJ, (bf16*)(ws + WS_ACT + 836 * MiB), (bf16*)(ws + WS_Y), F.in[I_HBF] + (size_t)jl * 2048, F.in[I_HLB], jl, h, SG0, SG1, nullptr, nullptr, 0, 0, e0, e1); }
            }
            SEAM(pb + 2);
        }
        if (IN(pb + 3)) { PHASE_LOCALS
            const int nitems = ctx_out ? 320 : 256;
            for (int id = F.bid; id < nitems; id += F.G) {
                MlSeg SG0, SG1; int bh, npre0 = 0, npre1 = 0; const int csz = odd ? 32 : 64;
                if (id < 256) { bh = id >> 2; const int q = id & 3; SG0 = MlSeg{(bh >> 3) * SEQ, SEQ, q * 2048, 2048 / csz}; npre0 = q + 1; npre1 = 4 - q; }
                else { bh = id - 256; SG0 = MlSeg{M_LAT + (bh >> 3) * CTXL, CTXL, 0, CTXL / csz}; }
                SG1 = SG0;
                const int h = bh & 7;
                if (!odd) { const float* s0 = STATE + (size_t)((bh * 2 + 0) * 4) * ML_STATE_F; const float* s1 = STATE + (size_t)((bh * 2 + 1) * 4) * ML_STATE_F;
                    if (EN_ML & 2) mlstm_item<true>(F, PROJ, (const bf16*)(ws + WS_ACT + 400 * MiB), GATES, (bf16*)(ws + WS_ACT + 536 * MiB), (bf16*)(ws + WS_Y), h, SG0, SG1, s0, s1, npre0, npre1, nullptr, nullptr); }
                else { const float* s0 = STATE + (size_t)((bh * 2 + 0) * 4) * HG_STATE_F; const float* s1 = STATE + (size_t)((bh * 2 + 1) * 4) * HG_STATE_F;
                    if (EN_HG & 2) hgrn_item<true>(F, PROJ, (bf16*)(ws + WS_ACT + 836 * MiB), (bf16*)(ws + WS_Y), F.in[I_HBF] + (size_t)jl * 2048, F.in[I_HLB], jl, h, SG0, SG1, s0, s1, npre0, npre1, nullptr, nullptr); }
            }
            SEAM(pb + 3);
        }
        if (IN(pb + 4)) { PHASE_LOCALS
            const bf16* HFp = (const bf16*)(ws + WS_ACT + (odd ? 836 : 536) * MiB); const bf16* HBp = (const bf16*)(ws + WS_Y);
            if (!odd) phase_headnorm(F, HFp, HBp, PROJ, NP_M, 2048, F.in[I_MGHEAD] + jl * 1024, U, ctx_out ? M_ALL : M_LAT);
            else phase_headnorm(F, HFp, HBp, PROJ, NP_H, 4096, F.in[I_HGHEAD] + jl * 1024, U, ctx_out ? M_ALL : M_LAT);
            SEAM(pb + 4);
        }
        if (IN(pb + 5)) { PHASE_LOCALS
            const int nM = (ctx_out ? M_ALL : M_LAT) / 256;
            pg8::Gemm g{U, (const bf16*)(wb + (odd ? WOD_OUT : WE_OUT)), nM * 256, D, D}; pg8::Order S; S.init(nM, D, F.G, F.bid, nullptr, 0);
            pg8::EpiStore E{Y, D, D / 256, -1, nullptr}; if (EN_GEMM & (1 << 2)) pg8::gemm_phase<pg8::EpiStore, pg8::Order, PG_ALIGN, PG_SP2>(F.lds, g, S, E);
            SEAM(pb + 5);
        }
        if (IN(pb + 6)) { PHASE_LOCALS
            TokCfg T{}; T.lat_src_l = (L == 0) ? F.in[I_X] : F.out; T.lat_src_c = (L == 0) ? F.in[I_CTX] : LATC; T.lat_dst_l = F.out; T.lat_dst_c = LATC;
            T.y = Y; T.y_perm = odd ? 1 : 0; T.vupd = mv + 2 * 1024; T.vna = mv + 3 * 1024; T.vnb = mv + 4 * 1024; T.u = U; T.route = odd ? 1 : 0; T.jr = jl; T.nrows = ctx_out ? M_ALL : M_LAT;
            if (EN_TOK) phase_tok(F, T);
            if (L >= 1 && L + 1 < DEPTH) { __syncthreads(); if (EN_MISC) phase_wconv(F, L + 1); }
            SEAM(pb + 6);
        }
        if (IN(pb + 7)) { PHASE_LOCALS
            if (odd) { if (EN_MISC) phase_moe_scatter(F, jl, ctx_out ? M_ALL : M_LAT, U, AMOE); SEAM(pb + 7); }
        }
        if (IN(pb + 8)) { PHASE_LOCALS
            if (!odd) { pg8::Gemm g{U, (const bf16*)(wb + WE_GU), M_ALL, NGU, D}; pg8::Order S; S.init(M_ALL / 256, NGU, F.G, F.bid, nullptr, 0);
                pg8::EpiSwiGLU E{HB, FF}; if (EN_GEMM & (1 << 3)) pg8::gemm_phase<pg8::EpiSwiGLU, pg8::Order, PG_ALIGN, PG_SP2>(F.lds, g, S, E); }
            else { const int np = __builtin_amdgcn_readfirstlane(pexp[MOE_PANELS]);
                pg8::Gemm g{AMOE, (const bf16*)(wb + WOD_GU), np * 256, NGU, D}; pg8::Order S; S.init(np, NGU, F.G, F.bid, pexp, EGU_BYTES);
                pg8::EpiSwiGLU E{HMOE, FF}; if (EN_GEMM & (1 << 4)) pg8::gemm_phase<pg8::EpiSwiGLU, pg8::Order, PG_ALIGN, PG_SP2>(F.lds, g, S, E); }
            SEAM(pb + 8);
        }
        if (IN(pb + 9)) { PHASE_LOCALS
            if (!odd) { pg8::Gemm g{HB, (const bf16*)(wb + WE_DOWN), M_ALL, D, FF}; pg8::Order S; S.init(M_ALL / 256, D, F.G, F.bid, nullptr, 0);
                pg8::EpiStore E{Y, D, D / 256, -1, nullptr}; if (EN_GEMM & (1 << 5)) pg8::gemm_phase<pg8::EpiStore, pg8::Order, PG_ALIGN, PG_SP2>(F.lds, g, S, E); }
            else { const int np = __builtin_amdgcn_readfirstlane(pexp[MOE_PANELS]);
                pg8::Gemm g{HMOE, (const bf16*)(wb + WOD_DOWN), np * 256, D, FF}; pg8::Order S; S.init(np, D, F.G, F.bid, pexp, EDOWN_BYTES);
                pg8::EpiStore E{AMOE, D, D / 256, -1, nullptr}; if (EN_GEMM & (1 << 6)) pg8::gemm_phase<pg8::EpiStore, pg8::Order, PG_ALIGN, PG_SP2>(F.lds, g, S, E); }
            SEAM(pb + 9);
        }
        if (IN(pb + 10)) { PHASE_LOCALS
            TokCfg T{}; T.lat_src_l = F.out; T.lat_src_c = LATC; T.lat_dst_l = F.out; T.lat_dst_c = LATC;
            T.y = odd ? AMOE : Y; T.moe_combine = odd ? 1 : 0; T.vupd = mv + 5 * 1024; T.nrows = ctx_out ? M_ALL : M_LAT;
            if (L + 1 < DEPTH) { const float* mn = modv + (size_t)(L + 1) * 9 * 6 * 1024; T.vna = mn; T.vnb = mn + 1024; T.u = U; T.u_perm = ((L + 1) & 1) ? 1 : 0; }
            if (EN_TOK) phase_tok(F, T);
            SEAM(pb + 10);
        }
    }
    if (TIMER_MASK != 0ull) { timer_stamp(lds_raw, ((TIMER_MASK >> (N_PHASES - 1)) & 1ull) != 0ull);
        if (blockIdx.x == 0 && threadIdx.x == 0) { volatile LAS unsigned* tw = (volatile LAS unsigned*)((LAS unsigned char*)lds_raw + LDSCTL_OFF) + 32; const unsigned long long acc = ((unsigned long long)tw[3] << 32) | tw[2];
            asm volatile("s_waitcnt vmcnt(0)" ::: "memory"); args.out[0] = (float)acc * 0.01f / TIMER_DIV; } }
#undef IN
#undef SEAM
}

extern "C" void kernel_launch(void* const* d_in, const int* in_sizes, int n_in, void* d_out, int out_size, void* d_ws, size_t ws_size, hipStream_t stream) {
    static int grid = 0;
    if (grid == 0) {
        if (n_in != 23 || out_size != M_LAT * D || ws_size < WS_END) { fprintf(stderr, "kernel_launch: unexpected shapes / workspace (n_in %d out %d ws %zu need %zu)\n", n_in, out_size, ws_size, (size_t)WS_END); grid = -1; return; }
        int dev = 0, cus = 0, per_cu = 0;
        if (hipGetDevice(&dev) != hipSuccess || hipDeviceGetAttribute(&cus, hipDeviceAttributeMultiprocessorCount, dev) != hipSuccess) { grid = -1; return; }
        if (hipFuncSetAttribute((const void*)fwd, hipFuncAttributeMaxDynamicSharedMemorySize, LDS_BYTES) != hipSuccess) { fprintf(stderr, "kernel_launch: hipFuncSetAttribute failed\n"); grid = -1; return; }
        if (hipOccupancyMaxActiveBlocksPerMultiprocessor(&per_cu, (const void*)fwd, NTHR, LDS_BYTES) != hipSuccess || per_cu < 1) fprintf(stderr, "kernel_launch: occupancy query reports %d\n", per_cu);
        (void)hipGetLastError();
        grid = cus;
    }
    if (grid < 0) return;
    (void)hipMemsetAsync((char*)d_ws + WS_CTL, 0, CTL_ZERO_BYTES, stream);
    Args a{};
    for (int i = 0; i < 23; ++i) a.in[i] = (const float*)d_in[i];
    a.out = (float*)d_out; a.ws = (unsigned char*)d_ws;
#if MK_SPLIT
    for (int p = 0; p < N_PHASES; ++p) { a.ph_lo = p; a.ph_hi = p + 1; a.use_bar = 0; a.pad = 0; hipLaunchKernelGGL(fwd, dim3(grid), dim3(NTHR), LDS_BYTES, stream, a); }
#else
    a.ph_lo = 0; a.ph_hi = N_PHASES; a.use_bar = 1; a.pad = 0;
    hipLaunchKernelGGL(fwd, dim3(grid), dim3(NTHR), LDS_BYTES, stream, a);
#endif
}
```

```cpp
#include <hip/hip_runtime.h>
#include <cstdio>
#include <cstdint>

namespace pg8 {
#define PG8_LAS __attribute__((address_space(3)))
typedef unsigned short bf16_t;
typedef short bf16x8 __attribute__((ext_vector_type(8)));
typedef float f32x4 __attribute__((ext_vector_type(4)));
typedef unsigned u32x4 __attribute__((ext_vector_type(4)));
typedef unsigned u32x2 __attribute__((ext_vector_type(2)));
typedef int v8i_t __attribute__((ext_vector_type(8)));
constexpr int BM = 256, BK = 64, HALF = 128, HTB = HALF * BK * 2  , STAGE_BYTES = 8 * HTB, NXCD = 8, WGM = 8;

__host__ __device__ __forceinline__ int lds_byte(int r, int c) { const int st = (r >> 4) * 2 + (c >> 5), rr = r & 15, cc = c & 31, ob = rr * 64 + cc * 2; return st * 1024 + (ob ^ (((ob >> 9) & 1) << 5)); }
__host__ __device__ __forceinline__ void stage_rc(int b, int& R, int& C) { const int st = b / 1024, sb = b % 1024, swz = sb ^ (((sb >> 9) & 1) << 5); R = (st >> 1) * 16 + swz / 64; C = (st & 1) * 32 + (swz % 64) / 2; }
__host__ __device__ __forceinline__ int perm32(int rho) { const int n = rho >> 4, i = rho & 15; return 8 * (i >> 2) + 4 * n + (i & 3); }

struct Unit { int pm, pn; };
struct Gemm { const bf16_t* A; const bf16_t* Bt; int M, N, K; };

struct Order {
    int nM, nN, nwg, G, c; const int* pexp; size_t bstride;
    __device__ void init(int nM_, int N, int G_, int c_, const int* pexp_, size_t bstride_) { nM = nM_; nN = N / BM; nwg = nM * nN; G = G_; c = c_; pexp = pexp_; bstride = bstride_; }
    __device__ bool next(int i, Unit& u) const {
        const long L = (long)i * G + c; if (L >= nwg) return false;
        int wgid = (int)L; { const int q = nwg / NXCD, r = nwg % NXCD, xcd = wgid % NXCD, off = wgid / NXCD; wgid = (xcd < r ? xcd * (q + 1) : r * (q + 1) + (xcd - r) * q) + off; }
        const int nig = WGM * nN, gid = wgid / nig, fm = gid * WGM, gsz = (nM - fm) < WGM ? (nM - fm) : WGM;
        u.pm = fm + ((wgid % nig) % gsz); u.pn = (wgid % nig) / gsz; return true;
    }
    __device__ __forceinline__ size_t boff(const Unit& u) const { return pexp ? (size_t)__builtin_amdgcn_readfirstlane(pexp[u.pm]) * bstride : (size_t)0; }
    __device__ __forceinline__ void a_ready(const Unit&) const {}
    __device__ __forceinline__ void done(const Unit&) const {}
};

__device__ __forceinline__ unsigned cvt_pk_bf16(float lo, float hi) { unsigned r; asm volatile("v_cvt_pk_bf16_f32 %0, %1, %2" : "=v"(r) : "v"(lo), "v"(hi)); return r; }

struct EpiStore {
    static constexpr bool PERM = true, AFTER_DRAIN = false;
    bf16_t* O; int ldc; int ncol_tiles; int gate_pn; float* gates; float oscale;
    __device__ __forceinline__ void operator()(const f32x4 (&acc)[2][2][4][2], const Unit& u, int wr, int wc, int fr, int fq) const {
        const int row0 = u.pm * BM + wr * 64 + fr;
        if (u.pn < ncol_tiles) {
            const int col0 = u.pn * BM + wc * 32 + 8 * fq;
#pragma unroll
            for (int ai = 0; ai < 2; ++ai)
#pragma unroll
                for (int m = 0; m < 4; ++m) { bf16_t* rowp = O + (size_t)(row0 + ai * HALF + m * 16) * ldc + col0;
#pragma unroll
                    for (int bj = 0; bj < 2; ++bj) { const f32x4 v0 = acc[ai][bj][m][0] * oscale, v1 = acc[ai][bj][m][1] * oscale;
                        u32x4 w; w.x = cvt_pk_bf16(v0[0], v0[1]); w.y = cvt_pk_bf16(v0[2], v0[3]); w.z = cvt_pk_bf16(v1[0], v1[1]); w.w = cvt_pk_bf16(v1[2], v1[3]);
                        *(u32x4*)(rowp + bj * HALF) = w; } }
        } else if (u.pn == gate_pn && wc == 0) {
#pragma unroll
            for (int ai = 0; ai < 2; ++ai)
#pragma unroll
                for (int m = 0; m < 4; ++m) { float* rowp = gates + (size_t)(row0 + ai * HALF + m * 16) * 32 + 8 * fq;
                    *(f32x4*)(rowp) = acc[ai][0][m][0]; *(f32x4*)(rowp + 4) = acc[ai][0][m][1]; }
        }
    }
};
struct EpiSwiGLU {
    static constexpr bool PERM = true, AFTER_DRAIN = false;
    bf16_t* O; int ldc;
    __device__ __forceinline__ void operator()(const f32x4 (&acc)[2][2][4][2], const Unit& u, int wr, int wc, int fr, int fq) const {
        const int row0 = u.pm * BM + wr * 64 + fr, col0 = u.pn * HALF + wc * 32 + 8 * fq;
#pragma unroll
        for (int ai = 0; ai < 2; ++ai)
#pragma unroll
            for (int m = 0; m < 4; ++m) { bf16_t* rowp = O + (size_t)(row0 + ai * HALF + m * 16) * ldc + col0; float r[8];
#pragma unroll
                for (int n = 0; n < 2; ++n)
#pragma unroll
                    for (int j = 0; j < 4; ++j) { const float g = acc[ai][0][m][n][j], up = acc[ai][1][m][n][j]; r[n * 4 + j] = g * __builtin_amdgcn_rcpf(1.0f + __expf(-g)) * up; }
                u32x4 w; w.x = cvt_pk_bf16(r[0], r[1]); w.y = cvt_pk_bf16(r[2], r[3]); w.z = cvt_pk_bf16(r[4], r[5]); w.w = cvt_pk_bf16(r[6], r[7]);
                *(u32x4*)(rowp) = w; }
    }
};
struct EpiSwiGLU8 {
    static constexpr bool PERM = true, AFTER_DRAIN = false;
    unsigned char* O; int ldc; float ascale;
    __device__ __forceinline__ void operator()(const f32x4 (&acc)[2][2][4][2], const Unit& u, int wr, int wc, int fr, int fq) const {
        const int row0 = u.pm * BM + wr * 64 + fr, col0 = u.pn * HALF + wc * 32 + 8 * fq;
#pragma unroll
        for (int ai = 0; ai < 2; ++ai)
#pragma unroll
            for (int m = 0; m < 4; ++m) { unsigned char* rowp = O + (size_t)(row0 + ai * HALF + m * 16) * ldc + col0; float r[8];
#pragma unroll
                for (int n = 0; n < 2; ++n)
#pragma unroll
                    for (int j = 0; j < 4; ++j) { const float g = acc[ai][0][m][n][j] * ascale, up = acc[ai][1][m][n][j] * ascale; r[n * 4 + j] = g * __builtin_amdgcn_rcpf(1.0f + __expf(-g)) * up; }
                u32x2 w; unsigned t = 0; t = __builtin_amdgcn_cvt_pk_fp8_f32(r[0], r[1], t, false); t = __builtin_amdgcn_cvt_pk_fp8_f32(r[2], r[3], t, true); w.x = t;
                t = 0; t = __builtin_amdgcn_cvt_pk_fp8_f32(r[4], r[5], t, false); t = __builtin_amdgcn_cvt_pk_fp8_f32(r[6], r[7], t, true); w.y = t;
                *(u32x2*)(rowp) = w; }
    }
};

template <bool FP8> struct Frag;
template <> struct Frag<false> { bf16x8 v[2]; };
template <> struct Frag<true> { v8i_t v; };
template <bool FP8> __device__ __forceinline__ void ldfrag(Frag<FP8>& f, const PG8_LAS unsigned char* p) {
    if constexpr (FP8) { const bf16x8 a = *(const PG8_LAS bf16x8*)p, b = *(const PG8_LAS bf16x8*)(p + 1024); f.v = __builtin_bit_cast(v8i_t, __builtin_shufflevector(a, b, 0, 1, 2, 3, 4, 5, 6, 7, 8, 9, 10, 11, 12, 13, 14, 15)); }
    else { f.v[0] = *(const PG8_LAS bf16x8*)p; f.v[1] = *(const PG8_LAS bf16x8*)(p + 1024); }
}
template <class Epi, class Sched, bool ALIGN_EPI = false, bool SP2 = false, bool FP8 = false>
__device__ __forceinline__ void gemm_phase(PG8_LAS unsigned char* lds, const Gemm g, const Sched& S, const Epi& E) {
    int tid = threadIdx.x; asm volatile("" : "+v"(tid)); const int wid = __builtin_amdgcn_readfirstlane(tid >> 6), lane = tid & 63, wr = wid >> 2, wc = wid & 3, fr = lane & 15, fq = lane >> 4;
    const int K = g.K, rowb = FP8 ? K : 2 * K, nt = rowb / 128;
    unsigned voffA[2], voffB[2];
#pragma unroll
    for (int i = 0; i < 2; ++i) { int R, C; stage_rc(tid * 16 + i * 8192, R, C); const int Rb = Epi::PERM ? ((R & ~31) + perm32(R & 31)) : R;
        voffA[i] = (unsigned)(R * rowb + C * 2); voffB[i] = (unsigned)(Rb * rowb + C * 2); }
    const size_t kstep = (size_t)(BK * 2);
    const size_t hstep = (size_t)HALF * rowb;
    const size_t tstep = 2 * hstep;
    const unsigned ldsw = (unsigned)wid * 1024u;
    const int aoff = lds_byte(wr * 64 + fr, fq * 8), boff = lds_byte(wc * 32 + fr, fq * 8);
#define PG8_SA(b, h) (((b) * 2 + (h)) * HTB)
#define PG8_SB(b, h) ((4 + (b) * 2 + (h)) * HTB)
#define PG8_STAGE(bufoff, gbase, voff) do { _Pragma("unroll") for (int _i = 0; _i < 2; ++_i) \
        __builtin_amdgcn_global_load_lds((const unsigned*)((const char*)(gbase) + (voff)[_i]), (PG8_LAS unsigned*)(lds + (bufoff) + ldsw + _i * 8192), 16, 0, 0); } while (0)
#define PG8_LDA(dst, b, h) do { _Pragma("unroll") for (int m = 0; m < 4; ++m) ldfrag<FP8>(dst[m], lds + PG8_SA(b, h) + aoff + m * 2048); } while (0)
#define PG8_LDB(dst, b, h) do { _Pragma("unroll") for (int n = 0; n < 2; ++n) ldfrag<FP8>(dst[n], lds + PG8_SB(b, h) + boff + n * 2048); } while (0)
#define PG8_MMA(ai, bj, At, Bt) do { __builtin_amdgcn_s_setprio(1); _Pragma("unroll") for (int m = 0; m < 4; ++m) _Pragma("unroll") for (int n = 0; n < 2; ++n) { \
        if constexpr (FP8) { asm volatile("v_mfma_f32_16x16x128_f8f6f4 %0, %1, %2, %0" : "+v"(acc[ai][bj][m][n]) : "v"(Bt[n].v), "v"(At[m].v)); }     \
        else { _Pragma("unroll") for (int k = 0; k < 2; ++k) acc[ai][bj][m][n] = __builtin_amdgcn_mfma_f32_16x16x32_bf16(Bt[n].v[k], At[m].v[k], acc[ai][bj][m][n], 0, 0, 0); } } __builtin_amdgcn_s_setprio(0); } while (0)
#define PG8_WAIT_V(n) asm volatile("s_waitcnt vmcnt(" #n ")" ::: "memory")
#define PG8_WAIT_L(n) asm volatile("s_waitcnt lgkmcnt(" #n ")" ::: "memory")
#define PG8_BAR __builtin_amdgcn_s_barrier()
#define PG8_SCHED __builtin_amdgcn_sched_barrier(0)
    Unit cur, nxt; int ui = 0;
    if (!S.next(0, cur)) return;
    f32x4 acc[2][2][4][2];
#pragma unroll
    for (int a = 0; a < 2; ++a)
#pragma unroll
        for (int b = 0; b < 2; ++b)
#pragma unroll
            for (int m = 0; m < 4; ++m)
#pragma unroll
                for (int n = 0; n < 2; ++n) acc[a][b][m][n] = (f32x4){0.f, 0.f, 0.f, 0.f};
    Frag<FP8> At[4], B0[2], B1[2];
    const char* cA = (const char*)g.A + (size_t)cur.pm * tstep; const char* cB = (const char*)g.Bt + S.boff(cur) + (size_t)cur.pn * tstep;
    S.a_ready(cur);
    if constexpr (SP2) {
        PG8_STAGE(PG8_SB(0, 0), cB, voffB); PG8_STAGE(PG8_SB(0, 1), cB + hstep, voffB); PG8_STAGE(PG8_SA(0, 0), cA, voffA); PG8_STAGE(PG8_SA(0, 1), cA + hstep, voffA);
        if (wr == 1) PG8_BAR;
        PG8_WAIT_V(2); PG8_BAR;
        PG8_STAGE(PG8_SB(1, 0), cB + kstep, voffB); PG8_STAGE(PG8_SA(1, 0), cA + kstep, voffA); PG8_STAGE(PG8_SB(1, 1), cB + hstep + kstep, voffB);
        PG8_WAIT_V(6); PG8_BAR;
    } else {
        PG8_STAGE(PG8_SB(0, 0), cB, voffB); PG8_STAGE(PG8_SA(0, 0), cA, voffA); PG8_STAGE(PG8_SB(0, 1), cB + hstep, voffB); PG8_STAGE(PG8_SA(0, 1), cA + hstep, voffA);
        if (wr == 1) PG8_BAR;
        PG8_WAIT_V(4); PG8_BAR;
        PG8_STAGE(PG8_SB(1, 0), cB + kstep, voffB); PG8_STAGE(PG8_SA(1, 0), cA + kstep, voffA); PG8_STAGE(PG8_SB(1, 1), cB + hstep + kstep, voffB);
        PG8_WAIT_V(6); PG8_BAR;
    }
    for (;;) {
        const bool has_next = S.next(ui + 1, nxt);
        const char* nA = has_next ? (const char*)g.A + (size_t)nxt.pm * tstep : cA; const char* nB = has_next ? (const char*)g.Bt + S.boff(nxt) + (size_t)nxt.pn * tstep : cB;
#pragma unroll 1
        for (int t = 0; t < nt; t += 2) {
            const bool last = (t == nt - 2);
            const char* a1 = cA + (size_t)(t + 1) * kstep;
            const char* a2 = last ? nA : cA + (size_t)(t + 2) * kstep; const char* b2 = last ? nB : cB + (size_t)(t + 2) * kstep;
            const char* a3 = a2 + kstep; const char* b3 = b2 + kstep;
            if (last && has_next) S.a_ready(nxt);
            if constexpr (SP2) {
            PG8_LDB(B0, 0, 0); PG8_LDB(B1, 0, 1); PG8_SCHED; PG8_LDA(At, 0, 0); PG8_STAGE(PG8_SA(1, 1), a1 + hstep, voffA);
            PG8_WAIT_V(8); PG8_WAIT_L(0); PG8_BAR; PG8_MMA(0, 0, At, B0); PG8_MMA(0, 1, At, B1); PG8_BAR; PG8_SCHED;
            PG8_LDA(At, 0, 1); PG8_STAGE(PG8_SB(0, 0), b2, voffB); PG8_STAGE(PG8_SB(0, 1), b2 + hstep, voffB); PG8_STAGE(PG8_SA(0, 0), a2, voffA);
            PG8_WAIT_V(8); PG8_WAIT_L(0); PG8_BAR; PG8_MMA(1, 0, At, B0); PG8_MMA(1, 1, At, B1); PG8_BAR; PG8_SCHED;
            PG8_LDB(B0, 1, 0); PG8_LDB(B1, 1, 1); PG8_SCHED; PG8_LDA(At, 1, 0); PG8_STAGE(PG8_SA(0, 1), a2 + hstep, voffA);
            PG8_WAIT_V(8); PG8_WAIT_L(0); PG8_BAR; PG8_MMA(0, 0, At, B0); PG8_MMA(0, 1, At, B1); PG8_BAR; PG8_SCHED;
            PG8_LDA(At, 1, 1); PG8_STAGE(PG8_SB(1, 0), b3, voffB); PG8_STAGE(PG8_SB(1, 1), b3 + hstep, voffB); PG8_STAGE(PG8_SA(1, 0), a3, voffA);
            PG8_WAIT_V(8); PG8_WAIT_L(0); PG8_BAR; PG8_MMA(1, 0, At, B0); PG8_MMA(1, 1, At, B1); PG8_BAR; PG8_SCHED;
            } else {
            PG8_LDB(B0, 0, 0); PG8_SCHED; PG8_LDA(At, 0, 0); PG8_STAGE(PG8_SA(1, 1), a1 + hstep, voffA);
            PG8_WAIT_L(8); PG8_BAR; PG8_WAIT_L(0); PG8_MMA(0, 0, At, B0); PG8_BAR; PG8_SCHED;
            PG8_LDB(B1, 0, 1); PG8_STAGE(PG8_SB(0, 0), b2, voffB);
            PG8_BAR; PG8_WAIT_L(0); PG8_MMA(0, 1, At, B1); PG8_BAR;
            PG8_LDA(At, 0, 1); PG8_STAGE(PG8_SA(0, 0), a2, voffA);
            PG8_BAR; PG8_WAIT_L(0); PG8_MMA(1, 0, At, B0); PG8_BAR; PG8_SCHED;
            PG8_STAGE(PG8_SB(0, 1), b2 + hstep, voffB);
            PG8_WAIT_V(6); PG8_BAR; PG8_MMA(1, 1, At, B1); PG8_BAR;
            PG8_LDB(B0, 1, 0); PG8_SCHED; PG8_LDA(At, 1, 0); PG8_STAGE(PG8_SA(0, 1), a2 + hstep, voffA);
            PG8_WAIT_L(8); PG8_BAR; PG8_WAIT_L(0); PG8_MMA(0, 0, At, B0); PG8_BAR; PG8_SCHED;
            PG8_LDB(B1, 1, 1); PG8_STAGE(PG8_SB(1, 0), b3, voffB);
            PG8_BAR; PG8_WAIT_L(0); PG8_MMA(0, 1, At, B1); PG8_BAR;
            PG8_LDA(At, 1, 1); PG8_STAGE(PG8_SA(1, 0), a3, voffA);
            PG8_BAR; PG8_WAIT_L(0); PG8_MMA(1, 0, At, B0); PG8_BAR; PG8_SCHED;
            PG8_STAGE(PG8_SB(1, 1), b3 + hstep, voffB);
            PG8_WAIT_V(6); PG8_BAR; PG8_MMA(1, 1, At, B1); PG8_BAR;
            }
        }
        if constexpr (ALIGN_EPI) { if (wr == 0) PG8_BAR; }
        if constexpr (FP8) { asm volatile("s_nop 15\n\ts_nop 15" ::: "memory"); }
        if constexpr (!Epi::AFTER_DRAIN) { E(acc, cur, wr, wc, fr, fq); S.done(cur); }
        if (!has_next) break;
#pragma unroll
        for (int a = 0; a < 2; ++a)
#pragma unroll
            for (int b = 0; b < 2; ++b)
#pragma unroll
                for (int m = 0; m < 4; ++m)
#pragma unroll
                    for (int n = 0; n < 2; ++n) acc[a][b][m][n] = (f32x4){0.f, 0.f, 0.f, 0.f};
        cur = nxt; cA = nA; cB = nB; ++ui;
        if constexpr (ALIGN_EPI) { if (wr == 1) PG8_BAR; }
    }
    PG8_WAIT_V(0);
    if constexpr (!ALIGN_EPI) { if (wr == 0) PG8_BAR; }
    PG8_BAR;
    if constexpr (Epi::AFTER_DRAIN) { E.fused(acc, cur, wr, wc, fr, fq, lds, wid, lane); S.done(cur); }
#undef PG8_SA
#undef PG8_SB
#undef PG8_STAGE
#undef PG8_LDA
#undef PG8_LDB
#undef PG8_MMA
#undef PG8_WAIT_V
#undef PG8_WAIT_L
#undef PG8_BAR
#undef PG8_SCHED
}
}

constexpr int D = 1024, NB = 8, SEQ = 8192, CTXL = 256, DEPTH = 4, GRIDW = 64, ROWS_G = SEQ / GRIDW  ;
constexpr int M_LAT = NB * SEQ  , M_CTX = NB * CTXL  , M_ALL = M_LAT + M_CTX  ;
constexpr int NHEAD = 8, M_DK = 64, M_DV = 128, H_DK = 128, H_DV = 128;
constexpr int NP_M = 3072, NIN_M = 3328, NW_M = 3104, NP_H = 5120;
constexpr int FF = 2816, NGU = 2 * FF, NEXP = 8;
constexpr int MOE_ROWS = 137216, MOE_PANELS = MOE_ROWS / 256;
constexpr float EPS = 1e-6f;
constexpr int NWAVES = 8, NTHR = 512;

constexpr size_t MiB = 1u << 20;
constexpr size_t WS_CTL = 0, CTL_ZERO_BYTES = 1 * MiB;
constexpr size_t WS_MODV = 1 * MiB;
constexpr size_t WS_SMALL = 2 * MiB;
constexpr size_t WS_LATC = 3 * MiB;
constexpr size_t WS_WE = 11 * MiB;
constexpr size_t WS_WO = 37 * MiB;
constexpr size_t WS_U = 181 * MiB;
constexpr size_t WS_GATES = 313 * MiB;
constexpr size_t WS_STATE = 322 * MiB;
constexpr size_t WS_ROUTE = 362 * MiB;
constexpr size_t WS_ACT = 364 * MiB;
constexpr size_t WS_Y = WS_ACT + 700 * MiB;
constexpr size_t WS_END = WS_ACT + 1005 * MiB;
constexpr size_t WE_IN = 0, WE_OUT = 7 * MiB, WE_GU = 9 * MiB, WE_DOWN = 20 * MiB;
constexpr size_t WOD_IN = 0, WOD_OUT = 10 * MiB, WOD_GU = 12 * MiB, WOD_DOWN = 100 * MiB;
constexpr size_t EGU_BYTES = (size_t)NGU * D * 2, EDOWN_BYTES = (size_t)D * FF * 2;
static_assert(WOD_GU + 8 * EGU_BYTES <= WOD_DOWN && WOD_DOWN + 8 * EDOWN_BYTES <= 144 * MiB, "odd weights map");
static_assert((size_t)NIN_M * D * 2 <= 7 * MiB && WE_GU + EGU_BYTES <= WE_DOWN && WE_DOWN + EDOWN_BYTES <= 26 * MiB, "even weights map");
static_assert((size_t)M_ALL * NP_H * 2 <= 700 * MiB && (size_t)MOE_ROWS * D * 2 + (size_t)MOE_ROWS * FF * 2 <= 1005 * MiB && 700 * MiB + (size_t)M_ALL * D * 2 <= 1005 * MiB, "act map");
constexpr int CW_BAR = 4096;
constexpr int CW_ECNT = 8192;
constexpr int CW_DBG = 16384;
constexpr size_t RT_E = 0;
constexpr size_t RT_R = 512 * 1024;
constexpr size_t RT_W = 512 * 1024 + 1024 * 1024;
constexpr size_t SM_LB = 0;
constexpr size_t SM_PEXP = 64 * 1024;
constexpr size_t SM_EBASE = 96 * 1024;

constexpr int LDS_MAIN = 147456;
constexpr int LDSCTL_OFF = LDS_MAIN;
constexpr int LDS_BYTES = LDS_MAIN + 512;

#define GAS __attribute__((address_space(1)))
#define LAS __attribute__((address_space(3)))
typedef unsigned short bf16;
typedef unsigned v4u __attribute__((ext_vector_type(4)));
typedef unsigned v2u __attribute__((ext_vector_type(2)));
typedef float f32x4 __attribute__((ext_vector_type(4)));
typedef float f32x16 __attribute__((ext_vector_type(16)));
typedef short bf16x8 __attribute__((ext_vector_type(8)));
typedef short s16x4 __attribute__((ext_vector_type(4)));
typedef GAS unsigned gu32;
#define RLX_AGENT __ATOMIC_RELAXED, __HIP_MEMORY_SCOPE_AGENT
#define LDS_WAIT() asm volatile("s_waitcnt lgkmcnt(0)" ::: "memory")
#define VM_WAIT() asm volatile("s_waitcnt vmcnt(0)" ::: "memory")
#define CFENCE() asm volatile("" ::: "memory")
__device__ __forceinline__ unsigned f2bf(float f) { unsigned u = __builtin_bit_cast(unsigned, f); return (u + 0x7fffu + ((u >> 16) & 1u)) >> 16; }
typedef __bf16 bf16x2_t __attribute__((ext_vector_type(2)));
typedef float f32x2_t __attribute__((ext_vector_type(2)));
__device__ __forceinline__ unsigned pk2(float lo, float hi) { f32x2_t v = {lo, hi}; bf16x2_t b = __builtin_convertvector(v, bf16x2_t); return __builtin_bit_cast(unsigned, b); }
__device__ __forceinline__ float bf2f(unsigned short b) { return __builtin_bit_cast(float, (unsigned)b << 16); }
__device__ __forceinline__ float bflo(unsigned w) { return __builtin_bit_cast(float, w << 16); }
__device__ __forceinline__ float bfhi(unsigned w) { return __builtin_bit_cast(float, w & 0xffff0000u); }
__device__ __forceinline__ float sigmoidf_(float x) { return __builtin_amdgcn_rcpf(1.0f + __expf(-x)); }
__device__ __forceinline__ float siluf_(float x) { return x * sigmoidf_(x); }
__device__ __forceinline__ float wave_sum(float v) {
#pragma unroll
    for (int o = 1; o < 64; o <<= 1) v += __shfl_xor(v, o);
    return v;
}

#define XB_TMO      128
#define XB_XCNT(j)  (256  + 64 * (j))
#define XB_XSUB(j)  (1280 + 64 * (j))
#define XB_XGEN(j)  (2304 + 64 * (j))
#define XB_TOP      3328
#define XB_TOPGEN   3392
#define XCD_BAR_WORDS 3456
#define XB_SPIN_CAP (1u << 18)
__device__ __forceinline__ unsigned xb_ld(unsigned* p)              { return __hip_atomic_load(p, __ATOMIC_RELAXED, __HIP_MEMORY_SCOPE_AGENT); }
__device__ __forceinline__ unsigned xb_add(unsigned* p, unsigned v) { return __hip_atomic_fetch_add(p, v, __ATOMIC_RELAXED, __HIP_MEMORY_SCOPE_AGENT); }
__device__ __forceinline__ unsigned xb_xcc_id() { return (unsigned)__builtin_amdgcn_s_getreg((3 << 11) | 20) & 0xFu; }
#define XB_SPIN(cond, bar) do { unsigned _sp = 0; while (cond) { __builtin_amdgcn_s_sleep(1); \
    if ((++_sp & 255u) == 0u) { if (xb_ld(&(bar)[XB_TMO])) break; if (_sp > XB_SPIN_CAP) { atomicAdd(&(bar)[XB_TMO], 1u); break; } } } } while (0)
struct XcdBarrier { unsigned* bar; unsigned x; volatile LAS unsigned* st; };
__device__ __forceinline__ XcdBarrier xcd_barrier_post(unsigned* bar, volatile LAS unsigned* st) {
    XcdBarrier b; b.bar = bar; b.x = xb_xcc_id(); b.st = st;
    if (threadIdx.x == 0) (void)xb_add(&bar[XB_XCNT(b.x)], 1u);
    return b;
}
__device__ __forceinline__ void xcd_barrier_complete(unsigned* bar, unsigned x, unsigned& nloc, unsigned& nx) {
    const unsigned G = gridDim.x * gridDim.y * gridDim.z;
    unsigned sum, cnt, mine, sp = 0u;
    for (;;) {
        sum = 0u; cnt = 0u; mine = 0u;
#pragma unroll
        for (unsigned j = 0; j < 16; ++j) { const unsigned c = xb_ld(&bar[XB_XCNT(j)]); sum += c; cnt += (c > 0u) ? 1u : 0u; mine = (j == x) ? c : mine; }
        if (sum == G) break;
        __builtin_amdgcn_s_sleep(1);
        if ((++sp & 255u) == 0u) { if (xb_ld(&bar[XB_TMO])) break; if (sp > XB_SPIN_CAP) { atomicAdd(&bar[XB_TMO], 1u); break; } }
    }
    nloc = mine > 0u ? mine : 1u; nx = cnt > 0u ? cnt : 1u;
}
__device__ __forceinline__ void xcd_barrier(const XcdBarrier& b) {
    asm volatile("s_waitcnt vmcnt(0)" ::: "memory");
    __syncthreads();
    if (threadIdx.x == 0) {
        unsigned* bar = b.bar;
        __builtin_amdgcn_s_waitcnt(0);
        unsigned nloc = b.st[0], nx = b.st[1];
        if (nloc == 0u) { xcd_barrier_complete(bar, b.x, nloc, nx); b.st[0] = nloc; b.st[1] = nx; }
        const unsigned old = xb_add(&bar[XB_XSUB(b.x)], 1u);
        const unsigned gen = old / nloc;
        if (old + 1u == (gen + 1u) * nloc) {
            __builtin_amdgcn_fence(__ATOMIC_RELEASE, "agent");
            asm volatile("s_waitcnt vmcnt(0)" ::: "memory");
            const unsigned og = xb_add(&bar[XB_TOP], 1u);
            const unsigned tg = og / nx;
            if (og + 1u == (tg + 1u) * nx) xb_add(&bar[XB_TOPGEN], 1u);
            else XB_SPIN(xb_ld(&bar[XB_TOPGEN]) == tg, bar);
            __builtin_amdgcn_fence(__ATOMIC_ACQUIRE, "agent");
            xb_add(&bar[XB_XGEN(b.x)], 1u);
            asm volatile("s_waitcnt vmcnt(0)" ::: "memory");
        } else {
            XB_SPIN(xb_ld(&bar[XB_XGEN(b.x)]) == gen, bar);
            __builtin_amdgcn_fence(__ATOMIC_ACQUIRE, "agent");
            asm volatile("s_waitcnt vmcnt(0)" ::: "memory");
        }
    }
    __syncthreads();
}

struct Args {
    const float* in[23];
    float* out; unsigned char* ws;
    int ph_lo, ph_hi;
    int use_bar, pad;
};
struct Frame {
    LAS unsigned char* lds;
    int tid, lane, wave, G, bid;
    unsigned char* ws;
    const float* const __attribute__((address_space(4)))* in;
    float* out;
};
enum { I_X = 0, I_C, I_CTX, I_CCTX, I_MODW, I_MODB, I_NORMG, I_MWIN, I_MBGATE, I_MWCONV, I_MGHEAD, I_MWOUT, I_HWIN, I_HBF, I_HLB, I_HGHEAD, I_HWOUT, I_FWGU, I_FWDOWN, I_EWR, I_EBR, I_EWGU, I_EWDOWN };

#ifndef FP8_LAYERS
#define FP8_LAYERS 0xE
#endif
#define FFN_FP8_L(L) (((FP8_LAYERS) >> (L)) & 1)
#ifndef FFN_FP8
#define FFN_FP8 1
#endif
constexpr float WSCALE8 = 64.0f;

__device__ __forceinline__ void phase_mods(Frame& F) {
    LAS float* SV = (LAS float*)(F.lds);
    LAS float* RED = (LAS float*)(F.lds + 9 * 1024 * 4);
    const float* cvec = F.in[I_C]; const float* cctx = F.in[I_CCTX];
    for (int i = F.tid; i < 9 * 1024; i += NTHR) { const int b = i >> 10, k = i & 1023; const float v = b < 8 ? cvec[b * 1024 + k] : cctx[k]; SV[i] = siluf_(v); }
    __syncthreads();
    const float* modw = F.in[I_MODW]; const float* modb = F.in[I_MODB]; const float* normg = F.in[I_NORMG];
    float* modv = (float*)(F.ws + WS_MODV);
    for (int item = F.bid; item < 4 * 96; item += F.G) {
        const int L = item / 96, n0 = (item % 96) * 64;
        const float* wp = modw + (size_t)L * 1024 * 6144 + n0 + F.lane;
        float acc[9];
#pragma unroll
        for (int b = 0; b < 9; ++b) acc[b] = 0.f;
        const int k0 = F.wave * 128;
#pragma unroll 4
        for (int k = 0; k < 128; ++k) { const float wv = wp[(size_t)(k0 + k) * 6144];
#pragma unroll
            for (int b = 0; b < 9; ++b) acc[b] += SV[b * 1024 + k0 + k] * wv; }
#pragma unroll
        for (int b = 0; b < 9; ++b) RED[(F.wave * 9 + b) * 64 + F.lane] = acc[b];
        __syncthreads();
        for (int o = F.tid; o < 9 * 64; o += NTHR) { const int b = o >> 6, l = o & 63; float v = 0.f;
#pragma unroll
            for (int w = 0; w < 8; ++w) v += RED[(w * 9 + b) * 64 + l];
            const int n = n0 + l, s = n >> 10, c = n & 1023; v += modb[L * 6144 + n];
            const float* g = normg + (size_t)L * 4 * 1024;
            int slot; float r;
            if (s == 0) { slot = 1; r = v; } else if (s == 1) { slot = 0; r = g[c] * (1.f + v); } else if (s == 2) { slot = 2; r = v * g[1024 + c]; }
            else if (s == 3) { slot = 4; r = v; } else if (s == 4) { slot = 3; r = g[2048 + c] * (1.f + v); } else { slot = 5; r = v * g[3072 + c]; }
            modv[((size_t)(L * 9 + b) * 6 + slot) * 1024 + c] = r; }
        __syncthreads();
    }
}

__device__ __forceinline__ void wconv_item(const float* W, int K, int N, bf16* WT, int gu_mode, LAS float* scr, int item, int lane) {
    const int nblk = N / 32, kb = item / nblk, nb = item % nblk, k0 = 64 * kb, n0 = 32 * nb;
    int row0 = n0;
    if (gu_mode) { const int half = n0 / FF, nn = n0 - half * FF; row0 = 256 * (nn >> 7) + 128 * half + (nn & 127); }
#pragma unroll 8
    for (int i = 0; i < 32; ++i) { const int kk = 2 * i + (lane >> 5); scr[kk * 33 + (lane & 31)] = W[(size_t)(k0 + kk) * N + n0 + (lane & 31)]; }
    LDS_WAIT(); CFENCE();
    const int c = lane & 7;
#pragma unroll
    for (int j = 0; j < 4; ++j) { const int n = (lane >> 3) + 8 * j; const LAS float* s = scr + (8 * c) * 33 + n;
        v4u o; o.x = pk2(s[0 * 33], s[1 * 33]); o.y = pk2(s[2 * 33], s[3 * 33]); o.z = pk2(s[4 * 33], s[5 * 33]); o.w = pk2(s[6 * 33], s[7 * 33]);
        *(GAS v4u*)(WT + (size_t)(row0 + n) * K + k0 + 8 * c) = o; }
    LDS_WAIT(); CFENCE();
}
__device__ __forceinline__ void wconv_item8(const float* W, int K, int N, unsigned char* WT, int gu_mode, float wscale, LAS float* scr, int item, int lane) {
    const int nblk = N / 32, kb = item / nblk, nb = item % nblk, k0 = 64 * kb, n0 = 32 * nb;
    int row0 = n0;
    if (gu_mode) { const int half = n0 / FF, nn = n0 - half * FF; row0 = 256 * (nn >> 7) + 128 * half + (nn & 127); }
#pragma unroll 8
    for (int i = 0; i < 32; ++i) { const int kk = 2 * i + (lane >> 5); scr[kk * 33 + (lane & 31)] = W[(size_t)(k0 + kk) * N + n0 + (lane & 31)]; }
    LDS_WAIT(); CFENCE();
    const int c = lane & 7;
#pragma unroll
    for (int j = 0; j < 4; ++j) { const int n = (lane >> 3) + 8 * j; const LAS float* s = scr + (8 * c) * 33 + n;
        v2u o; unsigned w = 0; w = __builtin_amdgcn_cvt_pk_fp8_f32(s[0 * 33] * wscale, s[1 * 33] * wscale, w, false); w = __builtin_amdgcn_cvt_pk_fp8_f32(s[2 * 33] * wscale, s[3 * 33] * wscale, w, true); o.x = w;
        w = 0; w = __builtin_amdgcn_cvt_pk_fp8_f32(s[4 * 33] * wscale, s[5 * 33] * wscale, w, false); w = __builtin_amdgcn_cvt_pk_fp8_f32(s[6 * 33] * wscale, s[7 * 33] * wscale, w, true); o.y = w;
        *(GAS v2u*)(WT + (size_t)(row0 + n) * K + k0 + 8 * c) = o; }
    LDS_WAIT(); CFENCE();
}
__device__ __forceinline__ void phase_wconv(Frame& F, int L) {
    LAS float* scr = (LAS float*)(F.lds + F.wave * 16384);
    const int gw = F.bid * NWAVES + F.wave, NGW = F.G * NWAVES; const int j = L >> 1;
    if ((L & 1) == 0) {
        unsigned char* wb = F.ws + WS_WE;
        const float* w_in = F.in[I_MWIN] + (size_t)j * D * NW_M; const float* w_out = F.in[I_MWOUT] + (size_t)j * D * D;
        const float* w_gu = F.in[I_FWGU] + (size_t)j * D * NGU; const float* w_dn = F.in[I_FWDOWN] + (size_t)j * FF * D;
        constexpr int I0 = 16 * (NW_M / 32), I1 = 16 * 32, I2 = 16 * (NGU / 32), I3 = (FF / 64) * 32;
        for (int it = gw; it < I0 + I1 + I2 + I3; it += NGW) { int r = it;
            if (r < I0) { wconv_item(w_in, D, NW_M, (bf16*)(wb + WE_IN), 0, scr, r, F.lane); continue; } r -= I0;
            if (r < I1) { wconv_item(w_out, D, D, (bf16*)(wb + WE_OUT), 0, scr, r, F.lane); continue; } r -= I1;
            if (r < I2) { if (FFN_FP8_L(L)) wconv_item8(w_gu, D, NGU, wb + WE_GU, 1, WSCALE8, scr, r, F.lane); else wconv_item(w_gu, D, NGU, (bf16*)(wb + WE_GU), 1, scr, r, F.lane); continue; } r -= I2;
            if (FFN_FP8_L(L)) wconv_item8(w_dn, FF, D, wb + WE_DOWN, 0, WSCALE8, scr, r, F.lane); else wconv_item(w_dn, FF, D, (bf16*)(wb + WE_DOWN), 0, scr, r, F.lane); }
        GAS v4u* z = (GAS v4u*)(wb + WE_IN + (size_t)NW_M * D * 2); const int nz = (NIN_M - NW_M) * D * 2 / 16;
        for (int i = F.bid * NTHR + F.tid; i < nz; i += F.G * NTHR) z[i] = (v4u){0u, 0u, 0u, 0u};
    } else {
        unsigned char* wb = F.ws + WS_WO;
        const float* w_in = F.in[I_HWIN] + (size_t)j * D * NP_H; const float* w_out = F.in[I_HWOUT] + (size_t)j * D * D;
        const float* w_gu = F.in[I_EWGU] + (size_t)j * NEXP * D * NGU; const float* w_dn = F.in[I_EWDOWN] + (size_t)j * NEXP * FF * D;
        constexpr int I0 = 16 * (NP_H / 32), I1 = 16 * 32, I2 = 16 * (NGU / 32), I3 = (FF / 64) * 32;
        for (int it = gw; it < I0 + I1 + NEXP * (I2 + I3); it += NGW) { int r = it;
            if (r < I0) { wconv_item(w_in, D, NP_H, (bf16*)(wb + WOD_IN), 0, scr, r, F.lane); continue; } r -= I0;
            if (r < I1) { wconv_item(w_out, D, D, (bf16*)(wb + WOD_OUT), 0, scr, r, F.lane); continue; } r -= I1;
            const int e = r / (I2 + I3); r -= e * (I2 + I3);
            if (r < I2) { if (FFN_FP8_L(L)) wconv_item8(w_gu + (size_t)e * D * NGU, D, NGU, wb + WOD_GU + e * EGU_BYTES, 1, WSCALE8, scr, r, F.lane); else wconv_item(w_gu + (size_t)e * D * NGU, D, NGU, (bf16*)(wb + WOD_GU + e * EGU_BYTES), 1, scr, r, F.lane); continue; } r -= I2;
            if (FFN_FP8_L(L)) wconv_item8(w_dn + (size_t)e * FF * D, FF, D, wb + WOD_DOWN + e * EDOWN_BYTES, 0, WSCALE8, scr, r, F.lane); else wconv_item(w_dn + (size_t)e * FF * D, FF, D, (bf16*)(wb + WOD_DOWN + e * EDOWN_BYTES), 0, scr, r, F.lane); }
    }
}

struct TokCfg {
    const float* lat_src_l; const float* lat_src_c;
    float* lat_dst_l; float* lat_dst_c;
    const bf16* y; int y_perm; int moe_combine;
    const float* vupd;
    const float* vna; const float* vnb;
    bf16* u; int u_perm; int u_fp8;
    int route; int jr;
    int nrows;
};
__device__ __forceinline__ int perm_cm(int t) { return (t & 63) * ROWS_G + (t >> 6); }

__device__ __forceinline__ void phase_tok(Frame& F, const TokCfg& T) {
    const int gw = F.bid * NWAVES + F.wave, NGW = F.G * NWAVES;
    const int R = (T.nrows + NGW - 1) / NGW; const int r0 = gw * R; int r1 = r0 + R; if (r1 > T.nrows) r1 = T.nrows;
    LAS float* WR = (LAS float*)F.lds;
    if (T.route) { const float* wr = F.in[I_EWR] + (size_t)T.jr * 1024 * 8; for (int i = F.tid; i < 8192; i += NTHR) WR[i] = wr[i]; }
    __syncthreads();
    f32x4 VU[4], VA[4], VB[4]; int curb = -1;
    int my_e0 = 0, my_e1 = 0; float my_w = 0.f;
    for (int row = r0; row < r1; ++row) {
        const int b = row < M_LAT ? (row >> 13) : 8;
        if (b != curb) { curb = b;
#pragma unroll
            for (int j = 0; j < 4; ++j) {
                if (T.y) VU[j] = ((const f32x4*)(T.vupd + (size_t)b * 6144))[F.lane + 64 * j];
                if (T.vna) { VA[j] = ((const f32x4*)(T.vna + (size_t)b * 6144))[F.lane + 64 * j]; VB[j] = ((const f32x4*)(T.vnb + (size_t)b * 6144))[F.lane + 64 * j]; } } }
        const float* lp = row < M_LAT ? T.lat_src_l + (size_t)row * D : T.lat_src_c + (size_t)(row - M_LAT) * D;
        f32x4 v[4];
#pragma unroll
        for (int j = 0; j < 4; ++j) v[j] = ((const f32x4*)lp)[F.lane + 64 * j];
        if (T.y) {
            f32x4 yv[4];
            if (T.moe_combine) {
                const int* rr = (const int*)(F.ws + WS_ROUTE + RT_R); const float w0 = ((const float*)(F.ws + WS_ROUTE + RT_W))[row], w1 = 1.f - w0;
                const int p0 = rr[2 * row], p1 = rr[2 * row + 1];
                const v2u* ya = (const v2u*)(T.y + (size_t)p0 * D); const v2u* yb = (const v2u*)(T.y + (size_t)p1 * D);
#pragma unroll
                for (int j = 0; j < 4; ++j) { const v2u a = ya[F.lane + 64 * j], c = yb[F.lane + 64 * j];
                    yv[j] = (f32x4){w0 * bflo(a.x) + w1 * bflo(c.x), w0 * bfhi(a.x) + w1 * bfhi(c.x), w0 * bflo(a.y) + w1 * bflo(c.y), w0 * bfhi(a.y) + w1 * bfhi(c.y)}; }
            } else {
                int yr = row; if (T.y_perm && row < M_LAT) yr = (row & ~8191) + perm_cm(row & 8191);
                const v2u* yp = (const v2u*)(T.y + (size_t)yr * D);
#pragma unroll
                for (int j = 0; j < 4; ++j) { const v2u a = yp[F.lane + 64 * j]; yv[j] = (f32x4){bflo(a.x), bfhi(a.x), bflo(a.y), bfhi(a.y)}; }
            }
            float ss = 0.f;
#pragma unroll
            for (int j = 0; j < 4; ++j) ss += (yv[j].x * yv[j].x + yv[j].y * yv[j].y) + (yv[j].z * yv[j].z + yv[j].w * yv[j].w);
            const float rs = rsqrtf(wave_sum(ss) * (1.f / D) + EPS);
#pragma unroll
            for (int j = 0; j < 4; ++j) v[j] = v[j] + VU[j] * (yv[j] * rs);
        }
        float* dp = row < M_LAT ? (T.lat_dst_l ? T.lat_dst_l + (size_t)row * D : nullptr) : (T.lat_dst_c ? T.lat_dst_c + (size_t)(row - M_LAT) * D : nullptr);
        if (dp) {
#pragma unroll
            for (int j = 0; j < 4; ++j) ((f32x4*)dp)[F.lane + 64 * j] = v[j];
        }
        if (T.vna) {
            float ss = 0.f;
#pragma unroll
            for (int j = 0; j < 4; ++j) ss += (v[j].x * v[j].x + v[j].y * v[j].y) + (v[j].z * v[j].z + v[j].w * v[j].w);
            const float rs = rsqrtf(wave_sum(ss) * (1.f / D) + EPS);
            f32x4 uu[4];
#pragma unroll
            for (int j = 0; j < 4; ++j) uu[j] = (v[j] * rs) * VA[j] + VB[j];
            int ur = row; if (T.u_perm && row < M_LAT) ur = (row & ~8191) + perm_cm(row & 8191);
            if (T.u_fp8) { unsigned* up8 = (unsigned*)((unsigned char*)T.u + (size_t)ur * D);
#pragma unroll
                for (int j = 0; j < 4; ++j) { unsigned w = 0; w = __builtin_amdgcn_cvt_pk_fp8_f32(uu[j].x, uu[j].y, w, false); w = __builtin_amdgcn_cvt_pk_fp8_f32(uu[j].z, uu[j].w, w, true); up8[F.lane + 64 * j] = w; } }
            else { v2u* up = (v2u*)(T.u + (size_t)ur * D);
#pragma unroll
                for (int j = 0; j < 4; ++j) { v2u o; o.x = pk2(uu[j].x, uu[j].y); o.y = pk2(uu[j].z, uu[j].w); up[F.lane + 64 * j] = o; } }
            if (T.route) {
                float lg[8];
#pragma unroll
                for (int e = 0; e < 8; ++e) lg[e] = 0.f;
#pragma unroll
                for (int j = 0; j < 4; ++j)
#pragma unroll
                    for (int i = 0; i < 4; ++i) { const int c = 4 * (F.lane + 64 * j) + i; const f32x4 wa = *(const LAS f32x4*)(WR + c * 8), wb = *(const LAS f32x4*)(WR + c * 8 + 4); const float x = uu[j][i];
                        lg[0] += x * wa.x; lg[1] += x * wa.y; lg[2] += x * wa.z; lg[3] += x * wa.w; lg[4] += x * wb.x; lg[5] += x * wb.y; lg[6] += x * wb.z; lg[7] += x * wb.w; }
                const float* br = F.in[I_EBR] + T.jr * 8;
#pragma unroll
                for (int e = 0; e < 8; ++e) lg[e] = wave_sum(lg[e]) + br[e];
                int e0 = 0; float v0 = lg[0];
#pragma unroll
                for (int e = 1; e < 8; ++e) if (lg[e] > v0) { v0 = lg[e]; e0 = e; }
                int e1 = -1; float v1 = -3.0e38f;
#pragma unroll
                for (int e = 0; e < 8; ++e) if (e != e0 && lg[e] > v1) { v1 = lg[e]; e1 = e; }
                const float w0 = 1.f / (1.f + __expf(v1 - v0));
                if (F.lane == row - r0) { my_e0 = e0; my_e1 = e1; my_w = w0; }
            }
        }
    }
    if (T.route) {
        const int n = r1 - r0; const bool act = F.lane < n; const int row = r0 + F.lane;
        unsigned* ecnt = (unsigned*)(F.ws + WS_CTL) + CW_ECNT + T.jr * 8 * 64;
        int rk0 = 0, rk1 = 0;
        const unsigned long long ltmask = (F.lane == 0) ? 0ull : (~0ull >> (64 - F.lane));
#pragma unroll
        for (int e = 0; e < 8; ++e) {
            const unsigned long long m0 = __ballot(act && my_e0 == e), m1 = __ballot(act && my_e1 == e);
            const int c0 = __popcll(m0), c1 = __popcll(m1);
            unsigned base = 0;
            if (c0 + c1 > 0) { if (F.lane == 0) base = __hip_atomic_fetch_add(ecnt + e * 64, (unsigned)(c0 + c1), RLX_AGENT); base = __builtin_amdgcn_readfirstlane(base); }
            if (my_e0 == e) rk0 = (int)base + __popcll(m0 & ltmask);
            if (my_e1 == e) rk1 = (int)base + c0 + __popcll(m1 & ltmask);
        }
        if (act) { ((int*)(F.ws + WS_ROUTE + RT_E))[row] = my_e0 | (my_e1 << 8); ((int*)(F.ws + WS_ROUTE + RT_R))[2 * row] = rk0; ((int*)(F.ws + WS_ROUTE + RT_R))[2 * row + 1] = rk1;
            ((float*)(F.ws + WS_ROUTE + RT_W))[row] = my_w; }
    }
}

__device__ __forceinline__ void phase_moe_scatter(Frame& F, int jr, int nrows, const unsigned char* U, unsigned char* AM, int rowb) {
    const unsigned* ecnt = (const unsigned*)(F.ws + WS_CTL) + CW_ECNT + jr * 8 * 64;
    int base[8]; int acc = 0;
#pragma unroll
    for (int e = 0; e < 8; ++e) { const int c = (int)__hip_atomic_load(ecnt + e * 64, RLX_AGENT); base[e] = acc; acc += (c + 255) & ~255; }
    int* pexp = (int*)(F.ws + WS_SMALL + SM_PEXP);
    if (F.bid == 0) { const int np = acc >> 8;
        for (int p = F.tid; p < np; p += NTHR) { int e = 0;
#pragma unroll
            for (int q = 1; q < 8; ++q) if (p * 256 >= base[q]) e = q;
            pexp[p] = e; }
        if (F.tid == 0) pexp[MOE_PANELS] = np; }
    const int gw = F.bid * NWAVES + F.wave, NGW = F.G * NWAVES;
    const int R = (nrows + NGW - 1) / NGW; const int r0 = gw * R; int r1 = r0 + R; if (r1 > nrows) r1 = nrows;
    int* rr = (int*)(F.ws + WS_ROUTE + RT_R); const int* re = (const int*)(F.ws + WS_ROUTE + RT_E);
    for (int row = r0; row < r1; ++row) {
        const int ee = re[row], e0 = ee & 255, e1 = ee >> 8; int b0 = 0, b1 = 0;
#pragma unroll
        for (int e = 0; e < 8; ++e) { if (e0 == e) b0 = base[e]; if (e1 == e) b1 = base[e]; }
        const int p0 = b0 + rr[2 * row], p1 = b1 + rr[2 * row + 1];
        const v4u* src = (const v4u*)(U + (size_t)row * rowb); v4u* d0 = (v4u*)(AM + (size_t)p0 * rowb); v4u* d1 = (v4u*)(AM + (size_t)p1 * rowb);
        const v4u a = src[F.lane]; d0[F.lane] = a; d1[F.lane] = a;
        if (rowb > 1024) { const v4u c = src[F.lane + 64]; d0[F.lane + 64] = c; d1[F.lane + 64] = c; }
        CFENCE();
        if (F.lane == 0) { rr[2 * row] = p0; rr[2 * row + 1] = p1; }
    }
}

#define MFMA32(a, b, c) __builtin_amdgcn_mfma_f32_32x32x16_bf16((a), (b), (c), 0, 0, 0)
typedef short v4i16_t __attribute__((ext_vector_type(4)));
typedef LAS unsigned char* ldsp;
__device__ __forceinline__ unsigned cvtpk(float lo, float hi) { f32x2_t v = {lo, hi}; bf16x2_t b = __builtin_convertvector(v, bf16x2_t); return __builtin_bit_cast(unsigned, b); }
__device__ __forceinline__ int crow(int reg, int h) { return (reg & 3) + 8 * (reg >> 2) + 4 * h; }
__device__ __forceinline__ bf16x8 pack8(const f32x16& x, int s) {
    v4u p; p.x = cvtpk(x[8 * s], x[8 * s + 1]); p.y = cvtpk(x[8 * s + 2], x[8 * s + 3]); p.z = cvtpk(x[8 * s + 4], x[8 * s + 5]); p.w = cvtpk(x[8 * s + 6], x[8 * s + 7]);
    return __builtin_bit_cast(bf16x8, p);
}
__device__ __forceinline__ bf16x8 lds16(ldsp p) { return *(const LAS bf16x8*)p; }
__device__ __forceinline__ bf16x8 lds8x2(ldsp p) { const s16x4 lo = *(const LAS s16x4*)p, hi = *(const LAS s16x4*)(p + 16); return __builtin_shufflevector(lo, hi, 0, 1, 2, 3, 4, 5, 6, 7); }
__device__ __forceinline__ s16x4 tr16(ldsp p) { return __builtin_bit_cast(s16x4, __builtin_amdgcn_ds_read_tr16_b64_v4i16((LAS v4i16_t*)p)); }
__device__ __forceinline__ bf16x8 ldstr2(ldsp p, int second) { const s16x4 lo = tr16(p), hi = tr16(p + second); return __builtin_shufflevector(lo, hi, 0, 1, 2, 3, 4, 5, 6, 7); }
__device__ __forceinline__ f32x16 zero16() { f32x16 z;
#pragma unroll
    for (int i = 0; i < 16; ++i) z[i] = 0.f; return z; }
__device__ __forceinline__ void unpack8(const v4u& w, float (&x)[8]) { x[0] = bflo(w.x); x[1] = bfhi(w.x); x[2] = bflo(w.y); x[3] = bfhi(w.y); x[4] = bflo(w.z); x[5] = bfhi(w.z); x[6] = bflo(w.w); x[7] = bfhi(w.w); }
__device__ __forceinline__ int launder_v(int x) { asm volatile("" : "+v"(x)); return x; }
struct FragOff { int o_row, o_perm, o_trn, o_trp; };
__device__ __forceinline__ FragOff frag_off(int lane, int LD) {
    const int r = lane & 31, hh = lane >> 5, i16 = lane & 15, q = i16 >> 2, p = i16 & 3, blk = (lane >> 4) & 1; FragOff f;
    f.o_row = (r * LD + 8 * hh) * 2; f.o_perm = (r * LD + 4 * hh) * 2;
    f.o_trn = ((8 * hh + q) * LD + 16 * blk + 4 * p) * 2; f.o_trp = ((4 * hh + q) * LD + 16 * blk + 4 * p) * 2; return f;
}


template <int CTRL, int RM, int BM> __device__ __forceinline__ float dpp_f(float old, float x) {
    return __builtin_bit_cast(float, __builtin_amdgcn_update_dpp(__builtin_bit_cast(int, old), __builtin_bit_cast(int, x), CTRL, RM, BM, false)); }
__device__ __forceinline__ float wave_scan_add(float x) {
    float r = x;
    r += dpp_f<0x111, 0xf, 0xf>(0.f, x); r += dpp_f<0x112, 0xf, 0xf>(0.f, x); r += dpp_f<0x113, 0xf, 0xf>(0.f, x);
    r += dpp_f<0x114, 0xf, 0xe>(0.f, r); r += dpp_f<0x118, 0xf, 0xc>(0.f, r);
    r += dpp_f<0x142, 0xa, 0xf>(0.f, r); r += dpp_f<0x143, 0xc, 0xf>(0.f, r);
    return r;
}
__device__ __forceinline__ float wave_scan_max(float x) {
    const float NEG = -3.0e38f; float r = x;
    r = fmaxf(r, dpp_f<0x111, 0xf, 0xf>(NEG, x)); r = fmaxf(r, dpp_f<0x112, 0xf, 0xf>(NEG, x)); r = fmaxf(r, dpp_f<0x113, 0xf, 0xf>(NEG, x));
    r = fmaxf(r, dpp_f<0x114, 0xf, 0xe>(NEG, r)); r = fmaxf(r, dpp_f<0x118, 0xf, 0xc>(NEG, r));
    r = fmaxf(r, dpp_f<0x142, 0xa, 0xf>(NEG, r)); r = fmaxf(r, dpp_f<0x143, 0xc, 0xf>(NEG, r));
    return r;
}
__device__ __forceinline__ float lane63(float x) { return __builtin_bit_cast(float, __builtin_amdgcn_readlane(__builtin_bit_cast(int, x), 63)); }
__device__ __forceinline__ float sum_halves(float x) {
    const unsigned u = __builtin_bit_cast(unsigned, x); auto rr = __builtin_amdgcn_permlane32_swap(u, u, false, false);
    return __builtin_bit_cast(float, (unsigned)rr[0]) + __builtin_bit_cast(float, (unsigned)rr[1]); }

constexpr int ML_LDQ = 72, ML_LDV = 136;
constexpr int ML_QC = 0, ML_KC = 9216, ML_KH = 18432, ML_V = 27648, ML_GS = 45056, ML_OB = 50176, ML_NV = 68608, ML_SSQ = 70656, ML_INV = 71680, ML_GROUP = 73728;
static_assert(2 * ML_GROUP <= LDS_MAIN, "mLSTM LDS map");
constexpr int ML_STATE_F = 8448;

struct MlPref { v4u q[2], k[2], v[4]; float gi, gf; };
struct MlSeg { int rowbase; int len; int t0; int nchunk; };

__device__ __forceinline__ void ml_issue(MlPref& P, const bf16* proj, const bf16* qkc, const float* gates, int rowbase, int t0c, int g, int h, int tg, int lane, bool need_q) {
    const int c8q = tg & 7;
#pragma unroll
    for (int i = 0; i < 2; ++i) { const int tau = (tg + 256 * i) >> 3; const int t = t0c + (g ? 63 - tau : tau);
        const bf16* rp = qkc + (size_t)(rowbase + t) * D + h * 64 + c8q * 8;
        P.q[i] = need_q ? *(const GAS v4u*)rp : (v4u){0u, 0u, 0u, 0u}; P.k[i] = *(const GAS v4u*)(rp + 512); }
#pragma unroll
    for (int i = 0; i < 4; ++i) { const int p = tg + 256 * i, tau = p >> 4, c8 = p & 15; const int t = t0c + (g ? 63 - tau : tau);
        P.v[i] = *(const GAS v4u*)(proj + (size_t)(rowbase + t) * NP_M + 1024 + h * 128 + c8 * 8); }
    { const int t = t0c + (g ? 63 - lane : lane); const GAS float* gp = (const GAS float*)(gates + (size_t)(rowbase + t) * 32 + g * 16 + h); P.gi = gp[0]; P.gf = gp[8]; }
}

template <bool OUTPUT>
__device__ __forceinline__ void mlstm_item(Frame& F, const bf16* proj, const bf16* qkc, const float* gates, bf16* hx0, bf16* hx1,
                                           int h, MlSeg S0, MlSeg S1, const float* st_in0, const float* st_in1, int npre0, int npre1, float* st_out0, float* st_out1) {
    const int tid_l = launder_v(F.tid); const int wave_l = __builtin_amdgcn_readfirstlane(tid_l >> 6);
    const int g = wave_l >> 2, j = wave_l & 3, tg = tid_l & 255, lane = tid_l & 63, r = lane & 31, hh = lane >> 5;
    const ldsp gb = F.lds + g * ML_GROUP;
    const ldsp GSb = gb + ML_GS + j * 1280;
    LAS float* GS = (LAS float*)GSb;
    const ldsp OBb = gb + ML_OB + j * 4608;
    LAS float* NV = (LAS float*)(gb + ML_NV);
    LAS float* SSQ = (LAS float*)(gb + ML_SSQ);
    const ldsp INVb = gb + ML_INV + j * 256;
    const int rowbase = g ? S1.rowbase : S0.rowbase, seg_t0 = g ? S1.t0 : S0.t0, nch = g ? S1.nchunk : S0.nchunk;
    const int vcol = 64 * j;
    __syncthreads();
    f32x16 C[2]; C[0] = zero16(); C[1] = zero16();
    float m_prev = -1.0e30f, btot = 0.f;
    float nreg = 0.f;
    if (OUTPUT) {
        const float* sp = g ? st_in1 : st_in0; const int np = g ? npre1 : npre0;
#pragma unroll 1
        for (int k = 0; k < np; ++k) { const float* e = sp + (size_t)k * ML_STATE_F;
            const float mloc = e[8192 + 64], B = e[8192 + 65];
            const float mnew = fmaxf(B + m_prev, mloc), al = __expf(B + m_prev - mnew), be = __expf(mloc - mnew);
            const float* ep = e + (4 * hh) * 128 + 32 * j + r;
#pragma unroll
            for (int dt = 0; dt < 2; ++dt)
#pragma unroll
                for (int i = 0; i < 16; ++i) C[dt][i] = al * C[dt][i] + be * ep[(32 * dt + (i & 3) + 8 * (i >> 2)) * 128];
            nreg = al * nreg + be * e[8192 + 16 * j + (lane & 15)];
            m_prev = mnew; }
    }
    if (lane < 16) NV[16 * j + lane] = nreg;
    MlPref PP[2]; ml_issue(PP[0], proj, qkc, gates, rowbase, seg_t0 + 64 * (g ? nch - 1 : 0), g, h, tg, lane, OUTPUT);
    ml_issue(PP[1], proj, qkc, gates, rowbase, seg_t0 + 64 * (g ? nch - 2 : 1), g, h, tg, lane, OUTPUT);
    __syncthreads();
#pragma unroll 1
    for (int step2 = 0; step2 < nch; step2 += 2) {
#pragma unroll
    for (int hf = 0; hf < 2; ++hf) { const int step = step2 + hf; MlPref& P = PP[hf];
        const int tgs = launder_v(tg), lns = launder_v(lane);
        const int r = lns & 31, hh = lns >> 5;
        const FragOff fq = frag_off(lns, ML_LDQ), fv = frag_off(lns, ML_LDV);
        const int o_h4 = 16 * hh;
        const int o_obw = (4 * hh * 36 + r) * 4, o_obr = ((lns >> 1) * 36 + 16 * (lns & 1)) * 4;
        const int ci = g ? nch - 1 - step : step;
        const int par = step & 1;
        float decay;
        {
            const float xi = P.gi, lf = P.gf;
            const float bc = wave_scan_add(lf);
            const float a = xi - bc; const float pm = wave_scan_max(a);
            const float Mt = fmaxf(m_prev, pm);
            const float Ml = lane63(Mt), bl = lane63(bc);
            GS[lns] = a; GS[64 + lns] = Mt; GS[128 + lns] = __expf(m_prev - Mt); GS[192 + lns] = __expf(-(bc + Mt)); GS[256 + lns] = __expf(a - Ml);
            decay = __expf(m_prev - Ml); m_prev = bl + Ml; btot += bl;
        }
        LDS_WAIT(); CFENCE();
        {
            const int c8 = tgs & 7;
#pragma unroll
            for (int i = 0; i < 2; ++i) { const int tau = (tgs + 256 * i) >> 3; const ldsp tp = gb + (tau * ML_LDQ + c8 * 8) * 2;
                if (OUTPUT) { *(LAS v4u*)(tp + ML_QC) = P.q[i]; *(LAS v4u*)(tp + ML_KC) = P.k[i]; }
                float o[8]; unpack8(P.k[i], o); const float wkk = GS[256 + tau]; v4u w;
                w.x = pk2(o[0] * wkk, o[1] * wkk); w.y = pk2(o[2] * wkk, o[3] * wkk); w.z = pk2(o[4] * wkk, o[5] * wkk); w.w = pk2(o[6] * wkk, o[7] * wkk);
                *(LAS v4u*)(tp + ML_KH) = w; }
#pragma unroll
            for (int i = 0; i < 4; ++i) { const int p = tgs + 256 * i, tau = p >> 4, cc = p & 15; *(LAS v4u*)(gb + ML_V + (tau * ML_LDV + cc * 8) * 2) = P.v[i]; }
        }
        if (step + 2 < nch) ml_issue(P, proj, qkc, gates, rowbase, seg_t0 + 64 * (g ? nch - 3 - step : step + 2), g, h, tgs, lns, OUTPUT);
        __syncthreads();
        if (OUTPUT) {
            bf16* hx = g ? hx1 : hx0;
#pragma unroll
            for (int tt = 0; tt < 2; ++tt) {
                f32x16 acc = zero16();
#pragma unroll
                for (int dt = 0; dt < 2; ++dt)
#pragma unroll
                    for (int sp = 0; sp < 2; ++sp) acc = MFMA32(lds8x2(gb + ML_QC + fq.o_perm + (32 * tt * ML_LDQ + 32 * dt + 16 * sp) * 2), pack8(C[dt], sp), acc);
#pragma unroll
                for (int q4 = 0; q4 < 4; ++q4) { const f32x4 wv = *(const LAS f32x4*)(GSb + o_h4 + (128 + 32 * tt + 8 * q4) * 4);
#pragma unroll
                    for (int e = 0; e < 4; ++e) acc[4 * q4 + e] *= wv[e]; }
                const float Mt = GS[64 + 32 * tt + r];
                float den = 0.f;
#pragma unroll
                for (int st = 0; st <= tt; ++st) {
                    f32x16 s = zero16();
#pragma unroll
                    for (int ks = 0; ks < 4; ++ks) s = MFMA32(lds16(gb + ML_KC + fq.o_row + (32 * st * ML_LDQ + 16 * ks) * 2), lds16(gb + ML_QC + fq.o_row + (32 * tt * ML_LDQ + 16 * ks) * 2), s);
#pragma unroll
                    for (int q4 = 0; q4 < 4; ++q4) { const f32x4 av = *(const LAS f32x4*)(GSb + o_h4 + (32 * st + 8 * q4) * 4);
#pragma unroll
                        for (int e = 0; e < 4; ++e) { const int i = 4 * q4 + e; const int srow = 32 * st + crow(i, hh); const float pv = (srow <= 32 * tt + r) ? s[i] * __expf(av[e] - Mt) : 0.f; s[i] = pv; den += pv; } }
                    const bf16x8 pa0 = pack8(s, 0), pa1 = pack8(s, 1);
                    acc = MFMA32(pa0, ldstr2(gb + ML_V + fv.o_trp + vcol + ((32 * st) * ML_LDV) * 2, 8 * ML_LDV * 2), acc);
                    acc = MFMA32(pa1, ldstr2(gb + ML_V + fv.o_trp + vcol + ((32 * st + 16) * ML_LDV) * 2, 8 * ML_LDV * 2), acc);
                    }
                float qn;
                { float q0 = 0.f, q1 = 0.f, q2 = 0.f, q3 = 0.f;
#pragma unroll
                for (int c4 = 0; c4 < 4; ++c4) { const v4u qw = *(const LAS v4u*)(gb + ML_QC + (r * ML_LDQ + 32 * hh) * 2 + (32 * tt * ML_LDQ + 8 * c4) * 2); float qx[8]; unpack8(qw, qx);
                    const f32x4 n0 = *(const LAS f32x4*)(gb + ML_NV + 8 * o_h4 + (par * 64 + 8 * c4) * 4), n1 = *(const LAS f32x4*)(gb + ML_NV + 8 * o_h4 + (par * 64 + 8 * c4 + 4) * 4);
                    q0 += qx[0] * n0[0] + qx[4] * n1[0]; q1 += qx[1] * n0[1] + qx[5] * n1[1]; q2 += qx[2] * n0[2] + qx[6] * n1[2]; q3 += qx[3] * n0[3] + qx[7] * n1[3]; }
                qn = (q0 + q1) + (q2 + q3); }
                den = sum_halves(den); qn = sum_halves(qn);
                const float dtot = den + GS[128 + 32 * tt + r] * qn;
                const float inv = __builtin_amdgcn_rcpf(fmaxf(fabsf(dtot), GS[192 + 32 * tt + r]));
                if (hh == 0) *(LAS float*)(INVb + (32 * tt + r) * 4) = inv;
                LDS_WAIT(); CFENCE();
                f32x16 hv;
#pragma unroll
                for (int q4 = 0; q4 < 4; ++q4) { const f32x4 iv = *(const LAS f32x4*)(INVb + o_h4 + (32 * tt + 8 * q4) * 4);
#pragma unroll
                    for (int e = 0; e < 4; ++e) { const int i = 4 * q4 + e; hv[i] = acc[i] * iv[e]; } }
#pragma unroll
                for (int i = 0; i < 16; ++i) *(LAS float*)(OBb + o_obw + ((i & 3) + 8 * (i >> 2)) * 144) = hv[i];
                LDS_WAIT(); CFENCE();
                { const f32x4 x0 = *(const LAS f32x4*)(OBb + o_obr), x1 = *(const LAS f32x4*)(OBb + o_obr + 16), x2 = *(const LAS f32x4*)(OBb + o_obr + 32), x3 = *(const LAS f32x4*)(OBb + o_obr + 48);
                    const int tau = 32 * tt + (lns >> 1); const int t = seg_t0 + 64 * ci + (g ? 63 - tau : tau);
                    bf16* op = hx + (size_t)(rowbase + t) * D + h * 128 + 32 * j + 16 * (lns & 1);
                    v4u w0, w1; w0.x = pk2(x0[0], x0[1]); w0.y = pk2(x0[2], x0[3]); w0.z = pk2(x1[0], x1[1]); w0.w = pk2(x1[2], x1[3]); w1.x = pk2(x2[0], x2[1]); w1.y = pk2(x2[2], x2[3]); w1.z = pk2(x3[0], x3[1]); w1.w = pk2(x3[2], x3[3]);
                    *(GAS v4u*)op = w0; *(GAS v4u*)(op + 8) = w1; }
                LDS_WAIT(); CFENCE();
            }
        }
        __builtin_amdgcn_sched_barrier(0);
#pragma unroll
        for (int dt = 0; dt < 2; ++dt) {
#pragma unroll
            for (int i = 0; i < 16; ++i) C[dt][i] *= decay;
#pragma unroll
            for (int ks = 0; ks < 4; ++ks) C[dt] = MFMA32(ldstr2(gb + ML_KH + fq.o_trn + (16 * ks * ML_LDQ + 32 * dt) * 2, 4 * ML_LDQ * 2), ldstr2(gb + ML_V + fv.o_trn + vcol + (16 * ks * ML_LDV) * 2, 4 * ML_LDV * 2), C[dt]);
        }
        {   const int dkl = 16 * j + (lns & 15), tq = lns >> 4; float s0 = 0.f, s1 = 0.f;
#pragma unroll
            for (int i = 0; i < 16; i += 2) { s0 += bf2f(*(const LAS bf16*)(gb + ML_KH + ((16 * tq + i) * ML_LDQ + dkl) * 2)); s1 += bf2f(*(const LAS bf16*)(gb + ML_KH + ((16 * tq + i + 1) * ML_LDQ + dkl) * 2)); }
            float sacc = s0 + s1; sacc += __shfl_xor(sacc, 16); sacc = sum_halves(sacc);
            nreg = decay * nreg + sacc; if (lns < 16) NV[(par ^ 1) * 64 + dkl] = nreg; }
        __syncthreads();
    } }
    if (!OUTPUT) {
        float* e = g ? st_out1 : st_out0; float* ep = e + (4 * hh) * 128 + 32 * j + r;
#pragma unroll
        for (int dt = 0; dt < 2; ++dt)
#pragma unroll
            for (int i = 0; i < 16; ++i) ep[(32 * dt + (i & 3) + 8 * (i >> 2)) * 128] = C[dt][i];
        if (lane < 16) e[8192 + 16 * j + lane] = nreg;
        if (j == 0 && lane == 0) { e[8192 + 64] = m_prev; e[8192 + 65] = btot; }
    }
}

constexpr int HG_LD = 136;
constexpr int HG_LF = 0, HG_QT = 16384, HG_KT = 25088, HG_KH = 33792, HG_V = 42496, HG_OB = 51200, HG_AUX = 69632, HG_SSQ = 71168, HG_EAM = 71680, HG_BIAS = 72192, HG_LBV = 72704, HG_GROUP = 73728;
static_assert(2 * HG_GROUP <= LDS_MAIN, "HGRN2 LDS map");
constexpr int HG_STATE_F = 16512;

struct HgPref { v4u q[2], f[2], v[2]; };
__device__ __forceinline__ void hg_issue(HgPref& P, const bf16* proj, int rowbase, int t0c, int g, int h, int tg, bool need_q) {
#pragma unroll
    for (int i = 0; i < 2; ++i) { const int p = tg + 256 * i, tau = p >> 4, c8 = p & 15; const int t = t0c + (g ? 31 - tau : tau);
        const bf16* rp = proj + (size_t)(rowbase + t) * NP_H + h * 128 + c8 * 8;
        P.q[i] = need_q ? *(const GAS v4u*)rp : (v4u){0u, 0u, 0u, 0u}; P.v[i] = *(const GAS v4u*)(rp + 1024); P.f[i] = *(const GAS v4u*)(rp + 2048 + 1024 * g); }
}
__device__ __forceinline__ float clamp80(float x) { return fminf(fmaxf(x, -80.f), 80.f); }

template <bool OUTPUT>
__device__ __forceinline__ void hgrn_item(Frame& F, const bf16* proj, bf16* hx0, bf16* hx1, const float* bf_, const float* lbraw, int jl,
                                          int h, MlSeg S0, MlSeg S1, const float* st_in0, const float* st_in1, int npre0, int npre1, float* st_out0, float* st_out1) {
    const int tid_l = launder_v(F.tid); const int wave_l = __builtin_amdgcn_readfirstlane(tid_l >> 6);
    const int g = wave_l >> 2, j = wave_l & 3, tg = tid_l & 255, lane = tid_l & 63, r = lane & 31, hh = lane >> 5;
    const ldsp gb = F.lds + g * HG_GROUP;
    LAS float* LF = (LAS float*)(gb + HG_LF);
    const ldsp OBb = gb + HG_OB + j * 4608;
    LAS float* AMID = (LAS float*)(gb + HG_AUX); LAS float* ALAST = AMID + 128; LAS float* DEC = AMID + 256;
    LAS float* SSQ = (LAS float*)(gb + HG_SSQ); LAS float* EAM = (LAS float*)(gb + HG_EAM); LAS float* BIASV = (LAS float*)(gb + HG_BIAS); LAS float* LBV = (LAS float*)(gb + HG_LBV);
    const int rowbase = g ? S1.rowbase : S0.rowbase, seg_t0 = g ? S1.t0 : S0.t0, nch = g ? S1.nchunk : S0.nchunk;
    const int vcol = 64 * j;
    __syncthreads();
    if (tg < 128) { const int c = h * 128 + tg; BIASV[tg] = bf_[g * 1024 + c]; LBV[tg] = jl == 0 ? 0.f : sigmoidf_(lbraw[(1 * 2 + g) * 1024 + c] - lbraw[(0 * 2 + g) * 1024 + c]); }
    f32x16 St[4];
#pragma unroll
    for (int dt = 0; dt < 4; ++dt) St[dt] = zero16();
    float atot = 0.f;
    if (OUTPUT) {   const float* sp = g ? st_in1 : st_in0; const int np = g ? npre1 : npre0;
#pragma unroll 1
        for (int k = 0; k < np; ++k) { const float* e = sp + (size_t)k * HG_STATE_F; const float* ep = e + (4 * hh) * 128 + 32 * j + r; const float* ap = e + 16384 + 4 * hh;
#pragma unroll
            for (int dt = 0; dt < 4; ++dt)
#pragma unroll
                for (int i = 0; i < 16; ++i) { const int dk0 = 32 * dt + (i & 3) + 8 * (i >> 2); St[dt][i] = __expf(ap[dk0]) * St[dt][i] + ep[dk0 * 128]; } }
    }
    HgPref PP[2]; hg_issue(PP[0], proj, rowbase, seg_t0 + 32 * (g ? nch - 1 : 0), g, h, tg, OUTPUT);
    hg_issue(PP[1], proj, rowbase, seg_t0 + 32 * (g ? nch - 2 : 1), g, h, tg, OUTPUT);
    __syncthreads();
#pragma unroll 1
    for (int step2 = 0; step2 < nch; step2 += 2) {
#pragma unroll
    for (int hf = 0; hf < 2; ++hf) { const int step = step2 + hf; HgPref& P = PP[hf];
        const int tgs = launder_v(tg), lns = launder_v(lane);
        const int r = lns & 31, hh = lns >> 5;
        const FragOff fo = frag_off(lns, HG_LD);
        const int o_h4 = 16 * hh;
        const int o_obw = (4 * hh * 36 + r) * 4, o_obr = ((lns >> 1) * 36 + 16 * (lns & 1)) * 4;
        const int c8 = tgs & 15;
        const int o_piece = (((tgs >> 4) * HG_LD) + c8 * 8) * 2;
        const int ci = g ? nch - 1 - step : step;
#pragma unroll
        for (int i = 0; i < 2; ++i) { const int tau = (tgs + 256 * i) >> 4; float x[8], lf[8], kk[8]; unpack8(P.f[i], x);
            const f32x4 b0 = *(const LAS f32x4*)(BIASV + c8 * 8), b1 = *(const LAS f32x4*)(BIASV + c8 * 8 + 4), l0 = *(const LAS f32x4*)(LBV + c8 * 8), l1 = *(const LAS f32x4*)(LBV + c8 * 8 + 4);
            const float bb[8] = {b0[0], b0[1], b0[2], b0[3], b1[0], b1[1], b1[2], b1[3]}, ll[8] = {l0[0], l0[1], l0[2], l0[3], l1[0], l1[1], l1[2], l1[3]};
#pragma unroll
            for (int e = 0; e < 8; ++e) { const float sg = sigmoidf_(x[e] + bb[e]); const float f = ll[e] + (1.f - ll[e]) * sg; lf[e] = __logf(fmaxf(f, 1e-37f)); kk[e] = 1.f - f; }
            *(LAS f32x4*)(LF + tau * 128 + c8 * 8) = (f32x4){lf[0], lf[1], lf[2], lf[3]}; *(LAS f32x4*)(LF + tau * 128 + c8 * 8 + 4) = (f32x4){lf[4], lf[5], lf[6], lf[7]};
            v4u w; w.x = pk2(kk[0], kk[1]); w.y = pk2(kk[2], kk[3]); w.z = pk2(kk[4], kk[5]); w.w = pk2(kk[6], kk[7]);
            const ldsp tp = gb + o_piece + i * (16 * HG_LD * 2);
            *(LAS v4u*)(tp + HG_KT) = w;
            if (OUTPUT) *(LAS v4u*)(tp + HG_QT) = P.q[i];
            *(LAS v4u*)(tp + HG_V) = P.v[i]; }
        if (step + 2 < nch) hg_issue(P, proj, rowbase, seg_t0 + 32 * (g ? nch - 3 - step : step + 2), g, h, tgs, OUTPUT);
        __syncthreads();
        {   const int dkc = tgs & 127, half = tgs >> 7; float pre = 0.f;
            if (half) { float p0 = 0.f, p1 = 0.f, p2 = 0.f, p3 = 0.f;
#pragma unroll
                for (int tau = 0; tau < 16; tau += 4) { p0 += LF[tau * 128 + dkc]; p1 += LF[(tau + 1) * 128 + dkc]; p2 += LF[(tau + 2) * 128 + dkc]; p3 += LF[(tau + 3) * 128 + dkc]; }
                pre = (p0 + p1) + (p2 + p3); }
            float v[16];
#pragma unroll
            for (int i = 0; i < 16; ++i) v[i] = LF[(16 * half + i) * 128 + dkc];
            LDS_WAIT(); __builtin_amdgcn_s_barrier(); CFENCE();
            float run = pre;
#pragma unroll
            for (int i = 0; i < 16; ++i) { run += v[i]; LF[(16 * half + i) * 128 + dkc] = run; }
            if (!half) { AMID[dkc] = run; EAM[dkc] = __expf(run); } else { ALAST[dkc] = run; DEC[dkc] = __expf(run); atot += run; } }
        __syncthreads();
#pragma unroll
        for (int i = 0; i < 2; ++i) { const int tau = (tgs + 256 * i) >> 4; const ldsp tp = gb + o_piece + i * (16 * HG_LD * 2);
            const f32x4 a0 = *(const LAS f32x4*)(LF + tau * 128 + c8 * 8), a1 = *(const LAS f32x4*)(LF + tau * 128 + c8 * 8 + 4);
            const f32x4 m0 = *(const LAS f32x4*)(AMID + c8 * 8), m1 = *(const LAS f32x4*)(AMID + c8 * 8 + 4), l0 = *(const LAS f32x4*)(ALAST + c8 * 8), l1 = *(const LAS f32x4*)(ALAST + c8 * 8 + 4);
            float a[8] = {a0[0], a0[1], a0[2], a0[3], a1[0], a1[1], a1[2], a1[3]}, am[8] = {m0[0], m0[1], m0[2], m0[3], m1[0], m1[1], m1[2], m1[3]}, al[8] = {l0[0], l0[1], l0[2], l0[3], l1[0], l1[1], l1[2], l1[3]};
            float qx[8], kx[8], qo[8], ko[8], ho[8]; { const v4u kw = *(const LAS v4u*)(tp + HG_KT); unpack8(kw, kx); if (OUTPUT) { const v4u qw = *(const LAS v4u*)(tp + HG_QT); unpack8(qw, qx); } }
#pragma unroll
            for (int e = 0; e < 8; ++e) { if (OUTPUT) { qo[e] = qx[e] * __expf(clamp80(a[e] - am[e])); ko[e] = kx[e] * __expf(clamp80(am[e] - a[e])); } ho[e] = kx[e] * __expf(al[e] - a[e]); }
            v4u w;
            if (OUTPUT) { w.x = pk2(qo[0], qo[1]); w.y = pk2(qo[2], qo[3]); w.z = pk2(qo[4], qo[5]); w.w = pk2(qo[6], qo[7]); *(LAS v4u*)(tp + HG_QT) = w;
                w.x = pk2(ko[0], ko[1]); w.y = pk2(ko[2], ko[3]); w.z = pk2(ko[4], ko[5]); w.w = pk2(ko[6], ko[7]); *(LAS v4u*)(tp + HG_KT) = w; }
            w.x = pk2(ho[0], ho[1]); w.y = pk2(ho[2], ho[3]); w.z = pk2(ho[4], ho[5]); w.w = pk2(ho[6], ho[7]); *(LAS v4u*)(tp + HG_KH) = w; }
        __syncthreads();
        if (OUTPUT) {
            bf16* hx = g ? hx1 : hx0;
            f32x16 s = zero16();
#pragma unroll
            for (int ks = 0; ks < 8; ++ks) s = MFMA32(lds16(gb + HG_KT + fo.o_row + 32 * ks), lds16(gb + HG_QT + fo.o_row + 32 * ks), s);
#pragma unroll
            for (int i = 0; i < 16; ++i) s[i] = (crow(i, hh) <= r) ? s[i] : 0.f;
            f32x16 o = zero16();
#pragma unroll
            for (int sp = 0; sp < 2; ++sp) o = MFMA32(pack8(s, sp), ldstr2(gb + HG_V + fo.o_trp + vcol + (16 * sp * HG_LD) * 2, 8 * HG_LD * 2), o);
#pragma unroll
            for (int dt = 0; dt < 4; ++dt)
#pragma unroll
                for (int sp = 0; sp < 2; ++sp) { const f32x4 e0 = *(const LAS f32x4*)(gb + HG_EAM + o_h4 + (32 * dt + 16 * sp) * 4), e1 = *(const LAS f32x4*)(gb + HG_EAM + o_h4 + (32 * dt + 16 * sp + 8) * 4);
                    v4u pw; pw.x = cvtpk(St[dt][8 * sp] * e0[0], St[dt][8 * sp + 1] * e0[1]); pw.y = cvtpk(St[dt][8 * sp + 2] * e0[2], St[dt][8 * sp + 3] * e0[3]);
                    pw.z = cvtpk(St[dt][8 * sp + 4] * e1[0], St[dt][8 * sp + 5] * e1[1]); pw.w = cvtpk(St[dt][8 * sp + 6] * e1[2], St[dt][8 * sp + 7] * e1[3]);
                    o = MFMA32(lds8x2(gb + HG_QT + fo.o_perm + (32 * dt + 16 * sp) * 2), __builtin_bit_cast(bf16x8, pw), o); }
#pragma unroll
            for (int i = 0; i < 16; ++i) *(LAS float*)(OBb + o_obw + ((i & 3) + 8 * (i >> 2)) * 144) = o[i];
            LDS_WAIT(); CFENCE();
            { const f32x4 x0 = *(const LAS f32x4*)(OBb + o_obr), x1 = *(const LAS f32x4*)(OBb + o_obr + 16), x2 = *(const LAS f32x4*)(OBb + o_obr + 32), x3 = *(const LAS f32x4*)(OBb + o_obr + 48);
                const int tau = lns >> 1; const int t = seg_t0 + 32 * ci + (g ? 31 - tau : tau);
                bf16* op = hx + (size_t)(rowbase + t) * D + h * 128 + 32 * j + 16 * (lns & 1);
                v4u w0, w1; w0.x = pk2(x0[0], x0[1]); w0.y = pk2(x0[2], x0[3]); w0.z = pk2(x1[0], x1[1]); w0.w = pk2(x1[2], x1[3]); w1.x = pk2(x2[0], x2[1]); w1.y = pk2(x2[2], x2[3]); w1.z = pk2(x3[0], x3[1]); w1.w = pk2(x3[2], x3[3]);
                *(GAS v4u*)op = w0; *(GAS v4u*)(op + 8) = w1; }
            LDS_WAIT(); CFENCE();
        }
#pragma unroll
        for (int dt = 0; dt < 4; ++dt) {
#pragma unroll
            for (int q4 = 0; q4 < 4; ++q4) { const f32x4 dv = *(const LAS f32x4*)(gb + HG_AUX + 1024 + o_h4 + (32 * dt + 8 * q4) * 4);
#pragma unroll
                for (int e = 0; e < 4; ++e) St[dt][4 * q4 + e] *= dv[e]; }
#pragma unroll
            for (int sp = 0; sp < 2; ++sp) St[dt] = MFMA32(ldstr2(gb + HG_KH + fo.o_trn + (16 * sp * HG_LD + 32 * dt) * 2, 4 * HG_LD * 2), ldstr2(gb + HG_V + fo.o_trn + vcol + (16 * sp * HG_LD) * 2, 4 * HG_LD * 2), St[dt]);
        }
        __syncthreads();
    } }
    if (!OUTPUT) {
        float* e = g ? st_out1 : st_out0; float* ep = e + (4 * hh) * 128 + 32 * j + r;
#pragma unroll
        for (int dt = 0; dt < 4; ++dt)
#pragma unroll
            for (int i = 0; i < 16; ++i) ep[(32 * dt + (i & 3) + 8 * (i >> 2)) * 128] = St[dt][i];
        if (tg >= 128) e[16384 + (tg & 127)] = atot;
    }
}

constexpr int PH_PER_LAYER = 11, PH_BASE = 2, N_PHASES = PH_BASE + DEPTH * PH_PER_LAYER;
#ifndef EN_GEMM
#define EN_GEMM 0xff
#endif
#ifndef EN_ML
#define EN_ML 3
#endif
#ifndef EN_HG
#define EN_HG 3
#endif
#ifndef EN_TOK
#define EN_TOK 1
#endif
#ifndef EN_MISC
#define EN_MISC 1
#endif
#ifndef PG_SP2
#define PG_SP2 true
#endif
#ifndef PG_ALIGN
#define PG_ALIGN true
#endif
#ifndef TIMER_MASK
#define TIMER_MASK 0ull
#endif
#ifndef TIMER_DIV
#define TIMER_DIV 20.0f
#endif
#ifndef MK_SPLIT
#define MK_SPLIT 0
#endif


__device__ __forceinline__ void phase_headnorm(Frame& F, const bf16* hf, const bf16* hb, const bf16* gate, int gpitch, int gcol0, const float* ghead, bf16* aout, int nrows) {
    const int tid = launder_v(F.tid); const int lane = tid & 63, wave = __builtin_amdgcn_readfirstlane(tid >> 6);
    const int gw = F.bid * NWAVES + wave, NGW = F.G * NWAVES;
    float gh[16];
#pragma unroll
    for (int e = 0; e < 16; ++e) gh[e] = ghead[lane * 16 + e];
    for (int row = gw; row < nrows; row += NGW) {
        const v4u a0 = *(const v4u*)(hf + (size_t)row * D + lane * 16), a1 = *(const v4u*)(hf + (size_t)row * D + lane * 16 + 8);
        const v4u b0 = *(const v4u*)(hb + (size_t)row * D + lane * 16), b1 = *(const v4u*)(hb + (size_t)row * D + lane * 16 + 8);
        const v4u g0 = *(const v4u*)(gate + (size_t)row * gpitch + gcol0 + lane * 16), g1 = *(const v4u*)(gate + (size_t)row * gpitch + gcol0 + lane * 16 + 8);
        float x[16], y[8], o[16]; unpack8(a0, y);
#pragma unroll
        for (int e = 0; e < 8; ++e) x[e] = y[e];
        unpack8(a1, y);
#pragma unroll
        for (int e = 0; e < 8; ++e) x[8 + e] = y[e];
        unpack8(b0, y);
#pragma unroll
        for (int e = 0; e < 8; ++e) x[e] += y[e];
        unpack8(b1, y);
#pragma unroll
        for (int e = 0; e < 8; ++e) x[8 + e] += y[e];
        float ss = 0.f;
#pragma unroll
        for (int e = 0; e < 16; ++e) ss += x[e] * x[e];
        ss += __shfl_xor(ss, 1); ss += __shfl_xor(ss, 2); ss += __shfl_xor(ss, 4);
        const float rs = rsqrtf(ss * (1.f / 128.f) + EPS);
        unpack8(g0, y);
#pragma unroll
        for (int e = 0; e < 8; ++e) o[e] = x[e] * rs * gh[e] * sigmoidf_(y[e]);
        unpack8(g1, y);
#pragma unroll
        for (int e = 0; e < 8; ++e) o[8 + e] = x[8 + e] * rs * gh[8 + e] * sigmoidf_(y[e]);
        v4u w0, w1; w0.x = pk2(o[0], o[1]); w0.y = pk2(o[2], o[3]); w0.z = pk2(o[4], o[5]); w0.w = pk2(o[6], o[7]); w1.x = pk2(o[8], o[9]); w1.y = pk2(o[10], o[11]); w1.z = pk2(o[12], o[13]); w1.w = pk2(o[14], o[15]);
        *(v4u*)(aout + (size_t)row * D + lane * 16) = w0; *(v4u*)(aout + (size_t)row * D + lane * 16 + 8) = w1;
    }
}

__device__ __forceinline__ void phase_conv(Frame& F, const bf16* proj, bf16* qkc, float* gates, const float* wconv, const float* bgate) {
    const int gt = F.bid * NTHR + F.tid, cp = gt & 127, rstep = (F.G * NTHR) >> 7;
    float w[3][8];
#pragma unroll
    for (int d = 0; d < 3; ++d)
#pragma unroll
        for (int e = 0; e < 8; ++e) w[d][e] = wconv[d * 1024 + cp * 8 + e];
    const float sc = cp >= 64 ? 0.125f : 1.0f;
    for (int row = gt >> 7; row < M_ALL; row += rstep) {
        int t, len; if (row < M_LAT) { t = row & (SEQ - 1); len = SEQ; } else { t = (row - M_LAT) & (CTXL - 1); len = CTXL; }
        const bf16* rp = proj + (size_t)row * NP_M + cp * 8;
        const v4u z = (v4u){0u, 0u, 0u, 0u};
        const v4u r0 = t > 0 ? *(const v4u*)(rp - NP_M) : z, r1 = *(const v4u*)rp, r2 = t + 1 < len ? *(const v4u*)(rp + NP_M) : z;
        float x0[8], x1[8], x2[8], o[8]; unpack8(r0, x0); unpack8(r1, x1); unpack8(r2, x2);
#pragma unroll
        for (int e = 0; e < 8; ++e) o[e] = sc * siluf_(w[0][e] * x0[e] + w[1][e] * x1[e] + w[2][e] * x2[e]);
        v4u q; q.x = pk2(o[0], o[1]); q.y = pk2(o[2], o[3]); q.z = pk2(o[4], o[5]); q.w = pk2(o[6], o[7]);
        *(v4u*)(qkc + (size_t)row * D + cp * 8) = q;
    }
    for (int i = gt; i < M_ALL * 32; i += F.G * NTHR) { const int c = i & 31; const float x = gates[i] + bgate[c];
        gates[i] = ((c >> 3) & 1) ? (fminf(x, 0.f) - __logf(1.f + __expf(-fabsf(x)))) : x; }
}

__device__ __forceinline__ void timer_stamp(unsigned char* lds_raw, bool add) {
    if (threadIdx.x == 0) { volatile LAS unsigned* tw = (volatile LAS unsigned*)((LAS unsigned char*)lds_raw + LDSCTL_OFF) + 32;
        const unsigned long long t = wall_clock64(); const unsigned long long last = ((unsigned long long)tw[1] << 32) | tw[0];
        if (add) { unsigned long long acc = ((unsigned long long)tw[3] << 32) | tw[2]; acc += t - last; tw[2] = (unsigned)acc; tw[3] = (unsigned)(acc >> 32); }
        tw[0] = (unsigned)t; tw[1] = (unsigned)(t >> 32); }
}

__device__ __forceinline__ Frame mkframe(const Args& args, unsigned char* lds_raw) {
    Frame F; int t = threadIdx.x; asm volatile("" : "+v"(t));
    F.lds = (LAS unsigned char*)lds_raw; F.tid = t; F.lane = t & 63; F.wave = __builtin_amdgcn_readfirstlane(t >> 6);
    int g = gridDim.x, b = blockIdx.x; asm volatile("" : "+s"(g), "+s"(b)); F.G = g; F.bid = b;
    const __attribute__((address_space(4))) Args* ap = (const __attribute__((address_space(4))) Args*)__builtin_amdgcn_kernarg_segment_ptr(); asm volatile("" : "+s"(ap));
    F.ws = ap->ws; F.in = ap->in; F.out = ap->out;
    return F;
}
#define PHASE_LOCALS \
    Frame F = mkframe(args, lds_raw); unsigned char* ws = F.ws; \
    float* modv = (float*)(ws + WS_MODV); bf16* U = (bf16*)(ws + WS_U); bf16* Y = (bf16*)(ws + WS_Y); bf16* PROJ = (bf16*)(ws + WS_ACT); bf16* HB = (bf16*)(ws + WS_ACT); \
    bf16* AMOE = (bf16*)(ws + WS_ACT); bf16* HMOE = (bf16*)(ws + WS_ACT + (size_t)MOE_ROWS * D * 2); \
    float* GATES = (float*)(ws + WS_GATES); float* LATC = (float*)(ws + WS_LATC); float* STATE = (float*)(ws + WS_STATE); \
    const int* pexp = (const int*)(ws + WS_SMALL + SM_PEXP); \
    unsigned char* wb = ws + (odd ? WS_WO : WS_WE); const float* mv = modv + (size_t)L * 9 * 6 * 1024; \
    (void)modv; (void)U; (void)Y; (void)PROJ; (void)HB; (void)AMOE; (void)HMOE; (void)GATES; (void)LATC; (void)STATE; (void)pexp; (void)wb; (void)mv;

__global__ void __launch_bounds__(NTHR, 2) fwd(Args args) {
    extern __shared__ __attribute__((aligned(16))) unsigned char lds_raw[];
    Frame F = mkframe(args, lds_raw);
    volatile LAS unsigned* LCTL = (volatile LAS unsigned*)(F.lds + LDSCTL_OFF);
    for (int u = F.tid; u < 128; u += NTHR) LCTL[u] = 0u;
    __syncthreads();
    XcdBarrier bar; bar.bar = (unsigned*)(F.ws + WS_CTL) + CW_BAR; bar.x = 0; bar.st = nullptr;
    if (args.use_bar) bar = xcd_barrier_post((unsigned*)(F.ws + WS_CTL) + CW_BAR, LCTL + 8);
    const int lo = args.ph_lo, hi = args.ph_hi;
#define IN(k) (lo <= (k) && (k) < hi)
#define SEAM(k) do { if ((k) + 1 < hi) xcd_barrier(bar); if (TIMER_MASK != 0ull) timer_stamp(lds_raw, ((TIMER_MASK >> (k)) & 1ull) != 0ull); } while (0)
    if (TIMER_MASK != 0ull) timer_stamp(lds_raw, false);
    if (IN(0)) { const int L = 0; const bool odd = false; PHASE_LOCALS if (EN_MISC) phase_mods(F); __syncthreads(); if (EN_MISC) phase_wconv(F, 0); SEAM(0); }
    if (IN(1)) { const int L = 0; const bool odd = false; PHASE_LOCALS
        TokCfg T{}; T.lat_src_l = F.in[I_X]; T.lat_src_c = F.in[I_CTX]; T.vna = modv + 0 * 1024; T.vnb = modv + 1 * 1024; T.u = U; T.nrows = M_ALL;
        if (EN_TOK) phase_tok(F, T); __syncthreads(); if (EN_MISC) phase_wconv(F, 1); SEAM(1);
    }
    for (int L = 0; L < DEPTH; ++L) {
        const int pb = PH_BASE + L * PH_PER_LAYER; const bool odd = (L & 1) != 0; const int jl = L >> 1;
        const bool ctx_out = L < DEPTH - 1;
        if (IN(pb + 0)) { PHASE_LOCALS
            pg8::Order S; pg8::Gemm g;
            if (!odd) { g = pg8::Gemm{U, (const bf16*)(wb + WE_IN), M_ALL, NIN_M, D}; S.init(M_ALL / 256, NIN_M, F.G, F.bid, nullptr, 0);
                pg8::EpiStore E{PROJ, NP_M, NP_M / 256, NP_M / 256, GATES, 1.0f}; if (EN_GEMM & (1 << 0)) pg8::gemm_phase<pg8::EpiStore, pg8::Order, PG_ALIGN, PG_SP2>(F.lds, g, S, E); }
            else { g = pg8::Gemm{U, (const bf16*)(wb + WOD_IN), M_ALL, NP_H, D}; S.init(M_ALL / 256, NP_H, F.G, F.bid, nullptr, 0);
                pg8::EpiStore E{PROJ, NP_H, NP_H / 256, -1, nullptr, 1.0f}; if (EN_GEMM & (1 << 1)) pg8::gemm_phase<pg8::EpiStore, pg8::Order, PG_ALIGN, PG_SP2>(F.lds, g, S, E); }
            SEAM(pb + 0);
        }
        if (IN(pb + 1)) {
            if (!odd) { PHASE_LOCALS
                phase_conv(F, PROJ, (bf16*)(ws + WS_ACT + 400 * MiB), GATES, F.in[I_MWCONV] + (size_t)jl * 3 * 1024, F.in[I_MBGATE] + jl * 32); SEAM(pb + 1); }
        }
        if (IN(pb + 2)) { PHASE_LOCALS
            for (int id = F.bid; id < 256; id += F.G) {
                const int bh = id >> 2, p = id & 3, b = bh >> 3, h = bh & 7;
                MlSeg SG0, SG1;
                const int csz = odd ? 32 : 64;
                if (p == 0) { SG0 = MlSeg{M_LAT + b * CTXL, CTXL, 0, CTXL / csz}; SG1 = SG0; }
                else { SG0 = MlSeg{b * SEQ, SEQ, (p - 1) * 2048, 2048 / csz}; SG1 = MlSeg{b * SEQ, SEQ, (4 - p) * 2048, 2048 / csz}; }
                if (!odd) { float* e0 = STATE + (size_t)((bh * 2 + 0) * 4 + p) * ML_STATE_F; float* e1 = STATE + (size_t)((bh * 2 + 1) * 4 + p) * ML_STATE_F;
                    if (EN_ML & 1) mlstm_item<false>(F, PROJ, (const bf16*)(ws + WS_ACT + 400 * MiB), GATES, (bf16*)(ws + WS_ACT + 536 * MiB), (bf16*)(ws + WS_Y), h, SG0, SG1, nullptr, nullptr, 0, 0, e0, e1); }
                else { float* e0 = STATE + (size_t)((bh * 2 + 0) * 4 + p) * HG_STATE_F; float* e1 = STATE + (size_t)((bh * 2 + 1) * 4 + p) * HG_STATE_F;
                    if (EN_HG & 1) hgrn_item<false>(F, PROJ, (bf16*)(ws + WS_ACT + 836 * MiB), (bf16*)(ws + WS_Y), F.in[I_HBF] + (size_t)jl * 2048, F.in[I_HLB], jl, h, SG0, SG1, nullptr, nullptr, 0, 0, e0, e1); }
            }
            SEAM(pb + 2);
        }
        if (IN(pb + 3)) { PHASE_LOCALS
            const int nitems = ctx_out ? 320 : 256;
            for (int id = F.bid; id < nitems; id += F.G) {
                MlSeg SG0, SG1; int bh, npre0 = 0, npre1 = 0; const int csz = odd ? 32 : 64;
                if (id < 256) { bh = id >> 2; const int q = id & 3; SG0 = MlSeg{(bh >> 3) * SEQ, SEQ, q * 2048, 2048 / csz}; npre0 = q + 1; npre1 = 4 - q; }
                else { bh = id - 256; SG0 = MlSeg{M_LAT + (bh >> 3) * CTXL, CTXL, 0, CTXL / csz}; }
                SG1 = SG0;
                const int h = bh & 7;
                if (!odd) { const float* s0 = STATE + (size_t)((bh * 2 + 0) * 4) * ML_STATE_F; const float* s1 = STATE + (size_t)((bh * 2 + 1) * 4) * ML_STATE_F;
                    if (EN_ML & 2) mlstm_item<true>(F, PROJ, (const bf16*)(ws + WS_ACT + 400 * MiB), GATES, (bf16*)(ws + WS_ACT + 536 * MiB), (bf16*)(ws + WS_Y), h, SG0, SG1, s0, s1, npre0, npre1, nullptr, nullptr); }
                else { const float* s0 = STATE + (size_t)((bh * 2 + 0) * 4) * HG_STATE_F; const float* s1 = STATE + (size_t)((bh * 2 + 1) * 4) * HG_STATE_F;
                    if (EN_HG & 2) hgrn_item<true>(F, PROJ, (bf16*)(ws + WS_ACT + 836 * MiB), (bf16*)(ws + WS_Y), F.in[I_HBF] + (size_t)jl * 2048, F.in[I_HLB], jl, h, SG0, SG1, s0, s1, npre0, npre1, nullptr, nullptr); }
            }
            SEAM(pb + 3);
        }
        if (IN(pb + 4)) { PHASE_LOCALS
            const bf16* HFp = (const bf16*)(ws + WS_ACT + (odd ? 836 : 536) * MiB); const bf16* HBp = (const bf16*)(ws + WS_Y);
            if (!odd) phase_headnorm(F, HFp, HBp, PROJ, NP_M, 2048, F.in[I_MGHEAD] + jl * 1024, U, ctx_out ? M_ALL : M_LAT);
            else phase_headnorm(F, HFp, HBp, PROJ, NP_H, 4096, F.in[I_HGHEAD] + jl * 1024, U, ctx_out ? M_ALL : M_LAT);
            SEAM(pb + 4);
        }
        if (IN(pb + 5)) { PHASE_LOCALS
            const int nM = (ctx_out ? M_ALL : M_LAT) / 256;
            pg8::Gemm g{U, (const bf16*)(wb + (odd ? WOD_OUT : WE_OUT)), nM * 256, D, D}; pg8::Order S; S.init(nM, D, F.G, F.bid, nullptr, 0);
            pg8::EpiStore E{Y, D, D / 256, -1, nullptr, 1.0f}; if (EN_GEMM & (1 << 2)) pg8::gemm_phase<pg8::EpiStore, pg8::Order, PG_ALIGN, PG_SP2>(F.lds, g, S, E);
            SEAM(pb + 5);
        }
        if (IN(pb + 6)) { PHASE_LOCALS
            TokCfg T{}; T.lat_src_l = (L == 0) ? F.in[I_X] : F.out; T.lat_src_c = (L == 0) ? F.in[I_CTX] : LATC; T.lat_dst_l = F.out; T.lat_dst_c = LATC;
            T.y = Y; T.y_perm = odd ? 1 : 0; T.vupd = mv + 2 * 1024; T.vna = mv + 3 * 1024; T.vnb = mv + 4 * 1024; T.u = U; T.u_fp8 = FFN_FP8_L(L); T.route = odd ? 1 : 0; T.jr = jl; T.nrows = ctx_out ? M_ALL : M_LAT;
            if (EN_TOK) phase_tok(F, T);
            if (L >= 1 && L + 1 < DEPTH) { __syncthreads(); if (EN_MISC) phase_wconv(F, L + 1); }
            SEAM(pb + 6);
        }
        if (IN(pb + 7)) { PHASE_LOCALS
            if (odd) { if (EN_MISC) phase_moe_scatter(F, jl, ctx_out ? M_ALL : M_LAT, (const unsigned char*)U, (unsigned char*)AMOE, FFN_FP8_L(L) ? 1024 : 2048); SEAM(pb + 7); }
        }
        if (IN(pb + 8)) { PHASE_LOCALS
            const bool f8 = FFN_FP8_L(L) != 0;
            if (!odd) { pg8::Gemm g{U, (const bf16*)(wb + WE_GU), M_ALL, NGU, D}; pg8::Order S; S.init(M_ALL / 256, NGU, F.G, F.bid, nullptr, 0);
                if (f8) { if ((FP8_LAYERS) & 0x5) { pg8::EpiSwiGLU8 E{(unsigned char*)HB, FF, 1.0f / WSCALE8}; if (EN_GEMM & (1 << 3)) pg8::gemm_phase<pg8::EpiSwiGLU8, pg8::Order, PG_ALIGN, PG_SP2, true>(F.lds, g, S, E); } }
                else { if ((~(FP8_LAYERS)) & 0x5) { pg8::EpiSwiGLU E{HB, FF}; if (EN_GEMM & (1 << 3)) pg8::gemm_phase<pg8::EpiSwiGLU, pg8::Order, PG_ALIGN, PG_SP2>(F.lds, g, S, E); } } }
            else { const int np = __builtin_amdgcn_readfirstlane(pexp[MOE_PANELS]);
                pg8::Gemm g{AMOE, (const bf16*)(wb + WOD_GU), np * 256, NGU, D}; pg8::Order S; S.init(np, NGU, F.G, F.bid, pexp, EGU_BYTES);
                if (f8) { if ((FP8_LAYERS) & 0xA) { pg8::EpiSwiGLU8 E{(unsigned char*)HMOE, FF, 1.0f / WSCALE8}; if (EN_GEMM & (1 << 4)) pg8::gemm_phase<pg8::EpiSwiGLU8, pg8::Order, PG_ALIGN, PG_SP2, true>(F.lds, g, S, E); } }
                else { if ((~(FP8_LAYERS)) & 0xA) { pg8::EpiSwiGLU E{HMOE, FF}; if (EN_GEMM & (1 << 4)) pg8::gemm_phase<pg8::EpiSwiGLU, pg8::Order, PG_ALIGN, PG_SP2>(F.lds, g, S, E); } } }
            SEAM(pb + 8);
        }
        if (IN(pb + 9)) { PHASE_LOCALS
            const bool f8 = FFN_FP8_L(L) != 0;
            if (!odd) { pg8::Gemm g{HB, (const bf16*)(wb + WE_DOWN), M_ALL, D, FF}; pg8::Order S; S.init(M_ALL / 256, D, F.G, F.bid, nullptr, 0);
                if (f8) { if ((FP8_LAYERS) & 0x5) { pg8::EpiStore E{Y, D, D / 256, -1, nullptr, 1.0f / WSCALE8}; if (EN_GEMM & (1 << 5)) pg8::gemm_phase<pg8::EpiStore, pg8::Order, PG_ALIGN, PG_SP2, true>(F.lds, g, S, E); } }
                else { if ((~(FP8_LAYERS)) & 0x5) { pg8::EpiStore E{Y, D, D / 256, -1, nullptr, 1.0f}; if (EN_GEMM & (1 << 5)) pg8::gemm_phase<pg8::EpiStore, pg8::Order, PG_ALIGN, PG_SP2>(F.lds, g, S, E); } } }
            else { const int np = __builtin_amdgcn_readfirstlane(pexp[MOE_PANELS]);
                pg8::Gemm g{HMOE, (const bf16*)(wb + WOD_DOWN), np * 256, D, FF}; pg8::Order S; S.init(np, D, F.G, F.bid, pexp, EDOWN_BYTES);
                if (f8) { if ((FP8_LAYERS) & 0xA) { pg8::EpiStore E{AMOE, D, D / 256, -1, nullptr, 1.0f / WSCALE8}; if (EN_GEMM & (1 << 6)) pg8::gemm_phase<pg8::EpiStore, pg8::Order, PG_ALIGN, PG_SP2, true>(F.lds, g, S, E); } }
                else { if ((~(FP8_LAYERS)) & 0xA) { pg8::EpiStore E{AMOE, D, D / 256, -1, nullptr, 1.0f}; if (EN_GEMM & (1 << 6)) pg8::gemm_phase<pg8::EpiStore, pg8::Order, PG_ALIGN, PG_SP2>(F.lds, g, S, E); } } }
            SEAM(pb + 9);
        }
        if (IN(pb + 10)) { PHASE_LOCALS
            TokCfg T{}; T.lat_src_l = F.out; T.lat_src_c = LATC; T.lat_dst_l = F.out; T.lat_dst_c = LATC;
            T.y = odd ? AMOE : Y; T.moe_combine = odd ? 1 : 0; T.vupd = mv + 5 * 1024; T.nrows = ctx_out ? M_ALL : M_LAT;
            if (L + 1 < DEPTH) { const float* mn = modv + (size_t)(L + 1) * 9 * 6 * 1024; T.vna = mn; T.vnb = mn + 1024; T.u = U; T.u_perm = ((L + 1) & 1) ? 1 : 0; }
            if (EN_TOK) phase_tok(F, T);
            SEAM(pb + 10);
        }
    }
    if (TIMER_MASK != 0ull) { timer_stamp(lds_raw, ((TIMER_MASK >> (N_PHASES - 1)) & 1ull) != 0ull);
        if (blockIdx.x == 0 && threadIdx.x == 0) { volatile LAS unsigned* tw = (volatile LAS unsigned*)((LAS unsigned char*)lds_raw + LDSCTL_OFF) + 32; const unsigned long long acc = ((unsigned long long)tw[3] << 32) | tw[2];
            asm volatile("s_waitcnt vmcnt(0)" ::: "memory"); args.out[0] = (float)acc * 0.01f / TIMER_DIV; } }
#undef IN
#undef SEAM
}

extern "C" void kernel_launch(void* const* d_in, const int* in_sizes, int n_in, void* d_out, int out_size, void* d_ws, size_t ws_size, hipStream_t stream) {
    static int grid = 0;
    if (grid == 0) {
        if (n_in != 23 || out_size != M_LAT * D || ws_size < WS_END) { fprintf(stderr, "kernel_launch: unexpected shapes / workspace (n_in %d out %d ws %zu need %zu)\n", n_in, out_size, ws_size, (size_t)WS_END); grid = -1; return; }
        int dev = 0, cus = 0, per_cu = 0;
        if (hipGetDevice(&dev) != hipSuccess || hipDeviceGetAttribute(&cus, hipDeviceAttributeMultiprocessorCount, dev) != hipSuccess) { grid = -1; return; }
        if (hipFuncSetAttribute((const void*)fwd, hipFuncAttributeMaxDynamicSharedMemorySize, LDS_BYTES) != hipSuccess) { fprintf(stderr, "kernel_launch: hipFuncSetAttribute failed\n"); grid = -1; return; }
        if (hipOccupancyMaxActiveBlocksPerMultiprocessor(&per_cu, (const void*)fwd, NTHR, LDS_BYTES) != hipSuccess || per_cu < 1) fprintf(stderr, "kernel_launch: occupancy query reports %d\n", per_cu);
        (void)hipGetLastError();
        grid = cus;
    }
    if (grid < 0) return;
    (void)hipMemsetAsync((char*)d_ws + WS_CTL, 0, CTL_ZERO_BYTES, stream);
    Args a{};
    for (int i = 0; i < 23; ++i) a.in[i] = (const float*)d_in[i];
    a.out = (float*)d_out; a.ws = (unsigned char*)d_ws;
#if MK_SPLIT
    for (int p = 0; p < N_PHASES; ++p) { a.ph_lo = p; a.ph_hi = p + 1; a.use_bar = 0; a.pad = 0; hipLaunchKernelGGL(fwd, dim3(grid), dim3(NTHR), LDS_BYTES, stream, a); }
#else
    a.ph_lo = 0; a.ph_hi = N_PHASES; a.use_bar = 1; a.pad = 0;
    hipLaunchKernelGGL(fwd, dim3(grid), dim3(NTHR), LDS_BYTES, stream, a);
#endif
}
```

```cpp
#include <hip/hip_runtime.h>
#include <cstdio>
#include <cstdint>

namespace pg8 {
#define PG8_LAS __attribute__((address_space(3)))
typedef unsigned short bf16_t;
typedef short bf16x8 __attribute__((ext_vector_type(8)));
typedef float f32x4 __attribute__((ext_vector_type(4)));
typedef unsigned u32x4 __attribute__((ext_vector_type(4)));
typedef unsigned u32x2 __attribute__((ext_vector_type(2)));
typedef int v8i_t __attribute__((ext_vector_type(8)));
constexpr int BM = 256, BK = 64, HALF = 128, HTB = HALF * BK * 2  , STAGE_BYTES = 8 * HTB, NXCD = 8, WGM = 8;

__host__ __device__ __forceinline__ int lds_byte(int r, int c) { const int st = (r >> 4) * 2 + (c >> 5), rr = r & 15, cc = c & 31, ob = rr * 64 + cc * 2; return st * 1024 + (ob ^ (((ob >> 9) & 1) << 5)); }
__host__ __device__ __forceinline__ void stage_rc(int b, int& R, int& C) { const int st = b / 1024, sb = b % 1024, swz = sb ^ (((sb >> 9) & 1) << 5); R = (st >> 1) * 16 + swz / 64; C = (st & 1) * 32 + (swz % 64) / 2; }
__host__ __device__ __forceinline__ int perm32(int rho) { const int n = rho >> 4, i = rho & 15; return 8 * (i >> 2) + 4 * n + (i & 3); }

struct Unit { int pm, pn; };
struct Gemm { const bf16_t* A; const bf16_t* Bt; int M, N, K; };

struct Order {
    int nM, nN, nwg, G, c; const int* pexp; size_t bstride;
    __device__ void init(int nM_, int N, int G_, int c_, const int* pexp_, size_t bstride_) { nM = nM_; nN = N / BM; nwg = nM * nN; G = G_; c = c_; pexp = pexp_; bstride = bstride_; }
    __device__ bool next(int i, Unit& u) const {
        const long L = (long)i * G + c; if (L >= nwg) return false;
        int wgid = (int)L; { const int q = nwg / NXCD, r = nwg % NXCD, xcd = wgid % NXCD, off = wgid / NXCD; wgid = (xcd < r ? xcd * (q + 1) : r * (q + 1) + (xcd - r) * q) + off; }
        const int nig = WGM * nN, gid = wgid / nig, fm = gid * WGM, gsz = (nM - fm) < WGM ? (nM - fm) : WGM;
        u.pm = fm + ((wgid % nig) % gsz); u.pn = (wgid % nig) / gsz; return true;
    }
    __device__ __forceinline__ size_t boff(const Unit& u) const { return pexp ? (size_t)__builtin_amdgcn_readfirstlane(pexp[u.pm]) * bstride : (size_t)0; }
    __device__ __forceinline__ void a_ready(const Unit&) const {}
    __device__ __forceinline__ void done(const Unit&) const {}
};

__device__ __forceinline__ unsigned cvt_pk_bf16(float lo, float hi) { unsigned r; asm volatile("v_cvt_pk_bf16_f32 %0, %1, %2" : "=v"(r) : "v"(lo), "v"(hi)); return r; }

struct EpiStore {
    static constexpr bool PERM = true, AFTER_DRAIN = false;
    bf16_t* O; int ldc; int ncol_tiles; int gate_pn; float* gates; float oscale;
    __device__ __forceinline__ void operator()(const f32x4 (&acc)[2][2][4][2], const Unit& u, int wr, int wc, int fr, int fq) const {
        const int row0 = u.pm * BM + wr * 64 + fr;
        if (u.pn < ncol_tiles) {
            const int col0 = u.pn * BM + wc * 32 + 8 * fq;
#pragma unroll
            for (int ai = 0; ai < 2; ++ai)
#pragma unroll
                for (int m = 0; m < 4; ++m) { bf16_t* rowp = O + (size_t)(row0 + ai * HALF + m * 16) * ldc + col0;
#pragma unroll
                    for (int bj = 0; bj < 2; ++bj) { const f32x4 v0 = acc[ai][bj][m][0] * oscale, v1 = acc[ai][bj][m][1] * oscale;
                        u32x4 w; w.x = cvt_pk_bf16(v0[0], v0[1]); w.y = cvt_pk_bf16(v0[2], v0[3]); w.z = cvt_pk_bf16(v1[0], v1[1]); w.w = cvt_pk_bf16(v1[2], v1[3]);
                        *(u32x4*)(rowp + bj * HALF) = w; } }
        } else if (u.pn == gate_pn && wc == 0) {
#pragma unroll
            for (int ai = 0; ai < 2; ++ai)
#pragma unroll
                for (int m = 0; m < 4; ++m) { float* rowp = gates + (size_t)(row0 + ai * HALF + m * 16) * 32 + 8 * fq;
                    *(f32x4*)(rowp) = acc[ai][0][m][0]; *(f32x4*)(rowp + 4) = acc[ai][0][m][1]; }
        }
    }
};
struct EpiSwiGLU {
    static constexpr bool PERM = true, AFTER_DRAIN = false;
    bf16_t* O; int ldc;
    __device__ __forceinline__ void operator()(const f32x4 (&acc)[2][2][4][2], const Unit& u, int wr, int wc, int fr, int fq) const {
        const int row0 = u.pm * BM + wr * 64 + fr, col0 = u.pn * HALF + wc * 32 + 8 * fq;
#pragma unroll
        for (int ai = 0; ai < 2; ++ai)
#pragma unroll
            for (int m = 0; m < 4; ++m) { bf16_t* rowp = O + (size_t)(row0 + ai * HALF + m * 16) * ldc + col0; float r[8];
#pragma unroll
                for (int n = 0; n < 2; ++n)
#pragma unroll
                    for (int j = 0; j < 4; ++j) { const float g = acc[ai][0][m][n][j], up = acc[ai][1][m][n][j]; r[n * 4 + j] = g * __builtin_amdgcn_rcpf(1.0f + __expf(-g)) * up; }
                u32x4 w; w.x = cvt_pk_bf16(r[0], r[1]); w.y = cvt_pk_bf16(r[2], r[3]); w.z = cvt_pk_bf16(r[4], r[5]); w.w = cvt_pk_bf16(r[6], r[7]);
                *(u32x4*)(rowp) = w; }
    }
};
struct EpiSwiGLU8 {
    static constexpr bool PERM = true, AFTER_DRAIN = false;
    unsigned char* O; int ldc; float ascale;
    __device__ __forceinline__ void operator()(const f32x4 (&acc)[2][2][4][2], const Unit& u, int wr, int wc, int fr, int fq) const {
        const int row0 = u.pm * BM + wr * 64 + fr, col0 = u.pn * HALF + wc * 32 + 8 * fq;
#pragma unroll
        for (int ai = 0; ai < 2; ++ai)
#pragma unroll
            for (int m = 0; m < 4; ++m) { unsigned char* rowp = O + (size_t)(row0 + ai * HALF + m * 16) * ldc + col0; float r[8];
#pragma unroll
                for (int n = 0; n < 2; ++n)
#pragma unroll
                    for (int j = 0; j < 4; ++j) { const float g = acc[ai][0][m][n][j] * ascale, up = acc[ai][1][m][n][j] * ascale; r[n * 4 + j] = g * __builtin_amdgcn_rcpf(1.0f + __expf(-g)) * up; }
                u32x2 w; unsigned t = 0; t = __builtin_amdgcn_cvt_pk_fp8_f32(r[0], r[1], t, false); t = __builtin_amdgcn_cvt_pk_fp8_f32(r[2], r[3], t, true); w.x = t;
                t = 0; t = __builtin_amdgcn_cvt_pk_fp8_f32(r[4], r[5], t, false); t = __builtin_amdgcn_cvt_pk_fp8_f32(r[6], r[7], t, true); w.y = t;
                *(u32x2*)(rowp) = w; }
    }
};

template <bool FP8> struct Frag;
template <> struct Frag<false> { bf16x8 v[2]; };
template <> struct Frag<true> { v8i_t v; };
template <bool FP8> __device__ __forceinline__ void ldfrag(Frag<FP8>& f, const PG8_LAS unsigned char* p) {
    if constexpr (FP8) { const bf16x8 a = *(const PG8_LAS bf16x8*)p, b = *(const PG8_LAS bf16x8*)(p + 1024); f.v = __builtin_bit_cast(v8i_t, __builtin_shufflevector(a, b, 0, 1, 2, 3, 4, 5, 6, 7, 8, 9, 10, 11, 12, 13, 14, 15)); }
    else { f.v[0] = *(const PG8_LAS bf16x8*)p; f.v[1] = *(const PG8_LAS bf16x8*)(p + 1024); }
}
template <class Epi, class Sched, bool ALIGN_EPI = false, bool SP2 = false, bool FP8 = false>
__device__ __forceinline__ void gemm_phase(PG8_LAS unsigned char* lds, const Gemm g, const Sched& S, const Epi& E) {
    int tid = threadIdx.x; asm volatile("" : "+v"(tid)); const int wid = __builtin_amdgcn_readfirstlane(tid >> 6), lane = tid & 63, wr = wid >> 2, wc = wid & 3, fr = lane & 15, fq = lane >> 4;
    const int K = g.K, rowb = FP8 ? K : 2 * K, nt = rowb / 128;
    unsigned voffA[2], voffB[2];
#pragma unroll
    for (int i = 0; i < 2; ++i) { int R, C; stage_rc(tid * 16 + i * 8192, R, C); const int Rb = Epi::PERM ? ((R & ~31) + perm32(R & 31)) : R;
        voffA[i] = (unsigned)(R * rowb + C * 2); voffB[i] = (unsigned)(Rb * rowb + C * 2); }
    const size_t kstep = (size_t)(BK * 2);
    const size_t hstep = (size_t)HALF * rowb;
    const size_t tstep = 2 * hstep;
    const unsigned ldsw = (unsigned)wid * 1024u;
    const int aoff = lds_byte(wr * 64 + fr, fq * 8), boff = lds_byte(wc * 32 + fr, fq * 8);
#define PG8_SA(b, h) (((b) * 2 + (h)) * HTB)
#define PG8_SB(b, h) ((4 + (b) * 2 + (h)) * HTB)
#define PG8_STAGE(bufoff, gbase, voff) do { _Pragma("unroll") for (int _i = 0; _i < 2; ++_i) \
        __builtin_amdgcn_global_load_lds((const unsigned*)((const char*)(gbase) + (voff)[_i]), (PG8_LAS unsigned*)(lds + (bufoff) + ldsw + _i * 8192), 16, 0, 0); } while (0)
#define PG8_LDA(dst, b, h) do { _Pragma("unroll") for (int m = 0; m < 4; ++m) ldfrag<FP8>(dst[m], lds + PG8_SA(b, h) + aoff + m * 2048); } while (0)
#define PG8_LDB(dst, b, h) do { _Pragma("unroll") for (int n = 0; n < 2; ++n) ldfrag<FP8>(dst[n], lds + PG8_SB(b, h) + boff + n * 2048); } while (0)
#define PG8_MMA(ai, bj, At, Bt) do { __builtin_amdgcn_s_setprio(1); _Pragma("unroll") for (int m = 0; m < 4; ++m) _Pragma("unroll") for (int n = 0; n < 2; ++n) { \
        if constexpr (FP8) { asm volatile("v_mfma_f32_16x16x128_f8f6f4 %0, %1, %2, %0" : "+v"(acc[ai][bj][m][n]) : "v"(Bt[n].v), "v"(At[m].v)); }     \
        else { _Pragma("unroll") for (int k = 0; k < 2; ++k) acc[ai][bj][m][n] = __builtin_amdgcn_mfma_f32_16x16x32_bf16(Bt[n].v[k], At[m].v[k], acc[ai][bj][m][n], 0, 0, 0); } } __builtin_amdgcn_s_setprio(0); } while (0)
#define PG8_WAIT_V(n) asm volatile("s_waitcnt vmcnt(" #n ")" ::: "memory")
#define PG8_WAIT_L(n) asm volatile("s_waitcnt lgkmcnt(" #n ")" ::: "memory")
#define PG8_BAR __builtin_amdgcn_s_barrier()
#define PG8_SCHED __builtin_amdgcn_sched_barrier(0)
    Unit cur, nxt; int ui = 0;
    if (!S.next(0, cur)) return;
    f32x4 acc[2][2][4][2];
#pragma unroll
    for (int a = 0; a < 2; ++a)
#pragma unroll
        for (int b = 0; b < 2; ++b)
#pragma unroll
            for (int m = 0; m < 4; ++m)
#pragma unroll
                for (int n = 0; n < 2; ++n) acc[a][b][m][n] = (f32x4){0.f, 0.f, 0.f, 0.f};
    Frag<FP8> At[4], B0[2], B1[2];
    const char* cA = (const char*)g.A + (size_t)cur.pm * tstep; const char* cB = (const char*)g.Bt + S.boff(cur) + (size_t)cur.pn * tstep;
    S.a_ready(cur);
    if constexpr (SP2) {
        PG8_STAGE(PG8_SB(0, 0), cB, voffB); PG8_STAGE(PG8_SB(0, 1), cB + hstep, voffB); PG8_STAGE(PG8_SA(0, 0), cA, voffA); PG8_STAGE(PG8_SA(0, 1), cA + hstep, voffA);
        if (wr == 1) PG8_BAR;
        PG8_WAIT_V(2); PG8_BAR;
        PG8_STAGE(PG8_SB(1, 0), cB + kstep, voffB); PG8_STAGE(PG8_SA(1, 0), cA + kstep, voffA); PG8_STAGE(PG8_SB(1, 1), cB + hstep + kstep, voffB);
        PG8_WAIT_V(6); PG8_BAR;
    } else {
        PG8_STAGE(PG8_SB(0, 0), cB, voffB); PG8_STAGE(PG8_SA(0, 0), cA, voffA); PG8_STAGE(PG8_SB(0, 1), cB + hstep, voffB); PG8_STAGE(PG8_SA(0, 1), cA + hstep, voffA);
        if (wr == 1) PG8_BAR;
        PG8_WAIT_V(4); PG8_BAR;
        PG8_STAGE(PG8_SB(1, 0), cB + kstep, voffB); PG8_STAGE(PG8_SA(1, 0), cA + kstep, voffA); PG8_STAGE(PG8_SB(1, 1), cB + hstep + kstep, voffB);
        PG8_WAIT_V(6); PG8_BAR;
    }
    for (;;) {
        const bool has_next = S.next(ui + 1, nxt);
        const char* nA = has_next ? (const char*)g.A + (size_t)nxt.pm * tstep : cA; const char* nB = has_next ? (const char*)g.Bt + S.boff(nxt) + (size_t)nxt.pn * tstep : cB;
#pragma unroll 1
        for (int t = 0; t < nt; t += 2) {
            const bool last = (t == nt - 2);
            const char* a1 = cA + (size_t)(t + 1) * kstep;
            const char* a2 = last ? nA : cA + (size_t)(t + 2) * kstep; const char* b2 = last ? nB : cB + (size_t)(t + 2) * kstep;
            const char* a3 = a2 + kstep; const char* b3 = b2 + kstep;
            if (last && has_next) S.a_ready(nxt);
            if constexpr (SP2) {
            PG8_LDB(B0, 0, 0); PG8_LDB(B1, 0, 1); PG8_SCHED; PG8_LDA(At, 0, 0); PG8_STAGE(PG8_SA(1, 1), a1 + hstep, voffA);
            PG8_WAIT_V(8); PG8_WAIT_L(0); PG8_BAR; PG8_MMA(0, 0, At, B0); PG8_MMA(0, 1, At, B1); PG8_BAR; PG8_SCHED;
            PG8_LDA(At, 0, 1); PG8_STAGE(PG8_SB(0, 0), b2, voffB); PG8_STAGE(PG8_SB(0, 1), b2 + hstep, voffB); PG8_STAGE(PG8_SA(0, 0), a2, voffA);
            PG8_WAIT_V(8); PG8_WAIT_L(0); PG8_BAR; PG8_MMA(1, 0, At, B0); PG8_MMA(1, 1, At, B1); PG8_BAR; PG8_SCHED;
            PG8_LDB(B0, 1, 0); PG8_LDB(B1, 1, 1); PG8_SCHED; PG8_LDA(At, 1, 0); PG8_STAGE(PG8_SA(0, 1), a2 + hstep, voffA);
            PG8_WAIT_V(8); PG8_WAIT_L(0); PG8_BAR; PG8_MMA(0, 0, At, B0); PG8_MMA(0, 1, At, B1); PG8_BAR; PG8_SCHED;
            PG8_LDA(At, 1, 1); PG8_STAGE(PG8_SB(1, 0), b3, voffB); PG8_STAGE(PG8_SB(1, 1), b3 + hstep, voffB); PG8_STAGE(PG8_SA(1, 0), a3, voffA);
            PG8_WAIT_V(8); PG8_WAIT_L(0); PG8_BAR; PG8_MMA(1, 0, At, B0); PG8_MMA(1, 1, At, B1); PG8_BAR; PG8_SCHED;
            } else {
            PG8_LDB(B0, 0, 0); PG8_SCHED; PG8_LDA(At, 0, 0); PG8_STAGE(PG8_SA(1, 1), a1 + hstep, voffA);
            PG8_WAIT_L(8); PG8_BAR; PG8_WAIT_L(0); PG8_MMA(0, 0, At, B0); PG8_BAR; PG8_SCHED;
            PG8_LDB(B1, 0, 1); PG8_STAGE(PG8_SB(0, 0), b2, voffB);
            PG8_BAR; PG8_WAIT_L(0); PG8_MMA(0, 1, At, B1); PG8_BAR;
            PG8_LDA(At, 0, 1); PG8_STAGE(PG8_SA(0, 0), a2, voffA);
            PG8_BAR; PG8_WAIT_L(0); PG8_MMA(1, 0, At, B0); PG8_BAR; PG8_SCHED;
            PG8_STAGE(PG8_SB(0, 1), b2 + hstep, voffB);
            PG8_WAIT_V(6); PG8_BAR; PG8_MMA(1, 1, At, B1); PG8_BAR;
            PG8_LDB(B0, 1, 0); PG8_SCHED; PG8_LDA(At, 1, 0); PG8_STAGE(PG8_SA(0, 1), a2 + hstep, voffA);
            PG8_WAIT_L(8); PG8_BAR; PG8_WAIT_L(0); PG8_MMA(0, 0, At, B0); PG8_BAR; PG8_SCHED;
            PG8_LDB(B1, 1, 1); PG8_STAGE(PG8_SB(1, 0), b3, voffB);
            PG8_BAR; PG8_WAIT_L(0); PG8_MMA(0, 1, At, B1); PG8_BAR;
            PG8_LDA(At, 1, 1); PG8_STAGE(PG8_SA(1, 0), a3, voffA);
            PG8_BAR; PG8_WAIT_L(0); PG8_MMA(1, 0, At, B0); PG8_BAR; PG8_SCHED;
            PG8_STAGE(PG8_SB(1, 1), b3 + hstep, voffB);
            PG8_WAIT_V(6); PG8_BAR; PG8_MMA(1, 1, At, B1); PG8_BAR;
            }
        }
        if constexpr (ALIGN_EPI) { if (wr == 0) PG8_BAR; }
        if constexpr (FP8) { asm volatile("s_nop 15\n\ts_nop 15" ::: "memory"); }
        if constexpr (!Epi::AFTER_DRAIN) { E(acc, cur, wr, wc, fr, fq); S.done(cur); }
        if (!has_next) break;
#pragma unroll
        for (int a = 0; a < 2; ++a)
#pragma unroll
            for (int b = 0; b < 2; ++b)
#pragma unroll
                for (int m = 0; m < 4; ++m)
#pragma unroll
                    for (int n = 0; n < 2; ++n) acc[a][b][m][n] = (f32x4){0.f, 0.f, 0.f, 0.f};
        cur = nxt; cA = nA; cB = nB; ++ui;
        if constexpr (ALIGN_EPI) { if (wr == 1) PG8_BAR; }
    }
    PG8_WAIT_V(0);
    if constexpr (!ALIGN_EPI) { if (wr == 0) PG8_BAR; }
    PG8_BAR;
    if constexpr (Epi::AFTER_DRAIN) { E.fused(acc, cur, wr, wc, fr, fq, lds, wid, lane); S.done(cur); }
#undef PG8_SA
#undef PG8_SB
#undef PG8_STAGE
#undef PG8_LDA
#undef PG8_LDB
#undef PG8_MMA
#undef PG8_WAIT_V
#undef PG8_WAIT_L
#undef PG8_BAR
#undef PG8_SCHED
}
}

constexpr int D = 1024, NB = 8, SEQ = 8192, CTXL = 256, DEPTH = 4, GRIDW = 64, ROWS_G = SEQ / GRIDW  ;
constexpr int M_LAT = NB * SEQ  , M_CTX = NB * CTXL  , M_ALL = M_LAT + M_CTX  ;
constexpr int NHEAD = 8, M_DK = 64, M_DV = 128, H_DK = 128, H_DV = 128;
constexpr int NP_M = 3072, NIN_M = 3328, NW_M = 3104, NP_H = 5120;
constexpr int FF = 2816, NGU = 2 * FF, NEXP = 8;
constexpr int MOE_ROWS = 137216, MOE_PANELS = MOE_ROWS / 256;
constexpr float EPS = 1e-6f;
constexpr int NWAVES = 8, NTHR = 512;

constexpr size_t MiB = 1u << 20;
constexpr size_t WS_CTL = 0, CTL_ZERO_BYTES = 1 * MiB;
constexpr size_t WS_MODV = 1 * MiB;
constexpr size_t WS_SMALL = 2 * MiB;
constexpr size_t WS_LATC = 3 * MiB;
constexpr size_t WS_WE = 11 * MiB;
constexpr size_t WS_WO = 37 * MiB;
constexpr size_t WS_U = 181 * MiB;
constexpr size_t WS_GATES = 313 * MiB;
constexpr size_t WS_STATE = 322 * MiB;
constexpr size_t WS_ROUTE = 362 * MiB;
constexpr size_t WS_ACT = 364 * MiB;
constexpr size_t WS_Y = WS_ACT + 700 * MiB;
constexpr size_t WS_END = WS_ACT + 1005 * MiB;
constexpr size_t WE_IN = 0, WE_OUT = 7 * MiB, WE_GU = 9 * MiB, WE_DOWN = 20 * MiB;
constexpr size_t WOD_IN = 0, WOD_OUT = 10 * MiB, WOD_GU = 12 * MiB, WOD_DOWN = 100 * MiB;
constexpr size_t EGU_BYTES = (size_t)NGU * D * 2, EDOWN_BYTES = (size_t)D * FF * 2;
static_assert(WOD_GU + 8 * EGU_BYTES <= WOD_DOWN && WOD_DOWN + 8 * EDOWN_BYTES <= 144 * MiB, "odd weights map");
static_assert((size_t)NIN_M * D * 2 <= 7 * MiB && WE_GU + EGU_BYTES <= WE_DOWN && WE_DOWN + EDOWN_BYTES <= 26 * MiB, "even weights map");
static_assert((size_t)M_ALL * NP_H * 2 <= 700 * MiB && (size_t)MOE_ROWS * D * 2 + (size_t)MOE_ROWS * FF * 2 <= 1005 * MiB && 700 * MiB + (size_t)M_ALL * D * 2 <= 1005 * MiB, "act map");
constexpr int CW_BAR = 4096;
constexpr int CW_ECNT = 8192;
constexpr int CW_DBG = 16384;
constexpr size_t RT_E = 0;
constexpr size_t RT_R = 512 * 1024;
constexpr size_t RT_W = 512 * 1024 + 1024 * 1024;
constexpr size_t SM_LB = 0;
constexpr size_t SM_PEXP = 64 * 1024;
constexpr size_t SM_EBASE = 96 * 1024;

constexpr int LDS_MAIN = 147456;
constexpr int LDSCTL_OFF = LDS_MAIN;
constexpr int LDS_BYTES = LDS_MAIN + 512;

#define GAS __attribute__((address_space(1)))
#define LAS __attribute__((address_space(3)))
typedef unsigned short bf16;
typedef unsigned v4u __attribute__((ext_vector_type(4)));
typedef unsigned v2u __attribute__((ext_vector_type(2)));
typedef float f32x4 __attribute__((ext_vector_type(4)));
typedef float f32x16 __attribute__((ext_vector_type(16)));
typedef short bf16x8 __attribute__((ext_vector_type(8)));
typedef short s16x4 __attribute__((ext_vector_type(4)));
typedef GAS unsigned gu32;
#define RLX_AGENT __ATOMIC_RELAXED, __HIP_MEMORY_SCOPE_AGENT
#define LDS_WAIT() asm volatile("s_waitcnt lgkmcnt(0)" ::: "memory")
#define VM_WAIT() asm volatile("s_waitcnt vmcnt(0)" ::: "memory")
#define CFENCE() asm volatile("" ::: "memory")
__device__ __forceinline__ unsigned f2bf(float f) { unsigned u = __builtin_bit_cast(unsigned, f); return (u + 0x7fffu + ((u >> 16) & 1u)) >> 16; }
typedef __bf16 bf16x2_t __attribute__((ext_vector_type(2)));
typedef float f32x2_t __attribute__((ext_vector_type(2)));
__device__ __forceinline__ unsigned pk2(float lo, float hi) { f32x2_t v = {lo, hi}; bf16x2_t b = __builtin_convertvector(v, bf16x2_t); return __builtin_bit_cast(unsigned, b); }
__device__ __forceinline__ float bf2f(unsigned short b) { return __builtin_bit_cast(float, (unsigned)b << 16); }
__device__ __forceinline__ float bflo(unsigned w) { return __builtin_bit_cast(float, w << 16); }
__device__ __forceinline__ float bfhi(unsigned w) { return __builtin_bit_cast(float, w & 0xffff0000u); }
__device__ __forceinline__ float sigmoidf_(float x) { return __builtin_amdgcn_rcpf(1.0f + __expf(-x)); }
__device__ __forceinline__ float siluf_(float x) { return x * sigmoidf_(x); }
__device__ __forceinline__ float wave_sum(float v) {
#pragma unroll
    for (int o = 1; o < 64; o <<= 1) v += __shfl_xor(v, o);
    return v;
}

#define XB_TMO      128
#define XB_XCNT(j)  (256  + 64 * (j))
#define XB_XSUB(j)  (1280 + 64 * (j))
#define XB_XGEN(j)  (2304 + 64 * (j))
#define XB_TOP      3328
#define XB_TOPGEN   3392
#define XCD_BAR_WORDS 3456
#define XB_SPIN_CAP (1u << 18)
__device__ __forceinline__ unsigned xb_ld(unsigned* p)              { return __hip_atomic_load(p, __ATOMIC_RELAXED, __HIP_MEMORY_SCOPE_AGENT); }
__device__ __forceinline__ unsigned xb_add(unsigned* p, unsigned v) { return __hip_atomic_fetch_add(p, v, __ATOMIC_RELAXED, __HIP_MEMORY_SCOPE_AGENT); }
__device__ __forceinline__ unsigned xb_xcc_id() { return (unsigned)__builtin_amdgcn_s_getreg((3 << 11) | 20) & 0xFu; }
#define XB_SPIN(cond, bar) do { unsigned _sp = 0; while (cond) { __builtin_amdgcn_s_sleep(1); \
    if ((++_sp & 255u) == 0u) { if (xb_ld(&(bar)[XB_TMO])) break; if (_sp > XB_SPIN_CAP) { atomicAdd(&(bar)[XB_TMO], 1u); break; } } } } while (0)
struct XcdBarrier { unsigned* bar; unsigned x; volatile LAS unsigned* st; };
__device__ __forceinline__ XcdBarrier xcd_barrier_post(unsigned* bar, volatile LAS unsigned* st) {
    XcdBarrier b; b.bar = bar; b.x = xb_xcc_id(); b.st = st;
    if (threadIdx.x == 0) (void)xb_add(&bar[XB_XCNT(b.x)], 1u);
    return b;
}
__device__ __forceinline__ void xcd_barrier_complete(unsigned* bar, unsigned x, unsigned& nloc, unsigned& nx) {
    const unsigned G = gridDim.x * gridDim.y * gridDim.z;
    unsigned sum, cnt, mine, sp = 0u;
    for (;;) {
        sum = 0u; cnt = 0u; mine = 0u;
#pragma unroll
        for (unsigned j = 0; j < 16; ++j) { const unsigned c = xb_ld(&bar[XB_XCNT(j)]); sum += c; cnt += (c > 0u) ? 1u : 0u; mine = (j == x) ? c : mine; }
        if (sum == G) break;
        __builtin_amdgcn_s_sleep(1);
        if ((++sp & 255u) == 0u) { if (xb_ld(&bar[XB_TMO])) break; if (sp > XB_SPIN_CAP) { atomicAdd(&bar[XB_TMO], 1u); break; } }
    }
    nloc = mine > 0u ? mine : 1u; nx = cnt > 0u ? cnt : 1u;
}
__device__ __forceinline__ void xcd_barrier(const XcdBarrier& b) {
    asm volatile("s_waitcnt vmcnt(0)" ::: "memory");
    __syncthreads();
    if (threadIdx.x == 0) {
        unsigned* bar = b.bar;
        __builtin_amdgcn_s_waitcnt(0);
        unsigned nloc = b.st[0], nx = b.st[1];
        if (nloc == 0u) { xcd_barrier_complete(bar, b.x, nloc, nx); b.st[0] = nloc; b.st[1] = nx; }
        const unsigned old = xb_add(&bar[XB_XSUB(b.x)], 1u);
        const unsigned gen = old / nloc;
        if (old + 1u == (gen + 1u) * nloc) {
            __builtin_amdgcn_fence(__ATOMIC_RELEASE, "agent");
            asm volatile("s_waitcnt vmcnt(0)" ::: "memory");
            const unsigned og = xb_add(&bar[XB_TOP], 1u);
            const unsigned tg = og / nx;
            if (og + 1u == (tg + 1u) * nx) xb_add(&bar[XB_TOPGEN], 1u);
            else XB_SPIN(xb_ld(&bar[XB_TOPGEN]) == tg, bar);
            __builtin_amdgcn_fence(__ATOMIC_ACQUIRE, "agent");
            xb_add(&bar[XB_XGEN(b.x)], 1u);
            asm volatile("s_waitcnt vmcnt(0)" ::: "memory");
        } else {
            XB_SPIN(xb_ld(&bar[XB_XGEN(b.x)]) == gen, bar);
            __builtin_amdgcn_fence(__ATOMIC_ACQUIRE, "agent");
            asm volatile("s_waitcnt vmcnt(0)" ::: "memory");
        }
    }
    __syncthreads();
}

struct Args {
    const float* in[23];
    float* out; unsigned char* ws;
    int ph_lo, ph_hi;
    int use_bar, pad;
};
struct Frame {
    LAS unsigned char* lds;
    int tid, lane, wave, G, bid;
    unsigned char* ws;
    const float* const __attribute__((address_space(4)))* in;
    float* out;
};
enum { I_X = 0, I_C, I_CTX, I_CCTX, I_MODW, I_MODB, I_NORMG, I_MWIN, I_MBGATE, I_MWCONV, I_MGHEAD, I_MWOUT, I_HWIN, I_HBF, I_HLB, I_HGHEAD, I_HWOUT, I_FWGU, I_FWDOWN, I_EWR, I_EBR, I_EWGU, I_EWDOWN };

#ifndef FP8_LAYERS
#define FP8_LAYERS 0xE
#endif
#define FFN_FP8_L(L) (((FP8_LAYERS) >> (L)) & 1)
#ifndef FFN_FP8
#define FFN_FP8 1
#endif
constexpr float WSCALE8 = 64.0f;

__device__ __forceinline__ void phase_mods(Frame& F) {
    LAS float* SV = (LAS float*)(F.lds);
    LAS float* RED = (LAS float*)(F.lds + 9 * 1024 * 4);
    const float* cvec = F.in[I_C]; const float* cctx = F.in[I_CCTX];
    for (int i = F.tid; i < 9 * 1024; i += NTHR) { const int b = i >> 10, k = i & 1023; const float v = b < 8 ? cvec[b * 1024 + k] : cctx[k]; SV[i] = siluf_(v); }
    __syncthreads();
    const float* modw = F.in[I_MODW]; const float* modb = F.in[I_MODB]; const float* normg = F.in[I_NORMG];
    float* modv = (float*)(F.ws + WS_MODV);
    for (int item = F.bid; item < 4 * 96; item += F.G) {
        const int L = item / 96, n0 = (item % 96) * 64;
        const float* wp = modw + (size_t)L * 1024 * 6144 + n0 + F.lane;
        float acc[9];
#pragma unroll
        for (int b = 0; b < 9; ++b) acc[b] = 0.f;
        const int k0 = F.wave * 128;
#pragma unroll 4
        for (int k = 0; k < 128; ++k) { const float wv = wp[(size_t)(k0 + k) * 6144];
#pragma unroll
            for (int b = 0; b < 9; ++b) acc[b] += SV[b * 1024 + k0 + k] * wv; }
#pragma unroll
        for (int b = 0; b < 9; ++b) RED[(F.wave * 9 + b) * 64 + F.lane] = acc[b];
        __syncthreads();
        for (int o = F.tid; o < 9 * 64; o += NTHR) { const int b = o >> 6, l = o & 63; float v = 0.f;
#pragma unroll
            for (int w = 0; w < 8; ++w) v += RED[(w * 9 + b) * 64 + l];
            const int n = n0 + l, s = n >> 10, c = n & 1023; v += modb[L * 6144 + n];
            const float* g = normg + (size_t)L * 4 * 1024;
            int slot; float r;
            if (s == 0) { slot = 1; r = v; } else if (s == 1) { slot = 0; r = g[c] * (1.f + v); } else if (s == 2) { slot = 2; r = v * g[1024 + c]; }
            else if (s == 3) { slot = 4; r = v; } else if (s == 4) { slot = 3; r = g[2048 + c] * (1.f + v); } else { slot = 5; r = v * g[3072 + c]; }
            modv[((size_t)(L * 9 + b) * 6 + slot) * 1024 + c] = r; }
        __syncthreads();
    }
}

__device__ __forceinline__ void wconv_item(const float* W, int K, int N, bf16* WT, int gu_mode, LAS float* scr, int item, int lane) {
    const int nblk = N / 32, kb = item / nblk, nb = item % nblk, k0 = 64 * kb, n0 = 32 * nb;
    int row0 = n0;
    if (gu_mode) { const int half = n0 / FF, nn = n0 - half * FF; row0 = 256 * (nn >> 7) + 128 * half + (nn & 127); }
#pragma unroll 8
    for (int i = 0; i < 32; ++i) { const int kk = 2 * i + (lane >> 5); scr[kk * 33 + (lane & 31)] = W[(size_t)(k0 + kk) * N + n0 + (lane & 31)]; }
    LDS_WAIT(); CFENCE();
    const int c = lane & 7;
#pragma unroll
    for (int j = 0; j < 4; ++j) { const int n = (lane >> 3) + 8 * j; const LAS float* s = scr + (8 * c) * 33 + n;
        v4u o; o.x = pk2(s[0 * 33], s[1 * 33]); o.y = pk2(s[2 * 33], s[3 * 33]); o.z = pk2(s[4 * 33], s[5 * 33]); o.w = pk2(s[6 * 33], s[7 * 33]);
        *(GAS v4u*)(WT + (size_t)(row0 + n) * K + k0 + 8 * c) = o; }
    LDS_WAIT(); CFENCE();
}
__device__ __forceinline__ void wconv_item8(const float* W, int K, int N, unsigned char* WT, int gu_mode, float wscale, LAS float* scr, int item, int lane) {
    const int nblk = N / 32, kb = item / nblk, nb = item % nblk, k0 = 64 * kb, n0 = 32 * nb;
    int row0 = n0;
    if (gu_mode) { const int half = n0 / FF, nn = n0 - half * FF; row0 = 256 * (nn >> 7) + 128 * half + (nn & 127); }
#pragma unroll 8
    for (int i = 0; i < 32; ++i) { const int kk = 2 * i + (lane >> 5); scr[kk * 33 + (lane & 31)] = W[(size_t)(k0 + kk) * N + n0 + (lane & 31)]; }
    LDS_WAIT(); CFENCE();
    const int c = lane & 7;
#pragma unroll
    for (int j = 0; j < 4; ++j) { const int n = (lane >> 3) + 8 * j; const LAS float* s = scr + (8 * c) * 33 + n;
        v2u o; unsigned w = 0; w = __builtin_amdgcn_cvt_pk_fp8_f32(s[0 * 33] * wscale, s[1 * 33] * wscale, w, false); w = __builtin_amdgcn_cvt_pk_fp8_f32(s[2 * 33] * wscale, s[3 * 33] * wscale, w, true); o.x = w;
        w = 0; w = __builtin_amdgcn_cvt_pk_fp8_f32(s[4 * 33] * wscale, s[5 * 33] * wscale, w, false); w = __builtin_amdgcn_cvt_pk_fp8_f32(s[6 * 33] * wscale, s[7 * 33] * wscale, w, true); o.y = w;
        *(GAS v2u*)(WT + (size_t)(row0 + n) * K + k0 + 8 * c) = o; }
    LDS_WAIT(); CFENCE();
}
__device__ __forceinline__ void phase_wconv(Frame& F, int L) {
    LAS float* scr = (LAS float*)(F.lds + F.wave * 16384);
    const int gw = F.bid * NWAVES + F.wave, NGW = F.G * NWAVES; const int j = L >> 1;
    if ((L & 1) == 0) {
        unsigned char* wb = F.ws + WS_WE;
        const float* w_in = F.in[I_MWIN] + (size_t)j * D * NW_M; const float* w_out = F.in[I_MWOUT] + (size_t)j * D * D;
        const float* w_gu = F.in[I_FWGU] + (size_t)j * D * NGU; const float* w_dn = F.in[I_FWDOWN] + (size_t)j * FF * D;
        constexpr int I0 = 16 * (NW_M / 32), I1 = 16 * 32, I2 = 16 * (NGU / 32), I3 = (FF / 64) * 32;
        for (int it = gw; it < I0 + I1 + I2 + I3; it += NGW) { int r = it;
            if (r < I0) { wconv_item(w_in, D, NW_M, (bf16*)(wb + WE_IN), 0, scr, r, F.lane); continue; } r -= I0;
            if (r < I1) { wconv_item(w_out, D, D, (bf16*)(wb + WE_OUT), 0, scr, r, F.lane); continue; } r -= I1;
            if (r < I2) { if (FFN_FP8_L(L)) wconv_item8(w_gu, D, NGU, wb + WE_GU, 1, WSCALE8, scr, r, F.lane); else wconv_item(w_gu, D, NGU, (bf16*)(wb + WE_GU), 1, scr, r, F.lane); continue; } r -= I2;
            if (FFN_FP8_L(L)) wconv_item8(w_dn, FF, D, wb + WE_DOWN, 0, WSCALE8, scr, r, F.lane); else wconv_item(w_dn, FF, D, (bf16*)(wb + WE_DOWN), 0, scr, r, F.lane); }
        GAS v4u* z = (GAS v4u*)(wb + WE_IN + (size_t)NW_M * D * 2); const int nz = (NIN_M - NW_M) * D * 2 / 16;
        for (int i = F.bid * NTHR + F.tid; i < nz; i += F.G * NTHR) z[i] = (v4u){0u, 0u, 0u, 0u};
    } else {
        unsigned char* wb = F.ws + WS_WO;
        const float* w_in = F.in[I_HWIN] + (size_t)j * D * NP_H; const float* w_out = F.in[I_HWOUT] + (size_t)j * D * D;
        const float* w_gu = F.in[I_EWGU] + (size_t)j * NEXP * D * NGU; const float* w_dn = F.in[I_EWDOWN] + (size_t)j * NEXP * FF * D;
        constexpr int I0 = 16 * (NP_H / 32), I1 = 16 * 32, I2 = 16 * (NGU / 32), I3 = (FF / 64) * 32;
        for (int it = gw; it < I0 + I1 + NEXP * (I2 + I3); it += NGW) { int r = it;
            if (r < I0) { wconv_item(w_in, D, NP_H, (bf16*)(wb + WOD_IN), 0, scr, r, F.lane); continue; } r -= I0;
            if (r < I1) { wconv_item(w_out, D, D, (bf16*)(wb + WOD_OUT), 0, scr, r, F.lane); continue; } r -= I1;
            const int e = r / (I2 + I3); r -= e * (I2 + I3);
            if (r < I2) { if (FFN_FP8_L(L)) wconv_item8(w_gu + (size_t)e * D * NGU, D, NGU, wb + WOD_GU + e * EGU_BYTES, 1, WSCALE8, scr, r, F.lane); else wconv_item(w_gu + (size_t)e * D * NGU, D, NGU, (bf16*)(wb + WOD_GU + e * EGU_BYTES), 1, scr, r, F.lane); continue; } r -= I2;
            if (FFN_FP8_L(L)) wconv_item8(w_dn + (size_t)e * FF * D, FF, D, wb + WOD_DOWN + e * EDOWN_BYTES, 0, WSCALE8, scr, r, F.lane); else wconv_item(w_dn + (size_t)e * FF * D, FF, D, (bf16*)(wb + WOD_DOWN + e * EDOWN_BYTES), 0, scr, r, F.lane); }
    }
}

struct TokCfg {
    const void* lat_src_l; const void* lat_src_c;
    void* lat_dst_l; void* lat_dst_c;
    int src_f32, dst_f32;
    const bf16* y; int y_perm; int moe_combine;
    const float* vupd;
    const float* vna; const float* vnb;
    bf16* u; int u_perm; int u_fp8;
    int route; int jr;
    int nrows;
};
__device__ __forceinline__ int perm_cm(int t) { return (t & 63) * ROWS_G + (t >> 6); }

__device__ __forceinline__ void phase_tok(Frame& F, const TokCfg& T) {
    const int gw = F.bid * NWAVES + F.wave, NGW = F.G * NWAVES;
    const int R = (T.nrows + NGW - 1) / NGW; const int r0 = gw * R; int r1 = r0 + R; if (r1 > T.nrows) r1 = T.nrows;
    LAS float* WR = (LAS float*)F.lds;
    if (T.route) { const float* wr = F.in[I_EWR] + (size_t)T.jr * 1024 * 8; for (int i = F.tid; i < 8192; i += NTHR) WR[i] = wr[i]; }
    __syncthreads();
    f32x4 VU[4], VA[4], VB[4]; int curb = -1;
    int my_e0 = 0, my_e1 = 0; float my_w = 0.f;
    for (int row = r0; row < r1; ++row) {
        const int b = row < M_LAT ? (row >> 13) : 8;
        if (b != curb) { curb = b;
#pragma unroll
            for (int j = 0; j < 4; ++j) {
                if (T.y) VU[j] = ((const f32x4*)(T.vupd + (size_t)b * 6144))[F.lane + 64 * j];
                if (T.vna) { VA[j] = ((const f32x4*)(T.vna + (size_t)b * 6144))[F.lane + 64 * j]; VB[j] = ((const f32x4*)(T.vnb + (size_t)b * 6144))[F.lane + 64 * j]; } } }
        f32x4 v[4];
        if (T.src_f32) { const float* lp = row < M_LAT ? (const float*)T.lat_src_l + (size_t)row * D : (const float*)T.lat_src_c + (size_t)(row - M_LAT) * D;
#pragma unroll
            for (int j = 0; j < 4; ++j) v[j] = ((const f32x4*)lp)[F.lane + 64 * j]; }
        else { const bf16* lp = row < M_LAT ? (const bf16*)T.lat_src_l + (size_t)row * D : (const bf16*)T.lat_src_c + (size_t)(row - M_LAT) * D;
#pragma unroll
            for (int j = 0; j < 4; ++j) { const v2u a = ((const v2u*)lp)[F.lane + 64 * j]; v[j] = (f32x4){bflo(a.x), bfhi(a.x), bflo(a.y), bfhi(a.y)}; } }
        if (T.y) {
            f32x4 yv[4];
            if (T.moe_combine) {
                const int* rr = (const int*)(F.ws + WS_ROUTE + RT_R); const float w0 = ((const float*)(F.ws + WS_ROUTE + RT_W))[row], w1 = 1.f - w0;
                const int p0 = rr[2 * row], p1 = rr[2 * row + 1];
                const v2u* ya = (const v2u*)(T.y + (size_t)p0 * D); const v2u* yb = (const v2u*)(T.y + (size_t)p1 * D);
#pragma unroll
                for (int j = 0; j < 4; ++j) { const v2u a = ya[F.lane + 64 * j], c = yb[F.lane + 64 * j];
                    yv[j] = (f32x4){w0 * bflo(a.x) + w1 * bflo(c.x), w0 * bfhi(a.x) + w1 * bfhi(c.x), w0 * bflo(a.y) + w1 * bflo(c.y), w0 * bfhi(a.y) + w1 * bfhi(c.y)}; }
            } else {
                int yr = row; if (T.y_perm && row < M_LAT) yr = (row & ~8191) + perm_cm(row & 8191);
                const v2u* yp = (const v2u*)(T.y + (size_t)yr * D);
#pragma unroll
                for (int j = 0; j < 4; ++j) { const v2u a = yp[F.lane + 64 * j]; yv[j] = (f32x4){bflo(a.x), bfhi(a.x), bflo(a.y), bfhi(a.y)}; }
            }
            float ss = 0.f;
#pragma unroll
            for (int j = 0; j < 4; ++j) ss += (yv[j].x * yv[j].x + yv[j].y * yv[j].y) + (yv[j].z * yv[j].z + yv[j].w * yv[j].w);
            const float rs = rsqrtf(wave_sum(ss) * (1.f / D) + EPS);
#pragma unroll
            for (int j = 0; j < 4; ++j) v[j] = v[j] + VU[j] * (yv[j] * rs);
        }
        void* dpv = row < M_LAT ? T.lat_dst_l : T.lat_dst_c;
        if (dpv) { const size_t ro = (size_t)(row < M_LAT ? row : row - M_LAT) * D;
            if (T.dst_f32) { float* dp = (float*)dpv + ro;
#pragma unroll
                for (int j = 0; j < 4; ++j) ((f32x4*)dp)[F.lane + 64 * j] = v[j]; }
            else { bf16* dp = (bf16*)dpv + ro;
#pragma unroll
                for (int j = 0; j < 4; ++j) { v2u o; o.x = pk2(v[j].x, v[j].y); o.y = pk2(v[j].z, v[j].w); ((v2u*)dp)[F.lane + 64 * j] = o; } } }
        if (T.vna) {
            float ss = 0.f;
#pragma unroll
            for (int j = 0; j < 4; ++j) ss += (v[j].x * v[j].x + v[j].y * v[j].y) + (v[j].z * v[j].z + v[j].w * v[j].w);
            const float rs = rsqrtf(wave_sum(ss) * (1.f / D) + EPS);
            f32x4 uu[4];
#pragma unroll
            for (int j = 0; j < 4; ++j) uu[j] = (v[j] * rs) * VA[j] + VB[j];
            int ur = row; if (T.u_perm && row < M_LAT) ur = (row & ~8191) + perm_cm(row & 8191);
            if (T.u_fp8) { unsigned* up8 = (unsigned*)((unsigned char*)T.u + (size_t)ur * D);
#pragma unroll
                for (int j = 0; j < 4; ++j) { unsigned w = 0; w = __builtin_amdgcn_cvt_pk_fp8_f32(uu[j].x, uu[j].y, w, false); w = __builtin_amdgcn_cvt_pk_fp8_f32(uu[j].z, uu[j].w, w, true); up8[F.lane + 64 * j] = w; } }
            else { v2u* up = (v2u*)(T.u + (size_t)ur * D);
#pragma unroll
                for (int j = 0; j < 4; ++j) { v2u o; o.x = pk2(uu[j].x, uu[j].y); o.y = pk2(uu[j].z, uu[j].w); up[F.lane + 64 * j] = o; } }
            if (T.route) {
                float lg[8];
#pragma unroll
                for (int e = 0; e < 8; ++e) lg[e] = 0.f;
#pragma unroll
                for (int j = 0; j < 4; ++j)
#pragma unroll
                    for (int i = 0; i < 4; ++i) { const int c = 4 * (F.lane + 64 * j) + i; const f32x4 wa = *(const LAS f32x4*)(WR + c * 8), wb = *(const LAS f32x4*)(WR + c * 8 + 4); const float x = uu[j][i];
                        lg[0] += x * wa.x; lg[1] += x * wa.y; lg[2] += x * wa.z; lg[3] += x * wa.w; lg[4] += x * wb.x; lg[5] += x * wb.y; lg[6] += x * wb.z; lg[7] += x * wb.w; }
                const float* br = F.in[I_EBR] + T.jr * 8;
#pragma unroll
                for (int e = 0; e < 8; ++e) lg[e] = wave_sum(lg[e]) + br[e];
                int e0 = 0; float v0 = lg[0];
#pragma unroll
                for (int e = 1; e < 8; ++e) if (lg[e] > v0) { v0 = lg[e]; e0 = e; }
                int e1 = -1; float v1 = -3.0e38f;
#pragma unroll
                for (int e = 0; e < 8; ++e) if (e != e0 && lg[e] > v1) { v1 = lg[e]; e1 = e; }
                const float w0 = 1.f / (1.f + __expf(v1 - v0));
                if (F.lane == row - r0) { my_e0 = e0; my_e1 = e1; my_w = w0; }
            }
        }
    }
    if (T.route) {
        const int n = r1 - r0; const bool act = F.lane < n; const int row = r0 + F.lane;
        unsigned* ecnt = (unsigned*)(F.ws + WS_CTL) + CW_ECNT + T.jr * 8 * 64;
        int rk0 = 0, rk1 = 0;
        const unsigned long long ltmask = (F.lane == 0) ? 0ull : (~0ull >> (64 - F.lane));
#pragma unroll
        for (int e = 0; e < 8; ++e) {
            const unsigned long long m0 = __ballot(act && my_e0 == e), m1 = __ballot(act && my_e1 == e);
            const int c0 = __popcll(m0), c1 = __popcll(m1);
            unsigned base = 0;
            if (c0 + c1 > 0) { if (F.lane == 0) base = __hip_atomic_fetch_add(ecnt + e * 64, (unsigned)(c0 + c1), RLX_AGENT); base = __builtin_amdgcn_readfirstlane(base); }
            if (my_e0 == e) rk0 = (int)base + __popcll(m0 & ltmask);
            if (my_e1 == e) rk1 = (int)base + c0 + __popcll(m1 & ltmask);
        }
        if (act) { ((int*)(F.ws + WS_ROUTE + RT_E))[row] = my_e0 | (my_e1 << 8); ((int*)(F.ws + WS_ROUTE + RT_R))[2 * row] = rk0; ((int*)(F.ws + WS_ROUTE + RT_R))[2 * row + 1] = rk1;
            ((float*)(F.ws + WS_ROUTE + RT_W))[row] = my_w; }
    }
}

__device__ __forceinline__ void phase_moe_scatter(Frame& F, int jr, int nrows, const unsigned char* U, unsigned char* AM, int rowb) {
    const unsigned* ecnt = (const unsigned*)(F.ws + WS_CTL) + CW_ECNT + jr * 8 * 64;
    int base[8]; int acc = 0;
#pragma unroll
    for (int e = 0; e < 8; ++e) { const int c = (int)__hip_atomic_load(ecnt + e * 64, RLX_AGENT); base[e] = acc; acc += (c + 255) & ~255; }
    int* pexp = (int*)(F.ws + WS_SMALL + SM_PEXP);
    if (F.bid == 0) { const int np = acc >> 8;
        for (int p = F.tid; p < np; p += NTHR) { int e = 0;
#pragma unroll
            for (int q = 1; q < 8; ++q) if (p * 256 >= base[q]) e = q;
            pexp[p] = e; }
        if (F.tid == 0) pexp[MOE_PANELS] = np; }
    const int gw = F.bid * NWAVES + F.wave, NGW = F.G * NWAVES;
    const int R = (nrows + NGW - 1) / NGW; const int r0 = gw * R; int r1 = r0 + R; if (r1 > nrows) r1 = nrows;
    int* rr = (int*)(F.ws + WS_ROUTE + RT_R); const int* re = (const int*)(F.ws + WS_ROUTE + RT_E);
    for (int row = r0; row < r1; ++row) {
        const int ee = re[row], e0 = ee & 255, e1 = ee >> 8; int b0 = 0, b1 = 0;
#pragma unroll
        for (int e = 0; e < 8; ++e) { if (e0 == e) b0 = base[e]; if (e1 == e) b1 = base[e]; }
        const int p0 = b0 + rr[2 * row], p1 = b1 + rr[2 * row + 1];
        const v4u* src = (const v4u*)(U + (size_t)row * rowb); v4u* d0 = (v4u*)(AM + (size_t)p0 * rowb); v4u* d1 = (v4u*)(AM + (size_t)p1 * rowb);
        const v4u a = src[F.lane]; d0[F.lane] = a; d1[F.lane] = a;
        if (rowb > 1024) { const v4u c = src[F.lane + 64]; d0[F.lane + 64] = c; d1[F.lane + 64] = c; }
        CFENCE();
        if (F.lane == 0) { rr[2 * row] = p0; rr[2 * row + 1] = p1; }
    }
}

#define MFMA32(a, b, c) __builtin_amdgcn_mfma_f32_32x32x16_bf16((a), (b), (c), 0, 0, 0)
typedef short v4i16_t __attribute__((ext_vector_type(4)));
typedef LAS unsigned char* ldsp;
__device__ __forceinline__ unsigned cvtpk(float lo, float hi) { f32x2_t v = {lo, hi}; bf16x2_t b = __builtin_convertvector(v, bf16x2_t); return __builtin_bit_cast(unsigned, b); }
__device__ __forceinline__ int crow(int reg, int h) { return (reg & 3) + 8 * (reg >> 2) + 4 * h; }
__device__ __forceinline__ bf16x8 pack8(const f32x16& x, int s) {
    v4u p; p.x = cvtpk(x[8 * s], x[8 * s + 1]); p.y = cvtpk(x[8 * s + 2], x[8 * s + 3]); p.z = cvtpk(x[8 * s + 4], x[8 * s + 5]); p.w = cvtpk(x[8 * s + 6], x[8 * s + 7]);
    return __builtin_bit_cast(bf16x8, p);
}
__device__ __forceinline__ bf16x8 lds16(ldsp p) { return *(const LAS bf16x8*)p; }
__device__ __forceinline__ bf16x8 lds8x2(ldsp p) { const s16x4 lo = *(const LAS s16x4*)p, hi = *(const LAS s16x4*)(p + 16); return __builtin_shufflevector(lo, hi, 0, 1, 2, 3, 4, 5, 6, 7); }
__device__ __forceinline__ s16x4 tr16(ldsp p) { return __builtin_bit_cast(s16x4, __builtin_amdgcn_ds_read_tr16_b64_v4i16((LAS v4i16_t*)p)); }
__device__ __forceinline__ bf16x8 ldstr2(ldsp p, int second) { const s16x4 lo = tr16(p), hi = tr16(p + second); return __builtin_shufflevector(lo, hi, 0, 1, 2, 3, 4, 5, 6, 7); }
__device__ __forceinline__ f32x16 zero16() { f32x16 z;
#pragma unroll
    for (int i = 0; i < 16; ++i) z[i] = 0.f; return z; }
__device__ __forceinline__ void unpack8(const v4u& w, float (&x)[8]) { x[0] = bflo(w.x); x[1] = bfhi(w.x); x[2] = bflo(w.y); x[3] = bfhi(w.y); x[4] = bflo(w.z); x[5] = bfhi(w.z); x[6] = bflo(w.w); x[7] = bfhi(w.w); }
__device__ __forceinline__ int launder_v(int x) { asm volatile("" : "+v"(x)); return x; }
struct FragOff { int o_row, o_perm, o_trn, o_trp; };
__device__ __forceinline__ FragOff frag_off(int lane, int LD) {
    const int r = lane & 31, hh = lane >> 5, i16 = lane & 15, q = i16 >> 2, p = i16 & 3, blk = (lane >> 4) & 1; FragOff f;
    f.o_row = (r * LD + 8 * hh) * 2; f.o_perm = (r * LD + 4 * hh) * 2;
    f.o_trn = ((8 * hh + q) * LD + 16 * blk + 4 * p) * 2; f.o_trp = ((4 * hh + q) * LD + 16 * blk + 4 * p) * 2; return f;
}


template <int CTRL, int RM, int BM> __device__ __forceinline__ float dpp_f(float old, float x) {
    return __builtin_bit_cast(float, __builtin_amdgcn_update_dpp(__builtin_bit_cast(int, old), __builtin_bit_cast(int, x), CTRL, RM, BM, false)); }
__device__ __forceinline__ float wave_scan_add(float x) {
    float r = x;
    r += dpp_f<0x111, 0xf, 0xf>(0.f, x); r += dpp_f<0x112, 0xf, 0xf>(0.f, x); r += dpp_f<0x113, 0xf, 0xf>(0.f, x);
    r += dpp_f<0x114, 0xf, 0xe>(0.f, r); r += dpp_f<0x118, 0xf, 0xc>(0.f, r);
    r += dpp_f<0x142, 0xa, 0xf>(0.f, r); r += dpp_f<0x143, 0xc, 0xf>(0.f, r);
    return r;
}
__device__ __forceinline__ float wave_scan_max(float x) {
    const float NEG = -3.0e38f; float r = x;
    r = fmaxf(r, dpp_f<0x111, 0xf, 0xf>(NEG, x)); r = fmaxf(r, dpp_f<0x112, 0xf, 0xf>(NEG, x)); r = fmaxf(r, dpp_f<0x113, 0xf, 0xf>(NEG, x));
    r = fmaxf(r, dpp_f<0x114, 0xf, 0xe>(NEG, r)); r = fmaxf(r, dpp_f<0x118, 0xf, 0xc>(NEG, r));
    r = fmaxf(r, dpp_f<0x142, 0xa, 0xf>(NEG, r)); r = fmaxf(r, dpp_f<0x143, 0xc, 0xf>(NEG, r));
    return r;
}
__device__ __forceinline__ float lane63(float x) { return __builtin_bit_cast(float, __builtin_amdgcn_readlane(__builtin_bit_cast(int, x), 63)); }
__device__ __forceinline__ float sum_halves(float x) {
    const unsigned u = __builtin_bit_cast(unsigned, x); auto rr = __builtin_amdgcn_permlane32_swap(u, u, false, false);
    return __builtin_bit_cast(float, (unsigned)rr[0]) + __builtin_bit_cast(float, (unsigned)rr[1]); }

__device__ __forceinline__ void item_headnorm(int tid, const bf16* hf, const bf16* hb, const bf16* gate, int gpitch, int gcol, const float* gh_head, bf16* aout, int rowbase, int t0, int ntok, int h) {
    VM_WAIT(); __syncthreads();
    const int sub = tid & 7, rr = tid >> 3;
    float gh[16];
#pragma unroll
    for (int e = 0; e < 16; ++e) gh[e] = gh_head[sub * 16 + e];
#pragma unroll 2
    for (int row = rr; row < ntok; row += 64) {
        const size_t grow = (size_t)(rowbase + t0 + row);
        const size_t o = grow * D + h * 128 + sub * 16;
        const v4u a0 = *(const GAS v4u*)(hf + o), a1 = *(const GAS v4u*)(hf + o + 8), b0 = *(const GAS v4u*)(hb + o), b1 = *(const GAS v4u*)(hb + o + 8);
        const bf16* gp = gate + grow * gpitch + gcol + h * 128 + sub * 16; const v4u g0 = *(const GAS v4u*)gp, g1 = *(const GAS v4u*)(gp + 8);
        float x[16], y[8];
        unpack8(a0, y);
#pragma unroll
        for (int e = 0; e < 8; ++e) x[e] = y[e];
        unpack8(a1, y);
#pragma unroll
        for (int e = 0; e < 8; ++e) x[8 + e] = y[e];
        unpack8(b0, y);
#pragma unroll
        for (int e = 0; e < 8; ++e) x[e] += y[e];
        unpack8(b1, y);
#pragma unroll
        for (int e = 0; e < 8; ++e) x[8 + e] += y[e];
        float ss = 0.f;
#pragma unroll
        for (int e = 0; e < 16; ++e) ss += x[e] * x[e];
        ss += __shfl_xor(ss, 1); ss += __shfl_xor(ss, 2); ss += __shfl_xor(ss, 4);
        const float rs = rsqrtf(ss * (1.f / 128.f) + EPS);
        float o16[16];
        unpack8(g0, y);
#pragma unroll
        for (int e = 0; e < 8; ++e) o16[e] = x[e] * rs * gh[e] * sigmoidf_(y[e]);
        unpack8(g1, y);
#pragma unroll
        for (int e = 0; e < 8; ++e) o16[8 + e] = x[8 + e] * rs * gh[8 + e] * sigmoidf_(y[e]);
        v4u w0, w1; w0.x = pk2(o16[0], o16[1]); w0.y = pk2(o16[2], o16[3]); w0.z = pk2(o16[4], o16[5]); w0.w = pk2(o16[6], o16[7]); w1.x = pk2(o16[8], o16[9]); w1.y = pk2(o16[10], o16[11]); w1.z = pk2(o16[12], o16[13]); w1.w = pk2(o16[14], o16[15]);
        *(GAS v4u*)(aout + o) = w0; *(GAS v4u*)(aout + o + 8) = w1;
    }
}

constexpr int ML_LDQ = 72, ML_LDV = 136;
constexpr int ML_QC = 0, ML_KC = 9216, ML_KH = 18432, ML_V = 27648, ML_GS = 45056, ML_OB = 50176, ML_NV = 68608, ML_SSQ = 70656, ML_INV = 71680, ML_GROUP = 73728;
static_assert(2 * ML_GROUP <= LDS_MAIN, "mLSTM LDS map");
constexpr int ML_STATE_F = 8448;

struct MlPref { v4u q[2], k[2], v[4]; float gi, gf; };
struct MlSeg { int rowbase; int len; int t0; int nchunk; };

__device__ __forceinline__ void ml_issue(MlPref& P, const bf16* proj, const bf16* qkc, const float* gates, int rowbase, int t0c, int g, int h, int tg, int lane, bool need_q) {
    const int c8q = tg & 7;
#pragma unroll
    for (int i = 0; i < 2; ++i) { const int tau = (tg + 256 * i) >> 3; const int t = t0c + (g ? 63 - tau : tau);
        const bf16* rp = qkc + (size_t)(rowbase + t) * D + h * 64 + c8q * 8;
        P.q[i] = need_q ? *(const GAS v4u*)rp : (v4u){0u, 0u, 0u, 0u}; P.k[i] = *(const GAS v4u*)(rp + 512); }
#pragma unroll
    for (int i = 0; i < 4; ++i) { const int p = tg + 256 * i, tau = p >> 4, c8 = p & 15; const int t = t0c + (g ? 63 - tau : tau);
        P.v[i] = *(const GAS v4u*)(proj + (size_t)(rowbase + t) * NP_M + 1024 + h * 128 + c8 * 8); }
    { const int t = t0c + (g ? 63 - lane : lane); const GAS float* gp = (const GAS float*)(gates + (size_t)(rowbase + t) * 32 + g * 16 + h); P.gi = gp[0]; P.gf = gp[8]; }
}

template <bool OUTPUT>
__device__ __forceinline__ void mlstm_item(Frame& F, const bf16* proj, const bf16* qkc, const float* gates, bf16* hx0, bf16* hx1, bf16* aout, const float* ghead,
                                           int h, MlSeg S0, MlSeg S1, const float* st_in0, const float* st_in1, int npre0, int npre1, float* st_out0, float* st_out1) {
    const int tid_l = launder_v(F.tid); const int wave_l = __builtin_amdgcn_readfirstlane(tid_l >> 6);
    const int g = wave_l >> 2, j = wave_l & 3, tg = tid_l & 255, lane = tid_l & 63, r = lane & 31, hh = lane >> 5;
    const ldsp gb = F.lds + g * ML_GROUP;
    const ldsp GSb = gb + ML_GS + j * 1280;
    LAS float* GS = (LAS float*)GSb;
    const ldsp OBb = gb + ML_OB + j * 4608;
    LAS float* NV = (LAS float*)(gb + ML_NV);
    LAS float* SSQ = (LAS float*)(gb + ML_SSQ);
    const ldsp INVb = gb + ML_INV + j * 256;
    const int rowbase = g ? S1.rowbase : S0.rowbase, seg_t0 = g ? S1.t0 : S0.t0, nch = g ? S1.nchunk : S0.nchunk;
    const int vcol = 64 * j;
    __syncthreads();
    f32x16 C[2]; C[0] = zero16(); C[1] = zero16();
    float m_prev = -1.0e30f, btot = 0.f;
    float nreg = 0.f;
    if (OUTPUT) {
        const float* sp = g ? st_in1 : st_in0; const int np = g ? npre1 : npre0;
#pragma unroll 1
        for (int k = 0; k < np; ++k) { const float* e = sp + (size_t)k * ML_STATE_F;
            const float mloc = e[8192 + 64], B = e[8192 + 65];
            const float mnew = fmaxf(B + m_prev, mloc), al = __expf(B + m_prev - mnew), be = __expf(mloc - mnew);
            const float* ep = e + (4 * hh) * 128 + 32 * j + r;
#pragma unroll
            for (int dt = 0; dt < 2; ++dt)
#pragma unroll
                for (int i = 0; i < 16; ++i) C[dt][i] = al * C[dt][i] + be * ep[(32 * dt + (i & 3) + 8 * (i >> 2)) * 128];
            nreg = al * nreg + be * e[8192 + 16 * j + (lane & 15)];
            m_prev = mnew; }
    }
    if (lane < 16) NV[16 * j + lane] = nreg;
    MlPref PP[2]; ml_issue(PP[0], proj, qkc, gates, rowbase, seg_t0 + 64 * (g ? nch - 1 : 0), g, h, tg, lane, OUTPUT);
    ml_issue(PP[1], proj, qkc, gates, rowbase, seg_t0 + 64 * (g ? nch - 2 : 1), g, h, tg, lane, OUTPUT);
    __syncthreads();
#pragma unroll 1
    for (int step2 = 0; step2 < nch; step2 += 2) {
#pragma unroll
    for (int hf = 0; hf < 2; ++hf) { const int step = step2 + hf; MlPref& P = PP[hf];
        const int tgs = launder_v(tg), lns = launder_v(lane);
        const int r = lns & 31, hh = lns >> 5;
        const FragOff fq = frag_off(lns, ML_LDQ), fv = frag_off(lns, ML_LDV);
        const int o_h4 = 16 * hh;
        const int o_obw = (4 * hh * 36 + r) * 4, o_obr = ((lns >> 1) * 36 + 16 * (lns & 1)) * 4;
        const int ci = g ? nch - 1 - step : step;
        const int par = step & 1;
        float decay;
        {
            const float xi = P.gi, lf = P.gf;
            const float bc = wave_scan_add(lf);
            const float a = xi - bc; const float pm = wave_scan_max(a);
            const float Mt = fmaxf(m_prev, pm);
            const float Ml = lane63(Mt), bl = lane63(bc);
            GS[lns] = a; GS[64 + lns] = Mt; GS[128 + lns] = __expf(m_prev - Mt); GS[192 + lns] = __expf(-(bc + Mt)); GS[256 + lns] = __expf(a - Ml);
            decay = __expf(m_prev - Ml); m_prev = bl + Ml; btot += bl;
        }
        LDS_WAIT(); CFENCE();
        {
            const int c8 = tgs & 7;
#pragma unroll
            for (int i = 0; i < 2; ++i) { const int tau = (tgs + 256 * i) >> 3; const ldsp tp = gb + (tau * ML_LDQ + c8 * 8) * 2;
                if (OUTPUT) { *(LAS v4u*)(tp + ML_QC) = P.q[i]; *(LAS v4u*)(tp + ML_KC) = P.k[i]; }
                float o[8]; unpack8(P.k[i], o); const float wkk = GS[256 + tau]; v4u w;
                w.x = pk2(o[0] * wkk, o[1] * wkk); w.y = pk2(o[2] * wkk, o[3] * wkk); w.z = pk2(o[4] * wkk, o[5] * wkk); w.w = pk2(o[6] * wkk, o[7] * wkk);
                *(LAS v4u*)(tp + ML_KH) = w; }
#pragma unroll
            for (int i = 0; i < 4; ++i) { const int p = tgs + 256 * i, tau = p >> 4, cc = p & 15; *(LAS v4u*)(gb + ML_V + (tau * ML_LDV + cc * 8) * 2) = P.v[i]; }
        }
        if (step + 2 < nch) ml_issue(P, proj, qkc, gates, rowbase, seg_t0 + 64 * (g ? nch - 3 - step : step + 2), g, h, tgs, lns, OUTPUT);
        __syncthreads();
        if (OUTPUT) {
            bf16* hx = g ? hx1 : hx0;
#pragma unroll
            for (int tt = 0; tt < 2; ++tt) {
                f32x16 acc = zero16();
#pragma unroll
                for (int dt = 0; dt < 2; ++dt)
#pragma unroll
                    for (int sp = 0; sp < 2; ++sp) acc = MFMA32(lds8x2(gb + ML_QC + fq.o_perm + (32 * tt * ML_LDQ + 32 * dt + 16 * sp) * 2), pack8(C[dt], sp), acc);
#pragma unroll
                for (int q4 = 0; q4 < 4; ++q4) { const f32x4 wv = *(const LAS f32x4*)(GSb + o_h4 + (128 + 32 * tt + 8 * q4) * 4);
#pragma unroll
                    for (int e = 0; e < 4; ++e) acc[4 * q4 + e] *= wv[e]; }
                const float Mt = GS[64 + 32 * tt + r];
                float den = 0.f;
#pragma unroll
                for (int st = 0; st <= tt; ++st) {
                    f32x16 s = zero16();
#pragma unroll
                    for (int ks = 0; ks < 4; ++ks) s = MFMA32(lds16(gb + ML_KC + fq.o_row + (32 * st * ML_LDQ + 16 * ks) * 2), lds16(gb + ML_QC + fq.o_row + (32 * tt * ML_LDQ + 16 * ks) * 2), s);
#pragma unroll
                    for (int q4 = 0; q4 < 4; ++q4) { const f32x4 av = *(const LAS f32x4*)(GSb + o_h4 + (32 * st + 8 * q4) * 4);
#pragma unroll
                        for (int e = 0; e < 4; ++e) { const int i = 4 * q4 + e; const int srow = 32 * st + crow(i, hh); const float pv = (srow <= 32 * tt + r) ? s[i] * __expf(av[e] - Mt) : 0.f; s[i] = pv; den += pv; } }
                    const bf16x8 pa0 = pack8(s, 0), pa1 = pack8(s, 1);
                    acc = MFMA32(pa0, ldstr2(gb + ML_V + fv.o_trp + vcol + ((32 * st) * ML_LDV) * 2, 8 * ML_LDV * 2), acc);
                    acc = MFMA32(pa1, ldstr2(gb + ML_V + fv.o_trp + vcol + ((32 * st + 16) * ML_LDV) * 2, 8 * ML_LDV * 2), acc);
                    }
                float qn;
                { float q0 = 0.f, q1 = 0.f, q2 = 0.f, q3 = 0.f;
#pragma unroll
                for (int c4 = 0; c4 < 4; ++c4) { const v4u qw = *(const LAS v4u*)(gb + ML_QC + (r * ML_LDQ + 32 * hh) * 2 + (32 * tt * ML_LDQ + 8 * c4) * 2); float qx[8]; unpack8(qw, qx);
                    const f32x4 n0 = *(const LAS f32x4*)(gb + ML_NV + 8 * o_h4 + (par * 64 + 8 * c4) * 4), n1 = *(const LAS f32x4*)(gb + ML_NV + 8 * o_h4 + (par * 64 + 8 * c4 + 4) * 4);
                    q0 += qx[0] * n0[0] + qx[4] * n1[0]; q1 += qx[1] * n0[1] + qx[5] * n1[1]; q2 += qx[2] * n0[2] + qx[6] * n1[2]; q3 += qx[3] * n0[3] + qx[7] * n1[3]; }
                qn = (q0 + q1) + (q2 + q3); }
                den = sum_halves(den); qn = sum_halves(qn);
                const float dtot = den + GS[128 + 32 * tt + r] * qn;
                const float inv = __builtin_amdgcn_rcpf(fmaxf(fabsf(dtot), GS[192 + 32 * tt + r]));
                if (hh == 0) *(LAS float*)(INVb + (32 * tt + r) * 4) = inv;
                LDS_WAIT(); CFENCE();
                f32x16 hv;
#pragma unroll
                for (int q4 = 0; q4 < 4; ++q4) { const f32x4 iv = *(const LAS f32x4*)(INVb + o_h4 + (32 * tt + 8 * q4) * 4);
#pragma unroll
                    for (int e = 0; e < 4; ++e) { const int i = 4 * q4 + e; hv[i] = acc[i] * iv[e]; } }
#pragma unroll
                for (int i = 0; i < 16; ++i) *(LAS float*)(OBb + o_obw + ((i & 3) + 8 * (i >> 2)) * 144) = hv[i];
                LDS_WAIT(); CFENCE();
                { const f32x4 x0 = *(const LAS f32x4*)(OBb + o_obr), x1 = *(const LAS f32x4*)(OBb + o_obr + 16), x2 = *(const LAS f32x4*)(OBb + o_obr + 32), x3 = *(const LAS f32x4*)(OBb + o_obr + 48);
                    const int tau = 32 * tt + (lns >> 1); const int t = seg_t0 + 64 * ci + (g ? 63 - tau : tau);
                    bf16* op = hx + (size_t)(rowbase + t) * D + h * 128 + 32 * j + 16 * (lns & 1);
                    v4u w0, w1; w0.x = pk2(x0[0], x0[1]); w0.y = pk2(x0[2], x0[3]); w0.z = pk2(x1[0], x1[1]); w0.w = pk2(x1[2], x1[3]); w1.x = pk2(x2[0], x2[1]); w1.y = pk2(x2[2], x2[3]); w1.z = pk2(x3[0], x3[1]); w1.w = pk2(x3[2], x3[3]);
                    *(GAS v4u*)op = w0; *(GAS v4u*)(op + 8) = w1; }
                LDS_WAIT(); CFENCE();
            }
        }
        __builtin_amdgcn_sched_barrier(0);
#pragma unroll
        for (int dt = 0; dt < 2; ++dt) {
#pragma unroll
            for (int i = 0; i < 16; ++i) C[dt][i] *= decay;
#pragma unroll
            for (int ks = 0; ks < 4; ++ks) C[dt] = MFMA32(ldstr2(gb + ML_KH + fq.o_trn + (16 * ks * ML_LDQ + 32 * dt) * 2, 4 * ML_LDQ * 2), ldstr2(gb + ML_V + fv.o_trn + vcol + (16 * ks * ML_LDV) * 2, 4 * ML_LDV * 2), C[dt]);
        }
        {   const int dkl = 16 * j + (lns & 15), tq = lns >> 4; float s0 = 0.f, s1 = 0.f;
#pragma unroll
            for (int i = 0; i < 16; i += 2) { s0 += bf2f(*(const LAS bf16*)(gb + ML_KH + ((16 * tq + i) * ML_LDQ + dkl) * 2)); s1 += bf2f(*(const LAS bf16*)(gb + ML_KH + ((16 * tq + i + 1) * ML_LDQ + dkl) * 2)); }
            float sacc = s0 + s1; sacc += __shfl_xor(sacc, 16); sacc = sum_halves(sacc);
            nreg = decay * nreg + sacc; if (lns < 16) NV[(par ^ 1) * 64 + dkl] = nreg; }
        __syncthreads();
    } }
    if (OUTPUT) item_headnorm(launder_v(tid_l), hx0, hx1, proj, NP_M, 2048, ghead + h * 128, aout, S0.rowbase, S0.t0, S0.nchunk * 64, h);
    if (!OUTPUT) {
        float* e = g ? st_out1 : st_out0; float* ep = e + (4 * hh) * 128 + 32 * j + r;
#pragma unroll
        for (int dt = 0; dt < 2; ++dt)
#pragma unroll
            for (int i = 0; i < 16; ++i) ep[(32 * dt + (i & 3) + 8 * (i >> 2)) * 128] = C[dt][i];
        if (lane < 16) e[8192 + 16 * j + lane] = nreg;
        if (j == 0 && lane == 0) { e[8192 + 64] = m_prev; e[8192 + 65] = btot; }
    }
}

constexpr int HG_LD = 136;
constexpr int HG_LF = 0, HG_QT = 16384, HG_KT = 25088, HG_KH = 33792, HG_V = 42496, HG_OB = 51200, HG_AUX = 69632, HG_SSQ = 71168, HG_EAM = 71680, HG_BIAS = 72192, HG_LBV = 72704, HG_GROUP = 73728;
static_assert(2 * HG_GROUP <= LDS_MAIN, "HGRN2 LDS map");
constexpr int HG_STATE_F = 16512;

struct HgPref { v4u q[2], f[2], v[2]; };
__device__ __forceinline__ void hg_issue(HgPref& P, const bf16* proj, int rowbase, int t0c, int g, int h, int tg, bool need_q) {
#pragma unroll
    for (int i = 0; i < 2; ++i) { const int p = tg + 256 * i, tau = p >> 4, c8 = p & 15; const int t = t0c + (g ? 31 - tau : tau);
        const bf16* rp = proj + (size_t)(rowbase + t) * NP_H + h * 128 + c8 * 8;
        P.q[i] = need_q ? *(const GAS v4u*)rp : (v4u){0u, 0u, 0u, 0u}; P.v[i] = *(const GAS v4u*)(rp + 1024); P.f[i] = *(const GAS v4u*)(rp + 2048 + 1024 * g); }
}
__device__ __forceinline__ float clamp80(float x) { return fminf(fmaxf(x, -80.f), 80.f); }

template <bool OUTPUT>
__device__ __forceinline__ void hgrn_item(Frame& F, const bf16* proj, bf16* hx0, bf16* hx1, bf16* aout, const float* ghead, const float* bf_, const float* lbraw, int jl,
                                          int h, MlSeg S0, MlSeg S1, const float* st_in0, const float* st_in1, int npre0, int npre1, float* st_out0, float* st_out1) {
    const int tid_l = launder_v(F.tid); const int wave_l = __builtin_amdgcn_readfirstlane(tid_l >> 6);
    const int g = wave_l >> 2, j = wave_l & 3, tg = tid_l & 255, lane = tid_l & 63, r = lane & 31, hh = lane >> 5;
    const ldsp gb = F.lds + g * HG_GROUP;
    LAS float* LF = (LAS float*)(gb + HG_LF);
    const ldsp OBb = gb + HG_OB + j * 4608;
    LAS float* AMID = (LAS float*)(gb + HG_AUX); LAS float* ALAST = AMID + 128; LAS float* DEC = AMID + 256;
    LAS float* SSQ = (LAS float*)(gb + HG_SSQ); LAS float* EAM = (LAS float*)(gb + HG_EAM); LAS float* BIASV = (LAS float*)(gb + HG_BIAS); LAS float* LBV = (LAS float*)(gb + HG_LBV);
    const int rowbase = g ? S1.rowbase : S0.rowbase, seg_t0 = g ? S1.t0 : S0.t0, nch = g ? S1.nchunk : S0.nchunk;
    const int vcol = 64 * j;
    __syncthreads();
    if (tg < 128) { const int c = h * 128 + tg; BIASV[tg] = bf_[g * 1024 + c]; LBV[tg] = jl == 0 ? 0.f : sigmoidf_(lbraw[(1 * 2 + g) * 1024 + c] - lbraw[(0 * 2 + g) * 1024 + c]); }
    f32x16 St[4];
#pragma unroll
    for (int dt = 0; dt < 4; ++dt) St[dt] = zero16();
    float atot = 0.f;
    if (OUTPUT) {   const float* sp = g ? st_in1 : st_in0; const int np = g ? npre1 : npre0;
#pragma unroll 1
        for (int k = 0; k < np; ++k) { const float* e = sp + (size_t)k * HG_STATE_F; const float* ep = e + (4 * hh) * 128 + 32 * j + r; const float* ap = e + 16384 + 4 * hh;
#pragma unroll
            for (int dt = 0; dt < 4; ++dt)
#pragma unroll
                for (int i = 0; i < 16; ++i) { const int dk0 = 32 * dt + (i & 3) + 8 * (i >> 2); St[dt][i] = __expf(ap[dk0]) * St[dt][i] + ep[dk0 * 128]; } }
    }
    HgPref PP[2]; hg_issue(PP[0], proj, rowbase, seg_t0 + 32 * (g ? nch - 1 : 0), g, h, tg, OUTPUT);
    hg_issue(PP[1], proj, rowbase, seg_t0 + 32 * (g ? nch - 2 : 1), g, h, tg, OUTPUT);
    __syncthreads();
#pragma unroll 1
    for (int step2 = 0; step2 < nch; step2 += 2) {
#pragma unroll
    for (int hf = 0; hf < 2; ++hf) { const int step = step2 + hf; HgPref& P = PP[hf];
        const int tgs = launder_v(tg), lns = launder_v(lane);
        const int r = lns & 31, hh = lns >> 5;
        const FragOff fo = frag_off(lns, HG_LD);
        const int o_h4 = 16 * hh;
        const int o_obw = (4 * hh * 36 + r) * 4, o_obr = ((lns >> 1) * 36 + 16 * (lns & 1)) * 4;
        const int c8 = tgs & 15;
        const int o_piece = (((tgs >> 4) * HG_LD) + c8 * 8) * 2;
        const int ci = g ? nch - 1 - step : step;
#pragma unroll
        for (int i = 0; i < 2; ++i) { const int tau = (tgs + 256 * i) >> 4; float x[8], lf[8], kk[8]; unpack8(P.f[i], x);
            const f32x4 b0 = *(const LAS f32x4*)(BIASV + c8 * 8), b1 = *(const LAS f32x4*)(BIASV + c8 * 8 + 4), l0 = *(const LAS f32x4*)(LBV + c8 * 8), l1 = *(const LAS f32x4*)(LBV + c8 * 8 + 4);
            const float bb[8] = {b0[0], b0[1], b0[2], b0[3], b1[0], b1[1], b1[2], b1[3]}, ll[8] = {l0[0], l0[1], l0[2], l0[3], l1[0], l1[1], l1[2], l1[3]};
#pragma unroll
            for (int e = 0; e < 8; ++e) { const float sg = sigmoidf_(x[e] + bb[e]); const float f = ll[e] + (1.f - ll[e]) * sg; lf[e] = __logf(fmaxf(f, 1e-37f)); kk[e] = 1.f - f; }
            *(LAS f32x4*)(LF + tau * 128 + c8 * 8) = (f32x4){lf[0], lf[1], lf[2], lf[3]}; *(LAS f32x4*)(LF + tau * 128 + c8 * 8 + 4) = (f32x4){lf[4], lf[5], lf[6], lf[7]};
            v4u w; w.x = pk2(kk[0], kk[1]); w.y = pk2(kk[2], kk[3]); w.z = pk2(kk[4], kk[5]); w.w = pk2(kk[6], kk[7]);
            const ldsp tp = gb + o_piece + i * (16 * HG_LD * 2);
            *(LAS v4u*)(tp + HG_KT) = w;
            if (OUTPUT) *(LAS v4u*)(tp + HG_QT) = P.q[i];
            *(LAS v4u*)(tp + HG_V) = P.v[i]; }
        if (step + 2 < nch) hg_issue(P, proj, rowbase, seg_t0 + 32 * (g ? nch - 3 - step : step + 2), g, h, tgs, OUTPUT);
        __syncthreads();
        {   const int dkc = tgs & 127, half = tgs >> 7; float pre = 0.f;
            if (half) { float p0 = 0.f, p1 = 0.f, p2 = 0.f, p3 = 0.f;
#pragma unroll
                for (int tau = 0; tau < 16; tau += 4) { p0 += LF[tau * 128 + dkc]; p1 += LF[(tau + 1) * 128 + dkc]; p2 += LF[(tau + 2) * 128 + dkc]; p3 += LF[(tau + 3) * 128 + dkc]; }
                pre = (p0 + p1) + (p2 + p3); }
            float v[16];
#pragma unroll
            for (int i = 0; i < 16; ++i) v[i] = LF[(16 * half + i) * 128 + dkc];
            LDS_WAIT(); __builtin_amdgcn_s_barrier(); CFENCE();
            float run = pre;
#pragma unroll
            for (int i = 0; i < 16; ++i) { run += v[i]; LF[(16 * half + i) * 128 + dkc] = run; }
            if (!half) { AMID[dkc] = run; EAM[dkc] = __expf(run); } else { ALAST[dkc] = run; DEC[dkc] = __expf(run); atot += run; } }
        __syncthreads();
#pragma unroll
        for (int i = 0; i < 2; ++i) { const int tau = (tgs + 256 * i) >> 4; const ldsp tp = gb + o_piece + i * (16 * HG_LD * 2);
            const f32x4 a0 = *(const LAS f32x4*)(LF + tau * 128 + c8 * 8), a1 = *(const LAS f32x4*)(LF + tau * 128 + c8 * 8 + 4);
            const f32x4 m0 = *(const LAS f32x4*)(AMID + c8 * 8), m1 = *(const LAS f32x4*)(AMID + c8 * 8 + 4), l0 = *(const LAS f32x4*)(ALAST + c8 * 8), l1 = *(const LAS f32x4*)(ALAST + c8 * 8 + 4);
            float a[8] = {a0[0], a0[1], a0[2], a0[3], a1[0], a1[1], a1[2], a1[3]}, am[8] = {m0[0], m0[1], m0[2], m0[3], m1[0], m1[1], m1[2], m1[3]}, al[8] = {l0[0], l0[1], l0[2], l0[3], l1[0], l1[1], l1[2], l1[3]};
            float qx[8], kx[8], qo[8], ko[8], ho[8]; { const v4u kw = *(const LAS v4u*)(tp + HG_KT); unpack8(kw, kx); if (OUTPUT) { const v4u qw = *(const LAS v4u*)(tp + HG_QT); unpack8(qw, qx); } }
#pragma unroll
            for (int e = 0; e < 8; ++e) { if (OUTPUT) { qo[e] = qx[e] * __expf(clamp80(a[e] - am[e])); ko[e] = kx[e] * __expf(clamp80(am[e] - a[e])); } ho[e] = kx[e] * __expf(al[e] - a[e]); }
            v4u w;
            if (OUTPUT) { w.x = pk2(qo[0], qo[1]); w.y = pk2(qo[2], qo[3]); w.z = pk2(qo[4], qo[5]); w.w = pk2(qo[6], qo[7]); *(LAS v4u*)(tp + HG_QT) = w;
                w.x = pk2(ko[0], ko[1]); w.y = pk2(ko[2], ko[3]); w.z = pk2(ko[4], ko[5]); w.w = pk2(ko[6], ko[7]); *(LAS v4u*)(tp + HG_KT) = w; }
            w.x = pk2(ho[0], ho[1]); w.y = pk2(ho[2], ho[3]); w.z = pk2(ho[4], ho[5]); w.w = pk2(ho[6], ho[7]); *(LAS v4u*)(tp + HG_KH) = w; }
        __syncthreads();
        if (OUTPUT) {
            bf16* hx = g ? hx1 : hx0;
            f32x16 s = zero16();
#pragma unroll
            for (int ks = 0; ks < 8; ++ks) s = MFMA32(lds16(gb + HG_KT + fo.o_row + 32 * ks), lds16(gb + HG_QT + fo.o_row + 32 * ks), s);
#pragma unroll
            for (int i = 0; i < 16; ++i) s[i] = (crow(i, hh) <= r) ? s[i] : 0.f;
            f32x16 o = zero16();
#pragma unroll
            for (int sp = 0; sp < 2; ++sp) o = MFMA32(pack8(s, sp), ldstr2(gb + HG_V + fo.o_trp + vcol + (16 * sp * HG_LD) * 2, 8 * HG_LD * 2), o);
#pragma unroll
            for (int dt = 0; dt < 4; ++dt)
#pragma unroll
                for (int sp = 0; sp < 2; ++sp) { const f32x4 e0 = *(const LAS f32x4*)(gb + HG_EAM + o_h4 + (32 * dt + 16 * sp) * 4), e1 = *(const LAS f32x4*)(gb + HG_EAM + o_h4 + (32 * dt + 16 * sp + 8) * 4);
                    v4u pw; pw.x = cvtpk(St[dt][8 * sp] * e0[0], St[dt][8 * sp + 1] * e0[1]); pw.y = cvtpk(St[dt][8 * sp + 2] * e0[2], St[dt][8 * sp + 3] * e0[3]);
                    pw.z = cvtpk(St[dt][8 * sp + 4] * e1[0], St[dt][8 * sp + 5] * e1[1]); pw.w = cvtpk(St[dt][8 * sp + 6] * e1[2], St[dt][8 * sp + 7] * e1[3]);
                    o = MFMA32(lds8x2(gb + HG_QT + fo.o_perm + (32 * dt + 16 * sp) * 2), __builtin_bit_cast(bf16x8, pw), o); }
#pragma unroll
            for (int i = 0; i < 16; ++i) *(LAS float*)(OBb + o_obw + ((i & 3) + 8 * (i >> 2)) * 144) = o[i];
            LDS_WAIT(); CFENCE();
            { const f32x4 x0 = *(const LAS f32x4*)(OBb + o_obr), x1 = *(const LAS f32x4*)(OBb + o_obr + 16), x2 = *(const LAS f32x4*)(OBb + o_obr + 32), x3 = *(const LAS f32x4*)(OBb + o_obr + 48);
                const int tau = lns >> 1; const int t = seg_t0 + 32 * ci + (g ? 31 - tau : tau);
                bf16* op = hx + (size_t)(rowbase + t) * D + h * 128 + 32 * j + 16 * (lns & 1);
                v4u w0, w1; w0.x = pk2(x0[0], x0[1]); w0.y = pk2(x0[2], x0[3]); w0.z = pk2(x1[0], x1[1]); w0.w = pk2(x1[2], x1[3]); w1.x = pk2(x2[0], x2[1]); w1.y = pk2(x2[2], x2[3]); w1.z = pk2(x3[0], x3[1]); w1.w = pk2(x3[2], x3[3]);
                *(GAS v4u*)op = w0; *(GAS v4u*)(op + 8) = w1; }
            LDS_WAIT(); CFENCE();
        }
#pragma unroll
        for (int dt = 0; dt < 4; ++dt) {
#pragma unroll
            for (int q4 = 0; q4 < 4; ++q4) { const f32x4 dv = *(const LAS f32x4*)(gb + HG_AUX + 1024 + o_h4 + (32 * dt + 8 * q4) * 4);
#pragma unroll
                for (int e = 0; e < 4; ++e) St[dt][4 * q4 + e] *= dv[e]; }
#pragma unroll
            for (int sp = 0; sp < 2; ++sp) St[dt] = MFMA32(ldstr2(gb + HG_KH + fo.o_trn + (16 * sp * HG_LD + 32 * dt) * 2, 4 * HG_LD * 2), ldstr2(gb + HG_V + fo.o_trn + vcol + (16 * sp * HG_LD) * 2, 4 * HG_LD * 2), St[dt]);
        }
        __syncthreads();
    } }
    if (OUTPUT) item_headnorm(launder_v(tid_l), hx0, hx1, proj, NP_H, 4096, ghead + h * 128, aout, S0.rowbase, S0.t0, S0.nchunk * 32, h);
    if (!OUTPUT) {
        float* e = g ? st_out1 : st_out0; float* ep = e + (4 * hh) * 128 + 32 * j + r;
#pragma unroll
        for (int dt = 0; dt < 4; ++dt)
#pragma unroll
            for (int i = 0; i < 16; ++i) ep[(32 * dt + (i & 3) + 8 * (i >> 2)) * 128] = St[dt][i];
        if (tg >= 128) e[16384 + (tg & 127)] = atot;
    }
}

constexpr int PH_PER_LAYER = 11, PH_BASE = 2, N_PHASES = PH_BASE + DEPTH * PH_PER_LAYER;
#ifndef EN_GEMM
#define EN_GEMM 0xff
#endif
#ifndef EN_ML
#define EN_ML 3
#endif
#ifndef EN_HG
#define EN_HG 3
#endif
#ifndef EN_TOK
#define EN_TOK 1
#endif
#ifndef EN_MISC
#define EN_MISC 1
#endif
#ifndef PG_SP2
#define PG_SP2 true
#endif
#ifndef PG_ALIGN
#define PG_ALIGN true
#endif
#ifndef TIMER_MASK
#define TIMER_MASK 0ull
#endif
#ifndef TIMER_DIV
#define TIMER_DIV 20.0f
#endif
#ifndef MK_SPLIT
#define MK_SPLIT 0
#endif


__device__ __forceinline__ void phase_headnorm(Frame& F, const bf16* hf, const bf16* hb, const bf16* gate, int gpitch, int gcol0, const float* ghead, bf16* aout, int nrows) {
    const int tid = launder_v(F.tid); const int lane = tid & 63, wave = __builtin_amdgcn_readfirstlane(tid >> 6);
    const int gw = F.bid * NWAVES + wave, NGW = F.G * NWAVES;
    float gh[16];
#pragma unroll
    for (int e = 0; e < 16; ++e) gh[e] = ghead[lane * 16 + e];
    for (int row = gw; row < nrows; row += NGW) {
        const v4u a0 = *(const v4u*)(hf + (size_t)row * D + lane * 16), a1 = *(const v4u*)(hf + (size_t)row * D + lane * 16 + 8);
        const v4u b0 = *(const v4u*)(hb + (size_t)row * D + lane * 16), b1 = *(const v4u*)(hb + (size_t)row * D + lane * 16 + 8);
        const v4u g0 = *(const v4u*)(gate + (size_t)row * gpitch + gcol0 + lane * 16), g1 = *(const v4u*)(gate + (size_t)row * gpitch + gcol0 + lane * 16 + 8);
        float x[16], y[8], o[16]; unpack8(a0, y);
#pragma unroll
        for (int e = 0; e < 8; ++e) x[e] = y[e];
        unpack8(a1, y);
#pragma unroll
        for (int e = 0; e < 8; ++e) x[8 + e] = y[e];
        unpack8(b0, y);
#pragma unroll
        for (int e = 0; e < 8; ++e) x[e] += y[e];
        unpack8(b1, y);
#pragma unroll
        for (int e = 0; e < 8; ++e) x[8 + e] += y[e];
        float ss = 0.f;
#pragma unroll
        for (int e = 0; e < 16; ++e) ss += x[e] * x[e];
        ss += __shfl_xor(ss, 1); ss += __shfl_xor(ss, 2); ss += __shfl_xor(ss, 4);
        const float rs = rsqrtf(ss * (1.f / 128.f) + EPS);
        unpack8(g0, y);
#pragma unroll
        for (int e = 0; e < 8; ++e) o[e] = x[e] * rs * gh[e] * sigmoidf_(y[e]);
        unpack8(g1, y);
#pragma unroll
        for (int e = 0; e < 8; ++e) o[8 + e] = x[8 + e] * rs * gh[8 + e] * sigmoidf_(y[e]);
        v4u w0, w1; w0.x = pk2(o[0], o[1]); w0.y = pk2(o[2], o[3]); w0.z = pk2(o[4], o[5]); w0.w = pk2(o[6], o[7]); w1.x = pk2(o[8], o[9]); w1.y = pk2(o[10], o[11]); w1.z = pk2(o[12], o[13]); w1.w = pk2(o[14], o[15]);
        *(v4u*)(aout + (size_t)row * D + lane * 16) = w0; *(v4u*)(aout + (size_t)row * D + lane * 16 + 8) = w1;
    }
}

__device__ __forceinline__ void phase_conv(Frame& F, const bf16* proj, bf16* qkc, float* gates, const float* wconv, const float* bgate) {
    const int gt = F.bid * NTHR + F.tid, cp = gt & 127, rstep = (F.G * NTHR) >> 7;
    float w[3][8];
#pragma unroll
    for (int d = 0; d < 3; ++d)
#pragma unroll
        for (int e = 0; e < 8; ++e) w[d][e] = wconv[d * 1024 + cp * 8 + e];
    const float sc = cp >= 64 ? 0.125f : 1.0f;
    for (int row = gt >> 7; row < M_ALL; row += rstep) {
        int t, len; if (row < M_LAT) { t = row & (SEQ - 1); len = SEQ; } else { t = (row - M_LAT) & (CTXL - 1); len = CTXL; }
        const bf16* rp = proj + (size_t)row * NP_M + cp * 8;
        const v4u z = (v4u){0u, 0u, 0u, 0u};
        const v4u r0 = t > 0 ? *(const v4u*)(rp - NP_M) : z, r1 = *(const v4u*)rp, r2 = t + 1 < len ? *(const v4u*)(rp + NP_M) : z;
        float x0[8], x1[8], x2[8], o[8]; unpack8(r0, x0); unpack8(r1, x1); unpack8(r2, x2);
#pragma unroll
        for (int e = 0; e < 8; ++e) o[e] = sc * siluf_(w[0][e] * x0[e] + w[1][e] * x1[e] + w[2][e] * x2[e]);
        v4u q; q.x = pk2(o[0], o[1]); q.y = pk2(o[2], o[3]); q.z = pk2(o[4], o[5]); q.w = pk2(o[6], o[7]);
        *(v4u*)(qkc + (size_t)row * D + cp * 8) = q;
    }
    for (int i = gt; i < M_ALL * 32; i += F.G * NTHR) { const int c = i & 31; const float x = gates[i] + bgate[c];
        gates[i] = ((c >> 3) & 1) ? (fminf(x, 0.f) - __logf(1.f + __expf(-fabsf(x)))) : x; }
}

__device__ __forceinline__ void timer_stamp(unsigned char* lds_raw, bool add) {
    if (threadIdx.x == 0) { volatile LAS unsigned* tw = (volatile LAS unsigned*)((LAS unsigned char*)lds_raw + LDSCTL_OFF) + 32;
        const unsigned long long t = wall_clock64(); const unsigned long long last = ((unsigned long long)tw[1] << 32) | tw[0];
        if (add) { unsigned long long acc = ((unsigned long long)tw[3] << 32) | tw[2]; acc += t - last; tw[2] = (unsigned)acc; tw[3] = (unsigned)(acc >> 32); }
        tw[0] = (unsigned)t; tw[1] = (unsigned)(t >> 32); }
}

__device__ __forceinline__ Frame mkframe(const Args& args, unsigned char* lds_raw) {
    Frame F; int t = threadIdx.x; asm volatile("" : "+v"(t));
    F.lds = (LAS unsigned char*)lds_raw; F.tid = t; F.lane = t & 63; F.wave = __builtin_amdgcn_readfirstlane(t >> 6);
    int g = gridDim.x, b = blockIdx.x; asm volatile("" : "+s"(g), "+s"(b)); F.G = g; F.bid = b;
    const __attribute__((address_space(4))) Args* ap = (const __attribute__((address_space(4))) Args*)__builtin_amdgcn_kernarg_segment_ptr(); asm volatile("" : "+s"(ap));
    F.ws = ap->ws; F.in = ap->in; F.out = ap->out;
    return F;
}
#define PHASE_LOCALS \
    Frame F = mkframe(args, lds_raw); unsigned char* ws = F.ws; \
    float* modv = (float*)(ws + WS_MODV); bf16* U = (bf16*)(ws + WS_U); bf16* Y = (bf16*)(ws + WS_Y); bf16* PROJ = (bf16*)(ws + WS_ACT); bf16* HB = (bf16*)(ws + WS_ACT); \
    bf16* AMOE = (bf16*)(ws + WS_ACT); bf16* HMOE = (bf16*)(ws + WS_ACT + (size_t)MOE_ROWS * D * 2); \
    float* GATES = (float*)(ws + WS_GATES); float* LATC = (float*)(ws + WS_LATC); float* STATE = (float*)(ws + WS_STATE); \
    const int* pexp = (const int*)(ws + WS_SMALL + SM_PEXP); \
    unsigned char* wb = ws + (odd ? WS_WO : WS_WE); const float* mv = modv + (size_t)L * 9 * 6 * 1024; \
    (void)modv; (void)U; (void)Y; (void)PROJ; (void)HB; (void)AMOE; (void)HMOE; (void)GATES; (void)LATC; (void)STATE; (void)pexp; (void)wb; (void)mv;

__global__ void __launch_bounds__(NTHR, 2) fwd(Args args) {
    extern __shared__ __attribute__((aligned(16))) unsigned char lds_raw[];
    Frame F = mkframe(args, lds_raw);
    volatile LAS unsigned* LCTL = (volatile LAS unsigned*)(F.lds + LDSCTL_OFF);
    for (int u = F.tid; u < 128; u += NTHR) LCTL[u] = 0u;
    __syncthreads();
    XcdBarrier bar; bar.bar = (unsigned*)(F.ws + WS_CTL) + CW_BAR; bar.x = 0; bar.st = nullptr;
    if (args.use_bar) bar = xcd_barrier_post((unsigned*)(F.ws + WS_CTL) + CW_BAR, LCTL + 8);
    const int lo = args.ph_lo, hi = args.ph_hi;
#define IN(k) (lo <= (k) && (k) < hi)
#define SEAM(k) do { if ((k) + 1 < hi) xcd_barrier(bar); if (TIMER_MASK != 0ull) timer_stamp(lds_raw, ((TIMER_MASK >> (k)) & 1ull) != 0ull); } while (0)
    if (TIMER_MASK != 0ull) timer_stamp(lds_raw, false);
    if (IN(0)) { const int L = 0; const bool odd = false; PHASE_LOCALS if (EN_MISC) phase_mods(F); __syncthreads(); if (EN_MISC) phase_wconv(F, 0); SEAM(0); }
    if (IN(1)) { const int L = 0; const bool odd = false; PHASE_LOCALS
        TokCfg T{}; T.lat_src_l = F.in[I_X]; T.lat_src_c = F.in[I_CTX]; T.src_f32 = 1; T.vna = modv + 0 * 1024; T.vnb = modv + 1 * 1024; T.u = U; T.nrows = M_ALL;
        if (EN_TOK) phase_tok(F, T); __syncthreads(); if (EN_MISC) phase_wconv(F, 1); SEAM(1);
    }
    for (int L = 0; L < DEPTH; ++L) {
        const int pb = PH_BASE + L * PH_PER_LAYER; const bool odd = (L & 1) != 0; const int jl = L >> 1;
        const bool ctx_out = L < DEPTH - 1;
        if (IN(pb + 0)) { PHASE_LOCALS
            pg8::Order S; pg8::Gemm g;
            if (!odd) { g = pg8::Gemm{U, (const bf16*)(wb + WE_IN), M_ALL, NIN_M, D}; S.init(M_ALL / 256, NIN_M, F.G, F.bid, nullptr, 0);
                pg8::EpiStore E{PROJ, NP_M, NP_M / 256, NP_M / 256, GATES, 1.0f}; if (EN_GEMM & (1 << 0)) pg8::gemm_phase<pg8::EpiStore, pg8::Order, PG_ALIGN, PG_SP2>(F.lds, g, S, E); }
            else { g = pg8::Gemm{U, (const bf16*)(wb + WOD_IN), M_ALL, NP_H, D}; S.init(M_ALL / 256, NP_H, F.G, F.bid, nullptr, 0);
                pg8::EpiStore E{PROJ, NP_H, NP_H / 256, -1, nullptr, 1.0f}; if (EN_GEMM & (1 << 1)) pg8::gemm_phase<pg8::EpiStore, pg8::Order, PG_ALIGN, PG_SP2>(F.lds, g, S, E); }
            SEAM(pb + 0);
        }
        if (IN(pb + 1)) {
            if (!odd) { PHASE_LOCALS
                phase_conv(F, PROJ, (bf16*)(ws + WS_ACT + 400 * MiB), GATES, F.in[I_MWCONV] + (size_t)jl * 3 * 1024, F.in[I_MBGATE] + jl * 32); SEAM(pb + 1); }
        }
        if (IN(pb + 2)) { PHASE_LOCALS
            for (int id = F.bid; id < 256; id += F.G) {
                const int bh = id >> 2, p = id & 3, b = bh >> 3, h = bh & 7;
                MlSeg SG0, SG1;
                const int csz = odd ? 32 : 64;
                if (p == 0) { SG0 = MlSeg{M_LAT + b * CTXL, CTXL, 0, CTXL / csz}; SG1 = SG0; }
                else { SG0 = MlSeg{b * SEQ, SEQ, (p - 1) * 2048, 2048 / csz}; SG1 = MlSeg{b * SEQ, SEQ, (4 - p) * 2048, 2048 / csz}; }
                if (!odd) { float* e0 = STATE + (size_t)((bh * 2 + 0) * 4 + p) * ML_STATE_F; float* e1 = STATE + (size_t)((bh * 2 + 1) * 4 + p) * ML_STATE_F;
                    if (EN_ML & 1) mlstm_item<false>(F, PROJ, (const bf16*)(ws + WS_ACT + 400 * MiB), GATES, (bf16*)(ws + WS_ACT + 536 * MiB), (bf16*)(ws + WS_Y), U, F.in[I_MGHEAD] + jl * 1024, h, SG0, SG1, nullptr, nullptr, 0, 0, e0, e1); }
                else { float* e0 = STATE + (size_t)((bh * 2 + 0) * 4 + p) * HG_STATE_F; float* e1 = STATE + (size_t)((bh * 2 + 1) * 4 + p) * HG_STATE_F;
                    if (EN_HG & 1) hgrn_item<false>(F, PROJ, U, (bf16*)(ws + WS_Y), U, F.in[I_HGHEAD] + jl * 1024, F.in[I_HBF] + (size_t)jl * 2048, F.in[I_HLB], jl, h, SG0, SG1, nullptr, nullptr, 0, 0, e0, e1); }
            }
            SEAM(pb + 2);
        }
        if (IN(pb + 3)) { PHASE_LOCALS
            const int nitems = ctx_out ? 320 : 256;
            for (int id = F.bid; id < nitems; id += F.G) {
                MlSeg SG0, SG1; int bh, npre0 = 0, npre1 = 0; const int csz = odd ? 32 : 64;
                if (id < 256) { bh = id >> 2; const int q = id & 3; SG0 = MlSeg{(bh >> 3) * SEQ, SEQ, q * 2048, 2048 / csz}; npre0 = q + 1; npre1 = 4 - q; }
                else { bh = id - 256; SG0 = MlSeg{M_LAT + (bh >> 3) * CTXL, CTXL, 0, CTXL / csz}; }
                SG1 = SG0;
                const int h = bh & 7;
                if (!odd) { const float* s0 = STATE + (size_t)((bh * 2 + 0) * 4) * ML_STATE_F; const float* s1 = STATE + (size_t)((bh * 2 + 1) * 4) * ML_STATE_F;
                    if (EN_ML & 2) mlstm_item<true>(F, PROJ, (const bf16*)(ws + WS_ACT + 400 * MiB), GATES, (bf16*)(ws + WS_ACT + 536 * MiB), (bf16*)(ws + WS_Y), U, F.in[I_MGHEAD] + jl * 1024, h, SG0, SG1, s0, s1, npre0, npre1, nullptr, nullptr); }
                else { const float* s0 = STATE + (size_t)((bh * 2 + 0) * 4) * HG_STATE_F; const float* s1 = STATE + (size_t)((bh * 2 + 1) * 4) * HG_STATE_F;
                    if (EN_HG & 2) hgrn_item<true>(F, PROJ, U, (bf16*)(ws + WS_Y), U, F.in[I_HGHEAD] + jl * 1024, F.in[I_HBF] + (size_t)jl * 2048, F.in[I_HLB], jl, h, SG0, SG1, s0, s1, npre0, npre1, nullptr, nullptr); }
            }
            SEAM(pb + 3);
        }
        if (IN(pb + 5)) { PHASE_LOCALS
            const int nM = (ctx_out ? M_ALL : M_LAT) / 256;
            pg8::Gemm g{U, (const bf16*)(wb + (odd ? WOD_OUT : WE_OUT)), nM * 256, D, D}; pg8::Order S; S.init(nM, D, F.G, F.bid, nullptr, 0);
            pg8::EpiStore E{Y, D, D / 256, -1, nullptr, 1.0f}; if (EN_GEMM & (1 << 2)) pg8::gemm_phase<pg8::EpiStore, pg8::Order, PG_ALIGN, PG_SP2>(F.lds, g, S, E);
            SEAM(pb + 5);
        }
        if (IN(pb + 6)) { PHASE_LOCALS
            TokCfg T{}; bf16* LAT16 = (bf16*)(ws + WS_ACT + 836 * MiB); T.src_f32 = (L == 0) ? 1 : 0; T.lat_src_l = (L == 0) ? (const void*)F.in[I_X] : (const void*)LAT16; T.lat_src_c = (L == 0) ? (const void*)F.in[I_CTX] : (const void*)LATC; T.lat_dst_l = LAT16; T.lat_dst_c = LATC;
            T.y = Y; T.y_perm = odd ? 1 : 0; T.vupd = mv + 2 * 1024; T.vna = mv + 3 * 1024; T.vnb = mv + 4 * 1024; T.u = U; T.u_fp8 = FFN_FP8_L(L); T.route = odd ? 1 : 0; T.jr = jl; T.nrows = ctx_out ? M_ALL : M_LAT;
            if (EN_TOK) phase_tok(F, T);
            if (L >= 1 && L + 1 < DEPTH) { __syncthreads(); if (EN_MISC) phase_wconv(F, L + 1); }
            SEAM(pb + 6);
        }
        if (IN(pb + 7)) { PHASE_LOCALS
            if (odd) { if (EN_MISC) phase_moe_scatter(F, jl, ctx_out ? M_ALL : M_LAT, (const unsigned char*)U, (unsigned char*)AMOE, FFN_FP8_L(L) ? 1024 : 2048); SEAM(pb + 7); }
        }
        if (IN(pb + 8)) { PHASE_LOCALS
            const bool f8 = FFN_FP8_L(L) != 0;
            if (!odd) { pg8::Gemm g{U, (const bf16*)(wb + WE_GU), M_ALL, NGU, D}; pg8::Order S; S.init(M_ALL / 256, NGU, F.G, F.bid, nullptr, 0);
                if (f8) { if ((FP8_LAYERS) & 0x5) { pg8::EpiSwiGLU8 E{(unsigned char*)HB, FF, 1.0f / WSCALE8}; if (EN_GEMM & (1 << 3)) pg8::gemm_phase<pg8::EpiSwiGLU8, pg8::Order, PG_ALIGN, PG_SP2, true>(F.lds, g, S, E); } }
                else { if ((~(FP8_LAYERS)) & 0x5) { pg8::EpiSwiGLU E{HB, FF}; if (EN_GEMM & (1 << 3)) pg8::gemm_phase<pg8::EpiSwiGLU, pg8::Order, PG_ALIGN, PG_SP2>(F.lds, g, S, E); } } }
            else { const int np = __builtin_amdgcn_readfirstlane(pexp[MOE_PANELS]);
                pg8::Gemm g{AMOE, (const bf16*)(wb + WOD_GU), np * 256, NGU, D}; pg8::Order S; S.init(np, NGU, F.G, F.bid, pexp, EGU_BYTES);
                if (f8) { if ((FP8_LAYERS) & 0xA) { pg8::EpiSwiGLU8 E{(unsigned char*)HMOE, FF, 1.0f / WSCALE8}; if (EN_GEMM & (1 << 4)) pg8::gemm_phase<pg8::EpiSwiGLU8, pg8::Order, PG_ALIGN, PG_SP2, true>(F.lds, g, S, E); } }
                else { if ((~(FP8_LAYERS)) & 0xA) { pg8::EpiSwiGLU E{HMOE, FF}; if (EN_GEMM & (1 << 4)) pg8::gemm_phase<pg8::EpiSwiGLU, pg8::Order, PG_ALIGN, PG_SP2>(F.lds, g, S, E); } } }
            SEAM(pb + 8);
        }
        if (IN(pb + 9)) { PHASE_LOCALS
            const bool f8 = FFN_FP8_L(L) != 0;
            if (!odd) { pg8::Gemm g{HB, (const bf16*)(wb + WE_DOWN), M_ALL, D, FF}; pg8::Order S; S.init(M_ALL / 256, D, F.G, F.bid, nullptr, 0);
                if (f8) { if ((FP8_LAYERS) & 0x5) { pg8::EpiStore E{Y, D, D / 256, -1, nullptr, 1.0f / WSCALE8}; if (EN_GEMM & (1 << 5)) pg8::gemm_phase<pg8::EpiStore, pg8::Order, PG_ALIGN, PG_SP2, true>(F.lds, g, S, E); } }
                else { if ((~(FP8_LAYERS)) & 0x5) { pg8::EpiStore E{Y, D, D / 256, -1, nullptr, 1.0f}; if (EN_GEMM & (1 << 5)) pg8::gemm_phase<pg8::EpiStore, pg8::Order, PG_ALIGN, PG_SP2>(F.lds, g, S, E); } } }
            else { const int np = __builtin_amdgcn_readfirstlane(pexp[MOE_PANELS]);
                pg8::Gemm g{HMOE, (const bf16*)(wb + WOD_DOWN), np * 256, D, FF}; pg8::Order S; S.init(np, D, F.G, F.bid, pexp, EDOWN_BYTES);
                if (f8) { if ((FP8_LAYERS) & 0xA) { pg8::EpiStore E{AMOE, D, D / 256, -1, nullptr, 1.0f / WSCALE8}; if (EN_GEMM & (1 << 6)) pg8::gemm_phase<pg8::EpiStore, pg8::Order, PG_ALIGN, PG_SP2, true>(F.lds, g, S, E); } }
                else { if ((~(FP8_LAYERS)) & 0xA) { pg8::EpiStore E{AMOE, D, D / 256, -1, nullptr, 1.0f}; if (EN_GEMM & (1 << 6)) pg8::gemm_phase<pg8::EpiStore, pg8::Order, PG_ALIGN, PG_SP2>(F.lds, g, S, E); } } }
            SEAM(pb + 9);
        }
        if (IN(pb + 10)) { PHASE_LOCALS
            TokCfg T{}; bf16* LAT16 = (bf16*)(ws + WS_ACT + 836 * MiB); T.lat_src_l = LAT16; T.lat_src_c = LATC; T.lat_dst_l = (L + 1 < DEPTH) ? (void*)LAT16 : (void*)F.out; T.lat_dst_c = LATC; T.dst_f32 = (L + 1 < DEPTH) ? 0 : 1;
            T.y = odd ? AMOE : Y; T.moe_combine = odd ? 1 : 0; T.vupd = mv + 5 * 1024; T.nrows = ctx_out ? M_ALL : M_LAT;
            if (L + 1 < DEPTH) { const float* mn = modv + (size_t)(L + 1) * 9 * 6 * 1024; T.vna = mn; T.vnb = mn + 1024; T.u = U; T.u_perm = ((L + 1) & 1) ? 1 : 0; }
            if (EN_TOK) phase_tok(F, T);
            SEAM(pb + 10);
        }
    }
    if (TIMER_MASK != 0ull) { timer_stamp(lds_raw, ((TIMER_MASK >> (N_PHASES - 1)) & 1ull) != 0ull);
        if (blockIdx.x == 0 && threadIdx.x == 0) { volatile LAS unsigned* tw = (volatile LAS unsigned*)((LAS unsigned char*)lds_raw + LDSCTL_OFF) + 32; const unsigned long long acc = ((unsigned long long)tw[3] << 32) | tw[2];
            asm volatile("s_waitcnt vmcnt(0)" ::: "memory"); args.out[0] = (float)acc * 0.01f / TIMER_DIV; } }
#undef IN
#undef SEAM
}

extern "C" void kernel_launch(void* const* d_in, const int* in_sizes, int n_in, void* d_out, int out_size, void* d_ws, size_t ws_size, hipStream_t stream) {
    static int grid = 0;
    if (grid == 0) {
        if (n_in != 23 || out_size != M_LAT * D || ws_size < WS_END) { fprintf(stderr, "kernel_launch: unexpected shapes / workspace (n_in %d out %d ws %zu need %zu)\n", n_in, out_size, ws_size, (size_t)WS_END); grid = -1; return; }
        int dev = 0, cus = 0, per_cu = 0;
        if (hipGetDevice(&dev) != hipSuccess || hipDeviceGetAttribute(&cus, hipDeviceAttributeMultiprocessorCount, dev) != hipSuccess) { grid = -1; return; }
        if (hipFuncSetAttribute((const void*)fwd, hipFuncAttributeMaxDynamicSharedMemorySize, LDS_BYTES) != hipSuccess) { fprintf(stderr, "kernel_launch: hipFuncSetAttribute failed\n"); grid = -1; return; }
        if (hipOccupancyMaxActiveBlocksPerMultiprocessor(&per_cu, (const void*)fwd, NTHR, LDS_BYTES) != hipSuccess || per_cu < 1) fprintf(stderr, "kernel_launch: occupancy query reports %d\n", per_cu);
        (void)hipGetLastError();
        grid = cus;
    }
    if (grid < 0) return;
    (void)hipMemsetAsync((char*)d_ws + WS_CTL, 0, CTL_ZERO_BYTES, stream);
    Args a{};
    for (int i = 0; i < 23; ++i) a.in[i] = (const float*)d_in[i];
    a.out = (float*)d_out; a.ws = (unsigned char*)d_ws;
#if MK_SPLIT
    for (int p = 0; p < N_PHASES; ++p) { a.ph_lo = p; a.ph_hi = p + 1; a.use_bar = 0; a.pad = 0; hipLaunchKernelGGL(fwd, dim3(grid), dim3(NTHR), LDS_BYTES, stream, a); }
#else
    a.ph_lo = 0; a.ph_hi = N_PHASES; a.use_bar = 1; a.pad = 0;
    hipLaunchKernelGGL(fwd, dim3(grid), dim3(NTHR), LDS_BYTES, stream, a);
#endif
}
```

```cpp
#include <hip/hip_runtime.h>
#include <cstdio>
#include <cstdint>

namespace pg8 {
#define PG8_LAS __attribute__((address_space(3)))
typedef unsigned short bf16_t;
typedef short bf16x8 __attribute__((ext_vector_type(8)));
typedef float f32x4 __attribute__((ext_vector_type(4)));
typedef unsigned u32x4 __attribute__((ext_vector_type(4)));
typedef unsigned u32x2 __attribute__((ext_vector_type(2)));
typedef int v8i_t __attribute__((ext_vector_type(8)));
constexpr int BM = 256, BK = 64, HALF = 128, HTB = HALF * BK * 2  , STAGE_BYTES = 8 * HTB, NXCD = 8, WGM = 8;

__host__ __device__ __forceinline__ int lds_byte(int r, int c) { const int st = (r >> 4) * 2 + (c >> 5), rr = r & 15, cc = c & 31, ob = rr * 64 + cc * 2; return st * 1024 + (ob ^ (((ob >> 9) & 1) << 5)); }
__host__ __device__ __forceinline__ void stage_rc(int b, int& R, int& C) { const int st = b / 1024, sb = b % 1024, swz = sb ^ (((sb >> 9) & 1) << 5); R = (st >> 1) * 16 + swz / 64; C = (st & 1) * 32 + (swz % 64) / 2; }
__host__ __device__ __forceinline__ int perm32(int rho) { const int n = rho >> 4, i = rho & 15; return 8 * (i >> 2) + 4 * n + (i & 3); }

struct Unit { int pm, pn; };
struct Gemm { const bf16_t* A; const bf16_t* Bt; int M, N, K; };

struct Order {
    int nM, nN, nwg, G, c; const int* pexp; size_t bstride;
    __device__ void init(int nM_, int N, int G_, int c_, const int* pexp_, size_t bstride_) { nM = nM_; nN = N / BM; nwg = nM * nN; G = G_; c = c_; pexp = pexp_; bstride = bstride_; }
    __device__ bool next(int i, Unit& u) const {
        const long L = (long)i * G + c; if (L >= nwg) return false;
        int wgid = (int)L; { const int q = nwg / NXCD, r = nwg % NXCD, xcd = wgid % NXCD, off = wgid / NXCD; wgid = (xcd < r ? xcd * (q + 1) : r * (q + 1) + (xcd - r) * q) + off; }
        const int nig = WGM * nN, gid = wgid / nig, fm = gid * WGM, gsz = (nM - fm) < WGM ? (nM - fm) : WGM;
        u.pm = fm + ((wgid % nig) % gsz); u.pn = (wgid % nig) / gsz; return true;
    }
    __device__ __forceinline__ size_t boff(const Unit& u) const { return pexp ? (size_t)__builtin_amdgcn_readfirstlane(pexp[u.pm]) * bstride : (size_t)0; }
    __device__ __forceinline__ void a_ready(const Unit&) const {}
    __device__ __forceinline__ void done(const Unit&) const {}
};

__device__ __forceinline__ unsigned cvt_pk_bf16(float lo, float hi) { unsigned r; asm volatile("v_cvt_pk_bf16_f32 %0, %1, %2" : "=v"(r) : "v"(lo), "v"(hi)); return r; }

struct EpiStore {
    static constexpr bool PERM = true, AFTER_DRAIN = false;
    bf16_t* O; int ldc; int ncol_tiles; int gate_pn; float* gates; float oscale;
    __device__ __forceinline__ void operator()(const f32x4 (&acc)[2][2][4][2], const Unit& u, int wr, int wc, int fr, int fq) const {
        const int row0 = u.pm * BM + wr * 64 + fr;
        if (u.pn < ncol_tiles) {
            const int col0 = u.pn * BM + wc * 32 + 8 * fq;
#pragma unroll
            for (int ai = 0; ai < 2; ++ai)
#pragma unroll
                for (int m = 0; m < 4; ++m) { bf16_t* rowp = O + (size_t)(row0 + ai * HALF + m * 16) * ldc + col0;
#pragma unroll
                    for (int bj = 0; bj < 2; ++bj) { const f32x4 v0 = acc[ai][bj][m][0] * oscale, v1 = acc[ai][bj][m][1] * oscale;
                        u32x4 w; w.x = cvt_pk_bf16(v0[0], v0[1]); w.y = cvt_pk_bf16(v0[2], v0[3]); w.z = cvt_pk_bf16(v1[0], v1[1]); w.w = cvt_pk_bf16(v1[2], v1[3]);
                        *(u32x4*)(rowp + bj * HALF) = w; } }
        } else if (u.pn == gate_pn && wc == 0) {
#pragma unroll
            for (int ai = 0; ai < 2; ++ai)
#pragma unroll
                for (int m = 0; m < 4; ++m) { float* rowp = gates + (size_t)(row0 + ai * HALF + m * 16) * 32 + 8 * fq;
                    *(f32x4*)(rowp) = acc[ai][0][m][0]; *(f32x4*)(rowp + 4) = acc[ai][0][m][1]; }
        }
    }
};
struct EpiSwiGLU {
    static constexpr bool PERM = true, AFTER_DRAIN = false;
    bf16_t* O; int ldc;
    __device__ __forceinline__ void operator()(const f32x4 (&acc)[2][2][4][2], const Unit& u, int wr, int wc, int fr, int fq) const {
        const int row0 = u.pm * BM + wr * 64 + fr, col0 = u.pn * HALF + wc * 32 + 8 * fq;
#pragma unroll
        for (int ai = 0; ai < 2; ++ai)
#pragma unroll
            for (int m = 0; m < 4; ++m) { bf16_t* rowp = O + (size_t)(row0 + ai * HALF + m * 16) * ldc + col0; float r[8];
#pragma unroll
                for (int n = 0; n < 2; ++n)
#pragma unroll
                    for (int j = 0; j < 4; ++j) { const float g = acc[ai][0][m][n][j], up = acc[ai][1][m][n][j]; r[n * 4 + j] = g * __builtin_amdgcn_rcpf(1.0f + __expf(-g)) * up; }
                u32x4 w; w.x = cvt_pk_bf16(r[0], r[1]); w.y = cvt_pk_bf16(r[2], r[3]); w.z = cvt_pk_bf16(r[4], r[5]); w.w = cvt_pk_bf16(r[6], r[7]);
                *(u32x4*)(rowp) = w; }
    }
};
struct EpiSwiGLU8 {
    static constexpr bool PERM = true, AFTER_DRAIN = false;
    unsigned char* O; int ldc; float ascale;
    __device__ __forceinline__ void operator()(const f32x4 (&acc)[2][2][4][2], const Unit& u, int wr, int wc, int fr, int fq) const {
        const int row0 = u.pm * BM + wr * 64 + fr, col0 = u.pn * HALF + wc * 32 + 8 * fq;
#pragma unroll
        for (int ai = 0; ai < 2; ++ai)
#pragma unroll
            for (int m = 0; m < 4; ++m) { unsigned char* rowp = O + (size_t)(row0 + ai * HALF + m * 16) * ldc + col0; float r[8];
#pragma unroll
                for (int n = 0; n < 2; ++n)
#pragma unroll
                    for (int j = 0; j < 4; ++j) { const float g = acc[ai][0][m][n][j] * ascale, up = acc[ai][1][m][n][j] * ascale; r[n * 4 + j] = g * __builtin_amdgcn_rcpf(1.0f + __expf(-g)) * up; }
                u32x2 w; unsigned t = 0; t = __builtin_amdgcn_cvt_pk_fp8_f32(r[0], r[1], t, false); t = __builtin_amdgcn_cvt_pk_fp8_f32(r[2], r[3], t, true); w.x = t;
                t = 0; t = __builtin_amdgcn_cvt_pk_fp8_f32(r[4], r[5], t, false); t = __builtin_amdgcn_cvt_pk_fp8_f32(r[6], r[7], t, true); w.y = t;
                *(u32x2*)(rowp) = w; }
    }
};

template <bool FP8> struct Frag;
template <> struct Frag<false> { bf16x8 v[2]; };
template <> struct Frag<true> { v8i_t v; };
template <bool FP8> __device__ __forceinline__ void ldfrag(Frag<FP8>& f, const PG8_LAS unsigned char* p) {
    if constexpr (FP8) { const bf16x8 a = *(const PG8_LAS bf16x8*)p, b = *(const PG8_LAS bf16x8*)(p + 1024); f.v = __builtin_bit_cast(v8i_t, __builtin_shufflevector(a, b, 0, 1, 2, 3, 4, 5, 6, 7, 8, 9, 10, 11, 12, 13, 14, 15)); }
    else { f.v[0] = *(const PG8_LAS bf16x8*)p; f.v[1] = *(const PG8_LAS bf16x8*)(p + 1024); }
}
template <class Epi, class Sched, bool ALIGN_EPI = false, bool SP2 = false, bool FP8 = false>
__device__ __forceinline__ void gemm_phase(PG8_LAS unsigned char* lds, const Gemm g, const Sched& S, const Epi& E) {
    int tid = threadIdx.x; asm volatile("" : "+v"(tid)); const int wid = __builtin_amdgcn_readfirstlane(tid >> 6), lane = tid & 63, wr = wid >> 2, wc = wid & 3, fr = lane & 15, fq = lane >> 4;
    const int K = g.K, rowb = FP8 ? K : 2 * K, nt = rowb / 128;
    unsigned voffA[2], voffB[2];
#pragma unroll
    for (int i = 0; i < 2; ++i) { int R, C; stage_rc(tid * 16 + i * 8192, R, C); const int Rb = Epi::PERM ? ((R & ~31) + perm32(R & 31)) : R;
        voffA[i] = (unsigned)(R * rowb + C * 2); voffB[i] = (unsigned)(Rb * rowb + C * 2); }
    const size_t kstep = (size_t)(BK * 2);
    const size_t hstep = (size_t)HALF * rowb;
    const size_t tstep = 2 * hstep;
    const unsigned ldsw = (unsigned)wid * 1024u;
    const int aoff = lds_byte(wr * 64 + fr, fq * 8), boff = lds_byte(wc * 32 + fr, fq * 8);
#define PG8_SA(b, h) (((b) * 2 + (h)) * HTB)
#define PG8_SB(b, h) ((4 + (b) * 2 + (h)) * HTB)
#define PG8_STAGE(bufoff, gbase, voff) do { _Pragma("unroll") for (int _i = 0; _i < 2; ++_i) \
        __builtin_amdgcn_global_load_lds((const unsigned*)((const char*)(gbase) + (voff)[_i]), (PG8_LAS unsigned*)(lds + (bufoff) + ldsw + _i * 8192), 16, 0, 0); } while (0)
#define PG8_LDA(dst, b, h) do { _Pragma("unroll") for (int m = 0; m < 4; ++m) ldfrag<FP8>(dst[m], lds + PG8_SA(b, h) + aoff + m * 2048); } while (0)
#define PG8_LDB(dst, b, h) do { _Pragma("unroll") for (int n = 0; n < 2; ++n) ldfrag<FP8>(dst[n], lds + PG8_SB(b, h) + boff + n * 2048); } while (0)
#define PG8_MMA(ai, bj, At, Bt) do { __builtin_amdgcn_s_setprio(1); _Pragma("unroll") for (int m = 0; m < 4; ++m) _Pragma("unroll") for (int n = 0; n < 2; ++n) { \
        if constexpr (FP8) { asm volatile("v_mfma_f32_16x16x128_f8f6f4 %0, %1, %2, %0" : "+v"(acc[ai][bj][m][n]) : "v"(Bt[n].v), "v"(At[m].v)); }     \
        else { _Pragma("unroll") for (int k = 0; k < 2; ++k) acc[ai][bj][m][n] = __builtin_amdgcn_mfma_f32_16x16x32_bf16(Bt[n].v[k], At[m].v[k], acc[ai][bj][m][n], 0, 0, 0); } } __builtin_amdgcn_s_setprio(0); } while (0)
#define PG8_WAIT_V(n) asm volatile("s_waitcnt vmcnt(" #n ")" ::: "memory")
#define PG8_WAIT_L(n) asm volatile("s_waitcnt lgkmcnt(" #n ")" ::: "memory")
#define PG8_BAR __builtin_amdgcn_s_barrier()
#define PG8_SCHED __builtin_amdgcn_sched_barrier(0)
    Unit cur, nxt; int ui = 0;
    if (!S.next(0, cur)) return;
    f32x4 acc[2][2][4][2];
#pragma unroll
    for (int a = 0; a < 2; ++a)
#pragma unroll
        for (int b = 0; b < 2; ++b)
#pragma unroll
            for (int m = 0; m < 4; ++m)
#pragma unroll
                for (int n = 0; n < 2; ++n) acc[a][b][m][n] = (f32x4){0.f, 0.f, 0.f, 0.f};
    Frag<FP8> At[4], B0[2], B1[2];
    const char* cA = (const char*)g.A + (size_t)cur.pm * tstep; const char* cB = (const char*)g.Bt + S.boff(cur) + (size_t)cur.pn * tstep;
    S.a_ready(cur);
    if constexpr (SP2) {
        PG8_STAGE(PG8_SB(0, 0), cB, voffB); PG8_STAGE(PG8_SB(0, 1), cB + hstep, voffB); PG8_STAGE(PG8_SA(0, 0), cA, voffA); PG8_STAGE(PG8_SA(0, 1), cA + hstep, voffA);
        if (wr == 1) PG8_BAR;
        PG8_WAIT_V(2); PG8_BAR;
        PG8_STAGE(PG8_SB(1, 0), cB + kstep, voffB); PG8_STAGE(PG8_SA(1, 0), cA + kstep, voffA); PG8_STAGE(PG8_SB(1, 1), cB + hstep + kstep, voffB);
        PG8_WAIT_V(6); PG8_BAR;
    } else {
        PG8_STAGE(PG8_SB(0, 0), cB, voffB); PG8_STAGE(PG8_SA(0, 0), cA, voffA); PG8_STAGE(PG8_SB(0, 1), cB + hstep, voffB); PG8_STAGE(PG8_SA(0, 1), cA + hstep, voffA);
        if (wr == 1) PG8_BAR;
        PG8_WAIT_V(4); PG8_BAR;
        PG8_STAGE(PG8_SB(1, 0), cB + kstep, voffB); PG8_STAGE(PG8_SA(1, 0), cA + kstep, voffA); PG8_STAGE(PG8_SB(1, 1), cB + hstep + kstep, voffB);
        PG8_WAIT_V(6); PG8_BAR;
    }
    for (;;) {
        const bool has_next = S.next(ui + 1, nxt);
        const char* nA = has_next ? (const char*)g.A + (size_t)nxt.pm * tstep : cA; const char* nB = has_next ? (const char*)g.Bt + S.boff(nxt) + (size_t)nxt.pn * tstep : cB;
#pragma unroll 1
        for (int t = 0; t < nt; t += 2) {
            const bool last = (t == nt - 2);
            const char* a1 = cA + (size_t)(t + 1) * kstep;
            const char* a2 = last ? nA : cA + (size_t)(t + 2) * kstep; const char* b2 = last ? nB : cB + (size_t)(t + 2) * kstep;
            const char* a3 = a2 + kstep; const char* b3 = b2 + kstep;
            if (last && has_next) S.a_ready(nxt);
            if constexpr (SP2) {
            PG8_LDB(B0, 0, 0); PG8_LDB(B1, 0, 1); PG8_SCHED; PG8_LDA(At, 0, 0); PG8_STAGE(PG8_SA(1, 1), a1 + hstep, voffA);
            PG8_WAIT_V(8); PG8_WAIT_L(0); PG8_BAR; PG8_MMA(0, 0, At, B0); PG8_MMA(0, 1, At, B1); PG8_BAR; PG8_SCHED;
            PG8_LDA(At, 0, 1); PG8_STAGE(PG8_SB(0, 0), b2, voffB); PG8_STAGE(PG8_SB(0, 1), b2 + hstep, voffB); PG8_STAGE(PG8_SA(0, 0), a2, voffA);
            PG8_WAIT_V(8); PG8_WAIT_L(0); PG8_BAR; PG8_MMA(1, 0, At, B0); PG8_MMA(1, 1, At, B1); PG8_BAR; PG8_SCHED;
            PG8_LDB(B0, 1, 0); PG8_LDB(B1, 1, 1); PG8_SCHED; PG8_LDA(At, 1, 0); PG8_STAGE(PG8_SA(0, 1), a2 + hstep, voffA);
            PG8_WAIT_V(8); PG8_WAIT_L(0); PG8_BAR; PG8_MMA(0, 0, At, B0); PG8_MMA(0, 1, At, B1); PG8_BAR; PG8_SCHED;
            PG8_LDA(At, 1, 1); PG8_STAGE(PG8_SB(1, 0), b3, voffB); PG8_STAGE(PG8_SB(1, 1), b3 + hstep, voffB); PG8_STAGE(PG8_SA(1, 0), a3, voffA);
            PG8_WAIT_V(8); PG8_WAIT_L(0); PG8_BAR; PG8_MMA(1, 0, At, B0); PG8_MMA(1, 1, At, B1); PG8_BAR; PG8_SCHED;
            } else {
            PG8_LDB(B0, 0, 0); PG8_SCHED; PG8_LDA(At, 0, 0); PG8_STAGE(PG8_SA(1, 1), a1 + hstep, voffA);
            PG8_WAIT_L(8); PG8_BAR; PG8_WAIT_L(0); PG8_MMA(0, 0, At, B0); PG8_BAR; PG8_SCHED;
            PG8_LDB(B1, 0, 1); PG8_STAGE(PG8_SB(0, 0), b2, voffB);
            PG8_BAR; PG8_WAIT_L(0); PG8_MMA(0, 1, At, B1); PG8_BAR;
            PG8_LDA(At, 0, 1); PG8_STAGE(PG8_SA(0, 0), a2, voffA);
            PG8_BAR; PG8_WAIT_L(0); PG8_MMA(1, 0, At, B0); PG8_BAR; PG8_SCHED;
            PG8_STAGE(PG8_SB(0, 1), b2 + hstep, voffB);
            PG8_WAIT_V(6); PG8_BAR; PG8_MMA(1, 1, At, B1); PG8_BAR;
            PG8_LDB(B0, 1, 0); PG8_SCHED; PG8_LDA(At, 1, 0); PG8_STAGE(PG8_SA(0, 1), a2 + hstep, voffA);
            PG8_WAIT_L(8); PG8_BAR; PG8_WAIT_L(0); PG8_MMA(0, 0, At, B0); PG8_BAR; PG8_SCHED;
            PG8_LDB(B1, 1, 1); PG8_STAGE(PG8_SB(1, 0), b3, voffB);
            PG8_BAR; PG8_WAIT_L(0); PG8_MMA(0, 1, At, B1); PG8_BAR;
            PG8_LDA(At, 1, 1); PG8_STAGE(PG8_SA(1, 0), a3, voffA);
            PG8_BAR; PG8_WAIT_L(0); PG8_MMA(1, 0, At, B0); PG8_BAR; PG8_SCHED;
            PG8_STAGE(PG8_SB(1, 1), b3 + hstep, voffB);
            PG8_WAIT_V(6); PG8_BAR; PG8_MMA(1, 1, At, B1); PG8_BAR;
            }
        }
        if constexpr (ALIGN_EPI) { if (wr == 0) PG8_BAR; }
        if constexpr (FP8) { asm volatile("s_nop 15\n\ts_nop 15" ::: "memory"); }
        if constexpr (!Epi::AFTER_DRAIN) { E(acc, cur, wr, wc, fr, fq); S.done(cur); }
        if (!has_next) break;
#pragma unroll
        for (int a = 0; a < 2; ++a)
#pragma unroll
            for (int b = 0; b < 2; ++b)
#pragma unroll
                for (int m = 0; m < 4; ++m)
#pragma unroll
                    for (int n = 0; n < 2; ++n) acc[a][b][m][n] = (f32x4){0.f, 0.f, 0.f, 0.f};
        cur = nxt; cA = nA; cB = nB; ++ui;
        if constexpr (ALIGN_EPI) { if (wr == 1) PG8_BAR; }
    }
    PG8_WAIT_V(0);
    if constexpr (!ALIGN_EPI) { if (wr == 0) PG8_BAR; }
    PG8_BAR;
    if constexpr (Epi::AFTER_DRAIN) { E.fused(acc, cur, wr, wc, fr, fq, lds, wid, lane); S.done(cur); }
#undef PG8_SA
#undef PG8_SB
#undef PG8_STAGE
#undef PG8_LDA
#undef PG8_LDB
#undef PG8_MMA
#undef PG8_WAIT_V
#undef PG8_WAIT_L
#undef PG8_BAR
#undef PG8_SCHED
}
}

constexpr int D = 1024, NB = 8, SEQ = 8192, CTXL = 256, DEPTH = 4, GRIDW = 64, ROWS_G = SEQ / GRIDW  ;
constexpr int M_LAT = NB * SEQ  , M_CTX = NB * CTXL  , M_ALL = M_LAT + M_CTX  ;
constexpr int NHEAD = 8, M_DK = 64, M_DV = 128, H_DK = 128, H_DV = 128;
constexpr int NP_M = 3072, NIN_M = 3328, NW_M = 3104, NP_H = 5120;
constexpr int FF = 2816, NGU = 2 * FF, NEXP = 8;
constexpr int MOE_ROWS = 137216, MOE_PANELS = MOE_ROWS / 256;
constexpr float EPS = 1e-6f;
constexpr int NWAVES = 8, NTHR = 512;

constexpr size_t MiB = 1u << 20;
constexpr size_t WS_CTL = 0, CTL_ZERO_BYTES = 80 * 1024;
constexpr size_t WS_MODV = 1 * MiB;
constexpr size_t WS_SMALL = 2 * MiB;
constexpr size_t WS_LATC = 3 * MiB;
constexpr size_t WS_WE = 11 * MiB;
constexpr size_t WS_WO = 37 * MiB;
constexpr size_t WS_U = 181 * MiB;
constexpr size_t WS_GATES = 313 * MiB;
constexpr size_t WS_STATE = 322 * MiB;
constexpr size_t WS_ROUTE = 362 * MiB;
constexpr size_t WS_ACT = 364 * MiB;
constexpr size_t WS_Y = WS_ACT + 700 * MiB;
constexpr size_t WS_END = WS_ACT + 1005 * MiB;
constexpr size_t WE_IN = 0, WE_OUT = 7 * MiB, WE_GU = 9 * MiB, WE_DOWN = 20 * MiB;
constexpr size_t WOD_IN = 0, WOD_OUT = 10 * MiB, WOD_GU = 12 * MiB, WOD_DOWN = 100 * MiB;
constexpr size_t EGU_BYTES = (size_t)NGU * D * 2, EDOWN_BYTES = (size_t)D * FF * 2;
static_assert(WOD_GU + 8 * EGU_BYTES <= WOD_DOWN && WOD_DOWN + 8 * EDOWN_BYTES <= 144 * MiB, "odd weights map");
static_assert((size_t)NIN_M * D * 2 <= 7 * MiB && WE_GU + EGU_BYTES <= WE_DOWN && WE_DOWN + EDOWN_BYTES <= 26 * MiB, "even weights map");
static_assert((size_t)M_ALL * NP_H * 2 <= 700 * MiB && (size_t)MOE_ROWS * D * 2 + (size_t)MOE_ROWS * FF * 2 <= 1005 * MiB && 700 * MiB + (size_t)M_ALL * D * 2 <= 1005 * MiB, "act map");
constexpr int CW_BAR = 4096;
constexpr int CW_ECNT = 8192;
constexpr int CW_DBG = 16384;
constexpr size_t RT_E = 0;
constexpr size_t RT_R = 512 * 1024;
constexpr size_t RT_W = 512 * 1024 + 1024 * 1024;
constexpr size_t SM_LB = 0;
constexpr size_t SM_PEXP = 64 * 1024;
constexpr size_t SM_EBASE = 96 * 1024;

constexpr int LDS_MAIN = 147456;
constexpr int LDSCTL_OFF = LDS_MAIN;
constexpr int LDS_BYTES = LDS_MAIN + 512;

#define GAS __attribute__((address_space(1)))
#define LAS __attribute__((address_space(3)))
typedef unsigned short bf16;
typedef unsigned v4u __attribute__((ext_vector_type(4)));
typedef unsigned v2u __attribute__((ext_vector_type(2)));
typedef float f32x4 __attribute__((ext_vector_type(4)));
typedef float f32x16 __attribute__((ext_vector_type(16)));
typedef short bf16x8 __attribute__((ext_vector_type(8)));
typedef short s16x4 __attribute__((ext_vector_type(4)));
typedef GAS unsigned gu32;
#define RLX_AGENT __ATOMIC_RELAXED, __HIP_MEMORY_SCOPE_AGENT
#define LDS_WAIT() asm volatile("s_waitcnt lgkmcnt(0)" ::: "memory")
#define VM_WAIT() asm volatile("s_waitcnt vmcnt(0)" ::: "memory")
#define CFENCE() asm volatile("" ::: "memory")
__device__ __forceinline__ unsigned f2bf(float f) { unsigned u = __builtin_bit_cast(unsigned, f); return (u + 0x7fffu + ((u >> 16) & 1u)) >> 16; }
typedef __bf16 bf16x2_t __attribute__((ext_vector_type(2)));
typedef float f32x2_t __attribute__((ext_vector_type(2)));
__device__ __forceinline__ unsigned pk2(float lo, float hi) { f32x2_t v = {lo, hi}; bf16x2_t b = __builtin_convertvector(v, bf16x2_t); return __builtin_bit_cast(unsigned, b); }
__device__ __forceinline__ float bf2f(unsigned short b) { return __builtin_bit_cast(float, (unsigned)b << 16); }
__device__ __forceinline__ float bflo(unsigned w) { return __builtin_bit_cast(float, w << 16); }
__device__ __forceinline__ float bfhi(unsigned w) { return __builtin_bit_cast(float, w & 0xffff0000u); }
__device__ __forceinline__ float sigmoidf_(float x) { return __builtin_amdgcn_rcpf(1.0f + __expf(-x)); }
__device__ __forceinline__ float siluf_(float x) { return x * sigmoidf_(x); }
template <int CTRL, int RM> __device__ __forceinline__ float dppmov(float x) { return __builtin_bit_cast(float, __builtin_amdgcn_update_dpp(0, __builtin_bit_cast(int, x), CTRL, RM, 0xf, false)); }
__device__ __forceinline__ float wave_sum(float v) {
    v += dppmov<0xB1, 0xf>(v); v += dppmov<0x4E, 0xf>(v); v += dppmov<0x141, 0xf>(v); v += dppmov<0x140, 0xf>(v);
    v += dppmov<0x142, 0xa>(v); v += dppmov<0x143, 0xc>(v);
    return __builtin_bit_cast(float, __builtin_amdgcn_readlane(__builtin_bit_cast(int, v), 63));
}

#define XB_TMO      128
#define XB_XCNT(j)  (256  + 64 * (j))
#define XB_XSUB(j)  (1280 + 64 * (j))
#define XB_XGEN(j)  (2304 + 64 * (j))
#define XB_TOP      3328
#define XB_TOPGEN   3392
#define XCD_BAR_WORDS 3456
#define XB_SPIN_CAP (1u << 18)
__device__ __forceinline__ unsigned xb_ld(unsigned* p)              { return __hip_atomic_load(p, __ATOMIC_RELAXED, __HIP_MEMORY_SCOPE_AGENT); }
__device__ __forceinline__ unsigned xb_add(unsigned* p, unsigned v) { return __hip_atomic_fetch_add(p, v, __ATOMIC_RELAXED, __HIP_MEMORY_SCOPE_AGENT); }
__device__ __forceinline__ unsigned xb_xcc_id() { return (unsigned)__builtin_amdgcn_s_getreg((3 << 11) | 20) & 0xFu; }
#define XB_SPIN(cond, bar) do { unsigned _sp = 0; while (cond) { __builtin_amdgcn_s_sleep(1); \
    if ((++_sp & 255u) == 0u) { if (xb_ld(&(bar)[XB_TMO])) break; if (_sp > XB_SPIN_CAP) { atomicAdd(&(bar)[XB_TMO], 1u); break; } } } } while (0)
struct XcdBarrier { unsigned* bar; unsigned x; volatile LAS unsigned* st; };
__device__ __forceinline__ XcdBarrier xcd_barrier_post(unsigned* bar, volatile LAS unsigned* st) {
    XcdBarrier b; b.bar = bar; b.x = xb_xcc_id(); b.st = st;
    if (threadIdx.x == 0) (void)xb_add(&bar[XB_XCNT(b.x)], 1u);
    return b;
}
__device__ __forceinline__ void xcd_barrier_complete(unsigned* bar, unsigned x, unsigned& nloc, unsigned& nx) {
    const unsigned G = gridDim.x * gridDim.y * gridDim.z;
    unsigned sum, cnt, mine, sp = 0u;
    for (;;) {
        sum = 0u; cnt = 0u; mine = 0u;
#pragma unroll
        for (unsigned j = 0; j < 16; ++j) { const unsigned c = xb_ld(&bar[XB_XCNT(j)]); sum += c; cnt += (c > 0u) ? 1u : 0u; mine = (j == x) ? c : mine; }
        if (sum == G) break;
        __builtin_amdgcn_s_sleep(1);
        if ((++sp & 255u) == 0u) { if (xb_ld(&bar[XB_TMO])) break; if (sp > XB_SPIN_CAP) { atomicAdd(&bar[XB_TMO], 1u); break; } }
    }
    nloc = mine > 0u ? mine : 1u; nx = cnt > 0u ? cnt : 1u;
}
__device__ __attribute__((noinline)) void xcd_barrier(unsigned* bar_, unsigned bx_, volatile LAS unsigned* st_) { XcdBarrier b; b.bar = bar_; b.x = bx_; b.st = st_;
    asm volatile("s_waitcnt vmcnt(0)" ::: "memory");
    __syncthreads();
    if (threadIdx.x == 0) {
        unsigned* bar = b.bar;
        __builtin_amdgcn_s_waitcnt(0);
        unsigned nloc = b.st[0], nx = b.st[1];
        if (nloc == 0u) { xcd_barrier_complete(bar, b.x, nloc, nx); b.st[0] = nloc; b.st[1] = nx; }
        const unsigned old = xb_add(&bar[XB_XSUB(b.x)], 1u);
        const unsigned gen = old / nloc;
        if (old + 1u == (gen + 1u) * nloc) {
            __builtin_amdgcn_fence(__ATOMIC_RELEASE, "agent");
            asm volatile("s_waitcnt vmcnt(0)" ::: "memory");
            const unsigned og = xb_add(&bar[XB_TOP], 1u);
            const unsigned tg = og / nx;
            if (og + 1u == (tg + 1u) * nx) xb_add(&bar[XB_TOPGEN], 1u);
            else XB_SPIN(xb_ld(&bar[XB_TOPGEN]) == tg, bar);
            __builtin_amdgcn_fence(__ATOMIC_ACQUIRE, "agent");
            xb_add(&bar[XB_XGEN(b.x)], 1u);
            asm volatile("s_waitcnt vmcnt(0)" ::: "memory");
        } else {
            XB_SPIN(xb_ld(&bar[XB_XGEN(b.x)]) == gen, bar);
            __builtin_amdgcn_fence(__ATOMIC_ACQUIRE, "agent");
            asm volatile("s_waitcnt vmcnt(0)" ::: "memory");
        }
    }
    __syncthreads();
}

struct Args {
    const float* in[23];
    float* out; unsigned char* ws;
    int ph_lo, ph_hi;
    int use_bar, pad;
};
struct Frame {
    LAS unsigned char* lds;
    int tid, lane, wave, G, bid;
    unsigned char* ws;
    const float* const __attribute__((address_space(4)))* in;
    float* out;
};
enum { I_X = 0, I_C, I_CTX, I_CCTX, I_MODW, I_MODB, I_NORMG, I_MWIN, I_MBGATE, I_MWCONV, I_MGHEAD, I_MWOUT, I_HWIN, I_HBF, I_HLB, I_HGHEAD, I_HWOUT, I_FWGU, I_FWDOWN, I_EWR, I_EBR, I_EWGU, I_EWDOWN };

#ifndef FP8_LAYERS
#define FP8_LAYERS 0xE
#endif
#define FFN_FP8_L(L) (((FP8_LAYERS) >> (L)) & 1)
#ifndef FFN_FP8
#define FFN_FP8 1
#endif
constexpr float WSCALE8 = 64.0f;

__device__ __forceinline__ void phase_mods(Frame& F) {
    LAS float* SV = (LAS float*)(F.lds);
    LAS float* RED = (LAS float*)(F.lds + 9 * 1024 * 4);
    const float* cvec = F.in[I_C]; const float* cctx = F.in[I_CCTX];
    for (int i = F.tid; i < 9 * 1024; i += NTHR) { const int b = i >> 10, k = i & 1023; const float v = b < 8 ? cvec[b * 1024 + k] : cctx[k]; SV[i] = siluf_(v); }
    __syncthreads();
    const float* modw = F.in[I_MODW]; const float* modb = F.in[I_MODB]; const float* normg = F.in[I_NORMG];
    float* modv = (float*)(F.ws + WS_MODV);
    for (int item = F.bid; item < 4 * 96; item += F.G) {
        const int L = item / 96, n0 = (item % 96) * 64;
        const float* wp = modw + (size_t)L * 1024 * 6144 + n0 + F.lane;
        float acc[9];
#pragma unroll
        for (int b = 0; b < 9; ++b) acc[b] = 0.f;
        const int k0 = F.wave * 128;
#pragma unroll 4
        for (int k = 0; k < 128; ++k) { const float wv = wp[(size_t)(k0 + k) * 6144];
#pragma unroll
            for (int b = 0; b < 9; ++b) acc[b] += SV[b * 1024 + k0 + k] * wv; }
#pragma unroll
        for (int b = 0; b < 9; ++b) RED[(F.wave * 9 + b) * 64 + F.lane] = acc[b];
        __syncthreads();
        for (int o = F.tid; o < 9 * 64; o += NTHR) { const int b = o >> 6, l = o & 63; float v = 0.f;
#pragma unroll
            for (int w = 0; w < 8; ++w) v += RED[(w * 9 + b) * 64 + l];
            const int n = n0 + l, s = n >> 10, c = n & 1023; v += modb[L * 6144 + n];
            const float* g = normg + (size_t)L * 4 * 1024;
            int slot; float r;
            if (s == 0) { slot = 1; r = v; } else if (s == 1) { slot = 0; r = g[c] * (1.f + v); } else if (s == 2) { slot = 2; r = v * g[1024 + c]; }
            else if (s == 3) { slot = 4; r = v; } else if (s == 4) { slot = 3; r = g[2048 + c] * (1.f + v); } else { slot = 5; r = v * g[3072 + c]; }
            modv[((size_t)(L * 9 + b) * 6 + slot) * 1024 + c] = r; }
        __syncthreads();
    }
}

__device__ __forceinline__ void wconv_item(const float* W, int K, int N, bf16* WT, int gu_mode, LAS float* scr, int item, int lane) {
    const int nblk = N / 32, kb = item / nblk, nb = item % nblk, k0 = 64 * kb, n0 = 32 * nb;
    int row0 = n0;
    if (gu_mode) { const int half = n0 / FF, nn = n0 - half * FF; row0 = 256 * (nn >> 7) + 128 * half + (nn & 127); }
#pragma unroll 8
    for (int i = 0; i < 32; ++i) { const int kk = 2 * i + (lane >> 5); scr[kk * 33 + (lane & 31)] = W[(size_t)(k0 + kk) * N + n0 + (lane & 31)]; }
    LDS_WAIT(); CFENCE();
    const int c = lane & 7;
#pragma unroll
    for (int j = 0; j < 4; ++j) { const int n = (lane >> 3) + 8 * j; const LAS float* s = scr + (8 * c) * 33 + n;
        v4u o; o.x = pk2(s[0 * 33], s[1 * 33]); o.y = pk2(s[2 * 33], s[3 * 33]); o.z = pk2(s[4 * 33], s[5 * 33]); o.w = pk2(s[6 * 33], s[7 * 33]);
        *(GAS v4u*)(WT + (size_t)(row0 + n) * K + k0 + 8 * c) = o; }
    LDS_WAIT(); CFENCE();
}
__device__ __forceinline__ void wconv_item8(const float* W, int K, int N, unsigned char* WT, int gu_mode, float wscale, LAS float* scr, int item, int lane) {
    const int nblk = N / 32, kb = item / nblk, nb = item % nblk, k0 = 64 * kb, n0 = 32 * nb;
    int row0 = n0;
    if (gu_mode) { const int half = n0 / FF, nn = n0 - half * FF; row0 = 256 * (nn >> 7) + 128 * half + (nn & 127); }
#pragma unroll 8
    for (int i = 0; i < 32; ++i) { const int kk = 2 * i + (lane >> 5); scr[kk * 33 + (lane & 31)] = W[(size_t)(k0 + kk) * N + n0 + (lane & 31)]; }
    LDS_WAIT(); CFENCE();
    const int c = lane & 7;
#pragma unroll
    for (int j = 0; j < 4; ++j) { const int n = (lane >> 3) + 8 * j; const LAS float* s = scr + (8 * c) * 33 + n;
        v2u o; unsigned w = 0; w = __builtin_amdgcn_cvt_pk_fp8_f32(s[0 * 33] * wscale, s[1 * 33] * wscale, w, false); w = __builtin_amdgcn_cvt_pk_fp8_f32(s[2 * 33] * wscale, s[3 * 33] * wscale, w, true); o.x = w;
        w = 0; w = __builtin_amdgcn_cvt_pk_fp8_f32(s[4 * 33] * wscale, s[5 * 33] * wscale, w, false); w = __builtin_amdgcn_cvt_pk_fp8_f32(s[6 * 33] * wscale, s[7 * 33] * wscale, w, true); o.y = w;
        *(GAS v2u*)(WT + (size_t)(row0 + n) * K + k0 + 8 * c) = o; }
    LDS_WAIT(); CFENCE();
}
__device__ __forceinline__ void phase_wconv(Frame& F, int L) {
    LAS float* scr = (LAS float*)(F.lds + F.wave * 16384);
    const int gw = F.bid * NWAVES + F.wave, NGW = F.G * NWAVES; const int j = L >> 1;
    if ((L & 1) == 0) {
        unsigned char* wb = F.ws + WS_WE;
        const float* w_in = F.in[I_MWIN] + (size_t)j * D * NW_M; const float* w_out = F.in[I_MWOUT] + (size_t)j * D * D;
        const float* w_gu = F.in[I_FWGU] + (size_t)j * D * NGU; const float* w_dn = F.in[I_FWDOWN] + (size_t)j * FF * D;
        constexpr int I0 = 16 * (NW_M / 32), I1 = 16 * 32, I2 = 16 * (NGU / 32), I3 = (FF / 64) * 32;
        for (int it = gw; it < I0 + I1 + I2 + I3; it += NGW) { int r = it;
            if (r < I0) { wconv_item(w_in, D, NW_M, (bf16*)(wb + WE_IN), 0, scr, r, F.lane); continue; } r -= I0;
            if (r < I1) { wconv_item(w_out, D, D, (bf16*)(wb + WE_OUT), 0, scr, r, F.lane); continue; } r -= I1;
            if (r < I2) { if (FFN_FP8_L(L)) wconv_item8(w_gu, D, NGU, wb + WE_GU, 1, WSCALE8, scr, r, F.lane); else wconv_item(w_gu, D, NGU, (bf16*)(wb + WE_GU), 1, scr, r, F.lane); continue; } r -= I2;
            if (FFN_FP8_L(L)) wconv_item8(w_dn, FF, D, wb + WE_DOWN, 0, WSCALE8, scr, r, F.lane); else wconv_item(w_dn, FF, D, (bf16*)(wb + WE_DOWN), 0, scr, r, F.lane); }
        GAS v4u* z = (GAS v4u*)(wb + WE_IN + (size_t)NW_M * D * 2); const int nz = (NIN_M - NW_M) * D * 2 / 16;
        for (int i = F.bid * NTHR + F.tid; i < nz; i += F.G * NTHR) z[i] = (v4u){0u, 0u, 0u, 0u};
    } else {
        unsigned char* wb = F.ws + WS_WO;
        const float* w_in = F.in[I_HWIN] + (size_t)j * D * NP_H; const float* w_out = F.in[I_HWOUT] + (size_t)j * D * D;
        const float* w_gu = F.in[I_EWGU] + (size_t)j * NEXP * D * NGU; const float* w_dn = F.in[I_EWDOWN] + (size_t)j * NEXP * FF * D;
        constexpr int I0 = 16 * (NP_H / 32), I1 = 16 * 32, I2 = 16 * (NGU / 32), I3 = (FF / 64) * 32;
        for (int it = gw; it < I0 + I1 + NEXP * (I2 + I3); it += NGW) { int r = it;
            if (r < I0) { wconv_item(w_in, D, NP_H, (bf16*)(wb + WOD_IN), 0, scr, r, F.lane); continue; } r -= I0;
            if (r < I1) { wconv_item(w_out, D, D, (bf16*)(wb + WOD_OUT), 0, scr, r, F.lane); continue; } r -= I1;
            const int e = r / (I2 + I3); r -= e * (I2 + I3);
            if (r < I2) { if (FFN_FP8_L(L)) wconv_item8(w_gu + (size_t)e * D * NGU, D, NGU, wb + WOD_GU + e * EGU_BYTES, 1, WSCALE8, scr, r, F.lane); else wconv_item(w_gu + (size_t)e * D * NGU, D, NGU, (bf16*)(wb + WOD_GU + e * EGU_BYTES), 1, scr, r, F.lane); continue; } r -= I2;
            if (FFN_FP8_L(L)) wconv_item8(w_dn + (size_t)e * FF * D, FF, D, wb + WOD_DOWN + e * EDOWN_BYTES, 0, WSCALE8, scr, r, F.lane); else wconv_item(w_dn + (size_t)e * FF * D, FF, D, (bf16*)(wb + WOD_DOWN + e * EDOWN_BYTES), 0, scr, r, F.lane); }
    }
}

struct TokCfg {
    const void* lat_src_l; const void* lat_src_c;
    void* lat_dst_l; void* lat_dst_c;
    int src_f32, dst_f32;
    const bf16* y; int y_perm; int moe_combine;
    const float* vupd;
    const float* vna; const float* vnb;
    bf16* u; int u_perm; int u_fp8;
    int route; int jr;
    int nrows;
};
__device__ __forceinline__ int perm_cm(int t) { return (t & 63) * ROWS_G + (t >> 6); }

struct RowRaw { v4u l0, l1, l2, l3; v2u a0, a1, a2, a3, b0, b1, b2, b3; };
__device__ __forceinline__ RowRaw tok_issue(const TokCfg& T, int row, int p0, int p1, int lane) {
    RowRaw R; const v4u z4 = (v4u){0u, 0u, 0u, 0u}; const v2u z2 = (v2u){0u, 0u};
    R.l0 = z4; R.l1 = z4; R.l2 = z4; R.l3 = z4; R.a0 = z2; R.a1 = z2; R.a2 = z2; R.a3 = z2; R.b0 = z2; R.b1 = z2; R.b2 = z2; R.b3 = z2;
    if (T.src_f32) { const GAS v4u* lp = (const GAS v4u*)(row < M_LAT ? (const float*)T.lat_src_l + (size_t)row * D : (const float*)T.lat_src_c + (size_t)(row - M_LAT) * D) + lane;
        R.l0 = lp[0]; R.l1 = lp[64]; R.l2 = lp[128]; R.l3 = lp[192]; }
    else { const GAS v2u* lp = (const GAS v2u*)(row < M_LAT ? (const bf16*)T.lat_src_l + (size_t)row * D : (const bf16*)T.lat_src_c + (size_t)(row - M_LAT) * D) + lane;
        const v2u a = lp[0], b = lp[64], c = lp[128], d = lp[192]; R.l0.x = a.x; R.l0.y = a.y; R.l1.x = b.x; R.l1.y = b.y; R.l2.x = c.x; R.l2.y = c.y; R.l3.x = d.x; R.l3.y = d.y; }
    if (T.y) {
        if (T.moe_combine) { const GAS v2u* ya = (const GAS v2u*)(T.y + (size_t)p0 * D) + lane; const GAS v2u* yb = (const GAS v2u*)(T.y + (size_t)p1 * D) + lane;
            R.a0 = ya[0]; R.a1 = ya[64]; R.a2 = ya[128]; R.a3 = ya[192]; R.b0 = yb[0]; R.b1 = yb[64]; R.b2 = yb[128]; R.b3 = yb[192]; }
        else { int yr = row; if (T.y_perm && row < M_LAT) yr = (row & ~8191) + perm_cm(row & 8191);
            const GAS v2u* yp = (const GAS v2u*)(T.y + (size_t)yr * D) + lane; R.a0 = yp[0]; R.a1 = yp[64]; R.a2 = yp[128]; R.a3 = yp[192]; }
    }
    return R;
}
__device__ __forceinline__ void phase_tok(Frame& F, const TokCfg& T) {
    const int gw = F.bid * NWAVES + F.wave, NGW = F.G * NWAVES;
    const int R = (T.nrows + NGW - 1) / NGW; const int r0 = gw * R; int r1 = r0 + R; if (r1 > T.nrows) r1 = T.nrows;
    LAS float* WR = (LAS float*)F.lds;
    if (T.route) { const float* wr = F.in[I_EWR] + (size_t)T.jr * 1024 * 8; for (int i = F.tid; i < 8192; i += NTHR) WR[i] = wr[i]; }
    __syncthreads();
    f32x4 VU[4], VA[4], VB[4]; int curb = -1;
    int my_e0 = 0, my_e1 = 0; float my_w = 0.f;
    const int* rrp = (const int*)(F.ws + WS_ROUTE + RT_R); const float* rwp = (const float*)(F.ws + WS_ROUTE + RT_W);
    int p0c = 0, p1c = 0, p0n = 0, p1n = 0; float w0c = 0.f, w0n = 0.f;
    if (T.moe_combine && r0 < r1) { p0c = rrp[2 * r0]; p1c = rrp[2 * r0 + 1]; w0c = rwp[r0]; if (r0 + 1 < r1) { p0n = rrp[2 * r0 + 2]; p1n = rrp[2 * r0 + 3]; w0n = rwp[r0 + 1]; } }
    RowRaw C = tok_issue(T, r0 < r1 ? r0 : 0, p0c, p1c, F.lane);
    for (int row = r0; row < r1; ++row) {
        const bool hn = row + 1 < r1;
        int p0nn = 0, p1nn = 0; float w0nn = 0.f;
        const RowRaw N = tok_issue(T, hn ? row + 1 : row, p0n, p1n, F.lane);
        if (hn) {
            if (T.moe_combine && row + 2 < r1) { p0nn = rrp[2 * row + 4]; p1nn = rrp[2 * row + 5]; w0nn = rwp[row + 2]; } }
        const int b = row < M_LAT ? (row >> 13) : 8;
        if (b != curb) { curb = b;
#pragma unroll
            for (int j = 0; j < 4; ++j) {
                if (T.y) VU[j] = ((const f32x4*)(T.vupd + (size_t)b * 6144))[F.lane + 64 * j];
                if (T.vna) { VA[j] = ((const f32x4*)(T.vna + (size_t)b * 6144))[F.lane + 64 * j]; VB[j] = ((const f32x4*)(T.vnb + (size_t)b * 6144))[F.lane + 64 * j]; } } }
        f32x4 v[4];
        if (T.src_f32) {
            v[0] = __builtin_bit_cast(f32x4, C.l0); v[1] = __builtin_bit_cast(f32x4, C.l1); v[2] = __builtin_bit_cast(f32x4, C.l2); v[3] = __builtin_bit_cast(f32x4, C.l3); }
        else {
            const v4u cl[4] = {C.l0, C.l1, C.l2, C.l3};
#pragma unroll
            for (int j = 0; j < 4; ++j) v[j] = (f32x4){bflo(cl[j].x), bfhi(cl[j].x), bflo(cl[j].y), bfhi(cl[j].y)}; }
        if (T.y) {
            f32x4 yv[4]; const v2u cya[4] = {C.a0, C.a1, C.a2, C.a3}, cyb[4] = {C.b0, C.b1, C.b2, C.b3};
            if (T.moe_combine) { const float w0 = w0c, w1 = 1.f - w0c;
#pragma unroll
                for (int j = 0; j < 4; ++j) { const v2u a = cya[j], c = cyb[j];
                    yv[j] = (f32x4){w0 * bflo(a.x) + w1 * bflo(c.x), w0 * bfhi(a.x) + w1 * bfhi(c.x), w0 * bflo(a.y) + w1 * bflo(c.y), w0 * bfhi(a.y) + w1 * bfhi(c.y)}; }
            } else {
#pragma unroll
                for (int j = 0; j < 4; ++j) { const v2u a = cya[j]; yv[j] = (f32x4){bflo(a.x), bfhi(a.x), bflo(a.y), bfhi(a.y)}; }
            }
            float ss = 0.f;
#pragma unroll
            for (int j = 0; j < 4; ++j) ss += (yv[j].x * yv[j].x + yv[j].y * yv[j].y) + (yv[j].z * yv[j].z + yv[j].w * yv[j].w);
            const float rs = rsqrtf(wave_sum(ss) * (1.f / D) + EPS);
#pragma unroll
            for (int j = 0; j < 4; ++j) v[j] = v[j] + VU[j] * (yv[j] * rs);
        }
        void* dpv = row < M_LAT ? T.lat_dst_l : T.lat_dst_c;
        if (dpv) { const size_t ro = (size_t)(row < M_LAT ? row : row - M_LAT) * D;
            if (T.dst_f32) { float* dp = (float*)dpv + ro;
#pragma unroll
                for (int j = 0; j < 4; ++j) ((GAS f32x4*)dp)[F.lane + 64 * j] = v[j]; }
            else { bf16* dp = (bf16*)dpv + ro;
#pragma unroll
                for (int j = 0; j < 4; ++j) { v2u o; o.x = pk2(v[j].x, v[j].y); o.y = pk2(v[j].z, v[j].w); ((GAS v2u*)dp)[F.lane + 64 * j] = o; } } }
        if (T.vna) {
            float ss = 0.f;
#pragma unroll
            for (int j = 0; j < 4; ++j) ss += (v[j].x * v[j].x + v[j].y * v[j].y) + (v[j].z * v[j].z + v[j].w * v[j].w);
            const float rs = rsqrtf(wave_sum(ss) * (1.f / D) + EPS);
            f32x4 uu[4];
#pragma unroll
            for (int j = 0; j < 4; ++j) uu[j] = (v[j] * rs) * VA[j] + VB[j];
            int ur = row; if (T.u_perm && row < M_LAT) ur = (row & ~8191) + perm_cm(row & 8191);
            if (T.u_fp8) { GAS unsigned* up8 = (GAS unsigned*)((unsigned char*)T.u + (size_t)ur * D);
#pragma unroll
                for (int j = 0; j < 4; ++j) { unsigned w = 0; w = __builtin_amdgcn_cvt_pk_fp8_f32(uu[j].x, uu[j].y, w, false); w = __builtin_amdgcn_cvt_pk_fp8_f32(uu[j].z, uu[j].w, w, true); up8[F.lane + 64 * j] = w; } }
            else { GAS v2u* up = (GAS v2u*)(T.u + (size_t)ur * D);
#pragma unroll
                for (int j = 0; j < 4; ++j) { v2u o; o.x = pk2(uu[j].x, uu[j].y); o.y = pk2(uu[j].z, uu[j].w); up[F.lane + 64 * j] = o; } }
            if (T.route) {
                float lg[8];
#pragma unroll
                for (int e = 0; e < 8; ++e) lg[e] = 0.f;
#pragma unroll
                for (int j = 0; j < 4; ++j)
#pragma unroll
                    for (int i = 0; i < 4; ++i) { const int c = 4 * (F.lane + 64 * j) + i; const f32x4 wa = *(const LAS f32x4*)(WR + c * 8), wb = *(const LAS f32x4*)(WR + c * 8 + 4); const float x = uu[j][i];
                        lg[0] += x * wa.x; lg[1] += x * wa.y; lg[2] += x * wa.z; lg[3] += x * wa.w; lg[4] += x * wb.x; lg[5] += x * wb.y; lg[6] += x * wb.z; lg[7] += x * wb.w; }
                const float* br = F.in[I_EBR] + T.jr * 8;
#pragma unroll
                for (int e = 0; e < 8; ++e) lg[e] = wave_sum(lg[e]) + br[e];
                int e0 = 0; float v0 = lg[0];
#pragma unroll
                for (int e = 1; e < 8; ++e) if (lg[e] > v0) { v0 = lg[e]; e0 = e; }
                int e1 = -1; float v1 = -3.0e38f;
#pragma unroll
                for (int e = 0; e < 8; ++e) if (e != e0 && lg[e] > v1) { v1 = lg[e]; e1 = e; }
                const float w0 = 1.f / (1.f + __expf(v1 - v0));
                if (F.lane == row - r0) { my_e0 = e0; my_e1 = e1; my_w = w0; }
            }
        }
        if (hn) { C = N; p0n = p0nn; p1n = p1nn; w0c = w0n; w0n = w0nn; }
    }
    if (T.route) {
        const int n = r1 - r0; const bool act = F.lane < n; const int row = r0 + F.lane;
        unsigned* ecnt = (unsigned*)(F.ws + WS_CTL) + CW_ECNT + T.jr * 8 * 64;
        int rk0 = 0, rk1 = 0;
        const unsigned long long ltmask = (F.lane == 0) ? 0ull : (~0ull >> (64 - F.lane));
#pragma unroll
        for (int e = 0; e < 8; ++e) {
            const unsigned long long m0 = __ballot(act && my_e0 == e), m1 = __ballot(act && my_e1 == e);
            const int c0 = __popcll(m0), c1 = __popcll(m1);
            unsigned base = 0;
            if (c0 + c1 > 0) { if (F.lane == 0) base = __hip_atomic_fetch_add(ecnt + e * 64, (unsigned)(c0 + c1), RLX_AGENT); base = __builtin_amdgcn_readfirstlane(base); }
            if (my_e0 == e) rk0 = (int)base + __popcll(m0 & ltmask);
            if (my_e1 == e) rk1 = (int)base + c0 + __popcll(m1 & ltmask);
        }
        if (act) { ((int*)(F.ws + WS_ROUTE + RT_E))[row] = my_e0 | (my_e1 << 8); ((int*)(F.ws + WS_ROUTE + RT_R))[2 * row] = rk0; ((int*)(F.ws + WS_ROUTE + RT_R))[2 * row + 1] = rk1;
            ((float*)(F.ws + WS_ROUTE + RT_W))[row] = my_w; }
    }
}

__device__ __forceinline__ void phase_moe_scatter(Frame& F, int jr, int nrows, const unsigned char* U, unsigned char* AM, int rowb) {
    const unsigned* ecnt = (const unsigned*)(F.ws + WS_CTL) + CW_ECNT + jr * 8 * 64;
    int base[8]; int acc = 0;
#pragma unroll
    for (int e = 0; e < 8; ++e) { const int c = (int)__hip_atomic_load(ecnt + e * 64, RLX_AGENT); base[e] = acc; acc += (c + 255) & ~255; }
    int* pexp = (int*)(F.ws + WS_SMALL + SM_PEXP);
    if (F.bid == 0) { const int np = acc >> 8;
        for (int p = F.tid; p < np; p += NTHR) { int e = 0;
#pragma unroll
            for (int q = 1; q < 8; ++q) if (p * 256 >= base[q]) e = q;
            pexp[p] = e; }
        if (F.tid == 0) pexp[MOE_PANELS] = np; }
    const int gw = F.bid * NWAVES + F.wave, NGW = F.G * NWAVES;
    const int R = (nrows + NGW - 1) / NGW; const int r0 = gw * R; int r1 = r0 + R; if (r1 > nrows) r1 = nrows;
    int* rr = (int*)(F.ws + WS_ROUTE + RT_R); const int* re = (const int*)(F.ws + WS_ROUTE + RT_E);
    for (int row = r0; row < r1; ++row) {
        const int ee = re[row], e0 = ee & 255, e1 = ee >> 8; int b0 = 0, b1 = 0;
#pragma unroll
        for (int e = 0; e < 8; ++e) { if (e0 == e) b0 = base[e]; if (e1 == e) b1 = base[e]; }
        const int p0 = b0 + rr[2 * row], p1 = b1 + rr[2 * row + 1];
        const v4u* src = (const v4u*)(U + (size_t)row * rowb); v4u* d0 = (v4u*)(AM + (size_t)p0 * rowb); v4u* d1 = (v4u*)(AM + (size_t)p1 * rowb);
        const v4u a = src[F.lane]; d0[F.lane] = a; d1[F.lane] = a;
        if (rowb > 1024) { const v4u c = src[F.lane + 64]; d0[F.lane + 64] = c; d1[F.lane + 64] = c; }
        CFENCE();
        if (F.lane == 0) { rr[2 * row] = p0; rr[2 * row + 1] = p1; }
    }
}

#define MFMA32(a, b, c) __builtin_amdgcn_mfma_f32_32x32x16_bf16((a), (b), (c), 0, 0, 0)
typedef short v4i16_t __attribute__((ext_vector_type(4)));
typedef LAS unsigned char* ldsp;
__device__ __forceinline__ unsigned cvtpk(float lo, float hi) { f32x2_t v = {lo, hi}; bf16x2_t b = __builtin_convertvector(v, bf16x2_t); return __builtin_bit_cast(unsigned, b); }
__device__ __forceinline__ int crow(int reg, int h) { return (reg & 3) + 8 * (reg >> 2) + 4 * h; }
__device__ __forceinline__ bf16x8 pack8(const f32x16& x, int s) {
    v4u p; p.x = cvtpk(x[8 * s], x[8 * s + 1]); p.y = cvtpk(x[8 * s + 2], x[8 * s + 3]); p.z = cvtpk(x[8 * s + 4], x[8 * s + 5]); p.w = cvtpk(x[8 * s + 6], x[8 * s + 7]);
    return __builtin_bit_cast(bf16x8, p);
}
__device__ __forceinline__ bf16x8 lds16(ldsp p) { return *(const LAS bf16x8*)p; }
__device__ __forceinline__ bf16x8 lds8x2(ldsp p) { const s16x4 lo = *(const LAS s16x4*)p, hi = *(const LAS s16x4*)(p + 16); return __builtin_shufflevector(lo, hi, 0, 1, 2, 3, 4, 5, 6, 7); }
__device__ __forceinline__ s16x4 tr16(ldsp p) { return __builtin_bit_cast(s16x4, __builtin_amdgcn_ds_read_tr16_b64_v4i16((LAS v4i16_t*)p)); }
__device__ __forceinline__ bf16x8 ldstr2(ldsp p, int second) { const s16x4 lo = tr16(p), hi = tr16(p + second); return __builtin_shufflevector(lo, hi, 0, 1, 2, 3, 4, 5, 6, 7); }
__device__ __forceinline__ f32x16 zero16() { f32x16 z;
#pragma unroll
    for (int i = 0; i < 16; ++i) z[i] = 0.f; return z; }
__device__ __forceinline__ void unpack8(const v4u& w, float (&x)[8]) { x[0] = bflo(w.x); x[1] = bfhi(w.x); x[2] = bflo(w.y); x[3] = bfhi(w.y); x[4] = bflo(w.z); x[5] = bfhi(w.z); x[6] = bflo(w.w); x[7] = bfhi(w.w); }
__device__ __forceinline__ int launder_v(int x) { asm volatile("" : "+v"(x)); return x; }
struct FragOff { int o_row, o_perm, o_trn, o_trp; };
__device__ __forceinline__ FragOff frag_off(int lane, int LD) {
    const int r = lane & 31, hh = lane >> 5, i16 = lane & 15, q = i16 >> 2, p = i16 & 3, blk = (lane >> 4) & 1; FragOff f;
    f.o_row = (r * LD + 8 * hh) * 2; f.o_perm = (r * LD + 4 * hh) * 2;
    f.o_trn = ((8 * hh + q) * LD + 16 * blk + 4 * p) * 2; f.o_trp = ((4 * hh + q) * LD + 16 * blk + 4 * p) * 2; return f;
}


template <int CTRL, int RM, int BM> __device__ __forceinline__ float dpp_f(float old, float x) {
    return __builtin_bit_cast(float, __builtin_amdgcn_update_dpp(__builtin_bit_cast(int, old), __builtin_bit_cast(int, x), CTRL, RM, BM, false)); }
__device__ __forceinline__ float wave_scan_add(float x) {
    float r = x;
    r += dpp_f<0x111, 0xf, 0xf>(0.f, x); r += dpp_f<0x112, 0xf, 0xf>(0.f, x); r += dpp_f<0x113, 0xf, 0xf>(0.f, x);
    r += dpp_f<0x114, 0xf, 0xe>(0.f, r); r += dpp_f<0x118, 0xf, 0xc>(0.f, r);
    r += dpp_f<0x142, 0xa, 0xf>(0.f, r); r += dpp_f<0x143, 0xc, 0xf>(0.f, r);
    return r;
}
__device__ __forceinline__ float wave_scan_max(float x) {
    const float NEG = -3.0e38f; float r = x;
    r = fmaxf(r, dpp_f<0x111, 0xf, 0xf>(NEG, x)); r = fmaxf(r, dpp_f<0x112, 0xf, 0xf>(NEG, x)); r = fmaxf(r, dpp_f<0x113, 0xf, 0xf>(NEG, x));
    r = fmaxf(r, dpp_f<0x114, 0xf, 0xe>(NEG, r)); r = fmaxf(r, dpp_f<0x118, 0xf, 0xc>(NEG, r));
    r = fmaxf(r, dpp_f<0x142, 0xa, 0xf>(NEG, r)); r = fmaxf(r, dpp_f<0x143, 0xc, 0xf>(NEG, r));
    return r;
}
__device__ __forceinline__ float lane63(float x) { return __builtin_bit_cast(float, __builtin_amdgcn_readlane(__builtin_bit_cast(int, x), 63)); }
__device__ __forceinline__ float sum_halves(float x) {
    const unsigned u = __builtin_bit_cast(unsigned, x); auto rr = __builtin_amdgcn_permlane32_swap(u, u, false, false);
    return __builtin_bit_cast(float, (unsigned)rr[0]) + __builtin_bit_cast(float, (unsigned)rr[1]); }

__device__ __forceinline__ void item_headnorm(int tid, const bf16* hf, const bf16* hb, const bf16* gate, int gpitch, int gcol, const float* gh_head, bf16* aout, int rowbase, int t0, int ntok, int h) {
    VM_WAIT(); __syncthreads();
    const int sub = tid & 7, rr = tid >> 3;
    float gh[16];
#pragma unroll
    for (int e = 0; e < 16; ++e) gh[e] = gh_head[sub * 16 + e];
#pragma unroll 2
    for (int row = rr; row < ntok; row += 64) {
        const size_t grow = (size_t)(rowbase + t0 + row);
        const size_t o = grow * D + h * 128 + sub * 16;
        const v4u a0 = *(const GAS v4u*)(hf + o), a1 = *(const GAS v4u*)(hf + o + 8), b0 = *(const GAS v4u*)(hb + o), b1 = *(const GAS v4u*)(hb + o + 8);
        const bf16* gp = gate + grow * gpitch + gcol + h * 128 + sub * 16; const v4u g0 = *(const GAS v4u*)gp, g1 = *(const GAS v4u*)(gp + 8);
        float x[16], y[8];
        unpack8(a0, y);
#pragma unroll
        for (int e = 0; e < 8; ++e) x[e] = y[e];
        unpack8(a1, y);
#pragma unroll
        for (int e = 0; e < 8; ++e) x[8 + e] = y[e];
        unpack8(b0, y);
#pragma unroll
        for (int e = 0; e < 8; ++e) x[e] += y[e];
        unpack8(b1, y);
#pragma unroll
        for (int e = 0; e < 8; ++e) x[8 + e] += y[e];
        float ss = 0.f;
#pragma unroll
        for (int e = 0; e < 16; ++e) ss += x[e] * x[e];
        ss += __shfl_xor(ss, 1); ss += __shfl_xor(ss, 2); ss += __shfl_xor(ss, 4);
        const float rs = rsqrtf(ss * (1.f / 128.f) + EPS);
        float o16[16];
        unpack8(g0, y);
#pragma unroll
        for (int e = 0; e < 8; ++e) o16[e] = x[e] * rs * gh[e] * sigmoidf_(y[e]);
        unpack8(g1, y);
#pragma unroll
        for (int e = 0; e < 8; ++e) o16[8 + e] = x[8 + e] * rs * gh[8 + e] * sigmoidf_(y[e]);
        v4u w0, w1; w0.x = pk2(o16[0], o16[1]); w0.y = pk2(o16[2], o16[3]); w0.z = pk2(o16[4], o16[5]); w0.w = pk2(o16[6], o16[7]); w1.x = pk2(o16[8], o16[9]); w1.y = pk2(o16[10], o16[11]); w1.z = pk2(o16[12], o16[13]); w1.w = pk2(o16[14], o16[15]);
        *(GAS v4u*)(aout + o) = w0; *(GAS v4u*)(aout + o + 8) = w1;
    }
}

constexpr int ML_LDQ = 72, ML_LDV = 136;
constexpr int ML_QC = 0, ML_KC = 9216, ML_KH = 18432, ML_V = 27648, ML_GS = 45056, ML_OB = 50176, ML_NV = 68608, ML_SSQ = 70656, ML_INV = 71680, ML_GROUP = 73728;
static_assert(2 * ML_GROUP <= LDS_MAIN, "mLSTM LDS map");
constexpr int ML_STATE_F = 8448;

struct MlPref { v4u q[2], k[2], v[4]; float gi, gf; };
struct MlSeg { int rowbase; int len; int t0; int nchunk; };

__device__ __forceinline__ void ml_issue(MlPref& P, const bf16* proj, const bf16* qkc, const float* gates, int rowbase, int t0c, int g, int h, int tg, int lane, bool need_q) {
    const int c8q = tg & 7;
#pragma unroll
    for (int i = 0; i < 2; ++i) { const int tau = (tg + 256 * i) >> 3; const int t = t0c + (g ? 63 - tau : tau);
        const bf16* rp = qkc + (size_t)(rowbase + t) * D + h * 64 + c8q * 8;
        P.q[i] = need_q ? *(const GAS v4u*)rp : (v4u){0u, 0u, 0u, 0u}; P.k[i] = *(const GAS v4u*)(rp + 512); }
#pragma unroll
    for (int i = 0; i < 4; ++i) { const int p = tg + 256 * i, tau = p >> 4, c8 = p & 15; const int t = t0c + (g ? 63 - tau : tau);
        P.v[i] = *(const GAS v4u*)(proj + (size_t)(rowbase + t) * NP_M + 1024 + h * 128 + c8 * 8); }
    { const int t = t0c + (g ? 63 - lane : lane); const GAS float* gp = (const GAS float*)(gates + (size_t)(rowbase + t) * 32 + g * 16 + h); P.gi = gp[0]; P.gf = gp[8]; }
}

template <bool OUTPUT>
__device__ __forceinline__ void mlstm_item(Frame& F, const bf16* proj, const bf16* qkc, const float* gates, bf16* hx0, bf16* hx1, bf16* aout, const float* ghead,
                                           int h, MlSeg S0, MlSeg S1, const float* st_in0, const float* st_in1, int npre0, int npre1, float* st_out0, float* st_out1) {
    const int tid_l = launder_v(F.tid); const int wave_l = __builtin_amdgcn_readfirstlane(tid_l >> 6);
    const int g = wave_l >> 2, j = wave_l & 3, tg = tid_l & 255, lane = tid_l & 63, r = lane & 31, hh = lane >> 5;
    const ldsp gb = F.lds + g * ML_GROUP;
    const ldsp GSb = gb + ML_GS + j * 1280;
    LAS float* GS = (LAS float*)GSb;
    const ldsp OBb = gb + ML_OB + j * 4608;
    LAS float* NV = (LAS float*)(gb + ML_NV);
    LAS float* SSQ = (LAS float*)(gb + ML_SSQ);
    const ldsp INVb = gb + ML_INV + j * 256;
    const int rowbase = g ? S1.rowbase : S0.rowbase, seg_t0 = g ? S1.t0 : S0.t0, nch = g ? S1.nchunk : S0.nchunk;
    const int vcol = 64 * j;
    __syncthreads();
    f32x16 C[2]; C[0] = zero16(); C[1] = zero16();
    float m_prev = -1.0e30f, btot = 0.f;
    float nreg = 0.f;
    if (OUTPUT) {
        const float* sp = g ? st_in1 : st_in0; const int np = g ? npre1 : npre0;
#pragma unroll 1
        for (int k = 0; k < np; ++k) { const float* e = sp + (size_t)k * ML_STATE_F;
            const float mloc = e[8192 + 64], B = e[8192 + 65];
            const float mnew = fmaxf(B + m_prev, mloc), al = __expf(B + m_prev - mnew), be = __expf(mloc - mnew);
            const float* ep = e + (4 * hh) * 128 + 32 * j + r;
#pragma unroll
            for (int dt = 0; dt < 2; ++dt)
#pragma unroll
                for (int i = 0; i < 16; ++i) C[dt][i] = al * C[dt][i] + be * ep[(32 * dt + (i & 3) + 8 * (i >> 2)) * 128];
            nreg = al * nreg + be * e[8192 + 16 * j + (lane & 15)];
            m_prev = mnew; }
    }
    if (lane < 16) NV[16 * j + lane] = nreg;
    MlPref PP[2]; ml_issue(PP[0], proj, qkc, gates, rowbase, seg_t0 + 64 * (g ? nch - 1 : 0), g, h, tg, lane, OUTPUT);
    ml_issue(PP[1], proj, qkc, gates, rowbase, seg_t0 + 64 * (g ? nch - 2 : 1), g, h, tg, lane, OUTPUT);
    __syncthreads();
#pragma unroll 1
    for (int step2 = 0; step2 < nch; step2 += 2) {
#pragma unroll
    for (int hf = 0; hf < 2; ++hf) { const int step = step2 + hf; MlPref& P = PP[hf];
        const int tgs = launder_v(tg), lns = launder_v(lane);
        const int r = lns & 31, hh = lns >> 5;
        const FragOff fq = frag_off(lns, ML_LDQ), fv = frag_off(lns, ML_LDV);
        const int o_h4 = 16 * hh;
        const int o_obw = (4 * hh * 36 + r) * 4, o_obr = ((lns >> 1) * 36 + 16 * (lns & 1)) * 4;
        const int ci = g ? nch - 1 - step : step;
        const int par = step & 1;
        float decay;
        {
            const float xi = P.gi, lf = P.gf;
            const float bc = wave_scan_add(lf);
            const float a = xi - bc; const float pm = wave_scan_max(a);
            const float Mt = fmaxf(m_prev, pm);
            const float Ml = lane63(Mt), bl = lane63(bc);
            GS[lns] = a; GS[64 + lns] = Mt; GS[128 + lns] = __expf(m_prev - Mt); GS[192 + lns] = __expf(-(bc + Mt)); GS[256 + lns] = __expf(a - Ml);
            decay = __expf(m_prev - Ml); m_prev = bl + Ml; btot += bl;
        }
        LDS_WAIT(); CFENCE();
        {
            const int c8 = tgs & 7;
#pragma unroll
            for (int i = 0; i < 2; ++i) { const int tau = (tgs + 256 * i) >> 3; const ldsp tp = gb + (tau * ML_LDQ + c8 * 8) * 2;
                if (OUTPUT) { *(LAS v4u*)(tp + ML_QC) = P.q[i]; *(LAS v4u*)(tp + ML_KC) = P.k[i]; }
                float o[8]; unpack8(P.k[i], o); const float wkk = GS[256 + tau]; v4u w;
                w.x = pk2(o[0] * wkk, o[1] * wkk); w.y = pk2(o[2] * wkk, o[3] * wkk); w.z = pk2(o[4] * wkk, o[5] * wkk); w.w = pk2(o[6] * wkk, o[7] * wkk);
                *(LAS v4u*)(tp + ML_KH) = w; }
#pragma unroll
            for (int i = 0; i < 4; ++i) { const int p = tgs + 256 * i, tau = p >> 4, cc = p & 15; *(LAS v4u*)(gb + ML_V + (tau * ML_LDV + cc * 8) * 2) = P.v[i]; }
        }
        if (step + 2 < nch) ml_issue(P, proj, qkc, gates, rowbase, seg_t0 + 64 * (g ? nch - 3 - step : step + 2), g, h, tgs, lns, OUTPUT);
        __syncthreads();
        if (OUTPUT) {
            bf16* hx = g ? hx1 : hx0;
#pragma unroll
            for (int tt = 0; tt < 2; ++tt) {
                f32x16 acc = zero16();
#pragma unroll
                for (int dt = 0; dt < 2; ++dt)
#pragma unroll
                    for (int sp = 0; sp < 2; ++sp) acc = MFMA32(lds8x2(gb + ML_QC + fq.o_perm + (32 * tt * ML_LDQ + 32 * dt + 16 * sp) * 2), pack8(C[dt], sp), acc);
#pragma unroll
                for (int q4 = 0; q4 < 4; ++q4) { const f32x4 wv = *(const LAS f32x4*)(GSb + o_h4 + (128 + 32 * tt + 8 * q4) * 4);
#pragma unroll
                    for (int e = 0; e < 4; ++e) acc[4 * q4 + e] *= wv[e]; }
                const float Mt = GS[64 + 32 * tt + r];
                float den = 0.f;
#pragma unroll
                for (int st = 0; st <= tt; ++st) {
                    f32x16 s = zero16();
#pragma unroll
                    for (int ks = 0; ks < 4; ++ks) s = MFMA32(lds16(gb + ML_KC + fq.o_row + (32 * st * ML_LDQ + 16 * ks) * 2), lds16(gb + ML_QC + fq.o_row + (32 * tt * ML_LDQ + 16 * ks) * 2), s);
#pragma unroll
                    for (int q4 = 0; q4 < 4; ++q4) { const f32x4 av = *(const LAS f32x4*)(GSb + o_h4 + (32 * st + 8 * q4) * 4);
#pragma unroll
                        for (int e = 0; e < 4; ++e) { const int i = 4 * q4 + e; const int srow = 32 * st + crow(i, hh); const float pv = (srow <= 32 * tt + r) ? s[i] * __expf(av[e] - Mt) : 0.f; s[i] = pv; den += pv; } }
                    const bf16x8 pa0 = pack8(s, 0), pa1 = pack8(s, 1);
                    acc = MFMA32(pa0, ldstr2(gb + ML_V + fv.o_trp + vcol + ((32 * st) * ML_LDV) * 2, 8 * ML_LDV * 2), acc);
                    acc = MFMA32(pa1, ldstr2(gb + ML_V + fv.o_trp + vcol + ((32 * st + 16) * ML_LDV) * 2, 8 * ML_LDV * 2), acc);
                    }
                float qn;
                { float q0 = 0.f, q1 = 0.f, q2 = 0.f, q3 = 0.f;
#pragma unroll
                for (int c4 = 0; c4 < 4; ++c4) { const v4u qw = *(const LAS v4u*)(gb + ML_QC + (r * ML_LDQ + 32 * hh) * 2 + (32 * tt * ML_LDQ + 8 * c4) * 2); float qx[8]; unpack8(qw, qx);
                    const f32x4 n0 = *(const LAS f32x4*)(gb + ML_NV + 8 * o_h4 + (par * 64 + 8 * c4) * 4), n1 = *(const LAS f32x4*)(gb + ML_NV + 8 * o_h4 + (par * 64 + 8 * c4 + 4) * 4);
                    q0 += qx[0] * n0[0] + qx[4] * n1[0]; q1 += qx[1] * n0[1] + qx[5] * n1[1]; q2 += qx[2] * n0[2] + qx[6] * n1[2]; q3 += qx[3] * n0[3] + qx[7] * n1[3]; }
                qn = (q0 + q1) + (q2 + q3); }
                den = sum_halves(den); qn = sum_halves(qn);
                const float dtot = den + GS[128 + 32 * tt + r] * qn;
                const float inv = __builtin_amdgcn_rcpf(fmaxf(fabsf(dtot), GS[192 + 32 * tt + r]));
                if (hh == 0) *(LAS float*)(INVb + (32 * tt + r) * 4) = inv;
                LDS_WAIT(); CFENCE();
                f32x16 hv;
#pragma unroll
                for (int q4 = 0; q4 < 4; ++q4) { const f32x4 iv = *(const LAS f32x4*)(INVb + o_h4 + (32 * tt + 8 * q4) * 4);
#pragma unroll
                    for (int e = 0; e < 4; ++e) { const int i = 4 * q4 + e; hv[i] = acc[i] * iv[e]; } }
#pragma unroll
                for (int i = 0; i < 16; ++i) *(LAS float*)(OBb + o_obw + ((i & 3) + 8 * (i >> 2)) * 144) = hv[i];
                LDS_WAIT(); CFENCE();
                { const f32x4 x0 = *(const LAS f32x4*)(OBb + o_obr), x1 = *(const LAS f32x4*)(OBb + o_obr + 16), x2 = *(const LAS f32x4*)(OBb + o_obr + 32), x3 = *(const LAS f32x4*)(OBb + o_obr + 48);
                    const int tau = 32 * tt + (lns >> 1); const int t = seg_t0 + 64 * ci + (g ? 63 - tau : tau);
                    bf16* op = hx + (size_t)(rowbase + t) * D + h * 128 + 32 * j + 16 * (lns & 1);
                    v4u w0, w1; w0.x = pk2(x0[0], x0[1]); w0.y = pk2(x0[2], x0[3]); w0.z = pk2(x1[0], x1[1]); w0.w = pk2(x1[2], x1[3]); w1.x = pk2(x2[0], x2[1]); w1.y = pk2(x2[2], x2[3]); w1.z = pk2(x3[0], x3[1]); w1.w = pk2(x3[2], x3[3]);
                    *(GAS v4u*)op = w0; *(GAS v4u*)(op + 8) = w1; }
                LDS_WAIT(); CFENCE();
            }
        }
        __builtin_amdgcn_sched_barrier(0);
#pragma unroll
        for (int dt = 0; dt < 2; ++dt) {
#pragma unroll
            for (int i = 0; i < 16; ++i) C[dt][i] *= decay;
#pragma unroll
            for (int ks = 0; ks < 4; ++ks) C[dt] = MFMA32(ldstr2(gb + ML_KH + fq.o_trn + (16 * ks * ML_LDQ + 32 * dt) * 2, 4 * ML_LDQ * 2), ldstr2(gb + ML_V + fv.o_trn + vcol + (16 * ks * ML_LDV) * 2, 4 * ML_LDV * 2), C[dt]);
        }
        {   const int dkl = 16 * j + (lns & 15), tq = lns >> 4; float s0 = 0.f, s1 = 0.f;
#pragma unroll
            for (int i = 0; i < 16; i += 2) { s0 += bf2f(*(const LAS bf16*)(gb + ML_KH + ((16 * tq + i) * ML_LDQ + dkl) * 2)); s1 += bf2f(*(const LAS bf16*)(gb + ML_KH + ((16 * tq + i + 1) * ML_LDQ + dkl) * 2)); }
            float sacc = s0 + s1; sacc += __shfl_xor(sacc, 16); sacc = sum_halves(sacc);
            nreg = decay * nreg + sacc; if (lns < 16) NV[(par ^ 1) * 64 + dkl] = nreg; }
        __syncthreads();
    } }
    if (OUTPUT) item_headnorm(launder_v(tid_l), hx0, hx1, proj, NP_M, 2048, ghead + h * 128, aout, S0.rowbase, S0.t0, S0.nchunk * 64, h);
    if (!OUTPUT) {
        float* e = g ? st_out1 : st_out0; float* ep = e + (4 * hh) * 128 + 32 * j + r;
#pragma unroll
        for (int dt = 0; dt < 2; ++dt)
#pragma unroll
            for (int i = 0; i < 16; ++i) ep[(32 * dt + (i & 3) + 8 * (i >> 2)) * 128] = C[dt][i];
        if (lane < 16) e[8192 + 16 * j + lane] = nreg;
        if (j == 0 && lane == 0) { e[8192 + 64] = m_prev; e[8192 + 65] = btot; }
    }
}

constexpr int HG_LD = 136;
constexpr int HG_LF = 0, HG_QT = 16384, HG_KT = 25088, HG_KH = 33792, HG_V = 42496, HG_OB = 51200, HG_AUX = 69632, HG_SSQ = 71168, HG_EAM = 71680, HG_BIAS = 72192, HG_LBV = 72704, HG_GROUP = 73728;
static_assert(2 * HG_GROUP <= LDS_MAIN, "HGRN2 LDS map");
constexpr int HG_STATE_F = 16512;

struct HgPref { v4u q[2], f[2], v[2]; };
__device__ __forceinline__ void hg_issue(HgPref& P, const bf16* proj, int rowbase, int t0c, int g, int h, int tg, bool need_q) {
#pragma unroll
    for (int i = 0; i < 2; ++i) { const int p = tg + 256 * i, tau = p >> 4, c8 = p & 15; const int t = t0c + (g ? 31 - tau : tau);
        const bf16* rp = proj + (size_t)(rowbase + t) * NP_H + h * 128 + c8 * 8;
        P.q[i] = need_q ? *(const GAS v4u*)rp : (v4u){0u, 0u, 0u, 0u}; P.v[i] = *(const GAS v4u*)(rp + 1024); P.f[i] = *(const GAS v4u*)(rp + 2048 + 1024 * g); }
}
__device__ __forceinline__ float clamp80(float x) { return fminf(fmaxf(x, -80.f), 80.f); }

template <bool OUTPUT>
__device__ __forceinline__ void hgrn_item(Frame& F, const bf16* proj, bf16* hx0, bf16* hx1, bf16* aout, const float* ghead, const float* bf_, const float* lbraw, int jl,
                                          int h, MlSeg S0, MlSeg S1, const float* st_in0, const float* st_in1, int npre0, int npre1, float* st_out0, float* st_out1) {
    const int tid_l = launder_v(F.tid); const int wave_l = __builtin_amdgcn_readfirstlane(tid_l >> 6);
    const int g = wave_l >> 2, j = wave_l & 3, tg = tid_l & 255, lane = tid_l & 63, r = lane & 31, hh = lane >> 5;
    const ldsp gb = F.lds + g * HG_GROUP;
    LAS float* LF = (LAS float*)(gb + HG_LF);
    const ldsp OBb = gb + HG_OB + j * 4608;
    LAS float* AMID = (LAS float*)(gb + HG_AUX); LAS float* ALAST = AMID + 128; LAS float* DEC = AMID + 256;
    LAS float* SSQ = (LAS float*)(gb + HG_SSQ); LAS float* EAM = (LAS float*)(gb + HG_EAM); LAS float* BIASV = (LAS float*)(gb + HG_BIAS); LAS float* LBV = (LAS float*)(gb + HG_LBV);
    const int rowbase = g ? S1.rowbase : S0.rowbase, seg_t0 = g ? S1.t0 : S0.t0, nch = g ? S1.nchunk : S0.nchunk;
    const int vcol = 64 * j;
    __syncthreads();
    if (tg < 128) { const int c = h * 128 + tg; BIASV[tg] = bf_[g * 1024 + c]; LBV[tg] = jl == 0 ? 0.f : sigmoidf_(lbraw[(1 * 2 + g) * 1024 + c] - lbraw[(0 * 2 + g) * 1024 + c]); }
    f32x16 St[4];
#pragma unroll
    for (int dt = 0; dt < 4; ++dt) St[dt] = zero16();
    float atot = 0.f;
    if (OUTPUT) {   const float* sp = g ? st_in1 : st_in0; const int np = g ? npre1 : npre0;
#pragma unroll 1
        for (int k = 0; k < np; ++k) { const float* e = sp + (size_t)k * HG_STATE_F; const float* ep = e + (4 * hh) * 128 + 32 * j + r; const float* ap = e + 16384 + 4 * hh;
#pragma unroll
            for (int dt = 0; dt < 4; ++dt)
#pragma unroll
                for (int i = 0; i < 16; ++i) { const int dk0 = 32 * dt + (i & 3) + 8 * (i >> 2); St[dt][i] = __expf(ap[dk0]) * St[dt][i] + ep[dk0 * 128]; } }
    }
    HgPref PP[2]; hg_issue(PP[0], proj, rowbase, seg_t0 + 32 * (g ? nch - 1 : 0), g, h, tg, OUTPUT);
    hg_issue(PP[1], proj, rowbase, seg_t0 + 32 * (g ? nch - 2 : 1), g, h, tg, OUTPUT);
    __syncthreads();
#pragma unroll 1
    for (int step2 = 0; step2 < nch; step2 += 2) {
#pragma unroll
    for (int hf = 0; hf < 2; ++hf) { const int step = step2 + hf; HgPref& P = PP[hf];
        const int tgs = launder_v(tg), lns = launder_v(lane);
        const int r = lns & 31, hh = lns >> 5;
        const FragOff fo = frag_off(lns, HG_LD);
        const int o_h4 = 16 * hh;
        const int o_obw = (4 * hh * 36 + r) * 4, o_obr = ((lns >> 1) * 36 + 16 * (lns & 1)) * 4;
        const int c8 = tgs & 15;
        const int o_piece = (((tgs >> 4) * HG_LD) + c8 * 8) * 2;
        const int ci = g ? nch - 1 - step : step;
#pragma unroll
        for (int i = 0; i < 2; ++i) { const int tau = (tgs + 256 * i) >> 4; float x[8], lf[8], kk[8]; unpack8(P.f[i], x);
            const f32x4 b0 = *(const LAS f32x4*)(BIASV + c8 * 8), b1 = *(const LAS f32x4*)(BIASV + c8 * 8 + 4), l0 = *(const LAS f32x4*)(LBV + c8 * 8), l1 = *(const LAS f32x4*)(LBV + c8 * 8 + 4);
            const float bb[8] = {b0[0], b0[1], b0[2], b0[3], b1[0], b1[1], b1[2], b1[3]}, ll[8] = {l0[0], l0[1], l0[2], l0[3], l1[0], l1[1], l1[2], l1[3]};
#pragma unroll
            for (int e = 0; e < 8; ++e) { const float sg = sigmoidf_(x[e] + bb[e]); const float f = ll[e] + (1.f - ll[e]) * sg; lf[e] = __logf(fmaxf(f, 1e-37f)); kk[e] = 1.f - f; }
            *(LAS f32x4*)(LF + tau * 128 + c8 * 8) = (f32x4){lf[0], lf[1], lf[2], lf[3]}; *(LAS f32x4*)(LF + tau * 128 + c8 * 8 + 4) = (f32x4){lf[4], lf[5], lf[6], lf[7]};
            v4u w; w.x = pk2(kk[0], kk[1]); w.y = pk2(kk[2], kk[3]); w.z = pk2(kk[4], kk[5]); w.w = pk2(kk[6], kk[7]);
            const ldsp tp = gb + o_piece + i * (16 * HG_LD * 2);
            *(LAS v4u*)(tp + HG_KT) = w;
            if (OUTPUT) *(LAS v4u*)(tp + HG_QT) = P.q[i];
            *(LAS v4u*)(tp + HG_V) = P.v[i]; }
        if (step + 2 < nch) hg_issue(P, proj, rowbase, seg_t0 + 32 * (g ? nch - 3 - step : step + 2), g, h, tgs, OUTPUT);
        __syncthreads();
        {   const int dkc = tgs & 127, half = tgs >> 7; float pre = 0.f;
            if (half) { float p0 = 0.f, p1 = 0.f, p2 = 0.f, p3 = 0.f;
#pragma unroll
                for (int tau = 0; tau < 16; tau += 4) { p0 += LF[tau * 128 + dkc]; p1 += LF[(tau + 1) * 128 + dkc]; p2 += LF[(tau + 2) * 128 + dkc]; p3 += LF[(tau + 3) * 128 + dkc]; }
                pre = (p0 + p1) + (p2 + p3); }
            float v[16];
#pragma unroll
            for (int i = 0; i < 16; ++i) v[i] = LF[(16 * half + i) * 128 + dkc];
            LDS_WAIT(); __builtin_amdgcn_s_barrier(); CFENCE();
            float run = pre;
#pragma unroll
            for (int i = 0; i < 16; ++i) { run += v[i]; LF[(16 * half + i) * 128 + dkc] = run; }
            if (!half) { AMID[dkc] = run; EAM[dkc] = __expf(run); } else { ALAST[dkc] = __expf(run - pre); DEC[dkc] = __expf(run); atot += run; } }
        __syncthreads();
#pragma unroll
        for (int i = 0; i < 2; ++i) { const int tau = (tgs + 256 * i) >> 4; const ldsp tp = gb + o_piece + i * (16 * HG_LD * 2);
            const f32x4 a0 = *(const LAS f32x4*)(LF + tau * 128 + c8 * 8), a1 = *(const LAS f32x4*)(LF + tau * 128 + c8 * 8 + 4);
            const f32x4 m0 = *(const LAS f32x4*)(AMID + c8 * 8), m1 = *(const LAS f32x4*)(AMID + c8 * 8 + 4), l0 = *(const LAS f32x4*)(ALAST + c8 * 8), l1 = *(const LAS f32x4*)(ALAST + c8 * 8 + 4);
            float a[8] = {a0[0], a0[1], a0[2], a0[3], a1[0], a1[1], a1[2], a1[3]}, am[8] = {m0[0], m0[1], m0[2], m0[3], m1[0], m1[1], m1[2], m1[3]}, al[8] = {l0[0], l0[1], l0[2], l0[3], l1[0], l1[1], l1[2], l1[3]};
            float qx[8], kx[8], qo[8], ko[8], ho[8]; { const v4u kw = *(const LAS v4u*)(tp + HG_KT); unpack8(kw, kx); if (OUTPUT) { const v4u qw = *(const LAS v4u*)(tp + HG_QT); unpack8(qw, qx); } }
#pragma unroll
            for (int e = 0; e < 8; ++e) { const float e1 = __expf(clamp80(a[e] - am[e])); const float kt = kx[e] * __builtin_amdgcn_rcpf(e1);
                if (OUTPUT) { qo[e] = qx[e] * e1; ko[e] = kt; } ho[e] = kt * al[e]; }
            v4u w;
            if (OUTPUT) { w.x = pk2(qo[0], qo[1]); w.y = pk2(qo[2], qo[3]); w.z = pk2(qo[4], qo[5]); w.w = pk2(qo[6], qo[7]); *(LAS v4u*)(tp + HG_QT) = w;
                w.x = pk2(ko[0], ko[1]); w.y = pk2(ko[2], ko[3]); w.z = pk2(ko[4], ko[5]); w.w = pk2(ko[6], ko[7]); *(LAS v4u*)(tp + HG_KT) = w; }
            w.x = pk2(ho[0], ho[1]); w.y = pk2(ho[2], ho[3]); w.z = pk2(ho[4], ho[5]); w.w = pk2(ho[6], ho[7]); *(LAS v4u*)(tp + HG_KH) = w; }
        __syncthreads();
        if (OUTPUT) {
            bf16* hx = g ? hx1 : hx0;
            f32x16 s = zero16();
#pragma unroll
            for (int ks = 0; ks < 8; ++ks) s = MFMA32(lds16(gb + HG_KT + fo.o_row + 32 * ks), lds16(gb + HG_QT + fo.o_row + 32 * ks), s);
#pragma unroll
            for (int i = 0; i < 16; ++i) s[i] = (crow(i, hh) <= r) ? s[i] : 0.f;
            f32x16 o = zero16();
#pragma unroll
            for (int sp = 0; sp < 2; ++sp) o = MFMA32(pack8(s, sp), ldstr2(gb + HG_V + fo.o_trp + vcol + (16 * sp * HG_LD) * 2, 8 * HG_LD * 2), o);
#pragma unroll
            for (int dt = 0; dt < 4; ++dt)
#pragma unroll
                for (int sp = 0; sp < 2; ++sp) { const f32x4 e0 = *(const LAS f32x4*)(gb + HG_EAM + o_h4 + (32 * dt + 16 * sp) * 4), e1 = *(const LAS f32x4*)(gb + HG_EAM + o_h4 + (32 * dt + 16 * sp + 8) * 4);
                    v4u pw; pw.x = cvtpk(St[dt][8 * sp] * e0[0], St[dt][8 * sp + 1] * e0[1]); pw.y = cvtpk(St[dt][8 * sp + 2] * e0[2], St[dt][8 * sp + 3] * e0[3]);
                    pw.z = cvtpk(St[dt][8 * sp + 4] * e1[0], St[dt][8 * sp + 5] * e1[1]); pw.w = cvtpk(St[dt][8 * sp + 6] * e1[2], St[dt][8 * sp + 7] * e1[3]);
                    o = MFMA32(lds8x2(gb + HG_QT + fo.o_perm + (32 * dt + 16 * sp) * 2), __builtin_bit_cast(bf16x8, pw), o); }
#pragma unroll
            for (int i = 0; i < 16; ++i) *(LAS float*)(OBb + o_obw + ((i & 3) + 8 * (i >> 2)) * 144) = o[i];
            LDS_WAIT(); CFENCE();
            { const f32x4 x0 = *(const LAS f32x4*)(OBb + o_obr), x1 = *(const LAS f32x4*)(OBb + o_obr + 16), x2 = *(const LAS f32x4*)(OBb + o_obr + 32), x3 = *(const LAS f32x4*)(OBb + o_obr + 48);
                const int tau = lns >> 1; const int t = seg_t0 + 32 * ci + (g ? 31 - tau : tau);
                bf16* op = hx + (size_t)(rowbase + t) * D + h * 128 + 32 * j + 16 * (lns & 1);
                v4u w0, w1; w0.x = pk2(x0[0], x0[1]); w0.y = pk2(x0[2], x0[3]); w0.z = pk2(x1[0], x1[1]); w0.w = pk2(x1[2], x1[3]); w1.x = pk2(x2[0], x2[1]); w1.y = pk2(x2[2], x2[3]); w1.z = pk2(x3[0], x3[1]); w1.w = pk2(x3[2], x3[3]);
                *(GAS v4u*)op = w0; *(GAS v4u*)(op + 8) = w1; }
            LDS_WAIT(); CFENCE();
        }
#pragma unroll
        for (int dt = 0; dt < 4; ++dt) {
#pragma unroll
            for (int q4 = 0; q4 < 4; ++q4) { const f32x4 dv = *(const LAS f32x4*)(gb + HG_AUX + 1024 + o_h4 + (32 * dt + 8 * q4) * 4);
#pragma unroll
                for (int e = 0; e < 4; ++e) St[dt][4 * q4 + e] *= dv[e]; }
#pragma unroll
            for (int sp = 0; sp < 2; ++sp) St[dt] = MFMA32(ldstr2(gb + HG_KH + fo.o_trn + (16 * sp * HG_LD + 32 * dt) * 2, 4 * HG_LD * 2), ldstr2(gb + HG_V + fo.o_trn + vcol + (16 * sp * HG_LD) * 2, 4 * HG_LD * 2), St[dt]);
        }
        __syncthreads();
    } }
    if (OUTPUT) item_headnorm(launder_v(tid_l), hx0, hx1, proj, NP_H, 4096, ghead + h * 128, aout, S0.rowbase, S0.t0, S0.nchunk * 32, h);
    if (!OUTPUT) {
        float* e = g ? st_out1 : st_out0; float* ep = e + (4 * hh) * 128 + 32 * j + r;
#pragma unroll
        for (int dt = 0; dt < 4; ++dt)
#pragma unroll
            for (int i = 0; i < 16; ++i) ep[(32 * dt + (i & 3) + 8 * (i >> 2)) * 128] = St[dt][i];
        if (tg >= 128) e[16384 + (tg & 127)] = atot;
    }
}

constexpr int PH_PER_LAYER = 11, PH_BASE = 2, N_PHASES = PH_BASE + DEPTH * PH_PER_LAYER;
#ifndef EN_GEMM
#define EN_GEMM 0xff
#endif
#ifndef EN_ML
#define EN_ML 3
#endif
#ifndef EN_HG
#define EN_HG 3
#endif
#ifndef EN_TOK
#define EN_TOK 1
#endif
#ifndef EN_MISC
#define EN_MISC 1
#endif
#ifndef PG_SP2
#define PG_SP2 true
#endif
#ifndef PG_ALIGN
#define PG_ALIGN true
#endif
#ifndef TIMER_MASK
#define TIMER_MASK 0ull
#endif
#ifndef TIMER_DIV
#define TIMER_DIV 20.0f
#endif
#ifndef MK_SPLIT
#define MK_SPLIT 0
#endif


__device__ __forceinline__ void phase_headnorm(Frame& F, const bf16* hf, const bf16* hb, const bf16* gate, int gpitch, int gcol0, const float* ghead, bf16* aout, int nrows) {
    const int tid = launder_v(F.tid); const int lane = tid & 63, wave = __builtin_amdgcn_readfirstlane(tid >> 6);
    const int gw = F.bid * NWAVES + wave, NGW = F.G * NWAVES;
    float gh[16];
#pragma unroll
    for (int e = 0; e < 16; ++e) gh[e] = ghead[lane * 16 + e];
    for (int row = gw; row < nrows; row += NGW) {
        const v4u a0 = *(const v4u*)(hf + (size_t)row * D + lane * 16), a1 = *(const v4u*)(hf + (size_t)row * D + lane * 16 + 8);
        const v4u b0 = *(const v4u*)(hb + (size_t)row * D + lane * 16), b1 = *(const v4u*)(hb + (size_t)row * D + lane * 16 + 8);
        const v4u g0 = *(const v4u*)(gate + (size_t)row * gpitch + gcol0 + lane * 16), g1 = *(const v4u*)(gate + (size_t)row * gpitch + gcol0 + lane * 16 + 8);
        float x[16], y[8], o[16]; unpack8(a0, y);
#pragma unroll
        for (int e = 0; e < 8; ++e) x[e] = y[e];
        unpack8(a1, y);
#pragma unroll
        for (int e = 0; e < 8; ++e) x[8 + e] = y[e];
        unpack8(b0, y);
#pragma unroll
        for (int e = 0; e < 8; ++e) x[e] += y[e];
        unpack8(b1, y);
#pragma unroll
        for (int e = 0; e < 8; ++e) x[8 + e] += y[e];
        float ss = 0.f;
#pragma unroll
        for (int e = 0; e < 16; ++e) ss += x[e] * x[e];
        ss += __shfl_xor(ss, 1); ss += __shfl_xor(ss, 2); ss += __shfl_xor(ss, 4);
        const float rs = rsqrtf(ss * (1.f / 128.f) + EPS);
        unpack8(g0, y);
#pragma unroll
        for (int e = 0; e < 8; ++e) o[e] = x[e] * rs * gh[e] * sigmoidf_(y[e]);
        unpack8(g1, y);
#pragma unroll
        for (int e = 0; e < 8; ++e) o[8 + e] = x[8 + e] * rs * gh[8 + e] * sigmoidf_(y[e]);
        v4u w0, w1; w0.x = pk2(o[0], o[1]); w0.y = pk2(o[2], o[3]); w0.z = pk2(o[4], o[5]); w0.w = pk2(o[6], o[7]); w1.x = pk2(o[8], o[9]); w1.y = pk2(o[10], o[11]); w1.z = pk2(o[12], o[13]); w1.w = pk2(o[14], o[15]);
        *(v4u*)(aout + (size_t)row * D + lane * 16) = w0; *(v4u*)(aout + (size_t)row * D + lane * 16 + 8) = w1;
    }
}

__device__ __forceinline__ void phase_conv(Frame& F, const bf16* proj, bf16* qkc, float* gates, const float* wconv, const float* bgate) {
    const int gt = F.bid * NTHR + F.tid, cp = gt & 127, rstep = (F.G * NTHR) >> 7;
    float w[3][8];
#pragma unroll
    for (int d = 0; d < 3; ++d)
#pragma unroll
        for (int e = 0; e < 8; ++e) w[d][e] = wconv[d * 1024 + cp * 8 + e];
    const float sc = cp >= 64 ? 0.125f : 1.0f;
    for (int row = gt >> 7; row < M_ALL; row += rstep) {
        int t, len; if (row < M_LAT) { t = row & (SEQ - 1); len = SEQ; } else { t = (row - M_LAT) & (CTXL - 1); len = CTXL; }
        const bf16* rp = proj + (size_t)row * NP_M + cp * 8;
        const v4u z = (v4u){0u, 0u, 0u, 0u};
        const v4u r0 = t > 0 ? *(const v4u*)(rp - NP_M) : z, r1 = *(const v4u*)rp, r2 = t + 1 < len ? *(const v4u*)(rp + NP_M) : z;
        float x0[8], x1[8], x2[8], o[8]; unpack8(r0, x0); unpack8(r1, x1); unpack8(r2, x2);
#pragma unroll
        for (int e = 0; e < 8; ++e) o[e] = sc * siluf_(w[0][e] * x0[e] + w[1][e] * x1[e] + w[2][e] * x2[e]);
        v4u q; q.x = pk2(o[0], o[1]); q.y = pk2(o[2], o[3]); q.z = pk2(o[4], o[5]); q.w = pk2(o[6], o[7]);
        *(v4u*)(qkc + (size_t)row * D + cp * 8) = q;
    }
    for (int i = gt; i < M_ALL * 32; i += F.G * NTHR) { const int c = i & 31; const float x = gates[i] + bgate[c];
        gates[i] = ((c >> 3) & 1) ? (fminf(x, 0.f) - __logf(1.f + __expf(-fabsf(x)))) : x; }
}

__device__ __forceinline__ void timer_stamp(unsigned char* lds_raw, bool add) {
    if (threadIdx.x == 0) { volatile LAS unsigned* tw = (volatile LAS unsigned*)((LAS unsigned char*)lds_raw + LDSCTL_OFF) + 32;
        const unsigned long long t = wall_clock64(); const unsigned long long last = ((unsigned long long)tw[1] << 32) | tw[0];
        if (add) { unsigned long long acc = ((unsigned long long)tw[3] << 32) | tw[2]; acc += t - last; tw[2] = (unsigned)acc; tw[3] = (unsigned)(acc >> 32); }
        tw[0] = (unsigned)t; tw[1] = (unsigned)(t >> 32); }
}

__device__ __forceinline__ void seg_of(bool odd, bool ctx_out, int q, int& t0, int& len) {
    int a, b; if (!ctx_out) { a = 2048; b = 2048; } else if (!odd) { a = 30 * 64; b = 34 * 64; } else { a = 60 * 32; b = 68 * 32; }
    t0 = (q == 0) ? 0 : (q == 1) ? a : (q == 2) ? a + b : a + 2 * b; len = (q == 0 || q == 3) ? a : b;
}

__device__ __forceinline__ Frame mkframe(const Args& args, unsigned char* lds_raw) {
    Frame F; int t = threadIdx.x; asm volatile("" : "+v"(t));
    F.lds = (LAS unsigned char*)lds_raw; F.tid = t; F.lane = t & 63; F.wave = __builtin_amdgcn_readfirstlane(t >> 6);
    int g = gridDim.x, b = blockIdx.x; asm volatile("" : "+s"(g), "+s"(b)); F.G = g; F.bid = b;
    const __attribute__((address_space(4))) Args* ap = (const __attribute__((address_space(4))) Args*)__builtin_amdgcn_kernarg_segment_ptr(); asm volatile("" : "+s"(ap));
    F.ws = ap->ws; F.in = ap->in; F.out = ap->out;
    return F;
}
#define PHASE_LOCALS \
    Frame F = mkframe(args, lds_raw); unsigned char* ws = F.ws; \
    float* modv = (float*)(ws + WS_MODV); bf16* U = (bf16*)(ws + WS_U); bf16* Y = (bf16*)(ws + WS_Y); bf16* PROJ = (bf16*)(ws + WS_ACT); bf16* HB = (bf16*)(ws + WS_ACT); \
    bf16* AMOE = (bf16*)(ws + WS_ACT); bf16* HMOE = (bf16*)(ws + WS_ACT + (size_t)MOE_ROWS * D * 2); \
    float* GATES = (float*)(ws + WS_GATES); float* LATC = (float*)(ws + WS_LATC); float* STATE = (float*)(ws + WS_STATE); \
    const int* pexp = (const int*)(ws + WS_SMALL + SM_PEXP); \
    unsigned char* wb = ws + (odd ? WS_WO : WS_WE); const float* mv = modv + (size_t)L * 9 * 6 * 1024; \
    (void)modv; (void)U; (void)Y; (void)PROJ; (void)HB; (void)AMOE; (void)HMOE; (void)GATES; (void)LATC; (void)STATE; (void)pexp; (void)wb; (void)mv;

__global__ void __launch_bounds__(NTHR, 2) fwd(Args args) {
    extern __shared__ __attribute__((aligned(16))) unsigned char lds_raw[];
    Frame F = mkframe(args, lds_raw);
    volatile LAS unsigned* LCTL = (volatile LAS unsigned*)(F.lds + LDSCTL_OFF);
    for (int u = F.tid; u < 128; u += NTHR) LCTL[u] = 0u;
    __syncthreads();
    XcdBarrier bar; bar.bar = (unsigned*)(F.ws + WS_CTL) + CW_BAR; bar.x = 0; bar.st = nullptr;
    if (args.use_bar) bar = xcd_barrier_post((unsigned*)(F.ws + WS_CTL) + CW_BAR, LCTL + 8);
    const int lo = args.ph_lo, hi = args.ph_hi;
#define IN(k) (lo <= (k) && (k) < hi)
#define SEAM(k) do { if ((k) + 1 < hi) xcd_barrier(bar.bar, bar.x, bar.st); if (TIMER_MASK != 0ull) timer_stamp(lds_raw, ((TIMER_MASK >> (k)) & 1ull) != 0ull); } while (0)
    if (TIMER_MASK != 0ull) timer_stamp(lds_raw, false);
    if (IN(0)) { const int L = 0; const bool odd = false; PHASE_LOCALS if (EN_MISC) phase_mods(F); __syncthreads(); if (EN_MISC) phase_wconv(F, 0); SEAM(0); }
    if (IN(1)) { const int L = 0; const bool odd = false; PHASE_LOCALS
        TokCfg T{}; T.lat_src_l = F.in[I_X]; T.lat_src_c = F.in[I_CTX]; T.src_f32 = 1; T.vna = modv + 0 * 1024; T.vnb = modv + 1 * 1024; T.u = U; T.nrows = M_ALL;
        if (EN_TOK) phase_tok(F, T); __syncthreads(); if (EN_MISC) phase_wconv(F, 1); SEAM(1);
    }
    for (int L = 0; L < DEPTH; ++L) {
        const int pb = PH_BASE + L * PH_PER_LAYER; const bool odd = (L & 1) != 0; const int jl = L >> 1;
        const bool ctx_out = L < DEPTH - 1;
        if (IN(pb + 0)) { PHASE_LOCALS
            pg8::Order S; pg8::Gemm g;
            if (!odd) { g = pg8::Gemm{U, (const bf16*)(wb + WE_IN), M_ALL, NIN_M, D}; S.init(M_ALL / 256, NIN_M, F.G, F.bid, nullptr, 0);
                pg8::EpiStore E{PROJ, NP_M, NP_M / 256, NP_M / 256, GATES, 1.0f}; if (EN_GEMM & (1 << 0)) pg8::gemm_phase<pg8::EpiStore, pg8::Order, PG_ALIGN, PG_SP2>(F.lds, g, S, E); }
            else { g = pg8::Gemm{U, (const bf16*)(wb + WOD_IN), M_ALL, NP_H, D}; S.init(M_ALL / 256, NP_H, F.G, F.bid, nullptr, 0);
                pg8::EpiStore E{PROJ, NP_H, NP_H / 256, -1, nullptr, 1.0f}; if (EN_GEMM & (1 << 1)) pg8::gemm_phase<pg8::EpiStore, pg8::Order, PG_ALIGN, PG_SP2>(F.lds, g, S, E); }
            SEAM(pb + 0);
        }
        if (IN(pb + 1)) {
            if (!odd) { PHASE_LOCALS
                phase_conv(F, PROJ, (bf16*)(ws + WS_ACT + 400 * MiB), GATES, F.in[I_MWCONV] + (size_t)jl * 3 * 1024, F.in[I_MBGATE] + jl * 32); SEAM(pb + 1); }
        }
        if (IN(pb + 2)) { PHASE_LOCALS
            for (int id = F.bid; id < 256; id += F.G) {
                const int bh = id >> 2, p = id & 3, b = bh >> 3, h = bh & 7;
                MlSeg SG0, SG1;
                const int csz = odd ? 32 : 64;
                if (p == 0) { SG0 = MlSeg{M_LAT + b * CTXL, CTXL, 0, CTXL / csz}; SG1 = SG0; }
                else { int t0a, la, t0b, lb2; seg_of(odd, ctx_out, p - 1, t0a, la); seg_of(odd, ctx_out, 4 - p, t0b, lb2); SG0 = MlSeg{b * SEQ, SEQ, t0a, la / csz}; SG1 = MlSeg{b * SEQ, SEQ, t0b, lb2 / csz}; }
                if (!odd) { float* e0 = STATE + (size_t)((bh * 2 + 0) * 4 + p) * ML_STATE_F; float* e1 = STATE + (size_t)((bh * 2 + 1) * 4 + p) * ML_STATE_F;
                    if (EN_ML & 1) mlstm_item<false>(F, PROJ, (const bf16*)(ws + WS_ACT + 400 * MiB), GATES, (bf16*)(ws + WS_ACT + 536 * MiB), (bf16*)(ws + WS_Y), U, F.in[I_MGHEAD] + jl * 1024, h, SG0, SG1, nullptr, nullptr, 0, 0, e0, e1); }
                else { float* e0 = STATE + (size_t)((bh * 2 + 0) * 4 + p) * HG_STATE_F; float* e1 = STATE + (size_t)((bh * 2 + 1) * 4 + p) * HG_STATE_F;
                    if (EN_HG & 1) hgrn_item<false>(F, PROJ, U, (bf16*)(ws + WS_Y), U, F.in[I_HGHEAD] + jl * 1024, F.in[I_HBF] + (size_t)jl * 2048, F.in[I_HLB], jl, h, SG0, SG1, nullptr, nullptr, 0, 0, e0, e1); }
            }
            SEAM(pb + 2);
        }
        if (IN(pb + 3)) { PHASE_LOCALS
            const int nitems = ctx_out ? 320 : 256;
            for (int id = F.bid; id < nitems; id += F.G) {
                MlSeg SG0, SG1; int bh, npre0 = 0, npre1 = 0; const int csz = odd ? 32 : 64;
                if (id < 256) { int q; if (id < 128) { bh = id >> 1; q = (id & 1) ? 3 : 0; } else { bh = (id - 128) >> 1; q = 1 + (id & 1); } int t0q, lq; seg_of(odd, ctx_out, q, t0q, lq); SG0 = MlSeg{(bh >> 3) * SEQ, SEQ, t0q, lq / csz}; npre0 = q + 1; npre1 = 4 - q; }
                else { bh = id - 256; SG0 = MlSeg{M_LAT + (bh >> 3) * CTXL, CTXL, 0, CTXL / csz}; }
                SG1 = SG0;
                const int h = bh & 7;
                if (!odd) { const float* s0 = STATE + (size_t)((bh * 2 + 0) * 4) * ML_STATE_F; const float* s1 = STATE + (size_t)((bh * 2 + 1) * 4) * ML_STATE_F;
                    if (EN_ML & 2) mlstm_item<true>(F, PROJ, (const bf16*)(ws + WS_ACT + 400 * MiB), GATES, (bf16*)(ws + WS_ACT + 536 * MiB), (bf16*)(ws + WS_Y), U, F.in[I_MGHEAD] + jl * 1024, h, SG0, SG1, s0, s1, npre0, npre1, nullptr, nullptr); }
                else { const float* s0 = STATE + (size_t)((bh * 2 + 0) * 4) * HG_STATE_F; const float* s1 = STATE + (size_t)((bh * 2 + 1) * 4) * HG_STATE_F;
                    if (EN_HG & 2) hgrn_item<true>(F, PROJ, U, (bf16*)(ws + WS_Y), U, F.in[I_HGHEAD] + jl * 1024, F.in[I_HBF] + (size_t)jl * 2048, F.in[I_HLB], jl, h, SG0, SG1, s0, s1, npre0, npre1, nullptr, nullptr); }
            }
            SEAM(pb + 3);
        }
        if (IN(pb + 5)) { PHASE_LOCALS
            const int nM = (ctx_out ? M_ALL : M_LAT) / 256;
            pg8::Gemm g{U, (const bf16*)(wb + (odd ? WOD_OUT : WE_OUT)), nM * 256, D, D}; pg8::Order S; S.init(nM, D, F.G, F.bid, nullptr, 0);
            pg8::EpiStore E{Y, D, D / 256, -1, nullptr, 1.0f}; if (EN_GEMM & (1 << 2)) pg8::gemm_phase<pg8::EpiStore, pg8::Order, PG_ALIGN, PG_SP2>(F.lds, g, S, E);
            SEAM(pb + 5);
        }
        if (IN(pb + 6)) { PHASE_LOCALS
            TokCfg T{}; bf16* LAT16 = (bf16*)(ws + WS_ACT + 836 * MiB); T.src_f32 = (L == 0) ? 1 : 0; T.lat_src_l = (L == 0) ? (const void*)F.in[I_X] : (const void*)LAT16; T.lat_src_c = (L == 0) ? (const void*)F.in[I_CTX] : (const void*)LATC; T.lat_dst_l = LAT16; T.lat_dst_c = LATC;
            T.y = Y; T.y_perm = odd ? 1 : 0; T.vupd = mv + 2 * 1024; T.vna = mv + 3 * 1024; T.vnb = mv + 4 * 1024; T.u = U; T.u_fp8 = FFN_FP8_L(L); T.route = odd ? 1 : 0; T.jr = jl; T.nrows = ctx_out ? M_ALL : M_LAT;
            if (EN_TOK) phase_tok(F, T);
            if (L >= 1 && L + 1 < DEPTH) { __syncthreads(); if (EN_MISC) phase_wconv(F, L + 1); }
            SEAM(pb + 6);
        }
        if (IN(pb + 7)) { PHASE_LOCALS
            if (odd) { if (EN_MISC) phase_moe_scatter(F, jl, ctx_out ? M_ALL : M_LAT, (const unsigned char*)U, (unsigned char*)AMOE, FFN_FP8_L(L) ? 1024 : 2048); SEAM(pb + 7); }
        }
        if (IN(pb + 8)) { PHASE_LOCALS
            const bool f8 = FFN_FP8_L(L) != 0;
            if (!odd) { pg8::Gemm g{U, (const bf16*)(wb + WE_GU), M_ALL, NGU, D}; pg8::Order S; S.init(M_ALL / 256, NGU, F.G, F.bid, nullptr, 0);
                if (f8) { if ((FP8_LAYERS) & 0x5) { pg8::EpiSwiGLU8 E{(unsigned char*)HB, FF, 1.0f / WSCALE8}; if (EN_GEMM & (1 << 3)) pg8::gemm_phase<pg8::EpiSwiGLU8, pg8::Order, PG_ALIGN, PG_SP2, true>(F.lds, g, S, E); } }
                else { if ((~(FP8_LAYERS)) & 0x5) { pg8::EpiSwiGLU E{HB, FF}; if (EN_GEMM & (1 << 3)) pg8::gemm_phase<pg8::EpiSwiGLU, pg8::Order, PG_ALIGN, PG_SP2>(F.lds, g, S, E); } } }
            else { const int np = __builtin_amdgcn_readfirstlane(pexp[MOE_PANELS]);
                pg8::Gemm g{AMOE, (const bf16*)(wb + WOD_GU), np * 256, NGU, D}; pg8::Order S; S.init(np, NGU, F.G, F.bid, pexp, EGU_BYTES);
                if (f8) { if ((FP8_LAYERS) & 0xA) { pg8::EpiSwiGLU8 E{(unsigned char*)HMOE, FF, 1.0f / WSCALE8}; if (EN_GEMM & (1 << 4)) pg8::gemm_phase<pg8::EpiSwiGLU8, pg8::Order, PG_ALIGN, PG_SP2, true>(F.lds, g, S, E); } }
                else { if ((~(FP8_LAYERS)) & 0xA) { pg8::EpiSwiGLU E{HMOE, FF}; if (EN_GEMM & (1 << 4)) pg8::gemm_phase<pg8::EpiSwiGLU, pg8::Order, PG_ALIGN, PG_SP2>(F.lds, g, S, E); } } }
            SEAM(pb + 8);
        }
        if (IN(pb + 9)) { PHASE_LOCALS
            const bool f8 = FFN_FP8_L(L) != 0;
            if (!odd) { pg8::Gemm g{HB, (const bf16*)(wb + WE_DOWN), M_ALL, D, FF}; pg8::Order S; S.init(M_ALL / 256, D, F.G, F.bid, nullptr, 0);
                if (f8) { if ((FP8_LAYERS) & 0x5) { pg8::EpiStore E{Y, D, D / 256, -1, nullptr, 1.0f / WSCALE8}; if (EN_GEMM & (1 << 5)) pg8::gemm_phase<pg8::EpiStore, pg8::Order, PG_ALIGN, PG_SP2, true>(F.lds, g, S, E); } }
                else { if ((~(FP8_LAYERS)) & 0x5) { pg8::EpiStore E{Y, D, D / 256, -1, nullptr, 1.0f}; if (EN_GEMM & (1 << 5)) pg8::gemm_phase<pg8::EpiStore, pg8::Order, PG_ALIGN, PG_SP2>(F.lds, g, S, E); } } }
            else { const int np = __builtin_amdgcn_readfirstlane(pexp[MOE_PANELS]);
                pg8::Gemm g{HMOE, (const bf16*)(wb + WOD_DOWN), np * 256, D, FF}; pg8::Order S; S.init(np, D, F.G, F.bid, pexp, EDOWN_BYTES);
                if (f8) { if ((FP8_LAYERS) & 0xA) { pg8::EpiStore E{AMOE, D, D / 256, -1, nullptr, 1.0f / WSCALE8}; if (EN_GEMM & (1 << 6)) pg8::gemm_phase<pg8::EpiStore, pg8::Order, PG_ALIGN, PG_SP2, true>(F.lds, g, S, E); } }
                else { if ((~(FP8_LAYERS)) & 0xA) { pg8::EpiStore E{AMOE, D, D / 256, -1, nullptr, 1.0f}; if (EN_GEMM & (1 << 6)) pg8::gemm_phase<pg8::EpiStore, pg8::Order, PG_ALIGN, PG_SP2>(F.lds, g, S, E); } } }
            SEAM(pb + 9);
        }
        if (IN(pb + 10)) { PHASE_LOCALS
            TokCfg T{}; bf16* LAT16 = (bf16*)(ws + WS_ACT + 836 * MiB); T.lat_src_l = LAT16; T.lat_src_c = LATC; T.lat_dst_l = (L + 1 < DEPTH) ? (void*)LAT16 : (void*)F.out; T.lat_dst_c = LATC; T.dst_f32 = (L + 1 < DEPTH) ? 0 : 1;
            T.y = odd ? AMOE : Y; T.moe_combine = odd ? 1 : 0; T.vupd = mv + 5 * 1024; T.nrows = ctx_out ? M_ALL : M_LAT;
            if (L + 1 < DEPTH) { const float* mn = modv + (size_t)(L + 1) * 9 * 6 * 1024; T.vna = mn; T.vnb = mn + 1024; T.u = U; T.u_perm = ((L + 1) & 1) ? 1 : 0; }
            if (EN_TOK) phase_tok(F, T);
            SEAM(pb + 10);
        }
    }
    if (TIMER_MASK != 0ull) { timer_stamp(lds_raw, ((TIMER_MASK >> (N_PHASES - 1)) & 1ull) != 0ull);
        if (blockIdx.x == 0 && threadIdx.x == 0) { volatile LAS unsigned* tw = (volatile LAS unsigned*)((LAS unsigned char*)lds_raw + LDSCTL_OFF) + 32; const unsigned long long acc = ((unsigned long long)tw[3] << 32) | tw[2];
            asm volatile("s_waitcnt vmcnt(0)" ::: "memory"); args.out[0] = (float)acc * 0.01f / TIMER_DIV; } }
#undef IN
#undef SEAM
}

extern "C" void kernel_launch(void* const* d_in, const int* in_sizes, int n_in, void* d_out, int out_size, void* d_ws, size_t ws_size, hipStream_t stream) {
    static int grid = 0;
    if (grid == 0) {
        if (n_in != 23 || out_size != M_LAT * D || ws_size < WS_END) { fprintf(stderr, "kernel_launch: unexpected shapes / workspace (n_in %d out %d ws %zu need %zu)\n", n_in, out_size, ws_size, (size_t)WS_END); grid = -1; return; }
        int dev = 0, cus = 0, per_cu = 0;
        if (hipGetDevice(&dev) != hipSuccess || hipDeviceGetAttribute(&cus, hipDeviceAttributeMultiprocessorCount, dev) != hipSuccess) { grid = -1; return; }
        if (hipFuncSetAttribute((const void*)fwd, hipFuncAttributeMaxDynamicSharedMemorySize, LDS_BYTES) != hipSuccess) { fprintf(stderr, "kernel_launch: hipFuncSetAttribute failed\n"); grid = -1; return; }
        if (hipOccupancyMaxActiveBlocksPerMultiprocessor(&per_cu, (const void*)fwd, NTHR, LDS_BYTES) != hipSuccess || per_cu < 1) fprintf(stderr, "kernel_launch: occupancy query reports %d\n", per_cu);
        (void)hipGetLastError();
        grid = cus;
    }
    if (grid < 0) return;
    (void)hipMemsetAsync((char*)d_ws + WS_CTL, 0, CTL_ZERO_BYTES, stream);
    Args a{};
    for (int i = 0; i < 23; ++i) a.in[i] = (const float*)d_in[i];
    a.out = (float*)d_out; a.ws = (unsigned char*)d_ws;
#if MK_SPLIT
    for (int p = 0; p < N_PHASES; ++p) { a.ph_lo = p; a.ph_hi = p + 1; a.use_bar = 0; a.pad = 0; hipLaunchKernelGGL(fwd, dim3(grid), dim3(NTHR), LDS_BYTES, stream, a); }
#else
    a.ph_lo = 0; a.ph_hi = N_PHASES; a.use_bar = 1; a.pad = 0;
    hipLaunchKernelGGL(fwd, dim3(grid), dim3(NTHR), LDS_BYTES, stream, a);
#endif
}
```

```cpp
#include <hip/hip_runtime.h>
#include <cstdio>
#include <cstdint>

namespace pg8 {
#define PG8_LAS __attribute__((address_space(3)))
typedef unsigned short bf16_t;
typedef short bf16x8 __attribute__((ext_vector_type(8)));
typedef float f32x4 __attribute__((ext_vector_type(4)));
typedef unsigned u32x4 __attribute__((ext_vector_type(4)));
typedef unsigned u32x2 __attribute__((ext_vector_type(2)));
typedef int v8i_t __attribute__((ext_vector_type(8)));
typedef int v4i_t __attribute__((ext_vector_type(4)));
constexpr int BM = 256, BK = 64, HALF = 128, HTB = HALF * BK * 2  , STAGE_BYTES = 8 * HTB, NXCD = 8, WGM = 8;

__host__ __device__ __forceinline__ int lds_byte(int r, int c) { const int st = (r >> 4) * 2 + (c >> 5), rr = r & 15, cc = c & 31, ob = rr * 64 + cc * 2; return st * 1024 + (ob ^ (((ob >> 9) & 1) << 5)); }
__host__ __device__ __forceinline__ void stage_rc(int b, int& R, int& C) { const int st = b / 1024, sb = b % 1024, swz = sb ^ (((sb >> 9) & 1) << 5); R = (st >> 1) * 16 + swz / 64; C = (st & 1) * 32 + (swz % 64) / 2; }
__host__ __device__ __forceinline__ int perm32(int rho) { const int n = rho >> 4, i = rho & 15; return 8 * (i >> 2) + 4 * n + (i & 3); }

struct Unit { int pm, pn; };
struct Gemm { const bf16_t* A; const bf16_t* Bt; int M, N, K; };

struct Order {
    int nM, nN, nwg, G, c; const int* pexp; size_t bstride;
    __device__ void init(int nM_, int N, int G_, int c_, const int* pexp_, size_t bstride_) { nM = nM_; nN = N / BM; nwg = nM * nN; G = G_; c = c_; pexp = pexp_; bstride = bstride_; }
    __device__ bool next(int i, Unit& u) const {
        const long L = (long)i * G + c; if (L >= nwg) return false;
        int wgid = (int)L; { const int q = nwg / NXCD, r = nwg % NXCD, xcd = wgid % NXCD, off = wgid / NXCD; wgid = (xcd < r ? xcd * (q + 1) : r * (q + 1) + (xcd - r) * q) + off; }
        const int nig = WGM * nN, gid = wgid / nig, fm = gid * WGM, gsz = (nM - fm) < WGM ? (nM - fm) : WGM;
        u.pm = fm + ((wgid % nig) % gsz); u.pn = (wgid % nig) / gsz; return true;
    }
    __device__ __forceinline__ size_t boff(const Unit& u) const { return pexp ? (size_t)__builtin_amdgcn_readfirstlane(pexp[u.pm]) * bstride : (size_t)0; }
    __device__ __forceinline__ void a_ready(const Unit&) const {}
    __device__ __forceinline__ void done(const Unit&) const {}
};

__device__ __forceinline__ unsigned cvt_pk_bf16(float lo, float hi) { unsigned r; asm volatile("v_cvt_pk_bf16_f32 %0, %1, %2" : "=v"(r) : "v"(lo), "v"(hi)); return r; }

struct EpiStore {
    static constexpr bool PERM = true, AFTER_DRAIN = false;
    bf16_t* O; int ldc; int ncol_tiles; int gate_pn; float* gates; float oscale;
    __device__ __forceinline__ void operator()(const f32x4 (&acc)[2][2][4][2], const Unit& u, int wr, int wc, int fr, int fq) const {
        const int row0 = u.pm * BM + wr * 64 + fr;
        if (u.pn < ncol_tiles) {
            const int col0 = u.pn * BM + wc * 32 + 8 * fq;
#pragma unroll
            for (int ai = 0; ai < 2; ++ai)
#pragma unroll
                for (int m = 0; m < 4; ++m) { bf16_t* rowp = O + (size_t)(row0 + ai * HALF + m * 16) * ldc + col0;
#pragma unroll
                    for (int bj = 0; bj < 2; ++bj) { const f32x4 v0 = acc[ai][bj][m][0] * oscale, v1 = acc[ai][bj][m][1] * oscale;
                        u32x4 w; w.x = cvt_pk_bf16(v0[0], v0[1]); w.y = cvt_pk_bf16(v0[2], v0[3]); w.z = cvt_pk_bf16(v1[0], v1[1]); w.w = cvt_pk_bf16(v1[2], v1[3]);
                        *(u32x4*)(rowp + bj * HALF) = w; } }
        } else if (u.pn == gate_pn && wc == 0) {
#pragma unroll
            for (int ai = 0; ai < 2; ++ai)
#pragma unroll
                for (int m = 0; m < 4; ++m) { float* rowp = gates + (size_t)(row0 + ai * HALF + m * 16) * 32 + 8 * fq;
                    *(f32x4*)(rowp) = acc[ai][0][m][0]; *(f32x4*)(rowp + 4) = acc[ai][0][m][1]; }
        }
    }
};
struct EpiSwiGLU {
    static constexpr bool PERM = true, AFTER_DRAIN = false;
    bf16_t* O; int ldc;
    __device__ __forceinline__ void operator()(const f32x4 (&acc)[2][2][4][2], const Unit& u, int wr, int wc, int fr, int fq) const {
        const int row0 = u.pm * BM + wr * 64 + fr, col0 = u.pn * HALF + wc * 32 + 8 * fq;
#pragma unroll
        for (int ai = 0; ai < 2; ++ai)
#pragma unroll
            for (int m = 0; m < 4; ++m) { bf16_t* rowp = O + (size_t)(row0 + ai * HALF + m * 16) * ldc + col0; float r[8];
#pragma unroll
                for (int n = 0; n < 2; ++n)
#pragma unroll
                    for (int j = 0; j < 4; ++j) { const float g = acc[ai][0][m][n][j], up = acc[ai][1][m][n][j]; r[n * 4 + j] = g * __builtin_amdgcn_rcpf(1.0f + __expf(-g)) * up; }
                u32x4 w; w.x = cvt_pk_bf16(r[0], r[1]); w.y = cvt_pk_bf16(r[2], r[3]); w.z = cvt_pk_bf16(r[4], r[5]); w.w = cvt_pk_bf16(r[6], r[7]);
                *(u32x4*)(rowp) = w; }
    }
};
struct EpiSwiGLU8 {
    static constexpr bool PERM = true, AFTER_DRAIN = false;
    unsigned char* O; int ldc; float ascale;
    __device__ __forceinline__ void operator()(const f32x4 (&acc)[2][2][4][2], const Unit& u, int wr, int wc, int fr, int fq) const {
        typedef float f32x2 __attribute__((ext_vector_type(2)));
        const int row0 = u.pm * BM + wr * 64 + fr, col0 = u.pn * HALF + wc * 32 + 8 * fq;
        const float c1 = -ascale * 1.4426950408889634f, c2 = ascale * ascale;
#pragma unroll
        for (int ai = 0; ai < 2; ++ai)
#pragma unroll
            for (int m = 0; m < 4; ++m) { unsigned char* rowp = O + (size_t)(row0 + ai * HALF + m * 16) * ldc + col0; f32x2 r[4];
#pragma unroll
                for (int n = 0; n < 2; ++n)
#pragma unroll
                    for (int j = 0; j < 2; ++j) { const f32x2 ag = {acc[ai][0][m][n][2 * j], acc[ai][0][m][n][2 * j + 1]}, au = {acc[ai][1][m][n][2 * j], acc[ai][1][m][n][2 * j + 1]};
                        const f32x2 t = ag * c1; f32x2 d = {__builtin_amdgcn_exp2f(t.x), __builtin_amdgcn_exp2f(t.y)}; d = d + 1.0f;
                        const f32x2 q = {__builtin_amdgcn_rcpf(d.x), __builtin_amdgcn_rcpf(d.y)};
                        r[n * 2 + j] = ((ag * au) * q) * c2; }
                u32x2 w; unsigned t = 0; t = __builtin_amdgcn_cvt_pk_fp8_f32(r[0].x, r[0].y, t, false); t = __builtin_amdgcn_cvt_pk_fp8_f32(r[1].x, r[1].y, t, true); w.x = t;
                t = 0; t = __builtin_amdgcn_cvt_pk_fp8_f32(r[2].x, r[2].y, t, false); t = __builtin_amdgcn_cvt_pk_fp8_f32(r[3].x, r[3].y, t, true); w.y = t;
                *(u32x2*)(rowp) = w; }
    }
};
struct EpiStoreI8 {
    static constexpr bool PERM = true, AFTER_DRAIN = false;
    bf16_t* O; int ldc; int ncol_tiles; int gate_pn; float* gates; const float* sa; const float* sw;
    __device__ __forceinline__ void operator()(const f32x4 (&acc)[2][2][4][2], const Unit& u, int wr, int wc, int fr, int fq) const {
        const int row0 = u.pm * BM + wr * 64 + fr;
        if (u.pn < ncol_tiles) {
            const int col0 = u.pn * BM + wc * 32 + 8 * fq;
            f32x4 cs[2][2];
#pragma unroll
            for (int bj = 0; bj < 2; ++bj) { cs[bj][0] = *(const f32x4*)(sw + col0 + bj * HALF); cs[bj][1] = *(const f32x4*)(sw + col0 + bj * HALF + 4); }
#pragma unroll
            for (int ai = 0; ai < 2; ++ai)
#pragma unroll
                for (int m = 0; m < 4; ++m) { const int row = row0 + ai * HALF + m * 16; const float rs = sa[row]; bf16_t* rowp = O + (size_t)row * ldc + col0;
#pragma unroll
                    for (int bj = 0; bj < 2; ++bj) { const v4i_t i0 = __builtin_bit_cast(v4i_t, acc[ai][bj][m][0]), i1 = __builtin_bit_cast(v4i_t, acc[ai][bj][m][1]);
                        const f32x4 v0 = __builtin_convertvector(i0, f32x4) * cs[bj][0] * rs, v1 = __builtin_convertvector(i1, f32x4) * cs[bj][1] * rs;
                        u32x4 w; w.x = cvt_pk_bf16(v0[0], v0[1]); w.y = cvt_pk_bf16(v0[2], v0[3]); w.z = cvt_pk_bf16(v1[0], v1[1]); w.w = cvt_pk_bf16(v1[2], v1[3]);
                        *(u32x4*)(rowp + bj * HALF) = w; } }
        } else if (u.pn == gate_pn && wc == 0) {
            const int col0 = u.pn * BM + 8 * fq; const f32x4 c0 = *(const f32x4*)(sw + col0), c1 = *(const f32x4*)(sw + col0 + 4);
#pragma unroll
            for (int ai = 0; ai < 2; ++ai)
#pragma unroll
                for (int m = 0; m < 4; ++m) { const int row = row0 + ai * HALF + m * 16; const float rs = sa[row]; float* rowp = gates + (size_t)row * 32 + 8 * fq;
                    *(f32x4*)(rowp) = __builtin_convertvector(__builtin_bit_cast(v4i_t, acc[ai][0][m][0]), f32x4) * c0 * rs; *(f32x4*)(rowp + 4) = __builtin_convertvector(__builtin_bit_cast(v4i_t, acc[ai][0][m][1]), f32x4) * c1 * rs; }
        }
    }
};
struct EpiSwiGLU8I {
    static constexpr bool PERM = true, AFTER_DRAIN = false;
    unsigned char* O; int ldc; const float* sa; const float* sw; const int* pexp; int swstride; int obf16;
    __device__ __forceinline__ void operator()(const f32x4 (&acc)[2][2][4][2], const Unit& u, int wr, int wc, int fr, int fq) const {
        typedef float f32x2 __attribute__((ext_vector_type(2)));
        const int row0 = u.pm * BM + wr * 64 + fr, col0 = u.pn * HALF + wc * 32 + 8 * fq;
        const float* swe = sw + (pexp ? (size_t)__builtin_amdgcn_readfirstlane(pexp[u.pm]) * swstride : (size_t)0) + u.pn * BM + wc * 32 + 8 * fq;
        const f32x4 g0 = *(const f32x4*)(swe), g1 = *(const f32x4*)(swe + 4), u0 = *(const f32x4*)(swe + HALF), u1 = *(const f32x4*)(swe + HALF + 4);
        const float gs[8] = {g0[0], g0[1], g0[2], g0[3], g1[0], g1[1], g1[2], g1[3]}, us[8] = {u0[0], u0[1], u0[2], u0[3], u1[0], u1[1], u1[2], u1[3]};
#pragma unroll
        for (int ai = 0; ai < 2; ++ai)
#pragma unroll
            for (int m = 0; m < 4; ++m) { const int row = row0 + ai * HALF + m * 16; const float rs = sa[row]; unsigned char* rowp = O + (size_t)row * ldc + col0; float r[8];
#pragma unroll
                for (int n = 0; n < 2; ++n) { const v4i_t ig = __builtin_bit_cast(v4i_t, acc[ai][0][m][n]), iu = __builtin_bit_cast(v4i_t, acc[ai][1][m][n]);
#pragma unroll
                    for (int j = 0; j < 4; ++j) { const float g = (float)ig[j] * (gs[4 * n + j] * rs), up = (float)iu[j] * (us[4 * n + j] * rs);
                        r[4 * n + j] = g * __builtin_amdgcn_rcpf(1.0f + __builtin_amdgcn_exp2f(g * -1.4426950408889634f)) * up; } }
                if (obf16) { u32x4 w; w.x = cvt_pk_bf16(r[0], r[1]); w.y = cvt_pk_bf16(r[2], r[3]); w.z = cvt_pk_bf16(r[4], r[5]); w.w = cvt_pk_bf16(r[6], r[7]);
                    *(u32x4*)((bf16_t*)O + (size_t)row * ldc + col0) = w; }
                else { u32x2 w; unsigned t = 0; t = __builtin_amdgcn_cvt_pk_fp8_f32(r[0], r[1], t, false); t = __builtin_amdgcn_cvt_pk_fp8_f32(r[2], r[3], t, true); w.x = t;
                    t = 0; t = __builtin_amdgcn_cvt_pk_fp8_f32(r[4], r[5], t, false); t = __builtin_amdgcn_cvt_pk_fp8_f32(r[6], r[7], t, true); w.y = t;
                    *(u32x2*)(rowp) = w; } }
    }
};

template <bool FP8> struct Frag;
template <> struct Frag<false> { bf16x8 v[2]; };
template <> struct Frag<true> { v8i_t v; };
template <bool FP8> __device__ __forceinline__ void ldfrag(Frag<FP8>& f, const PG8_LAS unsigned char* p) {
    if constexpr (FP8) { const bf16x8 a = *(const PG8_LAS bf16x8*)p, b = *(const PG8_LAS bf16x8*)(p + 1024); f.v = __builtin_bit_cast(v8i_t, __builtin_shufflevector(a, b, 0, 1, 2, 3, 4, 5, 6, 7, 8, 9, 10, 11, 12, 13, 14, 15)); }
    else { f.v[0] = *(const PG8_LAS bf16x8*)p; f.v[1] = *(const PG8_LAS bf16x8*)(p + 1024); }
}
template <class Epi, class Sched, bool ALIGN_EPI = false, bool SP2 = false, int MODE = 0  >
__device__ __forceinline__ void gemm_phase(PG8_LAS unsigned char* lds, const Gemm g, const Sched& S, const Epi& E) {
    int tid = threadIdx.x; asm volatile("" : "+v"(tid)); const int wid = __builtin_amdgcn_readfirstlane(tid >> 6), lane = tid & 63, wr = wid >> 2, wc = wid & 3, fr = lane & 15, fq = lane >> 4;
    constexpr bool FP8 = (MODE == 1);
    const int K = g.K, rowb = (MODE != 0) ? K : 2 * K, nt = rowb / 128;
    unsigned voffA[2], voffB[2];
#pragma unroll
    for (int i = 0; i < 2; ++i) { int R, C; stage_rc(tid * 16 + i * 8192, R, C); const int Rb = Epi::PERM ? ((R & ~31) + perm32(R & 31)) : R;
        voffA[i] = (unsigned)(R * rowb + C * 2); voffB[i] = (unsigned)(Rb * rowb + C * 2); }
    const size_t kstep = (size_t)(BK * 2);
    const size_t hstep = (size_t)HALF * rowb;
    const size_t tstep = 2 * hstep;
    const unsigned ldsw = (unsigned)wid * 1024u;
    const int aoff = lds_byte(wr * 64 + fr, fq * 8), boff = lds_byte(wc * 32 + fr, fq * 8);
#define PG8_SA(b, h) (((b) * 2 + (h)) * HTB)
#define PG8_SB(b, h) ((4 + (b) * 2 + (h)) * HTB)
#define PG8_STAGE(bufoff, gbase, voff) do { _Pragma("unroll") for (int _i = 0; _i < 2; ++_i) \
        __builtin_amdgcn_global_load_lds((const unsigned*)((const char*)(gbase) + (voff)[_i]), (PG8_LAS unsigned*)(lds + (bufoff) + ldsw + _i * 8192), 16, 0, 0); } while (0)
#define PG8_LDA(dst, b, h) do { _Pragma("unroll") for (int m = 0; m < 4; ++m) ldfrag<FP8>(dst[m], lds + PG8_SA(b, h) + aoff + m * 2048); } while (0)
#define PG8_LDB(dst, b, h) do { _Pragma("unroll") for (int n = 0; n < 2; ++n) ldfrag<FP8>(dst[n], lds + PG8_SB(b, h) + boff + n * 2048); } while (0)
#define PG8_MMA(ai, bj, At, Bt) do { __builtin_amdgcn_s_setprio(1); _Pragma("unroll") for (int m = 0; m < 4; ++m) _Pragma("unroll") for (int n = 0; n < 2; ++n) { \
        if constexpr (FP8) { asm volatile("v_mfma_f32_16x16x128_f8f6f4 %0, %1, %2, %0" : "+v"(acc[ai][bj][m][n]) : "v"(Bt[n].v), "v"(At[m].v)); }     \
        else if constexpr (MODE == 2) { _Pragma("unroll") for (int k = 0; k < 2; ++k) acc[ai][bj][m][n] = __builtin_bit_cast(f32x4, __builtin_amdgcn_mfma_i32_16x16x64_i8(__builtin_bit_cast(v4i_t, Bt[n].v[k]), __builtin_bit_cast(v4i_t, At[m].v[k]), __builtin_bit_cast(v4i_t, acc[ai][bj][m][n]), 0, 0, 0)); } \
        else { _Pragma("unroll") for (int k = 0; k < 2; ++k) acc[ai][bj][m][n] = __builtin_amdgcn_mfma_f32_16x16x32_bf16(Bt[n].v[k], At[m].v[k], acc[ai][bj][m][n], 0, 0, 0); } } __builtin_amdgcn_s_setprio(0); } while (0)
#define PG8_WAIT_V(n) asm volatile("s_waitcnt vmcnt(" #n ")" ::: "memory")
#define PG8_WAIT_L(n) asm volatile("s_waitcnt lgkmcnt(" #n ")" ::: "memory")
#define PG8_BAR __builtin_amdgcn_s_barrier()
#define PG8_SCHED __builtin_amdgcn_sched_barrier(0)
    Unit cur, nxt; int ui = 0;
    if (!S.next(0, cur)) return;
    f32x4 acc[2][2][4][2];
#pragma unroll
    for (int a = 0; a < 2; ++a)
#pragma unroll
        for (int b = 0; b < 2; ++b)
#pragma unroll
            for (int m = 0; m < 4; ++m)
#pragma unroll
                for (int n = 0; n < 2; ++n) acc[a][b][m][n] = (f32x4){0.f, 0.f, 0.f, 0.f};
    Frag<FP8> At[4], B0[2], B1[2];
    const char* cA = (const char*)g.A + (size_t)cur.pm * tstep; const char* cB = (const char*)g.Bt + S.boff(cur) + (size_t)cur.pn * tstep;
    S.a_ready(cur);
    if constexpr (SP2) {
        PG8_STAGE(PG8_SB(0, 0), cB, voffB); PG8_STAGE(PG8_SB(0, 1), cB + hstep, voffB); PG8_STAGE(PG8_SA(0, 0), cA, voffA); PG8_STAGE(PG8_SA(0, 1), cA + hstep, voffA);
        if (wr == 1) PG8_BAR;
        PG8_WAIT_V(2); PG8_BAR;
        PG8_STAGE(PG8_SB(1, 0), cB + kstep, voffB); PG8_STAGE(PG8_SA(1, 0), cA + kstep, voffA); PG8_STAGE(PG8_SB(1, 1), cB + hstep + kstep, voffB);
        PG8_WAIT_V(6); PG8_BAR;
    } else {
        PG8_STAGE(PG8_SB(0, 0), cB, voffB); PG8_STAGE(PG8_SA(0, 0), cA, voffA); PG8_STAGE(PG8_SB(0, 1), cB + hstep, voffB); PG8_STAGE(PG8_SA(0, 1), cA + hstep, voffA);
        if (wr == 1) PG8_BAR;
        PG8_WAIT_V(4); PG8_BAR;
        PG8_STAGE(PG8_SB(1, 0), cB + kstep, voffB); PG8_STAGE(PG8_SA(1, 0), cA + kstep, voffA); PG8_STAGE(PG8_SB(1, 1), cB + hstep + kstep, voffB);
        PG8_WAIT_V(6); PG8_BAR;
    }
    for (;;) {
        const bool has_next = S.next(ui + 1, nxt);
        const char* nA = has_next ? (const char*)g.A + (size_t)nxt.pm * tstep : cA; const char* nB = has_next ? (const char*)g.Bt + S.boff(nxt) + (size_t)nxt.pn * tstep : cB;
#pragma unroll 1
        for (int t = 0; t < nt; t += 2) {
            const bool last = (t == nt - 2);
            const char* a1 = cA + (size_t)(t + 1) * kstep;
            const char* a2 = last ? nA : cA + (size_t)(t + 2) * kstep; const char* b2 = last ? nB : cB + (size_t)(t + 2) * kstep;
            const char* a3 = a2 + kstep; const char* b3 = b2 + kstep;
            if (last && has_next) S.a_ready(nxt);
            if constexpr (SP2) {
            PG8_LDB(B0, 0, 0); PG8_LDB(B1, 0, 1); PG8_SCHED; PG8_LDA(At, 0, 0); PG8_STAGE(PG8_SA(1, 1), a1 + hstep, voffA);
            PG8_WAIT_V(8); PG8_WAIT_L(0); PG8_BAR; PG8_MMA(0, 0, At, B0); PG8_MMA(0, 1, At, B1); PG8_BAR; PG8_SCHED;
            PG8_LDA(At, 0, 1); PG8_STAGE(PG8_SB(0, 0), b2, voffB); PG8_STAGE(PG8_SB(0, 1), b2 + hstep, voffB); PG8_STAGE(PG8_SA(0, 0), a2, voffA);
            PG8_WAIT_V(8); PG8_WAIT_L(0); PG8_BAR; PG8_MMA(1, 0, At, B0); PG8_MMA(1, 1, At, B1); PG8_BAR; PG8_SCHED;
            PG8_LDB(B0, 1, 0); PG8_LDB(B1, 1, 1); PG8_SCHED; PG8_LDA(At, 1, 0); PG8_STAGE(PG8_SA(0, 1), a2 + hstep, voffA);
            PG8_WAIT_V(8); PG8_WAIT_L(0); PG8_BAR; PG8_MMA(0, 0, At, B0); PG8_MMA(0, 1, At, B1); PG8_BAR; PG8_SCHED;
            PG8_LDA(At, 1, 1); PG8_STAGE(PG8_SB(1, 0), b3, voffB); PG8_STAGE(PG8_SB(1, 1), b3 + hstep, voffB); PG8_STAGE(PG8_SA(1, 0), a3, voffA);
            PG8_WAIT_V(8); PG8_WAIT_L(0); PG8_BAR; PG8_MMA(1, 0, At, B0); PG8_MMA(1, 1, At, B1); PG8_BAR; PG8_SCHED;
            } else {
            PG8_LDB(B0, 0, 0); PG8_SCHED; PG8_LDA(At, 0, 0); PG8_STAGE(PG8_SA(1, 1), a1 + hstep, voffA);
            PG8_WAIT_L(8); PG8_BAR; PG8_WAIT_L(0); PG8_MMA(0, 0, At, B0); PG8_BAR; PG8_SCHED;
            PG8_LDB(B1, 0, 1); PG8_STAGE(PG8_SB(0, 0), b2, voffB);
            PG8_BAR; PG8_WAIT_L(0); PG8_MMA(0, 1, At, B1); PG8_BAR;
            PG8_LDA(At, 0, 1); PG8_STAGE(PG8_SA(0, 0), a2, voffA);
            PG8_BAR; PG8_WAIT_L(0); PG8_MMA(1, 0, At, B0); PG8_BAR; PG8_SCHED;
            PG8_STAGE(PG8_SB(0, 1), b2 + hstep, voffB);
            PG8_WAIT_V(6); PG8_BAR; PG8_MMA(1, 1, At, B1); PG8_BAR;
            PG8_LDB(B0, 1, 0); PG8_SCHED; PG8_LDA(At, 1, 0); PG8_STAGE(PG8_SA(0, 1), a2 + hstep, voffA);
            PG8_WAIT_L(8); PG8_BAR; PG8_WAIT_L(0); PG8_MMA(0, 0, At, B0); PG8_BAR; PG8_SCHED;
            PG8_LDB(B1, 1, 1); PG8_STAGE(PG8_SB(1, 0), b3, voffB);
            PG8_BAR; PG8_WAIT_L(0); PG8_MMA(0, 1, At, B1); PG8_BAR;
            PG8_LDA(At, 1, 1); PG8_STAGE(PG8_SA(1, 0), a3, voffA);
            PG8_BAR; PG8_WAIT_L(0); PG8_MMA(1, 0, At, B0); PG8_BAR; PG8_SCHED;
            PG8_STAGE(PG8_SB(1, 1), b3 + hstep, voffB);
            PG8_WAIT_V(6); PG8_BAR; PG8_MMA(1, 1, At, B1); PG8_BAR;
            }
        }
        if constexpr (ALIGN_EPI) { if (wr == 0) PG8_BAR; }
        if constexpr (FP8) { asm volatile("s_nop 15\n\ts_nop 15" ::: "memory"); }
        if constexpr (!Epi::AFTER_DRAIN) { E(acc, cur, wr, wc, fr, fq); S.done(cur); }
        if (!has_next) break;
#pragma unroll
        for (int a = 0; a < 2; ++a)
#pragma unroll
            for (int b = 0; b < 2; ++b)
#pragma unroll
                for (int m = 0; m < 4; ++m)
#pragma unroll
                    for (int n = 0; n < 2; ++n) acc[a][b][m][n] = (f32x4){0.f, 0.f, 0.f, 0.f};
        cur = nxt; cA = nA; cB = nB; ++ui;
        if constexpr (ALIGN_EPI) { if (wr == 1) PG8_BAR; }
    }
    PG8_WAIT_V(0);
    if constexpr (!ALIGN_EPI) { if (wr == 0) PG8_BAR; }
    PG8_BAR;
    if constexpr (Epi::AFTER_DRAIN) { E.fused(acc, cur, wr, wc, fr, fq, lds, wid, lane); S.done(cur); }
#undef PG8_SA
#undef PG8_SB
#undef PG8_STAGE
#undef PG8_LDA
#undef PG8_LDB
#undef PG8_MMA
#undef PG8_WAIT_V
#undef PG8_WAIT_L
#undef PG8_BAR
#undef PG8_SCHED
}
}

constexpr int D = 1024, NB = 8, SEQ = 8192, CTXL = 256, DEPTH = 4, GRIDW = 64, ROWS_G = SEQ / GRIDW  ;
constexpr int M_LAT = NB * SEQ  , M_CTX = NB * CTXL  , M_ALL = M_LAT + M_CTX  ;
constexpr int NHEAD = 8, M_DK = 64, M_DV = 128, H_DK = 128, H_DV = 128;
constexpr int NP_M = 3072, NIN_M = 3328, NW_M = 3104, NP_H = 5120;
constexpr int FF = 2816, NGU = 2 * FF, NEXP = 8;
constexpr int MOE_ROWS = 137216, MOE_PANELS = MOE_ROWS / 256;
constexpr float EPS = 1e-6f;
constexpr int NWAVES = 8, NTHR = 512;

constexpr size_t MiB = 1u << 20;
constexpr size_t WS_CTL = 0, CTL_ZERO_BYTES = 80 * 1024;
constexpr size_t WS_MODV = 1 * MiB;
constexpr size_t WS_SMALL = 2 * MiB;
constexpr size_t WS_LATC = 3 * MiB;
constexpr size_t WS_WE = 11 * MiB;
constexpr size_t WS_WO = 37 * MiB;
constexpr size_t WS_U = 181 * MiB;
constexpr size_t WS_GATES = 313 * MiB;
constexpr size_t WS_STATE = 322 * MiB;
constexpr size_t WS_ROUTE = 362 * MiB;
constexpr size_t WS_ACT = 364 * MiB;
constexpr size_t WS_Y = WS_ACT + 700 * MiB;
constexpr size_t WS_END = WS_ACT + 1005 * MiB;
constexpr size_t WE_IN = 0, WE_OUT = 7 * MiB, WE_GU = 9 * MiB, WE_DOWN = 20 * MiB;
constexpr size_t WOD_IN = 0, WOD_OUT = 10 * MiB, WOD_GU = 12 * MiB, WOD_DOWN = 100 * MiB;
constexpr size_t EGU_BYTES = (size_t)NGU * D * 2, EDOWN_BYTES = (size_t)D * FF * 2;
static_assert(WOD_GU + 8 * EGU_BYTES <= WOD_DOWN && WOD_DOWN + 8 * EDOWN_BYTES <= 144 * MiB, "odd weights map");
static_assert((size_t)NIN_M * D * 2 <= 7 * MiB && WE_GU + EGU_BYTES <= WE_DOWN && WE_DOWN + EDOWN_BYTES <= 26 * MiB, "even weights map");
static_assert((size_t)M_ALL * NP_H * 2 <= 700 * MiB && (size_t)MOE_ROWS * D * 2 + (size_t)MOE_ROWS * FF * 2 <= 1005 * MiB && 700 * MiB + (size_t)M_ALL * D * 2 <= 1005 * MiB, "act map");
constexpr int CW_BAR = 4096;
constexpr int CW_ECNT = 8192;
constexpr int CW_DBG = 16384;
constexpr size_t RT_E = 0;
constexpr size_t RT_R = 512 * 1024;
constexpr size_t RT_W = 512 * 1024 + 1024 * 1024;
constexpr size_t SM_LB = 0;
constexpr size_t SM_PEXP = 64 * 1024;
constexpr size_t SM_EBASE = 96 * 1024;
constexpr size_t SM_SAU = 128 * 1024;
constexpr size_t SM_SAU2 = 400 * 1024;
constexpr size_t SM_SWE = 672 * 1024;
constexpr size_t SM_SWO = 712 * 1024;
constexpr int SWE_IN = 0, SWE_GU = 3328, SWO_IN = 0, SWO_GU = 5120;
static_assert(SM_SAU + (size_t)M_ALL * 4 <= SM_SAU2 && SM_SAU2 + (size_t)M_ALL * 4 <= SM_SWE && SM_SWE + (3328 + 5632) * 4 <= SM_SWO && SM_SWO + (5120 + 8 * 5632) * 4 <= 1024 * 1024, "small region map");
constexpr size_t GATES_SAMOE = (size_t)M_ALL * 32 * 4;
static_assert(GATES_SAMOE + (size_t)MOE_ROWS * 4 <= 9 * MiB, "gates region map");

constexpr int LDS_MAIN = 147456;
constexpr int LDSCTL_OFF = LDS_MAIN;
constexpr int LDS_BYTES = LDS_MAIN + 512;

#define GAS __attribute__((address_space(1)))
#define LAS __attribute__((address_space(3)))
typedef unsigned short bf16;
typedef unsigned v4u __attribute__((ext_vector_type(4)));
typedef unsigned v2u __attribute__((ext_vector_type(2)));
typedef float f32x4 __attribute__((ext_vector_type(4)));
typedef float f32x16 __attribute__((ext_vector_type(16)));
typedef short bf16x8 __attribute__((ext_vector_type(8)));
typedef short s16x4 __attribute__((ext_vector_type(4)));
typedef GAS unsigned gu32;
#define RLX_AGENT __ATOMIC_RELAXED, __HIP_MEMORY_SCOPE_AGENT
#define LDS_WAIT() asm volatile("s_waitcnt lgkmcnt(0)" ::: "memory")
#define VM_WAIT() asm volatile("s_waitcnt vmcnt(0)" ::: "memory")
#define CFENCE() asm volatile("" ::: "memory")
__device__ __forceinline__ unsigned f2bf(float f) { unsigned u = __builtin_bit_cast(unsigned, f); return (u + 0x7fffu + ((u >> 16) & 1u)) >> 16; }
typedef __bf16 bf16x2_t __attribute__((ext_vector_type(2)));
typedef float f32x2_t __attribute__((ext_vector_type(2)));
__device__ __forceinline__ unsigned pk2(float lo, float hi) { f32x2_t v = {lo, hi}; bf16x2_t b = __builtin_convertvector(v, bf16x2_t); return __builtin_bit_cast(unsigned, b); }
__device__ __forceinline__ float bf2f(unsigned short b) { return __builtin_bit_cast(float, (unsigned)b << 16); }
__device__ __forceinline__ float bflo(unsigned w) { return __builtin_bit_cast(float, w << 16); }
__device__ __forceinline__ float bfhi(unsigned w) { return __builtin_bit_cast(float, w & 0xffff0000u); }
__device__ __forceinline__ float sigmoidf_(float x) { return __builtin_amdgcn_rcpf(1.0f + __expf(-x)); }
__device__ __forceinline__ float siluf_(float x) { return x * sigmoidf_(x); }
template <int CTRL, int RM> __device__ __forceinline__ float dppmov(float x) { return __builtin_bit_cast(float, __builtin_amdgcn_update_dpp(0, __builtin_bit_cast(int, x), CTRL, RM, 0xf, false)); }
__device__ __forceinline__ float wave_sum(float v) {
    v += dppmov<0xB1, 0xf>(v); v += dppmov<0x4E, 0xf>(v); v += dppmov<0x141, 0xf>(v); v += dppmov<0x140, 0xf>(v);
    v += dppmov<0x142, 0xa>(v); v += dppmov<0x143, 0xc>(v);
    return __builtin_bit_cast(float, __builtin_amdgcn_readlane(__builtin_bit_cast(int, v), 63));
}

__device__ __forceinline__ float wave_max(float v) {
    v = fmaxf(v, dppmov<0xB1, 0xf>(v)); v = fmaxf(v, dppmov<0x4E, 0xf>(v)); v = fmaxf(v, dppmov<0x141, 0xf>(v)); v = fmaxf(v, dppmov<0x140, 0xf>(v));
    v = fmaxf(v, dppmov<0x142, 0xa>(v)); v = fmaxf(v, dppmov<0x143, 0xc>(v));
    return __builtin_bit_cast(float, __builtin_amdgcn_readlane(__builtin_bit_cast(int, v), 63));
}

#define XB_TMO      128
#define XB_XCNT(j)  (256  + 64 * (j))
#define XB_XSUB(j)  (1280 + 64 * (j))
#define XB_XGEN(j)  (2304 + 64 * (j))
#define XB_TOP      3328
#define XB_TOPGEN   3392
#define XCD_BAR_WORDS 3456
#define XB_SPIN_CAP (1u << 18)
__device__ __forceinline__ unsigned xb_ld(unsigned* p)              { return __hip_atomic_load(p, __ATOMIC_RELAXED, __HIP_MEMORY_SCOPE_AGENT); }
__device__ __forceinline__ unsigned xb_add(unsigned* p, unsigned v) { return __hip_atomic_fetch_add(p, v, __ATOMIC_RELAXED, __HIP_MEMORY_SCOPE_AGENT); }
__device__ __forceinline__ unsigned xb_xcc_id() { return (unsigned)__builtin_amdgcn_s_getreg((3 << 11) | 20) & 0xFu; }
#define XB_SPIN(cond, bar) do { unsigned _sp = 0; while (cond) { __builtin_amdgcn_s_sleep(1); \
    if ((++_sp & 255u) == 0u) { if (xb_ld(&(bar)[XB_TMO])) break; if (_sp > XB_SPIN_CAP) { atomicAdd(&(bar)[XB_TMO], 1u); break; } } } } while (0)
struct XcdBarrier { unsigned* bar; unsigned x; volatile LAS unsigned* st; };
__device__ __forceinline__ XcdBarrier xcd_barrier_post(unsigned* bar, volatile LAS unsigned* st) {
    XcdBarrier b; b.bar = bar; b.x = xb_xcc_id(); b.st = st;
    if (threadIdx.x == 0) (void)xb_add(&bar[XB_XCNT(b.x)], 1u);
    return b;
}
__device__ __forceinline__ void xcd_barrier_complete(unsigned* bar, unsigned x, unsigned& nloc, unsigned& nx) {
    const unsigned G = gridDim.x * gridDim.y * gridDim.z;
    unsigned sum, cnt, mine, sp = 0u;
    for (;;) {
        sum = 0u; cnt = 0u; mine = 0u;
#pragma unroll
        for (unsigned j = 0; j < 16; ++j) { const unsigned c = xb_ld(&bar[XB_XCNT(j)]); sum += c; cnt += (c > 0u) ? 1u : 0u; mine = (j == x) ? c : mine; }
        if (sum == G) break;
        __builtin_amdgcn_s_sleep(1);
        if ((++sp & 255u) == 0u) { if (xb_ld(&bar[XB_TMO])) break; if (sp > XB_SPIN_CAP) { atomicAdd(&bar[XB_TMO], 1u); break; } }
    }
    nloc = mine > 0u ? mine : 1u; nx = cnt > 0u ? cnt : 1u;
}
__device__ __attribute__((noinline)) void xcd_barrier(unsigned* bar_, unsigned bx_, volatile LAS unsigned* st_) { XcdBarrier b; b.bar = bar_; b.x = bx_; b.st = st_;
    asm volatile("s_waitcnt vmcnt(0)" ::: "memory");
    __syncthreads();
    if (threadIdx.x == 0) {
        unsigned* bar = b.bar;
        __builtin_amdgcn_s_waitcnt(0);
        unsigned nloc = b.st[0], nx = b.st[1];
        if (nloc == 0u) { xcd_barrier_complete(bar, b.x, nloc, nx); b.st[0] = nloc; b.st[1] = nx; }
        const unsigned old = xb_add(&bar[XB_XSUB(b.x)], 1u);
        const unsigned gen = old / nloc;
        if (old + 1u == (gen + 1u) * nloc) {
            __builtin_amdgcn_fence(__ATOMIC_RELEASE, "agent");
            asm volatile("s_waitcnt vmcnt(0)" ::: "memory");
            const unsigned og = xb_add(&bar[XB_TOP], 1u);
            const unsigned tg = og / nx;
            if (og + 1u == (tg + 1u) * nx) xb_add(&bar[XB_TOPGEN], 1u);
            else XB_SPIN(xb_ld(&bar[XB_TOPGEN]) == tg, bar);
            __builtin_amdgcn_fence(__ATOMIC_ACQUIRE, "agent");
            xb_add(&bar[XB_XGEN(b.x)], 1u);
            asm volatile("s_waitcnt vmcnt(0)" ::: "memory");
        } else {
            XB_SPIN(xb_ld(&bar[XB_XGEN(b.x)]) == gen, bar);
            __builtin_amdgcn_fence(__ATOMIC_ACQUIRE, "agent");
            asm volatile("s_waitcnt vmcnt(0)" ::: "memory");
        }
    }
    __syncthreads();
}

struct Args {
    const float* in[23];
    float* out; unsigned char* ws;
    int ph_lo, ph_hi;
    int use_bar, pad;
};
struct Frame {
    LAS unsigned char* lds;
    int tid, lane, wave, G, bid;
    unsigned char* ws;
    const float* const __attribute__((address_space(4)))* in;
    float* out;
};
enum { I_X = 0, I_C, I_CTX, I_CCTX, I_MODW, I_MODB, I_NORMG, I_MWIN, I_MBGATE, I_MWCONV, I_MGHEAD, I_MWOUT, I_HWIN, I_HBF, I_HLB, I_HGHEAD, I_HWOUT, I_FWGU, I_FWDOWN, I_EWR, I_EBR, I_EWGU, I_EWDOWN };

#ifndef FP8_LAYERS
#define FP8_LAYERS 0xE
#endif
#define FFN_FP8_L(L) (((FP8_LAYERS) >> (L)) & 1)
#ifndef INPROJ_I8
#define INPROJ_I8 1
#endif
#ifndef UP_I8
#define UP_I8 1
#endif
#ifndef FFN_FP8
#define FFN_FP8 1
#endif
constexpr float WSCALE8 = 64.0f;

__device__ __forceinline__ void phase_mods(Frame& F) {
    LAS float* SV = (LAS float*)(F.lds);
    LAS float* RED = (LAS float*)(F.lds + 9 * 1024 * 4);
    const float* cvec = F.in[I_C]; const float* cctx = F.in[I_CCTX];
    for (int i = F.tid; i < 9 * 1024; i += NTHR) { const int b = i >> 10, k = i & 1023; const float v = b < 8 ? cvec[b * 1024 + k] : cctx[k]; SV[i] = siluf_(v); }
    __syncthreads();
    const float* modw = F.in[I_MODW]; const float* modb = F.in[I_MODB]; const float* normg = F.in[I_NORMG];
    float* modv = (float*)(F.ws + WS_MODV);
    for (int item = F.bid; item < 4 * 96; item += F.G) {
        const int L = item / 96, n0 = (item % 96) * 64;
        const float* wp = modw + (size_t)L * 1024 * 6144 + n0 + F.lane;
        float acc[9];
#pragma unroll
        for (int b = 0; b < 9; ++b) acc[b] = 0.f;
        const int k0 = F.wave * 128;
#pragma unroll 4
        for (int k = 0; k < 128; ++k) { const float wv = wp[(size_t)(k0 + k) * 6144];
#pragma unroll
            for (int b = 0; b < 9; ++b) acc[b] += SV[b * 1024 + k0 + k] * wv; }
#pragma unroll
        for (int b = 0; b < 9; ++b) RED[(F.wave * 9 + b) * 64 + F.lane] = acc[b];
        __syncthreads();
        for (int o = F.tid; o < 9 * 64; o += NTHR) { const int b = o >> 6, l = o & 63; float v = 0.f;
#pragma unroll
            for (int w = 0; w < 8; ++w) v += RED[(w * 9 + b) * 64 + l];
            const int n = n0 + l, s = n >> 10, c = n & 1023; v += modb[L * 6144 + n];
            const float* g = normg + (size_t)L * 4 * 1024;
            int slot; float r;
            if (s == 0) { slot = 1; r = v; } else if (s == 1) { slot = 0; r = g[c] * (1.f + v); } else if (s == 2) { slot = 2; r = v * g[1024 + c]; }
            else if (s == 3) { slot = 4; r = v; } else if (s == 4) { slot = 3; r = g[2048 + c] * (1.f + v); } else { slot = 5; r = v * g[3072 + c]; }
            modv[((size_t)(L * 9 + b) * 6 + slot) * 1024 + c] = r; }
        __syncthreads();
    }
}

__device__ __forceinline__ void wconv_item(const float* W, int K, int N, bf16* WT, int gu_mode, LAS float* scr, int item, int lane) {
    const int nblk = N / 32, kb = item / nblk, nb = item % nblk, k0 = 64 * kb, n0 = 32 * nb;
    int row0 = n0;
    if (gu_mode) { const int half = n0 / FF, nn = n0 - half * FF; row0 = 256 * (nn >> 7) + 128 * half + (nn & 127); }
#pragma unroll 8
    for (int i = 0; i < 32; ++i) { const int kk = 2 * i + (lane >> 5); scr[kk * 33 + (lane & 31)] = W[(size_t)(k0 + kk) * N + n0 + (lane & 31)]; }
    LDS_WAIT(); CFENCE();
    const int c = lane & 7;
#pragma unroll
    for (int j = 0; j < 4; ++j) { const int n = (lane >> 3) + 8 * j; const LAS float* s = scr + (8 * c) * 33 + n;
        v4u o; o.x = pk2(s[0 * 33], s[1 * 33]); o.y = pk2(s[2 * 33], s[3 * 33]); o.z = pk2(s[4 * 33], s[5 * 33]); o.w = pk2(s[6 * 33], s[7 * 33]);
        *(GAS v4u*)(WT + (size_t)(row0 + n) * K + k0 + 8 * c) = o; }
    LDS_WAIT(); CFENCE();
}
__device__ __forceinline__ void wconv_item8(const float* W, int K, int N, unsigned char* WT, int gu_mode, float wscale, LAS float* scr, int item, int lane) {
    const int nblk = N / 32, kb = item / nblk, nb = item % nblk, k0 = 64 * kb, n0 = 32 * nb;
    int row0 = n0;
    if (gu_mode) { const int half = n0 / FF, nn = n0 - half * FF; row0 = 256 * (nn >> 7) + 128 * half + (nn & 127); }
#pragma unroll 8
    for (int i = 0; i < 32; ++i) { const int kk = 2 * i + (lane >> 5); scr[kk * 33 + (lane & 31)] = W[(size_t)(k0 + kk) * N + n0 + (lane & 31)]; }
    LDS_WAIT(); CFENCE();
    const int c = lane & 7;
#pragma unroll
    for (int j = 0; j < 4; ++j) { const int n = (lane >> 3) + 8 * j; const LAS float* s = scr + (8 * c) * 33 + n;
        v2u o; unsigned w = 0; w = __builtin_amdgcn_cvt_pk_fp8_f32(s[0 * 33] * wscale, s[1 * 33] * wscale, w, false); w = __builtin_amdgcn_cvt_pk_fp8_f32(s[2 * 33] * wscale, s[3 * 33] * wscale, w, true); o.x = w;
        w = 0; w = __builtin_amdgcn_cvt_pk_fp8_f32(s[4 * 33] * wscale, s[5 * 33] * wscale, w, false); w = __builtin_amdgcn_cvt_pk_fp8_f32(s[6 * 33] * wscale, s[7 * 33] * wscale, w, true); o.y = w;
        *(GAS v2u*)(WT + (size_t)(row0 + n) * K + k0 + 8 * c) = o; }
    LDS_WAIT(); CFENCE();
}
__device__ __forceinline__ void wconv_cols_i8(const float* W, int K, int N, unsigned char* WT, float* sw, int gu_mode, LAS float* scr, int item, int lane) {
    const int n0 = 32 * item; int row0 = n0;
    if (gu_mode) { const int half = n0 / FF, nn = n0 - half * FF; row0 = 256 * (nn >> 7) + 128 * half + (nn & 127); }
    const float* wp = W + n0 + (lane & 31) + (size_t)(lane >> 5) * N;
    float mx = 0.f;
    for (int k = 0; k < K; k += 32) { float v[16];
#pragma unroll
        for (int i = 0; i < 16; ++i) v[i] = wp[(size_t)(2 * i) * N];
        wp += (size_t)32 * N;
#pragma unroll
        for (int i = 0; i < 16; ++i) mx = fmaxf(mx, fabsf(v[i])); }
    mx = fmaxf(mx, __shfl_xor(mx, 32));
    const float scale = mx > 0.f ? mx * (1.0f / 127.0f) : 1.0f, inv = mx > 0.f ? 127.0f / mx : 0.f;
    if (lane < 32) sw[row0 + lane] = scale;
    LAS float* invs = scr + 64 * 33;
    if (lane < 32) invs[lane] = inv;
    LDS_WAIT(); CFENCE();
    const int c = lane & 7;
    for (int k0 = 0; k0 < K; k0 += 64) {
#pragma unroll 16
        for (int i = 0; i < 32; ++i) { const int kk = 2 * i + (lane >> 5); scr[kk * 33 + (lane & 31)] = W[(size_t)(k0 + kk) * N + n0 + (lane & 31)]; }
        LDS_WAIT(); CFENCE();
#pragma unroll
        for (int j = 0; j < 4; ++j) { const int n = (lane >> 3) + 8 * j; const LAS float* s = scr + (8 * c) * 33 + n; const float iv = invs[n]; unsigned q[8];
#pragma unroll
            for (int e = 0; e < 8; ++e) q[e] = (unsigned)(int)__builtin_rintf(s[e * 33] * iv) & 0xffu;
            v2u o; o.x = q[0] | (q[1] << 8) | (q[2] << 16) | (q[3] << 24); o.y = q[4] | (q[5] << 8) | (q[6] << 16) | (q[7] << 24);
            *(GAS v2u*)(WT + (size_t)(row0 + n) * K + k0 + 8 * c) = o; }
        LDS_WAIT(); CFENCE();
    }
}
__device__ __forceinline__ void phase_wconv(Frame& F, int L) {
    LAS float* scr = (LAS float*)(F.lds + F.wave * 16384);
    const int gw = F.bid * NWAVES + F.wave, NGW = F.G * NWAVES; const int j = L >> 1;
    if ((L & 1) == 0) {
        unsigned char* wb = F.ws + WS_WE; float* swb = (float*)(F.ws + WS_SMALL + SM_SWE);
        const float* w_in = F.in[I_MWIN] + (size_t)j * D * NW_M; const float* w_out = F.in[I_MWOUT] + (size_t)j * D * D;
        const float* w_gu = F.in[I_FWGU] + (size_t)j * D * NGU; const float* w_dn = F.in[I_FWDOWN] + (size_t)j * FF * D;
        constexpr int I0 = INPROJ_I8 ? (NW_M / 32) : 16 * (NW_M / 32), I1 = 16 * 32, I2 = UP_I8 ? (NGU / 32) : 16 * (NGU / 32), I3 = (FF / 64) * 32;
        for (int it = gw; it < I0 + I1 + I2 + I3; it += NGW) { int r = it;
            if (r < I0) { if (INPROJ_I8) wconv_cols_i8(w_in, D, NW_M, wb + WE_IN, swb + SWE_IN, 0, scr, r, F.lane); else wconv_item(w_in, D, NW_M, (bf16*)(wb + WE_IN), 0, scr, r, F.lane); continue; } r -= I0;
            if (r < I1) { wconv_item(w_out, D, D, (bf16*)(wb + WE_OUT), 0, scr, r, F.lane); continue; } r -= I1;
            if (r < I2) { if (UP_I8) wconv_cols_i8(w_gu, D, NGU, wb + WE_GU, swb + SWE_GU, 1, scr, r, F.lane); else if (FFN_FP8_L(L)) wconv_item8(w_gu, D, NGU, wb + WE_GU, 1, WSCALE8, scr, r, F.lane); else wconv_item(w_gu, D, NGU, (bf16*)(wb + WE_GU), 1, scr, r, F.lane); continue; } r -= I2;
            if (FFN_FP8_L(L)) wconv_item8(w_dn, FF, D, wb + WE_DOWN, 0, WSCALE8, scr, r, F.lane); else wconv_item(w_dn, FF, D, (bf16*)(wb + WE_DOWN), 0, scr, r, F.lane); }
        GAS v4u* z = (GAS v4u*)(wb + WE_IN + (size_t)NW_M * D * (INPROJ_I8 ? 1 : 2)); const int nz = (NIN_M - NW_M) * D * (INPROJ_I8 ? 1 : 2) / 16;
        for (int i = F.bid * NTHR + F.tid; i < nz; i += F.G * NTHR) z[i] = (v4u){0u, 0u, 0u, 0u};
        if (INPROJ_I8 && F.bid == 0 && F.tid < NIN_M - NW_M) swb[SWE_IN + NW_M + F.tid] = 1.0f;
    } else {
        unsigned char* wb = F.ws + WS_WO; float* swb = (float*)(F.ws + WS_SMALL + SM_SWO);
        const float* w_in = F.in[I_HWIN] + (size_t)j * D * NP_H; const float* w_out = F.in[I_HWOUT] + (size_t)j * D * D;
        const float* w_gu = F.in[I_EWGU] + (size_t)j * NEXP * D * NGU; const float* w_dn = F.in[I_EWDOWN] + (size_t)j * NEXP * FF * D;
        constexpr int I0 = INPROJ_I8 ? (NP_H / 32) : 16 * (NP_H / 32), I1 = 16 * 32, I2 = 16 * (NGU / 32), I3 = (FF / 64) * 32;
        for (int it = gw; it < I0 + I1 + NEXP * (I2 + I3); it += NGW) { int r = it;
            if (r < I0) { if (INPROJ_I8) wconv_cols_i8(w_in, D, NP_H, wb + WOD_IN, swb + SWO_IN, 0, scr, r, F.lane); else wconv_item(w_in, D, NP_H, (bf16*)(wb + WOD_IN), 0, scr, r, F.lane); continue; } r -= I0;
            if (r < I1) { wconv_item(w_out, D, D, (bf16*)(wb + WOD_OUT), 0, scr, r, F.lane); continue; } r -= I1;
            const int e = r / (I2 + I3); r -= e * (I2 + I3);
            if (r < I2) { if (FFN_FP8_L(L)) wconv_item8(w_gu + (size_t)e * D * NGU, D, NGU, wb + WOD_GU + e * EGU_BYTES, 1, WSCALE8, scr, r, F.lane); else wconv_item(w_gu + (size_t)e * D * NGU, D, NGU, (bf16*)(wb + WOD_GU + e * EGU_BYTES), 1, scr, r, F.lane); continue; } r -= I2;
            if (FFN_FP8_L(L)) wconv_item8(w_dn + (size_t)e * FF * D, FF, D, wb + WOD_DOWN + e * EDOWN_BYTES, 0, WSCALE8, scr, r, F.lane); else wconv_item(w_dn + (size_t)e * FF * D, FF, D, (bf16*)(wb + WOD_DOWN + e * EDOWN_BYTES), 0, scr, r, F.lane); }
    }
}

struct TokCfg {
    const void* lat_src_l; const void* lat_src_c;
    void* lat_dst_l; void* lat_dst_c;
    int src_f32, dst_f32;
    const bf16* y; int y_perm; int moe_combine;
    const float* vupd;
    const float* vna; const float* vnb;
    bf16* u; int u_perm; int u_fp8;
    float* u_scale;
    int route; int jr;
    int nrows;
};
__device__ __forceinline__ int perm_cm(int t) { return (t & 63) * ROWS_G + (t >> 6); }

struct RowRaw { v4u l0, l1, l2, l3; v2u a0, a1, a2, a3, b0, b1, b2, b3; };
__device__ __forceinline__ RowRaw tok_issue(const TokCfg& T, int row, int p0, int p1, int lane) {
    RowRaw R; const v4u z4 = (v4u){0u, 0u, 0u, 0u}; const v2u z2 = (v2u){0u, 0u};
    R.l0 = z4; R.l1 = z4; R.l2 = z4; R.l3 = z4; R.a0 = z2; R.a1 = z2; R.a2 = z2; R.a3 = z2; R.b0 = z2; R.b1 = z2; R.b2 = z2; R.b3 = z2;
    if (T.src_f32) { const GAS v4u* lp = (const GAS v4u*)(row < M_LAT ? (const float*)T.lat_src_l + (size_t)row * D : (const float*)T.lat_src_c + (size_t)(row - M_LAT) * D) + lane;
        R.l0 = lp[0]; R.l1 = lp[64]; R.l2 = lp[128]; R.l3 = lp[192]; }
    else { const GAS v2u* lp = (const GAS v2u*)(row < M_LAT ? (const bf16*)T.lat_src_l + (size_t)row * D : (const bf16*)T.lat_src_c + (size_t)(row - M_LAT) * D) + lane;
        const v2u a = lp[0], b = lp[64], c = lp[128], d = lp[192]; R.l0.x = a.x; R.l0.y = a.y; R.l1.x = b.x; R.l1.y = b.y; R.l2.x = c.x; R.l2.y = c.y; R.l3.x = d.x; R.l3.y = d.y; }
    if (T.y) {
        if (T.moe_combine) { const GAS v2u* ya = (const GAS v2u*)(T.y + (size_t)p0 * D) + lane; const GAS v2u* yb = (const GAS v2u*)(T.y + (size_t)p1 * D) + lane;
            R.a0 = ya[0]; R.a1 = ya[64]; R.a2 = ya[128]; R.a3 = ya[192]; R.b0 = yb[0]; R.b1 = yb[64]; R.b2 = yb[128]; R.b3 = yb[192]; }
        else { int yr = row; if (T.y_perm && row < M_LAT) yr = (row & ~8191) + perm_cm(row & 8191);
            const GAS v2u* yp = (const GAS v2u*)(T.y + (size_t)yr * D) + lane; R.a0 = yp[0]; R.a1 = yp[64]; R.a2 = yp[128]; R.a3 = yp[192]; }
    }
    return R;
}
__device__ __forceinline__ void phase_tok(Frame& F, const TokCfg& T) {
    const int gw = F.bid * NWAVES + F.wave, NGW = F.G * NWAVES;
    const int R = (T.nrows + NGW - 1) / NGW; const int r0 = gw * R; int r1 = r0 + R; if (r1 > T.nrows) r1 = T.nrows;
    LAS float* WR = (LAS float*)F.lds;
    if (T.route) { const float* wr = F.in[I_EWR] + (size_t)T.jr * 1024 * 8; for (int i = F.tid; i < 8192; i += NTHR) WR[i] = wr[i]; }
    __syncthreads();
    f32x4 VU[4], VA[4], VB[4]; int curb = -1;
    int my_e0 = 0, my_e1 = 0; float my_w = 0.f;
    const int* rrp = (const int*)(F.ws + WS_ROUTE + RT_R); const float* rwp = (const float*)(F.ws + WS_ROUTE + RT_W);
    int p0c = 0, p1c = 0, p0n = 0, p1n = 0; float w0c = 0.f, w0n = 0.f;
    if (T.moe_combine && r0 < r1) { p0c = rrp[2 * r0]; p1c = rrp[2 * r0 + 1]; w0c = rwp[r0]; if (r0 + 1 < r1) { p0n = rrp[2 * r0 + 2]; p1n = rrp[2 * r0 + 3]; w0n = rwp[r0 + 1]; } }
    RowRaw C = tok_issue(T, r0 < r1 ? r0 : 0, p0c, p1c, F.lane);
    for (int row = r0; row < r1; ++row) {
        const bool hn = row + 1 < r1;
        int p0nn = 0, p1nn = 0; float w0nn = 0.f;
        const RowRaw N = tok_issue(T, hn ? row + 1 : row, p0n, p1n, F.lane);
        if (hn) {
            if (T.moe_combine && row + 2 < r1) { p0nn = rrp[2 * row + 4]; p1nn = rrp[2 * row + 5]; w0nn = rwp[row + 2]; } }
        const int b = row < M_LAT ? (row >> 13) : 8;
        if (b != curb) { curb = b;
#pragma unroll
            for (int j = 0; j < 4; ++j) {
                if (T.y) VU[j] = ((const f32x4*)(T.vupd + (size_t)b * 6144))[F.lane + 64 * j];
                if (T.vna) { VA[j] = ((const f32x4*)(T.vna + (size_t)b * 6144))[F.lane + 64 * j]; VB[j] = ((const f32x4*)(T.vnb + (size_t)b * 6144))[F.lane + 64 * j]; } } }
        f32x4 v[4];
        if (T.src_f32) {
            v[0] = __builtin_bit_cast(f32x4, C.l0); v[1] = __builtin_bit_cast(f32x4, C.l1); v[2] = __builtin_bit_cast(f32x4, C.l2); v[3] = __builtin_bit_cast(f32x4, C.l3); }
        else {
            const v4u cl[4] = {C.l0, C.l1, C.l2, C.l3};
#pragma unroll
            for (int j = 0; j < 4; ++j) v[j] = (f32x4){bflo(cl[j].x), bfhi(cl[j].x), bflo(cl[j].y), bfhi(cl[j].y)}; }
        if (T.y) {
            f32x4 yv[4]; const v2u cya[4] = {C.a0, C.a1, C.a2, C.a3}, cyb[4] = {C.b0, C.b1, C.b2, C.b3};
            if (T.moe_combine) { const float w0 = w0c, w1 = 1.f - w0c;
#pragma unroll
                for (int j = 0; j < 4; ++j) { const v2u a = cya[j], c = cyb[j];
                    yv[j] = (f32x4){w0 * bflo(a.x) + w1 * bflo(c.x), w0 * bfhi(a.x) + w1 * bfhi(c.x), w0 * bflo(a.y) + w1 * bflo(c.y), w0 * bfhi(a.y) + w1 * bfhi(c.y)}; }
            } else {
#pragma unroll
                for (int j = 0; j < 4; ++j) { const v2u a = cya[j]; yv[j] = (f32x4){bflo(a.x), bfhi(a.x), bflo(a.y), bfhi(a.y)}; }
            }
            float ss = 0.f;
#pragma unroll
            for (int j = 0; j < 4; ++j) ss += (yv[j].x * yv[j].x + yv[j].y * yv[j].y) + (yv[j].z * yv[j].z + yv[j].w * yv[j].w);
            const float rs = rsqrtf(wave_sum(ss) * (1.f / D) + EPS);
#pragma unroll
            for (int j = 0; j < 4; ++j) v[j] = v[j] + VU[j] * (yv[j] * rs);
        }
        void* dpv = row < M_LAT ? T.lat_dst_l : T.lat_dst_c;
        if (dpv) { const size_t ro = (size_t)(row < M_LAT ? row : row - M_LAT) * D;
            if (T.dst_f32) { float* dp = (float*)dpv + ro;
#pragma unroll
                for (int j = 0; j < 4; ++j) ((GAS f32x4*)dp)[F.lane + 64 * j] = v[j]; }
            else { bf16* dp = (bf16*)dpv + ro;
#pragma unroll
                for (int j = 0; j < 4; ++j) { v2u o; o.x = pk2(v[j].x, v[j].y); o.y = pk2(v[j].z, v[j].w); ((GAS v2u*)dp)[F.lane + 64 * j] = o; } } }
        if (T.vna) {
            float ss = 0.f;
#pragma unroll
            for (int j = 0; j < 4; ++j) ss += (v[j].x * v[j].x + v[j].y * v[j].y) + (v[j].z * v[j].z + v[j].w * v[j].w);
            const float rs = rsqrtf(wave_sum(ss) * (1.f / D) + EPS);
            f32x4 uu[4];
#pragma unroll
            for (int j = 0; j < 4; ++j) uu[j] = (v[j] * rs) * VA[j] + VB[j];
            int ur = row; if (T.u_perm && row < M_LAT) ur = (row & ~8191) + perm_cm(row & 8191);
            if (T.u_fp8 == 2) { GAS unsigned* up8 = (GAS unsigned*)((unsigned char*)T.u + (size_t)ur * D);
                float mx = 0.f;
#pragma unroll
                for (int j = 0; j < 4; ++j) mx = fmaxf(fmaxf(mx, fmaxf(fabsf(uu[j].x), fabsf(uu[j].y))), fmaxf(fabsf(uu[j].z), fabsf(uu[j].w)));
                mx = wave_max(mx); const float iv = mx > 0.f ? 127.0f / mx : 0.f;
#pragma unroll
                for (int j = 0; j < 4; ++j) { const unsigned q0 = (unsigned)(int)__builtin_rintf(uu[j].x * iv) & 0xffu, q1 = (unsigned)(int)__builtin_rintf(uu[j].y * iv) & 0xffu, q2 = (unsigned)(int)__builtin_rintf(uu[j].z * iv) & 0xffu, q3 = (unsigned)(int)__builtin_rintf(uu[j].w * iv);
                    up8[F.lane + 64 * j] = q0 | (q1 << 8) | (q2 << 16) | (q3 << 24); }
                if (F.lane == 0) T.u_scale[ur] = mx > 0.f ? mx * (1.0f / 127.0f) : 1.0f; }
            else if (T.u_fp8) { GAS unsigned* up8 = (GAS unsigned*)((unsigned char*)T.u + (size_t)ur * D);
#pragma unroll
                for (int j = 0; j < 4; ++j) { unsigned w = 0; w = __builtin_amdgcn_cvt_pk_fp8_f32(uu[j].x, uu[j].y, w, false); w = __builtin_amdgcn_cvt_pk_fp8_f32(uu[j].z, uu[j].w, w, true); up8[F.lane + 64 * j] = w; } }
            else { GAS v2u* up = (GAS v2u*)(T.u + (size_t)ur * D);
#pragma unroll
                for (int j = 0; j < 4; ++j) { v2u o; o.x = pk2(uu[j].x, uu[j].y); o.y = pk2(uu[j].z, uu[j].w); up[F.lane + 64 * j] = o; } }
            if (T.route) {
                float lg[8];
#pragma unroll
                for (int e = 0; e < 8; ++e) lg[e] = 0.f;
#pragma unroll
                for (int j = 0; j < 4; ++j)
#pragma unroll
                    for (int i = 0; i < 4; ++i) { const int c = 4 * (F.lane + 64 * j) + i; const f32x4 wa = *(const LAS f32x4*)(WR + c * 8), wb = *(const LAS f32x4*)(WR + c * 8 + 4); const float x = uu[j][i];
                        lg[0] += x * wa.x; lg[1] += x * wa.y; lg[2] += x * wa.z; lg[3] += x * wa.w; lg[4] += x * wb.x; lg[5] += x * wb.y; lg[6] += x * wb.z; lg[7] += x * wb.w; }
                const float* br = F.in[I_EBR] + T.jr * 8;
#pragma unroll
                for (int e = 0; e < 8; ++e) lg[e] = wave_sum(lg[e]) + br[e];
                int e0 = 0; float v0 = lg[0];
#pragma unroll
                for (int e = 1; e < 8; ++e) if (lg[e] > v0) { v0 = lg[e]; e0 = e; }
                int e1 = -1; float v1 = -3.0e38f;
#pragma unroll
                for (int e = 0; e < 8; ++e) if (e != e0 && lg[e] > v1) { v1 = lg[e]; e1 = e; }
                const float w0 = 1.f / (1.f + __expf(v1 - v0));
                if (F.lane == row - r0) { my_e0 = e0; my_e1 = e1; my_w = w0; }
            }
        }
        if (hn) { C = N; p0n = p0nn; p1n = p1nn; w0c = w0n; w0n = w0nn; }
    }
    if (T.route) {
        const int n = r1 - r0; const bool act = F.lane < n; const int row = r0 + F.lane;
        unsigned* ecnt = (unsigned*)(F.ws + WS_CTL) + CW_ECNT + T.jr * 8 * 64;
        int rk0 = 0, rk1 = 0;
        const unsigned long long ltmask = (F.lane == 0) ? 0ull : (~0ull >> (64 - F.lane));
#pragma unroll
        for (int e = 0; e < 8; ++e) {
            const unsigned long long m0 = __ballot(act && my_e0 == e), m1 = __ballot(act && my_e1 == e);
            const int c0 = __popcll(m0), c1 = __popcll(m1);
            unsigned base = 0;
            if (c0 + c1 > 0) { if (F.lane == 0) base = __hip_atomic_fetch_add(ecnt + e * 64, (unsigned)(c0 + c1), RLX_AGENT); base = __builtin_amdgcn_readfirstlane(base); }
            if (my_e0 == e) rk0 = (int)base + __popcll(m0 & ltmask);
            if (my_e1 == e) rk1 = (int)base + c0 + __popcll(m1 & ltmask);
        }
        if (act) { ((int*)(F.ws + WS_ROUTE + RT_E))[row] = my_e0 | (my_e1 << 8); ((int*)(F.ws + WS_ROUTE + RT_R))[2 * row] = rk0; ((int*)(F.ws + WS_ROUTE + RT_R))[2 * row + 1] = rk1;
            ((float*)(F.ws + WS_ROUTE + RT_W))[row] = my_w; }
    }
}

__device__ __forceinline__ void phase_moe_scatter(Frame& F, int jr, int nrows, const unsigned char* U, unsigned char* AM, int rowb, const float* sa_src, float* sa_dst) {
    const unsigned* ecnt = (const unsigned*)(F.ws + WS_CTL) + CW_ECNT + jr * 8 * 64;
    int base[8]; int acc = 0;
#pragma unroll
    for (int e = 0; e < 8; ++e) { const int c = (int)__hip_atomic_load(ecnt + e * 64, RLX_AGENT); base[e] = acc; acc += (c + 255) & ~255; }
    int* pexp = (int*)(F.ws + WS_SMALL + SM_PEXP);
    if (F.bid == 0) { const int np = acc >> 8;
        for (int p = F.tid; p < np; p += NTHR) { int e = 0;
#pragma unroll
            for (int q = 1; q < 8; ++q) if (p * 256 >= base[q]) e = q;
            pexp[p] = e; }
        if (F.tid == 0) pexp[MOE_PANELS] = np; }
    const int gw = F.bid * NWAVES + F.wave, NGW = F.G * NWAVES;
    const int R = (nrows + NGW - 1) / NGW; const int r0 = gw * R; int r1 = r0 + R; if (r1 > nrows) r1 = nrows;
    int* rr = (int*)(F.ws + WS_ROUTE + RT_R); const int* re = (const int*)(F.ws + WS_ROUTE + RT_E);
    for (int row = r0; row < r1; ++row) {
        const int ee = re[row], e0 = ee & 255, e1 = ee >> 8; int b0 = 0, b1 = 0;
#pragma unroll
        for (int e = 0; e < 8; ++e) { if (e0 == e) b0 = base[e]; if (e1 == e) b1 = base[e]; }
        const int p0 = b0 + rr[2 * row], p1 = b1 + rr[2 * row + 1];
        const v4u* src = (const v4u*)(U + (size_t)row * rowb); v4u* d0 = (v4u*)(AM + (size_t)p0 * rowb); v4u* d1 = (v4u*)(AM + (size_t)p1 * rowb);
        const v4u a = src[F.lane]; d0[F.lane] = a; d1[F.lane] = a;
        if (rowb > 1024) { const v4u c = src[F.lane + 64]; d0[F.lane + 64] = c; d1[F.lane + 64] = c; }
        CFENCE();
        if (F.lane == 0) { rr[2 * row] = p0; rr[2 * row + 1] = p1; if (sa_src) { const float s = sa_src[row]; sa_dst[p0] = s; sa_dst[p1] = s; } }
    }
}

#define MFMA32(a, b, c) __builtin_amdgcn_mfma_f32_32x32x16_bf16((a), (b), (c), 0, 0, 0)
typedef short v4i16_t __attribute__((ext_vector_type(4)));
typedef LAS unsigned char* ldsp;
__device__ __forceinline__ unsigned cvtpk(float lo, float hi) { f32x2_t v = {lo, hi}; bf16x2_t b = __builtin_convertvector(v, bf16x2_t); return __builtin_bit_cast(unsigned, b); }
__device__ __forceinline__ int crow(int reg, int h) { return (reg & 3) + 8 * (reg >> 2) + 4 * h; }
__device__ __forceinline__ bf16x8 pack8(const f32x16& x, int s) {
    v4u p; p.x = cvtpk(x[8 * s], x[8 * s + 1]); p.y = cvtpk(x[8 * s + 2], x[8 * s + 3]); p.z = cvtpk(x[8 * s + 4], x[8 * s + 5]); p.w = cvtpk(x[8 * s + 6], x[8 * s + 7]);
    return __builtin_bit_cast(bf16x8, p);
}
__device__ __forceinline__ bf16x8 lds16(ldsp p) { return *(const LAS bf16x8*)p; }
__device__ __forceinline__ bf16x8 lds8x2(ldsp p) { const s16x4 lo = *(const LAS s16x4*)p, hi = *(const LAS s16x4*)(p + 16); return __builtin_shufflevector(lo, hi, 0, 1, 2, 3, 4, 5, 6, 7); }
__device__ __forceinline__ s16x4 tr16(ldsp p) { return __builtin_bit_cast(s16x4, __builtin_amdgcn_ds_read_tr16_b64_v4i16((LAS v4i16_t*)p)); }
__device__ __forceinline__ bf16x8 ldstr2(ldsp p, int second) { const s16x4 lo = tr16(p), hi = tr16(p + second); return __builtin_shufflevector(lo, hi, 0, 1, 2, 3, 4, 5, 6, 7); }
__device__ __forceinline__ f32x16 zero16() { f32x16 z;
#pragma unroll
    for (int i = 0; i < 16; ++i) z[i] = 0.f; return z; }
__device__ __forceinline__ void unpack8(const v4u& w, float (&x)[8]) { x[0] = bflo(w.x); x[1] = bfhi(w.x); x[2] = bflo(w.y); x[3] = bfhi(w.y); x[4] = bflo(w.z); x[5] = bfhi(w.z); x[6] = bflo(w.w); x[7] = bfhi(w.w); }
__device__ __forceinline__ int launder_v(int x) { asm volatile("" : "+v"(x)); return x; }
struct FragOff { int o_row, o_perm, o_trn, o_trp; };
__device__ __forceinline__ FragOff frag_off(int lane, int LD) {
    const int r = lane & 31, hh = lane >> 5, i16 = lane & 15, q = i16 >> 2, p = i16 & 3, blk = (lane >> 4) & 1; FragOff f;
    f.o_row = (r * LD + 8 * hh) * 2; f.o_perm = (r * LD + 4 * hh) * 2;
    f.o_trn = ((8 * hh + q) * LD + 16 * blk + 4 * p) * 2; f.o_trp = ((4 * hh + q) * LD + 16 * blk + 4 * p) * 2; return f;
}


template <int CTRL, int RM, int BM> __device__ __forceinline__ float dpp_f(float old, float x) {
    return __builtin_bit_cast(float, __builtin_amdgcn_update_dpp(__builtin_bit_cast(int, old), __builtin_bit_cast(int, x), CTRL, RM, BM, false)); }
__device__ __forceinline__ float wave_scan_add(float x) {
    float r = x;
    r += dpp_f<0x111, 0xf, 0xf>(0.f, x); r += dpp_f<0x112, 0xf, 0xf>(0.f, x); r += dpp_f<0x113, 0xf, 0xf>(0.f, x);
    r += dpp_f<0x114, 0xf, 0xe>(0.f, r); r += dpp_f<0x118, 0xf, 0xc>(0.f, r);
    r += dpp_f<0x142, 0xa, 0xf>(0.f, r); r += dpp_f<0x143, 0xc, 0xf>(0.f, r);
    return r;
}
__device__ __forceinline__ float wave_scan_max(float x) {
    const float NEG = -3.0e38f; float r = x;
    r = fmaxf(r, dpp_f<0x111, 0xf, 0xf>(NEG, x)); r = fmaxf(r, dpp_f<0x112, 0xf, 0xf>(NEG, x)); r = fmaxf(r, dpp_f<0x113, 0xf, 0xf>(NEG, x));
    r = fmaxf(r, dpp_f<0x114, 0xf, 0xe>(NEG, r)); r = fmaxf(r, dpp_f<0x118, 0xf, 0xc>(NEG, r));
    r = fmaxf(r, dpp_f<0x142, 0xa, 0xf>(NEG, r)); r = fmaxf(r, dpp_f<0x143, 0xc, 0xf>(NEG, r));
    return r;
}
__device__ __forceinline__ float lane63(float x) { return __builtin_bit_cast(float, __builtin_amdgcn_readlane(__builtin_bit_cast(int, x), 63)); }
__device__ __forceinline__ float sum_halves(float x) {
    const unsigned u = __builtin_bit_cast(unsigned, x); auto rr = __builtin_amdgcn_permlane32_swap(u, u, false, false);
    return __builtin_bit_cast(float, (unsigned)rr[0]) + __builtin_bit_cast(float, (unsigned)rr[1]); }

__device__ __forceinline__ void item_headnorm(int tid, const bf16* hf, const bf16* hb, const bf16* gate, int gpitch, int gcol, const float* gh_head, bf16* aout, int rowbase, int t0, int ntok, int h) {
    VM_WAIT(); __syncthreads();
    const int sub = tid & 7, rr = tid >> 3;
    float gh[16];
#pragma unroll
    for (int e = 0; e < 16; ++e) gh[e] = gh_head[sub * 16 + e];
#pragma unroll 2
    for (int row = rr; row < ntok; row += 64) {
        const size_t grow = (size_t)(rowbase + t0 + row);
        const size_t o = grow * D + h * 128 + sub * 16;
        const v4u a0 = *(const GAS v4u*)(hf + o), a1 = *(const GAS v4u*)(hf + o + 8), b0 = *(const GAS v4u*)(hb + o), b1 = *(const GAS v4u*)(hb + o + 8);
        const bf16* gp = gate + grow * gpitch + gcol + h * 128 + sub * 16; const v4u g0 = *(const GAS v4u*)gp, g1 = *(const GAS v4u*)(gp + 8);
        float x[16], y[8];
        unpack8(a0, y);
#pragma unroll
        for (int e = 0; e < 8; ++e) x[e] = y[e];
        unpack8(a1, y);
#pragma unroll
        for (int e = 0; e < 8; ++e) x[8 + e] = y[e];
        unpack8(b0, y);
#pragma unroll
        for (int e = 0; e < 8; ++e) x[e] += y[e];
        unpack8(b1, y);
#pragma unroll
        for (int e = 0; e < 8; ++e) x[8 + e] += y[e];
        float ss = 0.f;
#pragma unroll
        for (int e = 0; e < 16; ++e) ss += x[e] * x[e];
        ss += __shfl_xor(ss, 1); ss += __shfl_xor(ss, 2); ss += __shfl_xor(ss, 4);
        const float rs = rsqrtf(ss * (1.f / 128.f) + EPS);
        float o16[16];
        unpack8(g0, y);
#pragma unroll
        for (int e = 0; e < 8; ++e) o16[e] = x[e] * rs * gh[e] * sigmoidf_(y[e]);
        unpack8(g1, y);
#pragma unroll
        for (int e = 0; e < 8; ++e) o16[8 + e] = x[8 + e] * rs * gh[8 + e] * sigmoidf_(y[e]);
        v4u w0, w1; w0.x = pk2(o16[0], o16[1]); w0.y = pk2(o16[2], o16[3]); w0.z = pk2(o16[4], o16[5]); w0.w = pk2(o16[6], o16[7]); w1.x = pk2(o16[8], o16[9]); w1.y = pk2(o16[10], o16[11]); w1.z = pk2(o16[12], o16[13]); w1.w = pk2(o16[14], o16[15]);
        *(GAS v4u*)(aout + o) = w0; *(GAS v4u*)(aout + o + 8) = w1;
    }
}

#ifndef SCAN_PF_OUT
#define SCAN_PF_OUT 1
#endif
constexpr int ML_LDQ = 72, ML_LDV = 136;
constexpr int ML_QC = 0, ML_KC = 9216, ML_KH = 18432, ML_V = 27648, ML_GS = 45056, ML_OB = 50176, ML_NV = 68608, ML_SSQ = 70656, ML_INV = 71680, ML_GROUP = 73728;
static_assert(2 * ML_GROUP <= LDS_MAIN, "mLSTM LDS map");
constexpr int ML_STATE_F = 8448;

struct MlPref { v4u q[2], k[2], v[4]; float gi, gf; };
struct MlSeg { int rowbase; int len; int t0; int nchunk; };

__device__ __forceinline__ void ml_issue(MlPref& P, const bf16* proj, const bf16* qkc, const float* gates, int rowbase, int t0c, int g, int h, int tg, int lane, bool need_q) {
    const int c8q = tg & 7;
#pragma unroll
    for (int i = 0; i < 2; ++i) { const int tau = (tg + 256 * i) >> 3; const int t = t0c + (g ? 63 - tau : tau);
        const bf16* rp = qkc + (size_t)(rowbase + t) * D + h * 64 + c8q * 8;
        P.q[i] = need_q ? *(const GAS v4u*)rp : (v4u){0u, 0u, 0u, 0u}; P.k[i] = *(const GAS v4u*)(rp + 512); }
#pragma unroll
    for (int i = 0; i < 4; ++i) { const int p = tg + 256 * i, tau = p >> 4, c8 = p & 15; const int t = t0c + (g ? 63 - tau : tau);
        P.v[i] = *(const GAS v4u*)(proj + (size_t)(rowbase + t) * NP_M + 1024 + h * 128 + c8 * 8); }
    { const int t = t0c + (g ? 63 - lane : lane); const GAS float* gp = (const GAS float*)(gates + (size_t)(rowbase + t) * 32 + g * 16 + h); P.gi = gp[0]; P.gf = gp[8]; }
}

template <bool OUTPUT>
__device__ __forceinline__ void mlstm_item(Frame& F, const bf16* proj, const bf16* qkc, const float* gates, bf16* hx0, bf16* hx1, bf16* aout, const float* ghead,
                                           int h, MlSeg S0, MlSeg S1, const float* st_in0, const float* st_in1, int npre0, int npre1, float* st_out0, float* st_out1) {
    const int tid_l = launder_v(F.tid); const int wave_l = __builtin_amdgcn_readfirstlane(tid_l >> 6);
    const int g = wave_l >> 2, j = wave_l & 3, tg = tid_l & 255, lane = tid_l & 63, r = lane & 31, hh = lane >> 5;
    const ldsp gb = F.lds + g * ML_GROUP;
    const ldsp GSb = gb + ML_GS + j * 1280;
    LAS float* GS = (LAS float*)GSb;
    const ldsp OBb = gb + ML_OB + j * 4608;
    LAS float* NV = (LAS float*)(gb + ML_NV);
    LAS float* SSQ = (LAS float*)(gb + ML_SSQ);
    const ldsp INVb = gb + ML_INV + j * 256;
    const int rowbase = g ? S1.rowbase : S0.rowbase, seg_t0 = g ? S1.t0 : S0.t0, nch = g ? S1.nchunk : S0.nchunk;
    const int vcol = 64 * j;
    __syncthreads();
    f32x16 C[2]; C[0] = zero16(); C[1] = zero16();
    float m_prev = -1.0e30f, btot = 0.f;
    float nreg = 0.f;
    if (OUTPUT) {
        const float* sp = g ? st_in1 : st_in0; const int np = g ? npre1 : npre0;
#pragma unroll 1
        for (int k = 0; k < np; ++k) { const float* e = sp + (size_t)k * ML_STATE_F;
            const float mloc = e[8192 + 64], B = e[8192 + 65];
            const float mnew = fmaxf(B + m_prev, mloc), al = __expf(B + m_prev - mnew), be = __expf(mloc - mnew);
            const float* ep = e + (4 * hh) * 128 + 32 * j + r;
#pragma unroll
            for (int dt = 0; dt < 2; ++dt)
#pragma unroll
                for (int i = 0; i < 16; ++i) C[dt][i] = al * C[dt][i] + be * ep[(32 * dt + (i & 3) + 8 * (i >> 2)) * 128];
            nreg = al * nreg + be * e[8192 + 16 * j + (lane & 15)];
            m_prev = mnew; }
    }
    if (lane < 16) NV[16 * j + lane] = nreg;
    constexpr int NPF = OUTPUT ? SCAN_PF_OUT : 2;
    MlPref PP[NPF]; ml_issue(PP[0], proj, qkc, gates, rowbase, seg_t0 + 64 * (g ? nch - 1 : 0), g, h, tg, lane, OUTPUT);
    if (NPF == 2) ml_issue(PP[NPF - 1], proj, qkc, gates, rowbase, seg_t0 + 64 * (g ? nch - 2 : 1), g, h, tg, lane, OUTPUT);
    __syncthreads();
#pragma unroll 1
    for (int step2 = 0; step2 < nch; step2 += NPF) {
#pragma unroll
    for (int hf = 0; hf < NPF; ++hf) { const int step = step2 + hf; MlPref& P = PP[hf];
        const int tgs = launder_v(tg), lns = launder_v(lane);
        const int r = lns & 31, hh = lns >> 5;
        const FragOff fq = frag_off(lns, ML_LDQ), fv = frag_off(lns, ML_LDV);
        const int o_h4 = 16 * hh;
        const int o_obw = (4 * hh * 36 + r) * 4, o_obr = ((lns >> 1) * 36 + 16 * (lns & 1)) * 4;
        const int ci = g ? nch - 1 - step : step;
        const int par = step & 1;
        float decay;
        {
            const float xi = P.gi, lf = P.gf;
            const float bc = wave_scan_add(lf);
            const float a = xi - bc; const float pm = wave_scan_max(a);
            const float Mt = fmaxf(m_prev, pm);
            const float Ml = lane63(Mt), bl = lane63(bc);
            GS[lns] = a; GS[64 + lns] = Mt; GS[128 + lns] = __expf(m_prev - Mt); GS[192 + lns] = __expf(-(bc + Mt)); GS[256 + lns] = __expf(a - Ml);
            decay = __expf(m_prev - Ml); m_prev = bl + Ml; btot += bl;
        }
        LDS_WAIT(); CFENCE();
        {
            const int c8 = tgs & 7;
#pragma unroll
            for (int i = 0; i < 2; ++i) { const int tau = (tgs + 256 * i) >> 3; const ldsp tp = gb + (tau * ML_LDQ + c8 * 8) * 2;
                if (OUTPUT) { *(LAS v4u*)(tp + ML_QC) = P.q[i]; *(LAS v4u*)(tp + ML_KC) = P.k[i]; }
                float o[8]; unpack8(P.k[i], o); const float wkk = GS[256 + tau]; v4u w;
                w.x = pk2(o[0] * wkk, o[1] * wkk); w.y = pk2(o[2] * wkk, o[3] * wkk); w.z = pk2(o[4] * wkk, o[5] * wkk); w.w = pk2(o[6] * wkk, o[7] * wkk);
                *(LAS v4u*)(tp + ML_KH) = w; }
#pragma unroll
            for (int i = 0; i < 4; ++i) { const int p = tgs + 256 * i, tau = p >> 4, cc = p & 15; *(LAS v4u*)(gb + ML_V + (tau * ML_LDV + cc * 8) * 2) = P.v[i]; }
        }
        if (step + NPF < nch) ml_issue(P, proj, qkc, gates, rowbase, seg_t0 + 64 * (g ? nch - 1 - NPF - step : step + NPF), g, h, tgs, lns, OUTPUT);
        __syncthreads();
        if (OUTPUT) {
            bf16* hx = g ? hx1 : hx0;
#pragma unroll
            for (int tt = 0; tt < 2; ++tt) {
                f32x16 acc = zero16();
#pragma unroll
                for (int dt = 0; dt < 2; ++dt)
#pragma unroll
                    for (int sp = 0; sp < 2; ++sp) acc = MFMA32(lds8x2(gb + ML_QC + fq.o_perm + (32 * tt * ML_LDQ + 32 * dt + 16 * sp) * 2), pack8(C[dt], sp), acc);
#pragma unroll
                for (int q4 = 0; q4 < 4; ++q4) { const f32x4 wv = *(const LAS f32x4*)(GSb + o_h4 + (128 + 32 * tt + 8 * q4) * 4);
#pragma unroll
                    for (int e = 0; e < 4; ++e) acc[4 * q4 + e] *= wv[e]; }
                const float Mt = GS[64 + 32 * tt + r];
                float den = 0.f;
#pragma unroll
                for (int st = 0; st <= tt; ++st) {
                    f32x16 s = zero16();
#pragma unroll
                    for (int ks = 0; ks < 4; ++ks) s = MFMA32(lds16(gb + ML_KC + fq.o_row + (32 * st * ML_LDQ + 16 * ks) * 2), lds16(gb + ML_QC + fq.o_row + (32 * tt * ML_LDQ + 16 * ks) * 2), s);
#pragma unroll
                    for (int q4 = 0; q4 < 4; ++q4) { const f32x4 av = *(const LAS f32x4*)(GSb + o_h4 + (32 * st + 8 * q4) * 4);
#pragma unroll
                        for (int e = 0; e < 4; ++e) { const int i = 4 * q4 + e; const int srow = 32 * st + crow(i, hh); const float pv = (srow <= 32 * tt + r) ? s[i] * __expf(av[e] - Mt) : 0.f; s[i] = pv; den += pv; } }
                    const bf16x8 pa0 = pack8(s, 0), pa1 = pack8(s, 1);
                    acc = MFMA32(pa0, ldstr2(gb + ML_V + fv.o_trp + vcol + ((32 * st) * ML_LDV) * 2, 8 * ML_LDV * 2), acc);
                    acc = MFMA32(pa1, ldstr2(gb + ML_V + fv.o_trp + vcol + ((32 * st + 16) * ML_LDV) * 2, 8 * ML_LDV * 2), acc);
                    }
                float qn;
                { float q0 = 0.f, q1 = 0.f, q2 = 0.f, q3 = 0.f;
#pragma unroll
                for (int c4 = 0; c4 < 4; ++c4) { const v4u qw = *(const LAS v4u*)(gb + ML_QC + (r * ML_LDQ + 32 * hh) * 2 + (32 * tt * ML_LDQ + 8 * c4) * 2); float qx[8]; unpack8(qw, qx);
                    const f32x4 n0 = *(const LAS f32x4*)(gb + ML_NV + 8 * o_h4 + (par * 64 + 8 * c4) * 4), n1 = *(const LAS f32x4*)(gb + ML_NV + 8 * o_h4 + (par * 64 + 8 * c4 + 4) * 4);
                    q0 += qx[0] * n0[0] + qx[4] * n1[0]; q1 += qx[1] * n0[1] + qx[5] * n1[1]; q2 += qx[2] * n0[2] + qx[6] * n1[2]; q3 += qx[3] * n0[3] + qx[7] * n1[3]; }
                qn = (q0 + q1) + (q2 + q3); }
                den = sum_halves(den); qn = sum_halves(qn);
                const float dtot = den + GS[128 + 32 * tt + r] * qn;
                const float inv = __builtin_amdgcn_rcpf(fmaxf(fabsf(dtot), GS[192 + 32 * tt + r]));
                if (hh == 0) *(LAS float*)(INVb + (32 * tt + r) * 4) = inv;
                LDS_WAIT(); CFENCE();
                f32x16 hv;
#pragma unroll
                for (int q4 = 0; q4 < 4; ++q4) { const f32x4 iv = *(const LAS f32x4*)(INVb + o_h4 + (32 * tt + 8 * q4) * 4);
#pragma unroll
                    for (int e = 0; e < 4; ++e) { const int i = 4 * q4 + e; hv[i] = acc[i] * iv[e]; } }
#pragma unroll
                for (int i = 0; i < 16; ++i) *(LAS float*)(OBb + o_obw + ((i & 3) + 8 * (i >> 2)) * 144) = hv[i];
                LDS_WAIT(); CFENCE();
                { const f32x4 x0 = *(const LAS f32x4*)(OBb + o_obr), x1 = *(const LAS f32x4*)(OBb + o_obr + 16), x2 = *(const LAS f32x4*)(OBb + o_obr + 32), x3 = *(const LAS f32x4*)(OBb + o_obr + 48);
                    const int tau = 32 * tt + (lns >> 1); const int t = seg_t0 + 64 * ci + (g ? 63 - tau : tau);
                    bf16* op = hx + (size_t)(rowbase + t) * D + h * 128 + 32 * j + 16 * (lns & 1);
                    v4u w0, w1; w0.x = pk2(x0[0], x0[1]); w0.y = pk2(x0[2], x0[3]); w0.z = pk2(x1[0], x1[1]); w0.w = pk2(x1[2], x1[3]); w1.x = pk2(x2[0], x2[1]); w1.y = pk2(x2[2], x2[3]); w1.z = pk2(x3[0], x3[1]); w1.w = pk2(x3[2], x3[3]);
                    *(GAS v4u*)op = w0; *(GAS v4u*)(op + 8) = w1; }
                LDS_WAIT(); CFENCE();
            }
        }
        __builtin_amdgcn_sched_barrier(0);
#pragma unroll
        for (int dt = 0; dt < 2; ++dt) {
#pragma unroll
            for (int i = 0; i < 16; ++i) C[dt][i] *= decay;
#pragma unroll
            for (int ks = 0; ks < 4; ++ks) C[dt] = MFMA32(ldstr2(gb + ML_KH + fq.o_trn + (16 * ks * ML_LDQ + 32 * dt) * 2, 4 * ML_LDQ * 2), ldstr2(gb + ML_V + fv.o_trn + vcol + (16 * ks * ML_LDV) * 2, 4 * ML_LDV * 2), C[dt]);
        }
        {   const int dkl = 16 * j + (lns & 15), tq = lns >> 4; float s0 = 0.f, s1 = 0.f;
#pragma unroll
            for (int i = 0; i < 16; i += 2) { s0 += bf2f(*(const LAS bf16*)(gb + ML_KH + ((16 * tq + i) * ML_LDQ + dkl) * 2)); s1 += bf2f(*(const LAS bf16*)(gb + ML_KH + ((16 * tq + i + 1) * ML_LDQ + dkl) * 2)); }
            float sacc = s0 + s1; sacc += __shfl_xor(sacc, 16); sacc = sum_halves(sacc);
            nreg = decay * nreg + sacc; if (lns < 16) NV[(par ^ 1) * 64 + dkl] = nreg; }
        __syncthreads();
    } }
    if (OUTPUT) item_headnorm(launder_v(tid_l), hx0, hx1, proj, NP_M, 2048, ghead + h * 128, aout, S0.rowbase, S0.t0, S0.nchunk * 64, h);
    if (!OUTPUT) {
        float* e = g ? st_out1 : st_out0; float* ep = e + (4 * hh) * 128 + 32 * j + r;
#pragma unroll
        for (int dt = 0; dt < 2; ++dt)
#pragma unroll
            for (int i = 0; i < 16; ++i) ep[(32 * dt + (i & 3) + 8 * (i >> 2)) * 128] = C[dt][i];
        if (lane < 16) e[8192 + 16 * j + lane] = nreg;
        if (j == 0 && lane == 0) { e[8192 + 64] = m_prev; e[8192 + 65] = btot; }
    }
}

constexpr int HG_LD = 136;
constexpr int HG_LF = 0, HG_QT = 16384, HG_KT = 25088, HG_KH = 33792, HG_V = 42496, HG_OB = 51200, HG_AUX = 69632, HG_SSQ = 71168, HG_EAM = 71680, HG_BIAS = 72192, HG_LBV = 72704, HG_GROUP = 73728;
static_assert(2 * HG_GROUP <= LDS_MAIN, "HGRN2 LDS map");
constexpr int HG_STATE_F = 16512;

struct HgPref { v4u q[2], f[2], v[2]; };
__device__ __forceinline__ void hg_issue(HgPref& P, const bf16* proj, int rowbase, int t0c, int g, int h, int tg, bool need_q) {
#pragma unroll
    for (int i = 0; i < 2; ++i) { const int p = tg + 256 * i, tau = p >> 4, c8 = p & 15; const int t = t0c + (g ? 31 - tau : tau);
        const bf16* rp = proj + (size_t)(rowbase + t) * NP_H + h * 128 + c8 * 8;
        P.q[i] = need_q ? *(const GAS v4u*)rp : (v4u){0u, 0u, 0u, 0u}; P.v[i] = *(const GAS v4u*)(rp + 1024); P.f[i] = *(const GAS v4u*)(rp + 2048 + 1024 * g); }
}
__device__ __forceinline__ float clamp80(float x) { return fminf(fmaxf(x, -80.f), 80.f); }

template <bool OUTPUT>
__device__ __forceinline__ void hgrn_item(Frame& F, const bf16* proj, bf16* hx0, bf16* hx1, bf16* aout, const float* ghead, const float* bf_, const float* lbraw, int jl,
                                          int h, MlSeg S0, MlSeg S1, const float* st_in0, const float* st_in1, int npre0, int npre1, float* st_out0, float* st_out1) {
    const int tid_l = launder_v(F.tid); const int wave_l = __builtin_amdgcn_readfirstlane(tid_l >> 6);
    const int g = wave_l >> 2, j = wave_l & 3, tg = tid_l & 255, lane = tid_l & 63, r = lane & 31, hh = lane >> 5;
    const ldsp gb = F.lds + g * HG_GROUP;
    LAS float* LF = (LAS float*)(gb + HG_LF);
    const ldsp OBb = gb + HG_OB + j * 4608;
    LAS float* AMID = (LAS float*)(gb + HG_AUX); LAS float* ALAST = AMID + 128; LAS float* DEC = AMID + 256;
    LAS float* SSQ = (LAS float*)(gb + HG_SSQ); LAS float* EAM = (LAS float*)(gb + HG_EAM); LAS float* BIASV = (LAS float*)(gb + HG_BIAS); LAS float* LBV = (LAS float*)(gb + HG_LBV);
    const int rowbase = g ? S1.rowbase : S0.rowbase, seg_t0 = g ? S1.t0 : S0.t0, nch = g ? S1.nchunk : S0.nchunk;
    const int vcol = 64 * j;
    __syncthreads();
    if (tg < 128) { const int c = h * 128 + tg; BIASV[tg] = bf_[g * 1024 + c]; LBV[tg] = jl == 0 ? 0.f : sigmoidf_(lbraw[(1 * 2 + g) * 1024 + c] - lbraw[(0 * 2 + g) * 1024 + c]); }
    f32x16 St[4];
#pragma unroll
    for (int dt = 0; dt < 4; ++dt) St[dt] = zero16();
    float atot = 0.f;
    if (OUTPUT) {   const float* sp = g ? st_in1 : st_in0; const int np = g ? npre1 : npre0;
#pragma unroll 1
        for (int k = 0; k < np; ++k) { const float* e = sp + (size_t)k * HG_STATE_F; const float* ep = e + (4 * hh) * 128 + 32 * j + r; const float* ap = e + 16384 + 4 * hh;
#pragma unroll
            for (int dt = 0; dt < 4; ++dt)
#pragma unroll
                for (int i = 0; i < 16; ++i) { const int dk0 = 32 * dt + (i & 3) + 8 * (i >> 2); St[dt][i] = __expf(ap[dk0]) * St[dt][i] + ep[dk0 * 128]; } }
    }
    constexpr int NPF = OUTPUT ? SCAN_PF_OUT : 2;
    HgPref PP[NPF]; hg_issue(PP[0], proj, rowbase, seg_t0 + 32 * (g ? nch - 1 : 0), g, h, tg, OUTPUT);
    if (NPF == 2) hg_issue(PP[NPF - 1], proj, rowbase, seg_t0 + 32 * (g ? nch - 2 : 1), g, h, tg, OUTPUT);
    __syncthreads();
#pragma unroll 1
    for (int step2 = 0; step2 < nch; step2 += NPF) {
#pragma unroll
    for (int hf = 0; hf < NPF; ++hf) { const int step = step2 + hf; HgPref& P = PP[hf];
        const int tgs = launder_v(tg), lns = launder_v(lane);
        const int r = lns & 31, hh = lns >> 5;
        const FragOff fo = frag_off(lns, HG_LD);
        const int o_h4 = 16 * hh;
        const int o_obw = (4 * hh * 36 + r) * 4, o_obr = ((lns >> 1) * 36 + 16 * (lns & 1)) * 4;
        const int c8 = tgs & 15;
        const int o_piece = (((tgs >> 4) * HG_LD) + c8 * 8) * 2;
        const int ci = g ? nch - 1 - step : step;
#pragma unroll
        for (int i = 0; i < 2; ++i) { const int tau = (tgs + 256 * i) >> 4; float x[8], lf[8], kk[8]; unpack8(P.f[i], x);
            const f32x4 b0 = *(const LAS f32x4*)(BIASV + c8 * 8), b1 = *(const LAS f32x4*)(BIASV + c8 * 8 + 4), l0 = *(const LAS f32x4*)(LBV + c8 * 8), l1 = *(const LAS f32x4*)(LBV + c8 * 8 + 4);
            const float bb[8] = {b0[0], b0[1], b0[2], b0[3], b1[0], b1[1], b1[2], b1[3]}, ll[8] = {l0[0], l0[1], l0[2], l0[3], l1[0], l1[1], l1[2], l1[3]};
#pragma unroll
            for (int e = 0; e < 8; ++e) { const float sg = sigmoidf_(x[e] + bb[e]); const float f = ll[e] + (1.f - ll[e]) * sg; lf[e] = __logf(fmaxf(f, 1e-37f)); kk[e] = 1.f - f; }
            *(LAS f32x4*)(LF + tau * 128 + c8 * 8) = (f32x4){lf[0], lf[1], lf[2], lf[3]}; *(LAS f32x4*)(LF + tau * 128 + c8 * 8 + 4) = (f32x4){lf[4], lf[5], lf[6], lf[7]};
            v4u w; w.x = pk2(kk[0], kk[1]); w.y = pk2(kk[2], kk[3]); w.z = pk2(kk[4], kk[5]); w.w = pk2(kk[6], kk[7]);
            const ldsp tp = gb + o_piece + i * (16 * HG_LD * 2);
            *(LAS v4u*)(tp + HG_KT) = w;
            if (OUTPUT) *(LAS v4u*)(tp + HG_QT) = P.q[i];
            *(LAS v4u*)(tp + HG_V) = P.v[i]; }
        if (step + NPF < nch) hg_issue(P, proj, rowbase, seg_t0 + 32 * (g ? nch - 1 - NPF - step : step + NPF), g, h, tgs, OUTPUT);
        __syncthreads();
        {   const int dkc = tgs & 127, half = tgs >> 7; float pre = 0.f;
            if (half) { float p0 = 0.f, p1 = 0.f, p2 = 0.f, p3 = 0.f;
#pragma unroll
                for (int tau = 0; tau < 16; tau += 4) { p0 += LF[tau * 128 + dkc]; p1 += LF[(tau + 1) * 128 + dkc]; p2 += LF[(tau + 2) * 128 + dkc]; p3 += LF[(tau + 3) * 128 + dkc]; }
                pre = (p0 + p1) + (p2 + p3); }
            float v[16];
#pragma unroll
            for (int i = 0; i < 16; ++i) v[i] = LF[(16 * half + i) * 128 + dkc];
            LDS_WAIT(); __builtin_amdgcn_s_barrier(); CFENCE();
            float run = pre;
#pragma unroll
            for (int i = 0; i < 16; ++i) { run += v[i]; LF[(16 * half + i) * 128 + dkc] = run; }
            if (!half) { AMID[dkc] = run; EAM[dkc] = __expf(run); } else { ALAST[dkc] = __expf(run - pre); DEC[dkc] = __expf(run); atot += run; } }
        __syncthreads();
#pragma unroll
        for (int i = 0; i < 2; ++i) { const int tau = (tgs + 256 * i) >> 4; const ldsp tp = gb + o_piece + i * (16 * HG_LD * 2);
            const f32x4 a0 = *(const LAS f32x4*)(LF + tau * 128 + c8 * 8), a1 = *(const LAS f32x4*)(LF + tau * 128 + c8 * 8 + 4);
            const f32x4 m0 = *(const LAS f32x4*)(AMID + c8 * 8), m1 = *(const LAS f32x4*)(AMID + c8 * 8 + 4), l0 = *(const LAS f32x4*)(ALAST + c8 * 8), l1 = *(const LAS f32x4*)(ALAST + c8 * 8 + 4);
            float a[8] = {a0[0], a0[1], a0[2], a0[3], a1[0], a1[1], a1[2], a1[3]}, am[8] = {m0[0], m0[1], m0[2], m0[3], m1[0], m1[1], m1[2], m1[3]}, al[8] = {l0[0], l0[1], l0[2], l0[3], l1[0], l1[1], l1[2], l1[3]};
            float qx[8], kx[8], qo[8], ko[8], ho[8]; { const v4u kw = *(const LAS v4u*)(tp + HG_KT); unpack8(kw, kx); if (OUTPUT) { const v4u qw = *(const LAS v4u*)(tp + HG_QT); unpack8(qw, qx); } }
#pragma unroll
            for (int e = 0; e < 8; ++e) { const float e1 = __expf(clamp80(a[e] - am[e])); const float kt = kx[e] * __builtin_amdgcn_rcpf(e1);
                if (OUTPUT) { qo[e] = qx[e] * e1; ko[e] = kt; } ho[e] = kt * al[e]; }
            v4u w;
            if (OUTPUT) { w.x = pk2(qo[0], qo[1]); w.y = pk2(qo[2], qo[3]); w.z = pk2(qo[4], qo[5]); w.w = pk2(qo[6], qo[7]); *(LAS v4u*)(tp + HG_QT) = w;
                w.x = pk2(ko[0], ko[1]); w.y = pk2(ko[2], ko[3]); w.z = pk2(ko[4], ko[5]); w.w = pk2(ko[6], ko[7]); *(LAS v4u*)(tp + HG_KT) = w; }
            w.x = pk2(ho[0], ho[1]); w.y = pk2(ho[2], ho[3]); w.z = pk2(ho[4], ho[5]); w.w = pk2(ho[6], ho[7]); *(LAS v4u*)(tp + HG_KH) = w; }
        __syncthreads();
        if (OUTPUT) {
            bf16* hx = g ? hx1 : hx0;
            f32x16 s = zero16();
#pragma unroll
            for (int ks = 0; ks < 8; ++ks) s = MFMA32(lds16(gb + HG_KT + fo.o_row + 32 * ks), lds16(gb + HG_QT + fo.o_row + 32 * ks), s);
#pragma unroll
            for (int i = 0; i < 16; ++i) s[i] = (crow(i, hh) <= r) ? s[i] : 0.f;
            f32x16 o = zero16();
#pragma unroll
            for (int sp = 0; sp < 2; ++sp) o = MFMA32(pack8(s, sp), ldstr2(gb + HG_V + fo.o_trp + vcol + (16 * sp * HG_LD) * 2, 8 * HG_LD * 2), o);
#pragma unroll
            for (int dt = 0; dt < 4; ++dt)
#pragma unroll
                for (int sp = 0; sp < 2; ++sp) { const f32x4 e0 = *(const LAS f32x4*)(gb + HG_EAM + o_h4 + (32 * dt + 16 * sp) * 4), e1 = *(const LAS f32x4*)(gb + HG_EAM + o_h4 + (32 * dt + 16 * sp + 8) * 4);
                    v4u pw; pw.x = cvtpk(St[dt][8 * sp] * e0[0], St[dt][8 * sp + 1] * e0[1]); pw.y = cvtpk(St[dt][8 * sp + 2] * e0[2], St[dt][8 * sp + 3] * e0[3]);
                    pw.z = cvtpk(St[dt][8 * sp + 4] * e1[0], St[dt][8 * sp + 5] * e1[1]); pw.w = cvtpk(St[dt][8 * sp + 6] * e1[2], St[dt][8 * sp + 7] * e1[3]);
                    o = MFMA32(lds8x2(gb + HG_QT + fo.o_perm + (32 * dt + 16 * sp) * 2), __builtin_bit_cast(bf16x8, pw), o); }
#pragma unroll
            for (int i = 0; i < 16; ++i) *(LAS float*)(OBb + o_obw + ((i & 3) + 8 * (i >> 2)) * 144) = o[i];
            LDS_WAIT(); CFENCE();
            { const f32x4 x0 = *(const LAS f32x4*)(OBb + o_obr), x1 = *(const LAS f32x4*)(OBb + o_obr + 16), x2 = *(const LAS f32x4*)(OBb + o_obr + 32), x3 = *(const LAS f32x4*)(OBb + o_obr + 48);
                const int tau = lns >> 1; const int t = seg_t0 + 32 * ci + (g ? 31 - tau : tau);
                bf16* op = hx + (size_t)(rowbase + t) * D + h * 128 + 32 * j + 16 * (lns & 1);
                v4u w0, w1; w0.x = pk2(x0[0], x0[1]); w0.y = pk2(x0[2], x0[3]); w0.z = pk2(x1[0], x1[1]); w0.w = pk2(x1[2], x1[3]); w1.x = pk2(x2[0], x2[1]); w1.y = pk2(x2[2], x2[3]); w1.z = pk2(x3[0], x3[1]); w1.w = pk2(x3[2], x3[3]);
                *(GAS v4u*)op = w0; *(GAS v4u*)(op + 8) = w1; }
            LDS_WAIT(); CFENCE();
        }
#pragma unroll
        for (int dt = 0; dt < 4; ++dt) {
#pragma unroll
            for (int q4 = 0; q4 < 4; ++q4) { const f32x4 dv = *(const LAS f32x4*)(gb + HG_AUX + 1024 + o_h4 + (32 * dt + 8 * q4) * 4);
#pragma unroll
                for (int e = 0; e < 4; ++e) St[dt][4 * q4 + e] *= dv[e]; }
#pragma unroll
            for (int sp = 0; sp < 2; ++sp) St[dt] = MFMA32(ldstr2(gb + HG_KH + fo.o_trn + (16 * sp * HG_LD + 32 * dt) * 2, 4 * HG_LD * 2), ldstr2(gb + HG_V + fo.o_trn + vcol + (16 * sp * HG_LD) * 2, 4 * HG_LD * 2), St[dt]);
        }
        __syncthreads();
    } }
    if (OUTPUT) item_headnorm(launder_v(tid_l), hx0, hx1, proj, NP_H, 4096, ghead + h * 128, aout, S0.rowbase, S0.t0, S0.nchunk * 32, h);
    if (!OUTPUT) {
        float* e = g ? st_out1 : st_out0; float* ep = e + (4 * hh) * 128 + 32 * j + r;
#pragma unroll
        for (int dt = 0; dt < 4; ++dt)
#pragma unroll
            for (int i = 0; i < 16; ++i) ep[(32 * dt + (i & 3) + 8 * (i >> 2)) * 128] = St[dt][i];
        if (tg >= 128) e[16384 + (tg & 127)] = atot;
    }
}

constexpr int PH_PER_LAYER = 11, PH_BASE = 2, N_PHASES = PH_BASE + DEPTH * PH_PER_LAYER;
#ifndef EN_GEMM
#define EN_GEMM 0xff
#endif
#ifndef EN_ML
#define EN_ML 3
#endif
#ifndef EN_HG
#define EN_HG 3
#endif
#ifndef EN_TOK
#define EN_TOK 1
#endif
#ifndef EN_MISC
#define EN_MISC 1
#endif
#ifndef PG_SP2
#define PG_SP2 true
#endif
#ifndef PG_ALIGN
#define PG_ALIGN true
#endif
#ifndef TIMER_MASK
#define TIMER_MASK 0ull
#endif
#ifndef TIMER_DIV
#define TIMER_DIV 20.0f
#endif
#ifndef MK_SPLIT
#define MK_SPLIT 0
#endif


__device__ __forceinline__ void phase_headnorm(Frame& F, const bf16* hf, const bf16* hb, const bf16* gate, int gpitch, int gcol0, const float* ghead, bf16* aout, int nrows) {
    const int tid = launder_v(F.tid); const int lane = tid & 63, wave = __builtin_amdgcn_readfirstlane(tid >> 6);
    const int gw = F.bid * NWAVES + wave, NGW = F.G * NWAVES;
    float gh[16];
#pragma unroll
    for (int e = 0; e < 16; ++e) gh[e] = ghead[lane * 16 + e];
    for (int row = gw; row < nrows; row += NGW) {
        const v4u a0 = *(const v4u*)(hf + (size_t)row * D + lane * 16), a1 = *(const v4u*)(hf + (size_t)row * D + lane * 16 + 8);
        const v4u b0 = *(const v4u*)(hb + (size_t)row * D + lane * 16), b1 = *(const v4u*)(hb + (size_t)row * D + lane * 16 + 8);
        const v4u g0 = *(const v4u*)(gate + (size_t)row * gpitch + gcol0 + lane * 16), g1 = *(const v4u*)(gate + (size_t)row * gpitch + gcol0 + lane * 16 + 8);
        float x[16], y[8], o[16]; unpack8(a0, y);
#pragma unroll
        for (int e = 0; e < 8; ++e) x[e] = y[e];
        unpack8(a1, y);
#pragma unroll
        for (int e = 0; e < 8; ++e) x[8 + e] = y[e];
        unpack8(b0, y);
#pragma unroll
        for (int e = 0; e < 8; ++e) x[e] += y[e];
        unpack8(b1, y);
#pragma unroll
        for (int e = 0; e < 8; ++e) x[8 + e] += y[e];
        float ss = 0.f;
#pragma unroll
        for (int e = 0; e < 16; ++e) ss += x[e] * x[e];
        ss += __shfl_xor(ss, 1); ss += __shfl_xor(ss, 2); ss += __shfl_xor(ss, 4);
        const float rs = rsqrtf(ss * (1.f / 128.f) + EPS);
        unpack8(g0, y);
#pragma unroll
        for (int e = 0; e < 8; ++e) o[e] = x[e] * rs * gh[e] * sigmoidf_(y[e]);
        unpack8(g1, y);
#pragma unroll
        for (int e = 0; e < 8; ++e) o[8 + e] = x[8 + e] * rs * gh[8 + e] * sigmoidf_(y[e]);
        v4u w0, w1; w0.x = pk2(o[0], o[1]); w0.y = pk2(o[2], o[3]); w0.z = pk2(o[4], o[5]); w0.w = pk2(o[6], o[7]); w1.x = pk2(o[8], o[9]); w1.y = pk2(o[10], o[11]); w1.z = pk2(o[12], o[13]); w1.w = pk2(o[14], o[15]);
        *(v4u*)(aout + (size_t)row * D + lane * 16) = w0; *(v4u*)(aout + (size_t)row * D + lane * 16 + 8) = w1;
    }
}

__device__ __forceinline__ void phase_conv(Frame& F, const bf16* proj, bf16* qkc, float* gates, const float* wconv, const float* bgate) {
    const int gt = F.bid * NTHR + F.tid, cp = gt & 127, rstep = (F.G * NTHR) >> 7;
    float w[3][8];
#pragma unroll
    for (int d = 0; d < 3; ++d)
#pragma unroll
        for (int e = 0; e < 8; ++e) w[d][e] = wconv[d * 1024 + cp * 8 + e];
    const float sc = cp >= 64 ? 0.125f : 1.0f;
    for (int row = gt >> 7; row < M_ALL; row += rstep) {
        int t, len; if (row < M_LAT) { t = row & (SEQ - 1); len = SEQ; } else { t = (row - M_LAT) & (CTXL - 1); len = CTXL; }
        const bf16* rp = proj + (size_t)row * NP_M + cp * 8;
        const v4u z = (v4u){0u, 0u, 0u, 0u};
        const v4u r0 = t > 0 ? *(const v4u*)(rp - NP_M) : z, r1 = *(const v4u*)rp, r2 = t + 1 < len ? *(const v4u*)(rp + NP_M) : z;
        float x0[8], x1[8], x2[8], o[8]; unpack8(r0, x0); unpack8(r1, x1); unpack8(r2, x2);
#pragma unroll
        for (int e = 0; e < 8; ++e) o[e] = sc * siluf_(w[0][e] * x0[e] + w[1][e] * x1[e] + w[2][e] * x2[e]);
        v4u q; q.x = pk2(o[0], o[1]); q.y = pk2(o[2], o[3]); q.z = pk2(o[4], o[5]); q.w = pk2(o[6], o[7]);
        *(v4u*)(qkc + (size_t)row * D + cp * 8) = q;
    }
    for (int i = gt; i < M_ALL * 32; i += F.G * NTHR) { const int c = i & 31; const float x = gates[i] + bgate[c];
        gates[i] = ((c >> 3) & 1) ? (fminf(x, 0.f) - __logf(1.f + __expf(-fabsf(x)))) : x; }
}

__device__ __forceinline__ void timer_stamp(unsigned char* lds_raw, bool add) {
    if (threadIdx.x == 0) { volatile LAS unsigned* tw = (volatile LAS unsigned*)((LAS unsigned char*)lds_raw + LDSCTL_OFF) + 32;
        const unsigned long long t = wall_clock64(); const unsigned long long last = ((unsigned long long)tw[1] << 32) | tw[0];
        if (add) { unsigned long long acc = ((unsigned long long)tw[3] << 32) | tw[2]; acc += t - last; tw[2] = (unsigned)acc; tw[3] = (unsigned)(acc >> 32); }
        tw[0] = (unsigned)t; tw[1] = (unsigned)(t >> 32); }
}

__device__ __forceinline__ void seg_of(bool odd, bool ctx_out, int q, int& t0, int& len) {
    int a, b; if (!ctx_out) { a = 2048; b = 2048; } else if (!odd) { a = 30 * 64; b = 34 * 64; } else { a = 60 * 32; b = 68 * 32; }
    t0 = (q == 0) ? 0 : (q == 1) ? a : (q == 2) ? a + b : a + 2 * b; len = (q == 0 || q == 3) ? a : b;
}

__device__ __forceinline__ Frame mkframe(const Args& args, unsigned char* lds_raw) {
    Frame F; int t = threadIdx.x; asm volatile("" : "+v"(t));
    F.lds = (LAS unsigned char*)lds_raw; F.tid = t; F.lane = t & 63; F.wave = __builtin_amdgcn_readfirstlane(t >> 6);
    int g = gridDim.x, b = blockIdx.x; asm volatile("" : "+s"(g), "+s"(b)); F.G = g; F.bid = b;
    const __attribute__((address_space(4))) Args* ap = (const __attribute__((address_space(4))) Args*)__builtin_amdgcn_kernarg_segment_ptr(); asm volatile("" : "+s"(ap));
    F.ws = ap->ws; F.in = ap->in; F.out = ap->out;
    return F;
}
#define PHASE_LOCALS \
    Frame F = mkframe(args, lds_raw); unsigned char* ws = F.ws; \
    float* modv = (float*)(ws + WS_MODV); bf16* U = (bf16*)(ws + WS_U); bf16* Y = (bf16*)(ws + WS_Y); bf16* PROJ = (bf16*)(ws + WS_ACT); bf16* HB = (bf16*)(ws + WS_ACT); \
    bf16* AMOE = (bf16*)(ws + WS_ACT); bf16* HMOE = (bf16*)(ws + WS_ACT + (size_t)MOE_ROWS * D * 2); \
    float* GATES = (float*)(ws + WS_GATES); float* LATC = (float*)(ws + WS_LATC); float* STATE = (float*)(ws + WS_STATE); \
    const int* pexp = (const int*)(ws + WS_SMALL + SM_PEXP); float* SA_U = (float*)(ws + WS_SMALL + SM_SAU); float* SA_U2 = (float*)(ws + WS_SMALL + SM_SAU2); float* SA_MOE = (float*)(ws + WS_GATES + GATES_SAMOE); \
    const float* SWL = (const float*)(ws + WS_SMALL + (odd ? SM_SWO : SM_SWE)); (void)SA_U; (void)SA_U2; (void)SA_MOE; (void)SWL; \
    unsigned char* wb = ws + (odd ? WS_WO : WS_WE); const float* mv = modv + (size_t)L * 9 * 6 * 1024; \
    (void)modv; (void)U; (void)Y; (void)PROJ; (void)HB; (void)AMOE; (void)HMOE; (void)GATES; (void)LATC; (void)STATE; (void)pexp; (void)wb; (void)mv;

__global__ void __launch_bounds__(NTHR, 2) fwd(Args args) {
    extern __shared__ __attribute__((aligned(16))) unsigned char lds_raw[];
    Frame F = mkframe(args, lds_raw);
    volatile LAS unsigned* LCTL = (volatile LAS unsigned*)(F.lds + LDSCTL_OFF);
    for (int u = F.tid; u < 128; u += NTHR) LCTL[u] = 0u;
    __syncthreads();
    XcdBarrier bar; bar.bar = (unsigned*)(F.ws + WS_CTL) + CW_BAR; bar.x = 0; bar.st = nullptr;
    if (args.use_bar) bar = xcd_barrier_post((unsigned*)(F.ws + WS_CTL) + CW_BAR, LCTL + 8);
    const int lo = args.ph_lo, hi = args.ph_hi;
#define IN(k) (lo <= (k) && (k) < hi)
#define SEAM(k) do { if ((k) + 1 < hi) xcd_barrier(bar.bar, bar.x, bar.st); if (TIMER_MASK != 0ull) timer_stamp(lds_raw, ((TIMER_MASK >> (k)) & 1ull) != 0ull); } while (0)
    if (TIMER_MASK != 0ull) timer_stamp(lds_raw, false);
    if (IN(0)) { const int L = 0; const bool odd = false; PHASE_LOCALS if (EN_MISC) phase_mods(F); __syncthreads(); if (EN_MISC) phase_wconv(F, 0); SEAM(0); }
    if (IN(1)) { const int L = 0; const bool odd = false; PHASE_LOCALS
        TokCfg T{}; T.lat_src_l = F.in[I_X]; T.lat_src_c = F.in[I_CTX]; T.src_f32 = 1; T.vna = modv + 0 * 1024; T.vnb = modv + 1 * 1024; T.u = U; T.u_fp8 = INPROJ_I8 ? 2 : 0; T.u_scale = SA_U; T.nrows = M_ALL;
        if (EN_TOK) phase_tok(F, T); __syncthreads(); if (EN_MISC) phase_wconv(F, 1); SEAM(1);
    }
    for (int L = 0; L < DEPTH; ++L) {
        const int pb = PH_BASE + L * PH_PER_LAYER; const bool odd = (L & 1) != 0; const int jl = L >> 1;
        const bool ctx_out = L < DEPTH - 1;
        if (IN(pb + 0)) { PHASE_LOCALS
            pg8::Order S; pg8::Gemm g;
#if INPROJ_I8
            if (!odd) { g = pg8::Gemm{U, (const bf16*)(wb + WE_IN), M_ALL, NIN_M, D}; S.init(M_ALL / 256, NIN_M, F.G, F.bid, nullptr, 0);
                pg8::EpiStoreI8 E{PROJ, NP_M, NP_M / 256, NP_M / 256, GATES, SA_U, SWL + SWE_IN}; if (EN_GEMM & (1 << 0)) pg8::gemm_phase<pg8::EpiStoreI8, pg8::Order, PG_ALIGN, PG_SP2, 2>(F.lds, g, S, E); }
            else { g = pg8::Gemm{U, (const bf16*)(wb + WOD_IN), M_ALL, NP_H, D}; S.init(M_ALL / 256, NP_H, F.G, F.bid, nullptr, 0);
                pg8::EpiStoreI8 E{PROJ, NP_H, NP_H / 256, -1, nullptr, SA_U, SWL + SWO_IN}; if (EN_GEMM & (1 << 1)) pg8::gemm_phase<pg8::EpiStoreI8, pg8::Order, PG_ALIGN, PG_SP2, 2>(F.lds, g, S, E); }
#else
            if (!odd) { g = pg8::Gemm{U, (const bf16*)(wb + WE_IN), M_ALL, NIN_M, D}; S.init(M_ALL / 256, NIN_M, F.G, F.bid, nullptr, 0);
                pg8::EpiStore E{PROJ, NP_M, NP_M / 256, NP_M / 256, GATES, 1.0f}; if (EN_GEMM & (1 << 0)) pg8::gemm_phase<pg8::EpiStore, pg8::Order, PG_ALIGN, PG_SP2>(F.lds, g, S, E); }
            else { g = pg8::Gemm{U, (const bf16*)(wb + WOD_IN), M_ALL, NP_H, D}; S.init(M_ALL / 256, NP_H, F.G, F.bid, nullptr, 0);
                pg8::EpiStore E{PROJ, NP_H, NP_H / 256, -1, nullptr, 1.0f}; if (EN_GEMM & (1 << 1)) pg8::gemm_phase<pg8::EpiStore, pg8::Order, PG_ALIGN, PG_SP2>(F.lds, g, S, E); }
#endif
            SEAM(pb + 0);
        }
        if (IN(pb + 1)) {
            if (!odd) { PHASE_LOCALS
                phase_conv(F, PROJ, (bf16*)(ws + WS_ACT + 400 * MiB), GATES, F.in[I_MWCONV] + (size_t)jl * 3 * 1024, F.in[I_MBGATE] + jl * 32); SEAM(pb + 1); }
        }
        if (IN(pb + 2)) { PHASE_LOCALS
            for (int id = F.bid; id < 256; id += F.G) {
                const int bh = id >> 2, p = id & 3, b = bh >> 3, h = bh & 7;
                MlSeg SG0, SG1;
                const int csz = odd ? 32 : 64;
                if (p == 0) { SG0 = MlSeg{M_LAT + b * CTXL, CTXL, 0, CTXL / csz}; SG1 = SG0; }
                else { int t0a, la, t0b, lb2; seg_of(odd, ctx_out, p - 1, t0a, la); seg_of(odd, ctx_out, 4 - p, t0b, lb2); SG0 = MlSeg{b * SEQ, SEQ, t0a, la / csz}; SG1 = MlSeg{b * SEQ, SEQ, t0b, lb2 / csz}; }
                if (!odd) { float* e0 = STATE + (size_t)((bh * 2 + 0) * 4 + p) * ML_STATE_F; float* e1 = STATE + (size_t)((bh * 2 + 1) * 4 + p) * ML_STATE_F;
                    if (EN_ML & 1) mlstm_item<false>(F, PROJ, (const bf16*)(ws + WS_ACT + 400 * MiB), GATES, (bf16*)(ws + WS_ACT + 536 * MiB), (bf16*)(ws + WS_Y), U, F.in[I_MGHEAD] + jl * 1024, h, SG0, SG1, nullptr, nullptr, 0, 0, e0, e1); }
                else { float* e0 = STATE + (size_t)((bh * 2 + 0) * 4 + p) * HG_STATE_F; float* e1 = STATE + (size_t)((bh * 2 + 1) * 4 + p) * HG_STATE_F;
                    if (EN_HG & 1) hgrn_item<false>(F, PROJ, U, (bf16*)(ws + WS_Y), U, F.in[I_HGHEAD] + jl * 1024, F.in[I_HBF] + (size_t)jl * 2048, F.in[I_HLB], jl, h, SG0, SG1, nullptr, nullptr, 0, 0, e0, e1); }
            }
            SEAM(pb + 2);
        }
        if (IN(pb + 3)) { PHASE_LOCALS
            const int nitems = ctx_out ? 320 : 256;
            for (int id = F.bid; id < nitems; id += F.G) {
                MlSeg SG0, SG1; int bh, npre0 = 0, npre1 = 0; const int csz = odd ? 32 : 64;
                if (id < 256) { int q; if (id < 128) { bh = id >> 1; q = (id & 1) ? 3 : 0; } else { bh = (id - 128) >> 1; q = 1 + (id & 1); } int t0q, lq; seg_of(odd, ctx_out, q, t0q, lq); SG0 = MlSeg{(bh >> 3) * SEQ, SEQ, t0q, lq / csz}; npre0 = q + 1; npre1 = 4 - q; }
                else { bh = id - 256; SG0 = MlSeg{M_LAT + (bh >> 3) * CTXL, CTXL, 0, CTXL / csz}; }
                SG1 = SG0;
                const int h = bh & 7;
                if (!odd) { const float* s0 = STATE + (size_t)((bh * 2 + 0) * 4) * ML_STATE_F; const float* s1 = STATE + (size_t)((bh * 2 + 1) * 4) * ML_STATE_F;
                    if (EN_ML & 2) mlstm_item<true>(F, PROJ, (const bf16*)(ws + WS_ACT + 400 * MiB), GATES, (bf16*)(ws + WS_ACT + 536 * MiB), (bf16*)(ws + WS_Y), U, F.in[I_MGHEAD] + jl * 1024, h, SG0, SG1, s0, s1, npre0, npre1, nullptr, nullptr); }
                else { const float* s0 = STATE + (size_t)((bh * 2 + 0) * 4) * HG_STATE_F; const float* s1 = STATE + (size_t)((bh * 2 + 1) * 4) * HG_STATE_F;
                    if (EN_HG & 2) hgrn_item<true>(F, PROJ, U, (bf16*)(ws + WS_Y), U, F.in[I_HGHEAD] + jl * 1024, F.in[I_HBF] + (size_t)jl * 2048, F.in[I_HLB], jl, h, SG0, SG1, s0, s1, npre0, npre1, nullptr, nullptr); }
            }
            SEAM(pb + 3);
        }
        if (IN(pb + 5)) { PHASE_LOCALS
            const int nM = (ctx_out ? M_ALL : M_LAT) / 256;
            pg8::Gemm g{U, (const bf16*)(wb + (odd ? WOD_OUT : WE_OUT)), nM * 256, D, D}; pg8::Order S; S.init(nM, D, F.G, F.bid, nullptr, 0);
            pg8::EpiStore E{Y, D, D / 256, -1, nullptr, 1.0f}; if (EN_GEMM & (1 << 2)) pg8::gemm_phase<pg8::EpiStore, pg8::Order, PG_ALIGN, PG_SP2>(F.lds, g, S, E);
            SEAM(pb + 5);
        }
        if (IN(pb + 6)) { PHASE_LOCALS
            TokCfg T{}; bf16* LAT16 = (bf16*)(ws + WS_ACT + 836 * MiB); T.src_f32 = (L == 0) ? 1 : 0; T.lat_src_l = (L == 0) ? (const void*)F.in[I_X] : (const void*)LAT16; T.lat_src_c = (L == 0) ? (const void*)F.in[I_CTX] : (const void*)LATC; T.lat_dst_l = LAT16; T.lat_dst_c = LATC;
            T.y = Y; T.y_perm = odd ? 1 : 0; T.vupd = mv + 2 * 1024; T.vna = mv + 3 * 1024; T.vnb = mv + 4 * 1024; T.u = U; T.u_fp8 = (UP_I8 && !odd) ? 2 : FFN_FP8_L(L); T.u_scale = SA_U2; T.route = odd ? 1 : 0; T.jr = jl; T.nrows = ctx_out ? M_ALL : M_LAT;
            if (EN_TOK) phase_tok(F, T);
            if (L >= 1 && L + 1 < DEPTH) { __syncthreads(); if (EN_MISC) phase_wconv(F, L + 1); }
            SEAM(pb + 6);
        }
        if (IN(pb + 7)) { PHASE_LOCALS
            if (odd) { if (EN_MISC) phase_moe_scatter(F, jl, ctx_out ? M_ALL : M_LAT, (const unsigned char*)U, (unsigned char*)AMOE, FFN_FP8_L(L) ? 1024 : 2048, nullptr, SA_MOE); SEAM(pb + 7); }
        }
        if (IN(pb + 8)) { PHASE_LOCALS
            if (!odd) { pg8::Gemm g{U, (const bf16*)(wb + WE_GU), M_ALL, NGU, D}; pg8::Order S; S.init(M_ALL / 256, NGU, F.G, F.bid, nullptr, 0);
#if UP_I8
                pg8::EpiSwiGLU8I E{(unsigned char*)HB, FF, SA_U2, SWL + SWE_GU, nullptr, 0, FFN_FP8_L(L) ? 0 : 1}; if (EN_GEMM & (1 << 3)) pg8::gemm_phase<pg8::EpiSwiGLU8I, pg8::Order, PG_ALIGN, PG_SP2, 2>(F.lds, g, S, E);
#else
                pg8::EpiSwiGLU8 E{(unsigned char*)HB, FF, 1.0f / WSCALE8}; if (EN_GEMM & (1 << 3)) pg8::gemm_phase<pg8::EpiSwiGLU8, pg8::Order, PG_ALIGN, PG_SP2, 1>(F.lds, g, S, E);
#endif
            }
            else { const int np = __builtin_amdgcn_readfirstlane(pexp[MOE_PANELS]);
                pg8::Gemm g{AMOE, (const bf16*)(wb + WOD_GU), np * 256, NGU, D}; pg8::Order S; S.init(np, NGU, F.G, F.bid, pexp, EGU_BYTES);
                pg8::EpiSwiGLU8 E{(unsigned char*)HMOE, FF, 1.0f / WSCALE8}; if (EN_GEMM & (1 << 4)) pg8::gemm_phase<pg8::EpiSwiGLU8, pg8::Order, PG_ALIGN, PG_SP2, 1>(F.lds, g, S, E); }
            SEAM(pb + 8);
        }
        if (IN(pb + 9)) { PHASE_LOCALS
            const bool f8 = FFN_FP8_L(L) != 0;
            if (!odd) { pg8::Gemm g{HB, (const bf16*)(wb + WE_DOWN), M_ALL, D, FF}; pg8::Order S; S.init(M_ALL / 256, D, F.G, F.bid, nullptr, 0);
                if (f8) { if ((FP8_LAYERS) & 0x5) { pg8::EpiStore E{Y, D, D / 256, -1, nullptr, 1.0f / WSCALE8}; if (EN_GEMM & (1 << 5)) pg8::gemm_phase<pg8::EpiStore, pg8::Order, PG_ALIGN, PG_SP2, 1>(F.lds, g, S, E); } }
                else { if ((~(FP8_LAYERS)) & 0x5) { pg8::EpiStore E{Y, D, D / 256, -1, nullptr, 1.0f}; if (EN_GEMM & (1 << 5)) pg8::gemm_phase<pg8::EpiStore, pg8::Order, PG_ALIGN, PG_SP2>(F.lds, g, S, E); } } }
            else { const int np = __builtin_amdgcn_readfirstlane(pexp[MOE_PANELS]);
                pg8::Gemm g{HMOE, (const bf16*)(wb + WOD_DOWN), np * 256, D, FF}; pg8::Order S; S.init(np, D, F.G, F.bid, pexp, EDOWN_BYTES);
                if (f8) { if ((FP8_LAYERS) & 0xA) { pg8::EpiStore E{AMOE, D, D / 256, -1, nullptr, 1.0f / WSCALE8}; if (EN_GEMM & (1 << 6)) pg8::gemm_phase<pg8::EpiStore, pg8::Order, PG_ALIGN, PG_SP2, 1>(F.lds, g, S, E); } }
                else { if ((~(FP8_LAYERS)) & 0xA) { pg8::EpiStore E{AMOE, D, D / 256, -1, nullptr, 1.0f}; if (EN_GEMM & (1 << 6)) pg8::gemm_phase<pg8::EpiStore, pg8::Order, PG_ALIGN, PG_SP2>(F.lds, g, S, E); } } }
            SEAM(pb + 9);
        }
        if (IN(pb + 10)) { PHASE_LOCALS
            TokCfg T{}; bf16* LAT16 = (bf16*)(ws + WS_ACT + 836 * MiB); T.lat_src_l = LAT16; T.lat_src_c = LATC; T.lat_dst_l = (L + 1 < DEPTH) ? (void*)LAT16 : (void*)F.out; T.lat_dst_c = LATC; T.dst_f32 = (L + 1 < DEPTH) ? 0 : 1;
            T.y = odd ? AMOE : Y; T.moe_combine = odd ? 1 : 0; T.vupd = mv + 5 * 1024; T.nrows = ctx_out ? M_ALL : M_LAT;
            if (L + 1 < DEPTH) { const float* mn = modv + (size_t)(L + 1) * 9 * 6 * 1024; T.vna = mn; T.vnb = mn + 1024; T.u = U; T.u_perm = ((L + 1) & 1) ? 1 : 0; T.u_fp8 = INPROJ_I8 ? 2 : 0; T.u_scale = SA_U; }
            if (EN_TOK) phase_tok(F, T);
            SEAM(pb + 10);
        }
    }
    if (TIMER_MASK != 0ull) { timer_stamp(lds_raw, ((TIMER_MASK >> (N_PHASES - 1)) & 1ull) != 0ull);
        if (blockIdx.x == 0 && threadIdx.x == 0) { volatile LAS unsigned* tw = (volatile LAS unsigned*)((LAS unsigned char*)lds_raw + LDSCTL_OFF) + 32; const unsigned long long acc = ((unsigned long long)tw[3] << 32) | tw[2];
            asm volatile("s_waitcnt vmcnt(0)" ::: "memory"); args.out[0] = (float)acc * 0.01f / TIMER_DIV; } }
#undef IN
#undef SEAM
}

extern "C" void kernel_launch(void* const* d_in, const int* in_sizes, int n_in, void* d_out, int out_size, void* d_ws, size_t ws_size, hipStream_t stream) {
    static int grid = 0;
    if (grid == 0) {
        if (n_in != 23 || out_size != M_LAT * D || ws_size < WS_END) { fprintf(stderr, "kernel_launch: unexpected shapes / workspace (n_in %d out %d ws %zu need %zu)\n", n_in, out_size, ws_size, (size_t)WS_END); grid = -1; return; }
        int dev = 0, cus = 0, per_cu = 0;
        if (hipGetDevice(&dev) != hipSuccess || hipDeviceGetAttribute(&cus, hipDeviceAttributeMultiprocessorCount, dev) != hipSuccess) { grid = -1; return; }
        if (hipFuncSetAttribute((const void*)fwd, hipFuncAttributeMaxDynamicSharedMemorySize, LDS_BYTES) != hipSuccess) { fprintf(stderr, "kernel_launch: hipFuncSetAttribute failed\n"); grid = -1; return; }
        if (hipOccupancyMaxActiveBlocksPerMultiprocessor(&per_cu, (const void*)fwd, NTHR, LDS_BYTES) != hipSuccess || per_cu < 1) fprintf(stderr, "kernel_launch: occupancy query reports %d\n", per_cu);
        (void)hipGetLastError();
        grid = cus;
    }
    if (grid < 0) return;
    (void)hipMemsetAsync((char*)d_ws + WS_CTL, 0, CTL_ZERO_BYTES, stream);
    Args a{};
    for (int i = 0; i < 23; ++i) a.in[i] = (const float*)d_in[i];
    a.out = (float*)d_out; a.ws = (unsigned char*)d_ws;
#if MK_SPLIT
    for (int p = 0; p < N_PHASES; ++p) { a.ph_lo = p; a.ph_hi = p + 1; a.use_bar = 0; a.pad = 0; hipLaunchKernelGGL(fwd, dim3(grid), dim3(NTHR), LDS_BYTES, stream, a); }
#else
    a.ph_lo = 0; a.ph_hi = N_PHASES; a.use_bar = 1; a.pad = 0;
    hipLaunchKernelGGL(fwd, dim3(grid), dim3(NTHR), LDS_BYTES, stream, a);
#endif
}
```

```cpp
#include <hip/hip_runtime.h>
#include <cstdio>
#include <cstdint>

namespace pg8 {
#define PG8_LAS __attribute__((address_space(3)))
typedef unsigned short bf16_t;
typedef short bf16x8 __attribute__((ext_vector_type(8)));
typedef float f32x4 __attribute__((ext_vector_type(4)));
typedef unsigned u32x4 __attribute__((ext_vector_type(4)));
typedef unsigned u32x2 __attribute__((ext_vector_type(2)));
typedef int v8i_t __attribute__((ext_vector_type(8)));
typedef int v4i_t __attribute__((ext_vector_type(4)));
constexpr int BM = 256, BK = 64, HALF = 128, HTB = HALF * BK * 2  , STAGE_BYTES = 8 * HTB, NXCD = 8, WGM = 8;

__host__ __device__ __forceinline__ int lds_byte(int r, int c) { const int st = (r >> 4) * 2 + (c >> 5), rr = r & 15, cc = c & 31, ob = rr * 64 + cc * 2; return st * 1024 + (ob ^ (((ob >> 9) & 1) << 5)); }
__host__ __device__ __forceinline__ void stage_rc(int b, int& R, int& C) { const int st = b / 1024, sb = b % 1024, swz = sb ^ (((sb >> 9) & 1) << 5); R = (st >> 1) * 16 + swz / 64; C = (st & 1) * 32 + (swz % 64) / 2; }
__host__ __device__ __forceinline__ int perm32(int rho) { const int n = rho >> 4, i = rho & 15; return 8 * (i >> 2) + 4 * n + (i & 3); }

struct Unit { int pm, pn; };
struct Gemm { const bf16_t* A; const bf16_t* Bt; int M, N, K; };

struct Order {
    int nM, nN, nwg, G, c; const int* pexp; size_t bstride;
    __device__ void init(int nM_, int N, int G_, int c_, const int* pexp_, size_t bstride_) { nM = nM_; nN = N / BM; nwg = nM * nN; G = G_; c = c_; pexp = pexp_; bstride = bstride_; }
    __device__ bool next(int i, Unit& u) const {
        const long L = (long)i * G + c; if (L >= nwg) return false;
        int wgid = (int)L; { const int q = nwg / NXCD, r = nwg % NXCD, xcd = wgid % NXCD, off = wgid / NXCD; wgid = (xcd < r ? xcd * (q + 1) : r * (q + 1) + (xcd - r) * q) + off; }
        const int nig = WGM * nN, gid = wgid / nig, fm = gid * WGM, gsz = (nM - fm) < WGM ? (nM - fm) : WGM;
        u.pm = fm + ((wgid % nig) % gsz); u.pn = (wgid % nig) / gsz; return true;
    }
    __device__ __forceinline__ size_t boff(const Unit& u) const { return pexp ? (size_t)__builtin_amdgcn_readfirstlane(pexp[u.pm]) * bstride : (size_t)0; }
    __device__ __forceinline__ void a_ready(const Unit&) const {}
    __device__ __forceinline__ void done(const Unit&) const {}
};

__device__ __forceinline__ unsigned cvt_pk_bf16(float lo, float hi) { unsigned r; asm volatile("v_cvt_pk_bf16_f32 %0, %1, %2" : "=v"(r) : "v"(lo), "v"(hi)); return r; }

struct EpiStore {
    static constexpr bool PERM = true, AFTER_DRAIN = false;
    bf16_t* O; int ldc; int ncol_tiles; int gate_pn; float* gates; float oscale;
    __device__ __forceinline__ void operator()(const f32x4 (&acc)[2][2][4][2], const Unit& u, int wr, int wc, int fr, int fq) const {
        const int row0 = u.pm * BM + wr * 64 + fr;
        if (u.pn < ncol_tiles) {
            const int col0 = u.pn * BM + wc * 32 + 8 * fq;
#pragma unroll
            for (int ai = 0; ai < 2; ++ai)
#pragma unroll
                for (int m = 0; m < 4; ++m) { bf16_t* rowp = O + (size_t)(row0 + ai * HALF + m * 16) * ldc + col0;
#pragma unroll
                    for (int bj = 0; bj < 2; ++bj) { const f32x4 v0 = acc[ai][bj][m][0] * oscale, v1 = acc[ai][bj][m][1] * oscale;
                        u32x4 w; w.x = cvt_pk_bf16(v0[0], v0[1]); w.y = cvt_pk_bf16(v0[2], v0[3]); w.z = cvt_pk_bf16(v1[0], v1[1]); w.w = cvt_pk_bf16(v1[2], v1[3]);
                        *(u32x4*)(rowp + bj * HALF) = w; } }
        } else if (u.pn == gate_pn && wc == 0) {
#pragma unroll
            for (int ai = 0; ai < 2; ++ai)
#pragma unroll
                for (int m = 0; m < 4; ++m) { float* rowp = gates + (size_t)(row0 + ai * HALF + m * 16) * 32 + 8 * fq;
                    *(f32x4*)(rowp) = acc[ai][0][m][0]; *(f32x4*)(rowp + 4) = acc[ai][0][m][1]; }
        }
    }
};
struct EpiSwiGLU {
    static constexpr bool PERM = true, AFTER_DRAIN = false;
    bf16_t* O; int ldc;
    __device__ __forceinline__ void operator()(const f32x4 (&acc)[2][2][4][2], const Unit& u, int wr, int wc, int fr, int fq) const {
        const int row0 = u.pm * BM + wr * 64 + fr, col0 = u.pn * HALF + wc * 32 + 8 * fq;
#pragma unroll
        for (int ai = 0; ai < 2; ++ai)
#pragma unroll
            for (int m = 0; m < 4; ++m) { bf16_t* rowp = O + (size_t)(row0 + ai * HALF + m * 16) * ldc + col0; float r[8];
#pragma unroll
                for (int n = 0; n < 2; ++n)
#pragma unroll
                    for (int j = 0; j < 4; ++j) { const float g = acc[ai][0][m][n][j], up = acc[ai][1][m][n][j]; r[n * 4 + j] = g * __builtin_amdgcn_rcpf(1.0f + __expf(-g)) * up; }
                u32x4 w; w.x = cvt_pk_bf16(r[0], r[1]); w.y = cvt_pk_bf16(r[2], r[3]); w.z = cvt_pk_bf16(r[4], r[5]); w.w = cvt_pk_bf16(r[6], r[7]);
                *(u32x4*)(rowp) = w; }
    }
};
struct EpiSwiGLU8 {
    static constexpr bool PERM = true, AFTER_DRAIN = false;
    unsigned char* O; int ldc; float ascale;
    __device__ __forceinline__ void operator()(const f32x4 (&acc)[2][2][4][2], const Unit& u, int wr, int wc, int fr, int fq) const {
        typedef float f32x2 __attribute__((ext_vector_type(2)));
        const int row0 = u.pm * BM + wr * 64 + fr, col0 = u.pn * HALF + wc * 32 + 8 * fq;
        const float c1 = -ascale * 1.4426950408889634f, c2 = ascale * ascale;
#pragma unroll
        for (int ai = 0; ai < 2; ++ai)
#pragma unroll
            for (int m = 0; m < 4; ++m) { unsigned char* rowp = O + (size_t)(row0 + ai * HALF + m * 16) * ldc + col0; f32x2 r[4];
#pragma unroll
                for (int n = 0; n < 2; ++n)
#pragma unroll
                    for (int j = 0; j < 2; ++j) { const f32x2 ag = {acc[ai][0][m][n][2 * j], acc[ai][0][m][n][2 * j + 1]}, au = {acc[ai][1][m][n][2 * j], acc[ai][1][m][n][2 * j + 1]};
                        const f32x2 t = ag * c1; f32x2 d = {__builtin_amdgcn_exp2f(t.x), __builtin_amdgcn_exp2f(t.y)}; d = d + 1.0f;
                        const f32x2 q = {__builtin_amdgcn_rcpf(d.x), __builtin_amdgcn_rcpf(d.y)};
                        r[n * 2 + j] = ((ag * au) * q) * c2; }
                u32x2 w; unsigned t = 0; t = __builtin_amdgcn_cvt_pk_fp8_f32(r[0].x, r[0].y, t, false); t = __builtin_amdgcn_cvt_pk_fp8_f32(r[1].x, r[1].y, t, true); w.x = t;
                t = 0; t = __builtin_amdgcn_cvt_pk_fp8_f32(r[2].x, r[2].y, t, false); t = __builtin_amdgcn_cvt_pk_fp8_f32(r[3].x, r[3].y, t, true); w.y = t;
                *(u32x2*)(rowp) = w; }
    }
};
struct EpiStoreI8 {
    static constexpr bool PERM = true, AFTER_DRAIN = false;
    bf16_t* O; int ldc; int ncol_tiles; int gate_pn; float* gates; const float* sa; const float* sw;
    __device__ __forceinline__ void operator()(const f32x4 (&acc)[2][2][4][2], const Unit& u, int wr, int wc, int fr, int fq) const {
        const int row0 = u.pm * BM + wr * 64 + fr;
        if (u.pn < ncol_tiles) {
            const int col0 = u.pn * BM + wc * 32 + 8 * fq;
            f32x4 cs[2][2];
#pragma unroll
            for (int bj = 0; bj < 2; ++bj) { cs[bj][0] = *(const f32x4*)(sw + col0 + bj * HALF); cs[bj][1] = *(const f32x4*)(sw + col0 + bj * HALF + 4); }
#pragma unroll
            for (int ai = 0; ai < 2; ++ai)
#pragma unroll
                for (int m = 0; m < 4; ++m) { const int row = row0 + ai * HALF + m * 16; const float rs = sa[row]; bf16_t* rowp = O + (size_t)row * ldc + col0;
#pragma unroll
                    for (int bj = 0; bj < 2; ++bj) { const v4i_t i0 = __builtin_bit_cast(v4i_t, acc[ai][bj][m][0]), i1 = __builtin_bit_cast(v4i_t, acc[ai][bj][m][1]);
                        const f32x4 v0 = __builtin_convertvector(i0, f32x4) * cs[bj][0] * rs, v1 = __builtin_convertvector(i1, f32x4) * cs[bj][1] * rs;
                        u32x4 w; w.x = cvt_pk_bf16(v0[0], v0[1]); w.y = cvt_pk_bf16(v0[2], v0[3]); w.z = cvt_pk_bf16(v1[0], v1[1]); w.w = cvt_pk_bf16(v1[2], v1[3]);
                        *(u32x4*)(rowp + bj * HALF) = w; } }
        } else if (u.pn == gate_pn && wc == 0) {
            const int col0 = u.pn * BM + 8 * fq; const f32x4 c0 = *(const f32x4*)(sw + col0), c1 = *(const f32x4*)(sw + col0 + 4);
#pragma unroll
            for (int ai = 0; ai < 2; ++ai)
#pragma unroll
                for (int m = 0; m < 4; ++m) { const int row = row0 + ai * HALF + m * 16; const float rs = sa[row]; float* rowp = gates + (size_t)row * 32 + 8 * fq;
                    *(f32x4*)(rowp) = __builtin_convertvector(__builtin_bit_cast(v4i_t, acc[ai][0][m][0]), f32x4) * c0 * rs; *(f32x4*)(rowp + 4) = __builtin_convertvector(__builtin_bit_cast(v4i_t, acc[ai][0][m][1]), f32x4) * c1 * rs; }
        }
    }
};
struct EpiSwiGLU8I {
    static constexpr bool PERM = true, AFTER_DRAIN = false;
    unsigned char* O; int ldc; const float* sa; const float* sw; const int* pexp; int swstride; int obf16;
    __device__ __forceinline__ void operator()(const f32x4 (&acc)[2][2][4][2], const Unit& u, int wr, int wc, int fr, int fq) const {
        typedef float f32x2 __attribute__((ext_vector_type(2)));
        const int row0 = u.pm * BM + wr * 64 + fr, col0 = u.pn * HALF + wc * 32 + 8 * fq;
        const float* swe = sw + (pexp ? (size_t)__builtin_amdgcn_readfirstlane(pexp[u.pm]) * swstride : (size_t)0) + u.pn * BM + wc * 32 + 8 * fq;
        const f32x4 g0 = *(const f32x4*)(swe), g1 = *(const f32x4*)(swe + 4), u0 = *(const f32x4*)(swe + HALF), u1 = *(const f32x4*)(swe + HALF + 4);
        const float gs[8] = {g0[0], g0[1], g0[2], g0[3], g1[0], g1[1], g1[2], g1[3]}, us[8] = {u0[0], u0[1], u0[2], u0[3], u1[0], u1[1], u1[2], u1[3]};
#pragma unroll
        for (int ai = 0; ai < 2; ++ai)
#pragma unroll
            for (int m = 0; m < 4; ++m) { const int row = row0 + ai * HALF + m * 16; const float rs = sa[row]; unsigned char* rowp = O + (size_t)row * ldc + col0; float r[8];
#pragma unroll
                for (int n = 0; n < 2; ++n) { const v4i_t ig = __builtin_bit_cast(v4i_t, acc[ai][0][m][n]), iu = __builtin_bit_cast(v4i_t, acc[ai][1][m][n]);
#pragma unroll
                    for (int j = 0; j < 4; ++j) { const float g = (float)ig[j] * (gs[4 * n + j] * rs), up = (float)iu[j] * (us[4 * n + j] * rs);
                        r[4 * n + j] = g * __builtin_amdgcn_rcpf(1.0f + __builtin_amdgcn_exp2f(g * -1.4426950408889634f)) * up; } }
                if (obf16) { u32x4 w; w.x = cvt_pk_bf16(r[0], r[1]); w.y = cvt_pk_bf16(r[2], r[3]); w.z = cvt_pk_bf16(r[4], r[5]); w.w = cvt_pk_bf16(r[6], r[7]);
                    *(u32x4*)((bf16_t*)O + (size_t)row * ldc + col0) = w; }
                else { u32x2 w; unsigned t = 0; t = __builtin_amdgcn_cvt_pk_fp8_f32(r[0], r[1], t, false); t = __builtin_amdgcn_cvt_pk_fp8_f32(r[2], r[3], t, true); w.x = t;
                    t = 0; t = __builtin_amdgcn_cvt_pk_fp8_f32(r[4], r[5], t, false); t = __builtin_amdgcn_cvt_pk_fp8_f32(r[6], r[7], t, true); w.y = t;
                    *(u32x2*)(rowp) = w; } }
    }
};

template <bool FP8> struct Frag;
template <> struct Frag<false> { bf16x8 v[2]; };
template <> struct Frag<true> { v8i_t v; };
template <bool FP8> __device__ __forceinline__ void ldfrag(Frag<FP8>& f, const PG8_LAS unsigned char* p) {
    if constexpr (FP8) { const bf16x8 a = *(const PG8_LAS bf16x8*)p, b = *(const PG8_LAS bf16x8*)(p + 1024); f.v = __builtin_bit_cast(v8i_t, __builtin_shufflevector(a, b, 0, 1, 2, 3, 4, 5, 6, 7, 8, 9, 10, 11, 12, 13, 14, 15)); }
    else { f.v[0] = *(const PG8_LAS bf16x8*)p; f.v[1] = *(const PG8_LAS bf16x8*)(p + 1024); }
}
template <class Epi, class Sched, bool ALIGN_EPI = false, bool SP2 = false, int MODE = 0  >
__device__ __forceinline__ void gemm_phase(PG8_LAS unsigned char* lds, const Gemm g, const Sched& S, const Epi& E) {
    int tid = threadIdx.x; asm volatile("" : "+v"(tid)); const int wid = __builtin_amdgcn_readfirstlane(tid >> 6), lane = tid & 63, wr = wid >> 2, wc = wid & 3, fr = lane & 15, fq = lane >> 4;
    constexpr bool FP8 = (MODE == 1);
    const int K = g.K, rowb = (MODE != 0) ? K : 2 * K, nt = rowb / 128;
    unsigned voffA[2], voffB[2];
#pragma unroll
    for (int i = 0; i < 2; ++i) { int R, C; stage_rc(tid * 16 + i * 8192, R, C); const int Rb = Epi::PERM ? ((R & ~31) + perm32(R & 31)) : R;
        voffA[i] = (unsigned)(R * rowb + C * 2); voffB[i] = (unsigned)(Rb * rowb + C * 2); }
    const size_t kstep = (size_t)(BK * 2);
    const size_t hstep = (size_t)HALF * rowb;
    const size_t tstep = 2 * hstep;
    const unsigned ldsw = (unsigned)wid * 1024u;
    const int aoff = lds_byte(wr * 64 + fr, fq * 8), boff = lds_byte(wc * 32 + fr, fq * 8);
#define PG8_SA(b, h) (((b) * 2 + (h)) * HTB)
#define PG8_SB(b, h) ((4 + (b) * 2 + (h)) * HTB)
#define PG8_STAGE(bufoff, gbase, voff) do { _Pragma("unroll") for (int _i = 0; _i < 2; ++_i) \
        __builtin_amdgcn_global_load_lds((const unsigned*)((const char*)(gbase) + (voff)[_i]), (PG8_LAS unsigned*)(lds + (bufoff) + ldsw + _i * 8192), 16, 0, 0); } while (0)
#define PG8_LDA(dst, b, h) do { _Pragma("unroll") for (int m = 0; m < 4; ++m) ldfrag<FP8>(dst[m], lds + PG8_SA(b, h) + aoff + m * 2048); } while (0)
#define PG8_LDB(dst, b, h) do { _Pragma("unroll") for (int n = 0; n < 2; ++n) ldfrag<FP8>(dst[n], lds + PG8_SB(b, h) + boff + n * 2048); } while (0)
#define PG8_MMA(ai, bj, At, Bt) do { __builtin_amdgcn_s_setprio(1); _Pragma("unroll") for (int m = 0; m < 4; ++m) _Pragma("unroll") for (int n = 0; n < 2; ++n) { \
        if constexpr (FP8) { asm volatile("v_mfma_f32_16x16x128_f8f6f4 %0, %1, %2, %0" : "+v"(acc[ai][bj][m][n]) : "v"(Bt[n].v), "v"(At[m].v)); }     \
        else if constexpr (MODE == 2) { _Pragma("unroll") for (int k = 0; k < 2; ++k) acc[ai][bj][m][n] = __builtin_bit_cast(f32x4, __builtin_amdgcn_mfma_i32_16x16x64_i8(__builtin_bit_cast(v4i_t, Bt[n].v[k]), __builtin_bit_cast(v4i_t, At[m].v[k]), __builtin_bit_cast(v4i_t, acc[ai][bj][m][n]), 0, 0, 0)); } \
        else { _Pragma("unroll") for (int k = 0; k < 2; ++k) acc[ai][bj][m][n] = __builtin_amdgcn_mfma_f32_16x16x32_bf16(Bt[n].v[k], At[m].v[k], acc[ai][bj][m][n], 0, 0, 0); } } __builtin_amdgcn_s_setprio(0); } while (0)
#define PG8_WAIT_V(n) asm volatile("s_waitcnt vmcnt(" #n ")" ::: "memory")
#define PG8_WAIT_L(n) asm volatile("s_waitcnt lgkmcnt(" #n ")" ::: "memory")
#define PG8_BAR __builtin_amdgcn_s_barrier()
#define PG8_SCHED __builtin_amdgcn_sched_barrier(0)
    Unit cur, nxt; int ui = 0;
    if (!S.next(0, cur)) return;
    f32x4 acc[2][2][4][2];
#pragma unroll
    for (int a = 0; a < 2; ++a)
#pragma unroll
        for (int b = 0; b < 2; ++b)
#pragma unroll
            for (int m = 0; m < 4; ++m)
#pragma unroll
                for (int n = 0; n < 2; ++n) acc[a][b][m][n] = (f32x4){0.f, 0.f, 0.f, 0.f};
    Frag<FP8> At[4], B0[2], B1[2];
    const char* cA = (const char*)g.A + (size_t)cur.pm * tstep; const char* cB = (const char*)g.Bt + S.boff(cur) + (size_t)cur.pn * tstep;
    S.a_ready(cur);
    if constexpr (SP2) {
        PG8_STAGE(PG8_SB(0, 0), cB, voffB); PG8_STAGE(PG8_SB(0, 1), cB + hstep, voffB); PG8_STAGE(PG8_SA(0, 0), cA, voffA); PG8_STAGE(PG8_SA(0, 1), cA + hstep, voffA);
        if (wr == 1) PG8_BAR;
        PG8_WAIT_V(2); PG8_BAR;
        PG8_STAGE(PG8_SB(1, 0), cB + kstep, voffB); PG8_STAGE(PG8_SA(1, 0), cA + kstep, voffA); PG8_STAGE(PG8_SB(1, 1), cB + hstep + kstep, voffB);
        PG8_WAIT_V(6); PG8_BAR;
    } else {
        PG8_STAGE(PG8_SB(0, 0), cB, voffB); PG8_STAGE(PG8_SA(0, 0), cA, voffA); PG8_STAGE(PG8_SB(0, 1), cB + hstep, voffB); PG8_STAGE(PG8_SA(0, 1), cA + hstep, voffA);
        if (wr == 1) PG8_BAR;
        PG8_WAIT_V(4); PG8_BAR;
        PG8_STAGE(PG8_SB(1, 0), cB + kstep, voffB); PG8_STAGE(PG8_SA(1, 0), cA + kstep, voffA); PG8_STAGE(PG8_SB(1, 1), cB + hstep + kstep, voffB);
        PG8_WAIT_V(6); PG8_BAR;
    }
    for (;;) {
        const bool has_next = S.next(ui + 1, nxt);
        const char* nA = has_next ? (const char*)g.A + (size_t)nxt.pm * tstep : cA; const char* nB = has_next ? (const char*)g.Bt + S.boff(nxt) + (size_t)nxt.pn * tstep : cB;
#pragma unroll 1
        for (int t = 0; t < nt; t += 2) {
            const bool last = (t == nt - 2);
            const char* a1 = cA + (size_t)(t + 1) * kstep;
            const char* a2 = last ? nA : cA + (size_t)(t + 2) * kstep; const char* b2 = last ? nB : cB + (size_t)(t + 2) * kstep;
            const char* a3 = a2 + kstep; const char* b3 = b2 + kstep;
            if (last && has_next) S.a_ready(nxt);
            if constexpr (SP2) {
            PG8_LDB(B0, 0, 0); PG8_LDB(B1, 0, 1); PG8_SCHED; PG8_LDA(At, 0, 0); PG8_STAGE(PG8_SA(1, 1), a1 + hstep, voffA);
            PG8_WAIT_V(8); PG8_WAIT_L(0); PG8_BAR; PG8_MMA(0, 0, At, B0); PG8_MMA(0, 1, At, B1); PG8_BAR; PG8_SCHED;
            PG8_LDA(At, 0, 1); PG8_STAGE(PG8_SB(0, 0), b2, voffB); PG8_STAGE(PG8_SB(0, 1), b2 + hstep, voffB); PG8_STAGE(PG8_SA(0, 0), a2, voffA);
            PG8_WAIT_V(8); PG8_WAIT_L(0); PG8_BAR; PG8_MMA(1, 0, At, B0); PG8_MMA(1, 1, At, B1); PG8_BAR; PG8_SCHED;
            PG8_LDB(B0, 1, 0); PG8_LDB(B1, 1, 1); PG8_SCHED; PG8_LDA(At, 1, 0); PG8_STAGE(PG8_SA(0, 1), a2 + hstep, voffA);
            PG8_WAIT_V(8); PG8_WAIT_L(0); PG8_BAR; PG8_MMA(0, 0, At, B0); PG8_MMA(0, 1, At, B1); PG8_BAR; PG8_SCHED;
            PG8_LDA(At, 1, 1); PG8_STAGE(PG8_SB(1, 0), b3, voffB); PG8_STAGE(PG8_SB(1, 1), b3 + hstep, voffB); PG8_STAGE(PG8_SA(1, 0), a3, voffA);
            PG8_WAIT_V(8); PG8_WAIT_L(0); PG8_BAR; PG8_MMA(1, 0, At, B0); PG8_MMA(1, 1, At, B1); PG8_BAR; PG8_SCHED;
            } else {
            PG8_LDB(B0, 0, 0); PG8_SCHED; PG8_LDA(At, 0, 0); PG8_STAGE(PG8_SA(1, 1), a1 + hstep, voffA);
            PG8_WAIT_L(8); PG8_BAR; PG8_WAIT_L(0); PG8_MMA(0, 0, At, B0); PG8_BAR; PG8_SCHED;
            PG8_LDB(B1, 0, 1); PG8_STAGE(PG8_SB(0, 0), b2, voffB);
            PG8_BAR; PG8_WAIT_L(0); PG8_MMA(0, 1, At, B1); PG8_BAR;
            PG8_LDA(At, 0, 1); PG8_STAGE(PG8_SA(0, 0), a2, voffA);
            PG8_BAR; PG8_WAIT_L(0); PG8_MMA(1, 0, At, B0); PG8_BAR; PG8_SCHED;
            PG8_STAGE(PG8_SB(0, 1), b2 + hstep, voffB);
            PG8_WAIT_V(6); PG8_BAR; PG8_MMA(1, 1, At, B1); PG8_BAR;
            PG8_LDB(B0, 1, 0); PG8_SCHED; PG8_LDA(At, 1, 0); PG8_STAGE(PG8_SA(0, 1), a2 + hstep, voffA);
            PG8_WAIT_L(8); PG8_BAR; PG8_WAIT_L(0); PG8_MMA(0, 0, At, B0); PG8_BAR; PG8_SCHED;
            PG8_LDB(B1, 1, 1); PG8_STAGE(PG8_SB(1, 0), b3, voffB);
            PG8_BAR; PG8_WAIT_L(0); PG8_MMA(0, 1, At, B1); PG8_BAR;
            PG8_LDA(At, 1, 1); PG8_STAGE(PG8_SA(1, 0), a3, voffA);
            PG8_BAR; PG8_WAIT_L(0); PG8_MMA(1, 0, At, B0); PG8_BAR; PG8_SCHED;
            PG8_STAGE(PG8_SB(1, 1), b3 + hstep, voffB);
            PG8_WAIT_V(6); PG8_BAR; PG8_MMA(1, 1, At, B1); PG8_BAR;
            }
        }
        if constexpr (ALIGN_EPI) { if (wr == 0) PG8_BAR; }
        if constexpr (FP8) { asm volatile("s_nop 15\n\ts_nop 15" ::: "memory"); }
        if constexpr (!Epi::AFTER_DRAIN) { E(acc, cur, wr, wc, fr, fq); S.done(cur); }
        if (!has_next) break;
#pragma unroll
        for (int a = 0; a < 2; ++a)
#pragma unroll
            for (int b = 0; b < 2; ++b)
#pragma unroll
                for (int m = 0; m < 4; ++m)
#pragma unroll
                    for (int n = 0; n < 2; ++n) acc[a][b][m][n] = (f32x4){0.f, 0.f, 0.f, 0.f};
        cur = nxt; cA = nA; cB = nB; ++ui;
        if constexpr (ALIGN_EPI) { if (wr == 1) PG8_BAR; }
    }
    PG8_WAIT_V(0);
    if constexpr (!ALIGN_EPI) { if (wr == 0) PG8_BAR; }
    PG8_BAR;
    if constexpr (Epi::AFTER_DRAIN) { E.fused(acc, cur, wr, wc, fr, fq, lds, wid, lane); S.done(cur); }
#undef PG8_SA
#undef PG8_SB
#undef PG8_STAGE
#undef PG8_LDA
#undef PG8_LDB
#undef PG8_MMA
#undef PG8_WAIT_V
#undef PG8_WAIT_L
#undef PG8_BAR
#undef PG8_SCHED
}
}

constexpr int D = 1024, NB = 8, SEQ = 8192, CTXL = 256, DEPTH = 4, GRIDW = 64, ROWS_G = SEQ / GRIDW  ;
constexpr int M_LAT = NB * SEQ  , M_CTX = NB * CTXL  , M_ALL = M_LAT + M_CTX  ;
constexpr int NHEAD = 8, M_DK = 64, M_DV = 128, H_DK = 128, H_DV = 128;
constexpr int NP_M = 3072, NIN_M = 3328, NW_M = 3104, NP_H = 5120;
constexpr int FF = 2816, NGU = 2 * FF, NEXP = 8;
constexpr int MOE_ROWS = 137216, MOE_PANELS = MOE_ROWS / 256;
constexpr float EPS = 1e-6f;
constexpr int NWAVES = 8, NTHR = 512;

constexpr size_t MiB = 1u << 20;
constexpr size_t WS_CTL = 0, CTL_ZERO_BYTES = 80 * 1024;
constexpr size_t WS_MODV = 1 * MiB;
constexpr size_t WS_SMALL = 2 * MiB;
constexpr size_t WS_LATC = 3 * MiB;
constexpr size_t WS_WE = 11 * MiB;
constexpr size_t WS_WO = 37 * MiB;
constexpr size_t WS_U = 181 * MiB;
constexpr size_t WS_GATES = 313 * MiB;
constexpr size_t WS_STATE = 322 * MiB;
constexpr size_t WS_ROUTE = 362 * MiB;
constexpr size_t WS_ACT = 364 * MiB;
constexpr size_t WS_Y = WS_ACT + 700 * MiB;
constexpr size_t WS_END = WS_ACT + 1005 * MiB;
constexpr size_t WE_IN = 0, WE_OUT = 7 * MiB, WE_GU = 9 * MiB, WE_DOWN = 20 * MiB;
constexpr size_t WOD_IN = 0, WOD_OUT = 10 * MiB, WOD_GU = 12 * MiB, WOD_DOWN = 100 * MiB;
constexpr size_t EGU_BYTES = (size_t)NGU * D * 2, EDOWN_BYTES = (size_t)D * FF * 2;
static_assert(WOD_GU + 8 * EGU_BYTES <= WOD_DOWN && WOD_DOWN + 8 * EDOWN_BYTES <= 144 * MiB, "odd weights map");
static_assert((size_t)NIN_M * D * 2 <= 7 * MiB && WE_GU + EGU_BYTES <= WE_DOWN && WE_DOWN + EDOWN_BYTES <= 26 * MiB, "even weights map");
static_assert((size_t)M_ALL * NP_H * 2 <= 700 * MiB && (size_t)MOE_ROWS * D * 2 + (size_t)MOE_ROWS * FF * 2 <= 1005 * MiB && 700 * MiB + (size_t)M_ALL * D * 2 <= 1005 * MiB, "act map");
constexpr int CW_BAR = 4096;
constexpr int CW_ECNT = 8192;
constexpr int CW_DBG = 16384;
constexpr size_t RT_E = 0;
constexpr size_t RT_R = 512 * 1024;
constexpr size_t RT_W = 512 * 1024 + 1024 * 1024;
constexpr size_t SM_LB = 0;
constexpr size_t SM_PEXP = 64 * 1024;
constexpr size_t SM_EBASE = 96 * 1024;
constexpr size_t SM_SAU = 128 * 1024;
constexpr size_t SM_SAU2 = 400 * 1024;
constexpr size_t SM_SWE = 672 * 1024;
constexpr size_t SM_SWO = 712 * 1024;
constexpr int SWE_IN = 0, SWE_GU = 3328, SWO_IN = 0, SWO_GU = 5120;
static_assert(SM_SAU + (size_t)M_ALL * 4 <= SM_SAU2 && SM_SAU2 + (size_t)M_ALL * 4 <= SM_SWE && SM_SWE + (3328 + 5632) * 4 <= SM_SWO && SM_SWO + (5120 + 8 * 5632) * 4 <= 1024 * 1024, "small region map");
constexpr size_t GATES_SAMOE = (size_t)M_ALL * 32 * 4;
static_assert(GATES_SAMOE + (size_t)MOE_ROWS * 4 <= 9 * MiB, "gates region map");

constexpr int LDS_MAIN = 147456;
constexpr int LDSCTL_OFF = LDS_MAIN;
constexpr int LDS_BYTES = LDS_MAIN + 512;

#define GAS __attribute__((address_space(1)))
#define LAS __attribute__((address_space(3)))
typedef unsigned short bf16;
typedef unsigned v4u __attribute__((ext_vector_type(4)));
typedef unsigned v2u __attribute__((ext_vector_type(2)));
typedef float f32x4 __attribute__((ext_vector_type(4)));
typedef float f32x16 __attribute__((ext_vector_type(16)));
typedef short bf16x8 __attribute__((ext_vector_type(8)));
typedef short s16x4 __attribute__((ext_vector_type(4)));
typedef GAS unsigned gu32;
#define RLX_AGENT __ATOMIC_RELAXED, __HIP_MEMORY_SCOPE_AGENT
#define LDS_WAIT() asm volatile("s_waitcnt lgkmcnt(0)" ::: "memory")
#define VM_WAIT() asm volatile("s_waitcnt vmcnt(0)" ::: "memory")
#define CFENCE() asm volatile("" ::: "memory")
__device__ __forceinline__ unsigned f2bf(float f) { unsigned u = __builtin_bit_cast(unsigned, f); return (u + 0x7fffu + ((u >> 16) & 1u)) >> 16; }
typedef __bf16 bf16x2_t __attribute__((ext_vector_type(2)));
typedef float f32x2_t __attribute__((ext_vector_type(2)));
__device__ __forceinline__ unsigned pk2(float lo, float hi) { f32x2_t v = {lo, hi}; bf16x2_t b = __builtin_convertvector(v, bf16x2_t); return __builtin_bit_cast(unsigned, b); }
__device__ __forceinline__ float bf2f(unsigned short b) { return __builtin_bit_cast(float, (unsigned)b << 16); }
__device__ __forceinline__ float bflo(unsigned w) { return __builtin_bit_cast(float, w << 16); }
__device__ __forceinline__ float bfhi(unsigned w) { return __builtin_bit_cast(float, w & 0xffff0000u); }
__device__ __forceinline__ float sigmoidf_(float x) { return __builtin_amdgcn_rcpf(1.0f + __expf(-x)); }
__device__ __forceinline__ float siluf_(float x) { return x * sigmoidf_(x); }
template <int CTRL, int RM> __device__ __forceinline__ float dppmov(float x) { return __builtin_bit_cast(float, __builtin_amdgcn_update_dpp(0, __builtin_bit_cast(int, x), CTRL, RM, 0xf, false)); }
__device__ __forceinline__ float wave_sum(float v) {
    v += dppmov<0xB1, 0xf>(v); v += dppmov<0x4E, 0xf>(v); v += dppmov<0x141, 0xf>(v); v += dppmov<0x140, 0xf>(v);
    v += dppmov<0x142, 0xa>(v); v += dppmov<0x143, 0xc>(v);
    return __builtin_bit_cast(float, __builtin_amdgcn_readlane(__builtin_bit_cast(int, v), 63));
}

__device__ __forceinline__ float wave_max(float v) {
    v = fmaxf(v, dppmov<0xB1, 0xf>(v)); v = fmaxf(v, dppmov<0x4E, 0xf>(v)); v = fmaxf(v, dppmov<0x141, 0xf>(v)); v = fmaxf(v, dppmov<0x140, 0xf>(v));
    v = fmaxf(v, dppmov<0x142, 0xa>(v)); v = fmaxf(v, dppmov<0x143, 0xc>(v));
    return __builtin_bit_cast(float, __builtin_amdgcn_readlane(__builtin_bit_cast(int, v), 63));
}

#define XB_TMO      128
#define XB_XCNT(j)  (256  + 64 * (j))
#define XB_XSUB(j)  (1280 + 64 * (j))
#define XB_XGEN(j)  (2304 + 64 * (j))
#define XB_TOP      3328
#define XB_TOPGEN   3392
#define XCD_BAR_WORDS 3456
#define XB_SPIN_CAP (1u << 18)
__device__ __forceinline__ unsigned xb_ld(unsigned* p)              { return __hip_atomic_load(p, __ATOMIC_RELAXED, __HIP_MEMORY_SCOPE_AGENT); }
__device__ __forceinline__ unsigned xb_add(unsigned* p, unsigned v) { return __hip_atomic_fetch_add(p, v, __ATOMIC_RELAXED, __HIP_MEMORY_SCOPE_AGENT); }
__device__ __forceinline__ unsigned xb_xcc_id() { return (unsigned)__builtin_amdgcn_s_getreg((3 << 11) | 20) & 0xFu; }
#define XB_SPIN(cond, bar) do { unsigned _sp = 0; while (cond) { __builtin_amdgcn_s_sleep(1); \
    if ((++_sp & 255u) == 0u) { if (xb_ld(&(bar)[XB_TMO])) break; if (_sp > XB_SPIN_CAP) { atomicAdd(&(bar)[XB_TMO], 1u); break; } } } } while (0)
struct XcdBarrier { unsigned* bar; unsigned x; volatile LAS unsigned* st; };
__device__ __forceinline__ XcdBarrier xcd_barrier_post(unsigned* bar, volatile LAS unsigned* st) {
    XcdBarrier b; b.bar = bar; b.x = xb_xcc_id(); b.st = st;
    if (threadIdx.x == 0) (void)xb_add(&bar[XB_XCNT(b.x)], 1u);
    return b;
}
__device__ __forceinline__ void xcd_barrier_complete(unsigned* bar, unsigned x, unsigned& nloc, unsigned& nx) {
    const unsigned G = gridDim.x * gridDim.y * gridDim.z;
    unsigned sum, cnt, mine, sp = 0u;
    for (;;) {
        sum = 0u; cnt = 0u; mine = 0u;
#pragma unroll
        for (unsigned j = 0; j < 16; ++j) { const unsigned c = xb_ld(&bar[XB_XCNT(j)]); sum += c; cnt += (c > 0u) ? 1u : 0u; mine = (j == x) ? c : mine; }
        if (sum == G) break;
        __builtin_amdgcn_s_sleep(1);
        if ((++sp & 255u) == 0u) { if (xb_ld(&bar[XB_TMO])) break; if (sp > XB_SPIN_CAP) { atomicAdd(&bar[XB_TMO], 1u); break; } }
    }
    nloc = mine > 0u ? mine : 1u; nx = cnt > 0u ? cnt : 1u;
}
__device__ __attribute__((noinline)) void xcd_barrier(unsigned* bar_, unsigned bx_, volatile LAS unsigned* st_) { XcdBarrier b; b.bar = bar_; b.x = bx_; b.st = st_;
    asm volatile("s_waitcnt vmcnt(0)" ::: "memory");
    __syncthreads();
    if (threadIdx.x == 0) {
        unsigned* bar = b.bar;
        __builtin_amdgcn_s_waitcnt(0);
        unsigned nloc = b.st[0], nx = b.st[1];
        if (nloc == 0u) { xcd_barrier_complete(bar, b.x, nloc, nx); b.st[0] = nloc; b.st[1] = nx; }
        const unsigned old = xb_add(&bar[XB_XSUB(b.x)], 1u);
        const unsigned gen = old / nloc;
        if (old + 1u == (gen + 1u) * nloc) {
            __builtin_amdgcn_fence(__ATOMIC_RELEASE, "agent");
            asm volatile("s_waitcnt vmcnt(0)" ::: "memory");
            const unsigned og = xb_add(&bar[XB_TOP], 1u);
            const unsigned tg = og / nx;
            if (og + 1u == (tg + 1u) * nx) xb_add(&bar[XB_TOPGEN], 1u);
            else XB_SPIN(xb_ld(&bar[XB_TOPGEN]) == tg, bar);
            __builtin_amdgcn_fence(__ATOMIC_ACQUIRE, "agent");
            xb_add(&bar[XB_XGEN(b.x)], 1u);
            asm volatile("s_waitcnt vmcnt(0)" ::: "memory");
        } else {
            XB_SPIN(xb_ld(&bar[XB_XGEN(b.x)]) == gen, bar);
            __builtin_amdgcn_fence(__ATOMIC_ACQUIRE, "agent");
            asm volatile("s_waitcnt vmcnt(0)" ::: "memory");
        }
    }
    __syncthreads();
}

struct Args {
    const float* in[23];
    float* out; unsigned char* ws;
    int ph_lo, ph_hi;
    int use_bar, pad;
};
struct Frame {
    LAS unsigned char* lds;
    int tid, lane, wave, G, bid;
    unsigned char* ws;
    const float* const __attribute__((address_space(4)))* in;
    float* out;
};
enum { I_X = 0, I_C, I_CTX, I_CCTX, I_MODW, I_MODB, I_NORMG, I_MWIN, I_MBGATE, I_MWCONV, I_MGHEAD, I_MWOUT, I_HWIN, I_HBF, I_HLB, I_HGHEAD, I_HWOUT, I_FWGU, I_FWDOWN, I_EWR, I_EBR, I_EWGU, I_EWDOWN };

#ifndef FP8_LAYERS
#define FP8_LAYERS 0xE
#endif
#define FFN_FP8_L(L) (((FP8_LAYERS) >> (L)) & 1)
#ifndef INPROJ_I8
#define INPROJ_I8 1
#endif
#ifndef UP_I8
#define UP_I8 1
#endif
#ifndef FFN_FP8
#define FFN_FP8 1
#endif
constexpr float WSCALE8 = 64.0f;

__device__ __forceinline__ void phase_mods(Frame& F) {
    LAS float* SV = (LAS float*)(F.lds);
    LAS float* RED = (LAS float*)(F.lds + 9 * 1024 * 4);
    const float* cvec = F.in[I_C]; const float* cctx = F.in[I_CCTX];
    for (int i = F.tid; i < 9 * 1024; i += NTHR) { const int b = i >> 10, k = i & 1023; const float v = b < 8 ? cvec[b * 1024 + k] : cctx[k]; SV[i] = siluf_(v); }
    __syncthreads();
    const float* modw = F.in[I_MODW]; const float* modb = F.in[I_MODB]; const float* normg = F.in[I_NORMG];
    float* modv = (float*)(F.ws + WS_MODV);
    for (int item = F.bid; item < 4 * 96; item += F.G) {
        const int L = item / 96, n0 = (item % 96) * 64;
        const float* wp = modw + (size_t)L * 1024 * 6144 + n0 + F.lane;
        float acc[9];
#pragma unroll
        for (int b = 0; b < 9; ++b) acc[b] = 0.f;
        const int k0 = F.wave * 128;
#pragma unroll 4
        for (int k = 0; k < 128; ++k) { const float wv = wp[(size_t)(k0 + k) * 6144];
#pragma unroll
            for (int b = 0; b < 9; ++b) acc[b] += SV[b * 1024 + k0 + k] * wv; }
#pragma unroll
        for (int b = 0; b < 9; ++b) RED[(F.wave * 9 + b) * 64 + F.lane] = acc[b];
        __syncthreads();
        for (int o = F.tid; o < 9 * 64; o += NTHR) { const int b = o >> 6, l = o & 63; float v = 0.f;
#pragma unroll
            for (int w = 0; w < 8; ++w) v += RED[(w * 9 + b) * 64 + l];
            const int n = n0 + l, s = n >> 10, c = n & 1023; v += modb[L * 6144 + n];
            const float* g = normg + (size_t)L * 4 * 1024;
            int slot; float r;
            if (s == 0) { slot = 1; r = v; } else if (s == 1) { slot = 0; r = g[c] * (1.f + v); } else if (s == 2) { slot = 2; r = v * g[1024 + c]; }
            else if (s == 3) { slot = 4; r = v; } else if (s == 4) { slot = 3; r = g[2048 + c] * (1.f + v); } else { slot = 5; r = v * g[3072 + c]; }
            modv[((size_t)(L * 9 + b) * 6 + slot) * 1024 + c] = r; }
        __syncthreads();
    }
}

__device__ __forceinline__ void wconv_item(const float* W, int K, int N, bf16* WT, int gu_mode, LAS float* scr, int item, int lane) {
    const int nblk = N / 32, kb = item / nblk, nb = item % nblk, k0 = 64 * kb, n0 = 32 * nb;
    int row0 = n0;
    if (gu_mode) { const int half = n0 / FF, nn = n0 - half * FF; row0 = 256 * (nn >> 7) + 128 * half + (nn & 127); }
#pragma unroll 8
    for (int i = 0; i < 32; ++i) { const int kk = 2 * i + (lane >> 5); scr[kk * 33 + (lane & 31)] = W[(size_t)(k0 + kk) * N + n0 + (lane & 31)]; }
    LDS_WAIT(); CFENCE();
    const int c = lane & 7;
#pragma unroll
    for (int j = 0; j < 4; ++j) { const int n = (lane >> 3) + 8 * j; const LAS float* s = scr + (8 * c) * 33 + n;
        v4u o; o.x = pk2(s[0 * 33], s[1 * 33]); o.y = pk2(s[2 * 33], s[3 * 33]); o.z = pk2(s[4 * 33], s[5 * 33]); o.w = pk2(s[6 * 33], s[7 * 33]);
        *(GAS v4u*)(WT + (size_t)(row0 + n) * K + k0 + 8 * c) = o; }
    LDS_WAIT(); CFENCE();
}
__device__ __forceinline__ void wconv_item8(const float* W, int K, int N, unsigned char* WT, int gu_mode, float wscale, LAS float* scr, int item, int lane) {
    const int nblk = N / 32, kb = item / nblk, nb = item % nblk, k0 = 64 * kb, n0 = 32 * nb;
    int row0 = n0;
    if (gu_mode) { const int half = n0 / FF, nn = n0 - half * FF; row0 = 256 * (nn >> 7) + 128 * half + (nn & 127); }
#pragma unroll 8
    for (int i = 0; i < 32; ++i) { const int kk = 2 * i + (lane >> 5); scr[kk * 33 + (lane & 31)] = W[(size_t)(k0 + kk) * N + n0 + (lane & 31)]; }
    LDS_WAIT(); CFENCE();
    const int c = lane & 7;
#pragma unroll
    for (int j = 0; j < 4; ++j) { const int n = (lane >> 3) + 8 * j; const LAS float* s = scr + (8 * c) * 33 + n;
        v2u o; unsigned w = 0; w = __builtin_amdgcn_cvt_pk_fp8_f32(s[0 * 33] * wscale, s[1 * 33] * wscale, w, false); w = __builtin_amdgcn_cvt_pk_fp8_f32(s[2 * 33] * wscale, s[3 * 33] * wscale, w, true); o.x = w;
        w = 0; w = __builtin_amdgcn_cvt_pk_fp8_f32(s[4 * 33] * wscale, s[5 * 33] * wscale, w, false); w = __builtin_amdgcn_cvt_pk_fp8_f32(s[6 * 33] * wscale, s[7 * 33] * wscale, w, true); o.y = w;
        *(GAS v2u*)(WT + (size_t)(row0 + n) * K + k0 + 8 * c) = o; }
    LDS_WAIT(); CFENCE();
}
__device__ __forceinline__ void wconv_cols_i8(const float* W, int K, int N, unsigned char* WT, float* sw, int gu_mode, LAS float* scr, int item, int lane) {
    const int n0 = 32 * item; int row0 = n0;
    if (gu_mode) { const int half = n0 / FF, nn = n0 - half * FF; row0 = 256 * (nn >> 7) + 128 * half + (nn & 127); }
    const float* wp = W + n0 + (lane & 31) + (size_t)(lane >> 5) * N;
    float mx = 0.f;
    for (int k = 0; k < K; k += 32) { float v[16];
#pragma unroll
        for (int i = 0; i < 16; ++i) v[i] = wp[(size_t)(2 * i) * N];
        wp += (size_t)32 * N;
#pragma unroll
        for (int i = 0; i < 16; ++i) mx = fmaxf(mx, fabsf(v[i])); }
    mx = fmaxf(mx, __shfl_xor(mx, 32));
    const float scale = mx > 0.f ? mx * (1.0f / 127.0f) : 1.0f, inv = mx > 0.f ? 127.0f / mx : 0.f;
    if (lane < 32) sw[row0 + lane] = scale;
    LAS float* invs = scr + 64 * 33;
    if (lane < 32) invs[lane] = inv;
    LDS_WAIT(); CFENCE();
    const int c = lane & 7;
    for (int k0 = 0; k0 < K; k0 += 64) {
#pragma unroll 16
        for (int i = 0; i < 32; ++i) { const int kk = 2 * i + (lane >> 5); scr[kk * 33 + (lane & 31)] = W[(size_t)(k0 + kk) * N + n0 + (lane & 31)]; }
        LDS_WAIT(); CFENCE();
#pragma unroll
        for (int j = 0; j < 4; ++j) { const int n = (lane >> 3) + 8 * j; const LAS float* s = scr + (8 * c) * 33 + n; const float iv = invs[n]; unsigned q[8];
#pragma unroll
            for (int e = 0; e < 8; ++e) q[e] = (unsigned)(int)__builtin_rintf(s[e * 33] * iv) & 0xffu;
            v2u o; o.x = q[0] | (q[1] << 8) | (q[2] << 16) | (q[3] << 24); o.y = q[4] | (q[5] << 8) | (q[6] << 16) | (q[7] << 24);
            *(GAS v2u*)(WT + (size_t)(row0 + n) * K + k0 + 8 * c) = o; }
        LDS_WAIT(); CFENCE();
    }
}
__device__ __forceinline__ void phase_wconv(Frame& F, int L) {
    LAS float* scr = (LAS float*)(F.lds + F.wave * 16384);
    const int gw = F.bid * NWAVES + F.wave, NGW = F.G * NWAVES; const int j = L >> 1;
    if ((L & 1) == 0) {
        unsigned char* wb = F.ws + WS_WE; float* swb = (float*)(F.ws + WS_SMALL + SM_SWE);
        const float* w_in = F.in[I_MWIN] + (size_t)j * D * NW_M; const float* w_out = F.in[I_MWOUT] + (size_t)j * D * D;
        const float* w_gu = F.in[I_FWGU] + (size_t)j * D * NGU; const float* w_dn = F.in[I_FWDOWN] + (size_t)j * FF * D;
        constexpr int I0 = INPROJ_I8 ? (NW_M / 32) : 16 * (NW_M / 32), I1 = 16 * 32, I2 = UP_I8 ? (NGU / 32) : 16 * (NGU / 32), I3 = (FF / 64) * 32;
        for (int it = gw; it < I0 + I1 + I2 + I3; it += NGW) { int r = it;
            if (r < I0) { if (INPROJ_I8) wconv_cols_i8(w_in, D, NW_M, wb + WE_IN, swb + SWE_IN, 0, scr, r, F.lane); else wconv_item(w_in, D, NW_M, (bf16*)(wb + WE_IN), 0, scr, r, F.lane); continue; } r -= I0;
            if (r < I1) { wconv_item(w_out, D, D, (bf16*)(wb + WE_OUT), 0, scr, r, F.lane); continue; } r -= I1;
            if (r < I2) { if (UP_I8) wconv_cols_i8(w_gu, D, NGU, wb + WE_GU, swb + SWE_GU, 1, scr, r, F.lane); else if (FFN_FP8_L(L)) wconv_item8(w_gu, D, NGU, wb + WE_GU, 1, WSCALE8, scr, r, F.lane); else wconv_item(w_gu, D, NGU, (bf16*)(wb + WE_GU), 1, scr, r, F.lane); continue; } r -= I2;
            if (FFN_FP8_L(L)) wconv_item8(w_dn, FF, D, wb + WE_DOWN, 0, WSCALE8, scr, r, F.lane); else wconv_item(w_dn, FF, D, (bf16*)(wb + WE_DOWN), 0, scr, r, F.lane); }
        GAS v4u* z = (GAS v4u*)(wb + WE_IN + (size_t)NW_M * D * (INPROJ_I8 ? 1 : 2)); const int nz = (NIN_M - NW_M) * D * (INPROJ_I8 ? 1 : 2) / 16;
        for (int i = F.bid * NTHR + F.tid; i < nz; i += F.G * NTHR) z[i] = (v4u){0u, 0u, 0u, 0u};
        if (INPROJ_I8 && F.bid == 0 && F.tid < NIN_M - NW_M) swb[SWE_IN + NW_M + F.tid] = 1.0f;
    } else {
        unsigned char* wb = F.ws + WS_WO; float* swb = (float*)(F.ws + WS_SMALL + SM_SWO);
        const float* w_in = F.in[I_HWIN] + (size_t)j * D * NP_H; const float* w_out = F.in[I_HWOUT] + (size_t)j * D * D;
        const float* w_gu = F.in[I_EWGU] + (size_t)j * NEXP * D * NGU; const float* w_dn = F.in[I_EWDOWN] + (size_t)j * NEXP * FF * D;
        constexpr int I0 = INPROJ_I8 ? (NP_H / 32) : 16 * (NP_H / 32), I1 = 16 * 32, I2 = 16 * (NGU / 32), I3 = (FF / 64) * 32;
        for (int it = gw; it < I0 + I1 + NEXP * (I2 + I3); it += NGW) { int r = it;
            if (r < I0) { if (INPROJ_I8) wconv_cols_i8(w_in, D, NP_H, wb + WOD_IN, swb + SWO_IN, 0, scr, r, F.lane); else wconv_item(w_in, D, NP_H, (bf16*)(wb + WOD_IN), 0, scr, r, F.lane); continue; } r -= I0;
            if (r < I1) { wconv_item(w_out, D, D, (bf16*)(wb + WOD_OUT), 0, scr, r, F.lane); continue; } r -= I1;
            const int e = r / (I2 + I3); r -= e * (I2 + I3);
            if (r < I2) { if (FFN_FP8_L(L)) wconv_item8(w_gu + (size_t)e * D * NGU, D, NGU, wb + WOD_GU + e * EGU_BYTES, 1, WSCALE8, scr, r, F.lane); else wconv_item(w_gu + (size_t)e * D * NGU, D, NGU, (bf16*)(wb + WOD_GU + e * EGU_BYTES), 1, scr, r, F.lane); continue; } r -= I2;
            if (FFN_FP8_L(L)) wconv_item8(w_dn + (size_t)e * FF * D, FF, D, wb + WOD_DOWN + e * EDOWN_BYTES, 0, WSCALE8, scr, r, F.lane); else wconv_item(w_dn + (size_t)e * FF * D, FF, D, (bf16*)(wb + WOD_DOWN + e * EDOWN_BYTES), 0, scr, r, F.lane); }
    }
}

struct TokCfg {
    const void* lat_src_l; const void* lat_src_c;
    void* lat_dst_l; void* lat_dst_c;
    int src_f32, dst_f32;
    const bf16* y; int y_perm; int moe_combine;
    const float* vupd;
    const float* vna; const float* vnb;
    bf16* u; int u_perm; int u_fp8;
    float* u_scale;
    int route; int jr;
    int nrows;
};
__device__ __forceinline__ int perm_cm(int t) { return (t & 63) * ROWS_G + (t >> 6); }

struct RowRaw { v4u l0, l1, l2, l3; v2u a0, a1, a2, a3, b0, b1, b2, b3; };
__device__ __forceinline__ RowRaw tok_issue(const TokCfg& T, int row, int p0, int p1, int lane) {
    RowRaw R; const v4u z4 = (v4u){0u, 0u, 0u, 0u}; const v2u z2 = (v2u){0u, 0u};
    R.l0 = z4; R.l1 = z4; R.l2 = z4; R.l3 = z4; R.a0 = z2; R.a1 = z2; R.a2 = z2; R.a3 = z2; R.b0 = z2; R.b1 = z2; R.b2 = z2; R.b3 = z2;
    if (T.src_f32) { const GAS v4u* lp = (const GAS v4u*)(row < M_LAT ? (const float*)T.lat_src_l + (size_t)row * D : (const float*)T.lat_src_c + (size_t)(row - M_LAT) * D) + lane;
        R.l0 = lp[0]; R.l1 = lp[64]; R.l2 = lp[128]; R.l3 = lp[192]; }
    else { const GAS v2u* lp = (const GAS v2u*)(row < M_LAT ? (const bf16*)T.lat_src_l + (size_t)row * D : (const bf16*)T.lat_src_c + (size_t)(row - M_LAT) * D) + lane;
        const v2u a = lp[0], b = lp[64], c = lp[128], d = lp[192]; R.l0.x = a.x; R.l0.y = a.y; R.l1.x = b.x; R.l1.y = b.y; R.l2.x = c.x; R.l2.y = c.y; R.l3.x = d.x; R.l3.y = d.y; }
    if (T.y) {
        if (T.moe_combine) { const GAS v2u* ya = (const GAS v2u*)(T.y + (size_t)p0 * D) + lane; const GAS v2u* yb = (const GAS v2u*)(T.y + (size_t)p1 * D) + lane;
            R.a0 = ya[0]; R.a1 = ya[64]; R.a2 = ya[128]; R.a3 = ya[192]; R.b0 = yb[0]; R.b1 = yb[64]; R.b2 = yb[128]; R.b3 = yb[192]; }
        else { int yr = row; if (T.y_perm && row < M_LAT) yr = (row & ~8191) + perm_cm(row & 8191);
            const GAS v2u* yp = (const GAS v2u*)(T.y + (size_t)yr * D) + lane; R.a0 = yp[0]; R.a1 = yp[64]; R.a2 = yp[128]; R.a3 = yp[192]; }
    }
    return R;
}
__device__ __forceinline__ void phase_tok(Frame& F, const TokCfg& T) {
    const int gw = F.bid * NWAVES + F.wave, NGW = F.G * NWAVES;
    const int R = (T.nrows + NGW - 1) / NGW; const int r0 = gw * R; int r1 = r0 + R; if (r1 > T.nrows) r1 = T.nrows;
    LAS float* WR = (LAS float*)F.lds;
    if (T.route) { const float* wr = F.in[I_EWR] + (size_t)T.jr * 1024 * 8; for (int i = F.tid; i < 8192; i += NTHR) WR[i] = wr[i]; }
    __syncthreads();
    f32x4 VU[4], VA[4], VB[4]; int curb = -1;
    int my_e0 = 0, my_e1 = 0; float my_w = 0.f;
    const int* rrp = (const int*)(F.ws + WS_ROUTE + RT_R); const float* rwp = (const float*)(F.ws + WS_ROUTE + RT_W);
    int p0c = 0, p1c = 0, p0n = 0, p1n = 0; float w0c = 0.f, w0n = 0.f;
    if (T.moe_combine && r0 < r1) { p0c = rrp[2 * r0]; p1c = rrp[2 * r0 + 1]; w0c = rwp[r0]; if (r0 + 1 < r1) { p0n = rrp[2 * r0 + 2]; p1n = rrp[2 * r0 + 3]; w0n = rwp[r0 + 1]; } }
    RowRaw C = tok_issue(T, r0 < r1 ? r0 : 0, p0c, p1c, F.lane);
    for (int row = r0; row < r1; ++row) {
        const bool hn = row + 1 < r1;
        int p0nn = 0, p1nn = 0; float w0nn = 0.f;
        const RowRaw N = tok_issue(T, hn ? row + 1 : row, p0n, p1n, F.lane);
        if (hn) {
            if (T.moe_combine && row + 2 < r1) { p0nn = rrp[2 * row + 4]; p1nn = rrp[2 * row + 5]; w0nn = rwp[row + 2]; } }
        const int b = row < M_LAT ? (row >> 13) : 8;
        if (b != curb) { curb = b;
#pragma unroll
            for (int j = 0; j < 4; ++j) {
                if (T.y) VU[j] = ((const f32x4*)(T.vupd + (size_t)b * 6144))[F.lane + 64 * j];
                if (T.vna) { VA[j] = ((const f32x4*)(T.vna + (size_t)b * 6144))[F.lane + 64 * j]; VB[j] = ((const f32x4*)(T.vnb + (size_t)b * 6144))[F.lane + 64 * j]; } } }
        f32x4 v[4];
        if (T.src_f32) {
            v[0] = __builtin_bit_cast(f32x4, C.l0); v[1] = __builtin_bit_cast(f32x4, C.l1); v[2] = __builtin_bit_cast(f32x4, C.l2); v[3] = __builtin_bit_cast(f32x4, C.l3); }
        else {
            const v4u cl[4] = {C.l0, C.l1, C.l2, C.l3};
#pragma unroll
            for (int j = 0; j < 4; ++j) v[j] = (f32x4){bflo(cl[j].x), bfhi(cl[j].x), bflo(cl[j].y), bfhi(cl[j].y)}; }
        if (T.y) {
            f32x4 yv[4]; const v2u cya[4] = {C.a0, C.a1, C.a2, C.a3}, cyb[4] = {C.b0, C.b1, C.b2, C.b3};
            if (T.moe_combine) { const float w0 = w0c, w1 = 1.f - w0c;
#pragma unroll
                for (int j = 0; j < 4; ++j) { const v2u a = cya[j], c = cyb[j];
                    yv[j] = (f32x4){w0 * bflo(a.x) + w1 * bflo(c.x), w0 * bfhi(a.x) + w1 * bfhi(c.x), w0 * bflo(a.y) + w1 * bflo(c.y), w0 * bfhi(a.y) + w1 * bfhi(c.y)}; }
            } else {
#pragma unroll
                for (int j = 0; j < 4; ++j) { const v2u a = cya[j]; yv[j] = (f32x4){bflo(a.x), bfhi(a.x), bflo(a.y), bfhi(a.y)}; }
            }
            float ss = 0.f;
#pragma unroll
            for (int j = 0; j < 4; ++j) ss += (yv[j].x * yv[j].x + yv[j].y * yv[j].y) + (yv[j].z * yv[j].z + yv[j].w * yv[j].w);
            const float rs = rsqrtf(wave_sum(ss) * (1.f / D) + EPS);
#pragma unroll
            for (int j = 0; j < 4; ++j) v[j] = v[j] + VU[j] * (yv[j] * rs);
        }
        void* dpv = row < M_LAT ? T.lat_dst_l : T.lat_dst_c;
        if (dpv) { const size_t ro = (size_t)(row < M_LAT ? row : row - M_LAT) * D;
            if (T.dst_f32) { float* dp = (float*)dpv + ro;
#pragma unroll
                for (int j = 0; j < 4; ++j) ((GAS f32x4*)dp)[F.lane + 64 * j] = v[j]; }
            else { bf16* dp = (bf16*)dpv + ro;
#pragma unroll
                for (int j = 0; j < 4; ++j) { v2u o; o.x = pk2(v[j].x, v[j].y); o.y = pk2(v[j].z, v[j].w); ((GAS v2u*)dp)[F.lane + 64 * j] = o; } } }
        if (T.vna) {
            float ss = 0.f;
#pragma unroll
            for (int j = 0; j < 4; ++j) ss += (v[j].x * v[j].x + v[j].y * v[j].y) + (v[j].z * v[j].z + v[j].w * v[j].w);
            const float rs = rsqrtf(wave_sum(ss) * (1.f / D) + EPS);
            f32x4 uu[4];
#pragma unroll
            for (int j = 0; j < 4; ++j) uu[j] = (v[j] * rs) * VA[j] + VB[j];
            int ur = row; if (T.u_perm && row < M_LAT) ur = (row & ~8191) + perm_cm(row & 8191);
            if (T.u_fp8 == 2) { GAS unsigned* up8 = (GAS unsigned*)((unsigned char*)T.u + (size_t)ur * D);
                float mx = 0.f;
#pragma unroll
                for (int j = 0; j < 4; ++j) mx = fmaxf(fmaxf(mx, fmaxf(fabsf(uu[j].x), fabsf(uu[j].y))), fmaxf(fabsf(uu[j].z), fabsf(uu[j].w)));
                mx = wave_max(mx); const float iv = mx > 0.f ? 127.0f / mx : 0.f;
#pragma unroll
                for (int j = 0; j < 4; ++j) { const unsigned q0 = (unsigned)(int)__builtin_rintf(uu[j].x * iv) & 0xffu, q1 = (unsigned)(int)__builtin_rintf(uu[j].y * iv) & 0xffu, q2 = (unsigned)(int)__builtin_rintf(uu[j].z * iv) & 0xffu, q3 = (unsigned)(int)__builtin_rintf(uu[j].w * iv);
                    up8[F.lane + 64 * j] = q0 | (q1 << 8) | (q2 << 16) | (q3 << 24); }
                if (F.lane == 0) T.u_scale[ur] = mx > 0.f ? mx * (1.0f / 127.0f) : 1.0f; }
            else if (T.u_fp8) { GAS unsigned* up8 = (GAS unsigned*)((unsigned char*)T.u + (size_t)ur * D);
#pragma unroll
                for (int j = 0; j < 4; ++j) { unsigned w = 0; w = __builtin_amdgcn_cvt_pk_fp8_f32(uu[j].x, uu[j].y, w, false); w = __builtin_amdgcn_cvt_pk_fp8_f32(uu[j].z, uu[j].w, w, true); up8[F.lane + 64 * j] = w; } }
            else { GAS v2u* up = (GAS v2u*)(T.u + (size_t)ur * D);
#pragma unroll
                for (int j = 0; j < 4; ++j) { v2u o; o.x = pk2(uu[j].x, uu[j].y); o.y = pk2(uu[j].z, uu[j].w); up[F.lane + 64 * j] = o; } }
            if (T.route) {
                float lg[8];
#pragma unroll
                for (int e = 0; e < 8; ++e) lg[e] = 0.f;
#pragma unroll
                for (int j = 0; j < 4; ++j)
#pragma unroll
                    for (int i = 0; i < 4; ++i) { const int c = 4 * (F.lane + 64 * j) + i; const f32x4 wa = *(const LAS f32x4*)(WR + c * 8), wb = *(const LAS f32x4*)(WR + c * 8 + 4); const float x = uu[j][i];
                        lg[0] += x * wa.x; lg[1] += x * wa.y; lg[2] += x * wa.z; lg[3] += x * wa.w; lg[4] += x * wb.x; lg[5] += x * wb.y; lg[6] += x * wb.z; lg[7] += x * wb.w; }
                const float* br = F.in[I_EBR] + T.jr * 8;
#pragma unroll
                for (int e = 0; e < 8; ++e) lg[e] = wave_sum(lg[e]) + br[e];
                int e0 = 0; float v0 = lg[0];
#pragma unroll
                for (int e = 1; e < 8; ++e) if (lg[e] > v0) { v0 = lg[e]; e0 = e; }
                int e1 = -1; float v1 = -3.0e38f;
#pragma unroll
                for (int e = 0; e < 8; ++e) if (e != e0 && lg[e] > v1) { v1 = lg[e]; e1 = e; }
                const float w0 = 1.f / (1.f + __expf(v1 - v0));
                if (F.lane == row - r0) { my_e0 = e0; my_e1 = e1; my_w = w0; }
            }
        }
        if (hn) { C = N; p0n = p0nn; p1n = p1nn; w0c = w0n; w0n = w0nn; }
    }
    if (T.route) {
        const int n = r1 - r0; const bool act = F.lane < n; const int row = r0 + F.lane;
        unsigned* ecnt = (unsigned*)(F.ws + WS_CTL) + CW_ECNT + T.jr * 8 * 64;
        int rk0 = 0, rk1 = 0;
        const unsigned long long ltmask = (F.lane == 0) ? 0ull : (~0ull >> (64 - F.lane));
#pragma unroll
        for (int e = 0; e < 8; ++e) {
            const unsigned long long m0 = __ballot(act && my_e0 == e), m1 = __ballot(act && my_e1 == e);
            const int c0 = __popcll(m0), c1 = __popcll(m1);
            unsigned base = 0;
            if (c0 + c1 > 0) { if (F.lane == 0) base = __hip_atomic_fetch_add(ecnt + e * 64, (unsigned)(c0 + c1), RLX_AGENT); base = __builtin_amdgcn_readfirstlane(base); }
            if (my_e0 == e) rk0 = (int)base + __popcll(m0 & ltmask);
            if (my_e1 == e) rk1 = (int)base + c0 + __popcll(m1 & ltmask);
        }
        if (act) { ((int*)(F.ws + WS_ROUTE + RT_E))[row] = my_e0 | (my_e1 << 8); ((int*)(F.ws + WS_ROUTE + RT_R))[2 * row] = rk0; ((int*)(F.ws + WS_ROUTE + RT_R))[2 * row + 1] = rk1;
            ((float*)(F.ws + WS_ROUTE + RT_W))[row] = my_w; }
    }
}

__device__ __forceinline__ void phase_moe_scatter(Frame& F, int jr, int nrows, const unsigned char* U, unsigned char* AM, int rowb, const float* sa_src, float* sa_dst) {
    const unsigned* ecnt = (const unsigned*)(F.ws + WS_CTL) + CW_ECNT + jr * 8 * 64;
    int base[8]; int acc = 0;
#pragma unroll
    for (int e = 0; e < 8; ++e) { const int c = (int)__hip_atomic_load(ecnt + e * 64, RLX_AGENT); base[e] = acc; acc += (c + 255) & ~255; }
    int* pexp = (int*)(F.ws + WS_SMALL + SM_PEXP);
    if (F.bid == 0) { const int np = acc >> 8;
        for (int p = F.tid; p < np; p += NTHR) { int e = 0;
#pragma unroll
            for (int q = 1; q < 8; ++q) if (p * 256 >= base[q]) e = q;
            pexp[p] = e; }
        if (F.tid == 0) pexp[MOE_PANELS] = np; }
    const int gw = F.bid * NWAVES + F.wave, NGW = F.G * NWAVES;
    const int R = (nrows + NGW - 1) / NGW; const int r0 = gw * R; int r1 = r0 + R; if (r1 > nrows) r1 = nrows;
    int* rr = (int*)(F.ws + WS_ROUTE + RT_R); const int* re = (const int*)(F.ws + WS_ROUTE + RT_E);
    for (int row = r0; row < r1; ++row) {
        const int ee = re[row], e0 = ee & 255, e1 = ee >> 8; int b0 = 0, b1 = 0;
#pragma unroll
        for (int e = 0; e < 8; ++e) { if (e0 == e) b0 = base[e]; if (e1 == e) b1 = base[e]; }
        const int p0 = b0 + rr[2 * row], p1 = b1 + rr[2 * row + 1];
        const v4u* src = (const v4u*)(U + (size_t)row * rowb); v4u* d0 = (v4u*)(AM + (size_t)p0 * rowb); v4u* d1 = (v4u*)(AM + (size_t)p1 * rowb);
        const v4u a = src[F.lane]; d0[F.lane] = a; d1[F.lane] = a;
        if (rowb > 1024) { const v4u c = src[F.lane + 64]; d0[F.lane + 64] = c; d1[F.lane + 64] = c; }
        CFENCE();
        if (F.lane == 0) { rr[2 * row] = p0; rr[2 * row + 1] = p1; if (sa_src) { const float s = sa_src[row]; sa_dst[p0] = s; sa_dst[p1] = s; } }
    }
}

#define MFMA32(a, b, c) __builtin_amdgcn_mfma_f32_32x32x16_bf16((a), (b), (c), 0, 0, 0)
typedef short v4i16_t __attribute__((ext_vector_type(4)));
typedef LAS unsigned char* ldsp;
__device__ __forceinline__ unsigned cvtpk(float lo, float hi) { f32x2_t v = {lo, hi}; bf16x2_t b = __builtin_convertvector(v, bf16x2_t); return __builtin_bit_cast(unsigned, b); }
__device__ __forceinline__ int crow(int reg, int h) { return (reg & 3) + 8 * (reg >> 2) + 4 * h; }
__device__ __forceinline__ bf16x8 pack8(const f32x16& x, int s) {
    v4u p; p.x = cvtpk(x[8 * s], x[8 * s + 1]); p.y = cvtpk(x[8 * s + 2], x[8 * s + 3]); p.z = cvtpk(x[8 * s + 4], x[8 * s + 5]); p.w = cvtpk(x[8 * s + 6], x[8 * s + 7]);
    return __builtin_bit_cast(bf16x8, p);
}
__device__ __forceinline__ bf16x8 lds16(ldsp p) { return *(const LAS bf16x8*)p; }
__device__ __forceinline__ bf16x8 lds8x2(ldsp p) { const s16x4 lo = *(const LAS s16x4*)p, hi = *(const LAS s16x4*)(p + 16); return __builtin_shufflevector(lo, hi, 0, 1, 2, 3, 4, 5, 6, 7); }
__device__ __forceinline__ s16x4 tr16(ldsp p) { return __builtin_bit_cast(s16x4, __builtin_amdgcn_ds_read_tr16_b64_v4i16((LAS v4i16_t*)p)); }
__device__ __forceinline__ bf16x8 ldstr2(ldsp p, int second) { const s16x4 lo = tr16(p), hi = tr16(p + second); return __builtin_shufflevector(lo, hi, 0, 1, 2, 3, 4, 5, 6, 7); }
__device__ __forceinline__ f32x16 zero16() { f32x16 z;
#pragma unroll
    for (int i = 0; i < 16; ++i) z[i] = 0.f; return z; }
__device__ __forceinline__ void unpack8(const v4u& w, float (&x)[8]) { x[0] = bflo(w.x); x[1] = bfhi(w.x); x[2] = bflo(w.y); x[3] = bfhi(w.y); x[4] = bflo(w.z); x[5] = bfhi(w.z); x[6] = bflo(w.w); x[7] = bfhi(w.w); }
__device__ __forceinline__ int launder_v(int x) { asm volatile("" : "+v"(x)); return x; }
struct FragOff { int o_row, o_perm, o_trn, o_trp; };
__device__ __forceinline__ FragOff frag_off(int lane, int LD) {
    const int r = lane & 31, hh = lane >> 5, i16 = lane & 15, q = i16 >> 2, p = i16 & 3, blk = (lane >> 4) & 1; FragOff f;
    f.o_row = (r * LD + 8 * hh) * 2; f.o_perm = (r * LD + 4 * hh) * 2;
    f.o_trn = ((8 * hh + q) * LD + 16 * blk + 4 * p) * 2; f.o_trp = ((4 * hh + q) * LD + 16 * blk + 4 * p) * 2; return f;
}


template <int CTRL, int RM, int BM> __device__ __forceinline__ float dpp_f(float old, float x) {
    return __builtin_bit_cast(float, __builtin_amdgcn_update_dpp(__builtin_bit_cast(int, old), __builtin_bit_cast(int, x), CTRL, RM, BM, false)); }
__device__ __forceinline__ float wave_scan_add(float x) {
    float r = x;
    r += dpp_f<0x111, 0xf, 0xf>(0.f, x); r += dpp_f<0x112, 0xf, 0xf>(0.f, x); r += dpp_f<0x113, 0xf, 0xf>(0.f, x);
    r += dpp_f<0x114, 0xf, 0xe>(0.f, r); r += dpp_f<0x118, 0xf, 0xc>(0.f, r);
    r += dpp_f<0x142, 0xa, 0xf>(0.f, r); r += dpp_f<0x143, 0xc, 0xf>(0.f, r);
    return r;
}
__device__ __forceinline__ float wave_scan_max(float x) {
    const float NEG = -3.0e38f; float r = x;
    r = fmaxf(r, dpp_f<0x111, 0xf, 0xf>(NEG, x)); r = fmaxf(r, dpp_f<0x112, 0xf, 0xf>(NEG, x)); r = fmaxf(r, dpp_f<0x113, 0xf, 0xf>(NEG, x));
    r = fmaxf(r, dpp_f<0x114, 0xf, 0xe>(NEG, r)); r = fmaxf(r, dpp_f<0x118, 0xf, 0xc>(NEG, r));
    r = fmaxf(r, dpp_f<0x142, 0xa, 0xf>(NEG, r)); r = fmaxf(r, dpp_f<0x143, 0xc, 0xf>(NEG, r));
    return r;
}
__device__ __forceinline__ float lane63(float x) { return __builtin_bit_cast(float, __builtin_amdgcn_readlane(__builtin_bit_cast(int, x), 63)); }
__device__ __forceinline__ float sum_halves(float x) {
    const unsigned u = __builtin_bit_cast(unsigned, x); auto rr = __builtin_amdgcn_permlane32_swap(u, u, false, false);
    return __builtin_bit_cast(float, (unsigned)rr[0]) + __builtin_bit_cast(float, (unsigned)rr[1]); }

__device__ __forceinline__ void item_headnorm(int tid, const bf16* hf, const bf16* hb, const bf16* gate, int gpitch, int gcol, const float* gh_head, bf16* aout, int rowbase, int t0, int ntok, int h) {
    VM_WAIT(); __syncthreads();
    const int sub = tid & 7, rr = tid >> 3;
    float gh[16];
#pragma unroll
    for (int e = 0; e < 16; ++e) gh[e] = gh_head[sub * 16 + e];
#pragma unroll 2
    for (int row = rr; row < ntok; row += 64) {
        const size_t grow = (size_t)(rowbase + t0 + row);
        const size_t o = grow * D + h * 128 + sub * 16;
        const v4u a0 = *(const GAS v4u*)(hf + o), a1 = *(const GAS v4u*)(hf + o + 8), b0 = *(const GAS v4u*)(hb + o), b1 = *(const GAS v4u*)(hb + o + 8);
        const bf16* gp = gate + grow * gpitch + gcol + h * 128 + sub * 16; const v4u g0 = *(const GAS v4u*)gp, g1 = *(const GAS v4u*)(gp + 8);
        float x[16], y[8];
        unpack8(a0, y);
#pragma unroll
        for (int e = 0; e < 8; ++e) x[e] = y[e];
        unpack8(a1, y);
#pragma unroll
        for (int e = 0; e < 8; ++e) x[8 + e] = y[e];
        unpack8(b0, y);
#pragma unroll
        for (int e = 0; e < 8; ++e) x[e] += y[e];
        unpack8(b1, y);
#pragma unroll
        for (int e = 0; e < 8; ++e) x[8 + e] += y[e];
        float ss = 0.f;
#pragma unroll
        for (int e = 0; e < 16; ++e) ss += x[e] * x[e];
        ss += __shfl_xor(ss, 1); ss += __shfl_xor(ss, 2); ss += __shfl_xor(ss, 4);
        const float rs = rsqrtf(ss * (1.f / 128.f) + EPS);
        float o16[16];
        unpack8(g0, y);
#pragma unroll
        for (int e = 0; e < 8; ++e) o16[e] = x[e] * rs * gh[e] * sigmoidf_(y[e]);
        unpack8(g1, y);
#pragma unroll
        for (int e = 0; e < 8; ++e) o16[8 + e] = x[8 + e] * rs * gh[8 + e] * sigmoidf_(y[e]);
        v4u w0, w1; w0.x = pk2(o16[0], o16[1]); w0.y = pk2(o16[2], o16[3]); w0.z = pk2(o16[4], o16[5]); w0.w = pk2(o16[6], o16[7]); w1.x = pk2(o16[8], o16[9]); w1.y = pk2(o16[10], o16[11]); w1.z = pk2(o16[12], o16[13]); w1.w = pk2(o16[14], o16[15]);
        *(GAS v4u*)(aout + o) = w0; *(GAS v4u*)(aout + o + 8) = w1;
    }
}

#ifndef SCAN_PF_OUT
#define SCAN_PF_OUT 1
#endif
constexpr int ML_LDQ = 72, ML_LDV = 136;
constexpr int ML_QC = 0, ML_KC = 9216, ML_KH = 18432, ML_V = 27648, ML_GS = 45056, ML_OB = 50176, ML_NV = 68608, ML_SSQ = 70656, ML_INV = 71680, ML_GROUP = 73728;
static_assert(2 * ML_GROUP <= LDS_MAIN, "mLSTM LDS map");
constexpr int ML_STATE_F = 8448;

struct MlPref { v4u q[2], k[2], v[4]; float gi, gf; };
struct MlSeg { int rowbase; int len; int t0; int nchunk; };

__device__ __forceinline__ void ml_issue(MlPref& P, const bf16* proj, const bf16* qkc, const float* gates, int rowbase, int t0c, int g, int h, int tg, int lane, bool need_q) {
    const int c8q = tg & 7;
#pragma unroll
    for (int i = 0; i < 2; ++i) { const int tau = (tg + 256 * i) >> 3; const int t = t0c + (g ? 63 - tau : tau);
        const bf16* rp = qkc + (size_t)(rowbase + t) * D + h * 64 + c8q * 8;
        P.q[i] = need_q ? *(const GAS v4u*)rp : (v4u){0u, 0u, 0u, 0u}; P.k[i] = *(const GAS v4u*)(rp + 512); }
#pragma unroll
    for (int i = 0; i < 4; ++i) { const int p = tg + 256 * i, tau = p >> 4, c8 = p & 15; const int t = t0c + (g ? 63 - tau : tau);
        P.v[i] = *(const GAS v4u*)(proj + (size_t)(rowbase + t) * NP_M + 1024 + h * 128 + c8 * 8); }
    { const int t = t0c + (g ? 63 - lane : lane); const GAS float* gp = (const GAS float*)(gates + (size_t)(rowbase + t) * 32 + g * 16 + h); P.gi = gp[0]; P.gf = gp[8]; }
}

template <bool OUTPUT>
__device__ __forceinline__ void mlstm_item(Frame& F, const bf16* proj, const bf16* qkc, const float* gates, bf16* hx0, bf16* hx1, bf16* aout, const float* ghead,
                                           int h, MlSeg S0, MlSeg S1, const float* st_in0, const float* st_in1, int npre0, int npre1, float* st_out0, float* st_out1) {
    const int tid_l = launder_v(F.tid); const int wave_l = __builtin_amdgcn_readfirstlane(tid_l >> 6);
    const int g = wave_l >> 2, j = wave_l & 3, tg = tid_l & 255, lane = tid_l & 63, r = lane & 31, hh = lane >> 5;
    const ldsp gb = F.lds + g * ML_GROUP;
    const ldsp GSb = gb + ML_GS + j * 1280;
    LAS float* GS = (LAS float*)GSb;
    const ldsp OBb = gb + ML_OB + j * 4608;
    LAS float* NV = (LAS float*)(gb + ML_NV);
    LAS float* SSQ = (LAS float*)(gb + ML_SSQ);
    const ldsp INVb = gb + ML_INV + j * 256;
    const int rowbase = g ? S1.rowbase : S0.rowbase, seg_t0 = g ? S1.t0 : S0.t0, nch = g ? S1.nchunk : S0.nchunk;
    const int vcol = 64 * j;
    __syncthreads();
    f32x16 C[2]; C[0] = zero16(); C[1] = zero16();
    float m_prev = -1.0e30f, btot = 0.f;
    float nreg = 0.f;
    if (OUTPUT) {
        const float* sp = g ? st_in1 : st_in0; const int np = g ? npre1 : npre0;
#pragma unroll 1
        for (int k = 0; k < np; ++k) { const float* e = sp + (size_t)k * ML_STATE_F;
            const float mloc = e[8192 + 64], B = e[8192 + 65];
            const float mnew = fmaxf(B + m_prev, mloc), al = __expf(B + m_prev - mnew), be = __expf(mloc - mnew);
            const float* ep = e + (4 * hh) * 128 + 32 * j + r;
#pragma unroll
            for (int dt = 0; dt < 2; ++dt)
#pragma unroll
                for (int i = 0; i < 16; ++i) C[dt][i] = al * C[dt][i] + be * ep[(32 * dt + (i & 3) + 8 * (i >> 2)) * 128];
            nreg = al * nreg + be * e[8192 + 16 * j + (lane & 15)];
            m_prev = mnew; }
    }
    if (lane < 16) NV[16 * j + lane] = nreg;
    constexpr int NPF = OUTPUT ? SCAN_PF_OUT : 2;
    MlPref PP[NPF]; ml_issue(PP[0], proj, qkc, gates, rowbase, seg_t0 + 64 * (g ? nch - 1 : 0), g, h, tg, lane, OUTPUT);
    if (NPF == 2) ml_issue(PP[NPF - 1], proj, qkc, gates, rowbase, seg_t0 + 64 * (g ? nch - 2 : 1), g, h, tg, lane, OUTPUT);
    __syncthreads();
#pragma unroll 1
    for (int step2 = 0; step2 < nch; step2 += NPF) {
#pragma unroll
    for (int hf = 0; hf < NPF; ++hf) { const int step = step2 + hf; MlPref& P = PP[hf];
        const int tgs = launder_v(tg), lns = launder_v(lane);
        const int r = lns & 31, hh = lns >> 5;
        const FragOff fq = frag_off(lns, ML_LDQ), fv = frag_off(lns, ML_LDV);
        const int o_h4 = 16 * hh;
        const int o_obw = (4 * hh * 36 + r) * 4, o_obr = ((lns >> 1) * 36 + 16 * (lns & 1)) * 4;
        const int ci = g ? nch - 1 - step : step;
        const int par = step & 1;
        float decay;
        {
            const float xi = P.gi, lf = P.gf;
            const float bc = wave_scan_add(lf);
            const float a = xi - bc; const float pm = wave_scan_max(a);
            const float Mt = fmaxf(m_prev, pm);
            const float Ml = lane63(Mt), bl = lane63(bc);
            GS[lns] = a; GS[64 + lns] = Mt; GS[128 + lns] = __expf(m_prev - Mt); GS[192 + lns] = __expf(-(bc + Mt)); GS[256 + lns] = __expf(a - Ml);
            decay = __expf(m_prev - Ml); m_prev = bl + Ml; btot += bl;
        }
        LDS_WAIT(); CFENCE();
        {
            const int c8 = tgs & 7;
#pragma unroll
            for (int i = 0; i < 2; ++i) { const int tau = (tgs + 256 * i) >> 3; const ldsp tp = gb + (tau * ML_LDQ + c8 * 8) * 2;
                if (OUTPUT) { *(LAS v4u*)(tp + ML_QC) = P.q[i]; *(LAS v4u*)(tp + ML_KC) = P.k[i]; }
                float o[8]; unpack8(P.k[i], o); const float wkk = GS[256 + tau]; v4u w;
                w.x = pk2(o[0] * wkk, o[1] * wkk); w.y = pk2(o[2] * wkk, o[3] * wkk); w.z = pk2(o[4] * wkk, o[5] * wkk); w.w = pk2(o[6] * wkk, o[7] * wkk);
                *(LAS v4u*)(tp + ML_KH) = w; }
#pragma unroll
            for (int i = 0; i < 4; ++i) { const int p = tgs + 256 * i, tau = p >> 4, cc = p & 15; *(LAS v4u*)(gb + ML_V + (tau * ML_LDV + cc * 8) * 2) = P.v[i]; }
        }
        if (step + NPF < nch) ml_issue(P, proj, qkc, gates, rowbase, seg_t0 + 64 * (g ? nch - 1 - NPF - step : step + NPF), g, h, tgs, lns, OUTPUT);
        __syncthreads();
        if (OUTPUT) {
            bf16* hx = g ? hx1 : hx0;
#pragma unroll
            for (int tt = 0; tt < 2; ++tt) {
                f32x16 acc = zero16();
#pragma unroll
                for (int dt = 0; dt < 2; ++dt)
#pragma unroll
                    for (int sp = 0; sp < 2; ++sp) acc = MFMA32(lds8x2(gb + ML_QC + fq.o_perm + (32 * tt * ML_LDQ + 32 * dt + 16 * sp) * 2), pack8(C[dt], sp), acc);
#pragma unroll
                for (int q4 = 0; q4 < 4; ++q4) { const f32x4 wv = *(const LAS f32x4*)(GSb + o_h4 + (128 + 32 * tt + 8 * q4) * 4);
#pragma unroll
                    for (int e = 0; e < 4; ++e) acc[4 * q4 + e] *= wv[e]; }
                const float Mt = GS[64 + 32 * tt + r];
                float den = 0.f;
#pragma unroll
                for (int st = 0; st <= tt; ++st) {
                    f32x16 s = zero16();
#pragma unroll
                    for (int ks = 0; ks < 4; ++ks) s = MFMA32(lds16(gb + ML_KC + fq.o_row + (32 * st * ML_LDQ + 16 * ks) * 2), lds16(gb + ML_QC + fq.o_row + (32 * tt * ML_LDQ + 16 * ks) * 2), s);
#pragma unroll
                    for (int q4 = 0; q4 < 4; ++q4) { const f32x4 av = *(const LAS f32x4*)(GSb + o_h4 + (32 * st + 8 * q4) * 4);
#pragma unroll
                        for (int e = 0; e < 4; ++e) { const int i = 4 * q4 + e; const int srow = 32 * st + crow(i, hh); const float pv = (srow <= 32 * tt + r) ? s[i] * __expf(av[e] - Mt) : 0.f; s[i] = pv; den += pv; } }
                    const bf16x8 pa0 = pack8(s, 0), pa1 = pack8(s, 1);
                    acc = MFMA32(pa0, ldstr2(gb + ML_V + fv.o_trp + vcol + ((32 * st) * ML_LDV) * 2, 8 * ML_LDV * 2), acc);
                    acc = MFMA32(pa1, ldstr2(gb + ML_V + fv.o_trp + vcol + ((32 * st + 16) * ML_LDV) * 2, 8 * ML_LDV * 2), acc);
                    }
                float qn;
                { float q0 = 0.f, q1 = 0.f, q2 = 0.f, q3 = 0.f;
#pragma unroll
                for (int c4 = 0; c4 < 4; ++c4) { const v4u qw = *(const LAS v4u*)(gb + ML_QC + (r * ML_LDQ + 32 * hh) * 2 + (32 * tt * ML_LDQ + 8 * c4) * 2); float qx[8]; unpack8(qw, qx);
                    const f32x4 n0 = *(const LAS f32x4*)(gb + ML_NV + 8 * o_h4 + (par * 64 + 8 * c4) * 4), n1 = *(const LAS f32x4*)(gb + ML_NV + 8 * o_h4 + (par * 64 + 8 * c4 + 4) * 4);
                    q0 += qx[0] * n0[0] + qx[4] * n1[0]; q1 += qx[1] * n0[1] + qx[5] * n1[1]; q2 += qx[2] * n0[2] + qx[6] * n1[2]; q3 += qx[3] * n0[3] + qx[7] * n1[3]; }
                qn = (q0 + q1) + (q2 + q3); }
                den = sum_halves(den); qn = sum_halves(qn);
                const float dtot = den + GS[128 + 32 * tt + r] * qn;
                const float inv = __builtin_amdgcn_rcpf(fmaxf(fabsf(dtot), GS[192 + 32 * tt + r]));
                if (hh == 0) *(LAS float*)(INVb + (32 * tt + r) * 4) = inv;
                LDS_WAIT(); CFENCE();
                f32x16 hv;
#pragma unroll
                for (int q4 = 0; q4 < 4; ++q4) { const f32x4 iv = *(const LAS f32x4*)(INVb + o_h4 + (32 * tt + 8 * q4) * 4);
#pragma unroll
                    for (int e = 0; e < 4; ++e) { const int i = 4 * q4 + e; hv[i] = acc[i] * iv[e]; } }
#pragma unroll
                for (int i = 0; i < 16; ++i) *(LAS float*)(OBb + o_obw + ((i & 3) + 8 * (i >> 2)) * 144) = hv[i];
                LDS_WAIT(); CFENCE();
                { const f32x4 x0 = *(const LAS f32x4*)(OBb + o_obr), x1 = *(const LAS f32x4*)(OBb + o_obr + 16), x2 = *(const LAS f32x4*)(OBb + o_obr + 32), x3 = *(const LAS f32x4*)(OBb + o_obr + 48);
                    const int tau = 32 * tt + (lns >> 1); const int t = seg_t0 + 64 * ci + (g ? 63 - tau : tau);
                    bf16* op = hx + (size_t)(rowbase + t) * D + h * 128 + 32 * j + 16 * (lns & 1);
                    v4u w0, w1; w0.x = pk2(x0[0], x0[1]); w0.y = pk2(x0[2], x0[3]); w0.z = pk2(x1[0], x1[1]); w0.w = pk2(x1[2], x1[3]); w1.x = pk2(x2[0], x2[1]); w1.y = pk2(x2[2], x2[3]); w1.z = pk2(x3[0], x3[1]); w1.w = pk2(x3[2], x3[3]);
                    *(GAS v4u*)op = w0; *(GAS v4u*)(op + 8) = w1; }
                LDS_WAIT(); CFENCE();
            }
        }
        __builtin_amdgcn_sched_barrier(0);
#pragma unroll
        for (int dt = 0; dt < 2; ++dt) {
#pragma unroll
            for (int i = 0; i < 16; ++i) C[dt][i] *= decay;
#pragma unroll
            for (int ks = 0; ks < 4; ++ks) C[dt] = MFMA32(ldstr2(gb + ML_KH + fq.o_trn + (16 * ks * ML_LDQ + 32 * dt) * 2, 4 * ML_LDQ * 2), ldstr2(gb + ML_V + fv.o_trn + vcol + (16 * ks * ML_LDV) * 2, 4 * ML_LDV * 2), C[dt]);
        }
        {   const int dkl = 16 * j + (lns & 15), tq = lns >> 4; float s0 = 0.f, s1 = 0.f;
#pragma unroll
            for (int i = 0; i < 16; i += 2) { s0 += bf2f(*(const LAS bf16*)(gb + ML_KH + ((16 * tq + i) * ML_LDQ + dkl) * 2)); s1 += bf2f(*(const LAS bf16*)(gb + ML_KH + ((16 * tq + i + 1) * ML_LDQ + dkl) * 2)); }
            float sacc = s0 + s1; sacc += __shfl_xor(sacc, 16); sacc = sum_halves(sacc);
            nreg = decay * nreg + sacc; if (lns < 16) NV[(par ^ 1) * 64 + dkl] = nreg; }
        __syncthreads();
    } }
    if (OUTPUT) item_headnorm(launder_v(tid_l), hx0, hx1, proj, NP_M, 2048, ghead + h * 128, aout, S0.rowbase, S0.t0, S0.nchunk * 64, h);
    if (!OUTPUT) {
        float* e = g ? st_out1 : st_out0; float* ep = e + (4 * hh) * 128 + 32 * j + r;
#pragma unroll
        for (int dt = 0; dt < 2; ++dt)
#pragma unroll
            for (int i = 0; i < 16; ++i) ep[(32 * dt + (i & 3) + 8 * (i >> 2)) * 128] = C[dt][i];
        if (lane < 16) e[8192 + 16 * j + lane] = nreg;
        if (j == 0 && lane == 0) { e[8192 + 64] = m_prev; e[8192 + 65] = btot; }
    }
}

constexpr int MS_KH = 0, MS_V = 9216, MS_BUF = 26624, MS_W = 2 * MS_BUF  ;
static_assert(MS_W + 34 * 64 * 4 <= ML_GROUP, "mLSTM S1 LDS map");
struct MsPref { v4u k[2], v[4]; };
__device__ __forceinline__ void ms_issue(MsPref& P, const bf16* proj, const bf16* qkc, int rowbase, int t0c, int g, int h, int tg) {
    const int c8q = tg & 7;
#pragma unroll
    for (int i = 0; i < 2; ++i) { const int tau = (tg + 256 * i) >> 3; const int t = t0c + (g ? 63 - tau : tau);
        P.k[i] = *(const GAS v4u*)(qkc + (size_t)(rowbase + t) * D + 512 + h * 64 + c8q * 8); }
#pragma unroll
    for (int i = 0; i < 4; ++i) { const int p = tg + 256 * i, tau = p >> 4, c8 = p & 15; const int t = t0c + (g ? 63 - tau : tau);
        P.v[i] = *(const GAS v4u*)(proj + (size_t)(rowbase + t) * NP_M + 1024 + h * 128 + c8 * 8); }
}
__device__ __forceinline__ void mlstm_s1_item(Frame& F, const bf16* proj, const bf16* qkc, const float* gates, int h, MlSeg S0, MlSeg S1, float* st_out0, float* st_out1) {
    const int tid_l = launder_v(F.tid); const int wave_l = __builtin_amdgcn_readfirstlane(tid_l >> 6);
    const int g = wave_l >> 2, j = wave_l & 3, tg = tid_l & 255, lane = tid_l & 63, r = lane & 31, hh = lane >> 5;
    const ldsp gb = F.lds + g * ML_GROUP;
    LAS float* W = (LAS float*)(gb + MS_W);
    const int rowbase = g ? S1.rowbase : S0.rowbase, seg_t0 = g ? S1.t0 : S0.t0, nch = g ? S1.nchunk : S0.nchunk;
    __syncthreads();
    MsPref PP[2]; ms_issue(PP[0], proj, qkc, rowbase, seg_t0 + 64 * (g ? nch - 1 : 0), g, h, tg);
    ms_issue(PP[1], proj, qkc, rowbase, seg_t0 + 64 * (g ? nch - 2 : 1), g, h, tg);
    float m_loc, btot;
    {
        float carry = 0.f, mx = -3.0e38f;
#pragma unroll 1
        for (int c = 0; c < nch; ++c) { const int ci = g ? nch - 1 - c : c; const int t = seg_t0 + 64 * ci + (g ? 63 - lane : lane);
            const GAS float* gp = (const GAS float*)(gates + (size_t)(rowbase + t) * 32 + g * 16 + h); const float xi = gp[0], lf = gp[8];
            const float bc = carry + wave_scan_add(lf); const float a = xi - bc;
            if (j == 0) W[64 * c + lane] = a;
            mx = fmaxf(mx, a); carry = lane63(bc); }
        mx = fmaxf(mx, __shfl_xor(mx, 1)); mx = fmaxf(mx, __shfl_xor(mx, 2)); mx = fmaxf(mx, __shfl_xor(mx, 4)); mx = fmaxf(mx, __shfl_xor(mx, 8)); mx = fmaxf(mx, __shfl_xor(mx, 16)); mx = fmaxf(mx, __shfl_xor(mx, 32));
        btot = carry; m_loc = btot + mx;
        __syncthreads();
        for (int s = tg; s < 64 * nch; s += 256) W[s] = __expf(W[s] - mx);
    }
    f32x16 C[2]; C[0] = zero16(); C[1] = zero16(); float nreg = 0.f;
    __syncthreads();
#pragma unroll 1
    for (int step2 = 0; step2 < nch; step2 += 2) {
#pragma unroll
    for (int hf = 0; hf < 2; ++hf) { const int step = step2 + hf; MsPref& P = PP[hf];
        const int tgs = launder_v(tg), lns = launder_v(lane);
        const FragOff fq = frag_off(lns, ML_LDQ), fv = frag_off(lns, ML_LDV);
        const ldsp bb = gb + hf * MS_BUF;
        {   const int c8 = tgs & 7;
#pragma unroll
            for (int i = 0; i < 2; ++i) { const int tau = (tgs + 256 * i) >> 3; float o[8]; unpack8(P.k[i], o); const float wkk = W[64 * step + tau]; v4u w;
                w.x = pk2(o[0] * wkk, o[1] * wkk); w.y = pk2(o[2] * wkk, o[3] * wkk); w.z = pk2(o[4] * wkk, o[5] * wkk); w.w = pk2(o[6] * wkk, o[7] * wkk);
                *(LAS v4u*)(bb + MS_KH + (tau * ML_LDQ + c8 * 8) * 2) = w; }
#pragma unroll
            for (int i = 0; i < 4; ++i) { const int p = tgs + 256 * i, tau = p >> 4, cc = p & 15; *(LAS v4u*)(bb + MS_V + (tau * ML_LDV + cc * 8) * 2) = P.v[i]; }
        }
        if (step + 2 < nch) ms_issue(P, proj, qkc, rowbase, seg_t0 + 64 * (g ? nch - 3 - step : step + 2), g, h, tgs);
        __syncthreads();
#pragma unroll
        for (int dt = 0; dt < 2; ++dt)
#pragma unroll
            for (int ks = 0; ks < 4; ++ks) C[dt] = MFMA32(ldstr2(bb + MS_KH + fq.o_trn + (16 * ks * ML_LDQ + 32 * dt) * 2, 4 * ML_LDQ * 2), ldstr2(bb + MS_V + fv.o_trn + 64 * j + (16 * ks * ML_LDV) * 2, 4 * ML_LDV * 2), C[dt]);
        {   const int dkl = 16 * j + (lns & 15), tq = lns >> 4; float s0 = 0.f, s1 = 0.f;
#pragma unroll
            for (int i = 0; i < 16; i += 2) { s0 += bf2f(*(const LAS bf16*)(bb + MS_KH + ((16 * tq + i) * ML_LDQ + dkl) * 2)); s1 += bf2f(*(const LAS bf16*)(bb + MS_KH + ((16 * tq + i + 1) * ML_LDQ + dkl) * 2)); }
            float sacc = s0 + s1; sacc += __shfl_xor(sacc, 16); sacc = sum_halves(sacc); nreg += sacc; }
    } }
    float* e = g ? st_out1 : st_out0; float* ep = e + (4 * hh) * 128 + 32 * j + r;
#pragma unroll
    for (int dt = 0; dt < 2; ++dt)
#pragma unroll
        for (int i = 0; i < 16; ++i) ep[(32 * dt + (i & 3) + 8 * (i >> 2)) * 128] = C[dt][i];
    if (lane < 16) e[8192 + 16 * j + lane] = nreg;
    if (j == 0 && lane == 0) { e[8192 + 64] = m_loc; e[8192 + 65] = btot; }
}

constexpr int HG_LD = 136;
constexpr int HG_LF = 0, HG_QT = 16384, HG_KT = 25088, HG_KH = 33792, HG_V = 42496, HG_OB = 51200, HG_AUX = 69632, HG_SSQ = 71168, HG_EAM = 71680, HG_BIAS = 72192, HG_LBV = 72704, HG_GROUP = 73728;
static_assert(2 * HG_GROUP <= LDS_MAIN, "HGRN2 LDS map");
constexpr int HG_STATE_F = 16512;

struct HgPref { unsigned q[8], f[8]; v4u v[2]; };
__device__ __forceinline__ void hg_issue(HgPref& P, const bf16* proj, int rowbase, int t0c, int g, int h, int tg, bool need_q) {
    const int lane = tg & 63, j = tg >> 6, cp = lane & 15, tq = lane >> 4, c0 = 32 * j + 2 * cp;
#pragma unroll
    for (int i = 0; i < 8; ++i) { const int tau = 8 * tq + i; const int t = t0c + (g ? 31 - tau : tau);
        const bf16* rp = proj + (size_t)(rowbase + t) * NP_H + h * 128 + c0;
        P.q[i] = need_q ? *(const GAS unsigned*)rp : 0u; P.f[i] = *(const GAS unsigned*)(rp + 2048 + 1024 * g); }
#pragma unroll
    for (int i = 0; i < 2; ++i) { const int p = tg + 256 * i, tau = p >> 4, c8 = p & 15; const int t = t0c + (g ? 31 - tau : tau);
        P.v[i] = *(const GAS v4u*)(proj + (size_t)(rowbase + t) * NP_H + 1024 + h * 128 + c8 * 8); }
}
__device__ __forceinline__ float clamp80(float x) { return fminf(fmaxf(x, -80.f), 80.f); }

template <bool OUTPUT>
__device__ __forceinline__ void hgrn_item(Frame& F, const bf16* proj, bf16* hx0, bf16* hx1, bf16* aout, const float* ghead, const float* bf_, const float* lbraw, int jl,
                                          int h, MlSeg S0, MlSeg S1, const float* st_in0, const float* st_in1, int npre0, int npre1, float* st_out0, float* st_out1) {
    const int tid_l = launder_v(F.tid); const int wave_l = __builtin_amdgcn_readfirstlane(tid_l >> 6);
    const int g = wave_l >> 2, j = wave_l & 3, tg = tid_l & 255, lane = tid_l & 63, r = lane & 31, hh = lane >> 5;
    const ldsp gb = F.lds + g * HG_GROUP;
    LAS float* LF = (LAS float*)(gb + HG_LF);
    const ldsp OBb = gb + HG_OB + j * 4608;
    LAS float* AMID = (LAS float*)(gb + HG_AUX); LAS float* ALAST = AMID + 128; LAS float* DEC = AMID + 256;
    LAS float* SSQ = (LAS float*)(gb + HG_SSQ); LAS float* EAM = (LAS float*)(gb + HG_EAM); LAS float* BIASV = (LAS float*)(gb + HG_BIAS); LAS float* LBV = (LAS float*)(gb + HG_LBV);
    const int rowbase = g ? S1.rowbase : S0.rowbase, seg_t0 = g ? S1.t0 : S0.t0, nch = g ? S1.nchunk : S0.nchunk;
    const int vcol = 64 * j;
    __syncthreads();
    if (tg < 128) { const int c = h * 128 + tg; BIASV[tg] = bf_[g * 1024 + c]; LBV[tg] = jl == 0 ? 0.f : sigmoidf_(lbraw[(1 * 2 + g) * 1024 + c] - lbraw[(0 * 2 + g) * 1024 + c]); }
    f32x16 St[4];
#pragma unroll
    for (int dt = 0; dt < 4; ++dt) St[dt] = zero16();
    float atot0 = 0.f, atot1 = 0.f;
    if (OUTPUT) {   const float* sp = g ? st_in1 : st_in0; const int np = g ? npre1 : npre0;
#pragma unroll 1
        for (int k = 0; k < np; ++k) { const float* e = sp + (size_t)k * HG_STATE_F; const float* ep = e + (4 * hh) * 128 + 32 * j + r; const float* ap = e + 16384 + 4 * hh;
#pragma unroll
            for (int dt = 0; dt < 4; ++dt)
#pragma unroll
                for (int i = 0; i < 16; ++i) { const int dk0 = 32 * dt + (i & 3) + 8 * (i >> 2); St[dt][i] = __expf(ap[dk0]) * St[dt][i] + ep[dk0 * 128]; } }
    }
    constexpr int NPF = OUTPUT ? SCAN_PF_OUT : 2;
    HgPref PP[NPF]; hg_issue(PP[0], proj, rowbase, seg_t0 + 32 * (g ? nch - 1 : 0), g, h, tg, OUTPUT);
    if (NPF == 2) hg_issue(PP[NPF - 1], proj, rowbase, seg_t0 + 32 * (g ? nch - 2 : 1), g, h, tg, OUTPUT);
    __syncthreads();
#pragma unroll 1
    for (int step2 = 0; step2 < nch; step2 += NPF) {
#pragma unroll
    for (int hf = 0; hf < NPF; ++hf) { const int step = step2 + hf; HgPref& P = PP[hf];
        const int tgs = launder_v(tg), lns = launder_v(lane);
        const int r = lns & 31, hh = lns >> 5;
        const FragOff fo = frag_off(lns, HG_LD);
        const int o_h4 = 16 * hh;
        const int o_obw = (4 * hh * 36 + r) * 4, o_obr = ((lns >> 1) * 36 + 16 * (lns & 1)) * 4;
        const int ci = g ? nch - 1 - step : step;
        {
            const int cp = lns & 15, tq = lns >> 4, c0 = 32 * j + 2 * cp;
            const f32x2_t bb = *(const LAS f32x2_t*)(BIASV + c0), ll = *(const LAS f32x2_t*)(LBV + c0);
            float a0[8], a1[8], k0[8], k1[8]; float r0 = 0.f, r1 = 0.f;
#pragma unroll
            for (int i = 0; i < 8; ++i) { const float s0 = sigmoidf_(bflo(P.f[i]) + bb.x), s1 = sigmoidf_(bfhi(P.f[i]) + bb.y);
                const float f0 = ll.x + (1.f - ll.x) * s0, f1 = ll.y + (1.f - ll.y) * s1;
                r0 += __logf(fmaxf(f0, 1e-37f)); r1 += __logf(fmaxf(f1, 1e-37f)); a0[i] = r0; a1[i] = r1; k0[i] = 1.f - f0; k1[i] = 1.f - f1; }
            LAS f32x2_t* XT = (LAS f32x2_t*)(gb + HG_LF + j * 512);
            XT[tq * 16 + cp] = (f32x2_t){r0, r1};
            LDS_WAIT(); CFENCE();
            const f32x2_t t0 = XT[cp], t1 = XT[16 + cp], t2 = XT[32 + cp], t3 = XT[48 + cp];
            LDS_WAIT(); CFENCE();
            const float am0 = t0.x + t1.x, am1 = t0.y + t1.y, al0 = am0 + t2.x + t3.x, al1 = am1 + t2.y + t3.y;
            const float pre0 = (tq > 0 ? t0.x : 0.f) + (tq > 1 ? t1.x : 0.f) + (tq > 2 ? t2.x : 0.f), pre1 = (tq > 0 ? t0.y : 0.f) + (tq > 1 ? t1.y : 0.f) + (tq > 2 ? t2.y : 0.f);
            const float el0 = __expf(al0 - am0), el1 = __expf(al1 - am1);
            if (tq == 0) { *(LAS f32x2_t*)(DEC + c0) = (f32x2_t){__expf(al0), __expf(al1)}; *(LAS f32x2_t*)(EAM + c0) = (f32x2_t){__expf(am0), __expf(am1)}; atot0 += al0; atot1 += al1; }
#pragma unroll
            for (int i = 0; i < 8; ++i) { const int tau = 8 * tq + i; const ldsp tp = gb + (tau * HG_LD + c0) * 2;
                const float e0 = __expf(clamp80(a0[i] + pre0 - am0)), e1 = __expf(clamp80(a1[i] + pre1 - am1));
                const float kt0 = k0[i] * __builtin_amdgcn_rcpf(e0), kt1 = k1[i] * __builtin_amdgcn_rcpf(e1);
                if (OUTPUT) { *(LAS unsigned*)(tp + HG_QT) = pk2(bflo(P.q[i]) * e0, bfhi(P.q[i]) * e1); *(LAS unsigned*)(tp + HG_KT) = pk2(kt0, kt1); }
                *(LAS unsigned*)(tp + HG_KH) = pk2(kt0 * el0, kt1 * el1); }
#pragma unroll
            for (int i = 0; i < 2; ++i) { const int p = tgs + 256 * i; *(LAS v4u*)(gb + HG_V + ((p >> 4) * HG_LD + (p & 15) * 8) * 2) = P.v[i]; }
        }
        if (step + NPF < nch) hg_issue(P, proj, rowbase, seg_t0 + 32 * (g ? nch - 1 - NPF - step : step + NPF), g, h, tgs, OUTPUT);
        __syncthreads();
        if (OUTPUT) {
            bf16* hx = g ? hx1 : hx0;
            f32x16 s = zero16();
#pragma unroll
            for (int ks = 0; ks < 8; ++ks) s = MFMA32(lds16(gb + HG_KT + fo.o_row + 32 * ks), lds16(gb + HG_QT + fo.o_row + 32 * ks), s);
#pragma unroll
            for (int i = 0; i < 16; ++i) s[i] = (crow(i, hh) <= r) ? s[i] : 0.f;
            f32x16 o = zero16();
#pragma unroll
            for (int sp = 0; sp < 2; ++sp) o = MFMA32(pack8(s, sp), ldstr2(gb + HG_V + fo.o_trp + vcol + (16 * sp * HG_LD) * 2, 8 * HG_LD * 2), o);
#pragma unroll
            for (int dt = 0; dt < 4; ++dt)
#pragma unroll
                for (int sp = 0; sp < 2; ++sp) { const f32x4 e0 = *(const LAS f32x4*)(gb + HG_EAM + o_h4 + (32 * dt + 16 * sp) * 4), e1 = *(const LAS f32x4*)(gb + HG_EAM + o_h4 + (32 * dt + 16 * sp + 8) * 4);
                    v4u pw; pw.x = cvtpk(St[dt][8 * sp] * e0[0], St[dt][8 * sp + 1] * e0[1]); pw.y = cvtpk(St[dt][8 * sp + 2] * e0[2], St[dt][8 * sp + 3] * e0[3]);
                    pw.z = cvtpk(St[dt][8 * sp + 4] * e1[0], St[dt][8 * sp + 5] * e1[1]); pw.w = cvtpk(St[dt][8 * sp + 6] * e1[2], St[dt][8 * sp + 7] * e1[3]);
                    o = MFMA32(lds8x2(gb + HG_QT + fo.o_perm + (32 * dt + 16 * sp) * 2), __builtin_bit_cast(bf16x8, pw), o); }
#pragma unroll
            for (int i = 0; i < 16; ++i) *(LAS float*)(OBb + o_obw + ((i & 3) + 8 * (i >> 2)) * 144) = o[i];
            LDS_WAIT(); CFENCE();
            { const f32x4 x0 = *(const LAS f32x4*)(OBb + o_obr), x1 = *(const LAS f32x4*)(OBb + o_obr + 16), x2 = *(const LAS f32x4*)(OBb + o_obr + 32), x3 = *(const LAS f32x4*)(OBb + o_obr + 48);
                const int tau = lns >> 1; const int t = seg_t0 + 32 * ci + (g ? 31 - tau : tau);
                bf16* op = hx + (size_t)(rowbase + t) * D + h * 128 + 32 * j + 16 * (lns & 1);
                v4u w0, w1; w0.x = pk2(x0[0], x0[1]); w0.y = pk2(x0[2], x0[3]); w0.z = pk2(x1[0], x1[1]); w0.w = pk2(x1[2], x1[3]); w1.x = pk2(x2[0], x2[1]); w1.y = pk2(x2[2], x2[3]); w1.z = pk2(x3[0], x3[1]); w1.w = pk2(x3[2], x3[3]);
                *(GAS v4u*)op = w0; *(GAS v4u*)(op + 8) = w1; }
            LDS_WAIT(); CFENCE();
        }
#pragma unroll
        for (int dt = 0; dt < 4; ++dt) {
#pragma unroll
            for (int q4 = 0; q4 < 4; ++q4) { const f32x4 dv = *(const LAS f32x4*)(gb + HG_AUX + 1024 + o_h4 + (32 * dt + 8 * q4) * 4);
#pragma unroll
                for (int e = 0; e < 4; ++e) St[dt][4 * q4 + e] *= dv[e]; }
#pragma unroll
            for (int sp = 0; sp < 2; ++sp) St[dt] = MFMA32(ldstr2(gb + HG_KH + fo.o_trn + (16 * sp * HG_LD + 32 * dt) * 2, 4 * HG_LD * 2), ldstr2(gb + HG_V + fo.o_trn + vcol + (16 * sp * HG_LD) * 2, 4 * HG_LD * 2), St[dt]);
        }
        __syncthreads();
    } }
    if (OUTPUT) item_headnorm(launder_v(tid_l), hx0, hx1, proj, NP_H, 4096, ghead + h * 128, aout, S0.rowbase, S0.t0, S0.nchunk * 32, h);
    if (!OUTPUT) {
        float* e = g ? st_out1 : st_out0; float* ep = e + (4 * hh) * 128 + 32 * j + r;
#pragma unroll
        for (int dt = 0; dt < 4; ++dt)
#pragma unroll
            for (int i = 0; i < 16; ++i) ep[(32 * dt + (i & 3) + 8 * (i >> 2)) * 128] = St[dt][i];
        if ((lane >> 4) == 0) { e[16384 + 32 * j + 2 * (lane & 15)] = atot0; e[16384 + 32 * j + 2 * (lane & 15) + 1] = atot1; }
    }
}

constexpr int PH_PER_LAYER = 11, PH_BASE = 2, N_PHASES = PH_BASE + DEPTH * PH_PER_LAYER;
#ifndef EN_GEMM
#define EN_GEMM 0xff
#endif
#ifndef EN_ML
#define EN_ML 3
#endif
#ifndef EN_HG
#define EN_HG 3
#endif
#ifndef EN_TOK
#define EN_TOK 1
#endif
#ifndef EN_MISC
#define EN_MISC 1
#endif
#ifndef PG_SP2
#define PG_SP2 true
#endif
#ifndef PG_ALIGN
#define PG_ALIGN true
#endif
#ifndef TIMER_MASK
#define TIMER_MASK 0ull
#endif
#ifndef TIMER_DIV
#define TIMER_DIV 20.0f
#endif
#ifndef MK_SPLIT
#define MK_SPLIT 0
#endif


__device__ __forceinline__ void phase_headnorm(Frame& F, const bf16* hf, const bf16* hb, const bf16* gate, int gpitch, int gcol0, const float* ghead, bf16* aout, int nrows) {
    const int tid = launder_v(F.tid); const int lane = tid & 63, wave = __builtin_amdgcn_readfirstlane(tid >> 6);
    const int gw = F.bid * NWAVES + wave, NGW = F.G * NWAVES;
    float gh[16];
#pragma unroll
    for (int e = 0; e < 16; ++e) gh[e] = ghead[lane * 16 + e];
    for (int row = gw; row < nrows; row += NGW) {
        const v4u a0 = *(const v4u*)(hf + (size_t)row * D + lane * 16), a1 = *(const v4u*)(hf + (size_t)row * D + lane * 16 + 8);
        const v4u b0 = *(const v4u*)(hb + (size_t)row * D + lane * 16), b1 = *(const v4u*)(hb + (size_t)row * D + lane * 16 + 8);
        const v4u g0 = *(const v4u*)(gate + (size_t)row * gpitch + gcol0 + lane * 16), g1 = *(const v4u*)(gate + (size_t)row * gpitch + gcol0 + lane * 16 + 8);
        float x[16], y[8], o[16]; unpack8(a0, y);
#pragma unroll
        for (int e = 0; e < 8; ++e) x[e] = y[e];
        unpack8(a1, y);
#pragma unroll
        for (int e = 0; e < 8; ++e) x[8 + e] = y[e];
        unpack8(b0, y);
#pragma unroll
        for (int e = 0; e < 8; ++e) x[e] += y[e];
        unpack8(b1, y);
#pragma unroll
        for (int e = 0; e < 8; ++e) x[8 + e] += y[e];
        float ss = 0.f;
#pragma unroll
        for (int e = 0; e < 16; ++e) ss += x[e] * x[e];
        ss += __shfl_xor(ss, 1); ss += __shfl_xor(ss, 2); ss += __shfl_xor(ss, 4);
        const float rs = rsqrtf(ss * (1.f / 128.f) + EPS);
        unpack8(g0, y);
#pragma unroll
        for (int e = 0; e < 8; ++e) o[e] = x[e] * rs * gh[e] * sigmoidf_(y[e]);
        unpack8(g1, y);
#pragma unroll
        for (int e = 0; e < 8; ++e) o[8 + e] = x[8 + e] * rs * gh[8 + e] * sigmoidf_(y[e]);
        v4u w0, w1; w0.x = pk2(o[0], o[1]); w0.y = pk2(o[2], o[3]); w0.z = pk2(o[4], o[5]); w0.w = pk2(o[6], o[7]); w1.x = pk2(o[8], o[9]); w1.y = pk2(o[10], o[11]); w1.z = pk2(o[12], o[13]); w1.w = pk2(o[14], o[15]);
        *(v4u*)(aout + (size_t)row * D + lane * 16) = w0; *(v4u*)(aout + (size_t)row * D + lane * 16 + 8) = w1;
    }
}

__device__ __forceinline__ void phase_conv(Frame& F, const bf16* proj, bf16* qkc, float* gates, const float* wconv, const float* bgate) {
    const int gt = F.bid * NTHR + F.tid, cp = gt & 127, rstep = (F.G * NTHR) >> 7;
    float w[3][8];
#pragma unroll
    for (int d = 0; d < 3; ++d)
#pragma unroll
        for (int e = 0; e < 8; ++e) w[d][e] = wconv[d * 1024 + cp * 8 + e];
    const float sc = cp >= 64 ? 0.125f : 1.0f;
    for (int row = gt >> 7; row < M_ALL; row += rstep) {
        int t, len; if (row < M_LAT) { t = row & (SEQ - 1); len = SEQ; } else { t = (row - M_LAT) & (CTXL - 1); len = CTXL; }
        const bf16* rp = proj + (size_t)row * NP_M + cp * 8;
        const v4u z = (v4u){0u, 0u, 0u, 0u};
        const v4u r0 = t > 0 ? *(const v4u*)(rp - NP_M) : z, r1 = *(const v4u*)rp, r2 = t + 1 < len ? *(const v4u*)(rp + NP_M) : z;
        float x0[8], x1[8], x2[8], o[8]; unpack8(r0, x0); unpack8(r1, x1); unpack8(r2, x2);
#pragma unroll
        for (int e = 0; e < 8; ++e) o[e] = sc * siluf_(w[0][e] * x0[e] + w[1][e] * x1[e] + w[2][e] * x2[e]);
        v4u q; q.x = pk2(o[0], o[1]); q.y = pk2(o[2], o[3]); q.z = pk2(o[4], o[5]); q.w = pk2(o[6], o[7]);
        *(v4u*)(qkc + (size_t)row * D + cp * 8) = q;
    }
    for (int i = gt; i < M_ALL * 32; i += F.G * NTHR) { const int c = i & 31; const float x = gates[i] + bgate[c];
        gates[i] = ((c >> 3) & 1) ? (fminf(x, 0.f) - __logf(1.f + __expf(-fabsf(x)))) : x; }
}

__device__ __forceinline__ void timer_stamp(unsigned char* lds_raw, bool add) {
    if (threadIdx.x == 0) { volatile LAS unsigned* tw = (volatile LAS unsigned*)((LAS unsigned char*)lds_raw + LDSCTL_OFF) + 32;
        const unsigned long long t = wall_clock64(); const unsigned long long last = ((unsigned long long)tw[1] << 32) | tw[0];
        if (add) { unsigned long long acc = ((unsigned long long)tw[3] << 32) | tw[2]; acc += t - last; tw[2] = (unsigned)acc; tw[3] = (unsigned)(acc >> 32); }
        tw[0] = (unsigned)t; tw[1] = (unsigned)(t >> 32); }
}

__device__ __forceinline__ void seg_of(bool odd, bool ctx_out, int q, int& t0, int& len) {
    int a, b; if (!ctx_out) { a = 2048; b = 2048; } else if (!odd) { a = 30 * 64; b = 34 * 64; } else { a = 60 * 32; b = 68 * 32; }
    t0 = (q == 0) ? 0 : (q == 1) ? a : (q == 2) ? a + b : a + 2 * b; len = (q == 0 || q == 3) ? a : b;
}

__device__ __forceinline__ Frame mkframe(const Args& args, unsigned char* lds_raw) {
    Frame F; int t = threadIdx.x; asm volatile("" : "+v"(t));
    F.lds = (LAS unsigned char*)lds_raw; F.tid = t; F.lane = t & 63; F.wave = __builtin_amdgcn_readfirstlane(t >> 6);
    int g = gridDim.x, b = blockIdx.x; asm volatile("" : "+s"(g), "+s"(b)); F.G = g; F.bid = b;
    const __attribute__((address_space(4))) Args* ap = (const __attribute__((address_space(4))) Args*)__builtin_amdgcn_kernarg_segment_ptr(); asm volatile("" : "+s"(ap));
    F.ws = ap->ws; F.in = ap->in; F.out = ap->out;
    return F;
}
#define PHASE_LOCALS \
    Frame F = mkframe(args, lds_raw); unsigned char* ws = F.ws; \
    float* modv = (float*)(ws + WS_MODV); bf16* U = (bf16*)(ws + WS_U); bf16* Y = (bf16*)(ws + WS_Y); bf16* PROJ = (bf16*)(ws + WS_ACT); bf16* HB = (bf16*)(ws + WS_ACT); \
    bf16* AMOE = (bf16*)(ws + WS_ACT); bf16* HMOE = (bf16*)(ws + WS_ACT + (size_t)MOE_ROWS * D * 2); \
    float* GATES = (float*)(ws + WS_GATES); float* LATC = (float*)(ws + WS_LATC); float* STATE = (float*)(ws + WS_STATE); \
    const int* pexp = (const int*)(ws + WS_SMALL + SM_PEXP); float* SA_U = (float*)(ws + WS_SMALL + SM_SAU); float* SA_U2 = (float*)(ws + WS_SMALL + SM_SAU2); float* SA_MOE = (float*)(ws + WS_GATES + GATES_SAMOE); \
    const float* SWL = (const float*)(ws + WS_SMALL + (odd ? SM_SWO : SM_SWE)); (void)SA_U; (void)SA_U2; (void)SA_MOE; (void)SWL; \
    unsigned char* wb = ws + (odd ? WS_WO : WS_WE); const float* mv = modv + (size_t)L * 9 * 6 * 1024; \
    (void)modv; (void)U; (void)Y; (void)PROJ; (void)HB; (void)AMOE; (void)HMOE; (void)GATES; (void)LATC; (void)STATE; (void)pexp; (void)wb; (void)mv;

__global__ void __launch_bounds__(NTHR, 2) fwd(Args args) {
    extern __shared__ __attribute__((aligned(16))) unsigned char lds_raw[];
    Frame F = mkframe(args, lds_raw);
    volatile LAS unsigned* LCTL = (volatile LAS unsigned*)(F.lds + LDSCTL_OFF);
    for (int u = F.tid; u < 128; u += NTHR) LCTL[u] = 0u;
    __syncthreads();
    XcdBarrier bar; bar.bar = (unsigned*)(F.ws + WS_CTL) + CW_BAR; bar.x = 0; bar.st = nullptr;
    if (args.use_bar) bar = xcd_barrier_post((unsigned*)(F.ws + WS_CTL) + CW_BAR, LCTL + 8);
    const int lo = args.ph_lo, hi = args.ph_hi;
#define IN(k) (lo <= (k) && (k) < hi)
#define SEAM(k) do { if ((k) + 1 < hi) xcd_barrier(bar.bar, bar.x, bar.st); if (TIMER_MASK != 0ull) timer_stamp(lds_raw, ((TIMER_MASK >> (k)) & 1ull) != 0ull); } while (0)
    if (TIMER_MASK != 0ull) timer_stamp(lds_raw, false);
    if (IN(0)) { const int L = 0; const bool odd = false; PHASE_LOCALS if (EN_MISC) phase_mods(F); __syncthreads(); if (EN_MISC) phase_wconv(F, 0); SEAM(0); }
    if (IN(1)) { const int L = 0; const bool odd = false; PHASE_LOCALS
        TokCfg T{}; T.lat_src_l = F.in[I_X]; T.lat_src_c = F.in[I_CTX]; T.src_f32 = 1; T.vna = modv + 0 * 1024; T.vnb = modv + 1 * 1024; T.u = U; T.u_fp8 = INPROJ_I8 ? 2 : 0; T.u_scale = SA_U; T.nrows = M_ALL;
        if (EN_TOK) phase_tok(F, T); __syncthreads(); if (EN_MISC) phase_wconv(F, 1); SEAM(1);
    }
    for (int L = 0; L < DEPTH; ++L) {
        const int pb = PH_BASE + L * PH_PER_LAYER; const bool odd = (L & 1) != 0; const int jl = L >> 1;
        const bool ctx_out = L < DEPTH - 1;
        if (IN(pb + 0)) { PHASE_LOCALS
            pg8::Order S; pg8::Gemm g;
#if INPROJ_I8
            if (!odd) { g = pg8::Gemm{U, (const bf16*)(wb + WE_IN), M_ALL, NIN_M, D}; S.init(M_ALL / 256, NIN_M, F.G, F.bid, nullptr, 0);
                pg8::EpiStoreI8 E{PROJ, NP_M, NP_M / 256, NP_M / 256, GATES, SA_U, SWL + SWE_IN}; if (EN_GEMM & (1 << 0)) pg8::gemm_phase<pg8::EpiStoreI8, pg8::Order, PG_ALIGN, PG_SP2, 2>(F.lds, g, S, E); }
            else { g = pg8::Gemm{U, (const bf16*)(wb + WOD_IN), M_ALL, NP_H, D}; S.init(M_ALL / 256, NP_H, F.G, F.bid, nullptr, 0);
                pg8::EpiStoreI8 E{PROJ, NP_H, NP_H / 256, -1, nullptr, SA_U, SWL + SWO_IN}; if (EN_GEMM & (1 << 1)) pg8::gemm_phase<pg8::EpiStoreI8, pg8::Order, PG_ALIGN, PG_SP2, 2>(F.lds, g, S, E); }
#else
            if (!odd) { g = pg8::Gemm{U, (const bf16*)(wb + WE_IN), M_ALL, NIN_M, D}; S.init(M_ALL / 256, NIN_M, F.G, F.bid, nullptr, 0);
                pg8::EpiStore E{PROJ, NP_M, NP_M / 256, NP_M / 256, GATES, 1.0f}; if (EN_GEMM & (1 << 0)) pg8::gemm_phase<pg8::EpiStore, pg8::Order, PG_ALIGN, PG_SP2>(F.lds, g, S, E); }
            else { g = pg8::Gemm{U, (const bf16*)(wb + WOD_IN), M_ALL, NP_H, D}; S.init(M_ALL / 256, NP_H, F.G, F.bid, nullptr, 0);
                pg8::EpiStore E{PROJ, NP_H, NP_H / 256, -1, nullptr, 1.0f}; if (EN_GEMM & (1 << 1)) pg8::gemm_phase<pg8::EpiStore, pg8::Order, PG_ALIGN, PG_SP2>(F.lds, g, S, E); }
#endif
            SEAM(pb + 0);
        }
        if (IN(pb + 1)) {
            if (!odd) { PHASE_LOCALS
                phase_conv(F, PROJ, (bf16*)(ws + WS_ACT + 400 * MiB), GATES, F.in[I_MWCONV] + (size_t)jl * 3 * 1024, F.in[I_MBGATE] + jl * 32); SEAM(pb + 1); }
        }
        if (IN(pb + 2)) { PHASE_LOCALS
            for (int id = F.bid; id < 256; id += F.G) {
                const int bh = id >> 2, p = id & 3, b = bh >> 3, h = bh & 7;
                MlSeg SG0, SG1;
                const int csz = odd ? 32 : 64;
                if (p == 0) { SG0 = MlSeg{M_LAT + b * CTXL, CTXL, 0, CTXL / csz}; SG1 = SG0; }
                else { int t0a, la, t0b, lb2; seg_of(odd, ctx_out, p - 1, t0a, la); seg_of(odd, ctx_out, 4 - p, t0b, lb2); SG0 = MlSeg{b * SEQ, SEQ, t0a, la / csz}; SG1 = MlSeg{b * SEQ, SEQ, t0b, lb2 / csz}; }
                if (!odd) { float* e0 = STATE + (size_t)((bh * 2 + 0) * 4 + p) * ML_STATE_F; float* e1 = STATE + (size_t)((bh * 2 + 1) * 4 + p) * ML_STATE_F;
                    if (EN_ML & 1) mlstm_s1_item(F, PROJ, (const bf16*)(ws + WS_ACT + 400 * MiB), GATES, h, SG0, SG1, e0, e1); }
                else { float* e0 = STATE + (size_t)((bh * 2 + 0) * 4 + p) * HG_STATE_F; float* e1 = STATE + (size_t)((bh * 2 + 1) * 4 + p) * HG_STATE_F;
                    if (EN_HG & 1) hgrn_item<false>(F, PROJ, U, (bf16*)(ws + WS_Y), U, F.in[I_HGHEAD] + jl * 1024, F.in[I_HBF] + (size_t)jl * 2048, F.in[I_HLB], jl, h, SG0, SG1, nullptr, nullptr, 0, 0, e0, e1); }
            }
            SEAM(pb + 2);
        }
        if (IN(pb + 3)) { PHASE_LOCALS
            const int nitems = ctx_out ? 320 : 256;
            for (int id = F.bid; id < nitems; id += F.G) {
                MlSeg SG0, SG1; int bh, npre0 = 0, npre1 = 0; const int csz = odd ? 32 : 64;
                if (id < 256) { int q; if (id < 128) { bh = id >> 1; q = (id & 1) ? 3 : 0; } else { bh = (id - 128) >> 1; q = 1 + (id & 1); } int t0q, lq; seg_of(odd, ctx_out, q, t0q, lq); SG0 = MlSeg{(bh >> 3) * SEQ, SEQ, t0q, lq / csz}; npre0 = q + 1; npre1 = 4 - q; }
                else { bh = id - 256; SG0 = MlSeg{M_LAT + (bh >> 3) * CTXL, CTXL, 0, CTXL / csz}; }
                SG1 = SG0;
                const int h = bh & 7;
                if (!odd) { const float* s0 = STATE + (size_t)((bh * 2 + 0) * 4) * ML_STATE_F; const float* s1 = STATE + (size_t)((bh * 2 + 1) * 4) * ML_STATE_F;
                    if (EN_ML & 2) mlstm_item<true>(F, PROJ, (const bf16*)(ws + WS_ACT + 400 * MiB), GATES, (bf16*)(ws + WS_ACT + 536 * MiB), (bf16*)(ws + WS_Y), U, F.in[I_MGHEAD] + jl * 1024, h, SG0, SG1, s0, s1, npre0, npre1, nullptr, nullptr); }
                else { const float* s0 = STATE + (size_t)((bh * 2 + 0) * 4) * HG_STATE_F; const float* s1 = STATE + (size_t)((bh * 2 + 1) * 4) * HG_STATE_F;
                    if (EN_HG & 2) hgrn_item<true>(F, PROJ, U, (bf16*)(ws + WS_Y), U, F.in[I_HGHEAD] + jl * 1024, F.in[I_HBF] + (size_t)jl * 2048, F.in[I_HLB], jl, h, SG0, SG1, s0, s1, npre0, npre1, nullptr, nullptr); }
            }
            SEAM(pb + 3);
        }
        if (IN(pb + 5)) { PHASE_LOCALS
            const int nM = (ctx_out ? M_ALL : M_LAT) / 256;
            pg8::Gemm g{U, (const bf16*)(wb + (odd ? WOD_OUT : WE_OUT)), nM * 256, D, D}; pg8::Order S; S.init(nM, D, F.G, F.bid, nullptr, 0);
            pg8::EpiStore E{Y, D, D / 256, -1, nullptr, 1.0f}; if (EN_GEMM & (1 << 2)) pg8::gemm_phase<pg8::EpiStore, pg8::Order, PG_ALIGN, PG_SP2>(F.lds, g, S, E);
            SEAM(pb + 5);
        }
        if (IN(pb + 6)) { PHASE_LOCALS
            TokCfg T{}; bf16* LAT16 = (bf16*)(ws + WS_ACT + 836 * MiB); T.src_f32 = (L == 0) ? 1 : 0; T.lat_src_l = (L == 0) ? (const void*)F.in[I_X] : (const void*)LAT16; T.lat_src_c = (L == 0) ? (const void*)F.in[I_CTX] : (const void*)LATC; T.lat_dst_l = LAT16; T.lat_dst_c = LATC;
            T.y = Y; T.y_perm = odd ? 1 : 0; T.vupd = mv + 2 * 1024; T.vna = mv + 3 * 1024; T.vnb = mv + 4 * 1024; T.u = U; T.u_fp8 = (UP_I8 && !odd) ? 2 : FFN_FP8_L(L); T.u_scale = SA_U2; T.route = odd ? 1 : 0; T.jr = jl; T.nrows = ctx_out ? M_ALL : M_LAT;
            if (EN_TOK) phase_tok(F, T);
            if (L >= 1 && L + 1 < DEPTH) { __syncthreads(); if (EN_MISC) phase_wconv(F, L + 1); }
            SEAM(pb + 6);
        }
        if (IN(pb + 7)) { PHASE_LOCALS
            if (odd) { if (EN_MISC) phase_moe_scatter(F, jl, ctx_out ? M_ALL : M_LAT, (const unsigned char*)U, (unsigned char*)AMOE, FFN_FP8_L(L) ? 1024 : 2048, nullptr, SA_MOE); SEAM(pb + 7); }
        }
        if (IN(pb + 8)) { PHASE_LOCALS
            if (!odd) { pg8::Gemm g{U, (const bf16*)(wb + WE_GU), M_ALL, NGU, D}; pg8::Order S; S.init(M_ALL / 256, NGU, F.G, F.bid, nullptr, 0);
#if UP_I8
                pg8::EpiSwiGLU8I E{(unsigned char*)HB, FF, SA_U2, SWL + SWE_GU, nullptr, 0, FFN_FP8_L(L) ? 0 : 1}; if (EN_GEMM & (1 << 3)) pg8::gemm_phase<pg8::EpiSwiGLU8I, pg8::Order, PG_ALIGN, PG_SP2, 2>(F.lds, g, S, E);
#else
                pg8::EpiSwiGLU8 E{(unsigned char*)HB, FF, 1.0f / WSCALE8}; if (EN_GEMM & (1 << 3)) pg8::gemm_phase<pg8::EpiSwiGLU8, pg8::Order, PG_ALIGN, PG_SP2, 1>(F.lds, g, S, E);
#endif
            }
            else { const int np = __builtin_amdgcn_readfirstlane(pexp[MOE_PANELS]);
                pg8::Gemm g{AMOE, (const bf16*)(wb + WOD_GU), np * 256, NGU, D}; pg8::Order S; S.init(np, NGU, F.G, F.bid, pexp, EGU_BYTES);
                pg8::EpiSwiGLU8 E{(unsigned char*)HMOE, FF, 1.0f / WSCALE8}; if (EN_GEMM & (1 << 4)) pg8::gemm_phase<pg8::EpiSwiGLU8, pg8::Order, PG_ALIGN, PG_SP2, 1>(F.lds, g, S, E); }
            SEAM(pb + 8);
        }
        if (IN(pb + 9)) { PHASE_LOCALS
            const bool f8 = FFN_FP8_L(L) != 0;
            if (!odd) { pg8::Gemm g{HB, (const bf16*)(wb + WE_DOWN), M_ALL, D, FF}; pg8::Order S; S.init(M_ALL / 256, D, F.G, F.bid, nullptr, 0);
                if (f8) { if ((FP8_LAYERS) & 0x5) { pg8::EpiStore E{Y, D, D / 256, -1, nullptr, 1.0f / WSCALE8}; if (EN_GEMM & (1 << 5)) pg8::gemm_phase<pg8::EpiStore, pg8::Order, PG_ALIGN, PG_SP2, 1>(F.lds, g, S, E); } }
                else { if ((~(FP8_LAYERS)) & 0x5) { pg8::EpiStore E{Y, D, D / 256, -1, nullptr, 1.0f}; if (EN_GEMM & (1 << 5)) pg8::gemm_phase<pg8::EpiStore, pg8::Order, PG_ALIGN, PG_SP2>(F.lds, g, S, E); } } }
            else { const int np = __builtin_amdgcn_readfirstlane(pexp[MOE_PANELS]);
                pg8::Gemm g{HMOE, (const bf16*)(wb + WOD_DOWN), np * 256, D, FF}; pg8::Order S; S.init(np, D, F.G, F.bid, pexp, EDOWN_BYTES);
                if (f8) { if ((FP8_LAYERS) & 0xA) { pg8::EpiStore E{AMOE, D, D / 256, -1, nullptr, 1.0f / WSCALE8}; if (EN_GEMM & (1 << 6)) pg8::gemm_phase<pg8::EpiStore, pg8::Order, PG_ALIGN, PG_SP2, 1>(F.lds, g, S, E); } }
                else { if ((~(FP8_LAYERS)) & 0xA) { pg8::EpiStore E{AMOE, D, D / 256, -1, nullptr, 1.0f}; if (EN_GEMM & (1 << 6)) pg8::gemm_phase<pg8::EpiStore, pg8::Order, PG_ALIGN, PG_SP2>(F.lds, g, S, E); } } }
            SEAM(pb + 9);
        }
        if (IN(pb + 10)) { PHASE_LOCALS
            TokCfg T{}; bf16* LAT16 = (bf16*)(ws + WS_ACT + 836 * MiB); T.lat_src_l = LAT16; T.lat_src_c = LATC; T.lat_dst_l = (L + 1 < DEPTH) ? (void*)LAT16 : (void*)F.out; T.lat_dst_c = LATC; T.dst_f32 = (L + 1 < DEPTH) ? 0 : 1;
            T.y = odd ? AMOE : Y; T.moe_combine = odd ? 1 : 0; T.vupd = mv + 5 * 1024; T.nrows = ctx_out ? M_ALL : M_LAT;
            if (L + 1 < DEPTH) { const float* mn = modv + (size_t)(L + 1) * 9 * 6 * 1024; T.vna = mn; T.vnb = mn + 1024; T.u = U; T.u_perm = ((L + 1) & 1) ? 1 : 0; T.u_fp8 = INPROJ_I8 ? 2 : 0; T.u_scale = SA_U; }
            if (EN_TOK) phase_tok(F, T);
            SEAM(pb + 10);
        }
    }
    if (TIMER_MASK != 0ull) { timer_stamp(lds_raw, ((TIMER_MASK >> (N_PHASES - 1)) & 1ull) != 0ull);
        if (blockIdx.x == 0 && threadIdx.x == 0) { volatile LAS unsigned* tw = (volatile LAS unsigned*)((LAS unsigned char*)lds_raw + LDSCTL_OFF) + 32; const unsigned long long acc = ((unsigned long long)tw[3] << 32) | tw[2];
            asm volatile("s_waitcnt vmcnt(0)" ::: "memory"); args.out[0] = (float)acc * 0.01f / TIMER_DIV; } }
#undef IN
#undef SEAM
}

extern "C" void kernel_launch(void* const* d_in, const int* in_sizes, int n_in, void* d_out, int out_size, void* d_ws, size_t ws_size, hipStream_t stream) {
    static int grid = 0;
    if (grid == 0) {
        if (n_in != 23 || out_size != M_LAT * D || ws_size < WS_END) { fprintf(stderr, "kernel_launch: unexpected shapes / workspace (n_in %d out %d ws %zu need %zu)\n", n_in, out_size, ws_size, (size_t)WS_END); grid = -1; return; }
        int dev = 0, cus = 0, per_cu = 0;
        if (hipGetDevice(&dev) != hipSuccess || hipDeviceGetAttribute(&cus, hipDeviceAttributeMultiprocessorCount, dev) != hipSuccess) { grid = -1; return; }
        if (hipFuncSetAttribute((const void*)fwd, hipFuncAttributeMaxDynamicSharedMemorySize, LDS_BYTES) != hipSuccess) { fprintf(stderr, "kernel_launch: hipFuncSetAttribute failed\n"); grid = -1; return; }
        if (hipOccupancyMaxActiveBlocksPerMultiprocessor(&per_cu, (const void*)fwd, NTHR, LDS_BYTES) != hipSuccess || per_cu < 1) fprintf(stderr, "kernel_launch: occupancy query reports %d\n", per_cu);
        (void)hipGetLastError();
        grid = cus;
    }
    if (grid < 0) return;
    (void)hipMemsetAsync((char*)d_ws + WS_CTL, 0, CTL_ZERO_BYTES, stream);
    Args a{};
    for (int i = 0; i < 23; ++i) a.in[i] = (const float*)d_in[i];
    a.out = (float*)d_out; a.ws = (unsigned char*)d_ws;
#if MK_SPLIT
    for (int p = 0; p < N_PHASES; ++p) { a.ph_lo = p; a.ph_hi = p + 1; a.use_bar = 0; a.pad = 0; hipLaunchKernelGGL(fwd, dim3(grid), dim3(NTHR), LDS_BYTES, stream, a); }
#else
    a.ph_lo = 0; a.ph_hi = N_PHASES; a.use_bar = 1; a.pad = 0;
    hipLaunchKernelGGL(fwd, dim3(grid), dim3(NTHR), LDS_BYTES, stream, a);
#endif
}
```

```cpp
#include <hip/hip_runtime.h>
#include <cstdio>
#include <cstdint>

namespace pg8 {
#define PG8_LAS __attribute__((address_space(3)))
typedef unsigned short bf16_t;
typedef short bf16x8 __attribute__((ext_vector_type(8)));
typedef float f32x4 __attribute__((ext_vector_type(4)));
typedef unsigned u32x4 __attribute__((ext_vector_type(4)));
typedef unsigned u32x2 __attribute__((ext_vector_type(2)));
typedef int v8i_t __attribute__((ext_vector_type(8)));
typedef int v4i_t __attribute__((ext_vector_type(4)));
constexpr int BM = 256, BK = 64, HALF = 128, HTB = HALF * BK * 2  , STAGE_BYTES = 8 * HTB, NXCD = 8, WGM = 8;

__host__ __device__ __forceinline__ int lds_byte(int r, int c) { const int st = (r >> 4) * 2 + (c >> 5), rr = r & 15, cc = c & 31, ob = rr * 64 + cc * 2; return st * 1024 + (ob ^ (((ob >> 9) & 1) << 5)); }
__host__ __device__ __forceinline__ void stage_rc(int b, int& R, int& C) { const int st = b / 1024, sb = b % 1024, swz = sb ^ (((sb >> 9) & 1) << 5); R = (st >> 1) * 16 + swz / 64; C = (st & 1) * 32 + (swz % 64) / 2; }
__host__ __device__ __forceinline__ int perm32(int rho) { const int n = rho >> 4, i = rho & 15; return 8 * (i >> 2) + 4 * n + (i & 3); }

struct Unit { int pm, pn; };
struct Gemm { const bf16_t* A; const bf16_t* Bt; int M, N, K; };

struct Order {
    int nM, nN, nwg, G, c; const int* pexp; size_t bstride;
    __device__ void init(int nM_, int N, int G_, int c_, const int* pexp_, size_t bstride_) { nM = nM_; nN = N / BM; nwg = nM * nN; G = G_; c = c_; pexp = pexp_; bstride = bstride_; }
    __device__ bool next(int i, Unit& u) const {
        const long L = (long)i * G + c; if (L >= nwg) return false;
        int wgid = (int)L; { const int q = nwg / NXCD, r = nwg % NXCD, xcd = wgid % NXCD, off = wgid / NXCD; wgid = (xcd < r ? xcd * (q + 1) : r * (q + 1) + (xcd - r) * q) + off; }
        const int nig = WGM * nN, gid = wgid / nig, fm = gid * WGM, gsz = (nM - fm) < WGM ? (nM - fm) : WGM;
        u.pm = fm + ((wgid % nig) % gsz); u.pn = (wgid % nig) / gsz; return true;
    }
    __device__ __forceinline__ size_t boff(const Unit& u) const { return pexp ? (size_t)__builtin_amdgcn_readfirstlane(pexp[u.pm]) * bstride : (size_t)0; }
    __device__ __forceinline__ void a_ready(const Unit&) const {}
    __device__ __forceinline__ void done(const Unit&) const {}
};

__device__ __forceinline__ unsigned cvt_pk_bf16(float lo, float hi) { unsigned r; asm volatile("v_cvt_pk_bf16_f32 %0, %1, %2" : "=v"(r) : "v"(lo), "v"(hi)); return r; }

struct EpiStore {
    static constexpr bool PERM = true, AFTER_DRAIN = false;
    bf16_t* O; int ldc; int ncol_tiles; int gate_pn; float* gates; float oscale;
    __device__ __forceinline__ void operator()(const f32x4 (&acc)[2][2][4][2], const Unit& u, int wr, int wc, int fr, int fq) const {
        const int row0 = u.pm * BM + wr * 64 + fr;
        if (u.pn < ncol_tiles) {
            const int col0 = u.pn * BM + wc * 32 + 8 * fq;
#pragma unroll
            for (int ai = 0; ai < 2; ++ai)
#pragma unroll
                for (int m = 0; m < 4; ++m) { bf16_t* rowp = O + (size_t)(row0 + ai * HALF + m * 16) * ldc + col0;
#pragma unroll
                    for (int bj = 0; bj < 2; ++bj) { const f32x4 v0 = acc[ai][bj][m][0] * oscale, v1 = acc[ai][bj][m][1] * oscale;
                        u32x4 w; w.x = cvt_pk_bf16(v0[0], v0[1]); w.y = cvt_pk_bf16(v0[2], v0[3]); w.z = cvt_pk_bf16(v1[0], v1[1]); w.w = cvt_pk_bf16(v1[2], v1[3]);
                        *(u32x4*)(rowp + bj * HALF) = w; } }
        } else if (u.pn == gate_pn && wc == 0) {
#pragma unroll
            for (int ai = 0; ai < 2; ++ai)
#pragma unroll
                for (int m = 0; m < 4; ++m) { float* rowp = gates + (size_t)(row0 + ai * HALF + m * 16) * 32 + 8 * fq;
                    *(f32x4*)(rowp) = acc[ai][0][m][0]; *(f32x4*)(rowp + 4) = acc[ai][0][m][1]; }
        }
    }
};
struct EpiSwiGLU {
    static constexpr bool PERM = true, AFTER_DRAIN = false;
    bf16_t* O; int ldc;
    __device__ __forceinline__ void operator()(const f32x4 (&acc)[2][2][4][2], const Unit& u, int wr, int wc, int fr, int fq) const {
        const int row0 = u.pm * BM + wr * 64 + fr, col0 = u.pn * HALF + wc * 32 + 8 * fq;
#pragma unroll
        for (int ai = 0; ai < 2; ++ai)
#pragma unroll
            for (int m = 0; m < 4; ++m) { bf16_t* rowp = O + (size_t)(row0 + ai * HALF + m * 16) * ldc + col0; float r[8];
#pragma unroll
                for (int n = 0; n < 2; ++n)
#pragma unroll
                    for (int j = 0; j < 4; ++j) { const float g = acc[ai][0][m][n][j], up = acc[ai][1][m][n][j]; r[n * 4 + j] = g * __builtin_amdgcn_rcpf(1.0f + __expf(-g)) * up; }
                u32x4 w; w.x = cvt_pk_bf16(r[0], r[1]); w.y = cvt_pk_bf16(r[2], r[3]); w.z = cvt_pk_bf16(r[4], r[5]); w.w = cvt_pk_bf16(r[6], r[7]);
                *(u32x4*)(rowp) = w; }
    }
};
struct EpiSwiGLU8 {
    static constexpr bool PERM = true, AFTER_DRAIN = false;
    unsigned char* O; int ldc; float ascale;
    __device__ __forceinline__ void operator()(const f32x4 (&acc)[2][2][4][2], const Unit& u, int wr, int wc, int fr, int fq) const {
        typedef float f32x2 __attribute__((ext_vector_type(2)));
        const int row0 = u.pm * BM + wr * 64 + fr, col0 = u.pn * HALF + wc * 32 + 8 * fq;
        const float c1 = -ascale * 1.4426950408889634f, c2 = ascale * ascale;
#pragma unroll
        for (int ai = 0; ai < 2; ++ai)
#pragma unroll
            for (int m = 0; m < 4; ++m) { unsigned char* rowp = O + (size_t)(row0 + ai * HALF + m * 16) * ldc + col0; f32x2 r[4];
#pragma unroll
                for (int n = 0; n < 2; ++n)
#pragma unroll
                    for (int j = 0; j < 2; ++j) { const f32x2 ag = {acc[ai][0][m][n][2 * j], acc[ai][0][m][n][2 * j + 1]}, au = {acc[ai][1][m][n][2 * j], acc[ai][1][m][n][2 * j + 1]};
                        const f32x2 t = ag * c1; f32x2 d = {__builtin_amdgcn_exp2f(t.x), __builtin_amdgcn_exp2f(t.y)}; d = d + 1.0f;
                        const f32x2 q = {__builtin_amdgcn_rcpf(d.x), __builtin_amdgcn_rcpf(d.y)};
                        r[n * 2 + j] = ((ag * au) * q) * c2; }
                u32x2 w; unsigned t = 0; t = __builtin_amdgcn_cvt_pk_fp8_f32(r[0].x, r[0].y, t, false); t = __builtin_amdgcn_cvt_pk_fp8_f32(r[1].x, r[1].y, t, true); w.x = t;
                t = 0; t = __builtin_amdgcn_cvt_pk_fp8_f32(r[2].x, r[2].y, t, false); t = __builtin_amdgcn_cvt_pk_fp8_f32(r[3].x, r[3].y, t, true); w.y = t;
                *(u32x2*)(rowp) = w; }
    }
};
struct EpiStoreI8 {
    static constexpr bool PERM = true, AFTER_DRAIN = false;
    bf16_t* O; int ldc; int ncol_tiles; int gate_pn; float* gates; const float* sa; const float* sw;
    __device__ __forceinline__ void operator()(const f32x4 (&acc)[2][2][4][2], const Unit& u, int wr, int wc, int fr, int fq) const {
        const int row0 = u.pm * BM + wr * 64 + fr;
        if (u.pn < ncol_tiles) {
            const int col0 = u.pn * BM + wc * 32 + 8 * fq;
            f32x4 cs[2][2];
#pragma unroll
            for (int bj = 0; bj < 2; ++bj) { cs[bj][0] = *(const f32x4*)(sw + col0 + bj * HALF); cs[bj][1] = *(const f32x4*)(sw + col0 + bj * HALF + 4); }
#pragma unroll
            for (int ai = 0; ai < 2; ++ai)
#pragma unroll
                for (int m = 0; m < 4; ++m) { const int row = row0 + ai * HALF + m * 16; const float rs = sa[row]; bf16_t* rowp = O + (size_t)row * ldc + col0;
#pragma unroll
                    for (int bj = 0; bj < 2; ++bj) { const v4i_t i0 = __builtin_bit_cast(v4i_t, acc[ai][bj][m][0]), i1 = __builtin_bit_cast(v4i_t, acc[ai][bj][m][1]);
                        const f32x4 v0 = __builtin_convertvector(i0, f32x4) * cs[bj][0] * rs, v1 = __builtin_convertvector(i1, f32x4) * cs[bj][1] * rs;
                        u32x4 w; w.x = cvt_pk_bf16(v0[0], v0[1]); w.y = cvt_pk_bf16(v0[2], v0[3]); w.z = cvt_pk_bf16(v1[0], v1[1]); w.w = cvt_pk_bf16(v1[2], v1[3]);
                        *(u32x4*)(rowp + bj * HALF) = w; } }
        } else if (u.pn == gate_pn && wc == 0) {
            const int col0 = u.pn * BM + 8 * fq; const f32x4 c0 = *(const f32x4*)(sw + col0), c1 = *(const f32x4*)(sw + col0 + 4);
#pragma unroll
            for (int ai = 0; ai < 2; ++ai)
#pragma unroll
                for (int m = 0; m < 4; ++m) { const int row = row0 + ai * HALF + m * 16; const float rs = sa[row]; float* rowp = gates + (size_t)row * 32 + 8 * fq;
                    *(f32x4*)(rowp) = __builtin_convertvector(__builtin_bit_cast(v4i_t, acc[ai][0][m][0]), f32x4) * c0 * rs; *(f32x4*)(rowp + 4) = __builtin_convertvector(__builtin_bit_cast(v4i_t, acc[ai][0][m][1]), f32x4) * c1 * rs; }
        }
    }
};
struct EpiSwiGLU8I {
    static constexpr bool PERM = true, AFTER_DRAIN = false;
    unsigned char* O; int ldc; const float* sa; const float* sw; const int* pexp; int swstride; int obf16;
    __device__ __forceinline__ void operator()(const f32x4 (&acc)[2][2][4][2], const Unit& u, int wr, int wc, int fr, int fq) const {
        typedef float f32x2 __attribute__((ext_vector_type(2)));
        const int row0 = u.pm * BM + wr * 64 + fr, col0 = u.pn * HALF + wc * 32 + 8 * fq;
        const float* swe = sw + (pexp ? (size_t)__builtin_amdgcn_readfirstlane(pexp[u.pm]) * swstride : (size_t)0) + u.pn * BM + wc * 32 + 8 * fq;
        const f32x4 g0 = *(const f32x4*)(swe), g1 = *(const f32x4*)(swe + 4), u0 = *(const f32x4*)(swe + HALF), u1 = *(const f32x4*)(swe + HALF + 4);
        const float gs[8] = {g0[0], g0[1], g0[2], g0[3], g1[0], g1[1], g1[2], g1[3]}, us[8] = {u0[0], u0[1], u0[2], u0[3], u1[0], u1[1], u1[2], u1[3]};
#pragma unroll
        for (int ai = 0; ai < 2; ++ai)
#pragma unroll
            for (int m = 0; m < 4; ++m) { const int row = row0 + ai * HALF + m * 16; const float rs = sa[row]; unsigned char* rowp = O + (size_t)row * ldc + col0; float r[8];
#pragma unroll
                for (int n = 0; n < 2; ++n) { const v4i_t ig = __builtin_bit_cast(v4i_t, acc[ai][0][m][n]), iu = __builtin_bit_cast(v4i_t, acc[ai][1][m][n]);
#pragma unroll
                    for (int j = 0; j < 4; ++j) { const float g = (float)ig[j] * (gs[4 * n + j] * rs), up = (float)iu[j] * (us[4 * n + j] * rs);
                        r[4 * n + j] = g * __builtin_amdgcn_rcpf(1.0f + __builtin_amdgcn_exp2f(g * -1.4426950408889634f)) * up; } }
                if (obf16) { u32x4 w; w.x = cvt_pk_bf16(r[0], r[1]); w.y = cvt_pk_bf16(r[2], r[3]); w.z = cvt_pk_bf16(r[4], r[5]); w.w = cvt_pk_bf16(r[6], r[7]);
                    *(u32x4*)((bf16_t*)O + (size_t)row * ldc + col0) = w; }
                else { u32x2 w; unsigned t = 0; t = __builtin_amdgcn_cvt_pk_fp8_f32(r[0], r[1], t, false); t = __builtin_amdgcn_cvt_pk_fp8_f32(r[2], r[3], t, true); w.x = t;
                    t = 0; t = __builtin_amdgcn_cvt_pk_fp8_f32(r[4], r[5], t, false); t = __builtin_amdgcn_cvt_pk_fp8_f32(r[6], r[7], t, true); w.y = t;
                    *(u32x2*)(rowp) = w; } }
    }
};

template <bool FP8> struct Frag;
template <> struct Frag<false> { bf16x8 v[2]; };
template <> struct Frag<true> { v8i_t v; };
template <bool FP8> __device__ __forceinline__ void ldfrag(Frag<FP8>& f, const PG8_LAS unsigned char* p) {
    if constexpr (FP8) { const bf16x8 a = *(const PG8_LAS bf16x8*)p, b = *(const PG8_LAS bf16x8*)(p + 1024); f.v = __builtin_bit_cast(v8i_t, __builtin_shufflevector(a, b, 0, 1, 2, 3, 4, 5, 6, 7, 8, 9, 10, 11, 12, 13, 14, 15)); }
    else { f.v[0] = *(const PG8_LAS bf16x8*)p; f.v[1] = *(const PG8_LAS bf16x8*)(p + 1024); }
}
template <class Epi, class Sched, bool ALIGN_EPI = false, bool SP2 = false, int MODE = 0  >
__device__ __forceinline__ void gemm_phase(PG8_LAS unsigned char* lds, const Gemm g, const Sched& S, const Epi& E) {
    int tid = threadIdx.x; asm volatile("" : "+v"(tid)); const int wid = __builtin_amdgcn_readfirstlane(tid >> 6), lane = tid & 63, wr = wid >> 2, wc = wid & 3, fr = lane & 15, fq = lane >> 4;
    constexpr bool FP8 = (MODE == 1);
    const int K = g.K, rowb = (MODE != 0) ? K : 2 * K, nt = rowb / 128;
    unsigned voffA[2], voffB[2];
#pragma unroll
    for (int i = 0; i < 2; ++i) { int R, C; stage_rc(tid * 16 + i * 8192, R, C); const int Rb = Epi::PERM ? ((R & ~31) + perm32(R & 31)) : R;
        voffA[i] = (unsigned)(R * rowb + C * 2); voffB[i] = (unsigned)(Rb * rowb + C * 2); }
    const size_t kstep = (size_t)(BK * 2);
    const size_t hstep = (size_t)HALF * rowb;
    const size_t tstep = 2 * hstep;
    const unsigned ldsw = (unsigned)wid * 1024u;
    const int aoff = lds_byte(wr * 64 + fr, fq * 8), boff = lds_byte(wc * 32 + fr, fq * 8);
#define PG8_SA(b, h) (((b) * 2 + (h)) * HTB)
#define PG8_SB(b, h) ((4 + (b) * 2 + (h)) * HTB)
#define PG8_STAGE(bufoff, gbase, voff) do { _Pragma("unroll") for (int _i = 0; _i < 2; ++_i) \
        __builtin_amdgcn_global_load_lds((const unsigned*)((const char*)(gbase) + (voff)[_i]), (PG8_LAS unsigned*)(lds + (bufoff) + ldsw + _i * 8192), 16, 0, 0); } while (0)
#define PG8_LDA(dst, b, h) do { _Pragma("unroll") for (int m = 0; m < 4; ++m) ldfrag<FP8>(dst[m], lds + PG8_SA(b, h) + aoff + m * 2048); } while (0)
#define PG8_LDB(dst, b, h) do { _Pragma("unroll") for (int n = 0; n < 2; ++n) ldfrag<FP8>(dst[n], lds + PG8_SB(b, h) + boff + n * 2048); } while (0)
#define PG8_MMA(ai, bj, At, Bt) do { __builtin_amdgcn_s_setprio(1); _Pragma("unroll") for (int m = 0; m < 4; ++m) _Pragma("unroll") for (int n = 0; n < 2; ++n) { \
        if constexpr (FP8) { asm volatile("v_mfma_f32_16x16x128_f8f6f4 %0, %1, %2, %0" : "+v"(acc[ai][bj][m][n]) : "v"(Bt[n].v), "v"(At[m].v)); }     \
        else if constexpr (MODE == 2) { _Pragma("unroll") for (int k = 0; k < 2; ++k) acc[ai][bj][m][n] = __builtin_bit_cast(f32x4, __builtin_amdgcn_mfma_i32_16x16x64_i8(__builtin_bit_cast(v4i_t, Bt[n].v[k]), __builtin_bit_cast(v4i_t, At[m].v[k]), __builtin_bit_cast(v4i_t, acc[ai][bj][m][n]), 0, 0, 0)); } \
        else { _Pragma("unroll") for (int k = 0; k < 2; ++k) acc[ai][bj][m][n] = __builtin_amdgcn_mfma_f32_16x16x32_bf16(Bt[n].v[k], At[m].v[k], acc[ai][bj][m][n], 0, 0, 0); } } __builtin_amdgcn_s_setprio(0); } while (0)
#define PG8_WAIT_V(n) asm volatile("s_waitcnt vmcnt(" #n ")" ::: "memory")
#define PG8_WAIT_L(n) asm volatile("s_waitcnt lgkmcnt(" #n ")" ::: "memory")
#define PG8_BAR __builtin_amdgcn_s_barrier()
#define PG8_SCHED __builtin_amdgcn_sched_barrier(0)
    Unit cur, nxt; int ui = 0;
    if (!S.next(0, cur)) return;
    f32x4 acc[2][2][4][2];
#pragma unroll
    for (int a = 0; a < 2; ++a)
#pragma unroll
        for (int b = 0; b < 2; ++b)
#pragma unroll
            for (int m = 0; m < 4; ++m)
#pragma unroll
                for (int n = 0; n < 2; ++n) acc[a][b][m][n] = (f32x4){0.f, 0.f, 0.f, 0.f};
    Frag<FP8> At[4], B0[2], B1[2];
    const char* cA = (const char*)g.A + (size_t)cur.pm * tstep; const char* cB = (const char*)g.Bt + S.boff(cur) + (size_t)cur.pn * tstep;
    S.a_ready(cur);
    if constexpr (SP2) {
        PG8_STAGE(PG8_SB(0, 0), cB, voffB); PG8_STAGE(PG8_SB(0, 1), cB + hstep, voffB); PG8_STAGE(PG8_SA(0, 0), cA, voffA); PG8_STAGE(PG8_SA(0, 1), cA + hstep, voffA);
        if (wr == 1) PG8_BAR;
        PG8_WAIT_V(2); PG8_BAR;
        PG8_STAGE(PG8_SB(1, 0), cB + kstep, voffB); PG8_STAGE(PG8_SA(1, 0), cA + kstep, voffA); PG8_STAGE(PG8_SB(1, 1), cB + hstep + kstep, voffB);
        PG8_WAIT_V(6); PG8_BAR;
    } else {
        PG8_STAGE(PG8_SB(0, 0), cB, voffB); PG8_STAGE(PG8_SA(0, 0), cA, voffA); PG8_STAGE(PG8_SB(0, 1), cB + hstep, voffB); PG8_STAGE(PG8_SA(0, 1), cA + hstep, voffA);
        if (wr == 1) PG8_BAR;
        PG8_WAIT_V(4); PG8_BAR;
        PG8_STAGE(PG8_SB(1, 0), cB + kstep, voffB); PG8_STAGE(PG8_SA(1, 0), cA + kstep, voffA); PG8_STAGE(PG8_SB(1, 1), cB + hstep + kstep, voffB);
        PG8_WAIT_V(6); PG8_BAR;
    }
    for (;;) {
        const bool has_next = S.next(ui + 1, nxt);
        const char* nA = has_next ? (const char*)g.A + (size_t)nxt.pm * tstep : cA; const char* nB = has_next ? (const char*)g.Bt + S.boff(nxt) + (size_t)nxt.pn * tstep : cB;
#pragma unroll 1
        for (int t = 0; t < nt; t += 2) {
            const bool last = (t == nt - 2);
            const char* a1 = cA + (size_t)(t + 1) * kstep;
            const char* a2 = last ? nA : cA + (size_t)(t + 2) * kstep; const char* b2 = last ? nB : cB + (size_t)(t + 2) * kstep;
            const char* a3 = a2 + kstep; const char* b3 = b2 + kstep;
            if (last && has_next) S.a_ready(nxt);
            if constexpr (SP2) {
            PG8_LDB(B0, 0, 0); PG8_LDB(B1, 0, 1); PG8_SCHED; PG8_LDA(At, 0, 0); PG8_STAGE(PG8_SA(1, 1), a1 + hstep, voffA);
            PG8_WAIT_V(8); PG8_WAIT_L(0); PG8_BAR; PG8_MMA(0, 0, At, B0); PG8_MMA(0, 1, At, B1); PG8_BAR; PG8_SCHED;
            PG8_LDA(At, 0, 1); PG8_STAGE(PG8_SB(0, 0), b2, voffB); PG8_STAGE(PG8_SB(0, 1), b2 + hstep, voffB); PG8_STAGE(PG8_SA(0, 0), a2, voffA);
            PG8_WAIT_V(8); PG8_WAIT_L(0); PG8_BAR; PG8_MMA(1, 0, At, B0); PG8_MMA(1, 1, At, B1); PG8_BAR; PG8_SCHED;
            PG8_LDB(B0, 1, 0); PG8_LDB(B1, 1, 1); PG8_SCHED; PG8_LDA(At, 1, 0); PG8_STAGE(PG8_SA(0, 1), a2 + hstep, voffA);
            PG8_WAIT_V(8); PG8_WAIT_L(0); PG8_BAR; PG8_MMA(0, 0, At, B0); PG8_MMA(0, 1, At, B1); PG8_BAR; PG8_SCHED;
            PG8_LDA(At, 1, 1); PG8_STAGE(PG8_SB(1, 0), b3, voffB); PG8_STAGE(PG8_SB(1, 1), b3 + hstep, voffB); PG8_STAGE(PG8_SA(1, 0), a3, voffA);
            PG8_WAIT_V(8); PG8_WAIT_L(0); PG8_BAR; PG8_MMA(1, 0, At, B0); PG8_MMA(1, 1, At, B1); PG8_BAR; PG8_SCHED;
            } else {
            PG8_LDB(B0, 0, 0); PG8_SCHED; PG8_LDA(At, 0, 0); PG8_STAGE(PG8_SA(1, 1), a1 + hstep, voffA);
            PG8_WAIT_L(8); PG8_BAR; PG8_WAIT_L(0); PG8_MMA(0, 0, At, B0); PG8_BAR; PG8_SCHED;
            PG8_LDB(B1, 0, 1); PG8_STAGE(PG8_SB(0, 0), b2, voffB);
            PG8_BAR; PG8_WAIT_L(0); PG8_MMA(0, 1, At, B1); PG8_BAR;
            PG8_LDA(At, 0, 1); PG8_STAGE(PG8_SA(0, 0), a2, voffA);
            PG8_BAR; PG8_WAIT_L(0); PG8_MMA(1, 0, At, B0); PG8_BAR; PG8_SCHED;
            PG8_STAGE(PG8_SB(0, 1), b2 + hstep, voffB);
            PG8_WAIT_V(6); PG8_BAR; PG8_MMA(1, 1, At, B1); PG8_BAR;
            PG8_LDB(B0, 1, 0); PG8_SCHED; PG8_LDA(At, 1, 0); PG8_STAGE(PG8_SA(0, 1), a2 + hstep, voffA);
            PG8_WAIT_L(8); PG8_BAR; PG8_WAIT_L(0); PG8_MMA(0, 0, At, B0); PG8_BAR; PG8_SCHED;
            PG8_LDB(B1, 1, 1); PG8_STAGE(PG8_SB(1, 0), b3, voffB);
            PG8_BAR; PG8_WAIT_L(0); PG8_MMA(0, 1, At, B1); PG8_BAR;
            PG8_LDA(At, 1, 1); PG8_STAGE(PG8_SA(1, 0), a3, voffA);
            PG8_BAR; PG8_WAIT_L(0); PG8_MMA(1, 0, At, B0); PG8_BAR; PG8_SCHED;
            PG8_STAGE(PG8_SB(1, 1), b3 + hstep, voffB);
            PG8_WAIT_V(6); PG8_BAR; PG8_MMA(1, 1, At, B1); PG8_BAR;
            }
        }
        if constexpr (ALIGN_EPI) { if (wr == 0) PG8_BAR; }
        if constexpr (FP8) { asm volatile("s_nop 15\n\ts_nop 15" ::: "memory"); }
        if constexpr (!Epi::AFTER_DRAIN) { E(acc, cur, wr, wc, fr, fq); S.done(cur); }
        if (!has_next) break;
#pragma unroll
        for (int a = 0; a < 2; ++a)
#pragma unroll
            for (int b = 0; b < 2; ++b)
#pragma unroll
                for (int m = 0; m < 4; ++m)
#pragma unroll
                    for (int n = 0; n < 2; ++n) acc[a][b][m][n] = (f32x4){0.f, 0.f, 0.f, 0.f};
        cur = nxt; cA = nA; cB = nB; ++ui;
        if constexpr (ALIGN_EPI) { if (wr == 1) PG8_BAR; }
    }
    PG8_WAIT_V(0);
    if constexpr (!ALIGN_EPI) { if (wr == 0) PG8_BAR; }
    PG8_BAR;
    if constexpr (Epi::AFTER_DRAIN) { E.fused(acc, cur, wr, wc, fr, fq, lds, wid, lane); S.done(cur); }
#undef PG8_SA
#undef PG8_SB
#undef PG8_STAGE
#undef PG8_LDA
#undef PG8_LDB
#undef PG8_MMA
#undef PG8_WAIT_V
#undef PG8_WAIT_L
#undef PG8_BAR
#undef PG8_SCHED
}
}

constexpr int D = 1024, NB = 8, SEQ = 8192, CTXL = 256, DEPTH = 4, GRIDW = 64, ROWS_G = SEQ / GRIDW  ;
constexpr int M_LAT = NB * SEQ  , M_CTX = NB * CTXL  , M_ALL = M_LAT + M_CTX  ;
constexpr int NHEAD = 8, M_DK = 64, M_DV = 128, H_DK = 128, H_DV = 128;
constexpr int NP_M = 3072, NIN_M = 3328, NW_M = 3104, NP_H = 5120;
constexpr int FF = 2816, NGU = 2 * FF, NEXP = 8;
constexpr int MOE_ROWS = 137216, MOE_PANELS = MOE_ROWS / 256;
constexpr float EPS = 1e-6f;
constexpr int NWAVES = 8, NTHR = 512;

constexpr size_t MiB = 1u << 20;
constexpr size_t WS_CTL = 0, CTL_ZERO_BYTES = 936 * 1024;
constexpr size_t WS_MODV = 1 * MiB;
constexpr size_t WS_SMALL = 2 * MiB;
constexpr size_t WS_LATC = 3 * MiB;
constexpr size_t WS_WE = 11 * MiB;
constexpr size_t WS_WO = 37 * MiB;
constexpr size_t WS_U = 181 * MiB;
constexpr size_t WS_GATES = 313 * MiB;
constexpr size_t WS_STATE = 322 * MiB;
constexpr size_t WS_ROUTE = 362 * MiB;
constexpr size_t WS_ACT = 364 * MiB;
constexpr size_t WS_Y = WS_ACT + 700 * MiB;
constexpr size_t WS_END = WS_ACT + 1005 * MiB;
constexpr size_t WE_IN = 0, WE_OUT = 7 * MiB, WE_GU = 9 * MiB, WE_DOWN = 20 * MiB;
constexpr size_t WOD_IN = 0, WOD_OUT = 10 * MiB, WOD_GU = 12 * MiB, WOD_DOWN = 100 * MiB;
constexpr size_t EGU_BYTES = (size_t)NGU * D * 2, EDOWN_BYTES = (size_t)D * FF * 2;
static_assert(WOD_GU + 8 * EGU_BYTES <= WOD_DOWN && WOD_DOWN + 8 * EDOWN_BYTES <= 144 * MiB, "odd weights map");
static_assert((size_t)NIN_M * D * 2 <= 7 * MiB && WE_GU + EGU_BYTES <= WE_DOWN && WE_DOWN + EDOWN_BYTES <= 26 * MiB, "even weights map");
static_assert((size_t)M_ALL * NP_H * 2 <= 700 * MiB && (size_t)MOE_ROWS * D * 2 + (size_t)MOE_ROWS * FF * 2 <= 1005 * MiB && 700 * MiB + (size_t)M_ALL * D * 2 <= 1005 * MiB, "act map");
constexpr int CW_BAR = 4096;
constexpr int CW_ECNT = 8192;
constexpr int CW_DBG = 16384;
constexpr int CW_CMAX = 32768, CM_LSTRIDE = 50176, CM_GU = 3328, CM_GU_O = 5120;
static_assert((size_t)(CW_CMAX + 4 * CM_LSTRIDE) * 4 <= CTL_ZERO_BYTES, "ctl map");
constexpr size_t RT_E = 0;
constexpr size_t RT_R = 512 * 1024;
constexpr size_t RT_W = 512 * 1024 + 1024 * 1024;
constexpr size_t SM_LB = 0;
constexpr size_t SM_PEXP = 64 * 1024;
constexpr size_t SM_EBASE = 96 * 1024;
constexpr size_t SM_SAU = 128 * 1024;
constexpr size_t SM_SAU2 = 400 * 1024;
constexpr size_t SM_SWE = 672 * 1024;
constexpr size_t SM_SWO = 712 * 1024;
constexpr int SWE_IN = 0, SWE_GU = 3328, SWO_IN = 0, SWO_GU = 5120;
static_assert(SM_SAU + (size_t)M_ALL * 4 <= SM_SAU2 && SM_SAU2 + (size_t)M_ALL * 4 <= SM_SWE && SM_SWE + (3328 + 5632) * 4 <= SM_SWO && SM_SWO + (5120 + 8 * 5632) * 4 <= 1024 * 1024, "small region map");
constexpr size_t GATES_SAMOE = (size_t)M_ALL * 32 * 4;
static_assert(GATES_SAMOE + (size_t)MOE_ROWS * 4 <= 9 * MiB, "gates region map");

constexpr int LDS_MAIN = 147456;
constexpr int LDSCTL_OFF = LDS_MAIN;
constexpr int LDS_BYTES = LDS_MAIN + 512;

#define GAS __attribute__((address_space(1)))
#define LAS __attribute__((address_space(3)))
typedef unsigned short bf16;
typedef unsigned v4u __attribute__((ext_vector_type(4)));
typedef unsigned v2u __attribute__((ext_vector_type(2)));
typedef float f32x4 __attribute__((ext_vector_type(4)));
typedef float f32x16 __attribute__((ext_vector_type(16)));
typedef short bf16x8 __attribute__((ext_vector_type(8)));
typedef short s16x4 __attribute__((ext_vector_type(4)));
typedef GAS unsigned gu32;
#define RLX_AGENT __ATOMIC_RELAXED, __HIP_MEMORY_SCOPE_AGENT
#define LDS_WAIT() asm volatile("s_waitcnt lgkmcnt(0)" ::: "memory")
#define VM_WAIT() asm volatile("s_waitcnt vmcnt(0)" ::: "memory")
#define CFENCE() asm volatile("" ::: "memory")
__device__ __forceinline__ unsigned f2bf(float f) { unsigned u = __builtin_bit_cast(unsigned, f); return (u + 0x7fffu + ((u >> 16) & 1u)) >> 16; }
typedef __bf16 bf16x2_t __attribute__((ext_vector_type(2)));
typedef float f32x2_t __attribute__((ext_vector_type(2)));
__device__ __forceinline__ unsigned pk2(float lo, float hi) { f32x2_t v = {lo, hi}; bf16x2_t b = __builtin_convertvector(v, bf16x2_t); return __builtin_bit_cast(unsigned, b); }
__device__ __forceinline__ float bf2f(unsigned short b) { return __builtin_bit_cast(float, (unsigned)b << 16); }
__device__ __forceinline__ float bflo(unsigned w) { return __builtin_bit_cast(float, w << 16); }
__device__ __forceinline__ float bfhi(unsigned w) { return __builtin_bit_cast(float, w & 0xffff0000u); }
__device__ __forceinline__ float sigmoidf_(float x) { return __builtin_amdgcn_rcpf(1.0f + __expf(-x)); }
__device__ __forceinline__ float siluf_(float x) { return x * sigmoidf_(x); }
template <int CTRL, int RM> __device__ __forceinline__ float dppmov(float x) { return __builtin_bit_cast(float, __builtin_amdgcn_update_dpp(0, __builtin_bit_cast(int, x), CTRL, RM, 0xf, false)); }
__device__ __forceinline__ float wave_sum(float v) {
    v += dppmov<0xB1, 0xf>(v); v += dppmov<0x4E, 0xf>(v); v += dppmov<0x141, 0xf>(v); v += dppmov<0x140, 0xf>(v);
    v += dppmov<0x142, 0xa>(v); v += dppmov<0x143, 0xc>(v);
    return __builtin_bit_cast(float, __builtin_amdgcn_readlane(__builtin_bit_cast(int, v), 63));
}

__device__ __forceinline__ float wave_max(float v) {
    v = fmaxf(v, dppmov<0xB1, 0xf>(v)); v = fmaxf(v, dppmov<0x4E, 0xf>(v)); v = fmaxf(v, dppmov<0x141, 0xf>(v)); v = fmaxf(v, dppmov<0x140, 0xf>(v));
    v = fmaxf(v, dppmov<0x142, 0xa>(v)); v = fmaxf(v, dppmov<0x143, 0xc>(v));
    return __builtin_bit_cast(float, __builtin_amdgcn_readlane(__builtin_bit_cast(int, v), 63));
}

#define XB_TMO      128
#define XB_XCNT(j)  (256  + 64 * (j))
#define XB_XSUB(j)  (1280 + 64 * (j))
#define XB_XGEN(j)  (2304 + 64 * (j))
#define XB_TOP      3328
#define XB_TOPGEN   3392
#define XCD_BAR_WORDS 3456
#define XB_SPIN_CAP (1u << 18)
__device__ __forceinline__ unsigned xb_ld(unsigned* p)              { return __hip_atomic_load(p, __ATOMIC_RELAXED, __HIP_MEMORY_SCOPE_AGENT); }
__device__ __forceinline__ unsigned xb_add(unsigned* p, unsigned v) { return __hip_atomic_fetch_add(p, v, __ATOMIC_RELAXED, __HIP_MEMORY_SCOPE_AGENT); }
__device__ __forceinline__ unsigned xb_xcc_id() { return (unsigned)__builtin_amdgcn_s_getreg((3 << 11) | 20) & 0xFu; }
#define XB_SPIN(cond, bar) do { unsigned _sp = 0; while (cond) { __builtin_amdgcn_s_sleep(1); \
    if ((++_sp & 255u) == 0u) { if (xb_ld(&(bar)[XB_TMO])) break; if (_sp > XB_SPIN_CAP) { atomicAdd(&(bar)[XB_TMO], 1u); break; } } } } while (0)
struct XcdBarrier { unsigned* bar; unsigned x; volatile LAS unsigned* st; };
__device__ __forceinline__ XcdBarrier xcd_barrier_post(unsigned* bar, volatile LAS unsigned* st) {
    XcdBarrier b; b.bar = bar; b.x = xb_xcc_id(); b.st = st;
    if (threadIdx.x == 0) (void)xb_add(&bar[XB_XCNT(b.x)], 1u);
    return b;
}
__device__ __forceinline__ void xcd_barrier_complete(unsigned* bar, unsigned x, unsigned& nloc, unsigned& nx) {
    const unsigned G = gridDim.x * gridDim.y * gridDim.z;
    unsigned sum, cnt, mine, sp = 0u;
    for (;;) {
        sum = 0u; cnt = 0u; mine = 0u;
#pragma unroll
        for (unsigned j = 0; j < 16; ++j) { const unsigned c = xb_ld(&bar[XB_XCNT(j)]); sum += c; cnt += (c > 0u) ? 1u : 0u; mine = (j == x) ? c : mine; }
        if (sum == G) break;
        __builtin_amdgcn_s_sleep(1);
        if ((++sp & 255u) == 0u) { if (xb_ld(&bar[XB_TMO])) break; if (sp > XB_SPIN_CAP) { atomicAdd(&bar[XB_TMO], 1u); break; } }
    }
    nloc = mine > 0u ? mine : 1u; nx = cnt > 0u ? cnt : 1u;
}
__device__ __attribute__((noinline)) void xcd_barrier(unsigned* bar_, unsigned bx_, volatile LAS unsigned* st_) { XcdBarrier b; b.bar = bar_; b.x = bx_; b.st = st_;
    asm volatile("s_waitcnt vmcnt(0)" ::: "memory");
    __syncthreads();
    if (threadIdx.x == 0) {
        unsigned* bar = b.bar;
        __builtin_amdgcn_s_waitcnt(0);
        unsigned nloc = b.st[0], nx = b.st[1];
        if (nloc == 0u) { xcd_barrier_complete(bar, b.x, nloc, nx); b.st[0] = nloc; b.st[1] = nx; }
        const unsigned old = xb_add(&bar[XB_XSUB(b.x)], 1u);
        const unsigned gen = old / nloc;
        if (old + 1u == (gen + 1u) * nloc) {
            __builtin_amdgcn_fence(__ATOMIC_RELEASE, "agent");
            asm volatile("s_waitcnt vmcnt(0)" ::: "memory");
            const unsigned og = xb_add(&bar[XB_TOP], 1u);
            const unsigned tg = og / nx;
            if (og + 1u == (tg + 1u) * nx) xb_add(&bar[XB_TOPGEN], 1u);
            else XB_SPIN(xb_ld(&bar[XB_TOPGEN]) == tg, bar);
            __builtin_amdgcn_fence(__ATOMIC_ACQUIRE, "agent");
            xb_add(&bar[XB_XGEN(b.x)], 1u);
            asm volatile("s_waitcnt vmcnt(0)" ::: "memory");
        } else {
            XB_SPIN(xb_ld(&bar[XB_XGEN(b.x)]) == gen, bar);
            __builtin_amdgcn_fence(__ATOMIC_ACQUIRE, "agent");
            asm volatile("s_waitcnt vmcnt(0)" ::: "memory");
        }
    }
    __syncthreads();
}

struct Args {
    const float* in[23];
    float* out; unsigned char* ws;
    int ph_lo, ph_hi;
    int use_bar, pad;
};
struct Frame {
    LAS unsigned char* lds;
    int tid, lane, wave, G, bid;
    unsigned char* ws;
    const float* const __attribute__((address_space(4)))* in;
    float* out;
};
enum { I_X = 0, I_C, I_CTX, I_CCTX, I_MODW, I_MODB, I_NORMG, I_MWIN, I_MBGATE, I_MWCONV, I_MGHEAD, I_MWOUT, I_HWIN, I_HBF, I_HLB, I_HGHEAD, I_HWOUT, I_FWGU, I_FWDOWN, I_EWR, I_EBR, I_EWGU, I_EWDOWN };

#ifndef FP8_LAYERS
#define FP8_LAYERS 0xE
#endif
#define FFN_FP8_L(L) (((FP8_LAYERS) >> (L)) & 1)
#ifndef INPROJ_I8
#define INPROJ_I8 1
#endif
#ifndef UP_I8
#define UP_I8 1
#endif
#ifndef UP_I8_MOE
#define UP_I8_MOE 0
#endif
#ifndef FFN_FP8
#define FFN_FP8 1
#endif
constexpr float WSCALE8 = 64.0f;

__device__ __forceinline__ void phase_mods(Frame& F) {
    LAS float* SV = (LAS float*)(F.lds);
    LAS float* RED = (LAS float*)(F.lds + 9 * 1024 * 4);
    const float* cvec = F.in[I_C]; const float* cctx = F.in[I_CCTX];
    for (int i = F.tid; i < 9 * 1024; i += NTHR) { const int b = i >> 10, k = i & 1023; const float v = b < 8 ? cvec[b * 1024 + k] : cctx[k]; SV[i] = siluf_(v); }
    __syncthreads();
    const float* modw = F.in[I_MODW]; const float* modb = F.in[I_MODB]; const float* normg = F.in[I_NORMG];
    float* modv = (float*)(F.ws + WS_MODV);
    for (int item = F.bid; item < 4 * 96; item += F.G) {
        const int L = item / 96, n0 = (item % 96) * 64;
        const float* wp = modw + (size_t)L * 1024 * 6144 + n0 + F.lane;
        float acc[9];
#pragma unroll
        for (int b = 0; b < 9; ++b) acc[b] = 0.f;
        const int k0 = F.wave * 128;
#pragma unroll 4
        for (int k = 0; k < 128; ++k) { const float wv = wp[(size_t)(k0 + k) * 6144];
#pragma unroll
            for (int b = 0; b < 9; ++b) acc[b] += SV[b * 1024 + k0 + k] * wv; }
#pragma unroll
        for (int b = 0; b < 9; ++b) RED[(F.wave * 9 + b) * 64 + F.lane] = acc[b];
        __syncthreads();
        for (int o = F.tid; o < 9 * 64; o += NTHR) { const int b = o >> 6, l = o & 63; float v = 0.f;
#pragma unroll
            for (int w = 0; w < 8; ++w) v += RED[(w * 9 + b) * 64 + l];
            const int n = n0 + l, s = n >> 10, c = n & 1023; v += modb[L * 6144 + n];
            const float* g = normg + (size_t)L * 4 * 1024;
            int slot; float r;
            if (s == 0) { slot = 1; r = v; } else if (s == 1) { slot = 0; r = g[c] * (1.f + v); } else if (s == 2) { slot = 2; r = v * g[1024 + c]; }
            else if (s == 3) { slot = 4; r = v; } else if (s == 4) { slot = 3; r = g[2048 + c] * (1.f + v); } else { slot = 5; r = v * g[3072 + c]; }
            modv[((size_t)(L * 9 + b) * 6 + slot) * 1024 + c] = r; }
        __syncthreads();
    }
}

struct WDesc { const float* src; unsigned char* dst; const unsigned* cmax; float* sw; int N; int Kb; int mode; };
__device__ __forceinline__ int wrow_gu(int n0) { const int half = n0 / FF, nn = n0 - half * FF; return 256 * (nn >> 7) + 128 * half + (nn & 127); }
__device__ __forceinline__ WDesc wdesc(const float* W, int K, int N, unsigned char* WT, int gu_mode, int mode, const unsigned* cmax, float* sw, int r, int lane) {
    const int nkb = K >> 6, nb = r / nkb, kb = r - nb * nkb, k0 = 64 * kb, n0 = 32 * nb;
    const int row0 = gu_mode ? wrow_gu(n0) : n0; const int esz = mode == 0 ? 2 : 1;
    WDesc d; d.N = N; d.Kb = K * esz; d.mode = mode;
    d.src = W + (size_t)(k0 + (lane >> 3)) * N + n0 + 4 * (lane & 7);
    d.dst = WT + (size_t)(row0 + (lane >> 3)) * d.Kb + (size_t)(k0 + 8 * (lane & 7)) * esz;
    d.cmax = cmax + n0; d.sw = (mode == 2 && kb == 0) ? sw + row0 : nullptr;
    return d;
}
#define WT_DECL(T) f32x4 T##0, T##1, T##2, T##3, T##4, T##5, T##6, T##7
#define WT_LOAD(T, p, N) do { const GAS float* _p = (const GAS float*)(p); const size_t _s = (size_t)8 * (N); \
    T##0 = *(const GAS f32x4*)(_p); T##1 = *(const GAS f32x4*)(_p + _s); T##2 = *(const GAS f32x4*)(_p + 2 * _s); T##3 = *(const GAS f32x4*)(_p + 3 * _s); \
    T##4 = *(const GAS f32x4*)(_p + 4 * _s); T##5 = *(const GAS f32x4*)(_p + 5 * _s); T##6 = *(const GAS f32x4*)(_p + 6 * _s); T##7 = *(const GAS f32x4*)(_p + 7 * _s); } while (0)
#define WT_COPY(A, B) do { A##0 = B##0; A##1 = B##1; A##2 = B##2; A##3 = B##3; A##4 = B##4; A##5 = B##5; A##6 = B##6; A##7 = B##7; } while (0)
__device__ __forceinline__ void wt_put(LAS float* w, int i, const f32x4 v) { w[(8 * i) * 33] = v[0]; w[(8 * i) * 33 + 1] = v[1]; w[(8 * i) * 33 + 2] = v[2]; w[(8 * i) * 33 + 3] = v[3]; }
__device__ __forceinline__ void wt_process(const WDesc& d, const f32x4 t0, const f32x4 t1, const f32x4 t2, const f32x4 t3, const f32x4 t4, const f32x4 t5, const f32x4 t6, const f32x4 t7, LAS float* scr, int lane) {
    LAS float* w = scr + (lane >> 3) * 33 + 4 * (lane & 7);
    wt_put(w, 0, t0); wt_put(w, 1, t1); wt_put(w, 2, t2); wt_put(w, 3, t3); wt_put(w, 4, t4); wt_put(w, 5, t5); wt_put(w, 6, t6); wt_put(w, 7, t7);
    LDS_WAIT(); CFENCE();
    const int c = lane & 7;
#pragma unroll
    for (int j = 0; j < 4; ++j) { const int n = (lane >> 3) + 8 * j; const LAS float* s = scr + (8 * c) * 33 + n;
        float x[8];
#pragma unroll
        for (int e = 0; e < 8; ++e) x[e] = s[e * 33];
        unsigned char* dp = d.dst + (size_t)(8 * j) * d.Kb;
        if (d.mode == 0) { v4u o; o.x = pk2(x[0], x[1]); o.y = pk2(x[2], x[3]); o.z = pk2(x[4], x[5]); o.w = pk2(x[6], x[7]); *(GAS v4u*)dp = o; }
        else if (d.mode == 1) { v2u o; unsigned q = 0; q = __builtin_amdgcn_cvt_pk_fp8_f32(x[0] * WSCALE8, x[1] * WSCALE8, q, false); q = __builtin_amdgcn_cvt_pk_fp8_f32(x[2] * WSCALE8, x[3] * WSCALE8, q, true); o.x = q;
            q = 0; q = __builtin_amdgcn_cvt_pk_fp8_f32(x[4] * WSCALE8, x[5] * WSCALE8, q, false); q = __builtin_amdgcn_cvt_pk_fp8_f32(x[6] * WSCALE8, x[7] * WSCALE8, q, true); o.y = q; *(GAS v2u*)dp = o; }
        else { const float mx = __uint_as_float(d.cmax[n]); const float iv = mx > 0.f ? 127.0f / mx : 0.f; unsigned q[8];
#pragma unroll
            for (int e = 0; e < 8; ++e) q[e] = (unsigned)(int)__builtin_rintf(x[e] * iv) & 0xffu;
            v2u o; o.x = q[0] | (q[1] << 8) | (q[2] << 16) | (q[3] << 24); o.y = q[4] | (q[5] << 8) | (q[6] << 16) | (q[7] << 24); *(GAS v2u*)dp = o;
            if (d.sw != nullptr && c == 0) d.sw[n] = mx > 0.f ? mx * (1.0f / 127.0f) : 1.0f; }
    }
    LDS_WAIT(); CFENCE();
}
__device__ __forceinline__ WDesc wdesc_layer(Frame& F, int L, int it) {
    const int j = L >> 1; int r = it; const unsigned* cm = (const unsigned*)(F.ws + WS_CTL) + CW_CMAX + L * CM_LSTRIDE;
    if ((L & 1) == 0) {
        unsigned char* wb = F.ws + WS_WE; float* swb = (float*)(F.ws + WS_SMALL + SM_SWE);
        constexpr int I0 = 16 * (NW_M / 32), I1 = 16 * 32, I2 = 16 * (NGU / 32);
        if (r < I0) return wdesc(F.in[I_MWIN] + (size_t)j * D * NW_M, D, NW_M, wb + WE_IN, 0, INPROJ_I8 ? 2 : 0, cm, swb + SWE_IN, r, F.lane); r -= I0;
        if (r < I1) return wdesc(F.in[I_MWOUT] + (size_t)j * D * D, D, D, wb + WE_OUT, 0, 0, cm, nullptr, r, F.lane); r -= I1;
        if (r < I2) return wdesc(F.in[I_FWGU] + (size_t)j * D * NGU, D, NGU, wb + WE_GU, 1, UP_I8 ? 2 : (FFN_FP8_L(L) ? 1 : 0), cm + CM_GU, swb + SWE_GU, r, F.lane); r -= I2;
        return wdesc(F.in[I_FWDOWN] + (size_t)j * FF * D, FF, D, wb + WE_DOWN, 0, FFN_FP8_L(L) ? 1 : 0, cm, nullptr, r, F.lane);
    } else {
        unsigned char* wb = F.ws + WS_WO; float* swb = (float*)(F.ws + WS_SMALL + SM_SWO);
        constexpr int I0 = 16 * (NP_H / 32), I1 = 16 * 32, I2 = 16 * (NGU / 32), I3 = (FF / 64) * 32;
        if (r < I0) return wdesc(F.in[I_HWIN] + (size_t)j * D * NP_H, D, NP_H, wb + WOD_IN, 0, INPROJ_I8 ? 2 : 0, cm, swb + SWO_IN, r, F.lane); r -= I0;
        if (r < I1) return wdesc(F.in[I_HWOUT] + (size_t)j * D * D, D, D, wb + WOD_OUT, 0, 0, cm, nullptr, r, F.lane); r -= I1;
        const int e = r / (I2 + I3); r -= e * (I2 + I3);
        if (r < I2) return wdesc(F.in[I_EWGU] + ((size_t)j * NEXP + e) * D * NGU, D, NGU, wb + WOD_GU + e * EGU_BYTES, 1, UP_I8_MOE ? 2 : (FFN_FP8_L(L) ? 1 : 0), cm + CM_GU_O + e * NGU, swb + SWO_GU + e * NGU, r, F.lane); r -= I2;
        return wdesc(F.in[I_EWDOWN] + ((size_t)j * NEXP + e) * FF * D, FF, D, wb + WOD_DOWN + e * EDOWN_BYTES, 0, FFN_FP8_L(L) ? 1 : 0, cm, nullptr, r, F.lane);
    }
}
__device__ __forceinline__ void phase_wconv(Frame& F, int L) {
    LAS float* scr = (LAS float*)(F.lds + F.wave * 16384);
    const int gw = F.bid * NWAVES + F.wave, NGW = F.G * NWAVES;
    const int total = (L & 1) ? 16 * (NP_H / 32) + 16 * 32 + NEXP * (16 * (NGU / 32) + (FF / 64) * 32) : 16 * (NW_M / 32) + 16 * 32 + 16 * (NGU / 32) + (FF / 64) * 32;
    WT_DECL(c); WT_DECL(n); WDesc dc, dn;
    int it = gw;
    if (it < total) { dc = wdesc_layer(F, L, it); WT_LOAD(c, dc.src, dc.N); }
#pragma unroll 1
    for (; it < total; it += NGW) {
        const bool more = it + NGW < total;
        if (more) { dn = wdesc_layer(F, L, it + NGW); WT_LOAD(n, dn.src, dn.N); }
        wt_process(dc, c0, c1, c2, c3, c4, c5, c6, c7, scr, F.lane);
        if (more) { dc = dn; WT_COPY(c, n); }
    }
    if ((L & 1) == 0) {
        unsigned char* wb = F.ws + WS_WE; float* swb = (float*)(F.ws + WS_SMALL + SM_SWE);
        GAS v4u* z = (GAS v4u*)(wb + WE_IN + (size_t)NW_M * D * (INPROJ_I8 ? 1 : 2)); const int nz = (NIN_M - NW_M) * D * (INPROJ_I8 ? 1 : 2) / 16;
        for (int i = F.bid * NTHR + F.tid; i < nz; i += F.G * NTHR) z[i] = (v4u){0u, 0u, 0u, 0u};
        if (INPROJ_I8 && F.bid == 0 && F.tid < NIN_M - NW_M) swb[SWE_IN + NW_M + F.tid] = 1.0f;
    }
}
__device__ __forceinline__ void phase_colmax(Frame& F) {
    const int gw = F.bid * NWAVES + F.wave, NGW = F.G * NWAVES;
    constexpr int TE_IN = 16 * (NW_M / 32), TE_GU = 16 * (NGU / 32), TO_IN = 16 * (NP_H / 32);
    constexpr int TE = (INPROJ_I8 ? TE_IN : 0) + (UP_I8 ? TE_GU : 0), TO = (INPROJ_I8 ? TO_IN : 0) + (UP_I8_MOE ? NEXP * TE_GU : 0), total = 2 * (TE + TO);
#pragma unroll 1
    for (int it = gw; it < total; it += NGW) {
        int r = it; int L; const float* W; int N, nnb, cbase;
        const int pr = r / (TE + TO); r -= pr * (TE + TO);
        if (r < TE) { L = 2 * pr; if (INPROJ_I8 && r < TE_IN) { W = F.in[I_MWIN] + (size_t)pr * D * NW_M; N = NW_M; nnb = NW_M / 32; cbase = 0; } else { if (INPROJ_I8) r -= TE_IN; W = F.in[I_FWGU] + (size_t)pr * D * NGU; N = NGU; nnb = NGU / 32; cbase = CM_GU; } }
        else { r -= TE; L = 2 * pr + 1;
            if (INPROJ_I8 && r < TO_IN) { W = F.in[I_HWIN] + (size_t)pr * D * NP_H; N = NP_H; nnb = NP_H / 32; cbase = 0; }
            else { if (INPROJ_I8) r -= TO_IN; const int e = r / TE_GU; r -= e * TE_GU; W = F.in[I_EWGU] + ((size_t)pr * NEXP + e) * D * NGU; N = NGU; nnb = NGU / 32; cbase = CM_GU_O + e * NGU; } }
        const int kb = r / nnb, nb = r - kb * nnb;
        const float* p = W + (size_t)(64 * kb + (F.lane >> 3)) * N + 32 * nb + 4 * (F.lane & 7);
        WT_DECL(t); WT_LOAD(t, p, N);
        f32x4 mx;
#pragma unroll
        for (int q = 0; q < 4; ++q) { float a = fmaxf(fmaxf(fabsf(t0[q]), fabsf(t1[q])), fmaxf(fabsf(t2[q]), fabsf(t3[q]))); a = fmaxf(a, fmaxf(fmaxf(fabsf(t4[q]), fabsf(t5[q])), fmaxf(fabsf(t6[q]), fabsf(t7[q]))));
            a = fmaxf(a, __shfl_xor(a, 8)); a = fmaxf(a, __shfl_xor(a, 16)); a = fmaxf(a, __shfl_xor(a, 32)); mx[q] = a; }
        if (F.lane < 8) { unsigned* cm = (unsigned*)(F.ws + WS_CTL) + CW_CMAX + L * CM_LSTRIDE + cbase + 32 * nb + 4 * F.lane;
#pragma unroll
            for (int q = 0; q < 4; ++q) atomicMax(cm + q, __float_as_uint(mx[q])); }
    }
}

struct TokCfg {
    const void* lat_src_l; const void* lat_src_c;
    void* lat_dst_l; void* lat_dst_c;
    int src_f32, dst_f32;
    const bf16* y; int y_perm; int moe_combine;
    const float* vupd;
    const float* vna; const float* vnb;
    bf16* u; int u_perm; int u_fp8;
    float* u_scale;
    int route; int jr;
    int nrows;
};
__device__ __forceinline__ int perm_cm(int t) { return (t & 63) * ROWS_G + (t >> 6); }

struct RowRaw { v4u l0, l1, l2, l3; v2u a0, a1, a2, a3, b0, b1, b2, b3; };
__device__ __forceinline__ RowRaw tok_issue(const TokCfg& T, int row, int p0, int p1, int lane) {
    RowRaw R; const v4u z4 = (v4u){0u, 0u, 0u, 0u}; const v2u z2 = (v2u){0u, 0u};
    R.l0 = z4; R.l1 = z4; R.l2 = z4; R.l3 = z4; R.a0 = z2; R.a1 = z2; R.a2 = z2; R.a3 = z2; R.b0 = z2; R.b1 = z2; R.b2 = z2; R.b3 = z2;
    if (T.src_f32) { const GAS v4u* lp = (const GAS v4u*)(row < M_LAT ? (const float*)T.lat_src_l + (size_t)row * D : (const float*)T.lat_src_c + (size_t)(row - M_LAT) * D) + lane;
        R.l0 = lp[0]; R.l1 = lp[64]; R.l2 = lp[128]; R.l3 = lp[192]; }
    else { const GAS v2u* lp = (const GAS v2u*)(row < M_LAT ? (const bf16*)T.lat_src_l + (size_t)row * D : (const bf16*)T.lat_src_c + (size_t)(row - M_LAT) * D) + lane;
        const v2u a = lp[0], b = lp[64], c = lp[128], d = lp[192]; R.l0.x = a.x; R.l0.y = a.y; R.l1.x = b.x; R.l1.y = b.y; R.l2.x = c.x; R.l2.y = c.y; R.l3.x = d.x; R.l3.y = d.y; }
    if (T.y) {
        if (T.moe_combine) { const GAS v2u* ya = (const GAS v2u*)(T.y + (size_t)p0 * D) + lane; const GAS v2u* yb = (const GAS v2u*)(T.y + (size_t)p1 * D) + lane;
            R.a0 = ya[0]; R.a1 = ya[64]; R.a2 = ya[128]; R.a3 = ya[192]; R.b0 = yb[0]; R.b1 = yb[64]; R.b2 = yb[128]; R.b3 = yb[192]; }
        else { int yr = row; if (T.y_perm && row < M_LAT) yr = (row & ~8191) + perm_cm(row & 8191);
            const GAS v2u* yp = (const GAS v2u*)(T.y + (size_t)yr * D) + lane; R.a0 = yp[0]; R.a1 = yp[64]; R.a2 = yp[128]; R.a3 = yp[192]; }
    }
    return R;
}
__device__ __forceinline__ void phase_tok(Frame& F, const TokCfg& T) {
    const int gw = F.bid * NWAVES + F.wave, NGW = F.G * NWAVES;
    const int R = (T.nrows + NGW - 1) / NGW; const int r0 = gw * R; int r1 = r0 + R; if (r1 > T.nrows) r1 = T.nrows;
    LAS float* WR = (LAS float*)F.lds;
    if (T.route) { const float* wr = F.in[I_EWR] + (size_t)T.jr * 1024 * 8; for (int i = F.tid; i < 8192; i += NTHR) WR[i] = wr[i]; }
    __syncthreads();
    f32x4 VU[4], VA[4], VB[4]; int curb = -1;
    int my_e0 = 0, my_e1 = 0; float my_w = 0.f;
    const int* rrp = (const int*)(F.ws + WS_ROUTE + RT_R); const float* rwp = (const float*)(F.ws + WS_ROUTE + RT_W);
    int p0c = 0, p1c = 0, p0n = 0, p1n = 0; float w0c = 0.f, w0n = 0.f;
    if (T.moe_combine && r0 < r1) { p0c = rrp[2 * r0]; p1c = rrp[2 * r0 + 1]; w0c = rwp[r0]; if (r0 + 1 < r1) { p0n = rrp[2 * r0 + 2]; p1n = rrp[2 * r0 + 3]; w0n = rwp[r0 + 1]; } }
    RowRaw C = tok_issue(T, r0 < r1 ? r0 : 0, p0c, p1c, F.lane);
    for (int row = r0; row < r1; ++row) {
        const bool hn = row + 1 < r1;
        int p0nn = 0, p1nn = 0; float w0nn = 0.f;
        const RowRaw N = tok_issue(T, hn ? row + 1 : row, p0n, p1n, F.lane);
        if (hn) {
            if (T.moe_combine && row + 2 < r1) { p0nn = rrp[2 * row + 4]; p1nn = rrp[2 * row + 5]; w0nn = rwp[row + 2]; } }
        const int b = row < M_LAT ? (row >> 13) : 8;
        if (b != curb) { curb = b;
#pragma unroll
            for (int j = 0; j < 4; ++j) {
                if (T.y) VU[j] = ((const f32x4*)(T.vupd + (size_t)b * 6144))[F.lane + 64 * j];
                if (T.vna) { VA[j] = ((const f32x4*)(T.vna + (size_t)b * 6144))[F.lane + 64 * j]; VB[j] = ((const f32x4*)(T.vnb + (size_t)b * 6144))[F.lane + 64 * j]; } } }
        f32x4 v[4];
        if (T.src_f32) {
            v[0] = __builtin_bit_cast(f32x4, C.l0); v[1] = __builtin_bit_cast(f32x4, C.l1); v[2] = __builtin_bit_cast(f32x4, C.l2); v[3] = __builtin_bit_cast(f32x4, C.l3); }
        else {
            const v4u cl[4] = {C.l0, C.l1, C.l2, C.l3};
#pragma unroll
            for (int j = 0; j < 4; ++j) v[j] = (f32x4){bflo(cl[j].x), bfhi(cl[j].x), bflo(cl[j].y), bfhi(cl[j].y)}; }
        if (T.y) {
            f32x4 yv[4]; const v2u cya[4] = {C.a0, C.a1, C.a2, C.a3}, cyb[4] = {C.b0, C.b1, C.b2, C.b3};
            if (T.moe_combine) { const float w0 = w0c, w1 = 1.f - w0c;
#pragma unroll
                for (int j = 0; j < 4; ++j) { const v2u a = cya[j], c = cyb[j];
                    yv[j] = (f32x4){w0 * bflo(a.x) + w1 * bflo(c.x), w0 * bfhi(a.x) + w1 * bfhi(c.x), w0 * bflo(a.y) + w1 * bflo(c.y), w0 * bfhi(a.y) + w1 * bfhi(c.y)}; }
            } else {
#pragma unroll
                for (int j = 0; j < 4; ++j) { const v2u a = cya[j]; yv[j] = (f32x4){bflo(a.x), bfhi(a.x), bflo(a.y), bfhi(a.y)}; }
            }
            float ss = 0.f;
#pragma unroll
            for (int j = 0; j < 4; ++j) ss += (yv[j].x * yv[j].x + yv[j].y * yv[j].y) + (yv[j].z * yv[j].z + yv[j].w * yv[j].w);
            const float rs = rsqrtf(wave_sum(ss) * (1.f / D) + EPS);
#pragma unroll
            for (int j = 0; j < 4; ++j) v[j] = v[j] + VU[j] * (yv[j] * rs);
        }
        void* dpv = row < M_LAT ? T.lat_dst_l : T.lat_dst_c;
        if (dpv) { const size_t ro = (size_t)(row < M_LAT ? row : row - M_LAT) * D;
            if (T.dst_f32) { float* dp = (float*)dpv + ro;
#pragma unroll
                for (int j = 0; j < 4; ++j) ((GAS f32x4*)dp)[F.lane + 64 * j] = v[j]; }
            else { bf16* dp = (bf16*)dpv + ro;
#pragma unroll
                for (int j = 0; j < 4; ++j) { v2u o; o.x = pk2(v[j].x, v[j].y); o.y = pk2(v[j].z, v[j].w); ((GAS v2u*)dp)[F.lane + 64 * j] = o; } } }
        if (T.vna) {
            float ss = 0.f;
#pragma unroll
            for (int j = 0; j < 4; ++j) ss += (v[j].x * v[j].x + v[j].y * v[j].y) + (v[j].z * v[j].z + v[j].w * v[j].w);
            const float rs = rsqrtf(wave_sum(ss) * (1.f / D) + EPS);
            f32x4 uu[4];
#pragma unroll
            for (int j = 0; j < 4; ++j) uu[j] = (v[j] * rs) * VA[j] + VB[j];
            int ur = row; if (T.u_perm && row < M_LAT) ur = (row & ~8191) + perm_cm(row & 8191);
            if (T.u_fp8 == 2) { GAS unsigned* up8 = (GAS unsigned*)((unsigned char*)T.u + (size_t)ur * D);
                float mx = 0.f;
#pragma unroll
                for (int j = 0; j < 4; ++j) mx = fmaxf(fmaxf(mx, fmaxf(fabsf(uu[j].x), fabsf(uu[j].y))), fmaxf(fabsf(uu[j].z), fabsf(uu[j].w)));
                mx = wave_max(mx); const float iv = mx > 0.f ? 127.0f / mx : 0.f;
#pragma unroll
                for (int j = 0; j < 4; ++j) { const unsigned q0 = (unsigned)(int)__builtin_rintf(uu[j].x * iv) & 0xffu, q1 = (unsigned)(int)__builtin_rintf(uu[j].y * iv) & 0xffu, q2 = (unsigned)(int)__builtin_rintf(uu[j].z * iv) & 0xffu, q3 = (unsigned)(int)__builtin_rintf(uu[j].w * iv);
                    up8[F.lane + 64 * j] = q0 | (q1 << 8) | (q2 << 16) | (q3 << 24); }
                if (F.lane == 0) T.u_scale[ur] = mx > 0.f ? mx * (1.0f / 127.0f) : 1.0f; }
            else if (T.u_fp8) { GAS unsigned* up8 = (GAS unsigned*)((unsigned char*)T.u + (size_t)ur * D);
#pragma unroll
                for (int j = 0; j < 4; ++j) { unsigned w = 0; w = __builtin_amdgcn_cvt_pk_fp8_f32(uu[j].x, uu[j].y, w, false); w = __builtin_amdgcn_cvt_pk_fp8_f32(uu[j].z, uu[j].w, w, true); up8[F.lane + 64 * j] = w; } }
            else { GAS v2u* up = (GAS v2u*)(T.u + (size_t)ur * D);
#pragma unroll
                for (int j = 0; j < 4; ++j) { v2u o; o.x = pk2(uu[j].x, uu[j].y); o.y = pk2(uu[j].z, uu[j].w); up[F.lane + 64 * j] = o; } }
            if (T.route) {
                float lg[8];
#pragma unroll
                for (int e = 0; e < 8; ++e) lg[e] = 0.f;
#pragma unroll
                for (int j = 0; j < 4; ++j)
#pragma unroll
                    for (int i = 0; i < 4; ++i) { const int c = 4 * (F.lane + 64 * j) + i; const f32x4 wa = *(const LAS f32x4*)(WR + c * 8), wb = *(const LAS f32x4*)(WR + c * 8 + 4); const float x = uu[j][i];
                        lg[0] += x * wa.x; lg[1] += x * wa.y; lg[2] += x * wa.z; lg[3] += x * wa.w; lg[4] += x * wb.x; lg[5] += x * wb.y; lg[6] += x * wb.z; lg[7] += x * wb.w; }
                const float* br = F.in[I_EBR] + T.jr * 8;
#pragma unroll
                for (int e = 0; e < 8; ++e) lg[e] = wave_sum(lg[e]) + br[e];
                int e0 = 0; float v0 = lg[0];
#pragma unroll
                for (int e = 1; e < 8; ++e) if (lg[e] > v0) { v0 = lg[e]; e0 = e; }
                int e1 = -1; float v1 = -3.0e38f;
#pragma unroll
                for (int e = 0; e < 8; ++e) if (e != e0 && lg[e] > v1) { v1 = lg[e]; e1 = e; }
                const float w0 = 1.f / (1.f + __expf(v1 - v0));
                if (F.lane == row - r0) { my_e0 = e0; my_e1 = e1; my_w = w0; }
            }
        }
        if (hn) { C = N; p0n = p0nn; p1n = p1nn; w0c = w0n; w0n = w0nn; }
    }
    if (T.route) {
        const int n = r1 - r0; const bool act = F.lane < n; const int row = r0 + F.lane;
        unsigned* ecnt = (unsigned*)(F.ws + WS_CTL) + CW_ECNT + T.jr * 8 * 64;
        int rk0 = 0, rk1 = 0;
        const unsigned long long ltmask = (F.lane == 0) ? 0ull : (~0ull >> (64 - F.lane));
#pragma unroll
        for (int e = 0; e < 8; ++e) {
            const unsigned long long m0 = __ballot(act && my_e0 == e), m1 = __ballot(act && my_e1 == e);
            const int c0 = __popcll(m0), c1 = __popcll(m1);
            unsigned base = 0;
            if (c0 + c1 > 0) { if (F.lane == 0) base = __hip_atomic_fetch_add(ecnt + e * 64, (unsigned)(c0 + c1), RLX_AGENT); base = __builtin_amdgcn_readfirstlane(base); }
            if (my_e0 == e) rk0 = (int)base + __popcll(m0 & ltmask);
            if (my_e1 == e) rk1 = (int)base + c0 + __popcll(m1 & ltmask);
        }
        if (act) { ((int*)(F.ws + WS_ROUTE + RT_E))[row] = my_e0 | (my_e1 << 8); ((int*)(F.ws + WS_ROUTE + RT_R))[2 * row] = rk0; ((int*)(F.ws + WS_ROUTE + RT_R))[2 * row + 1] = rk1;
            ((float*)(F.ws + WS_ROUTE + RT_W))[row] = my_w; }
    }
}

__device__ __forceinline__ void phase_moe_scatter(Frame& F, int jr, int nrows, const unsigned char* U, unsigned char* AM, int rowb, const float* sa_src, float* sa_dst) {
    const unsigned* ecnt = (const unsigned*)(F.ws + WS_CTL) + CW_ECNT + jr * 8 * 64;
    int base[8]; int acc = 0;
#pragma unroll
    for (int e = 0; e < 8; ++e) { const int c = (int)__hip_atomic_load(ecnt + e * 64, RLX_AGENT); base[e] = acc; acc += (c + 255) & ~255; }
    int* pexp = (int*)(F.ws + WS_SMALL + SM_PEXP);
    if (F.bid == 0) { const int np = acc >> 8;
        for (int p = F.tid; p < np; p += NTHR) { int e = 0;
#pragma unroll
            for (int q = 1; q < 8; ++q) if (p * 256 >= base[q]) e = q;
            pexp[p] = e; }
        if (F.tid == 0) pexp[MOE_PANELS] = np; }
    const int gw = F.bid * NWAVES + F.wave, NGW = F.G * NWAVES;
    const int R = (nrows + NGW - 1) / NGW; const int r0 = gw * R; int r1 = r0 + R; if (r1 > nrows) r1 = nrows;
    int* rr = (int*)(F.ws + WS_ROUTE + RT_R); const int* re = (const int*)(F.ws + WS_ROUTE + RT_E);
    for (int row = r0; row < r1; ++row) {
        const int ee = re[row], e0 = ee & 255, e1 = ee >> 8; int b0 = 0, b1 = 0;
#pragma unroll
        for (int e = 0; e < 8; ++e) { if (e0 == e) b0 = base[e]; if (e1 == e) b1 = base[e]; }
        const int p0 = b0 + rr[2 * row], p1 = b1 + rr[2 * row + 1];
        const v4u* src = (const v4u*)(U + (size_t)row * rowb); v4u* d0 = (v4u*)(AM + (size_t)p0 * rowb); v4u* d1 = (v4u*)(AM + (size_t)p1 * rowb);
        const v4u a = src[F.lane]; d0[F.lane] = a; d1[F.lane] = a;
        if (rowb > 1024) { const v4u c = src[F.lane + 64]; d0[F.lane + 64] = c; d1[F.lane + 64] = c; }
        CFENCE();
        if (F.lane == 0) { rr[2 * row] = p0; rr[2 * row + 1] = p1; if (sa_src) { const float s = sa_src[row]; sa_dst[p0] = s; sa_dst[p1] = s; } }
    }
}

#define MFMA32(a, b, c) __builtin_amdgcn_mfma_f32_32x32x16_bf16((a), (b), (c), 0, 0, 0)
typedef short v4i16_t __attribute__((ext_vector_type(4)));
typedef LAS unsigned char* ldsp;
__device__ __forceinline__ unsigned cvtpk(float lo, float hi) { f32x2_t v = {lo, hi}; bf16x2_t b = __builtin_convertvector(v, bf16x2_t); return __builtin_bit_cast(unsigned, b); }
__device__ __forceinline__ int crow(int reg, int h) { return (reg & 3) + 8 * (reg >> 2) + 4 * h; }
__device__ __forceinline__ bf16x8 pack8(const f32x16& x, int s) {
    v4u p; p.x = cvtpk(x[8 * s], x[8 * s + 1]); p.y = cvtpk(x[8 * s + 2], x[8 * s + 3]); p.z = cvtpk(x[8 * s + 4], x[8 * s + 5]); p.w = cvtpk(x[8 * s + 6], x[8 * s + 7]);
    return __builtin_bit_cast(bf16x8, p);
}
__device__ __forceinline__ bf16x8 lds16(ldsp p) { return *(const LAS bf16x8*)p; }
__device__ __forceinline__ bf16x8 lds8x2(ldsp p) { const s16x4 lo = *(const LAS s16x4*)p, hi = *(const LAS s16x4*)(p + 16); return __builtin_shufflevector(lo, hi, 0, 1, 2, 3, 4, 5, 6, 7); }
__device__ __forceinline__ s16x4 tr16(ldsp p) { return __builtin_bit_cast(s16x4, __builtin_amdgcn_ds_read_tr16_b64_v4i16((LAS v4i16_t*)p)); }
__device__ __forceinline__ bf16x8 ldstr2(ldsp p, int second) { const s16x4 lo = tr16(p), hi = tr16(p + second); return __builtin_shufflevector(lo, hi, 0, 1, 2, 3, 4, 5, 6, 7); }
__device__ __forceinline__ f32x16 zero16() { f32x16 z;
#pragma unroll
    for (int i = 0; i < 16; ++i) z[i] = 0.f; return z; }
__device__ __forceinline__ void unpack8(const v4u& w, float (&x)[8]) { x[0] = bflo(w.x); x[1] = bfhi(w.x); x[2] = bflo(w.y); x[3] = bfhi(w.y); x[4] = bflo(w.z); x[5] = bfhi(w.z); x[6] = bflo(w.w); x[7] = bfhi(w.w); }
__device__ __forceinline__ int launder_v(int x) { asm volatile("" : "+v"(x)); return x; }
struct FragOff { int o_row, o_perm, o_trn, o_trp; };
__device__ __forceinline__ FragOff frag_off(int lane, int LD) {
    const int r = lane & 31, hh = lane >> 5, i16 = lane & 15, q = i16 >> 2, p = i16 & 3, blk = (lane >> 4) & 1; FragOff f;
    f.o_row = (r * LD + 8 * hh) * 2; f.o_perm = (r * LD + 4 * hh) * 2;
    f.o_trn = ((8 * hh + q) * LD + 16 * blk + 4 * p) * 2; f.o_trp = ((4 * hh + q) * LD + 16 * blk + 4 * p) * 2; return f;
}


template <int CTRL, int RM, int BM> __device__ __forceinline__ float dpp_f(float old, float x) {
    return __builtin_bit_cast(float, __builtin_amdgcn_update_dpp(__builtin_bit_cast(int, old), __builtin_bit_cast(int, x), CTRL, RM, BM, false)); }
__device__ __forceinline__ float wave_scan_add(float x) {
    float r = x;
    r += dpp_f<0x111, 0xf, 0xf>(0.f, x); r += dpp_f<0x112, 0xf, 0xf>(0.f, x); r += dpp_f<0x113, 0xf, 0xf>(0.f, x);
    r += dpp_f<0x114, 0xf, 0xe>(0.f, r); r += dpp_f<0x118, 0xf, 0xc>(0.f, r);
    r += dpp_f<0x142, 0xa, 0xf>(0.f, r); r += dpp_f<0x143, 0xc, 0xf>(0.f, r);
    return r;
}
__device__ __forceinline__ float wave_scan_max(float x) {
    const float NEG = -3.0e38f; float r = x;
    r = fmaxf(r, dpp_f<0x111, 0xf, 0xf>(NEG, x)); r = fmaxf(r, dpp_f<0x112, 0xf, 0xf>(NEG, x)); r = fmaxf(r, dpp_f<0x113, 0xf, 0xf>(NEG, x));
    r = fmaxf(r, dpp_f<0x114, 0xf, 0xe>(NEG, r)); r = fmaxf(r, dpp_f<0x118, 0xf, 0xc>(NEG, r));
    r = fmaxf(r, dpp_f<0x142, 0xa, 0xf>(NEG, r)); r = fmaxf(r, dpp_f<0x143, 0xc, 0xf>(NEG, r));
    return r;
}
__device__ __forceinline__ float lane63(float x) { return __builtin_bit_cast(float, __builtin_amdgcn_readlane(__builtin_bit_cast(int, x), 63)); }
__device__ __forceinline__ float sum_halves(float x) {
    const unsigned u = __builtin_bit_cast(unsigned, x); auto rr = __builtin_amdgcn_permlane32_swap(u, u, false, false);
    return __builtin_bit_cast(float, (unsigned)rr[0]) + __builtin_bit_cast(float, (unsigned)rr[1]); }

__device__ __forceinline__ void item_headnorm(int tid, const bf16* hf, const bf16* hb, const bf16* gate, int gpitch, int gcol, const float* gh_head, bf16* aout, int rowbase, int t0, int ntok, int h) {
    VM_WAIT(); __syncthreads();
    const int sub = tid & 7, rr = tid >> 3;
    float gh[16];
#pragma unroll
    for (int e = 0; e < 16; ++e) gh[e] = gh_head[sub * 16 + e];
#pragma unroll 4
    for (int row = rr; row < ntok; row += 64) {
        const size_t grow = (size_t)(rowbase + t0 + row);
        const size_t o = grow * D + h * 128 + sub * 16;
        const v4u a0 = *(const GAS v4u*)(hf + o), a1 = *(const GAS v4u*)(hf + o + 8), b0 = *(const GAS v4u*)(hb + o), b1 = *(const GAS v4u*)(hb + o + 8);
        const bf16* gp = gate + grow * gpitch + gcol + h * 128 + sub * 16; const v4u g0 = *(const GAS v4u*)gp, g1 = *(const GAS v4u*)(gp + 8);
        float x[16], y[8];
        unpack8(a0, y);
#pragma unroll
        for (int e = 0; e < 8; ++e) x[e] = y[e];
        unpack8(a1, y);
#pragma unroll
        for (int e = 0; e < 8; ++e) x[8 + e] = y[e];
        unpack8(b0, y);
#pragma unroll
        for (int e = 0; e < 8; ++e) x[e] += y[e];
        unpack8(b1, y);
#pragma unroll
        for (int e = 0; e < 8; ++e) x[8 + e] += y[e];
        float ss = 0.f;
#pragma unroll
        for (int e = 0; e < 16; ++e) ss += x[e] * x[e];
        ss += __shfl_xor(ss, 1); ss += __shfl_xor(ss, 2); ss += __shfl_xor(ss, 4);
        const float rs = rsqrtf(ss * (1.f / 128.f) + EPS);
        float o16[16];
        unpack8(g0, y);
#pragma unroll
        for (int e = 0; e < 8; ++e) o16[e] = x[e] * rs * gh[e] * sigmoidf_(y[e]);
        unpack8(g1, y);
#pragma unroll
        for (int e = 0; e < 8; ++e) o16[8 + e] = x[8 + e] * rs * gh[8 + e] * sigmoidf_(y[e]);
        v4u w0, w1; w0.x = pk2(o16[0], o16[1]); w0.y = pk2(o16[2], o16[3]); w0.z = pk2(o16[4], o16[5]); w0.w = pk2(o16[6], o16[7]); w1.x = pk2(o16[8], o16[9]); w1.y = pk2(o16[10], o16[11]); w1.z = pk2(o16[12], o16[13]); w1.w = pk2(o16[14], o16[15]);
        *(GAS v4u*)(aout + o) = w0; *(GAS v4u*)(aout + o + 8) = w1;
    }
}

#ifndef SCAN_PF_OUT
#define SCAN_PF_OUT 1
#endif
constexpr int ML_LDQ = 72, ML_LDV = 136;
constexpr int ML_QC = 0, ML_KC = 9216, ML_KH = 18432, ML_V = 27648, ML_GS = 45056, ML_OB = 50176, ML_NV = 68608, ML_SSQ = 70656, ML_INV = 71680, ML_GROUP = 73728;
static_assert(2 * ML_GROUP <= LDS_MAIN, "mLSTM LDS map");
constexpr int ML_STATE_F = 8448;

struct MlPref { v4u q[2], k[2], v[4]; float gi, gf; };
struct MlSeg { int rowbase; int len; int t0; int nchunk; };

__device__ __forceinline__ void ml_issue(MlPref& P, const bf16* proj, const bf16* qkc, const float* gates, int rowbase, int t0c, int g, int h, int tg, int lane, bool need_q) {
    const int c8q = tg & 7;
#pragma unroll
    for (int i = 0; i < 2; ++i) { const int tau = (tg + 256 * i) >> 3; const int t = t0c + (g ? 63 - tau : tau);
        const bf16* rp = qkc + (size_t)(rowbase + t) * D + h * 64 + c8q * 8;
        P.q[i] = need_q ? *(const GAS v4u*)rp : (v4u){0u, 0u, 0u, 0u}; P.k[i] = *(const GAS v4u*)(rp + 512); }
#pragma unroll
    for (int i = 0; i < 4; ++i) { const int p = tg + 256 * i, tau = p >> 4, c8 = p & 15; const int t = t0c + (g ? 63 - tau : tau);
        P.v[i] = *(const GAS v4u*)(proj + (size_t)(rowbase + t) * NP_M + 1024 + h * 128 + c8 * 8); }
    { const int t = t0c + (g ? 63 - lane : lane); const GAS float* gp = (const GAS float*)(gates + (size_t)(rowbase + t) * 32 + g * 16 + h); P.gi = gp[0]; P.gf = gp[8]; }
}

template <bool OUTPUT>
__device__ __forceinline__ void mlstm_item(Frame& F, const bf16* proj, const bf16* qkc, const float* gates, bf16* hx0, bf16* hx1, bf16* aout, const float* ghead,
                                           int h, MlSeg S0, MlSeg S1, const float* st_in0, const float* st_in1, int npre0, int npre1, float* st_out0, float* st_out1) {
    const int tid_l = launder_v(F.tid); const int wave_l = __builtin_amdgcn_readfirstlane(tid_l >> 6);
    const int g = wave_l >> 2, j = wave_l & 3, tg = tid_l & 255, lane = tid_l & 63, r = lane & 31, hh = lane >> 5;
    const ldsp gb = F.lds + g * ML_GROUP;
    const ldsp GSb = gb + ML_GS + j * 1280;
    LAS float* GS = (LAS float*)GSb;
    const ldsp OBb = gb + ML_OB + j * 4608;
    LAS float* NV = (LAS float*)(gb + ML_NV);
    LAS float* SSQ = (LAS float*)(gb + ML_SSQ);
    const ldsp INVb = gb + ML_INV + j * 256;
    const int rowbase = g ? S1.rowbase : S0.rowbase, seg_t0 = g ? S1.t0 : S0.t0, nch = g ? S1.nchunk : S0.nchunk;
    const int vcol = 64 * j;
    __syncthreads();
    f32x16 C[2]; C[0] = zero16(); C[1] = zero16();
    float m_prev = -1.0e30f, btot = 0.f;
    float nreg = 0.f;
    if (OUTPUT) {
        const float* sp = g ? st_in1 : st_in0; const int np = g ? npre1 : npre0;
#pragma unroll 1
        for (int k = 0; k < np; ++k) { const float* e = sp + (size_t)k * ML_STATE_F;
            const float mloc = e[8192 + 64], B = e[8192 + 65];
            const float mnew = fmaxf(B + m_prev, mloc), al = __expf(B + m_prev - mnew), be = __expf(mloc - mnew);
            const float* ep = e + (4 * hh) * 128 + 32 * j + r;
#pragma unroll
            for (int dt = 0; dt < 2; ++dt)
#pragma unroll
                for (int i = 0; i < 16; ++i) C[dt][i] = al * C[dt][i] + be * ep[(32 * dt + (i & 3) + 8 * (i >> 2)) * 128];
            nreg = al * nreg + be * e[8192 + 16 * j + (lane & 15)];
            m_prev = mnew; }
    }
    if (lane < 16) NV[16 * j + lane] = nreg;
    constexpr int NPF = OUTPUT ? SCAN_PF_OUT : 2;
    MlPref PP[NPF]; ml_issue(PP[0], proj, qkc, gates, rowbase, seg_t0 + 64 * (g ? nch - 1 : 0), g, h, tg, lane, OUTPUT);
    if (NPF == 2) ml_issue(PP[NPF - 1], proj, qkc, gates, rowbase, seg_t0 + 64 * (g ? nch - 2 : 1), g, h, tg, lane, OUTPUT);
    __syncthreads();
#pragma unroll 1
    for (int step2 = 0; step2 < nch; step2 += NPF) {
#pragma unroll
    for (int hf = 0; hf < NPF; ++hf) { const int step = step2 + hf; MlPref& P = PP[hf];
        const int tgs = launder_v(tg), lns = launder_v(lane);
        const int r = lns & 31, hh = lns >> 5;
        const FragOff fq = frag_off(lns, ML_LDQ), fv = frag_off(lns, ML_LDV);
        const int o_h4 = 16 * hh;
        const int o_obw = (4 * hh * 36 + r) * 4, o_obr = ((lns >> 1) * 36 + 16 * (lns & 1)) * 4;
        const int ci = g ? nch - 1 - step : step;
        const int par = step & 1;
        float decay;
        {
            const float xi = P.gi, lf = P.gf;
            const float bc = wave_scan_add(lf);
            const float a = xi - bc; const float pm = wave_scan_max(a);
            const float Mt = fmaxf(m_prev, pm);
            const float Ml = lane63(Mt), bl = lane63(bc);
            GS[lns] = __expf(fminf(Ml - Mt, 80.f)); GS[192 + lns] = __expf(-(bc + Mt)); GS[256 + lns] = __expf(a - Ml);
            decay = __expf(m_prev - Ml); m_prev = bl + Ml; btot += bl;
        }
        LDS_WAIT(); CFENCE();
        {
            const int c8 = tgs & 7;
#pragma unroll
            for (int i = 0; i < 2; ++i) { const int tau = (tgs + 256 * i) >> 3; const ldsp tp = gb + (tau * ML_LDQ + c8 * 8) * 2; float o[8]; v4u w;
                if (OUTPUT) { unpack8(P.q[i], o); const float qs = GS[tau];
                    w.x = pk2(o[0] * qs, o[1] * qs); w.y = pk2(o[2] * qs, o[3] * qs); w.z = pk2(o[4] * qs, o[5] * qs); w.w = pk2(o[6] * qs, o[7] * qs); *(LAS v4u*)(tp + ML_QC) = w; }
                unpack8(P.k[i], o); const float wkk = GS[256 + tau];
                w.x = pk2(o[0] * wkk, o[1] * wkk); w.y = pk2(o[2] * wkk, o[3] * wkk); w.z = pk2(o[4] * wkk, o[5] * wkk); w.w = pk2(o[6] * wkk, o[7] * wkk);
                *(LAS v4u*)(tp + ML_KH) = w; }
#pragma unroll
            for (int i = 0; i < 4; ++i) { const int p = tgs + 256 * i, tau = p >> 4, cc = p & 15; *(LAS v4u*)(gb + ML_V + (tau * ML_LDV + cc * 8) * 2) = P.v[i]; }
        }
        if (step + NPF < nch) ml_issue(P, proj, qkc, gates, rowbase, seg_t0 + 64 * (g ? nch - 1 - NPF - step : step + NPF), g, h, tgs, lns, OUTPUT);
        __syncthreads();
#pragma unroll
        for (int dt = 0; dt < 2; ++dt)
#pragma unroll
            for (int i = 0; i < 16; ++i) C[dt][i] *= decay;
        if (OUTPUT) {
            bf16* hx = g ? hx1 : hx0;
#pragma unroll
            for (int tt = 0; tt < 2; ++tt) {
                f32x16 acc = zero16();
#pragma unroll
                for (int dt = 0; dt < 2; ++dt)
#pragma unroll
                    for (int sp = 0; sp < 2; ++sp) acc = MFMA32(lds8x2(gb + ML_QC + fq.o_perm + (32 * tt * ML_LDQ + 32 * dt + 16 * sp) * 2), pack8(C[dt], sp), acc);
                float den = 0.f;
#pragma unroll
                for (int st = 0; st <= tt; ++st) {
                    f32x16 s = zero16();
#pragma unroll
                    for (int ks = 0; ks < 4; ++ks) s = MFMA32(lds16(gb + ML_KH + fq.o_row + (32 * st * ML_LDQ + 16 * ks) * 2), lds16(gb + ML_QC + fq.o_row + (32 * tt * ML_LDQ + 16 * ks) * 2), s);
#pragma unroll
                    for (int i = 0; i < 16; ++i) { const float pv = (st < tt || crow(i, hh) <= r) ? s[i] : 0.f; s[i] = pv; den += pv; }
                    const bf16x8 pa0 = pack8(s, 0), pa1 = pack8(s, 1);
                    acc = MFMA32(pa0, ldstr2(gb + ML_V + fv.o_trp + vcol + ((32 * st) * ML_LDV) * 2, 8 * ML_LDV * 2), acc);
                    acc = MFMA32(pa1, ldstr2(gb + ML_V + fv.o_trp + vcol + ((32 * st + 16) * ML_LDV) * 2, 8 * ML_LDV * 2), acc);
                    }
                float qn;
                { float q0 = 0.f, q1 = 0.f, q2 = 0.f, q3 = 0.f;
#pragma unroll
                for (int c4 = 0; c4 < 4; ++c4) { const v4u qw = *(const LAS v4u*)(gb + ML_QC + (r * ML_LDQ + 32 * hh) * 2 + (32 * tt * ML_LDQ + 8 * c4) * 2); float qx[8]; unpack8(qw, qx);
                    const f32x4 n0 = *(const LAS f32x4*)(gb + ML_NV + 8 * o_h4 + (par * 64 + 8 * c4) * 4), n1 = *(const LAS f32x4*)(gb + ML_NV + 8 * o_h4 + (par * 64 + 8 * c4 + 4) * 4);
                    q0 += qx[0] * n0[0] + qx[4] * n1[0]; q1 += qx[1] * n0[1] + qx[5] * n1[1]; q2 += qx[2] * n0[2] + qx[6] * n1[2]; q3 += qx[3] * n0[3] + qx[7] * n1[3]; }
                qn = (q0 + q1) + (q2 + q3); }
                den = sum_halves(den); qn = sum_halves(qn);
                const float dtot = den + decay * qn;
                const float inv = __builtin_amdgcn_rcpf(fmaxf(fabsf(dtot), GS[192 + 32 * tt + r]));
                if (hh == 0) *(LAS float*)(INVb + (32 * tt + r) * 4) = inv;
                LDS_WAIT(); CFENCE();
                f32x16 hv;
#pragma unroll
                for (int q4 = 0; q4 < 4; ++q4) { const f32x4 iv = *(const LAS f32x4*)(INVb + o_h4 + (32 * tt + 8 * q4) * 4);
#pragma unroll
                    for (int e = 0; e < 4; ++e) { const int i = 4 * q4 + e; hv[i] = acc[i] * iv[e]; } }
#pragma unroll
                for (int i = 0; i < 16; ++i) *(LAS float*)(OBb + o_obw + ((i & 3) + 8 * (i >> 2)) * 144) = hv[i];
                LDS_WAIT(); CFENCE();
                { const f32x4 x0 = *(const LAS f32x4*)(OBb + o_obr), x1 = *(const LAS f32x4*)(OBb + o_obr + 16), x2 = *(const LAS f32x4*)(OBb + o_obr + 32), x3 = *(const LAS f32x4*)(OBb + o_obr + 48);
                    const int tau = 32 * tt + (lns >> 1); const int t = seg_t0 + 64 * ci + (g ? 63 - tau : tau);
                    bf16* op = hx + (size_t)(rowbase + t) * D + h * 128 + 32 * j + 16 * (lns & 1);
                    v4u w0, w1; w0.x = pk2(x0[0], x0[1]); w0.y = pk2(x0[2], x0[3]); w0.z = pk2(x1[0], x1[1]); w0.w = pk2(x1[2], x1[3]); w1.x = pk2(x2[0], x2[1]); w1.y = pk2(x2[2], x2[3]); w1.z = pk2(x3[0], x3[1]); w1.w = pk2(x3[2], x3[3]);
                    *(GAS v4u*)op = w0; *(GAS v4u*)(op + 8) = w1; }
                LDS_WAIT(); CFENCE();
            }
        }
        __builtin_amdgcn_sched_barrier(0);
#pragma unroll
        for (int dt = 0; dt < 2; ++dt)
#pragma unroll
            for (int ks = 0; ks < 4; ++ks) C[dt] = MFMA32(ldstr2(gb + ML_KH + fq.o_trn + (16 * ks * ML_LDQ + 32 * dt) * 2, 4 * ML_LDQ * 2), ldstr2(gb + ML_V + fv.o_trn + vcol + (16 * ks * ML_LDV) * 2, 4 * ML_LDV * 2), C[dt]);
        {   const int dkl = 16 * j + (lns & 15), tq = lns >> 4; float s0 = 0.f, s1 = 0.f;
#pragma unroll
            for (int i = 0; i < 16; i += 2) { s0 += bf2f(*(const LAS bf16*)(gb + ML_KH + ((16 * tq + i) * ML_LDQ + dkl) * 2)); s1 += bf2f(*(const LAS bf16*)(gb + ML_KH + ((16 * tq + i + 1) * ML_LDQ + dkl) * 2)); }
            float sacc = s0 + s1; sacc += __shfl_xor(sacc, 16); sacc = sum_halves(sacc);
            nreg = decay * nreg + sacc; if (lns < 16) NV[(par ^ 1) * 64 + dkl] = nreg; }
        __syncthreads();
    } }
    if (OUTPUT) item_headnorm(launder_v(tid_l), hx0, hx1, proj, NP_M, 2048, ghead + h * 128, aout, S0.rowbase, S0.t0, S0.nchunk * 64, h);
    if (!OUTPUT) {
        float* e = g ? st_out1 : st_out0; float* ep = e + (4 * hh) * 128 + 32 * j + r;
#pragma unroll
        for (int dt = 0; dt < 2; ++dt)
#pragma unroll
            for (int i = 0; i < 16; ++i) ep[(32 * dt + (i & 3) + 8 * (i >> 2)) * 128] = C[dt][i];
        if (lane < 16) e[8192 + 16 * j + lane] = nreg;
        if (j == 0 && lane == 0) { e[8192 + 64] = m_prev; e[8192 + 65] = btot; }
    }
}

constexpr int MS_KH = 0, MS_V = 9216, MS_BUF = 26624, MS_W = 2 * MS_BUF  ;
static_assert(MS_W + 34 * 64 * 4 <= ML_GROUP, "mLSTM S1 LDS map");
struct MsPref { v4u k[2], v[4]; };
__device__ __forceinline__ void ms_issue(MsPref& P, const bf16* proj, const bf16* qkc, int rowbase, int t0c, int g, int h, int tg) {
    const int c8q = tg & 7;
#pragma unroll
    for (int i = 0; i < 2; ++i) { const int tau = (tg + 256 * i) >> 3; const int t = t0c + (g ? 63 - tau : tau);
        P.k[i] = *(const GAS v4u*)(qkc + (size_t)(rowbase + t) * D + 512 + h * 64 + c8q * 8); }
#pragma unroll
    for (int i = 0; i < 4; ++i) { const int p = tg + 256 * i, tau = p >> 4, c8 = p & 15; const int t = t0c + (g ? 63 - tau : tau);
        P.v[i] = *(const GAS v4u*)(proj + (size_t)(rowbase + t) * NP_M + 1024 + h * 128 + c8 * 8); }
}
__device__ __forceinline__ void mlstm_s1_item(Frame& F, const bf16* proj, const bf16* qkc, const float* gates, int h, MlSeg S0, MlSeg S1, float* st_out0, float* st_out1) {
    const int tid_l = launder_v(F.tid); const int wave_l = __builtin_amdgcn_readfirstlane(tid_l >> 6);
    const int g = wave_l >> 2, j = wave_l & 3, tg = tid_l & 255, lane = tid_l & 63, r = lane & 31, hh = lane >> 5;
    const ldsp gb = F.lds + g * ML_GROUP;
    LAS float* W = (LAS float*)(gb + MS_W);
    const int rowbase = g ? S1.rowbase : S0.rowbase, seg_t0 = g ? S1.t0 : S0.t0, nch = g ? S1.nchunk : S0.nchunk;
    __syncthreads();
    MsPref PP[2]; ms_issue(PP[0], proj, qkc, rowbase, seg_t0 + 64 * (g ? nch - 1 : 0), g, h, tg);
    ms_issue(PP[1], proj, qkc, rowbase, seg_t0 + 64 * (g ? nch - 2 : 1), g, h, tg);
    float m_loc, btot;
    {
        float carry = 0.f, mx = -3.0e38f;
#pragma unroll 1
        for (int c = 0; c < nch; ++c) { const int ci = g ? nch - 1 - c : c; const int t = seg_t0 + 64 * ci + (g ? 63 - lane : lane);
            const GAS float* gp = (const GAS float*)(gates + (size_t)(rowbase + t) * 32 + g * 16 + h); const float xi = gp[0], lf = gp[8];
            const float bc = carry + wave_scan_add(lf); const float a = xi - bc;
            if (j == 0) W[64 * c + lane] = a;
            mx = fmaxf(mx, a); carry = lane63(bc); }
        mx = fmaxf(mx, __shfl_xor(mx, 1)); mx = fmaxf(mx, __shfl_xor(mx, 2)); mx = fmaxf(mx, __shfl_xor(mx, 4)); mx = fmaxf(mx, __shfl_xor(mx, 8)); mx = fmaxf(mx, __shfl_xor(mx, 16)); mx = fmaxf(mx, __shfl_xor(mx, 32));
        btot = carry; m_loc = btot + mx;
        __syncthreads();
        for (int s = tg; s < 64 * nch; s += 256) W[s] = __expf(W[s] - mx);
    }
    f32x16 C[2]; C[0] = zero16(); C[1] = zero16(); float nreg = 0.f;
    __syncthreads();
#pragma unroll 1
    for (int step2 = 0; step2 < nch; step2 += 2) {
#pragma unroll
    for (int hf = 0; hf < 2; ++hf) { const int step = step2 + hf; MsPref& P = PP[hf];
        const int tgs = launder_v(tg), lns = launder_v(lane);
        const FragOff fq = frag_off(lns, ML_LDQ), fv = frag_off(lns, ML_LDV);
        const ldsp bb = gb + hf * MS_BUF;
        {   const int c8 = tgs & 7;
#pragma unroll
            for (int i = 0; i < 2; ++i) { const int tau = (tgs + 256 * i) >> 3; float o[8]; unpack8(P.k[i], o); const float wkk = W[64 * step + tau]; v4u w;
                w.x = pk2(o[0] * wkk, o[1] * wkk); w.y = pk2(o[2] * wkk, o[3] * wkk); w.z = pk2(o[4] * wkk, o[5] * wkk); w.w = pk2(o[6] * wkk, o[7] * wkk);
                *(LAS v4u*)(bb + MS_KH + (tau * ML_LDQ + c8 * 8) * 2) = w; }
#pragma unroll
            for (int i = 0; i < 4; ++i) { const int p = tgs + 256 * i, tau = p >> 4, cc = p & 15; *(LAS v4u*)(bb + MS_V + (tau * ML_LDV + cc * 8) * 2) = P.v[i]; }
        }
        if (step + 2 < nch) ms_issue(P, proj, qkc, rowbase, seg_t0 + 64 * (g ? nch - 3 - step : step + 2), g, h, tgs);
        __syncthreads();
#pragma unroll
        for (int dt = 0; dt < 2; ++dt)
#pragma unroll
            for (int ks = 0; ks < 4; ++ks) C[dt] = MFMA32(ldstr2(bb + MS_KH + fq.o_trn + (16 * ks * ML_LDQ + 32 * dt) * 2, 4 * ML_LDQ * 2), ldstr2(bb + MS_V + fv.o_trn + 64 * j + (16 * ks * ML_LDV) * 2, 4 * ML_LDV * 2), C[dt]);
        {   const int dkl = 16 * j + (lns & 15), tq = lns >> 4; float s0 = 0.f, s1 = 0.f;
#pragma unroll
            for (int i = 0; i < 16; i += 2) { s0 += bf2f(*(const LAS bf16*)(bb + MS_KH + ((16 * tq + i) * ML_LDQ + dkl) * 2)); s1 += bf2f(*(const LAS bf16*)(bb + MS_KH + ((16 * tq + i + 1) * ML_LDQ + dkl) * 2)); }
            float sacc = s0 + s1; sacc += __shfl_xor(sacc, 16); sacc = sum_halves(sacc); nreg += sacc; }
    } }
    float* e = g ? st_out1 : st_out0; float* ep = e + (4 * hh) * 128 + 32 * j + r;
#pragma unroll
    for (int dt = 0; dt < 2; ++dt)
#pragma unroll
        for (int i = 0; i < 16; ++i) ep[(32 * dt + (i & 3) + 8 * (i >> 2)) * 128] = C[dt][i];
    if (lane < 16) e[8192 + 16 * j + lane] = nreg;
    if (j == 0 && lane == 0) { e[8192 + 64] = m_loc; e[8192 + 65] = btot; }
}

constexpr int HG_LD = 136;
constexpr int HG_LF = 0, HG_QT = 16384, HG_KT = 25088, HG_KH = 33792, HG_V = 42496, HG_OB = 51200, HG_AUX = 69632, HG_SSQ = 71168, HG_EAM = 71680, HG_BIAS = 72192, HG_LBV = 72704, HG_GROUP = 73728;
static_assert(2 * HG_GROUP <= LDS_MAIN, "HGRN2 LDS map");
constexpr int HG_STATE_F = 16512;

struct HgPref { unsigned q[8], f[8]; v4u v[2]; };
__device__ __forceinline__ void hg_issue(HgPref& P, const bf16* proj, int rowbase, int t0c, int g, int h, int tg, bool need_q) {
    const int lane = tg & 63, j = tg >> 6, cp = lane & 15, tq = lane >> 4, c0 = 32 * j + 2 * cp;
#pragma unroll
    for (int i = 0; i < 8; ++i) { const int tau = 8 * tq + i; const int t = t0c + (g ? 31 - tau : tau);
        const bf16* rp = proj + (size_t)(rowbase + t) * NP_H + h * 128 + c0;
        P.q[i] = need_q ? *(const GAS unsigned*)rp : 0u; P.f[i] = *(const GAS unsigned*)(rp + 2048 + 1024 * g); }
#pragma unroll
    for (int i = 0; i < 2; ++i) { const int p = tg + 256 * i, tau = p >> 4, c8 = p & 15; const int t = t0c + (g ? 31 - tau : tau);
        P.v[i] = *(const GAS v4u*)(proj + (size_t)(rowbase + t) * NP_H + 1024 + h * 128 + c8 * 8); }
}
__device__ __forceinline__ float clamp80(float x) { return fminf(fmaxf(x, -80.f), 80.f); }

template <bool OUTPUT>
__device__ __forceinline__ void hgrn_item(Frame& F, const bf16* proj, bf16* hx0, bf16* hx1, bf16* aout, const float* ghead, const float* bf_, const float* lbraw, int jl,
                                          int h, MlSeg S0, MlSeg S1, const float* st_in0, const float* st_in1, int npre0, int npre1, float* st_out0, float* st_out1) {
    const int tid_l = launder_v(F.tid); const int wave_l = __builtin_amdgcn_readfirstlane(tid_l >> 6);
    const int g = wave_l >> 2, j = wave_l & 3, tg = tid_l & 255, lane = tid_l & 63, r = lane & 31, hh = lane >> 5;
#ifdef SUBT
    unsigned long long _st = 0;
#define ST_MARK(slot) do { if (OUTPUT && tid_l == SUBT_TID) { const unsigned long long _n = wall_clock64(); volatile LAS unsigned* _w = (volatile LAS unsigned*)(F.lds + LDSCTL_OFF) + 40 + (slot); _w[0] += (unsigned)(_n - _st); _st = _n; } } while (0)
#else
#define ST_MARK(slot) do { } while (0)
#endif
    ST_MARK(7);
    const ldsp gb = F.lds + g * HG_GROUP;
    LAS float* LF = (LAS float*)(gb + HG_LF);
    const ldsp OBb = gb + HG_OB + j * 4608;
    LAS float* AMID = (LAS float*)(gb + HG_AUX); LAS float* ALAST = AMID + 128; LAS float* DEC = AMID + 256;
    LAS float* SSQ = (LAS float*)(gb + HG_SSQ); LAS float* EAM = (LAS float*)(gb + HG_EAM); LAS float* BIASV = (LAS float*)(gb + HG_BIAS); LAS float* LBV = (LAS float*)(gb + HG_LBV);
    const int rowbase = g ? S1.rowbase : S0.rowbase, seg_t0 = g ? S1.t0 : S0.t0, nch = g ? S1.nchunk : S0.nchunk;
    const int vcol = 64 * j;
    __syncthreads();
    if (tg < 128) { const int c = h * 128 + tg; BIASV[tg] = -1.44269504f * bf_[g * 1024 + c]; LBV[tg] = jl == 0 ? 0.f : sigmoidf_(lbraw[(1 * 2 + g) * 1024 + c] - lbraw[(0 * 2 + g) * 1024 + c]); }
    f32x16 St[4];
#pragma unroll
    for (int dt = 0; dt < 4; ++dt) St[dt] = zero16();
    float atot0 = 0.f, atot1 = 0.f;
    if (OUTPUT) {   const float* sp = g ? st_in1 : st_in0; const int np = g ? npre1 : npre0;
#pragma unroll 1
        for (int k = 0; k < np; ++k) { const float* e = sp + (size_t)k * HG_STATE_F; const float* ep = e + (4 * hh) * 128 + 32 * j + r; const float* ap = e + 16384 + 4 * hh;
#pragma unroll
            for (int dt = 0; dt < 4; ++dt)
#pragma unroll
                for (int i = 0; i < 16; ++i) { const int dk0 = 32 * dt + (i & 3) + 8 * (i >> 2); St[dt][i] = __builtin_amdgcn_exp2f(ap[dk0]) * St[dt][i] + ep[dk0 * 128]; } }
    }
    constexpr int NPF = OUTPUT ? SCAN_PF_OUT : 2;
    HgPref PP[NPF]; hg_issue(PP[0], proj, rowbase, seg_t0 + 32 * (g ? nch - 1 : 0), g, h, tg, OUTPUT);
    if (NPF == 2) hg_issue(PP[NPF - 1], proj, rowbase, seg_t0 + 32 * (g ? nch - 2 : 1), g, h, tg, OUTPUT);
    __syncthreads();
    ST_MARK(4);
    if (g) __builtin_amdgcn_s_barrier();
#pragma unroll 1
    for (int step2 = 0; step2 < nch; step2 += NPF) {
#pragma unroll
    for (int hf = 0; hf < NPF; ++hf) { const int step = step2 + hf; HgPref& P = PP[hf];
        const int tgs = launder_v(tg), lns = launder_v(lane);
        const int r = lns & 31, hh = lns >> 5;
        const FragOff fo = frag_off(lns, HG_LD);
        const int o_h4 = 16 * hh;
        const int o_obw = (4 * hh * 36 + r) * 4, o_obr = ((lns >> 1) * 36 + 16 * (lns & 1)) * 4;
        const int ci = g ? nch - 1 - step : step;
        ST_MARK(7);
        {
            const int cp = lns & 15, tq = lns >> 4, c0 = 32 * j + 2 * cp;
            const f32x2_t bb = *(const LAS f32x2_t*)(BIASV + c0), ll = *(const LAS f32x2_t*)(LBV + c0);
            const float ol0 = 1.f - ll.x, ol1 = 1.f - ll.y;
            float F0[8], F1[8], f0v[8], f1v[8]; float p0 = 1.f, p1 = 1.f;
#pragma unroll
            for (int i = 0; i < 8; ++i) { const float s0 = __builtin_amdgcn_rcpf(1.f + __builtin_amdgcn_exp2f(__builtin_fmaf(bflo(P.f[i]), -1.44269504f, bb.x))), s1 = __builtin_amdgcn_rcpf(1.f + __builtin_amdgcn_exp2f(__builtin_fmaf(bfhi(P.f[i]), -1.44269504f, bb.y)));
                const float f0 = fmaxf(__builtin_fmaf(ol0, s0, ll.x), 3.0517578125e-5f), f1 = fmaxf(__builtin_fmaf(ol1, s1, ll.y), 3.0517578125e-5f);
                p0 *= f0; p1 *= f1; F0[i] = p0; F1[i] = p1; f0v[i] = f0; f1v[i] = f1; }
            const float r0 = __builtin_amdgcn_logf(p0), r1 = __builtin_amdgcn_logf(p1);
            LAS f32x2_t* XT = (LAS f32x2_t*)(gb + HG_LF + j * 512);
            XT[tq * 16 + cp] = (f32x2_t){r0, r1};
            LDS_WAIT(); CFENCE();
            const f32x2_t t0 = XT[cp], t1 = XT[16 + cp], t2 = XT[32 + cp], t3 = XT[48 + cp];
            LDS_WAIT(); CFENCE();
            const float al0 = (t0.x + t1.x) + (t2.x + t3.x), al1 = (t0.y + t1.y) + (t2.y + t3.y);
            const float pre0 = (tq > 0 ? t0.x : 0.f) + (tq > 1 ? t1.x : 0.f) + (tq > 2 ? t2.x : 0.f), pre1 = (tq > 0 ? t0.y : 0.f) + (tq > 1 ? t1.y : 0.f) + (tq > 2 ? t2.y : 0.f);
            if (tq == 0) { *(LAS f32x2_t*)(DEC + c0) = (f32x2_t){__builtin_amdgcn_exp2f(al0), __builtin_amdgcn_exp2f(al1)}; atot0 += al0; atot1 += al1; }
            const float G0 = OUTPUT ? __builtin_amdgcn_exp2f(fminf(pre0 - al0, 115.f)) : 0.f, G1 = OUTPUT ? __builtin_amdgcn_exp2f(fminf(pre1 - al1, 115.f)) : 0.f;
            float h0 = __builtin_amdgcn_exp2f(al0 - pre0 - r0), h1 = __builtin_amdgcn_exp2f(al1 - pre1 - r1);
#pragma unroll
            for (int i = 7; i >= 0; --i) { const int tau = 8 * tq + i; const ldsp tp = gb + (tau * HG_LD + c0) * 2;
                if (OUTPUT) *(LAS unsigned*)(tp + HG_QT) = pk2(bflo(P.q[i]) * (F0[i] * G0), bfhi(P.q[i]) * (F1[i] * G1));
                *(LAS unsigned*)(tp + HG_KH) = pk2((1.f - f0v[i]) * h0, (1.f - f1v[i]) * h1);
                h0 *= f0v[i]; h1 *= f1v[i]; }
#pragma unroll
            for (int i = 0; i < 2; ++i) { const int p = tgs + 256 * i; *(LAS v4u*)(gb + HG_V + ((p >> 4) * HG_LD + (p & 15) * 8) * 2) = P.v[i]; }
        }
        if (step + NPF < nch) hg_issue(P, proj, rowbase, seg_t0 + 32 * (g ? nch - 1 - NPF - step : step + NPF), g, h, tgs, OUTPUT);
        ST_MARK(0);
        __syncthreads();
        ST_MARK(1);
        {   f32x4 dvv[16];
#pragma unroll
            for (int dt = 0; dt < 4; ++dt)
#pragma unroll
                for (int q4 = 0; q4 < 4; ++q4) dvv[4 * dt + q4] = *(const LAS f32x4*)(gb + HG_AUX + 1024 + o_h4 + (32 * dt + 8 * q4) * 4);
            __builtin_amdgcn_sched_barrier(0);
#pragma unroll
            for (int dt = 0; dt < 4; ++dt)
#pragma unroll
                for (int q4 = 0; q4 < 4; ++q4)
#pragma unroll
                    for (int e = 0; e < 4; ++e) St[dt][4 * q4 + e] *= dvv[4 * dt + q4][e]; }
        if (OUTPUT) {
            bf16* hx = g ? hx1 : hx0;
            f32x16 s = zero16(), o = zero16();
            {   bf16x8 ka[8], qa[8];
#pragma unroll
                for (int ks = 0; ks < 8; ++ks) { ka[ks] = lds16(gb + HG_KH + fo.o_row + 32 * ks); qa[ks] = lds16(gb + HG_QT + fo.o_row + 32 * ks); }
                __builtin_amdgcn_sched_barrier(0);
#pragma unroll
                for (int ks = 0; ks < 8; ++ks) s = MFMA32(ka[ks], qa[ks], s); }
            {   bf16x8 qp[8];
#pragma unroll
                for (int dt = 0; dt < 4; ++dt)
#pragma unroll
                    for (int sp = 0; sp < 2; ++sp) qp[2 * dt + sp] = lds8x2(gb + HG_QT + fo.o_perm + (32 * dt + 16 * sp) * 2);
                const bf16x8 v0 = ldstr2(gb + HG_V + fo.o_trp + vcol, 8 * HG_LD * 2), v1 = ldstr2(gb + HG_V + fo.o_trp + vcol + (16 * HG_LD) * 2, 8 * HG_LD * 2);
                __builtin_amdgcn_sched_barrier(0);
#pragma unroll
                for (int dt = 0; dt < 4; ++dt)
#pragma unroll
                    for (int sp = 0; sp < 2; ++sp) o = MFMA32(qp[2 * dt + sp], pack8(St[dt], sp), o);
#pragma unroll
                for (int i = 0; i < 16; ++i) s[i] = (crow(i, hh) <= r) ? s[i] : 0.f;
                o = MFMA32(pack8(s, 0), v0, o); o = MFMA32(pack8(s, 1), v1, o); }
#pragma unroll
            for (int i = 0; i < 16; ++i) *(LAS float*)(OBb + o_obw + ((i & 3) + 8 * (i >> 2)) * 144) = o[i];
            LDS_WAIT(); CFENCE();
            { const f32x4 x0 = *(const LAS f32x4*)(OBb + o_obr), x1 = *(const LAS f32x4*)(OBb + o_obr + 16), x2 = *(const LAS f32x4*)(OBb + o_obr + 32), x3 = *(const LAS f32x4*)(OBb + o_obr + 48);
                const int tau = lns >> 1; const int t = seg_t0 + 32 * ci + (g ? 31 - tau : tau);
                bf16* op = hx + (size_t)(rowbase + t) * D + h * 128 + 32 * j + 16 * (lns & 1);
                v4u w0, w1; w0.x = pk2(x0[0], x0[1]); w0.y = pk2(x0[2], x0[3]); w0.z = pk2(x1[0], x1[1]); w0.w = pk2(x1[2], x1[3]); w1.x = pk2(x2[0], x2[1]); w1.y = pk2(x2[2], x2[3]); w1.z = pk2(x3[0], x3[1]); w1.w = pk2(x3[2], x3[3]);
                *(GAS v4u*)op = w0; *(GAS v4u*)(op + 8) = w1; }
            LDS_WAIT(); CFENCE();
        }
        {   bf16x8 kt[8], vt[2];
#pragma unroll
            for (int sp = 0; sp < 2; ++sp) vt[sp] = ldstr2(gb + HG_V + fo.o_trn + vcol + (16 * sp * HG_LD) * 2, 4 * HG_LD * 2);
#pragma unroll
            for (int dt = 0; dt < 4; ++dt)
#pragma unroll
                for (int sp = 0; sp < 2; ++sp) kt[2 * dt + sp] = ldstr2(gb + HG_KH + fo.o_trn + (16 * sp * HG_LD + 32 * dt) * 2, 4 * HG_LD * 2);
            __builtin_amdgcn_sched_barrier(0);
#pragma unroll
            for (int dt = 0; dt < 4; ++dt)
#pragma unroll
                for (int sp = 0; sp < 2; ++sp) St[dt] = MFMA32(kt[2 * dt + sp], vt[sp], St[dt]); }
        ST_MARK(2);
        __syncthreads();
        ST_MARK(3);
    } }
    if (!g) __builtin_amdgcn_s_barrier();
    if (OUTPUT) item_headnorm(launder_v(tid_l), hx0, hx1, proj, NP_H, 4096, ghead + h * 128, aout, S0.rowbase, S0.t0, S0.nchunk * 32, h);
    ST_MARK(5);
    if (!OUTPUT) {
        float* e = g ? st_out1 : st_out0; float* ep = e + (4 * hh) * 128 + 32 * j + r;
#pragma unroll
        for (int dt = 0; dt < 4; ++dt)
#pragma unroll
            for (int i = 0; i < 16; ++i) ep[(32 * dt + (i & 3) + 8 * (i >> 2)) * 128] = St[dt][i];
        if ((lane >> 4) == 0) { e[16384 + 32 * j + 2 * (lane & 15)] = atot0; e[16384 + 32 * j + 2 * (lane & 15) + 1] = atot1; }
    }
}
#undef ST_MARK

constexpr int PH_PER_LAYER = 11, PH_BASE = 2, N_PHASES = PH_BASE + DEPTH * PH_PER_LAYER;
#ifndef EN_GEMM
#define EN_GEMM 0xff
#endif
#ifndef EN_ML
#define EN_ML 3
#endif
#ifndef EN_HG
#define EN_HG 3
#endif
#ifndef EN_TOK
#define EN_TOK 1
#endif
#ifndef EN_MISC
#define EN_MISC 1
#endif
#ifndef PG_SP2
#define PG_SP2 true
#endif
#ifndef PG_ALIGN
#define PG_ALIGN true
#endif
#ifndef TIMER_MASK
#define TIMER_MASK 0ull
#endif
#ifndef TIMER_DIV
#define TIMER_DIV 20.0f
#endif
#ifndef MK_SPLIT
#define MK_SPLIT 0
#endif


__device__ __forceinline__ void phase_headnorm(Frame& F, const bf16* hf, const bf16* hb, const bf16* gate, int gpitch, int gcol0, const float* ghead, bf16* aout, int nrows) {
    const int tid = launder_v(F.tid); const int lane = tid & 63, wave = __builtin_amdgcn_readfirstlane(tid >> 6);
    const int gw = F.bid * NWAVES + wave, NGW = F.G * NWAVES;
    float gh[16];
#pragma unroll
    for (int e = 0; e < 16; ++e) gh[e] = ghead[lane * 16 + e];
    for (int row = gw; row < nrows; row += NGW) {
        const v4u a0 = *(const v4u*)(hf + (size_t)row * D + lane * 16), a1 = *(const v4u*)(hf + (size_t)row * D + lane * 16 + 8);
        const v4u b0 = *(const v4u*)(hb + (size_t)row * D + lane * 16), b1 = *(const v4u*)(hb + (size_t)row * D + lane * 16 + 8);
        const v4u g0 = *(const v4u*)(gate + (size_t)row * gpitch + gcol0 + lane * 16), g1 = *(const v4u*)(gate + (size_t)row * gpitch + gcol0 + lane * 16 + 8);
        float x[16], y[8], o[16]; unpack8(a0, y);
#pragma unroll
        for (int e = 0; e < 8; ++e) x[e] = y[e];
        unpack8(a1, y);
#pragma unroll
        for (int e = 0; e < 8; ++e) x[8 + e] = y[e];
        unpack8(b0, y);
#pragma unroll
        for (int e = 0; e < 8; ++e) x[e] += y[e];
        unpack8(b1, y);
#pragma unroll
        for (int e = 0; e < 8; ++e) x[8 + e] += y[e];
        float ss = 0.f;
#pragma unroll
        for (int e = 0; e < 16; ++e) ss += x[e] * x[e];
        ss += __shfl_xor(ss, 1); ss += __shfl_xor(ss, 2); ss += __shfl_xor(ss, 4);
        const float rs = rsqrtf(ss * (1.f / 128.f) + EPS);
        unpack8(g0, y);
#pragma unroll
        for (int e = 0; e < 8; ++e) o[e] = x[e] * rs * gh[e] * sigmoidf_(y[e]);
        unpack8(g1, y);
#pragma unroll
        for (int e = 0; e < 8; ++e) o[8 + e] = x[8 + e] * rs * gh[8 + e] * sigmoidf_(y[e]);
        v4u w0, w1; w0.x = pk2(o[0], o[1]); w0.y = pk2(o[2], o[3]); w0.z = pk2(o[4], o[5]); w0.w = pk2(o[6], o[7]); w1.x = pk2(o[8], o[9]); w1.y = pk2(o[10], o[11]); w1.z = pk2(o[12], o[13]); w1.w = pk2(o[14], o[15]);
        *(v4u*)(aout + (size_t)row * D + lane * 16) = w0; *(v4u*)(aout + (size_t)row * D + lane * 16 + 8) = w1;
    }
}

__device__ __forceinline__ void phase_conv(Frame& F, const bf16* proj, bf16* qkc, float* gates, const float* wconv, const float* bgate) {
    const int gt = F.bid * NTHR + F.tid, cp = gt & 127;
    const int rpb = (M_ALL + F.G - 1) / F.G, rlo = F.bid * rpb, rhi = min(M_ALL, rlo + rpb);
    float w[3][8];
#pragma unroll
    for (int d = 0; d < 3; ++d)
#pragma unroll
        for (int e = 0; e < 8; ++e) w[d][e] = wconv[d * 1024 + cp * 8 + e];
    const float sc = cp >= 64 ? 0.125f : 1.0f;
#pragma unroll 3
    for (int row = rlo + (F.tid >> 7); row < rhi; row += NTHR >> 7) {
        int t, len; if (row < M_LAT) { t = row & (SEQ - 1); len = SEQ; } else { t = (row - M_LAT) & (CTXL - 1); len = CTXL; }
        const bf16* rp = proj + (size_t)row * NP_M + cp * 8;
        const v4u z = (v4u){0u, 0u, 0u, 0u};
        const v4u r0 = t > 0 ? *(const v4u*)(rp - NP_M) : z, r1 = *(const v4u*)rp, r2 = t + 1 < len ? *(const v4u*)(rp + NP_M) : z;
        float x0[8], x1[8], x2[8], o[8]; unpack8(r0, x0); unpack8(r1, x1); unpack8(r2, x2);
#pragma unroll
        for (int e = 0; e < 8; ++e) o[e] = sc * siluf_(w[0][e] * x0[e] + w[1][e] * x1[e] + w[2][e] * x2[e]);
        v4u q; q.x = pk2(o[0], o[1]); q.y = pk2(o[2], o[3]); q.z = pk2(o[4], o[5]); q.w = pk2(o[6], o[7]);
        *(v4u*)(qkc + (size_t)row * D + cp * 8) = q;
    }
    {   const int c4 = (gt * 4) & 31; const f32x4 bg = *(const f32x4*)(bgate + c4); const bool lsg = ((c4 >> 3) & 1) != 0;
#pragma unroll 4
        for (int i = gt; i < M_ALL * 8; i += F.G * NTHR) { f32x4 x = *(const GAS f32x4*)(gates + (size_t)i * 4) + bg;
            if (lsg) {
#pragma unroll
                for (int e = 0; e < 4; ++e) x[e] = fminf(x[e], 0.f) - __logf(1.f + __expf(-fabsf(x[e]))); }
            *(GAS f32x4*)(gates + (size_t)i * 4) = x; } }
}

__device__ __forceinline__ void timer_stamp(unsigned char* lds_raw, bool add) {
    if (threadIdx.x == 0) { volatile LAS unsigned* tw = (volatile LAS unsigned*)((LAS unsigned char*)lds_raw + LDSCTL_OFF) + 32;
        const unsigned long long t = wall_clock64(); const unsigned long long last = ((unsigned long long)tw[1] << 32) | tw[0];
        if (add) { unsigned long long acc = ((unsigned long long)tw[3] << 32) | tw[2]; acc += t - last; tw[2] = (unsigned)acc; tw[3] = (unsigned)(acc >> 32); }
        tw[0] = (unsigned)t; tw[1] = (unsigned)(t >> 32); }
}

__device__ __forceinline__ void seg_of(bool odd, bool ctx_out, int q, int& t0, int& len) {
    int a, b; if (!ctx_out) { a = 2048; b = 2048; } else if (!odd) { a = 30 * 64; b = 34 * 64; } else { a = 60 * 32; b = 68 * 32; }
    t0 = (q == 0) ? 0 : (q == 1) ? a : (q == 2) ? a + b : a + 2 * b; len = (q == 0 || q == 3) ? a : b;
}

__device__ __forceinline__ Frame mkframe(const Args& args, unsigned char* lds_raw) {
    Frame F; int t = threadIdx.x; asm volatile("" : "+v"(t));
    F.lds = (LAS unsigned char*)lds_raw; F.tid = t; F.lane = t & 63; F.wave = __builtin_amdgcn_readfirstlane(t >> 6);
    int g = gridDim.x, b = blockIdx.x; asm volatile("" : "+s"(g), "+s"(b)); F.G = g; F.bid = b;
    const __attribute__((address_space(4))) Args* ap = (const __attribute__((address_space(4))) Args*)__builtin_amdgcn_kernarg_segment_ptr(); asm volatile("" : "+s"(ap));
    F.ws = ap->ws; F.in = ap->in; F.out = ap->out;
    return F;
}
#define PHASE_LOCALS \
    Frame F = mkframe(args, lds_raw); unsigned char* ws = F.ws; \
    float* modv = (float*)(ws + WS_MODV); bf16* U = (bf16*)(ws + WS_U); bf16* Y = (bf16*)(ws + WS_Y); bf16* PROJ = (bf16*)(ws + WS_ACT); bf16* HB = (bf16*)(ws + WS_ACT); \
    bf16* AMOE = (bf16*)(ws + WS_ACT); bf16* HMOE = (bf16*)(ws + WS_ACT + (size_t)MOE_ROWS * D * 2); \
    float* GATES = (float*)(ws + WS_GATES); float* LATC = (float*)(ws + WS_LATC); float* STATE = (float*)(ws + WS_STATE); \
    const int* pexp = (const int*)(ws + WS_SMALL + SM_PEXP); float* SA_U = (float*)(ws + WS_SMALL + SM_SAU); float* SA_U2 = (float*)(ws + WS_SMALL + SM_SAU2); float* SA_MOE = (float*)(ws + WS_GATES + GATES_SAMOE); \
    const float* SWL = (const float*)(ws + WS_SMALL + (odd ? SM_SWO : SM_SWE)); (void)SA_U; (void)SA_U2; (void)SA_MOE; (void)SWL; \
    unsigned char* wb = ws + (odd ? WS_WO : WS_WE); const float* mv = modv + (size_t)L * 9 * 6 * 1024; \
    (void)modv; (void)U; (void)Y; (void)PROJ; (void)HB; (void)AMOE; (void)HMOE; (void)GATES; (void)LATC; (void)STATE; (void)pexp; (void)wb; (void)mv;

__global__ void __launch_bounds__(NTHR, 2) fwd(Args args) {
    extern __shared__ __attribute__((aligned(16))) unsigned char lds_raw[];
    Frame F = mkframe(args, lds_raw);
    volatile LAS unsigned* LCTL = (volatile LAS unsigned*)(F.lds + LDSCTL_OFF);
    for (int u = F.tid; u < 128; u += NTHR) LCTL[u] = 0u;
    __syncthreads();
    XcdBarrier bar; bar.bar = (unsigned*)(F.ws + WS_CTL) + CW_BAR; bar.x = 0; bar.st = nullptr;
    if (args.use_bar) bar = xcd_barrier_post((unsigned*)(F.ws + WS_CTL) + CW_BAR, LCTL + 8);
    const int lo = args.ph_lo, hi = args.ph_hi;
#define IN(k) (lo <= (k) && (k) < hi)
#define SEAM(k) do { if ((k) + 1 < hi) xcd_barrier(bar.bar, bar.x, bar.st); if (TIMER_MASK != 0ull) timer_stamp(lds_raw, ((TIMER_MASK >> (k)) & 1ull) != 0ull); } while (0)
#ifdef TIMER_SPAN
    if (threadIdx.x == 0) { unsigned long long* dbg = (unsigned long long*)((unsigned*)(F.ws + WS_CTL) + CW_DBG); atomicMax(dbg, ~wall_clock64()); }
#endif
#ifdef SPIN_START
    { const unsigned long long t0 = wall_clock64(); while (wall_clock64() - t0 < (unsigned long long)(SPIN_START)) __builtin_amdgcn_s_sleep(8); }
#endif
    if (TIMER_MASK != 0ull) timer_stamp(lds_raw, false);
#ifdef EXTRA_BARS
    for (int eb = 0; eb < EXTRA_BARS; ++eb) xcd_barrier(bar.bar, bar.x, bar.st);
#endif
    if (IN(0)) { const int L = 0; const bool odd = false; PHASE_LOCALS if (EN_MISC) phase_mods(F); __syncthreads(); if (EN_MISC) phase_colmax(F); xcd_barrier(bar.bar, bar.x, bar.st); if (EN_MISC) phase_wconv(F, 0); SEAM(0); }
    if (IN(1)) { const int L = 0; const bool odd = false; PHASE_LOCALS
        TokCfg T{}; T.lat_src_l = F.in[I_X]; T.lat_src_c = F.in[I_CTX]; T.src_f32 = 1; T.vna = modv + 0 * 1024; T.vnb = modv + 1 * 1024; T.u = U; T.u_fp8 = INPROJ_I8 ? 2 : 0; T.u_scale = SA_U; T.nrows = M_ALL;
        if (EN_TOK) phase_tok(F, T); __syncthreads(); if (EN_MISC) phase_wconv(F, 1); SEAM(1);
    }
    for (int L = 0; L < DEPTH; ++L) {
        const int pb = PH_BASE + L * PH_PER_LAYER; const bool odd = (L & 1) != 0; const int jl = L >> 1;
        const bool ctx_out = L < DEPTH - 1;
        if (IN(pb + 0)) { PHASE_LOCALS
            pg8::Order S; pg8::Gemm g;
#if INPROJ_I8
            if (!odd) { g = pg8::Gemm{U, (const bf16*)(wb + WE_IN), M_ALL, NIN_M, D}; S.init(M_ALL / 256, NIN_M, F.G, F.bid, nullptr, 0);
                pg8::EpiStoreI8 E{PROJ, NP_M, NP_M / 256, NP_M / 256, GATES, SA_U, SWL + SWE_IN}; if (EN_GEMM & (1 << 0)) pg8::gemm_phase<pg8::EpiStoreI8, pg8::Order, PG_ALIGN, PG_SP2, 2>(F.lds, g, S, E); }
            else { g = pg8::Gemm{U, (const bf16*)(wb + WOD_IN), M_ALL, NP_H, D}; S.init(M_ALL / 256, NP_H, F.G, F.bid, nullptr, 0);
                pg8::EpiStoreI8 E{PROJ, NP_H, NP_H / 256, -1, nullptr, SA_U, SWL + SWO_IN}; if (EN_GEMM & (1 << 1)) pg8::gemm_phase<pg8::EpiStoreI8, pg8::Order, PG_ALIGN, PG_SP2, 2>(F.lds, g, S, E); }
#else
            if (!odd) { g = pg8::Gemm{U, (const bf16*)(wb + WE_IN), M_ALL, NIN_M, D}; S.init(M_ALL / 256, NIN_M, F.G, F.bid, nullptr, 0);
                pg8::EpiStore E{PROJ, NP_M, NP_M / 256, NP_M / 256, GATES, 1.0f}; if (EN_GEMM & (1 << 0)) pg8::gemm_phase<pg8::EpiStore, pg8::Order, PG_ALIGN, PG_SP2>(F.lds, g, S, E); }
            else { g = pg8::Gemm{U, (const bf16*)(wb + WOD_IN), M_ALL, NP_H, D}; S.init(M_ALL / 256, NP_H, F.G, F.bid, nullptr, 0);
                pg8::EpiStore E{PROJ, NP_H, NP_H / 256, -1, nullptr, 1.0f}; if (EN_GEMM & (1 << 1)) pg8::gemm_phase<pg8::EpiStore, pg8::Order, PG_ALIGN, PG_SP2>(F.lds, g, S, E); }
#endif
            SEAM(pb + 0);
        }
        if (IN(pb + 1)) {
            if (!odd) { PHASE_LOCALS
                phase_conv(F, PROJ, (bf16*)(ws + WS_ACT + 400 * MiB), GATES, F.in[I_MWCONV] + (size_t)jl * 3 * 1024, F.in[I_MBGATE] + jl * 32); SEAM(pb + 1); }
        }
        if (IN(pb + 2)) { PHASE_LOCALS
            for (int id = F.bid; id < 256; id += F.G) {
                const int bh = id >> 2, p = id & 3, b = bh >> 3, h = bh & 7;
                MlSeg SG0, SG1;
                const int csz = odd ? 32 : 64;
                if (p == 0) { SG0 = MlSeg{M_LAT + b * CTXL, CTXL, 0, CTXL / csz}; SG1 = SG0; }
                else { int t0a, la, t0b, lb2; seg_of(odd, ctx_out, p - 1, t0a, la); seg_of(odd, ctx_out, 4 - p, t0b, lb2); SG0 = MlSeg{b * SEQ, SEQ, t0a, la / csz}; SG1 = MlSeg{b * SEQ, SEQ, t0b, lb2 / csz}; }
                if (!odd) { float* e0 = STATE + (size_t)((bh * 2 + 0) * 4 + p) * ML_STATE_F; float* e1 = STATE + (size_t)((bh * 2 + 1) * 4 + p) * ML_STATE_F;
                    if (EN_ML & 1) mlstm_s1_item(F, PROJ, (const bf16*)(ws + WS_ACT + 400 * MiB), GATES, h, SG0, SG1, e0, e1); }
                else { float* e0 = STATE + (size_t)((bh * 2 + 0) * 4 + p) * HG_STATE_F; float* e1 = STATE + (size_t)((bh * 2 + 1) * 4 + p) * HG_STATE_F;
                    if (EN_HG & 1) hgrn_item<false>(F, PROJ, U, (bf16*)(ws + WS_Y), U, F.in[I_HGHEAD] + jl * 1024, F.in[I_HBF] + (size_t)jl * 2048, F.in[I_HLB], jl, h, SG0, SG1, nullptr, nullptr, 0, 0, e0, e1); }
            }
            SEAM(pb + 2);
        }
        if (IN(pb + 3)) { PHASE_LOCALS
            const int nitems = ctx_out ? 320 : 256;
            for (int id = F.bid; id < nitems; id += F.G) {
                MlSeg SG0, SG1; int bh, npre0 = 0, npre1 = 0; const int csz = odd ? 32 : 64;
                if (id < 256) { int q; if (id < 128) { bh = id >> 1; q = (id & 1) ? 3 : 0; } else { bh = (id - 128) >> 1; q = 1 + (id & 1); } int t0q, lq; seg_of(odd, ctx_out, q, t0q, lq); SG0 = MlSeg{(bh >> 3) * SEQ, SEQ, t0q, lq / csz}; npre0 = q + 1; npre1 = 4 - q; }
                else { bh = id - 256; SG0 = MlSeg{M_LAT + (bh >> 3) * CTXL, CTXL, 0, CTXL / csz}; }
                SG1 = SG0;
                const int h = bh & 7;
                if (!odd) { const float* s0 = STATE + (size_t)((bh * 2 + 0) * 4) * ML_STATE_F; const float* s1 = STATE + (size_t)((bh * 2 + 1) * 4) * ML_STATE_F;
                    if (EN_ML & 2) mlstm_item<true>(F, PROJ, (const bf16*)(ws + WS_ACT + 400 * MiB), GATES, (bf16*)(ws + WS_ACT + 536 * MiB), (bf16*)(ws + WS_Y), U, F.in[I_MGHEAD] + jl * 1024, h, SG0, SG1, s0, s1, npre0, npre1, nullptr, nullptr); }
                else { const float* s0 = STATE + (size_t)((bh * 2 + 0) * 4) * HG_STATE_F; const float* s1 = STATE + (size_t)((bh * 2 + 1) * 4) * HG_STATE_F;
                    if (EN_HG & 2) hgrn_item<true>(F, PROJ, U, (bf16*)(ws + WS_Y), U, F.in[I_HGHEAD] + jl * 1024, F.in[I_HBF] + (size_t)jl * 2048, F.in[I_HLB], jl, h, SG0, SG1, s0, s1, npre0, npre1, nullptr, nullptr); }
            }
            SEAM(pb + 3);
        }
        if (IN(pb + 5)) { PHASE_LOCALS
            const int nM = (ctx_out ? M_ALL : M_LAT) / 256;
            pg8::Gemm g{U, (const bf16*)(wb + (odd ? WOD_OUT : WE_OUT)), nM * 256, D, D}; pg8::Order S; S.init(nM, D, F.G, F.bid, nullptr, 0);
            pg8::EpiStore E{Y, D, D / 256, -1, nullptr, 1.0f}; if (EN_GEMM & (1 << 2)) pg8::gemm_phase<pg8::EpiStore, pg8::Order, PG_ALIGN, PG_SP2>(F.lds, g, S, E);
            SEAM(pb + 5);
        }
        if (IN(pb + 6)) { PHASE_LOCALS
            TokCfg T{}; bf16* LAT16 = (bf16*)(ws + WS_ACT + 836 * MiB); T.src_f32 = (L == 0) ? 1 : 0; T.lat_src_l = (L == 0) ? (const void*)F.in[I_X] : (const void*)LAT16; T.lat_src_c = (L == 0) ? (const void*)F.in[I_CTX] : (const void*)LATC; T.lat_dst_l = LAT16; T.lat_dst_c = LATC;
            T.y = Y; T.y_perm = odd ? 1 : 0; T.vupd = mv + 2 * 1024; T.vna = mv + 3 * 1024; T.vnb = mv + 4 * 1024; T.u = U; T.u_fp8 = ((UP_I8 && !odd) || (UP_I8_MOE && odd)) ? 2 : FFN_FP8_L(L); T.u_scale = SA_U2; T.route = odd ? 1 : 0; T.jr = jl; T.nrows = ctx_out ? M_ALL : M_LAT;
            if (EN_TOK) phase_tok(F, T);
            if (L >= 1 && L + 1 < DEPTH) { __syncthreads(); if (EN_MISC) phase_wconv(F, L + 1); }
            SEAM(pb + 6);
        }
        if (IN(pb + 7)) { PHASE_LOCALS
            if (odd) { if (EN_MISC) phase_moe_scatter(F, jl, ctx_out ? M_ALL : M_LAT, (const unsigned char*)U, (unsigned char*)AMOE, (UP_I8_MOE || FFN_FP8_L(L)) ? 1024 : 2048, UP_I8_MOE ? SA_U2 : nullptr, SA_MOE); SEAM(pb + 7); }
        }
        if (IN(pb + 8)) { PHASE_LOCALS
            if (!odd) { pg8::Gemm g{U, (const bf16*)(wb + WE_GU), M_ALL, NGU, D}; pg8::Order S; S.init(M_ALL / 256, NGU, F.G, F.bid, nullptr, 0);
#if UP_I8
                pg8::EpiSwiGLU8I E{(unsigned char*)HB, FF, SA_U2, SWL + SWE_GU, nullptr, 0, FFN_FP8_L(L) ? 0 : 1}; if (EN_GEMM & (1 << 3)) pg8::gemm_phase<pg8::EpiSwiGLU8I, pg8::Order, PG_ALIGN, PG_SP2, 2>(F.lds, g, S, E);
#else
                pg8::EpiSwiGLU8 E{(unsigned char*)HB, FF, 1.0f / WSCALE8}; if (EN_GEMM & (1 << 3)) pg8::gemm_phase<pg8::EpiSwiGLU8, pg8::Order, PG_ALIGN, PG_SP2, 1>(F.lds, g, S, E);
#endif
            }
            else { const int np = __builtin_amdgcn_readfirstlane(pexp[MOE_PANELS]);
                pg8::Gemm g{AMOE, (const bf16*)(wb + WOD_GU), np * 256, NGU, D}; pg8::Order S; S.init(np, NGU, F.G, F.bid, pexp, EGU_BYTES);
#if UP_I8_MOE
                pg8::EpiSwiGLU8I E{(unsigned char*)HMOE, FF, SA_MOE, SWL + SWO_GU, pexp, NGU, 0}; if (EN_GEMM & (1 << 4)) pg8::gemm_phase<pg8::EpiSwiGLU8I, pg8::Order, PG_ALIGN, PG_SP2, 2>(F.lds, g, S, E); }
#else
                pg8::EpiSwiGLU8 E{(unsigned char*)HMOE, FF, 1.0f / WSCALE8}; if (EN_GEMM & (1 << 4)) pg8::gemm_phase<pg8::EpiSwiGLU8, pg8::Order, PG_ALIGN, PG_SP2, 1>(F.lds, g, S, E); }
#endif
            SEAM(pb + 8);
        }
        if (IN(pb + 9)) { PHASE_LOCALS
            const bool f8 = FFN_FP8_L(L) != 0;
            if (!odd) { pg8::Gemm g{HB, (const bf16*)(wb + WE_DOWN), M_ALL, D, FF}; pg8::Order S; S.init(M_ALL / 256, D, F.G, F.bid, nullptr, 0);
                if (f8) { if ((FP8_LAYERS) & 0x5) { pg8::EpiStore E{Y, D, D / 256, -1, nullptr, 1.0f / WSCALE8}; if (EN_GEMM & (1 << 5)) pg8::gemm_phase<pg8::EpiStore, pg8::Order, PG_ALIGN, PG_SP2, 1>(F.lds, g, S, E); } }
                else { if ((~(FP8_LAYERS)) & 0x5) { pg8::EpiStore E{Y, D, D / 256, -1, nullptr, 1.0f}; if (EN_GEMM & (1 << 5)) pg8::gemm_phase<pg8::EpiStore, pg8::Order, PG_ALIGN, PG_SP2>(F.lds, g, S, E); } } }
            else { const int np = __builtin_amdgcn_readfirstlane(pexp[MOE_PANELS]);
                pg8::Gemm g{HMOE, (const bf16*)(wb + WOD_DOWN), np * 256, D, FF}; pg8::Order S; S.init(np, D, F.G, F.bid, pexp, EDOWN_BYTES);
                if (f8) { if ((FP8_LAYERS) & 0xA) { pg8::EpiStore E{AMOE, D, D / 256, -1, nullptr, 1.0f / WSCALE8}; if (EN_GEMM & (1 << 6)) pg8::gemm_phase<pg8::EpiStore, pg8::Order, PG_ALIGN, PG_SP2, 1>(F.lds, g, S, E); } }
                else { if ((~(FP8_LAYERS)) & 0xA) { pg8::EpiStore E{AMOE, D, D / 256, -1, nullptr, 1.0f}; if (EN_GEMM & (1 << 6)) pg8::gemm_phase<pg8::EpiStore, pg8::Order, PG_ALIGN, PG_SP2>(F.lds, g, S, E); } } }
            SEAM(pb + 9);
        }
        if (IN(pb + 10)) { PHASE_LOCALS
            TokCfg T{}; bf16* LAT16 = (bf16*)(ws + WS_ACT + 836 * MiB); T.lat_src_l = LAT16; T.lat_src_c = LATC; T.lat_dst_l = (L + 1 < DEPTH) ? (void*)LAT16 : (void*)F.out; T.lat_dst_c = LATC; T.dst_f32 = (L + 1 < DEPTH) ? 0 : 1;
            T.y = odd ? AMOE : Y; T.moe_combine = odd ? 1 : 0; T.vupd = mv + 5 * 1024; T.nrows = ctx_out ? M_ALL : M_LAT;
            if (L + 1 < DEPTH) { const float* mn = modv + (size_t)(L + 1) * 9 * 6 * 1024; T.vna = mn; T.vnb = mn + 1024; T.u = U; T.u_perm = ((L + 1) & 1) ? 1 : 0; T.u_fp8 = INPROJ_I8 ? 2 : 0; T.u_scale = SA_U; }
            if (EN_TOK) phase_tok(F, T);
            SEAM(pb + 10);
        }
    }
    if (TIMER_MASK != 0ull) { timer_stamp(lds_raw, ((TIMER_MASK >> (N_PHASES - 1)) & 1ull) != 0ull);
        if (blockIdx.x == 0 && threadIdx.x == 0) { volatile LAS unsigned* tw = (volatile LAS unsigned*)((LAS unsigned char*)lds_raw + LDSCTL_OFF) + 32; const unsigned long long acc = ((unsigned long long)tw[3] << 32) | tw[2];
            asm volatile("s_waitcnt vmcnt(0)" ::: "memory"); args.out[0] = (float)acc * 0.01f / TIMER_DIV; } }
#ifdef SUBT
    __syncthreads();
    if (blockIdx.x == 0 && threadIdx.x == 0) { volatile LAS unsigned* tw = (volatile LAS unsigned*)((LAS unsigned char*)lds_raw + LDSCTL_OFF) + 40; asm volatile("s_waitcnt vmcnt(0)" ::: "memory"); args.out[0] = (float)tw[SUBT] * 0.01f / SUBT_DIV; }
#endif
#ifdef TIMER_SPAN
    __syncthreads();
    if (threadIdx.x == 0) { unsigned long long* dbg = (unsigned long long*)((unsigned*)(args.ws + WS_CTL) + CW_DBG);
        asm volatile("s_waitcnt vmcnt(0)" ::: "memory"); __threadfence();
        if (blockIdx.x != 0) { atomicMax(dbg + 1, wall_clock64()); __threadfence(); atomicAdd(dbg + 2, 1ull); }
        else { while (atomicAdd(dbg + 2, 0ull) < (unsigned long long)(gridDim.x - 1)) __builtin_amdgcn_s_sleep(4);
            unsigned long long te = atomicMax(dbg + 1, 0ull); const unsigned long long tn = wall_clock64(); if (tn > te) te = tn; const unsigned long long ts = ~atomicMax(dbg, 0ull);
            args.out[0] = (float)(te - ts) * 0.01f / TIMER_SPAN; } }
#endif
#ifdef SPIN_TICKS
    { const unsigned long long t0 = wall_clock64(); while (wall_clock64() - t0 < (unsigned long long)(SPIN_TICKS)) __builtin_amdgcn_s_sleep(8); }
#endif
#undef IN
#undef SEAM
}

extern "C" void kernel_launch(void* const* d_in, const int* in_sizes, int n_in, void* d_out, int out_size, void* d_ws, size_t ws_size, hipStream_t stream) {
    static int grid = 0;
    if (grid == 0) {
        if (n_in != 23 || out_size != M_LAT * D || ws_size < WS_END) { fprintf(stderr, "kernel_launch: unexpected shapes / workspace (n_in %d out %d ws %zu need %zu)\n", n_in, out_size, ws_size, (size_t)WS_END); grid = -1; return; }
        int dev = 0, cus = 0, per_cu = 0;
        if (hipGetDevice(&dev) != hipSuccess || hipDeviceGetAttribute(&cus, hipDeviceAttributeMultiprocessorCount, dev) != hipSuccess) { grid = -1; return; }
        if (hipFuncSetAttribute((const void*)fwd, hipFuncAttributeMaxDynamicSharedMemorySize, LDS_BYTES) != hipSuccess) { fprintf(stderr, "kernel_launch: hipFuncSetAttribute failed\n"); grid = -1; return; }
        if (hipOccupancyMaxActiveBlocksPerMultiprocessor(&per_cu, (const void*)fwd, NTHR, LDS_BYTES) != hipSuccess || per_cu < 1) fprintf(stderr, "kernel_launch: occupancy query reports %d\n", per_cu);
        (void)hipGetLastError();
        grid = cus;
    }
    if (grid < 0) return;
    (void)hipMemsetAsync((char*)d_ws + WS_CTL, 0, CTL_ZERO_BYTES, stream);
    Args a{};
    for (int i = 0; i < 23; ++i) a.in[i] = (const float*)d_in[i];
    a.out = (float*)d_out; a.ws = (unsigned char*)d_ws;
#if MK_SPLIT
    for (int p = 0; p < N_PHASES; ++p) { a.ph_lo = p; a.ph_hi = p + 1; a.use_bar = 0; a.pad = 0; hipLaunchKernelGGL(fwd, dim3(grid), dim3(NTHR), LDS_BYTES, stream, a); }
#else
    a.ph_lo = 0; a.ph_hi = N_PHASES; a.use_bar = 1; a.pad = 0;
    hipLaunchKernelGGL(fwd, dim3(grid), dim3(NTHR), LDS_BYTES, stream, a);
#endif
}
```

```cpp
#include <hip/hip_runtime.h>
#include <cstdio>
#include <cstdint>

namespace pg8 {
#define PG8_LAS __attribute__((address_space(3)))
typedef unsigned short bf16_t;
typedef short bf16x8 __attribute__((ext_vector_type(8)));
typedef float f32x4 __attribute__((ext_vector_type(4)));
typedef unsigned u32x4 __attribute__((ext_vector_type(4)));
typedef unsigned u32x2 __attribute__((ext_vector_type(2)));
typedef int v8i_t __attribute__((ext_vector_type(8)));
typedef int v4i_t __attribute__((ext_vector_type(4)));
constexpr int BM = 256, BK = 64, HALF = 128, HTB = HALF * BK * 2  , STAGE_BYTES = 8 * HTB, NXCD = 8, WGM = 8;

__host__ __device__ __forceinline__ int lds_byte(int r, int c) { const int st = (r >> 4) * 2 + (c >> 5), rr = r & 15, cc = c & 31, ob = rr * 64 + cc * 2; return st * 1024 + (ob ^ (((ob >> 9) & 1) << 5)); }
__host__ __device__ __forceinline__ void stage_rc(int b, int& R, int& C) { const int st = b / 1024, sb = b % 1024, swz = sb ^ (((sb >> 9) & 1) << 5); R = (st >> 1) * 16 + swz / 64; C = (st & 1) * 32 + (swz % 64) / 2; }
__host__ __device__ __forceinline__ int perm32(int rho) { const int n = rho >> 4, i = rho & 15; return 8 * (i >> 2) + 4 * n + (i & 3); }

struct Unit { int pm, pn; };
struct Gemm { const bf16_t* A; const bf16_t* Bt; int M, N, K; };

struct Order {
    int nM, nN, nwg, G, c; const int* pexp; size_t bstride;
    __device__ void init(int nM_, int N, int G_, int c_, const int* pexp_, size_t bstride_) { nM = nM_; nN = N / BM; nwg = nM * nN; G = G_; c = c_; pexp = pexp_; bstride = bstride_; }
    __device__ bool next(int i, Unit& u) const {
        const long L = (long)i * G + c; if (L >= nwg) return false;
        int wgid = (int)L; { const int q = nwg / NXCD, r = nwg % NXCD, xcd = wgid % NXCD, off = wgid / NXCD; wgid = (xcd < r ? xcd * (q + 1) : r * (q + 1) + (xcd - r) * q) + off; }
        const int nig = WGM * nN, gid = wgid / nig, fm = gid * WGM, gsz = (nM - fm) < WGM ? (nM - fm) : WGM;
        u.pm = fm + ((wgid % nig) % gsz); u.pn = (wgid % nig) / gsz; return true;
    }
    __device__ __forceinline__ size_t boff(const Unit& u) const { return pexp ? (size_t)__builtin_amdgcn_readfirstlane(pexp[u.pm]) * bstride : (size_t)0; }
    __device__ __forceinline__ void a_ready(const Unit&) const {}
    __device__ __forceinline__ void done(const Unit&) const {}
};

__device__ __forceinline__ unsigned cvt_pk_bf16(float lo, float hi) { unsigned r; asm volatile("v_cvt_pk_bf16_f32 %0, %1, %2" : "=v"(r) : "v"(lo), "v"(hi)); return r; }

struct EpiStore {
    static constexpr bool PERM = true, AFTER_DRAIN = false;
    bf16_t* O; int ldc; int ncol_tiles; int gate_pn; float* gates; float oscale;
    __device__ __forceinline__ void operator()(const f32x4 (&acc)[2][2][4][2], const Unit& u, int wr, int wc, int fr, int fq) const {
        const int row0 = u.pm * BM + wr * 64 + fr;
        if (u.pn < ncol_tiles) {
            const int col0 = u.pn * BM + wc * 32 + 8 * fq;
#pragma unroll
            for (int ai = 0; ai < 2; ++ai)
#pragma unroll
                for (int m = 0; m < 4; ++m) { bf16_t* rowp = O + (size_t)(row0 + ai * HALF + m * 16) * ldc + col0;
#pragma unroll
                    for (int bj = 0; bj < 2; ++bj) { const f32x4 v0 = acc[ai][bj][m][0] * oscale, v1 = acc[ai][bj][m][1] * oscale;
                        u32x4 w; w.x = cvt_pk_bf16(v0[0], v0[1]); w.y = cvt_pk_bf16(v0[2], v0[3]); w.z = cvt_pk_bf16(v1[0], v1[1]); w.w = cvt_pk_bf16(v1[2], v1[3]);
                        *(u32x4*)(rowp + bj * HALF) = w; } }
        } else if (u.pn == gate_pn && wc == 0) {
#pragma unroll
            for (int ai = 0; ai < 2; ++ai)
#pragma unroll
                for (int m = 0; m < 4; ++m) { float* rowp = gates + (size_t)(row0 + ai * HALF + m * 16) * 32 + 8 * fq;
                    *(f32x4*)(rowp) = acc[ai][0][m][0]; *(f32x4*)(rowp + 4) = acc[ai][0][m][1]; }
        }
    }
};
struct EpiSwiGLU {
    static constexpr bool PERM = true, AFTER_DRAIN = false;
    bf16_t* O; int ldc;
    __device__ __forceinline__ void operator()(const f32x4 (&acc)[2][2][4][2], const Unit& u, int wr, int wc, int fr, int fq) const {
        const int row0 = u.pm * BM + wr * 64 + fr, col0 = u.pn * HALF + wc * 32 + 8 * fq;
#pragma unroll
        for (int ai = 0; ai < 2; ++ai)
#pragma unroll
            for (int m = 0; m < 4; ++m) { bf16_t* rowp = O + (size_t)(row0 + ai * HALF + m * 16) * ldc + col0; float r[8];
#pragma unroll
                for (int n = 0; n < 2; ++n)
#pragma unroll
                    for (int j = 0; j < 4; ++j) { const float g = acc[ai][0][m][n][j], up = acc[ai][1][m][n][j]; r[n * 4 + j] = g * __builtin_amdgcn_rcpf(1.0f + __expf(-g)) * up; }
                u32x4 w; w.x = cvt_pk_bf16(r[0], r[1]); w.y = cvt_pk_bf16(r[2], r[3]); w.z = cvt_pk_bf16(r[4], r[5]); w.w = cvt_pk_bf16(r[6], r[7]);
                *(u32x4*)(rowp) = w; }
    }
};
struct EpiSwiGLU8 {
    static constexpr bool PERM = true, AFTER_DRAIN = false;
    unsigned char* O; int ldc; float ascale;
    __device__ __forceinline__ void operator()(const f32x4 (&acc)[2][2][4][2], const Unit& u, int wr, int wc, int fr, int fq) const {
        typedef float f32x2 __attribute__((ext_vector_type(2)));
        const int row0 = u.pm * BM + wr * 64 + fr, col0 = u.pn * HALF + wc * 32 + 8 * fq;
        const float c1 = -ascale * 1.4426950408889634f, c2 = ascale * ascale;
#pragma unroll
        for (int ai = 0; ai < 2; ++ai)
#pragma unroll
            for (int m = 0; m < 4; ++m) { unsigned char* rowp = O + (size_t)(row0 + ai * HALF + m * 16) * ldc + col0; f32x2 r[4];
#pragma unroll
                for (int n = 0; n < 2; ++n)
#pragma unroll
                    for (int j = 0; j < 2; ++j) { const f32x2 ag = {acc[ai][0][m][n][2 * j], acc[ai][0][m][n][2 * j + 1]}, au = {acc[ai][1][m][n][2 * j], acc[ai][1][m][n][2 * j + 1]};
                        const f32x2 t = ag * c1; f32x2 d = {__builtin_amdgcn_exp2f(t.x), __builtin_amdgcn_exp2f(t.y)}; d = d + 1.0f;
                        const f32x2 q = {__builtin_amdgcn_rcpf(d.x), __builtin_amdgcn_rcpf(d.y)};
                        r[n * 2 + j] = ((ag * au) * q) * c2; }
                u32x2 w; unsigned t = 0; t = __builtin_amdgcn_cvt_pk_fp8_f32(r[0].x, r[0].y, t, false); t = __builtin_amdgcn_cvt_pk_fp8_f32(r[1].x, r[1].y, t, true); w.x = t;
                t = 0; t = __builtin_amdgcn_cvt_pk_fp8_f32(r[2].x, r[2].y, t, false); t = __builtin_amdgcn_cvt_pk_fp8_f32(r[3].x, r[3].y, t, true); w.y = t;
                *(u32x2*)(rowp) = w; }
    }
};
struct EpiStoreI8 {
    static constexpr bool PERM = true, AFTER_DRAIN = false;
    bf16_t* O; int ldc; int ncol_tiles; int gate_pn; float* gates; const float* sa; const float* sw;
    __device__ __forceinline__ void operator()(const f32x4 (&acc)[2][2][4][2], const Unit& u, int wr, int wc, int fr, int fq) const {
        const int row0 = u.pm * BM + wr * 64 + fr;
        if (u.pn < ncol_tiles) {
            const int col0 = u.pn * BM + wc * 32 + 8 * fq;
            f32x4 cs[2][2];
#pragma unroll
            for (int bj = 0; bj < 2; ++bj) { cs[bj][0] = *(const f32x4*)(sw + col0 + bj * HALF); cs[bj][1] = *(const f32x4*)(sw + col0 + bj * HALF + 4); }
#pragma unroll
            for (int ai = 0; ai < 2; ++ai)
#pragma unroll
                for (int m = 0; m < 4; ++m) { const int row = row0 + ai * HALF + m * 16; const float rs = sa[row]; bf16_t* rowp = O + (size_t)row * ldc + col0;
#pragma unroll
                    for (int bj = 0; bj < 2; ++bj) { const v4i_t i0 = __builtin_bit_cast(v4i_t, acc[ai][bj][m][0]), i1 = __builtin_bit_cast(v4i_t, acc[ai][bj][m][1]);
                        const f32x4 v0 = __builtin_convertvector(i0, f32x4) * cs[bj][0] * rs, v1 = __builtin_convertvector(i1, f32x4) * cs[bj][1] * rs;
                        u32x4 w; w.x = cvt_pk_bf16(v0[0], v0[1]); w.y = cvt_pk_bf16(v0[2], v0[3]); w.z = cvt_pk_bf16(v1[0], v1[1]); w.w = cvt_pk_bf16(v1[2], v1[3]);
                        *(u32x4*)(rowp + bj * HALF) = w; } }
        } else if (u.pn == gate_pn && wc == 0) {
            const int col0 = u.pn * BM + 8 * fq; const f32x4 c0 = *(const f32x4*)(sw + col0), c1 = *(const f32x4*)(sw + col0 + 4);
#pragma unroll
            for (int ai = 0; ai < 2; ++ai)
#pragma unroll
                for (int m = 0; m < 4; ++m) { const int row = row0 + ai * HALF + m * 16; const float rs = sa[row]; float* rowp = gates + (size_t)row * 32 + 8 * fq;
                    *(f32x4*)(rowp) = __builtin_convertvector(__builtin_bit_cast(v4i_t, acc[ai][0][m][0]), f32x4) * c0 * rs; *(f32x4*)(rowp + 4) = __builtin_convertvector(__builtin_bit_cast(v4i_t, acc[ai][0][m][1]), f32x4) * c1 * rs; }
        }
    }
};
struct EpiSwiGLU8I {
    static constexpr bool PERM = true, AFTER_DRAIN = false;
    unsigned char* O; int ldc; const float* sa; const float* sw; const int* pexp; int swstride; int obf16;
    __device__ __forceinline__ void operator()(const f32x4 (&acc)[2][2][4][2], const Unit& u, int wr, int wc, int fr, int fq) const {
        typedef float f32x2 __attribute__((ext_vector_type(2)));
        const int row0 = u.pm * BM + wr * 64 + fr, col0 = u.pn * HALF + wc * 32 + 8 * fq;
        const float* swe = sw + (pexp ? (size_t)__builtin_amdgcn_readfirstlane(pexp[u.pm]) * swstride : (size_t)0) + u.pn * BM + wc * 32 + 8 * fq;
        const f32x4 g0 = *(const f32x4*)(swe), g1 = *(const f32x4*)(swe + 4), u0 = *(const f32x4*)(swe + HALF), u1 = *(const f32x4*)(swe + HALF + 4);
        const float gs[8] = {g0[0], g0[1], g0[2], g0[3], g1[0], g1[1], g1[2], g1[3]}, us[8] = {u0[0], u0[1], u0[2], u0[3], u1[0], u1[1], u1[2], u1[3]};
#pragma unroll
        for (int ai = 0; ai < 2; ++ai)
#pragma unroll
            for (int m = 0; m < 4; ++m) { const int row = row0 + ai * HALF + m * 16; const float rs = sa[row]; unsigned char* rowp = O + (size_t)row * ldc + col0; float r[8];
#pragma unroll
                for (int n = 0; n < 2; ++n) { const v4i_t ig = __builtin_bit_cast(v4i_t, acc[ai][0][m][n]), iu = __builtin_bit_cast(v4i_t, acc[ai][1][m][n]);
#pragma unroll
                    for (int j = 0; j < 4; ++j) { const float g = (float)ig[j] * (gs[4 * n + j] * rs), up = (float)iu[j] * (us[4 * n + j] * rs);
                        r[4 * n + j] = g * __builtin_amdgcn_rcpf(1.0f + __builtin_amdgcn_exp2f(g * -1.4426950408889634f)) * up; } }
                if (obf16) { u32x4 w; w.x = cvt_pk_bf16(r[0], r[1]); w.y = cvt_pk_bf16(r[2], r[3]); w.z = cvt_pk_bf16(r[4], r[5]); w.w = cvt_pk_bf16(r[6], r[7]);
                    *(u32x4*)((bf16_t*)O + (size_t)row * ldc + col0) = w; }
                else { u32x2 w; unsigned t = 0; t = __builtin_amdgcn_cvt_pk_fp8_f32(r[0], r[1], t, false); t = __builtin_amdgcn_cvt_pk_fp8_f32(r[2], r[3], t, true); w.x = t;
                    t = 0; t = __builtin_amdgcn_cvt_pk_fp8_f32(r[4], r[5], t, false); t = __builtin_amdgcn_cvt_pk_fp8_f32(r[6], r[7], t, true); w.y = t;
                    *(u32x2*)(rowp) = w; } }
    }
};

template <bool FP8> struct Frag;
template <> struct Frag<false> { bf16x8 v[2]; };
template <> struct Frag<true> { v8i_t v; };
template <bool FP8> __device__ __forceinline__ void ldfrag(Frag<FP8>& f, const PG8_LAS unsigned char* p) {
    if constexpr (FP8) { const bf16x8 a = *(const PG8_LAS bf16x8*)p, b = *(const PG8_LAS bf16x8*)(p + 1024); f.v = __builtin_bit_cast(v8i_t, __builtin_shufflevector(a, b, 0, 1, 2, 3, 4, 5, 6, 7, 8, 9, 10, 11, 12, 13, 14, 15)); }
    else { f.v[0] = *(const PG8_LAS bf16x8*)p; f.v[1] = *(const PG8_LAS bf16x8*)(p + 1024); }
}
template <class Epi, class Sched, bool ALIGN_EPI = false, bool SP2 = false, int MODE = 0  >
__device__ __forceinline__ void gemm_phase(PG8_LAS unsigned char* lds, const Gemm g, const Sched& S, const Epi& E) {
    int tid = threadIdx.x; asm volatile("" : "+v"(tid)); const int wid = __builtin_amdgcn_readfirstlane(tid >> 6), lane = tid & 63, wr = wid >> 2, wc = wid & 3, fr = lane & 15, fq = lane >> 4;
    constexpr bool FP8 = (MODE == 1);
    const int K = g.K, rowb = (MODE != 0) ? K : 2 * K, nt = rowb / 128;
    unsigned voffA[2], voffB[2];
#pragma unroll
    for (int i = 0; i < 2; ++i) { int R, C; stage_rc(tid * 16 + i * 8192, R, C); const int Rb = Epi::PERM ? ((R & ~31) + perm32(R & 31)) : R;
        voffA[i] = (unsigned)(R * rowb + C * 2); voffB[i] = (unsigned)(Rb * rowb + C * 2); }
    const size_t kstep = (size_t)(BK * 2);
    const size_t hstep = (size_t)HALF * rowb;
    const size_t tstep = 2 * hstep;
    const unsigned ldsw = (unsigned)wid * 1024u;
    const int aoff = lds_byte(wr * 64 + fr, fq * 8), boff = lds_byte(wc * 32 + fr, fq * 8);
#define PG8_SA(b, h) (((b) * 2 + (h)) * HTB)
#define PG8_SB(b, h) ((4 + (b) * 2 + (h)) * HTB)
#define PG8_STAGE(bufoff, gbase, voff) do { _Pragma("unroll") for (int _i = 0; _i < 2; ++_i) \
        __builtin_amdgcn_global_load_lds((const unsigned*)((const char*)(gbase) + (voff)[_i]), (PG8_LAS unsigned*)(lds + (bufoff) + ldsw + _i * 8192), 16, 0, 0); } while (0)
#define PG8_LDA(dst, b, h) do { _Pragma("unroll") for (int m = 0; m < 4; ++m) ldfrag<FP8>(dst[m], lds + PG8_SA(b, h) + aoff + m * 2048); } while (0)
#define PG8_LDB(dst, b, h) do { _Pragma("unroll") for (int n = 0; n < 2; ++n) ldfrag<FP8>(dst[n], lds + PG8_SB(b, h) + boff + n * 2048); } while (0)
#define PG8_MMA(ai, bj, At, Bt) do { __builtin_amdgcn_s_setprio(1); _Pragma("unroll") for (int m = 0; m < 4; ++m) _Pragma("unroll") for (int n = 0; n < 2; ++n) { \
        if constexpr (FP8) { asm volatile("v_mfma_f32_16x16x128_f8f6f4 %0, %1, %2, %0" : "+v"(acc[ai][bj][m][n]) : "v"(Bt[n].v), "v"(At[m].v)); }     \
        else if constexpr (MODE == 2) { _Pragma("unroll") for (int k = 0; k < 2; ++k) acc[ai][bj][m][n] = __builtin_bit_cast(f32x4, __builtin_amdgcn_mfma_i32_16x16x64_i8(__builtin_bit_cast(v4i_t, Bt[n].v[k]), __builtin_bit_cast(v4i_t, At[m].v[k]), __builtin_bit_cast(v4i_t, acc[ai][bj][m][n]), 0, 0, 0)); } \
        else { _Pragma("unroll") for (int k = 0; k < 2; ++k) acc[ai][bj][m][n] = __builtin_amdgcn_mfma_f32_16x16x32_bf16(Bt[n].v[k], At[m].v[k], acc[ai][bj][m][n], 0, 0, 0); } } __builtin_amdgcn_s_setprio(0); } while (0)
#define PG8_WAIT_V(n) asm volatile("s_waitcnt vmcnt(" #n ")" ::: "memory")
#define PG8_WAIT_L(n) asm volatile("s_waitcnt lgkmcnt(" #n ")" ::: "memory")
#define PG8_BAR __builtin_amdgcn_s_barrier()
#define PG8_SCHED __builtin_amdgcn_sched_barrier(0)
    Unit cur, nxt; int ui = 0;
    if (!S.next(0, cur)) return;
    f32x4 acc[2][2][4][2];
#pragma unroll
    for (int a = 0; a < 2; ++a)
#pragma unroll
        for (int b = 0; b < 2; ++b)
#pragma unroll
            for (int m = 0; m < 4; ++m)
#pragma unroll
                for (int n = 0; n < 2; ++n) acc[a][b][m][n] = (f32x4){0.f, 0.f, 0.f, 0.f};
    Frag<FP8> At[4], B0[2], B1[2];
    const char* cA = (const char*)g.A + (size_t)cur.pm * tstep; const char* cB = (const char*)g.Bt + S.boff(cur) + (size_t)cur.pn * tstep;
    S.a_ready(cur);
    if constexpr (SP2) {
        PG8_STAGE(PG8_SB(0, 0), cB, voffB); PG8_STAGE(PG8_SB(0, 1), cB + hstep, voffB); PG8_STAGE(PG8_SA(0, 0), cA, voffA); PG8_STAGE(PG8_SA(0, 1), cA + hstep, voffA);
        if (wr == 1) PG8_BAR;
        PG8_WAIT_V(2); PG8_BAR;
        PG8_STAGE(PG8_SB(1, 0), cB + kstep, voffB); PG8_STAGE(PG8_SA(1, 0), cA + kstep, voffA); PG8_STAGE(PG8_SB(1, 1), cB + hstep + kstep, voffB);
        PG8_WAIT_V(6); PG8_BAR;
    } else {
        PG8_STAGE(PG8_SB(0, 0), cB, voffB); PG8_STAGE(PG8_SA(0, 0), cA, voffA); PG8_STAGE(PG8_SB(0, 1), cB + hstep, voffB); PG8_STAGE(PG8_SA(0, 1), cA + hstep, voffA);
        if (wr == 1) PG8_BAR;
        PG8_WAIT_V(4); PG8_BAR;
        PG8_STAGE(PG8_SB(1, 0), cB + kstep, voffB); PG8_STAGE(PG8_SA(1, 0), cA + kstep, voffA); PG8_STAGE(PG8_SB(1, 1), cB + hstep + kstep, voffB);
        PG8_WAIT_V(6); PG8_BAR;
    }
    for (;;) {
        const bool has_next = S.next(ui + 1, nxt);
        const char* nA = has_next ? (const char*)g.A + (size_t)nxt.pm * tstep : cA; const char* nB = has_next ? (const char*)g.Bt + S.boff(nxt) + (size_t)nxt.pn * tstep : cB;
#pragma unroll 1
        for (int t = 0; t < nt; t += 2) {
            const bool last = (t == nt - 2);
            const char* a1 = cA + (size_t)(t + 1) * kstep;
            const char* a2 = last ? nA : cA + (size_t)(t + 2) * kstep; const char* b2 = last ? nB : cB + (size_t)(t + 2) * kstep;
            const char* a3 = a2 + kstep; const char* b3 = b2 + kstep;
            if (last && has_next) S.a_ready(nxt);
            if constexpr (SP2) {
            PG8_LDB(B0, 0, 0); PG8_LDB(B1, 0, 1); PG8_SCHED; PG8_LDA(At, 0, 0); PG8_STAGE(PG8_SA(1, 1), a1 + hstep, voffA);
            PG8_WAIT_V(8); PG8_WAIT_L(0); PG8_BAR; PG8_MMA(0, 0, At, B0); PG8_MMA(0, 1, At, B1); PG8_BAR; PG8_SCHED;
            PG8_LDA(At, 0, 1); PG8_STAGE(PG8_SB(0, 0), b2, voffB); PG8_STAGE(PG8_SB(0, 1), b2 + hstep, voffB); PG8_STAGE(PG8_SA(0, 0), a2, voffA);
            PG8_WAIT_V(8); PG8_WAIT_L(0); PG8_BAR; PG8_MMA(1, 0, At, B0); PG8_MMA(1, 1, At, B1); PG8_BAR; PG8_SCHED;
            PG8_LDB(B0, 1, 0); PG8_LDB(B1, 1, 1); PG8_SCHED; PG8_LDA(At, 1, 0); PG8_STAGE(PG8_SA(0, 1), a2 + hstep, voffA);
            PG8_WAIT_V(8); PG8_WAIT_L(0); PG8_BAR; PG8_MMA(0, 0, At, B0); PG8_MMA(0, 1, At, B1); PG8_BAR; PG8_SCHED;
            PG8_LDA(At, 1, 1); PG8_STAGE(PG8_SB(1, 0), b3, voffB); PG8_STAGE(PG8_SB(1, 1), b3 + hstep, voffB); PG8_STAGE(PG8_SA(1, 0), a3, voffA);
            PG8_WAIT_V(8); PG8_WAIT_L(0); PG8_BAR; PG8_MMA(1, 0, At, B0); PG8_MMA(1, 1, At, B1); PG8_BAR; PG8_SCHED;
            } else {
            PG8_LDB(B0, 0, 0); PG8_SCHED; PG8_LDA(At, 0, 0); PG8_STAGE(PG8_SA(1, 1), a1 + hstep, voffA);
            PG8_WAIT_L(8); PG8_BAR; PG8_WAIT_L(0); PG8_MMA(0, 0, At, B0); PG8_BAR; PG8_SCHED;
            PG8_LDB(B1, 0, 1); PG8_STAGE(PG8_SB(0, 0), b2, voffB);
            PG8_BAR; PG8_WAIT_L(0); PG8_MMA(0, 1, At, B1); PG8_BAR;
            PG8_LDA(At, 0, 1); PG8_STAGE(PG8_SA(0, 0), a2, voffA);
            PG8_BAR; PG8_WAIT_L(0); PG8_MMA(1, 0, At, B0); PG8_BAR; PG8_SCHED;
            PG8_STAGE(PG8_SB(0, 1), b2 + hstep, voffB);
            PG8_WAIT_V(6); PG8_BAR; PG8_MMA(1, 1, At, B1); PG8_BAR;
            PG8_LDB(B0, 1, 0); PG8_SCHED; PG8_LDA(At, 1, 0); PG8_STAGE(PG8_SA(0, 1), a2 + hstep, voffA);
            PG8_WAIT_L(8); PG8_BAR; PG8_WAIT_L(0); PG8_MMA(0, 0, At, B0); PG8_BAR; PG8_SCHED;
            PG8_LDB(B1, 1, 1); PG8_STAGE(PG8_SB(1, 0), b3, voffB);
            PG8_BAR; PG8_WAIT_L(0); PG8_MMA(0, 1, At, B1); PG8_BAR;
            PG8_LDA(At, 1, 1); PG8_STAGE(PG8_SA(1, 0), a3, voffA);
            PG8_BAR; PG8_WAIT_L(0); PG8_MMA(1, 0, At, B0); PG8_BAR; PG8_SCHED;
            PG8_STAGE(PG8_SB(1, 1), b3 + hstep, voffB);
            PG8_WAIT_V(6); PG8_BAR; PG8_MMA(1, 1, At, B1); PG8_BAR;
            }
        }
        if constexpr (ALIGN_EPI) { if (wr == 0) PG8_BAR; }
        if constexpr (FP8) { asm volatile("s_nop 15\n\ts_nop 15" ::: "memory"); }
        if constexpr (!Epi::AFTER_DRAIN) { E(acc, cur, wr, wc, fr, fq); S.done(cur); }
        if (!has_next) break;
#pragma unroll
        for (int a = 0; a < 2; ++a)
#pragma unroll
            for (int b = 0; b < 2; ++b)
#pragma unroll
                for (int m = 0; m < 4; ++m)
#pragma unroll
                    for (int n = 0; n < 2; ++n) acc[a][b][m][n] = (f32x4){0.f, 0.f, 0.f, 0.f};
        cur = nxt; cA = nA; cB = nB; ++ui;
        if constexpr (ALIGN_EPI) { if (wr == 1) PG8_BAR; }
    }
    PG8_WAIT_V(0);
    if constexpr (!ALIGN_EPI) { if (wr == 0) PG8_BAR; }
    PG8_BAR;
    if constexpr (Epi::AFTER_DRAIN) { E.fused(acc, cur, wr, wc, fr, fq, lds, wid, lane); S.done(cur); }
#undef PG8_SA
#undef PG8_SB
#undef PG8_STAGE
#undef PG8_LDA
#undef PG8_LDB
#undef PG8_MMA
#undef PG8_WAIT_V
#undef PG8_WAIT_L
#undef PG8_BAR
#undef PG8_SCHED
}
}

constexpr int D = 1024, NB = 8, SEQ = 8192, CTXL = 256, DEPTH = 4, GRIDW = 64, ROWS_G = SEQ / GRIDW  ;
constexpr int M_LAT = NB * SEQ  , M_CTX = NB * CTXL  , M_ALL = M_LAT + M_CTX  ;
constexpr int NHEAD = 8, M_DK = 64, M_DV = 128, H_DK = 128, H_DV = 128;
constexpr int NP_M = 3072, NIN_M = 3328, NW_M = 3104, NP_H = 5120;
constexpr int FF = 2816, NGU = 2 * FF, NEXP = 8;
constexpr int MOE_ROWS = 137216, MOE_PANELS = MOE_ROWS / 256;
constexpr float EPS = 1e-6f;
constexpr int NWAVES = 8, NTHR = 512;

constexpr size_t MiB = 1u << 20;
constexpr size_t WS_CTL = 0, CTL_ZERO_BYTES = 936 * 1024;
constexpr size_t WS_MODV = 1 * MiB;
constexpr size_t WS_SMALL = 2 * MiB;
constexpr size_t WS_LATC = 3 * MiB;
constexpr size_t WS_WE = 11 * MiB;
constexpr size_t WS_WO = 37 * MiB;
constexpr size_t WS_U = 181 * MiB;
constexpr size_t WS_GATES = 313 * MiB;
constexpr size_t WS_STATE = 322 * MiB;
constexpr size_t WS_ROUTE = 362 * MiB;
constexpr size_t WS_ACT = 364 * MiB;
constexpr size_t WS_Y = WS_ACT + 700 * MiB;
constexpr size_t WS_END = WS_ACT + 1005 * MiB;
constexpr size_t WE_IN = 0, WE_OUT = 7 * MiB, WE_GU = 9 * MiB, WE_DOWN = 20 * MiB;
constexpr size_t WOD_IN = 0, WOD_OUT = 10 * MiB, WOD_GU = 12 * MiB, WOD_DOWN = 100 * MiB;
constexpr size_t EGU_BYTES = (size_t)NGU * D * 2, EDOWN_BYTES = (size_t)D * FF * 2;
static_assert(WOD_GU + 8 * EGU_BYTES <= WOD_DOWN && WOD_DOWN + 8 * EDOWN_BYTES <= 144 * MiB, "odd weights map");
static_assert((size_t)NIN_M * D * 2 <= 7 * MiB && WE_GU + EGU_BYTES <= WE_DOWN && WE_DOWN + EDOWN_BYTES <= 26 * MiB, "even weights map");
static_assert((size_t)M_ALL * NP_H * 2 <= 700 * MiB && (size_t)MOE_ROWS * D * 2 + (size_t)MOE_ROWS * FF * 2 <= 1005 * MiB && 700 * MiB + (size_t)M_ALL * D * 2 <= 1005 * MiB, "act map");
constexpr int CW_BAR = 4096;
constexpr int CW_ECNT = 8192;
constexpr int CW_DBG = 16384;
constexpr int CW_CMAX = 32768, CM_LSTRIDE = 50176, CM_GU = 3328, CM_GU_O = 5120;
static_assert((size_t)(CW_CMAX + 4 * CM_LSTRIDE) * 4 <= CTL_ZERO_BYTES, "ctl map");
constexpr size_t RT_E = 0;
constexpr size_t RT_R = 512 * 1024;
constexpr size_t RT_W = 512 * 1024 + 1024 * 1024;
constexpr size_t SM_LB = 0;
constexpr size_t SM_PEXP = 64 * 1024;
constexpr size_t SM_EBASE = 96 * 1024;
constexpr size_t SM_SAU = 128 * 1024;
constexpr size_t SM_SAU2 = 400 * 1024;
constexpr size_t SM_SWE = 672 * 1024;
constexpr size_t SM_SWO = 712 * 1024;
constexpr int SWE_IN = 0, SWE_GU = 3328, SWO_IN = 0, SWO_GU = 5120;
static_assert(SM_SAU + (size_t)M_ALL * 4 <= SM_SAU2 && SM_SAU2 + (size_t)M_ALL * 4 <= SM_SWE && SM_SWE + (3328 + 5632) * 4 <= SM_SWO && SM_SWO + (5120 + 8 * 5632) * 4 <= 1024 * 1024, "small region map");
constexpr size_t GATES_SAMOE = (size_t)M_ALL * 32 * 4;
static_assert(GATES_SAMOE + (size_t)MOE_ROWS * 4 <= 9 * MiB, "gates region map");

constexpr int LDS_MAIN = 147456;
constexpr int LDSCTL_OFF = LDS_MAIN;
constexpr int LDS_BYTES = LDS_MAIN + 512;

#define GAS __attribute__((address_space(1)))
#define LAS __attribute__((address_space(3)))
typedef unsigned short bf16;
typedef unsigned v4u __attribute__((ext_vector_type(4)));
typedef unsigned v2u __attribute__((ext_vector_type(2)));
typedef float f32x4 __attribute__((ext_vector_type(4)));
typedef float f32x16 __attribute__((ext_vector_type(16)));
typedef short bf16x8 __attribute__((ext_vector_type(8)));
typedef short s16x4 __attribute__((ext_vector_type(4)));
typedef GAS unsigned gu32;
#define RLX_AGENT __ATOMIC_RELAXED, __HIP_MEMORY_SCOPE_AGENT
#define LDS_WAIT() asm volatile("s_waitcnt lgkmcnt(0)" ::: "memory")
#define VM_WAIT() asm volatile("s_waitcnt vmcnt(0)" ::: "memory")
#define CFENCE() asm volatile("" ::: "memory")
__device__ __forceinline__ unsigned f2bf(float f) { unsigned u = __builtin_bit_cast(unsigned, f); return (u + 0x7fffu + ((u >> 16) & 1u)) >> 16; }
typedef __bf16 bf16x2_t __attribute__((ext_vector_type(2)));
typedef float f32x2_t __attribute__((ext_vector_type(2)));
__device__ __forceinline__ unsigned pk2(float lo, float hi) { f32x2_t v = {lo, hi}; bf16x2_t b = __builtin_convertvector(v, bf16x2_t); return __builtin_bit_cast(unsigned, b); }
__device__ __forceinline__ float bf2f(unsigned short b) { return __builtin_bit_cast(float, (unsigned)b << 16); }
__device__ __forceinline__ float bflo(unsigned w) { return __builtin_bit_cast(float, w << 16); }
__device__ __forceinline__ float bfhi(unsigned w) { return __builtin_bit_cast(float, w & 0xffff0000u); }
__device__ __forceinline__ float sigmoidf_(float x) { return __builtin_amdgcn_rcpf(1.0f + __expf(-x)); }
__device__ __forceinline__ float siluf_(float x) { return x * sigmoidf_(x); }
template <int CTRL, int RM> __device__ __forceinline__ float dppmov(float x) { return __builtin_bit_cast(float, __builtin_amdgcn_update_dpp(0, __builtin_bit_cast(int, x), CTRL, RM, 0xf, false)); }
__device__ __forceinline__ float wave_sum(float v) {
    v += dppmov<0xB1, 0xf>(v); v += dppmov<0x4E, 0xf>(v); v += dppmov<0x141, 0xf>(v); v += dppmov<0x140, 0xf>(v);
    v += dppmov<0x142, 0xa>(v); v += dppmov<0x143, 0xc>(v);
    return __builtin_bit_cast(float, __builtin_amdgcn_readlane(__builtin_bit_cast(int, v), 63));
}

__device__ __forceinline__ float wave_max(float v) {
    v = fmaxf(v, dppmov<0xB1, 0xf>(v)); v = fmaxf(v, dppmov<0x4E, 0xf>(v)); v = fmaxf(v, dppmov<0x141, 0xf>(v)); v = fmaxf(v, dppmov<0x140, 0xf>(v));
    v = fmaxf(v, dppmov<0x142, 0xa>(v)); v = fmaxf(v, dppmov<0x143, 0xc>(v));
    return __builtin_bit_cast(float, __builtin_amdgcn_readlane(__builtin_bit_cast(int, v), 63));
}

#define XB_TMO      128
#define XB_XCNT(j)  (256  + 64 * (j))
#define XB_XSUB(j)  (1280 + 64 * (j))
#define XB_XGEN(j)  (2304 + 64 * (j))
#define XB_TOP      3328
#define XB_TOPGEN   3392
#define XCD_BAR_WORDS 3456
#define XB_SPIN_CAP (1u << 18)
__device__ __forceinline__ unsigned xb_ld(unsigned* p)              { return __hip_atomic_load(p, __ATOMIC_RELAXED, __HIP_MEMORY_SCOPE_AGENT); }
__device__ __forceinline__ unsigned xb_add(unsigned* p, unsigned v) { return __hip_atomic_fetch_add(p, v, __ATOMIC_RELAXED, __HIP_MEMORY_SCOPE_AGENT); }
__device__ __forceinline__ unsigned xb_xcc_id() { return (unsigned)__builtin_amdgcn_s_getreg((3 << 11) | 20) & 0xFu; }
#define XB_SPIN(cond, bar) do { unsigned _sp = 0; while (cond) { __builtin_amdgcn_s_sleep(1); \
    if ((++_sp & 255u) == 0u) { if (xb_ld(&(bar)[XB_TMO])) break; if (_sp > XB_SPIN_CAP) { atomicAdd(&(bar)[XB_TMO], 1u); break; } } } } while (0)
struct XcdBarrier { unsigned* bar; unsigned x; volatile LAS unsigned* st; };
__device__ __forceinline__ XcdBarrier xcd_barrier_post(unsigned* bar, volatile LAS unsigned* st) {
    XcdBarrier b; b.bar = bar; b.x = xb_xcc_id(); b.st = st;
    if (threadIdx.x == 0) (void)xb_add(&bar[XB_XCNT(b.x)], 1u);
    return b;
}
__device__ __forceinline__ void xcd_barrier_complete(unsigned* bar, unsigned x, unsigned& nloc, unsigned& nx) {
    const unsigned G = gridDim.x * gridDim.y * gridDim.z;
    unsigned sum, cnt, mine, sp = 0u;
    for (;;) {
        sum = 0u; cnt = 0u; mine = 0u;
#pragma unroll
        for (unsigned j = 0; j < 16; ++j) { const unsigned c = xb_ld(&bar[XB_XCNT(j)]); sum += c; cnt += (c > 0u) ? 1u : 0u; mine = (j == x) ? c : mine; }
        if (sum == G) break;
        __builtin_amdgcn_s_sleep(1);
        if ((++sp & 255u) == 0u) { if (xb_ld(&bar[XB_TMO])) break; if (sp > XB_SPIN_CAP) { atomicAdd(&bar[XB_TMO], 1u); break; } }
    }
    nloc = mine > 0u ? mine : 1u; nx = cnt > 0u ? cnt : 1u;
}
__device__ __attribute__((noinline)) void xcd_barrier(unsigned* bar_, unsigned bx_, volatile LAS unsigned* st_) { XcdBarrier b; b.bar = bar_; b.x = bx_; b.st = st_;
    asm volatile("s_waitcnt vmcnt(0)" ::: "memory");
    __syncthreads();
    if (threadIdx.x == 0) {
        unsigned* bar = b.bar;
        __builtin_amdgcn_s_waitcnt(0);
        unsigned nloc = b.st[0], nx = b.st[1];
        if (nloc == 0u) { xcd_barrier_complete(bar, b.x, nloc, nx); b.st[0] = nloc; b.st[1] = nx; }
        const unsigned old = xb_add(&bar[XB_XSUB(b.x)], 1u);
        const unsigned gen = old / nloc;
        if (old + 1u == (gen + 1u) * nloc) {
            __builtin_amdgcn_fence(__ATOMIC_RELEASE, "agent");
            asm volatile("s_waitcnt vmcnt(0)" ::: "memory");
            const unsigned og = xb_add(&bar[XB_TOP], 1u);
            const unsigned tg = og / nx;
            if (og + 1u == (tg + 1u) * nx) xb_add(&bar[XB_TOPGEN], 1u);
            else XB_SPIN(xb_ld(&bar[XB_TOPGEN]) == tg, bar);
            __builtin_amdgcn_fence(__ATOMIC_ACQUIRE, "agent");
            xb_add(&bar[XB_XGEN(b.x)], 1u);
            asm volatile("s_waitcnt vmcnt(0)" ::: "memory");
        } else {
            XB_SPIN(xb_ld(&bar[XB_XGEN(b.x)]) == gen, bar);
            __builtin_amdgcn_fence(__ATOMIC_ACQUIRE, "agent");
            asm volatile("s_waitcnt vmcnt(0)" ::: "memory");
        }
    }
    __syncthreads();
}

struct Args {
    const float* in[23];
    float* out; unsigned char* ws;
    int ph_lo, ph_hi;
    int use_bar, pad;
};
struct Frame {
    LAS unsigned char* lds;
    int tid, lane, wave, G, bid;
    unsigned char* ws;
    const float* const __attribute__((address_space(4)))* in;
    float* out;
};
enum { I_X = 0, I_C, I_CTX, I_CCTX, I_MODW, I_MODB, I_NORMG, I_MWIN, I_MBGATE, I_MWCONV, I_MGHEAD, I_MWOUT, I_HWIN, I_HBF, I_HLB, I_HGHEAD, I_HWOUT, I_FWGU, I_FWDOWN, I_EWR, I_EBR, I_EWGU, I_EWDOWN };

#ifndef FP8_LAYERS
#define FP8_LAYERS 0xE
#endif
#define FFN_FP8_L(L) (((FP8_LAYERS) >> (L)) & 1)
#ifndef INPROJ_I8
#define INPROJ_I8 1
#endif
#ifndef UP_I8
#define UP_I8 1
#endif
#ifndef UP_I8_MOE
#define UP_I8_MOE 0
#endif
#ifndef FFN_FP8
#define FFN_FP8 1
#endif
constexpr float WSCALE8 = 64.0f;

__device__ __forceinline__ void phase_mods(Frame& F) {
    LAS float* SV = (LAS float*)(F.lds);
    LAS float* RED = (LAS float*)(F.lds + 9 * 1024 * 4);
    const float* cvec = F.in[I_C]; const float* cctx = F.in[I_CCTX];
    for (int i = F.tid; i < 9 * 1024; i += NTHR) { const int b = i >> 10, k = i & 1023; const float v = b < 8 ? cvec[b * 1024 + k] : cctx[k]; SV[i] = siluf_(v); }
    __syncthreads();
    const float* modw = F.in[I_MODW]; const float* modb = F.in[I_MODB]; const float* normg = F.in[I_NORMG];
    float* modv = (float*)(F.ws + WS_MODV);
    for (int item = F.bid; item < 4 * 96; item += F.G) {
        const int L = item / 96, n0 = (item % 96) * 64;
        const float* wp = modw + (size_t)L * 1024 * 6144 + n0 + F.lane;
        float acc[9];
#pragma unroll
        for (int b = 0; b < 9; ++b) acc[b] = 0.f;
        const int k0 = F.wave * 128;
#pragma unroll 4
        for (int k = 0; k < 128; ++k) { const float wv = wp[(size_t)(k0 + k) * 6144];
#pragma unroll
            for (int b = 0; b < 9; ++b) acc[b] += SV[b * 1024 + k0 + k] * wv; }
#pragma unroll
        for (int b = 0; b < 9; ++b) RED[(F.wave * 9 + b) * 64 + F.lane] = acc[b];
        __syncthreads();
        for (int o = F.tid; o < 9 * 64; o += NTHR) { const int b = o >> 6, l = o & 63; float v = 0.f;
#pragma unroll
            for (int w = 0; w < 8; ++w) v += RED[(w * 9 + b) * 64 + l];
            const int n = n0 + l, s = n >> 10, c = n & 1023; v += modb[L * 6144 + n];
            const float* g = normg + (size_t)L * 4 * 1024;
            int slot; float r;
            if (s == 0) { slot = 1; r = v; } else if (s == 1) { slot = 0; r = g[c] * (1.f + v); } else if (s == 2) { slot = 2; r = v * g[1024 + c]; }
            else if (s == 3) { slot = 4; r = v; } else if (s == 4) { slot = 3; r = g[2048 + c] * (1.f + v); } else { slot = 5; r = v * g[3072 + c]; }
            modv[((size_t)(L * 9 + b) * 6 + slot) * 1024 + c] = r; }
        __syncthreads();
    }
}

struct WDesc { const float* src; unsigned char* dst; const unsigned* cmax; float* sw; int N; int Kb; int mode; };
__device__ __forceinline__ int wrow_gu(int n0) { const int half = n0 / FF, nn = n0 - half * FF; return 256 * (nn >> 7) + 128 * half + (nn & 127); }
__device__ __forceinline__ WDesc wdesc(const float* W, int K, int N, unsigned char* WT, int gu_mode, int mode, const unsigned* cmax, float* sw, int r, int lane) {
    const int nkb = K >> 6, nb = r / nkb, kb = r - nb * nkb, k0 = 64 * kb, n0 = 32 * nb;
    const int row0 = gu_mode ? wrow_gu(n0) : n0; const int esz = mode == 0 ? 2 : 1;
    WDesc d; d.N = N; d.Kb = K * esz; d.mode = mode;
    d.src = W + (size_t)(k0 + (lane >> 3)) * N + n0 + 4 * (lane & 7);
    d.dst = WT + (size_t)(row0 + (lane >> 3)) * d.Kb + (size_t)(k0 + 8 * (lane & 7)) * esz;
    d.cmax = cmax + n0; d.sw = (mode == 2 && kb == 0) ? sw + row0 : nullptr;
    return d;
}
#define WT_DECL(T) f32x4 T##0, T##1, T##2, T##3, T##4, T##5, T##6, T##7
#define WT_LOAD(T, p, N) do { const GAS float* _p = (const GAS float*)(p); const size_t _s = (size_t)8 * (N); \
    T##0 = *(const GAS f32x4*)(_p); T##1 = *(const GAS f32x4*)(_p + _s); T##2 = *(const GAS f32x4*)(_p + 2 * _s); T##3 = *(const GAS f32x4*)(_p + 3 * _s); \
    T##4 = *(const GAS f32x4*)(_p + 4 * _s); T##5 = *(const GAS f32x4*)(_p + 5 * _s); T##6 = *(const GAS f32x4*)(_p + 6 * _s); T##7 = *(const GAS f32x4*)(_p + 7 * _s); } while (0)
#define WT_COPY(A, B) do { A##0 = B##0; A##1 = B##1; A##2 = B##2; A##3 = B##3; A##4 = B##4; A##5 = B##5; A##6 = B##6; A##7 = B##7; } while (0)
__device__ __forceinline__ void wt_put(LAS float* w, int i, const f32x4 v) { w[(8 * i) * 33] = v[0]; w[(8 * i) * 33 + 1] = v[1]; w[(8 * i) * 33 + 2] = v[2]; w[(8 * i) * 33 + 3] = v[3]; }
__device__ __forceinline__ void wt_process(const WDesc& d, const f32x4 t0, const f32x4 t1, const f32x4 t2, const f32x4 t3, const f32x4 t4, const f32x4 t5, const f32x4 t6, const f32x4 t7, LAS float* scr, int lane) {
    LAS float* w = scr + (lane >> 3) * 33 + 4 * (lane & 7);
    wt_put(w, 0, t0); wt_put(w, 1, t1); wt_put(w, 2, t2); wt_put(w, 3, t3); wt_put(w, 4, t4); wt_put(w, 5, t5); wt_put(w, 6, t6); wt_put(w, 7, t7);
    LDS_WAIT(); CFENCE();
    const int c = lane & 7;
#pragma unroll
    for (int j = 0; j < 4; ++j) { const int n = (lane >> 3) + 8 * j; const LAS float* s = scr + (8 * c) * 33 + n;
        float x[8];
#pragma unroll
        for (int e = 0; e < 8; ++e) x[e] = s[e * 33];
        unsigned char* dp = d.dst + (size_t)(8 * j) * d.Kb;
        if (d.mode == 0) { v4u o; o.x = pk2(x[0], x[1]); o.y = pk2(x[2], x[3]); o.z = pk2(x[4], x[5]); o.w = pk2(x[6], x[7]); *(GAS v4u*)dp = o; }
        else if (d.mode == 1) { v2u o; unsigned q = 0; q = __builtin_amdgcn_cvt_pk_fp8_f32(x[0] * WSCALE8, x[1] * WSCALE8, q, false); q = __builtin_amdgcn_cvt_pk_fp8_f32(x[2] * WSCALE8, x[3] * WSCALE8, q, true); o.x = q;
            q = 0; q = __builtin_amdgcn_cvt_pk_fp8_f32(x[4] * WSCALE8, x[5] * WSCALE8, q, false); q = __builtin_amdgcn_cvt_pk_fp8_f32(x[6] * WSCALE8, x[7] * WSCALE8, q, true); o.y = q; *(GAS v2u*)dp = o; }
        else { const float mx = __uint_as_float(d.cmax[n]); const float iv = mx > 0.f ? 127.0f / mx : 0.f; unsigned q[8];
#pragma unroll
            for (int e = 0; e < 8; ++e) q[e] = (unsigned)(int)__builtin_rintf(x[e] * iv) & 0xffu;
            v2u o; o.x = q[0] | (q[1] << 8) | (q[2] << 16) | (q[3] << 24); o.y = q[4] | (q[5] << 8) | (q[6] << 16) | (q[7] << 24); *(GAS v2u*)dp = o;
            if (d.sw != nullptr && c == 0) d.sw[n] = mx > 0.f ? mx * (1.0f / 127.0f) : 1.0f; }
    }
    LDS_WAIT(); CFENCE();
}
__device__ __forceinline__ WDesc wdesc_layer(Frame& F, int L, int it) {
    const int j = L >> 1; int r = it; const unsigned* cm = (const unsigned*)(F.ws + WS_CTL) + CW_CMAX + L * CM_LSTRIDE;
    if ((L & 1) == 0) {
        unsigned char* wb = F.ws + WS_WE; float* swb = (float*)(F.ws + WS_SMALL + SM_SWE);
        constexpr int I0 = 16 * (NW_M / 32), I1 = 16 * 32, I2 = 16 * (NGU / 32);
        if (r < I0) return wdesc(F.in[I_MWIN] + (size_t)j * D * NW_M, D, NW_M, wb + WE_IN, 0, INPROJ_I8 ? 2 : 0, cm, swb + SWE_IN, r, F.lane); r -= I0;
        if (r < I1) return wdesc(F.in[I_MWOUT] + (size_t)j * D * D, D, D, wb + WE_OUT, 0, 0, cm, nullptr, r, F.lane); r -= I1;
        if (r < I2) return wdesc(F.in[I_FWGU] + (size_t)j * D * NGU, D, NGU, wb + WE_GU, 1, UP_I8 ? 2 : (FFN_FP8_L(L) ? 1 : 0), cm + CM_GU, swb + SWE_GU, r, F.lane); r -= I2;
        return wdesc(F.in[I_FWDOWN] + (size_t)j * FF * D, FF, D, wb + WE_DOWN, 0, FFN_FP8_L(L) ? 1 : 0, cm, nullptr, r, F.lane);
    } else {
        unsigned char* wb = F.ws + WS_WO; float* swb = (float*)(F.ws + WS_SMALL + SM_SWO);
        constexpr int I0 = 16 * (NP_H / 32), I1 = 16 * 32, I2 = 16 * (NGU / 32), I3 = (FF / 64) * 32;
        if (r < I0) return wdesc(F.in[I_HWIN] + (size_t)j * D * NP_H, D, NP_H, wb + WOD_IN, 0, INPROJ_I8 ? 2 : 0, cm, swb + SWO_IN, r, F.lane); r -= I0;
        if (r < I1) return wdesc(F.in[I_HWOUT] + (size_t)j * D * D, D, D, wb + WOD_OUT, 0, 0, cm, nullptr, r, F.lane); r -= I1;
        const int e = r / (I2 + I3); r -= e * (I2 + I3);
        if (r < I2) return wdesc(F.in[I_EWGU] + ((size_t)j * NEXP + e) * D * NGU, D, NGU, wb + WOD_GU + e * EGU_BYTES, 1, UP_I8_MOE ? 2 : (FFN_FP8_L(L) ? 1 : 0), cm + CM_GU_O + e * NGU, swb + SWO_GU + e * NGU, r, F.lane); r -= I2;
        return wdesc(F.in[I_EWDOWN] + ((size_t)j * NEXP + e) * FF * D, FF, D, wb + WOD_DOWN + e * EDOWN_BYTES, 0, FFN_FP8_L(L) ? 1 : 0, cm, nullptr, r, F.lane);
    }
}
__device__ __forceinline__ void phase_wconv(Frame& F, int L) {
    LAS float* scr = (LAS float*)(F.lds + F.wave * 16384);
    const int gw = F.bid * NWAVES + F.wave, NGW = F.G * NWAVES;
    const int total = (L & 1) ? 16 * (NP_H / 32) + 16 * 32 + NEXP * (16 * (NGU / 32) + (FF / 64) * 32) : 16 * (NW_M / 32) + 16 * 32 + 16 * (NGU / 32) + (FF / 64) * 32;
    WT_DECL(c); WT_DECL(n); WDesc dc, dn;
    int it = gw;
    if (it < total) { dc = wdesc_layer(F, L, it); WT_LOAD(c, dc.src, dc.N); }
#pragma unroll 1
    for (; it < total; it += NGW) {
        const bool more = it + NGW < total;
        if (more) { dn = wdesc_layer(F, L, it + NGW); WT_LOAD(n, dn.src, dn.N); }
        wt_process(dc, c0, c1, c2, c3, c4, c5, c6, c7, scr, F.lane);
        if (more) { dc = dn; WT_COPY(c, n); }
    }
    if ((L & 1) == 0) {
        unsigned char* wb = F.ws + WS_WE; float* swb = (float*)(F.ws + WS_SMALL + SM_SWE);
        GAS v4u* z = (GAS v4u*)(wb + WE_IN + (size_t)NW_M * D * (INPROJ_I8 ? 1 : 2)); const int nz = (NIN_M - NW_M) * D * (INPROJ_I8 ? 1 : 2) / 16;
        for (int i = F.bid * NTHR + F.tid; i < nz; i += F.G * NTHR) z[i] = (v4u){0u, 0u, 0u, 0u};
        if (INPROJ_I8 && F.bid == 0 && F.tid < NIN_M - NW_M) swb[SWE_IN + NW_M + F.tid] = 1.0f;
    }
}
__device__ __forceinline__ void phase_colmax(Frame& F) {
    const int gw = F.bid * NWAVES + F.wave, NGW = F.G * NWAVES;
    constexpr int TE_IN = 16 * (NW_M / 32), TE_GU = 16 * (NGU / 32), TO_IN = 16 * (NP_H / 32);
    constexpr int TE = (INPROJ_I8 ? TE_IN : 0) + (UP_I8 ? TE_GU : 0), TO = (INPROJ_I8 ? TO_IN : 0) + (UP_I8_MOE ? NEXP * TE_GU : 0), total = 2 * (TE + TO);
#pragma unroll 1
    for (int it = gw; it < total; it += NGW) {
        int r = it; int L; const float* W; int N, nnb, cbase;
        const int pr = r / (TE + TO); r -= pr * (TE + TO);
        if (r < TE) { L = 2 * pr; if (INPROJ_I8 && r < TE_IN) { W = F.in[I_MWIN] + (size_t)pr * D * NW_M; N = NW_M; nnb = NW_M / 32; cbase = 0; } else { if (INPROJ_I8) r -= TE_IN; W = F.in[I_FWGU] + (size_t)pr * D * NGU; N = NGU; nnb = NGU / 32; cbase = CM_GU; } }
        else { r -= TE; L = 2 * pr + 1;
            if (INPROJ_I8 && r < TO_IN) { W = F.in[I_HWIN] + (size_t)pr * D * NP_H; N = NP_H; nnb = NP_H / 32; cbase = 0; }
            else { if (INPROJ_I8) r -= TO_IN; const int e = r / TE_GU; r -= e * TE_GU; W = F.in[I_EWGU] + ((size_t)pr * NEXP + e) * D * NGU; N = NGU; nnb = NGU / 32; cbase = CM_GU_O + e * NGU; } }
        const int kb = r / nnb, nb = r - kb * nnb;
        const float* p = W + (size_t)(64 * kb + (F.lane >> 3)) * N + 32 * nb + 4 * (F.lane & 7);
        WT_DECL(t); WT_LOAD(t, p, N);
        f32x4 mx;
#pragma unroll
        for (int q = 0; q < 4; ++q) { float a = fmaxf(fmaxf(fabsf(t0[q]), fabsf(t1[q])), fmaxf(fabsf(t2[q]), fabsf(t3[q]))); a = fmaxf(a, fmaxf(fmaxf(fabsf(t4[q]), fabsf(t5[q])), fmaxf(fabsf(t6[q]), fabsf(t7[q]))));
            a = fmaxf(a, __shfl_xor(a, 8)); a = fmaxf(a, __shfl_xor(a, 16)); a = fmaxf(a, __shfl_xor(a, 32)); mx[q] = a; }
        if (F.lane < 8) { unsigned* cm = (unsigned*)(F.ws + WS_CTL) + CW_CMAX + L * CM_LSTRIDE + cbase + 32 * nb + 4 * F.lane;
#pragma unroll
            for (int q = 0; q < 4; ++q) atomicMax(cm + q, __float_as_uint(mx[q])); }
    }
}

struct TokCfg {
    const void* lat_src_l; const void* lat_src_c;
    void* lat_dst_l; void* lat_dst_c;
    int src_f32, dst_f32;
    const bf16* y; int y_perm; int moe_combine;
    const float* vupd;
    const float* vna; const float* vnb;
    bf16* u; int u_perm; int u_fp8;
    float* u_scale;
    int route; int jr;
    int nrows;
};
__device__ __forceinline__ int perm_cm(int t) { return (t & 63) * ROWS_G + (t >> 6); }

struct RowRaw { v4u l0, l1, l2, l3; v2u a0, a1, a2, a3, b0, b1, b2, b3; };
__device__ __forceinline__ RowRaw tok_issue(const TokCfg& T, int row, int p0, int p1, int lane) {
    RowRaw R; const v4u z4 = (v4u){0u, 0u, 0u, 0u}; const v2u z2 = (v2u){0u, 0u};
    R.l0 = z4; R.l1 = z4; R.l2 = z4; R.l3 = z4; R.a0 = z2; R.a1 = z2; R.a2 = z2; R.a3 = z2; R.b0 = z2; R.b1 = z2; R.b2 = z2; R.b3 = z2;
    if (T.src_f32) { const GAS v4u* lp = (const GAS v4u*)(row < M_LAT ? (const float*)T.lat_src_l + (size_t)row * D : (const float*)T.lat_src_c + (size_t)(row - M_LAT) * D) + lane;
        R.l0 = lp[0]; R.l1 = lp[64]; R.l2 = lp[128]; R.l3 = lp[192]; }
    else { const GAS v2u* lp = (const GAS v2u*)(row < M_LAT ? (const bf16*)T.lat_src_l + (size_t)row * D : (const bf16*)T.lat_src_c + (size_t)(row - M_LAT) * D) + lane;
        const v2u a = lp[0], b = lp[64], c = lp[128], d = lp[192]; R.l0.x = a.x; R.l0.y = a.y; R.l1.x = b.x; R.l1.y = b.y; R.l2.x = c.x; R.l2.y = c.y; R.l3.x = d.x; R.l3.y = d.y; }
    if (T.y) {
        if (T.moe_combine) { const GAS v2u* ya = (const GAS v2u*)(T.y + (size_t)p0 * D) + lane; const GAS v2u* yb = (const GAS v2u*)(T.y + (size_t)p1 * D) + lane;
            R.a0 = ya[0]; R.a1 = ya[64]; R.a2 = ya[128]; R.a3 = ya[192]; R.b0 = yb[0]; R.b1 = yb[64]; R.b2 = yb[128]; R.b3 = yb[192]; }
        else { int yr = row; if (T.y_perm && row < M_LAT) yr = (row & ~8191) + perm_cm(row & 8191);
            const GAS v2u* yp = (const GAS v2u*)(T.y + (size_t)yr * D) + lane; R.a0 = yp[0]; R.a1 = yp[64]; R.a2 = yp[128]; R.a3 = yp[192]; }
    }
    return R;
}
__device__ __forceinline__ void phase_tok(Frame& F, const TokCfg& T) {
    const int gw = F.bid * NWAVES + F.wave, NGW = F.G * NWAVES;
    const int R = (T.nrows + NGW - 1) / NGW; const int r0 = gw * R; int r1 = r0 + R; if (r1 > T.nrows) r1 = T.nrows;
    LAS float* WR = (LAS float*)F.lds;
    if (T.route) { const float* wr = F.in[I_EWR] + (size_t)T.jr * 1024 * 8; for (int i = F.tid; i < 8192; i += NTHR) WR[i] = wr[i]; }
    __syncthreads();
    f32x4 VU[4], VA[4], VB[4]; int curb = -1;
    int my_e0 = 0, my_e1 = 0; float my_w = 0.f;
    const int* rrp = (const int*)(F.ws + WS_ROUTE + RT_R); const float* rwp = (const float*)(F.ws + WS_ROUTE + RT_W);
    int p0c = 0, p1c = 0, p0n = 0, p1n = 0; float w0c = 0.f, w0n = 0.f;
    if (T.moe_combine && r0 < r1) { p0c = rrp[2 * r0]; p1c = rrp[2 * r0 + 1]; w0c = rwp[r0]; if (r0 + 1 < r1) { p0n = rrp[2 * r0 + 2]; p1n = rrp[2 * r0 + 3]; w0n = rwp[r0 + 1]; } }
    RowRaw C = tok_issue(T, r0 < r1 ? r0 : 0, p0c, p1c, F.lane);
    for (int row = r0; row < r1; ++row) {
        const bool hn = row + 1 < r1;
        int p0nn = 0, p1nn = 0; float w0nn = 0.f;
        const RowRaw N = tok_issue(T, hn ? row + 1 : row, p0n, p1n, F.lane);
        if (hn) {
            if (T.moe_combine && row + 2 < r1) { p0nn = rrp[2 * row + 4]; p1nn = rrp[2 * row + 5]; w0nn = rwp[row + 2]; } }
        const int b = row < M_LAT ? (row >> 13) : 8;
        if (b != curb) { curb = b;
#pragma unroll
            for (int j = 0; j < 4; ++j) {
                if (T.y) VU[j] = ((const f32x4*)(T.vupd + (size_t)b * 6144))[F.lane + 64 * j];
                if (T.vna) { VA[j] = ((const f32x4*)(T.vna + (size_t)b * 6144))[F.lane + 64 * j]; VB[j] = ((const f32x4*)(T.vnb + (size_t)b * 6144))[F.lane + 64 * j]; } } }
        f32x4 v[4];
        if (T.src_f32) {
            v[0] = __builtin_bit_cast(f32x4, C.l0); v[1] = __builtin_bit_cast(f32x4, C.l1); v[2] = __builtin_bit_cast(f32x4, C.l2); v[3] = __builtin_bit_cast(f32x4, C.l3); }
        else {
            const v4u cl[4] = {C.l0, C.l1, C.l2, C.l3};
#pragma unroll
            for (int j = 0; j < 4; ++j) v[j] = (f32x4){bflo(cl[j].x), bfhi(cl[j].x), bflo(cl[j].y), bfhi(cl[j].y)}; }
        if (T.y) {
            f32x4 yv[4]; const v2u cya[4] = {C.a0, C.a1, C.a2, C.a3}, cyb[4] = {C.b0, C.b1, C.b2, C.b3};
            if (T.moe_combine) { const float w0 = w0c, w1 = 1.f - w0c;
#pragma unroll
                for (int j = 0; j < 4; ++j) { const v2u a = cya[j], c = cyb[j];
                    yv[j] = (f32x4){w0 * bflo(a.x) + w1 * bflo(c.x), w0 * bfhi(a.x) + w1 * bfhi(c.x), w0 * bflo(a.y) + w1 * bflo(c.y), w0 * bfhi(a.y) + w1 * bfhi(c.y)}; }
            } else {
#pragma unroll
                for (int j = 0; j < 4; ++j) { const v2u a = cya[j]; yv[j] = (f32x4){bflo(a.x), bfhi(a.x), bflo(a.y), bfhi(a.y)}; }
            }
            float ss = 0.f;
#pragma unroll
            for (int j = 0; j < 4; ++j) ss += (yv[j].x * yv[j].x + yv[j].y * yv[j].y) + (yv[j].z * yv[j].z + yv[j].w * yv[j].w);
            const float rs = rsqrtf(wave_sum(ss) * (1.f / D) + EPS);
#pragma unroll
            for (int j = 0; j < 4; ++j) v[j] = v[j] + VU[j] * (yv[j] * rs);
        }
        void* dpv = row < M_LAT ? T.lat_dst_l : T.lat_dst_c;
        if (dpv) { const size_t ro = (size_t)(row < M_LAT ? row : row - M_LAT) * D;
            if (T.dst_f32) { float* dp = (float*)dpv + ro;
#pragma unroll
                for (int j = 0; j < 4; ++j) ((GAS f32x4*)dp)[F.lane + 64 * j] = v[j]; }
            else { bf16* dp = (bf16*)dpv + ro;
#pragma unroll
                for (int j = 0; j < 4; ++j) { v2u o; o.x = pk2(v[j].x, v[j].y); o.y = pk2(v[j].z, v[j].w); ((GAS v2u*)dp)[F.lane + 64 * j] = o; } } }
        if (T.vna) {
            float ss = 0.f;
#pragma unroll
            for (int j = 0; j < 4; ++j) ss += (v[j].x * v[j].x + v[j].y * v[j].y) + (v[j].z * v[j].z + v[j].w * v[j].w);
            const float rs = rsqrtf(wave_sum(ss) * (1.f / D) + EPS);
            f32x4 uu[4];
#pragma unroll
            for (int j = 0; j < 4; ++j) uu[j] = (v[j] * rs) * VA[j] + VB[j];
            int ur = row; if (T.u_perm && row < M_LAT) ur = (row & ~8191) + perm_cm(row & 8191);
            if (T.u_fp8 == 2) { GAS unsigned* up8 = (GAS unsigned*)((unsigned char*)T.u + (size_t)ur * D);
                float mx = 0.f;
#pragma unroll
                for (int j = 0; j < 4; ++j) mx = fmaxf(fmaxf(mx, fmaxf(fabsf(uu[j].x), fabsf(uu[j].y))), fmaxf(fabsf(uu[j].z), fabsf(uu[j].w)));
                mx = wave_max(mx); const float iv = mx > 0.f ? 127.0f / mx : 0.f;
#pragma unroll
                for (int j = 0; j < 4; ++j) { const unsigned q0 = (unsigned)(int)__builtin_rintf(uu[j].x * iv) & 0xffu, q1 = (unsigned)(int)__builtin_rintf(uu[j].y * iv) & 0xffu, q2 = (unsigned)(int)__builtin_rintf(uu[j].z * iv) & 0xffu, q3 = (unsigned)(int)__builtin_rintf(uu[j].w * iv);
                    up8[F.lane + 64 * j] = q0 | (q1 << 8) | (q2 << 16) | (q3 << 24); }
                if (F.lane == 0) T.u_scale[ur] = mx > 0.f ? mx * (1.0f / 127.0f) : 1.0f; }
            else if (T.u_fp8) { GAS unsigned* up8 = (GAS unsigned*)((unsigned char*)T.u + (size_t)ur * D);
#pragma unroll
                for (int j = 0; j < 4; ++j) { unsigned w = 0; w = __builtin_amdgcn_cvt_pk_fp8_f32(uu[j].x, uu[j].y, w, false); w = __builtin_amdgcn_cvt_pk_fp8_f32(uu[j].z, uu[j].w, w, true); up8[F.lane + 64 * j] = w; } }
            else { GAS v2u* up = (GAS v2u*)(T.u + (size_t)ur * D);
#pragma unroll
                for (int j = 0; j < 4; ++j) { v2u o; o.x = pk2(uu[j].x, uu[j].y); o.y = pk2(uu[j].z, uu[j].w); up[F.lane + 64 * j] = o; } }
            if (T.route) {
                float lg[8];
#pragma unroll
                for (int e = 0; e < 8; ++e) lg[e] = 0.f;
#pragma unroll
                for (int j = 0; j < 4; ++j)
#pragma unroll
                    for (int i = 0; i < 4; ++i) { const int c = 4 * (F.lane + 64 * j) + i; const f32x4 wa = *(const LAS f32x4*)(WR + c * 8), wb = *(const LAS f32x4*)(WR + c * 8 + 4); const float x = uu[j][i];
                        lg[0] += x * wa.x; lg[1] += x * wa.y; lg[2] += x * wa.z; lg[3] += x * wa.w; lg[4] += x * wb.x; lg[5] += x * wb.y; lg[6] += x * wb.z; lg[7] += x * wb.w; }
                const float* br = F.in[I_EBR] + T.jr * 8;
#pragma unroll
                for (int e = 0; e < 8; ++e) lg[e] = wave_sum(lg[e]) + br[e];
                int e0 = 0; float v0 = lg[0];
#pragma unroll
                for (int e = 1; e < 8; ++e) if (lg[e] > v0) { v0 = lg[e]; e0 = e; }
                int e1 = -1; float v1 = -3.0e38f;
#pragma unroll
                for (int e = 0; e < 8; ++e) if (e != e0 && lg[e] > v1) { v1 = lg[e]; e1 = e; }
                const float w0 = 1.f / (1.f + __expf(v1 - v0));
                if (F.lane == row - r0) { my_e0 = e0; my_e1 = e1; my_w = w0; }
            }
        }
        if (hn) { C = N; p0n = p0nn; p1n = p1nn; w0c = w0n; w0n = w0nn; }
    }
    if (T.route) {
        const int n = r1 - r0; const bool act = F.lane < n; const int row = r0 + F.lane;
        unsigned* ecnt = (unsigned*)(F.ws + WS_CTL) + CW_ECNT + T.jr * 8 * 64;
        int rk0 = 0, rk1 = 0;
        const unsigned long long ltmask = (F.lane == 0) ? 0ull : (~0ull >> (64 - F.lane));
#pragma unroll
        for (int e = 0; e < 8; ++e) {
            const unsigned long long m0 = __ballot(act && my_e0 == e), m1 = __ballot(act && my_e1 == e);
            const int c0 = __popcll(m0), c1 = __popcll(m1);
            unsigned base = 0;
            if (c0 + c1 > 0) { if (F.lane == 0) base = __hip_atomic_fetch_add(ecnt + e * 64, (unsigned)(c0 + c1), RLX_AGENT); base = __builtin_amdgcn_readfirstlane(base); }
            if (my_e0 == e) rk0 = (int)base + __popcll(m0 & ltmask);
            if (my_e1 == e) rk1 = (int)base + c0 + __popcll(m1 & ltmask);
        }
        if (act) { ((int*)(F.ws + WS_ROUTE + RT_E))[row] = my_e0 | (my_e1 << 8); ((int*)(F.ws + WS_ROUTE + RT_R))[2 * row] = rk0; ((int*)(F.ws + WS_ROUTE + RT_R))[2 * row + 1] = rk1;
            ((float*)(F.ws + WS_ROUTE + RT_W))[row] = my_w; }
    }
}

__device__ __forceinline__ void phase_moe_scatter(Frame& F, int jr, int nrows, const unsigned char* U, unsigned char* AM, int rowb, const float* sa_src, float* sa_dst) {
    const unsigned* ecnt = (const unsigned*)(F.ws + WS_CTL) + CW_ECNT + jr * 8 * 64;
    int base[8]; int acc = 0;
#pragma unroll
    for (int e = 0; e < 8; ++e) { const int c = (int)__hip_atomic_load(ecnt + e * 64, RLX_AGENT); base[e] = acc; acc += (c + 255) & ~255; }
    int* pexp = (int*)(F.ws + WS_SMALL + SM_PEXP);
    if (F.bid == 0) { const int np = acc >> 8;
        for (int p = F.tid; p < np; p += NTHR) { int e = 0;
#pragma unroll
            for (int q = 1; q < 8; ++q) if (p * 256 >= base[q]) e = q;
            pexp[p] = e; }
        if (F.tid == 0) pexp[MOE_PANELS] = np; }
    const int gw = F.bid * NWAVES + F.wave, NGW = F.G * NWAVES;
    const int R = (nrows + NGW - 1) / NGW; const int r0 = gw * R; int r1 = r0 + R; if (r1 > nrows) r1 = nrows;
    int* rr = (int*)(F.ws + WS_ROUTE + RT_R); const int* re = (const int*)(F.ws + WS_ROUTE + RT_E);
    for (int row = r0; row < r1; ++row) {
        const int ee = re[row], e0 = ee & 255, e1 = ee >> 8; int b0 = 0, b1 = 0;
#pragma unroll
        for (int e = 0; e < 8; ++e) { if (e0 == e) b0 = base[e]; if (e1 == e) b1 = base[e]; }
        const int p0 = b0 + rr[2 * row], p1 = b1 + rr[2 * row + 1];
        const v4u* src = (const v4u*)(U + (size_t)row * rowb); v4u* d0 = (v4u*)(AM + (size_t)p0 * rowb); v4u* d1 = (v4u*)(AM + (size_t)p1 * rowb);
        const v4u a = src[F.lane]; d0[F.lane] = a; d1[F.lane] = a;
        if (rowb > 1024) { const v4u c = src[F.lane + 64]; d0[F.lane + 64] = c; d1[F.lane + 64] = c; }
        CFENCE();
        if (F.lane == 0) { rr[2 * row] = p0; rr[2 * row + 1] = p1; if (sa_src) { const float s = sa_src[row]; sa_dst[p0] = s; sa_dst[p1] = s; } }
    }
}

#define MFMA32(a, b, c) __builtin_amdgcn_mfma_f32_32x32x16_bf16((a), (b), (c), 0, 0, 0)
typedef short v4i16_t __attribute__((ext_vector_type(4)));
typedef LAS unsigned char* ldsp;
__device__ __forceinline__ unsigned cvtpk(float lo, float hi) { f32x2_t v = {lo, hi}; bf16x2_t b = __builtin_convertvector(v, bf16x2_t); return __builtin_bit_cast(unsigned, b); }
__device__ __forceinline__ int crow(int reg, int h) { return (reg & 3) + 8 * (reg >> 2) + 4 * h; }
__device__ __forceinline__ bf16x8 pack8(const f32x16& x, int s) {
    v4u p; p.x = cvtpk(x[8 * s], x[8 * s + 1]); p.y = cvtpk(x[8 * s + 2], x[8 * s + 3]); p.z = cvtpk(x[8 * s + 4], x[8 * s + 5]); p.w = cvtpk(x[8 * s + 6], x[8 * s + 7]);
    return __builtin_bit_cast(bf16x8, p);
}
__device__ __forceinline__ bf16x8 lds16(ldsp p) { return *(const LAS bf16x8*)p; }
__device__ __forceinline__ bf16x8 lds8x2(ldsp p) { const s16x4 lo = *(const LAS s16x4*)p, hi = *(const LAS s16x4*)(p + 16); return __builtin_shufflevector(lo, hi, 0, 1, 2, 3, 4, 5, 6, 7); }
__device__ __forceinline__ s16x4 tr16(ldsp p) { return __builtin_bit_cast(s16x4, __builtin_amdgcn_ds_read_tr16_b64_v4i16((LAS v4i16_t*)p)); }
__device__ __forceinline__ bf16x8 ldstr2(ldsp p, int second) { const s16x4 lo = tr16(p), hi = tr16(p + second); return __builtin_shufflevector(lo, hi, 0, 1, 2, 3, 4, 5, 6, 7); }
__device__ __forceinline__ f32x16 zero16() { f32x16 z;
#pragma unroll
    for (int i = 0; i < 16; ++i) z[i] = 0.f; return z; }
__device__ __forceinline__ void unpack8(const v4u& w, float (&x)[8]) { x[0] = bflo(w.x); x[1] = bfhi(w.x); x[2] = bflo(w.y); x[3] = bfhi(w.y); x[4] = bflo(w.z); x[5] = bfhi(w.z); x[6] = bflo(w.w); x[7] = bfhi(w.w); }
__device__ __forceinline__ int launder_v(int x) { asm volatile("" : "+v"(x)); return x; }
struct FragOff { int o_row, o_perm, o_trn, o_trp; };
__device__ __forceinline__ FragOff frag_off(int lane, int LD) {
    const int r = lane & 31, hh = lane >> 5, i16 = lane & 15, q = i16 >> 2, p = i16 & 3, blk = (lane >> 4) & 1; FragOff f;
    f.o_row = (r * LD + 8 * hh) * 2; f.o_perm = (r * LD + 4 * hh) * 2;
    f.o_trn = ((8 * hh + q) * LD + 16 * blk + 4 * p) * 2; f.o_trp = ((4 * hh + q) * LD + 16 * blk + 4 * p) * 2; return f;
}


template <int CTRL, int RM, int BM> __device__ __forceinline__ float dpp_f(float old, float x) {
    return __builtin_bit_cast(float, __builtin_amdgcn_update_dpp(__builtin_bit_cast(int, old), __builtin_bit_cast(int, x), CTRL, RM, BM, false)); }
__device__ __forceinline__ float wave_scan_add(float x) {
    float r = x;
    r += dpp_f<0x111, 0xf, 0xf>(0.f, x); r += dpp_f<0x112, 0xf, 0xf>(0.f, x); r += dpp_f<0x113, 0xf, 0xf>(0.f, x);
    r += dpp_f<0x114, 0xf, 0xe>(0.f, r); r += dpp_f<0x118, 0xf, 0xc>(0.f, r);
    r += dpp_f<0x142, 0xa, 0xf>(0.f, r); r += dpp_f<0x143, 0xc, 0xf>(0.f, r);
    return r;
}
__device__ __forceinline__ float wave_scan_max(float x) {
    const float NEG = -3.0e38f; float r = x;
    r = fmaxf(r, dpp_f<0x111, 0xf, 0xf>(NEG, x)); r = fmaxf(r, dpp_f<0x112, 0xf, 0xf>(NEG, x)); r = fmaxf(r, dpp_f<0x113, 0xf, 0xf>(NEG, x));
    r = fmaxf(r, dpp_f<0x114, 0xf, 0xe>(NEG, r)); r = fmaxf(r, dpp_f<0x118, 0xf, 0xc>(NEG, r));
    r = fmaxf(r, dpp_f<0x142, 0xa, 0xf>(NEG, r)); r = fmaxf(r, dpp_f<0x143, 0xc, 0xf>(NEG, r));
    return r;
}
__device__ __forceinline__ float lane63(float x) { return __builtin_bit_cast(float, __builtin_amdgcn_readlane(__builtin_bit_cast(int, x), 63)); }
__device__ __forceinline__ float sum_halves(float x) {
    const unsigned u = __builtin_bit_cast(unsigned, x); auto rr = __builtin_amdgcn_permlane32_swap(u, u, false, false);
    return __builtin_bit_cast(float, (unsigned)rr[0]) + __builtin_bit_cast(float, (unsigned)rr[1]); }

__device__ __forceinline__ void item_headnorm(int tid, const bf16* hf, const bf16* hb, const bf16* gate, int gpitch, int gcol, const float* gh_head, bf16* aout, int rowbase, int t0, int ntok, int h) {
    VM_WAIT(); __syncthreads();
    const int sub = tid & 7, rr = tid >> 3;
    float gh[16];
#pragma unroll
    for (int e = 0; e < 16; ++e) gh[e] = gh_head[sub * 16 + e];
#pragma unroll 4
    for (int row = rr; row < ntok; row += 64) {
        const size_t grow = (size_t)(rowbase + t0 + row);
        const size_t o = grow * D + h * 128 + sub * 16;
        const v4u a0 = *(const GAS v4u*)(hf + o), a1 = *(const GAS v4u*)(hf + o + 8), b0 = *(const GAS v4u*)(hb + o), b1 = *(const GAS v4u*)(hb + o + 8);
        const bf16* gp = gate + grow * gpitch + gcol + h * 128 + sub * 16; const v4u g0 = *(const GAS v4u*)gp, g1 = *(const GAS v4u*)(gp + 8);
        float x[16], y[8];
        unpack8(a0, y);
#pragma unroll
        for (int e = 0; e < 8; ++e) x[e] = y[e];
        unpack8(a1, y);
#pragma unroll
        for (int e = 0; e < 8; ++e) x[8 + e] = y[e];
        unpack8(b0, y);
#pragma unroll
        for (int e = 0; e < 8; ++e) x[e] += y[e];
        unpack8(b1, y);
#pragma unroll
        for (int e = 0; e < 8; ++e) x[8 + e] += y[e];
        float ss = 0.f;
#pragma unroll
        for (int e = 0; e < 16; ++e) ss += x[e] * x[e];
        ss += __shfl_xor(ss, 1); ss += __shfl_xor(ss, 2); ss += __shfl_xor(ss, 4);
        const float rs = rsqrtf(ss * (1.f / 128.f) + EPS);
        float o16[16];
        unpack8(g0, y);
#pragma unroll
        for (int e = 0; e < 8; ++e) o16[e] = x[e] * rs * gh[e] * sigmoidf_(y[e]);
        unpack8(g1, y);
#pragma unroll
        for (int e = 0; e < 8; ++e) o16[8 + e] = x[8 + e] * rs * gh[8 + e] * sigmoidf_(y[e]);
        v4u w0, w1; w0.x = pk2(o16[0], o16[1]); w0.y = pk2(o16[2], o16[3]); w0.z = pk2(o16[4], o16[5]); w0.w = pk2(o16[6], o16[7]); w1.x = pk2(o16[8], o16[9]); w1.y = pk2(o16[10], o16[11]); w1.z = pk2(o16[12], o16[13]); w1.w = pk2(o16[14], o16[15]);
        *(GAS v4u*)(aout + o) = w0; *(GAS v4u*)(aout + o + 8) = w1;
    }
}

#ifndef SCAN_PF_OUT
#define SCAN_PF_OUT 1
#endif
constexpr int ML_LDQ = 72, ML_LDV = 136;
constexpr int ML_QC = 0, ML_KC = 9216, ML_KH = 18432, ML_V = 27648, ML_GS = 45056, ML_OB = 50176, ML_NV = 68608, ML_SSQ = 70656, ML_INV = 71680, ML_GROUP = 73728;
static_assert(2 * ML_GROUP <= LDS_MAIN, "mLSTM LDS map");
constexpr int ML_STATE_F = 8448;

struct MlPref { v4u q[2], k[2], v[4]; float gi, gf; };
struct MlSeg { int rowbase; int len; int t0; int nchunk; };

__device__ __forceinline__ void ml_issue(MlPref& P, const bf16* proj, const bf16* qkc, const float* gates, int rowbase, int t0c, int g, int h, int tg, int lane, bool need_q) {
    const int c8q = tg & 7;
#pragma unroll
    for (int i = 0; i < 2; ++i) { const int tau = (tg + 256 * i) >> 3; const int t = t0c + (g ? 63 - tau : tau);
        const bf16* rp = qkc + (size_t)(rowbase + t) * D + h * 64 + c8q * 8;
        P.q[i] = need_q ? *(const GAS v4u*)rp : (v4u){0u, 0u, 0u, 0u}; P.k[i] = *(const GAS v4u*)(rp + 512); }
#pragma unroll
    for (int i = 0; i < 4; ++i) { const int p = tg + 256 * i, tau = p >> 4, c8 = p & 15; const int t = t0c + (g ? 63 - tau : tau);
        P.v[i] = *(const GAS v4u*)(proj + (size_t)(rowbase + t) * NP_M + 1024 + h * 128 + c8 * 8); }
    { const int t = t0c + (g ? 63 - lane : lane); const GAS float* gp = (const GAS float*)(gates + (size_t)(rowbase + t) * 32 + g * 16 + h); P.gi = gp[0]; P.gf = gp[8]; }
}

template <bool OUTPUT>
__device__ __forceinline__ void mlstm_item(Frame& F, const bf16* proj, const bf16* qkc, const float* gates, bf16* hx0, bf16* hx1, bf16* aout, const float* ghead,
                                           int h, MlSeg S0, MlSeg S1, const float* st_in0, const float* st_in1, int npre0, int npre1, float* st_out0, float* st_out1) {
    const int tid_l = launder_v(F.tid); const int wave_l = __builtin_amdgcn_readfirstlane(tid_l >> 6);
    const int g = wave_l >> 2, j = wave_l & 3, tg = tid_l & 255, lane = tid_l & 63, r = lane & 31, hh = lane >> 5;
    const ldsp gb = F.lds + g * ML_GROUP;
    const ldsp GSb = gb + ML_GS + j * 1280;
    LAS float* GS = (LAS float*)GSb;
    const ldsp OBb = gb + ML_OB + j * 4608;
    LAS float* NV = (LAS float*)(gb + ML_NV);
    LAS float* SSQ = (LAS float*)(gb + ML_SSQ);
    const ldsp INVb = gb + ML_INV + j * 256;
    const int rowbase = g ? S1.rowbase : S0.rowbase, seg_t0 = g ? S1.t0 : S0.t0, nch = g ? S1.nchunk : S0.nchunk;
    const int vcol = 64 * j;
    __syncthreads();
    f32x16 C[2]; C[0] = zero16(); C[1] = zero16();
    float m_prev = -1.0e30f, btot = 0.f;
    float nreg = 0.f;
    if (OUTPUT) {
        const float* sp = g ? st_in1 : st_in0; const int np = g ? npre1 : npre0;
#pragma unroll 1
        for (int k = 0; k < np; ++k) { const float* e = sp + (size_t)k * ML_STATE_F;
            const float mloc = e[8192 + 64], B = e[8192 + 65];
            const float mnew = fmaxf(B + m_prev, mloc), al = __expf(B + m_prev - mnew), be = __expf(mloc - mnew);
            const float* ep = e + (4 * hh) * 128 + 32 * j + r;
#pragma unroll
            for (int dt = 0; dt < 2; ++dt)
#pragma unroll
                for (int i = 0; i < 16; ++i) C[dt][i] = al * C[dt][i] + be * ep[(32 * dt + (i & 3) + 8 * (i >> 2)) * 128];
            nreg = al * nreg + be * e[8192 + 16 * j + (lane & 15)];
            m_prev = mnew; }
    }
    if (lane < 16) NV[16 * j + lane] = nreg;
    constexpr int NPF = OUTPUT ? SCAN_PF_OUT : 2;
    MlPref PP[NPF]; ml_issue(PP[0], proj, qkc, gates, rowbase, seg_t0 + 64 * (g ? nch - 1 : 0), g, h, tg, lane, OUTPUT);
    if (NPF == 2) ml_issue(PP[NPF - 1], proj, qkc, gates, rowbase, seg_t0 + 64 * (g ? nch - 2 : 1), g, h, tg, lane, OUTPUT);
    __syncthreads();
#pragma unroll 1
    for (int step2 = 0; step2 < nch; step2 += NPF) {
#pragma unroll
    for (int hf = 0; hf < NPF; ++hf) { const int step = step2 + hf; MlPref& P = PP[hf];
        const int tgs = launder_v(tg), lns = launder_v(lane);
        const int r = lns & 31, hh = lns >> 5;
        const FragOff fq = frag_off(lns, ML_LDQ), fv = frag_off(lns, ML_LDV);
        const int o_h4 = 16 * hh;
        const int o_obw = (4 * hh * 36 + r) * 4, o_obr = ((lns >> 1) * 36 + 16 * (lns & 1)) * 4;
        const int ci = g ? nch - 1 - step : step;
        const int par = step & 1;
        float decay;
        {
            const float xi = P.gi, lf = P.gf;
            const float bc = wave_scan_add(lf);
            const float a = xi - bc; const float pm = wave_scan_max(a);
            const float Mt = fmaxf(m_prev, pm);
            const float Ml = lane63(Mt), bl = lane63(bc);
            GS[lns] = __expf(fminf(Ml - Mt, 80.f)); GS[192 + lns] = __expf(-(bc + Mt)); GS[256 + lns] = __expf(a - Ml);
            decay = __expf(m_prev - Ml); m_prev = bl + Ml; btot += bl;
        }
        LDS_WAIT(); CFENCE();
        {
            const int c8 = tgs & 7;
#pragma unroll
            for (int i = 0; i < 2; ++i) { const int tau = (tgs + 256 * i) >> 3; const ldsp tp = gb + (tau * ML_LDQ + c8 * 8) * 2; float o[8]; v4u w;
                if (OUTPUT) { unpack8(P.q[i], o); const float qs = GS[tau];
                    w.x = pk2(o[0] * qs, o[1] * qs); w.y = pk2(o[2] * qs, o[3] * qs); w.z = pk2(o[4] * qs, o[5] * qs); w.w = pk2(o[6] * qs, o[7] * qs); *(LAS v4u*)(tp + ML_QC) = w; }
                unpack8(P.k[i], o); const float wkk = GS[256 + tau];
                w.x = pk2(o[0] * wkk, o[1] * wkk); w.y = pk2(o[2] * wkk, o[3] * wkk); w.z = pk2(o[4] * wkk, o[5] * wkk); w.w = pk2(o[6] * wkk, o[7] * wkk);
                *(LAS v4u*)(tp + ML_KH) = w; }
#pragma unroll
            for (int i = 0; i < 4; ++i) { const int p = tgs + 256 * i, tau = p >> 4, cc = p & 15; *(LAS v4u*)(gb + ML_V + (tau * ML_LDV + cc * 8) * 2) = P.v[i]; }
        }
        if (step + NPF < nch) ml_issue(P, proj, qkc, gates, rowbase, seg_t0 + 64 * (g ? nch - 1 - NPF - step : step + NPF), g, h, tgs, lns, OUTPUT);
        __syncthreads();
#pragma unroll
        for (int dt = 0; dt < 2; ++dt)
#pragma unroll
            for (int i = 0; i < 16; ++i) C[dt][i] *= decay;
        if (OUTPUT) {
            bf16* hx = g ? hx1 : hx0;
#pragma unroll
            for (int tt = 0; tt < 2; ++tt) {
                f32x16 acc = zero16();
#pragma unroll
                for (int dt = 0; dt < 2; ++dt)
#pragma unroll
                    for (int sp = 0; sp < 2; ++sp) acc = MFMA32(lds8x2(gb + ML_QC + fq.o_perm + (32 * tt * ML_LDQ + 32 * dt + 16 * sp) * 2), pack8(C[dt], sp), acc);
                float den = 0.f;
#pragma unroll
                for (int st = 0; st <= tt; ++st) {
                    f32x16 s = zero16();
#pragma unroll
                    for (int ks = 0; ks < 4; ++ks) s = MFMA32(lds16(gb + ML_KH + fq.o_row + (32 * st * ML_LDQ + 16 * ks) * 2), lds16(gb + ML_QC + fq.o_row + (32 * tt * ML_LDQ + 16 * ks) * 2), s);
#pragma unroll
                    for (int i = 0; i < 16; ++i) { const float pv = (st < tt || crow(i, hh) <= r) ? s[i] : 0.f; s[i] = pv; den += pv; }
                    const bf16x8 pa0 = pack8(s, 0), pa1 = pack8(s, 1);
                    acc = MFMA32(pa0, ldstr2(gb + ML_V + fv.o_trp + vcol + ((32 * st) * ML_LDV) * 2, 8 * ML_LDV * 2), acc);
                    acc = MFMA32(pa1, ldstr2(gb + ML_V + fv.o_trp + vcol + ((32 * st + 16) * ML_LDV) * 2, 8 * ML_LDV * 2), acc);
                    }
                float qn;
                { float q0 = 0.f, q1 = 0.f, q2 = 0.f, q3 = 0.f;
#pragma unroll
                for (int c4 = 0; c4 < 4; ++c4) { const v4u qw = *(const LAS v4u*)(gb + ML_QC + (r * ML_LDQ + 32 * hh) * 2 + (32 * tt * ML_LDQ + 8 * c4) * 2); float qx[8]; unpack8(qw, qx);
                    const f32x4 n0 = *(const LAS f32x4*)(gb + ML_NV + 8 * o_h4 + (par * 64 + 8 * c4) * 4), n1 = *(const LAS f32x4*)(gb + ML_NV + 8 * o_h4 + (par * 64 + 8 * c4 + 4) * 4);
                    q0 += qx[0] * n0[0] + qx[4] * n1[0]; q1 += qx[1] * n0[1] + qx[5] * n1[1]; q2 += qx[2] * n0[2] + qx[6] * n1[2]; q3 += qx[3] * n0[3] + qx[7] * n1[3]; }
                qn = (q0 + q1) + (q2 + q3); }
                den = sum_halves(den); qn = sum_halves(qn);
                const float dtot = den + decay * qn;
                const float inv = __builtin_amdgcn_rcpf(fmaxf(fabsf(dtot), GS[192 + 32 * tt + r]));
                if (hh == 0) *(LAS float*)(INVb + (32 * tt + r) * 4) = inv;
                LDS_WAIT(); CFENCE();
                f32x16 hv;
#pragma unroll
                for (int q4 = 0; q4 < 4; ++q4) { const f32x4 iv = *(const LAS f32x4*)(INVb + o_h4 + (32 * tt + 8 * q4) * 4);
#pragma unroll
                    for (int e = 0; e < 4; ++e) { const int i = 4 * q4 + e; hv[i] = acc[i] * iv[e]; } }
#pragma unroll
                for (int i = 0; i < 16; ++i) *(LAS float*)(OBb + o_obw + ((i & 3) + 8 * (i >> 2)) * 144) = hv[i];
                LDS_WAIT(); CFENCE();
                { const f32x4 x0 = *(const LAS f32x4*)(OBb + o_obr), x1 = *(const LAS f32x4*)(OBb + o_obr + 16), x2 = *(const LAS f32x4*)(OBb + o_obr + 32), x3 = *(const LAS f32x4*)(OBb + o_obr + 48);
                    const int tau = 32 * tt + (lns >> 1); const int t = seg_t0 + 64 * ci + (g ? 63 - tau : tau);
                    bf16* op = hx + (size_t)(rowbase + t) * D + h * 128 + 32 * j + 16 * (lns & 1);
                    v4u w0, w1; w0.x = pk2(x0[0], x0[1]); w0.y = pk2(x0[2], x0[3]); w0.z = pk2(x1[0], x1[1]); w0.w = pk2(x1[2], x1[3]); w1.x = pk2(x2[0], x2[1]); w1.y = pk2(x2[2], x2[3]); w1.z = pk2(x3[0], x3[1]); w1.w = pk2(x3[2], x3[3]);
                    *(GAS v4u*)op = w0; *(GAS v4u*)(op + 8) = w1; }
                LDS_WAIT(); CFENCE();
            }
        }
        __builtin_amdgcn_sched_barrier(0);
#pragma unroll
        for (int dt = 0; dt < 2; ++dt)
#pragma unroll
            for (int ks = 0; ks < 4; ++ks) C[dt] = MFMA32(ldstr2(gb + ML_KH + fq.o_trn + (16 * ks * ML_LDQ + 32 * dt) * 2, 4 * ML_LDQ * 2), ldstr2(gb + ML_V + fv.o_trn + vcol + (16 * ks * ML_LDV) * 2, 4 * ML_LDV * 2), C[dt]);
        {   const int dkl = 16 * j + (lns & 15), tq = lns >> 4; float s0 = 0.f, s1 = 0.f;
#pragma unroll
            for (int i = 0; i < 16; i += 2) { s0 += bf2f(*(const LAS bf16*)(gb + ML_KH + ((16 * tq + i) * ML_LDQ + dkl) * 2)); s1 += bf2f(*(const LAS bf16*)(gb + ML_KH + ((16 * tq + i + 1) * ML_LDQ + dkl) * 2)); }
            float sacc = s0 + s1; sacc += __shfl_xor(sacc, 16); sacc = sum_halves(sacc);
            nreg = decay * nreg + sacc; if (lns < 16) NV[(par ^ 1) * 64 + dkl] = nreg; }
        __syncthreads();
    } }
    if (OUTPUT) item_headnorm(launder_v(tid_l), hx0, hx1, proj, NP_M, 2048, ghead + h * 128, aout, S0.rowbase, S0.t0, S0.nchunk * 64, h);
    if (!OUTPUT) {
        float* e = g ? st_out1 : st_out0; float* ep = e + (4 * hh) * 128 + 32 * j + r;
#pragma unroll
        for (int dt = 0; dt < 2; ++dt)
#pragma unroll
            for (int i = 0; i < 16; ++i) ep[(32 * dt + (i & 3) + 8 * (i >> 2)) * 128] = C[dt][i];
        if (lane < 16) e[8192 + 16 * j + lane] = nreg;
        if (j == 0 && lane == 0) { e[8192 + 64] = m_prev; e[8192 + 65] = btot; }
    }
}

constexpr int MS_KH = 0, MS_V = 9216, MS_BUF = 26624, MS_W = 2 * MS_BUF  ;
static_assert(MS_W + 34 * 64 * 4 <= ML_GROUP, "mLSTM S1 LDS map");
struct MsPref { v4u k[2], v[4]; };
__device__ __forceinline__ void ms_issue(MsPref& P, const bf16* proj, const bf16* qkc, int rowbase, int t0c, int g, int h, int tg) {
    const int c8q = tg & 7;
#pragma unroll
    for (int i = 0; i < 2; ++i) { const int tau = (tg + 256 * i) >> 3; const int t = t0c + (g ? 63 - tau : tau);
        P.k[i] = *(const GAS v4u*)(qkc + (size_t)(rowbase + t) * D + 512 + h * 64 + c8q * 8); }
#pragma unroll
    for (int i = 0; i < 4; ++i) { const int p = tg + 256 * i, tau = p >> 4, c8 = p & 15; const int t = t0c + (g ? 63 - tau : tau);
        P.v[i] = *(const GAS v4u*)(proj + (size_t)(rowbase + t) * NP_M + 1024 + h * 128 + c8 * 8); }
}
__device__ __forceinline__ void mlstm_s1_item(Frame& F, const bf16* proj, const bf16* qkc, const float* gates, int h, MlSeg S0, MlSeg S1, float* st_out0, float* st_out1) {
    const int tid_l = launder_v(F.tid); const int wave_l = __builtin_amdgcn_readfirstlane(tid_l >> 6);
    const int g = wave_l >> 2, j = wave_l & 3, tg = tid_l & 255, lane = tid_l & 63, r = lane & 31, hh = lane >> 5;
    const ldsp gb = F.lds + g * ML_GROUP;
    LAS float* W = (LAS float*)(gb + MS_W);
    const int rowbase = g ? S1.rowbase : S0.rowbase, seg_t0 = g ? S1.t0 : S0.t0, nch = g ? S1.nchunk : S0.nchunk;
    __syncthreads();
    MsPref PP[2]; ms_issue(PP[0], proj, qkc, rowbase, seg_t0 + 64 * (g ? nch - 1 : 0), g, h, tg);
    ms_issue(PP[1], proj, qkc, rowbase, seg_t0 + 64 * (g ? nch - 2 : 1), g, h, tg);
    float m_loc, btot;
    {
        float carry = 0.f, mx = -3.0e38f;
#pragma unroll 1
        for (int c = 0; c < nch; ++c) { const int ci = g ? nch - 1 - c : c; const int t = seg_t0 + 64 * ci + (g ? 63 - lane : lane);
            const GAS float* gp = (const GAS float*)(gates + (size_t)(rowbase + t) * 32 + g * 16 + h); const float xi = gp[0], lf = gp[8];
            const float bc = carry + wave_scan_add(lf); const float a = xi - bc;
            if (j == 0) W[64 * c + lane] = a;
            mx = fmaxf(mx, a); carry = lane63(bc); }
        mx = fmaxf(mx, __shfl_xor(mx, 1)); mx = fmaxf(mx, __shfl_xor(mx, 2)); mx = fmaxf(mx, __shfl_xor(mx, 4)); mx = fmaxf(mx, __shfl_xor(mx, 8)); mx = fmaxf(mx, __shfl_xor(mx, 16)); mx = fmaxf(mx, __shfl_xor(mx, 32));
        btot = carry; m_loc = btot + mx;
        __syncthreads();
        for (int s = tg; s < 64 * nch; s += 256) W[s] = __expf(W[s] - mx);
    }
    f32x16 C[2]; C[0] = zero16(); C[1] = zero16(); float nreg = 0.f;
    __syncthreads();
#pragma unroll 1
    for (int step2 = 0; step2 < nch; step2 += 2) {
#pragma unroll
    for (int hf = 0; hf < 2; ++hf) { const int step = step2 + hf; MsPref& P = PP[hf];
        const int tgs = launder_v(tg), lns = launder_v(lane);
        const FragOff fq = frag_off(lns, ML_LDQ), fv = frag_off(lns, ML_LDV);
        const ldsp bb = gb + hf * MS_BUF;
        {   const int c8 = tgs & 7;
#pragma unroll
            for (int i = 0; i < 2; ++i) { const int tau = (tgs + 256 * i) >> 3; float o[8]; unpack8(P.k[i], o); const float wkk = W[64 * step + tau]; v4u w;
                w.x = pk2(o[0] * wkk, o[1] * wkk); w.y = pk2(o[2] * wkk, o[3] * wkk); w.z = pk2(o[4] * wkk, o[5] * wkk); w.w = pk2(o[6] * wkk, o[7] * wkk);
                *(LAS v4u*)(bb + MS_KH + (tau * ML_LDQ + c8 * 8) * 2) = w; }
#pragma unroll
            for (int i = 0; i < 4; ++i) { const int p = tgs + 256 * i, tau = p >> 4, cc = p & 15; *(LAS v4u*)(bb + MS_V + (tau * ML_LDV + cc * 8) * 2) = P.v[i]; }
        }
        if (step + 2 < nch) ms_issue(P, proj, qkc, rowbase, seg_t0 + 64 * (g ? nch - 3 - step : step + 2), g, h, tgs);
        __syncthreads();
#pragma unroll
        for (int dt = 0; dt < 2; ++dt)
#pragma unroll
            for (int ks = 0; ks < 4; ++ks) C[dt] = MFMA32(ldstr2(bb + MS_KH + fq.o_trn + (16 * ks * ML_LDQ + 32 * dt) * 2, 4 * ML_LDQ * 2), ldstr2(bb + MS_V + fv.o_trn + 64 * j + (16 * ks * ML_LDV) * 2, 4 * ML_LDV * 2), C[dt]);
        {   const int dkl = 16 * j + (lns & 15), tq = lns >> 4; float s0 = 0.f, s1 = 0.f;
#pragma unroll
            for (int i = 0; i < 16; i += 2) { s0 += bf2f(*(const LAS bf16*)(bb + MS_KH + ((16 * tq + i) * ML_LDQ + dkl) * 2)); s1 += bf2f(*(const LAS bf16*)(bb + MS_KH + ((16 * tq + i + 1) * ML_LDQ + dkl) * 2)); }
            float sacc = s0 + s1; sacc += __shfl_xor(sacc, 16); sacc = sum_halves(sacc); nreg += sacc; }
    } }
    float* e = g ? st_out1 : st_out0; float* ep = e + (4 * hh) * 128 + 32 * j + r;
#pragma unroll
    for (int dt = 0; dt < 2; ++dt)
#pragma unroll
        for (int i = 0; i < 16; ++i) ep[(32 * dt + (i & 3) + 8 * (i >> 2)) * 128] = C[dt][i];
    if (lane < 16) e[8192 + 16 * j + lane] = nreg;
    if (j == 0 && lane == 0) { e[8192 + 64] = m_loc; e[8192 + 65] = btot; }
}

constexpr int HG_LD = 136;
constexpr int HG_LF = 0, HG_QT = 16384, HG_KT = 25088, HG_KH = 33792, HG_V = 42496, HG_OB = 51200, HG_AUX = 69632, HG_SSQ = 71168, HG_EAM = 71680, HG_BIAS = 72192, HG_LBV = 72704, HG_GROUP = 73728;
static_assert(2 * HG_GROUP <= LDS_MAIN, "HGRN2 LDS map");
constexpr int HG_STATE_F = 16512;

struct HgPref { unsigned q[8], f[8]; v4u v[2]; };
__device__ __forceinline__ void hg_issue(HgPref& P, const bf16* proj, int rowbase, int t0c, int g, int h, int tg, bool need_q) {
    const int lane = tg & 63, j = tg >> 6, cp = lane & 15, tq = lane >> 4, c0 = 32 * j + 2 * cp;
#pragma unroll
    for (int i = 0; i < 8; ++i) { const int tau = 8 * tq + i; const int t = t0c + (g ? 31 - tau : tau);
        const bf16* rp = proj + (size_t)(rowbase + t) * NP_H + h * 128 + c0;
        P.q[i] = need_q ? *(const GAS unsigned*)rp : 0u; P.f[i] = *(const GAS unsigned*)(rp + 2048 + 1024 * g); }
#pragma unroll
    for (int i = 0; i < 2; ++i) { const int p = tg + 256 * i, tau = p >> 4, c8 = p & 15; const int t = t0c + (g ? 31 - tau : tau);
        P.v[i] = *(const GAS v4u*)(proj + (size_t)(rowbase + t) * NP_H + 1024 + h * 128 + c8 * 8); }
}
struct HgFin { v4u pa0, pa1, ga0, ga1; };
__device__ __forceinline__ void hg_issue_fin(HgFin& Fn, const bf16* part, const bf16* proj, int rowbase, int t0c, int g, int h, int j, int lns) {
    const int tau = lns >> 1; const int t = t0c + (g ? 31 - tau : tau); const int col = h * 128 + 32 * j + 16 * (lns & 1);
    const bf16* pp = part + (size_t)(rowbase + t) * D + col; const bf16* gp = proj + (size_t)(rowbase + t) * NP_H + 4096 + col;
    Fn.pa0 = *(const GAS v4u*)pp; Fn.pa1 = *(const GAS v4u*)(pp + 8); Fn.ga0 = *(const GAS v4u*)gp; Fn.ga1 = *(const GAS v4u*)(gp + 8);
}
__device__ __forceinline__ float clamp80(float x) { return fminf(fmaxf(x, -80.f), 80.f); }

template <bool OUTPUT>
__device__ __forceinline__ void hgrn_item(Frame& F, const bf16* proj, bf16* hx0, bf16* hx1, bf16* aout, const float* ghead, const float* bf_, const float* lbraw, int jl,
                                          int h, MlSeg S0, MlSeg S1, const float* st_in0, const float* st_in1, int npre0, int npre1, float* st_out0, float* st_out1) {
    const int tid_l = launder_v(F.tid); const int wave_l = __builtin_amdgcn_readfirstlane(tid_l >> 6);
    const int g = wave_l >> 2, j = wave_l & 3, tg = tid_l & 255, lane = tid_l & 63, r = lane & 31, hh = lane >> 5;
#ifdef SUBT
    unsigned long long _st = 0;
#define ST_MARK(slot) do { if (OUTPUT && tid_l == SUBT_TID) { const unsigned long long _n = wall_clock64(); volatile LAS unsigned* _w = (volatile LAS unsigned*)(F.lds + LDSCTL_OFF) + 40 + (slot); _w[0] += (unsigned)(_n - _st); _st = _n; } } while (0)
#else
#define ST_MARK(slot) do { } while (0)
#endif
    ST_MARK(7);
    const ldsp gb = F.lds + g * HG_GROUP;
    LAS float* LF = (LAS float*)(gb + HG_LF);
    const ldsp OBb = gb + HG_OB + j * 4608;
    LAS float* AMID = (LAS float*)(gb + HG_AUX); LAS float* ALAST = AMID + 128; LAS float* DEC = AMID + 256;
    LAS float* SSQ = (LAS float*)(gb + HG_SSQ); LAS float* EAM = (LAS float*)(gb + HG_EAM); LAS float* BIASV = (LAS float*)(gb + HG_BIAS); LAS float* LBV = (LAS float*)(gb + HG_LBV);
    const int rowbase = g ? S1.rowbase : S0.rowbase, seg_t0 = g ? S1.t0 : S0.t0, nch = g ? S1.nchunk : S0.nchunk;
    const int vcol = 64 * j;
    __syncthreads();
    if (OUTPUT && tg < 128) EAM[tg] = ghead[h * 128 + tg];
    if (tg < 128) { const int c = h * 128 + tg; BIASV[tg] = -1.44269504f * bf_[g * 1024 + c]; LBV[tg] = jl == 0 ? 0.f : sigmoidf_(lbraw[(1 * 2 + g) * 1024 + c] - lbraw[(0 * 2 + g) * 1024 + c]); }
    f32x16 St[4];
#pragma unroll
    for (int dt = 0; dt < 4; ++dt) St[dt] = zero16();
    float atot0 = 0.f, atot1 = 0.f;
    if (OUTPUT) {   const float* sp = g ? st_in1 : st_in0; const int np = g ? npre1 : npre0;
#pragma unroll 1
        for (int k = 0; k < np; ++k) { const float* e = sp + (size_t)k * HG_STATE_F; const float* ep = e + (4 * hh) * 128 + 32 * j + r; const float* ap = e + 16384 + 4 * hh;
#pragma unroll
            for (int dt = 0; dt < 4; ++dt)
#pragma unroll
                for (int i = 0; i < 16; ++i) { const int dk0 = 32 * dt + (i & 3) + 8 * (i >> 2); St[dt][i] = __builtin_amdgcn_exp2f(ap[dk0]) * St[dt][i] + ep[dk0 * 128]; } }
    }
    constexpr int NPF = OUTPUT ? SCAN_PF_OUT : 2;
    HgPref PP[NPF]; hg_issue(PP[0], proj, rowbase, seg_t0 + 32 * (g ? nch - 1 : 0), g, h, tg, OUTPUT);
    if (NPF == 2) hg_issue(PP[NPF - 1], proj, rowbase, seg_t0 + 32 * (g ? nch - 2 : 1), g, h, tg, OUTPUT);
    __syncthreads();
    ST_MARK(4);
    float yv[16]; bool pend = false; int pend_t = 0; HgFin FN; FN.pa0 = FN.pa1 = FN.ga0 = FN.ga1 = (v4u){0u, 0u, 0u, 0u};
#pragma unroll
    for (int e = 0; e < 16; ++e) yv[e] = 0.f;
    const int hmid = nch >> 1;
#pragma unroll 1
    for (int step2 = 0; step2 < nch; step2 += NPF) {
#pragma unroll
    for (int hf = 0; hf < NPF; ++hf) { const int step = step2 + hf; HgPref& P = PP[hf];
        const int tgs = launder_v(tg), lns = launder_v(lane);
        const int r = lns & 31, hh = lns >> 5;
        const FragOff fo = frag_off(lns, HG_LD);
        const int o_h4 = 16 * hh;
        const int o_obw = (4 * hh * 36 + r) * 4, o_obr = ((lns >> 1) * 36 + 16 * (lns & 1)) * 4;
        const int ci = g ? nch - 1 - step : step;
        ST_MARK(7);
        if (OUTPUT && pend) {
            const f32x4 sq = *(const LAS f32x4*)(SSQ + 4 * (lns >> 1)); const float rs = rsqrtf(((sq[0] + sq[1]) + (sq[2] + sq[3])) * (1.f / 128.f) + EPS);
            bf16* op = aout + (size_t)(rowbase + pend_t + (g ? 31 - (lns >> 1) : (lns >> 1))) * D + h * 128 + 32 * j + 16 * (lns & 1);
            v4u w0, w1; w0.x = pk2(yv[0] * rs, yv[1] * rs); w0.y = pk2(yv[2] * rs, yv[3] * rs); w0.z = pk2(yv[4] * rs, yv[5] * rs); w0.w = pk2(yv[6] * rs, yv[7] * rs);
            w1.x = pk2(yv[8] * rs, yv[9] * rs); w1.y = pk2(yv[10] * rs, yv[11] * rs); w1.z = pk2(yv[12] * rs, yv[13] * rs); w1.w = pk2(yv[14] * rs, yv[15] * rs);
            *(GAS v4u*)op = w0; *(GAS v4u*)(op + 8) = w1; pend = false; }
        {
            const int cp = lns & 15, tq = lns >> 4, c0 = 32 * j + 2 * cp;
            const f32x2_t bb = *(const LAS f32x2_t*)(BIASV + c0), ll = *(const LAS f32x2_t*)(LBV + c0);
            const float ol0 = 1.f - ll.x, ol1 = 1.f - ll.y;
            float F0[8], F1[8], f0v[8], f1v[8]; float p0 = 1.f, p1 = 1.f;
#pragma unroll
            for (int i = 0; i < 8; ++i) { const float s0 = __builtin_amdgcn_rcpf(1.f + __builtin_amdgcn_exp2f(__builtin_fmaf(bflo(P.f[i]), -1.44269504f, bb.x))), s1 = __builtin_amdgcn_rcpf(1.f + __builtin_amdgcn_exp2f(__builtin_fmaf(bfhi(P.f[i]), -1.44269504f, bb.y)));
                const float f0 = fmaxf(__builtin_fmaf(ol0, s0, ll.x), 3.0517578125e-5f), f1 = fmaxf(__builtin_fmaf(ol1, s1, ll.y), 3.0517578125e-5f);
                p0 *= f0; p1 *= f1; F0[i] = p0; F1[i] = p1; f0v[i] = f0; f1v[i] = f1; }
            const float r0 = __builtin_amdgcn_logf(p0), r1 = __builtin_amdgcn_logf(p1);
            LAS f32x2_t* XT = (LAS f32x2_t*)(gb + HG_LF + j * 512);
            XT[tq * 16 + cp] = (f32x2_t){r0, r1};
            LDS_WAIT(); CFENCE();
            const f32x2_t t0 = XT[cp], t1 = XT[16 + cp], t2 = XT[32 + cp], t3 = XT[48 + cp];
            LDS_WAIT(); CFENCE();
            const float al0 = (t0.x + t1.x) + (t2.x + t3.x), al1 = (t0.y + t1.y) + (t2.y + t3.y);
            const float pre0 = (tq > 0 ? t0.x : 0.f) + (tq > 1 ? t1.x : 0.f) + (tq > 2 ? t2.x : 0.f), pre1 = (tq > 0 ? t0.y : 0.f) + (tq > 1 ? t1.y : 0.f) + (tq > 2 ? t2.y : 0.f);
            if (tq == 0) { *(LAS f32x2_t*)(DEC + c0) = (f32x2_t){__builtin_amdgcn_exp2f(al0), __builtin_amdgcn_exp2f(al1)}; atot0 += al0; atot1 += al1; }
            const float G0 = OUTPUT ? __builtin_amdgcn_exp2f(fminf(pre0 - al0, 115.f)) : 0.f, G1 = OUTPUT ? __builtin_amdgcn_exp2f(fminf(pre1 - al1, 115.f)) : 0.f;
            float h0 = __builtin_amdgcn_exp2f(al0 - pre0 - r0), h1 = __builtin_amdgcn_exp2f(al1 - pre1 - r1);
#pragma unroll
            for (int i = 7; i >= 0; --i) { const int tau = 8 * tq + i; const ldsp tp = gb + (tau * HG_LD + c0) * 2;
                if (OUTPUT) *(LAS unsigned*)(tp + HG_QT) = pk2(bflo(P.q[i]) * (F0[i] * G0), bfhi(P.q[i]) * (F1[i] * G1));
                *(LAS unsigned*)(tp + HG_KH) = pk2((1.f - f0v[i]) * h0, (1.f - f1v[i]) * h1);
                h0 *= f0v[i]; h1 *= f1v[i]; }
#pragma unroll
            for (int i = 0; i < 2; ++i) { const int p = tgs + 256 * i; *(LAS v4u*)(gb + HG_V + ((p >> 4) * HG_LD + (p & 15) * 8) * 2) = P.v[i]; }
        }
        ST_MARK(0);
        if (OUTPUT) VM_WAIT();
        __syncthreads();
        ST_MARK(1);
        if (step + NPF < nch) hg_issue(P, proj, rowbase, seg_t0 + 32 * (g ? nch - 1 - NPF - step : step + NPF), g, h, tgs, OUTPUT);
        const bool fin = OUTPUT && step > hmid;
        {   f32x4 dvv[16];
#pragma unroll
            for (int dt = 0; dt < 4; ++dt)
#pragma unroll
                for (int q4 = 0; q4 < 4; ++q4) dvv[4 * dt + q4] = *(const LAS f32x4*)(gb + HG_AUX + 1024 + o_h4 + (32 * dt + 8 * q4) * 4);
            __builtin_amdgcn_sched_barrier(0);
#pragma unroll
            for (int dt = 0; dt < 4; ++dt)
#pragma unroll
                for (int q4 = 0; q4 < 4; ++q4)
#pragma unroll
                    for (int e = 0; e < 4; ++e) St[dt][4 * q4 + e] *= dvv[4 * dt + q4][e]; }
        if (OUTPUT) {
            bf16* hx = g ? hx1 : hx0;
            f32x16 s = zero16(), o = zero16();
            {   bf16x8 ka[8], qa[8];
#pragma unroll
                for (int ks = 0; ks < 8; ++ks) { ka[ks] = lds16(gb + HG_KH + fo.o_row + 32 * ks); qa[ks] = lds16(gb + HG_QT + fo.o_row + 32 * ks); }
                __builtin_amdgcn_sched_barrier(0);
#pragma unroll
                for (int ks = 0; ks < 8; ++ks) s = MFMA32(ka[ks], qa[ks], s); }
            {   bf16x8 qp[8];
#pragma unroll
                for (int dt = 0; dt < 4; ++dt)
#pragma unroll
                    for (int sp = 0; sp < 2; ++sp) qp[2 * dt + sp] = lds8x2(gb + HG_QT + fo.o_perm + (32 * dt + 16 * sp) * 2);
                const bf16x8 v0 = ldstr2(gb + HG_V + fo.o_trp + vcol, 8 * HG_LD * 2), v1 = ldstr2(gb + HG_V + fo.o_trp + vcol + (16 * HG_LD) * 2, 8 * HG_LD * 2);
                __builtin_amdgcn_sched_barrier(0);
#pragma unroll
                for (int dt = 0; dt < 4; ++dt)
#pragma unroll
                    for (int sp = 0; sp < 2; ++sp) o = MFMA32(qp[2 * dt + sp], pack8(St[dt], sp), o);
#pragma unroll
                for (int i = 0; i < 16; ++i) s[i] = (crow(i, hh) <= r) ? s[i] : 0.f;
                o = MFMA32(pack8(s, 0), v0, o); o = MFMA32(pack8(s, 1), v1, o); }
#pragma unroll
            for (int i = 0; i < 16; ++i) *(LAS float*)(OBb + o_obw + ((i & 3) + 8 * (i >> 2)) * 144) = o[i];
            LDS_WAIT(); CFENCE();
            { const f32x4 x0 = *(const LAS f32x4*)(OBb + o_obr), x1 = *(const LAS f32x4*)(OBb + o_obr + 16), x2 = *(const LAS f32x4*)(OBb + o_obr + 32), x3 = *(const LAS f32x4*)(OBb + o_obr + 48);
                const int tau = lns >> 1; const int t = seg_t0 + 32 * ci + (g ? 31 - tau : tau);
                bf16* op = hx + (size_t)(rowbase + t) * D + h * 128 + 32 * j + 16 * (lns & 1);
                if (!fin) { v4u w0, w1; w0.x = pk2(x0[0], x0[1]); w0.y = pk2(x0[2], x0[3]); w0.z = pk2(x1[0], x1[1]); w0.w = pk2(x1[2], x1[3]); w1.x = pk2(x2[0], x2[1]); w1.y = pk2(x2[2], x2[3]); w1.z = pk2(x3[0], x3[1]); w1.w = pk2(x3[2], x3[3]);
                    *(GAS v4u*)op = w0; *(GAS v4u*)(op + 8) = w1; }
                else { float pp[8], gg[8], xs[16];
                    unpack8(FN.pa0, pp);
#pragma unroll
                    for (int e = 0; e < 4; ++e) { xs[e] = x0[e] + pp[e]; xs[4 + e] = x1[e] + pp[4 + e]; }
                    unpack8(FN.pa1, pp);
#pragma unroll
                    for (int e = 0; e < 4; ++e) { xs[8 + e] = x2[e] + pp[e]; xs[12 + e] = x3[e] + pp[4 + e]; }
                    float ss = 0.f;
#pragma unroll
                    for (int e = 0; e < 16; ++e) ss += xs[e] * xs[e];
                    ss += __shfl_xor(ss, 1);
                    if ((lns & 1) == 0) SSQ[4 * tau + j] = ss;
                    const LAS float* ghp = EAM + 32 * j + 16 * (lns & 1);
                    unpack8(FN.ga0, gg);
#pragma unroll
                    for (int e = 0; e < 8; ++e) yv[e] = xs[e] * ghp[e] * sigmoidf_(gg[e]);
                    unpack8(FN.ga1, gg);
#pragma unroll
                    for (int e = 0; e < 8; ++e) yv[8 + e] = xs[8 + e] * ghp[8 + e] * sigmoidf_(gg[e]);
                    pend = true; pend_t = seg_t0 + 32 * ci; } }
            LDS_WAIT(); CFENCE();
            if (step + 1 > hmid && step + 1 < nch) hg_issue_fin(FN, g ? hx0 : hx1, proj, rowbase, seg_t0 + 32 * (g ? nch - 2 - step : step + 1), g, h, j, lns);
        }
        {   bf16x8 kt[8], vt[2];
#pragma unroll
            for (int sp = 0; sp < 2; ++sp) vt[sp] = ldstr2(gb + HG_V + fo.o_trn + vcol + (16 * sp * HG_LD) * 2, 4 * HG_LD * 2);
#pragma unroll
            for (int dt = 0; dt < 4; ++dt)
#pragma unroll
                for (int sp = 0; sp < 2; ++sp) kt[2 * dt + sp] = ldstr2(gb + HG_KH + fo.o_trn + (16 * sp * HG_LD + 32 * dt) * 2, 4 * HG_LD * 2);
            __builtin_amdgcn_sched_barrier(0);
#pragma unroll
            for (int dt = 0; dt < 4; ++dt)
#pragma unroll
                for (int sp = 0; sp < 2; ++sp) St[dt] = MFMA32(kt[2 * dt + sp], vt[sp], St[dt]); }
        ST_MARK(2);
        __syncthreads();
        ST_MARK(3);
    } }
    if (OUTPUT) {
        if (pend) { const int lns = launder_v(lane);
            const f32x4 sq = *(const LAS f32x4*)(SSQ + 4 * (lns >> 1)); const float rs = rsqrtf(((sq[0] + sq[1]) + (sq[2] + sq[3])) * (1.f / 128.f) + EPS);
            bf16* op = aout + (size_t)(rowbase + pend_t + (g ? 31 - (lns >> 1) : (lns >> 1))) * D + h * 128 + 32 * j + 16 * (lns & 1);
            v4u w0, w1; w0.x = pk2(yv[0] * rs, yv[1] * rs); w0.y = pk2(yv[2] * rs, yv[3] * rs); w0.z = pk2(yv[4] * rs, yv[5] * rs); w0.w = pk2(yv[6] * rs, yv[7] * rs);
            w1.x = pk2(yv[8] * rs, yv[9] * rs); w1.y = pk2(yv[10] * rs, yv[11] * rs); w1.z = pk2(yv[12] * rs, yv[13] * rs); w1.w = pk2(yv[14] * rs, yv[15] * rs);
            *(GAS v4u*)op = w0; *(GAS v4u*)(op + 8) = w1; }
        item_headnorm(launder_v(tid_l), hx0, hx1, proj, NP_H, 4096, ghead + h * 128, aout, S0.rowbase, S0.t0 + 32 * ((S0.nchunk >> 1) - 1), 64, h); }
    ST_MARK(5);
    if (!OUTPUT) {
        float* e = g ? st_out1 : st_out0; float* ep = e + (4 * hh) * 128 + 32 * j + r;
#pragma unroll
        for (int dt = 0; dt < 4; ++dt)
#pragma unroll
            for (int i = 0; i < 16; ++i) ep[(32 * dt + (i & 3) + 8 * (i >> 2)) * 128] = St[dt][i];
        if ((lane >> 4) == 0) { e[16384 + 32 * j + 2 * (lane & 15)] = atot0; e[16384 + 32 * j + 2 * (lane & 15) + 1] = atot1; }
    }
}
#undef ST_MARK

constexpr int PH_PER_LAYER = 11, PH_BASE = 2, N_PHASES = PH_BASE + DEPTH * PH_PER_LAYER;
#ifndef EN_GEMM
#define EN_GEMM 0xff
#endif
#ifndef EN_ML
#define EN_ML 3
#endif
#ifndef EN_HG
#define EN_HG 3
#endif
#ifndef EN_TOK
#define EN_TOK 1
#endif
#ifndef EN_MISC
#define EN_MISC 1
#endif
#ifndef PG_SP2
#define PG_SP2 true
#endif
#ifndef PG_ALIGN
#define PG_ALIGN true
#endif
#ifndef TIMER_MASK
#define TIMER_MASK 0ull
#endif
#ifndef TIMER_DIV
#define TIMER_DIV 20.0f
#endif
#ifndef MK_SPLIT
#define MK_SPLIT 0
#endif


__device__ __forceinline__ void phase_headnorm(Frame& F, const bf16* hf, const bf16* hb, const bf16* gate, int gpitch, int gcol0, const float* ghead, bf16* aout, int nrows) {
    const int tid = launder_v(F.tid); const int lane = tid & 63, wave = __builtin_amdgcn_readfirstlane(tid >> 6);
    const int gw = F.bid * NWAVES + wave, NGW = F.G * NWAVES;
    float gh[16];
#pragma unroll
    for (int e = 0; e < 16; ++e) gh[e] = ghead[lane * 16 + e];
    for (int row = gw; row < nrows; row += NGW) {
        const v4u a0 = *(const v4u*)(hf + (size_t)row * D + lane * 16), a1 = *(const v4u*)(hf + (size_t)row * D + lane * 16 + 8);
        const v4u b0 = *(const v4u*)(hb + (size_t)row * D + lane * 16), b1 = *(const v4u*)(hb + (size_t)row * D + lane * 16 + 8);
        const v4u g0 = *(const v4u*)(gate + (size_t)row * gpitch + gcol0 + lane * 16), g1 = *(const v4u*)(gate + (size_t)row * gpitch + gcol0 + lane * 16 + 8);
        float x[16], y[8], o[16]; unpack8(a0, y);
#pragma unroll
        for (int e = 0; e < 8; ++e) x[e] = y[e];
        unpack8(a1, y);
#pragma unroll
        for (int e = 0; e < 8; ++e) x[8 + e] = y[e];
        unpack8(b0, y);
#pragma unroll
        for (int e = 0; e < 8; ++e) x[e] += y[e];
        unpack8(b1, y);
#pragma unroll
        for (int e = 0; e < 8; ++e) x[8 + e] += y[e];
        float ss = 0.f;
#pragma unroll
        for (int e = 0; e < 16; ++e) ss += x[e] * x[e];
        ss += __shfl_xor(ss, 1); ss += __shfl_xor(ss, 2); ss += __shfl_xor(ss, 4);
        const float rs = rsqrtf(ss * (1.f / 128.f) + EPS);
        unpack8(g0, y);
#pragma unroll
        for (int e = 0; e < 8; ++e) o[e] = x[e] * rs * gh[e] * sigmoidf_(y[e]);
        unpack8(g1, y);
#pragma unroll
        for (int e = 0; e < 8; ++e) o[8 + e] = x[8 + e] * rs * gh[8 + e] * sigmoidf_(y[e]);
        v4u w0, w1; w0.x = pk2(o[0], o[1]); w0.y = pk2(o[2], o[3]); w0.z = pk2(o[4], o[5]); w0.w = pk2(o[6], o[7]); w1.x = pk2(o[8], o[9]); w1.y = pk2(o[10], o[11]); w1.z = pk2(o[12], o[13]); w1.w = pk2(o[14], o[15]);
        *(v4u*)(aout + (size_t)row * D + lane * 16) = w0; *(v4u*)(aout + (size_t)row * D + lane * 16 + 8) = w1;
    }
}

__device__ __forceinline__ void phase_conv(Frame& F, const bf16* proj, bf16* qkc, float* gates, const float* wconv, const float* bgate) {
    const int gt = F.bid * NTHR + F.tid, cp = gt & 127;
    const int rpb = (M_ALL + F.G - 1) / F.G, rlo = F.bid * rpb, rhi = min(M_ALL, rlo + rpb);
    float w[3][8];
#pragma unroll
    for (int d = 0; d < 3; ++d)
#pragma unroll
        for (int e = 0; e < 8; ++e) w[d][e] = wconv[d * 1024 + cp * 8 + e];
    const float sc = cp >= 64 ? 0.125f : 1.0f;
#pragma unroll 3
    for (int row = rlo + (F.tid >> 7); row < rhi; row += NTHR >> 7) {
        int t, len; if (row < M_LAT) { t = row & (SEQ - 1); len = SEQ; } else { t = (row - M_LAT) & (CTXL - 1); len = CTXL; }
        const bf16* rp = proj + (size_t)row * NP_M + cp * 8;
        const v4u z = (v4u){0u, 0u, 0u, 0u};
        const v4u r0 = t > 0 ? *(const v4u*)(rp - NP_M) : z, r1 = *(const v4u*)rp, r2 = t + 1 < len ? *(const v4u*)(rp + NP_M) : z;
        float x0[8], x1[8], x2[8], o[8]; unpack8(r0, x0); unpack8(r1, x1); unpack8(r2, x2);
#pragma unroll
        for (int e = 0; e < 8; ++e) o[e] = sc * siluf_(w[0][e] * x0[e] + w[1][e] * x1[e] + w[2][e] * x2[e]);
        v4u q; q.x = pk2(o[0], o[1]); q.y = pk2(o[2], o[3]); q.z = pk2(o[4], o[5]); q.w = pk2(o[6], o[7]);
        *(v4u*)(qkc + (size_t)row * D + cp * 8) = q;
    }
    {   const int c4 = (gt * 4) & 31; const f32x4 bg = *(const f32x4*)(bgate + c4); const bool lsg = ((c4 >> 3) & 1) != 0;
#pragma unroll 4
        for (int i = gt; i < M_ALL * 8; i += F.G * NTHR) { f32x4 x = *(const GAS f32x4*)(gates + (size_t)i * 4) + bg;
            if (lsg) {
#pragma unroll
                for (int e = 0; e < 4; ++e) x[e] = fminf(x[e], 0.f) - __logf(1.f + __expf(-fabsf(x[e]))); }
            *(GAS f32x4*)(gates + (size_t)i * 4) = x; } }
}

__device__ __forceinline__ void timer_stamp(unsigned char* lds_raw, bool add) {
    if (threadIdx.x == 0) { volatile LAS unsigned* tw = (volatile LAS unsigned*)((LAS unsigned char*)lds_raw + LDSCTL_OFF) + 32;
        const unsigned long long t = wall_clock64(); const unsigned long long last = ((unsigned long long)tw[1] << 32) | tw[0];
        if (add) { unsigned long long acc = ((unsigned long long)tw[3] << 32) | tw[2]; acc += t - last; tw[2] = (unsigned)acc; tw[3] = (unsigned)(acc >> 32); }
        tw[0] = (unsigned)t; tw[1] = (unsigned)(t >> 32); }
}

__device__ __forceinline__ void seg_of(bool odd, bool ctx_out, int q, int& t0, int& len) {
    int a, b; if (!ctx_out) { a = 2048; b = 2048; } else if (!odd) { a = 30 * 64; b = 34 * 64; } else { a = 60 * 32; b = 68 * 32; }
    t0 = (q == 0) ? 0 : (q == 1) ? a : (q == 2) ? a + b : a + 2 * b; len = (q == 0 || q == 3) ? a : b;
}

__device__ __forceinline__ Frame mkframe(const Args& args, unsigned char* lds_raw) {
    Frame F; int t = threadIdx.x; asm volatile("" : "+v"(t));
    F.lds = (LAS unsigned char*)lds_raw; F.tid = t; F.lane = t & 63; F.wave = __builtin_amdgcn_readfirstlane(t >> 6);
    int g = gridDim.x, b = blockIdx.x; asm volatile("" : "+s"(g), "+s"(b)); F.G = g; F.bid = b;
    const __attribute__((address_space(4))) Args* ap = (const __attribute__((address_space(4))) Args*)__builtin_amdgcn_kernarg_segment_ptr(); asm volatile("" : "+s"(ap));
    F.ws = ap->ws; F.in = ap->in; F.out = ap->out;
    return F;
}
#define PHASE_LOCALS \
    Frame F = mkframe(args, lds_raw); unsigned char* ws = F.ws; \
    float* modv = (float*)(ws + WS_MODV); bf16* U = (bf16*)(ws + WS_U); bf16* Y = (bf16*)(ws + WS_Y); bf16* PROJ = (bf16*)(ws + WS_ACT); bf16* HB = (bf16*)(ws + WS_ACT); \
    bf16* AMOE = (bf16*)(ws + WS_ACT); bf16* HMOE = (bf16*)(ws + WS_ACT + (size_t)MOE_ROWS * D * 2); \
    float* GATES = (float*)(ws + WS_GATES); float* LATC = (float*)(ws + WS_LATC); float* STATE = (float*)(ws + WS_STATE); \
    const int* pexp = (const int*)(ws + WS_SMALL + SM_PEXP); float* SA_U = (float*)(ws + WS_SMALL + SM_SAU); float* SA_U2 = (float*)(ws + WS_SMALL + SM_SAU2); float* SA_MOE = (float*)(ws + WS_GATES + GATES_SAMOE); \
    const float* SWL = (const float*)(ws + WS_SMALL + (odd ? SM_SWO : SM_SWE)); (void)SA_U; (void)SA_U2; (void)SA_MOE; (void)SWL; \
    unsigned char* wb = ws + (odd ? WS_WO : WS_WE); const float* mv = modv + (size_t)L * 9 * 6 * 1024; \
    (void)modv; (void)U; (void)Y; (void)PROJ; (void)HB; (void)AMOE; (void)HMOE; (void)GATES; (void)LATC; (void)STATE; (void)pexp; (void)wb; (void)mv;

__global__ void __launch_bounds__(NTHR, 2) fwd(Args args) {
    extern __shared__ __attribute__((aligned(16))) unsigned char lds_raw[];
    Frame F = mkframe(args, lds_raw);
    volatile LAS unsigned* LCTL = (volatile LAS unsigned*)(F.lds + LDSCTL_OFF);
    for (int u = F.tid; u < 128; u += NTHR) LCTL[u] = 0u;
    __syncthreads();
    XcdBarrier bar; bar.bar = (unsigned*)(F.ws + WS_CTL) + CW_BAR; bar.x = 0; bar.st = nullptr;
    if (args.use_bar) bar = xcd_barrier_post((unsigned*)(F.ws + WS_CTL) + CW_BAR, LCTL + 8);
    const int lo = args.ph_lo, hi = args.ph_hi;
#define IN(k) (lo <= (k) && (k) < hi)
#define SEAM(k) do { if ((k) + 1 < hi) xcd_barrier(bar.bar, bar.x, bar.st); if (TIMER_MASK != 0ull) timer_stamp(lds_raw, ((TIMER_MASK >> (k)) & 1ull) != 0ull); } while (0)
#ifdef TIMER_SPAN
    if (threadIdx.x == 0) { unsigned long long* dbg = (unsigned long long*)((unsigned*)(F.ws + WS_CTL) + CW_DBG); atomicMax(dbg, ~wall_clock64()); }
#endif
#ifdef SPIN_START
    { const unsigned long long t0 = wall_clock64(); while (wall_clock64() - t0 < (unsigned long long)(SPIN_START)) __builtin_amdgcn_s_sleep(8); }
#endif
    if (TIMER_MASK != 0ull) timer_stamp(lds_raw, false);
#ifdef EXTRA_BARS
    for (int eb = 0; eb < EXTRA_BARS; ++eb) xcd_barrier(bar.bar, bar.x, bar.st);
#endif
    if (IN(0)) { const int L = 0; const bool odd = false; PHASE_LOCALS if (EN_MISC) phase_mods(F); __syncthreads(); if (EN_MISC) phase_colmax(F); xcd_barrier(bar.bar, bar.x, bar.st); if (EN_MISC) phase_wconv(F, 0); SEAM(0); }
    if (IN(1)) { const int L = 0; const bool odd = false; PHASE_LOCALS
        TokCfg T{}; T.lat_src_l = F.in[I_X]; T.lat_src_c = F.in[I_CTX]; T.src_f32 = 1; T.vna = modv + 0 * 1024; T.vnb = modv + 1 * 1024; T.u = U; T.u_fp8 = INPROJ_I8 ? 2 : 0; T.u_scale = SA_U; T.nrows = M_ALL;
        if (EN_TOK) phase_tok(F, T); __syncthreads(); if (EN_MISC) phase_wconv(F, 1); SEAM(1);
    }
    for (int L = 0; L < DEPTH; ++L) {
        const int pb = PH_BASE + L * PH_PER_LAYER; const bool odd = (L & 1) != 0; const int jl = L >> 1;
        const bool ctx_out = L < DEPTH - 1;
        if (IN(pb + 0)) { PHASE_LOCALS
            pg8::Order S; pg8::Gemm g;
#if INPROJ_I8
            if (!odd) { g = pg8::Gemm{U, (const bf16*)(wb + WE_IN), M_ALL, NIN_M, D}; S.init(M_ALL / 256, NIN_M, F.G, F.bid, nullptr, 0);
                pg8::EpiStoreI8 E{PROJ, NP_M, NP_M / 256, NP_M / 256, GATES, SA_U, SWL + SWE_IN}; if (EN_GEMM & (1 << 0)) pg8::gemm_phase<pg8::EpiStoreI8, pg8::Order, PG_ALIGN, PG_SP2, 2>(F.lds, g, S, E); }
            else { g = pg8::Gemm{U, (const bf16*)(wb + WOD_IN), M_ALL, NP_H, D}; S.init(M_ALL / 256, NP_H, F.G, F.bid, nullptr, 0);
                pg8::EpiStoreI8 E{PROJ, NP_H, NP_H / 256, -1, nullptr, SA_U, SWL + SWO_IN}; if (EN_GEMM & (1 << 1)) pg8::gemm_phase<pg8::EpiStoreI8, pg8::Order, PG_ALIGN, PG_SP2, 2>(F.lds, g, S, E); }
#else
            if (!odd) { g = pg8::Gemm{U, (const bf16*)(wb + WE_IN), M_ALL, NIN_M, D}; S.init(M_ALL / 256, NIN_M, F.G, F.bid, nullptr, 0);
                pg8::EpiStore E{PROJ, NP_M, NP_M / 256, NP_M / 256, GATES, 1.0f}; if (EN_GEMM & (1 << 0)) pg8::gemm_phase<pg8::EpiStore, pg8::Order, PG_ALIGN, PG_SP2>(F.lds, g, S, E); }
            else { g = pg8::Gemm{U, (const bf16*)(wb + WOD_IN), M_ALL, NP_H, D}; S.init(M_ALL / 256, NP_H, F.G, F.bid, nullptr, 0);
                pg8::EpiStore E{PROJ, NP_H, NP_H / 256, -1, nullptr, 1.0f}; if (EN_GEMM & (1 << 1)) pg8::gemm_phase<pg8::EpiStore, pg8::Order, PG_ALIGN, PG_SP2>(F.lds, g, S, E); }
#endif
            SEAM(pb + 0);
        }
        if (IN(pb + 1)) {
            if (!odd) { PHASE_LOCALS
                phase_conv(F, PROJ, (bf16*)(ws + WS_ACT + 400 * MiB), GATES, F.in[I_MWCONV] + (size_t)jl * 3 * 1024, F.in[I_MBGATE] + jl * 32); SEAM(pb + 1); }
        }
        if (IN(pb + 2)) { PHASE_LOCALS
            for (int id = F.bid; id < 256; id += F.G) {
                const int bh = id >> 2, p = id & 3, b = bh >> 3, h = bh & 7;
                MlSeg SG0, SG1;
                const int csz = odd ? 32 : 64;
                if (p == 0) { SG0 = MlSeg{M_LAT + b * CTXL, CTXL, 0, CTXL / csz}; SG1 = SG0; }
                else { int t0a, la, t0b, lb2; seg_of(odd, ctx_out, p - 1, t0a, la); seg_of(odd, ctx_out, 4 - p, t0b, lb2); SG0 = MlSeg{b * SEQ, SEQ, t0a, la / csz}; SG1 = MlSeg{b * SEQ, SEQ, t0b, lb2 / csz}; }
                if (!odd) { float* e0 = STATE + (size_t)((bh * 2 + 0) * 4 + p) * ML_STATE_F; float* e1 = STATE + (size_t)((bh * 2 + 1) * 4 + p) * ML_STATE_F;
                    if (EN_ML & 1) mlstm_s1_item(F, PROJ, (const bf16*)(ws + WS_ACT + 400 * MiB), GATES, h, SG0, SG1, e0, e1); }
                else { float* e0 = STATE + (size_t)((bh * 2 + 0) * 4 + p) * HG_STATE_F; float* e1 = STATE + (size_t)((bh * 2 + 1) * 4 + p) * HG_STATE_F;
                    if (EN_HG & 1) hgrn_item<false>(F, PROJ, U, (bf16*)(ws + WS_Y), U, F.in[I_HGHEAD] + jl * 1024, F.in[I_HBF] + (size_t)jl * 2048, F.in[I_HLB], jl, h, SG0, SG1, nullptr, nullptr, 0, 0, e0, e1); }
            }
            SEAM(pb + 2);
        }
        if (IN(pb + 3)) { PHASE_LOCALS
            const int nitems = ctx_out ? 320 : 256;
            for (int id = F.bid; id < nitems; id += F.G) {
                MlSeg SG0, SG1; int bh, npre0 = 0, npre1 = 0; const int csz = odd ? 32 : 64;
                if (id < 256) { int q; if (id < 128) { bh = id >> 1; q = (id & 1) ? 3 : 0; } else { bh = (id - 128) >> 1; q = 1 + (id & 1); } int t0q, lq; seg_of(odd, ctx_out, q, t0q, lq); SG0 = MlSeg{(bh >> 3) * SEQ, SEQ, t0q, lq / csz}; npre0 = q + 1; npre1 = 4 - q; }
                else { bh = id - 256; SG0 = MlSeg{M_LAT + (bh >> 3) * CTXL, CTXL, 0, CTXL / csz}; }
                SG1 = SG0;
                const int h = bh & 7;
                if (!odd) { const float* s0 = STATE + (size_t)((bh * 2 + 0) * 4) * ML_STATE_F; const float* s1 = STATE + (size_t)((bh * 2 + 1) * 4) * ML_STATE_F;
                    if (EN_ML & 2) mlstm_item<true>(F, PROJ, (const bf16*)(ws + WS_ACT + 400 * MiB), GATES, (bf16*)(ws + WS_ACT + 536 * MiB), (bf16*)(ws + WS_Y), U, F.in[I_MGHEAD] + jl * 1024, h, SG0, SG1, s0, s1, npre0, npre1, nullptr, nullptr); }
                else { const float* s0 = STATE + (size_t)((bh * 2 + 0) * 4) * HG_STATE_F; const float* s1 = STATE + (size_t)((bh * 2 + 1) * 4) * HG_STATE_F;
                    if (EN_HG & 2) hgrn_item<true>(F, PROJ, U, (bf16*)(ws + WS_Y), U, F.in[I_HGHEAD] + jl * 1024, F.in[I_HBF] + (size_t)jl * 2048, F.in[I_HLB], jl, h, SG0, SG1, s0, s1, npre0, npre1, nullptr, nullptr); }
            }
            SEAM(pb + 3);
        }
        if (IN(pb + 5)) { PHASE_LOCALS
            const int nM = (ctx_out ? M_ALL : M_LAT) / 256;
            pg8::Gemm g{U, (const bf16*)(wb + (odd ? WOD_OUT : WE_OUT)), nM * 256, D, D}; pg8::Order S; S.init(nM, D, F.G, F.bid, nullptr, 0);
            pg8::EpiStore E{Y, D, D / 256, -1, nullptr, 1.0f}; if (EN_GEMM & (1 << 2)) pg8::gemm_phase<pg8::EpiStore, pg8::Order, PG_ALIGN, PG_SP2>(F.lds, g, S, E);
            SEAM(pb + 5);
        }
        if (IN(pb + 6)) { PHASE_LOCALS
            TokCfg T{}; bf16* LAT16 = (bf16*)(ws + WS_ACT + 836 * MiB); T.src_f32 = (L == 0) ? 1 : 0; T.lat_src_l = (L == 0) ? (const void*)F.in[I_X] : (const void*)LAT16; T.lat_src_c = (L == 0) ? (const void*)F.in[I_CTX] : (const void*)LATC; T.lat_dst_l = LAT16; T.lat_dst_c = LATC;
            T.y = Y; T.y_perm = odd ? 1 : 0; T.vupd = mv + 2 * 1024; T.vna = mv + 3 * 1024; T.vnb = mv + 4 * 1024; T.u = U; T.u_fp8 = ((UP_I8 && !odd) || (UP_I8_MOE && odd)) ? 2 : FFN_FP8_L(L); T.u_scale = SA_U2; T.route = odd ? 1 : 0; T.jr = jl; T.nrows = ctx_out ? M_ALL : M_LAT;
            if (EN_TOK) phase_tok(F, T);
            if (L >= 1 && L + 1 < DEPTH) { __syncthreads(); if (EN_MISC) phase_wconv(F, L + 1); }
            SEAM(pb + 6);
        }
        if (IN(pb + 7)) { PHASE_LOCALS
            if (odd) { if (EN_MISC) phase_moe_scatter(F, jl, ctx_out ? M_ALL : M_LAT, (const unsigned char*)U, (unsigned char*)AMOE, (UP_I8_MOE || FFN_FP8_L(L)) ? 1024 : 2048, UP_I8_MOE ? SA_U2 : nullptr, SA_MOE); SEAM(pb + 7); }
        }
        if (IN(pb + 8)) { PHASE_LOCALS
            if (!odd) { pg8::Gemm g{U, (const bf16*)(wb + WE_GU), M_ALL, NGU, D}; pg8::Order S; S.init(M_ALL / 256, NGU, F.G, F.bid, nullptr, 0);
#if UP_I8
                pg8::EpiSwiGLU8I E{(unsigned char*)HB, FF, SA_U2, SWL + SWE_GU, nullptr, 0, FFN_FP8_L(L) ? 0 : 1}; if (EN_GEMM & (1 << 3)) pg8::gemm_phase<pg8::EpiSwiGLU8I, pg8::Order, PG_ALIGN, PG_SP2, 2>(F.lds, g, S, E);
#else
                pg8::EpiSwiGLU8 E{(unsigned char*)HB, FF, 1.0f / WSCALE8}; if (EN_GEMM & (1 << 3)) pg8::gemm_phase<pg8::EpiSwiGLU8, pg8::Order, PG_ALIGN, PG_SP2, 1>(F.lds, g, S, E);
#endif
            }
            else { const int np = __builtin_amdgcn_readfirstlane(pexp[MOE_PANELS]);
                pg8::Gemm g{AMOE, (const bf16*)(wb + WOD_GU), np * 256, NGU, D}; pg8::Order S; S.init(np, NGU, F.G, F.bid, pexp, EGU_BYTES);
#if UP_I8_MOE
                pg8::EpiSwiGLU8I E{(unsigned char*)HMOE, FF, SA_MOE, SWL + SWO_GU, pexp, NGU, 0}; if (EN_GEMM & (1 << 4)) pg8::gemm_phase<pg8::EpiSwiGLU8I, pg8::Order, PG_ALIGN, PG_SP2, 2>(F.lds, g, S, E); }
#else
                pg8::EpiSwiGLU8 E{(unsigned char*)HMOE, FF, 1.0f / WSCALE8}; if (EN_GEMM & (1 << 4)) pg8::gemm_phase<pg8::EpiSwiGLU8, pg8::Order, PG_ALIGN, PG_SP2, 1>(F.lds, g, S, E); }
#endif
            SEAM(pb + 8);
        }
        if (IN(pb + 9)) { PHASE_LOCALS
            const bool f8 = FFN_FP8_L(L) != 0;
            if (!odd) { pg8::Gemm g{HB, (const bf16*)(wb + WE_DOWN), M_ALL, D, FF}; pg8::Order S; S.init(M_ALL / 256, D, F.G, F.bid, nullptr, 0);
                if (f8) { if ((FP8_LAYERS) & 0x5) { pg8::EpiStore E{Y, D, D / 256, -1, nullptr, 1.0f / WSCALE8}; if (EN_GEMM & (1 << 5)) pg8::gemm_phase<pg8::EpiStore, pg8::Order, PG_ALIGN, PG_SP2, 1>(F.lds, g, S, E); } }
                else { if ((~(FP8_LAYERS)) & 0x5) { pg8::EpiStore E{Y, D, D / 256, -1, nullptr, 1.0f}; if (EN_GEMM & (1 << 5)) pg8::gemm_phase<pg8::EpiStore, pg8::Order, PG_ALIGN, PG_SP2>(F.lds, g, S, E); } } }
            else { const int np = __builtin_amdgcn_readfirstlane(pexp[MOE_PANELS]);
                pg8::Gemm g{HMOE, (const bf16*)(wb + WOD_DOWN), np * 256, D, FF}; pg8::Order S; S.init(np, D, F.G, F.bid, pexp, EDOWN_BYTES);
                if (f8) { if ((FP8_LAYERS) & 0xA) { pg8::EpiStore E{AMOE, D, D / 256, -1, nullptr, 1.0f / WSCALE8}; if (EN_GEMM & (1 << 6)) pg8::gemm_phase<pg8::EpiStore, pg8::Order, PG_ALIGN, PG_SP2, 1>(F.lds, g, S, E); } }
                else { if ((~(FP8_LAYERS)) & 0xA) { pg8::EpiStore E{AMOE, D, D / 256, -1, nullptr, 1.0f}; if (EN_GEMM & (1 << 6)) pg8::gemm_phase<pg8::EpiStore, pg8::Order, PG_ALIGN, PG_SP2>(F.lds, g, S, E); } } }
            SEAM(pb + 9);
        }
        if (IN(pb + 10)) { PHASE_LOCALS
            TokCfg T{}; bf16* LAT16 = (bf16*)(ws + WS_ACT + 836 * MiB); T.lat_src_l = LAT16; T.lat_src_c = LATC; T.lat_dst_l = (L + 1 < DEPTH) ? (void*)LAT16 : (void*)F.out; T.lat_dst_c = LATC; T.dst_f32 = (L + 1 < DEPTH) ? 0 : 1;
            T.y = odd ? AMOE : Y; T.moe_combine = odd ? 1 : 0; T.vupd = mv + 5 * 1024; T.nrows = ctx_out ? M_ALL : M_LAT;
            if (L + 1 < DEPTH) { const float* mn = modv + (size_t)(L + 1) * 9 * 6 * 1024; T.vna = mn; T.vnb = mn + 1024; T.u = U; T.u_perm = ((L + 1) & 1) ? 1 : 0; T.u_fp8 = INPROJ_I8 ? 2 : 0; T.u_scale = SA_U; }
            if (EN_TOK) phase_tok(F, T);
            SEAM(pb + 10);
        }
    }
    if (TIMER_MASK != 0ull) { timer_stamp(lds_raw, ((TIMER_MASK >> (N_PHASES - 1)) & 1ull) != 0ull);
        if (blockIdx.x == 0 && threadIdx.x == 0) { volatile LAS unsigned* tw = (volatile LAS unsigned*)((LAS unsigned char*)lds_raw + LDSCTL_OFF) + 32; const unsigned long long acc = ((unsigned long long)tw[3] << 32) | tw[2];
            asm volatile("s_waitcnt vmcnt(0)" ::: "memory"); args.out[0] = (float)acc * 0.01f / TIMER_DIV; } }
#ifdef SUBT
    __syncthreads();
    if (blockIdx.x == 0 && threadIdx.x == 0) { volatile LAS unsigned* tw = (volatile LAS unsigned*)((LAS unsigned char*)lds_raw + LDSCTL_OFF) + 40; asm volatile("s_waitcnt vmcnt(0)" ::: "memory"); args.out[0] = (float)tw[SUBT] * 0.01f / SUBT_DIV; }
#endif
#ifdef TIMER_SPAN
    __syncthreads();
    if (threadIdx.x == 0) { unsigned long long* dbg = (unsigned long long*)((unsigned*)(args.ws + WS_CTL) + CW_DBG);
        asm volatile("s_waitcnt vmcnt(0)" ::: "memory"); __threadfence();
        if (blockIdx.x != 0) { atomicMax(dbg + 1, wall_clock64()); __threadfence(); atomicAdd(dbg + 2, 1ull); }
        else { while (atomicAdd(dbg + 2, 0ull) < (unsigned long long)(gridDim.x - 1)) __builtin_amdgcn_s_sleep(4);
            unsigned long long te = atomicMax(dbg + 1, 0ull); const unsigned long long tn = wall_clock64(); if (tn > te) te = tn; const unsigned long long ts = ~atomicMax(dbg, 0ull);
            args.out[0] = (float)(te - ts) * 0.01f / TIMER_SPAN; } }
#endif
#ifdef SPIN_TICKS
    { const unsigned long long t0 = wall_clock64(); while (wall_clock64() - t0 < (unsigned long long)(SPIN_TICKS)) __builtin_amdgcn_s_sleep(8); }
#endif
#undef IN
#undef SEAM
}

extern "C" void kernel_launch(void* const* d_in, const int* in_sizes, int n_in, void* d_out, int out_size, void* d_ws, size_t ws_size, hipStream_t stream) {
    static int grid = 0;
    if (grid == 0) {
        if (n_in != 23 || out_size != M_LAT * D || ws_size < WS_END) { fprintf(stderr, "kernel_launch: unexpected shapes / workspace (n_in %d out %d ws %zu need %zu)\n", n_in, out_size, ws_size, (size_t)WS_END); grid = -1; return; }
        int dev = 0, cus = 0, per_cu = 0;
        if (hipGetDevice(&dev) != hipSuccess || hipDeviceGetAttribute(&cus, hipDeviceAttributeMultiprocessorCount, dev) != hipSuccess) { grid = -1; return; }
        if (hipFuncSetAttribute((const void*)fwd, hipFuncAttributeMaxDynamicSharedMemorySize, LDS_BYTES) != hipSuccess) { fprintf(stderr, "kernel_launch: hipFuncSetAttribute failed\n"); grid = -1; return; }
        if (hipOccupancyMaxActiveBlocksPerMultiprocessor(&per_cu, (const void*)fwd, NTHR, LDS_BYTES) != hipSuccess || per_cu < 1) fprintf(stderr, "kernel_launch: occupancy query reports %d\n", per_cu);
        (void)hipGetLastError();
        grid = cus;
    }
    if (grid < 0) return;
    (void)hipMemsetAsync((char*)d_ws + WS_CTL, 0, CTL_ZERO_BYTES, stream);
    Args a{};
    for (int i = 0; i < 23; ++i) a.in[i] = (const float*)d_in[i];
    a.out = (float*)d_out; a.ws = (unsigned char*)d_ws;
#if MK_SPLIT
    for (int p = 0; p < N_PHASES; ++p) { a.ph_lo = p; a.ph_hi = p + 1; a.use_bar = 0; a.pad = 0; hipLaunchKernelGGL(fwd, dim3(grid), dim3(NTHR), LDS_BYTES, stream, a); }
#else
    a.ph_lo = 0; a.ph_hi = N_PHASES; a.use_bar = 1; a.pad = 0;
    hipLaunchKernelGGL(fwd, dim3(grid), dim3(NTHR), LDS_BYTES, stream, a);
#endif
}
```

```cpp
#include <hip/hip_runtime.h>
#include <cstdio>
#include <cstdint>

namespace pg8 {
#define PG8_LAS __attribute__((address_space(3)))
typedef unsigned short bf16_t;
typedef short bf16x8 __attribute__((ext_vector_type(8)));
typedef float f32x4 __attribute__((ext_vector_type(4)));
typedef unsigned u32x4 __attribute__((ext_vector_type(4)));
typedef unsigned u32x2 __attribute__((ext_vector_type(2)));
typedef int v8i_t __attribute__((ext_vector_type(8)));
typedef int v4i_t __attribute__((ext_vector_type(4)));
constexpr int BM = 256, BK = 64, HALF = 128, HTB = HALF * BK * 2  , STAGE_BYTES = 8 * HTB, NXCD = 8, WGM = 8;

__host__ __device__ __forceinline__ int lds_byte(int r, int c) { const int st = (r >> 4) * 2 + (c >> 5), rr = r & 15, cc = c & 31, ob = rr * 64 + cc * 2; return st * 1024 + (ob ^ (((ob >> 9) & 1) << 5)); }
__host__ __device__ __forceinline__ void stage_rc(int b, int& R, int& C) { const int st = b / 1024, sb = b % 1024, swz = sb ^ (((sb >> 9) & 1) << 5); R = (st >> 1) * 16 + swz / 64; C = (st & 1) * 32 + (swz % 64) / 2; }
__host__ __device__ __forceinline__ int perm32(int rho) { const int n = rho >> 4, i = rho & 15; return 8 * (i >> 2) + 4 * n + (i & 3); }

struct Unit { int pm, pn; };
struct Gemm { const bf16_t* A; const bf16_t* Bt; int M, N, K; };

struct Order {
    int nM, nN, nwg, G, c; const int* pexp; size_t bstride;
    __device__ void init(int nM_, int N, int G_, int c_, const int* pexp_, size_t bstride_) { nM = nM_; nN = N / BM; nwg = nM * nN; G = G_; c = c_; pexp = pexp_; bstride = bstride_; }
    __device__ bool next(int i, Unit& u) const {
        const long L = (long)i * G + c; if (L >= nwg) return false;
        int wgid = (int)L; { const int q = nwg / NXCD, r = nwg % NXCD, xcd = wgid % NXCD, off = wgid / NXCD; wgid = (xcd < r ? xcd * (q + 1) : r * (q + 1) + (xcd - r) * q) + off; }
        const int nig = WGM * nN, gid = wgid / nig, fm = gid * WGM, gsz = (nM - fm) < WGM ? (nM - fm) : WGM;
        u.pm = fm + ((wgid % nig) % gsz); u.pn = (wgid % nig) / gsz; return true;
    }
    __device__ __forceinline__ size_t boff(const Unit& u) const { return pexp ? (size_t)__builtin_amdgcn_readfirstlane(pexp[u.pm]) * bstride : (size_t)0; }
    __device__ __forceinline__ void a_ready(const Unit&) const {}
    __device__ __forceinline__ void done(const Unit&) const {}
};

__device__ __forceinline__ unsigned cvt_pk_bf16(float lo, float hi) { unsigned r; asm volatile("v_cvt_pk_bf16_f32 %0, %1, %2" : "=v"(r) : "v"(lo), "v"(hi)); return r; }

struct EpiStore {
    static constexpr bool PERM = true, AFTER_DRAIN = false;
    bf16_t* O; int ldc; int ncol_tiles; int gate_pn; float* gates; float oscale;
    __device__ __forceinline__ void operator()(const f32x4 (&acc)[2][2][4][2], const Unit& u, int wr, int wc, int fr, int fq) const {
        const int row0 = u.pm * BM + wr * 64 + fr;
        if (u.pn < ncol_tiles) {
            const int col0 = u.pn * BM + wc * 32 + 8 * fq;
#pragma unroll
            for (int ai = 0; ai < 2; ++ai)
#pragma unroll
                for (int m = 0; m < 4; ++m) { bf16_t* rowp = O + (size_t)(row0 + ai * HALF + m * 16) * ldc + col0;
#pragma unroll
                    for (int bj = 0; bj < 2; ++bj) { const f32x4 v0 = acc[ai][bj][m][0] * oscale, v1 = acc[ai][bj][m][1] * oscale;
                        u32x4 w; w.x = cvt_pk_bf16(v0[0], v0[1]); w.y = cvt_pk_bf16(v0[2], v0[3]); w.z = cvt_pk_bf16(v1[0], v1[1]); w.w = cvt_pk_bf16(v1[2], v1[3]);
                        *(u32x4*)(rowp + bj * HALF) = w; } }
        } else if (u.pn == gate_pn && wc == 0) {
#pragma unroll
            for (int ai = 0; ai < 2; ++ai)
#pragma unroll
                for (int m = 0; m < 4; ++m) { float* rowp = gates + (size_t)(row0 + ai * HALF + m * 16) * 32 + 8 * fq;
                    *(f32x4*)(rowp) = acc[ai][0][m][0]; *(f32x4*)(rowp + 4) = acc[ai][0][m][1]; }
        }
    }
};
struct EpiSwiGLU {
    static constexpr bool PERM = true, AFTER_DRAIN = false;
    bf16_t* O; int ldc;
    __device__ __forceinline__ void operator()(const f32x4 (&acc)[2][2][4][2], const Unit& u, int wr, int wc, int fr, int fq) const {
        const int row0 = u.pm * BM + wr * 64 + fr, col0 = u.pn * HALF + wc * 32 + 8 * fq;
#pragma unroll
        for (int ai = 0; ai < 2; ++ai)
#pragma unroll
            for (int m = 0; m < 4; ++m) { bf16_t* rowp = O + (size_t)(row0 + ai * HALF + m * 16) * ldc + col0; float r[8];
#pragma unroll
                for (int n = 0; n < 2; ++n)
#pragma unroll
                    for (int j = 0; j < 4; ++j) { const float g = acc[ai][0][m][n][j], up = acc[ai][1][m][n][j]; r[n * 4 + j] = g * __builtin_amdgcn_rcpf(1.0f + __expf(-g)) * up; }
                u32x4 w; w.x = cvt_pk_bf16(r[0], r[1]); w.y = cvt_pk_bf16(r[2], r[3]); w.z = cvt_pk_bf16(r[4], r[5]); w.w = cvt_pk_bf16(r[6], r[7]);
                *(u32x4*)(rowp) = w; }
    }
};
struct EpiSwiGLU8 {
    static constexpr bool PERM = true, AFTER_DRAIN = false;
    unsigned char* O; int ldc; float ascale;
    __device__ __forceinline__ void operator()(const f32x4 (&acc)[2][2][4][2], const Unit& u, int wr, int wc, int fr, int fq) const {
        typedef float f32x2 __attribute__((ext_vector_type(2)));
        const int row0 = u.pm * BM + wr * 64 + fr, col0 = u.pn * HALF + wc * 32 + 8 * fq;
        const float c1 = -ascale * 1.4426950408889634f, c2 = ascale * ascale;
#pragma unroll
        for (int ai = 0; ai < 2; ++ai)
#pragma unroll
            for (int m = 0; m < 4; ++m) { unsigned char* rowp = O + (size_t)(row0 + ai * HALF + m * 16) * ldc + col0; f32x2 r[4];
#pragma unroll
                for (int n = 0; n < 2; ++n)
#pragma unroll
                    for (int j = 0; j < 2; ++j) { const f32x2 ag = {acc[ai][0][m][n][2 * j], acc[ai][0][m][n][2 * j + 1]}, au = {acc[ai][1][m][n][2 * j], acc[ai][1][m][n][2 * j + 1]};
                        const f32x2 t = ag * c1; f32x2 d = {__builtin_amdgcn_exp2f(t.x), __builtin_amdgcn_exp2f(t.y)}; d = d + 1.0f;
                        const f32x2 q = {__builtin_amdgcn_rcpf(d.x), __builtin_amdgcn_rcpf(d.y)};
                        r[n * 2 + j] = ((ag * au) * q) * c2; }
                u32x2 w; unsigned t = 0; t = __builtin_amdgcn_cvt_pk_fp8_f32(r[0].x, r[0].y, t, false); t = __builtin_amdgcn_cvt_pk_fp8_f32(r[1].x, r[1].y, t, true); w.x = t;
                t = 0; t = __builtin_amdgcn_cvt_pk_fp8_f32(r[2].x, r[2].y, t, false); t = __builtin_amdgcn_cvt_pk_fp8_f32(r[3].x, r[3].y, t, true); w.y = t;
                *(u32x2*)(rowp) = w; }
    }
};
struct EpiStoreI8 {
    static constexpr bool PERM = true, AFTER_DRAIN = false;
    bf16_t* O; int ldc; int ncol_tiles; int gate_pn; float* gates; const float* sa; const float* sw;
    __device__ __forceinline__ void operator()(const f32x4 (&acc)[2][2][4][2], const Unit& u, int wr, int wc, int fr, int fq) const {
        const int row0 = u.pm * BM + wr * 64 + fr;
        if (u.pn < ncol_tiles) {
            const int col0 = u.pn * BM + wc * 32 + 8 * fq;
            f32x4 cs[2][2];
#pragma unroll
            for (int bj = 0; bj < 2; ++bj) { cs[bj][0] = *(const f32x4*)(sw + col0 + bj * HALF); cs[bj][1] = *(const f32x4*)(sw + col0 + bj * HALF + 4); }
#pragma unroll
            for (int ai = 0; ai < 2; ++ai)
#pragma unroll
                for (int m = 0; m < 4; ++m) { const int row = row0 + ai * HALF + m * 16; const float rs = sa[row]; bf16_t* rowp = O + (size_t)row * ldc + col0;
#pragma unroll
                    for (int bj = 0; bj < 2; ++bj) { const v4i_t i0 = __builtin_bit_cast(v4i_t, acc[ai][bj][m][0]), i1 = __builtin_bit_cast(v4i_t, acc[ai][bj][m][1]);
                        const f32x4 v0 = __builtin_convertvector(i0, f32x4) * cs[bj][0] * rs, v1 = __builtin_convertvector(i1, f32x4) * cs[bj][1] * rs;
                        u32x4 w; w.x = cvt_pk_bf16(v0[0], v0[1]); w.y = cvt_pk_bf16(v0[2], v0[3]); w.z = cvt_pk_bf16(v1[0], v1[1]); w.w = cvt_pk_bf16(v1[2], v1[3]);
                        *(u32x4*)(rowp + bj * HALF) = w; } }
        } else if (u.pn == gate_pn && wc == 0) {
            const int col0 = u.pn * BM + 8 * fq; const f32x4 c0 = *(const f32x4*)(sw + col0), c1 = *(const f32x4*)(sw + col0 + 4);
#pragma unroll
            for (int ai = 0; ai < 2; ++ai)
#pragma unroll
                for (int m = 0; m < 4; ++m) { const int row = row0 + ai * HALF + m * 16; const float rs = sa[row]; float* rowp = gates + (size_t)row * 32 + 8 * fq;
                    *(f32x4*)(rowp) = __builtin_convertvector(__builtin_bit_cast(v4i_t, acc[ai][0][m][0]), f32x4) * c0 * rs; *(f32x4*)(rowp + 4) = __builtin_convertvector(__builtin_bit_cast(v4i_t, acc[ai][0][m][1]), f32x4) * c1 * rs; }
        }
    }
};
struct EpiSwiGLU8I {
    static constexpr bool PERM = true, AFTER_DRAIN = false;
    unsigned char* O; int ldc; const float* sa; const float* sw; const int* pexp; int swstride; int obf16;
    __device__ __forceinline__ void operator()(const f32x4 (&acc)[2][2][4][2], const Unit& u, int wr, int wc, int fr, int fq) const {
        typedef float f32x2 __attribute__((ext_vector_type(2)));
        const int row0 = u.pm * BM + wr * 64 + fr, col0 = u.pn * HALF + wc * 32 + 8 * fq;
        const float* swe = sw + (pexp ? (size_t)__builtin_amdgcn_readfirstlane(pexp[u.pm]) * swstride : (size_t)0) + u.pn * BM + wc * 32 + 8 * fq;
        const f32x4 g0 = *(const f32x4*)(swe), g1 = *(const f32x4*)(swe + 4), u0 = *(const f32x4*)(swe + HALF), u1 = *(const f32x4*)(swe + HALF + 4);
        const float gs[8] = {g0[0], g0[1], g0[2], g0[3], g1[0], g1[1], g1[2], g1[3]}, us[8] = {u0[0], u0[1], u0[2], u0[3], u1[0], u1[1], u1[2], u1[3]};
#pragma unroll
        for (int ai = 0; ai < 2; ++ai)
#pragma unroll
            for (int m = 0; m < 4; ++m) { const int row = row0 + ai * HALF + m * 16; const float rs = sa[row]; unsigned char* rowp = O + (size_t)row * ldc + col0; float r[8];
#pragma unroll
                for (int n = 0; n < 2; ++n) { const v4i_t ig = __builtin_bit_cast(v4i_t, acc[ai][0][m][n]), iu = __builtin_bit_cast(v4i_t, acc[ai][1][m][n]);
#pragma unroll
                    for (int j = 0; j < 4; ++j) { const float g = (float)ig[j] * (gs[4 * n + j] * rs), up = (float)iu[j] * (us[4 * n + j] * rs);
                        r[4 * n + j] = g * __builtin_amdgcn_rcpf(1.0f + __builtin_amdgcn_exp2f(g * -1.4426950408889634f)) * up; } }
                if (obf16) { u32x4 w; w.x = cvt_pk_bf16(r[0], r[1]); w.y = cvt_pk_bf16(r[2], r[3]); w.z = cvt_pk_bf16(r[4], r[5]); w.w = cvt_pk_bf16(r[6], r[7]);
                    *(u32x4*)((bf16_t*)O + (size_t)row * ldc + col0) = w; }
                else { u32x2 w; unsigned t = 0; t = __builtin_amdgcn_cvt_pk_fp8_f32(r[0], r[1], t, false); t = __builtin_amdgcn_cvt_pk_fp8_f32(r[2], r[3], t, true); w.x = t;
                    t = 0; t = __builtin_amdgcn_cvt_pk_fp8_f32(r[4], r[5], t, false); t = __builtin_amdgcn_cvt_pk_fp8_f32(r[6], r[7], t, true); w.y = t;
                    *(u32x2*)(rowp) = w; } }
    }
};

template <bool FP8> struct Frag;
template <> struct Frag<false> { bf16x8 v[2]; };
template <> struct Frag<true> { v8i_t v; };
template <bool FP8> __device__ __forceinline__ void ldfrag(Frag<FP8>& f, const PG8_LAS unsigned char* p) {
    if constexpr (FP8) { const bf16x8 a = *(const PG8_LAS bf16x8*)p, b = *(const PG8_LAS bf16x8*)(p + 1024); f.v = __builtin_bit_cast(v8i_t, __builtin_shufflevector(a, b, 0, 1, 2, 3, 4, 5, 6, 7, 8, 9, 10, 11, 12, 13, 14, 15)); }
    else { f.v[0] = *(const PG8_LAS bf16x8*)p; f.v[1] = *(const PG8_LAS bf16x8*)(p + 1024); }
}
template <class Epi, class Sched, bool ALIGN_EPI = false, bool SP2 = false, int MODE = 0  >
__device__ __forceinline__ void gemm_phase(PG8_LAS unsigned char* lds, const Gemm g, const Sched& S, const Epi& E) {
    int tid = threadIdx.x; asm volatile("" : "+v"(tid)); const int wid = __builtin_amdgcn_readfirstlane(tid >> 6), lane = tid & 63, wr = wid >> 2, wc = wid & 3, fr = lane & 15, fq = lane >> 4;
    constexpr bool FP8 = (MODE == 1);
    const int K = g.K, rowb = (MODE != 0) ? K : 2 * K, nt = rowb / 128;
    unsigned voffA[2], voffB[2];
#pragma unroll
    for (int i = 0; i < 2; ++i) { int R, C; stage_rc(tid * 16 + i * 8192, R, C); const int Rb = Epi::PERM ? ((R & ~31) + perm32(R & 31)) : R;
        voffA[i] = (unsigned)(R * rowb + C * 2); voffB[i] = (unsigned)(Rb * rowb + C * 2); }
    const size_t kstep = (size_t)(BK * 2);
    const size_t hstep = (size_t)HALF * rowb;
    const size_t tstep = 2 * hstep;
    const unsigned ldsw = (unsigned)wid * 1024u;
    const int aoff = lds_byte(wr * 64 + fr, fq * 8), boff = lds_byte(wc * 32 + fr, fq * 8);
#define PG8_SA(b, h) (((b) * 2 + (h)) * HTB)
#define PG8_SB(b, h) ((4 + (b) * 2 + (h)) * HTB)
#define PG8_STAGE(bufoff, gbase, voff) do { _Pragma("unroll") for (int _i = 0; _i < 2; ++_i) \
        __builtin_amdgcn_global_load_lds((const unsigned*)((const char*)(gbase) + (voff)[_i]), (PG8_LAS unsigned*)(lds + (bufoff) + ldsw + _i * 8192), 16, 0, 0); } while (0)
#define PG8_LDA(dst, b, h) do { _Pragma("unroll") for (int m = 0; m < 4; ++m) ldfrag<FP8>(dst[m], lds + PG8_SA(b, h) + aoff + m * 2048); } while (0)
#define PG8_LDB(dst, b, h) do { _Pragma("unroll") for (int n = 0; n < 2; ++n) ldfrag<FP8>(dst[n], lds + PG8_SB(b, h) + boff + n * 2048); } while (0)
#define PG8_MMA(ai, bj, At, Bt) do { __builtin_amdgcn_s_setprio(1); _Pragma("unroll") for (int m = 0; m < 4; ++m) _Pragma("unroll") for (int n = 0; n < 2; ++n) { \
        if constexpr (FP8) { asm volatile("v_mfma_f32_16x16x128_f8f6f4 %0, %1, %2, %0" : "+v"(acc[ai][bj][m][n]) : "v"(Bt[n].v), "v"(At[m].v)); }     \
        else if constexpr (MODE == 2) { _Pragma("unroll") for (int k = 0; k < 2; ++k) acc[ai][bj][m][n] = __builtin_bit_cast(f32x4, __builtin_amdgcn_mfma_i32_16x16x64_i8(__builtin_bit_cast(v4i_t, Bt[n].v[k]), __builtin_bit_cast(v4i_t, At[m].v[k]), __builtin_bit_cast(v4i_t, acc[ai][bj][m][n]), 0, 0, 0)); } \
        else { _Pragma("unroll") for (int k = 0; k < 2; ++k) acc[ai][bj][m][n] = __builtin_amdgcn_mfma_f32_16x16x32_bf16(Bt[n].v[k], At[m].v[k], acc[ai][bj][m][n], 0, 0, 0); } } __builtin_amdgcn_s_setprio(0); } while (0)
#define PG8_WAIT_V(n) asm volatile("s_waitcnt vmcnt(" #n ")" ::: "memory")
#define PG8_WAIT_L(n) asm volatile("s_waitcnt lgkmcnt(" #n ")" ::: "memory")
#define PG8_BAR __builtin_amdgcn_s_barrier()
#define PG8_SCHED __builtin_amdgcn_sched_barrier(0)
    Unit cur, nxt; int ui = 0;
    if (!S.next(0, cur)) return;
    f32x4 acc[2][2][4][2];
#pragma unroll
    for (int a = 0; a < 2; ++a)
#pragma unroll
        for (int b = 0; b < 2; ++b)
#pragma unroll
            for (int m = 0; m < 4; ++m)
#pragma unroll
                for (int n = 0; n < 2; ++n) acc[a][b][m][n] = (f32x4){0.f, 0.f, 0.f, 0.f};
    Frag<FP8> At[4], B0[2], B1[2];
    const char* cA = (const char*)g.A + (size_t)cur.pm * tstep; const char* cB = (const char*)g.Bt + S.boff(cur) + (size_t)cur.pn * tstep;
    S.a_ready(cur);
    if constexpr (SP2) {
        PG8_STAGE(PG8_SB(0, 0), cB, voffB); PG8_STAGE(PG8_SB(0, 1), cB + hstep, voffB); PG8_STAGE(PG8_SA(0, 0), cA, voffA); PG8_STAGE(PG8_SA(0, 1), cA + hstep, voffA);
        if (wr == 1) PG8_BAR;
        PG8_WAIT_V(2); PG8_BAR;
        PG8_STAGE(PG8_SB(1, 0), cB + kstep, voffB); PG8_STAGE(PG8_SA(1, 0), cA + kstep, voffA); PG8_STAGE(PG8_SB(1, 1), cB + hstep + kstep, voffB);
        PG8_WAIT_V(6); PG8_BAR;
    } else {
        PG8_STAGE(PG8_SB(0, 0), cB, voffB); PG8_STAGE(PG8_SA(0, 0), cA, voffA); PG8_STAGE(PG8_SB(0, 1), cB + hstep, voffB); PG8_STAGE(PG8_SA(0, 1), cA + hstep, voffA);
        if (wr == 1) PG8_BAR;
        PG8_WAIT_V(4); PG8_BAR;
        PG8_STAGE(PG8_SB(1, 0), cB + kstep, voffB); PG8_STAGE(PG8_SA(1, 0), cA + kstep, voffA); PG8_STAGE(PG8_SB(1, 1), cB + hstep + kstep, voffB);
        PG8_WAIT_V(6); PG8_BAR;
    }
    for (;;) {
        const bool has_next = S.next(ui + 1, nxt);
        const char* nA = has_next ? (const char*)g.A + (size_t)nxt.pm * tstep : cA; const char* nB = has_next ? (const char*)g.Bt + S.boff(nxt) + (size_t)nxt.pn * tstep : cB;
#pragma unroll 1
        for (int t = 0; t < nt; t += 2) {
            const bool last = (t == nt - 2);
            const char* a1 = cA + (size_t)(t + 1) * kstep;
            const char* a2 = last ? nA : cA + (size_t)(t + 2) * kstep; const char* b2 = last ? nB : cB + (size_t)(t + 2) * kstep;
            const char* a3 = a2 + kstep; const char* b3 = b2 + kstep;
            if (last && has_next) S.a_ready(nxt);
            if constexpr (SP2) {
            PG8_LDB(B0, 0, 0); PG8_LDB(B1, 0, 1); PG8_SCHED; PG8_LDA(At, 0, 0); PG8_STAGE(PG8_SA(1, 1), a1 + hstep, voffA);
            PG8_WAIT_V(8); PG8_WAIT_L(0); PG8_BAR; PG8_MMA(0, 0, At, B0); PG8_MMA(0, 1, At, B1); PG8_BAR; PG8_SCHED;
            PG8_LDA(At, 0, 1); PG8_STAGE(PG8_SB(0, 0), b2, voffB); PG8_STAGE(PG8_SB(0, 1), b2 + hstep, voffB); PG8_STAGE(PG8_SA(0, 0), a2, voffA);
            PG8_WAIT_V(8); PG8_WAIT_L(0); PG8_BAR; PG8_MMA(1, 0, At, B0); PG8_MMA(1, 1, At, B1); PG8_BAR; PG8_SCHED;
            PG8_LDB(B0, 1, 0); PG8_LDB(B1, 1, 1); PG8_SCHED; PG8_LDA(At, 1, 0); PG8_STAGE(PG8_SA(0, 1), a2 + hstep, voffA);
            PG8_WAIT_V(8); PG8_WAIT_L(0); PG8_BAR; PG8_MMA(0, 0, At, B0); PG8_MMA(0, 1, At, B1); PG8_BAR; PG8_SCHED;
            PG8_LDA(At, 1, 1); PG8_STAGE(PG8_SB(1, 0), b3, voffB); PG8_STAGE(PG8_SB(1, 1), b3 + hstep, voffB); PG8_STAGE(PG8_SA(1, 0), a3, voffA);
            PG8_WAIT_V(8); PG8_WAIT_L(0); PG8_BAR; PG8_MMA(1, 0, At, B0); PG8_MMA(1, 1, At, B1); PG8_BAR; PG8_SCHED;
            } else {
            PG8_LDB(B0, 0, 0); PG8_SCHED; PG8_LDA(At, 0, 0); PG8_STAGE(PG8_SA(1, 1), a1 + hstep, voffA);
            PG8_WAIT_L(8); PG8_BAR; PG8_WAIT_L(0); PG8_MMA(0, 0, At, B0); PG8_BAR; PG8_SCHED;
            PG8_LDB(B1, 0, 1); PG8_STAGE(PG8_SB(0, 0), b2, voffB);
            PG8_BAR; PG8_WAIT_L(0); PG8_MMA(0, 1, At, B1); PG8_BAR;
            PG8_LDA(At, 0, 1); PG8_STAGE(PG8_SA(0, 0), a2, voffA);
            PG8_BAR; PG8_WAIT_L(0); PG8_MMA(1, 0, At, B0); PG8_BAR; PG8_SCHED;
            PG8_STAGE(PG8_SB(0, 1), b2 + hstep, voffB);
            PG8_WAIT_V(6); PG8_BAR; PG8_MMA(1, 1, At, B1); PG8_BAR;
            PG8_LDB(B0, 1, 0); PG8_SCHED; PG8_LDA(At, 1, 0); PG8_STAGE(PG8_SA(0, 1), a2 + hstep, voffA);
            PG8_WAIT_L(8); PG8_BAR; PG8_WAIT_L(0); PG8_MMA(0, 0, At, B0); PG8_BAR; PG8_SCHED;
            PG8_LDB(B1, 1, 1); PG8_STAGE(PG8_SB(1, 0), b3, voffB);
            PG8_BAR; PG8_WAIT_L(0); PG8_MMA(0, 1, At, B1); PG8_BAR;
            PG8_LDA(At, 1, 1); PG8_STAGE(PG8_SA(1, 0), a3, voffA);
            PG8_BAR; PG8_WAIT_L(0); PG8_MMA(1, 0, At, B0); PG8_BAR; PG8_SCHED;
            PG8_STAGE(PG8_SB(1, 1), b3 + hstep, voffB);
            PG8_WAIT_V(6); PG8_BAR; PG8_MMA(1, 1, At, B1); PG8_BAR;
            }
        }
        if constexpr (ALIGN_EPI) { if (wr == 0) PG8_BAR; }
        if constexpr (FP8) { asm volatile("s_nop 15\n\ts_nop 15" ::: "memory"); }
        if constexpr (!Epi::AFTER_DRAIN) { E(acc, cur, wr, wc, fr, fq); S.done(cur); }
        if (!has_next) break;
#pragma unroll
        for (int a = 0; a < 2; ++a)
#pragma unroll
            for (int b = 0; b < 2; ++b)
#pragma unroll
                for (int m = 0; m < 4; ++m)
#pragma unroll
                    for (int n = 0; n < 2; ++n) acc[a][b][m][n] = (f32x4){0.f, 0.f, 0.f, 0.f};
        cur = nxt; cA = nA; cB = nB; ++ui;
        if constexpr (ALIGN_EPI) { if (wr == 1) PG8_BAR; }
    }
    PG8_WAIT_V(0);
    if constexpr (!ALIGN_EPI) { if (wr == 0) PG8_BAR; }
    PG8_BAR;
    if constexpr (Epi::AFTER_DRAIN) { E.fused(acc, cur, wr, wc, fr, fq, lds, wid, lane); S.done(cur); }
#undef PG8_SA
#undef PG8_SB
#undef PG8_STAGE
#undef PG8_LDA
#undef PG8_LDB
#undef PG8_MMA
#undef PG8_WAIT_V
#undef PG8_WAIT_L
#undef PG8_BAR
#undef PG8_SCHED
}
}

constexpr int D = 1024, NB = 8, SEQ = 8192, CTXL = 256, DEPTH = 4, GRIDW = 64, ROWS_G = SEQ / GRIDW  ;
constexpr int M_LAT = NB * SEQ  , M_CTX = NB * CTXL  , M_ALL = M_LAT + M_CTX  ;
constexpr int NHEAD = 8, M_DK = 64, M_DV = 128, H_DK = 128, H_DV = 128;
constexpr int NP_M = 3072, NIN_M = 3328, NW_M = 3104, NP_H = 5120;
constexpr int FF = 2816, NGU = 2 * FF, NEXP = 8;
constexpr int MOE_ROWS = 137216, MOE_PANELS = MOE_ROWS / 256;
constexpr float EPS = 1e-6f;
constexpr int NWAVES = 8, NTHR = 512;

constexpr size_t MiB = 1u << 20;
constexpr size_t WS_CTL = 0, CTL_ZERO_BYTES = 936 * 1024;
constexpr size_t WS_MODV = 1 * MiB;
constexpr size_t WS_SMALL = 2 * MiB;
constexpr size_t WS_LATC = 3 * MiB;
constexpr size_t WS_WE = 11 * MiB;
constexpr size_t WS_WO = 37 * MiB;
constexpr size_t WS_U = 181 * MiB;
constexpr size_t WS_GATES = 313 * MiB;
constexpr size_t WS_STATE = 322 * MiB;
constexpr size_t WS_ROUTE = 362 * MiB;
constexpr size_t WS_ACT = 364 * MiB;
constexpr size_t WS_Y = WS_ACT + 700 * MiB;
constexpr size_t WS_END = WS_ACT + 1005 * MiB;
constexpr size_t WE_IN = 0, WE_OUT = 7 * MiB, WE_GU = 9 * MiB, WE_DOWN = 20 * MiB;
constexpr size_t WOD_IN = 0, WOD_OUT = 10 * MiB, WOD_GU = 12 * MiB, WOD_DOWN = 100 * MiB;
constexpr size_t EGU_BYTES = (size_t)NGU * D * 2, EDOWN_BYTES = (size_t)D * FF * 2;
static_assert(WOD_GU + 8 * EGU_BYTES <= WOD_DOWN && WOD_DOWN + 8 * EDOWN_BYTES <= 144 * MiB, "odd weights map");
static_assert((size_t)NIN_M * D * 2 <= 7 * MiB && WE_GU + EGU_BYTES <= WE_DOWN && WE_DOWN + EDOWN_BYTES <= 26 * MiB, "even weights map");
static_assert((size_t)M_ALL * NP_H * 2 <= 700 * MiB && (size_t)MOE_ROWS * D * 2 + (size_t)MOE_ROWS * FF * 2 <= 1005 * MiB && 700 * MiB + (size_t)M_ALL * D * 2 <= 1005 * MiB, "act map");
constexpr int CW_BAR = 4096;
constexpr int CW_ECNT = 8192;
constexpr int CW_DBG = 16384;
constexpr int CW_CMAX = 32768, CM_LSTRIDE = 50176, CM_GU = 3328, CM_GU_O = 5120;
static_assert((size_t)(CW_CMAX + 4 * CM_LSTRIDE) * 4 <= CTL_ZERO_BYTES, "ctl map");
constexpr size_t RT_E = 0;
constexpr size_t RT_R = 512 * 1024;
constexpr size_t RT_W = 512 * 1024 + 1024 * 1024;
constexpr size_t SM_LB = 0;
constexpr size_t SM_PEXP = 64 * 1024;
constexpr size_t SM_EBASE = 96 * 1024;
constexpr size_t SM_SAU = 128 * 1024;
constexpr size_t SM_SAU2 = 400 * 1024;
constexpr size_t SM_SWE = 672 * 1024;
constexpr size_t SM_SWO = 712 * 1024;
constexpr int SWE_IN = 0, SWE_GU = 3328, SWO_IN = 0, SWO_GU = 5120;
static_assert(SM_SAU + (size_t)M_ALL * 4 <= SM_SAU2 && SM_SAU2 + (size_t)M_ALL * 4 <= SM_SWE && SM_SWE + (3328 + 5632) * 4 <= SM_SWO && SM_SWO + (5120 + 8 * 5632) * 4 <= 1024 * 1024, "small region map");
constexpr size_t GATES_SAMOE = (size_t)M_ALL * 32 * 4;
static_assert(GATES_SAMOE + (size_t)MOE_ROWS * 4 <= 9 * MiB, "gates region map");

constexpr int LDS_MAIN = 147456;
constexpr int LDSCTL_OFF = LDS_MAIN;
constexpr int LDS_BYTES = LDS_MAIN + 512;

#define GAS __attribute__((address_space(1)))
#define LAS __attribute__((address_space(3)))
typedef unsigned short bf16;
typedef unsigned v4u __attribute__((ext_vector_type(4)));
typedef unsigned v2u __attribute__((ext_vector_type(2)));
typedef float f32x4 __attribute__((ext_vector_type(4)));
typedef float f32x16 __attribute__((ext_vector_type(16)));
typedef short bf16x8 __attribute__((ext_vector_type(8)));
typedef short s16x4 __attribute__((ext_vector_type(4)));
typedef GAS unsigned gu32;
#define RLX_AGENT __ATOMIC_RELAXED, __HIP_MEMORY_SCOPE_AGENT
#define LDS_WAIT() asm volatile("s_waitcnt lgkmcnt(0)" ::: "memory")
#define VM_WAIT() asm volatile("s_waitcnt vmcnt(0)" ::: "memory")
#define CFENCE() asm volatile("" ::: "memory")
__device__ __forceinline__ unsigned f2bf(float f) { unsigned u = __builtin_bit_cast(unsigned, f); return (u + 0x7fffu + ((u >> 16) & 1u)) >> 16; }
typedef __bf16 bf16x2_t __attribute__((ext_vector_type(2)));
typedef float f32x2_t __attribute__((ext_vector_type(2)));
__device__ __forceinline__ unsigned pk2(float lo, float hi) { f32x2_t v = {lo, hi}; bf16x2_t b = __builtin_convertvector(v, bf16x2_t); return __builtin_bit_cast(unsigned, b); }
__device__ __forceinline__ float bf2f(unsigned short b) { return __builtin_bit_cast(float, (unsigned)b << 16); }
__device__ __forceinline__ float bflo(unsigned w) { return __builtin_bit_cast(float, w << 16); }
__device__ __forceinline__ float bfhi(unsigned w) { return __builtin_bit_cast(float, w & 0xffff0000u); }
__device__ __forceinline__ float sigmoidf_(float x) { return __builtin_amdgcn_rcpf(1.0f + __expf(-x)); }
__device__ __forceinline__ float siluf_(float x) { return x * sigmoidf_(x); }
template <int CTRL, int RM> __device__ __forceinline__ float dppmov(float x) { return __builtin_bit_cast(float, __builtin_amdgcn_update_dpp(0, __builtin_bit_cast(int, x), CTRL, RM, 0xf, false)); }
__device__ __forceinline__ float wave_sum(float v) {
    v += dppmov<0xB1, 0xf>(v); v += dppmov<0x4E, 0xf>(v); v += dppmov<0x141, 0xf>(v); v += dppmov<0x140, 0xf>(v);
    v += dppmov<0x142, 0xa>(v); v += dppmov<0x143, 0xc>(v);
    return __builtin_bit_cast(float, __builtin_amdgcn_readlane(__builtin_bit_cast(int, v), 63));
}

__device__ __forceinline__ float wave_max(float v) {
    v = fmaxf(v, dppmov<0xB1, 0xf>(v)); v = fmaxf(v, dppmov<0x4E, 0xf>(v)); v = fmaxf(v, dppmov<0x141, 0xf>(v)); v = fmaxf(v, dppmov<0x140, 0xf>(v));
    v = fmaxf(v, dppmov<0x142, 0xa>(v)); v = fmaxf(v, dppmov<0x143, 0xc>(v));
    return __builtin_bit_cast(float, __builtin_amdgcn_readlane(__builtin_bit_cast(int, v), 63));
}

#define XB_TMO      128
#define XB_XCNT(j)  (256  + 64 * (j))
#define XB_XSUB(j)  (1280 + 64 * (j))
#define XB_XGEN(j)  (2304 + 64 * (j))
#define XB_TOP      3328
#define XB_TOPGEN   3392
#define XCD_BAR_WORDS 3456
#define XB_SPIN_CAP (1u << 18)
__device__ __forceinline__ unsigned xb_ld(unsigned* p)              { return __hip_atomic_load(p, __ATOMIC_RELAXED, __HIP_MEMORY_SCOPE_AGENT); }
__device__ __forceinline__ unsigned xb_add(unsigned* p, unsigned v) { return __hip_atomic_fetch_add(p, v, __ATOMIC_RELAXED, __HIP_MEMORY_SCOPE_AGENT); }
__device__ __forceinline__ unsigned xb_xcc_id() { return (unsigned)__builtin_amdgcn_s_getreg((3 << 11) | 20) & 0xFu; }
#define XB_SPIN(cond, bar) do { unsigned _sp = 0; while (cond) { __builtin_amdgcn_s_sleep(1); \
    if ((++_sp & 255u) == 0u) { if (xb_ld(&(bar)[XB_TMO])) break; if (_sp > XB_SPIN_CAP) { atomicAdd(&(bar)[XB_TMO], 1u); break; } } } } while (0)
struct XcdBarrier { unsigned* bar; unsigned x; volatile LAS unsigned* st; };
__device__ __forceinline__ XcdBarrier xcd_barrier_post(unsigned* bar, volatile LAS unsigned* st) {
    XcdBarrier b; b.bar = bar; b.x = xb_xcc_id(); b.st = st;
    if (threadIdx.x == 0) (void)xb_add(&bar[XB_XCNT(b.x)], 1u);
    return b;
}
__device__ __forceinline__ void xcd_barrier_complete(unsigned* bar, unsigned x, unsigned& nloc, unsigned& nx) {
    const unsigned G = gridDim.x * gridDim.y * gridDim.z;
    unsigned sum, cnt, mine, sp = 0u;
    for (;;) {
        sum = 0u; cnt = 0u; mine = 0u;
#pragma unroll
        for (unsigned j = 0; j < 16; ++j) { const unsigned c = xb_ld(&bar[XB_XCNT(j)]); sum += c; cnt += (c > 0u) ? 1u : 0u; mine = (j == x) ? c : mine; }
        if (sum == G) break;
        __builtin_amdgcn_s_sleep(1);
        if ((++sp & 255u) == 0u) { if (xb_ld(&bar[XB_TMO])) break; if (sp > XB_SPIN_CAP) { atomicAdd(&bar[XB_TMO], 1u); break; } }
    }
    nloc = mine > 0u ? mine : 1u; nx = cnt > 0u ? cnt : 1u;
}
__device__ __attribute__((noinline)) void xcd_barrier(unsigned* bar_, unsigned bx_, volatile LAS unsigned* st_) { XcdBarrier b; b.bar = bar_; b.x = bx_; b.st = st_;
    asm volatile("s_waitcnt vmcnt(0)" ::: "memory");
    __syncthreads();
    if (threadIdx.x == 0) {
        unsigned* bar = b.bar;
        __builtin_amdgcn_s_waitcnt(0);
        unsigned nloc = b.st[0], nx = b.st[1];
        if (nloc == 0u) { xcd_barrier_complete(bar, b.x, nloc, nx); b.st[0] = nloc; b.st[1] = nx; }
        const unsigned old = xb_add(&bar[XB_XSUB(b.x)], 1u);
        const unsigned gen = old / nloc;
        if (old + 1u == (gen + 1u) * nloc) {
            __builtin_amdgcn_fence(__ATOMIC_RELEASE, "agent");
            asm volatile("s_waitcnt vmcnt(0)" ::: "memory");
            const unsigned og = xb_add(&bar[XB_TOP], 1u);
            const unsigned tg = og / nx;
            if (og + 1u == (tg + 1u) * nx) xb_add(&bar[XB_TOPGEN], 1u);
            else XB_SPIN(xb_ld(&bar[XB_TOPGEN]) == tg, bar);
            __builtin_amdgcn_fence(__ATOMIC_ACQUIRE, "agent");
            xb_add(&bar[XB_XGEN(b.x)], 1u);
            asm volatile("s_waitcnt vmcnt(0)" ::: "memory");
        } else {
            XB_SPIN(xb_ld(&bar[XB_XGEN(b.x)]) == gen, bar);
            __builtin_amdgcn_fence(__ATOMIC_ACQUIRE, "agent");
            asm volatile("s_waitcnt vmcnt(0)" ::: "memory");
        }
    }
    __syncthreads();
}

struct Args {
    const float* in[23];
    float* out; unsigned char* ws;
    int ph_lo, ph_hi;
    int use_bar, pad;
};
struct Frame {
    LAS unsigned char* lds;
    int tid, lane, wave, G, bid;
    unsigned char* ws;
    const float* const __attribute__((address_space(4)))* in;
    float* out;
};
enum { I_X = 0, I_C, I_CTX, I_CCTX, I_MODW, I_MODB, I_NORMG, I_MWIN, I_MBGATE, I_MWCONV, I_MGHEAD, I_MWOUT, I_HWIN, I_HBF, I_HLB, I_HGHEAD, I_HWOUT, I_FWGU, I_FWDOWN, I_EWR, I_EBR, I_EWGU, I_EWDOWN };

#ifndef FP8_LAYERS
#define FP8_LAYERS 0xE
#endif
#define FFN_FP8_L(L) (((FP8_LAYERS) >> (L)) & 1)
#ifndef INPROJ_I8
#define INPROJ_I8 1
#endif
#ifndef UP_I8
#define UP_I8 1
#endif
#ifndef UP_I8_MOE
#define UP_I8_MOE 0
#endif
#ifndef FFN_FP8
#define FFN_FP8 1
#endif
constexpr float WSCALE8 = 64.0f;

__device__ __forceinline__ void phase_mods(Frame& F) {
    LAS float* SV = (LAS float*)(F.lds);
    LAS float* RED = (LAS float*)(F.lds + 9 * 1024 * 4);
    const float* cvec = F.in[I_C]; const float* cctx = F.in[I_CCTX];
    for (int i = F.tid; i < 9 * 1024; i += NTHR) { const int b = i >> 10, k = i & 1023; const float v = b < 8 ? cvec[b * 1024 + k] : cctx[k]; SV[i] = siluf_(v); }
    __syncthreads();
    const float* modw = F.in[I_MODW]; const float* modb = F.in[I_MODB]; const float* normg = F.in[I_NORMG];
    float* modv = (float*)(F.ws + WS_MODV);
    for (int item = F.bid; item < 4 * 96; item += F.G) {
        const int L = item / 96, n0 = (item % 96) * 64;
        const float* wp = modw + (size_t)L * 1024 * 6144 + n0 + F.lane;
        float acc[9];
#pragma unroll
        for (int b = 0; b < 9; ++b) acc[b] = 0.f;
        const int k0 = F.wave * 128;
#pragma unroll 4
        for (int k = 0; k < 128; ++k) { const float wv = wp[(size_t)(k0 + k) * 6144];
#pragma unroll
            for (int b = 0; b < 9; ++b) acc[b] += SV[b * 1024 + k0 + k] * wv; }
#pragma unroll
        for (int b = 0; b < 9; ++b) RED[(F.wave * 9 + b) * 64 + F.lane] = acc[b];
        __syncthreads();
        for (int o = F.tid; o < 9 * 64; o += NTHR) { const int b = o >> 6, l = o & 63; float v = 0.f;
#pragma unroll
            for (int w = 0; w < 8; ++w) v += RED[(w * 9 + b) * 64 + l];
            const int n = n0 + l, s = n >> 10, c = n & 1023; v += modb[L * 6144 + n];
            const float* g = normg + (size_t)L * 4 * 1024;
            int slot; float r;
            if (s == 0) { slot = 1; r = v; } else if (s == 1) { slot = 0; r = g[c] * (1.f + v); } else if (s == 2) { slot = 2; r = v * g[1024 + c]; }
            else if (s == 3) { slot = 4; r = v; } else if (s == 4) { slot = 3; r = g[2048 + c] * (1.f + v); } else { slot = 5; r = v * g[3072 + c]; }
            modv[((size_t)(L * 9 + b) * 6 + slot) * 1024 + c] = r; }
        __syncthreads();
    }
}

struct WDesc { const float* src; unsigned char* dst; const unsigned* cmax; float* sw; int N; int Kb; int mode; };
__device__ __forceinline__ int wrow_gu(int n0) { const int half = n0 / FF, nn = n0 - half * FF; return 256 * (nn >> 7) + 128 * half + (nn & 127); }
__device__ __forceinline__ WDesc wdesc(const float* W, int K, int N, unsigned char* WT, int gu_mode, int mode, const unsigned* cmax, float* sw, int r, int lane) {
    const int nkb = K >> 6, nb = r / nkb, kb = r - nb * nkb, k0 = 64 * kb, n0 = 32 * nb;
    const int row0 = gu_mode ? wrow_gu(n0) : n0; const int esz = mode == 0 ? 2 : 1;
    WDesc d; d.N = N; d.Kb = K * esz; d.mode = mode;
    d.src = W + (size_t)(k0 + (lane >> 3)) * N + n0 + 4 * (lane & 7);
    d.dst = WT + (size_t)(row0 + (lane >> 3)) * d.Kb + (size_t)(k0 + 8 * (lane & 7)) * esz;
    d.cmax = cmax + n0; d.sw = (mode == 2 && kb == 0) ? sw + row0 : nullptr;
    return d;
}
#define WT_DECL(T) f32x4 T##0, T##1, T##2, T##3, T##4, T##5, T##6, T##7
#define WT_LOAD(T, p, N) do { const GAS float* _p = (const GAS float*)(p); const size_t _s = (size_t)8 * (N); \
    T##0 = *(const GAS f32x4*)(_p); T##1 = *(const GAS f32x4*)(_p + _s); T##2 = *(const GAS f32x4*)(_p + 2 * _s); T##3 = *(const GAS f32x4*)(_p + 3 * _s); \
    T##4 = *(const GAS f32x4*)(_p + 4 * _s); T##5 = *(const GAS f32x4*)(_p + 5 * _s); T##6 = *(const GAS f32x4*)(_p + 6 * _s); T##7 = *(const GAS f32x4*)(_p + 7 * _s); } while (0)
#define WT_COPY(A, B) do { A##0 = B##0; A##1 = B##1; A##2 = B##2; A##3 = B##3; A##4 = B##4; A##5 = B##5; A##6 = B##6; A##7 = B##7; } while (0)
__device__ __forceinline__ void wt_put(LAS float* w, int i, const f32x4 v) { w[(8 * i) * 33] = v[0]; w[(8 * i) * 33 + 1] = v[1]; w[(8 * i) * 33 + 2] = v[2]; w[(8 * i) * 33 + 3] = v[3]; }
__device__ __forceinline__ void wt_process(const WDesc& d, const f32x4 t0, const f32x4 t1, const f32x4 t2, const f32x4 t3, const f32x4 t4, const f32x4 t5, const f32x4 t6, const f32x4 t7, LAS float* scr, int lane) {
    LAS float* w = scr + (lane >> 3) * 33 + 4 * (lane & 7);
    wt_put(w, 0, t0); wt_put(w, 1, t1); wt_put(w, 2, t2); wt_put(w, 3, t3); wt_put(w, 4, t4); wt_put(w, 5, t5); wt_put(w, 6, t6); wt_put(w, 7, t7);
    LDS_WAIT(); CFENCE();
    const int c = lane & 7;
#pragma unroll
    for (int j = 0; j < 4; ++j) { const int n = (lane >> 3) + 8 * j; const LAS float* s = scr + (8 * c) * 33 + n;
        float x[8];
#pragma unroll
        for (int e = 0; e < 8; ++e) x[e] = s[e * 33];
        unsigned char* dp = d.dst + (size_t)(8 * j) * d.Kb;
        if (d.mode == 0) { v4u o; o.x = pk2(x[0], x[1]); o.y = pk2(x[2], x[3]); o.z = pk2(x[4], x[5]); o.w = pk2(x[6], x[7]); *(GAS v4u*)dp = o; }
        else if (d.mode == 1) { v2u o; unsigned q = 0; q = __builtin_amdgcn_cvt_pk_fp8_f32(x[0] * WSCALE8, x[1] * WSCALE8, q, false); q = __builtin_amdgcn_cvt_pk_fp8_f32(x[2] * WSCALE8, x[3] * WSCALE8, q, true); o.x = q;
            q = 0; q = __builtin_amdgcn_cvt_pk_fp8_f32(x[4] * WSCALE8, x[5] * WSCALE8, q, false); q = __builtin_amdgcn_cvt_pk_fp8_f32(x[6] * WSCALE8, x[7] * WSCALE8, q, true); o.y = q; *(GAS v2u*)dp = o; }
        else { const float mx = __uint_as_float(d.cmax[n]); const float iv = mx > 0.f ? 127.0f / mx : 0.f; unsigned q[8];
#pragma unroll
            for (int e = 0; e < 8; ++e) q[e] = (unsigned)(int)__builtin_rintf(x[e] * iv) & 0xffu;
            v2u o; o.x = q[0] | (q[1] << 8) | (q[2] << 16) | (q[3] << 24); o.y = q[4] | (q[5] << 8) | (q[6] << 16) | (q[7] << 24); *(GAS v2u*)dp = o;
            if (d.sw != nullptr && c == 0) d.sw[n] = mx > 0.f ? mx * (1.0f / 127.0f) : 1.0f; }
    }
    LDS_WAIT(); CFENCE();
}
__device__ __forceinline__ WDesc wdesc_layer(Frame& F, int L, int it) {
    const int j = L >> 1; int r = it; const unsigned* cm = (const unsigned*)(F.ws + WS_CTL) + CW_CMAX + L * CM_LSTRIDE;
    if ((L & 1) == 0) {
        unsigned char* wb = F.ws + WS_WE; float* swb = (float*)(F.ws + WS_SMALL + SM_SWE);
        constexpr int I0 = 16 * (NW_M / 32), I1 = 16 * 32, I2 = 16 * (NGU / 32);
        if (r < I0) return wdesc(F.in[I_MWIN] + (size_t)j * D * NW_M, D, NW_M, wb + WE_IN, 0, INPROJ_I8 ? 2 : 0, cm, swb + SWE_IN, r, F.lane); r -= I0;
        if (r < I1) return wdesc(F.in[I_MWOUT] + (size_t)j * D * D, D, D, wb + WE_OUT, 0, 0, cm, nullptr, r, F.lane); r -= I1;
        if (r < I2) return wdesc(F.in[I_FWGU] + (size_t)j * D * NGU, D, NGU, wb + WE_GU, 1, UP_I8 ? 2 : (FFN_FP8_L(L) ? 1 : 0), cm + CM_GU, swb + SWE_GU, r, F.lane); r -= I2;
        return wdesc(F.in[I_FWDOWN] + (size_t)j * FF * D, FF, D, wb + WE_DOWN, 0, FFN_FP8_L(L) ? 1 : 0, cm, nullptr, r, F.lane);
    } else {
        unsigned char* wb = F.ws + WS_WO; float* swb = (float*)(F.ws + WS_SMALL + SM_SWO);
        constexpr int I0 = 16 * (NP_H / 32), I1 = 16 * 32, I2 = 16 * (NGU / 32), I3 = (FF / 64) * 32;
        if (r < I0) return wdesc(F.in[I_HWIN] + (size_t)j * D * NP_H, D, NP_H, wb + WOD_IN, 0, INPROJ_I8 ? 2 : 0, cm, swb + SWO_IN, r, F.lane); r -= I0;
        if (r < I1) return wdesc(F.in[I_HWOUT] + (size_t)j * D * D, D, D, wb + WOD_OUT, 0, 0, cm, nullptr, r, F.lane); r -= I1;
        const int e = r / (I2 + I3); r -= e * (I2 + I3);
        if (r < I2) return wdesc(F.in[I_EWGU] + ((size_t)j * NEXP + e) * D * NGU, D, NGU, wb + WOD_GU + e * EGU_BYTES, 1, UP_I8_MOE ? 2 : (FFN_FP8_L(L) ? 1 : 0), cm + CM_GU_O + e * NGU, swb + SWO_GU + e * NGU, r, F.lane); r -= I2;
        return wdesc(F.in[I_EWDOWN] + ((size_t)j * NEXP + e) * FF * D, FF, D, wb + WOD_DOWN + e * EDOWN_BYTES, 0, FFN_FP8_L(L) ? 1 : 0, cm, nullptr, r, F.lane);
    }
}
__device__ __forceinline__ void phase_wconv(Frame& F, int L) {
    LAS float* scr = (LAS float*)(F.lds + F.wave * 16384);
    const int gw = F.bid * NWAVES + F.wave, NGW = F.G * NWAVES;
    const int total = (L & 1) ? 16 * (NP_H / 32) + 16 * 32 + NEXP * (16 * (NGU / 32) + (FF / 64) * 32) : 16 * (NW_M / 32) + 16 * 32 + 16 * (NGU / 32) + (FF / 64) * 32;
    WT_DECL(c); WT_DECL(n); WDesc dc, dn;
    int it = gw;
    if (it < total) { dc = wdesc_layer(F, L, it); WT_LOAD(c, dc.src, dc.N); }
#pragma unroll 1
    for (; it < total; it += NGW) {
        const bool more = it + NGW < total;
        if (more) { dn = wdesc_layer(F, L, it + NGW); WT_LOAD(n, dn.src, dn.N); }
        wt_process(dc, c0, c1, c2, c3, c4, c5, c6, c7, scr, F.lane);
        if (more) { dc = dn; WT_COPY(c, n); }
    }
    if ((L & 1) == 0) {
        unsigned char* wb = F.ws + WS_WE; float* swb = (float*)(F.ws + WS_SMALL + SM_SWE);
        GAS v4u* z = (GAS v4u*)(wb + WE_IN + (size_t)NW_M * D * (INPROJ_I8 ? 1 : 2)); const int nz = (NIN_M - NW_M) * D * (INPROJ_I8 ? 1 : 2) / 16;
        for (int i = F.bid * NTHR + F.tid; i < nz; i += F.G * NTHR) z[i] = (v4u){0u, 0u, 0u, 0u};
        if (INPROJ_I8 && F.bid == 0 && F.tid < NIN_M - NW_M) swb[SWE_IN + NW_M + F.tid] = 1.0f;
    }
}
__device__ __forceinline__ void phase_colmax(Frame& F) {
    const int gw = F.bid * NWAVES + F.wave, NGW = F.G * NWAVES;
    constexpr int TE_IN = 16 * (NW_M / 32), TE_GU = 16 * (NGU / 32), TO_IN = 16 * (NP_H / 32);
    constexpr int TE = (INPROJ_I8 ? TE_IN : 0) + (UP_I8 ? TE_GU : 0), TO = (INPROJ_I8 ? TO_IN : 0) + (UP_I8_MOE ? NEXP * TE_GU : 0), total = 2 * (TE + TO);
#pragma unroll 1
    for (int it = gw; it < total; it += NGW) {
        int r = it; int L; const float* W; int N, nnb, cbase;
        const int pr = r / (TE + TO); r -= pr * (TE + TO);
        if (r < TE) { L = 2 * pr; if (INPROJ_I8 && r < TE_IN) { W = F.in[I_MWIN] + (size_t)pr * D * NW_M; N = NW_M; nnb = NW_M / 32; cbase = 0; } else { if (INPROJ_I8) r -= TE_IN; W = F.in[I_FWGU] + (size_t)pr * D * NGU; N = NGU; nnb = NGU / 32; cbase = CM_GU; } }
        else { r -= TE; L = 2 * pr + 1;
            if (INPROJ_I8 && r < TO_IN) { W = F.in[I_HWIN] + (size_t)pr * D * NP_H; N = NP_H; nnb = NP_H / 32; cbase = 0; }
            else { if (INPROJ_I8) r -= TO_IN; const int e = r / TE_GU; r -= e * TE_GU; W = F.in[I_EWGU] + ((size_t)pr * NEXP + e) * D * NGU; N = NGU; nnb = NGU / 32; cbase = CM_GU_O + e * NGU; } }
        const int kb = r / nnb, nb = r - kb * nnb;
        const float* p = W + (size_t)(64 * kb + (F.lane >> 3)) * N + 32 * nb + 4 * (F.lane & 7);
        WT_DECL(t); WT_LOAD(t, p, N);
        f32x4 mx;
#pragma unroll
        for (int q = 0; q < 4; ++q) { float a = fmaxf(fmaxf(fabsf(t0[q]), fabsf(t1[q])), fmaxf(fabsf(t2[q]), fabsf(t3[q]))); a = fmaxf(a, fmaxf(fmaxf(fabsf(t4[q]), fabsf(t5[q])), fmaxf(fabsf(t6[q]), fabsf(t7[q]))));
            a = fmaxf(a, __shfl_xor(a, 8)); a = fmaxf(a, __shfl_xor(a, 16)); a = fmaxf(a, __shfl_xor(a, 32)); mx[q] = a; }
        if (F.lane < 8) { unsigned* cm = (unsigned*)(F.ws + WS_CTL) + CW_CMAX + L * CM_LSTRIDE + cbase + 32 * nb + 4 * F.lane;
#pragma unroll
            for (int q = 0; q < 4; ++q) atomicMax(cm + q, __float_as_uint(mx[q])); }
    }
}

struct TokCfg {
    const void* lat_src_l; const void* lat_src_c;
    void* lat_dst_l; void* lat_dst_c;
    int src_f32, dst_f32;
    const bf16* y; int y_perm; int moe_combine;
    const float* vupd;
    const float* vna; const float* vnb;
    bf16* u; int u_perm; int u_fp8;
    float* u_scale;
    int route; int jr;
    int nrows;
};
__device__ __forceinline__ int perm_cm(int t) { return (t & 63) * ROWS_G + (t >> 6); }

struct RowRaw { v4u l0, l1, l2, l3; v2u a0, a1, a2, a3, b0, b1, b2, b3; };
__device__ __forceinline__ RowRaw tok_issue(const TokCfg& T, int row, int p0, int p1, int lane) {
    RowRaw R; const v4u z4 = (v4u){0u, 0u, 0u, 0u}; const v2u z2 = (v2u){0u, 0u};
    R.l0 = z4; R.l1 = z4; R.l2 = z4; R.l3 = z4; R.a0 = z2; R.a1 = z2; R.a2 = z2; R.a3 = z2; R.b0 = z2; R.b1 = z2; R.b2 = z2; R.b3 = z2;
    if (T.src_f32) { const GAS v4u* lp = (const GAS v4u*)(row < M_LAT ? (const float*)T.lat_src_l + (size_t)row * D : (const float*)T.lat_src_c + (size_t)(row - M_LAT) * D) + lane;
        R.l0 = lp[0]; R.l1 = lp[64]; R.l2 = lp[128]; R.l3 = lp[192]; }
    else { const GAS v2u* lp = (const GAS v2u*)(row < M_LAT ? (const bf16*)T.lat_src_l + (size_t)row * D : (const bf16*)T.lat_src_c + (size_t)(row - M_LAT) * D) + lane;
        const v2u a = lp[0], b = lp[64], c = lp[128], d = lp[192]; R.l0.x = a.x; R.l0.y = a.y; R.l1.x = b.x; R.l1.y = b.y; R.l2.x = c.x; R.l2.y = c.y; R.l3.x = d.x; R.l3.y = d.y; }
    if (T.y) {
        if (T.moe_combine) { const GAS v2u* ya = (const GAS v2u*)(T.y + (size_t)p0 * D) + lane; const GAS v2u* yb = (const GAS v2u*)(T.y + (size_t)p1 * D) + lane;
            R.a0 = ya[0]; R.a1 = ya[64]; R.a2 = ya[128]; R.a3 = ya[192]; R.b0 = yb[0]; R.b1 = yb[64]; R.b2 = yb[128]; R.b3 = yb[192]; }
        else { int yr = row; if (T.y_perm && row < M_LAT) yr = (row & ~8191) + perm_cm(row & 8191);
            const GAS v2u* yp = (const GAS v2u*)(T.y + (size_t)yr * D) + lane; R.a0 = yp[0]; R.a1 = yp[64]; R.a2 = yp[128]; R.a3 = yp[192]; }
    }
    return R;
}
__device__ __forceinline__ void phase_tok(Frame& F, const TokCfg& T) {
    const int gw = F.bid * NWAVES + F.wave, NGW = F.G * NWAVES;
    const int R = (T.nrows + NGW - 1) / NGW; const int r0 = gw * R; int r1 = r0 + R; if (r1 > T.nrows) r1 = T.nrows;
    LAS float* WR = (LAS float*)F.lds;
    if (T.route) { const float* wr = F.in[I_EWR] + (size_t)T.jr * 1024 * 8; for (int i = F.tid; i < 8192; i += NTHR) WR[i] = wr[i]; }
    __syncthreads();
    f32x4 VU[4], VA[4], VB[4]; int curb = -1;
    int my_e0 = 0, my_e1 = 0; float my_w = 0.f;
    const int* rrp = (const int*)(F.ws + WS_ROUTE + RT_R); const float* rwp = (const float*)(F.ws + WS_ROUTE + RT_W);
    int p0c = 0, p1c = 0, p0n = 0, p1n = 0; float w0c = 0.f, w0n = 0.f;
    if (T.moe_combine && r0 < r1) { p0c = rrp[2 * r0]; p1c = rrp[2 * r0 + 1]; w0c = rwp[r0]; if (r0 + 1 < r1) { p0n = rrp[2 * r0 + 2]; p1n = rrp[2 * r0 + 3]; w0n = rwp[r0 + 1]; } }
    RowRaw C = tok_issue(T, r0 < r1 ? r0 : 0, p0c, p1c, F.lane);
    for (int row = r0; row < r1; ++row) {
        const bool hn = row + 1 < r1;
        int p0nn = 0, p1nn = 0; float w0nn = 0.f;
        const RowRaw N = tok_issue(T, hn ? row + 1 : row, p0n, p1n, F.lane);
        if (hn) {
            if (T.moe_combine && row + 2 < r1) { p0nn = rrp[2 * row + 4]; p1nn = rrp[2 * row + 5]; w0nn = rwp[row + 2]; } }
        const int b = row < M_LAT ? (row >> 13) : 8;
        if (b != curb) { curb = b;
#pragma unroll
            for (int j = 0; j < 4; ++j) {
                if (T.y) VU[j] = ((const f32x4*)(T.vupd + (size_t)b * 6144))[F.lane + 64 * j];
                if (T.vna) { VA[j] = ((const f32x4*)(T.vna + (size_t)b * 6144))[F.lane + 64 * j]; VB[j] = ((const f32x4*)(T.vnb + (size_t)b * 6144))[F.lane + 64 * j]; } } }
        f32x4 v[4];
        if (T.src_f32) {
            v[0] = __builtin_bit_cast(f32x4, C.l0); v[1] = __builtin_bit_cast(f32x4, C.l1); v[2] = __builtin_bit_cast(f32x4, C.l2); v[3] = __builtin_bit_cast(f32x4, C.l3); }
        else {
            const v4u cl[4] = {C.l0, C.l1, C.l2, C.l3};
#pragma unroll
            for (int j = 0; j < 4; ++j) v[j] = (f32x4){bflo(cl[j].x), bfhi(cl[j].x), bflo(cl[j].y), bfhi(cl[j].y)}; }
        if (T.y) {
            f32x4 yv[4]; const v2u cya[4] = {C.a0, C.a1, C.a2, C.a3}, cyb[4] = {C.b0, C.b1, C.b2, C.b3};
            if (T.moe_combine) { const float w0 = w0c, w1 = 1.f - w0c;
#pragma unroll
                for (int j = 0; j < 4; ++j) { const v2u a = cya[j], c = cyb[j];
                    yv[j] = (f32x4){w0 * bflo(a.x) + w1 * bflo(c.x), w0 * bfhi(a.x) + w1 * bfhi(c.x), w0 * bflo(a.y) + w1 * bflo(c.y), w0 * bfhi(a.y) + w1 * bfhi(c.y)}; }
            } else {
#pragma unroll
                for (int j = 0; j < 4; ++j) { const v2u a = cya[j]; yv[j] = (f32x4){bflo(a.x), bfhi(a.x), bflo(a.y), bfhi(a.y)}; }
            }
            float ss = 0.f;
#pragma unroll
            for (int j = 0; j < 4; ++j) ss += (yv[j].x * yv[j].x + yv[j].y * yv[j].y) + (yv[j].z * yv[j].z + yv[j].w * yv[j].w);
            const float rs = rsqrtf(wave_sum(ss) * (1.f / D) + EPS);
#pragma unroll
            for (int j = 0; j < 4; ++j) v[j] = v[j] + VU[j] * (yv[j] * rs);
        }
        void* dpv = row < M_LAT ? T.lat_dst_l : T.lat_dst_c;
        if (dpv) { const size_t ro = (size_t)(row < M_LAT ? row : row - M_LAT) * D;
            if (T.dst_f32) { float* dp = (float*)dpv + ro;
#pragma unroll
                for (int j = 0; j < 4; ++j) ((GAS f32x4*)dp)[F.lane + 64 * j] = v[j]; }
            else { bf16* dp = (bf16*)dpv + ro;
#pragma unroll
                for (int j = 0; j < 4; ++j) { v2u o; o.x = pk2(v[j].x, v[j].y); o.y = pk2(v[j].z, v[j].w); ((GAS v2u*)dp)[F.lane + 64 * j] = o; } } }
        if (T.vna) {
            float ss = 0.f;
#pragma unroll
            for (int j = 0; j < 4; ++j) ss += (v[j].x * v[j].x + v[j].y * v[j].y) + (v[j].z * v[j].z + v[j].w * v[j].w);
            const float rs = rsqrtf(wave_sum(ss) * (1.f / D) + EPS);
            f32x4 uu[4];
#pragma unroll
            for (int j = 0; j < 4; ++j) uu[j] = (v[j] * rs) * VA[j] + VB[j];
            int ur = row; if (T.u_perm && row < M_LAT) ur = (row & ~8191) + perm_cm(row & 8191);
            if (T.u_fp8 == 2) { GAS unsigned* up8 = (GAS unsigned*)((unsigned char*)T.u + (size_t)ur * D);
                float mx = 0.f;
#pragma unroll
                for (int j = 0; j < 4; ++j) mx = fmaxf(fmaxf(mx, fmaxf(fabsf(uu[j].x), fabsf(uu[j].y))), fmaxf(fabsf(uu[j].z), fabsf(uu[j].w)));
                mx = wave_max(mx); const float iv = mx > 0.f ? 127.0f / mx : 0.f;
#pragma unroll
                for (int j = 0; j < 4; ++j) { const unsigned q0 = (unsigned)(int)__builtin_rintf(uu[j].x * iv) & 0xffu, q1 = (unsigned)(int)__builtin_rintf(uu[j].y * iv) & 0xffu, q2 = (unsigned)(int)__builtin_rintf(uu[j].z * iv) & 0xffu, q3 = (unsigned)(int)__builtin_rintf(uu[j].w * iv);
                    up8[F.lane + 64 * j] = q0 | (q1 << 8) | (q2 << 16) | (q3 << 24); }
                if (F.lane == 0) T.u_scale[ur] = mx > 0.f ? mx * (1.0f / 127.0f) : 1.0f; }
            else if (T.u_fp8) { GAS unsigned* up8 = (GAS unsigned*)((unsigned char*)T.u + (size_t)ur * D);
#pragma unroll
                for (int j = 0; j < 4; ++j) { unsigned w = 0; w = __builtin_amdgcn_cvt_pk_fp8_f32(uu[j].x, uu[j].y, w, false); w = __builtin_amdgcn_cvt_pk_fp8_f32(uu[j].z, uu[j].w, w, true); up8[F.lane + 64 * j] = w; } }
            else { GAS v2u* up = (GAS v2u*)(T.u + (size_t)ur * D);
#pragma unroll
                for (int j = 0; j < 4; ++j) { v2u o; o.x = pk2(uu[j].x, uu[j].y); o.y = pk2(uu[j].z, uu[j].w); up[F.lane + 64 * j] = o; } }
            if (T.route) {
                float lg[8];
#pragma unroll
                for (int e = 0; e < 8; ++e) lg[e] = 0.f;
#pragma unroll
                for (int j = 0; j < 4; ++j)
#pragma unroll
                    for (int i = 0; i < 4; ++i) { const int c = 4 * (F.lane + 64 * j) + i; const f32x4 wa = *(const LAS f32x4*)(WR + c * 8), wb = *(const LAS f32x4*)(WR + c * 8 + 4); const float x = uu[j][i];
                        lg[0] += x * wa.x; lg[1] += x * wa.y; lg[2] += x * wa.z; lg[3] += x * wa.w; lg[4] += x * wb.x; lg[5] += x * wb.y; lg[6] += x * wb.z; lg[7] += x * wb.w; }
                const float* br = F.in[I_EBR] + T.jr * 8;
#pragma unroll
                for (int e = 0; e < 8; ++e) lg[e] = wave_sum(lg[e]) + br[e];
                int e0 = 0; float v0 = lg[0];
#pragma unroll
                for (int e = 1; e < 8; ++e) if (lg[e] > v0) { v0 = lg[e]; e0 = e; }
                int e1 = -1; float v1 = -3.0e38f;
#pragma unroll
                for (int e = 0; e < 8; ++e) if (e != e0 && lg[e] > v1) { v1 = lg[e]; e1 = e; }
                const float w0 = 1.f / (1.f + __expf(v1 - v0));
                if (F.lane == row - r0) { my_e0 = e0; my_e1 = e1; my_w = w0; }
            }
        }
        if (hn) { C = N; p0n = p0nn; p1n = p1nn; w0c = w0n; w0n = w0nn; }
    }
    if (T.route) {
        const int n = r1 - r0; const bool act = F.lane < n; const int row = r0 + F.lane;
        unsigned* ecnt = (unsigned*)(F.ws + WS_CTL) + CW_ECNT + T.jr * 8 * 64;
        int rk0 = 0, rk1 = 0;
        const unsigned long long ltmask = (F.lane == 0) ? 0ull : (~0ull >> (64 - F.lane));
#pragma unroll
        for (int e = 0; e < 8; ++e) {
            const unsigned long long m0 = __ballot(act && my_e0 == e), m1 = __ballot(act && my_e1 == e);
            const int c0 = __popcll(m0), c1 = __popcll(m1);
            unsigned base = 0;
            if (c0 + c1 > 0) { if (F.lane == 0) base = __hip_atomic_fetch_add(ecnt + e * 64, (unsigned)(c0 + c1), RLX_AGENT); base = __builtin_amdgcn_readfirstlane(base); }
            if (my_e0 == e) rk0 = (int)base + __popcll(m0 & ltmask);
            if (my_e1 == e) rk1 = (int)base + c0 + __popcll(m1 & ltmask);
        }
        if (act) { ((int*)(F.ws + WS_ROUTE + RT_E))[row] = my_e0 | (my_e1 << 8); ((int*)(F.ws + WS_ROUTE + RT_R))[2 * row] = rk0; ((int*)(F.ws + WS_ROUTE + RT_R))[2 * row + 1] = rk1;
            ((float*)(F.ws + WS_ROUTE + RT_W))[row] = my_w; }
    }
}

__device__ __forceinline__ void phase_moe_scatter(Frame& F, int jr, int nrows, const unsigned char* U, unsigned char* AM, int rowb, const float* sa_src, float* sa_dst) {
    const unsigned* ecnt = (const unsigned*)(F.ws + WS_CTL) + CW_ECNT + jr * 8 * 64;
    int base[8]; int acc = 0;
#pragma unroll
    for (int e = 0; e < 8; ++e) { const int c = (int)__hip_atomic_load(ecnt + e * 64, RLX_AGENT); base[e] = acc; acc += (c + 255) & ~255; }
    int* pexp = (int*)(F.ws + WS_SMALL + SM_PEXP);
    if (F.bid == 0) { const int np = acc >> 8;
        for (int p = F.tid; p < np; p += NTHR) { int e = 0;
#pragma unroll
            for (int q = 1; q < 8; ++q) if (p * 256 >= base[q]) e = q;
            pexp[p] = e; }
        if (F.tid == 0) pexp[MOE_PANELS] = np; }
    const int gw = F.bid * NWAVES + F.wave, NGW = F.G * NWAVES;
    const int R = (nrows + NGW - 1) / NGW; const int r0 = gw * R; int r1 = r0 + R; if (r1 > nrows) r1 = nrows;
    int* rr = (int*)(F.ws + WS_ROUTE + RT_R); const int* re = (const int*)(F.ws + WS_ROUTE + RT_E);
    for (int row = r0; row < r1; ++row) {
        const int ee = re[row], e0 = ee & 255, e1 = ee >> 8; int b0 = 0, b1 = 0;
#pragma unroll
        for (int e = 0; e < 8; ++e) { if (e0 == e) b0 = base[e]; if (e1 == e) b1 = base[e]; }
        const int p0 = b0 + rr[2 * row], p1 = b1 + rr[2 * row + 1];
        const v4u* src = (const v4u*)(U + (size_t)row * rowb); v4u* d0 = (v4u*)(AM + (size_t)p0 * rowb); v4u* d1 = (v4u*)(AM + (size_t)p1 * rowb);
        const v4u a = src[F.lane]; d0[F.lane] = a; d1[F.lane] = a;
        if (rowb > 1024) { const v4u c = src[F.lane + 64]; d0[F.lane + 64] = c; d1[F.lane + 64] = c; }
        CFENCE();
        if (F.lane == 0) { rr[2 * row] = p0; rr[2 * row + 1] = p1; if (sa_src) { const float s = sa_src[row]; sa_dst[p0] = s; sa_dst[p1] = s; } }
    }
}

#define MFMA32(a, b, c) __builtin_amdgcn_mfma_f32_32x32x16_bf16((a), (b), (c), 0, 0, 0)
typedef short v4i16_t __attribute__((ext_vector_type(4)));
typedef LAS unsigned char* ldsp;
__device__ __forceinline__ unsigned cvtpk(float lo, float hi) { f32x2_t v = {lo, hi}; bf16x2_t b = __builtin_convertvector(v, bf16x2_t); return __builtin_bit_cast(unsigned, b); }
__device__ __forceinline__ int crow(int reg, int h) { return (reg & 3) + 8 * (reg >> 2) + 4 * h; }
__device__ __forceinline__ bf16x8 pack8(const f32x16& x, int s) {
    v4u p; p.x = cvtpk(x[8 * s], x[8 * s + 1]); p.y = cvtpk(x[8 * s + 2], x[8 * s + 3]); p.z = cvtpk(x[8 * s + 4], x[8 * s + 5]); p.w = cvtpk(x[8 * s + 6], x[8 * s + 7]);
    return __builtin_bit_cast(bf16x8, p);
}
__device__ __forceinline__ bf16x8 lds16(ldsp p) { return *(const LAS bf16x8*)p; }
__device__ __forceinline__ bf16x8 lds8x2(ldsp p) { const s16x4 lo = *(const LAS s16x4*)p, hi = *(const LAS s16x4*)(p + 16); return __builtin_shufflevector(lo, hi, 0, 1, 2, 3, 4, 5, 6, 7); }
__device__ __forceinline__ s16x4 tr16(ldsp p) { return __builtin_bit_cast(s16x4, __builtin_amdgcn_ds_read_tr16_b64_v4i16((LAS v4i16_t*)p)); }
__device__ __forceinline__ bf16x8 ldstr2(ldsp p, int second) { const s16x4 lo = tr16(p), hi = tr16(p + second); return __builtin_shufflevector(lo, hi, 0, 1, 2, 3, 4, 5, 6, 7); }
__device__ __forceinline__ f32x16 zero16() { f32x16 z;
#pragma unroll
    for (int i = 0; i < 16; ++i) z[i] = 0.f; return z; }
__device__ __forceinline__ void unpack8(const v4u& w, float (&x)[8]) { x[0] = bflo(w.x); x[1] = bfhi(w.x); x[2] = bflo(w.y); x[3] = bfhi(w.y); x[4] = bflo(w.z); x[5] = bfhi(w.z); x[6] = bflo(w.w); x[7] = bfhi(w.w); }
__device__ __forceinline__ int launder_v(int x) { asm volatile("" : "+v"(x)); return x; }
struct FragOff { int o_row, o_perm, o_trn, o_trp; };
__device__ __forceinline__ FragOff frag_off(int lane, int LD) {
    const int r = lane & 31, hh = lane >> 5, i16 = lane & 15, q = i16 >> 2, p = i16 & 3, blk = (lane >> 4) & 1; FragOff f;
    f.o_row = (r * LD + 8 * hh) * 2; f.o_perm = (r * LD + 4 * hh) * 2;
    f.o_trn = ((8 * hh + q) * LD + 16 * blk + 4 * p) * 2; f.o_trp = ((4 * hh + q) * LD + 16 * blk + 4 * p) * 2; return f;
}


template <int CTRL, int RM, int BM> __device__ __forceinline__ float dpp_f(float old, float x) {
    return __builtin_bit_cast(float, __builtin_amdgcn_update_dpp(__builtin_bit_cast(int, old), __builtin_bit_cast(int, x), CTRL, RM, BM, false)); }
__device__ __forceinline__ float wave_scan_add(float x) {
    float r = x;
    r += dpp_f<0x111, 0xf, 0xf>(0.f, x); r += dpp_f<0x112, 0xf, 0xf>(0.f, x); r += dpp_f<0x113, 0xf, 0xf>(0.f, x);
    r += dpp_f<0x114, 0xf, 0xe>(0.f, r); r += dpp_f<0x118, 0xf, 0xc>(0.f, r);
    r += dpp_f<0x142, 0xa, 0xf>(0.f, r); r += dpp_f<0x143, 0xc, 0xf>(0.f, r);
    return r;
}
__device__ __forceinline__ float wave_scan_max(float x) {
    const float NEG = -3.0e38f; float r = x;
    r = fmaxf(r, dpp_f<0x111, 0xf, 0xf>(NEG, x)); r = fmaxf(r, dpp_f<0x112, 0xf, 0xf>(NEG, x)); r = fmaxf(r, dpp_f<0x113, 0xf, 0xf>(NEG, x));
    r = fmaxf(r, dpp_f<0x114, 0xf, 0xe>(NEG, r)); r = fmaxf(r, dpp_f<0x118, 0xf, 0xc>(NEG, r));
    r = fmaxf(r, dpp_f<0x142, 0xa, 0xf>(NEG, r)); r = fmaxf(r, dpp_f<0x143, 0xc, 0xf>(NEG, r));
    return r;
}
__device__ __forceinline__ float lane63(float x) { return __builtin_bit_cast(float, __builtin_amdgcn_readlane(__builtin_bit_cast(int, x), 63)); }
__device__ __forceinline__ float sum_halves(float x) {
    const unsigned u = __builtin_bit_cast(unsigned, x); auto rr = __builtin_amdgcn_permlane32_swap(u, u, false, false);
    return __builtin_bit_cast(float, (unsigned)rr[0]) + __builtin_bit_cast(float, (unsigned)rr[1]); }

__device__ __forceinline__ void item_headnorm(int tid, const bf16* hf, const bf16* hb, const bf16* gate, int gpitch, int gcol, const float* gh_head, bf16* aout, int rowbase, int t0, int ntok, int h) {
    VM_WAIT(); __syncthreads();
    const int sub = tid & 7, rr = tid >> 3;
    float gh[16];
#pragma unroll
    for (int e = 0; e < 16; ++e) gh[e] = gh_head[sub * 16 + e];
#pragma unroll 4
    for (int row = rr; row < ntok; row += 64) {
        const size_t grow = (size_t)(rowbase + t0 + row);
        const size_t o = grow * D + h * 128 + sub * 16;
        const v4u a0 = *(const GAS v4u*)(hf + o), a1 = *(const GAS v4u*)(hf + o + 8), b0 = *(const GAS v4u*)(hb + o), b1 = *(const GAS v4u*)(hb + o + 8);
        const bf16* gp = gate + grow * gpitch + gcol + h * 128 + sub * 16; const v4u g0 = *(const GAS v4u*)gp, g1 = *(const GAS v4u*)(gp + 8);
        float x[16], y[8];
        unpack8(a0, y);
#pragma unroll
        for (int e = 0; e < 8; ++e) x[e] = y[e];
        unpack8(a1, y);
#pragma unroll
        for (int e = 0; e < 8; ++e) x[8 + e] = y[e];
        unpack8(b0, y);
#pragma unroll
        for (int e = 0; e < 8; ++e) x[e] += y[e];
        unpack8(b1, y);
#pragma unroll
        for (int e = 0; e < 8; ++e) x[8 + e] += y[e];
        float ss = 0.f;
#pragma unroll
        for (int e = 0; e < 16; ++e) ss += x[e] * x[e];
        ss += __shfl_xor(ss, 1); ss += __shfl_xor(ss, 2); ss += __shfl_xor(ss, 4);
        const float rs = rsqrtf(ss * (1.f / 128.f) + EPS);
        float o16[16];
        unpack8(g0, y);
#pragma unroll
        for (int e = 0; e < 8; ++e) o16[e] = x[e] * rs * gh[e] * sigmoidf_(y[e]);
        unpack8(g1, y);
#pragma unroll
        for (int e = 0; e < 8; ++e) o16[8 + e] = x[8 + e] * rs * gh[8 + e] * sigmoidf_(y[e]);
        v4u w0, w1; w0.x = pk2(o16[0], o16[1]); w0.y = pk2(o16[2], o16[3]); w0.z = pk2(o16[4], o16[5]); w0.w = pk2(o16[6], o16[7]); w1.x = pk2(o16[8], o16[9]); w1.y = pk2(o16[10], o16[11]); w1.z = pk2(o16[12], o16[13]); w1.w = pk2(o16[14], o16[15]);
        *(GAS v4u*)(aout + o) = w0; *(GAS v4u*)(aout + o + 8) = w1;
    }
}

#ifndef SCAN_PF_OUT
#define SCAN_PF_OUT 1
#endif
constexpr int ML_LDQ = 72, ML_LDV = 136;
constexpr int ML_QC = 0, ML_KC = 9216, ML_KH = 18432, ML_V = 27648, ML_GS = 45056, ML_OB = 50176, ML_NV = 68608, ML_SSQ = 70656, ML_INV = 71680, ML_GROUP = 73728;
static_assert(2 * ML_GROUP <= LDS_MAIN, "mLSTM LDS map");
constexpr int ML_STATE_F = 8448;

struct MlPref { v4u q[2], k[2], v[4]; float gi, gf; };
struct MlSeg { int rowbase; int len; int t0; int nchunk; };

__device__ __forceinline__ void ml_issue(MlPref& P, const bf16* proj, const bf16* qkc, const float* gates, int rowbase, int t0c, int g, int h, int tg, int lane, bool need_q) {
    const int c8q = tg & 7;
#pragma unroll
    for (int i = 0; i < 2; ++i) { const int tau = (tg + 256 * i) >> 3; const int t = t0c + (g ? 63 - tau : tau);
        const bf16* rp = qkc + (size_t)(rowbase + t) * D + h * 64 + c8q * 8;
        P.q[i] = need_q ? *(const GAS v4u*)rp : (v4u){0u, 0u, 0u, 0u}; P.k[i] = *(const GAS v4u*)(rp + 512); }
#pragma unroll
    for (int i = 0; i < 4; ++i) { const int p = tg + 256 * i, tau = p >> 4, c8 = p & 15; const int t = t0c + (g ? 63 - tau : tau);
        P.v[i] = *(const GAS v4u*)(proj + (size_t)(rowbase + t) * NP_M + 1024 + h * 128 + c8 * 8); }
    { const int t = t0c + (g ? 63 - lane : lane); const GAS float* gp = (const GAS float*)(gates + (size_t)(rowbase + t) * 32 + g * 16 + h); P.gi = gp[0]; P.gf = gp[8]; }
}

struct MlFin { v4u pa0, pa1, ga0, ga1; };
__device__ __forceinline__ void ml_issue_fin(MlFin& Fn, const bf16* part, const bf16* proj, int rowbase, int t0c, int tt, int g, int h, int j, int lns) {
    const int tau = 32 * tt + (lns >> 1); const int t = t0c + (g ? 63 - tau : tau); const int col = h * 128 + 32 * j + 16 * (lns & 1);
    const bf16* pp = part + (size_t)(rowbase + t) * D + col; const bf16* gp = proj + (size_t)(rowbase + t) * NP_M + 2048 + col;
    Fn.pa0 = *(const GAS v4u*)pp; Fn.pa1 = *(const GAS v4u*)(pp + 8); Fn.ga0 = *(const GAS v4u*)gp; Fn.ga1 = *(const GAS v4u*)(gp + 8);
}
__device__ __forceinline__ void ml_fin_store(const float (&y)[16], const LAS float* ssq, bf16* op) {
    const f32x4 sq = *(const LAS f32x4*)ssq; const float rs = rsqrtf(((sq[0] + sq[1]) + (sq[2] + sq[3])) * (1.f / 128.f) + EPS);
    v4u w0, w1; w0.x = pk2(y[0] * rs, y[1] * rs); w0.y = pk2(y[2] * rs, y[3] * rs); w0.z = pk2(y[4] * rs, y[5] * rs); w0.w = pk2(y[6] * rs, y[7] * rs);
    w1.x = pk2(y[8] * rs, y[9] * rs); w1.y = pk2(y[10] * rs, y[11] * rs); w1.z = pk2(y[12] * rs, y[13] * rs); w1.w = pk2(y[14] * rs, y[15] * rs);
    *(GAS v4u*)op = w0; *(GAS v4u*)(op + 8) = w1;
}
template <bool OUTPUT>
__device__ __forceinline__ void mlstm_item(Frame& F, const bf16* proj, const bf16* qkc, const float* gates, bf16* hx0, bf16* hx1, bf16* aout, const float* ghead,
                                           int h, MlSeg S0, MlSeg S1, const float* st_in0, const float* st_in1, int npre0, int npre1, float* st_out0, float* st_out1) {
    const int tid_l = launder_v(F.tid); const int wave_l = __builtin_amdgcn_readfirstlane(tid_l >> 6);
    const int g = wave_l >> 2, j = wave_l & 3, tg = tid_l & 255, lane = tid_l & 63, r = lane & 31, hh = lane >> 5;
    const ldsp gb = F.lds + g * ML_GROUP;
    const ldsp GSb = gb + ML_GS + j * 1280;
    LAS float* GS = (LAS float*)GSb;
    const ldsp OBb = gb + ML_OB + j * 4608;
    LAS float* NV = (LAS float*)(gb + ML_NV);
    LAS float* SSQ = (LAS float*)(gb + ML_SSQ);
    const ldsp INVb = gb + ML_INV + j * 256;
    const int rowbase = g ? S1.rowbase : S0.rowbase, seg_t0 = g ? S1.t0 : S0.t0, nch = g ? S1.nchunk : S0.nchunk;
    const int vcol = 64 * j;
    __syncthreads();
    f32x16 C[2]; C[0] = zero16(); C[1] = zero16();
    float m_prev = -1.0e30f, btot = 0.f;
    float nreg = 0.f;
    if (OUTPUT) {
        const float* sp = g ? st_in1 : st_in0; const int np = g ? npre1 : npre0;
#pragma unroll 1
        for (int k = 0; k < np; ++k) { const float* e = sp + (size_t)k * ML_STATE_F;
            const float mloc = e[8192 + 64], B = e[8192 + 65];
            const float mnew = fmaxf(B + m_prev, mloc), al = __expf(B + m_prev - mnew), be = __expf(mloc - mnew);
            const float* ep = e + (4 * hh) * 128 + 32 * j + r;
#pragma unroll
            for (int dt = 0; dt < 2; ++dt)
#pragma unroll
                for (int i = 0; i < 16; ++i) C[dt][i] = al * C[dt][i] + be * ep[(32 * dt + (i & 3) + 8 * (i >> 2)) * 128];
            nreg = al * nreg + be * e[8192 + 16 * j + (lane & 15)];
            m_prev = mnew; }
    }
    if (lane < 16) NV[16 * j + lane] = nreg;
    LAS float* GH = (LAS float*)(gb + ML_KC);
    if (OUTPUT && tg < 128) GH[tg] = ghead[h * 128 + tg];
    float yv0[16], yv1[16]; bool pend = false; int pend_t = 0; MlFin FN0, FN1; FN0.pa0 = FN0.pa1 = FN0.ga0 = FN0.ga1 = FN1.pa0 = FN1.pa1 = FN1.ga0 = FN1.ga1 = (v4u){0u, 0u, 0u, 0u};
#pragma unroll
    for (int e = 0; e < 16; ++e) { yv0[e] = 0.f; yv1[e] = 0.f; }
    const int hmid = nch >> 1;
    constexpr int NPF = OUTPUT ? SCAN_PF_OUT : 2;
    MlPref PP[NPF]; ml_issue(PP[0], proj, qkc, gates, rowbase, seg_t0 + 64 * (g ? nch - 1 : 0), g, h, tg, lane, OUTPUT);
    if (NPF == 2) ml_issue(PP[NPF - 1], proj, qkc, gates, rowbase, seg_t0 + 64 * (g ? nch - 2 : 1), g, h, tg, lane, OUTPUT);
    __syncthreads();
#pragma unroll 1
    for (int step2 = 0; step2 < nch; step2 += NPF) {
#pragma unroll
    for (int hf = 0; hf < NPF; ++hf) { const int step = step2 + hf; MlPref& P = PP[hf];
        const int tgs = launder_v(tg), lns = launder_v(lane);
        const int r = lns & 31, hh = lns >> 5;
        const FragOff fq = frag_off(lns, ML_LDQ), fv = frag_off(lns, ML_LDV);
        const int o_h4 = 16 * hh;
        const int o_obw = (4 * hh * 36 + r) * 4, o_obr = ((lns >> 1) * 36 + 16 * (lns & 1)) * 4;
        const int ci = g ? nch - 1 - step : step;
        const int par = step & 1;
        if (OUTPUT && pend) {
            const int tl = lns >> 1; bf16* ob = aout + (size_t)rowbase * D + h * 128 + 32 * j + 16 * (lns & 1);
            ml_fin_store(yv0, SSQ + 4 * tl, ob + (size_t)(pend_t + (g ? 63 - tl : tl)) * D);
            ml_fin_store(yv1, SSQ + 128 + 4 * tl, ob + (size_t)(pend_t + (g ? 31 - tl : 32 + tl)) * D); pend = false; }
        float decay;
        {
            const float xi = P.gi, lf = P.gf;
            const float bc = wave_scan_add(lf);
            const float a = xi - bc; const float pm = wave_scan_max(a);
            const float Mt = fmaxf(m_prev, pm);
            const float Ml = lane63(Mt), bl = lane63(bc);
            GS[lns] = __expf(fminf(Ml - Mt, 80.f)); GS[192 + lns] = __expf(-(bc + Mt)); GS[256 + lns] = __expf(a - Ml);
            decay = __expf(m_prev - Ml); m_prev = bl + Ml; btot += bl;
        }
        LDS_WAIT(); CFENCE();
        {
            const int c8 = tgs & 7;
#pragma unroll
            for (int i = 0; i < 2; ++i) { const int tau = (tgs + 256 * i) >> 3; const ldsp tp = gb + (tau * ML_LDQ + c8 * 8) * 2; float o[8]; v4u w;
                if (OUTPUT) { unpack8(P.q[i], o); const float qs = GS[tau];
                    w.x = pk2(o[0] * qs, o[1] * qs); w.y = pk2(o[2] * qs, o[3] * qs); w.z = pk2(o[4] * qs, o[5] * qs); w.w = pk2(o[6] * qs, o[7] * qs); *(LAS v4u*)(tp + ML_QC) = w; }
                unpack8(P.k[i], o); const float wkk = GS[256 + tau];
                w.x = pk2(o[0] * wkk, o[1] * wkk); w.y = pk2(o[2] * wkk, o[3] * wkk); w.z = pk2(o[4] * wkk, o[5] * wkk); w.w = pk2(o[6] * wkk, o[7] * wkk);
                *(LAS v4u*)(tp + ML_KH) = w; }
#pragma unroll
            for (int i = 0; i < 4; ++i) { const int p = tgs + 256 * i, tau = p >> 4, cc = p & 15; *(LAS v4u*)(gb + ML_V + (tau * ML_LDV + cc * 8) * 2) = P.v[i]; }
        }
        if (OUTPUT) VM_WAIT();
        __syncthreads();
        if (step + NPF < nch) ml_issue(P, proj, qkc, gates, rowbase, seg_t0 + 64 * (g ? nch - 1 - NPF - step : step + NPF), g, h, tgs, lns, OUTPUT);
        const bool fin = OUTPUT && step > hmid;
#pragma unroll
        for (int dt = 0; dt < 2; ++dt)
#pragma unroll
            for (int i = 0; i < 16; ++i) C[dt][i] *= decay;
        if (OUTPUT) {
            bf16* hx = g ? hx1 : hx0;
#pragma unroll
            for (int tt = 0; tt < 2; ++tt) {
                f32x16 acc = zero16();
#pragma unroll
                for (int dt = 0; dt < 2; ++dt)
#pragma unroll
                    for (int sp = 0; sp < 2; ++sp) acc = MFMA32(lds8x2(gb + ML_QC + fq.o_perm + (32 * tt * ML_LDQ + 32 * dt + 16 * sp) * 2), pack8(C[dt], sp), acc);
                float den = 0.f;
#pragma unroll
                for (int st = 0; st <= tt; ++st) {
                    f32x16 s = zero16();
#pragma unroll
                    for (int ks = 0; ks < 4; ++ks) s = MFMA32(lds16(gb + ML_KH + fq.o_row + (32 * st * ML_LDQ + 16 * ks) * 2), lds16(gb + ML_QC + fq.o_row + (32 * tt * ML_LDQ + 16 * ks) * 2), s);
#pragma unroll
                    for (int i = 0; i < 16; ++i) { const float pv = (st < tt || crow(i, hh) <= r) ? s[i] : 0.f; s[i] = pv; den += pv; }
                    const bf16x8 pa0 = pack8(s, 0), pa1 = pack8(s, 1);
                    acc = MFMA32(pa0, ldstr2(gb + ML_V + fv.o_trp + vcol + ((32 * st) * ML_LDV) * 2, 8 * ML_LDV * 2), acc);
                    acc = MFMA32(pa1, ldstr2(gb + ML_V + fv.o_trp + vcol + ((32 * st + 16) * ML_LDV) * 2, 8 * ML_LDV * 2), acc);
                    }
                float qn;
                { float q0 = 0.f, q1 = 0.f, q2 = 0.f, q3 = 0.f;
#pragma unroll
                for (int c4 = 0; c4 < 4; ++c4) { const v4u qw = *(const LAS v4u*)(gb + ML_QC + (r * ML_LDQ + 32 * hh) * 2 + (32 * tt * ML_LDQ + 8 * c4) * 2); float qx[8]; unpack8(qw, qx);
                    const f32x4 n0 = *(const LAS f32x4*)(gb + ML_NV + 8 * o_h4 + (par * 64 + 8 * c4) * 4), n1 = *(const LAS f32x4*)(gb + ML_NV + 8 * o_h4 + (par * 64 + 8 * c4 + 4) * 4);
                    q0 += qx[0] * n0[0] + qx[4] * n1[0]; q1 += qx[1] * n0[1] + qx[5] * n1[1]; q2 += qx[2] * n0[2] + qx[6] * n1[2]; q3 += qx[3] * n0[3] + qx[7] * n1[3]; }
                qn = (q0 + q1) + (q2 + q3); }
                den = sum_halves(den); qn = sum_halves(qn);
                const float dtot = den + decay * qn;
                const float inv = __builtin_amdgcn_rcpf(fmaxf(fabsf(dtot), GS[192 + 32 * tt + r]));
                if (hh == 0) *(LAS float*)(INVb + (32 * tt + r) * 4) = inv;
                LDS_WAIT(); CFENCE();
                f32x16 hv;
#pragma unroll
                for (int q4 = 0; q4 < 4; ++q4) { const f32x4 iv = *(const LAS f32x4*)(INVb + o_h4 + (32 * tt + 8 * q4) * 4);
#pragma unroll
                    for (int e = 0; e < 4; ++e) { const int i = 4 * q4 + e; hv[i] = acc[i] * iv[e]; } }
#pragma unroll
                for (int i = 0; i < 16; ++i) *(LAS float*)(OBb + o_obw + ((i & 3) + 8 * (i >> 2)) * 144) = hv[i];
                LDS_WAIT(); CFENCE();
                { const f32x4 x0 = *(const LAS f32x4*)(OBb + o_obr), x1 = *(const LAS f32x4*)(OBb + o_obr + 16), x2 = *(const LAS f32x4*)(OBb + o_obr + 32), x3 = *(const LAS f32x4*)(OBb + o_obr + 48);
                    const int tau = 32 * tt + (lns >> 1); const int t = seg_t0 + 64 * ci + (g ? 63 - tau : tau);
                    bf16* op = hx + (size_t)(rowbase + t) * D + h * 128 + 32 * j + 16 * (lns & 1);
                    if (!fin) { v4u w0, w1; w0.x = pk2(x0[0], x0[1]); w0.y = pk2(x0[2], x0[3]); w0.z = pk2(x1[0], x1[1]); w0.w = pk2(x1[2], x1[3]); w1.x = pk2(x2[0], x2[1]); w1.y = pk2(x2[2], x2[3]); w1.z = pk2(x3[0], x3[1]); w1.w = pk2(x3[2], x3[3]);
                        *(GAS v4u*)op = w0; *(GAS v4u*)(op + 8) = w1; }
                    else { float pp[8], gg[8], xs[16]; const MlFin& FC = tt ? FN1 : FN0; float (&yv)[16] = tt ? yv1 : yv0;
                        unpack8(FC.pa0, pp);
#pragma unroll
                        for (int e = 0; e < 4; ++e) { xs[e] = x0[e] + pp[e]; xs[4 + e] = x1[e] + pp[4 + e]; }
                        unpack8(FC.pa1, pp);
#pragma unroll
                        for (int e = 0; e < 4; ++e) { xs[8 + e] = x2[e] + pp[e]; xs[12 + e] = x3[e] + pp[4 + e]; }
                        float ss = 0.f;
#pragma unroll
                        for (int e = 0; e < 16; ++e) ss += xs[e] * xs[e];
                        ss += __shfl_xor(ss, 1);
                        if ((lns & 1) == 0) SSQ[128 * tt + 4 * (lns >> 1) + j] = ss;
                        const LAS float* ghp = GH + 32 * j + 16 * (lns & 1);
                        unpack8(FC.ga0, gg);
#pragma unroll
                        for (int e = 0; e < 8; ++e) yv[e] = xs[e] * ghp[e] * sigmoidf_(gg[e]);
                        unpack8(FC.ga1, gg);
#pragma unroll
                        for (int e = 0; e < 8; ++e) yv[8 + e] = xs[8 + e] * ghp[8 + e] * sigmoidf_(gg[e]); } }
                LDS_WAIT(); CFENCE();
            }
            if (fin) { pend = true; pend_t = seg_t0 + 64 * ci; }
            if (step + 1 > hmid && step + 1 < nch) { const int t0n = seg_t0 + 64 * (g ? nch - 2 - step : step + 1);
                ml_issue_fin(FN0, g ? hx0 : hx1, proj, rowbase, t0n, 0, g, h, j, lns); ml_issue_fin(FN1, g ? hx0 : hx1, proj, rowbase, t0n, 1, g, h, j, lns); }
        }
        __builtin_amdgcn_sched_barrier(0);
#pragma unroll
        for (int dt = 0; dt < 2; ++dt)
#pragma unroll
            for (int ks = 0; ks < 4; ++ks) C[dt] = MFMA32(ldstr2(gb + ML_KH + fq.o_trn + (16 * ks * ML_LDQ + 32 * dt) * 2, 4 * ML_LDQ * 2), ldstr2(gb + ML_V + fv.o_trn + vcol + (16 * ks * ML_LDV) * 2, 4 * ML_LDV * 2), C[dt]);
        {   const int dkl = 16 * j + (lns & 15), tq = lns >> 4; float s0 = 0.f, s1 = 0.f;
#pragma unroll
            for (int i = 0; i < 16; i += 2) { s0 += bf2f(*(const LAS bf16*)(gb + ML_KH + ((16 * tq + i) * ML_LDQ + dkl) * 2)); s1 += bf2f(*(const LAS bf16*)(gb + ML_KH + ((16 * tq + i + 1) * ML_LDQ + dkl) * 2)); }
            float sacc = s0 + s1; sacc += __shfl_xor(sacc, 16); sacc = sum_halves(sacc);
            nreg = decay * nreg + sacc; if (lns < 16) NV[(par ^ 1) * 64 + dkl] = nreg; }
        __syncthreads();
    } }
    if (OUTPUT) {
        if (pend) { const int lns = launder_v(lane); const int tl = lns >> 1; bf16* ob = aout + (size_t)rowbase * D + h * 128 + 32 * j + 16 * (lns & 1);
            ml_fin_store(yv0, SSQ + 4 * tl, ob + (size_t)(pend_t + (g ? 63 - tl : tl)) * D);
            ml_fin_store(yv1, SSQ + 128 + 4 * tl, ob + (size_t)(pend_t + (g ? 31 - tl : 32 + tl)) * D); }
        item_headnorm(launder_v(tid_l), hx0, hx1, proj, NP_M, 2048, ghead + h * 128, aout, S0.rowbase, S0.t0 + 64 * ((S0.nchunk >> 1) - 1), 128, h); }
    if (!OUTPUT) {
        float* e = g ? st_out1 : st_out0; float* ep = e + (4 * hh) * 128 + 32 * j + r;
#pragma unroll
        for (int dt = 0; dt < 2; ++dt)
#pragma unroll
            for (int i = 0; i < 16; ++i) ep[(32 * dt + (i & 3) + 8 * (i >> 2)) * 128] = C[dt][i];
        if (lane < 16) e[8192 + 16 * j + lane] = nreg;
        if (j == 0 && lane == 0) { e[8192 + 64] = m_prev; e[8192 + 65] = btot; }
    }
}

constexpr int MS_KH = 0, MS_V = 9216, MS_BUF = 26624, MS_W = 2 * MS_BUF  ;
static_assert(MS_W + 34 * 64 * 4 <= ML_GROUP, "mLSTM S1 LDS map");
struct MsPref { v4u k[2], v[4]; };
__device__ __forceinline__ void ms_issue(MsPref& P, const bf16* proj, const bf16* qkc, int rowbase, int t0c, int g, int h, int tg) {
    const int c8q = tg & 7;
#pragma unroll
    for (int i = 0; i < 2; ++i) { const int tau = (tg + 256 * i) >> 3; const int t = t0c + (g ? 63 - tau : tau);
        P.k[i] = *(const GAS v4u*)(qkc + (size_t)(rowbase + t) * D + 512 + h * 64 + c8q * 8); }
#pragma unroll
    for (int i = 0; i < 4; ++i) { const int p = tg + 256 * i, tau = p >> 4, c8 = p & 15; const int t = t0c + (g ? 63 - tau : tau);
        P.v[i] = *(const GAS v4u*)(proj + (size_t)(rowbase + t) * NP_M + 1024 + h * 128 + c8 * 8); }
}
__device__ __forceinline__ void mlstm_s1_item(Frame& F, const bf16* proj, const bf16* qkc, const float* gates, int h, MlSeg S0, MlSeg S1, float* st_out0, float* st_out1) {
    const int tid_l = launder_v(F.tid); const int wave_l = __builtin_amdgcn_readfirstlane(tid_l >> 6);
    const int g = wave_l >> 2, j = wave_l & 3, tg = tid_l & 255, lane = tid_l & 63, r = lane & 31, hh = lane >> 5;
    const ldsp gb = F.lds + g * ML_GROUP;
    LAS float* W = (LAS float*)(gb + MS_W);
    const int rowbase = g ? S1.rowbase : S0.rowbase, seg_t0 = g ? S1.t0 : S0.t0, nch = g ? S1.nchunk : S0.nchunk;
    __syncthreads();
    MsPref PP[2]; ms_issue(PP[0], proj, qkc, rowbase, seg_t0 + 64 * (g ? nch - 1 : 0), g, h, tg);
    ms_issue(PP[1], proj, qkc, rowbase, seg_t0 + 64 * (g ? nch - 2 : 1), g, h, tg);
    float m_loc, btot;
    {
        float carry = 0.f, mx = -3.0e38f;
#pragma unroll 1
        for (int c = 0; c < nch; ++c) { const int ci = g ? nch - 1 - c : c; const int t = seg_t0 + 64 * ci + (g ? 63 - lane : lane);
            const GAS float* gp = (const GAS float*)(gates + (size_t)(rowbase + t) * 32 + g * 16 + h); const float xi = gp[0], lf = gp[8];
            const float bc = carry + wave_scan_add(lf); const float a = xi - bc;
            if (j == 0) W[64 * c + lane] = a;
            mx = fmaxf(mx, a); carry = lane63(bc); }
        mx = fmaxf(mx, __shfl_xor(mx, 1)); mx = fmaxf(mx, __shfl_xor(mx, 2)); mx = fmaxf(mx, __shfl_xor(mx, 4)); mx = fmaxf(mx, __shfl_xor(mx, 8)); mx = fmaxf(mx, __shfl_xor(mx, 16)); mx = fmaxf(mx, __shfl_xor(mx, 32));
        btot = carry; m_loc = btot + mx;
        __syncthreads();
        for (int s = tg; s < 64 * nch; s += 256) W[s] = __expf(W[s] - mx);
    }
    f32x16 C[2]; C[0] = zero16(); C[1] = zero16(); float nreg = 0.f;
    __syncthreads();
#pragma unroll 1
    for (int step2 = 0; step2 < nch; step2 += 2) {
#pragma unroll
    for (int hf = 0; hf < 2; ++hf) { const int step = step2 + hf; MsPref& P = PP[hf];
        const int tgs = launder_v(tg), lns = launder_v(lane);
        const FragOff fq = frag_off(lns, ML_LDQ), fv = frag_off(lns, ML_LDV);
        const ldsp bb = gb + hf * MS_BUF;
        {   const int c8 = tgs & 7;
#pragma unroll
            for (int i = 0; i < 2; ++i) { const int tau = (tgs + 256 * i) >> 3; float o[8]; unpack8(P.k[i], o); const float wkk = W[64 * step + tau]; v4u w;
                w.x = pk2(o[0] * wkk, o[1] * wkk); w.y = pk2(o[2] * wkk, o[3] * wkk); w.z = pk2(o[4] * wkk, o[5] * wkk); w.w = pk2(o[6] * wkk, o[7] * wkk);
                *(LAS v4u*)(bb + MS_KH + (tau * ML_LDQ + c8 * 8) * 2) = w; }
#pragma unroll
            for (int i = 0; i < 4; ++i) { const int p = tgs + 256 * i, tau = p >> 4, cc = p & 15; *(LAS v4u*)(bb + MS_V + (tau * ML_LDV + cc * 8) * 2) = P.v[i]; }
        }
        if (step + 2 < nch) ms_issue(P, proj, qkc, rowbase, seg_t0 + 64 * (g ? nch - 3 - step : step + 2), g, h, tgs);
        __syncthreads();
#pragma unroll
        for (int dt = 0; dt < 2; ++dt)
#pragma unroll
            for (int ks = 0; ks < 4; ++ks) C[dt] = MFMA32(ldstr2(bb + MS_KH + fq.o_trn + (16 * ks * ML_LDQ + 32 * dt) * 2, 4 * ML_LDQ * 2), ldstr2(bb + MS_V + fv.o_trn + 64 * j + (16 * ks * ML_LDV) * 2, 4 * ML_LDV * 2), C[dt]);
        {   const int dkl = 16 * j + (lns & 15), tq = lns >> 4; float s0 = 0.f, s1 = 0.f;
#pragma unroll
            for (int i = 0; i < 16; i += 2) { s0 += bf2f(*(const LAS bf16*)(bb + MS_KH + ((16 * tq + i) * ML_LDQ + dkl) * 2)); s1 += bf2f(*(const LAS bf16*)(bb + MS_KH + ((16 * tq + i + 1) * ML_LDQ + dkl) * 2)); }
            float sacc = s0 + s1; sacc += __shfl_xor(sacc, 16); sacc = sum_halves(sacc); nreg += sacc; }
    } }
    float* e = g ? st_out1 : st_out0; float* ep = e + (4 * hh) * 128 + 32 * j + r;
#pragma unroll
    for (int dt = 0; dt < 2; ++dt)
#pragma unroll
        for (int i = 0; i < 16; ++i) ep[(32 * dt + (i & 3) + 8 * (i >> 2)) * 128] = C[dt][i];
    if (lane < 16) e[8192 + 16 * j + lane] = nreg;
    if (j == 0 && lane == 0) { e[8192 + 64] = m_loc; e[8192 + 65] = btot; }
}

constexpr int HG_LD = 136;
constexpr int HG_LF = 0, HG_QT = 16384, HG_KT = 25088, HG_KH = 33792, HG_V = 42496, HG_OB = 51200, HG_AUX = 69632, HG_SSQ = 71168, HG_EAM = 71680, HG_BIAS = 72192, HG_LBV = 72704, HG_GROUP = 73728;
static_assert(2 * HG_GROUP <= LDS_MAIN, "HGRN2 LDS map");
constexpr int HG_STATE_F = 16512;

struct HgPref { unsigned q[8], f[8]; v4u v[2]; };
__device__ __forceinline__ void hg_issue(HgPref& P, const bf16* proj, int rowbase, int t0c, int g, int h, int tg, bool need_q) {
    const int lane = tg & 63, j = tg >> 6, cp = lane & 15, tq = lane >> 4, c0 = 32 * j + 2 * cp;
#pragma unroll
    for (int i = 0; i < 8; ++i) { const int tau = 8 * tq + i; const int t = t0c + (g ? 31 - tau : tau);
        const bf16* rp = proj + (size_t)(rowbase + t) * NP_H + h * 128 + c0;
        P.q[i] = need_q ? *(const GAS unsigned*)rp : 0u; P.f[i] = *(const GAS unsigned*)(rp + 2048 + 1024 * g); }
#pragma unroll
    for (int i = 0; i < 2; ++i) { const int p = tg + 256 * i, tau = p >> 4, c8 = p & 15; const int t = t0c + (g ? 31 - tau : tau);
        P.v[i] = *(const GAS v4u*)(proj + (size_t)(rowbase + t) * NP_H + 1024 + h * 128 + c8 * 8); }
}
struct HgFin { v4u pa0, pa1, ga0, ga1; };
__device__ __forceinline__ void hg_issue_fin(HgFin& Fn, const bf16* part, const bf16* proj, int rowbase, int t0c, int g, int h, int j, int lns) {
    const int tau = lns >> 1; const int t = t0c + (g ? 31 - tau : tau); const int col = h * 128 + 32 * j + 16 * (lns & 1);
    const bf16* pp = part + (size_t)(rowbase + t) * D + col; const bf16* gp = proj + (size_t)(rowbase + t) * NP_H + 4096 + col;
    Fn.pa0 = *(const GAS v4u*)pp; Fn.pa1 = *(const GAS v4u*)(pp + 8); Fn.ga0 = *(const GAS v4u*)gp; Fn.ga1 = *(const GAS v4u*)(gp + 8);
}
__device__ __forceinline__ float clamp80(float x) { return fminf(fmaxf(x, -80.f), 80.f); }

template <bool OUTPUT>
__device__ __forceinline__ void hgrn_item(Frame& F, const bf16* proj, bf16* hx0, bf16* hx1, bf16* aout, const float* ghead, const float* bf_, const float* lbraw, int jl,
                                          int h, MlSeg S0, MlSeg S1, const float* st_in0, const float* st_in1, int npre0, int npre1, float* st_out0, float* st_out1) {
    const int tid_l = launder_v(F.tid); const int wave_l = __builtin_amdgcn_readfirstlane(tid_l >> 6);
    const int g = wave_l >> 2, j = wave_l & 3, tg = tid_l & 255, lane = tid_l & 63, r = lane & 31, hh = lane >> 5;
#ifdef SUBT
    unsigned long long _st = 0;
#define ST_MARK(slot) do { if (OUTPUT && tid_l == SUBT_TID) { const unsigned long long _n = wall_clock64(); volatile LAS unsigned* _w = (volatile LAS unsigned*)(F.lds + LDSCTL_OFF) + 40 + (slot); _w[0] += (unsigned)(_n - _st); _st = _n; } } while (0)
#else
#define ST_MARK(slot) do { } while (0)
#endif
    ST_MARK(7);
    const ldsp gb = F.lds + g * HG_GROUP;
    LAS float* LF = (LAS float*)(gb + HG_LF);
    const ldsp OBb = gb + HG_OB + j * 4608;
    LAS float* AMID = (LAS float*)(gb + HG_AUX); LAS float* ALAST = AMID + 128; LAS float* DEC = AMID + 256;
    LAS float* SSQ = (LAS float*)(gb + HG_SSQ); LAS float* EAM = (LAS float*)(gb + HG_EAM); LAS float* BIASV = (LAS float*)(gb + HG_BIAS); LAS float* LBV = (LAS float*)(gb + HG_LBV);
    const int rowbase = g ? S1.rowbase : S0.rowbase, seg_t0 = g ? S1.t0 : S0.t0, nch = g ? S1.nchunk : S0.nchunk;
    const int vcol = 64 * j;
    __syncthreads();
    if (OUTPUT && tg < 128) EAM[tg] = ghead[h * 128 + tg];
    if (tg < 128) { const int c = h * 128 + tg; BIASV[tg] = -1.44269504f * bf_[g * 1024 + c]; LBV[tg] = jl == 0 ? 0.f : sigmoidf_(lbraw[(1 * 2 + g) * 1024 + c] - lbraw[(0 * 2 + g) * 1024 + c]); }
    f32x16 St[4];
#pragma unroll
    for (int dt = 0; dt < 4; ++dt) St[dt] = zero16();
    float atot0 = 0.f, atot1 = 0.f;
    if (OUTPUT) {   const float* sp = g ? st_in1 : st_in0; const int np = g ? npre1 : npre0;
#pragma unroll 1
        for (int k = 0; k < np; ++k) { const float* e = sp + (size_t)k * HG_STATE_F; const float* ep = e + (4 * hh) * 128 + 32 * j + r; const float* ap = e + 16384 + 4 * hh;
#pragma unroll
            for (int dt = 0; dt < 4; ++dt)
#pragma unroll
                for (int i = 0; i < 16; ++i) { const int dk0 = 32 * dt + (i & 3) + 8 * (i >> 2); St[dt][i] = __builtin_amdgcn_exp2f(ap[dk0]) * St[dt][i] + ep[dk0 * 128]; } }
    }
    constexpr int NPF = OUTPUT ? SCAN_PF_OUT : 2;
    HgPref PP[NPF]; hg_issue(PP[0], proj, rowbase, seg_t0 + 32 * (g ? nch - 1 : 0), g, h, tg, OUTPUT);
    if (NPF == 2) hg_issue(PP[NPF - 1], proj, rowbase, seg_t0 + 32 * (g ? nch - 2 : 1), g, h, tg, OUTPUT);
    __syncthreads();
    ST_MARK(4);
    float yv[16]; bool pend = false; int pend_t = 0; HgFin FN; FN.pa0 = FN.pa1 = FN.ga0 = FN.ga1 = (v4u){0u, 0u, 0u, 0u};
#pragma unroll
    for (int e = 0; e < 16; ++e) yv[e] = 0.f;
    const int hmid = nch >> 1;
#pragma unroll 1
    for (int step2 = 0; step2 < nch; step2 += NPF) {
#pragma unroll
    for (int hf = 0; hf < NPF; ++hf) { const int step = step2 + hf; HgPref& P = PP[hf];
        const int tgs = launder_v(tg), lns = launder_v(lane);
        const int r = lns & 31, hh = lns >> 5;
        const FragOff fo = frag_off(lns, HG_LD);
        const int o_h4 = 16 * hh;
        const int o_obw = (4 * hh * 36 + r) * 4, o_obr = ((lns >> 1) * 36 + 16 * (lns & 1)) * 4;
        const int ci = g ? nch - 1 - step : step;
        ST_MARK(7);
        if (OUTPUT && pend) {
            const f32x4 sq = *(const LAS f32x4*)(SSQ + 4 * (lns >> 1)); const float rs = rsqrtf(((sq[0] + sq[1]) + (sq[2] + sq[3])) * (1.f / 128.f) + EPS);
            bf16* op = aout + (size_t)(rowbase + pend_t + (g ? 31 - (lns >> 1) : (lns >> 1))) * D + h * 128 + 32 * j + 16 * (lns & 1);
            v4u w0, w1; w0.x = pk2(yv[0] * rs, yv[1] * rs); w0.y = pk2(yv[2] * rs, yv[3] * rs); w0.z = pk2(yv[4] * rs, yv[5] * rs); w0.w = pk2(yv[6] * rs, yv[7] * rs);
            w1.x = pk2(yv[8] * rs, yv[9] * rs); w1.y = pk2(yv[10] * rs, yv[11] * rs); w1.z = pk2(yv[12] * rs, yv[13] * rs); w1.w = pk2(yv[14] * rs, yv[15] * rs);
            *(GAS v4u*)op = w0; *(GAS v4u*)(op + 8) = w1; pend = false; }
        {
            const int cp = lns & 15, tq = lns >> 4, c0 = 32 * j + 2 * cp;
            const f32x2_t bb = *(const LAS f32x2_t*)(BIASV + c0), ll = *(const LAS f32x2_t*)(LBV + c0);
            const float ol0 = 1.f - ll.x, ol1 = 1.f - ll.y;
            float F0[8], F1[8], f0v[8], f1v[8]; float p0 = 1.f, p1 = 1.f;
#pragma unroll
            for (int i = 0; i < 8; ++i) { const float s0 = __builtin_amdgcn_rcpf(1.f + __builtin_amdgcn_exp2f(__builtin_fmaf(bflo(P.f[i]), -1.44269504f, bb.x))), s1 = __builtin_amdgcn_rcpf(1.f + __builtin_amdgcn_exp2f(__builtin_fmaf(bfhi(P.f[i]), -1.44269504f, bb.y)));
                const float f0 = fmaxf(__builtin_fmaf(ol0, s0, ll.x), 3.0517578125e-5f), f1 = fmaxf(__builtin_fmaf(ol1, s1, ll.y), 3.0517578125e-5f);
                p0 *= f0; p1 *= f1; F0[i] = p0; F1[i] = p1; f0v[i] = f0; f1v[i] = f1; }
            const float r0 = __builtin_amdgcn_logf(p0), r1 = __builtin_amdgcn_logf(p1);
            LAS f32x2_t* XT = (LAS f32x2_t*)(gb + HG_LF + j * 512);
            XT[tq * 16 + cp] = (f32x2_t){r0, r1};
            LDS_WAIT(); CFENCE();
            const f32x2_t t0 = XT[cp], t1 = XT[16 + cp], t2 = XT[32 + cp], t3 = XT[48 + cp];
            LDS_WAIT(); CFENCE();
            const float al0 = (t0.x + t1.x) + (t2.x + t3.x), al1 = (t0.y + t1.y) + (t2.y + t3.y);
            const float pre0 = (tq > 0 ? t0.x : 0.f) + (tq > 1 ? t1.x : 0.f) + (tq > 2 ? t2.x : 0.f), pre1 = (tq > 0 ? t0.y : 0.f) + (tq > 1 ? t1.y : 0.f) + (tq > 2 ? t2.y : 0.f);
            if (tq == 0) { *(LAS f32x2_t*)(DEC + c0) = (f32x2_t){__builtin_amdgcn_exp2f(al0), __builtin_amdgcn_exp2f(al1)}; atot0 += al0; atot1 += al1; }
            const float G0 = OUTPUT ? __builtin_amdgcn_exp2f(fminf(pre0 - al0, 115.f)) : 0.f, G1 = OUTPUT ? __builtin_amdgcn_exp2f(fminf(pre1 - al1, 115.f)) : 0.f;
            float h0 = __builtin_amdgcn_exp2f(al0 - pre0 - r0), h1 = __builtin_amdgcn_exp2f(al1 - pre1 - r1);
#pragma unroll
            for (int i = 7; i >= 0; --i) { const int tau = 8 * tq + i; const ldsp tp = gb + (tau * HG_LD + c0) * 2;
                if (OUTPUT) *(LAS unsigned*)(tp + HG_QT) = pk2(bflo(P.q[i]) * (F0[i] * G0), bfhi(P.q[i]) * (F1[i] * G1));
                *(LAS unsigned*)(tp + HG_KH) = pk2((1.f - f0v[i]) * h0, (1.f - f1v[i]) * h1);
                h0 *= f0v[i]; h1 *= f1v[i]; }
#pragma unroll
            for (int i = 0; i < 2; ++i) { const int p = tgs + 256 * i; *(LAS v4u*)(gb + HG_V + ((p >> 4) * HG_LD + (p & 15) * 8) * 2) = P.v[i]; }
        }
        ST_MARK(0);
        if (OUTPUT) VM_WAIT();
        __syncthreads();
        ST_MARK(1);
        if (step + NPF < nch) hg_issue(P, proj, rowbase, seg_t0 + 32 * (g ? nch - 1 - NPF - step : step + NPF), g, h, tgs, OUTPUT);
        const bool fin = OUTPUT && step > hmid;
        {   f32x4 dvv[16];
#pragma unroll
            for (int dt = 0; dt < 4; ++dt)
#pragma unroll
                for (int q4 = 0; q4 < 4; ++q4) dvv[4 * dt + q4] = *(const LAS f32x4*)(gb + HG_AUX + 1024 + o_h4 + (32 * dt + 8 * q4) * 4);
            __builtin_amdgcn_sched_barrier(0);
#pragma unroll
            for (int dt = 0; dt < 4; ++dt)
#pragma unroll
                for (int q4 = 0; q4 < 4; ++q4)
#pragma unroll
                    for (int e = 0; e < 4; ++e) St[dt][4 * q4 + e] *= dvv[4 * dt + q4][e]; }
        if (OUTPUT) {
            bf16* hx = g ? hx1 : hx0;
            f32x16 s = zero16(), o = zero16();
            {   bf16x8 ka[8], qa[8];
#pragma unroll
                for (int ks = 0; ks < 8; ++ks) { ka[ks] = lds16(gb + HG_KH + fo.o_row + 32 * ks); qa[ks] = lds16(gb + HG_QT + fo.o_row + 32 * ks); }
                __builtin_amdgcn_sched_barrier(0);
#pragma unroll
                for (int ks = 0; ks < 8; ++ks) s = MFMA32(ka[ks], qa[ks], s); }
            {   bf16x8 qp[8];
#pragma unroll
                for (int dt = 0; dt < 4; ++dt)
#pragma unroll
                    for (int sp = 0; sp < 2; ++sp) qp[2 * dt + sp] = lds8x2(gb + HG_QT + fo.o_perm + (32 * dt + 16 * sp) * 2);
                const bf16x8 v0 = ldstr2(gb + HG_V + fo.o_trp + vcol, 8 * HG_LD * 2), v1 = ldstr2(gb + HG_V + fo.o_trp + vcol + (16 * HG_LD) * 2, 8 * HG_LD * 2);
                __builtin_amdgcn_sched_barrier(0);
#pragma unroll
                for (int dt = 0; dt < 4; ++dt)
#pragma unroll
                    for (int sp = 0; sp < 2; ++sp) o = MFMA32(qp[2 * dt + sp], pack8(St[dt], sp), o);
#pragma unroll
                for (int i = 0; i < 16; ++i) s[i] = (crow(i, hh) <= r) ? s[i] : 0.f;
                o = MFMA32(pack8(s, 0), v0, o); o = MFMA32(pack8(s, 1), v1, o); }
#pragma unroll
            for (int i = 0; i < 16; ++i) *(LAS float*)(OBb + o_obw + ((i & 3) + 8 * (i >> 2)) * 144) = o[i];
            LDS_WAIT(); CFENCE();
            { const f32x4 x0 = *(const LAS f32x4*)(OBb + o_obr), x1 = *(const LAS f32x4*)(OBb + o_obr + 16), x2 = *(const LAS f32x4*)(OBb + o_obr + 32), x3 = *(const LAS f32x4*)(OBb + o_obr + 48);
                const int tau = lns >> 1; const int t = seg_t0 + 32 * ci + (g ? 31 - tau : tau);
                bf16* op = hx + (size_t)(rowbase + t) * D + h * 128 + 32 * j + 16 * (lns & 1);
                if (!fin) { v4u w0, w1; w0.x = pk2(x0[0], x0[1]); w0.y = pk2(x0[2], x0[3]); w0.z = pk2(x1[0], x1[1]); w0.w = pk2(x1[2], x1[3]); w1.x = pk2(x2[0], x2[1]); w1.y = pk2(x2[2], x2[3]); w1.z = pk2(x3[0], x3[1]); w1.w = pk2(x3[2], x3[3]);
                    *(GAS v4u*)op = w0; *(GAS v4u*)(op + 8) = w1; }
                else { float pp[8], gg[8], xs[16];
                    unpack8(FN.pa0, pp);
#pragma unroll
                    for (int e = 0; e < 4; ++e) { xs[e] = x0[e] + pp[e]; xs[4 + e] = x1[e] + pp[4 + e]; }
                    unpack8(FN.pa1, pp);
#pragma unroll
                    for (int e = 0; e < 4; ++e) { xs[8 + e] = x2[e] + pp[e]; xs[12 + e] = x3[e] + pp[4 + e]; }
                    float ss = 0.f;
#pragma unroll
                    for (int e = 0; e < 16; ++e) ss += xs[e] * xs[e];
                    ss += __shfl_xor(ss, 1);
                    if ((lns & 1) == 0) SSQ[4 * tau + j] = ss;
                    const LAS float* ghp = EAM + 32 * j + 16 * (lns & 1);
                    unpack8(FN.ga0, gg);
#pragma unroll
                    for (int e = 0; e < 8; ++e) yv[e] = xs[e] * ghp[e] * sigmoidf_(gg[e]);
                    unpack8(FN.ga1, gg);
#pragma unroll
                    for (int e = 0; e < 8; ++e) yv[8 + e] = xs[8 + e] * ghp[8 + e] * sigmoidf_(gg[e]);
                    pend = true; pend_t = seg_t0 + 32 * ci; } }
            LDS_WAIT(); CFENCE();
            if (step + 1 > hmid && step + 1 < nch) hg_issue_fin(FN, g ? hx0 : hx1, proj, rowbase, seg_t0 + 32 * (g ? nch - 2 - step : step + 1), g, h, j, lns);
        }
        {   bf16x8 kt[8], vt[2];
#pragma unroll
            for (int sp = 0; sp < 2; ++sp) vt[sp] = ldstr2(gb + HG_V + fo.o_trn + vcol + (16 * sp * HG_LD) * 2, 4 * HG_LD * 2);
#pragma unroll
            for (int dt = 0; dt < 4; ++dt)
#pragma unroll
                for (int sp = 0; sp < 2; ++sp) kt[2 * dt + sp] = ldstr2(gb + HG_KH + fo.o_trn + (16 * sp * HG_LD + 32 * dt) * 2, 4 * HG_LD * 2);
            __builtin_amdgcn_sched_barrier(0);
#pragma unroll
            for (int dt = 0; dt < 4; ++dt)
#pragma unroll
                for (int sp = 0; sp < 2; ++sp) St[dt] = MFMA32(kt[2 * dt + sp], vt[sp], St[dt]); }
        ST_MARK(2);
        __syncthreads();
        ST_MARK(3);
    } }
    if (OUTPUT) {
        if (pend) { const int lns = launder_v(lane);
            const f32x4 sq = *(const LAS f32x4*)(SSQ + 4 * (lns >> 1)); const float rs = rsqrtf(((sq[0] + sq[1]) + (sq[2] + sq[3])) * (1.f / 128.f) + EPS);
            bf16* op = aout + (size_t)(rowbase + pend_t + (g ? 31 - (lns >> 1) : (lns >> 1))) * D + h * 128 + 32 * j + 16 * (lns & 1);
            v4u w0, w1; w0.x = pk2(yv[0] * rs, yv[1] * rs); w0.y = pk2(yv[2] * rs, yv[3] * rs); w0.z = pk2(yv[4] * rs, yv[5] * rs); w0.w = pk2(yv[6] * rs, yv[7] * rs);
            w1.x = pk2(yv[8] * rs, yv[9] * rs); w1.y = pk2(yv[10] * rs, yv[11] * rs); w1.z = pk2(yv[12] * rs, yv[13] * rs); w1.w = pk2(yv[14] * rs, yv[15] * rs);
            *(GAS v4u*)op = w0; *(GAS v4u*)(op + 8) = w1; }
        item_headnorm(launder_v(tid_l), hx0, hx1, proj, NP_H, 4096, ghead + h * 128, aout, S0.rowbase, S0.t0 + 32 * ((S0.nchunk >> 1) - 1), 64, h); }
    ST_MARK(5);
    if (!OUTPUT) {
        float* e = g ? st_out1 : st_out0; float* ep = e + (4 * hh) * 128 + 32 * j + r;
#pragma unroll
        for (int dt = 0; dt < 4; ++dt)
#pragma unroll
            for (int i = 0; i < 16; ++i) ep[(32 * dt + (i & 3) + 8 * (i >> 2)) * 128] = St[dt][i];
        if ((lane >> 4) == 0) { e[16384 + 32 * j + 2 * (lane & 15)] = atot0; e[16384 + 32 * j + 2 * (lane & 15) + 1] = atot1; }
    }
}
#undef ST_MARK

constexpr int PH_PER_LAYER = 11, PH_BASE = 2, N_PHASES = PH_BASE + DEPTH * PH_PER_LAYER;
#ifndef EN_GEMM
#define EN_GEMM 0xff
#endif
#ifndef EN_ML
#define EN_ML 3
#endif
#ifndef EN_HG
#define EN_HG 3
#endif
#ifndef EN_TOK
#define EN_TOK 1
#endif
#ifndef EN_MISC
#define EN_MISC 1
#endif
#ifndef PG_SP2
#define PG_SP2 true
#endif
#ifndef PG_ALIGN
#define PG_ALIGN true
#endif
#ifndef TIMER_MASK
#define TIMER_MASK 0ull
#endif
#ifndef TIMER_DIV
#define TIMER_DIV 20.0f
#endif
#ifndef MK_SPLIT
#define MK_SPLIT 0
#endif


__device__ __forceinline__ void phase_headnorm(Frame& F, const bf16* hf, const bf16* hb, const bf16* gate, int gpitch, int gcol0, const float* ghead, bf16* aout, int nrows) {
    const int tid = launder_v(F.tid); const int lane = tid & 63, wave = __builtin_amdgcn_readfirstlane(tid >> 6);
    const int gw = F.bid * NWAVES + wave, NGW = F.G * NWAVES;
    float gh[16];
#pragma unroll
    for (int e = 0; e < 16; ++e) gh[e] = ghead[lane * 16 + e];
    for (int row = gw; row < nrows; row += NGW) {
        const v4u a0 = *(const v4u*)(hf + (size_t)row * D + lane * 16), a1 = *(const v4u*)(hf + (size_t)row * D + lane * 16 + 8);
        const v4u b0 = *(const v4u*)(hb + (size_t)row * D + lane * 16), b1 = *(const v4u*)(hb + (size_t)row * D + lane * 16 + 8);
        const v4u g0 = *(const v4u*)(gate + (size_t)row * gpitch + gcol0 + lane * 16), g1 = *(const v4u*)(gate + (size_t)row * gpitch + gcol0 + lane * 16 + 8);
        float x[16], y[8], o[16]; unpack8(a0, y);
#pragma unroll
        for (int e = 0; e < 8; ++e) x[e] = y[e];
        unpack8(a1, y);
#pragma unroll
        for (int e = 0; e < 8; ++e) x[8 + e] = y[e];
        unpack8(b0, y);
#pragma unroll
        for (int e = 0; e < 8; ++e) x[e] += y[e];
        unpack8(b1, y);
#pragma unroll
        for (int e = 0; e < 8; ++e) x[8 + e] += y[e];
        float ss = 0.f;
#pragma unroll
        for (int e = 0; e < 16; ++e) ss += x[e] * x[e];
        ss += __shfl_xor(ss, 1); ss += __shfl_xor(ss, 2); ss += __shfl_xor(ss, 4);
        const float rs = rsqrtf(ss * (1.f / 128.f) + EPS);
        unpack8(g0, y);
#pragma unroll
        for (int e = 0; e < 8; ++e) o[e] = x[e] * rs * gh[e] * sigmoidf_(y[e]);
        unpack8(g1, y);
#pragma unroll
        for (int e = 0; e < 8; ++e) o[8 + e] = x[8 + e] * rs * gh[8 + e] * sigmoidf_(y[e]);
        v4u w0, w1; w0.x = pk2(o[0], o[1]); w0.y = pk2(o[2], o[3]); w0.z = pk2(o[4], o[5]); w0.w = pk2(o[6], o[7]); w1.x = pk2(o[8], o[9]); w1.y = pk2(o[10], o[11]); w1.z = pk2(o[12], o[13]); w1.w = pk2(o[14], o[15]);
        *(v4u*)(aout + (size_t)row * D + lane * 16) = w0; *(v4u*)(aout + (size_t)row * D + lane * 16 + 8) = w1;
    }
}

__device__ __forceinline__ void phase_conv(Frame& F, const bf16* proj, bf16* qkc, float* gates, const float* wconv, const float* bgate) {
    const int gt = F.bid * NTHR + F.tid, cp = gt & 127;
    const int rpb = (M_ALL + F.G - 1) / F.G, rlo = F.bid * rpb, rhi = min(M_ALL, rlo + rpb);
    float w[3][8];
#pragma unroll
    for (int d = 0; d < 3; ++d)
#pragma unroll
        for (int e = 0; e < 8; ++e) w[d][e] = wconv[d * 1024 + cp * 8 + e];
    const float sc = cp >= 64 ? 0.125f : 1.0f;
#pragma unroll 3
    for (int row = rlo + (F.tid >> 7); row < rhi; row += NTHR >> 7) {
        int t, len; if (row < M_LAT) { t = row & (SEQ - 1); len = SEQ; } else { t = (row - M_LAT) & (CTXL - 1); len = CTXL; }
        const bf16* rp = proj + (size_t)row * NP_M + cp * 8;
        const v4u z = (v4u){0u, 0u, 0u, 0u};
        const v4u r0 = t > 0 ? *(const v4u*)(rp - NP_M) : z, r1 = *(const v4u*)rp, r2 = t + 1 < len ? *(const v4u*)(rp + NP_M) : z;
        float x0[8], x1[8], x2[8], o[8]; unpack8(r0, x0); unpack8(r1, x1); unpack8(r2, x2);
#pragma unroll
        for (int e = 0; e < 8; ++e) o[e] = sc * siluf_(w[0][e] * x0[e] + w[1][e] * x1[e] + w[2][e] * x2[e]);
        v4u q; q.x = pk2(o[0], o[1]); q.y = pk2(o[2], o[3]); q.z = pk2(o[4], o[5]); q.w = pk2(o[6], o[7]);
        *(v4u*)(qkc + (size_t)row * D + cp * 8) = q;
    }
    {   const int c4 = (gt * 4) & 31; const f32x4 bg = *(const f32x4*)(bgate + c4); const bool lsg = ((c4 >> 3) & 1) != 0;
#pragma unroll 4
        for (int i = gt; i < M_ALL * 8; i += F.G * NTHR) { f32x4 x = *(const GAS f32x4*)(gates + (size_t)i * 4) + bg;
            if (lsg) {
#pragma unroll
                for (int e = 0; e < 4; ++e) x[e] = fminf(x[e], 0.f) - __logf(1.f + __expf(-fabsf(x[e]))); }
            *(GAS f32x4*)(gates + (size_t)i * 4) = x; } }
}

__device__ __forceinline__ void timer_stamp(unsigned char* lds_raw, bool add) {
    if (threadIdx.x == 0) { volatile LAS unsigned* tw = (volatile LAS unsigned*)((LAS unsigned char*)lds_raw + LDSCTL_OFF) + 32;
        const unsigned long long t = wall_clock64(); const unsigned long long last = ((unsigned long long)tw[1] << 32) | tw[0];
        if (add) { unsigned long long acc = ((unsigned long long)tw[3] << 32) | tw[2]; acc += t - last; tw[2] = (unsigned)acc; tw[3] = (unsigned)(acc >> 32); }
        tw[0] = (unsigned)t; tw[1] = (unsigned)(t >> 32); }
}

__device__ __forceinline__ void seg_of(bool odd, bool ctx_out, int q, int& t0, int& len) {
    int a, b; if (!ctx_out) { a = 2048; b = 2048; } else if (!odd) { a = 30 * 64; b = 34 * 64; } else { a = 60 * 32; b = 68 * 32; }
    t0 = (q == 0) ? 0 : (q == 1) ? a : (q == 2) ? a + b : a + 2 * b; len = (q == 0 || q == 3) ? a : b;
}

__device__ __forceinline__ Frame mkframe(const Args& args, unsigned char* lds_raw) {
    Frame F; int t = threadIdx.x; asm volatile("" : "+v"(t));
    F.lds = (LAS unsigned char*)lds_raw; F.tid = t; F.lane = t & 63; F.wave = __builtin_amdgcn_readfirstlane(t >> 6);
    int g = gridDim.x, b = blockIdx.x; asm volatile("" : "+s"(g), "+s"(b)); F.G = g; F.bid = b;
    const __attribute__((address_space(4))) Args* ap = (const __attribute__((address_space(4))) Args*)__builtin_amdgcn_kernarg_segment_ptr(); asm volatile("" : "+s"(ap));
    F.ws = ap->ws; F.in = ap->in; F.out = ap->out;
    return F;
}
#define PHASE_LOCALS \
    Frame F = mkframe(args, lds_raw); unsigned char* ws = F.ws; \
    float* modv = (float*)(ws + WS_MODV); bf16* U = (bf16*)(ws + WS_U); bf16* Y = (bf16*)(ws + WS_Y); bf16* PROJ = (bf16*)(ws + WS_ACT); bf16* HB = (bf16*)(ws + WS_ACT); \
    bf16* AMOE = (bf16*)(ws + WS_ACT); bf16* HMOE = (bf16*)(ws + WS_ACT + (size_t)MOE_ROWS * D * 2); \
    float* GATES = (float*)(ws + WS_GATES); float* LATC = (float*)(ws + WS_LATC); float* STATE = (float*)(ws + WS_STATE); \
    const int* pexp = (const int*)(ws + WS_SMALL + SM_PEXP); float* SA_U = (float*)(ws + WS_SMALL + SM_SAU); float* SA_U2 = (float*)(ws + WS_SMALL + SM_SAU2); float* SA_MOE = (float*)(ws + WS_GATES + GATES_SAMOE); \
    const float* SWL = (const float*)(ws + WS_SMALL + (odd ? SM_SWO : SM_SWE)); (void)SA_U; (void)SA_U2; (void)SA_MOE; (void)SWL; \
    unsigned char* wb = ws + (odd ? WS_WO : WS_WE); const float* mv = modv + (size_t)L * 9 * 6 * 1024; \
    (void)modv; (void)U; (void)Y; (void)PROJ; (void)HB; (void)AMOE; (void)HMOE; (void)GATES; (void)LATC; (void)STATE; (void)pexp; (void)wb; (void)mv;

__global__ void __launch_bounds__(NTHR, 2) fwd(Args args) {
    extern __shared__ __attribute__((aligned(16))) unsigned char lds_raw[];
    Frame F = mkframe(args, lds_raw);
    volatile LAS unsigned* LCTL = (volatile LAS unsigned*)(F.lds + LDSCTL_OFF);
    for (int u = F.tid; u < 128; u += NTHR) LCTL[u] = 0u;
    __syncthreads();
    XcdBarrier bar; bar.bar = (unsigned*)(F.ws + WS_CTL) + CW_BAR; bar.x = 0; bar.st = nullptr;
    if (args.use_bar) bar = xcd_barrier_post((unsigned*)(F.ws + WS_CTL) + CW_BAR, LCTL + 8);
    const int lo = args.ph_lo, hi = args.ph_hi;
#define IN(k) (lo <= (k) && (k) < hi)
#define SEAM(k) do { if ((k) + 1 < hi) xcd_barrier(bar.bar, bar.x, bar.st); if (TIMER_MASK != 0ull) timer_stamp(lds_raw, ((TIMER_MASK >> (k)) & 1ull) != 0ull); } while (0)
#ifdef TIMER_SPAN
    if (threadIdx.x == 0) { unsigned long long* dbg = (unsigned long long*)((unsigned*)(F.ws + WS_CTL) + CW_DBG); atomicMax(dbg, ~wall_clock64()); }
#endif
#ifdef SPIN_START
    { const unsigned long long t0 = wall_clock64(); while (wall_clock64() - t0 < (unsigned long long)(SPIN_START)) __builtin_amdgcn_s_sleep(8); }
#endif
    if (TIMER_MASK != 0ull) timer_stamp(lds_raw, false);
#ifdef EXTRA_BARS
    for (int eb = 0; eb < EXTRA_BARS; ++eb) xcd_barrier(bar.bar, bar.x, bar.st);
#endif
    if (IN(0)) { const int L = 0; const bool odd = false; PHASE_LOCALS if (EN_MISC) phase_mods(F); __syncthreads(); if (EN_MISC) phase_colmax(F); xcd_barrier(bar.bar, bar.x, bar.st); if (EN_MISC) phase_wconv(F, 0); SEAM(0); }
    if (IN(1)) { const int L = 0; const bool odd = false; PHASE_LOCALS
        TokCfg T{}; T.lat_src_l = F.in[I_X]; T.lat_src_c = F.in[I_CTX]; T.src_f32 = 1; T.vna = modv + 0 * 1024; T.vnb = modv + 1 * 1024; T.u = U; T.u_fp8 = INPROJ_I8 ? 2 : 0; T.u_scale = SA_U; T.nrows = M_ALL;
        if (EN_TOK) phase_tok(F, T); __syncthreads(); if (EN_MISC) phase_wconv(F, 1); SEAM(1);
    }
    for (int L = 0; L < DEPTH; ++L) {
        const int pb = PH_BASE + L * PH_PER_LAYER; const bool odd = (L & 1) != 0; const int jl = L >> 1;
        const bool ctx_out = L < DEPTH - 1;
        if (IN(pb + 0)) { PHASE_LOCALS
            pg8::Order S; pg8::Gemm g;
#if INPROJ_I8
            if (!odd) { g = pg8::Gemm{U, (const bf16*)(wb + WE_IN), M_ALL, NIN_M, D}; S.init(M_ALL / 256, NIN_M, F.G, F.bid, nullptr, 0);
                pg8::EpiStoreI8 E{PROJ, NP_M, NP_M / 256, NP_M / 256, GATES, SA_U, SWL + SWE_IN}; if (EN_GEMM & (1 << 0)) pg8::gemm_phase<pg8::EpiStoreI8, pg8::Order, PG_ALIGN, PG_SP2, 2>(F.lds, g, S, E); }
            else { g = pg8::Gemm{U, (const bf16*)(wb + WOD_IN), M_ALL, NP_H, D}; S.init(M_ALL / 256, NP_H, F.G, F.bid, nullptr, 0);
                pg8::EpiStoreI8 E{PROJ, NP_H, NP_H / 256, -1, nullptr, SA_U, SWL + SWO_IN}; if (EN_GEMM & (1 << 1)) pg8::gemm_phase<pg8::EpiStoreI8, pg8::Order, PG_ALIGN, PG_SP2, 2>(F.lds, g, S, E); }
#else
            if (!odd) { g = pg8::Gemm{U, (const bf16*)(wb + WE_IN), M_ALL, NIN_M, D}; S.init(M_ALL / 256, NIN_M, F.G, F.bid, nullptr, 0);
                pg8::EpiStore E{PROJ, NP_M, NP_M / 256, NP_M / 256, GATES, 1.0f}; if (EN_GEMM & (1 << 0)) pg8::gemm_phase<pg8::EpiStore, pg8::Order, PG_ALIGN, PG_SP2>(F.lds, g, S, E); }
            else { g = pg8::Gemm{U, (const bf16*)(wb + WOD_IN), M_ALL, NP_H, D}; S.init(M_ALL / 256, NP_H, F.G, F.bid, nullptr, 0);
                pg8::EpiStore E{PROJ, NP_H, NP_H / 256, -1, nullptr, 1.0f}; if (EN_GEMM & (1 << 1)) pg8::gemm_phase<pg8::EpiStore, pg8::Order, PG_ALIGN, PG_SP2>(F.lds, g, S, E); }
#endif
            SEAM(pb + 0);
        }
        if (IN(pb + 1)) {
            if (!odd) { PHASE_LOCALS
                phase_conv(F, PROJ, (bf16*)(ws + WS_ACT + 400 * MiB), GATES, F.in[I_MWCONV] + (size_t)jl * 3 * 1024, F.in[I_MBGATE] + jl * 32); SEAM(pb + 1); }
        }
        if (IN(pb + 2)) { PHASE_LOCALS
            for (int id = F.bid; id < 256; id += F.G) {
                const int bh = id >> 2, p = id & 3, b = bh >> 3, h = bh & 7;
                MlSeg SG0, SG1;
                const int csz = odd ? 32 : 64;
                if (p == 0) { SG0 = MlSeg{M_LAT + b * CTXL, CTXL, 0, CTXL / csz}; SG1 = SG0; }
                else { int t0a, la, t0b, lb2; seg_of(odd, ctx_out, p - 1, t0a, la); seg_of(odd, ctx_out, 4 - p, t0b, lb2); SG0 = MlSeg{b * SEQ, SEQ, t0a, la / csz}; SG1 = MlSeg{b * SEQ, SEQ, t0b, lb2 / csz}; }
                if (!odd) { float* e0 = STATE + (size_t)((bh * 2 + 0) * 4 + p) * ML_STATE_F; float* e1 = STATE + (size_t)((bh * 2 + 1) * 4 + p) * ML_STATE_F;
                    if (EN_ML & 1) mlstm_s1_item(F, PROJ, (const bf16*)(ws + WS_ACT + 400 * MiB), GATES, h, SG0, SG1, e0, e1); }
                else { float* e0 = STATE + (size_t)((bh * 2 + 0) * 4 + p) * HG_STATE_F; float* e1 = STATE + (size_t)((bh * 2 + 1) * 4 + p) * HG_STATE_F;
                    if (EN_HG & 1) hgrn_item<false>(F, PROJ, U, (bf16*)(ws + WS_Y), U, F.in[I_HGHEAD] + jl * 1024, F.in[I_HBF] + (size_t)jl * 2048, F.in[I_HLB], jl, h, SG0, SG1, nullptr, nullptr, 0, 0, e0, e1); }
            }
            SEAM(pb + 2);
        }
        if (IN(pb + 3)) { PHASE_LOCALS
            const int nitems = ctx_out ? 320 : 256;
            for (int id = F.bid; id < nitems; id += F.G) {
                MlSeg SG0, SG1; int bh, npre0 = 0, npre1 = 0; const int csz = odd ? 32 : 64;
                if (id < 256) { int q; if (id < 128) { bh = id >> 1; q = (id & 1) ? 3 : 0; } else { bh = (id - 128) >> 1; q = 1 + (id & 1); } int t0q, lq; seg_of(odd, ctx_out, q, t0q, lq); SG0 = MlSeg{(bh >> 3) * SEQ, SEQ, t0q, lq / csz}; npre0 = q + 1; npre1 = 4 - q; }
                else { bh = id - 256; SG0 = MlSeg{M_LAT + (bh >> 3) * CTXL, CTXL, 0, CTXL / csz}; }
                SG1 = SG0;
                const int h = bh & 7;
                if (!odd) { const float* s0 = STATE + (size_t)((bh * 2 + 0) * 4) * ML_STATE_F; const float* s1 = STATE + (size_t)((bh * 2 + 1) * 4) * ML_STATE_F;
                    if (EN_ML & 2) mlstm_item<true>(F, PROJ, (const bf16*)(ws + WS_ACT + 400 * MiB), GATES, (bf16*)(ws + WS_ACT + 536 * MiB), (bf16*)(ws + WS_Y), U, F.in[I_MGHEAD] + jl * 1024, h, SG0, SG1, s0, s1, npre0, npre1, nullptr, nullptr); }
                else { const float* s0 = STATE + (size_t)((bh * 2 + 0) * 4) * HG_STATE_F; const float* s1 = STATE + (size_t)((bh * 2 + 1) * 4) * HG_STATE_F;
                    if (EN_HG & 2) hgrn_item<true>(F, PROJ, U, (bf16*)(ws + WS_Y), U, F.in[I_HGHEAD] + jl * 1024, F.in[I_HBF] + (size_t)jl * 2048, F.in[I_HLB], jl, h, SG0, SG1, s0, s1, npre0, npre1, nullptr, nullptr); }
            }
            SEAM(pb + 3);
        }
        if (IN(pb + 5)) { PHASE_LOCALS
            const int nM = (ctx_out ? M_ALL : M_LAT) / 256;
            pg8::Gemm g{U, (const bf16*)(wb + (odd ? WOD_OUT : WE_OUT)), nM * 256, D, D}; pg8::Order S; S.init(nM, D, F.G, F.bid, nullptr, 0);
            pg8::EpiStore E{Y, D, D / 256, -1, nullptr, 1.0f}; if (EN_GEMM & (1 << 2)) pg8::gemm_phase<pg8::EpiStore, pg8::Order, PG_ALIGN, PG_SP2>(F.lds, g, S, E);
            SEAM(pb + 5);
        }
        if (IN(pb + 6)) { PHASE_LOCALS
            TokCfg T{}; bf16* LAT16 = (bf16*)(ws + WS_ACT + 836 * MiB); T.src_f32 = (L == 0) ? 1 : 0; T.lat_src_l = (L == 0) ? (const void*)F.in[I_X] : (const void*)LAT16; T.lat_src_c = (L == 0) ? (const void*)F.in[I_CTX] : (const void*)LATC; T.lat_dst_l = LAT16; T.lat_dst_c = LATC;
            T.y = Y; T.y_perm = odd ? 1 : 0; T.vupd = mv + 2 * 1024; T.vna = mv + 3 * 1024; T.vnb = mv + 4 * 1024; T.u = U; T.u_fp8 = ((UP_I8 && !odd) || (UP_I8_MOE && odd)) ? 2 : FFN_FP8_L(L); T.u_scale = SA_U2; T.route = odd ? 1 : 0; T.jr = jl; T.nrows = ctx_out ? M_ALL : M_LAT;
            if (EN_TOK) phase_tok(F, T);
            if (L >= 1 && L + 1 < DEPTH) { __syncthreads(); if (EN_MISC) phase_wconv(F, L + 1); }
            SEAM(pb + 6);
        }
        if (IN(pb + 7)) { PHASE_LOCALS
            if (odd) { if (EN_MISC) phase_moe_scatter(F, jl, ctx_out ? M_ALL : M_LAT, (const unsigned char*)U, (unsigned char*)AMOE, (UP_I8_MOE || FFN_FP8_L(L)) ? 1024 : 2048, UP_I8_MOE ? SA_U2 : nullptr, SA_MOE); SEAM(pb + 7); }
        }
        if (IN(pb + 8)) { PHASE_LOCALS
            if (!odd) { pg8::Gemm g{U, (const bf16*)(wb + WE_GU), M_ALL, NGU, D}; pg8::Order S; S.init(M_ALL / 256, NGU, F.G, F.bid, nullptr, 0);
#if UP_I8
                pg8::EpiSwiGLU8I E{(unsigned char*)HB, FF, SA_U2, SWL + SWE_GU, nullptr, 0, FFN_FP8_L(L) ? 0 : 1}; if (EN_GEMM & (1 << 3)) pg8::gemm_phase<pg8::EpiSwiGLU8I, pg8::Order, PG_ALIGN, PG_SP2, 2>(F.lds, g, S, E);
#else
                pg8::EpiSwiGLU8 E{(unsigned char*)HB, FF, 1.0f / WSCALE8}; if (EN_GEMM & (1 << 3)) pg8::gemm_phase<pg8::EpiSwiGLU8, pg8::Order, PG_ALIGN, PG_SP2, 1>(F.lds, g, S, E);
#endif
            }
            else { const int np = __builtin_amdgcn_readfirstlane(pexp[MOE_PANELS]);
                pg8::Gemm g{AMOE, (const bf16*)(wb + WOD_GU), np * 256, NGU, D}; pg8::Order S; S.init(np, NGU, F.G, F.bid, pexp, EGU_BYTES);
#if UP_I8_MOE
                pg8::EpiSwiGLU8I E{(unsigned char*)HMOE, FF, SA_MOE, SWL + SWO_GU, pexp, NGU, 0}; if (EN_GEMM & (1 << 4)) pg8::gemm_phase<pg8::EpiSwiGLU8I, pg8::Order, PG_ALIGN, PG_SP2, 2>(F.lds, g, S, E); }
#else
                pg8::EpiSwiGLU8 E{(unsigned char*)HMOE, FF, 1.0f / WSCALE8}; if (EN_GEMM & (1 << 4)) pg8::gemm_phase<pg8::EpiSwiGLU8, pg8::Order, PG_ALIGN, PG_SP2, 1>(F.lds, g, S, E); }
#endif
            SEAM(pb + 8);
        }
        if (IN(pb + 9)) { PHASE_LOCALS
            const bool f8 = FFN_FP8_L(L) != 0;
            if (!odd) { pg8::Gemm g{HB, (const bf16*)(wb + WE_DOWN), M_ALL, D, FF}; pg8::Order S; S.init(M_ALL / 256, D, F.G, F.bid, nullptr, 0);
                if (f8) { if ((FP8_LAYERS) & 0x5) { pg8::EpiStore E{Y, D, D / 256, -1, nullptr, 1.0f / WSCALE8}; if (EN_GEMM & (1 << 5)) pg8::gemm_phase<pg8::EpiStore, pg8::Order, PG_ALIGN, PG_SP2, 1>(F.lds, g, S, E); } }
                else { if ((~(FP8_LAYERS)) & 0x5) { pg8::EpiStore E{Y, D, D / 256, -1, nullptr, 1.0f}; if (EN_GEMM & (1 << 5)) pg8::gemm_phase<pg8::EpiStore, pg8::Order, PG_ALIGN, PG_SP2>(F.lds, g, S, E); } } }
            else { const int np = __builtin_amdgcn_readfirstlane(pexp[MOE_PANELS]);
                pg8::Gemm g{HMOE, (const bf16*)(wb + WOD_DOWN), np * 256, D, FF}; pg8::Order S; S.init(np, D, F.G, F.bid, pexp, EDOWN_BYTES);
                if (f8) { if ((FP8_LAYERS) & 0xA) { pg8::EpiStore E{AMOE, D, D / 256, -1, nullptr, 1.0f / WSCALE8}; if (EN_GEMM & (1 << 6)) pg8::gemm_phase<pg8::EpiStore, pg8::Order, PG_ALIGN, PG_SP2, 1>(F.lds, g, S, E); } }
                else { if ((~(FP8_LAYERS)) & 0xA) { pg8::EpiStore E{AMOE, D, D / 256, -1, nullptr, 1.0f}; if (EN_GEMM & (1 << 6)) pg8::gemm_phase<pg8::EpiStore, pg8::Order, PG_ALIGN, PG_SP2>(F.lds, g, S, E); } } }
            SEAM(pb + 9);
        }
        if (IN(pb + 10)) { PHASE_LOCALS
            TokCfg T{}; bf16* LAT16 = (bf16*)(ws + WS_ACT + 836 * MiB); T.lat_src_l = LAT16; T.lat_src_c = LATC; T.lat_dst_l = (L + 1 < DEPTH) ? (void*)LAT16 : (void*)F.out; T.lat_dst_c = LATC; T.dst_f32 = (L + 1 < DEPTH) ? 0 : 1;
            T.y = odd ? AMOE : Y; T.moe_combine = odd ? 1 : 0; T.vupd = mv + 5 * 1024; T.nrows = ctx_out ? M_ALL : M_LAT;
            if (L + 1 < DEPTH) { const float* mn = modv + (size_t)(L + 1) * 9 * 6 * 1024; T.vna = mn; T.vnb = mn + 1024; T.u = U; T.u_perm = ((L + 1) & 1) ? 1 : 0; T.u_fp8 = INPROJ_I8 ? 2 : 0; T.u_scale = SA_U; }
            if (EN_TOK) phase_tok(F, T);
            SEAM(pb + 10);
        }
    }
    if (TIMER_MASK != 0ull) { timer_stamp(lds_raw, ((TIMER_MASK >> (N_PHASES - 1)) & 1ull) != 0ull);
        if (blockIdx.x == 0 && threadIdx.x == 0) { volatile LAS unsigned* tw = (volatile LAS unsigned*)((LAS unsigned char*)lds_raw + LDSCTL_OFF) + 32; const unsigned long long acc = ((unsigned long long)tw[3] << 32) | tw[2];
            asm volatile("s_waitcnt vmcnt(0)" ::: "memory"); args.out[0] = (float)acc * 0.01f / TIMER_DIV; } }
#ifdef SUBT
    __syncthreads();
    if (blockIdx.x == 0 && threadIdx.x == 0) { volatile LAS unsigned* tw = (volatile LAS unsigned*)((LAS unsigned char*)lds_raw + LDSCTL_OFF) + 40; asm volatile("s_waitcnt vmcnt(0)" ::: "memory"); args.out[0] = (float)tw[SUBT] * 0.01f / SUBT_DIV; }
#endif
#ifdef TIMER_SPAN
    __syncthreads();
    if (threadIdx.x == 0) { unsigned long long* dbg = (unsigned long long*)((unsigned*)(args.ws + WS_CTL) + CW_DBG);
        asm volatile("s_waitcnt vmcnt(0)" ::: "memory"); __threadfence();
        if (blockIdx.x != 0) { atomicMax(dbg + 1, wall_clock64()); __threadfence(); atomicAdd(dbg + 2, 1ull); }
        else { while (atomicAdd(dbg + 2, 0ull) < (unsigned long long)(gridDim.x - 1)) __builtin_amdgcn_s_sleep(4);
            unsigned long long te = atomicMax(dbg + 1, 0ull); const unsigned long long tn = wall_clock64(); if (tn > te) te = tn; const unsigned long long ts = ~atomicMax(dbg, 0ull);
            args.out[0] = (float)(te - ts) * 0.01f / TIMER_SPAN; } }
#endif
#ifdef SPIN_TICKS
    { const unsigned long long t0 = wall_clock64(); while (wall_clock64() - t0 < (unsigned long long)(SPIN_TICKS)) __builtin_amdgcn_s_sleep(8); }
#endif
#undef IN
#undef SEAM
}

extern "C" void kernel_launch(void* const* d_in, const int* in_sizes, int n_in, void* d_out, int out_size, void* d_ws, size_t ws_size, hipStream_t stream) {
    static int grid = 0;
    if (grid == 0) {
        if (n_in != 23 || out_size != M_LAT * D || ws_size < WS_END) { fprintf(stderr, "kernel_launch: unexpected shapes / workspace (n_in %d out %d ws %zu need %zu)\n", n_in, out_size, ws_size, (size_t)WS_END); grid = -1; return; }
        int dev = 0, cus = 0, per_cu = 0;
        if (hipGetDevice(&dev) != hipSuccess || hipDeviceGetAttribute(&cus, hipDeviceAttributeMultiprocessorCount, dev) != hipSuccess) { grid = -1; return; }
        if (hipFuncSetAttribute((const void*)fwd, hipFuncAttributeMaxDynamicSharedMemorySize, LDS_BYTES) != hipSuccess) { fprintf(stderr, "kernel_launch: hipFuncSetAttribute failed\n"); grid = -1; return; }
        if (hipOccupancyMaxActiveBlocksPerMultiprocessor(&per_cu, (const void*)fwd, NTHR, LDS_BYTES) != hipSuccess || per_cu < 1) fprintf(stderr, "kernel_launch: occupancy query reports %d\n", per_cu);
        (void)hipGetLastError();
        grid = cus;
    }
    if (grid < 0) return;
    (void)hipMemsetAsync((char*)d_ws + WS_CTL, 0, CTL_ZERO_BYTES, stream);
    Args a{};
    for (int i = 0; i < 23; ++i) a.in[i] = (const float*)d_in[i];
    a.out = (float*)d_out; a.ws = (unsigned char*)d_ws;
#if MK_SPLIT
    for (int p = 0; p < N_PHASES; ++p) { a.ph_lo = p; a.ph_hi = p + 1; a.use_bar = 0; a.pad = 0; hipLaunchKernelGGL(fwd, dim3(grid), dim3(NTHR), LDS_BYTES, stream, a); }
#else
    a.ph_lo = 0; a.ph_hi = N_PHASES; a.use_bar = 1; a.pad = 0;
    hipLaunchKernelGGL(fwd, dim3(grid), dim3(NTHR), LDS_BYTES, stream, a);
#endif
}
```

```cpp
#include <hip/hip_runtime.h>
#include <cstdio>
#include <cstdint>

namespace pg8 {
#define PG8_LAS __attribute__((address_space(3)))
typedef unsigned short bf16_t;
typedef short bf16x8 __attribute__((ext_vector_type(8)));
typedef float f32x4 __attribute__((ext_vector_type(4)));
typedef unsigned u32x4 __attribute__((ext_vector_type(4)));
typedef unsigned u32x2 __attribute__((ext_vector_type(2)));
typedef int v8i_t __attribute__((ext_vector_type(8)));
typedef int v4i_t __attribute__((ext_vector_type(4)));
constexpr int BM = 256, BK = 64, HALF = 128, HTB = HALF * BK * 2  , STAGE_BYTES = 8 * HTB, NXCD = 8, WGM = 8;

__host__ __device__ __forceinline__ int lds_byte(int r, int c) { const int st = (r >> 4) * 2 + (c >> 5), rr = r & 15, cc = c & 31, ob = rr * 64 + cc * 2; return st * 1024 + (ob ^ (((ob >> 9) & 1) << 5)); }
__host__ __device__ __forceinline__ void stage_rc(int b, int& R, int& C) { const int st = b / 1024, sb = b % 1024, swz = sb ^ (((sb >> 9) & 1) << 5); R = (st >> 1) * 16 + swz / 64; C = (st & 1) * 32 + (swz % 64) / 2; }
__host__ __device__ __forceinline__ int perm32(int rho) { const int n = rho >> 4, i = rho & 15; return 8 * (i >> 2) + 4 * n + (i & 3); }

struct Unit { int pm, pn; };
struct Gemm { const bf16_t* A; const bf16_t* Bt; int M, N, K; };

struct Order {
    int nM, nN, nwg, G, c; const int* pexp; size_t bstride;
    __device__ void init(int nM_, int N, int G_, int c_, const int* pexp_, size_t bstride_) { nM = nM_; nN = N / BM; nwg = nM * nN; G = G_; c = c_; pexp = pexp_; bstride = bstride_; }
    __device__ bool next(int i, Unit& u) const {
        const long L = (long)i * G + c; if (L >= nwg) return false;
        int wgid = (int)L; { const int q = nwg / NXCD, r = nwg % NXCD, xcd = wgid % NXCD, off = wgid / NXCD; wgid = (xcd < r ? xcd * (q + 1) : r * (q + 1) + (xcd - r) * q) + off; }
        const int nig = WGM * nN, gid = wgid / nig, fm = gid * WGM, gsz = (nM - fm) < WGM ? (nM - fm) : WGM;
        u.pm = fm + ((wgid % nig) % gsz); u.pn = (wgid % nig) / gsz; return true;
    }
    __device__ __forceinline__ size_t boff(const Unit& u) const { return pexp ? (size_t)__builtin_amdgcn_readfirstlane(pexp[u.pm]) * bstride : (size_t)0; }
    __device__ __forceinline__ void a_ready(const Unit&) const {}
    __device__ __forceinline__ void done(const Unit&) const {}
};

__device__ __forceinline__ unsigned cvt_pk_bf16(float lo, float hi) { unsigned r; asm volatile("v_cvt_pk_bf16_f32 %0, %1, %2" : "=v"(r) : "v"(lo), "v"(hi)); return r; }

struct EpiStore {
    static constexpr bool PERM = true, AFTER_DRAIN = false;
    bf16_t* O; int ldc; int ncol_tiles; int gate_pn; float* gates; float oscale;
    __device__ __forceinline__ void operator()(const f32x4 (&acc)[2][2][4][2], const Unit& u, int wr, int wc, int fr, int fq) const {
        const int row0 = u.pm * BM + wr * 64 + fr;
        if (u.pn < ncol_tiles) {
            const int col0 = u.pn * BM + wc * 32 + 8 * fq;
#pragma unroll
            for (int ai = 0; ai < 2; ++ai)
#pragma unroll
                for (int m = 0; m < 4; ++m) { bf16_t* rowp = O + (size_t)(row0 + ai * HALF + m * 16) * ldc + col0;
#pragma unroll
                    for (int bj = 0; bj < 2; ++bj) { const f32x4 v0 = acc[ai][bj][m][0] * oscale, v1 = acc[ai][bj][m][1] * oscale;
                        u32x4 w; w.x = cvt_pk_bf16(v0[0], v0[1]); w.y = cvt_pk_bf16(v0[2], v0[3]); w.z = cvt_pk_bf16(v1[0], v1[1]); w.w = cvt_pk_bf16(v1[2], v1[3]);
                        *(u32x4*)(rowp + bj * HALF) = w; } }
        } else if (u.pn == gate_pn && wc == 0) {
#pragma unroll
            for (int ai = 0; ai < 2; ++ai)
#pragma unroll
                for (int m = 0; m < 4; ++m) { float* rowp = gates + (size_t)(row0 + ai * HALF + m * 16) * 32 + 8 * fq;
                    *(f32x4*)(rowp) = acc[ai][0][m][0]; *(f32x4*)(rowp + 4) = acc[ai][0][m][1]; }
        }
    }
};
struct EpiSwiGLU {
    static constexpr bool PERM = true, AFTER_DRAIN = false;
    bf16_t* O; int ldc;
    __device__ __forceinline__ void operator()(const f32x4 (&acc)[2][2][4][2], const Unit& u, int wr, int wc, int fr, int fq) const {
        const int row0 = u.pm * BM + wr * 64 + fr, col0 = u.pn * HALF + wc * 32 + 8 * fq;
#pragma unroll
        for (int ai = 0; ai < 2; ++ai)
#pragma unroll
            for (int m = 0; m < 4; ++m) { bf16_t* rowp = O + (size_t)(row0 + ai * HALF + m * 16) * ldc + col0; float r[8];
#pragma unroll
                for (int n = 0; n < 2; ++n)
#pragma unroll
                    for (int j = 0; j < 4; ++j) { const float g = acc[ai][0][m][n][j], up = acc[ai][1][m][n][j]; r[n * 4 + j] = g * __builtin_amdgcn_rcpf(1.0f + __expf(-g)) * up; }
                u32x4 w; w.x = cvt_pk_bf16(r[0], r[1]); w.y = cvt_pk_bf16(r[2], r[3]); w.z = cvt_pk_bf16(r[4], r[5]); w.w = cvt_pk_bf16(r[6], r[7]);
                *(u32x4*)(rowp) = w; }
    }
};
struct EpiSwiGLU8 {
    static constexpr bool PERM = true, AFTER_DRAIN = false;
    unsigned char* O; int ldc; float ascale;
    __device__ __forceinline__ void operator()(const f32x4 (&acc)[2][2][4][2], const Unit& u, int wr, int wc, int fr, int fq) const {
        typedef float f32x2 __attribute__((ext_vector_type(2)));
        const int row0 = u.pm * BM + wr * 64 + fr, col0 = u.pn * HALF + wc * 32 + 8 * fq;
        const float c1 = -ascale * 1.4426950408889634f, c2 = ascale * ascale;
#pragma unroll
        for (int ai = 0; ai < 2; ++ai)
#pragma unroll
            for (int m = 0; m < 4; ++m) { unsigned char* rowp = O + (size_t)(row0 + ai * HALF + m * 16) * ldc + col0; f32x2 r[4];
#pragma unroll
                for (int n = 0; n < 2; ++n)
#pragma unroll
                    for (int j = 0; j < 2; ++j) { const f32x2 ag = {acc[ai][0][m][n][2 * j], acc[ai][0][m][n][2 * j + 1]}, au = {acc[ai][1][m][n][2 * j], acc[ai][1][m][n][2 * j + 1]};
                        const f32x2 t = ag * c1; f32x2 d = {__builtin_amdgcn_exp2f(t.x), __builtin_amdgcn_exp2f(t.y)}; d = d + 1.0f;
                        const f32x2 q = {__builtin_amdgcn_rcpf(d.x), __builtin_amdgcn_rcpf(d.y)};
                        r[n * 2 + j] = ((ag * au) * q) * c2; }
                u32x2 w; unsigned t = 0; t = __builtin_amdgcn_cvt_pk_fp8_f32(r[0].x, r[0].y, t, false); t = __builtin_amdgcn_cvt_pk_fp8_f32(r[1].x, r[1].y, t, true); w.x = t;
                t = 0; t = __builtin_amdgcn_cvt_pk_fp8_f32(r[2].x, r[2].y, t, false); t = __builtin_amdgcn_cvt_pk_fp8_f32(r[3].x, r[3].y, t, true); w.y = t;
                *(u32x2*)(rowp) = w; }
    }
};
struct EpiStoreI8 {
    static constexpr bool PERM = true, AFTER_DRAIN = false;
    bf16_t* O; int ldc; int ncol_tiles; int gate_pn; float* gates; const float* sa; const float* sw;
    __device__ __forceinline__ void operator()(const f32x4 (&acc)[2][2][4][2], const Unit& u, int wr, int wc, int fr, int fq) const {
        const int row0 = u.pm * BM + wr * 64 + fr;
        if (u.pn < ncol_tiles) {
            const int col0 = u.pn * BM + wc * 32 + 8 * fq;
            f32x4 cs[2][2];
#pragma unroll
            for (int bj = 0; bj < 2; ++bj) { cs[bj][0] = *(const f32x4*)(sw + col0 + bj * HALF); cs[bj][1] = *(const f32x4*)(sw + col0 + bj * HALF + 4); }
#pragma unroll
            for (int ai = 0; ai < 2; ++ai)
#pragma unroll
                for (int m = 0; m < 4; ++m) { const int row = row0 + ai * HALF + m * 16; const float rs = sa[row]; bf16_t* rowp = O + (size_t)row * ldc + col0;
#pragma unroll
                    for (int bj = 0; bj < 2; ++bj) { const v4i_t i0 = __builtin_bit_cast(v4i_t, acc[ai][bj][m][0]), i1 = __builtin_bit_cast(v4i_t, acc[ai][bj][m][1]);
                        f32x4 v0 = __builtin_convertvector(i0, f32x4) * cs[bj][0] * rs, v1 = __builtin_convertvector(i1, f32x4) * cs[bj][1] * rs;
#ifdef EMU_F8_LO
                        if (u.pn >= EMU_F8_LO && u.pn < EMU_F8_HI) {
                            unsigned q0 = 0, q1 = 0; q0 = __builtin_amdgcn_cvt_pk_fp8_f32(v0[0], v0[1], q0, false); q0 = __builtin_amdgcn_cvt_pk_fp8_f32(v0[2], v0[3], q0, true); q1 = __builtin_amdgcn_cvt_pk_fp8_f32(v1[0], v1[1], q1, false); q1 = __builtin_amdgcn_cvt_pk_fp8_f32(v1[2], v1[3], q1, true);
                            const auto a = __builtin_amdgcn_cvt_pk_f32_fp8(q0, false), b = __builtin_amdgcn_cvt_pk_f32_fp8(q0, true), c = __builtin_amdgcn_cvt_pk_f32_fp8(q1, false), d = __builtin_amdgcn_cvt_pk_f32_fp8(q1, true);
                            v0[0] = a[0]; v0[1] = a[1]; v0[2] = b[0]; v0[3] = b[1]; v1[0] = c[0]; v1[1] = c[1]; v1[2] = d[0]; v1[3] = d[1]; }
#endif
                        u32x4 w; w.x = cvt_pk_bf16(v0[0], v0[1]); w.y = cvt_pk_bf16(v0[2], v0[3]); w.z = cvt_pk_bf16(v1[0], v1[1]); w.w = cvt_pk_bf16(v1[2], v1[3]);
                        *(u32x4*)(rowp + bj * HALF) = w; } }
        } else if (u.pn == gate_pn && wc == 0) {
            const int col0 = u.pn * BM + 8 * fq; const f32x4 c0 = *(const f32x4*)(sw + col0), c1 = *(const f32x4*)(sw + col0 + 4);
#pragma unroll
            for (int ai = 0; ai < 2; ++ai)
#pragma unroll
                for (int m = 0; m < 4; ++m) { const int row = row0 + ai * HALF + m * 16; const float rs = sa[row]; float* rowp = gates + (size_t)row * 32 + 8 * fq;
                    *(f32x4*)(rowp) = __builtin_convertvector(__builtin_bit_cast(v4i_t, acc[ai][0][m][0]), f32x4) * c0 * rs; *(f32x4*)(rowp + 4) = __builtin_convertvector(__builtin_bit_cast(v4i_t, acc[ai][0][m][1]), f32x4) * c1 * rs; }
        }
    }
};
struct EpiSwiGLU8I {
    static constexpr bool PERM = true, AFTER_DRAIN = false;
    unsigned char* O; int ldc; const float* sa; const float* sw; const int* pexp; int swstride; int obf16;
    __device__ __forceinline__ void operator()(const f32x4 (&acc)[2][2][4][2], const Unit& u, int wr, int wc, int fr, int fq) const {
        typedef float f32x2 __attribute__((ext_vector_type(2)));
        const int row0 = u.pm * BM + wr * 64 + fr, col0 = u.pn * HALF + wc * 32 + 8 * fq;
        const float* swe = sw + (pexp ? (size_t)__builtin_amdgcn_readfirstlane(pexp[u.pm]) * swstride : (size_t)0) + u.pn * BM + wc * 32 + 8 * fq;
        const f32x4 g0 = *(const f32x4*)(swe), g1 = *(const f32x4*)(swe + 4), u0 = *(const f32x4*)(swe + HALF), u1 = *(const f32x4*)(swe + HALF + 4);
        const float gs[8] = {g0[0], g0[1], g0[2], g0[3], g1[0], g1[1], g1[2], g1[3]}, us[8] = {u0[0], u0[1], u0[2], u0[3], u1[0], u1[1], u1[2], u1[3]};
#pragma unroll
        for (int ai = 0; ai < 2; ++ai)
#pragma unroll
            for (int m = 0; m < 4; ++m) { const int row = row0 + ai * HALF + m * 16; const float rs = sa[row]; unsigned char* rowp = O + (size_t)row * ldc + col0; float r[8];
#pragma unroll
                for (int n = 0; n < 2; ++n) { const v4i_t ig = __builtin_bit_cast(v4i_t, acc[ai][0][m][n]), iu = __builtin_bit_cast(v4i_t, acc[ai][1][m][n]);
#pragma unroll
                    for (int j = 0; j < 4; ++j) { const float g = (float)ig[j] * (gs[4 * n + j] * rs), up = (float)iu[j] * (us[4 * n + j] * rs);
                        r[4 * n + j] = g * __builtin_amdgcn_rcpf(1.0f + __builtin_amdgcn_exp2f(g * -1.4426950408889634f)) * up; } }
                if (obf16) { u32x4 w; w.x = cvt_pk_bf16(r[0], r[1]); w.y = cvt_pk_bf16(r[2], r[3]); w.z = cvt_pk_bf16(r[4], r[5]); w.w = cvt_pk_bf16(r[6], r[7]);
                    *(u32x4*)((bf16_t*)O + (size_t)row * ldc + col0) = w; }
                else { u32x2 w; unsigned t = 0; t = __builtin_amdgcn_cvt_pk_fp8_f32(r[0], r[1], t, false); t = __builtin_amdgcn_cvt_pk_fp8_f32(r[2], r[3], t, true); w.x = t;
                    t = 0; t = __builtin_amdgcn_cvt_pk_fp8_f32(r[4], r[5], t, false); t = __builtin_amdgcn_cvt_pk_fp8_f32(r[6], r[7], t, true); w.y = t;
                    *(u32x2*)(rowp) = w; } }
    }
};

template <bool FP8> struct Frag;
template <> struct Frag<false> { bf16x8 v[2]; };
template <> struct Frag<true> { v8i_t v; };
template <bool FP8> __device__ __forceinline__ void ldfrag(Frag<FP8>& f, const PG8_LAS unsigned char* p) {
    if constexpr (FP8) { const bf16x8 a = *(const PG8_LAS bf16x8*)p, b = *(const PG8_LAS bf16x8*)(p + 1024); f.v = __builtin_bit_cast(v8i_t, __builtin_shufflevector(a, b, 0, 1, 2, 3, 4, 5, 6, 7, 8, 9, 10, 11, 12, 13, 14, 15)); }
    else { f.v[0] = *(const PG8_LAS bf16x8*)p; f.v[1] = *(const PG8_LAS bf16x8*)(p + 1024); }
}
template <class Epi, class Sched, bool ALIGN_EPI = false, bool SP2 = false, int MODE = 0  >
__device__ __forceinline__ void gemm_phase(PG8_LAS unsigned char* lds, const Gemm g, const Sched& S, const Epi& E) {
    int tid = threadIdx.x; asm volatile("" : "+v"(tid)); const int wid = __builtin_amdgcn_readfirstlane(tid >> 6), lane = tid & 63, wr = wid >> 2, wc = wid & 3, fr = lane & 15, fq = lane >> 4;
    constexpr bool FP8 = (MODE == 1);
    const int K = g.K, rowb = (MODE != 0) ? K : 2 * K, nt = rowb / 128;
    unsigned voffA[2], voffB[2];
#pragma unroll
    for (int i = 0; i < 2; ++i) { int R, C; stage_rc(tid * 16 + i * 8192, R, C); const int Rb = Epi::PERM ? ((R & ~31) + perm32(R & 31)) : R;
        voffA[i] = (unsigned)(R * rowb + C * 2); voffB[i] = (unsigned)(Rb * rowb + C * 2); }
    const size_t kstep = (size_t)(BK * 2);
    const size_t hstep = (size_t)HALF * rowb;
    const size_t tstep = 2 * hstep;
    const unsigned ldsw = (unsigned)wid * 1024u;
    const int aoff = lds_byte(wr * 64 + fr, fq * 8), boff = lds_byte(wc * 32 + fr, fq * 8);
#define PG8_SA(b, h) (((b) * 2 + (h)) * HTB)
#define PG8_SB(b, h) ((4 + (b) * 2 + (h)) * HTB)
#define PG8_STAGE(bufoff, gbase, voff) do { _Pragma("unroll") for (int _i = 0; _i < 2; ++_i) \
        __builtin_amdgcn_global_load_lds((const unsigned*)((const char*)(gbase) + (voff)[_i]), (PG8_LAS unsigned*)(lds + (bufoff) + ldsw + _i * 8192), 16, 0, 0); } while (0)
#define PG8_LDA(dst, b, h) do { _Pragma("unroll") for (int m = 0; m < 4; ++m) ldfrag<FP8>(dst[m], lds + PG8_SA(b, h) + aoff + m * 2048); } while (0)
#define PG8_LDB(dst, b, h) do { _Pragma("unroll") for (int n = 0; n < 2; ++n) ldfrag<FP8>(dst[n], lds + PG8_SB(b, h) + boff + n * 2048); } while (0)
#define PG8_MMA(ai, bj, At, Bt) do { __builtin_amdgcn_s_setprio(1); _Pragma("unroll") for (int m = 0; m < 4; ++m) _Pragma("unroll") for (int n = 0; n < 2; ++n) { \
        if constexpr (FP8) { asm volatile("v_mfma_f32_16x16x128_f8f6f4 %0, %1, %2, %0" : "+v"(acc[ai][bj][m][n]) : "v"(Bt[n].v), "v"(At[m].v)); }     \
        else if constexpr (MODE == 2) { _Pragma("unroll") for (int k = 0; k < 2; ++k) acc[ai][bj][m][n] = __builtin_bit_cast(f32x4, __builtin_amdgcn_mfma_i32_16x16x64_i8(__builtin_bit_cast(v4i_t, Bt[n].v[k]), __builtin_bit_cast(v4i_t, At[m].v[k]), __builtin_bit_cast(v4i_t, acc[ai][bj][m][n]), 0, 0, 0)); } \
        else { _Pragma("unroll") for (int k = 0; k < 2; ++k) acc[ai][bj][m][n] = __builtin_amdgcn_mfma_f32_16x16x32_bf16(Bt[n].v[k], At[m].v[k], acc[ai][bj][m][n], 0, 0, 0); } } __builtin_amdgcn_s_setprio(0); } while (0)
#define PG8_WAIT_V(n) asm volatile("s_waitcnt vmcnt(" #n ")" ::: "memory")
#define PG8_WAIT_L(n) asm volatile("s_waitcnt lgkmcnt(" #n ")" ::: "memory")
#define PG8_BAR __builtin_amdgcn_s_barrier()
#define PG8_SCHED __builtin_amdgcn_sched_barrier(0)
    Unit cur, nxt; int ui = 0;
    if (!S.next(0, cur)) return;
    f32x4 acc[2][2][4][2];
#pragma unroll
    for (int a = 0; a < 2; ++a)
#pragma unroll
        for (int b = 0; b < 2; ++b)
#pragma unroll
            for (int m = 0; m < 4; ++m)
#pragma unroll
                for (int n = 0; n < 2; ++n) acc[a][b][m][n] = (f32x4){0.f, 0.f, 0.f, 0.f};
    Frag<FP8> At[4], B0[2], B1[2];
    const char* cA = (const char*)g.A + (size_t)cur.pm * tstep; const char* cB = (const char*)g.Bt + S.boff(cur) + (size_t)cur.pn * tstep;
    S.a_ready(cur);
    if constexpr (SP2) {
        PG8_STAGE(PG8_SB(0, 0), cB, voffB); PG8_STAGE(PG8_SB(0, 1), cB + hstep, voffB); PG8_STAGE(PG8_SA(0, 0), cA, voffA); PG8_STAGE(PG8_SA(0, 1), cA + hstep, voffA);
        if (wr == 1) PG8_BAR;
        PG8_WAIT_V(2); PG8_BAR;
        PG8_STAGE(PG8_SB(1, 0), cB + kstep, voffB); PG8_STAGE(PG8_SA(1, 0), cA + kstep, voffA); PG8_STAGE(PG8_SB(1, 1), cB + hstep + kstep, voffB);
        PG8_WAIT_V(6); PG8_BAR;
    } else {
        PG8_STAGE(PG8_SB(0, 0), cB, voffB); PG8_STAGE(PG8_SA(0, 0), cA, voffA); PG8_STAGE(PG8_SB(0, 1), cB + hstep, voffB); PG8_STAGE(PG8_SA(0, 1), cA + hstep, voffA);
        if (wr == 1) PG8_BAR;
        PG8_WAIT_V(4); PG8_BAR;
        PG8_STAGE(PG8_SB(1, 0), cB + kstep, voffB); PG8_STAGE(PG8_SA(1, 0), cA + kstep, voffA); PG8_STAGE(PG8_SB(1, 1), cB + hstep + kstep, voffB);
        PG8_WAIT_V(6); PG8_BAR;
    }
    for (;;) {
        const bool has_next = S.next(ui + 1, nxt);
        const char* nA = has_next ? (const char*)g.A + (size_t)nxt.pm * tstep : cA; const char* nB = has_next ? (const char*)g.Bt + S.boff(nxt) + (size_t)nxt.pn * tstep : cB;
#pragma unroll 1
        for (int t = 0; t < nt; t += 2) {
            const bool last = (t == nt - 2);
            const char* a1 = cA + (size_t)(t + 1) * kstep;
            const char* a2 = last ? nA : cA + (size_t)(t + 2) * kstep; const char* b2 = last ? nB : cB + (size_t)(t + 2) * kstep;
            const char* a3 = a2 + kstep; const char* b3 = b2 + kstep;
            if (last && has_next) S.a_ready(nxt);
            if constexpr (SP2) {
            PG8_LDB(B0, 0, 0); PG8_LDB(B1, 0, 1); PG8_SCHED; PG8_LDA(At, 0, 0); PG8_STAGE(PG8_SA(1, 1), a1 + hstep, voffA);
            PG8_WAIT_V(8); PG8_WAIT_L(0); PG8_BAR; PG8_MMA(0, 0, At, B0); PG8_MMA(0, 1, At, B1); PG8_BAR; PG8_SCHED;
            PG8_LDA(At, 0, 1); PG8_STAGE(PG8_SB(0, 0), b2, voffB); PG8_STAGE(PG8_SB(0, 1), b2 + hstep, voffB); PG8_STAGE(PG8_SA(0, 0), a2, voffA);
            PG8_WAIT_V(8); PG8_WAIT_L(0); PG8_BAR; PG8_MMA(1, 0, At, B0); PG8_MMA(1, 1, At, B1); PG8_BAR; PG8_SCHED;
            PG8_LDB(B0, 1, 0); PG8_LDB(B1, 1, 1); PG8_SCHED; PG8_LDA(At, 1, 0); PG8_STAGE(PG8_SA(0, 1), a2 + hstep, voffA);
            PG8_WAIT_V(8); PG8_WAIT_L(0); PG8_BAR; PG8_MMA(0, 0, At, B0); PG8_MMA(0, 1, At, B1); PG8_BAR; PG8_SCHED;
            PG8_LDA(At, 1, 1); PG8_STAGE(PG8_SB(1, 0), b3, voffB); PG8_STAGE(PG8_SB(1, 1), b3 + hstep, voffB); PG8_STAGE(PG8_SA(1, 0), a3, voffA);
            PG8_WAIT_V(8); PG8_WAIT_L(0); PG8_BAR; PG8_MMA(1, 0, At, B0); PG8_MMA(1, 1, At, B1); PG8_BAR; PG8_SCHED;
            } else {
            PG8_LDB(B0, 0, 0); PG8_SCHED; PG8_LDA(At, 0, 0); PG8_STAGE(PG8_SA(1, 1), a1 + hstep, voffA);
            PG8_WAIT_L(8); PG8_BAR; PG8_WAIT_L(0); PG8_MMA(0, 0, At, B0); PG8_BAR; PG8_SCHED;
            PG8_LDB(B1, 0, 1); PG8_STAGE(PG8_SB(0, 0), b2, voffB);
            PG8_BAR; PG8_WAIT_L(0); PG8_MMA(0, 1, At, B1); PG8_BAR;
            PG8_LDA(At, 0, 1); PG8_STAGE(PG8_SA(0, 0), a2, voffA);
            PG8_BAR; PG8_WAIT_L(0); PG8_MMA(1, 0, At, B0); PG8_BAR; PG8_SCHED;
            PG8_STAGE(PG8_SB(0, 1), b2 + hstep, voffB);
            PG8_WAIT_V(6); PG8_BAR; PG8_MMA(1, 1, At, B1); PG8_BAR;
            PG8_LDB(B0, 1, 0); PG8_SCHED; PG8_LDA(At, 1, 0); PG8_STAGE(PG8_SA(0, 1), a2 + hstep, voffA);
            PG8_WAIT_L(8); PG8_BAR; PG8_WAIT_L(0); PG8_MMA(0, 0, At, B0); PG8_BAR; PG8_SCHED;
            PG8_LDB(B1, 1, 1); PG8_STAGE(PG8_SB(1, 0), b3, voffB);
            PG8_BAR; PG8_WAIT_L(0); PG8_MMA(0, 1, At, B1); PG8_BAR;
            PG8_LDA(At, 1, 1); PG8_STAGE(PG8_SA(1, 0), a3, voffA);
            PG8_BAR; PG8_WAIT_L(0); PG8_MMA(1, 0, At, B0); PG8_BAR; PG8_SCHED;
            PG8_STAGE(PG8_SB(1, 1), b3 + hstep, voffB);
            PG8_WAIT_V(6); PG8_BAR; PG8_MMA(1, 1, At, B1); PG8_BAR;
            }
        }
        if constexpr (ALIGN_EPI) { if (wr == 0) PG8_BAR; }
        if constexpr (FP8) { asm volatile("s_nop 15\n\ts_nop 15" ::: "memory"); }
        if constexpr (!Epi::AFTER_DRAIN) { E(acc, cur, wr, wc, fr, fq); S.done(cur); }
        if (!has_next) break;
#pragma unroll
        for (int a = 0; a < 2; ++a)
#pragma unroll
            for (int b = 0; b < 2; ++b)
#pragma unroll
                for (int m = 0; m < 4; ++m)
#pragma unroll
                    for (int n = 0; n < 2; ++n) acc[a][b][m][n] = (f32x4){0.f, 0.f, 0.f, 0.f};
        cur = nxt; cA = nA; cB = nB; ++ui;
        if constexpr (ALIGN_EPI) { if (wr == 1) PG8_BAR; }
    }
    PG8_WAIT_V(0);
    if constexpr (!ALIGN_EPI) { if (wr == 0) PG8_BAR; }
    PG8_BAR;
    if constexpr (Epi::AFTER_DRAIN) { E.fused(acc, cur, wr, wc, fr, fq, lds, wid, lane); S.done(cur); }
#undef PG8_SA
#undef PG8_SB
#undef PG8_STAGE
#undef PG8_LDA
#undef PG8_LDB
#undef PG8_MMA
#undef PG8_WAIT_V
#undef PG8_WAIT_L
#undef PG8_BAR
#undef PG8_SCHED
}
}

constexpr int D = 1024, NB = 8, SEQ = 8192, CTXL = 256, DEPTH = 4, GRIDW = 64, ROWS_G = SEQ / GRIDW  ;
constexpr int M_LAT = NB * SEQ  , M_CTX = NB * CTXL  , M_ALL = M_LAT + M_CTX  ;
constexpr int NHEAD = 8, M_DK = 64, M_DV = 128, H_DK = 128, H_DV = 128;
constexpr int NP_M = 3072, NIN_M = 3328, NW_M = 3104, NP_H = 5120;
constexpr int FF = 2816, NGU = 2 * FF, NEXP = 8;
constexpr int MOE_ROWS = 137216, MOE_PANELS = MOE_ROWS / 256;
constexpr float EPS = 1e-6f;
constexpr int NWAVES = 8, NTHR = 512;

constexpr size_t MiB = 1u << 20;
constexpr size_t WS_CTL = 0, CTL_ZERO_BYTES = 936 * 1024;
constexpr size_t WS_MODV = 1 * MiB;
constexpr size_t WS_SMALL = 2 * MiB;
constexpr size_t WS_LATC = 3 * MiB;
constexpr size_t WS_WE = 11 * MiB;
constexpr size_t WS_WO = 37 * MiB;
constexpr size_t WS_U = 181 * MiB;
constexpr size_t WS_GATES = 313 * MiB;
constexpr size_t WS_STATE = 322 * MiB;
constexpr size_t WS_ROUTE = 362 * MiB;
constexpr size_t WS_ACT = 364 * MiB;
constexpr size_t WS_Y = WS_ACT + 700 * MiB;
constexpr size_t WS_END = WS_ACT + 1005 * MiB;
constexpr size_t WE_IN = 0, WE_OUT = 7 * MiB, WE_GU = 9 * MiB, WE_DOWN = 20 * MiB;
constexpr size_t WOD_IN = 0, WOD_OUT = 10 * MiB, WOD_GU = 12 * MiB, WOD_DOWN = 100 * MiB;
constexpr size_t EGU_BYTES = (size_t)NGU * D * 2, EDOWN_BYTES = (size_t)D * FF * 2;
static_assert(WOD_GU + 8 * EGU_BYTES <= WOD_DOWN && WOD_DOWN + 8 * EDOWN_BYTES <= 144 * MiB, "odd weights map");
static_assert((size_t)NIN_M * D * 2 <= 7 * MiB && WE_GU + EGU_BYTES <= WE_DOWN && WE_DOWN + EDOWN_BYTES <= 26 * MiB, "even weights map");
static_assert((size_t)M_ALL * NP_H * 2 <= 700 * MiB && (size_t)MOE_ROWS * D * 2 + (size_t)MOE_ROWS * FF * 2 <= 1005 * MiB && 700 * MiB + (size_t)M_ALL * D * 2 <= 1005 * MiB, "act map");
constexpr int CW_BAR = 4096;
constexpr int CW_ECNT = 8192;
constexpr int CW_DBG = 16384;
constexpr int CW_CMAX = 32768, CM_LSTRIDE = 50176, CM_GU = 3328, CM_GU_O = 5120;
static_assert((size_t)(CW_CMAX + 4 * CM_LSTRIDE) * 4 <= CTL_ZERO_BYTES, "ctl map");
constexpr size_t RT_E = 0;
constexpr size_t RT_R = 512 * 1024;
constexpr size_t RT_W = 512 * 1024 + 1024 * 1024;
constexpr size_t SM_LB = 0;
constexpr size_t SM_PEXP = 64 * 1024;
constexpr size_t SM_EBASE = 96 * 1024;
constexpr size_t SM_SAU = 128 * 1024;
constexpr size_t SM_SAU2 = 400 * 1024;
constexpr size_t SM_SWE = 672 * 1024;
constexpr size_t SM_SWO = 712 * 1024;
constexpr int SWE_IN = 0, SWE_GU = 3328, SWO_IN = 0, SWO_GU = 5120;
static_assert(SM_SAU + (size_t)M_ALL * 4 <= SM_SAU2 && SM_SAU2 + (size_t)M_ALL * 4 <= SM_SWE && SM_SWE + (3328 + 5632) * 4 <= SM_SWO && SM_SWO + (5120 + 8 * 5632) * 4 <= 1024 * 1024, "small region map");
constexpr size_t GATES_SAMOE = (size_t)M_ALL * 32 * 4;
static_assert(GATES_SAMOE + (size_t)MOE_ROWS * 4 <= 9 * MiB, "gates region map");

constexpr int LDS_MAIN = 147456;
constexpr int LDSCTL_OFF = LDS_MAIN;
constexpr int LDS_BYTES = LDS_MAIN + 512;

#define GAS __attribute__((address_space(1)))
#define LAS __attribute__((address_space(3)))
typedef unsigned short bf16;
typedef unsigned v4u __attribute__((ext_vector_type(4)));
typedef unsigned v2u __attribute__((ext_vector_type(2)));
typedef float f32x4 __attribute__((ext_vector_type(4)));
typedef float f32x16 __attribute__((ext_vector_type(16)));
typedef short bf16x8 __attribute__((ext_vector_type(8)));
typedef short s16x4 __attribute__((ext_vector_type(4)));
typedef GAS unsigned gu32;
#define RLX_AGENT __ATOMIC_RELAXED, __HIP_MEMORY_SCOPE_AGENT
#define LDS_WAIT() asm volatile("s_waitcnt lgkmcnt(0)" ::: "memory")
#define VM_WAIT() asm volatile("s_waitcnt vmcnt(0)" ::: "memory")
#define CFENCE() asm volatile("" ::: "memory")
__device__ __forceinline__ unsigned f2bf(float f) { unsigned u = __builtin_bit_cast(unsigned, f); return (u + 0x7fffu + ((u >> 16) & 1u)) >> 16; }
typedef __bf16 bf16x2_t __attribute__((ext_vector_type(2)));
typedef float f32x2_t __attribute__((ext_vector_type(2)));
__device__ __forceinline__ unsigned pk2(float lo, float hi) { f32x2_t v = {lo, hi}; bf16x2_t b = __builtin_convertvector(v, bf16x2_t); return __builtin_bit_cast(unsigned, b); }
__device__ __forceinline__ float bf2f(unsigned short b) { return __builtin_bit_cast(float, (unsigned)b << 16); }
__device__ __forceinline__ float bflo(unsigned w) { return __builtin_bit_cast(float, w << 16); }
__device__ __forceinline__ float bfhi(unsigned w) { return __builtin_bit_cast(float, w & 0xffff0000u); }
__device__ __forceinline__ float sigmoidf_(float x) { return __builtin_amdgcn_rcpf(1.0f + __expf(-x)); }
__device__ __forceinline__ float siluf_(float x) { return x * sigmoidf_(x); }
template <int CTRL, int RM> __device__ __forceinline__ float dppmov(float x) { return __builtin_bit_cast(float, __builtin_amdgcn_update_dpp(0, __builtin_bit_cast(int, x), CTRL, RM, 0xf, false)); }
__device__ __forceinline__ float wave_sum(float v) {
    v += dppmov<0xB1, 0xf>(v); v += dppmov<0x4E, 0xf>(v); v += dppmov<0x141, 0xf>(v); v += dppmov<0x140, 0xf>(v);
    v += dppmov<0x142, 0xa>(v); v += dppmov<0x143, 0xc>(v);
    return __builtin_bit_cast(float, __builtin_amdgcn_readlane(__builtin_bit_cast(int, v), 63));
}

__device__ __forceinline__ float wave_max(float v) {
    v = fmaxf(v, dppmov<0xB1, 0xf>(v)); v = fmaxf(v, dppmov<0x4E, 0xf>(v)); v = fmaxf(v, dppmov<0x141, 0xf>(v)); v = fmaxf(v, dppmov<0x140, 0xf>(v));
    v = fmaxf(v, dppmov<0x142, 0xa>(v)); v = fmaxf(v, dppmov<0x143, 0xc>(v));
    return __builtin_bit_cast(float, __builtin_amdgcn_readlane(__builtin_bit_cast(int, v), 63));
}

#define XB_TMO      128
#define XB_XCNT(j)  (256  + 64 * (j))
#define XB_XSUB(j)  (1280 + 64 * (j))
#define XB_XGEN(j)  (2304 + 64 * (j))
#define XB_TOP      3328
#define XB_TOPGEN   3392
#define XCD_BAR_WORDS 3456
#define XB_SPIN_CAP (1u << 18)
__device__ __forceinline__ unsigned xb_ld(unsigned* p)              { return __hip_atomic_load(p, __ATOMIC_RELAXED, __HIP_MEMORY_SCOPE_AGENT); }
__device__ __forceinline__ unsigned xb_add(unsigned* p, unsigned v) { return __hip_atomic_fetch_add(p, v, __ATOMIC_RELAXED, __HIP_MEMORY_SCOPE_AGENT); }
__device__ __forceinline__ unsigned xb_xcc_id() { return (unsigned)__builtin_amdgcn_s_getreg((3 << 11) | 20) & 0xFu; }
#define XB_SPIN(cond, bar) do { unsigned _sp = 0; while (cond) { __builtin_amdgcn_s_sleep(1); \
    if ((++_sp & 255u) == 0u) { if (xb_ld(&(bar)[XB_TMO])) break; if (_sp > XB_SPIN_CAP) { atomicAdd(&(bar)[XB_TMO], 1u); break; } } } } while (0)
struct XcdBarrier { unsigned* bar; unsigned x; volatile LAS unsigned* st; };
__device__ __forceinline__ XcdBarrier xcd_barrier_post(unsigned* bar, volatile LAS unsigned* st) {
    XcdBarrier b; b.bar = bar; b.x = xb_xcc_id(); b.st = st;
    if (threadIdx.x == 0) (void)xb_add(&bar[XB_XCNT(b.x)], 1u);
    return b;
}
__device__ __forceinline__ void xcd_barrier_complete(unsigned* bar, unsigned x, unsigned& nloc, unsigned& nx) {
    const unsigned G = gridDim.x * gridDim.y * gridDim.z;
    unsigned sum, cnt, mine, sp = 0u;
    for (;;) {
        sum = 0u; cnt = 0u; mine = 0u;
#pragma unroll
        for (unsigned j = 0; j < 16; ++j) { const unsigned c = xb_ld(&bar[XB_XCNT(j)]); sum += c; cnt += (c > 0u) ? 1u : 0u; mine = (j == x) ? c : mine; }
        if (sum == G) break;
        __builtin_amdgcn_s_sleep(1);
        if ((++sp & 255u) == 0u) { if (xb_ld(&bar[XB_TMO])) break; if (sp > XB_SPIN_CAP) { atomicAdd(&bar[XB_TMO], 1u); break; } }
    }
    nloc = mine > 0u ? mine : 1u; nx = cnt > 0u ? cnt : 1u;
}
__device__ __attribute__((noinline)) void xcd_barrier(unsigned* bar_, unsigned bx_, volatile LAS unsigned* st_) { XcdBarrier b; b.bar = bar_; b.x = bx_; b.st = st_;
    asm volatile("s_waitcnt vmcnt(0)" ::: "memory");
    __syncthreads();
    if (threadIdx.x == 0) {
        unsigned* bar = b.bar;
        __builtin_amdgcn_s_waitcnt(0);
        unsigned nloc = b.st[0], nx = b.st[1];
        if (nloc == 0u) { xcd_barrier_complete(bar, b.x, nloc, nx); b.st[0] = nloc; b.st[1] = nx; }
        const unsigned old = xb_add(&bar[XB_XSUB(b.x)], 1u);
        const unsigned gen = old / nloc;
        if (old + 1u == (gen + 1u) * nloc) {
            __builtin_amdgcn_fence(__ATOMIC_RELEASE, "agent");
            asm volatile("s_waitcnt vmcnt(0)" ::: "memory");
            const unsigned og = xb_add(&bar[XB_TOP], 1u);
            const unsigned tg = og / nx;
            if (og + 1u == (tg + 1u) * nx) xb_add(&bar[XB_TOPGEN], 1u);
            else XB_SPIN(xb_ld(&bar[XB_TOPGEN]) == tg, bar);
            __builtin_amdgcn_fence(__ATOMIC_ACQUIRE, "agent");
            xb_add(&bar[XB_XGEN(b.x)], 1u);
            asm volatile("s_waitcnt vmcnt(0)" ::: "memory");
        } else {
            XB_SPIN(xb_ld(&bar[XB_XGEN(b.x)]) == gen, bar);
            __builtin_amdgcn_fence(__ATOMIC_ACQUIRE, "agent");
            asm volatile("s_waitcnt vmcnt(0)" ::: "memory");
        }
    }
    __syncthreads();
}

struct Args {
    const float* in[23];
    float* out; unsigned char* ws;
    int ph_lo, ph_hi;
    int use_bar, pad;
};
struct Frame {
    LAS unsigned char* lds;
    int tid, lane, wave, G, bid;
    unsigned char* ws;
    const float* const __attribute__((address_space(4)))* in;
    float* out;
};
enum { I_X = 0, I_C, I_CTX, I_CCTX, I_MODW, I_MODB, I_NORMG, I_MWIN, I_MBGATE, I_MWCONV, I_MGHEAD, I_MWOUT, I_HWIN, I_HBF, I_HLB, I_HGHEAD, I_HWOUT, I_FWGU, I_FWDOWN, I_EWR, I_EBR, I_EWGU, I_EWDOWN };

#ifndef FP8_LAYERS
#define FP8_LAYERS 0xF
#endif
#define FFN_FP8_L(L) (((FP8_LAYERS) >> (L)) & 1)
#ifndef INPROJ_I8
#define INPROJ_I8 1
#endif
#ifndef UP_I8
#define UP_I8 1
#endif
#ifndef UP_I8_MOE
#define UP_I8_MOE 0
#endif
#ifndef FFN_FP8
#define FFN_FP8 1
#endif
constexpr float WSCALE8 = 64.0f;

__device__ __forceinline__ void phase_mods(Frame& F) {
    LAS float* SV = (LAS float*)(F.lds);
    LAS float* RED = (LAS float*)(F.lds + 9 * 1024 * 4);
    const float* cvec = F.in[I_C]; const float* cctx = F.in[I_CCTX];
    for (int i = F.tid; i < 9 * 1024; i += NTHR) { const int b = i >> 10, k = i & 1023; const float v = b < 8 ? cvec[b * 1024 + k] : cctx[k]; SV[i] = siluf_(v); }
    __syncthreads();
    const float* modw = F.in[I_MODW]; const float* modb = F.in[I_MODB]; const float* normg = F.in[I_NORMG];
    float* modv = (float*)(F.ws + WS_MODV);
    for (int item = F.bid; item < 4 * 96; item += F.G) {
        const int L = item / 96, n0 = (item % 96) * 64;
        const float* wp = modw + (size_t)L * 1024 * 6144 + n0 + F.lane;
        float acc[9];
#pragma unroll
        for (int b = 0; b < 9; ++b) acc[b] = 0.f;
        const int k0 = F.wave * 128;
#pragma unroll 4
        for (int k = 0; k < 128; ++k) { const float wv = wp[(size_t)(k0 + k) * 6144];
#pragma unroll
            for (int b = 0; b < 9; ++b) acc[b] += SV[b * 1024 + k0 + k] * wv; }
#pragma unroll
        for (int b = 0; b < 9; ++b) RED[(F.wave * 9 + b) * 64 + F.lane] = acc[b];
        __syncthreads();
        for (int o = F.tid; o < 9 * 64; o += NTHR) { const int b = o >> 6, l = o & 63; float v = 0.f;
#pragma unroll
            for (int w = 0; w < 8; ++w) v += RED[(w * 9 + b) * 64 + l];
            const int n = n0 + l, s = n >> 10, c = n & 1023; v += modb[L * 6144 + n];
            const float* g = normg + (size_t)L * 4 * 1024;
            int slot; float r;
            if (s == 0) { slot = 1; r = v; } else if (s == 1) { slot = 0; r = g[c] * (1.f + v); } else if (s == 2) { slot = 2; r = v * g[1024 + c]; }
            else if (s == 3) { slot = 4; r = v; } else if (s == 4) { slot = 3; r = g[2048 + c] * (1.f + v); } else { slot = 5; r = v * g[3072 + c]; }
            modv[((size_t)(L * 9 + b) * 6 + slot) * 1024 + c] = r; }
        __syncthreads();
    }
}

struct WDesc { const float* src; unsigned char* dst; const unsigned* cmax; float* sw; int N; int Kb; int mode; };
__device__ __forceinline__ int wrow_gu(int n0) { const int half = n0 / FF, nn = n0 - half * FF; return 256 * (nn >> 7) + 128 * half + (nn & 127); }
__device__ __forceinline__ WDesc wdesc(const float* W, int K, int N, unsigned char* WT, int gu_mode, int mode, const unsigned* cmax, float* sw, int r, int lane) {
    const int nkb = K >> 6, nb = r / nkb, kb = r - nb * nkb, k0 = 64 * kb, n0 = 32 * nb;
    const int row0 = gu_mode ? wrow_gu(n0) : n0; const int esz = mode == 0 ? 2 : 1;
    WDesc d; d.N = N; d.Kb = K * esz; d.mode = mode;
    d.src = W + (size_t)(k0 + (lane >> 3)) * N + n0 + 4 * (lane & 7);
    d.dst = WT + (size_t)(row0 + (lane >> 3)) * d.Kb + (size_t)(k0 + 8 * (lane & 7)) * esz;
    d.cmax = cmax + n0; d.sw = (mode == 2 && kb == 0) ? sw + row0 : nullptr;
    return d;
}
#define WT_DECL(T) f32x4 T##0, T##1, T##2, T##3, T##4, T##5, T##6, T##7
#define WT_LOAD(T, p, N) do { const GAS float* _p = (const GAS float*)(p); const size_t _s = (size_t)8 * (N); \
    T##0 = *(const GAS f32x4*)(_p); T##1 = *(const GAS f32x4*)(_p + _s); T##2 = *(const GAS f32x4*)(_p + 2 * _s); T##3 = *(const GAS f32x4*)(_p + 3 * _s); \
    T##4 = *(const GAS f32x4*)(_p + 4 * _s); T##5 = *(const GAS f32x4*)(_p + 5 * _s); T##6 = *(const GAS f32x4*)(_p + 6 * _s); T##7 = *(const GAS f32x4*)(_p + 7 * _s); } while (0)
#define WT_COPY(A, B) do { A##0 = B##0; A##1 = B##1; A##2 = B##2; A##3 = B##3; A##4 = B##4; A##5 = B##5; A##6 = B##6; A##7 = B##7; } while (0)
__device__ __forceinline__ void wt_put(LAS float* w, int i, const f32x4 v) { w[(8 * i) * 33] = v[0]; w[(8 * i) * 33 + 1] = v[1]; w[(8 * i) * 33 + 2] = v[2]; w[(8 * i) * 33 + 3] = v[3]; }
__device__ __forceinline__ void wt_process(const WDesc& d, const f32x4 t0, const f32x4 t1, const f32x4 t2, const f32x4 t3, const f32x4 t4, const f32x4 t5, const f32x4 t6, const f32x4 t7, LAS float* scr, int lane) {
    LAS float* w = scr + (lane >> 3) * 33 + 4 * (lane & 7);
    wt_put(w, 0, t0); wt_put(w, 1, t1); wt_put(w, 2, t2); wt_put(w, 3, t3); wt_put(w, 4, t4); wt_put(w, 5, t5); wt_put(w, 6, t6); wt_put(w, 7, t7);
    LDS_WAIT(); CFENCE();
    const int c = lane & 7;
#pragma unroll
    for (int j = 0; j < 4; ++j) { const int n = (lane >> 3) + 8 * j; const LAS float* s = scr + (8 * c) * 33 + n;
        float x[8];
#pragma unroll
        for (int e = 0; e < 8; ++e) x[e] = s[e * 33];
        unsigned char* dp = d.dst + (size_t)(8 * j) * d.Kb;
        if (d.mode == 0) { v4u o; o.x = pk2(x[0], x[1]); o.y = pk2(x[2], x[3]); o.z = pk2(x[4], x[5]); o.w = pk2(x[6], x[7]); *(GAS v4u*)dp = o; }
        else if (d.mode == 1) { v2u o; unsigned q = 0; q = __builtin_amdgcn_cvt_pk_fp8_f32(x[0] * WSCALE8, x[1] * WSCALE8, q, false); q = __builtin_amdgcn_cvt_pk_fp8_f32(x[2] * WSCALE8, x[3] * WSCALE8, q, true); o.x = q;
            q = 0; q = __builtin_amdgcn_cvt_pk_fp8_f32(x[4] * WSCALE8, x[5] * WSCALE8, q, false); q = __builtin_amdgcn_cvt_pk_fp8_f32(x[6] * WSCALE8, x[7] * WSCALE8, q, true); o.y = q; *(GAS v2u*)dp = o; }
        else { const float mx = __uint_as_float(d.cmax[n]); const float iv = mx > 0.f ? 127.0f / mx : 0.f; unsigned q[8];
#pragma unroll
            for (int e = 0; e < 8; ++e) q[e] = (unsigned)(int)__builtin_rintf(x[e] * iv) & 0xffu;
            v2u o; o.x = q[0] | (q[1] << 8) | (q[2] << 16) | (q[3] << 24); o.y = q[4] | (q[5] << 8) | (q[6] << 16) | (q[7] << 24); *(GAS v2u*)dp = o;
            if (d.sw != nullptr && c == 0) d.sw[n] = mx > 0.f ? mx * (1.0f / 127.0f) : 1.0f; }
    }
    LDS_WAIT(); CFENCE();
}
__device__ __forceinline__ WDesc wdesc_layer(Frame& F, int L, int it) {
    const int j = L >> 1; int r = it; const unsigned* cm = (const unsigned*)(F.ws + WS_CTL) + CW_CMAX + L * CM_LSTRIDE;
    if ((L & 1) == 0) {
        unsigned char* wb = F.ws + WS_WE; float* swb = (float*)(F.ws + WS_SMALL + SM_SWE);
        constexpr int I0 = 16 * (NW_M / 32), I1 = 16 * 32, I2 = 16 * (NGU / 32);
        if (r < I0) return wdesc(F.in[I_MWIN] + (size_t)j * D * NW_M, D, NW_M, wb + WE_IN, 0, INPROJ_I8 ? 2 : 0, cm, swb + SWE_IN, r, F.lane); r -= I0;
        if (r < I1) return wdesc(F.in[I_MWOUT] + (size_t)j * D * D, D, D, wb + WE_OUT, 0, 0, cm, nullptr, r, F.lane); r -= I1;
        if (r < I2) return wdesc(F.in[I_FWGU] + (size_t)j * D * NGU, D, NGU, wb + WE_GU, 1, UP_I8 ? 2 : (FFN_FP8_L(L) ? 1 : 0), cm + CM_GU, swb + SWE_GU, r, F.lane); r -= I2;
        return wdesc(F.in[I_FWDOWN] + (size_t)j * FF * D, FF, D, wb + WE_DOWN, 0, FFN_FP8_L(L) ? 1 : 0, cm, nullptr, r, F.lane);
    } else {
        unsigned char* wb = F.ws + WS_WO; float* swb = (float*)(F.ws + WS_SMALL + SM_SWO);
        constexpr int I0 = 16 * (NP_H / 32), I1 = 16 * 32, I2 = 16 * (NGU / 32), I3 = (FF / 64) * 32;
        if (r < I0) return wdesc(F.in[I_HWIN] + (size_t)j * D * NP_H, D, NP_H, wb + WOD_IN, 0, INPROJ_I8 ? 2 : 0, cm, swb + SWO_IN, r, F.lane); r -= I0;
        if (r < I1) return wdesc(F.in[I_HWOUT] + (size_t)j * D * D, D, D, wb + WOD_OUT, 0, 0, cm, nullptr, r, F.lane); r -= I1;
        const int e = r / (I2 + I3); r -= e * (I2 + I3);
        if (r < I2) return wdesc(F.in[I_EWGU] + ((size_t)j * NEXP + e) * D * NGU, D, NGU, wb + WOD_GU + e * EGU_BYTES, 1, UP_I8_MOE ? 2 : (FFN_FP8_L(L) ? 1 : 0), cm + CM_GU_O + e * NGU, swb + SWO_GU + e * NGU, r, F.lane); r -= I2;
        return wdesc(F.in[I_EWDOWN] + ((size_t)j * NEXP + e) * FF * D, FF, D, wb + WOD_DOWN + e * EDOWN_BYTES, 0, FFN_FP8_L(L) ? 1 : 0, cm, nullptr, r, F.lane);
    }
}
__device__ __forceinline__ void phase_wconv(Frame& F, int L) {
    LAS float* scr = (LAS float*)(F.lds + F.wave * 16384);
    const int gw = F.bid * NWAVES + F.wave, NGW = F.G * NWAVES;
    const int total = (L & 1) ? 16 * (NP_H / 32) + 16 * 32 + NEXP * (16 * (NGU / 32) + (FF / 64) * 32) : 16 * (NW_M / 32) + 16 * 32 + 16 * (NGU / 32) + (FF / 64) * 32;
    WT_DECL(c); WT_DECL(n); WDesc dc, dn;
    int it = gw;
    if (it < total) { dc = wdesc_layer(F, L, it); WT_LOAD(c, dc.src, dc.N); }
#pragma unroll 1
    for (; it < total; it += NGW) {
        const bool more = it + NGW < total;
        if (more) { dn = wdesc_layer(F, L, it + NGW); WT_LOAD(n, dn.src, dn.N); }
        wt_process(dc, c0, c1, c2, c3, c4, c5, c6, c7, scr, F.lane);
        if (more) { dc = dn; WT_COPY(c, n); }
    }
    if ((L & 1) == 0) {
        unsigned char* wb = F.ws + WS_WE; float* swb = (float*)(F.ws + WS_SMALL + SM_SWE);
        GAS v4u* z = (GAS v4u*)(wb + WE_IN + (size_t)NW_M * D * (INPROJ_I8 ? 1 : 2)); const int nz = (NIN_M - NW_M) * D * (INPROJ_I8 ? 1 : 2) / 16;
        for (int i = F.bid * NTHR + F.tid; i < nz; i += F.G * NTHR) z[i] = (v4u){0u, 0u, 0u, 0u};
        if (INPROJ_I8 && F.bid == 0 && F.tid < NIN_M - NW_M) swb[SWE_IN + NW_M + F.tid] = 1.0f;
    }
}
__device__ __forceinline__ void phase_colmax(Frame& F) {
    const int gw = F.bid * NWAVES + F.wave, NGW = F.G * NWAVES;
    constexpr int TE_IN = 16 * (NW_M / 32), TE_GU = 16 * (NGU / 32), TO_IN = 16 * (NP_H / 32);
    constexpr int TE = (INPROJ_I8 ? TE_IN : 0) + (UP_I8 ? TE_GU : 0), TO = (INPROJ_I8 ? TO_IN : 0) + (UP_I8_MOE ? NEXP * TE_GU : 0), total = 2 * (TE + TO);
#pragma unroll 1
    for (int it = gw; it < total; it += NGW) {
        int r = it; int L; const float* W; int N, nnb, cbase;
        const int pr = r / (TE + TO); r -= pr * (TE + TO);
        if (r < TE) { L = 2 * pr; if (INPROJ_I8 && r < TE_IN) { W = F.in[I_MWIN] + (size_t)pr * D * NW_M; N = NW_M; nnb = NW_M / 32; cbase = 0; } else { if (INPROJ_I8) r -= TE_IN; W = F.in[I_FWGU] + (size_t)pr * D * NGU; N = NGU; nnb = NGU / 32; cbase = CM_GU; } }
        else { r -= TE; L = 2 * pr + 1;
            if (INPROJ_I8 && r < TO_IN) { W = F.in[I_HWIN] + (size_t)pr * D * NP_H; N = NP_H; nnb = NP_H / 32; cbase = 0; }
            else { if (INPROJ_I8) r -= TO_IN; const int e = r / TE_GU; r -= e * TE_GU; W = F.in[I_EWGU] + ((size_t)pr * NEXP + e) * D * NGU; N = NGU; nnb = NGU / 32; cbase = CM_GU_O + e * NGU; } }
        const int kb = r / nnb, nb = r - kb * nnb;
        const float* p = W + (size_t)(64 * kb + (F.lane >> 3)) * N + 32 * nb + 4 * (F.lane & 7);
        WT_DECL(t); WT_LOAD(t, p, N);
        f32x4 mx;
#pragma unroll
        for (int q = 0; q < 4; ++q) { float a = fmaxf(fmaxf(fabsf(t0[q]), fabsf(t1[q])), fmaxf(fabsf(t2[q]), fabsf(t3[q]))); a = fmaxf(a, fmaxf(fmaxf(fabsf(t4[q]), fabsf(t5[q])), fmaxf(fabsf(t6[q]), fabsf(t7[q]))));
            a = fmaxf(a, __shfl_xor(a, 8)); a = fmaxf(a, __shfl_xor(a, 16)); a = fmaxf(a, __shfl_xor(a, 32)); mx[q] = a; }
        if (F.lane < 8) { unsigned* cm = (unsigned*)(F.ws + WS_CTL) + CW_CMAX + L * CM_LSTRIDE + cbase + 32 * nb + 4 * F.lane;
#pragma unroll
            for (int q = 0; q < 4; ++q) atomicMax(cm + q, __float_as_uint(mx[q])); }
    }
}

struct TokCfg {
    const void* lat_src_l; const void* lat_src_c;
    void* lat_dst_l; void* lat_dst_c;
    int src_f32, dst_f32;
    const bf16* y; int y_perm; int moe_combine;
    const float* vupd;
    const float* vna; const float* vnb;
    bf16* u; int u_perm; int u_fp8;
    float* u_scale;
    int route; int jr;
    int nrows;
};
__device__ __forceinline__ int perm_cm(int t) { return (t & 63) * ROWS_G + (t >> 6); }

struct RowRaw { v4u l0, l1, l2, l3; v2u a0, a1, a2, a3, b0, b1, b2, b3; };
__device__ __forceinline__ RowRaw tok_issue(const TokCfg& T, int row, int p0, int p1, int lane) {
    RowRaw R; const v4u z4 = (v4u){0u, 0u, 0u, 0u}; const v2u z2 = (v2u){0u, 0u};
    R.l0 = z4; R.l1 = z4; R.l2 = z4; R.l3 = z4; R.a0 = z2; R.a1 = z2; R.a2 = z2; R.a3 = z2; R.b0 = z2; R.b1 = z2; R.b2 = z2; R.b3 = z2;
    if (T.src_f32) { const GAS v4u* lp = (const GAS v4u*)(row < M_LAT ? (const float*)T.lat_src_l + (size_t)row * D : (const float*)T.lat_src_c + (size_t)(row - M_LAT) * D) + lane;
        R.l0 = lp[0]; R.l1 = lp[64]; R.l2 = lp[128]; R.l3 = lp[192]; }
    else { const GAS v2u* lp = (const GAS v2u*)(row < M_LAT ? (const bf16*)T.lat_src_l + (size_t)row * D : (const bf16*)T.lat_src_c + (size_t)(row - M_LAT) * D) + lane;
        const v2u a = lp[0], b = lp[64], c = lp[128], d = lp[192]; R.l0.x = a.x; R.l0.y = a.y; R.l1.x = b.x; R.l1.y = b.y; R.l2.x = c.x; R.l2.y = c.y; R.l3.x = d.x; R.l3.y = d.y; }
    if (T.y) {
        if (T.moe_combine) { const GAS v2u* ya = (const GAS v2u*)(T.y + (size_t)p0 * D) + lane; const GAS v2u* yb = (const GAS v2u*)(T.y + (size_t)p1 * D) + lane;
            R.a0 = ya[0]; R.a1 = ya[64]; R.a2 = ya[128]; R.a3 = ya[192]; R.b0 = yb[0]; R.b1 = yb[64]; R.b2 = yb[128]; R.b3 = yb[192]; }
        else { int yr = row; if (T.y_perm && row < M_LAT) yr = (row & ~8191) + perm_cm(row & 8191);
            const GAS v2u* yp = (const GAS v2u*)(T.y + (size_t)yr * D) + lane; R.a0 = yp[0]; R.a1 = yp[64]; R.a2 = yp[128]; R.a3 = yp[192]; }
    }
    return R;
}
__device__ __forceinline__ void phase_tok(Frame& F, const TokCfg& T) {
    const int gw = F.bid * NWAVES + F.wave, NGW = F.G * NWAVES;
    const int R = (T.nrows + NGW - 1) / NGW; const int r0 = gw * R; int r1 = r0 + R; if (r1 > T.nrows) r1 = T.nrows;
    LAS float* WR = (LAS float*)F.lds;
    if (T.route) { const float* wr = F.in[I_EWR] + (size_t)T.jr * 1024 * 8; for (int i = F.tid; i < 8192; i += NTHR) WR[i] = wr[i]; }
    __syncthreads();
    f32x4 VU[4], VA[4], VB[4]; int curb = -1;
    int my_e0 = 0, my_e1 = 0; float my_w = 0.f;
    const int* rrp = (const int*)(F.ws + WS_ROUTE + RT_R); const float* rwp = (const float*)(F.ws + WS_ROUTE + RT_W);
    int p0c = 0, p1c = 0, p0n = 0, p1n = 0; float w0c = 0.f, w0n = 0.f;
    if (T.moe_combine && r0 < r1) { p0c = rrp[2 * r0]; p1c = rrp[2 * r0 + 1]; w0c = rwp[r0]; if (r0 + 1 < r1) { p0n = rrp[2 * r0 + 2]; p1n = rrp[2 * r0 + 3]; w0n = rwp[r0 + 1]; } }
    RowRaw C = tok_issue(T, r0 < r1 ? r0 : 0, p0c, p1c, F.lane);
    for (int row = r0; row < r1; ++row) {
        const bool hn = row + 1 < r1;
        int p0nn = 0, p1nn = 0; float w0nn = 0.f;
        const RowRaw N = tok_issue(T, hn ? row + 1 : row, p0n, p1n, F.lane);
        if (hn) {
            if (T.moe_combine && row + 2 < r1) { p0nn = rrp[2 * row + 4]; p1nn = rrp[2 * row + 5]; w0nn = rwp[row + 2]; } }
        const int b = row < M_LAT ? (row >> 13) : 8;
        if (b != curb) { curb = b;
#pragma unroll
            for (int j = 0; j < 4; ++j) {
                if (T.y) VU[j] = ((const f32x4*)(T.vupd + (size_t)b * 6144))[F.lane + 64 * j];
                if (T.vna) { VA[j] = ((const f32x4*)(T.vna + (size_t)b * 6144))[F.lane + 64 * j]; VB[j] = ((const f32x4*)(T.vnb + (size_t)b * 6144))[F.lane + 64 * j]; } } }
        f32x4 v[4];
        if (T.src_f32) {
            v[0] = __builtin_bit_cast(f32x4, C.l0); v[1] = __builtin_bit_cast(f32x4, C.l1); v[2] = __builtin_bit_cast(f32x4, C.l2); v[3] = __builtin_bit_cast(f32x4, C.l3); }
        else {
            const v4u cl[4] = {C.l0, C.l1, C.l2, C.l3};
#pragma unroll
            for (int j = 0; j < 4; ++j) v[j] = (f32x4){bflo(cl[j].x), bfhi(cl[j].x), bflo(cl[j].y), bfhi(cl[j].y)}; }
        if (T.y) {
            f32x4 yv[4]; const v2u cya[4] = {C.a0, C.a1, C.a2, C.a3}, cyb[4] = {C.b0, C.b1, C.b2, C.b3};
            if (T.moe_combine) { const float w0 = w0c, w1 = 1.f - w0c;
#pragma unroll
                for (int j = 0; j < 4; ++j) { const v2u a = cya[j], c = cyb[j];
                    yv[j] = (f32x4){w0 * bflo(a.x) + w1 * bflo(c.x), w0 * bfhi(a.x) + w1 * bfhi(c.x), w0 * bflo(a.y) + w1 * bflo(c.y), w0 * bfhi(a.y) + w1 * bfhi(c.y)}; }
            } else {
#pragma unroll
                for (int j = 0; j < 4; ++j) { const v2u a = cya[j]; yv[j] = (f32x4){bflo(a.x), bfhi(a.x), bflo(a.y), bfhi(a.y)}; }
            }
            float ss = 0.f;
#pragma unroll
            for (int j = 0; j < 4; ++j) ss += (yv[j].x * yv[j].x + yv[j].y * yv[j].y) + (yv[j].z * yv[j].z + yv[j].w * yv[j].w);
            const float rs = rsqrtf(wave_sum(ss) * (1.f / D) + EPS);
#pragma unroll
            for (int j = 0; j < 4; ++j) v[j] = v[j] + VU[j] * (yv[j] * rs);
        }
        void* dpv = row < M_LAT ? T.lat_dst_l : T.lat_dst_c;
        if (dpv) { const size_t ro = (size_t)(row < M_LAT ? row : row - M_LAT) * D;
            if (T.dst_f32) { float* dp = (float*)dpv + ro;
#pragma unroll
                for (int j = 0; j < 4; ++j) ((GAS f32x4*)dp)[F.lane + 64 * j] = v[j]; }
            else { bf16* dp = (bf16*)dpv + ro;
#pragma unroll
                for (int j = 0; j < 4; ++j) { v2u o; o.x = pk2(v[j].x, v[j].y); o.y = pk2(v[j].z, v[j].w); ((GAS v2u*)dp)[F.lane + 64 * j] = o; } } }
        if (T.vna) {
            float ss = 0.f;
#pragma unroll
            for (int j = 0; j < 4; ++j) ss += (v[j].x * v[j].x + v[j].y * v[j].y) + (v[j].z * v[j].z + v[j].w * v[j].w);
            const float rs = rsqrtf(wave_sum(ss) * (1.f / D) + EPS);
            f32x4 uu[4];
#pragma unroll
            for (int j = 0; j < 4; ++j) uu[j] = (v[j] * rs) * VA[j] + VB[j];
            int ur = row; if (T.u_perm && row < M_LAT) ur = (row & ~8191) + perm_cm(row & 8191);
            if (T.u_fp8 == 2) { GAS unsigned* up8 = (GAS unsigned*)((unsigned char*)T.u + (size_t)ur * D);
                float mx = 0.f;
#pragma unroll
                for (int j = 0; j < 4; ++j) mx = fmaxf(fmaxf(mx, fmaxf(fabsf(uu[j].x), fabsf(uu[j].y))), fmaxf(fabsf(uu[j].z), fabsf(uu[j].w)));
                mx = wave_max(mx); const float iv = mx > 0.f ? 127.0f / mx : 0.f;
#pragma unroll
                for (int j = 0; j < 4; ++j) { const unsigned q0 = (unsigned)(int)__builtin_rintf(uu[j].x * iv) & 0xffu, q1 = (unsigned)(int)__builtin_rintf(uu[j].y * iv) & 0xffu, q2 = (unsigned)(int)__builtin_rintf(uu[j].z * iv) & 0xffu, q3 = (unsigned)(int)__builtin_rintf(uu[j].w * iv);
                    up8[F.lane + 64 * j] = q0 | (q1 << 8) | (q2 << 16) | (q3 << 24); }
                if (F.lane == 0) T.u_scale[ur] = mx > 0.f ? mx * (1.0f / 127.0f) : 1.0f; }
            else if (T.u_fp8) { GAS unsigned* up8 = (GAS unsigned*)((unsigned char*)T.u + (size_t)ur * D);
#pragma unroll
                for (int j = 0; j < 4; ++j) { unsigned w = 0; w = __builtin_amdgcn_cvt_pk_fp8_f32(uu[j].x, uu[j].y, w, false); w = __builtin_amdgcn_cvt_pk_fp8_f32(uu[j].z, uu[j].w, w, true); up8[F.lane + 64 * j] = w; } }
            else { GAS v2u* up = (GAS v2u*)(T.u + (size_t)ur * D);
#pragma unroll
                for (int j = 0; j < 4; ++j) { v2u o; o.x = pk2(uu[j].x, uu[j].y); o.y = pk2(uu[j].z, uu[j].w); up[F.lane + 64 * j] = o; } }
            if (T.route) {
                float lg[8];
#pragma unroll
                for (int e = 0; e < 8; ++e) lg[e] = 0.f;
#pragma unroll
                for (int j = 0; j < 4; ++j)
#pragma unroll
                    for (int i = 0; i < 4; ++i) { const int c = 4 * (F.lane + 64 * j) + i; const f32x4 wa = *(const LAS f32x4*)(WR + c * 8), wb = *(const LAS f32x4*)(WR + c * 8 + 4); const float x = uu[j][i];
                        lg[0] += x * wa.x; lg[1] += x * wa.y; lg[2] += x * wa.z; lg[3] += x * wa.w; lg[4] += x * wb.x; lg[5] += x * wb.y; lg[6] += x * wb.z; lg[7] += x * wb.w; }
                const float* br = F.in[I_EBR] + T.jr * 8;
#pragma unroll
                for (int e = 0; e < 8; ++e) lg[e] = wave_sum(lg[e]) + br[e];
                int e0 = 0; float v0 = lg[0];
#pragma unroll
                for (int e = 1; e < 8; ++e) if (lg[e] > v0) { v0 = lg[e]; e0 = e; }
                int e1 = -1; float v1 = -3.0e38f;
#pragma unroll
                for (int e = 0; e < 8; ++e) if (e != e0 && lg[e] > v1) { v1 = lg[e]; e1 = e; }
                const float w0 = 1.f / (1.f + __expf(v1 - v0));
                if (F.lane == row - r0) { my_e0 = e0; my_e1 = e1; my_w = w0; }
            }
        }
        if (hn) { C = N; p0n = p0nn; p1n = p1nn; w0c = w0n; w0n = w0nn; }
    }
    if (T.route) {
        const int n = r1 - r0; const bool act = F.lane < n; const int row = r0 + F.lane;
        unsigned* ecnt = (unsigned*)(F.ws + WS_CTL) + CW_ECNT + T.jr * 8 * 64;
        int rk0 = 0, rk1 = 0;
        const unsigned long long ltmask = (F.lane == 0) ? 0ull : (~0ull >> (64 - F.lane));
#pragma unroll
        for (int e = 0; e < 8; ++e) {
            const unsigned long long m0 = __ballot(act && my_e0 == e), m1 = __ballot(act && my_e1 == e);
            const int c0 = __popcll(m0), c1 = __popcll(m1);
            unsigned base = 0;
            if (c0 + c1 > 0) { if (F.lane == 0) base = __hip_atomic_fetch_add(ecnt + e * 64, (unsigned)(c0 + c1), RLX_AGENT); base = __builtin_amdgcn_readfirstlane(base); }
            if (my_e0 == e) rk0 = (int)base + __popcll(m0 & ltmask);
            if (my_e1 == e) rk1 = (int)base + c0 + __popcll(m1 & ltmask);
        }
        if (act) { ((int*)(F.ws + WS_ROUTE + RT_E))[row] = my_e0 | (my_e1 << 8); ((int*)(F.ws + WS_ROUTE + RT_R))[2 * row] = rk0; ((int*)(F.ws + WS_ROUTE + RT_R))[2 * row + 1] = rk1;
            ((float*)(F.ws + WS_ROUTE + RT_W))[row] = my_w; }
    }
}

__device__ __forceinline__ void phase_moe_scatter(Frame& F, int jr, int nrows, const unsigned char* U, unsigned char* AM, int rowb, const float* sa_src, float* sa_dst) {
    const unsigned* ecnt = (const unsigned*)(F.ws + WS_CTL) + CW_ECNT + jr * 8 * 64;
    int base[8]; int acc = 0;
#pragma unroll
    for (int e = 0; e < 8; ++e) { const int c = (int)__hip_atomic_load(ecnt + e * 64, RLX_AGENT); base[e] = acc; acc += (c + 255) & ~255; }
    int* pexp = (int*)(F.ws + WS_SMALL + SM_PEXP);
    if (F.bid == 0) { const int np = acc >> 8;
        for (int p = F.tid; p < np; p += NTHR) { int e = 0;
#pragma unroll
            for (int q = 1; q < 8; ++q) if (p * 256 >= base[q]) e = q;
            pexp[p] = e; }
        if (F.tid == 0) pexp[MOE_PANELS] = np; }
    const int gw = F.bid * NWAVES + F.wave, NGW = F.G * NWAVES;
    const int R = (nrows + NGW - 1) / NGW; const int r0 = gw * R; int r1 = r0 + R; if (r1 > nrows) r1 = nrows;
    int* rr = (int*)(F.ws + WS_ROUTE + RT_R); const int* re = (const int*)(F.ws + WS_ROUTE + RT_E);
    for (int row = r0; row < r1; ++row) {
        const int ee = re[row], e0 = ee & 255, e1 = ee >> 8; int b0 = 0, b1 = 0;
#pragma unroll
        for (int e = 0; e < 8; ++e) { if (e0 == e) b0 = base[e]; if (e1 == e) b1 = base[e]; }
        const int p0 = b0 + rr[2 * row], p1 = b1 + rr[2 * row + 1];
        const v4u* src = (const v4u*)(U + (size_t)row * rowb); v4u* d0 = (v4u*)(AM + (size_t)p0 * rowb); v4u* d1 = (v4u*)(AM + (size_t)p1 * rowb);
        const v4u a = src[F.lane]; d0[F.lane] = a; d1[F.lane] = a;
        if (rowb > 1024) { const v4u c = src[F.lane + 64]; d0[F.lane + 64] = c; d1[F.lane + 64] = c; }
        CFENCE();
        if (F.lane == 0) { rr[2 * row] = p0; rr[2 * row + 1] = p1; if (sa_src) { const float s = sa_src[row]; sa_dst[p0] = s; sa_dst[p1] = s; } }
    }
}

#define MFMA32(a, b, c) __builtin_amdgcn_mfma_f32_32x32x16_bf16((a), (b), (c), 0, 0, 0)
typedef short v4i16_t __attribute__((ext_vector_type(4)));
typedef LAS unsigned char* ldsp;
__device__ __forceinline__ unsigned cvtpk(float lo, float hi) { f32x2_t v = {lo, hi}; bf16x2_t b = __builtin_convertvector(v, bf16x2_t); return __builtin_bit_cast(unsigned, b); }
__device__ __forceinline__ int crow(int reg, int h) { return (reg & 3) + 8 * (reg >> 2) + 4 * h; }
__device__ __forceinline__ bf16x8 pack8(const f32x16& x, int s) {
    v4u p; p.x = cvtpk(x[8 * s], x[8 * s + 1]); p.y = cvtpk(x[8 * s + 2], x[8 * s + 3]); p.z = cvtpk(x[8 * s + 4], x[8 * s + 5]); p.w = cvtpk(x[8 * s + 6], x[8 * s + 7]);
    return __builtin_bit_cast(bf16x8, p);
}
__device__ __forceinline__ bf16x8 lds16(ldsp p) { return *(const LAS bf16x8*)p; }
__device__ __forceinline__ bf16x8 lds8x2(ldsp p) { const s16x4 lo = *(const LAS s16x4*)p, hi = *(const LAS s16x4*)(p + 16); return __builtin_shufflevector(lo, hi, 0, 1, 2, 3, 4, 5, 6, 7); }
__device__ __forceinline__ s16x4 tr16(ldsp p) { return __builtin_bit_cast(s16x4, __builtin_amdgcn_ds_read_tr16_b64_v4i16((LAS v4i16_t*)p)); }
__device__ __forceinline__ bf16x8 ldstr2(ldsp p, int second) { const s16x4 lo = tr16(p), hi = tr16(p + second); return __builtin_shufflevector(lo, hi, 0, 1, 2, 3, 4, 5, 6, 7); }
__device__ __forceinline__ f32x16 zero16() { f32x16 z;
#pragma unroll
    for (int i = 0; i < 16; ++i) z[i] = 0.f; return z; }
__device__ __forceinline__ void unpack8(const v4u& w, float (&x)[8]) { x[0] = bflo(w.x); x[1] = bfhi(w.x); x[2] = bflo(w.y); x[3] = bfhi(w.y); x[4] = bflo(w.z); x[5] = bfhi(w.z); x[6] = bflo(w.w); x[7] = bfhi(w.w); }
__device__ __forceinline__ int launder_v(int x) { asm volatile("" : "+v"(x)); return x; }
struct FragOff { int o_row, o_perm, o_trn, o_trp; };
__device__ __forceinline__ FragOff frag_off(int lane, int LD) {
    const int r = lane & 31, hh = lane >> 5, i16 = lane & 15, q = i16 >> 2, p = i16 & 3, blk = (lane >> 4) & 1; FragOff f;
    f.o_row = (r * LD + 8 * hh) * 2; f.o_perm = (r * LD + 4 * hh) * 2;
    f.o_trn = ((8 * hh + q) * LD + 16 * blk + 4 * p) * 2; f.o_trp = ((4 * hh + q) * LD + 16 * blk + 4 * p) * 2; return f;
}


template <int CTRL, int RM, int BM> __device__ __forceinline__ float dpp_f(float old, float x) {
    return __builtin_bit_cast(float, __builtin_amdgcn_update_dpp(__builtin_bit_cast(int, old), __builtin_bit_cast(int, x), CTRL, RM, BM, false)); }
__device__ __forceinline__ float wave_scan_add(float x) {
    float r = x;
    r += dpp_f<0x111, 0xf, 0xf>(0.f, x); r += dpp_f<0x112, 0xf, 0xf>(0.f, x); r += dpp_f<0x113, 0xf, 0xf>(0.f, x);
    r += dpp_f<0x114, 0xf, 0xe>(0.f, r); r += dpp_f<0x118, 0xf, 0xc>(0.f, r);
    r += dpp_f<0x142, 0xa, 0xf>(0.f, r); r += dpp_f<0x143, 0xc, 0xf>(0.f, r);
    return r;
}
__device__ __forceinline__ float wave_scan_max(float x) {
    const float NEG = -3.0e38f; float r = x;
    r = fmaxf(r, dpp_f<0x111, 0xf, 0xf>(NEG, x)); r = fmaxf(r, dpp_f<0x112, 0xf, 0xf>(NEG, x)); r = fmaxf(r, dpp_f<0x113, 0xf, 0xf>(NEG, x));
    r = fmaxf(r, dpp_f<0x114, 0xf, 0xe>(NEG, r)); r = fmaxf(r, dpp_f<0x118, 0xf, 0xc>(NEG, r));
    r = fmaxf(r, dpp_f<0x142, 0xa, 0xf>(NEG, r)); r = fmaxf(r, dpp_f<0x143, 0xc, 0xf>(NEG, r));
    return r;
}
__device__ __forceinline__ float lane63(float x) { return __builtin_bit_cast(float, __builtin_amdgcn_readlane(__builtin_bit_cast(int, x), 63)); }
__device__ __forceinline__ float sum_halves(float x) {
    const unsigned u = __builtin_bit_cast(unsigned, x); auto rr = __builtin_amdgcn_permlane32_swap(u, u, false, false);
    return __builtin_bit_cast(float, (unsigned)rr[0]) + __builtin_bit_cast(float, (unsigned)rr[1]); }

__device__ __forceinline__ void item_headnorm(int tid, const bf16* hf, const bf16* hb, const bf16* gate, int gpitch, int gcol, const float* gh_head, bf16* aout, int rowbase, int t0, int ntok, int h) {
    VM_WAIT(); __syncthreads();
    const int sub = tid & 7, rr = tid >> 3;
    float gh[16];
#pragma unroll
    for (int e = 0; e < 16; ++e) gh[e] = gh_head[sub * 16 + e];
#pragma unroll 4
    for (int row = rr; row < ntok; row += 64) {
        const size_t grow = (size_t)(rowbase + t0 + row);
        const size_t o = grow * D + h * 128 + sub * 16;
        const v4u a0 = *(const GAS v4u*)(hf + o), a1 = *(const GAS v4u*)(hf + o + 8), b0 = *(const GAS v4u*)(hb + o), b1 = *(const GAS v4u*)(hb + o + 8);
        const bf16* gp = gate + grow * gpitch + gcol + h * 128 + sub * 16; const v4u g0 = *(const GAS v4u*)gp, g1 = *(const GAS v4u*)(gp + 8);
        float x[16], y[8];
        unpack8(a0, y);
#pragma unroll
        for (int e = 0; e < 8; ++e) x[e] = y[e];
        unpack8(a1, y);
#pragma unroll
        for (int e = 0; e < 8; ++e) x[8 + e] = y[e];
        unpack8(b0, y);
#pragma unroll
        for (int e = 0; e < 8; ++e) x[e] += y[e];
        unpack8(b1, y);
#pragma unroll
        for (int e = 0; e < 8; ++e) x[8 + e] += y[e];
        float ss = 0.f;
#pragma unroll
        for (int e = 0; e < 16; ++e) ss += x[e] * x[e];
        ss += __shfl_xor(ss, 1); ss += __shfl_xor(ss, 2); ss += __shfl_xor(ss, 4);
        const float rs = rsqrtf(ss * (1.f / 128.f) + EPS);
        float o16[16];
        unpack8(g0, y);
#pragma unroll
        for (int e = 0; e < 8; ++e) o16[e] = x[e] * rs * gh[e] * sigmoidf_(y[e]);
        unpack8(g1, y);
#pragma unroll
        for (int e = 0; e < 8; ++e) o16[8 + e] = x[8 + e] * rs * gh[8 + e] * sigmoidf_(y[e]);
        v4u w0, w1; w0.x = pk2(o16[0], o16[1]); w0.y = pk2(o16[2], o16[3]); w0.z = pk2(o16[4], o16[5]); w0.w = pk2(o16[6], o16[7]); w1.x = pk2(o16[8], o16[9]); w1.y = pk2(o16[10], o16[11]); w1.z = pk2(o16[12], o16[13]); w1.w = pk2(o16[14], o16[15]);
        *(GAS v4u*)(aout + o) = w0; *(GAS v4u*)(aout + o + 8) = w1;
    }
}

#ifndef SCAN_PF_OUT
#define SCAN_PF_OUT 1
#endif
constexpr int ML_LDQ = 72, ML_LDV = 136;
constexpr int ML_QC = 0, ML_KC = 9216, ML_KH = 18432, ML_V = 27648, ML_GS = 45056, ML_OB = 50176, ML_NV = 68608, ML_SSQ = 70656, ML_INV = 71680, ML_GROUP = 73728;
static_assert(2 * ML_GROUP <= LDS_MAIN, "mLSTM LDS map");
constexpr int ML_STATE_F = 8448;

struct MlPref { v4u q[2], k[2], v[4]; float gi, gf; };
struct MlSeg { int rowbase; int len; int t0; int nchunk; };

__device__ __forceinline__ void ml_issue(MlPref& P, const bf16* proj, const bf16* qkc, const float* gates, int rowbase, int t0c, int g, int h, int tg, int lane, bool need_q) {
    const int c8q = tg & 7;
#pragma unroll
    for (int i = 0; i < 2; ++i) { const int tau = (tg + 256 * i) >> 3; const int t = t0c + (g ? 63 - tau : tau);
        const bf16* rp = qkc + (size_t)(rowbase + t) * D + h * 64 + c8q * 8;
        P.q[i] = need_q ? *(const GAS v4u*)rp : (v4u){0u, 0u, 0u, 0u}; P.k[i] = *(const GAS v4u*)(rp + 512); }
#pragma unroll
    for (int i = 0; i < 4; ++i) { const int p = tg + 256 * i, tau = p >> 4, c8 = p & 15; const int t = t0c + (g ? 63 - tau : tau);
        P.v[i] = *(const GAS v4u*)(proj + (size_t)(rowbase + t) * NP_M + 1024 + h * 128 + c8 * 8); }
    { const int t = t0c + (g ? 63 - lane : lane); const GAS float* gp = (const GAS float*)(gates + (size_t)(rowbase + t) * 32 + g * 16 + h); P.gi = gp[0]; P.gf = gp[8]; }
}

struct MlFin { v4u pa0, pa1, ga0, ga1; };
__device__ __forceinline__ void ml_issue_fin(MlFin& Fn, const bf16* part, const bf16* proj, int rowbase, int t0c, int tt, int g, int h, int j, int lns) {
    const int tau = 32 * tt + (lns >> 1); const int t = t0c + (g ? 63 - tau : tau); const int col = h * 128 + 32 * j + 16 * (lns & 1);
    const bf16* pp = part + (size_t)(rowbase + t) * D + col; const bf16* gp = proj + (size_t)(rowbase + t) * NP_M + 2048 + col;
    Fn.pa0 = *(const GAS v4u*)pp; Fn.pa1 = *(const GAS v4u*)(pp + 8); Fn.ga0 = *(const GAS v4u*)gp; Fn.ga1 = *(const GAS v4u*)(gp + 8);
}
__device__ __forceinline__ void ml_fin_store(const float (&y)[16], const LAS float* ssq, bf16* op) {
    const f32x4 sq = *(const LAS f32x4*)ssq; const float rs = rsqrtf(((sq[0] + sq[1]) + (sq[2] + sq[3])) * (1.f / 128.f) + EPS);
    v4u w0, w1; w0.x = pk2(y[0] * rs, y[1] * rs); w0.y = pk2(y[2] * rs, y[3] * rs); w0.z = pk2(y[4] * rs, y[5] * rs); w0.w = pk2(y[6] * rs, y[7] * rs);
    w1.x = pk2(y[8] * rs, y[9] * rs); w1.y = pk2(y[10] * rs, y[11] * rs); w1.z = pk2(y[12] * rs, y[13] * rs); w1.w = pk2(y[14] * rs, y[15] * rs);
    *(GAS v4u*)op = w0; *(GAS v4u*)(op + 8) = w1;
}
template <bool OUTPUT>
__device__ __forceinline__ void mlstm_item(Frame& F, const bf16* proj, const bf16* qkc, const float* gates, bf16* hx0, bf16* hx1, bf16* aout, const float* ghead,
                                           int h, MlSeg S0, MlSeg S1, const float* st_in0, const float* st_in1, int npre0, int npre1, float* st_out0, float* st_out1) {
    const int tid_l = launder_v(F.tid); const int wave_l = __builtin_amdgcn_readfirstlane(tid_l >> 6);
    const int g = wave_l >> 2, j = wave_l & 3, tg = tid_l & 255, lane = tid_l & 63, r = lane & 31, hh = lane >> 5;
    const ldsp gb = F.lds + g * ML_GROUP;
    const ldsp GSb = gb + ML_GS + j * 1280;
    LAS float* GS = (LAS float*)GSb;
    const ldsp OBb = gb + ML_OB + j * 4608;
    LAS float* NV = (LAS float*)(gb + ML_NV);
    LAS float* SSQ = (LAS float*)(gb + ML_SSQ);
    const ldsp INVb = gb + ML_INV + j * 256;
    const int rowbase = g ? S1.rowbase : S0.rowbase, seg_t0 = g ? S1.t0 : S0.t0, nch = g ? S1.nchunk : S0.nchunk;
    const int vcol = 64 * j;
    __syncthreads();
    f32x16 C[2]; C[0] = zero16(); C[1] = zero16();
    float m_prev = -1.0e30f, btot = 0.f;
    float nreg = 0.f;
    if (OUTPUT) {
        const float* sp = g ? st_in1 : st_in0; const int np = g ? npre1 : npre0;
#pragma unroll 1
        for (int k = 0; k < np; ++k) { const float* e = sp + (size_t)k * ML_STATE_F;
            const float mloc = e[8192 + 64], B = e[8192 + 65];
            const float mnew = fmaxf(B + m_prev, mloc), al = __expf(B + m_prev - mnew), be = __expf(mloc - mnew);
            const float* ep = e + (4 * hh) * 128 + 32 * j + r;
#pragma unroll
            for (int dt = 0; dt < 2; ++dt)
#pragma unroll
                for (int i = 0; i < 16; ++i) C[dt][i] = al * C[dt][i] + be * ep[(32 * dt + (i & 3) + 8 * (i >> 2)) * 128];
            nreg = al * nreg + be * e[8192 + 16 * j + (lane & 15)];
            m_prev = mnew; }
    }
    if (lane < 16) NV[16 * j + lane] = nreg;
    LAS float* GH = (LAS float*)(gb + ML_KC);
    if (OUTPUT && tg < 128) GH[tg] = ghead[h * 128 + tg];
    float yv0[16], yv1[16]; bool pend = false; int pend_t = 0; MlFin FN0, FN1; FN0.pa0 = FN0.pa1 = FN0.ga0 = FN0.ga1 = FN1.pa0 = FN1.pa1 = FN1.ga0 = FN1.ga1 = (v4u){0u, 0u, 0u, 0u};
#pragma unroll
    for (int e = 0; e < 16; ++e) { yv0[e] = 0.f; yv1[e] = 0.f; }
    const int hmid = nch >> 1;
    constexpr int NPF = OUTPUT ? SCAN_PF_OUT : 2;
    MlPref PP[NPF]; ml_issue(PP[0], proj, qkc, gates, rowbase, seg_t0 + 64 * (g ? nch - 1 : 0), g, h, tg, lane, OUTPUT);
    if (NPF == 2) ml_issue(PP[NPF - 1], proj, qkc, gates, rowbase, seg_t0 + 64 * (g ? nch - 2 : 1), g, h, tg, lane, OUTPUT);
    __syncthreads();
#pragma unroll 1
    for (int step2 = 0; step2 < nch; step2 += NPF) {
#pragma unroll
    for (int hf = 0; hf < NPF; ++hf) { const int step = step2 + hf; MlPref& P = PP[hf];
        const int tgs = launder_v(tg), lns = launder_v(lane);
        const int r = lns & 31, hh = lns >> 5;
        const FragOff fq = frag_off(lns, ML_LDQ), fv = frag_off(lns, ML_LDV);
        const int o_h4 = 16 * hh;
        const int o_obw = (4 * hh * 36 + r) * 4, o_obr = ((lns >> 1) * 36 + 16 * (lns & 1)) * 4;
        const int ci = g ? nch - 1 - step : step;
        const int par = step & 1;
        if (OUTPUT && pend) {
            const int tl = lns >> 1; bf16* ob = aout + (size_t)rowbase * D + h * 128 + 32 * j + 16 * (lns & 1);
            ml_fin_store(yv0, SSQ + 4 * tl, ob + (size_t)(pend_t + (g ? 63 - tl : tl)) * D);
            ml_fin_store(yv1, SSQ + 128 + 4 * tl, ob + (size_t)(pend_t + (g ? 31 - tl : 32 + tl)) * D); pend = false; }
        float decay;
        {
            const float xi = P.gi, lf = P.gf;
            const float bc = wave_scan_add(lf);
            const float a = xi - bc; const float pm = wave_scan_max(a);
            const float Mt = fmaxf(m_prev, pm);
            const float Ml = lane63(Mt), bl = lane63(bc);
            GS[lns] = __expf(fminf(Ml - Mt, 80.f)); GS[192 + lns] = __expf(-(bc + Mt)); GS[256 + lns] = __expf(a - Ml);
            decay = __expf(m_prev - Ml); m_prev = bl + Ml; btot += bl;
        }
        LDS_WAIT(); CFENCE();
        {
            const int c8 = tgs & 7;
#pragma unroll
            for (int i = 0; i < 2; ++i) { const int tau = (tgs + 256 * i) >> 3; const ldsp tp = gb + (tau * ML_LDQ + c8 * 8) * 2; float o[8]; v4u w;
                if (OUTPUT) { unpack8(P.q[i], o); const float qs = GS[tau];
                    w.x = pk2(o[0] * qs, o[1] * qs); w.y = pk2(o[2] * qs, o[3] * qs); w.z = pk2(o[4] * qs, o[5] * qs); w.w = pk2(o[6] * qs, o[7] * qs); *(LAS v4u*)(tp + ML_QC) = w; }
                unpack8(P.k[i], o); const float wkk = GS[256 + tau];
                w.x = pk2(o[0] * wkk, o[1] * wkk); w.y = pk2(o[2] * wkk, o[3] * wkk); w.z = pk2(o[4] * wkk, o[5] * wkk); w.w = pk2(o[6] * wkk, o[7] * wkk);
                *(LAS v4u*)(tp + ML_KH) = w; }
#pragma unroll
            for (int i = 0; i < 4; ++i) { const int p = tgs + 256 * i, tau = p >> 4, cc = p & 15; *(LAS v4u*)(gb + ML_V + (tau * ML_LDV + cc * 8) * 2) = P.v[i]; }
        }
        if (OUTPUT) VM_WAIT();
        __syncthreads();
        if (step + NPF < nch) ml_issue(P, proj, qkc, gates, rowbase, seg_t0 + 64 * (g ? nch - 1 - NPF - step : step + NPF), g, h, tgs, lns, OUTPUT);
        const bool fin = OUTPUT && step > hmid;
#pragma unroll
        for (int dt = 0; dt < 2; ++dt)
#pragma unroll
            for (int i = 0; i < 16; ++i) C[dt][i] *= decay;
        if (OUTPUT) {
            bf16* hx = g ? hx1 : hx0;
#pragma unroll
            for (int tt = 0; tt < 2; ++tt) {
                f32x16 acc = zero16();
#pragma unroll
                for (int dt = 0; dt < 2; ++dt)
#pragma unroll
                    for (int sp = 0; sp < 2; ++sp) acc = MFMA32(lds8x2(gb + ML_QC + fq.o_perm + (32 * tt * ML_LDQ + 32 * dt + 16 * sp) * 2), pack8(C[dt], sp), acc);
                float den = 0.f;
#pragma unroll
                for (int st = 0; st <= tt; ++st) {
                    f32x16 s = zero16();
#pragma unroll
                    for (int ks = 0; ks < 4; ++ks) s = MFMA32(lds16(gb + ML_KH + fq.o_row + (32 * st * ML_LDQ + 16 * ks) * 2), lds16(gb + ML_QC + fq.o_row + (32 * tt * ML_LDQ + 16 * ks) * 2), s);
#pragma unroll
                    for (int i = 0; i < 16; ++i) { const float pv = (st < tt || crow(i, hh) <= r) ? s[i] : 0.f; s[i] = pv; den += pv; }
                    const bf16x8 pa0 = pack8(s, 0), pa1 = pack8(s, 1);
                    acc = MFMA32(pa0, ldstr2(gb + ML_V + fv.o_trp + vcol + ((32 * st) * ML_LDV) * 2, 8 * ML_LDV * 2), acc);
                    acc = MFMA32(pa1, ldstr2(gb + ML_V + fv.o_trp + vcol + ((32 * st + 16) * ML_LDV) * 2, 8 * ML_LDV * 2), acc);
                    }
                float qn;
                { float q0 = 0.f, q1 = 0.f, q2 = 0.f, q3 = 0.f;
#pragma unroll
                for (int c4 = 0; c4 < 4; ++c4) { const v4u qw = *(const LAS v4u*)(gb + ML_QC + (r * ML_LDQ + 32 * hh) * 2 + (32 * tt * ML_LDQ + 8 * c4) * 2); float qx[8]; unpack8(qw, qx);
                    const f32x4 n0 = *(const LAS f32x4*)(gb + ML_NV + 8 * o_h4 + (par * 64 + 8 * c4) * 4), n1 = *(const LAS f32x4*)(gb + ML_NV + 8 * o_h4 + (par * 64 + 8 * c4 + 4) * 4);
                    q0 += qx[0] * n0[0] + qx[4] * n1[0]; q1 += qx[1] * n0[1] + qx[5] * n1[1]; q2 += qx[2] * n0[2] + qx[6] * n1[2]; q3 += qx[3] * n0[3] + qx[7] * n1[3]; }
                qn = (q0 + q1) + (q2 + q3); }
                den = sum_halves(den); qn = sum_halves(qn);
                const float dtot = den + decay * qn;
                const float inv = __builtin_amdgcn_rcpf(fmaxf(fabsf(dtot), GS[192 + 32 * tt + r]));
                if (hh == 0) *(LAS float*)(INVb + (32 * tt + r) * 4) = inv;
                LDS_WAIT(); CFENCE();
                f32x16 hv;
#pragma unroll
                for (int q4 = 0; q4 < 4; ++q4) { const f32x4 iv = *(const LAS f32x4*)(INVb + o_h4 + (32 * tt + 8 * q4) * 4);
#pragma unroll
                    for (int e = 0; e < 4; ++e) { const int i = 4 * q4 + e; hv[i] = acc[i] * iv[e]; } }
#pragma unroll
                for (int i = 0; i < 16; ++i) *(LAS float*)(OBb + o_obw + ((i & 3) + 8 * (i >> 2)) * 144) = hv[i];
                LDS_WAIT(); CFENCE();
                { const f32x4 x0 = *(const LAS f32x4*)(OBb + o_obr), x1 = *(const LAS f32x4*)(OBb + o_obr + 16), x2 = *(const LAS f32x4*)(OBb + o_obr + 32), x3 = *(const LAS f32x4*)(OBb + o_obr + 48);
                    const int tau = 32 * tt + (lns >> 1); const int t = seg_t0 + 64 * ci + (g ? 63 - tau : tau);
                    bf16* op = hx + (size_t)(rowbase + t) * D + h * 128 + 32 * j + 16 * (lns & 1);
                    if (!fin) { v4u w0, w1; w0.x = pk2(x0[0], x0[1]); w0.y = pk2(x0[2], x0[3]); w0.z = pk2(x1[0], x1[1]); w0.w = pk2(x1[2], x1[3]); w1.x = pk2(x2[0], x2[1]); w1.y = pk2(x2[2], x2[3]); w1.z = pk2(x3[0], x3[1]); w1.w = pk2(x3[2], x3[3]);
                        *(GAS v4u*)op = w0; *(GAS v4u*)(op + 8) = w1; }
                    else { float pp[8], gg[8], xs[16]; const MlFin& FC = tt ? FN1 : FN0; float (&yv)[16] = tt ? yv1 : yv0;
                        unpack8(FC.pa0, pp);
#pragma unroll
                        for (int e = 0; e < 4; ++e) { xs[e] = x0[e] + pp[e]; xs[4 + e] = x1[e] + pp[4 + e]; }
                        unpack8(FC.pa1, pp);
#pragma unroll
                        for (int e = 0; e < 4; ++e) { xs[8 + e] = x2[e] + pp[e]; xs[12 + e] = x3[e] + pp[4 + e]; }
                        float ss = 0.f;
#pragma unroll
                        for (int e = 0; e < 16; ++e) ss += xs[e] * xs[e];
                        ss += __shfl_xor(ss, 1);
                        if ((lns & 1) == 0) SSQ[128 * tt + 4 * (lns >> 1) + j] = ss;
                        const LAS float* ghp = GH + 32 * j + 16 * (lns & 1);
                        unpack8(FC.ga0, gg);
#pragma unroll
                        for (int e = 0; e < 8; ++e) yv[e] = xs[e] * ghp[e] * sigmoidf_(gg[e]);
                        unpack8(FC.ga1, gg);
#pragma unroll
                        for (int e = 0; e < 8; ++e) yv[8 + e] = xs[8 + e] * ghp[8 + e] * sigmoidf_(gg[e]); } }
                LDS_WAIT(); CFENCE();
            }
            if (fin) { pend = true; pend_t = seg_t0 + 64 * ci; }
            if (step + 1 > hmid && step + 1 < nch) { const int t0n = seg_t0 + 64 * (g ? nch - 2 - step : step + 1);
                ml_issue_fin(FN0, g ? hx0 : hx1, proj, rowbase, t0n, 0, g, h, j, lns); ml_issue_fin(FN1, g ? hx0 : hx1, proj, rowbase, t0n, 1, g, h, j, lns); }
        }
        __builtin_amdgcn_sched_barrier(0);
#pragma unroll
        for (int dt = 0; dt < 2; ++dt)
#pragma unroll
            for (int ks = 0; ks < 4; ++ks) C[dt] = MFMA32(ldstr2(gb + ML_KH + fq.o_trn + (16 * ks * ML_LDQ + 32 * dt) * 2, 4 * ML_LDQ * 2), ldstr2(gb + ML_V + fv.o_trn + vcol + (16 * ks * ML_LDV) * 2, 4 * ML_LDV * 2), C[dt]);
        {   const int dkl = 16 * j + (lns & 15), tq = lns >> 4; float s0 = 0.f, s1 = 0.f;
#pragma unroll
            for (int i = 0; i < 16; i += 2) { s0 += bf2f(*(const LAS bf16*)(gb + ML_KH + ((16 * tq + i) * ML_LDQ + dkl) * 2)); s1 += bf2f(*(const LAS bf16*)(gb + ML_KH + ((16 * tq + i + 1) * ML_LDQ + dkl) * 2)); }
            float sacc = s0 + s1; sacc += __shfl_xor(sacc, 16); sacc = sum_halves(sacc);
            nreg = decay * nreg + sacc; if (lns < 16) NV[(par ^ 1) * 64 + dkl] = nreg; }
        __syncthreads();
    } }
    if (OUTPUT) {
        if (pend) { const int lns = launder_v(lane); const int tl = lns >> 1; bf16* ob = aout + (size_t)rowbase * D + h * 128 + 32 * j + 16 * (lns & 1);
            ml_fin_store(yv0, SSQ + 4 * tl, ob + (size_t)(pend_t + (g ? 63 - tl : tl)) * D);
            ml_fin_store(yv1, SSQ + 128 + 4 * tl, ob + (size_t)(pend_t + (g ? 31 - tl : 32 + tl)) * D); }
        item_headnorm(launder_v(tid_l), hx0, hx1, proj, NP_M, 2048, ghead + h * 128, aout, S0.rowbase, S0.t0 + 64 * ((S0.nchunk >> 1) - 1), 128, h); }
    if (!OUTPUT) {
        float* e = g ? st_out1 : st_out0; float* ep = e + (4 * hh) * 128 + 32 * j + r;
#pragma unroll
        for (int dt = 0; dt < 2; ++dt)
#pragma unroll
            for (int i = 0; i < 16; ++i) ep[(32 * dt + (i & 3) + 8 * (i >> 2)) * 128] = C[dt][i];
        if (lane < 16) e[8192 + 16 * j + lane] = nreg;
        if (j == 0 && lane == 0) { e[8192 + 64] = m_prev; e[8192 + 65] = btot; }
    }
}

constexpr int MS_KH = 0, MS_V = 9216, MS_BUF = 26624, MS_W = 2 * MS_BUF  ;
static_assert(MS_W + 34 * 64 * 4 <= ML_GROUP, "mLSTM S1 LDS map");
struct MsPref { v4u k[2], v[4]; };
__device__ __forceinline__ void ms_issue(MsPref& P, const bf16* proj, const bf16* qkc, int rowbase, int t0c, int g, int h, int tg) {
    const int c8q = tg & 7;
#pragma unroll
    for (int i = 0; i < 2; ++i) { const int tau = (tg + 256 * i) >> 3; const int t = t0c + (g ? 63 - tau : tau);
        P.k[i] = *(const GAS v4u*)(qkc + (size_t)(rowbase + t) * D + 512 + h * 64 + c8q * 8); }
#pragma unroll
    for (int i = 0; i < 4; ++i) { const int p = tg + 256 * i, tau = p >> 4, c8 = p & 15; const int t = t0c + (g ? 63 - tau : tau);
        P.v[i] = *(const GAS v4u*)(proj + (size_t)(rowbase + t) * NP_M + 1024 + h * 128 + c8 * 8); }
}
__device__ __forceinline__ void mlstm_s1_item(Frame& F, const bf16* proj, const bf16* qkc, const float* gates, int h, MlSeg S0, MlSeg S1, float* st_out0, float* st_out1) {
    const int tid_l = launder_v(F.tid); const int wave_l = __builtin_amdgcn_readfirstlane(tid_l >> 6);
    const int g = wave_l >> 2, j = wave_l & 3, tg = tid_l & 255, lane = tid_l & 63, r = lane & 31, hh = lane >> 5;
    const ldsp gb = F.lds + g * ML_GROUP;
    LAS float* W = (LAS float*)(gb + MS_W);
    const int rowbase = g ? S1.rowbase : S0.rowbase, seg_t0 = g ? S1.t0 : S0.t0, nch = g ? S1.nchunk : S0.nchunk;
    __syncthreads();
    MsPref PP[2]; ms_issue(PP[0], proj, qkc, rowbase, seg_t0 + 64 * (g ? nch - 1 : 0), g, h, tg);
    ms_issue(PP[1], proj, qkc, rowbase, seg_t0 + 64 * (g ? nch - 2 : 1), g, h, tg);
    float m_loc, btot;
    {
        float carry = 0.f, mx = -3.0e38f;
#pragma unroll 1
        for (int c = 0; c < nch; ++c) { const int ci = g ? nch - 1 - c : c; const int t = seg_t0 + 64 * ci + (g ? 63 - lane : lane);
            const GAS float* gp = (const GAS float*)(gates + (size_t)(rowbase + t) * 32 + g * 16 + h); const float xi = gp[0], lf = gp[8];
            const float bc = carry + wave_scan_add(lf); const float a = xi - bc;
            if (j == 0) W[64 * c + lane] = a;
            mx = fmaxf(mx, a); carry = lane63(bc); }
        mx = fmaxf(mx, __shfl_xor(mx, 1)); mx = fmaxf(mx, __shfl_xor(mx, 2)); mx = fmaxf(mx, __shfl_xor(mx, 4)); mx = fmaxf(mx, __shfl_xor(mx, 8)); mx = fmaxf(mx, __shfl_xor(mx, 16)); mx = fmaxf(mx, __shfl_xor(mx, 32));
        btot = carry; m_loc = btot + mx;
        __syncthreads();
        for (int s = tg; s < 64 * nch; s += 256) W[s] = __expf(W[s] - mx);
    }
    f32x16 C[2]; C[0] = zero16(); C[1] = zero16(); float nreg = 0.f;
    __syncthreads();
#pragma unroll 1
    for (int step2 = 0; step2 < nch; step2 += 2) {
#pragma unroll
    for (int hf = 0; hf < 2; ++hf) { const int step = step2 + hf; MsPref& P = PP[hf];
        const int tgs = launder_v(tg), lns = launder_v(lane);
        const FragOff fq = frag_off(lns, ML_LDQ), fv = frag_off(lns, ML_LDV);
        const ldsp bb = gb + hf * MS_BUF;
        {   const int c8 = tgs & 7;
#pragma unroll
            for (int i = 0; i < 2; ++i) { const int tau = (tgs + 256 * i) >> 3; float o[8]; unpack8(P.k[i], o); const float wkk = W[64 * step + tau]; v4u w;
                w.x = pk2(o[0] * wkk, o[1] * wkk); w.y = pk2(o[2] * wkk, o[3] * wkk); w.z = pk2(o[4] * wkk, o[5] * wkk); w.w = pk2(o[6] * wkk, o[7] * wkk);
                *(LAS v4u*)(bb + MS_KH + (tau * ML_LDQ + c8 * 8) * 2) = w; }
#pragma unroll
            for (int i = 0; i < 4; ++i) { const int p = tgs + 256 * i, tau = p >> 4, cc = p & 15; *(LAS v4u*)(bb + MS_V + (tau * ML_LDV + cc * 8) * 2) = P.v[i]; }
        }
        if (step + 2 < nch) ms_issue(P, proj, qkc, rowbase, seg_t0 + 64 * (g ? nch - 3 - step : step + 2), g, h, tgs);
        __syncthreads();
#pragma unroll
        for (int dt = 0; dt < 2; ++dt)
#pragma unroll
            for (int ks = 0; ks < 4; ++ks) C[dt] = MFMA32(ldstr2(bb + MS_KH + fq.o_trn + (16 * ks * ML_LDQ + 32 * dt) * 2, 4 * ML_LDQ * 2), ldstr2(bb + MS_V + fv.o_trn + 64 * j + (16 * ks * ML_LDV) * 2, 4 * ML_LDV * 2), C[dt]);
        {   const int dkl = 16 * j + (lns & 15), tq = lns >> 4; float s0 = 0.f, s1 = 0.f;
#pragma unroll
            for (int i = 0; i < 16; i += 2) { s0 += bf2f(*(const LAS bf16*)(bb + MS_KH + ((16 * tq + i) * ML_LDQ + dkl) * 2)); s1 += bf2f(*(const LAS bf16*)(bb + MS_KH + ((16 * tq + i + 1) * ML_LDQ + dkl) * 2)); }
            float sacc = s0 + s1; sacc += __shfl_xor(sacc, 16); sacc = sum_halves(sacc); nreg += sacc; }
    } }
    float* e = g ? st_out1 : st_out0; float* ep = e + (4 * hh) * 128 + 32 * j + r;
#pragma unroll
    for (int dt = 0; dt < 2; ++dt)
#pragma unroll
        for (int i = 0; i < 16; ++i) ep[(32 * dt + (i & 3) + 8 * (i >> 2)) * 128] = C[dt][i];
    if (lane < 16) e[8192 + 16 * j + lane] = nreg;
    if (j == 0 && lane == 0) { e[8192 + 64] = m_loc; e[8192 + 65] = btot; }
}

constexpr int HG_LD = 136;
constexpr int HG_LF = 0, HG_QT = 16384, HG_KT = 25088, HG_KH = 33792, HG_V = 42496, HG_OB = 51200, HG_AUX = 69632, HG_SSQ = 71168, HG_EAM = 71680, HG_BIAS = 72192, HG_LBV = 72704, HG_GROUP = 73728;
static_assert(2 * HG_GROUP <= LDS_MAIN, "HGRN2 LDS map");
constexpr int HG_STATE_F = 16512;

struct HgPref { unsigned q[8], f[8]; v4u v[2]; };
__device__ __forceinline__ void hg_issue(HgPref& P, const bf16* proj, int rowbase, int t0c, int g, int h, int tg, bool need_q) {
    const int lane = tg & 63, j = tg >> 6, cp = lane & 15, tq = lane >> 4, c0 = 32 * j + 2 * cp;
#pragma unroll
    for (int i = 0; i < 8; ++i) { const int tau = 8 * tq + i; const int t = t0c + (g ? 31 - tau : tau);
        const bf16* rp = proj + (size_t)(rowbase + t) * NP_H + h * 128 + c0;
        P.q[i] = need_q ? *(const GAS unsigned*)rp : 0u; P.f[i] = *(const GAS unsigned*)(rp + 2048 + 1024 * g); }
#pragma unroll
    for (int i = 0; i < 2; ++i) { const int p = tg + 256 * i, tau = p >> 4, c8 = p & 15; const int t = t0c + (g ? 31 - tau : tau);
        P.v[i] = *(const GAS v4u*)(proj + (size_t)(rowbase + t) * NP_H + 1024 + h * 128 + c8 * 8); }
}
struct HgFin { v4u pa0, pa1, ga0, ga1; };
__device__ __forceinline__ void hg_issue_fin(HgFin& Fn, const bf16* part, const bf16* proj, int rowbase, int t0c, int g, int h, int j, int lns) {
    const int tau = lns >> 1; const int t = t0c + (g ? 31 - tau : tau); const int col = h * 128 + 32 * j + 16 * (lns & 1);
    const bf16* pp = part + (size_t)(rowbase + t) * D + col; const bf16* gp = proj + (size_t)(rowbase + t) * NP_H + 4096 + col;
    Fn.pa0 = *(const GAS v4u*)pp; Fn.pa1 = *(const GAS v4u*)(pp + 8); Fn.ga0 = *(const GAS v4u*)gp; Fn.ga1 = *(const GAS v4u*)(gp + 8);
}
__device__ __forceinline__ float clamp80(float x) { return fminf(fmaxf(x, -80.f), 80.f); }

template <bool OUTPUT>
__device__ __forceinline__ void hgrn_item(Frame& F, const bf16* proj, bf16* hx0, bf16* hx1, bf16* aout, const float* ghead, const float* bf_, const float* lbraw, int jl,
                                          int h, MlSeg S0, MlSeg S1, const float* st_in0, const float* st_in1, int npre0, int npre1, float* st_out0, float* st_out1) {
    const int tid_l = launder_v(F.tid); const int wave_l = __builtin_amdgcn_readfirstlane(tid_l >> 6);
    const int g = wave_l >> 2, j = wave_l & 3, tg = tid_l & 255, lane = tid_l & 63, r = lane & 31, hh = lane >> 5;
#ifdef SUBT
    unsigned long long _st = 0;
#define ST_MARK(slot) do { if (OUTPUT && tid_l == SUBT_TID) { const unsigned long long _n = wall_clock64(); volatile LAS unsigned* _w = (volatile LAS unsigned*)(F.lds + LDSCTL_OFF) + 40 + (slot); _w[0] += (unsigned)(_n - _st); _st = _n; } } while (0)
#else
#define ST_MARK(slot) do { } while (0)
#endif
    ST_MARK(7);
    const ldsp gb = F.lds + g * HG_GROUP;
    LAS float* LF = (LAS float*)(gb + HG_LF);
    const ldsp OBb = gb + HG_OB + j * 4608;
    LAS float* AMID = (LAS float*)(gb + HG_AUX); LAS float* ALAST = AMID + 128; LAS float* DEC = AMID + 256;
    LAS float* SSQ = (LAS float*)(gb + HG_SSQ); LAS float* EAM = (LAS float*)(gb + HG_EAM); LAS float* BIASV = (LAS float*)(gb + HG_BIAS); LAS float* LBV = (LAS float*)(gb + HG_LBV);
    const int rowbase = g ? S1.rowbase : S0.rowbase, seg_t0 = g ? S1.t0 : S0.t0, nch = g ? S1.nchunk : S0.nchunk;
    const int vcol = 64 * j;
    __syncthreads();
    if (OUTPUT && tg < 128) EAM[tg] = ghead[h * 128 + tg];
    if (tg < 128) { const int c = h * 128 + tg; BIASV[tg] = -1.44269504f * bf_[g * 1024 + c]; LBV[tg] = jl == 0 ? 0.f : sigmoidf_(lbraw[(1 * 2 + g) * 1024 + c] - lbraw[(0 * 2 + g) * 1024 + c]); }
    f32x16 St[4];
#pragma unroll
    for (int dt = 0; dt < 4; ++dt) St[dt] = zero16();
    float atot0 = 0.f, atot1 = 0.f;
    if (OUTPUT) {   const float* sp = g ? st_in1 : st_in0; const int np = g ? npre1 : npre0;
#pragma unroll 1
        for (int k = 0; k < np; ++k) { const float* e = sp + (size_t)k * HG_STATE_F; const float* ep = e + (4 * hh) * 128 + 32 * j + r; const float* ap = e + 16384 + 4 * hh;
#pragma unroll
            for (int dt = 0; dt < 4; ++dt)
#pragma unroll
                for (int i = 0; i < 16; ++i) { const int dk0 = 32 * dt + (i & 3) + 8 * (i >> 2); St[dt][i] = __builtin_amdgcn_exp2f(ap[dk0]) * St[dt][i] + ep[dk0 * 128]; } }
    }
    constexpr int NPF = OUTPUT ? SCAN_PF_OUT : 2;
    HgPref PP[NPF]; hg_issue(PP[0], proj, rowbase, seg_t0 + 32 * (g ? nch - 1 : 0), g, h, tg, OUTPUT);
    if (NPF == 2) hg_issue(PP[NPF - 1], proj, rowbase, seg_t0 + 32 * (g ? nch - 2 : 1), g, h, tg, OUTPUT);
    __syncthreads();
    ST_MARK(4);
    float yv[16]; bool pend = false; int pend_t = 0; HgFin FN; FN.pa0 = FN.pa1 = FN.ga0 = FN.ga1 = (v4u){0u, 0u, 0u, 0u};
#pragma unroll
    for (int e = 0; e < 16; ++e) yv[e] = 0.f;
    const int hmid = nch >> 1;
#pragma unroll 1
    for (int step2 = 0; step2 < nch; step2 += NPF) {
#pragma unroll
    for (int hf = 0; hf < NPF; ++hf) { const int step = step2 + hf; HgPref& P = PP[hf];
        const int tgs = launder_v(tg), lns = launder_v(lane);
        const int r = lns & 31, hh = lns >> 5;
        const FragOff fo = frag_off(lns, HG_LD);
        const int o_h4 = 16 * hh;
        const int o_obw = (4 * hh * 36 + r) * 4, o_obr = ((lns >> 1) * 36 + 16 * (lns & 1)) * 4;
        const int ci = g ? nch - 1 - step : step;
        ST_MARK(7);
        if (OUTPUT && pend) {
            const f32x4 sq = *(const LAS f32x4*)(SSQ + 4 * (lns >> 1)); const float rs = rsqrtf(((sq[0] + sq[1]) + (sq[2] + sq[3])) * (1.f / 128.f) + EPS);
            bf16* op = aout + (size_t)(rowbase + pend_t + (g ? 31 - (lns >> 1) : (lns >> 1))) * D + h * 128 + 32 * j + 16 * (lns & 1);
            v4u w0, w1; w0.x = pk2(yv[0] * rs, yv[1] * rs); w0.y = pk2(yv[2] * rs, yv[3] * rs); w0.z = pk2(yv[4] * rs, yv[5] * rs); w0.w = pk2(yv[6] * rs, yv[7] * rs);
            w1.x = pk2(yv[8] * rs, yv[9] * rs); w1.y = pk2(yv[10] * rs, yv[11] * rs); w1.z = pk2(yv[12] * rs, yv[13] * rs); w1.w = pk2(yv[14] * rs, yv[15] * rs);
            *(GAS v4u*)op = w0; *(GAS v4u*)(op + 8) = w1; pend = false; }
        {
            const int cp = lns & 15, tq = lns >> 4, c0 = 32 * j + 2 * cp;
            const f32x2_t bb = *(const LAS f32x2_t*)(BIASV + c0), ll = *(const LAS f32x2_t*)(LBV + c0);
            const float ol0 = 1.f - ll.x, ol1 = 1.f - ll.y;
            float F0[8], F1[8], f0v[8], f1v[8]; float p0 = 1.f, p1 = 1.f;
#pragma unroll
            for (int i = 0; i < 8; ++i) { const float s0 = __builtin_amdgcn_rcpf(1.f + __builtin_amdgcn_exp2f(__builtin_fmaf(bflo(P.f[i]), -1.44269504f, bb.x))), s1 = __builtin_amdgcn_rcpf(1.f + __builtin_amdgcn_exp2f(__builtin_fmaf(bfhi(P.f[i]), -1.44269504f, bb.y)));
                const float f0 = fmaxf(__builtin_fmaf(ol0, s0, ll.x), 3.0517578125e-5f), f1 = fmaxf(__builtin_fmaf(ol1, s1, ll.y), 3.0517578125e-5f);
                p0 *= f0; p1 *= f1; F0[i] = p0; F1[i] = p1; f0v[i] = f0; f1v[i] = f1; }
            const float r0 = __builtin_amdgcn_logf(p0), r1 = __builtin_amdgcn_logf(p1);
            LAS f32x2_t* XT = (LAS f32x2_t*)(gb + HG_LF + j * 512);
            XT[tq * 16 + cp] = (f32x2_t){r0, r1};
            LDS_WAIT(); CFENCE();
            const f32x2_t t0 = XT[cp], t1 = XT[16 + cp], t2 = XT[32 + cp], t3 = XT[48 + cp];
            LDS_WAIT(); CFENCE();
            const float al0 = (t0.x + t1.x) + (t2.x + t3.x), al1 = (t0.y + t1.y) + (t2.y + t3.y);
            const float pre0 = (tq > 0 ? t0.x : 0.f) + (tq > 1 ? t1.x : 0.f) + (tq > 2 ? t2.x : 0.f), pre1 = (tq > 0 ? t0.y : 0.f) + (tq > 1 ? t1.y : 0.f) + (tq > 2 ? t2.y : 0.f);
            if (tq == 0) { *(LAS f32x2_t*)(DEC + c0) = (f32x2_t){__builtin_amdgcn_exp2f(al0), __builtin_amdgcn_exp2f(al1)}; atot0 += al0; atot1 += al1; }
            const float G0 = OUTPUT ? __builtin_amdgcn_exp2f(fminf(pre0 - al0, 115.f)) : 0.f, G1 = OUTPUT ? __builtin_amdgcn_exp2f(fminf(pre1 - al1, 115.f)) : 0.f;
            float h0 = __builtin_amdgcn_exp2f(al0 - pre0 - r0), h1 = __builtin_amdgcn_exp2f(al1 - pre1 - r1);
#pragma unroll
            for (int i = 7; i >= 0; --i) { const int tau = 8 * tq + i; const ldsp tp = gb + (tau * HG_LD + c0) * 2;
                if (OUTPUT) *(LAS unsigned*)(tp + HG_QT) = pk2(bflo(P.q[i]) * (F0[i] * G0), bfhi(P.q[i]) * (F1[i] * G1));
                *(LAS unsigned*)(tp + HG_KH) = pk2((1.f - f0v[i]) * h0, (1.f - f1v[i]) * h1);
                h0 *= f0v[i]; h1 *= f1v[i]; }
#pragma unroll
            for (int i = 0; i < 2; ++i) { const int p = tgs + 256 * i; *(LAS v4u*)(gb + HG_V + ((p >> 4) * HG_LD + (p & 15) * 8) * 2) = P.v[i]; }
        }
        ST_MARK(0);
        if (OUTPUT) VM_WAIT();
        __syncthreads();
        ST_MARK(1);
        if (step + NPF < nch) hg_issue(P, proj, rowbase, seg_t0 + 32 * (g ? nch - 1 - NPF - step : step + NPF), g, h, tgs, OUTPUT);
        const bool fin = OUTPUT && step > hmid;
        {   f32x4 dvv[16];
#pragma unroll
            for (int dt = 0; dt < 4; ++dt)
#pragma unroll
                for (int q4 = 0; q4 < 4; ++q4) dvv[4 * dt + q4] = *(const LAS f32x4*)(gb + HG_AUX + 1024 + o_h4 + (32 * dt + 8 * q4) * 4);
            __builtin_amdgcn_sched_barrier(0);
#pragma unroll
            for (int dt = 0; dt < 4; ++dt)
#pragma unroll
                for (int q4 = 0; q4 < 4; ++q4)
#pragma unroll
                    for (int e = 0; e < 4; ++e) St[dt][4 * q4 + e] *= dvv[4 * dt + q4][e]; }
        if (OUTPUT) {
            bf16* hx = g ? hx1 : hx0;
            f32x16 s = zero16(), o = zero16();
            {   bf16x8 ka[8], qa[8];
#pragma unroll
                for (int ks = 0; ks < 8; ++ks) { ka[ks] = lds16(gb + HG_KH + fo.o_row + 32 * ks); qa[ks] = lds16(gb + HG_QT + fo.o_row + 32 * ks); }
                __builtin_amdgcn_sched_barrier(0);
#pragma unroll
                for (int ks = 0; ks < 8; ++ks) s = MFMA32(ka[ks], qa[ks], s); }
            {   bf16x8 qp[8];
#pragma unroll
                for (int dt = 0; dt < 4; ++dt)
#pragma unroll
                    for (int sp = 0; sp < 2; ++sp) qp[2 * dt + sp] = lds8x2(gb + HG_QT + fo.o_perm + (32 * dt + 16 * sp) * 2);
                const bf16x8 v0 = ldstr2(gb + HG_V + fo.o_trp + vcol, 8 * HG_LD * 2), v1 = ldstr2(gb + HG_V + fo.o_trp + vcol + (16 * HG_LD) * 2, 8 * HG_LD * 2);
                __builtin_amdgcn_sched_barrier(0);
#pragma unroll
                for (int dt = 0; dt < 4; ++dt)
#pragma unroll
                    for (int sp = 0; sp < 2; ++sp) o = MFMA32(qp[2 * dt + sp], pack8(St[dt], sp), o);
#pragma unroll
                for (int i = 0; i < 16; ++i) s[i] = (crow(i, hh) <= r) ? s[i] : 0.f;
                o = MFMA32(pack8(s, 0), v0, o); o = MFMA32(pack8(s, 1), v1, o); }
#pragma unroll
            for (int i = 0; i < 16; ++i) *(LAS float*)(OBb + o_obw + ((i & 3) + 8 * (i >> 2)) * 144) = o[i];
            LDS_WAIT(); CFENCE();
            { const f32x4 x0 = *(const LAS f32x4*)(OBb + o_obr), x1 = *(const LAS f32x4*)(OBb + o_obr + 16), x2 = *(const LAS f32x4*)(OBb + o_obr + 32), x3 = *(const LAS f32x4*)(OBb + o_obr + 48);
                const int tau = lns >> 1; const int t = seg_t0 + 32 * ci + (g ? 31 - tau : tau);
                bf16* op = hx + (size_t)(rowbase + t) * D + h * 128 + 32 * j + 16 * (lns & 1);
                if (!fin) { v4u w0, w1; w0.x = pk2(x0[0], x0[1]); w0.y = pk2(x0[2], x0[3]); w0.z = pk2(x1[0], x1[1]); w0.w = pk2(x1[2], x1[3]); w1.x = pk2(x2[0], x2[1]); w1.y = pk2(x2[2], x2[3]); w1.z = pk2(x3[0], x3[1]); w1.w = pk2(x3[2], x3[3]);
                    *(GAS v4u*)op = w0; *(GAS v4u*)(op + 8) = w1; }
                else { float pp[8], gg[8], xs[16];
                    unpack8(FN.pa0, pp);
#pragma unroll
                    for (int e = 0; e < 4; ++e) { xs[e] = x0[e] + pp[e]; xs[4 + e] = x1[e] + pp[4 + e]; }
                    unpack8(FN.pa1, pp);
#pragma unroll
                    for (int e = 0; e < 4; ++e) { xs[8 + e] = x2[e] + pp[e]; xs[12 + e] = x3[e] + pp[4 + e]; }
                    float ss = 0.f;
#pragma unroll
                    for (int e = 0; e < 16; ++e) ss += xs[e] * xs[e];
                    ss += __shfl_xor(ss, 1);
                    if ((lns & 1) == 0) SSQ[4 * tau + j] = ss;
                    const LAS float* ghp = EAM + 32 * j + 16 * (lns & 1);
                    unpack8(FN.ga0, gg);
#pragma unroll
                    for (int e = 0; e < 8; ++e) yv[e] = xs[e] * ghp[e] * sigmoidf_(gg[e]);
                    unpack8(FN.ga1, gg);
#pragma unroll
                    for (int e = 0; e < 8; ++e) yv[8 + e] = xs[8 + e] * ghp[8 + e] * sigmoidf_(gg[e]);
                    pend = true; pend_t = seg_t0 + 32 * ci; } }
            LDS_WAIT(); CFENCE();
            if (step + 1 > hmid && step + 1 < nch) hg_issue_fin(FN, g ? hx0 : hx1, proj, rowbase, seg_t0 + 32 * (g ? nch - 2 - step : step + 1), g, h, j, lns);
        }
        {   bf16x8 kt[8], vt[2];
#pragma unroll
            for (int sp = 0; sp < 2; ++sp) vt[sp] = ldstr2(gb + HG_V + fo.o_trn + vcol + (16 * sp * HG_LD) * 2, 4 * HG_LD * 2);
#pragma unroll
            for (int dt = 0; dt < 4; ++dt)
#pragma unroll
                for (int sp = 0; sp < 2; ++sp) kt[2 * dt + sp] = ldstr2(gb + HG_KH + fo.o_trn + (16 * sp * HG_LD + 32 * dt) * 2, 4 * HG_LD * 2);
            __builtin_amdgcn_sched_barrier(0);
#pragma unroll
            for (int dt = 0; dt < 4; ++dt)
#pragma unroll
                for (int sp = 0; sp < 2; ++sp) St[dt] = MFMA32(kt[2 * dt + sp], vt[sp], St[dt]); }
        ST_MARK(2);
        __syncthreads();
        ST_MARK(3);
    } }
    if (OUTPUT) {
        if (pend) { const int lns = launder_v(lane);
            const f32x4 sq = *(const LAS f32x4*)(SSQ + 4 * (lns >> 1)); const float rs = rsqrtf(((sq[0] + sq[1]) + (sq[2] + sq[3])) * (1.f / 128.f) + EPS);
            bf16* op = aout + (size_t)(rowbase + pend_t + (g ? 31 - (lns >> 1) : (lns >> 1))) * D + h * 128 + 32 * j + 16 * (lns & 1);
            v4u w0, w1; w0.x = pk2(yv[0] * rs, yv[1] * rs); w0.y = pk2(yv[2] * rs, yv[3] * rs); w0.z = pk2(yv[4] * rs, yv[5] * rs); w0.w = pk2(yv[6] * rs, yv[7] * rs);
            w1.x = pk2(yv[8] * rs, yv[9] * rs); w1.y = pk2(yv[10] * rs, yv[11] * rs); w1.z = pk2(yv[12] * rs, yv[13] * rs); w1.w = pk2(yv[14] * rs, yv[15] * rs);
            *(GAS v4u*)op = w0; *(GAS v4u*)(op + 8) = w1; }
        item_headnorm(launder_v(tid_l), hx0, hx1, proj, NP_H, 4096, ghead + h * 128, aout, S0.rowbase, S0.t0 + 32 * ((S0.nchunk >> 1) - 1), 64, h); }
    ST_MARK(5);
    if (!OUTPUT) {
        float* e = g ? st_out1 : st_out0; float* ep = e + (4 * hh) * 128 + 32 * j + r;
#pragma unroll
        for (int dt = 0; dt < 4; ++dt)
#pragma unroll
            for (int i = 0; i < 16; ++i) ep[(32 * dt + (i & 3) + 8 * (i >> 2)) * 128] = St[dt][i];
        if ((lane >> 4) == 0) { e[16384 + 32 * j + 2 * (lane & 15)] = atot0; e[16384 + 32 * j + 2 * (lane & 15) + 1] = atot1; }
    }
}
#undef ST_MARK

constexpr int PH_PER_LAYER = 11, PH_BASE = 2, N_PHASES = PH_BASE + DEPTH * PH_PER_LAYER;
#ifndef EN_GEMM
#define EN_GEMM 0xff
#endif
#ifndef EN_ML
#define EN_ML 3
#endif
#ifndef EN_HG
#define EN_HG 3
#endif
#ifndef EN_TOK
#define EN_TOK 1
#endif
#ifndef EN_MISC
#define EN_MISC 1
#endif
#ifndef PG_SP2
#define PG_SP2 true
#endif
#ifndef PG_ALIGN
#define PG_ALIGN true
#endif
#ifndef TIMER_MASK
#define TIMER_MASK 0ull
#endif
#ifndef TIMER_DIV
#define TIMER_DIV 20.0f
#endif
#ifndef MK_SPLIT
#define MK_SPLIT 0
#endif


__device__ __forceinline__ void phase_headnorm(Frame& F, const bf16* hf, const bf16* hb, const bf16* gate, int gpitch, int gcol0, const float* ghead, bf16* aout, int nrows) {
    const int tid = launder_v(F.tid); const int lane = tid & 63, wave = __builtin_amdgcn_readfirstlane(tid >> 6);
    const int gw = F.bid * NWAVES + wave, NGW = F.G * NWAVES;
    float gh[16];
#pragma unroll
    for (int e = 0; e < 16; ++e) gh[e] = ghead[lane * 16 + e];
    for (int row = gw; row < nrows; row += NGW) {
        const v4u a0 = *(const v4u*)(hf + (size_t)row * D + lane * 16), a1 = *(const v4u*)(hf + (size_t)row * D + lane * 16 + 8);
        const v4u b0 = *(const v4u*)(hb + (size_t)row * D + lane * 16), b1 = *(const v4u*)(hb + (size_t)row * D + lane * 16 + 8);
        const v4u g0 = *(const v4u*)(gate + (size_t)row * gpitch + gcol0 + lane * 16), g1 = *(const v4u*)(gate + (size_t)row * gpitch + gcol0 + lane * 16 + 8);
        float x[16], y[8], o[16]; unpack8(a0, y);
#pragma unroll
        for (int e = 0; e < 8; ++e) x[e] = y[e];
        unpack8(a1, y);
#pragma unroll
        for (int e = 0; e < 8; ++e) x[8 + e] = y[e];
        unpack8(b0, y);
#pragma unroll
        for (int e = 0; e < 8; ++e) x[e] += y[e];
        unpack8(b1, y);
#pragma unroll
        for (int e = 0; e < 8; ++e) x[8 + e] += y[e];
        float ss = 0.f;
#pragma unroll
        for (int e = 0; e < 16; ++e) ss += x[e] * x[e];
        ss += __shfl_xor(ss, 1); ss += __shfl_xor(ss, 2); ss += __shfl_xor(ss, 4);
        const float rs = rsqrtf(ss * (1.f / 128.f) + EPS);
        unpack8(g0, y);
#pragma unroll
        for (int e = 0; e < 8; ++e) o[e] = x[e] * rs * gh[e] * sigmoidf_(y[e]);
        unpack8(g1, y);
#pragma unroll
        for (int e = 0; e < 8; ++e) o[8 + e] = x[8 + e] * rs * gh[8 + e] * sigmoidf_(y[e]);
        v4u w0, w1; w0.x = pk2(o[0], o[1]); w0.y = pk2(o[2], o[3]); w0.z = pk2(o[4], o[5]); w0.w = pk2(o[6], o[7]); w1.x = pk2(o[8], o[9]); w1.y = pk2(o[10], o[11]); w1.z = pk2(o[12], o[13]); w1.w = pk2(o[14], o[15]);
        *(v4u*)(aout + (size_t)row * D + lane * 16) = w0; *(v4u*)(aout + (size_t)row * D + lane * 16 + 8) = w1;
    }
}

__device__ __forceinline__ void phase_conv(Frame& F, const bf16* proj, bf16* qkc, float* gates, const float* wconv, const float* bgate) {
    const int gt = F.bid * NTHR + F.tid, cp = gt & 127;
    const int rpb = (M_ALL + F.G - 1) / F.G, rlo = F.bid * rpb, rhi = min(M_ALL, rlo + rpb);
    float w[3][8];
#pragma unroll
    for (int d = 0; d < 3; ++d)
#pragma unroll
        for (int e = 0; e < 8; ++e) w[d][e] = wconv[d * 1024 + cp * 8 + e];
    const float sc = cp >= 64 ? 0.125f : 1.0f;
#pragma unroll 3
    for (int row = rlo + (F.tid >> 7); row < rhi; row += NTHR >> 7) {
        int t, len; if (row < M_LAT) { t = row & (SEQ - 1); len = SEQ; } else { t = (row - M_LAT) & (CTXL - 1); len = CTXL; }
        const bf16* rp = proj + (size_t)row * NP_M + cp * 8;
        const v4u z = (v4u){0u, 0u, 0u, 0u};
        const v4u r0 = t > 0 ? *(const v4u*)(rp - NP_M) : z, r1 = *(const v4u*)rp, r2 = t + 1 < len ? *(const v4u*)(rp + NP_M) : z;
        float x0[8], x1[8], x2[8], o[8]; unpack8(r0, x0); unpack8(r1, x1); unpack8(r2, x2);
#pragma unroll
        for (int e = 0; e < 8; ++e) o[e] = sc * siluf_(w[0][e] * x0[e] + w[1][e] * x1[e] + w[2][e] * x2[e]);
        v4u q; q.x = pk2(o[0], o[1]); q.y = pk2(o[2], o[3]); q.z = pk2(o[4], o[5]); q.w = pk2(o[6], o[7]);
        *(v4u*)(qkc + (size_t)row * D + cp * 8) = q;
    }
    {   const int c4 = (gt * 4) & 31; const f32x4 bg = *(const f32x4*)(bgate + c4); const bool lsg = ((c4 >> 3) & 1) != 0;
#pragma unroll 4
        for (int i = gt; i < M_ALL * 8; i += F.G * NTHR) { f32x4 x = *(const GAS f32x4*)(gates + (size_t)i * 4) + bg;
            if (lsg) {
#pragma unroll
                for (int e = 0; e < 4; ++e) x[e] = fminf(x[e], 0.f) - __logf(1.f + __expf(-fabsf(x[e]))); }
            *(GAS f32x4*)(gates + (size_t)i * 4) = x; } }
}

__device__ __forceinline__ void timer_stamp(unsigned char* lds_raw, bool add) {
    if (threadIdx.x == 0) { volatile LAS unsigned* tw = (volatile LAS unsigned*)((LAS unsigned char*)lds_raw + LDSCTL_OFF) + 32;
        const unsigned long long t = wall_clock64(); const unsigned long long last = ((unsigned long long)tw[1] << 32) | tw[0];
        if (add) { unsigned long long acc = ((unsigned long long)tw[3] << 32) | tw[2]; acc += t - last; tw[2] = (unsigned)acc; tw[3] = (unsigned)(acc >> 32); }
        tw[0] = (unsigned)t; tw[1] = (unsigned)(t >> 32); }
}

__device__ __forceinline__ void seg_of(bool odd, bool ctx_out, int q, int& t0, int& len) {
    int a, b; if (!ctx_out) { a = 2048; b = 2048; } else if (!odd) { a = 30 * 64; b = 34 * 64; } else { a = 60 * 32; b = 68 * 32; }
    t0 = (q == 0) ? 0 : (q == 1) ? a : (q == 2) ? a + b : a + 2 * b; len = (q == 0 || q == 3) ? a : b;
}

__device__ __forceinline__ Frame mkframe(const Args& args, unsigned char* lds_raw) {
    Frame F; int t = threadIdx.x; asm volatile("" : "+v"(t));
    F.lds = (LAS unsigned char*)lds_raw; F.tid = t; F.lane = t & 63; F.wave = __builtin_amdgcn_readfirstlane(t >> 6);
    int g = gridDim.x, b = blockIdx.x; asm volatile("" : "+s"(g), "+s"(b)); F.G = g; F.bid = b;
    const __attribute__((address_space(4))) Args* ap = (const __attribute__((address_space(4))) Args*)__builtin_amdgcn_kernarg_segment_ptr(); asm volatile("" : "+s"(ap));
    F.ws = ap->ws; F.in = ap->in; F.out = ap->out;
    return F;
}
#define PHASE_LOCALS \
    Frame F = mkframe(args, lds_raw); unsigned char* ws = F.ws; \
    float* modv = (float*)(ws + WS_MODV); bf16* U = (bf16*)(ws + WS_U); bf16* Y = (bf16*)(ws + WS_Y); bf16* PROJ = (bf16*)(ws + WS_ACT); bf16* HB = (bf16*)(ws + WS_ACT); \
    bf16* AMOE = (bf16*)(ws + WS_ACT); bf16* HMOE = (bf16*)(ws + WS_ACT + (size_t)MOE_ROWS * D * 2); \
    float* GATES = (float*)(ws + WS_GATES); float* LATC = (float*)(ws + WS_LATC); float* STATE = (float*)(ws + WS_STATE); \
    const int* pexp = (const int*)(ws + WS_SMALL + SM_PEXP); float* SA_U = (float*)(ws + WS_SMALL + SM_SAU); float* SA_U2 = (float*)(ws + WS_SMALL + SM_SAU2); float* SA_MOE = (float*)(ws + WS_GATES + GATES_SAMOE); \
    const float* SWL = (const float*)(ws + WS_SMALL + (odd ? SM_SWO : SM_SWE)); (void)SA_U; (void)SA_U2; (void)SA_MOE; (void)SWL; \
    unsigned char* wb = ws + (odd ? WS_WO : WS_WE); const float* mv = modv + (size_t)L * 9 * 6 * 1024; \
    (void)modv; (void)U; (void)Y; (void)PROJ; (void)HB; (void)AMOE; (void)HMOE; (void)GATES; (void)LATC; (void)STATE; (void)pexp; (void)wb; (void)mv;

__global__ void __launch_bounds__(NTHR, 2) fwd(Args args) {
    extern __shared__ __attribute__((aligned(16))) unsigned char lds_raw[];
    Frame F = mkframe(args, lds_raw);
    volatile LAS unsigned* LCTL = (volatile LAS unsigned*)(F.lds + LDSCTL_OFF);
    for (int u = F.tid; u < 128; u += NTHR) LCTL[u] = 0u;
    __syncthreads();
    XcdBarrier bar; bar.bar = (unsigned*)(F.ws + WS_CTL) + CW_BAR; bar.x = 0; bar.st = nullptr;
    if (args.use_bar) bar = xcd_barrier_post((unsigned*)(F.ws + WS_CTL) + CW_BAR, LCTL + 8);
    const int lo = args.ph_lo, hi = args.ph_hi;
#define IN(k) (lo <= (k) && (k) < hi)
#define SEAM(k) do { if ((k) + 1 < hi) xcd_barrier(bar.bar, bar.x, bar.st); if (TIMER_MASK != 0ull) timer_stamp(lds_raw, ((TIMER_MASK >> (k)) & 1ull) != 0ull); } while (0)
#ifdef TIMER_SPAN
    if (threadIdx.x == 0) { unsigned long long* dbg = (unsigned long long*)((unsigned*)(F.ws + WS_CTL) + CW_DBG); atomicMax(dbg, ~wall_clock64()); }
#endif
#ifdef SPIN_START
    { const unsigned long long t0 = wall_clock64(); while (wall_clock64() - t0 < (unsigned long long)(SPIN_START)) __builtin_amdgcn_s_sleep(8); }
#endif
    if (TIMER_MASK != 0ull) timer_stamp(lds_raw, false);
#ifdef EXTRA_BARS
    for (int eb = 0; eb < EXTRA_BARS; ++eb) xcd_barrier(bar.bar, bar.x, bar.st);
#endif
    if (IN(0)) { const int L = 0; const bool odd = false; PHASE_LOCALS if (EN_MISC) phase_mods(F); __syncthreads(); if (EN_MISC) phase_colmax(F); xcd_barrier(bar.bar, bar.x, bar.st); if (EN_MISC) phase_wconv(F, 0); SEAM(0); }
    if (IN(1)) { const int L = 0; const bool odd = false; PHASE_LOCALS
        TokCfg T{}; T.lat_src_l = F.in[I_X]; T.lat_src_c = F.in[I_CTX]; T.src_f32 = 1; T.vna = modv + 0 * 1024; T.vnb = modv + 1 * 1024; T.u = U; T.u_fp8 = INPROJ_I8 ? 2 : 0; T.u_scale = SA_U; T.nrows = M_ALL;
        if (EN_TOK) phase_tok(F, T); __syncthreads(); if (EN_MISC) phase_wconv(F, 1); SEAM(1);
    }
    for (int L = 0; L < DEPTH; ++L) {
        const int pb = PH_BASE + L * PH_PER_LAYER; const bool odd = (L & 1) != 0; const int jl = L >> 1;
        const bool ctx_out = L < DEPTH - 1;
        if (IN(pb + 0)) { PHASE_LOCALS
            pg8::Order S; pg8::Gemm g;
#if INPROJ_I8
            if (!odd) { g = pg8::Gemm{U, (const bf16*)(wb + WE_IN), M_ALL, NIN_M, D}; S.init(M_ALL / 256, NIN_M, F.G, F.bid, nullptr, 0);
                pg8::EpiStoreI8 E{PROJ, NP_M, NP_M / 256, NP_M / 256, GATES, SA_U, SWL + SWE_IN}; if (EN_GEMM & (1 << 0)) pg8::gemm_phase<pg8::EpiStoreI8, pg8::Order, PG_ALIGN, PG_SP2, 2>(F.lds, g, S, E); }
            else { g = pg8::Gemm{U, (const bf16*)(wb + WOD_IN), M_ALL, NP_H, D}; S.init(M_ALL / 256, NP_H, F.G, F.bid, nullptr, 0);
                pg8::EpiStoreI8 E{PROJ, NP_H, NP_H / 256, -1, nullptr, SA_U, SWL + SWO_IN}; if (EN_GEMM & (1 << 1)) pg8::gemm_phase<pg8::EpiStoreI8, pg8::Order, PG_ALIGN, PG_SP2, 2>(F.lds, g, S, E); }
#else
            if (!odd) { g = pg8::Gemm{U, (const bf16*)(wb + WE_IN), M_ALL, NIN_M, D}; S.init(M_ALL / 256, NIN_M, F.G, F.bid, nullptr, 0);
                pg8::EpiStore E{PROJ, NP_M, NP_M / 256, NP_M / 256, GATES, 1.0f}; if (EN_GEMM & (1 << 0)) pg8::gemm_phase<pg8::EpiStore, pg8::Order, PG_ALIGN, PG_SP2>(F.lds, g, S, E); }
            else { g = pg8::Gemm{U, (const bf16*)(wb + WOD_IN), M_ALL, NP_H, D}; S.init(M_ALL / 256, NP_H, F.G, F.bid, nullptr, 0);
                pg8::EpiStore E{PROJ, NP_H, NP_H / 256, -1, nullptr, 1.0f}; if (EN_GEMM & (1 << 1)) pg8::gemm_phase<pg8::EpiStore, pg8::Order, PG_ALIGN, PG_SP2>(F.lds, g, S, E); }
#endif
            SEAM(pb + 0);
        }
        if (IN(pb + 1)) {
            if (!odd) { PHASE_LOCALS
                phase_conv(F, PROJ, (bf16*)(ws + WS_ACT + 400 * MiB), GATES, F.in[I_MWCONV] + (size_t)jl * 3 * 1024, F.in[I_MBGATE] + jl * 32); SEAM(pb + 1); }
        }
        if (IN(pb + 2)) { PHASE_LOCALS
            for (int id = F.bid; id < 256; id += F.G) {
                const int bh = id >> 2, p = id & 3, b = bh >> 3, h = bh & 7;
                MlSeg SG0, SG1;
                const int csz = odd ? 32 : 64;
                if (p == 0) { SG0 = MlSeg{M_LAT + b * CTXL, CTXL, 0, CTXL / csz}; SG1 = SG0; }
                else { int t0a, la, t0b, lb2; seg_of(odd, ctx_out, p - 1, t0a, la); seg_of(odd, ctx_out, 4 - p, t0b, lb2); SG0 = MlSeg{b * SEQ, SEQ, t0a, la / csz}; SG1 = MlSeg{b * SEQ, SEQ, t0b, lb2 / csz}; }
                if (!odd) { float* e0 = STATE + (size_t)((bh * 2 + 0) * 4 + p) * ML_STATE_F; float* e1 = STATE + (size_t)((bh * 2 + 1) * 4 + p) * ML_STATE_F;
                    if (EN_ML & 1) mlstm_s1_item(F, PROJ, (const bf16*)(ws + WS_ACT + 400 * MiB), GATES, h, SG0, SG1, e0, e1); }
                else { float* e0 = STATE + (size_t)((bh * 2 + 0) * 4 + p) * HG_STATE_F; float* e1 = STATE + (size_t)((bh * 2 + 1) * 4 + p) * HG_STATE_F;
                    if (EN_HG & 1) hgrn_item<false>(F, PROJ, U, (bf16*)(ws + WS_Y), U, F.in[I_HGHEAD] + jl * 1024, F.in[I_HBF] + (size_t)jl * 2048, F.in[I_HLB], jl, h, SG0, SG1, nullptr, nullptr, 0, 0, e0, e1); }
            }
            SEAM(pb + 2);
        }
        if (IN(pb + 3)) { PHASE_LOCALS
            const int nitems = ctx_out ? 320 : 256;
            for (int id = F.bid; id < nitems; id += F.G) {
                MlSeg SG0, SG1; int bh, npre0 = 0, npre1 = 0; const int csz = odd ? 32 : 64;
                if (id < 256) { int q; if (id < 128) { bh = id >> 1; q = (id & 1) ? 3 : 0; } else { bh = (id - 128) >> 1; q = 1 + (id & 1); } int t0q, lq; seg_of(odd, ctx_out, q, t0q, lq); SG0 = MlSeg{(bh >> 3) * SEQ, SEQ, t0q, lq / csz}; npre0 = q + 1; npre1 = 4 - q; }
                else { bh = id - 256; SG0 = MlSeg{M_LAT + (bh >> 3) * CTXL, CTXL, 0, CTXL / csz}; }
                SG1 = SG0;
                const int h = bh & 7;
                if (!odd) { const float* s0 = STATE + (size_t)((bh * 2 + 0) * 4) * ML_STATE_F; const float* s1 = STATE + (size_t)((bh * 2 + 1) * 4) * ML_STATE_F;
                    if (EN_ML & 2) mlstm_item<true>(F, PROJ, (const bf16*)(ws + WS_ACT + 400 * MiB), GATES, (bf16*)(ws + WS_ACT + 536 * MiB), (bf16*)(ws + WS_Y), U, F.in[I_MGHEAD] + jl * 1024, h, SG0, SG1, s0, s1, npre0, npre1, nullptr, nullptr); }
                else { const float* s0 = STATE + (size_t)((bh * 2 + 0) * 4) * HG_STATE_F; const float* s1 = STATE + (size_t)((bh * 2 + 1) * 4) * HG_STATE_F;
                    if (EN_HG & 2) hgrn_item<true>(F, PROJ, U, (bf16*)(ws + WS_Y), U, F.in[I_HGHEAD] + jl * 1024, F.in[I_HBF] + (size_t)jl * 2048, F.in[I_HLB], jl, h, SG0, SG1, s0, s1, npre0, npre1, nullptr, nullptr); }
            }
            SEAM(pb + 3);
        }
        if (IN(pb + 5)) { PHASE_LOCALS
            const int nM = (ctx_out ? M_ALL : M_LAT) / 256;
            pg8::Gemm g{U, (const bf16*)(wb + (odd ? WOD_OUT : WE_OUT)), nM * 256, D, D}; pg8::Order S; S.init(nM, D, F.G, F.bid, nullptr, 0);
            pg8::EpiStore E{Y, D, D / 256, -1, nullptr, 1.0f}; if (EN_GEMM & (1 << 2)) pg8::gemm_phase<pg8::EpiStore, pg8::Order, PG_ALIGN, PG_SP2>(F.lds, g, S, E);
            SEAM(pb + 5);
        }
        if (IN(pb + 6)) { PHASE_LOCALS
            TokCfg T{}; bf16* LAT16 = (bf16*)(ws + WS_ACT + 836 * MiB); T.src_f32 = (L == 0) ? 1 : 0; T.lat_src_l = (L == 0) ? (const void*)F.in[I_X] : (const void*)LAT16; T.lat_src_c = (L == 0) ? (const void*)F.in[I_CTX] : (const void*)LATC; T.lat_dst_l = LAT16; T.lat_dst_c = LATC;
            T.y = Y; T.y_perm = odd ? 1 : 0; T.vupd = mv + 2 * 1024; T.vna = mv + 3 * 1024; T.vnb = mv + 4 * 1024; T.u = U; T.u_fp8 = ((UP_I8 && !odd) || (UP_I8_MOE && odd)) ? 2 : FFN_FP8_L(L); T.u_scale = SA_U2; T.route = odd ? 1 : 0; T.jr = jl; T.nrows = ctx_out ? M_ALL : M_LAT;
            if (EN_TOK) phase_tok(F, T);
            if (L >= 1 && L + 1 < DEPTH) { __syncthreads(); if (EN_MISC) phase_wconv(F, L + 1); }
            SEAM(pb + 6);
        }
        if (IN(pb + 7)) { PHASE_LOCALS
            if (odd) { if (EN_MISC) phase_moe_scatter(F, jl, ctx_out ? M_ALL : M_LAT, (const unsigned char*)U, (unsigned char*)AMOE, (UP_I8_MOE || FFN_FP8_L(L)) ? 1024 : 2048, UP_I8_MOE ? SA_U2 : nullptr, SA_MOE); SEAM(pb + 7); }
        }
        if (IN(pb + 8)) { PHASE_LOCALS
            if (!odd) { pg8::Gemm g{U, (const bf16*)(wb + WE_GU), M_ALL, NGU, D}; pg8::Order S; S.init(M_ALL / 256, NGU, F.G, F.bid, nullptr, 0);
#if UP_I8
                pg8::EpiSwiGLU8I E{(unsigned char*)HB, FF, SA_U2, SWL + SWE_GU, nullptr, 0, FFN_FP8_L(L) ? 0 : 1}; if (EN_GEMM & (1 << 3)) pg8::gemm_phase<pg8::EpiSwiGLU8I, pg8::Order, PG_ALIGN, PG_SP2, 2>(F.lds, g, S, E);
#else
                pg8::EpiSwiGLU8 E{(unsigned char*)HB, FF, 1.0f / WSCALE8}; if (EN_GEMM & (1 << 3)) pg8::gemm_phase<pg8::EpiSwiGLU8, pg8::Order, PG_ALIGN, PG_SP2, 1>(F.lds, g, S, E);
#endif
            }
            else { const int np = __builtin_amdgcn_readfirstlane(pexp[MOE_PANELS]);
                pg8::Gemm g{AMOE, (const bf16*)(wb + WOD_GU), np * 256, NGU, D}; pg8::Order S; S.init(np, NGU, F.G, F.bid, pexp, EGU_BYTES);
#if UP_I8_MOE
                pg8::EpiSwiGLU8I E{(unsigned char*)HMOE, FF, SA_MOE, SWL + SWO_GU, pexp, NGU, 0}; if (EN_GEMM & (1 << 4)) pg8::gemm_phase<pg8::EpiSwiGLU8I, pg8::Order, PG_ALIGN, PG_SP2, 2>(F.lds, g, S, E); }
#else
                pg8::EpiSwiGLU8 E{(unsigned char*)HMOE, FF, 1.0f / WSCALE8}; if (EN_GEMM & (1 << 4)) pg8::gemm_phase<pg8::EpiSwiGLU8, pg8::Order, PG_ALIGN, PG_SP2, 1>(F.lds, g, S, E); }
#endif
            SEAM(pb + 8);
        }
        if (IN(pb + 9)) { PHASE_LOCALS
            const bool f8 = FFN_FP8_L(L) != 0;
            if (!odd) { pg8::Gemm g{HB, (const bf16*)(wb + WE_DOWN), M_ALL, D, FF}; pg8::Order S; S.init(M_ALL / 256, D, F.G, F.bid, nullptr, 0);
                if (f8) { if ((FP8_LAYERS) & 0x5) { pg8::EpiStore E{Y, D, D / 256, -1, nullptr, 1.0f / WSCALE8}; if (EN_GEMM & (1 << 5)) pg8::gemm_phase<pg8::EpiStore, pg8::Order, PG_ALIGN, PG_SP2, 1>(F.lds, g, S, E); } }
                else { if ((~(FP8_LAYERS)) & 0x5) { pg8::EpiStore E{Y, D, D / 256, -1, nullptr, 1.0f}; if (EN_GEMM & (1 << 5)) pg8::gemm_phase<pg8::EpiStore, pg8::Order, PG_ALIGN, PG_SP2>(F.lds, g, S, E); } } }
            else { const int np = __builtin_amdgcn_readfirstlane(pexp[MOE_PANELS]);
                pg8::Gemm g{HMOE, (const bf16*)(wb + WOD_DOWN), np * 256, D, FF}; pg8::Order S; S.init(np, D, F.G, F.bid, pexp, EDOWN_BYTES);
                if (f8) { if ((FP8_LAYERS) & 0xA) { pg8::EpiStore E{AMOE, D, D / 256, -1, nullptr, 1.0f / WSCALE8}; if (EN_GEMM & (1 << 6)) pg8::gemm_phase<pg8::EpiStore, pg8::Order, PG_ALIGN, PG_SP2, 1>(F.lds, g, S, E); } }
                else { if ((~(FP8_LAYERS)) & 0xA) { pg8::EpiStore E{AMOE, D, D / 256, -1, nullptr, 1.0f}; if (EN_GEMM & (1 << 6)) pg8::gemm_phase<pg8::EpiStore, pg8::Order, PG_ALIGN, PG_SP2>(F.lds, g, S, E); } } }
            SEAM(pb + 9);
        }
        if (IN(pb + 10)) { PHASE_LOCALS
            TokCfg T{}; bf16* LAT16 = (bf16*)(ws + WS_ACT + 836 * MiB); T.lat_src_l = LAT16; T.lat_src_c = LATC; T.lat_dst_l = (L + 1 < DEPTH) ? (void*)LAT16 : (void*)F.out; T.lat_dst_c = LATC; T.dst_f32 = (L + 1 < DEPTH) ? 0 : 1;
            T.y = odd ? AMOE : Y; T.moe_combine = odd ? 1 : 0; T.vupd = mv + 5 * 1024; T.nrows = ctx_out ? M_ALL : M_LAT;
            if (L + 1 < DEPTH) { const float* mn = modv + (size_t)(L + 1) * 9 * 6 * 1024; T.vna = mn; T.vnb = mn + 1024; T.u = U; T.u_perm = ((L + 1) & 1) ? 1 : 0; T.u_fp8 = INPROJ_I8 ? 2 : 0; T.u_scale = SA_U; }
            if (EN_TOK) phase_tok(F, T);
            SEAM(pb + 10);
        }
    }
    if (TIMER_MASK != 0ull) { timer_stamp(lds_raw, ((TIMER_MASK >> (N_PHASES - 1)) & 1ull) != 0ull);
        if (blockIdx.x == 0 && threadIdx.x == 0) { volatile LAS unsigned* tw = (volatile LAS unsigned*)((LAS unsigned char*)lds_raw + LDSCTL_OFF) + 32; const unsigned long long acc = ((unsigned long long)tw[3] << 32) | tw[2];
            asm volatile("s_waitcnt vmcnt(0)" ::: "memory"); args.out[0] = (float)acc * 0.01f / TIMER_DIV; } }
#ifdef SUBT
    __syncthreads();
    if (blockIdx.x == 0 && threadIdx.x == 0) { volatile LAS unsigned* tw = (volatile LAS unsigned*)((LAS unsigned char*)lds_raw + LDSCTL_OFF) + 40; asm volatile("s_waitcnt vmcnt(0)" ::: "memory"); args.out[0] = (float)tw[SUBT] * 0.01f / SUBT_DIV; }
#endif
#ifdef TIMER_SPAN
    __syncthreads();
    if (threadIdx.x == 0) { unsigned long long* dbg = (unsigned long long*)((unsigned*)(args.ws + WS_CTL) + CW_DBG);
        asm volatile("s_waitcnt vmcnt(0)" ::: "memory"); __threadfence();
        if (blockIdx.x != 0) { atomicMax(dbg + 1, wall_clock64()); __threadfence(); atomicAdd(dbg + 2, 1ull); }
        else { while (atomicAdd(dbg + 2, 0ull) < (unsigned long long)(gridDim.x - 1)) __builtin_amdgcn_s_sleep(4);
            unsigned long long te = atomicMax(dbg + 1, 0ull); const unsigned long long tn = wall_clock64(); if (tn > te) te = tn; const unsigned long long ts = ~atomicMax(dbg, 0ull);
            args.out[0] = (float)(te - ts) * 0.01f / TIMER_SPAN; } }
#endif
#ifdef SPIN_TICKS
    { const unsigned long long t0 = wall_clock64(); while (wall_clock64() - t0 < (unsigned long long)(SPIN_TICKS)) __builtin_amdgcn_s_sleep(8); }
#endif
#undef IN
#undef SEAM
}

extern "C" void kernel_launch(void* const* d_in, const int* in_sizes, int n_in, void* d_out, int out_size, void* d_ws, size_t ws_size, hipStream_t stream) {
    static int grid = 0;
    if (grid == 0) {
        if (n_in != 23 || out_size != M_LAT * D || ws_size < WS_END) { fprintf(stderr, "kernel_launch: unexpected shapes / workspace (n_in %d out %d ws %zu need %zu)\n", n_in, out_size, ws_size, (size_t)WS_END); grid = -1; return; }
        int dev = 0, cus = 0, per_cu = 0;
        if (hipGetDevice(&dev) != hipSuccess || hipDeviceGetAttribute(&cus, hipDeviceAttributeMultiprocessorCount, dev) != hipSuccess) { grid = -1; return; }
        if (hipFuncSetAttribute((const void*)fwd, hipFuncAttributeMaxDynamicSharedMemorySize, LDS_BYTES) != hipSuccess) { fprintf(stderr, "kernel_launch: hipFuncSetAttribute failed\n"); grid = -1; return; }
        if (hipOccupancyMaxActiveBlocksPerMultiprocessor(&per_cu, (const void*)fwd, NTHR, LDS_BYTES) != hipSuccess || per_cu < 1) fprintf(stderr, "kernel_launch: occupancy query reports %d\n", per_cu);
        (void)hipGetLastError();
        grid = cus;
    }
    if (grid < 0) return;
    (void)hipMemsetAsync((char*)d_ws + WS_CTL, 0, CTL_ZERO_BYTES, stream);
    Args a{};
    for (int i = 0; i < 23; ++i) a.in[i] = (const float*)d_in[i];
    a.out = (float*)d_out; a.ws = (unsigned char*)d_ws;
#if MK_SPLIT
    for (int p = 0; p < N_PHASES; ++p) { a.ph_lo = p; a.ph_hi = p + 1; a.use_bar = 0; a.pad = 0; hipLaunchKernelGGL(fwd, dim3(grid), dim3(NTHR), LDS_BYTES, stream, a); }
#else
    a.ph_lo = 0; a.ph_hi = N_PHASES; a.use_bar = 1; a.pad = 0;
    hipLaunchKernelGGL(fwd, dim3(grid), dim3(NTHR), LDS_BYTES, stream, a);
#endif
}
```

```cpp
#include <hip/hip_runtime.h>
#include <cstdio>
#include <cstdint>

namespace pg8 {
#define PG8_LAS __attribute__((address_space(3)))
typedef unsigned short bf16_t;
typedef short bf16x8 __attribute__((ext_vector_type(8)));
typedef float f32x4 __attribute__((ext_vector_type(4)));
typedef unsigned u32x4 __attribute__((ext_vector_type(4)));
typedef unsigned u32x2 __attribute__((ext_vector_type(2)));
typedef int v8i_t __attribute__((ext_vector_type(8)));
typedef int v4i_t __attribute__((ext_vector_type(4)));
constexpr int BM = 256, BK = 64, HALF = 128, HTB = HALF * BK * 2  , STAGE_BYTES = 8 * HTB, NXCD = 8, WGM = 8;

__host__ __device__ __forceinline__ int lds_byte(int r, int c) { const int st = (r >> 4) * 2 + (c >> 5), rr = r & 15, cc = c & 31, ob = rr * 64 + cc * 2; return st * 1024 + (ob ^ (((ob >> 9) & 1) << 5)); }
__host__ __device__ __forceinline__ void stage_rc(int b, int& R, int& C) { const int st = b / 1024, sb = b % 1024, swz = sb ^ (((sb >> 9) & 1) << 5); R = (st >> 1) * 16 + swz / 64; C = (st & 1) * 32 + (swz % 64) / 2; }
__host__ __device__ __forceinline__ int perm32(int rho) { const int n = rho >> 4, i = rho & 15; return 8 * (i >> 2) + 4 * n + (i & 3); }

struct Unit { int pm, pn; };
struct Gemm { const bf16_t* A; const bf16_t* Bt; int M, N, K; };

struct Order {
    int nM, nN, nwg, G, c; const int* pexp; size_t bstride;
    __device__ void init(int nM_, int N, int G_, int c_, const int* pexp_, size_t bstride_) { nM = nM_; nN = N / BM; nwg = nM * nN; G = G_; c = c_; pexp = pexp_; bstride = bstride_; }
    __device__ bool next(int i, Unit& u) const {
        const long L = (long)i * G + c; if (L >= nwg) return false;
        int wgid = (int)L; { const int q = nwg / NXCD, r = nwg % NXCD, xcd = wgid % NXCD, off = wgid / NXCD; wgid = (xcd < r ? xcd * (q + 1) : r * (q + 1) + (xcd - r) * q) + off; }
        const int nig = WGM * nN, gid = wgid / nig, fm = gid * WGM, gsz = (nM - fm) < WGM ? (nM - fm) : WGM;
        u.pm = fm + ((wgid % nig) % gsz); u.pn = (wgid % nig) / gsz; return true;
    }
    __device__ __forceinline__ size_t boff(const Unit& u) const { return pexp ? (size_t)__builtin_amdgcn_readfirstlane(pexp[u.pm]) * bstride : (size_t)0; }
    __device__ __forceinline__ void a_ready(const Unit&) const {}
    __device__ __forceinline__ void done(const Unit&) const {}
};

__device__ __forceinline__ unsigned cvt_pk_bf16(float lo, float hi) { unsigned r; asm volatile("v_cvt_pk_bf16_f32 %0, %1, %2" : "=v"(r) : "v"(lo), "v"(hi)); return r; }

struct EpiStore {
    static constexpr bool PERM = true, AFTER_DRAIN = false;
    bf16_t* O; int ldc; int ncol_tiles; int gate_pn; float* gates; float oscale;
    __device__ __forceinline__ void operator()(const f32x4 (&acc)[2][2][4][2], const Unit& u, int wr, int wc, int fr, int fq) const {
        const int row0 = u.pm * BM + wr * 64 + fr;
        if (u.pn < ncol_tiles) {
            const int col0 = u.pn * BM + wc * 32 + 8 * fq;
#pragma unroll
            for (int ai = 0; ai < 2; ++ai)
#pragma unroll
                for (int m = 0; m < 4; ++m) { bf16_t* rowp = O + (size_t)(row0 + ai * HALF + m * 16) * ldc + col0;
#pragma unroll
                    for (int bj = 0; bj < 2; ++bj) { const f32x4 v0 = acc[ai][bj][m][0] * oscale, v1 = acc[ai][bj][m][1] * oscale;
                        u32x4 w; w.x = cvt_pk_bf16(v0[0], v0[1]); w.y = cvt_pk_bf16(v0[2], v0[3]); w.z = cvt_pk_bf16(v1[0], v1[1]); w.w = cvt_pk_bf16(v1[2], v1[3]);
                        *(u32x4*)(rowp + bj * HALF) = w; } }
        } else if (u.pn == gate_pn && wc == 0) {
#pragma unroll
            for (int ai = 0; ai < 2; ++ai)
#pragma unroll
                for (int m = 0; m < 4; ++m) { float* rowp = gates + (size_t)(row0 + ai * HALF + m * 16) * 32 + 8 * fq;
                    *(f32x4*)(rowp) = acc[ai][0][m][0]; *(f32x4*)(rowp + 4) = acc[ai][0][m][1]; }
        }
    }
};
struct EpiSwiGLU {
    static constexpr bool PERM = true, AFTER_DRAIN = false;
    bf16_t* O; int ldc;
    __device__ __forceinline__ void operator()(const f32x4 (&acc)[2][2][4][2], const Unit& u, int wr, int wc, int fr, int fq) const {
        const int row0 = u.pm * BM + wr * 64 + fr, col0 = u.pn * HALF + wc * 32 + 8 * fq;
#pragma unroll
        for (int ai = 0; ai < 2; ++ai)
#pragma unroll
            for (int m = 0; m < 4; ++m) { bf16_t* rowp = O + (size_t)(row0 + ai * HALF + m * 16) * ldc + col0; float r[8];
#pragma unroll
                for (int n = 0; n < 2; ++n)
#pragma unroll
                    for (int j = 0; j < 4; ++j) { const float g = acc[ai][0][m][n][j], up = acc[ai][1][m][n][j]; r[n * 4 + j] = g * __builtin_amdgcn_rcpf(1.0f + __expf(-g)) * up; }
                u32x4 w; w.x = cvt_pk_bf16(r[0], r[1]); w.y = cvt_pk_bf16(r[2], r[3]); w.z = cvt_pk_bf16(r[4], r[5]); w.w = cvt_pk_bf16(r[6], r[7]);
                *(u32x4*)(rowp) = w; }
    }
};
struct EpiSwiGLU8 {
    static constexpr bool PERM = true, AFTER_DRAIN = false;
    unsigned char* O; int ldc; float ascale;
    __device__ __forceinline__ void operator()(const f32x4 (&acc)[2][2][4][2], const Unit& u, int wr, int wc, int fr, int fq) const {
        typedef float f32x2 __attribute__((ext_vector_type(2)));
        const int row0 = u.pm * BM + wr * 64 + fr, col0 = u.pn * HALF + wc * 32 + 8 * fq;
        const float c1 = -ascale * 1.4426950408889634f, c2 = ascale * ascale;
#pragma unroll
        for (int ai = 0; ai < 2; ++ai)
#pragma unroll
            for (int m = 0; m < 4; ++m) { unsigned char* rowp = O + (size_t)(row0 + ai * HALF + m * 16) * ldc + col0; f32x2 r[4];
#pragma unroll
                for (int n = 0; n < 2; ++n)
#pragma unroll
                    for (int j = 0; j < 2; ++j) { const f32x2 ag = {acc[ai][0][m][n][2 * j], acc[ai][0][m][n][2 * j + 1]}, au = {acc[ai][1][m][n][2 * j], acc[ai][1][m][n][2 * j + 1]};
                        const f32x2 t = ag * c1; f32x2 d = {__builtin_amdgcn_exp2f(t.x), __builtin_amdgcn_exp2f(t.y)}; d = d + 1.0f;
                        const f32x2 q = {__builtin_amdgcn_rcpf(d.x), __builtin_amdgcn_rcpf(d.y)};
                        r[n * 2 + j] = ((ag * au) * q) * c2; }
                u32x2 w; unsigned t = 0; t = __builtin_amdgcn_cvt_pk_fp8_f32(r[0].x, r[0].y, t, false); t = __builtin_amdgcn_cvt_pk_fp8_f32(r[1].x, r[1].y, t, true); w.x = t;
                t = 0; t = __builtin_amdgcn_cvt_pk_fp8_f32(r[2].x, r[2].y, t, false); t = __builtin_amdgcn_cvt_pk_fp8_f32(r[3].x, r[3].y, t, true); w.y = t;
                *(u32x2*)(rowp) = w; }
    }
};
struct EpiStoreI8 {
    static constexpr bool PERM = true, AFTER_DRAIN = false;
    bf16_t* O; int ldc; int ncol_tiles; int gate_pn; float* gates; const float* sa; const float* sw;
    __device__ __forceinline__ void operator()(const f32x4 (&acc)[2][2][4][2], const Unit& u, int wr, int wc, int fr, int fq) const {
        const int row0 = u.pm * BM + wr * 64 + fr;
        if (u.pn < ncol_tiles) {
            const int col0 = u.pn * BM + wc * 32 + 8 * fq;
            f32x4 cs[2][2];
#pragma unroll
            for (int bj = 0; bj < 2; ++bj) { cs[bj][0] = *(const f32x4*)(sw + col0 + bj * HALF); cs[bj][1] = *(const f32x4*)(sw + col0 + bj * HALF + 4); }
#pragma unroll
            for (int ai = 0; ai < 2; ++ai)
#pragma unroll
                for (int m = 0; m < 4; ++m) { const int row = row0 + ai * HALF + m * 16; const float rs = sa[row]; bf16_t* rowp = O + (size_t)row * ldc + col0;
#pragma unroll
                    for (int bj = 0; bj < 2; ++bj) { const v4i_t i0 = __builtin_bit_cast(v4i_t, acc[ai][bj][m][0]), i1 = __builtin_bit_cast(v4i_t, acc[ai][bj][m][1]);
                        f32x4 v0 = __builtin_convertvector(i0, f32x4) * cs[bj][0] * rs, v1 = __builtin_convertvector(i1, f32x4) * cs[bj][1] * rs;
#ifdef EMU_F8_LO
                        if (u.pn >= EMU_F8_LO && u.pn < EMU_F8_HI) {
                            unsigned q0 = 0, q1 = 0; q0 = __builtin_amdgcn_cvt_pk_fp8_f32(v0[0], v0[1], q0, false); q0 = __builtin_amdgcn_cvt_pk_fp8_f32(v0[2], v0[3], q0, true); q1 = __builtin_amdgcn_cvt_pk_fp8_f32(v1[0], v1[1], q1, false); q1 = __builtin_amdgcn_cvt_pk_fp8_f32(v1[2], v1[3], q1, true);
                            const auto a = __builtin_amdgcn_cvt_pk_f32_fp8(q0, false), b = __builtin_amdgcn_cvt_pk_f32_fp8(q0, true), c = __builtin_amdgcn_cvt_pk_f32_fp8(q1, false), d = __builtin_amdgcn_cvt_pk_f32_fp8(q1, true);
                            v0[0] = a[0]; v0[1] = a[1]; v0[2] = b[0]; v0[3] = b[1]; v1[0] = c[0]; v1[1] = c[1]; v1[2] = d[0]; v1[3] = d[1]; }
#endif
                        u32x4 w; w.x = cvt_pk_bf16(v0[0], v0[1]); w.y = cvt_pk_bf16(v0[2], v0[3]); w.z = cvt_pk_bf16(v1[0], v1[1]); w.w = cvt_pk_bf16(v1[2], v1[3]);
                        *(u32x4*)(rowp + bj * HALF) = w; } }
        } else if (u.pn == gate_pn && wc == 0) {
            const int col0 = u.pn * BM + 8 * fq; const f32x4 c0 = *(const f32x4*)(sw + col0), c1 = *(const f32x4*)(sw + col0 + 4);
#pragma unroll
            for (int ai = 0; ai < 2; ++ai)
#pragma unroll
                for (int m = 0; m < 4; ++m) { const int row = row0 + ai * HALF + m * 16; const float rs = sa[row]; float* rowp = gates + (size_t)row * 32 + 8 * fq;
                    *(f32x4*)(rowp) = __builtin_convertvector(__builtin_bit_cast(v4i_t, acc[ai][0][m][0]), f32x4) * c0 * rs; *(f32x4*)(rowp + 4) = __builtin_convertvector(__builtin_bit_cast(v4i_t, acc[ai][0][m][1]), f32x4) * c1 * rs; }
        }
    }
};
struct EpiSwiGLU8I {
    static constexpr bool PERM = true, AFTER_DRAIN = false;
    unsigned char* O; int ldc; const float* sa; const float* sw; const int* pexp; int swstride; int obf16;
    __device__ __forceinline__ void operator()(const f32x4 (&acc)[2][2][4][2], const Unit& u, int wr, int wc, int fr, int fq) const {
        typedef float f32x2 __attribute__((ext_vector_type(2)));
        const int row0 = u.pm * BM + wr * 64 + fr, col0 = u.pn * HALF + wc * 32 + 8 * fq;
        const float* swe = sw + (pexp ? (size_t)__builtin_amdgcn_readfirstlane(pexp[u.pm]) * swstride : (size_t)0) + u.pn * BM + wc * 32 + 8 * fq;
        const f32x4 g0 = *(const f32x4*)(swe), g1 = *(const f32x4*)(swe + 4), u0 = *(const f32x4*)(swe + HALF), u1 = *(const f32x4*)(swe + HALF + 4);
        const float gs[8] = {g0[0], g0[1], g0[2], g0[3], g1[0], g1[1], g1[2], g1[3]}, us[8] = {u0[0], u0[1], u0[2], u0[3], u1[0], u1[1], u1[2], u1[3]};
#pragma unroll
        for (int ai = 0; ai < 2; ++ai)
#pragma unroll
            for (int m = 0; m < 4; ++m) { const int row = row0 + ai * HALF + m * 16; const float rs = sa[row]; unsigned char* rowp = O + (size_t)row * ldc + col0; float r[8];
#pragma unroll
                for (int n = 0; n < 2; ++n) { const v4i_t ig = __builtin_bit_cast(v4i_t, acc[ai][0][m][n]), iu = __builtin_bit_cast(v4i_t, acc[ai][1][m][n]);
#pragma unroll
                    for (int j = 0; j < 4; ++j) { const float g = (float)ig[j] * (gs[4 * n + j] * rs), up = (float)iu[j] * (us[4 * n + j] * rs);
                        r[4 * n + j] = g * __builtin_amdgcn_rcpf(1.0f + __builtin_amdgcn_exp2f(g * -1.4426950408889634f)) * up; } }
                if (obf16) { u32x4 w; w.x = cvt_pk_bf16(r[0], r[1]); w.y = cvt_pk_bf16(r[2], r[3]); w.z = cvt_pk_bf16(r[4], r[5]); w.w = cvt_pk_bf16(r[6], r[7]);
                    *(u32x4*)((bf16_t*)O + (size_t)row * ldc + col0) = w; }
                else { u32x2 w; unsigned t = 0; t = __builtin_amdgcn_cvt_pk_fp8_f32(r[0], r[1], t, false); t = __builtin_amdgcn_cvt_pk_fp8_f32(r[2], r[3], t, true); w.x = t;
                    t = 0; t = __builtin_amdgcn_cvt_pk_fp8_f32(r[4], r[5], t, false); t = __builtin_amdgcn_cvt_pk_fp8_f32(r[6], r[7], t, true); w.y = t;
                    *(u32x2*)(rowp) = w; } }
    }
};

template <bool FP8> struct Frag;
template <> struct Frag<false> { bf16x8 v[2]; };
template <> struct Frag<true> { v8i_t v; };
template <bool FP8> __device__ __forceinline__ void ldfrag(Frag<FP8>& f, const PG8_LAS unsigned char* p) {
    if constexpr (FP8) { const bf16x8 a = *(const PG8_LAS bf16x8*)p, b = *(const PG8_LAS bf16x8*)(p + 1024); f.v = __builtin_bit_cast(v8i_t, __builtin_shufflevector(a, b, 0, 1, 2, 3, 4, 5, 6, 7, 8, 9, 10, 11, 12, 13, 14, 15)); }
    else { f.v[0] = *(const PG8_LAS bf16x8*)p; f.v[1] = *(const PG8_LAS bf16x8*)(p + 1024); }
}
template <class Epi, class Sched, bool ALIGN_EPI = false, bool SP2 = false, int MODE = 0  >
__device__ __forceinline__ void gemm_phase(PG8_LAS unsigned char* lds, const Gemm g, const Sched& S, const Epi& E) {
    int tid = threadIdx.x; asm volatile("" : "+v"(tid)); const int wid = __builtin_amdgcn_readfirstlane(tid >> 6), lane = tid & 63, wr = wid >> 2, wc = wid & 3, fr = lane & 15, fq = lane >> 4;
    constexpr bool FP8 = (MODE == 1);
    const int K = g.K, rowb = (MODE != 0) ? K : 2 * K, nt = rowb / 128;
    unsigned voffA[2], voffB[2];
#pragma unroll
    for (int i = 0; i < 2; ++i) { int R, C; stage_rc(tid * 16 + i * 8192, R, C); const int Rb = Epi::PERM ? ((R & ~31) + perm32(R & 31)) : R;
        voffA[i] = (unsigned)(R * rowb + C * 2); voffB[i] = (unsigned)(Rb * rowb + C * 2); }
    const size_t kstep = (size_t)(BK * 2);
    const size_t hstep = (size_t)HALF * rowb;
    const size_t tstep = 2 * hstep;
    const unsigned ldsw = (unsigned)wid * 1024u;
    const int aoff = lds_byte(wr * 64 + fr, fq * 8), boff = lds_byte(wc * 32 + fr, fq * 8);
#define PG8_SA(b, h) (((b) * 2 + (h)) * HTB)
#define PG8_SB(b, h) ((4 + (b) * 2 + (h)) * HTB)
#define PG8_STAGE(bufoff, gbase, voff) do { _Pragma("unroll") for (int _i = 0; _i < 2; ++_i) \
        __builtin_amdgcn_global_load_lds((const unsigned*)((const char*)(gbase) + (voff)[_i]), (PG8_LAS unsigned*)(lds + (bufoff) + ldsw + _i * 8192), 16, 0, 0); } while (0)
#define PG8_LDA(dst, b, h) do { _Pragma("unroll") for (int m = 0; m < 4; ++m) ldfrag<FP8>(dst[m], lds + PG8_SA(b, h) + aoff + m * 2048); } while (0)
#define PG8_LDB(dst, b, h) do { _Pragma("unroll") for (int n = 0; n < 2; ++n) ldfrag<FP8>(dst[n], lds + PG8_SB(b, h) + boff + n * 2048); } while (0)
#define PG8_MMA(ai, bj, At, Bt) do { __builtin_amdgcn_s_setprio(1); _Pragma("unroll") for (int m = 0; m < 4; ++m) _Pragma("unroll") for (int n = 0; n < 2; ++n) { \
        if constexpr (FP8) { asm volatile("v_mfma_f32_16x16x128_f8f6f4 %0, %1, %2, %0" : "+v"(acc[ai][bj][m][n]) : "v"(Bt[n].v), "v"(At[m].v)); }     \
        else if constexpr (MODE == 2) { _Pragma("unroll") for (int k = 0; k < 2; ++k) acc[ai][bj][m][n] = __builtin_bit_cast(f32x4, __builtin_amdgcn_mfma_i32_16x16x64_i8(__builtin_bit_cast(v4i_t, Bt[n].v[k]), __builtin_bit_cast(v4i_t, At[m].v[k]), __builtin_bit_cast(v4i_t, acc[ai][bj][m][n]), 0, 0, 0)); } \
        else { _Pragma("unroll") for (int k = 0; k < 2; ++k) acc[ai][bj][m][n] = __builtin_amdgcn_mfma_f32_16x16x32_bf16(Bt[n].v[k], At[m].v[k], acc[ai][bj][m][n], 0, 0, 0); } } __builtin_amdgcn_s_setprio(0); } while (0)
#define PG8_WAIT_V(n) asm volatile("s_waitcnt vmcnt(" #n ")" ::: "memory")
#define PG8_WAIT_L(n) asm volatile("s_waitcnt lgkmcnt(" #n ")" ::: "memory")
#define PG8_BAR __builtin_amdgcn_s_barrier()
#define PG8_SCHED __builtin_amdgcn_sched_barrier(0)
    Unit cur, nxt; int ui = 0;
    if (!S.next(0, cur)) return;
    f32x4 acc[2][2][4][2];
#pragma unroll
    for (int a = 0; a < 2; ++a)
#pragma unroll
        for (int b = 0; b < 2; ++b)
#pragma unroll
            for (int m = 0; m < 4; ++m)
#pragma unroll
                for (int n = 0; n < 2; ++n) acc[a][b][m][n] = (f32x4){0.f, 0.f, 0.f, 0.f};
    Frag<FP8> At[4], B0[2], B1[2];
    const char* cA = (const char*)g.A + (size_t)cur.pm * tstep; const char* cB = (const char*)g.Bt + S.boff(cur) + (size_t)cur.pn * tstep;
    S.a_ready(cur);
    if constexpr (SP2) {
        PG8_STAGE(PG8_SB(0, 0), cB, voffB); PG8_STAGE(PG8_SB(0, 1), cB + hstep, voffB); PG8_STAGE(PG8_SA(0, 0), cA, voffA); PG8_STAGE(PG8_SA(0, 1), cA + hstep, voffA);
        if (wr == 1) PG8_BAR;
        PG8_WAIT_V(2); PG8_BAR;
        PG8_STAGE(PG8_SB(1, 0), cB + kstep, voffB); PG8_STAGE(PG8_SA(1, 0), cA + kstep, voffA); PG8_STAGE(PG8_SB(1, 1), cB + hstep + kstep, voffB);
        PG8_WAIT_V(6); PG8_BAR;
    } else {
        PG8_STAGE(PG8_SB(0, 0), cB, voffB); PG8_STAGE(PG8_SA(0, 0), cA, voffA); PG8_STAGE(PG8_SB(0, 1), cB + hstep, voffB); PG8_STAGE(PG8_SA(0, 1), cA + hstep, voffA);
        if (wr == 1) PG8_BAR;
        PG8_WAIT_V(4); PG8_BAR;
        PG8_STAGE(PG8_SB(1, 0), cB + kstep, voffB); PG8_STAGE(PG8_SA(1, 0), cA + kstep, voffA); PG8_STAGE(PG8_SB(1, 1), cB + hstep + kstep, voffB);
        PG8_WAIT_V(6); PG8_BAR;
    }
    for (;;) {
        const bool has_next = S.next(ui + 1, nxt);
        const char* nA = has_next ? (const char*)g.A + (size_t)nxt.pm * tstep : cA; const char* nB = has_next ? (const char*)g.Bt + S.boff(nxt) + (size_t)nxt.pn * tstep : cB;
#pragma unroll 1
        for (int t = 0; t < nt; t += 2) {
            const bool last = (t == nt - 2);
            const char* a1 = cA + (size_t)(t + 1) * kstep;
            const char* a2 = last ? nA : cA + (size_t)(t + 2) * kstep; const char* b2 = last ? nB : cB + (size_t)(t + 2) * kstep;
            const char* a3 = a2 + kstep; const char* b3 = b2 + kstep;
            if (last && has_next) S.a_ready(nxt);
            if constexpr (SP2) {
            PG8_LDB(B0, 0, 0); PG8_LDB(B1, 0, 1); PG8_SCHED; PG8_LDA(At, 0, 0); PG8_STAGE(PG8_SA(1, 1), a1 + hstep, voffA);
            PG8_WAIT_V(8); PG8_WAIT_L(0); PG8_BAR; PG8_MMA(0, 0, At, B0); PG8_MMA(0, 1, At, B1); PG8_BAR; PG8_SCHED;
            PG8_LDA(At, 0, 1); PG8_STAGE(PG8_SB(0, 0), b2, voffB); PG8_STAGE(PG8_SB(0, 1), b2 + hstep, voffB); PG8_STAGE(PG8_SA(0, 0), a2, voffA);
            PG8_WAIT_V(8); PG8_WAIT_L(0); PG8_BAR; PG8_MMA(1, 0, At, B0); PG8_MMA(1, 1, At, B1); PG8_BAR; PG8_SCHED;
            PG8_LDB(B0, 1, 0); PG8_LDB(B1, 1, 1); PG8_SCHED; PG8_LDA(At, 1, 0); PG8_STAGE(PG8_SA(0, 1), a2 + hstep, voffA);
            PG8_WAIT_V(8); PG8_WAIT_L(0); PG8_BAR; PG8_MMA(0, 0, At, B0); PG8_MMA(0, 1, At, B1); PG8_BAR; PG8_SCHED;
            PG8_LDA(At, 1, 1); PG8_STAGE(PG8_SB(1, 0), b3, voffB); PG8_STAGE(PG8_SB(1, 1), b3 + hstep, voffB); PG8_STAGE(PG8_SA(1, 0), a3, voffA);
            PG8_WAIT_V(8); PG8_WAIT_L(0); PG8_BAR; PG8_MMA(1, 0, At, B0); PG8_MMA(1, 1, At, B1); PG8_BAR; PG8_SCHED;
            } else {
            PG8_LDB(B0, 0, 0); PG8_SCHED; PG8_LDA(At, 0, 0); PG8_STAGE(PG8_SA(1, 1), a1 + hstep, voffA);
            PG8_WAIT_L(8); PG8_BAR; PG8_WAIT_L(0); PG8_MMA(0, 0, At, B0); PG8_BAR; PG8_SCHED;
            PG8_LDB(B1, 0, 1); PG8_STAGE(PG8_SB(0, 0), b2, voffB);
            PG8_BAR; PG8_WAIT_L(0); PG8_MMA(0, 1, At, B1); PG8_BAR;
            PG8_LDA(At, 0, 1); PG8_STAGE(PG8_SA(0, 0), a2, voffA);
            PG8_BAR; PG8_WAIT_L(0); PG8_MMA(1, 0, At, B0); PG8_BAR; PG8_SCHED;
            PG8_STAGE(PG8_SB(0, 1), b2 + hstep, voffB);
            PG8_WAIT_V(6); PG8_BAR; PG8_MMA(1, 1, At, B1); PG8_BAR;
            PG8_LDB(B0, 1, 0); PG8_SCHED; PG8_LDA(At, 1, 0); PG8_STAGE(PG8_SA(0, 1), a2 + hstep, voffA);
            PG8_WAIT_L(8); PG8_BAR; PG8_WAIT_L(0); PG8_MMA(0, 0, At, B0); PG8_BAR; PG8_SCHED;
            PG8_LDB(B1, 1, 1); PG8_STAGE(PG8_SB(1, 0), b3, voffB);
            PG8_BAR; PG8_WAIT_L(0); PG8_MMA(0, 1, At, B1); PG8_BAR;
            PG8_LDA(At, 1, 1); PG8_STAGE(PG8_SA(1, 0), a3, voffA);
            PG8_BAR; PG8_WAIT_L(0); PG8_MMA(1, 0, At, B0); PG8_BAR; PG8_SCHED;
            PG8_STAGE(PG8_SB(1, 1), b3 + hstep, voffB);
            PG8_WAIT_V(6); PG8_BAR; PG8_MMA(1, 1, At, B1); PG8_BAR;
            }
        }
        if constexpr (ALIGN_EPI) { if (wr == 0) PG8_BAR; }
        if constexpr (FP8) { asm volatile("s_nop 15\n\ts_nop 15" ::: "memory"); }
        if constexpr (!Epi::AFTER_DRAIN) { E(acc, cur, wr, wc, fr, fq); S.done(cur); }
        if (!has_next) break;
#pragma unroll
        for (int a = 0; a < 2; ++a)
#pragma unroll
            for (int b = 0; b < 2; ++b)
#pragma unroll
                for (int m = 0; m < 4; ++m)
#pragma unroll
                    for (int n = 0; n < 2; ++n) acc[a][b][m][n] = (f32x4){0.f, 0.f, 0.f, 0.f};
        cur = nxt; cA = nA; cB = nB; ++ui;
        if constexpr (ALIGN_EPI) { if (wr == 1) PG8_BAR; }
    }
    PG8_WAIT_V(0);
    if constexpr (!ALIGN_EPI) { if (wr == 0) PG8_BAR; }
    PG8_BAR;
    if constexpr (Epi::AFTER_DRAIN) { E.fused(acc, cur, wr, wc, fr, fq, lds, wid, lane); S.done(cur); }
#undef PG8_SA
#undef PG8_SB
#undef PG8_STAGE
#undef PG8_LDA
#undef PG8_LDB
#undef PG8_MMA
#undef PG8_WAIT_V
#undef PG8_WAIT_L
#undef PG8_BAR
#undef PG8_SCHED
}
}

constexpr int D = 1024, NB = 8, SEQ = 8192, CTXL = 256, DEPTH = 4, GRIDW = 64, ROWS_G = SEQ / GRIDW  ;
constexpr int M_LAT = NB * SEQ  , M_CTX = NB * CTXL  , M_ALL = M_LAT + M_CTX  ;
constexpr int NHEAD = 8, M_DK = 64, M_DV = 128, H_DK = 128, H_DV = 128;
constexpr int NP_M = 3072, NIN_M = 3328, NW_M = 3104, NP_H = 5120;
constexpr int FF = 2816, NGU = 2 * FF, NEXP = 8;
constexpr int MOE_ROWS = 137216, MOE_PANELS = MOE_ROWS / 256;
constexpr float EPS = 1e-6f;
constexpr int NWAVES = 8, NTHR = 512;

constexpr size_t MiB = 1u << 20;
constexpr size_t WS_CTL = 0, CTL_ZERO_BYTES = 936 * 1024;
constexpr size_t WS_MODV = 1 * MiB;
constexpr size_t WS_SMALL = 2 * MiB;
constexpr size_t WS_LATC = 3 * MiB;
constexpr size_t WS_WE = 11 * MiB;
constexpr size_t WS_WO = 37 * MiB;
constexpr size_t WS_U = 181 * MiB;
constexpr size_t WS_GATES = 313 * MiB;
constexpr size_t WS_STATE = 322 * MiB;
constexpr size_t WS_ROUTE = 362 * MiB;
constexpr size_t WS_ACT = 364 * MiB;
constexpr size_t WS_Y = WS_ACT + 700 * MiB;
constexpr size_t WS_AOUT8 = WS_ACT + 968 * MiB;
constexpr size_t WS_END = WS_AOUT8 + 66 * MiB;
constexpr size_t WE_IN = 0, WE_OUT = 7 * MiB, WE_GU = 9 * MiB, WE_DOWN = 20 * MiB;
constexpr size_t WOD_IN = 0, WOD_OUT = 10 * MiB, WOD_GU = 12 * MiB, WOD_DOWN = 100 * MiB;
constexpr size_t EGU_BYTES = (size_t)NGU * D * 2, EDOWN_BYTES = (size_t)D * FF * 2;
static_assert(WOD_GU + 8 * EGU_BYTES <= WOD_DOWN && WOD_DOWN + 8 * EDOWN_BYTES <= 144 * MiB, "odd weights map");
static_assert((size_t)NIN_M * D * 2 <= 7 * MiB && WE_GU + EGU_BYTES <= WE_DOWN && WE_DOWN + EDOWN_BYTES <= 26 * MiB, "even weights map");
static_assert((size_t)M_ALL * NP_H * 2 <= 700 * MiB && (size_t)MOE_ROWS * D * 2 + (size_t)MOE_ROWS * FF * 2 <= 1005 * MiB && 700 * MiB + (size_t)M_ALL * D * 2 <= 1005 * MiB, "act map");
constexpr int CW_BAR = 4096;
constexpr int CW_ECNT = 8192;
constexpr int CW_DBG = 16384;
constexpr int CW_CMAX = 32768, CM_LSTRIDE = 50176, CM_GU = 3328, CM_GU_O = 5120;
static_assert((size_t)(CW_CMAX + 4 * CM_LSTRIDE) * 4 <= CTL_ZERO_BYTES, "ctl map");
constexpr size_t RT_E = 0;
constexpr size_t RT_R = 512 * 1024;
constexpr size_t RT_W = 512 * 1024 + 1024 * 1024;
constexpr size_t SM_LB = 0;
constexpr size_t SM_PEXP = 64 * 1024;
constexpr size_t SM_EBASE = 96 * 1024;
constexpr size_t SM_SAU = 128 * 1024;
constexpr size_t SM_SAU2 = 400 * 1024;
constexpr size_t SM_SWE = 672 * 1024;
constexpr size_t SM_SWO = 712 * 1024;
constexpr int SWE_IN = 0, SWE_GU = 3328, SWO_IN = 0, SWO_GU = 5120;
static_assert(SM_SAU + (size_t)M_ALL * 4 <= SM_SAU2 && SM_SAU2 + (size_t)M_ALL * 4 <= SM_SWE && SM_SWE + (3328 + 5632) * 4 <= SM_SWO && SM_SWO + (5120 + 8 * 5632) * 4 <= 1024 * 1024, "small region map");
constexpr size_t GATES_SAMOE = (size_t)M_ALL * 32 * 4;
static_assert(GATES_SAMOE + (size_t)MOE_ROWS * 4 <= 9 * MiB, "gates region map");

constexpr int LDS_MAIN = 147456;
constexpr int LDSCTL_OFF = LDS_MAIN;
constexpr int LDS_BYTES = LDS_MAIN + 512;

#define GAS __attribute__((address_space(1)))
#define LAS __attribute__((address_space(3)))
typedef unsigned short bf16;
typedef unsigned v4u __attribute__((ext_vector_type(4)));
typedef unsigned v2u __attribute__((ext_vector_type(2)));
typedef float f32x4 __attribute__((ext_vector_type(4)));
typedef float f32x16 __attribute__((ext_vector_type(16)));
typedef short bf16x8 __attribute__((ext_vector_type(8)));
typedef short s16x4 __attribute__((ext_vector_type(4)));
typedef GAS unsigned gu32;
#define RLX_AGENT __ATOMIC_RELAXED, __HIP_MEMORY_SCOPE_AGENT
#define LDS_WAIT() asm volatile("s_waitcnt lgkmcnt(0)" ::: "memory")
#define VM_WAIT() asm volatile("s_waitcnt vmcnt(0)" ::: "memory")
#define CFENCE() asm volatile("" ::: "memory")
__device__ __forceinline__ unsigned f2bf(float f) { unsigned u = __builtin_bit_cast(unsigned, f); return (u + 0x7fffu + ((u >> 16) & 1u)) >> 16; }
typedef __bf16 bf16x2_t __attribute__((ext_vector_type(2)));
typedef float f32x2_t __attribute__((ext_vector_type(2)));
__device__ __forceinline__ unsigned pk2(float lo, float hi) { f32x2_t v = {lo, hi}; bf16x2_t b = __builtin_convertvector(v, bf16x2_t); return __builtin_bit_cast(unsigned, b); }
__device__ __forceinline__ float bf2f(unsigned short b) { return __builtin_bit_cast(float, (unsigned)b << 16); }
__device__ __forceinline__ float bflo(unsigned w) { return __builtin_bit_cast(float, w << 16); }
__device__ __forceinline__ float bfhi(unsigned w) { return __builtin_bit_cast(float, w & 0xffff0000u); }
__device__ __forceinline__ float sigmoidf_(float x) { return __builtin_amdgcn_rcpf(1.0f + __expf(-x)); }
__device__ __forceinline__ float siluf_(float x) { return x * sigmoidf_(x); }
template <int CTRL, int RM> __device__ __forceinline__ float dppmov(float x) { return __builtin_bit_cast(float, __builtin_amdgcn_update_dpp(0, __builtin_bit_cast(int, x), CTRL, RM, 0xf, false)); }
__device__ __forceinline__ float wave_sum(float v) {
    v += dppmov<0xB1, 0xf>(v); v += dppmov<0x4E, 0xf>(v); v += dppmov<0x141, 0xf>(v); v += dppmov<0x140, 0xf>(v);
    v += dppmov<0x142, 0xa>(v); v += dppmov<0x143, 0xc>(v);
    return __builtin_bit_cast(float, __builtin_amdgcn_readlane(__builtin_bit_cast(int, v), 63));
}

__device__ __forceinline__ float wave_max(float v) {
    v = fmaxf(v, dppmov<0xB1, 0xf>(v)); v = fmaxf(v, dppmov<0x4E, 0xf>(v)); v = fmaxf(v, dppmov<0x141, 0xf>(v)); v = fmaxf(v, dppmov<0x140, 0xf>(v));
    v = fmaxf(v, dppmov<0x142, 0xa>(v)); v = fmaxf(v, dppmov<0x143, 0xc>(v));
    return __builtin_bit_cast(float, __builtin_amdgcn_readlane(__builtin_bit_cast(int, v), 63));
}

#define XB_TMO      128
#define XB_XCNT(j)  (256  + 64 * (j))
#define XB_XSUB(j)  (1280 + 64 * (j))
#define XB_XGEN(j)  (2304 + 64 * (j))
#define XB_TOP      3328
#define XB_TOPGEN   3392
#define XCD_BAR_WORDS 3456
#define XB_SPIN_CAP (1u << 18)
__device__ __forceinline__ unsigned xb_ld(unsigned* p)              { return __hip_atomic_load(p, __ATOMIC_RELAXED, __HIP_MEMORY_SCOPE_AGENT); }
__device__ __forceinline__ unsigned xb_add(unsigned* p, unsigned v) { return __hip_atomic_fetch_add(p, v, __ATOMIC_RELAXED, __HIP_MEMORY_SCOPE_AGENT); }
__device__ __forceinline__ unsigned xb_xcc_id() { return (unsigned)__builtin_amdgcn_s_getreg((3 << 11) | 20) & 0xFu; }
#define XB_SPIN(cond, bar) do { unsigned _sp = 0; while (cond) { __builtin_amdgcn_s_sleep(1); \
    if ((++_sp & 255u) == 0u) { if (xb_ld(&(bar)[XB_TMO])) break; if (_sp > XB_SPIN_CAP) { atomicAdd(&(bar)[XB_TMO], 1u); break; } } } } while (0)
struct XcdBarrier { unsigned* bar; unsigned x; volatile LAS unsigned* st; };
__device__ __forceinline__ XcdBarrier xcd_barrier_post(unsigned* bar, volatile LAS unsigned* st) {
    XcdBarrier b; b.bar = bar; b.x = xb_xcc_id(); b.st = st;
    if (threadIdx.x == 0) (void)xb_add(&bar[XB_XCNT(b.x)], 1u);
    return b;
}
__device__ __forceinline__ void xcd_barrier_complete(unsigned* bar, unsigned x, unsigned& nloc, unsigned& nx) {
    const unsigned G = gridDim.x * gridDim.y * gridDim.z;
    unsigned sum, cnt, mine, sp = 0u;
    for (;;) {
        sum = 0u; cnt = 0u; mine = 0u;
#pragma unroll
        for (unsigned j = 0; j < 16; ++j) { const unsigned c = xb_ld(&bar[XB_XCNT(j)]); sum += c; cnt += (c > 0u) ? 1u : 0u; mine = (j == x) ? c : mine; }
        if (sum == G) break;
        __builtin_amdgcn_s_sleep(1);
        if ((++sp & 255u) == 0u) { if (xb_ld(&bar[XB_TMO])) break; if (sp > XB_SPIN_CAP) { atomicAdd(&bar[XB_TMO], 1u); break; } }
    }
    nloc = mine > 0u ? mine : 1u; nx = cnt > 0u ? cnt : 1u;
}
__device__ __attribute__((noinline)) void xcd_barrier(unsigned* bar_, unsigned bx_, volatile LAS unsigned* st_) { XcdBarrier b; b.bar = bar_; b.x = bx_; b.st = st_;
    asm volatile("s_waitcnt vmcnt(0)" ::: "memory");
    __syncthreads();
    if (threadIdx.x == 0) {
        unsigned* bar = b.bar;
        __builtin_amdgcn_s_waitcnt(0);
        unsigned nloc = b.st[0], nx = b.st[1];
        if (nloc == 0u) { xcd_barrier_complete(bar, b.x, nloc, nx); b.st[0] = nloc; b.st[1] = nx; }
        const unsigned old = xb_add(&bar[XB_XSUB(b.x)], 1u);
        const unsigned gen = old / nloc;
        if (old + 1u == (gen + 1u) * nloc) {
            __builtin_amdgcn_fence(__ATOMIC_RELEASE, "agent");
            asm volatile("s_waitcnt vmcnt(0)" ::: "memory");
            const unsigned og = xb_add(&bar[XB_TOP], 1u);
            const unsigned tg = og / nx;
            if (og + 1u == (tg + 1u) * nx) xb_add(&bar[XB_TOPGEN], 1u);
            else XB_SPIN(xb_ld(&bar[XB_TOPGEN]) == tg, bar);
            __builtin_amdgcn_fence(__ATOMIC_ACQUIRE, "agent");
            xb_add(&bar[XB_XGEN(b.x)], 1u);
            asm volatile("s_waitcnt vmcnt(0)" ::: "memory");
        } else {
            XB_SPIN(xb_ld(&bar[XB_XGEN(b.x)]) == gen, bar);
            __builtin_amdgcn_fence(__ATOMIC_ACQUIRE, "agent");
            asm volatile("s_waitcnt vmcnt(0)" ::: "memory");
        }
    }
    __syncthreads();
}

struct Args {
    const float* in[23];
    float* out; unsigned char* ws;
    int ph_lo, ph_hi;
    int use_bar, pad;
};
struct Frame {
    LAS unsigned char* lds;
    int tid, lane, wave, G, bid;
    unsigned char* ws;
    const float* const __attribute__((address_space(4)))* in;
    float* out;
};
enum { I_X = 0, I_C, I_CTX, I_CCTX, I_MODW, I_MODB, I_NORMG, I_MWIN, I_MBGATE, I_MWCONV, I_MGHEAD, I_MWOUT, I_HWIN, I_HBF, I_HLB, I_HGHEAD, I_HWOUT, I_FWGU, I_FWDOWN, I_EWR, I_EBR, I_EWGU, I_EWDOWN };

#ifndef FP8_LAYERS
#define FP8_LAYERS 0xF
#endif
#define FFN_FP8_L(L) (((FP8_LAYERS) >> (L)) & 1)
#ifndef OUT_FP8_LAYERS
#define OUT_FP8_LAYERS 0xC
#endif
#define OUT_FP8_L(L) (((OUT_FP8_LAYERS) >> (L)) & 1)
#ifndef INPROJ_I8
#define INPROJ_I8 1
#endif
#ifndef UP_I8
#define UP_I8 1
#endif
#ifndef UP_I8_MOE
#define UP_I8_MOE 0
#endif
#ifndef FFN_FP8
#define FFN_FP8 1
#endif
constexpr float WSCALE8 = 64.0f;

__device__ __forceinline__ void phase_mods(Frame& F) {
    LAS float* SV = (LAS float*)(F.lds);
    LAS float* RED = (LAS float*)(F.lds + 9 * 1024 * 4);
    const float* cvec = F.in[I_C]; const float* cctx = F.in[I_CCTX];
    for (int i = F.tid; i < 9 * 1024; i += NTHR) { const int b = i >> 10, k = i & 1023; const float v = b < 8 ? cvec[b * 1024 + k] : cctx[k]; SV[i] = siluf_(v); }
    __syncthreads();
    const float* modw = F.in[I_MODW]; const float* modb = F.in[I_MODB]; const float* normg = F.in[I_NORMG];
    float* modv = (float*)(F.ws + WS_MODV);
    for (int item = F.bid; item < 4 * 96; item += F.G) {
        const int L = item / 96, n0 = (item % 96) * 64;
        const float* wp = modw + (size_t)L * 1024 * 6144 + n0 + F.lane;
        float acc[9];
#pragma unroll
        for (int b = 0; b < 9; ++b) acc[b] = 0.f;
        const int k0 = F.wave * 128;
#pragma unroll 4
        for (int k = 0; k < 128; ++k) { const float wv = wp[(size_t)(k0 + k) * 6144];
#pragma unroll
            for (int b = 0; b < 9; ++b) acc[b] += SV[b * 1024 + k0 + k] * wv; }
#pragma unroll
        for (int b = 0; b < 9; ++b) RED[(F.wave * 9 + b) * 64 + F.lane] = acc[b];
        __syncthreads();
        for (int o = F.tid; o < 9 * 64; o += NTHR) { const int b = o >> 6, l = o & 63; float v = 0.f;
#pragma unroll
            for (int w = 0; w < 8; ++w) v += RED[(w * 9 + b) * 64 + l];
            const int n = n0 + l, s = n >> 10, c = n & 1023; v += modb[L * 6144 + n];
            const float* g = normg + (size_t)L * 4 * 1024;
            int slot; float r;
            if (s == 0) { slot = 1; r = v; } else if (s == 1) { slot = 0; r = g[c] * (1.f + v); } else if (s == 2) { slot = 2; r = v * g[1024 + c]; }
            else if (s == 3) { slot = 4; r = v; } else if (s == 4) { slot = 3; r = g[2048 + c] * (1.f + v); } else { slot = 5; r = v * g[3072 + c]; }
            modv[((size_t)(L * 9 + b) * 6 + slot) * 1024 + c] = r; }
        __syncthreads();
    }
}

struct WDesc { const float* src; unsigned char* dst; const unsigned* cmax; float* sw; int N; int Kb; int mode; };
__device__ __forceinline__ int wrow_gu(int n0) { const int half = n0 / FF, nn = n0 - half * FF; return 256 * (nn >> 7) + 128 * half + (nn & 127); }
__device__ __forceinline__ WDesc wdesc(const float* W, int K, int N, unsigned char* WT, int gu_mode, int mode, const unsigned* cmax, float* sw, int r, int lane) {
    const int nkb = K >> 6, nb = r / nkb, kb = r - nb * nkb, k0 = 64 * kb, n0 = 32 * nb;
    const int row0 = gu_mode ? wrow_gu(n0) : n0; const int esz = mode == 0 ? 2 : 1;
    WDesc d; d.N = N; d.Kb = K * esz; d.mode = mode;
    d.src = W + (size_t)(k0 + (lane >> 3)) * N + n0 + 4 * (lane & 7);
    d.dst = WT + (size_t)(row0 + (lane >> 3)) * d.Kb + (size_t)(k0 + 8 * (lane & 7)) * esz;
    d.cmax = cmax + n0; d.sw = (mode == 2 && kb == 0) ? sw + row0 : nullptr;
    return d;
}
#define WT_DECL(T) f32x4 T##0, T##1, T##2, T##3, T##4, T##5, T##6, T##7
#define WT_LOAD(T, p, N) do { const GAS float* _p = (const GAS float*)(p); const size_t _s = (size_t)8 * (N); \
    T##0 = *(const GAS f32x4*)(_p); T##1 = *(const GAS f32x4*)(_p + _s); T##2 = *(const GAS f32x4*)(_p + 2 * _s); T##3 = *(const GAS f32x4*)(_p + 3 * _s); \
    T##4 = *(const GAS f32x4*)(_p + 4 * _s); T##5 = *(const GAS f32x4*)(_p + 5 * _s); T##6 = *(const GAS f32x4*)(_p + 6 * _s); T##7 = *(const GAS f32x4*)(_p + 7 * _s); } while (0)
#define WT_COPY(A, B) do { A##0 = B##0; A##1 = B##1; A##2 = B##2; A##3 = B##3; A##4 = B##4; A##5 = B##5; A##6 = B##6; A##7 = B##7; } while (0)
__device__ __forceinline__ void wt_put(LAS float* w, int i, const f32x4 v) { w[(8 * i) * 33] = v[0]; w[(8 * i) * 33 + 1] = v[1]; w[(8 * i) * 33 + 2] = v[2]; w[(8 * i) * 33 + 3] = v[3]; }
__device__ __forceinline__ void wt_process(const WDesc& d, const f32x4 t0, const f32x4 t1, const f32x4 t2, const f32x4 t3, const f32x4 t4, const f32x4 t5, const f32x4 t6, const f32x4 t7, LAS float* scr, int lane) {
    LAS float* w = scr + (lane >> 3) * 33 + 4 * (lane & 7);
    wt_put(w, 0, t0); wt_put(w, 1, t1); wt_put(w, 2, t2); wt_put(w, 3, t3); wt_put(w, 4, t4); wt_put(w, 5, t5); wt_put(w, 6, t6); wt_put(w, 7, t7);
    LDS_WAIT(); CFENCE();
    const int c = lane & 7;
#pragma unroll
    for (int j = 0; j < 4; ++j) { const int n = (lane >> 3) + 8 * j; const LAS float* s = scr + (8 * c) * 33 + n;
        float x[8];
#pragma unroll
        for (int e = 0; e < 8; ++e) x[e] = s[e * 33];
        unsigned char* dp = d.dst + (size_t)(8 * j) * d.Kb;
        if (d.mode == 0) { v4u o; o.x = pk2(x[0], x[1]); o.y = pk2(x[2], x[3]); o.z = pk2(x[4], x[5]); o.w = pk2(x[6], x[7]); *(GAS v4u*)dp = o; }
        else if (d.mode == 1) { v2u o; unsigned q = 0; q = __builtin_amdgcn_cvt_pk_fp8_f32(x[0] * WSCALE8, x[1] * WSCALE8, q, false); q = __builtin_amdgcn_cvt_pk_fp8_f32(x[2] * WSCALE8, x[3] * WSCALE8, q, true); o.x = q;
            q = 0; q = __builtin_amdgcn_cvt_pk_fp8_f32(x[4] * WSCALE8, x[5] * WSCALE8, q, false); q = __builtin_amdgcn_cvt_pk_fp8_f32(x[6] * WSCALE8, x[7] * WSCALE8, q, true); o.y = q; *(GAS v2u*)dp = o; }
        else { const float mx = __uint_as_float(d.cmax[n]); const float iv = mx > 0.f ? 127.0f / mx : 0.f; unsigned q[8];
#pragma unroll
            for (int e = 0; e < 8; ++e) q[e] = (unsigned)(int)__builtin_rintf(x[e] * iv) & 0xffu;
            v2u o; o.x = q[0] | (q[1] << 8) | (q[2] << 16) | (q[3] << 24); o.y = q[4] | (q[5] << 8) | (q[6] << 16) | (q[7] << 24); *(GAS v2u*)dp = o;
            if (d.sw != nullptr && c == 0) d.sw[n] = mx > 0.f ? mx * (1.0f / 127.0f) : 1.0f; }
    }
    LDS_WAIT(); CFENCE();
}
__device__ __forceinline__ WDesc wdesc_layer(Frame& F, int L, int it) {
    const int j = L >> 1; int r = it; const unsigned* cm = (const unsigned*)(F.ws + WS_CTL) + CW_CMAX + L * CM_LSTRIDE;
    if ((L & 1) == 0) {
        unsigned char* wb = F.ws + WS_WE; float* swb = (float*)(F.ws + WS_SMALL + SM_SWE);
        constexpr int I0 = 16 * (NW_M / 32), I1 = 16 * 32, I2 = 16 * (NGU / 32);
        if (r < I0) return wdesc(F.in[I_MWIN] + (size_t)j * D * NW_M, D, NW_M, wb + WE_IN, 0, INPROJ_I8 ? 2 : 0, cm, swb + SWE_IN, r, F.lane); r -= I0;
        if (r < I1) return wdesc(F.in[I_MWOUT] + (size_t)j * D * D, D, D, wb + WE_OUT, 0, OUT_FP8_L(L) ? 1 : 0, cm, nullptr, r, F.lane); r -= I1;
        if (r < I2) return wdesc(F.in[I_FWGU] + (size_t)j * D * NGU, D, NGU, wb + WE_GU, 1, UP_I8 ? 2 : (FFN_FP8_L(L) ? 1 : 0), cm + CM_GU, swb + SWE_GU, r, F.lane); r -= I2;
        return wdesc(F.in[I_FWDOWN] + (size_t)j * FF * D, FF, D, wb + WE_DOWN, 0, FFN_FP8_L(L) ? 1 : 0, cm, nullptr, r, F.lane);
    } else {
        unsigned char* wb = F.ws + WS_WO; float* swb = (float*)(F.ws + WS_SMALL + SM_SWO);
        constexpr int I0 = 16 * (NP_H / 32), I1 = 16 * 32, I2 = 16 * (NGU / 32), I3 = (FF / 64) * 32;
        if (r < I0) return wdesc(F.in[I_HWIN] + (size_t)j * D * NP_H, D, NP_H, wb + WOD_IN, 0, INPROJ_I8 ? 2 : 0, cm, swb + SWO_IN, r, F.lane); r -= I0;
        if (r < I1) return wdesc(F.in[I_HWOUT] + (size_t)j * D * D, D, D, wb + WOD_OUT, 0, OUT_FP8_L(L) ? 1 : 0, cm, nullptr, r, F.lane); r -= I1;
        const int e = r / (I2 + I3); r -= e * (I2 + I3);
        if (r < I2) return wdesc(F.in[I_EWGU] + ((size_t)j * NEXP + e) * D * NGU, D, NGU, wb + WOD_GU + e * EGU_BYTES, 1, UP_I8_MOE ? 2 : (FFN_FP8_L(L) ? 1 : 0), cm + CM_GU_O + e * NGU, swb + SWO_GU + e * NGU, r, F.lane); r -= I2;
        return wdesc(F.in[I_EWDOWN] + ((size_t)j * NEXP + e) * FF * D, FF, D, wb + WOD_DOWN + e * EDOWN_BYTES, 0, FFN_FP8_L(L) ? 1 : 0, cm, nullptr, r, F.lane);
    }
}
__device__ __forceinline__ void phase_wconv(Frame& F, int L) {
    LAS float* scr = (LAS float*)(F.lds + F.wave * 16384);
    const int gw = F.bid * NWAVES + F.wave, NGW = F.G * NWAVES;
    const int total = (L & 1) ? 16 * (NP_H / 32) + 16 * 32 + NEXP * (16 * (NGU / 32) + (FF / 64) * 32) : 16 * (NW_M / 32) + 16 * 32 + 16 * (NGU / 32) + (FF / 64) * 32;
    WT_DECL(c); WT_DECL(n); WDesc dc, dn;
    int it = gw;
    if (it < total) { dc = wdesc_layer(F, L, it); WT_LOAD(c, dc.src, dc.N); }
#pragma unroll 1
    for (; it < total; it += NGW) {
        const bool more = it + NGW < total;
        if (more) { dn = wdesc_layer(F, L, it + NGW); WT_LOAD(n, dn.src, dn.N); }
        wt_process(dc, c0, c1, c2, c3, c4, c5, c6, c7, scr, F.lane);
        if (more) { dc = dn; WT_COPY(c, n); }
    }
    if ((L & 1) == 0) {
        unsigned char* wb = F.ws + WS_WE; float* swb = (float*)(F.ws + WS_SMALL + SM_SWE);
        GAS v4u* z = (GAS v4u*)(wb + WE_IN + (size_t)NW_M * D * (INPROJ_I8 ? 1 : 2)); const int nz = (NIN_M - NW_M) * D * (INPROJ_I8 ? 1 : 2) / 16;
        for (int i = F.bid * NTHR + F.tid; i < nz; i += F.G * NTHR) z[i] = (v4u){0u, 0u, 0u, 0u};
        if (INPROJ_I8 && F.bid == 0 && F.tid < NIN_M - NW_M) swb[SWE_IN + NW_M + F.tid] = 1.0f;
    }
}
__device__ __forceinline__ void phase_colmax(Frame& F) {
    const int gw = F.bid * NWAVES + F.wave, NGW = F.G * NWAVES;
    constexpr int TE_IN = 16 * (NW_M / 32), TE_GU = 16 * (NGU / 32), TO_IN = 16 * (NP_H / 32);
    constexpr int TE = (INPROJ_I8 ? TE_IN : 0) + (UP_I8 ? TE_GU : 0), TO = (INPROJ_I8 ? TO_IN : 0) + (UP_I8_MOE ? NEXP * TE_GU : 0), total = 2 * (TE + TO);
#pragma unroll 1
    for (int it = gw; it < total; it += NGW) {
        int r = it; int L; const float* W; int N, nnb, cbase;
        const int pr = r / (TE + TO); r -= pr * (TE + TO);
        if (r < TE) { L = 2 * pr; if (INPROJ_I8 && r < TE_IN) { W = F.in[I_MWIN] + (size_t)pr * D * NW_M; N = NW_M; nnb = NW_M / 32; cbase = 0; } else { if (INPROJ_I8) r -= TE_IN; W = F.in[I_FWGU] + (size_t)pr * D * NGU; N = NGU; nnb = NGU / 32; cbase = CM_GU; } }
        else { r -= TE; L = 2 * pr + 1;
            if (INPROJ_I8 && r < TO_IN) { W = F.in[I_HWIN] + (size_t)pr * D * NP_H; N = NP_H; nnb = NP_H / 32; cbase = 0; }
            else { if (INPROJ_I8) r -= TO_IN; const int e = r / TE_GU; r -= e * TE_GU; W = F.in[I_EWGU] + ((size_t)pr * NEXP + e) * D * NGU; N = NGU; nnb = NGU / 32; cbase = CM_GU_O + e * NGU; } }
        const int kb = r / nnb, nb = r - kb * nnb;
        const float* p = W + (size_t)(64 * kb + (F.lane >> 3)) * N + 32 * nb + 4 * (F.lane & 7);
        WT_DECL(t); WT_LOAD(t, p, N);
        f32x4 mx;
#pragma unroll
        for (int q = 0; q < 4; ++q) { float a = fmaxf(fmaxf(fabsf(t0[q]), fabsf(t1[q])), fmaxf(fabsf(t2[q]), fabsf(t3[q]))); a = fmaxf(a, fmaxf(fmaxf(fabsf(t4[q]), fabsf(t5[q])), fmaxf(fabsf(t6[q]), fabsf(t7[q]))));
            a = fmaxf(a, __shfl_xor(a, 8)); a = fmaxf(a, __shfl_xor(a, 16)); a = fmaxf(a, __shfl_xor(a, 32)); mx[q] = a; }
        if (F.lane < 8) { unsigned* cm = (unsigned*)(F.ws + WS_CTL) + CW_CMAX + L * CM_LSTRIDE + cbase + 32 * nb + 4 * F.lane;
#pragma unroll
            for (int q = 0; q < 4; ++q) atomicMax(cm + q, __float_as_uint(mx[q])); }
    }
}

struct TokCfg {
    const void* lat_src_l; const void* lat_src_c;
    void* lat_dst_l; void* lat_dst_c;
    int src_f32, dst_f32;
    const bf16* y; int y_perm; int moe_combine;
    const float* vupd;
    const float* vna; const float* vnb;
    bf16* u; int u_perm; int u_fp8;
    float* u_scale;
    int route; int jr;
    int nrows;
};
__device__ __forceinline__ int perm_cm(int t) { return (t & 63) * ROWS_G + (t >> 6); }

struct RowRaw { v4u l0, l1, l2, l3; v2u a0, a1, a2, a3, b0, b1, b2, b3; };
__device__ __forceinline__ RowRaw tok_issue(const TokCfg& T, int row, int p0, int p1, int lane) {
    RowRaw R; const v4u z4 = (v4u){0u, 0u, 0u, 0u}; const v2u z2 = (v2u){0u, 0u};
    R.l0 = z4; R.l1 = z4; R.l2 = z4; R.l3 = z4; R.a0 = z2; R.a1 = z2; R.a2 = z2; R.a3 = z2; R.b0 = z2; R.b1 = z2; R.b2 = z2; R.b3 = z2;
    if (T.src_f32) { const GAS v4u* lp = (const GAS v4u*)(row < M_LAT ? (const float*)T.lat_src_l + (size_t)row * D : (const float*)T.lat_src_c + (size_t)(row - M_LAT) * D) + lane;
        R.l0 = lp[0]; R.l1 = lp[64]; R.l2 = lp[128]; R.l3 = lp[192]; }
    else { const GAS v2u* lp = (const GAS v2u*)(row < M_LAT ? (const bf16*)T.lat_src_l + (size_t)row * D : (const bf16*)T.lat_src_c + (size_t)(row - M_LAT) * D) + lane;
        const v2u a = lp[0], b = lp[64], c = lp[128], d = lp[192]; R.l0.x = a.x; R.l0.y = a.y; R.l1.x = b.x; R.l1.y = b.y; R.l2.x = c.x; R.l2.y = c.y; R.l3.x = d.x; R.l3.y = d.y; }
    if (T.y) {
        if (T.moe_combine) { const GAS v2u* ya = (const GAS v2u*)(T.y + (size_t)p0 * D) + lane; const GAS v2u* yb = (const GAS v2u*)(T.y + (size_t)p1 * D) + lane;
            R.a0 = ya[0]; R.a1 = ya[64]; R.a2 = ya[128]; R.a3 = ya[192]; R.b0 = yb[0]; R.b1 = yb[64]; R.b2 = yb[128]; R.b3 = yb[192]; }
        else { int yr = row; if (T.y_perm && row < M_LAT) yr = (row & ~8191) + perm_cm(row & 8191);
            const GAS v2u* yp = (const GAS v2u*)(T.y + (size_t)yr * D) + lane; R.a0 = yp[0]; R.a1 = yp[64]; R.a2 = yp[128]; R.a3 = yp[192]; }
    }
    return R;
}
__device__ __forceinline__ void phase_tok(Frame& F, const TokCfg& T) {
    const int gw = F.bid * NWAVES + F.wave, NGW = F.G * NWAVES;
    const int R = (T.nrows + NGW - 1) / NGW; const int r0 = gw * R; int r1 = r0 + R; if (r1 > T.nrows) r1 = T.nrows;
    LAS float* WR = (LAS float*)F.lds;
    if (T.route) { const float* wr = F.in[I_EWR] + (size_t)T.jr * 1024 * 8; for (int i = F.tid; i < 8192; i += NTHR) WR[i] = wr[i]; }
    __syncthreads();
    f32x4 VU[4], VA[4], VB[4]; int curb = -1;
    int my_e0 = 0, my_e1 = 0; float my_w = 0.f;
    const int* rrp = (const int*)(F.ws + WS_ROUTE + RT_R); const float* rwp = (const float*)(F.ws + WS_ROUTE + RT_W);
    int p0c = 0, p1c = 0, p0n = 0, p1n = 0; float w0c = 0.f, w0n = 0.f;
    if (T.moe_combine && r0 < r1) { p0c = rrp[2 * r0]; p1c = rrp[2 * r0 + 1]; w0c = rwp[r0]; if (r0 + 1 < r1) { p0n = rrp[2 * r0 + 2]; p1n = rrp[2 * r0 + 3]; w0n = rwp[r0 + 1]; } }
    RowRaw C = tok_issue(T, r0 < r1 ? r0 : 0, p0c, p1c, F.lane);
    for (int row = r0; row < r1; ++row) {
        const bool hn = row + 1 < r1;
        int p0nn = 0, p1nn = 0; float w0nn = 0.f;
        const RowRaw N = tok_issue(T, hn ? row + 1 : row, p0n, p1n, F.lane);
        if (hn) {
            if (T.moe_combine && row + 2 < r1) { p0nn = rrp[2 * row + 4]; p1nn = rrp[2 * row + 5]; w0nn = rwp[row + 2]; } }
        const int b = row < M_LAT ? (row >> 13) : 8;
        if (b != curb) { curb = b;
#pragma unroll
            for (int j = 0; j < 4; ++j) {
                if (T.y) VU[j] = ((const f32x4*)(T.vupd + (size_t)b * 6144))[F.lane + 64 * j];
                if (T.vna) { VA[j] = ((const f32x4*)(T.vna + (size_t)b * 6144))[F.lane + 64 * j]; VB[j] = ((const f32x4*)(T.vnb + (size_t)b * 6144))[F.lane + 64 * j]; } } }
        f32x4 v[4];
        if (T.src_f32) {
            v[0] = __builtin_bit_cast(f32x4, C.l0); v[1] = __builtin_bit_cast(f32x4, C.l1); v[2] = __builtin_bit_cast(f32x4, C.l2); v[3] = __builtin_bit_cast(f32x4, C.l3); }
        else {
            const v4u cl[4] = {C.l0, C.l1, C.l2, C.l3};
#pragma unroll
            for (int j = 0; j < 4; ++j) v[j] = (f32x4){bflo(cl[j].x), bfhi(cl[j].x), bflo(cl[j].y), bfhi(cl[j].y)}; }
        if (T.y) {
            f32x4 yv[4]; const v2u cya[4] = {C.a0, C.a1, C.a2, C.a3}, cyb[4] = {C.b0, C.b1, C.b2, C.b3};
            if (T.moe_combine) { const float w0 = w0c, w1 = 1.f - w0c;
#pragma unroll
                for (int j = 0; j < 4; ++j) { const v2u a = cya[j], c = cyb[j];
                    yv[j] = (f32x4){w0 * bflo(a.x) + w1 * bflo(c.x), w0 * bfhi(a.x) + w1 * bfhi(c.x), w0 * bflo(a.y) + w1 * bflo(c.y), w0 * bfhi(a.y) + w1 * bfhi(c.y)}; }
            } else {
#pragma unroll
                for (int j = 0; j < 4; ++j) { const v2u a = cya[j]; yv[j] = (f32x4){bflo(a.x), bfhi(a.x), bflo(a.y), bfhi(a.y)}; }
            }
            float ss = 0.f;
#pragma unroll
            for (int j = 0; j < 4; ++j) ss += (yv[j].x * yv[j].x + yv[j].y * yv[j].y) + (yv[j].z * yv[j].z + yv[j].w * yv[j].w);
            const float rs = rsqrtf(wave_sum(ss) * (1.f / D) + EPS);
#pragma unroll
            for (int j = 0; j < 4; ++j) v[j] = v[j] + VU[j] * (yv[j] * rs);
        }
        void* dpv = row < M_LAT ? T.lat_dst_l : T.lat_dst_c;
        if (dpv) { const size_t ro = (size_t)(row < M_LAT ? row : row - M_LAT) * D;
            if (T.dst_f32) { float* dp = (float*)dpv + ro;
#pragma unroll
                for (int j = 0; j < 4; ++j) ((GAS f32x4*)dp)[F.lane + 64 * j] = v[j]; }
            else { bf16* dp = (bf16*)dpv + ro;
#pragma unroll
                for (int j = 0; j < 4; ++j) { v2u o; o.x = pk2(v[j].x, v[j].y); o.y = pk2(v[j].z, v[j].w); ((GAS v2u*)dp)[F.lane + 64 * j] = o; } } }
        if (T.vna) {
            float ss = 0.f;
#pragma unroll
            for (int j = 0; j < 4; ++j) ss += (v[j].x * v[j].x + v[j].y * v[j].y) + (v[j].z * v[j].z + v[j].w * v[j].w);
            const float rs = rsqrtf(wave_sum(ss) * (1.f / D) + EPS);
            f32x4 uu[4];
#pragma unroll
            for (int j = 0; j < 4; ++j) uu[j] = (v[j] * rs) * VA[j] + VB[j];
            int ur = row; if (T.u_perm && row < M_LAT) ur = (row & ~8191) + perm_cm(row & 8191);
            if (T.u_fp8 == 2) { GAS unsigned* up8 = (GAS unsigned*)((unsigned char*)T.u + (size_t)ur * D);
                float mx = 0.f;
#pragma unroll
                for (int j = 0; j < 4; ++j) mx = fmaxf(fmaxf(mx, fmaxf(fabsf(uu[j].x), fabsf(uu[j].y))), fmaxf(fabsf(uu[j].z), fabsf(uu[j].w)));
                mx = wave_max(mx); const float iv = mx > 0.f ? 127.0f / mx : 0.f;
#pragma unroll
                for (int j = 0; j < 4; ++j) { const unsigned q0 = (unsigned)(int)__builtin_rintf(uu[j].x * iv) & 0xffu, q1 = (unsigned)(int)__builtin_rintf(uu[j].y * iv) & 0xffu, q2 = (unsigned)(int)__builtin_rintf(uu[j].z * iv) & 0xffu, q3 = (unsigned)(int)__builtin_rintf(uu[j].w * iv);
                    up8[F.lane + 64 * j] = q0 | (q1 << 8) | (q2 << 16) | (q3 << 24); }
                if (F.lane == 0) T.u_scale[ur] = mx > 0.f ? mx * (1.0f / 127.0f) : 1.0f; }
            else if (T.u_fp8) { GAS unsigned* up8 = (GAS unsigned*)((unsigned char*)T.u + (size_t)ur * D);
#pragma unroll
                for (int j = 0; j < 4; ++j) { unsigned w = 0; w = __builtin_amdgcn_cvt_pk_fp8_f32(uu[j].x, uu[j].y, w, false); w = __builtin_amdgcn_cvt_pk_fp8_f32(uu[j].z, uu[j].w, w, true); up8[F.lane + 64 * j] = w; } }
            else { GAS v2u* up = (GAS v2u*)(T.u + (size_t)ur * D);
#pragma unroll
                for (int j = 0; j < 4; ++j) { v2u o; o.x = pk2(uu[j].x, uu[j].y); o.y = pk2(uu[j].z, uu[j].w); up[F.lane + 64 * j] = o; } }
            if (T.route) {
                float lg[8];
#pragma unroll
                for (int e = 0; e < 8; ++e) lg[e] = 0.f;
#pragma unroll
                for (int j = 0; j < 4; ++j)
#pragma unroll
                    for (int i = 0; i < 4; ++i) { const int c = 4 * (F.lane + 64 * j) + i; const f32x4 wa = *(const LAS f32x4*)(WR + c * 8), wb = *(const LAS f32x4*)(WR + c * 8 + 4); const float x = uu[j][i];
                        lg[0] += x * wa.x; lg[1] += x * wa.y; lg[2] += x * wa.z; lg[3] += x * wa.w; lg[4] += x * wb.x; lg[5] += x * wb.y; lg[6] += x * wb.z; lg[7] += x * wb.w; }
                const float* br = F.in[I_EBR] + T.jr * 8;
#pragma unroll
                for (int e = 0; e < 8; ++e) lg[e] = wave_sum(lg[e]) + br[e];
                int e0 = 0; float v0 = lg[0];
#pragma unroll
                for (int e = 1; e < 8; ++e) if (lg[e] > v0) { v0 = lg[e]; e0 = e; }
                int e1 = -1; float v1 = -3.0e38f;
#pragma unroll
                for (int e = 0; e < 8; ++e) if (e != e0 && lg[e] > v1) { v1 = lg[e]; e1 = e; }
                const float w0 = 1.f / (1.f + __expf(v1 - v0));
                if (F.lane == row - r0) { my_e0 = e0; my_e1 = e1; my_w = w0; }
            }
        }
        if (hn) { C = N; p0n = p0nn; p1n = p1nn; w0c = w0n; w0n = w0nn; }
    }
    if (T.route) {
        const int n = r1 - r0; const bool act = F.lane < n; const int row = r0 + F.lane;
        unsigned* ecnt = (unsigned*)(F.ws + WS_CTL) + CW_ECNT + T.jr * 8 * 64;
        int rk0 = 0, rk1 = 0;
        const unsigned long long ltmask = (F.lane == 0) ? 0ull : (~0ull >> (64 - F.lane));
#pragma unroll
        for (int e = 0; e < 8; ++e) {
            const unsigned long long m0 = __ballot(act && my_e0 == e), m1 = __ballot(act && my_e1 == e);
            const int c0 = __popcll(m0), c1 = __popcll(m1);
            unsigned base = 0;
            if (c0 + c1 > 0) { if (F.lane == 0) base = __hip_atomic_fetch_add(ecnt + e * 64, (unsigned)(c0 + c1), RLX_AGENT); base = __builtin_amdgcn_readfirstlane(base); }
            if (my_e0 == e) rk0 = (int)base + __popcll(m0 & ltmask);
            if (my_e1 == e) rk1 = (int)base + c0 + __popcll(m1 & ltmask);
        }
        if (act) { ((int*)(F.ws + WS_ROUTE + RT_E))[row] = my_e0 | (my_e1 << 8); ((int*)(F.ws + WS_ROUTE + RT_R))[2 * row] = rk0; ((int*)(F.ws + WS_ROUTE + RT_R))[2 * row + 1] = rk1;
            ((float*)(F.ws + WS_ROUTE + RT_W))[row] = my_w; }
    }
}

__device__ __forceinline__ void phase_moe_scatter(Frame& F, int jr, int nrows, const unsigned char* U, unsigned char* AM, int rowb, const float* sa_src, float* sa_dst) {
    const unsigned* ecnt = (const unsigned*)(F.ws + WS_CTL) + CW_ECNT + jr * 8 * 64;
    int base[8]; int acc = 0;
#pragma unroll
    for (int e = 0; e < 8; ++e) { const int c = (int)__hip_atomic_load(ecnt + e * 64, RLX_AGENT); base[e] = acc; acc += (c + 255) & ~255; }
    int* pexp = (int*)(F.ws + WS_SMALL + SM_PEXP);
    if (F.bid == 0) { const int np = acc >> 8;
        for (int p = F.tid; p < np; p += NTHR) { int e = 0;
#pragma unroll
            for (int q = 1; q < 8; ++q) if (p * 256 >= base[q]) e = q;
            pexp[p] = e; }
        if (F.tid == 0) pexp[MOE_PANELS] = np; }
    const int gw = F.bid * NWAVES + F.wave, NGW = F.G * NWAVES;
    const int R = (nrows + NGW - 1) / NGW; const int r0 = gw * R; int r1 = r0 + R; if (r1 > nrows) r1 = nrows;
    int* rr = (int*)(F.ws + WS_ROUTE + RT_R); const int* re = (const int*)(F.ws + WS_ROUTE + RT_E);
    for (int row = r0; row < r1; ++row) {
        const int ee = re[row], e0 = ee & 255, e1 = ee >> 8; int b0 = 0, b1 = 0;
#pragma unroll
        for (int e = 0; e < 8; ++e) { if (e0 == e) b0 = base[e]; if (e1 == e) b1 = base[e]; }
        const int p0 = b0 + rr[2 * row], p1 = b1 + rr[2 * row + 1];
        const v4u* src = (const v4u*)(U + (size_t)row * rowb); v4u* d0 = (v4u*)(AM + (size_t)p0 * rowb); v4u* d1 = (v4u*)(AM + (size_t)p1 * rowb);
        const v4u a = src[F.lane]; d0[F.lane] = a; d1[F.lane] = a;
        if (rowb > 1024) { const v4u c = src[F.lane + 64]; d0[F.lane + 64] = c; d1[F.lane + 64] = c; }
        CFENCE();
        if (F.lane == 0) { rr[2 * row] = p0; rr[2 * row + 1] = p1; if (sa_src) { const float s = sa_src[row]; sa_dst[p0] = s; sa_dst[p1] = s; } }
    }
}

#define MFMA32(a, b, c) __builtin_amdgcn_mfma_f32_32x32x16_bf16((a), (b), (c), 0, 0, 0)
typedef short v4i16_t __attribute__((ext_vector_type(4)));
typedef LAS unsigned char* ldsp;
__device__ __forceinline__ unsigned cvtpk(float lo, float hi) { f32x2_t v = {lo, hi}; bf16x2_t b = __builtin_convertvector(v, bf16x2_t); return __builtin_bit_cast(unsigned, b); }
__device__ __forceinline__ int crow(int reg, int h) { return (reg & 3) + 8 * (reg >> 2) + 4 * h; }
__device__ __forceinline__ bf16x8 pack8(const f32x16& x, int s) {
    v4u p; p.x = cvtpk(x[8 * s], x[8 * s + 1]); p.y = cvtpk(x[8 * s + 2], x[8 * s + 3]); p.z = cvtpk(x[8 * s + 4], x[8 * s + 5]); p.w = cvtpk(x[8 * s + 6], x[8 * s + 7]);
    return __builtin_bit_cast(bf16x8, p);
}
__device__ __forceinline__ bf16x8 lds16(ldsp p) { return *(const LAS bf16x8*)p; }
__device__ __forceinline__ bf16x8 lds8x2(ldsp p) { const s16x4 lo = *(const LAS s16x4*)p, hi = *(const LAS s16x4*)(p + 16); return __builtin_shufflevector(lo, hi, 0, 1, 2, 3, 4, 5, 6, 7); }
__device__ __forceinline__ s16x4 tr16(ldsp p) { return __builtin_bit_cast(s16x4, __builtin_amdgcn_ds_read_tr16_b64_v4i16((LAS v4i16_t*)p)); }
__device__ __forceinline__ bf16x8 ldstr2(ldsp p, int second) { const s16x4 lo = tr16(p), hi = tr16(p + second); return __builtin_shufflevector(lo, hi, 0, 1, 2, 3, 4, 5, 6, 7); }
__device__ __forceinline__ f32x16 zero16() { f32x16 z;
#pragma unroll
    for (int i = 0; i < 16; ++i) z[i] = 0.f; return z; }
__device__ __forceinline__ void unpack8(const v4u& w, float (&x)[8]) { x[0] = bflo(w.x); x[1] = bfhi(w.x); x[2] = bflo(w.y); x[3] = bfhi(w.y); x[4] = bflo(w.z); x[5] = bfhi(w.z); x[6] = bflo(w.w); x[7] = bfhi(w.w); }
__device__ __forceinline__ int launder_v(int x) { asm volatile("" : "+v"(x)); return x; }
struct FragOff { int o_row, o_perm, o_trn, o_trp; };
__device__ __forceinline__ FragOff frag_off(int lane, int LD) {
    const int r = lane & 31, hh = lane >> 5, i16 = lane & 15, q = i16 >> 2, p = i16 & 3, blk = (lane >> 4) & 1; FragOff f;
    f.o_row = (r * LD + 8 * hh) * 2; f.o_perm = (r * LD + 4 * hh) * 2;
    f.o_trn = ((8 * hh + q) * LD + 16 * blk + 4 * p) * 2; f.o_trp = ((4 * hh + q) * LD + 16 * blk + 4 * p) * 2; return f;
}


template <int CTRL, int RM, int BM> __device__ __forceinline__ float dpp_f(float old, float x) {
    return __builtin_bit_cast(float, __builtin_amdgcn_update_dpp(__builtin_bit_cast(int, old), __builtin_bit_cast(int, x), CTRL, RM, BM, false)); }
__device__ __forceinline__ float wave_scan_add(float x) {
    float r = x;
    r += dpp_f<0x111, 0xf, 0xf>(0.f, x); r += dpp_f<0x112, 0xf, 0xf>(0.f, x); r += dpp_f<0x113, 0xf, 0xf>(0.f, x);
    r += dpp_f<0x114, 0xf, 0xe>(0.f, r); r += dpp_f<0x118, 0xf, 0xc>(0.f, r);
    r += dpp_f<0x142, 0xa, 0xf>(0.f, r); r += dpp_f<0x143, 0xc, 0xf>(0.f, r);
    return r;
}
__device__ __forceinline__ float wave_scan_max(float x) {
    const float NEG = -3.0e38f; float r = x;
    r = fmaxf(r, dpp_f<0x111, 0xf, 0xf>(NEG, x)); r = fmaxf(r, dpp_f<0x112, 0xf, 0xf>(NEG, x)); r = fmaxf(r, dpp_f<0x113, 0xf, 0xf>(NEG, x));
    r = fmaxf(r, dpp_f<0x114, 0xf, 0xe>(NEG, r)); r = fmaxf(r, dpp_f<0x118, 0xf, 0xc>(NEG, r));
    r = fmaxf(r, dpp_f<0x142, 0xa, 0xf>(NEG, r)); r = fmaxf(r, dpp_f<0x143, 0xc, 0xf>(NEG, r));
    return r;
}
__device__ __forceinline__ float lane63(float x) { return __builtin_bit_cast(float, __builtin_amdgcn_readlane(__builtin_bit_cast(int, x), 63)); }
__device__ __forceinline__ float sum_halves(float x) {
    const unsigned u = __builtin_bit_cast(unsigned, x); auto rr = __builtin_amdgcn_permlane32_swap(u, u, false, false);
    return __builtin_bit_cast(float, (unsigned)rr[0]) + __builtin_bit_cast(float, (unsigned)rr[1]); }

__device__ __forceinline__ void out16_store(bf16* aout, size_t eoff, const float (&y)[16], float rs, int f8) {
    if (!f8) { v4u w0, w1; w0.x = pk2(y[0] * rs, y[1] * rs); w0.y = pk2(y[2] * rs, y[3] * rs); w0.z = pk2(y[4] * rs, y[5] * rs); w0.w = pk2(y[6] * rs, y[7] * rs);
        w1.x = pk2(y[8] * rs, y[9] * rs); w1.y = pk2(y[10] * rs, y[11] * rs); w1.z = pk2(y[12] * rs, y[13] * rs); w1.w = pk2(y[14] * rs, y[15] * rs);
        *(GAS v4u*)(aout + eoff) = w0; *(GAS v4u*)(aout + eoff + 8) = w1; }
    else { v4u w; unsigned t = 0; t = __builtin_amdgcn_cvt_pk_fp8_f32(y[0] * rs, y[1] * rs, t, false); t = __builtin_amdgcn_cvt_pk_fp8_f32(y[2] * rs, y[3] * rs, t, true); w.x = t;
        t = 0; t = __builtin_amdgcn_cvt_pk_fp8_f32(y[4] * rs, y[5] * rs, t, false); t = __builtin_amdgcn_cvt_pk_fp8_f32(y[6] * rs, y[7] * rs, t, true); w.y = t;
        t = 0; t = __builtin_amdgcn_cvt_pk_fp8_f32(y[8] * rs, y[9] * rs, t, false); t = __builtin_amdgcn_cvt_pk_fp8_f32(y[10] * rs, y[11] * rs, t, true); w.z = t;
        t = 0; t = __builtin_amdgcn_cvt_pk_fp8_f32(y[12] * rs, y[13] * rs, t, false); t = __builtin_amdgcn_cvt_pk_fp8_f32(y[14] * rs, y[15] * rs, t, true); w.w = t;
        *(GAS v4u*)((unsigned char*)aout + eoff) = w; }
}
__device__ __forceinline__ void item_headnorm(int tid, const bf16* hf, const bf16* hb, const bf16* gate, int gpitch, int gcol, const float* gh_head, bf16* aout, int rowbase, int t0, int ntok, int h, int out8) {
    VM_WAIT(); __syncthreads();
    const int sub = tid & 7, rr = tid >> 3;
    float gh[16];
#pragma unroll
    for (int e = 0; e < 16; ++e) gh[e] = gh_head[sub * 16 + e];
#pragma unroll 4
    for (int row = rr; row < ntok; row += 64) {
        const size_t grow = (size_t)(rowbase + t0 + row);
        const size_t o = grow * D + h * 128 + sub * 16;
        const v4u a0 = *(const GAS v4u*)(hf + o), a1 = *(const GAS v4u*)(hf + o + 8), b0 = *(const GAS v4u*)(hb + o), b1 = *(const GAS v4u*)(hb + o + 8);
        const bf16* gp = gate + grow * gpitch + gcol + h * 128 + sub * 16; const v4u g0 = *(const GAS v4u*)gp, g1 = *(const GAS v4u*)(gp + 8);
        float x[16], y[8];
        unpack8(a0, y);
#pragma unroll
        for (int e = 0; e < 8; ++e) x[e] = y[e];
        unpack8(a1, y);
#pragma unroll
        for (int e = 0; e < 8; ++e) x[8 + e] = y[e];
        unpack8(b0, y);
#pragma unroll
        for (int e = 0; e < 8; ++e) x[e] += y[e];
        unpack8(b1, y);
#pragma unroll
        for (int e = 0; e < 8; ++e) x[8 + e] += y[e];
        float ss = 0.f;
#pragma unroll
        for (int e = 0; e < 16; ++e) ss += x[e] * x[e];
        ss += __shfl_xor(ss, 1); ss += __shfl_xor(ss, 2); ss += __shfl_xor(ss, 4);
        const float rs = rsqrtf(ss * (1.f / 128.f) + EPS);
        float o16[16];
        unpack8(g0, y);
#pragma unroll
        for (int e = 0; e < 8; ++e) o16[e] = x[e] * rs * gh[e] * sigmoidf_(y[e]);
        unpack8(g1, y);
#pragma unroll
        for (int e = 0; e < 8; ++e) o16[8 + e] = x[8 + e] * rs * gh[8 + e] * sigmoidf_(y[e]);
        out16_store(aout, o, o16, 1.0f, out8);
    }
}

#ifndef SCAN_PF_OUT
#define SCAN_PF_OUT 1
#endif
constexpr int ML_LDQ = 72, ML_LDV = 136;
constexpr int ML_QC = 0, ML_KC = 9216, ML_KH = 18432, ML_V = 27648, ML_GS = 45056, ML_OB = 50176, ML_NV = 68608, ML_SSQ = 70656, ML_INV = 71680, ML_GROUP = 73728;
static_assert(2 * ML_GROUP <= LDS_MAIN, "mLSTM LDS map");
constexpr int ML_STATE_F = 8448;

struct MlPref { v4u q[2], k[2], v[4]; float gi, gf; };
struct MlSeg { int rowbase; int len; int t0; int nchunk; };

__device__ __forceinline__ void ml_issue(MlPref& P, const bf16* proj, const bf16* qkc, const float* gates, int rowbase, int t0c, int g, int h, int tg, int lane, bool need_q) {
    const int c8q = tg & 7;
#pragma unroll
    for (int i = 0; i < 2; ++i) { const int tau = (tg + 256 * i) >> 3; const int t = t0c + (g ? 63 - tau : tau);
        const bf16* rp = qkc + (size_t)(rowbase + t) * D + h * 64 + c8q * 8;
        P.q[i] = need_q ? *(const GAS v4u*)rp : (v4u){0u, 0u, 0u, 0u}; P.k[i] = *(const GAS v4u*)(rp + 512); }
#pragma unroll
    for (int i = 0; i < 4; ++i) { const int p = tg + 256 * i, tau = p >> 4, c8 = p & 15; const int t = t0c + (g ? 63 - tau : tau);
        P.v[i] = *(const GAS v4u*)(proj + (size_t)(rowbase + t) * NP_M + 1024 + h * 128 + c8 * 8); }
    { const int t = t0c + (g ? 63 - lane : lane); const GAS float* gp = (const GAS float*)(gates + (size_t)(rowbase + t) * 32 + g * 16 + h); P.gi = gp[0]; P.gf = gp[8]; }
}

struct MlFin { v4u pa0, pa1, ga0, ga1; };
__device__ __forceinline__ void ml_issue_fin(MlFin& Fn, const bf16* part, const bf16* proj, int rowbase, int t0c, int tt, int g, int h, int j, int lns) {
    const int tau = 32 * tt + (lns >> 1); const int t = t0c + (g ? 63 - tau : tau); const int col = h * 128 + 32 * j + 16 * (lns & 1);
    const bf16* pp = part + (size_t)(rowbase + t) * D + col; const bf16* gp = proj + (size_t)(rowbase + t) * NP_M + 2048 + col;
    Fn.pa0 = *(const GAS v4u*)pp; Fn.pa1 = *(const GAS v4u*)(pp + 8); Fn.ga0 = *(const GAS v4u*)gp; Fn.ga1 = *(const GAS v4u*)(gp + 8);
}
__device__ __forceinline__ void ml_fin_store(const float (&y)[16], const LAS float* ssq, bf16* aout, size_t eoff, int out8) {
    const f32x4 sq = *(const LAS f32x4*)ssq; const float rs = rsqrtf(((sq[0] + sq[1]) + (sq[2] + sq[3])) * (1.f / 128.f) + EPS);
    out16_store(aout, eoff, y, rs, out8);
}
template <bool OUTPUT>
__device__ __forceinline__ void mlstm_item(Frame& F, const bf16* proj, const bf16* qkc, const float* gates, bf16* hx0, bf16* hx1, bf16* aout, const float* ghead,
                                           int h, MlSeg S0, MlSeg S1, const float* st_in0, const float* st_in1, int npre0, int npre1, float* st_out0, float* st_out1, int out8) {
    const int tid_l = launder_v(F.tid); const int wave_l = __builtin_amdgcn_readfirstlane(tid_l >> 6);
    const int g = wave_l >> 2, j = wave_l & 3, tg = tid_l & 255, lane = tid_l & 63, r = lane & 31, hh = lane >> 5;
    const ldsp gb = F.lds + g * ML_GROUP;
    const ldsp GSb = gb + ML_GS + j * 1280;
    LAS float* GS = (LAS float*)GSb;
    const ldsp OBb = gb + ML_OB + j * 4608;
    LAS float* NV = (LAS float*)(gb + ML_NV);
    LAS float* SSQ = (LAS float*)(gb + ML_SSQ);
    const ldsp INVb = gb + ML_INV + j * 256;
    const int rowbase = g ? S1.rowbase : S0.rowbase, seg_t0 = g ? S1.t0 : S0.t0, nch = g ? S1.nchunk : S0.nchunk;
    const int vcol = 64 * j;
    __syncthreads();
    f32x16 C[2]; C[0] = zero16(); C[1] = zero16();
    float m_prev = -1.0e30f, btot = 0.f;
    float nreg = 0.f;
    if (OUTPUT) {
        const float* sp = g ? st_in1 : st_in0; const int np = g ? npre1 : npre0;
#pragma unroll 1
        for (int k = 0; k < np; ++k) { const float* e = sp + (size_t)k * ML_STATE_F;
            const float mloc = e[8192 + 64], B = e[8192 + 65];
            const float mnew = fmaxf(B + m_prev, mloc), al = __expf(B + m_prev - mnew), be = __expf(mloc - mnew);
            const float* ep = e + (4 * hh) * 128 + 32 * j + r;
#pragma unroll
            for (int dt = 0; dt < 2; ++dt)
#pragma unroll
                for (int i = 0; i < 16; ++i) C[dt][i] = al * C[dt][i] + be * ep[(32 * dt + (i & 3) + 8 * (i >> 2)) * 128];
            nreg = al * nreg + be * e[8192 + 16 * j + (lane & 15)];
            m_prev = mnew; }
    }
    if (lane < 16) NV[16 * j + lane] = nreg;
    LAS float* GH = (LAS float*)(gb + ML_KC);
    if (OUTPUT && tg < 128) GH[tg] = ghead[h * 128 + tg];
    float yv0[16], yv1[16]; bool pend = false; int pend_t = 0; MlFin FN0, FN1; FN0.pa0 = FN0.pa1 = FN0.ga0 = FN0.ga1 = FN1.pa0 = FN1.pa1 = FN1.ga0 = FN1.ga1 = (v4u){0u, 0u, 0u, 0u};
#pragma unroll
    for (int e = 0; e < 16; ++e) { yv0[e] = 0.f; yv1[e] = 0.f; }
    const int hmid = nch >> 1;
    constexpr int NPF = OUTPUT ? SCAN_PF_OUT : 2;
    MlPref PP[NPF]; ml_issue(PP[0], proj, qkc, gates, rowbase, seg_t0 + 64 * (g ? nch - 1 : 0), g, h, tg, lane, OUTPUT);
    if (NPF == 2) ml_issue(PP[NPF - 1], proj, qkc, gates, rowbase, seg_t0 + 64 * (g ? nch - 2 : 1), g, h, tg, lane, OUTPUT);
    __syncthreads();
#pragma unroll 1
    for (int step2 = 0; step2 < nch; step2 += NPF) {
#pragma unroll
    for (int hf = 0; hf < NPF; ++hf) { const int step = step2 + hf; MlPref& P = PP[hf];
        const int tgs = launder_v(tg), lns = launder_v(lane);
        const int r = lns & 31, hh = lns >> 5;
        const FragOff fq = frag_off(lns, ML_LDQ), fv = frag_off(lns, ML_LDV);
        const int o_h4 = 16 * hh;
        const int o_obw = (4 * hh * 36 + r) * 4, o_obr = ((lns >> 1) * 36 + 16 * (lns & 1)) * 4;
        const int ci = g ? nch - 1 - step : step;
        const int par = step & 1;
        if (OUTPUT && pend) {
            const int tl = lns >> 1; const size_t ob = (size_t)rowbase * D + h * 128 + 32 * j + 16 * (lns & 1);
            ml_fin_store(yv0, SSQ + 4 * tl, aout, ob + (size_t)(pend_t + (g ? 63 - tl : tl)) * D, out8);
            ml_fin_store(yv1, SSQ + 128 + 4 * tl, aout, ob + (size_t)(pend_t + (g ? 31 - tl : 32 + tl)) * D, out8); pend = false; }
        float decay;
        {
            const float xi = P.gi, lf = P.gf;
            const float bc = wave_scan_add(lf);
            const float a = xi - bc; const float pm = wave_scan_max(a);
            const float Mt = fmaxf(m_prev, pm);
            const float Ml = lane63(Mt), bl = lane63(bc);
            GS[lns] = __expf(fminf(Ml - Mt, 80.f)); GS[192 + lns] = __expf(-(bc + Mt)); GS[256 + lns] = __expf(a - Ml);
            decay = __expf(m_prev - Ml); m_prev = bl + Ml; btot += bl;
        }
        LDS_WAIT(); CFENCE();
        {
            const int c8 = tgs & 7;
#pragma unroll
            for (int i = 0; i < 2; ++i) { const int tau = (tgs + 256 * i) >> 3; const ldsp tp = gb + (tau * ML_LDQ + c8 * 8) * 2; float o[8]; v4u w;
                if (OUTPUT) { unpack8(P.q[i], o); const float qs = GS[tau];
                    w.x = pk2(o[0] * qs, o[1] * qs); w.y = pk2(o[2] * qs, o[3] * qs); w.z = pk2(o[4] * qs, o[5] * qs); w.w = pk2(o[6] * qs, o[7] * qs); *(LAS v4u*)(tp + ML_QC) = w; }
                unpack8(P.k[i], o); const float wkk = GS[256 + tau];
                w.x = pk2(o[0] * wkk, o[1] * wkk); w.y = pk2(o[2] * wkk, o[3] * wkk); w.z = pk2(o[4] * wkk, o[5] * wkk); w.w = pk2(o[6] * wkk, o[7] * wkk);
                *(LAS v4u*)(tp + ML_KH) = w; }
#pragma unroll
            for (int i = 0; i < 4; ++i) { const int p = tgs + 256 * i, tau = p >> 4, cc = p & 15; *(LAS v4u*)(gb + ML_V + (tau * ML_LDV + cc * 8) * 2) = P.v[i]; }
        }
        if (OUTPUT) VM_WAIT();
        __syncthreads();
        if (step + NPF < nch) ml_issue(P, proj, qkc, gates, rowbase, seg_t0 + 64 * (g ? nch - 1 - NPF - step : step + NPF), g, h, tgs, lns, OUTPUT);
        const bool fin = OUTPUT && step > hmid;
#pragma unroll
        for (int dt = 0; dt < 2; ++dt)
#pragma unroll
            for (int i = 0; i < 16; ++i) C[dt][i] *= decay;
        if (OUTPUT) {
            bf16* hx = g ? hx1 : hx0;
#pragma unroll
            for (int tt = 0; tt < 2; ++tt) {
                f32x16 acc = zero16();
#pragma unroll
                for (int dt = 0; dt < 2; ++dt)
#pragma unroll
                    for (int sp = 0; sp < 2; ++sp) acc = MFMA32(lds8x2(gb + ML_QC + fq.o_perm + (32 * tt * ML_LDQ + 32 * dt + 16 * sp) * 2), pack8(C[dt], sp), acc);
                float den = 0.f;
#pragma unroll
                for (int st = 0; st <= tt; ++st) {
                    f32x16 s = zero16();
#pragma unroll
                    for (int ks = 0; ks < 4; ++ks) s = MFMA32(lds16(gb + ML_KH + fq.o_row + (32 * st * ML_LDQ + 16 * ks) * 2), lds16(gb + ML_QC + fq.o_row + (32 * tt * ML_LDQ + 16 * ks) * 2), s);
#pragma unroll
                    for (int i = 0; i < 16; ++i) { const float pv = (st < tt || crow(i, hh) <= r) ? s[i] : 0.f; s[i] = pv; den += pv; }
                    const bf16x8 pa0 = pack8(s, 0), pa1 = pack8(s, 1);
                    acc = MFMA32(pa0, ldstr2(gb + ML_V + fv.o_trp + vcol + ((32 * st) * ML_LDV) * 2, 8 * ML_LDV * 2), acc);
                    acc = MFMA32(pa1, ldstr2(gb + ML_V + fv.o_trp + vcol + ((32 * st + 16) * ML_LDV) * 2, 8 * ML_LDV * 2), acc);
                    }
                float qn;
                { float q0 = 0.f, q1 = 0.f, q2 = 0.f, q3 = 0.f;
#pragma unroll
                for (int c4 = 0; c4 < 4; ++c4) { const v4u qw = *(const LAS v4u*)(gb + ML_QC + (r * ML_LDQ + 32 * hh) * 2 + (32 * tt * ML_LDQ + 8 * c4) * 2); float qx[8]; unpack8(qw, qx);
                    const f32x4 n0 = *(const LAS f32x4*)(gb + ML_NV + 8 * o_h4 + (par * 64 + 8 * c4) * 4), n1 = *(const LAS f32x4*)(gb + ML_NV + 8 * o_h4 + (par * 64 + 8 * c4 + 4) * 4);
                    q0 += qx[0] * n0[0] + qx[4] * n1[0]; q1 += qx[1] * n0[1] + qx[5] * n1[1]; q2 += qx[2] * n0[2] + qx[6] * n1[2]; q3 += qx[3] * n0[3] + qx[7] * n1[3]; }
                qn = (q0 + q1) + (q2 + q3); }
                den = sum_halves(den); qn = sum_halves(qn);
                const float dtot = den + decay * qn;
                const float inv = __builtin_amdgcn_rcpf(fmaxf(fabsf(dtot), GS[192 + 32 * tt + r]));
                if (hh == 0) *(LAS float*)(INVb + (32 * tt + r) * 4) = inv;
                LDS_WAIT(); CFENCE();
                f32x16 hv;
#pragma unroll
                for (int q4 = 0; q4 < 4; ++q4) { const f32x4 iv = *(const LAS f32x4*)(INVb + o_h4 + (32 * tt + 8 * q4) * 4);
#pragma unroll
                    for (int e = 0; e < 4; ++e) { const int i = 4 * q4 + e; hv[i] = acc[i] * iv[e]; } }
#pragma unroll
                for (int i = 0; i < 16; ++i) *(LAS float*)(OBb + o_obw + ((i & 3) + 8 * (i >> 2)) * 144) = hv[i];
                LDS_WAIT(); CFENCE();
                { const f32x4 x0 = *(const LAS f32x4*)(OBb + o_obr), x1 = *(const LAS f32x4*)(OBb + o_obr + 16), x2 = *(const LAS f32x4*)(OBb + o_obr + 32), x3 = *(const LAS f32x4*)(OBb + o_obr + 48);
                    const int tau = 32 * tt + (lns >> 1); const int t = seg_t0 + 64 * ci + (g ? 63 - tau : tau);
                    bf16* op = hx + (size_t)(rowbase + t) * D + h * 128 + 32 * j + 16 * (lns & 1);
                    if (!fin) { v4u w0, w1; w0.x = pk2(x0[0], x0[1]); w0.y = pk2(x0[2], x0[3]); w0.z = pk2(x1[0], x1[1]); w0.w = pk2(x1[2], x1[3]); w1.x = pk2(x2[0], x2[1]); w1.y = pk2(x2[2], x2[3]); w1.z = pk2(x3[0], x3[1]); w1.w = pk2(x3[2], x3[3]);
                        *(GAS v4u*)op = w0; *(GAS v4u*)(op + 8) = w1; }
                    else { float pp[8], gg[8], xs[16]; const MlFin& FC = tt ? FN1 : FN0; float (&yv)[16] = tt ? yv1 : yv0;
                        unpack8(FC.pa0, pp);
#pragma unroll
                        for (int e = 0; e < 4; ++e) { xs[e] = x0[e] + pp[e]; xs[4 + e] = x1[e] + pp[4 + e]; }
                        unpack8(FC.pa1, pp);
#pragma unroll
                        for (int e = 0; e < 4; ++e) { xs[8 + e] = x2[e] + pp[e]; xs[12 + e] = x3[e] + pp[4 + e]; }
                        float ss = 0.f;
#pragma unroll
                        for (int e = 0; e < 16; ++e) ss += xs[e] * xs[e];
                        ss += __shfl_xor(ss, 1);
                        if ((lns & 1) == 0) SSQ[128 * tt + 4 * (lns >> 1) + j] = ss;
                        const LAS float* ghp = GH + 32 * j + 16 * (lns & 1);
                        unpack8(FC.ga0, gg);
#pragma unroll
                        for (int e = 0; e < 8; ++e) yv[e] = xs[e] * ghp[e] * sigmoidf_(gg[e]);
                        unpack8(FC.ga1, gg);
#pragma unroll
                        for (int e = 0; e < 8; ++e) yv[8 + e] = xs[8 + e] * ghp[8 + e] * sigmoidf_(gg[e]); } }
                LDS_WAIT(); CFENCE();
            }
            if (fin) { pend = true; pend_t = seg_t0 + 64 * ci; }
            if (step + 1 > hmid && step + 1 < nch) { const int t0n = seg_t0 + 64 * (g ? nch - 2 - step : step + 1);
                ml_issue_fin(FN0, g ? hx0 : hx1, proj, rowbase, t0n, 0, g, h, j, lns); ml_issue_fin(FN1, g ? hx0 : hx1, proj, rowbase, t0n, 1, g, h, j, lns); }
        }
        __builtin_amdgcn_sched_barrier(0);
#pragma unroll
        for (int dt = 0; dt < 2; ++dt)
#pragma unroll
            for (int ks = 0; ks < 4; ++ks) C[dt] = MFMA32(ldstr2(gb + ML_KH + fq.o_trn + (16 * ks * ML_LDQ + 32 * dt) * 2, 4 * ML_LDQ * 2), ldstr2(gb + ML_V + fv.o_trn + vcol + (16 * ks * ML_LDV) * 2, 4 * ML_LDV * 2), C[dt]);
        {   const int dkl = 16 * j + (lns & 15), tq = lns >> 4; float s0 = 0.f, s1 = 0.f;
#pragma unroll
            for (int i = 0; i < 16; i += 2) { s0 += bf2f(*(const LAS bf16*)(gb + ML_KH + ((16 * tq + i) * ML_LDQ + dkl) * 2)); s1 += bf2f(*(const LAS bf16*)(gb + ML_KH + ((16 * tq + i + 1) * ML_LDQ + dkl) * 2)); }
            float sacc = s0 + s1; sacc += __shfl_xor(sacc, 16); sacc = sum_halves(sacc);
            nreg = decay * nreg + sacc; if (lns < 16) NV[(par ^ 1) * 64 + dkl] = nreg; }
        __syncthreads();
    } }
    if (OUTPUT) {
        if (pend) { const int lns = launder_v(lane); const int tl = lns >> 1; const size_t ob = (size_t)rowbase * D + h * 128 + 32 * j + 16 * (lns & 1);
            ml_fin_store(yv0, SSQ + 4 * tl, aout, ob + (size_t)(pend_t + (g ? 63 - tl : tl)) * D, out8);
            ml_fin_store(yv1, SSQ + 128 + 4 * tl, aout, ob + (size_t)(pend_t + (g ? 31 - tl : 32 + tl)) * D, out8); }
        item_headnorm(launder_v(tid_l), hx0, hx1, proj, NP_M, 2048, ghead + h * 128, aout, S0.rowbase, S0.t0 + 64 * ((S0.nchunk >> 1) - 1), 128, h, out8); }
    if (!OUTPUT) {
        float* e = g ? st_out1 : st_out0; float* ep = e + (4 * hh) * 128 + 32 * j + r;
#pragma unroll
        for (int dt = 0; dt < 2; ++dt)
#pragma unroll
            for (int i = 0; i < 16; ++i) ep[(32 * dt + (i & 3) + 8 * (i >> 2)) * 128] = C[dt][i];
        if (lane < 16) e[8192 + 16 * j + lane] = nreg;
        if (j == 0 && lane == 0) { e[8192 + 64] = m_prev; e[8192 + 65] = btot; }
    }
}

constexpr int MS_KH = 0, MS_V = 9216, MS_BUF = 26624, MS_W = 2 * MS_BUF  ;
static_assert(MS_W + 34 * 64 * 4 <= ML_GROUP, "mLSTM S1 LDS map");
struct MsPref { v4u k[2], v[4]; };
__device__ __forceinline__ void ms_issue(MsPref& P, const bf16* proj, const bf16* qkc, int rowbase, int t0c, int g, int h, int tg) {
    const int c8q = tg & 7;
#pragma unroll
    for (int i = 0; i < 2; ++i) { const int tau = (tg + 256 * i) >> 3; const int t = t0c + (g ? 63 - tau : tau);
        P.k[i] = *(const GAS v4u*)(qkc + (size_t)(rowbase + t) * D + 512 + h * 64 + c8q * 8); }
#pragma unroll
    for (int i = 0; i < 4; ++i) { const int p = tg + 256 * i, tau = p >> 4, c8 = p & 15; const int t = t0c + (g ? 63 - tau : tau);
        P.v[i] = *(const GAS v4u*)(proj + (size_t)(rowbase + t) * NP_M + 1024 + h * 128 + c8 * 8); }
}
__device__ __forceinline__ void mlstm_s1_item(Frame& F, const bf16* proj, const bf16* qkc, const float* gates, int h, MlSeg S0, MlSeg S1, float* st_out0, float* st_out1) {
    const int tid_l = launder_v(F.tid); const int wave_l = __builtin_amdgcn_readfirstlane(tid_l >> 6);
    const int g = wave_l >> 2, j = wave_l & 3, tg = tid_l & 255, lane = tid_l & 63, r = lane & 31, hh = lane >> 5;
    const ldsp gb = F.lds + g * ML_GROUP;
    LAS float* W = (LAS float*)(gb + MS_W);
    const int rowbase = g ? S1.rowbase : S0.rowbase, seg_t0 = g ? S1.t0 : S0.t0, nch = g ? S1.nchunk : S0.nchunk;
    __syncthreads();
    MsPref PP[2]; ms_issue(PP[0], proj, qkc, rowbase, seg_t0 + 64 * (g ? nch - 1 : 0), g, h, tg);
    ms_issue(PP[1], proj, qkc, rowbase, seg_t0 + 64 * (g ? nch - 2 : 1), g, h, tg);
    float m_loc, btot;
    {
        float carry = 0.f, mx = -3.0e38f;
#pragma unroll 1
        for (int c = 0; c < nch; ++c) { const int ci = g ? nch - 1 - c : c; const int t = seg_t0 + 64 * ci + (g ? 63 - lane : lane);
            const GAS float* gp = (const GAS float*)(gates + (size_t)(rowbase + t) * 32 + g * 16 + h); const float xi = gp[0], lf = gp[8];
            const float bc = carry + wave_scan_add(lf); const float a = xi - bc;
            if (j == 0) W[64 * c + lane] = a;
            mx = fmaxf(mx, a); carry = lane63(bc); }
        mx = fmaxf(mx, __shfl_xor(mx, 1)); mx = fmaxf(mx, __shfl_xor(mx, 2)); mx = fmaxf(mx, __shfl_xor(mx, 4)); mx = fmaxf(mx, __shfl_xor(mx, 8)); mx = fmaxf(mx, __shfl_xor(mx, 16)); mx = fmaxf(mx, __shfl_xor(mx, 32));
        btot = carry; m_loc = btot + mx;
        __syncthreads();
        for (int s = tg; s < 64 * nch; s += 256) W[s] = __expf(W[s] - mx);
    }
    f32x16 C[2]; C[0] = zero16(); C[1] = zero16(); float nreg = 0.f;
    __syncthreads();
#pragma unroll 1
    for (int step2 = 0; step2 < nch; step2 += 2) {
#pragma unroll
    for (int hf = 0; hf < 2; ++hf) { const int step = step2 + hf; MsPref& P = PP[hf];
        const int tgs = launder_v(tg), lns = launder_v(lane);
        const FragOff fq = frag_off(lns, ML_LDQ), fv = frag_off(lns, ML_LDV);
        const ldsp bb = gb + hf * MS_BUF;
        {   const int c8 = tgs & 7;
#pragma unroll
            for (int i = 0; i < 2; ++i) { const int tau = (tgs + 256 * i) >> 3; float o[8]; unpack8(P.k[i], o); const float wkk = W[64 * step + tau]; v4u w;
                w.x = pk2(o[0] * wkk, o[1] * wkk); w.y = pk2(o[2] * wkk, o[3] * wkk); w.z = pk2(o[4] * wkk, o[5] * wkk); w.w = pk2(o[6] * wkk, o[7] * wkk);
                *(LAS v4u*)(bb + MS_KH + (tau * ML_LDQ + c8 * 8) * 2) = w; }
#pragma unroll
            for (int i = 0; i < 4; ++i) { const int p = tgs + 256 * i, tau = p >> 4, cc = p & 15; *(LAS v4u*)(bb + MS_V + (tau * ML_LDV + cc * 8) * 2) = P.v[i]; }
        }
        if (step + 2 < nch) ms_issue(P, proj, qkc, rowbase, seg_t0 + 64 * (g ? nch - 3 - step : step + 2), g, h, tgs);
        __syncthreads();
#pragma unroll
        for (int dt = 0; dt < 2; ++dt)
#pragma unroll
            for (int ks = 0; ks < 4; ++ks) C[dt] = MFMA32(ldstr2(bb + MS_KH + fq.o_trn + (16 * ks * ML_LDQ + 32 * dt) * 2, 4 * ML_LDQ * 2), ldstr2(bb + MS_V + fv.o_trn + 64 * j + (16 * ks * ML_LDV) * 2, 4 * ML_LDV * 2), C[dt]);
        {   const int dkl = 16 * j + (lns & 15), tq = lns >> 4; float s0 = 0.f, s1 = 0.f;
#pragma unroll
            for (int i = 0; i < 16; i += 2) { s0 += bf2f(*(const LAS bf16*)(bb + MS_KH + ((16 * tq + i) * ML_LDQ + dkl) * 2)); s1 += bf2f(*(const LAS bf16*)(bb + MS_KH + ((16 * tq + i + 1) * ML_LDQ + dkl) * 2)); }
            float sacc = s0 + s1; sacc += __shfl_xor(sacc, 16); sacc = sum_halves(sacc); nreg += sacc; }
    } }
    float* e = g ? st_out1 : st_out0; float* ep = e + (4 * hh) * 128 + 32 * j + r;
#pragma unroll
    for (int dt = 0; dt < 2; ++dt)
#pragma unroll
        for (int i = 0; i < 16; ++i) ep[(32 * dt + (i & 3) + 8 * (i >> 2)) * 128] = C[dt][i];
    if (lane < 16) e[8192 + 16 * j + lane] = nreg;
    if (j == 0 && lane == 0) { e[8192 + 64] = m_loc; e[8192 + 65] = btot; }
}

constexpr int HG_LD = 136;
constexpr int HG_LF = 0, HG_QT = 16384, HG_KT = 25088, HG_KH = 33792, HG_V = 42496, HG_OB = 51200, HG_AUX = 69632, HG_SSQ = 71168, HG_EAM = 71680, HG_BIAS = 72192, HG_LBV = 72704, HG_GROUP = 73728;
static_assert(2 * HG_GROUP <= LDS_MAIN, "HGRN2 LDS map");
constexpr int HG_STATE_F = 16512;

struct HgPref { unsigned q[8], f[8]; v4u v[2]; };
__device__ __forceinline__ void hg_issue(HgPref& P, const bf16* proj, int rowbase, int t0c, int g, int h, int tg, bool need_q) {
    const int lane = tg & 63, j = tg >> 6, cp = lane & 15, tq = lane >> 4, c0 = 32 * j + 2 * cp;
#pragma unroll
    for (int i = 0; i < 8; ++i) { const int tau = 8 * tq + i; const int t = t0c + (g ? 31 - tau : tau);
        const bf16* rp = proj + (size_t)(rowbase + t) * NP_H + h * 128 + c0;
        P.q[i] = need_q ? *(const GAS unsigned*)rp : 0u; P.f[i] = *(const GAS unsigned*)(rp + 2048 + 1024 * g); }
#pragma unroll
    for (int i = 0; i < 2; ++i) { const int p = tg + 256 * i, tau = p >> 4, c8 = p & 15; const int t = t0c + (g ? 31 - tau : tau);
        P.v[i] = *(const GAS v4u*)(proj + (size_t)(rowbase + t) * NP_H + 1024 + h * 128 + c8 * 8); }
}
struct HgFin { v4u pa0, pa1, ga0, ga1; };
__device__ __forceinline__ void hg_issue_fin(HgFin& Fn, const bf16* part, const bf16* proj, int rowbase, int t0c, int g, int h, int j, int lns) {
    const int tau = lns >> 1; const int t = t0c + (g ? 31 - tau : tau); const int col = h * 128 + 32 * j + 16 * (lns & 1);
    const bf16* pp = part + (size_t)(rowbase + t) * D + col; const bf16* gp = proj + (size_t)(rowbase + t) * NP_H + 4096 + col;
    Fn.pa0 = *(const GAS v4u*)pp; Fn.pa1 = *(const GAS v4u*)(pp + 8); Fn.ga0 = *(const GAS v4u*)gp; Fn.ga1 = *(const GAS v4u*)(gp + 8);
}
__device__ __forceinline__ float clamp80(float x) { return fminf(fmaxf(x, -80.f), 80.f); }

template <bool OUTPUT>
__device__ __forceinline__ void hgrn_item(Frame& F, const bf16* proj, bf16* hx0, bf16* hx1, bf16* aout, const float* ghead, const float* bf_, const float* lbraw, int jl,
                                          int h, MlSeg S0, MlSeg S1, const float* st_in0, const float* st_in1, int npre0, int npre1, float* st_out0, float* st_out1, int out8) {
    const int tid_l = launder_v(F.tid); const int wave_l = __builtin_amdgcn_readfirstlane(tid_l >> 6);
    const int g = wave_l >> 2, j = wave_l & 3, tg = tid_l & 255, lane = tid_l & 63, r = lane & 31, hh = lane >> 5;
#ifdef SUBT
    unsigned long long _st = 0;
#define ST_MARK(slot) do { if (OUTPUT && tid_l == SUBT_TID) { const unsigned long long _n = wall_clock64(); volatile LAS unsigned* _w = (volatile LAS unsigned*)(F.lds + LDSCTL_OFF) + 40 + (slot); _w[0] += (unsigned)(_n - _st); _st = _n; } } while (0)
#else
#define ST_MARK(slot) do { } while (0)
#endif
    ST_MARK(7);
    const ldsp gb = F.lds + g * HG_GROUP;
    LAS float* LF = (LAS float*)(gb + HG_LF);
    const ldsp OBb = gb + HG_OB + j * 4608;
    LAS float* AMID = (LAS float*)(gb + HG_AUX); LAS float* ALAST = AMID + 128; LAS float* DEC = AMID + 256;
    LAS float* SSQ = (LAS float*)(gb + HG_SSQ); LAS float* EAM = (LAS float*)(gb + HG_EAM); LAS float* BIASV = (LAS float*)(gb + HG_BIAS); LAS float* LBV = (LAS float*)(gb + HG_LBV);
    const int rowbase = g ? S1.rowbase : S0.rowbase, seg_t0 = g ? S1.t0 : S0.t0, nch = g ? S1.nchunk : S0.nchunk;
    const int vcol = 64 * j;
    __syncthreads();
    if (OUTPUT && tg < 128) EAM[tg] = ghead[h * 128 + tg];
    if (tg < 128) { const int c = h * 128 + tg; BIASV[tg] = -1.44269504f * bf_[g * 1024 + c]; LBV[tg] = jl == 0 ? 0.f : sigmoidf_(lbraw[(1 * 2 + g) * 1024 + c] - lbraw[(0 * 2 + g) * 1024 + c]); }
    f32x16 St[4];
#pragma unroll
    for (int dt = 0; dt < 4; ++dt) St[dt] = zero16();
    float atot0 = 0.f, atot1 = 0.f;
    if (OUTPUT) {   const float* sp = g ? st_in1 : st_in0; const int np = g ? npre1 : npre0;
#pragma unroll 1
        for (int k = 0; k < np; ++k) { const float* e = sp + (size_t)k * HG_STATE_F; const float* ep = e + (4 * hh) * 128 + 32 * j + r; const float* ap = e + 16384 + 4 * hh;
#pragma unroll
            for (int dt = 0; dt < 4; ++dt)
#pragma unroll
                for (int i = 0; i < 16; ++i) { const int dk0 = 32 * dt + (i & 3) + 8 * (i >> 2); St[dt][i] = __builtin_amdgcn_exp2f(ap[dk0]) * St[dt][i] + ep[dk0 * 128]; } }
    }
    constexpr int NPF = OUTPUT ? SCAN_PF_OUT : 2;
    HgPref PP[NPF]; hg_issue(PP[0], proj, rowbase, seg_t0 + 32 * (g ? nch - 1 : 0), g, h, tg, OUTPUT);
    if (NPF == 2) hg_issue(PP[NPF - 1], proj, rowbase, seg_t0 + 32 * (g ? nch - 2 : 1), g, h, tg, OUTPUT);
    __syncthreads();
    ST_MARK(4);
    float yv[16]; bool pend = false; int pend_t = 0; HgFin FN; FN.pa0 = FN.pa1 = FN.ga0 = FN.ga1 = (v4u){0u, 0u, 0u, 0u};
#pragma unroll
    for (int e = 0; e < 16; ++e) yv[e] = 0.f;
    const int hmid = nch >> 1;
#pragma unroll 1
    for (int step2 = 0; step2 < nch; step2 += NPF) {
#pragma unroll
    for (int hf = 0; hf < NPF; ++hf) { const int step = step2 + hf; HgPref& P = PP[hf];
        const int tgs = launder_v(tg), lns = launder_v(lane);
        const int r = lns & 31, hh = lns >> 5;
        const FragOff fo = frag_off(lns, HG_LD);
        const int o_h4 = 16 * hh;
        const int o_obw = (4 * hh * 36 + r) * 4, o_obr = ((lns >> 1) * 36 + 16 * (lns & 1)) * 4;
        const int ci = g ? nch - 1 - step : step;
        ST_MARK(7);
        if (OUTPUT && pend) {
            const f32x4 sq = *(const LAS f32x4*)(SSQ + 4 * (lns >> 1)); const float rs = rsqrtf(((sq[0] + sq[1]) + (sq[2] + sq[3])) * (1.f / 128.f) + EPS);
            out16_store(aout, (size_t)(rowbase + pend_t + (g ? 31 - (lns >> 1) : (lns >> 1))) * D + h * 128 + 32 * j + 16 * (lns & 1), yv, rs, out8); pend = false; }
        {
            const int cp = lns & 15, tq = lns >> 4, c0 = 32 * j + 2 * cp;
            const f32x2_t bb = *(const LAS f32x2_t*)(BIASV + c0), ll = *(const LAS f32x2_t*)(LBV + c0);
            const float ol0 = 1.f - ll.x, ol1 = 1.f - ll.y;
            float F0[8], F1[8], f0v[8], f1v[8]; float p0 = 1.f, p1 = 1.f;
#pragma unroll
            for (int i = 0; i < 8; ++i) { const float s0 = __builtin_amdgcn_rcpf(1.f + __builtin_amdgcn_exp2f(__builtin_fmaf(bflo(P.f[i]), -1.44269504f, bb.x))), s1 = __builtin_amdgcn_rcpf(1.f + __builtin_amdgcn_exp2f(__builtin_fmaf(bfhi(P.f[i]), -1.44269504f, bb.y)));
                const float f0 = fmaxf(__builtin_fmaf(ol0, s0, ll.x), 3.0517578125e-5f), f1 = fmaxf(__builtin_fmaf(ol1, s1, ll.y), 3.0517578125e-5f);
                p0 *= f0; p1 *= f1; F0[i] = p0; F1[i] = p1; f0v[i] = f0; f1v[i] = f1; }
            const float r0 = __builtin_amdgcn_logf(p0), r1 = __builtin_amdgcn_logf(p1);
            LAS f32x2_t* XT = (LAS f32x2_t*)(gb + HG_LF + j * 512);
            XT[tq * 16 + cp] = (f32x2_t){r0, r1};
            LDS_WAIT(); CFENCE();
            const f32x2_t t0 = XT[cp], t1 = XT[16 + cp], t2 = XT[32 + cp], t3 = XT[48 + cp];
            LDS_WAIT(); CFENCE();
            const float al0 = (t0.x + t1.x) + (t2.x + t3.x), al1 = (t0.y + t1.y) + (t2.y + t3.y);
            const float pre0 = (tq > 0 ? t0.x : 0.f) + (tq > 1 ? t1.x : 0.f) + (tq > 2 ? t2.x : 0.f), pre1 = (tq > 0 ? t0.y : 0.f) + (tq > 1 ? t1.y : 0.f) + (tq > 2 ? t2.y : 0.f);
            if (tq == 0) { *(LAS f32x2_t*)(DEC + c0) = (f32x2_t){__builtin_amdgcn_exp2f(al0), __builtin_amdgcn_exp2f(al1)}; atot0 += al0; atot1 += al1; }
            const float G0 = OUTPUT ? __builtin_amdgcn_exp2f(fminf(pre0 - al0, 115.f)) : 0.f, G1 = OUTPUT ? __builtin_amdgcn_exp2f(fminf(pre1 - al1, 115.f)) : 0.f;
            float h0 = __builtin_amdgcn_exp2f(al0 - pre0 - r0), h1 = __builtin_amdgcn_exp2f(al1 - pre1 - r1);
#pragma unroll
            for (int i = 7; i >= 0; --i) { const int tau = 8 * tq + i; const ldsp tp = gb + (tau * HG_LD + c0) * 2;
                if (OUTPUT) *(LAS unsigned*)(tp + HG_QT) = pk2(bflo(P.q[i]) * (F0[i] * G0), bfhi(P.q[i]) * (F1[i] * G1));
                *(LAS unsigned*)(tp + HG_KH) = pk2((1.f - f0v[i]) * h0, (1.f - f1v[i]) * h1);
                h0 *= f0v[i]; h1 *= f1v[i]; }
#pragma unroll
            for (int i = 0; i < 2; ++i) { const int p = tgs + 256 * i; *(LAS v4u*)(gb + HG_V + ((p >> 4) * HG_LD + (p & 15) * 8) * 2) = P.v[i]; }
        }
        ST_MARK(0);
        if (OUTPUT) VM_WAIT();
        __syncthreads();
        ST_MARK(1);
        if (step + NPF < nch) hg_issue(P, proj, rowbase, seg_t0 + 32 * (g ? nch - 1 - NPF - step : step + NPF), g, h, tgs, OUTPUT);
        const bool fin = OUTPUT && step > hmid;
        {   f32x4 dvv[16];
#pragma unroll
            for (int dt = 0; dt < 4; ++dt)
#pragma unroll
                for (int q4 = 0; q4 < 4; ++q4) dvv[4 * dt + q4] = *(const LAS f32x4*)(gb + HG_AUX + 1024 + o_h4 + (32 * dt + 8 * q4) * 4);
            __builtin_amdgcn_sched_barrier(0);
#pragma unroll
            for (int dt = 0; dt < 4; ++dt)
#pragma unroll
                for (int q4 = 0; q4 < 4; ++q4)
#pragma unroll
                    for (int e = 0; e < 4; ++e) St[dt][4 * q4 + e] *= dvv[4 * dt + q4][e]; }
        if (OUTPUT) {
            bf16* hx = g ? hx1 : hx0;
            f32x16 s = zero16(), o = zero16();
            {   bf16x8 ka[8], qa[8];
#pragma unroll
                for (int ks = 0; ks < 8; ++ks) { ka[ks] = lds16(gb + HG_KH + fo.o_row + 32 * ks); qa[ks] = lds16(gb + HG_QT + fo.o_row + 32 * ks); }
                __builtin_amdgcn_sched_barrier(0);
#pragma unroll
                for (int ks = 0; ks < 8; ++ks) s = MFMA32(ka[ks], qa[ks], s); }
            {   bf16x8 qp[8];
#pragma unroll
                for (int dt = 0; dt < 4; ++dt)
#pragma unroll
                    for (int sp = 0; sp < 2; ++sp) qp[2 * dt + sp] = lds8x2(gb + HG_QT + fo.o_perm + (32 * dt + 16 * sp) * 2);
                const bf16x8 v0 = ldstr2(gb + HG_V + fo.o_trp + vcol, 8 * HG_LD * 2), v1 = ldstr2(gb + HG_V + fo.o_trp + vcol + (16 * HG_LD) * 2, 8 * HG_LD * 2);
                __builtin_amdgcn_sched_barrier(0);
#pragma unroll
                for (int dt = 0; dt < 4; ++dt)
#pragma unroll
                    for (int sp = 0; sp < 2; ++sp) o = MFMA32(qp[2 * dt + sp], pack8(St[dt], sp), o);
#pragma unroll
                for (int i = 0; i < 16; ++i) s[i] = (crow(i, hh) <= r) ? s[i] : 0.f;
                o = MFMA32(pack8(s, 0), v0, o); o = MFMA32(pack8(s, 1), v1, o); }
#pragma unroll
            for (int i = 0; i < 16; ++i) *(LAS float*)(OBb + o_obw + ((i & 3) + 8 * (i >> 2)) * 144) = o[i];
            LDS_WAIT(); CFENCE();
            { const f32x4 x0 = *(const LAS f32x4*)(OBb + o_obr), x1 = *(const LAS f32x4*)(OBb + o_obr + 16), x2 = *(const LAS f32x4*)(OBb + o_obr + 32), x3 = *(const LAS f32x4*)(OBb + o_obr + 48);
                const int tau = lns >> 1; const int t = seg_t0 + 32 * ci + (g ? 31 - tau : tau);
                bf16* op = hx + (size_t)(rowbase + t) * D + h * 128 + 32 * j + 16 * (lns & 1);
                if (!fin) { v4u w0, w1; w0.x = pk2(x0[0], x0[1]); w0.y = pk2(x0[2], x0[3]); w0.z = pk2(x1[0], x1[1]); w0.w = pk2(x1[2], x1[3]); w1.x = pk2(x2[0], x2[1]); w1.y = pk2(x2[2], x2[3]); w1.z = pk2(x3[0], x3[1]); w1.w = pk2(x3[2], x3[3]);
                    *(GAS v4u*)op = w0; *(GAS v4u*)(op + 8) = w1; }
                else { float pp[8], gg[8], xs[16];
                    unpack8(FN.pa0, pp);
#pragma unroll
                    for (int e = 0; e < 4; ++e) { xs[e] = x0[e] + pp[e]; xs[4 + e] = x1[e] + pp[4 + e]; }
                    unpack8(FN.pa1, pp);
#pragma unroll
                    for (int e = 0; e < 4; ++e) { xs[8 + e] = x2[e] + pp[e]; xs[12 + e] = x3[e] + pp[4 + e]; }
                    float ss = 0.f;
#pragma unroll
                    for (int e = 0; e < 16; ++e) ss += xs[e] * xs[e];
                    ss += __shfl_xor(ss, 1);
                    if ((lns & 1) == 0) SSQ[4 * tau + j] = ss;
                    const LAS float* ghp = EAM + 32 * j + 16 * (lns & 1);
                    unpack8(FN.ga0, gg);
#pragma unroll
                    for (int e = 0; e < 8; ++e) yv[e] = xs[e] * ghp[e] * sigmoidf_(gg[e]);
                    unpack8(FN.ga1, gg);
#pragma unroll
                    for (int e = 0; e < 8; ++e) yv[8 + e] = xs[8 + e] * ghp[8 + e] * sigmoidf_(gg[e]);
                    pend = true; pend_t = seg_t0 + 32 * ci; } }
            LDS_WAIT(); CFENCE();
            if (step + 1 > hmid && step + 1 < nch) hg_issue_fin(FN, g ? hx0 : hx1, proj, rowbase, seg_t0 + 32 * (g ? nch - 2 - step : step + 1), g, h, j, lns);
        }
        {   bf16x8 kt[8], vt[2];
#pragma unroll
            for (int sp = 0; sp < 2; ++sp) vt[sp] = ldstr2(gb + HG_V + fo.o_trn + vcol + (16 * sp * HG_LD) * 2, 4 * HG_LD * 2);
#pragma unroll
            for (int dt = 0; dt < 4; ++dt)
#pragma unroll
                for (int sp = 0; sp < 2; ++sp) kt[2 * dt + sp] = ldstr2(gb + HG_KH + fo.o_trn + (16 * sp * HG_LD + 32 * dt) * 2, 4 * HG_LD * 2);
            __builtin_amdgcn_sched_barrier(0);
#pragma unroll
            for (int dt = 0; dt < 4; ++dt)
#pragma unroll
                for (int sp = 0; sp < 2; ++sp) St[dt] = MFMA32(kt[2 * dt + sp], vt[sp], St[dt]); }
        ST_MARK(2);
        __syncthreads();
        ST_MARK(3);
    } }
    if (OUTPUT) {
        if (pend) { const int lns = launder_v(lane);
            const f32x4 sq = *(const LAS f32x4*)(SSQ + 4 * (lns >> 1)); const float rs = rsqrtf(((sq[0] + sq[1]) + (sq[2] + sq[3])) * (1.f / 128.f) + EPS);
            out16_store(aout, (size_t)(rowbase + pend_t + (g ? 31 - (lns >> 1) : (lns >> 1))) * D + h * 128 + 32 * j + 16 * (lns & 1), yv, rs, out8); }
        item_headnorm(launder_v(tid_l), hx0, hx1, proj, NP_H, 4096, ghead + h * 128, aout, S0.rowbase, S0.t0 + 32 * ((S0.nchunk >> 1) - 1), 64, h, out8); }
    ST_MARK(5);
    if (!OUTPUT) {
        float* e = g ? st_out1 : st_out0; float* ep = e + (4 * hh) * 128 + 32 * j + r;
#pragma unroll
        for (int dt = 0; dt < 4; ++dt)
#pragma unroll
            for (int i = 0; i < 16; ++i) ep[(32 * dt + (i & 3) + 8 * (i >> 2)) * 128] = St[dt][i];
        if ((lane >> 4) == 0) { e[16384 + 32 * j + 2 * (lane & 15)] = atot0; e[16384 + 32 * j + 2 * (lane & 15) + 1] = atot1; }
    }
}
#undef ST_MARK

constexpr int PH_PER_LAYER = 11, PH_BASE = 2, N_PHASES = PH_BASE + DEPTH * PH_PER_LAYER;
#ifndef EN_GEMM
#define EN_GEMM 0xff
#endif
#ifndef EN_ML
#define EN_ML 3
#endif
#ifndef EN_HG
#define EN_HG 3
#endif
#ifndef EN_TOK
#define EN_TOK 1
#endif
#ifndef EN_MISC
#define EN_MISC 1
#endif
#ifndef PG_SP2
#define PG_SP2 true
#endif
#ifndef PG_ALIGN
#define PG_ALIGN true
#endif
#ifndef TIMER_MASK
#define TIMER_MASK 0ull
#endif
#ifndef TIMER_DIV
#define TIMER_DIV 20.0f
#endif
#ifndef MK_SPLIT
#define MK_SPLIT 0
#endif


__device__ __forceinline__ void phase_headnorm(Frame& F, const bf16* hf, const bf16* hb, const bf16* gate, int gpitch, int gcol0, const float* ghead, bf16* aout, int nrows) {
    const int tid = launder_v(F.tid); const int lane = tid & 63, wave = __builtin_amdgcn_readfirstlane(tid >> 6);
    const int gw = F.bid * NWAVES + wave, NGW = F.G * NWAVES;
    float gh[16];
#pragma unroll
    for (int e = 0; e < 16; ++e) gh[e] = ghead[lane * 16 + e];
    for (int row = gw; row < nrows; row += NGW) {
        const v4u a0 = *(const v4u*)(hf + (size_t)row * D + lane * 16), a1 = *(const v4u*)(hf + (size_t)row * D + lane * 16 + 8);
        const v4u b0 = *(const v4u*)(hb + (size_t)row * D + lane * 16), b1 = *(const v4u*)(hb + (size_t)row * D + lane * 16 + 8);
        const v4u g0 = *(const v4u*)(gate + (size_t)row * gpitch + gcol0 + lane * 16), g1 = *(const v4u*)(gate + (size_t)row * gpitch + gcol0 + lane * 16 + 8);
        float x[16], y[8], o[16]; unpack8(a0, y);
#pragma unroll
        for (int e = 0; e < 8; ++e) x[e] = y[e];
        unpack8(a1, y);
#pragma unroll
        for (int e = 0; e < 8; ++e) x[8 + e] = y[e];
        unpack8(b0, y);
#pragma unroll
        for (int e = 0; e < 8; ++e) x[e] += y[e];
        unpack8(b1, y);
#pragma unroll
        for (int e = 0; e < 8; ++e) x[8 + e] += y[e];
        float ss = 0.f;
#pragma unroll
        for (int e = 0; e < 16; ++e) ss += x[e] * x[e];
        ss += __shfl_xor(ss, 1); ss += __shfl_xor(ss, 2); ss += __shfl_xor(ss, 4);
        const float rs = rsqrtf(ss * (1.f / 128.f) + EPS);
        unpack8(g0, y);
#pragma unroll
        for (int e = 0; e < 8; ++e) o[e] = x[e] * rs * gh[e] * sigmoidf_(y[e]);
        unpack8(g1, y);
#pragma unroll
        for (int e = 0; e < 8; ++e) o[8 + e] = x[8 + e] * rs * gh[8 + e] * sigmoidf_(y[e]);
        v4u w0, w1; w0.x = pk2(o[0], o[1]); w0.y = pk2(o[2], o[3]); w0.z = pk2(o[4], o[5]); w0.w = pk2(o[6], o[7]); w1.x = pk2(o[8], o[9]); w1.y = pk2(o[10], o[11]); w1.z = pk2(o[12], o[13]); w1.w = pk2(o[14], o[15]);
        *(v4u*)(aout + (size_t)row * D + lane * 16) = w0; *(v4u*)(aout + (size_t)row * D + lane * 16 + 8) = w1;
    }
}

__device__ __forceinline__ void phase_conv(Frame& F, const bf16* proj, bf16* qkc, float* gates, const float* wconv, const float* bgate) {
    const int gt = F.bid * NTHR + F.tid, cp = gt & 127;
    const int rpb = (M_ALL + F.G - 1) / F.G, rlo = F.bid * rpb, rhi = min(M_ALL, rlo + rpb);
    float w[3][8];
#pragma unroll
    for (int d = 0; d < 3; ++d)
#pragma unroll
        for (int e = 0; e < 8; ++e) w[d][e] = wconv[d * 1024 + cp * 8 + e];
    const float sc = cp >= 64 ? 0.125f : 1.0f;
#pragma unroll 3
    for (int row = rlo + (F.tid >> 7); row < rhi; row += NTHR >> 7) {
        int t, len; if (row < M_LAT) { t = row & (SEQ - 1); len = SEQ; } else { t = (row - M_LAT) & (CTXL - 1); len = CTXL; }
        const bf16* rp = proj + (size_t)row * NP_M + cp * 8;
        const v4u z = (v4u){0u, 0u, 0u, 0u};
        const v4u r0 = t > 0 ? *(const v4u*)(rp - NP_M) : z, r1 = *(const v4u*)rp, r2 = t + 1 < len ? *(const v4u*)(rp + NP_M) : z;
        float x0[8], x1[8], x2[8], o[8]; unpack8(r0, x0); unpack8(r1, x1); unpack8(r2, x2);
#pragma unroll
        for (int e = 0; e < 8; ++e) o[e] = sc * siluf_(w[0][e] * x0[e] + w[1][e] * x1[e] + w[2][e] * x2[e]);
        v4u q; q.x = pk2(o[0], o[1]); q.y = pk2(o[2], o[3]); q.z = pk2(o[4], o[5]); q.w = pk2(o[6], o[7]);
        *(v4u*)(qkc + (size_t)row * D + cp * 8) = q;
    }
    {   const int c4 = (gt * 4) & 31; const f32x4 bg = *(const f32x4*)(bgate + c4); const bool lsg = ((c4 >> 3) & 1) != 0;
#pragma unroll 4
        for (int i = gt; i < M_ALL * 8; i += F.G * NTHR) { f32x4 x = *(const GAS f32x4*)(gates + (size_t)i * 4) + bg;
            if (lsg) {
#pragma unroll
                for (int e = 0; e < 4; ++e) x[e] = fminf(x[e], 0.f) - __logf(1.f + __expf(-fabsf(x[e]))); }
            *(GAS f32x4*)(gates + (size_t)i * 4) = x; } }
}

__device__ __forceinline__ void timer_stamp(unsigned char* lds_raw, bool add) {
    if (threadIdx.x == 0) { volatile LAS unsigned* tw = (volatile LAS unsigned*)((LAS unsigned char*)lds_raw + LDSCTL_OFF) + 32;
        const unsigned long long t = wall_clock64(); const unsigned long long last = ((unsigned long long)tw[1] << 32) | tw[0];
        if (add) { unsigned long long acc = ((unsigned long long)tw[3] << 32) | tw[2]; acc += t - last; tw[2] = (unsigned)acc; tw[3] = (unsigned)(acc >> 32); }
        tw[0] = (unsigned)t; tw[1] = (unsigned)(t >> 32); }
}

__device__ __forceinline__ void seg_of(bool odd, bool ctx_out, int q, int& t0, int& len) {
    int a, b; if (!ctx_out) { a = 2048; b = 2048; } else if (!odd) { a = 30 * 64; b = 34 * 64; } else { a = 60 * 32; b = 68 * 32; }
    t0 = (q == 0) ? 0 : (q == 1) ? a : (q == 2) ? a + b : a + 2 * b; len = (q == 0 || q == 3) ? a : b;
}

__device__ __forceinline__ Frame mkframe(const Args& args, unsigned char* lds_raw) {
    Frame F; int t = threadIdx.x; asm volatile("" : "+v"(t));
    F.lds = (LAS unsigned char*)lds_raw; F.tid = t; F.lane = t & 63; F.wave = __builtin_amdgcn_readfirstlane(t >> 6);
    int g = gridDim.x, b = blockIdx.x; asm volatile("" : "+s"(g), "+s"(b)); F.G = g; F.bid = b;
    const __attribute__((address_space(4))) Args* ap = (const __attribute__((address_space(4))) Args*)__builtin_amdgcn_kernarg_segment_ptr(); asm volatile("" : "+s"(ap));
    F.ws = ap->ws; F.in = ap->in; F.out = ap->out;
    return F;
}
#define PHASE_LOCALS \
    Frame F = mkframe(args, lds_raw); unsigned char* ws = F.ws; \
    float* modv = (float*)(ws + WS_MODV); bf16* U = (bf16*)(ws + WS_U); bf16* Y = (bf16*)(ws + WS_Y); bf16* PROJ = (bf16*)(ws + WS_ACT); bf16* HB = (bf16*)(ws + WS_ACT); \
    bf16* AMOE = (bf16*)(ws + WS_ACT); bf16* HMOE = (bf16*)(ws + WS_ACT + (size_t)MOE_ROWS * D * 2); \
    float* GATES = (float*)(ws + WS_GATES); float* LATC = (float*)(ws + WS_LATC); float* STATE = (float*)(ws + WS_STATE); \
    const int* pexp = (const int*)(ws + WS_SMALL + SM_PEXP); float* SA_U = (float*)(ws + WS_SMALL + SM_SAU); float* SA_U2 = (float*)(ws + WS_SMALL + SM_SAU2); float* SA_MOE = (float*)(ws + WS_GATES + GATES_SAMOE); \
    const float* SWL = (const float*)(ws + WS_SMALL + (odd ? SM_SWO : SM_SWE)); (void)SA_U; (void)SA_U2; (void)SA_MOE; (void)SWL; \
    unsigned char* wb = ws + (odd ? WS_WO : WS_WE); const float* mv = modv + (size_t)L * 9 * 6 * 1024; \
    (void)modv; (void)U; (void)Y; (void)PROJ; (void)HB; (void)AMOE; (void)HMOE; (void)GATES; (void)LATC; (void)STATE; (void)pexp; (void)wb; (void)mv;

__global__ void __launch_bounds__(NTHR, 2) fwd(Args args) {
    extern __shared__ __attribute__((aligned(16))) unsigned char lds_raw[];
    Frame F = mkframe(args, lds_raw);
    volatile LAS unsigned* LCTL = (volatile LAS unsigned*)(F.lds + LDSCTL_OFF);
    for (int u = F.tid; u < 128; u += NTHR) LCTL[u] = 0u;
    __syncthreads();
    XcdBarrier bar; bar.bar = (unsigned*)(F.ws + WS_CTL) + CW_BAR; bar.x = 0; bar.st = nullptr;
    if (args.use_bar) bar = xcd_barrier_post((unsigned*)(F.ws + WS_CTL) + CW_BAR, LCTL + 8);
    const int lo = args.ph_lo, hi = args.ph_hi;
#define IN(k) (lo <= (k) && (k) < hi)
#define SEAM(k) do { if ((k) + 1 < hi) xcd_barrier(bar.bar, bar.x, bar.st); if (TIMER_MASK != 0ull) timer_stamp(lds_raw, ((TIMER_MASK >> (k)) & 1ull) != 0ull); } while (0)
#ifdef TIMER_SPAN
    if (threadIdx.x == 0) { unsigned long long* dbg = (unsigned long long*)((unsigned*)(F.ws + WS_CTL) + CW_DBG); atomicMax(dbg, ~wall_clock64()); }
#endif
#ifdef SPIN_START
    { const unsigned long long t0 = wall_clock64(); while (wall_clock64() - t0 < (unsigned long long)(SPIN_START)) __builtin_amdgcn_s_sleep(8); }
#endif
    if (TIMER_MASK != 0ull) timer_stamp(lds_raw, false);
#ifdef EXTRA_BARS
    for (int eb = 0; eb < EXTRA_BARS; ++eb) xcd_barrier(bar.bar, bar.x, bar.st);
#endif
    if (IN(0)) { const int L = 0; const bool odd = false; PHASE_LOCALS if (EN_MISC) phase_mods(F); __syncthreads(); if (EN_MISC) phase_colmax(F); xcd_barrier(bar.bar, bar.x, bar.st); if (EN_MISC) phase_wconv(F, 0); SEAM(0); }
    if (IN(1)) { const int L = 0; const bool odd = false; PHASE_LOCALS
        TokCfg T{}; T.lat_src_l = F.in[I_X]; T.lat_src_c = F.in[I_CTX]; T.src_f32 = 1; T.vna = modv + 0 * 1024; T.vnb = modv + 1 * 1024; T.u = U; T.u_fp8 = INPROJ_I8 ? 2 : 0; T.u_scale = SA_U; T.nrows = M_ALL;
        if (EN_TOK) phase_tok(F, T); __syncthreads(); if (EN_MISC) phase_wconv(F, 1); SEAM(1);
    }
    for (int L = 0; L < DEPTH; ++L) {
        const int pb = PH_BASE + L * PH_PER_LAYER; const bool odd = (L & 1) != 0; const int jl = L >> 1;
        const bool ctx_out = L < DEPTH - 1;
        if (IN(pb + 0)) { PHASE_LOCALS
            pg8::Order S; pg8::Gemm g;
#if INPROJ_I8
            if (!odd) { g = pg8::Gemm{U, (const bf16*)(wb + WE_IN), M_ALL, NIN_M, D}; S.init(M_ALL / 256, NIN_M, F.G, F.bid, nullptr, 0);
                pg8::EpiStoreI8 E{PROJ, NP_M, NP_M / 256, NP_M / 256, GATES, SA_U, SWL + SWE_IN}; if (EN_GEMM & (1 << 0)) pg8::gemm_phase<pg8::EpiStoreI8, pg8::Order, PG_ALIGN, PG_SP2, 2>(F.lds, g, S, E); }
            else { g = pg8::Gemm{U, (const bf16*)(wb + WOD_IN), M_ALL, NP_H, D}; S.init(M_ALL / 256, NP_H, F.G, F.bid, nullptr, 0);
                pg8::EpiStoreI8 E{PROJ, NP_H, NP_H / 256, -1, nullptr, SA_U, SWL + SWO_IN}; if (EN_GEMM & (1 << 1)) pg8::gemm_phase<pg8::EpiStoreI8, pg8::Order, PG_ALIGN, PG_SP2, 2>(F.lds, g, S, E); }
#else
            if (!odd) { g = pg8::Gemm{U, (const bf16*)(wb + WE_IN), M_ALL, NIN_M, D}; S.init(M_ALL / 256, NIN_M, F.G, F.bid, nullptr, 0);
                pg8::EpiStore E{PROJ, NP_M, NP_M / 256, NP_M / 256, GATES, 1.0f}; if (EN_GEMM & (1 << 0)) pg8::gemm_phase<pg8::EpiStore, pg8::Order, PG_ALIGN, PG_SP2>(F.lds, g, S, E); }
            else { g = pg8::Gemm{U, (const bf16*)(wb + WOD_IN), M_ALL, NP_H, D}; S.init(M_ALL / 256, NP_H, F.G, F.bid, nullptr, 0);
                pg8::EpiStore E{PROJ, NP_H, NP_H / 256, -1, nullptr, 1.0f}; if (EN_GEMM & (1 << 1)) pg8::gemm_phase<pg8::EpiStore, pg8::Order, PG_ALIGN, PG_SP2>(F.lds, g, S, E); }
#endif
            SEAM(pb + 0);
        }
        if (IN(pb + 1)) {
            if (!odd) { PHASE_LOCALS
                phase_conv(F, PROJ, (bf16*)(ws + WS_ACT + 400 * MiB), GATES, F.in[I_MWCONV] + (size_t)jl * 3 * 1024, F.in[I_MBGATE] + jl * 32); SEAM(pb + 1); }
        }
        if (IN(pb + 2)) { PHASE_LOCALS
            for (int id = F.bid; id < 256; id += F.G) {
                const int bh = id >> 2, p = id & 3, b = bh >> 3, h = bh & 7;
                MlSeg SG0, SG1;
                const int csz = odd ? 32 : 64;
                if (p == 0) { SG0 = MlSeg{M_LAT + b * CTXL, CTXL, 0, CTXL / csz}; SG1 = SG0; }
                else { int t0a, la, t0b, lb2; seg_of(odd, ctx_out, p - 1, t0a, la); seg_of(odd, ctx_out, 4 - p, t0b, lb2); SG0 = MlSeg{b * SEQ, SEQ, t0a, la / csz}; SG1 = MlSeg{b * SEQ, SEQ, t0b, lb2 / csz}; }
                if (!odd) { float* e0 = STATE + (size_t)((bh * 2 + 0) * 4 + p) * ML_STATE_F; float* e1 = STATE + (size_t)((bh * 2 + 1) * 4 + p) * ML_STATE_F;
                    if (EN_ML & 1) mlstm_s1_item(F, PROJ, (const bf16*)(ws + WS_ACT + 400 * MiB), GATES, h, SG0, SG1, e0, e1); }
                else { float* e0 = STATE + (size_t)((bh * 2 + 0) * 4 + p) * HG_STATE_F; float* e1 = STATE + (size_t)((bh * 2 + 1) * 4 + p) * HG_STATE_F;
                    if (EN_HG & 1) hgrn_item<false>(F, PROJ, U, (bf16*)(ws + WS_Y), U, F.in[I_HGHEAD] + jl * 1024, F.in[I_HBF] + (size_t)jl * 2048, F.in[I_HLB], jl, h, SG0, SG1, nullptr, nullptr, 0, 0, e0, e1, 0); }
            }
            SEAM(pb + 2);
        }
        if (IN(pb + 3)) { PHASE_LOCALS
            const int nitems = ctx_out ? 320 : 256;
            for (int id = F.bid; id < nitems; id += F.G) {
                MlSeg SG0, SG1; int bh, npre0 = 0, npre1 = 0; const int csz = odd ? 32 : 64;
                if (id < 256) { int q; if (id < 128) { bh = id >> 1; q = (id & 1) ? 3 : 0; } else { bh = (id - 128) >> 1; q = 1 + (id & 1); } int t0q, lq; seg_of(odd, ctx_out, q, t0q, lq); SG0 = MlSeg{(bh >> 3) * SEQ, SEQ, t0q, lq / csz}; npre0 = q + 1; npre1 = 4 - q; }
                else { bh = id - 256; SG0 = MlSeg{M_LAT + (bh >> 3) * CTXL, CTXL, 0, CTXL / csz}; }
                SG1 = SG0;
                const int h = bh & 7;
                if (!odd) { const float* s0 = STATE + (size_t)((bh * 2 + 0) * 4) * ML_STATE_F; const float* s1 = STATE + (size_t)((bh * 2 + 1) * 4) * ML_STATE_F;
                    if (EN_ML & 2) mlstm_item<true>(F, PROJ, (const bf16*)(ws + WS_ACT + 400 * MiB), GATES, (bf16*)(ws + WS_ACT + 536 * MiB), (bf16*)(ws + WS_Y), U, F.in[I_MGHEAD] + jl * 1024, h, SG0, SG1, s0, s1, npre0, npre1, nullptr, nullptr, OUT_FP8_L(L)); }
                else { const float* s0 = STATE + (size_t)((bh * 2 + 0) * 4) * HG_STATE_F; const float* s1 = STATE + (size_t)((bh * 2 + 1) * 4) * HG_STATE_F;
                    if (EN_HG & 2) hgrn_item<true>(F, PROJ, U, (bf16*)(ws + WS_Y), OUT_FP8_L(L) ? (bf16*)(ws + WS_AOUT8) : U, F.in[I_HGHEAD] + jl * 1024, F.in[I_HBF] + (size_t)jl * 2048, F.in[I_HLB], jl, h, SG0, SG1, s0, s1, npre0, npre1, nullptr, nullptr, OUT_FP8_L(L)); }
            }
            SEAM(pb + 3);
        }
        if (IN(pb + 5)) { PHASE_LOCALS
            const int nM = (ctx_out ? M_ALL : M_LAT) / 256;
            pg8::Gemm g{(odd && OUT_FP8_L(L)) ? (const bf16*)(ws + WS_AOUT8) : U, (const bf16*)(wb + (odd ? WOD_OUT : WE_OUT)), nM * 256, D, D}; pg8::Order S; S.init(nM, D, F.G, F.bid, nullptr, 0);
            if (OUT_FP8_L(L)) { if (OUT_FP8_LAYERS) { pg8::EpiStore E{Y, D, D / 256, -1, nullptr, 1.0f / WSCALE8}; if (EN_GEMM & (1 << 2)) pg8::gemm_phase<pg8::EpiStore, pg8::Order, PG_ALIGN, PG_SP2, 1>(F.lds, g, S, E); } }
            else { if ((~(OUT_FP8_LAYERS)) & 0xF) { pg8::EpiStore E{Y, D, D / 256, -1, nullptr, 1.0f}; if (EN_GEMM & (1 << 2)) pg8::gemm_phase<pg8::EpiStore, pg8::Order, PG_ALIGN, PG_SP2>(F.lds, g, S, E); } }
            SEAM(pb + 5);
        }
        if (IN(pb + 6)) { PHASE_LOCALS
            TokCfg T{}; bf16* LAT16 = (bf16*)(ws + WS_ACT + 836 * MiB); T.src_f32 = (L == 0) ? 1 : 0; T.lat_src_l = (L == 0) ? (const void*)F.in[I_X] : (const void*)LAT16; T.lat_src_c = (L == 0) ? (const void*)F.in[I_CTX] : (const void*)LATC; T.lat_dst_l = LAT16; T.lat_dst_c = LATC;
            T.y = Y; T.y_perm = odd ? 1 : 0; T.vupd = mv + 2 * 1024; T.vna = mv + 3 * 1024; T.vnb = mv + 4 * 1024; T.u = U; T.u_fp8 = ((UP_I8 && !odd) || (UP_I8_MOE && odd)) ? 2 : FFN_FP8_L(L); T.u_scale = SA_U2; T.route = odd ? 1 : 0; T.jr = jl; T.nrows = ctx_out ? M_ALL : M_LAT;
            if (EN_TOK) phase_tok(F, T);
            if (L >= 1 && L + 1 < DEPTH) { __syncthreads(); if (EN_MISC) phase_wconv(F, L + 1); }
            SEAM(pb + 6);
        }
        if (IN(pb + 7)) { PHASE_LOCALS
            if (odd) { if (EN_MISC) phase_moe_scatter(F, jl, ctx_out ? M_ALL : M_LAT, (const unsigned char*)U, (unsigned char*)AMOE, (UP_I8_MOE || FFN_FP8_L(L)) ? 1024 : 2048, UP_I8_MOE ? SA_U2 : nullptr, SA_MOE); SEAM(pb + 7); }
        }
        if (IN(pb + 8)) { PHASE_LOCALS
            if (!odd) { pg8::Gemm g{U, (const bf16*)(wb + WE_GU), M_ALL, NGU, D}; pg8::Order S; S.init(M_ALL / 256, NGU, F.G, F.bid, nullptr, 0);
#if UP_I8
                pg8::EpiSwiGLU8I E{(unsigned char*)HB, FF, SA_U2, SWL + SWE_GU, nullptr, 0, FFN_FP8_L(L) ? 0 : 1}; if (EN_GEMM & (1 << 3)) pg8::gemm_phase<pg8::EpiSwiGLU8I, pg8::Order, PG_ALIGN, PG_SP2, 2>(F.lds, g, S, E);
#else
                pg8::EpiSwiGLU8 E{(unsigned char*)HB, FF, 1.0f / WSCALE8}; if (EN_GEMM & (1 << 3)) pg8::gemm_phase<pg8::EpiSwiGLU8, pg8::Order, PG_ALIGN, PG_SP2, 1>(F.lds, g, S, E);
#endif
            }
            else { const int np = __builtin_amdgcn_readfirstlane(pexp[MOE_PANELS]);
                pg8::Gemm g{AMOE, (const bf16*)(wb + WOD_GU), np * 256, NGU, D}; pg8::Order S; S.init(np, NGU, F.G, F.bid, pexp, EGU_BYTES);
#if UP_I8_MOE
                pg8::EpiSwiGLU8I E{(unsigned char*)HMOE, FF, SA_MOE, SWL + SWO_GU, pexp, NGU, 0}; if (EN_GEMM & (1 << 4)) pg8::gemm_phase<pg8::EpiSwiGLU8I, pg8::Order, PG_ALIGN, PG_SP2, 2>(F.lds, g, S, E); }
#else
                pg8::EpiSwiGLU8 E{(unsigned char*)HMOE, FF, 1.0f / WSCALE8}; if (EN_GEMM & (1 << 4)) pg8::gemm_phase<pg8::EpiSwiGLU8, pg8::Order, PG_ALIGN, PG_SP2, 1>(F.lds, g, S, E); }
#endif
            SEAM(pb + 8);
        }
        if (IN(pb + 9)) { PHASE_LOCALS
            const bool f8 = FFN_FP8_L(L) != 0;
            if (!odd) { pg8::Gemm g{HB, (const bf16*)(wb + WE_DOWN), M_ALL, D, FF}; pg8::Order S; S.init(M_ALL / 256, D, F.G, F.bid, nullptr, 0);
                if (f8) { if ((FP8_LAYERS) & 0x5) { pg8::EpiStore E{Y, D, D / 256, -1, nullptr, 1.0f / WSCALE8}; if (EN_GEMM & (1 << 5)) pg8::gemm_phase<pg8::EpiStore, pg8::Order, PG_ALIGN, PG_SP2, 1>(F.lds, g, S, E); } }
                else { if ((~(FP8_LAYERS)) & 0x5) { pg8::EpiStore E{Y, D, D / 256, -1, nullptr, 1.0f}; if (EN_GEMM & (1 << 5)) pg8::gemm_phase<pg8::EpiStore, pg8::Order, PG_ALIGN, PG_SP2>(F.lds, g, S, E); } } }
            else { const int np = __builtin_amdgcn_readfirstlane(pexp[MOE_PANELS]);
                pg8::Gemm g{HMOE, (const bf16*)(wb + WOD_DOWN), np * 256, D, FF}; pg8::Order S; S.init(np, D, F.G, F.bid, pexp, EDOWN_BYTES);
                if (f8) { if ((FP8_LAYERS) & 0xA) { pg8::EpiStore E{AMOE, D, D / 256, -1, nullptr, 1.0f / WSCALE8}; if (EN_GEMM & (1 << 6)) pg8::gemm_phase<pg8::EpiStore, pg8::Order, PG_ALIGN, PG_SP2, 1>(F.lds, g, S, E); } }
                else { if ((~(FP8_LAYERS)) & 0xA) { pg8::EpiStore E{AMOE, D, D / 256, -1, nullptr, 1.0f}; if (EN_GEMM & (1 << 6)) pg8::gemm_phase<pg8::EpiStore, pg8::Order, PG_ALIGN, PG_SP2>(F.lds, g, S, E); } } }
            SEAM(pb + 9);
        }
        if (IN(pb + 10)) { PHASE_LOCALS
            TokCfg T{}; bf16* LAT16 = (bf16*)(ws + WS_ACT + 836 * MiB); T.lat_src_l = LAT16; T.lat_src_c = LATC; T.lat_dst_l = (L + 1 < DEPTH) ? (void*)LAT16 : (void*)F.out; T.lat_dst_c = LATC; T.dst_f32 = (L + 1 < DEPTH) ? 0 : 1;
            T.y = odd ? AMOE : Y; T.moe_combine = odd ? 1 : 0; T.vupd = mv + 5 * 1024; T.nrows = ctx_out ? M_ALL : M_LAT;
            if (L + 1 < DEPTH) { const float* mn = modv + (size_t)(L + 1) * 9 * 6 * 1024; T.vna = mn; T.vnb = mn + 1024; T.u = U; T.u_perm = ((L + 1) & 1) ? 1 : 0; T.u_fp8 = INPROJ_I8 ? 2 : 0; T.u_scale = SA_U; }
            if (EN_TOK) phase_tok(F, T);
            SEAM(pb + 10);
        }
    }
    if (TIMER_MASK != 0ull) { timer_stamp(lds_raw, ((TIMER_MASK >> (N_PHASES - 1)) & 1ull) != 0ull);
        if (blockIdx.x == 0 && threadIdx.x == 0) { volatile LAS unsigned* tw = (volatile LAS unsigned*)((LAS unsigned char*)lds_raw + LDSCTL_OFF) + 32; const unsigned long long acc = ((unsigned long long)tw[3] << 32) | tw[2];
            asm volatile("s_waitcnt vmcnt(0)" ::: "memory"); args.out[0] = (float)acc * 0.01f / TIMER_DIV; } }
#ifdef PROBE_WS
    __syncthreads();
    if (blockIdx.x == 0 && threadIdx.x == 0) { asm volatile("s_waitcnt vmcnt(0)" ::: "memory"); args.out[0] = (float)(args.pad - 1369); }
#endif
#ifdef SUBT
    __syncthreads();
    if (blockIdx.x == 0 && threadIdx.x == 0) { volatile LAS unsigned* tw = (volatile LAS unsigned*)((LAS unsigned char*)lds_raw + LDSCTL_OFF) + 40; asm volatile("s_waitcnt vmcnt(0)" ::: "memory"); args.out[0] = (float)tw[SUBT] * 0.01f / SUBT_DIV; }
#endif
#ifdef TIMER_SPAN
    __syncthreads();
    if (threadIdx.x == 0) { unsigned long long* dbg = (unsigned long long*)((unsigned*)(args.ws + WS_CTL) + CW_DBG);
        asm volatile("s_waitcnt vmcnt(0)" ::: "memory"); __threadfence();
        if (blockIdx.x != 0) { atomicMax(dbg + 1, wall_clock64()); __threadfence(); atomicAdd(dbg + 2, 1ull); }
        else { while (atomicAdd(dbg + 2, 0ull) < (unsigned long long)(gridDim.x - 1)) __builtin_amdgcn_s_sleep(4);
            unsigned long long te = atomicMax(dbg + 1, 0ull); const unsigned long long tn = wall_clock64(); if (tn > te) te = tn; const unsigned long long ts = ~atomicMax(dbg, 0ull);
            args.out[0] = (float)(te - ts) * 0.01f / TIMER_SPAN; } }
#endif
#ifdef SPIN_TICKS
    { const unsigned long long t0 = wall_clock64(); while (wall_clock64() - t0 < (unsigned long long)(SPIN_TICKS)) __builtin_amdgcn_s_sleep(8); }
#endif
#undef IN
#undef SEAM
}

extern "C" void kernel_launch(void* const* d_in, const int* in_sizes, int n_in, void* d_out, int out_size, void* d_ws, size_t ws_size, hipStream_t stream) {
    static int grid = 0;
    if (grid == 0) {
        if (n_in != 23 || out_size != M_LAT * D || ws_size < WS_END) { fprintf(stderr, "kernel_launch: unexpected shapes / workspace (n_in %d out %d ws %zu need %zu)\n", n_in, out_size, ws_size, (size_t)WS_END); grid = -1; return; }
        int dev = 0, cus = 0, per_cu = 0;
        if (hipGetDevice(&dev) != hipSuccess || hipDeviceGetAttribute(&cus, hipDeviceAttributeMultiprocessorCount, dev) != hipSuccess) { grid = -1; return; }
        if (hipFuncSetAttribute((const void*)fwd, hipFuncAttributeMaxDynamicSharedMemorySize, LDS_BYTES) != hipSuccess) { fprintf(stderr, "kernel_launch: hipFuncSetAttribute failed\n"); grid = -1; return; }
        if (hipOccupancyMaxActiveBlocksPerMultiprocessor(&per_cu, (const void*)fwd, NTHR, LDS_BYTES) != hipSuccess || per_cu < 1) fprintf(stderr, "kernel_launch: occupancy query reports %d\n", per_cu);
        (void)hipGetLastError();
        grid = cus;
    }
    if (grid < 0) return;
    (void)hipMemsetAsync((char*)d_ws + WS_CTL, 0, CTL_ZERO_BYTES, stream);
    Args a{};
    for (int i = 0; i < 23; ++i) a.in[i] = (const float*)d_in[i];
    a.out = (float*)d_out; a.ws = (unsigned char*)d_ws;
#if MK_SPLIT
    for (int p = 0; p < N_PHASES; ++p) { a.ph_lo = p; a.ph_hi = p + 1; a.use_bar = 0; a.pad = 0; hipLaunchKernelGGL(fwd, dim3(grid), dim3(NTHR), LDS_BYTES, stream, a); }
#else
    a.ph_lo = 0; a.ph_hi = N_PHASES; a.use_bar = 1; a.pad = 0;
#ifdef PROBE_WS
    a.pad = (int)(ws_size >> 20);
#endif
    hipLaunchKernelGGL(fwd, dim3(grid), dim3(NTHR), LDS_BYTES, stream, a);
#endif
}
```
